# Optimizing an MI355X kernel written in HIP

```python
import math
import jax
import jax.numpy as jnp
from jax import lax
import numpy as np

D_MODEL = 4096
BATCH = 1
SEQ = 16384
DEPTH = 4

GRID_W = 64
HEAD_DIM = 128
N_HEADS = D_MODEL // HEAD_DIM
N_KV_HEADS = max(1, N_HEADS // 4)
KV_DIM = N_KV_HEADS * HEAD_DIM
NA_MAX_ROWS = 8
NA_KW = 16
Q_BLOCK = 128
ROPE_THETA = 10000.0
S5_GROUP = 16
S5_GROUPS = D_MODEL // S5_GROUP
S5_STATE = 64
S5_GROUPS_PER_BLOCK = math.gcd(32, S5_GROUPS)
S5_DT_MIN = 1e-3
S5_DT_MAX = 1e-1
D_FF = 4 * D_MODEL
PLE_DIM = 256
N_MIXERS = 3
N_NA_LAYERS = (DEPTH + 2) // 3
N_GQA_LAYERS = (DEPTH + 1) // 3
N_S5_LAYERS = DEPTH // 3
RES_SCALE = (2 * DEPTH) ** -0.5
EPS = 1e-6

kernel_name = 'hybrid_na_gqa_s5_encoder'


def rms_norm(x, gain):
    xf = x.astype(jnp.float32)
    y = xf * lax.rsqrt(jnp.mean(xf * xf, axis=-1, keepdims=True) + EPS)
    return (y * gain.astype(jnp.float32)).astype(x.dtype)


def neighbourhood_attention(hn, w_qkv, w_o, q_gain, k_gain, rpb):
    b, L, d = hn.shape
    rows = L // GRID_W
    kh = min(NA_MAX_ROWS, rows)
    kw = NA_KW
    q, k, v = jnp.split(hn @ w_qkv, 3, axis=-1)
    shp = (b, rows, GRID_W, N_HEADS, HEAD_DIM)
    q = rms_norm(q.reshape(shp), q_gain) * HEAD_DIM ** -0.5
    k = rms_norm(k.reshape(shp), k_gain)
    v = v.reshape(shp)
    cols = jnp.arange(GRID_W)
    c0 = jnp.clip(cols - kw // 2, 0, GRID_W - kw)
    col_idx = c0[:, None] + jnp.arange(kw)[None, :]
    col_rel = col_idx - cols[:, None] + (NA_KW - 1)

    def row_block(r):
        r0 = jnp.clip(r - kh // 2, 0, rows - kh)
        row_rel = jnp.arange(kh) - (r - r0) + (NA_MAX_ROWS - 1)
        k_win = lax.dynamic_slice_in_dim(k, r0, kh, axis=1)[:, :, col_idx]
        v_win = lax.dynamic_slice_in_dim(v, r0, kh, axis=1)[:, :, col_idx]
        q_r = lax.dynamic_index_in_dim(q, r, axis=1, keepdims=False)
        s = jnp.einsum('bwhd,bawkhd->bhwak', q_r, k_win).astype(jnp.float32)
        bias = rpb[:, row_rel[None, :, None], col_rel[:, None, :]]
        s = s + bias.astype(jnp.float32)[None]
        pr = jax.nn.softmax(s.reshape(b, N_HEADS, GRID_W, kh * kw), axis=-1).reshape(s.shape)
        return jnp.einsum('bhwak,bawkhd->bwhd', pr.astype(v.dtype), v_win)

    o = lax.map(row_block, jnp.arange(rows))
    o = jnp.moveaxis(o, 0, 1).reshape(b, L, d)
    return o @ w_o


def axial_rope_tables(L):
    t = jnp.arange(L)
    row = (t // GRID_W).astype(jnp.float32)
    col = (t % GRID_W).astype(jnp.float32)
    nf = HEAD_DIM // 4
    inv = 1.0 / (ROPE_THETA ** (jnp.arange(nf, dtype=jnp.float32) / nf))
    ang = jnp.stack([row[:, None] * inv, col[:, None] * inv], axis=1)
    return jnp.cos(ang), jnp.sin(ang)


def apply_axial_rope(x, cos, sin):
    b, L, h, dh = x.shape
    xf = x.astype(jnp.float32).reshape(b, L, h, 2, 2, dh // 4)
    x1, x2 = xf[..., 0, :], xf[..., 1, :]
    c = cos[None, :, None]
    s = sin[None, :, None]
    out = jnp.stack([x1 * c - x2 * s, x2 * c + x1 * s], axis=-2)
    return out.reshape(b, L, h, dh).astype(x.dtype)


def gqa_axial_attention(hn, w_qkv, w_o, q_gain, k_gain):
    b, L, d = hn.shape
    qkv = hn @ w_qkv
    q = qkv[..., :d].reshape(b, L, N_HEADS, HEAD_DIM)
    k = qkv[..., d:d + KV_DIM].reshape(b, L, N_KV_HEADS, HEAD_DIM)
    v = qkv[..., d + KV_DIM:].reshape(b, L, N_KV_HEADS, HEAD_DIM)
    cos, sin = axial_rope_tables(L)
    q = apply_axial_rope(rms_norm(q, q_gain), cos, sin) * HEAD_DIM ** -0.5
    k = apply_axial_rope(rms_norm(k, k_gain), cos, sin)
    groups = N_HEADS // N_KV_HEADS
    nb = L // Q_BLOCK
    qb = jnp.moveaxis(q.reshape(b, nb, Q_BLOCK, N_KV_HEADS, groups, HEAD_DIM), 1, 0)

    def block(qblk):
        s = jnp.einsum('bqkgd,bskd->bkgqs', qblk, k).astype(jnp.float32)
        pr = jax.nn.softmax(s, axis=-1)
        return jnp.einsum('bkgqs,bskd->bqkgd', pr.astype(v.dtype), v)

    o = lax.map(block, qb)
    o = jnp.moveaxis(o, 0, 1).reshape(b, L, d)
    return o @ w_o


def _complex_linear_combine(e1, e2):
    a1r, a1i, b1r, b1i = e1
    a2r, a2i, b2r, b2i = e2
    return (a2r * a1r - a2i * a1i,
            a2r * a1i + a2i * a1r,
            a2r * b1r - a2i * b1i + b2r,
            a2r * b1i + a2i * b1r + b2i)


def s5_scan_direction(u, lam_re, lam_im, log_step, b_re, b_im, c_re, c_im, reverse):
    dt = jnp.exp(log_step)[:, None]
    mag = jnp.exp(lam_re * dt)
    a_re = mag * jnp.cos(lam_im * dt)
    a_im = mag * jnp.sin(lam_im * dt)
    den = lam_re * lam_re + lam_im * lam_im
    num_re = a_re - 1.0
    z_re = (num_re * lam_re + a_im * lam_im) / den
    z_im = (a_im * lam_re - num_re * lam_im) / den
    bb_re = z_re[..., None] * b_re - z_im[..., None] * b_im
    bb_im = z_re[..., None] * b_im + z_im[..., None] * b_re
    bu_re = jnp.einsum('blgp,gnp->blgn', u, bb_re)
    bu_im = jnp.einsum('blgp,gnp->blgn', u, bb_im)
    ar = jnp.broadcast_to(a_re, bu_re.shape)
    ai = jnp.broadcast_to(a_im, bu_re.shape)
    _, _, x_re, x_im = lax.associative_scan(_complex_linear_combine, (ar, ai, bu_re, bu_im), reverse=reverse, axis=1)
    return jnp.einsum('blgn,gpn->blgp', x_re, c_re) - jnp.einsum('blgn,gpn->blgp', x_im, c_im)


def s5_mixer(hn, w_in, lam_re, lam_im, log_step, b_re, b_im, c_re, c_im, d_skip, w_out):
    bsz, L, d = hn.shape
    f32 = jnp.float32
    u = (hn @ w_in).astype(f32)
    nblk = S5_GROUPS // S5_GROUPS_PER_BLOCK
    gb = S5_GROUPS_PER_BLOCK
    u_blk = jnp.moveaxis(u.reshape(bsz, L, nblk, gb, S5_GROUP), 2, 0)

    def chunk_params(a):
        return jnp.moveaxis(a.astype(f32).reshape((2, nblk, gb) + a.shape[2:]), 1, 0)

    params = tuple(chunk_params(a) for a in (lam_re, lam_im, log_step, b_re, b_im, c_re, c_im))

    def group_block(args):
        u_c, lr, li, ls, br, bi, cr, ci = args
        y_fwd = s5_scan_direction(u_c, lr[0], li[0], ls[0], br[0], bi[0], cr[0], ci[0], False)
        y_bwd = s5_scan_direction(u_c, lr[1], li[1], ls[1], br[1], bi[1], cr[1], ci[1], True)
        return y_fwd + y_bwd

    y = lax.map(group_block, (u_blk,) + params)
    y = jnp.moveaxis(y, 0, 2).reshape(bsz, L, d)
    y = y + d_skip.astype(f32) * u
    g = jax.nn.gelu(y).astype(hn.dtype)
    a, gate = jnp.split(g @ w_out, 2, axis=-1)
    return a * jax.nn.sigmoid(gate)


def squared_relu_mlp(hn, w1, w2):
    return jnp.square(jax.nn.relu(hn @ w1)) @ w2


def setup_inputs(seed: int = 0) -> dict:
    key = jax.random.key(seed)
    k = jax.random.split(key, 28)
    f32 = jnp.float32
    D = D_MODEL

    def nrm(i, shape, std):
        return std * jax.random.normal(k[i], shape, f32)

    s5_shape = (N_S5_LAYERS, 2, S5_GROUPS, S5_STATE)
    n_idx = jnp.arange(S5_STATE, dtype=f32)
    return {
        'x': nrm(0, (BATCH, SEQ, D), 1.0),
        'p': nrm(1, (DEPTH, BATCH, SEQ, PLE_DIM), 1.0),
        'mix_norm': 1.0 + nrm(2, (DEPTH, D), 0.1),
        'mlp_norm': 1.0 + nrm(3, (DEPTH, D), 0.1),
        'ple_norm': 1.0 + nrm(4, (DEPTH, D), 0.1),
        'na_w_qkv': nrm(5, (N_NA_LAYERS, D, 3 * D), D ** -0.5),
        'na_w_o': nrm(6, (N_NA_LAYERS, D, D), RES_SCALE * D ** -0.5),
        'na_q_gain': 1.0 + nrm(7, (N_NA_LAYERS, HEAD_DIM), 0.1),
        'na_k_gain': 1.0 + nrm(8, (N_NA_LAYERS, HEAD_DIM), 0.1),
        'na_rpb': nrm(9, (N_NA_LAYERS, N_HEADS, 2 * NA_MAX_ROWS - 1, 2 * NA_KW - 1), 0.2),
        'gqa_w_qkv': nrm(10, (N_GQA_LAYERS, D, D + 2 * KV_DIM), D ** -0.5),
        'gqa_w_o': nrm(11, (N_GQA_LAYERS, D, D), RES_SCALE * D ** -0.5),
        'gqa_q_gain': 1.0 + nrm(12, (N_GQA_LAYERS, HEAD_DIM), 0.1),
        'gqa_k_gain': 1.0 + nrm(13, (N_GQA_LAYERS, HEAD_DIM), 0.1),
        's5_w_in': nrm(14, (N_S5_LAYERS, D, D), D ** -0.5),
        's5_lam_re': -0.5 + nrm(15, s5_shape, 0.05),
        's5_lam_im': math.pi * n_idx + nrm(16, s5_shape, 0.05),
        's5_log_step': jax.random.uniform(k[17], (N_S5_LAYERS, 2, S5_GROUPS), f32, math.log(S5_DT_MIN), math.log(S5_DT_MAX)),
        's5_b_re': nrm(18, s5_shape + (S5_GROUP,), (2 * S5_GROUP) ** -0.5),
        's5_b_im': nrm(19, s5_shape + (S5_GROUP,), (2 * S5_GROUP) ** -0.5),
        's5_c_re': nrm(20, (N_S5_LAYERS, 2, S5_GROUPS, S5_GROUP, S5_STATE), S5_STATE ** -0.5),
        's5_c_im': nrm(21, (N_S5_LAYERS, 2, S5_GROUPS, S5_GROUP, S5_STATE), S5_STATE ** -0.5),
        's5_d': nrm(22, (N_S5_LAYERS, D), 1.0),
        's5_w_out': nrm(23, (N_S5_LAYERS, D, 2 * D), RES_SCALE * D ** -0.5),
        'mlp_w1': nrm(24, (DEPTH, D, D_FF), D ** -0.5),
        'mlp_w2': nrm(25, (DEPTH, D_FF, D), RES_SCALE * D_FF ** -0.5),
        'ple_w_proj': nrm(26, (DEPTH, PLE_DIM, D), RES_SCALE * PLE_DIM ** -0.5),
        'ple_w_gate': nrm(27, (DEPTH, D, D), D ** -0.5),
    }


def reference(x, p, mix_norm, mlp_norm, ple_norm, na_w_qkv, na_w_o, na_q_gain, na_k_gain, na_rpb,
              gqa_w_qkv, gqa_w_o, gqa_q_gain, gqa_k_gain, s5_w_in, s5_lam_re, s5_lam_im, s5_log_step,
              s5_b_re, s5_b_im, s5_c_re, s5_c_im, s5_d, s5_w_out, mlp_w1, mlp_w2, ple_w_proj, ple_w_gate):
    h = x
    for i in range(DEPTH):
        kind = i % N_MIXERS
        slot = i // N_MIXERS
        hn = rms_norm(h, mix_norm[i])
        if kind == 0:
            y = neighbourhood_attention(hn, na_w_qkv[slot], na_w_o[slot], na_q_gain[slot], na_k_gain[slot], na_rpb[slot])
        elif kind == 1:
            y = gqa_axial_attention(hn, gqa_w_qkv[slot], gqa_w_o[slot], gqa_q_gain[slot], gqa_k_gain[slot])
        else:
            y = s5_mixer(hn, s5_w_in[slot], s5_lam_re[slot], s5_lam_im[slot], s5_log_step[slot],
                         s5_b_re[slot], s5_b_im[slot], s5_c_re[slot], s5_c_im[slot], s5_d[slot], s5_w_out[slot])
        h = h + y.astype(h.dtype)
        h = h + squared_relu_mlp(rms_norm(h, mlp_norm[i]), mlp_w1[i], mlp_w2[i]).astype(h.dtype)
        gate = jax.nn.sigmoid(rms_norm(h, ple_norm[i]) @ ple_w_gate[i])
        h = h + (gate * (p[i].astype(h.dtype) @ ple_w_proj[i])).astype(h.dtype)
    return h
```

```cpp
#include <hip/hip_runtime.h>
#include <cstdio>
#include <cstdint>

#ifndef MK_N_LAUNCHES
#define MK_N_LAUNCHES 1
#endif

constexpr int L = 16384, DM = 4096, DEPTH = 4, GRID_W = 64, GROWS = L / GRID_W, HD = 128, NH = 32, NKV = 8, KVD = NKV * HD, FF = 4 * DM, PLE = 256;
constexpr int S5G = 256, S5P = 16, S5N = 64, S5TC = 16, S5NC = L / S5TC;
constexpr float EPS = 1e-6f;

#define GAS __attribute__((address_space(1)))
#define LAS __attribute__((address_space(3)))
typedef unsigned short bf16;
typedef unsigned v4u __attribute__((ext_vector_type(4)));
typedef unsigned v2u __attribute__((ext_vector_type(2)));
typedef float f32x4 __attribute__((ext_vector_type(4)));
typedef float f32x2 __attribute__((ext_vector_type(2)));
typedef short bf16x8 __attribute__((ext_vector_type(8)));
typedef short s16x4 __attribute__((ext_vector_type(4)));
typedef GAS unsigned gu32;
#define RLX_AGENT __ATOMIC_RELAXED, __HIP_MEMORY_SCOPE_AGENT
#define LDS_WAIT() asm volatile("s_waitcnt lgkmcnt(0)" ::: "memory")
#define VM_WAIT() asm volatile("s_waitcnt vmcnt(0)" ::: "memory")
__device__ __forceinline__ unsigned f2bf(float f) { unsigned u = __builtin_bit_cast(unsigned, f); return (u + 0x7fffu + ((u >> 16) & 1u)) >> 16; }
__device__ __forceinline__ unsigned pk2(float lo, float hi) { return f2bf(lo) | (f2bf(hi) << 16); }
__device__ __forceinline__ float bf2f(unsigned short b) { return __builtin_bit_cast(float, (unsigned)b << 16); }
__device__ __forceinline__ float bflo(unsigned w) { return __builtin_bit_cast(float, w << 16); }
__device__ __forceinline__ float bfhi(unsigned w) { return __builtin_bit_cast(float, w & 0xffff0000u); }
__device__ __forceinline__ float sigmoidf_fast(float x) { return __builtin_amdgcn_rcpf(1.0f + __builtin_amdgcn_exp2f(-1.4426950408889634f * x)); }

namespace pg8 {
#define PG8_LAS __attribute__((address_space(3)))
#if defined(PROBE_EPI2)
#define PROBE_EPI_DUP if constexpr (Epi::PERM) E(acc, cur, wr, wc, fr, fq);
#else
#define PROBE_EPI_DUP
#endif
typedef unsigned short bf16_t;
typedef short bf16x8 __attribute__((ext_vector_type(8)));
typedef float f32x4 __attribute__((ext_vector_type(4)));
typedef unsigned u32x4 __attribute__((ext_vector_type(4)));
constexpr int BM = 256, BK = 64, HALF = 128, HTB = HALF * BK * 2  , STAGE_BYTES = 8 * HTB, NXCD = 8, WGM = 8;

__host__ __device__ __forceinline__ int lds_byte(int r, int c) { const int st = (r >> 4) * 2 + (c >> 5), rr = r & 15, cc = c & 31, ob = rr * 64 + cc * 2; return st * 1024 + (ob ^ (((ob >> 9) & 1) << 5)); }
__host__ __device__ __forceinline__ void stage_rc(int b, int& R, int& C) { const int st = b / 1024, sb = b % 1024, swz = sb ^ (((sb >> 9) & 1) << 5); R = (st >> 1) * 16 + swz / 64; C = (st & 1) * 32 + (swz % 64) / 2; }
__host__ __device__ __forceinline__ int perm32(int rho) { const int n = rho >> 4, i = rho & 15; return 8 * (i >> 2) + 4 * n + (i & 3); }

struct Unit { int pm, pn; };
struct Gemm { const bf16_t* A; const bf16_t* Bt; int M, N, K, lda, ldb; };
__host__ __device__ __forceinline__ Gemm mkgemm(const bf16_t* A, const bf16_t* Bt, int M, int N, int K) { Gemm g; g.A = A; g.Bt = Bt; g.M = M; g.N = N; g.K = K; g.lda = K; g.ldb = K; return g; }

struct StaticOrder {
    int nM, nN, nwg, G, c;
    __host__ __device__ void init(int M, int N, int G_, int c_) { nM = M / BM; nN = N / BM; nwg = nM * nN; G = G_; c = c_; }
    __host__ __device__ bool next(int i, Unit& u) const {
        const long L = (long)i * G + c; if (L >= nwg) return false;
        int wgid = (int)L; { const int q = nwg / NXCD, r = nwg % NXCD, xcd = wgid % NXCD, off = wgid / NXCD; wgid = (xcd < r ? xcd * (q + 1) : r * (q + 1) + (xcd - r) * q) + off; }
        const int nig = WGM * nN, gid = wgid / nig, fm = gid * WGM, gsz = (nM - fm) < WGM ? (nM - fm) : WGM;
        u.pm = fm + ((wgid % nig) % gsz); u.pn = (wgid % nig) / gsz; return true;
    }
    __device__ __forceinline__ void a_ready(const Unit&) const {}
    __device__ __forceinline__ void done(const Unit&) const {}
};
struct RangeOrder { StaticOrder S; int i0, i1;
    __host__ __device__ bool next(int i, Unit& u) const { return (i + i0 < i1) ? S.next(i + i0, u) : false; }
    __device__ __forceinline__ void a_ready(const Unit&) const {}
    __device__ __forceinline__ void done(const Unit&) const {} };


__device__ __forceinline__ unsigned cvt_pk_bf16(float lo, float hi) { unsigned r; asm volatile("v_cvt_pk_bf16_f32 %0, %1, %2" : "=v"(r) : "v"(lo), "v"(hi)); return r; }
__device__ __forceinline__ float sigm(float x) { return __builtin_amdgcn_rcpf(1.0f + __builtin_amdgcn_exp2f(-1.4426950408889634f * x)); }

typedef unsigned long long rs_t;
constexpr float RS_FIX = 16777216.0f, RS_INV = 1.0f / (16777216.0f * 4096.0f), RS_EPS = 1e-6f;
__device__ __forceinline__ void row_ss_add(rs_t* rs, int row, float s, int fq) {
    s += __shfl_xor(s, 16); s += __shfl_xor(s, 32);
    if (fq == 0) __hip_atomic_fetch_add(rs + row, (rs_t)(s * RS_FIX), __ATOMIC_RELAXED, __HIP_MEMORY_SCOPE_AGENT);
}
__device__ __forceinline__ float rs_rinv(rs_t v) { return __builtin_amdgcn_rsqf((float)v * RS_INV + RS_EPS); }
#define PIN8(a) asm volatile("" : "+v"((a)[0]), "+v"((a)[1]), "+v"((a)[2]), "+v"((a)[3]), "+v"((a)[4]), "+v"((a)[5]), "+v"((a)[6]), "+v"((a)[7]))
template <int ACT> struct EpiBf16 {
    static constexpr bool PERM = true, AFTER_DRAIN = false;
    bf16_t *O0, *O1, *O2; int ld0, ld1, ld2, c1, c2; const rs_t* rs; int vt; int rs_from;
    __device__ __forceinline__ void operator()(const f32x4 (&acc)[2][2][4][2], const Unit& u, int wr, int wc, int fr, int fq) const {
        const int row0 = u.pm * BM + wr * 64 + fr; int colt = u.pn * BM; bf16_t* base = O0; int ldc = ld0;
        const rs_t* rs = (colt >= rs_from) ? this->rs : nullptr;
        bool tr = false;
        if (colt >= c2) { base = O2; ldc = ld2; colt -= c2; tr = vt != 0; } else if (colt >= c1) { base = O1; ldc = ld1; colt -= c1; }
        const int col0 = colt + wc * 32 + 8 * fq;
        rs_t scv[8];
#pragma unroll
        for (int gi = 0; gi < 8; ++gi) scv[gi] = rs ? rs[row0 + (gi >> 2) * HALF + (gi & 3) * 16] : 0ull;
        PIN8(scv);
#pragma unroll
        for (int ai = 0; ai < 2; ++ai)
#pragma unroll
            for (int m = 0; m < 4; ++m) { bf16_t* rowp = base + (size_t)(row0 + ai * HALF + m * 16) * ldc + col0; const float sc = rs ? rs_rinv(scv[ai * 4 + m]) : 1.0f;
#pragma unroll
                for (int bj = 0; bj < 2; ++bj) { f32x4 v0 = acc[ai][bj][m][0] * sc, v1 = acc[ai][bj][m][1] * sc;
                    if (ACT == 2) {
#pragma unroll
                        for (int j = 0; j < 4; ++j) { const float a = fmaxf(v0[j], 0.f), b = fmaxf(v1[j], 0.f); v0[j] = a * a; v1[j] = b * b; } }
                    u32x4 w; w.x = cvt_pk_bf16(v0[0], v0[1]); w.y = cvt_pk_bf16(v0[2], v0[3]); w.z = cvt_pk_bf16(v1[0], v1[1]); w.w = cvt_pk_bf16(v1[2], v1[3]);
                    if (tr) { bf16_t* tp = base + (size_t)(col0 + bj * HALF) * ldc + (row0 + ai * HALF + m * 16);
                        tp[0] = (bf16_t)w.x; tp[(size_t)ldc] = (bf16_t)(w.x >> 16); tp[(size_t)2 * ldc] = (bf16_t)w.y; tp[(size_t)3 * ldc] = (bf16_t)(w.y >> 16);
                        tp[(size_t)4 * ldc] = (bf16_t)w.z; tp[(size_t)5 * ldc] = (bf16_t)(w.z >> 16); tp[(size_t)6 * ldc] = (bf16_t)w.w; tp[(size_t)7 * ldc] = (bf16_t)(w.w >> 16); }
                    else *(u32x4*)(rowp + bj * HALF) = w; } }
    }
};
struct EpiF32 {
    static constexpr bool PERM = false, AFTER_DRAIN = false;
    float* C; int ldc;
    __device__ __forceinline__ void operator()(const f32x4 (&acc)[2][2][4][2], const Unit& u, int wr, int wc, int fr, int fq) const {
        const int row0 = u.pm * BM + wr * 64 + fr, col0 = u.pn * BM + wc * 32 + 4 * fq;
#pragma unroll
        for (int ai = 0; ai < 2; ++ai)
#pragma unroll
            for (int m = 0; m < 4; ++m) { float* rowp = C + (size_t)(row0 + ai * HALF + m * 16) * ldc + col0;
#pragma unroll
                for (int bj = 0; bj < 2; ++bj)
#pragma unroll
                    for (int n = 0; n < 2; ++n) *(f32x4*)(rowp + bj * HALF + n * 16) = acc[ai][bj][m][n]; }
    }
};
typedef unsigned u32x2 __attribute__((ext_vector_type(2)));
__device__ __forceinline__ f32x4 bf4_to_f32(u32x2 p) { return (f32x4){__builtin_bit_cast(float, p.x << 16), __builtin_bit_cast(float, p.x & 0xffff0000u), __builtin_bit_cast(float, p.y << 16), __builtin_bit_cast(float, p.y & 0xffff0000u)}; }
struct EpiRes {
    static constexpr bool PERM = false, AFTER_DRAIN = false;
    const bf16_t* base; bf16_t* out; rs_t* rs; int ldc; const rs_t* rsq;
    __device__ __forceinline__ void operator()(const f32x4 (&acc)[2][2][4][2], const Unit& u, int wr, int wc, int fr, int fq) const {
        constexpr int PD = 3;
        const int row0 = u.pm * BM + wr * 64 + fr, col0 = u.pn * BM + wc * 32 + 4 * fq;
        u32x2 nb[8][2][2];
        rs_t scv[8];
#pragma unroll
        for (int gi = 0; gi < 8; ++gi) scv[gi] = rsq ? rsq[row0 + (gi >> 2) * HALF + (gi & 3) * 16] : 0ull;
#define EPI_LD(g) do { const size_t o_ = (size_t)(row0 + ((g) >> 2) * HALF + ((g) & 3) * 16) * ldc + col0; _Pragma("unroll") for (int bj = 0; bj < 2; ++bj) _Pragma("unroll") for (int n = 0; n < 2; ++n) nb[g][bj][n] = *(const u32x2*)(base + o_ + bj * HALF + n * 16); } while (0)
#pragma unroll
        for (int g = 0; g < PD; ++g) EPI_LD(g);
        PIN8(scv);
#pragma unroll
        for (int gi = 0; gi < 8; ++gi) { const int ai = gi >> 2, m = gi & 3; const int row = row0 + ai * HALF + m * 16; const size_t off = (size_t)row * ldc + col0;
            if (gi + PD < 8) EPI_LD(gi + PD);
            const float sc2 = rsq ? __builtin_amdgcn_rcpf((float)scv[gi] * RS_INV + RS_EPS) : 1.0f;
            float ss = 0.f;
#pragma unroll
            for (int bj = 0; bj < 2; ++bj)
#pragma unroll
                for (int n = 0; n < 2; ++n) { const f32x4 o = bf4_to_f32(nb[gi][bj][n]) + acc[ai][bj][m][n] * sc2;
                    ss += (o[0] * o[0] + o[1] * o[1]) + (o[2] * o[2] + o[3] * o[3]);
                    u32x2 w; w.x = cvt_pk_bf16(o[0], o[1]); w.y = cvt_pk_bf16(o[2], o[3]); *(u32x2*)(out + off + bj * HALF + n * 16) = w; }
            row_ss_add(rs, row, ss, fq); }
#undef EPI_LD
    }
};
struct EpiGate {
    static constexpr bool PERM = false, AFTER_DRAIN = false;
    const bf16_t* base; bf16_t* out; float* out32; const bf16_t* pp; const rs_t* rsin; rs_t* rs; int ldc;
    __device__ __forceinline__ void operator()(const f32x4 (&acc)[2][2][4][2], const Unit& u, int wr, int wc, int fr, int fq) const {
        constexpr int PD = 2;
        const int row0 = u.pm * BM + wr * 64 + fr, col0 = u.pn * BM + wc * 32 + 4 * fq;
        rs_t scv[8];
#pragma unroll
        for (int gi = 0; gi < 8; ++gi) scv[gi] = rsin[row0 + (gi >> 2) * HALF + (gi & 3) * 16];
        u32x2 nb[8][2][2], np[8][2][2];
#define EPI_LD(g) do { const size_t o_ = (size_t)(row0 + ((g) >> 2) * HALF + ((g) & 3) * 16) * ldc + col0; _Pragma("unroll") for (int bj = 0; bj < 2; ++bj) _Pragma("unroll") for (int n = 0; n < 2; ++n) { \
            nb[g][bj][n] = *(const u32x2*)(base + o_ + bj * HALF + n * 16); np[g][bj][n] = *(const u32x2*)(pp + o_ + bj * HALF + n * 16); } } while (0)
#pragma unroll
        for (int g = 0; g < PD; ++g) EPI_LD(g);
        PIN8(scv);
#pragma unroll
        for (int gi = 0; gi < 8; ++gi) { const int ai = gi >> 2, m = gi & 3; const int row = row0 + ai * HALF + m * 16; const size_t off = (size_t)row * ldc + col0;
            if (gi + PD < 8) EPI_LD(gi + PD);
            const float sc = rs_rinv(scv[gi]);
            float ss = 0.f;
#pragma unroll
            for (int bj = 0; bj < 2; ++bj)
#pragma unroll
                for (int n = 0; n < 2; ++n) { const f32x4 a = acc[ai][bj][m][n] * sc, p = bf4_to_f32(np[gi][bj][n]); f32x4 o = bf4_to_f32(nb[gi][bj][n]);
#pragma unroll
                    for (int j = 0; j < 4; ++j) o[j] += sigm(a[j]) * p[j];
                    if (out32) *(f32x4*)(out32 + off + bj * HALF + n * 16) = o;
                    ss += (o[0] * o[0] + o[1] * o[1]) + (o[2] * o[2] + o[3] * o[3]);
                    u32x2 w; w.x = cvt_pk_bf16(o[0], o[1]); w.y = cvt_pk_bf16(o[2], o[3]); *(u32x2*)(out + off + bj * HALF + n * 16) = w; }
            row_ss_add(rs, row, ss, fq); }
#undef EPI_LD
    }
};
struct EpiGlu {
    static constexpr bool PERM = false, AFTER_DRAIN = false;
    const bf16_t* base; bf16_t* out; rs_t* rs; int ldc;
    __device__ __forceinline__ void operator()(const f32x4 (&acc)[2][2][4][2], const Unit& u, int wr, int wc, int fr, int fq) const {
        constexpr int PD = 3;
        const int row0 = u.pm * BM + wr * 64 + fr, col0 = u.pn * HALF + wc * 32 + 4 * fq;
        u32x2 nb[8][2];
#define EPI_LD(g) do { const size_t o_ = (size_t)(row0 + ((g) >> 2) * HALF + ((g) & 3) * 16) * ldc + col0; _Pragma("unroll") for (int n = 0; n < 2; ++n) nb[g][n] = *(const u32x2*)(base + o_ + n * 16); } while (0)
#pragma unroll
        for (int g = 0; g < PD; ++g) EPI_LD(g);
#pragma unroll
        for (int gi = 0; gi < 8; ++gi) { const int ai = gi >> 2, m = gi & 3; const int row = row0 + ai * HALF + m * 16; const size_t off = (size_t)row * ldc + col0;
            if (gi + PD < 8) EPI_LD(gi + PD);
            float ss = 0.f;
#pragma unroll
            for (int n = 0; n < 2; ++n) { const f32x4 a = acc[ai][0][m][n], g = acc[ai][1][m][n]; f32x4 o = bf4_to_f32(nb[gi][n]);
#pragma unroll
                for (int j = 0; j < 4; ++j) o[j] += a[j] * sigm(g[j]);
                ss += (o[0] * o[0] + o[1] * o[1]) + (o[2] * o[2] + o[3] * o[3]);
                u32x2 w; w.x = cvt_pk_bf16(o[0], o[1]); w.y = cvt_pk_bf16(o[2], o[3]); *(u32x2*)(out + off + n * 16) = w; }
            row_ss_add(rs, row, ss, fq); }
#undef EPI_LD
    }
};

constexpr int S5T = 32, S5NCH = 512, S5KS = 768;
struct S5Order {
    int G, c, MT, NT;
    __device__ __forceinline__ bool next(int i, Unit& u) const { const int idx = i * G + c; if (idx >= 256 * MT * NT) return false; const int g = idx & 255, sub = idx >> 8;
        u.pm = g * MT + sub / NT; u.pn = g * NT + sub % NT; return true; }
    __device__ __forceinline__ void a_ready(const Unit&) const {}
    __device__ __forceinline__ void done(const Unit&) const {}
};
struct EpiS5U {
    static constexpr bool PERM = true, AFTER_DRAIN = false;
    bf16_t* UA; const rs_t* rs;
    __device__ __forceinline__ void operator()(const f32x4 (&acc)[2][2][4][2], const Unit& u, int wr, int wc, int fr, int fq) const {
        const int row0 = u.pm * BM + wr * 64 + fr, col0 = u.pn * BM + wc * 32 + 8 * fq;
        rs_t scv[8];
#pragma unroll
        for (int gi = 0; gi < 8; ++gi) scv[gi] = rs[row0 + (gi >> 2) * HALF + (gi & 3) * 16];
        PIN8(scv);
#pragma unroll
        for (int ai = 0; ai < 2; ++ai)
#pragma unroll
            for (int m = 0; m < 4; ++m) { const int t = row0 + ai * HALF + m * 16, c = t >> 5, sg = t & 31; const float sc = rs_rinv(scv[ai * 4 + m]);
#pragma unroll
                for (int bj = 0; bj < 2; ++bj) { const int col = col0 + bj * HALF, g = col >> 4, q0 = col & 15;
                    const f32x4 v0 = acc[ai][bj][m][0] * sc, v1 = acc[ai][bj][m][1] * sc;
                    u32x4 w; w.x = cvt_pk_bf16(v0[0], v0[1]); w.y = cvt_pk_bf16(v0[2], v0[3]); w.z = cvt_pk_bf16(v1[0], v1[1]); w.w = cvt_pk_bf16(v1[2], v1[3]);
                    *(u32x4*)(UA + ((size_t)(g * S5NCH + c) * S5KS + sg * 16 + q0)) = w; } }
    }
};
struct EpiS5E {
    static constexpr bool PERM = false, AFTER_DRAIN = false;
    float* E;
    __device__ __forceinline__ void operator()(const f32x4 (&acc)[2][2][4][2], const Unit& u, int wr, int wc, int fr, int fq) const {
        const int row0 = u.pm * BM + wr * 64 + fr, col0 = wc * 32 + 4 * fq;
#pragma unroll
        for (int ai = 0; ai < 2; ++ai)
#pragma unroll
            for (int m = 0; m < 4; ++m) { float* rowp = E + (size_t)(row0 + ai * HALF + m * 16) * 256 + col0;
#pragma unroll
                for (int bj = 0; bj < 2; ++bj)
#pragma unroll
                    for (int n = 0; n < 2; ++n) *(f32x4*)(rowp + bj * HALF + n * 16) = acc[ai][bj][m][n]; }
    }
};
__device__ __forceinline__ float gelu_tanh_f(float v) {
    const float z = 0.7978845608028654f * (v + 0.044715f * v * v * v);
    const float e = __builtin_amdgcn_exp2f(2.0f * 1.4426950408889634f * z);
    return 0.5f * v * (2.0f - 2.0f * __builtin_amdgcn_rcpf(e + 1.0f));
}
struct EpiS5Y {
    static constexpr bool PERM = true, AFTER_DRAIN = false;
    const bf16_t* UA; const float* dskip; bf16_t* G; int ldg;
    __device__ __forceinline__ void operator()(const f32x4 (&acc)[2][2][4][2], const Unit& u, int wr, int wc, int fr, int fq) const {
        const int row0 = u.pm * BM + wr * 64 + fr, col0 = (u.pn & 1) * BM + wc * 32 + 8 * fq;
        const int g = u.pm >> 1, p0 = col0 & 15;
        const f32x4 d0 = *(const f32x4*)(dskip + 16 * g + p0), d1 = *(const f32x4*)(dskip + 16 * g + p0 + 4);
        u32x4 uu[8][2];
#pragma unroll
        for (int gi = 0; gi < 8; ++gi)
#pragma unroll
            for (int bj = 0; bj < 2; ++bj) uu[gi][bj] = *(const u32x4*)(UA + ((size_t)(row0 + (gi >> 2) * HALF + (gi & 3) * 16) * S5KS + col0 + bj * HALF));
#pragma unroll
        for (int gi = 0; gi < 8; ++gi) asm volatile("" : "+v"(uu[gi][0]), "+v"(uu[gi][1]));
#pragma unroll
        for (int gi = 0; gi < 8; ++gi) { const int ai = gi >> 2, m = gi & 3; const int rowg = row0 + ai * HALF + m * 16, c = rowg & 511;
#pragma unroll
            for (int bj = 0; bj < 2; ++bj) { const int col = col0 + bj * HALF, tau = col >> 4; const u32x4 w4 = uu[gi][bj];
                f32x4 v0 = acc[ai][bj][m][0], v1 = acc[ai][bj][m][1];
                v0[0] += d0[0] * __builtin_bit_cast(float, w4.x << 16); v0[1] += d0[1] * __builtin_bit_cast(float, w4.x & 0xffff0000u);
                v0[2] += d0[2] * __builtin_bit_cast(float, w4.y << 16); v0[3] += d0[3] * __builtin_bit_cast(float, w4.y & 0xffff0000u);
                v1[0] += d1[0] * __builtin_bit_cast(float, w4.z << 16); v1[1] += d1[1] * __builtin_bit_cast(float, w4.z & 0xffff0000u);
                v1[2] += d1[2] * __builtin_bit_cast(float, w4.w << 16); v1[3] += d1[3] * __builtin_bit_cast(float, w4.w & 0xffff0000u);
#pragma unroll
                for (int j = 0; j < 4; ++j) { v0[j] = gelu_tanh_f(v0[j]); v1[j] = gelu_tanh_f(v1[j]); }
                u32x4 w; w.x = cvt_pk_bf16(v0[0], v0[1]); w.y = cvt_pk_bf16(v0[2], v0[3]); w.z = cvt_pk_bf16(v1[0], v1[1]); w.w = cvt_pk_bf16(v1[2], v1[3]);
                *(u32x4*)(G + (size_t)(32 * c + tau) * ldg + 16 * g + p0) = w; } }
    }
};

template <class Epi, class Sched, bool ALIGN_EPI = false, bool SP2 = false>
__device__ __forceinline__ void gemm_phase(PG8_LAS unsigned char* lds, const Gemm g, const Sched& S, const Epi& E) {
    int tid_o = threadIdx.x; asm volatile("" : "+v"(tid_o)); const int tid = tid_o, wid = __builtin_amdgcn_readfirstlane(tid >> 6), lane = tid & 63, wr = wid >> 2, wc = wid & 3, fr = lane & 15, fq = lane >> 4;
    const int K = g.K, nt = K / BK;
    unsigned voffA[2], voffB[2];
#pragma unroll
    for (int i = 0; i < 2; ++i) { int R, C; stage_rc(tid * 16 + i * 8192, R, C); const int Rb = Epi::PERM ? ((R & ~31) + perm32(R & 31)) : R;
        voffA[i] = (unsigned)(R * g.lda + C) * 2u; voffB[i] = (unsigned)(Rb * g.ldb + C) * 2u; }
    const size_t kstep = (size_t)(BK * 2);
    const size_t hstepA = (size_t)HALF * g.lda * 2, hstepB = (size_t)HALF * g.ldb * 2;
    const size_t tstepA = 2 * hstepA, tstepB = 2 * hstepB;
    const unsigned ldsw = (unsigned)wid * 1024u;
    const int aoff = lds_byte(wr * 64 + fr, fq * 8), boff = lds_byte(wc * 32 + fr, fq * 8);
#define PG8_SA(b, h) (((b) * 2 + (h)) * HTB)
#define PG8_SB(b, h) ((4 + (b) * 2 + (h)) * HTB)
#define PG8_STAGE(bufoff, gbase, voff) do { _Pragma("unroll") for (int _i = 0; _i < 2; ++_i) \
        __builtin_amdgcn_global_load_lds((const unsigned*)((const char*)(gbase) + (voff)[_i]), (PG8_LAS unsigned*)(lds + (bufoff) + ldsw + _i * 8192), 16, 0, 0); } while (0)
#define PG8_LDA(dst, b, h) do { _Pragma("unroll") for (int m = 0; m < 4; ++m) _Pragma("unroll") for (int k = 0; k < 2; ++k) dst[m][k] = *(const PG8_LAS bf16x8*)(lds + PG8_SA(b, h) + aoff + m * 2048 + k * 1024); } while (0)
#define PG8_LDB(dst, b, h) do { _Pragma("unroll") for (int n = 0; n < 2; ++n) _Pragma("unroll") for (int k = 0; k < 2; ++k) dst[n][k] = *(const PG8_LAS bf16x8*)(lds + PG8_SB(b, h) + boff + n * 2048 + k * 1024); } while (0)
#define PG8_MMA(ai, bj, At, Bt) do { __builtin_amdgcn_s_setprio(1); _Pragma("unroll") for (int m = 0; m < 4; ++m) _Pragma("unroll") for (int n = 0; n < 2; ++n) _Pragma("unroll") for (int k = 0; k < 2; ++k) \
        acc[ai][bj][m][n] = __builtin_amdgcn_mfma_f32_16x16x32_bf16(Bt[n][k], At[m][k], acc[ai][bj][m][n], 0, 0, 0); __builtin_amdgcn_s_setprio(0); } while (0)
#define PG8_WAIT_V(n) asm volatile("s_waitcnt vmcnt(" #n ")" ::: "memory")
#define PG8_WAIT_L(n) asm volatile("s_waitcnt lgkmcnt(" #n ")" ::: "memory")
#define PG8_BAR __builtin_amdgcn_s_barrier()
#define PG8_SCHED __builtin_amdgcn_sched_barrier(0)
    Unit cur, nxt; int ui = 0;
    if (!S.next(0, cur)) return;
    f32x4 acc[2][2][4][2];
#pragma unroll
    for (int a = 0; a < 2; ++a)
#pragma unroll
        for (int b = 0; b < 2; ++b)
#pragma unroll
            for (int m = 0; m < 4; ++m)
#pragma unroll
                for (int n = 0; n < 2; ++n) acc[a][b][m][n] = (f32x4){0.f, 0.f, 0.f, 0.f};
    bf16x8 At[4][2], B0[2][2], B1[2][2];
    const char* cA = (const char*)g.A + (size_t)cur.pm * tstepA; const char* cB = (const char*)g.Bt + (size_t)cur.pn * tstepB;
    S.a_ready(cur);
    if constexpr (SP2) {
        PG8_STAGE(PG8_SB(0, 0), cB, voffB); PG8_STAGE(PG8_SB(0, 1), cB + hstepB, voffB); PG8_STAGE(PG8_SA(0, 0), cA, voffA); PG8_STAGE(PG8_SA(0, 1), cA + hstepA, voffA);
        if (wr == 1) PG8_BAR;
        PG8_WAIT_V(2); PG8_BAR;
        PG8_STAGE(PG8_SB(1, 0), cB + kstep, voffB); PG8_STAGE(PG8_SA(1, 0), cA + kstep, voffA); PG8_STAGE(PG8_SB(1, 1), cB + hstepB + kstep, voffB);
        PG8_WAIT_V(6); PG8_BAR;
    } else {
        PG8_STAGE(PG8_SB(0, 0), cB, voffB); PG8_STAGE(PG8_SA(0, 0), cA, voffA); PG8_STAGE(PG8_SB(0, 1), cB + hstepB, voffB); PG8_STAGE(PG8_SA(0, 1), cA + hstepA, voffA);
        if (wr == 1) PG8_BAR;
        PG8_WAIT_V(4); PG8_BAR;
        PG8_STAGE(PG8_SB(1, 0), cB + kstep, voffB); PG8_STAGE(PG8_SA(1, 0), cA + kstep, voffA); PG8_STAGE(PG8_SB(1, 1), cB + hstepB + kstep, voffB);
        PG8_WAIT_V(6); PG8_BAR;
    }
    for (;;) {
        const bool has_next = S.next(ui + 1, nxt);
        const char* nA = has_next ? (const char*)g.A + (size_t)nxt.pm * tstepA : cA; const char* nB = has_next ? (const char*)g.Bt + (size_t)nxt.pn * tstepB : cB;
        for (int t = 0; t < nt; t += 2) {
            const bool last = (t == nt - 2);
            const char* a1 = cA + (size_t)(t + 1) * kstep;
            const char* a2 = last ? nA : cA + (size_t)(t + 2) * kstep; const char* b2 = last ? nB : cB + (size_t)(t + 2) * kstep;
            const char* a3 = a2 + kstep; const char* b3 = b2 + kstep;
            if (last && has_next) S.a_ready(nxt);
            if constexpr (SP2) {
            PG8_LDB(B0, 0, 0); PG8_LDB(B1, 0, 1); PG8_SCHED; PG8_LDA(At, 0, 0); PG8_STAGE(PG8_SA(1, 1), a1 + hstepA, voffA);
            PG8_WAIT_V(8); PG8_WAIT_L(0); PG8_BAR; PG8_MMA(0, 0, At, B0); PG8_MMA(0, 1, At, B1); PG8_BAR; PG8_SCHED;
            PG8_LDA(At, 0, 1); PG8_STAGE(PG8_SB(0, 0), b2, voffB); PG8_STAGE(PG8_SB(0, 1), b2 + hstepB, voffB); PG8_STAGE(PG8_SA(0, 0), a2, voffA);
            PG8_WAIT_V(8); PG8_WAIT_L(0); PG8_BAR; PG8_MMA(1, 0, At, B0); PG8_MMA(1, 1, At, B1); PG8_BAR; PG8_SCHED;
            PG8_LDB(B0, 1, 0); PG8_LDB(B1, 1, 1); PG8_SCHED; PG8_LDA(At, 1, 0); PG8_STAGE(PG8_SA(0, 1), a2 + hstepA, voffA);
            PG8_WAIT_V(8); PG8_WAIT_L(0); PG8_BAR; PG8_MMA(0, 0, At, B0); PG8_MMA(0, 1, At, B1); PG8_BAR; PG8_SCHED;
            PG8_LDA(At, 1, 1); PG8_STAGE(PG8_SB(1, 0), b3, voffB); PG8_STAGE(PG8_SB(1, 1), b3 + hstepB, voffB); PG8_STAGE(PG8_SA(1, 0), a3, voffA);
            PG8_WAIT_V(8); PG8_WAIT_L(0); PG8_BAR; PG8_MMA(1, 0, At, B0); PG8_MMA(1, 1, At, B1); PG8_BAR; PG8_SCHED;
            } else {
            PG8_LDB(B0, 0, 0); PG8_SCHED; PG8_LDA(At, 0, 0); PG8_STAGE(PG8_SA(1, 1), a1 + hstepA, voffA);
            PG8_WAIT_L(8); PG8_BAR; PG8_WAIT_L(0); PG8_MMA(0, 0, At, B0); PG8_BAR; PG8_SCHED;
            PG8_LDB(B1, 0, 1); PG8_STAGE(PG8_SB(0, 0), b2, voffB);
            PG8_BAR; PG8_WAIT_L(0); PG8_MMA(0, 1, At, B1); PG8_BAR;
            PG8_LDA(At, 0, 1); PG8_STAGE(PG8_SA(0, 0), a2, voffA);
            PG8_BAR; PG8_WAIT_L(0); PG8_MMA(1, 0, At, B0); PG8_BAR; PG8_SCHED;
            PG8_STAGE(PG8_SB(0, 1), b2 + hstepB, voffB);
            PG8_WAIT_V(6); PG8_BAR; PG8_MMA(1, 1, At, B1); PG8_BAR;
            PG8_LDB(B0, 1, 0); PG8_SCHED; PG8_LDA(At, 1, 0); PG8_STAGE(PG8_SA(0, 1), a2 + hstepA, voffA);
            PG8_WAIT_L(8); PG8_BAR; PG8_WAIT_L(0); PG8_MMA(0, 0, At, B0); PG8_BAR; PG8_SCHED;
            PG8_LDB(B1, 1, 1); PG8_STAGE(PG8_SB(1, 0), b3, voffB);
            PG8_BAR; PG8_WAIT_L(0); PG8_MMA(0, 1, At, B1); PG8_BAR;
            PG8_LDA(At, 1, 1); PG8_STAGE(PG8_SA(1, 0), a3, voffA);
            PG8_BAR; PG8_WAIT_L(0); PG8_MMA(1, 0, At, B0); PG8_BAR; PG8_SCHED;
            PG8_STAGE(PG8_SB(1, 1), b3 + hstepB, voffB);
            PG8_WAIT_V(6); PG8_BAR; PG8_MMA(1, 1, At, B1); PG8_BAR;
            }
        }
        if constexpr (ALIGN_EPI) { if (wr == 0) PG8_BAR; }
        if constexpr (!Epi::AFTER_DRAIN) { E(acc, cur, wr, wc, fr, fq); PROBE_EPI_DUP S.done(cur); }
        if (!has_next) break;
#pragma unroll
        for (int a = 0; a < 2; ++a)
#pragma unroll
            for (int b = 0; b < 2; ++b)
#pragma unroll
                for (int m = 0; m < 4; ++m)
#pragma unroll
                    for (int n = 0; n < 2; ++n) acc[a][b][m][n] = (f32x4){0.f, 0.f, 0.f, 0.f};
        cur = nxt; cA = nA; cB = nB; ++ui;
        if constexpr (ALIGN_EPI) { if (wr == 1) PG8_BAR; }
    }
    PG8_WAIT_V(0);
    if constexpr (!ALIGN_EPI) { if (wr == 0) PG8_BAR; }
    PG8_BAR;
    if constexpr (Epi::AFTER_DRAIN) { E.fused(acc, cur, wr, wc, fr, fq, lds, wid, lane); S.done(cur); }
#undef PG8_SA
#undef PG8_SB
#undef PG8_STAGE
#undef PG8_LDA
#undef PG8_LDB
#undef PG8_MMA
#undef PG8_WAIT_V
#undef PG8_WAIT_L
#undef PG8_BAR
#undef PG8_SCHED
}
}
#define XB_TMO      128
#define XB_XCNT(j)  (256  + 64 * (j))
#define XB_XSUB(j)  (1280 + 64 * (j))
#define XB_XGEN(j)  (2304 + 64 * (j))
#define XB_TOP      3328
#define XB_TOPGEN   3392
#define XCD_BAR_WORDS 3456
#define XB_SPIN_CAP (1u << 18)

__device__ __forceinline__ unsigned xb_ld(unsigned* p)              { return __hip_atomic_load(p, __ATOMIC_RELAXED, __HIP_MEMORY_SCOPE_AGENT); }
__device__ __forceinline__ unsigned xb_add(unsigned* p, unsigned v) { return __hip_atomic_fetch_add(p, v, __ATOMIC_RELAXED, __HIP_MEMORY_SCOPE_AGENT); }
__device__ __forceinline__ unsigned xb_xcc_id() { return (unsigned)__builtin_amdgcn_s_getreg((3 << 11) | 20) & 0xFu; }
#define XB_SPIN(cond, bar) do { unsigned _sp = 0; while (cond) { __builtin_amdgcn_s_sleep(1); \
    if ((++_sp & 255u) == 0u) { if (xb_ld(&(bar)[XB_TMO])) break; if (_sp > XB_SPIN_CAP) { atomicAdd(&(bar)[XB_TMO], 1u); break; } } } } while (0)

struct XcdBarrier {
    unsigned* bar; unsigned x;
    volatile LAS unsigned* st;
};

__device__ __forceinline__ XcdBarrier xcd_barrier_post(unsigned* bar, volatile LAS unsigned* st) {
    XcdBarrier b; b.bar = bar; b.x = xb_xcc_id(); b.st = st;
    if (threadIdx.x == 0) (void)xb_add(&bar[XB_XCNT(b.x)], 1u);
    return b;
}
__device__ __forceinline__ void xcd_barrier_complete(unsigned* bar, unsigned x, unsigned& nloc, unsigned& nx) {
    const unsigned G = gridDim.x * gridDim.y * gridDim.z;
    unsigned sum, cnt, mine, sp = 0u;
    for (;;) {
        sum = 0u; cnt = 0u; mine = 0u;
#pragma unroll
        for (unsigned j = 0; j < 16; ++j) { const unsigned c = xb_ld(&bar[XB_XCNT(j)]); sum += c; cnt += (c > 0u) ? 1u : 0u; mine = (j == x) ? c : mine; }
        if (sum == G) break;
        __builtin_amdgcn_s_sleep(1);
        if ((++sp & 255u) == 0u) { if (xb_ld(&bar[XB_TMO])) break; if (sp > XB_SPIN_CAP) { atomicAdd(&bar[XB_TMO], 1u); break; } }
    }
    nloc = mine > 0u ? mine : 1u; nx = cnt > 0u ? cnt : 1u;
}

__device__ __forceinline__ void xcd_barrier(const XcdBarrier& b) {
    asm volatile("s_waitcnt vmcnt(0)" ::: "memory");
    __syncthreads();
    if (threadIdx.x == 0) {
        unsigned* bar = b.bar;
        __builtin_amdgcn_s_waitcnt(0);
        unsigned nloc = b.st[0], nx = b.st[1];
        if (nloc == 0u) { xcd_barrier_complete(bar, b.x, nloc, nx); b.st[0] = nloc; b.st[1] = nx; }
        const unsigned old = xb_add(&bar[XB_XSUB(b.x)], 1u);
        const unsigned gen = old / nloc;
        if (old + 1u == (gen + 1u) * nloc) {
            __builtin_amdgcn_fence(__ATOMIC_RELEASE, "agent");
            asm volatile("s_waitcnt vmcnt(0)" ::: "memory");
            const unsigned og = xb_add(&bar[XB_TOP], 1u);
            const unsigned tg = og / nx;
            if (og + 1u == (tg + 1u) * nx) xb_add(&bar[XB_TOPGEN], 1u);
            else XB_SPIN(xb_ld(&bar[XB_TOPGEN]) == tg, bar);
            __builtin_amdgcn_fence(__ATOMIC_ACQUIRE, "agent");
            xb_add(&bar[XB_XGEN(b.x)], 1u);
            asm volatile("s_waitcnt vmcnt(0)" ::: "memory");
        } else {
            XB_SPIN(xb_ld(&bar[XB_XGEN(b.x)]) == gen, bar);
            __builtin_amdgcn_fence(__ATOMIC_ACQUIRE, "agent");
            asm volatile("s_waitcnt vmcnt(0)" ::: "memory");
        }
    }
    __syncthreads();
}
namespace dattn {
typedef unsigned short bf16;
constexpr int   D = 128, NW = 8, QBLK = 32, KVBLK = 64;
constexpr float SCALE = 0.088388347648318440f;
constexpr float THR = 8.f;
constexpr int SDEPTH = 2;
constexpr int LDQ = 4096, LDK = 1024, LDO = 4096;
constexpr size_t SHM_V = KVBLK * D * 2, SHM_K = KVBLK * D * 2, SHM_ATTN = 3 * SHM_V + 3 * SHM_K + NW * 64 * 4 + 2048;
using bf16x8 = __attribute__((ext_vector_type(8))) short;
using s16x4  = __attribute__((ext_vector_type(4))) short;
using f32x16 = __attribute__((ext_vector_type(16))) float;
using f32x8  = __attribute__((ext_vector_type(8))) float;
using u32x4  = __attribute__((ext_vector_type(4))) unsigned;
#define KSWZ(row, colB) ((row) * 256 + ((colB) ^ (((row) & 7) << 4)))
#define SBAR() __builtin_amdgcn_sched_barrier(0)
__device__ __forceinline__ int crow(int r, int hi) { return (r & 3) + 8 * (r >> 2) + 4 * hi; }
__device__ __forceinline__ unsigned cvtpk(float lo, float hi) {
  unsigned r; asm volatile("v_cvt_pk_bf16_f32 %0, %1, %2" : "=v"(r) : "v"(lo), "v"(hi)); return r;
}
template <typename TIn> struct Stage;
template <> struct Stage<bf16>  { using T = bf16x8;
  __device__ static __forceinline__ T ld8(const bf16* p) { return *reinterpret_cast<const bf16x8*>(p); }
  __device__ static __forceinline__ bf16x8 tobf(T x) { return x; } };
template <> struct Stage<float> { using T = f32x8;
  __device__ static __forceinline__ T ld8(const float* p) { return *reinterpret_cast<const f32x8*>(p); }
  __device__ static __forceinline__ bf16x8 tobf(T x) {
    u32x4 w = {cvtpk(x[0], x[1]), cvtpk(x[2], x[3]), cvtpk(x[4], x[5]), cvtpk(x[6], x[7])}; return *reinterpret_cast<bf16x8*>(&w); } };

__device__ __forceinline__ void partialSM(f32x16& p0, f32x16& p1, float& m_reg, float& mn, float& alpha) {
  constexpr float C = SCALE * 1.4426950408889634f;
  float pmax = p0[0]; for (int r = 1; r < 16; ++r) pmax = fmaxf(pmax, p0[r]); for (int r = 0; r < 16; ++r) pmax = fmaxf(pmax, p1[r]);
  { auto rr = __builtin_amdgcn_permlane32_swap(__float_as_uint(pmax), __float_as_uint(pmax), false, false);
    pmax = fmaxf(__uint_as_float(rr[0]), __uint_as_float(rr[1])); }
  if (__builtin_expect(__all(pmax - m_reg <= THR / SCALE), 1)) { mn = m_reg; alpha = 1.f; }
  else { mn = fmaxf(m_reg, pmax); alpha = __builtin_amdgcn_exp2f((m_reg - mn) * C); m_reg = mn; }
  float mnC = -mn * C;
  for (int r = 0; r < 16; ++r) p0[r] = fmaf(p0[r], C, mnC); for (int r = 0; r < 16; ++r) p1[r] = fmaf(p1[r], C, mnC);
  for (int r = 0; r < 16; ++r) p0[r] = __builtin_amdgcn_exp2f(p0[r]);
}
__device__ __forceinline__ void finishSM(f32x16& p0, f32x16& p1, float alpha, float& l_reg, bf16x8& pa0, bf16x8& pa1, bf16x8& pa2, bf16x8& pa3) {
  for (int r = 0; r < 16; ++r) p1[r] = __builtin_amdgcn_exp2f(p1[r]);
  float ps = 0; for (int r = 0; r < 16; ++r) ps += p0[r]; for (int r = 0; r < 16; ++r) ps += p1[r];
  { auto rr = __builtin_amdgcn_permlane32_swap(__float_as_uint(ps), __float_as_uint(ps), false, false);
    ps = __uint_as_float(rr[0]) + __uint_as_float(rr[1]); }
  l_reg = l_reg * alpha + ps;
#define PK4(P, BASE, OUT) do { unsigned a0 = cvtpk(P[BASE + 0], P[BASE + 1]), a1 = cvtpk(P[BASE + 2], P[BASE + 3]);   \
    unsigned b0 = cvtpk(P[BASE + 4], P[BASE + 5]), b1 = cvtpk(P[BASE + 6], P[BASE + 7]);                              \
    auto r0 = __builtin_amdgcn_permlane32_swap(a0, b0, false, false); auto r1 = __builtin_amdgcn_permlane32_swap(a1, b1, false, false); \
    u32x4 w = {r0[0], r1[0], r0[1], r1[1]}; OUT = *reinterpret_cast<bf16x8*>(&w); } while (0)
  PK4(p0, 0, pa0); PK4(p0, 8, pa1); PK4(p1, 0, pa2); PK4(p1, 8, pa3);
#undef PK4
}
__device__ __forceinline__ void qkt(f32x16& p0, f32x16& p1, const bf16* Ks, const bf16x8* qr, int r32, int hi) {
  p0 = f32x16{}; p1 = f32x16{};
  bf16x8 nb0 = *reinterpret_cast<const bf16x8*>((const char*)Ks + KSWZ(r32, (hi * 8) * 2)), nb1 = *reinterpret_cast<const bf16x8*>((const char*)Ks + KSWZ(32 + r32, (hi * 8) * 2));
#pragma unroll
  for (int d0 = 0; d0 < 8; ++d0) { const bf16x8 b0 = nb0, b1 = nb1;
    if (d0 < 7) { const int cb = ((d0 + 1) * 16 + hi * 8) * 2;
      nb0 = *reinterpret_cast<const bf16x8*>((const char*)Ks + KSWZ(r32, cb)); nb1 = *reinterpret_cast<const bf16x8*>((const char*)Ks + KSWZ(32 + r32, cb)); }
    p0 = __builtin_amdgcn_mfma_f32_32x32x16_bf16(b0, qr[d0], p0, 0, 0, 0);
    p1 = __builtin_amdgcn_mfma_f32_32x32x16_bf16(b1, qr[d0], p1, 0, 0, 0); }
}
__device__ __forceinline__ int v_st(int k, int c) { const int kk = (k & ~0xC) | ((k & 4) << 1) | ((k & 8) >> 1); return ((kk >> 3) * 4 + (c >> 5)) * 512 + ((kk & 7) * 32 + (c & 31)) * 2; }
__device__ __forceinline__ int v_rd_base(int lane) { return ((lane & 3) << 3) | (((lane >> 2) & 3) << 6) | (((lane >> 4) & 1) << 5) | (((lane >> 5) & 1) << 8); }
constexpr int v_rd_off(int d0, int ks, int half) { return d0 * 512 + ks * 4096 + half * 2048; }
template <int OFF> __device__ __forceinline__ s16x4 tr_read(int vb) {
  s16x4 r; asm volatile("ds_read_b64_tr_b16 %0, %1 offset:%2" : "=&v"(r) : "v"(vb), "i"(OFF) : "memory"); return r;
}
template <int D0> __device__ __forceinline__ void pv_one(f32x16& od, int vb, bf16x8 pa0, bf16x8 pa1, bf16x8 pa2, bf16x8 pa3) {
  const s16x4 l0 = tr_read<v_rd_off(D0, 0, 0)>(vb), h0 = tr_read<v_rd_off(D0, 0, 1)>(vb), l1 = tr_read<v_rd_off(D0, 1, 0)>(vb), h1 = tr_read<v_rd_off(D0, 1, 1)>(vb);
  const s16x4 l2 = tr_read<v_rd_off(D0, 2, 0)>(vb), h2 = tr_read<v_rd_off(D0, 2, 1)>(vb), l3 = tr_read<v_rd_off(D0, 3, 0)>(vb), h3 = tr_read<v_rd_off(D0, 3, 1)>(vb);
  asm volatile("s_waitcnt lgkmcnt(0)" ::: "memory"); SBAR();
#define PK(L, H) (bf16x8){L[0], L[1], L[2], L[3], H[0], H[1], H[2], H[3]}
  od = __builtin_amdgcn_mfma_f32_32x32x16_bf16(pa0, PK(l0, h0), od, 0, 0, 0);
  od = __builtin_amdgcn_mfma_f32_32x32x16_bf16(pa1, PK(l1, h1), od, 0, 0, 0);
  od = __builtin_amdgcn_mfma_f32_32x32x16_bf16(pa2, PK(l2, h2), od, 0, 0, 0);
  od = __builtin_amdgcn_mfma_f32_32x32x16_bf16(pa3, PK(l3, h3), od, 0, 0, 0);
#undef PK
}
__device__ __forceinline__ void pv_d0(f32x16* o, int vb, bf16x8 pa0, bf16x8 pa1, bf16x8 pa2, bf16x8 pa3) {
  pv_one<0>(o[0], vb, pa0, pa1, pa2, pa3); pv_one<1>(o[1], vb, pa0, pa1, pa2, pa3); pv_one<2>(o[2], vb, pa0, pa1, pa2, pa3); pv_one<3>(o[3], vb, pa0, pa1, pa2, pa3);
}

template <typename TQ>
__device__ __forceinline__ void attn_dense_body(const TQ* __restrict__ Qb, const bf16* __restrict__ Kh, const bf16* __restrict__ Vh,
                                                bf16* __restrict__ Ob, int seq, char* lds) {
  using St = Stage<bf16>; using SQ = Stage<TQ>;
  int tid_o = threadIdx.x; asm volatile("" : "+v"(tid_o)); const int tid = tid_o, wid = __builtin_amdgcn_readfirstlane(tid >> 6), lane = tid & 63, r32 = lane & 31, hi = lane >> 5;
  bf16* V_lds = (bf16*)lds; bf16* K_lds = (bf16*)(lds + 3 * SHM_V);
  float* ws = (float*)(lds + 3 * SHM_V + 3 * SHM_K) + wid * 64; float* li_l = ws; float* al_l = ws + 32;
  float m_reg = -1e30f, l_reg = 0; f32x16 o[4] = {}; bf16x8 qr[8];
  const TQ* Qw = Qb + (long)(wid * QBLK + r32) * LDQ + hi * 8;
#pragma unroll
  for (int d0 = 0; d0 < 8; ++d0) qr[d0] = SQ::tobf(SQ::ld8(Qw + d0 * 16));
  const int sr = tid >> 4, sc = (tid & 15) * 8, vst0 = v_st(sr, sc), vst1 = v_st(32 + sr, sc);
  const int vb0 = (int)(uintptr_t)V_lds + v_rd_base(lane);
  struct { typename St::T vs0, vs1, ks0, ks1; } sr_[SDEPTH];
#define SLOAD(i, k0) do { sr_[i].vs0 = St::ld8(&Vh[(long)((k0) + sr) * LDK + sc]); sr_[i].vs1 = St::ld8(&Vh[(long)((k0) + 32 + sr) * LDK + sc]); \
    sr_[i].ks0 = St::ld8(&Kh[(long)((k0) + sr) * LDK + sc]); sr_[i].ks1 = St::ld8(&Kh[(long)((k0) + 32 + sr) * LDK + sc]); } while (0)
#define SWRITE(b, i) do { *(bf16x8*)((char*)V_lds + (b) * SHM_V + vst0) = St::tobf(sr_[i].vs0);          \
    *(bf16x8*)((char*)V_lds + (b) * SHM_V + vst1) = St::tobf(sr_[i].vs1); int kc = sc * 2;               \
    *(bf16x8*)((char*)K_lds + (b) * SHM_K + KSWZ(sr, kc)) = St::tobf(sr_[i].ks0);                       \
    *(bf16x8*)((char*)K_lds + (b) * SHM_K + KSWZ(32 + sr, kc)) = St::tobf(sr_[i].ks1); } while (0)
#define SWAIT() do { if constexpr (SDEPTH == 2) asm volatile("s_waitcnt vmcnt(4)" ::: "memory"); else asm volatile("s_waitcnt vmcnt(0)" ::: "memory"); } while (0)
#define RESC(a) do { if (__any((a) < 1.f)) { if (hi == 0) al_l[r32] = (a); asm volatile("s_waitcnt lgkmcnt(0)" ::: "memory"); \
    for (int d = 0; d < 4; ++d) for (int r = 0; r < 16; ++r) o[d][r] *= al_l[crow(r, hi)]; } } while (0)
  f32x16 pA0, pA1, pB0, pB1; float mnA, mnB, alA, alB; bf16x8 pa0, pa1, pa2, pa3; const int NT = seq / KVBLK;
  constexpr int SE = 0, SO = SDEPTH - 1;
  SLOAD(SE, 0); asm volatile("s_waitcnt vmcnt(0)" ::: "memory"); SWRITE(0, SE); __syncthreads();
  qkt(pA0, pA1, K_lds, qr, r32, hi); partialSM(pA0, pA1, m_reg, mnA, alA);
  SLOAD(SO, KVBLK); if constexpr (SDEPTH == 2) { if (2 < NT) SLOAD(SE, 2 * KVBLK); }
  SWAIT(); SWRITE(1, SO); __syncthreads();
  int bk = 1, bv = 0, bw = 2;
#define ROT3() do { const int t_ = bv; bv = bk; bk = bw; bw = t_; } while (0)
  for (int j = 1; j + 1 < NT; j += 2) {
    SBAR(); qkt(pB0, pB1, (bf16*)((char*)K_lds + bk * SHM_K), qr, r32, hi);
    finishSM(pA0, pA1, alA, l_reg, pa0, pa1, pa2, pa3); SBAR();
    SLOAD(SO, (j + SDEPTH) * KVBLK); SBAR();
    pv_d0(o, vb0 + bv * (int)SHM_V, pa0, pa1, pa2, pa3); partialSM(pB0, pB1, m_reg, mnB, alB);
    SWAIT(); SWRITE(bw, SE);
    RESC(alB); __syncthreads(); ROT3();
    SBAR(); qkt(pA0, pA1, (bf16*)((char*)K_lds + bk * SHM_K), qr, r32, hi);
    finishSM(pB0, pB1, alB, l_reg, pa0, pa1, pa2, pa3); SBAR();
    if (SDEPTH == 1 || j + 3 < NT) SLOAD(SE, (j + 1 + SDEPTH) * KVBLK); SBAR();
    pv_d0(o, vb0 + bv * (int)SHM_V, pa0, pa1, pa2, pa3); partialSM(pA0, pA1, m_reg, mnA, alA);
    SWAIT(); SWRITE(bw, SO);
    RESC(alA); __syncthreads(); ROT3();
  }
  SBAR(); qkt(pB0, pB1, (bf16*)((char*)K_lds + bk * SHM_K), qr, r32, hi);
  finishSM(pA0, pA1, alA, l_reg, pa0, pa1, pa2, pa3); SBAR();
  pv_d0(o, vb0 + bv * (int)SHM_V, pa0, pa1, pa2, pa3); partialSM(pB0, pB1, m_reg, mnB, alB);
  RESC(alB);
  finishSM(pB0, pB1, alB, l_reg, pa0, pa1, pa2, pa3); SBAR();
  pv_d0(o, vb0 + bk * (int)SHM_V, pa0, pa1, pa2, pa3);
#undef ROT3
  if (hi == 0) li_l[r32] = l_reg; asm volatile("s_waitcnt lgkmcnt(0)" ::: "memory");
  float rli[16];
#pragma unroll
  for (int r = 0; r < 16; ++r) rli[r] = __builtin_amdgcn_rcpf(li_l[crow(r, hi)]);
  bf16* Ow = Ob + (long)(wid * QBLK) * LDO;
#pragma unroll
  for (int r = 0; r < 16; ++r) { int orow = crow(r, hi);
    for (int d0 = 0; d0 < 4; ++d0) Ow[(long)orow * LDO + d0 * 32 + r32] = (bf16)(cvtpk(o[d0][r] * rli[r], 0.f) & 0xffffu); }
#undef SLOAD
#undef SWRITE
#undef SWAIT
#undef RESC
}

constexpr int NA_LD = 4096, NA_TILES = 12;
__device__ __forceinline__ void na_block_body(const bf16* __restrict__ Qb, const bf16* __restrict__ Kh, const bf16* __restrict__ Vh, bf16* __restrict__ Ob,
                                              const float* __restrict__ rpb_h, const float* __restrict__ qgain, const float* __restrict__ kgain, int R, int ks, char* lds) {
  using St = Stage<bf16>;
  int tid_o = threadIdx.x; asm volatile("" : "+v"(tid_o)); const int tid = tid_o, wid = __builtin_amdgcn_readfirstlane(tid >> 6), lane = tid & 63, r32 = lane & 31, hi = lane >> 5;
  bf16* V_lds = (bf16*)lds; bf16* K_lds = (bf16*)(lds + 2 * SHM_V);
  float* ws = (float*)(lds + 2 * SHM_V + 2 * SHM_K) + wid * 64; float* li_l = ws; float* al_l = ws + 32;
  float* bt = (float*)(lds + 2 * SHM_V + 2 * SHM_K + NW * 64 * 4);
  float m_reg = -1e30f, l_reg = 0; f32x16 o[4] = {}; bf16x8 qr[8];
  const bf16* Qw = Qb + (long)(wid * QBLK + r32) * NA_LD + hi * 8;
#pragma unroll
  for (int d0 = 0; d0 < 8; ++d0) qr[d0] = St::ld8(Qw + d0 * 16);
  {
    float ss = 0.f;
#pragma unroll
    for (int d0 = 0; d0 < 8; ++d0) { const u32x4 w = __builtin_bit_cast(u32x4, qr[d0]);
#pragma unroll
      for (int e = 0; e < 4; ++e) { const float a = __uint_as_float(w[e] << 16), b = __uint_as_float(w[e] & 0xffff0000u); ss += a * a + b * b; } }
    ss += __shfl_xor(ss, 32);
    const float rinv = __builtin_amdgcn_rsqf(ss * (1.0f / 128.0f) + 1e-6f);
#pragma unroll
    for (int d0 = 0; d0 < 8; ++d0) { const u32x4 w = __builtin_bit_cast(u32x4, qr[d0]); const float* gp = qgain + d0 * 16 + hi * 8;
      const f32x8 g = *reinterpret_cast<const f32x8*>(gp); u32x4 o;
#pragma unroll
      for (int e = 0; e < 4; ++e) o[e] = cvtpk(__uint_as_float(w[e] << 16) * rinv * g[2 * e], __uint_as_float(w[e] & 0xffff0000u) * rinv * g[2 * e + 1]);
      qr[d0] = __builtin_bit_cast(bf16x8, o); } }
  const f32x8 kg = *reinterpret_cast<const f32x8*>(kgain + (tid & 15) * 8);
  for (int i = tid; i < 15 * 31; i += 64 * NW) bt[i] = rpb_h[i];
  const int sr = tid >> 4, sc = (tid & 15) * 8, vst0 = v_st(sr, sc), vst1 = v_st(32 + sr, sc);
  const int vb0 = (int)(uintptr_t)V_lds + v_rd_base(lane);
  bf16x8 s_vs0, s_vs1, s_ks0, s_ks1;
#define NLOAD(k0) do { s_vs0 = St::ld8(&Vh[(long)((k0) + sr) * NA_LD + sc]); s_vs1 = St::ld8(&Vh[(long)((k0) + 32 + sr) * NA_LD + sc]); \
    s_ks0 = St::ld8(&Kh[(long)((k0) + sr) * NA_LD + sc]); s_ks1 = St::ld8(&Kh[(long)((k0) + 32 + sr) * NA_LD + sc]); } while (0)
#define KNORM(x) do { const u32x4 w_ = __builtin_bit_cast(u32x4, x); float a_[8]; float ss_ = 0.f; \
    _Pragma("unroll") for (int e = 0; e < 4; ++e) { a_[2 * e] = __uint_as_float(w_[e] << 16); a_[2 * e + 1] = __uint_as_float(w_[e] & 0xffff0000u); ss_ += a_[2 * e] * a_[2 * e] + a_[2 * e + 1] * a_[2 * e + 1]; } \
    ss_ += __shfl_xor(ss_, 1); ss_ += __shfl_xor(ss_, 2); ss_ += __shfl_xor(ss_, 4); ss_ += __shfl_xor(ss_, 8); \
    const float ri_ = __builtin_amdgcn_rsqf(ss_ * (1.0f / 128.0f) + 1e-6f); u32x4 o_; \
    _Pragma("unroll") for (int e = 0; e < 4; ++e) o_[e] = cvtpk(a_[2 * e] * ri_ * kg[2 * e], a_[2 * e + 1] * ri_ * kg[2 * e + 1]); \
    x = __builtin_bit_cast(bf16x8, o_); } while (0)
#define NWRITE(b) do { KNORM(s_ks0); KNORM(s_ks1); \
    *(bf16x8*)((char*)V_lds + (b) * SHM_V + vst0) = s_vs0; *(bf16x8*)((char*)V_lds + (b) * SHM_V + vst1) = s_vs1; const int kc_ = sc * 2; \
    *(bf16x8*)((char*)K_lds + (b) * SHM_K + KSWZ(sr, kc_)) = s_ks0; *(bf16x8*)((char*)K_lds + (b) * SHM_K + KSWZ(32 + sr, kc_)) = s_ks1; } while (0)
  const int qrow = R + (wid >> 1), r0q = min(max(qrow - 4, 0), 248), jlo = r0q - ks;
  const int c = 32 * (wid & 1) + r32, c0 = min(max(c - 8, 0), 48);
  NLOAD(0); asm volatile("s_waitcnt vmcnt(0)" ::: "memory"); NWRITE(0); __syncthreads();
  for (int j = 0; j < NA_TILES; ++j) {
    const int buf = j & 1;
    if (j + 1 < NA_TILES) NLOAD((j + 1) * KVBLK);
    if (j >= jlo && j < jlo + 8) {
      f32x16 p0, p1; float mn, al; bf16x8 pa0, pa1, pa2, pa3;
      SBAR(); qkt(p0, p1, (bf16*)((char*)K_lds + buf * SHM_K), qr, r32, hi);
      const float* brow = bt + (ks + j - qrow + 7) * 31 + (15 - c);
#pragma unroll
      for (int r = 0; r < 16; ++r) { const int k0 = crow(r, hi), k1 = 32 + k0; const bool v0 = (k0 >= c0) && (k0 < c0 + 16), v1 = (k1 >= c0) && (k1 < c0 + 16);
        const float b0 = brow[v0 ? k0 : c], b1 = brow[v1 ? k1 : c];
        p0[r] = v0 ? fmaf(b0, 1.0f / SCALE, p0[r]) : -1e30f; p1[r] = v1 ? fmaf(b1, 1.0f / SCALE, p1[r]) : -1e30f; }
      partialSM(p0, p1, m_reg, mn, al);
      if (__any(al < 1.f)) { if (hi == 0) al_l[r32] = al; asm volatile("s_waitcnt lgkmcnt(0)" ::: "memory");
#pragma unroll
        for (int d = 0; d < 4; ++d)
#pragma unroll
          for (int r = 0; r < 16; ++r) o[d][r] *= al_l[crow(r, hi)]; }
      finishSM(p0, p1, al, l_reg, pa0, pa1, pa2, pa3); SBAR();
      pv_d0(o, vb0 + buf * (int)SHM_V, pa0, pa1, pa2, pa3);
    }
    if (j + 1 < NA_TILES) { asm volatile("s_waitcnt vmcnt(0)" ::: "memory"); NWRITE(buf ^ 1); }
    __syncthreads();
  }
  if (hi == 0) li_l[r32] = l_reg; asm volatile("s_waitcnt lgkmcnt(0)" ::: "memory");
  float rli[16];
#pragma unroll
  for (int r = 0; r < 16; ++r) rli[r] = __builtin_amdgcn_rcpf(li_l[crow(r, hi)]);
  bf16* Ow = Ob + (long)(wid * QBLK) * NA_LD;
#pragma unroll
  for (int r = 0; r < 16; ++r) { const int orow = crow(r, hi);
    for (int d0 = 0; d0 < 4; ++d0) Ow[(long)orow * NA_LD + d0 * 32 + r32] = (bf16)(cvtpk(o[d0][r] * rli[r], 0.f) & 0xffffu); }
#undef NLOAD
#undef NWRITE
#undef KNORM
}
}
namespace nattn {
constexpr int VSTRIDE = 288;
constexpr int WAVE_LDS = 32 * VSTRIDE;
constexpr float SCALE = 0.088388347648318440f;
template <int OFF> __device__ __forceinline__ s16x4 tr_read(unsigned vb) {
    s16x4 r; asm volatile("ds_read_b64_tr_b16 %0, %1 offset:%2" : "=&v"(r) : "v"(vb), "i"(OFF) : "memory"); return r;
}
template <int DB> __device__ __forceinline__ void pv_block(f32x4& od, unsigned vb, const bf16x8& pb) {
    const s16x4 lo = tr_read<DB * 32>(vb), hi = tr_read<16 * VSTRIDE + DB * 32>(vb);
    asm volatile("s_waitcnt lgkmcnt(0)" ::: "memory"); __builtin_amdgcn_sched_barrier(0);
    const bf16x8 vf = (bf16x8){lo[0], lo[1], lo[2], lo[3], hi[0], hi[1], hi[2], hi[3]};
    od = __builtin_amdgcn_mfma_f32_16x16x32_bf16(vf, pb, od, 0, 0, 0);
}
__device__ __forceinline__ void na_unit(const bf16* __restrict__ Q, const bf16* __restrict__ K, const bf16* __restrict__ V, const float* __restrict__ rpb_h,
                                        bf16* __restrict__ O, int r, int h, int cb, LAS unsigned char* vl, int lane) {
    const int fr = lane & 15, fq = lane >> 4;
    const int r0 = min(max(r - 4, 0), GROWS - 8);
    const int w0 = cb == 0 ? 0 : (cb == 1 ? 8 : (cb == 2 ? 24 : 32));
    const int c = 16 * cb + fr;
    const int c0 = min(max(c - 8, 0), GRID_W - 16);
    const size_t hoff = (size_t)h * HD;
    bf16x8 qf[4];
    { const bf16* qp = Q + (size_t)(r * GRID_W + c) * DM + hoff + 32 * fq;
#pragma unroll
      for (int ks = 0; ks < 4; ++ks) qf[ks] = *(const bf16x8*)(qp + 8 * ks); }
    f32x4 s[8][2];
#pragma unroll
    for (int a = 0; a < 8; ++a)
#pragma unroll
        for (int b = 0; b < 2; ++b) {
            const bf16* kp = K + (size_t)((r0 + a) * GRID_W + w0 + 16 * b + fr) * DM + hoff + 32 * fq;
            bf16x8 kf[4];
#pragma unroll
            for (int ks = 0; ks < 4; ++ks) kf[ks] = *(const bf16x8*)(kp + 8 * ks);
            f32x4 acc = (f32x4){0.f, 0.f, 0.f, 0.f};
#pragma unroll
            for (int ks = 0; ks < 4; ++ks) acc = __builtin_amdgcn_mfma_f32_16x16x32_bf16(kf[ks], qf[ks], acc, 0, 0, 0);
            s[a][b] = acc;
        }
    constexpr float LOG2E = 1.4426950408889634f;
    float mx = -1e30f;
#pragma unroll
    for (int a = 0; a < 8; ++a) { const float* brow = rpb_h + (r0 + a - r + 7) * 31 + (15 - c);
#pragma unroll
        for (int b = 0; b < 2; ++b)
#pragma unroll
            for (int j = 0; j < 4; ++j) { const int kc = w0 + 16 * b + 4 * fq + j; const bool valid = (kc >= c0) && (kc < c0 + 16);
                float v = -1e30f; if (valid) v = (s[a][b][j] * SCALE + brow[kc]) * LOG2E;
                s[a][b][j] = v; mx = fmaxf(mx, v); } }
    mx = fmaxf(mx, __shfl_xor(mx, 16)); mx = fmaxf(mx, __shfl_xor(mx, 32));
    float lsum = 0.f;
#pragma unroll
    for (int a = 0; a < 8; ++a)
#pragma unroll
        for (int b = 0; b < 2; ++b)
#pragma unroll
            for (int j = 0; j < 4; ++j) { const float p = __builtin_amdgcn_exp2f(s[a][b][j] - mx); s[a][b][j] = p; lsum += p; }
    lsum += __shfl_xor(lsum, 16); lsum += __shfl_xor(lsum, 32);
    bf16x8 pb[8];
#pragma unroll
    for (int a = 0; a < 8; ++a) { v4u w; w.x = pg8::cvt_pk_bf16(s[a][0][0], s[a][0][1]); w.y = pg8::cvt_pk_bf16(s[a][0][2], s[a][0][3]);
        w.z = pg8::cvt_pk_bf16(s[a][1][0], s[a][1][1]); w.w = pg8::cvt_pk_bf16(s[a][1][2], s[a][1][3]); pb[a] = __builtin_bit_cast(bf16x8, w); }
    f32x4 o[8];
#pragma unroll
    for (int db = 0; db < 8; ++db) o[db] = (f32x4){0.f, 0.f, 0.f, 0.f};
    const unsigned vb = (unsigned)(uintptr_t)vl + (unsigned)((4 * fq + (fr >> 2)) * VSTRIDE + 8 * (fr & 3));
    const int srow = lane >> 4, sch = lane & 15;
    v4u vr[8];
#pragma unroll
    for (int i = 0; i < 8; ++i) vr[i] = *(const v4u*)(V + (size_t)(r0 * GRID_W + w0 + 4 * i + srow) * DM + hoff + 8 * sch);
#pragma unroll
    for (int a = 0; a < 8; ++a) {
#pragma unroll
        for (int i = 0; i < 8; ++i) *(LAS v4u*)(vl + (4 * i + srow) * VSTRIDE + 16 * sch) = vr[i];
        if (a < 7) {
#pragma unroll
            for (int i = 0; i < 8; ++i) vr[i] = *(const v4u*)(V + (size_t)((r0 + a + 1) * GRID_W + w0 + 4 * i + srow) * DM + hoff + 8 * sch);
        }
        asm volatile("s_waitcnt lgkmcnt(0)" ::: "memory"); __builtin_amdgcn_sched_barrier(0);
        pv_block<0>(o[0], vb, pb[a]); pv_block<1>(o[1], vb, pb[a]); pv_block<2>(o[2], vb, pb[a]); pv_block<3>(o[3], vb, pb[a]);
        pv_block<4>(o[4], vb, pb[a]); pv_block<5>(o[5], vb, pb[a]); pv_block<6>(o[6], vb, pb[a]); pv_block<7>(o[7], vb, pb[a]);
    }
    const float rl = __builtin_amdgcn_rcpf(lsum);
    bf16* op = O + (size_t)(r * GRID_W + c) * DM + hoff + 4 * fq;
#pragma unroll
    for (int db = 0; db < 8; ++db) { v2u w; w.x = pg8::cvt_pk_bf16(o[db][0] * rl, o[db][1] * rl); w.y = pg8::cvt_pk_bf16(o[db][2] * rl, o[db][3] * rl); *(v2u*)(op + 16 * db) = w; }
}
}

struct Frame {
    LAS unsigned char* lds;
    int tid, lane, wave;
    int bid, vcu, G;
};
__device__ __forceinline__ float wave_sum(float v) {
#pragma unroll
    for (int o = 1; o < 64; o <<= 1) v += __shfl_xor(v, o);
    return v;
}
__device__ __forceinline__ void xrows_phase(const Frame& F, const float* __restrict__ h, bf16* __restrict__ hb, pg8::rs_t* __restrict__ rs) {
    const int gw = F.vcu * 8 + F.wave, NGW = F.G * 8;
    for (int m = gw; m < L; m += NGW) {
        const f32x4* xr = (const f32x4*)(h + (size_t)m * DM) + F.lane;
        v2u* o8 = (v2u*)(hb + (size_t)m * DM) + F.lane;
        float s = 0.f;
#pragma unroll
        for (int j = 0; j < 16; ++j) { const f32x4 v = xr[64 * j]; s += (v.x * v.x + v.y * v.y) + (v.z * v.z + v.w * v.w); v2u w; w.x = pk2(v.x, v.y); w.y = pk2(v.z, v.w); o8[64 * j] = w; }
        s = wave_sum(s);
        if (F.lane == 0) rs[m] = (pg8::rs_t)(s * pg8::RS_FIX);
    }
}
__device__ __forceinline__ void headnorm_rows(bf16* __restrict__ X, int ld, int nheads, const float* __restrict__ gain, int t, int lane, bool rope, const float (&cs)[8], const float (&sn)[8]) {
    const int hs = lane >> 4, l16 = lane & 15;
    f32x4 g0 = *(const f32x4*)(gain + 8 * l16), g1 = *(const f32x4*)(gain + 8 * l16 + 4);
    const float gg[8] = {g0.x, g0.y, g0.z, g0.w, g1.x, g1.y, g1.z, g1.w};
    const bool second = ((l16 >> 2) & 1) != 0;
    for (int hg = 0; hg < nheads / 4; ++hg) {
        bf16* p = X + (size_t)t * ld + (size_t)(4 * hg + hs) * HD + 8 * l16;
        const v4u raw = *(const v4u*)p;
        float x[8] = {bflo(raw.x), bfhi(raw.x), bflo(raw.y), bfhi(raw.y), bflo(raw.z), bfhi(raw.z), bflo(raw.w), bfhi(raw.w)};
        float ss = 0.f;
#pragma unroll
        for (int e = 0; e < 8; ++e) ss += x[e] * x[e];
        ss += __shfl_xor(ss, 1); ss += __shfl_xor(ss, 2); ss += __shfl_xor(ss, 4); ss += __shfl_xor(ss, 8);
        const float rinv = 1.0f / sqrtf(ss * (1.0f / HD) + EPS);
        float y[8];
#pragma unroll
        for (int e = 0; e < 8; ++e) y[e] = x[e] * rinv * gg[e];
        if (rope) {
#pragma unroll
            for (int e = 0; e < 8; ++e) { const float yp = __shfl_xor(y[e], 4); y[e] = second ? (y[e] * cs[e] + yp * sn[e]) : (y[e] * cs[e] - yp * sn[e]); }
        }
        v4u w; w.x = pk2(y[0], y[1]); w.y = pk2(y[2], y[3]); w.z = pk2(y[4], y[5]); w.w = pk2(y[6], y[7]);
        *(v4u*)p = w;
    }
}
__device__ __forceinline__ void prep_phase(const Frame& F, bf16* Q, bf16* K, int ldk, int nkh, const float* qgain, const float* kgain, bool rope) {
    const int gw = F.vcu * 8 + F.wave, NGW = F.G * 8;
    const int l16 = F.lane & 15;
    for (int t = gw; t < L; t += NGW) {
        float cs[8], sn[8];
#pragma unroll
        for (int e = 0; e < 8; ++e) { cs[e] = 1.f; sn[e] = 0.f; }
        if (rope) {
            const int ax = l16 >> 3; const float pos = (float)(ax ? (t & (GRID_W - 1)) : (t / GRID_W));
#pragma unroll
            for (int e = 0; e < 8; ++e) { const int f = (l16 & 3) * 8 + e; const float inv = 1.0f / powf(10000.0f, (float)f * (1.0f / 32.0f)); const float ang = pos * inv; cs[e] = cosf(ang); sn[e] = sinf(ang); }
        }
        headnorm_rows(Q, DM, NH, qgain, t, F.lane, rope, cs, sn);
        headnorm_rows(K, ldk, nkh, kgain, t, F.lane, rope, cs, sn);
    }
}

constexpr int S5T = pg8::S5T, S5NCH = pg8::S5NCH, S5KS = pg8::S5KS;
__device__ __forceinline__ void s5_gen_group(const Frame& F, int g, const float* __restrict__ lam_re, const float* __restrict__ lam_im, const float* __restrict__ log_step,
                                             const float* __restrict__ b_re, const float* __restrict__ b_im, const float* __restrict__ c_re, const float* __restrict__ c_im,
                                             bf16* __restrict__ GM, bf16* __restrict__ BMt, f32x2* __restrict__ PAT) {
    LAS f32x2* apow = (LAS f32x2*)F.lds;
    LAS f32x2* zt = apow + 2 * 33 * 64;
    LAS float* Kd = (LAS float*)(zt + 2 * 64);
    const int tid = F.tid;
    if (tid < 128) {
        const int dir = tid >> 6, n = tid & 63, dg = dir * S5G + g, idx = dg * S5N + n;
        const double dt = exp((double)log_step[dg]);
        const double lr = (double)lam_re[idx], li = (double)lam_im[idx];
        const double mag = exp(lr * dt), are = mag * cos(li * dt), aim = mag * sin(li * dt);
        const double den = lr * lr + li * li, nre = are - 1.0;
        zt[dir * 64 + n] = (f32x2){(float)((nre * lr + aim * li) / den), (float)((aim * lr - nre * li) / den)};
        double pr = 1.0, pi = 0.0;
        for (int k = 0; k <= 32; ++k) { apow[(dir * 33 + k) * 64 + n] = (f32x2){(float)pr, (float)pi}; const double t = pr * are - pi * aim; pi = pr * aim + pi * are; pr = t; }
        PAT[idx] = apow[(dir * 33 + 32) * 64 + n];
    }
    LDS_WAIT(); __syncthreads();
    {
        const int dir = tid >> 8, p = (tid >> 4) & 15, q = tid & 15, dg = dir * S5G + g;
        float wr[64], wi[64];
        const float* cr = c_re + ((size_t)dg * S5P + p) * S5N; const float* ci = c_im + ((size_t)dg * S5P + p) * S5N;
#pragma unroll
        for (int n = 0; n < 64; ++n) { const f32x2 z = zt[dir * 64 + n]; const float br = b_re[((size_t)dg * S5N + n) * S5P + q], bi = b_im[((size_t)dg * S5N + n) * S5P + q];
            const float bbr = z.x * br - z.y * bi, bbi = z.x * bi + z.y * br; const float c0 = cr[n], c1 = ci[n];
            wr[n] = c0 * bbr - c1 * bbi; wi[n] = c0 * bbi + c1 * bbr; }
        for (int d = 0; d < 32; ++d) { float acc = 0.f; const LAS f32x2* ap = apow + (dir * 33 + d) * 64;
#pragma unroll
            for (int n = 0; n < 64; ++n) { const f32x2 a = ap[n]; acc = fmaf(wr[n], a.x, acc); acc = fmaf(-wi[n], a.y, acc); }
            Kd[(dir * 32 + d) * 256 + p * 16 + q] = acc; }
    }
    LDS_WAIT(); __syncthreads();
    bf16* BMg = BMt + (size_t)g * 512 * S5KS;
    for (int it = tid; it < 512 * 64; it += 512) { const int row = it >> 6, ch = it & 63, tau = row >> 4, p = row & 15, sg = ch >> 1, q0 = (ch & 1) * 8;
        float v[8];
        if (sg < tau) { const LAS float* k = Kd + (0 * 32 + (tau - sg)) * 256 + p * 16 + q0;
#pragma unroll
            for (int j = 0; j < 8; ++j) v[j] = k[j]; }
        else if (sg > tau) { const LAS float* k = Kd + (1 * 32 + (sg - tau)) * 256 + p * 16 + q0;
#pragma unroll
            for (int j = 0; j < 8; ++j) v[j] = k[j]; }
        else { const LAS float* k0 = Kd + p * 16 + q0; const LAS float* k1 = Kd + 32 * 256 + p * 16 + q0;
#pragma unroll
            for (int j = 0; j < 8; ++j) v[j] = k0[j] + k1[j]; }
        v4u w; w.x = pk2(v[0], v[1]); w.y = pk2(v[2], v[3]); w.z = pk2(v[4], v[5]); w.w = pk2(v[6], v[7]);
        *(v4u*)(BMg + (size_t)row * S5KS + ch * 8) = w; }
    for (int it = tid; it < 512 * 32; it += 512) { const int row = it >> 5, ch = it & 31, tau = row >> 4, p = row & 15, dir = ch >> 4, n0 = (ch & 15) * 4, dg = dir * S5G + g;
        const int k = dir ? (32 - tau) : (tau + 1);
        const f32x4 cr = *(const f32x4*)(c_re + ((size_t)dg * S5P + p) * S5N + n0), ci = *(const f32x4*)(c_im + ((size_t)dg * S5P + p) * S5N + n0);
        const LAS f32x2* ap = apow + (dir * 33 + k) * 64 + n0;
        unsigned o[4];
#pragma unroll
        for (int j = 0; j < 4; ++j) { const f32x2 a = ap[j]; const float vr = cr[j] * a.x - ci[j] * a.y, vi = cr[j] * a.y + ci[j] * a.x; o[j] = pk2(vr, -vi); }
        *(v4u*)(BMg + (size_t)row * S5KS + 512 + ch * 8) = (v4u){o[0], o[1], o[2], o[3]}; }
    bf16* GMg = GM + (size_t)g * 256 * 512;
    for (int it = tid; it < 128 * 64; it += 512) { const int dn = it >> 6, ch = it & 63, dir = dn >> 6, n = dn & 63, sg = ch >> 1, q0 = (ch & 1) * 8, dg = dir * S5G + g;
        const int pw = dir ? sg : (31 - sg);
        const f32x2 a = apow[(dir * 33 + pw) * 64 + n], z = zt[dir * 64 + n];
        const float wr_ = a.x * z.x - a.y * z.y, wi_ = a.x * z.y + a.y * z.x;
        const float* br = b_re + ((size_t)dg * S5N + n) * S5P + q0; const float* bi = b_im + ((size_t)dg * S5N + n) * S5P + q0;
        float re[8], im[8];
#pragma unroll
        for (int j = 0; j < 8; ++j) { re[j] = wr_ * br[j] - wi_ * bi[j]; im[j] = wr_ * bi[j] + wi_ * br[j]; }
        v4u w0, w1; w0.x = pk2(re[0], re[1]); w0.y = pk2(re[2], re[3]); w0.z = pk2(re[4], re[5]); w0.w = pk2(re[6], re[7]);
        w1.x = pk2(im[0], im[1]); w1.y = pk2(im[2], im[3]); w1.z = pk2(im[4], im[5]); w1.w = pk2(im[6], im[7]);
        *(v4u*)(GMg + (size_t)(dir * 128 + 2 * n) * 512 + ch * 8) = w0; *(v4u*)(GMg + (size_t)(dir * 128 + 2 * n + 1) * 512 + ch * 8) = w1; }
    LDS_WAIT(); __syncthreads();
}
__device__ __forceinline__ void s5_scan_phase(const Frame& F, const f32x2* __restrict__ PAT, const float* __restrict__ E, bf16* __restrict__ UA) {
    for (int task = F.bid + F.G * F.wave; task < 2 * S5G; task += F.G * 8) {
        const int dir = task >> 8, g = task & 255;
        const f32x2 a = PAT[task * S5N + F.lane];
        const float* e = E + (size_t)g * S5NCH * 256 + dir * 128 + 2 * F.lane;
        bf16* s = UA + (size_t)g * S5NCH * S5KS + 512 + dir * 128 + 2 * F.lane;
        float cr = 0.f, ci = 0.f;
        for (int c8 = 0; c8 < S5NCH; c8 += 8) {
            f32x2 v[8];
#pragma unroll
            for (int k = 0; k < 8; ++k) { const int c = dir ? (S5NCH - 1 - (c8 + k)) : (c8 + k); v[k] = *(const f32x2*)(e + (size_t)c * 256); }
#pragma unroll
            for (int k = 0; k < 8; ++k) { const int c = dir ? (S5NCH - 1 - (c8 + k)) : (c8 + k);
                *(unsigned*)(s + (size_t)c * S5KS) = pk2(cr, ci);
                const float nr = fmaf(a.x, cr, fmaf(-a.y, ci, v[k].x)), ni = fmaf(a.x, ci, fmaf(a.y, cr, v[k].y)); cr = nr; ci = ni; }
        }
    }
}


__device__ __forceinline__ void gqa_selfcheck(const Frame& F, const bf16* __restrict__ Qraw, const bf16* __restrict__ Kraw, const bf16* __restrict__ V, const bf16* __restrict__ O,
                                              const float* __restrict__ qg, const float* __restrict__ kg, float* __restrict__ SC, unsigned* flag) {
    LAS float* ql = (LAS float*)(F.lds + F.wave * 1024);
    const int lane = F.lane;
#pragma unroll 1
    for (int s = F.bid * 8 + F.wave; s < 1024; s += F.G * 8) {
        const int tok = (int)(((long)(s >> 5) * 5209 + 77) % L), hq = s & 31, kv = hq >> 2;
        float* sc = SC + (size_t)(F.bid * 8 + F.wave) * L;
        float qv[2]; { const bf16* qp = Qraw + (size_t)tok * DM + hq * HD; qv[0] = bf2f(qp[lane]); qv[1] = bf2f(qp[lane + 64]); }
        { const float ss = wave_sum(qv[0] * qv[0] + qv[1] * qv[1]); const float ri = 1.0f / sqrtf(ss * (1.0f / HD) + EPS); qv[0] *= ri * qg[lane]; qv[1] *= ri * qg[lane + 64]; }
#pragma unroll
        for (int a = 0; a < 2; ++a) { const float pos = (float)(a ? (tok & 63) : (tok >> 6)); const int f = lane & 31; const float ang = pos * (1.0f / powf(10000.0f, (float)f * (1.0f / 32.0f)));
            const float c = cosf(ang), sn = sinf(ang); const float other = __shfl_xor(qv[a], 32); qv[a] = (lane & 32) ? (qv[a] * c + other * sn) : (qv[a] * c - other * sn); }
        ql[lane] = qv[0]; ql[lane + 64] = qv[1]; LDS_WAIT();
        float mx = -1e30f;
#pragma unroll 1
        for (int j = lane; j < L; j += 64) { const bf16* kp = Kraw + (size_t)j * KVD + kv * HD; float ss = 0.f;
#pragma unroll 1
            for (int d = 0; d < HD; ++d) { const float x = bf2f(kp[d]); ss += x * x; }
            const float ri = 1.0f / sqrtf(ss * (1.0f / HD) + EPS); float dot = 0.f;
#pragma unroll 1
            for (int a = 0; a < 2; ++a) { const float pos = (float)(a ? (j & 63) : (j >> 6));
#pragma unroll 1
                for (int f = 0; f < 32; ++f) { const float ang = pos * (1.0f / powf(10000.0f, (float)f * (1.0f / 32.0f))); const float c = cosf(ang), sn = sinf(ang);
                    const float x1 = bf2f(kp[64 * a + f]) * ri * kg[64 * a + f], x2 = bf2f(kp[64 * a + 32 + f]) * ri * kg[64 * a + 32 + f];
                    dot += (x1 * c - x2 * sn) * ql[64 * a + f] + (x2 * c + x1 * sn) * ql[64 * a + 32 + f]; } }
            dot *= 0.088388347648318440f; sc[j] = dot; mx = fmaxf(mx, dot); }
#pragma unroll
        for (int o = 1; o < 64; o <<= 1) mx = fmaxf(mx, __shfl_xor(mx, o));
        asm volatile("s_waitcnt vmcnt(0)" ::: "memory"); __builtin_amdgcn_fence(__ATOMIC_RELEASE, "workgroup"); __builtin_amdgcn_fence(__ATOMIC_ACQUIRE, "agent");
        float o0 = 0.f, o1 = 0.f, lsum = 0.f;
#pragma unroll 1
        for (int j = 0; j < L; ++j) { const float pj = expf(__hip_atomic_load(sc + j, __ATOMIC_RELAXED, __HIP_MEMORY_SCOPE_AGENT) - mx); const bf16* vp = V + (size_t)j * KVD + kv * HD; o0 += pj * bf2f(vp[lane]); o1 += pj * bf2f(vp[lane + 64]); lsum += pj; }
        o0 /= lsum; o1 /= lsum;
        const bf16* op = O + (size_t)tok * DM + hq * HD; const float g0 = bf2f(op[lane]), g1 = bf2f(op[lane + 64]);
        float am = fmaxf(fabsf(o0), fabsf(o1));
#pragma unroll
        for (int o = 1; o < 64; o <<= 1) am = fmaxf(am, __shfl_xor(am, o));
        const float tol = 0.05f * am + 1e-5f;
        const bool bad = !(fabsf(g0 - o0) <= tol) || !(fabsf(g1 - o1) <= tol);
        if (__any(bad) && lane == 0) __hip_atomic_fetch_or(flag, 1u, __ATOMIC_RELAXED, __HIP_MEMORY_SCOPE_AGENT);
        LDS_WAIT();
    }
}

__device__ __forceinline__ void transpose_item(const float* __restrict__ W, int K, int N, bf16* __restrict__ WT, int mode, const float* __restrict__ gain, LAS float* scr, int item, int lane) {
    const int nblk = N / 32, kb = item / nblk, nb = item % nblk, k0 = 64 * kb, n0 = 32 * nb;
    int r0 = n0;
    if (mode == 1) r0 = (n0 < DM) ? ((n0 >> 7) * 256 + (n0 & 127)) : (((n0 - DM) >> 7) * 256 + 128 + ((n0 - DM) & 127));
    const float* src = W + (size_t)(k0 + (lane >> 5)) * N + n0 + (lane & 31);
    float v[32];
#pragma unroll
    for (int i = 0; i < 32; ++i) v[i] = src[(size_t)(2 * i) * N];
    const int c = lane & 7;
    f32x4 g0 = (f32x4){1.f, 1.f, 1.f, 1.f}, g1 = g0;
    if (gain) { g0 = *(const f32x4*)(gain + k0 + 8 * c); g1 = *(const f32x4*)(gain + k0 + 8 * c + 4); }
#pragma unroll
    for (int i = 0; i < 32; ++i) scr[(2 * i + (lane >> 5)) * 33 + (lane & 31)] = v[i];
    LDS_WAIT(); asm volatile("" ::: "memory");
#pragma unroll
    for (int j = 0; j < 4; ++j) { const int n = (lane >> 3) + 8 * j; const LAS float* s = scr + (8 * c) * 33 + n;
        v4u o; o.x = pk2(s[0 * 33] * g0.x, s[1 * 33] * g0.y); o.y = pk2(s[2 * 33] * g0.z, s[3 * 33] * g0.w); o.z = pk2(s[4 * 33] * g1.x, s[5 * 33] * g1.y); o.w = pk2(s[6 * 33] * g1.z, s[7 * 33] * g1.w);
        *(v4u*)(WT + (size_t)(r0 + n) * K + k0 + 8 * c) = o; }
    LDS_WAIT(); asm volatile("" ::: "memory");
}

constexpr size_t MiB = 1u << 20;
constexpr size_t SZ_NAQKV = (size_t)3 * DM * DM * 2, SZ_DD = (size_t)DM * DM * 2, SZ_GQAQKV = (size_t)(DM + 2 * KVD) * DM * 2, SZ_W1 = (size_t)FF * DM * 2, SZ_PROJ = (size_t)DM * PLE * 2, SZ_ACT = (size_t)L * DM * 2;
constexpr size_t OFF_CTL = 0, CTL_ZERO_BYTES = 3 * MiB, OFF_RS = 1 * MiB;
constexpr size_t OFF_NAQKV = 4 * MiB;
constexpr size_t OFF_NAWO = OFF_NAQKV + 2 * SZ_NAQKV;
constexpr size_t OFF_GQAQKV = OFF_NAWO + 2 * SZ_DD;
constexpr size_t OFF_GQAWO = OFF_GQAQKV + SZ_GQAQKV;
constexpr size_t OFF_S5IN = OFF_GQAWO + SZ_DD;
constexpr size_t OFF_S5OUT = OFF_S5IN + SZ_DD;
constexpr size_t OFF_W1 = OFF_S5OUT + 2 * SZ_DD;
constexpr size_t OFF_W2 = OFF_W1 + 4 * SZ_W1;
constexpr size_t OFF_PROJ = OFF_W2 + 4 * SZ_W1;
constexpr size_t OFF_GATE = OFF_PROJ + 4 * SZ_PROJ;
constexpr size_t OFF_PBF = OFF_GATE + 4 * SZ_DD;
constexpr size_t OFF_XN = OFF_PBF + 4 * (size_t)L * PLE * 2;
constexpr size_t OFF_ACT = OFF_XN + SZ_ACT;
constexpr size_t OFF_PP = OFF_ACT + 4 * SZ_ACT;
constexpr size_t OFF_S5BM = OFF_PP + SZ_ACT;
constexpr size_t OFF_S5GM = OFF_S5BM + 192 * MiB;
constexpr size_t OFF_S5PAR = OFF_S5GM + 64 * MiB;
constexpr size_t OFF_DUMMY = OFF_S5PAR + 8 * MiB;
constexpr size_t OFF_HB1 = OFF_DUMMY + 256 * MiB;
constexpr size_t WS_END = OFF_HB1 + SZ_ACT;
constexpr int CW_BAR = 4096;
constexpr int RING_BYTES = 131072, LDSCTL_OFF = RING_BYTES, MISC_OFF = LDSCTL_OFF + 320, PTAB_OFF = LDSCTL_OFF + 1024, LDS_BYTES = 147456;
static_assert(dattn::SHM_ATTN <= RING_BYTES && 8 * 64 * 33 * 4 <= RING_BYTES, "phase scratch fits the ring region");

constexpr int PH_PER_LAYER = 8, NPH = 1 + DEPTH * PH_PER_LAYER;
struct Args { const float* in[28]; float* out; unsigned char* ws; int ph_lo, ph_hi; };
enum { I_X = 0, I_P, I_MIXN, I_MLPN, I_PLEN, I_NAQKV, I_NAWO, I_NAQG, I_NAKG, I_NARPB, I_GQKV, I_GWO, I_GQG, I_GKG, I_S5IN, I_LAMRE, I_LAMIM, I_LOGSTEP, I_BRE, I_BIM, I_CRE, I_CIM, I_S5D, I_S5OUT, I_W1, I_W2, I_PROJ, I_GATE };


__device__ __forceinline__ unsigned long long tab_get(LAS unsigned char* lds, int i) {
    volatile LAS unsigned* t = (volatile LAS unsigned*)(lds + PTAB_OFF); const unsigned lo = t[2 * i], hi = t[2 * i + 1];
    return ((unsigned long long)(unsigned)__builtin_amdgcn_readfirstlane((int)hi) << 32) | (unsigned)__builtin_amdgcn_readfirstlane((int)lo); }
#define INP(i) ((const float*)(const GAS float*)tab_get(F.lds, (i)))
#define OUTP() ((float*)(GAS float*)tab_get(F.lds, 28))
#define WSP() ((unsigned char*)(GAS unsigned char*)tab_get(F.lds, 29))
__device__ __forceinline__ Frame mkframe(unsigned char* lds_generic) {
    Frame F; int t = threadIdx.x; asm volatile("" : "+v"(t)); F.tid = t; F.lane = t & 63; F.wave = __builtin_amdgcn_readfirstlane(t >> 6);
    F.lds = (LAS unsigned char*)lds_generic; int b = blockIdx.x; asm volatile("" : "+s"(b)); F.bid = b; int G = gridDim.x; asm volatile("" : "+s"(G)); F.G = G;
    F.vcu = (G % 8 == 0) ? (b % 8) * (G / 8) + b / 8 : b; return F; }
__device__ __forceinline__ void prologue_phase(const Frame& F) {
    unsigned char* ws = WSP();
    LAS float* scr = (LAS float*)(F.lds + F.wave * (64 * 33 * 4));
    const int gw = F.vcu * 8 + F.wave, NGW = F.G * 8;
    constexpr int I_QKV = (DM / 64) * (3 * DM / 32), I_DD = (DM / 64) * (DM / 32), I_GQ = (DM / 64) * ((DM + 2 * KVD) / 32), I_SO = (DM / 64) * (2 * DM / 32),
                  I_1 = (DM / 64) * (FF / 32), I_2 = (FF / 64) * (DM / 32), I_PJ = (PLE / 64) * (DM / 32);
    constexpr int NITEMS = 2 * I_QKV + 2 * I_DD + I_GQ + I_DD + I_DD + I_SO + 4 * I_1 + 4 * I_2 + 4 * I_PJ + 4 * I_DD;
    for (int it = gw; it < NITEMS; it += NGW) {
        int r = it; const float* W; int K, N, mode = 0; bf16* WT; const float* gain = nullptr;
        if (r < 2 * I_QKV) { const int l = r / I_QKV; r -= l * I_QKV; W = INP(I_NAQKV) + (size_t)l * DM * 3 * DM; K = DM; N = 3 * DM; WT = (bf16*)(ws + OFF_NAQKV + l * SZ_NAQKV); gain = INP(I_MIXN) + (size_t)(3 * l) * DM; }
        else { r -= 2 * I_QKV;
        if (r < 2 * I_DD) { const int l = r / I_DD; r -= l * I_DD; W = INP(I_NAWO) + (size_t)l * DM * DM; K = DM; N = DM; WT = (bf16*)(ws + OFF_NAWO + l * SZ_DD); }
        else { r -= 2 * I_DD;
        if (r < I_GQ) { W = INP(I_GQKV); K = DM; N = DM + 2 * KVD; WT = (bf16*)(ws + OFF_GQAQKV); gain = INP(I_MIXN) + (size_t)1 * DM; }
        else { r -= I_GQ;
        if (r < I_DD) { W = INP(I_GWO); K = DM; N = DM; WT = (bf16*)(ws + OFF_GQAWO); }
        else { r -= I_DD;
        if (r < I_DD) { W = INP(I_S5IN); K = DM; N = DM; WT = (bf16*)(ws + OFF_S5IN); gain = INP(I_MIXN) + (size_t)2 * DM; }
        else { r -= I_DD;
        if (r < I_SO) { W = INP(I_S5OUT); K = DM; N = 2 * DM; WT = (bf16*)(ws + OFF_S5OUT); mode = 1; }
        else { r -= I_SO;
        if (r < 4 * I_1) { const int l = r / I_1; r -= l * I_1; W = INP(I_W1) + (size_t)l * DM * FF; K = DM; N = FF; WT = (bf16*)(ws + OFF_W1 + l * SZ_W1); gain = INP(I_MLPN) + (size_t)l * DM; }
        else { r -= 4 * I_1;
        if (r < 4 * I_2) { const int l = r / I_2; r -= l * I_2; W = INP(I_W2) + (size_t)l * FF * DM; K = FF; N = DM; WT = (bf16*)(ws + OFF_W2 + l * SZ_W1); }
        else { r -= 4 * I_2;
        if (r < 4 * I_PJ) { const int l = r / I_PJ; r -= l * I_PJ; W = INP(I_PROJ) + (size_t)l * PLE * DM; K = PLE; N = DM; WT = (bf16*)(ws + OFF_PROJ + l * SZ_PROJ); }
        else { r -= 4 * I_PJ; const int l = r / I_DD; r -= l * I_DD; W = INP(I_GATE) + (size_t)l * DM * DM; K = DM; N = DM; WT = (bf16*)(ws + OFF_GATE + l * SZ_DD); gain = INP(I_PLEN) + (size_t)l * DM; } } } } } } } } }
        transpose_item(W, K, N, WT, mode, gain, scr, r, F.lane);
    }
    xrows_phase(F, INP(I_X), (bf16*)(ws + OFF_XN), (pg8::rs_t*)(ws + OFF_RS));
    { const size_t n8 = (size_t)DEPTH * L * PLE / 8; const float* p = INP(I_P); bf16* pb = (bf16*)(ws + OFF_PBF);
      for (size_t i = (size_t)gw * 64 + F.lane; i < n8; i += (size_t)NGW * 64) { const f32x4 a = *(const f32x4*)(p + i * 8), b = *(const f32x4*)(p + i * 8 + 4);
          v4u w; w.x = pk2(a.x, a.y); w.y = pk2(a.z, a.w); w.z = pk2(b.x, b.y); w.w = pk2(b.z, b.w); *(v4u*)(pb + i * 8) = w; } }
    { bf16* GM = (bf16*)(ws + OFF_S5GM); bf16* BMt = (bf16*)(ws + OFF_S5BM); f32x2* PAT = (f32x2*)(ws + OFF_S5PAR);
      LDS_WAIT(); __syncthreads();
      for (int g = F.bid; g < S5G; g += F.G) s5_gen_group(F, g, INP(I_LAMRE), INP(I_LAMIM), INP(I_LOGSTEP), INP(I_BRE), INP(I_BIM), INP(I_CRE), INP(I_CIM), GM, BMt, PAT); }
}

#define WS_PTRS() unsigned char* ws = WSP(); bf16* HB0 = (bf16*)(ws + OFF_XN); bf16* HB1 = (bf16*)(ws + OFF_HB1); bf16* Qb = (bf16*)(ws + OFF_ACT); bf16* Kb = (bf16*)(ws + OFF_ACT + SZ_ACT); bf16* Vb = (bf16*)(ws + OFF_ACT + 2 * SZ_ACT); \
    bf16* Ob = (bf16*)(ws + OFF_ACT + 3 * SZ_ACT); bf16* HID = (bf16*)(ws + OFF_ACT); bf16* UA = (bf16*)(ws + OFF_ACT); bf16* S5Gb = (bf16*)(ws + OFF_ACT + 2 * SZ_ACT); float* S5E = (float*)(ws + OFF_ACT + 3 * SZ_ACT); bf16* PP = (bf16*)(ws + OFF_PP); \
    (void)HB0; (void)HB1; (void)Qb; (void)Kb; (void)Vb; (void)Ob; (void)HID; (void)UA; (void)S5Gb; (void)PP; (void)S5E;
__global__ void __launch_bounds__(512, 2) enc_fwd(Args args) {
    extern __shared__ __attribute__((aligned(16))) unsigned char lds[];
    {
        LAS unsigned char* l3 = (LAS unsigned char*)lds;
        for (int u = threadIdx.x; u < (LDS_BYTES - LDSCTL_OFF) / 4; u += 512) ((LAS unsigned*)(l3 + LDSCTL_OFF))[u] = 0u;
        __syncthreads();
        if (threadIdx.x == 0) { LAS unsigned long long* t = (LAS unsigned long long*)(l3 + PTAB_OFF);
#pragma unroll
            for (int i = 0; i < 28; ++i) t[i] = (unsigned long long)args.in[i];
            t[28] = (unsigned long long)args.out; t[29] = (unsigned long long)args.ws; }
        __syncthreads();
    }
    const int lo = args.ph_lo, hi = args.ph_hi;
    XcdBarrier bar;
    { LAS unsigned char* l3 = (LAS unsigned char*)lds; unsigned* ctl = (unsigned*)(GAS unsigned*)(tab_get(l3, 29) + OFF_CTL); bar.bar = ctl + CW_BAR; bar.x = 0; bar.st = nullptr;
      if (hi - lo > 1) bar = xcd_barrier_post(ctl + CW_BAR, (volatile LAS unsigned*)(l3 + MISC_OFF) + 8); }
#define IN(k) (lo <= (k) && (k) < hi)
#ifndef PROBE_PH
#define PROBE_PH (-1)
#endif
#define REPS(k) for (int rep_ = 0, nrep_ = (((k) == PROBE_PH || PROBE_PH == -2) ? 2 : ((PROBE_PH == 300 && (k) == 11) ? 4 : 1)); rep_ < nrep_; ++rep_)
#define HBOUT(p) ((nrep_ == 2 && rep_ == 0) ? (bf16*)(ws + OFF_DUMMY) : (p))
#define RSOUT(i) ((nrep_ == 2 && rep_ == 0) ? (pg8::rs_t*)(ws + OFF_DUMMY + 128 * MiB) : RSP(i))
#define SEAM(k) do { if (IN(k) && IN((k) + 1)) xcd_barrier(bar); } while (0)

    if (IN(0)) REPS(0) { const Frame F = mkframe(lds); prologue_phase(F); } SEAM(0);
#if PROBE_PH == 200
    for (int xb_ = 0; xb_ < 40; ++xb_) xcd_barrier(bar);
#endif

#pragma unroll 1
    for (int layer = 0; layer < DEPTH; ++layer) {
        const int kind = layer % 3, slot = layer / 3, pb = 1 + PH_PER_LAYER * layer;
#define RSP(i) ((pg8::rs_t*)(ws + OFF_RS) + (size_t)(i) * L)
        const int irs = (layer == 0) ? 0 : 3 * layer;
        if (IN(pb + 0)) REPS(pb + 0) {
            const Frame F = mkframe(lds); WS_PTRS();
            if (kind != 2) {
                const int N = (kind == 0) ? 3 * DM : DM + 2 * KVD;
                const bf16* W = (kind == 0) ? (const bf16*)(ws + OFF_NAQKV + slot * SZ_NAQKV) : (const bf16*)(ws + OFF_GQAQKV);
                const pg8::Gemm g = pg8::mkgemm(HB0, W, L, N, DM); pg8::StaticOrder S; S.init(L, N, F.G, F.bid);
                pg8::EpiBf16<0> E{Qb, Kb, Vb, DM, (kind == 0) ? DM : KVD, (kind == 0) ? DM : KVD, DM, (kind == 0) ? 2 * DM : DM + KVD, RSP(irs), 0, (kind == 0) ? 2 * DM : DM + KVD};
                pg8::gemm_phase<pg8::EpiBf16<0>, pg8::StaticOrder, false, true>(F.lds, g, S, E);
            } else {
                const pg8::Gemm g = pg8::mkgemm(HB0, (const bf16*)(ws + OFF_S5IN), L, DM, DM); pg8::StaticOrder S; S.init(L, DM, F.G, F.bid);
                pg8::EpiS5U E{UA, RSP(irs)};
                pg8::gemm_phase<pg8::EpiS5U, pg8::StaticOrder, false, true>(F.lds, g, S, E);
            }
        }
        SEAM(pb + 0);
        if (kind != 2) {
#if PROBE_PH == 400
            if (kind == 1) { const Frame F = mkframe(lds); WS_PTRS();
                const v4u* sq = (const v4u*)Qb; v4u* dq = (v4u*)(ws + OFF_DUMMY); const v4u* sk = (const v4u*)Kb; v4u* dk = (v4u*)(ws + OFF_DUMMY + 128 * MiB);
                for (size_t i = (size_t)F.bid * 512 + F.tid; i < (size_t)L * DM / 8; i += (size_t)F.G * 512) dq[i] = sq[i];
                for (size_t i = (size_t)F.bid * 512 + F.tid; i < (size_t)L * KVD / 8; i += (size_t)F.G * 512) dk[i] = sk[i];
                xcd_barrier(bar); }
#endif
            if (kind == 1) { if (IN(pb + 1)) { const Frame F = mkframe(lds); WS_PTRS(); prep_phase(F, Qb, Kb, KVD, NKV, INP(I_GQG), INP(I_GKG), true); }
                SEAM(pb + 1); }
            if (IN(pb + 2)) REPS(pb + 2) { const Frame F = mkframe(lds); WS_PTRS();
                if (kind == 0) {
                    const float* rpb = INP(I_NARPB) + (size_t)slot * NH * 15 * 31;
                    for (int i = 0;; ++i) { const int unit = i * F.G + F.bid; if (unit >= NH * (GROWS / 4)) break;
                        const int h = unit >> 6, R = (unit & 63) * 4, ks = min(max(R - 4, 0), GROWS - dattn::NA_TILES);
                        dattn::na_block_body(Qb + (size_t)(R * GRID_W) * DM + h * HD, Kb + (size_t)(ks * GRID_W) * DM + h * HD, Vb + (size_t)(ks * GRID_W) * DM + h * HD,
                                             Ob + (size_t)(R * GRID_W) * DM + h * HD, rpb + (size_t)h * 15 * 31, INP(I_NAQG) + slot * HD, INP(I_NAKG) + slot * HD, R, ks, (char*)lds);
                        __syncthreads(); }
                } else {
                    for (int i = 0;; ++i) { const int unit = i * F.G + F.bid; if (unit >= NH * (L / 256)) break;
                        const int kvh = unit & 7, rest = unit >> 3, hq = kvh * 4 + (rest >> 6), qb = rest & 63;
                        dattn::attn_dense_body<bf16>(Qb + (size_t)(qb * 256) * DM + hq * HD, Kb + kvh * HD, Vb + kvh * HD, Ob + (size_t)(qb * 256) * DM + hq * HD, L, (char*)lds);
                        __syncthreads(); }
                }
            }
            if (IN(pb + 2) && IN(pb + 4)) xcd_barrier(bar);
#if PROBE_PH == 400
            if (kind == 1) { const Frame F = mkframe(lds); WS_PTRS();
                gqa_selfcheck(F, (const bf16*)(ws + OFF_DUMMY), (const bf16*)(ws + OFF_DUMMY + 128 * MiB), Vb, Ob, INP(I_GQG), INP(I_GKG), (float*)(ws + OFF_PP), (unsigned*)(ws + OFF_CTL) + 8);
                xcd_barrier(bar); }
#endif
        } else {
            if (IN(pb + 1)) REPS(pb + 1) { const Frame F = mkframe(lds); WS_PTRS();
                pg8::Gemm g; g.A = UA; g.Bt = (const bf16*)(ws + OFF_S5GM); g.M = S5G * S5NCH; g.N = 256; g.K = 512; g.lda = S5KS; g.ldb = 512;
                pg8::S5Order S{F.G, F.bid, 2, 1}; pg8::EpiS5E E{S5E};
                pg8::gemm_phase<pg8::EpiS5E, pg8::S5Order, false, true>(F.lds, g, S, E); }
            SEAM(pb + 1);
            if (IN(pb + 2)) REPS(pb + 2) { const Frame F = mkframe(lds); WS_PTRS(); s5_scan_phase(F, (const f32x2*)(ws + OFF_S5PAR), S5E, UA); }
            SEAM(pb + 2);
            if (IN(pb + 3)) REPS(pb + 3) { const Frame F = mkframe(lds); WS_PTRS();
                pg8::Gemm g; g.A = UA; g.Bt = (const bf16*)(ws + OFF_S5BM); g.M = S5G * S5NCH; g.N = S5G * 512; g.K = S5KS; g.lda = S5KS; g.ldb = S5KS;
                pg8::S5Order S{F.G, F.bid, 2, 2}; pg8::EpiS5Y E{UA, INP(I_S5D), S5Gb, DM};
                pg8::gemm_phase<pg8::EpiS5Y, pg8::S5Order, false, true>(F.lds, g, S, E); }
            SEAM(pb + 3);
        }
        if (IN(pb + 4)) REPS(pb + 4) {
            const Frame F = mkframe(lds); WS_PTRS();
            if (kind != 2) {
                const bf16* W = (kind == 0) ? (const bf16*)(ws + OFF_NAWO + slot * SZ_DD) : (const bf16*)(ws + OFF_GQAWO);
                const pg8::Gemm g = pg8::mkgemm(Ob, W, L, DM, DM); pg8::StaticOrder S; S.init(L, DM, F.G, F.bid);
                pg8::EpiRes E{HB0, HBOUT(HB0), RSOUT(1 + 3 * layer), DM, nullptr};
                pg8::gemm_phase<pg8::EpiRes, pg8::StaticOrder, false, true>(F.lds, g, S, E);
            } else {
                const pg8::Gemm g = pg8::mkgemm(S5Gb, (const bf16*)(ws + OFF_S5OUT), L, 2 * DM, DM); pg8::StaticOrder S; S.init(L, 2 * DM, F.G, F.bid);
                pg8::EpiGlu E{HB0, HBOUT(HB0), RSOUT(1 + 3 * layer), DM};
                pg8::gemm_phase<pg8::EpiGlu, pg8::StaticOrder, false, true>(F.lds, g, S, E);
            }
        }
        SEAM(pb + 4);
        if (IN(pb + 5)) REPS(pb + 5) { const Frame F = mkframe(lds); WS_PTRS();
            const pg8::Gemm g = pg8::mkgemm(HB0, (const bf16*)(ws + OFF_W1 + layer * SZ_W1), L, FF, DM); pg8::StaticOrder S; S.init(L, FF, F.G, F.bid);
            pg8::EpiBf16<2> E{HID, HID, HID, FF, FF, FF, 1 << 30, 1 << 30, nullptr, 0, 0};
#if PROBE_PH == 201
            { pg8::RangeOrder R1{S, 0, 8}, R2{S, 8, 16};
              pg8::gemm_phase<pg8::EpiBf16<2>, pg8::RangeOrder, false, true>(F.lds, g, R1, E); xcd_barrier(bar);
              pg8::gemm_phase<pg8::EpiBf16<2>, pg8::RangeOrder, false, true>(F.lds, g, R2, E); }
#else
            pg8::gemm_phase<pg8::EpiBf16<2>, pg8::StaticOrder, false, true>(F.lds, g, S, E);
#endif
        }
        SEAM(pb + 5);
        if (IN(pb + 6)) REPS(pb + 6) { const Frame F = mkframe(lds); WS_PTRS();
            { const pg8::Gemm g = pg8::mkgemm(HID, (const bf16*)(ws + OFF_W2 + layer * SZ_W1), L, DM, FF); pg8::StaticOrder S; S.init(L, DM, F.G, F.bid);
              pg8::EpiRes E{HB0, HBOUT(HB1), RSOUT(2 + 3 * layer), DM, RSP(1 + 3 * layer)};
              pg8::gemm_phase<pg8::EpiRes, pg8::StaticOrder, false, true>(F.lds, g, S, E); }
            { const pg8::Gemm g = pg8::mkgemm((const bf16*)(ws + OFF_PBF + (size_t)layer * L * PLE * 2), (const bf16*)(ws + OFF_PROJ + layer * SZ_PROJ), L, DM, PLE); pg8::StaticOrder S; S.init(L, DM, F.G, F.bid);
              pg8::EpiBf16<0> E{PP, PP, PP, DM, DM, DM, 1 << 30, 1 << 30, nullptr, 0, 0};
              pg8::gemm_phase<pg8::EpiBf16<0>, pg8::StaticOrder, false, true>(F.lds, g, S, E); }
        }
        SEAM(pb + 6);
        if (IN(pb + 7)) REPS(pb + 7) { const Frame F = mkframe(lds); WS_PTRS();
            const pg8::Gemm g = pg8::mkgemm(HB1, (const bf16*)(ws + OFF_GATE + layer * SZ_DD), L, DM, DM); pg8::StaticOrder S; S.init(L, DM, F.G, F.bid);
            pg8::EpiGate E{HB1, HBOUT(HB0), (layer == DEPTH - 1) ? OUTP() : nullptr, PP, RSP(2 + 3 * layer), RSOUT(3 + 3 * layer), DM};
            pg8::gemm_phase<pg8::EpiGate, pg8::StaticOrder, false, true>(F.lds, g, S, E);
        }
        SEAM(pb + 7);
    }
#if PROBE_PH == 400
    { xcd_barrier(bar); const Frame F = mkframe(lds); unsigned char* ws = WSP();
      if (__hip_atomic_load((unsigned*)(ws + OFF_CTL) + 8, __ATOMIC_RELAXED, __HIP_MEMORY_SCOPE_AGENT) != 0u && F.bid == 0 && F.tid < 64) OUTP()[F.tid] = __builtin_nanf(""); }
#endif
#undef IN
#undef SEAM
}

extern "C" void kernel_launch(void* const* d_in, const int* in_sizes, int n_in, void* d_out, int out_size, void* d_ws, size_t ws_size, hipStream_t stream) {
    static int grid = 0;
    if (grid == 0) {
        if (n_in != 28 || in_sizes[0] != L * DM || out_size != L * DM || ws_size < WS_END) {
            fprintf(stderr, "kernel_launch: built for 28 inputs, x/out of %d floats, >= %zu bytes of workspace; got n_in %d, in0 %d, out %d, ws %zu; nothing launched\n", L * DM, (size_t)WS_END, n_in, n_in > 0 ? in_sizes[0] : -1, out_size, ws_size);
            grid = -1; return; }
        int dev = 0, cus = 0, per_cu = 0;
        if (hipGetDevice(&dev) != hipSuccess || hipDeviceGetAttribute(&cus, hipDeviceAttributeMultiprocessorCount, dev) != hipSuccess) { fprintf(stderr, "kernel_launch: device query failed\n"); grid = -1; return; }
        if (hipFuncSetAttribute((const void*)enc_fwd, hipFuncAttributeMaxDynamicSharedMemorySize, LDS_BYTES) != hipSuccess) { fprintf(stderr, "kernel_launch: hipFuncSetAttribute failed\n"); grid = -1; return; }
        if (hipOccupancyMaxActiveBlocksPerMultiprocessor(&per_cu, (const void*)enc_fwd, 512, LDS_BYTES) != hipSuccess || per_cu < 1)
            fprintf(stderr, "kernel_launch: note: occupancy query reports %d workgroups per CU\n", per_cu);
        (void)hipGetLastError();
        grid = cus;
    }
    if (grid < 0) return;
    if (hipMemsetAsync((char*)d_ws + OFF_CTL, 0, CTL_ZERO_BYTES, stream) != hipSuccess) { fprintf(stderr, "kernel_launch: memset failed\n"); return; }
    Args a{};
    for (int i = 0; i < 28; ++i) a.in[i] = (const float*)d_in[i];
    a.out = (float*)d_out; a.ws = (unsigned char*)d_ws;
#if MK_N_LAUNCHES == 1
    a.ph_lo = 0; a.ph_hi = NPH;
    hipLaunchKernelGGL(enc_fwd, dim3(grid), dim3(512), LDS_BYTES, stream, a);
#else
    for (int ph = 0; ph < NPH; ++ph) {
        if (ph > 0) { const int layer = (ph - 1) / PH_PER_LAYER, j = (ph - 1) % PH_PER_LAYER; if (j == 3 && layer % 3 != 2) continue; }
        a.ph_lo = ph; a.ph_hi = ph + 1;
        hipLaunchKernelGGL(enc_fwd, dim3(grid), dim3(512), LDS_BYTES, stream, a);
    }
#endif
    const hipError_t le = hipPeekAtLastError();
    if (le != hipSuccess) fprintf(stderr, "kernel_launch: launch failed: %s\n", hipGetErrorName(le));
}
```

```cpp
#include <hip/hip_runtime.h>
#include <cstdio>
#include <cstdint>

#ifndef MK_N_LAUNCHES
#define MK_N_LAUNCHES 1
#endif

constexpr int L = 16384, DM = 4096, DEPTH = 4, GRID_W = 64, GROWS = L / GRID_W, HD = 128, NH = 32, NKV = 8, KVD = NKV * HD, FF = 4 * DM, PLE = 256;
constexpr int S5G = 256, S5P = 16, S5N = 64, S5TC = 16, S5NC = L / S5TC;
constexpr float EPS = 1e-6f;

#define GAS __attribute__((address_space(1)))
#define LAS __attribute__((address_space(3)))
typedef unsigned short bf16;
typedef unsigned v4u __attribute__((ext_vector_type(4)));
typedef unsigned v2u __attribute__((ext_vector_type(2)));
typedef float f32x4 __attribute__((ext_vector_type(4)));
typedef float f32x2 __attribute__((ext_vector_type(2)));
typedef short bf16x8 __attribute__((ext_vector_type(8)));
typedef short s16x4 __attribute__((ext_vector_type(4)));
typedef GAS unsigned gu32;
#define RLX_AGENT __ATOMIC_RELAXED, __HIP_MEMORY_SCOPE_AGENT
#define LDS_WAIT() asm volatile("s_waitcnt lgkmcnt(0)" ::: "memory")
#define VM_WAIT() asm volatile("s_waitcnt vmcnt(0)" ::: "memory")
__device__ __forceinline__ unsigned f2bf(float f) { unsigned u = __builtin_bit_cast(unsigned, f); return (u + 0x7fffu + ((u >> 16) & 1u)) >> 16; }
__device__ __forceinline__ unsigned pk2(float lo, float hi) { return f2bf(lo) | (f2bf(hi) << 16); }
__device__ __forceinline__ float bf2f(unsigned short b) { return __builtin_bit_cast(float, (unsigned)b << 16); }
__device__ __forceinline__ float bflo(unsigned w) { return __builtin_bit_cast(float, w << 16); }
__device__ __forceinline__ float bfhi(unsigned w) { return __builtin_bit_cast(float, w & 0xffff0000u); }
__device__ __forceinline__ float sigmoidf_fast(float x) { return __builtin_amdgcn_rcpf(1.0f + __builtin_amdgcn_exp2f(-1.4426950408889634f * x)); }

namespace pg8 {
#define PG8_LAS __attribute__((address_space(3)))
#if defined(PROBE_EPI2)
#define PROBE_EPI_DUP if constexpr (Epi::PERM) E(acc, cur, wr, wc, fr, fq);
#else
#define PROBE_EPI_DUP
#endif
typedef unsigned short bf16_t;
typedef short bf16x8 __attribute__((ext_vector_type(8)));
typedef float f32x4 __attribute__((ext_vector_type(4)));
typedef unsigned u32x4 __attribute__((ext_vector_type(4)));
constexpr int BM = 256, BK = 64, HALF = 128, HTB = HALF * BK * 2  , STAGE_BYTES = 8 * HTB, NXCD = 8, WGM = 8;

__host__ __device__ __forceinline__ int lds_byte(int r, int c) { const int st = (r >> 4) * 2 + (c >> 5), rr = r & 15, cc = c & 31, ob = rr * 64 + cc * 2; return st * 1024 + (ob ^ (((ob >> 9) & 1) << 5)); }
__host__ __device__ __forceinline__ void stage_rc(int b, int& R, int& C) { const int st = b / 1024, sb = b % 1024, swz = sb ^ (((sb >> 9) & 1) << 5); R = (st >> 1) * 16 + swz / 64; C = (st & 1) * 32 + (swz % 64) / 2; }
__host__ __device__ __forceinline__ int perm32(int rho) { const int n = rho >> 4, i = rho & 15; return 8 * (i >> 2) + 4 * n + (i & 3); }

struct Unit { int pm, pn; };
struct Gemm { const bf16_t* A; const bf16_t* Bt; int M, N, K, lda, ldb; };
__host__ __device__ __forceinline__ Gemm mkgemm(const bf16_t* A, const bf16_t* Bt, int M, int N, int K) { Gemm g; g.A = A; g.Bt = Bt; g.M = M; g.N = N; g.K = K; g.lda = K; g.ldb = K; return g; }

struct StaticOrder {
    int nM, nN, nwg, G, c;
    __host__ __device__ void init(int M, int N, int G_, int c_) { nM = M / BM; nN = N / BM; nwg = nM * nN; G = G_; c = c_; }
    __host__ __device__ bool next(int i, Unit& u) const {
        const long L = (long)i * G + c; if (L >= nwg) return false;
        int wgid = (int)L; { const int q = nwg / NXCD, r = nwg % NXCD, xcd = wgid % NXCD, off = wgid / NXCD; wgid = (xcd < r ? xcd * (q + 1) : r * (q + 1) + (xcd - r) * q) + off; }
        const int nig = WGM * nN, gid = wgid / nig, fm = gid * WGM, gsz = (nM - fm) < WGM ? (nM - fm) : WGM;
        u.pm = fm + ((wgid % nig) % gsz); u.pn = (wgid % nig) / gsz; return true;
    }
    __device__ __forceinline__ void a_ready(const Unit&) const {}
    __device__ __forceinline__ void done(const Unit&) const {}
};
struct RangeOrder { StaticOrder S; int i0, i1;
    __host__ __device__ bool next(int i, Unit& u) const { return (i + i0 < i1) ? S.next(i + i0, u) : false; }
    __device__ __forceinline__ void a_ready(const Unit&) const {}
    __device__ __forceinline__ void done(const Unit&) const {} };


__device__ __forceinline__ unsigned cvt_pk_bf16(float lo, float hi) { unsigned r; asm volatile("v_cvt_pk_bf16_f32 %0, %1, %2" : "=v"(r) : "v"(lo), "v"(hi)); return r; }
__device__ __forceinline__ float sigm(float x) { return __builtin_amdgcn_rcpf(1.0f + __builtin_amdgcn_exp2f(-1.4426950408889634f * x)); }

typedef unsigned long long rs_t;
constexpr float RS_FIX = 16777216.0f, RS_INV = 1.0f / (16777216.0f * 4096.0f), RS_EPS = 1e-6f;
__device__ __forceinline__ void row_ss_add(rs_t* rs, int row, float s, int fq) {
    s += __shfl_xor(s, 16); s += __shfl_xor(s, 32);
    if (fq == 0) __hip_atomic_fetch_add(rs + row, (rs_t)(s * RS_FIX), __ATOMIC_RELAXED, __HIP_MEMORY_SCOPE_AGENT);
}
__device__ __forceinline__ float rs_rinv(rs_t v) { return __builtin_amdgcn_rsqf((float)v * RS_INV + RS_EPS); }
#define PIN8(a) asm volatile("" : "+v"((a)[0]), "+v"((a)[1]), "+v"((a)[2]), "+v"((a)[3]), "+v"((a)[4]), "+v"((a)[5]), "+v"((a)[6]), "+v"((a)[7]))
template <int ACT> struct EpiBf16 {
    static constexpr bool PERM = true, AFTER_DRAIN = false;
    bf16_t *O0, *O1, *O2; int ld0, ld1, ld2, c1, c2; const rs_t* rs; int vt; int rs_from;
    __device__ __forceinline__ void operator()(const f32x4 (&acc)[2][2][4][2], const Unit& u, int wr, int wc, int fr, int fq) const {
        const int row0 = u.pm * BM + wr * 64 + fr; int colt = u.pn * BM; bf16_t* base = O0; int ldc = ld0;
        const rs_t* rs = (colt >= rs_from) ? this->rs : nullptr;
        bool tr = false;
        if (colt >= c2) { base = O2; ldc = ld2; colt -= c2; tr = vt != 0; } else if (colt >= c1) { base = O1; ldc = ld1; colt -= c1; }
        const int col0 = colt + wc * 32 + 8 * fq;
        rs_t scv[8];
#pragma unroll
        for (int gi = 0; gi < 8; ++gi) scv[gi] = rs ? rs[row0 + (gi >> 2) * HALF + (gi & 3) * 16] : 0ull;
        PIN8(scv);
#pragma unroll
        for (int ai = 0; ai < 2; ++ai)
#pragma unroll
            for (int m = 0; m < 4; ++m) { bf16_t* rowp = base + (size_t)(row0 + ai * HALF + m * 16) * ldc + col0; const float sc = rs ? rs_rinv(scv[ai * 4 + m]) : 1.0f;
#pragma unroll
                for (int bj = 0; bj < 2; ++bj) { f32x4 v0 = acc[ai][bj][m][0] * sc, v1 = acc[ai][bj][m][1] * sc;
                    if (ACT == 2) {
#pragma unroll
                        for (int j = 0; j < 4; ++j) { const float a = fmaxf(v0[j], 0.f), b = fmaxf(v1[j], 0.f); v0[j] = a * a; v1[j] = b * b; } }
                    u32x4 w; w.x = cvt_pk_bf16(v0[0], v0[1]); w.y = cvt_pk_bf16(v0[2], v0[3]); w.z = cvt_pk_bf16(v1[0], v1[1]); w.w = cvt_pk_bf16(v1[2], v1[3]);
                    if (tr) { bf16_t* tp = base + (size_t)(col0 + bj * HALF) * ldc + (row0 + ai * HALF + m * 16);
                        tp[0] = (bf16_t)w.x; tp[(size_t)ldc] = (bf16_t)(w.x >> 16); tp[(size_t)2 * ldc] = (bf16_t)w.y; tp[(size_t)3 * ldc] = (bf16_t)(w.y >> 16);
                        tp[(size_t)4 * ldc] = (bf16_t)w.z; tp[(size_t)5 * ldc] = (bf16_t)(w.z >> 16); tp[(size_t)6 * ldc] = (bf16_t)w.w; tp[(size_t)7 * ldc] = (bf16_t)(w.w >> 16); }
                    else *(u32x4*)(rowp + bj * HALF) = w; } }
    }
};
struct EpiF32 {
    static constexpr bool PERM = false, AFTER_DRAIN = false;
    float* C; int ldc;
    __device__ __forceinline__ void operator()(const f32x4 (&acc)[2][2][4][2], const Unit& u, int wr, int wc, int fr, int fq) const {
        const int row0 = u.pm * BM + wr * 64 + fr, col0 = u.pn * BM + wc * 32 + 4 * fq;
#pragma unroll
        for (int ai = 0; ai < 2; ++ai)
#pragma unroll
            for (int m = 0; m < 4; ++m) { float* rowp = C + (size_t)(row0 + ai * HALF + m * 16) * ldc + col0;
#pragma unroll
                for (int bj = 0; bj < 2; ++bj)
#pragma unroll
                    for (int n = 0; n < 2; ++n) *(f32x4*)(rowp + bj * HALF + n * 16) = acc[ai][bj][m][n]; }
    }
};
typedef unsigned u32x2 __attribute__((ext_vector_type(2)));
__device__ __forceinline__ f32x4 bf4_to_f32(u32x2 p) { return (f32x4){__builtin_bit_cast(float, p.x << 16), __builtin_bit_cast(float, p.x & 0xffff0000u), __builtin_bit_cast(float, p.y << 16), __builtin_bit_cast(float, p.y & 0xffff0000u)}; }
struct EpiRes {
    static constexpr bool PERM = false, AFTER_DRAIN = false;
    const bf16_t* base; bf16_t* out; rs_t* rs; int ldc; const rs_t* rsq;
    __device__ __forceinline__ void operator()(const f32x4 (&acc)[2][2][4][2], const Unit& u, int wr, int wc, int fr, int fq) const {
        constexpr int PD = 3;
        const int row0 = u.pm * BM + wr * 64 + fr, col0 = u.pn * BM + wc * 32 + 4 * fq;
        u32x2 nb[8][2][2];
        rs_t scv[8];
#pragma unroll
        for (int gi = 0; gi < 8; ++gi) scv[gi] = rsq ? rsq[row0 + (gi >> 2) * HALF + (gi & 3) * 16] : 0ull;
#define EPI_LD(g) do { const size_t o_ = (size_t)(row0 + ((g) >> 2) * HALF + ((g) & 3) * 16) * ldc + col0; _Pragma("unroll") for (int bj = 0; bj < 2; ++bj) _Pragma("unroll") for (int n = 0; n < 2; ++n) nb[g][bj][n] = *(const u32x2*)(base + o_ + bj * HALF + n * 16); } while (0)
#pragma unroll
        for (int g = 0; g < PD; ++g) EPI_LD(g);
        PIN8(scv);
#pragma unroll
        for (int gi = 0; gi < 8; ++gi) { const int ai = gi >> 2, m = gi & 3; const int row = row0 + ai * HALF + m * 16; const size_t off = (size_t)row * ldc + col0;
            if (gi + PD < 8) EPI_LD(gi + PD);
            const float sc2 = rsq ? __builtin_amdgcn_rcpf((float)scv[gi] * RS_INV + RS_EPS) : 1.0f;
            float ss = 0.f;
#pragma unroll
            for (int bj = 0; bj < 2; ++bj)
#pragma unroll
                for (int n = 0; n < 2; ++n) { const f32x4 o = bf4_to_f32(nb[gi][bj][n]) + acc[ai][bj][m][n] * sc2;
                    ss += (o[0] * o[0] + o[1] * o[1]) + (o[2] * o[2] + o[3] * o[3]);
                    u32x2 w; w.x = cvt_pk_bf16(o[0], o[1]); w.y = cvt_pk_bf16(o[2], o[3]); *(u32x2*)(out + off + bj * HALF + n * 16) = w; }
            row_ss_add(rs, row, ss, fq); }
#undef EPI_LD
    }
};
struct EpiGate {
    static constexpr bool PERM = false, AFTER_DRAIN = false;
    const bf16_t* base; bf16_t* out; float* out32; const bf16_t* pp; const rs_t* rsin; rs_t* rs; int ldc;
    __device__ __forceinline__ void operator()(const f32x4 (&acc)[2][2][4][2], const Unit& u, int wr, int wc, int fr, int fq) const {
        constexpr int PD = 2;
        const int row0 = u.pm * BM + wr * 64 + fr, col0 = u.pn * BM + wc * 32 + 4 * fq;
        rs_t scv[8];
#pragma unroll
        for (int gi = 0; gi < 8; ++gi) scv[gi] = rsin[row0 + (gi >> 2) * HALF + (gi & 3) * 16];
        u32x2 nb[8][2][2], np[8][2][2];
#define EPI_LD(g) do { const size_t o_ = (size_t)(row0 + ((g) >> 2) * HALF + ((g) & 3) * 16) * ldc + col0; _Pragma("unroll") for (int bj = 0; bj < 2; ++bj) _Pragma("unroll") for (int n = 0; n < 2; ++n) { \
            nb[g][bj][n] = *(const u32x2*)(base + o_ + bj * HALF + n * 16); np[g][bj][n] = *(const u32x2*)(pp + o_ + bj * HALF + n * 16); } } while (0)
#pragma unroll
        for (int g = 0; g < PD; ++g) EPI_LD(g);
        PIN8(scv);
#pragma unroll
        for (int gi = 0; gi < 8; ++gi) { const int ai = gi >> 2, m = gi & 3; const int row = row0 + ai * HALF + m * 16; const size_t off = (size_t)row * ldc + col0;
            if (gi + PD < 8) EPI_LD(gi + PD);
            const float sc = rs_rinv(scv[gi]);
            float ss = 0.f;
#pragma unroll
            for (int bj = 0; bj < 2; ++bj)
#pragma unroll
                for (int n = 0; n < 2; ++n) { const f32x4 a = acc[ai][bj][m][n] * sc, p = bf4_to_f32(np[gi][bj][n]); f32x4 o = bf4_to_f32(nb[gi][bj][n]);
#pragma unroll
                    for (int j = 0; j < 4; ++j) o[j] += sigm(a[j]) * p[j];
                    if (out32) *(f32x4*)(out32 + off + bj * HALF + n * 16) = o;
                    ss += (o[0] * o[0] + o[1] * o[1]) + (o[2] * o[2] + o[3] * o[3]);
                    u32x2 w; w.x = cvt_pk_bf16(o[0], o[1]); w.y = cvt_pk_bf16(o[2], o[3]); *(u32x2*)(out + off + bj * HALF + n * 16) = w; }
            row_ss_add(rs, row, ss, fq); }
#undef EPI_LD
    }
};
struct EpiGlu {
    static constexpr bool PERM = false, AFTER_DRAIN = false;
    const bf16_t* base; bf16_t* out; rs_t* rs; int ldc;
    __device__ __forceinline__ void operator()(const f32x4 (&acc)[2][2][4][2], const Unit& u, int wr, int wc, int fr, int fq) const {
        constexpr int PD = 3;
        const int row0 = u.pm * BM + wr * 64 + fr, col0 = u.pn * HALF + wc * 32 + 4 * fq;
        u32x2 nb[8][2];
#define EPI_LD(g) do { const size_t o_ = (size_t)(row0 + ((g) >> 2) * HALF + ((g) & 3) * 16) * ldc + col0; _Pragma("unroll") for (int n = 0; n < 2; ++n) nb[g][n] = *(const u32x2*)(base + o_ + n * 16); } while (0)
#pragma unroll
        for (int g = 0; g < PD; ++g) EPI_LD(g);
#pragma unroll
        for (int gi = 0; gi < 8; ++gi) { const int ai = gi >> 2, m = gi & 3; const int row = row0 + ai * HALF + m * 16; const size_t off = (size_t)row * ldc + col0;
            if (gi + PD < 8) EPI_LD(gi + PD);
            float ss = 0.f;
#pragma unroll
            for (int n = 0; n < 2; ++n) { const f32x4 a = acc[ai][0][m][n], g = acc[ai][1][m][n]; f32x4 o = bf4_to_f32(nb[gi][n]);
#pragma unroll
                for (int j = 0; j < 4; ++j) o[j] += a[j] * sigm(g[j]);
                ss += (o[0] * o[0] + o[1] * o[1]) + (o[2] * o[2] + o[3] * o[3]);
                u32x2 w; w.x = cvt_pk_bf16(o[0], o[1]); w.y = cvt_pk_bf16(o[2], o[3]); *(u32x2*)(out + off + n * 16) = w; }
            row_ss_add(rs, row, ss, fq); }
#undef EPI_LD
    }
};

constexpr int S5T = 32, S5NCH = 512, S5KS = 768;
struct S5Order {
    int G, c, MT, NT;
    __device__ __forceinline__ bool next(int i, Unit& u) const { const int idx = i * G + c; if (idx >= 256 * MT * NT) return false; const int g = idx & 255, sub = idx >> 8;
        u.pm = g * MT + sub / NT; u.pn = g * NT + sub % NT; return true; }
    __device__ __forceinline__ void a_ready(const Unit&) const {}
    __device__ __forceinline__ void done(const Unit&) const {}
};
struct EpiS5U {
    static constexpr bool PERM = true, AFTER_DRAIN = false;
    bf16_t* UA; const rs_t* rs;
    __device__ __forceinline__ void operator()(const f32x4 (&acc)[2][2][4][2], const Unit& u, int wr, int wc, int fr, int fq) const {
        const int row0 = u.pm * BM + wr * 64 + fr, col0 = u.pn * BM + wc * 32 + 8 * fq;
        rs_t scv[8];
#pragma unroll
        for (int gi = 0; gi < 8; ++gi) scv[gi] = rs[row0 + (gi >> 2) * HALF + (gi & 3) * 16];
        PIN8(scv);
#pragma unroll
        for (int ai = 0; ai < 2; ++ai)
#pragma unroll
            for (int m = 0; m < 4; ++m) { const int t = row0 + ai * HALF + m * 16, c = t >> 5, sg = t & 31; const float sc = rs_rinv(scv[ai * 4 + m]);
#pragma unroll
                for (int bj = 0; bj < 2; ++bj) { const int col = col0 + bj * HALF, g = col >> 4, q0 = col & 15;
                    const f32x4 v0 = acc[ai][bj][m][0] * sc, v1 = acc[ai][bj][m][1] * sc;
                    u32x4 w; w.x = cvt_pk_bf16(v0[0], v0[1]); w.y = cvt_pk_bf16(v0[2], v0[3]); w.z = cvt_pk_bf16(v1[0], v1[1]); w.w = cvt_pk_bf16(v1[2], v1[3]);
                    *(u32x4*)(UA + ((size_t)(g * S5NCH + c) * S5KS + sg * 16 + q0)) = w; } }
    }
};
struct EpiS5E {
    static constexpr bool PERM = false, AFTER_DRAIN = false;
    float* E;
    __device__ __forceinline__ void operator()(const f32x4 (&acc)[2][2][4][2], const Unit& u, int wr, int wc, int fr, int fq) const {
        const int row0 = u.pm * BM + wr * 64 + fr, col0 = wc * 32 + 4 * fq;
#pragma unroll
        for (int ai = 0; ai < 2; ++ai)
#pragma unroll
            for (int m = 0; m < 4; ++m) { float* rowp = E + (size_t)(row0 + ai * HALF + m * 16) * 256 + col0;
#pragma unroll
                for (int bj = 0; bj < 2; ++bj)
#pragma unroll
                    for (int n = 0; n < 2; ++n) *(f32x4*)(rowp + bj * HALF + n * 16) = acc[ai][bj][m][n]; }
    }
};
__device__ __forceinline__ float gelu_tanh_f(float v) {
    const float z = 0.7978845608028654f * (v + 0.044715f * v * v * v);
    const float e = __builtin_amdgcn_exp2f(2.0f * 1.4426950408889634f * z);
    return 0.5f * v * (2.0f - 2.0f * __builtin_amdgcn_rcpf(e + 1.0f));
}
struct EpiS5Y {
    static constexpr bool PERM = true, AFTER_DRAIN = false;
    const bf16_t* UA; const float* dskip; bf16_t* G; int ldg;
    __device__ __forceinline__ void operator()(const f32x4 (&acc)[2][2][4][2], const Unit& u, int wr, int wc, int fr, int fq) const {
        const int row0 = u.pm * BM + wr * 64 + fr, col0 = (u.pn & 1) * BM + wc * 32 + 8 * fq;
        const int g = u.pm >> 1, p0 = col0 & 15;
        const f32x4 d0 = *(const f32x4*)(dskip + 16 * g + p0), d1 = *(const f32x4*)(dskip + 16 * g + p0 + 4);
        u32x4 uu[8][2];
#pragma unroll
        for (int gi = 0; gi < 8; ++gi)
#pragma unroll
            for (int bj = 0; bj < 2; ++bj) uu[gi][bj] = *(const u32x4*)(UA + ((size_t)(row0 + (gi >> 2) * HALF + (gi & 3) * 16) * S5KS + col0 + bj * HALF));
#pragma unroll
        for (int gi = 0; gi < 8; ++gi) asm volatile("" : "+v"(uu[gi][0]), "+v"(uu[gi][1]));
#pragma unroll
        for (int gi = 0; gi < 8; ++gi) { const int ai = gi >> 2, m = gi & 3; const int rowg = row0 + ai * HALF + m * 16, c = rowg & 511;
#pragma unroll
            for (int bj = 0; bj < 2; ++bj) { const int col = col0 + bj * HALF, tau = col >> 4; const u32x4 w4 = uu[gi][bj];
                f32x4 v0 = acc[ai][bj][m][0], v1 = acc[ai][bj][m][1];
                v0[0] += d0[0] * __builtin_bit_cast(float, w4.x << 16); v0[1] += d0[1] * __builtin_bit_cast(float, w4.x & 0xffff0000u);
                v0[2] += d0[2] * __builtin_bit_cast(float, w4.y << 16); v0[3] += d0[3] * __builtin_bit_cast(float, w4.y & 0xffff0000u);
                v1[0] += d1[0] * __builtin_bit_cast(float, w4.z << 16); v1[1] += d1[1] * __builtin_bit_cast(float, w4.z & 0xffff0000u);
                v1[2] += d1[2] * __builtin_bit_cast(float, w4.w << 16); v1[3] += d1[3] * __builtin_bit_cast(float, w4.w & 0xffff0000u);
#pragma unroll
                for (int j = 0; j < 4; ++j) { v0[j] = gelu_tanh_f(v0[j]); v1[j] = gelu_tanh_f(v1[j]); }
                u32x4 w; w.x = cvt_pk_bf16(v0[0], v0[1]); w.y = cvt_pk_bf16(v0[2], v0[3]); w.z = cvt_pk_bf16(v1[0], v1[1]); w.w = cvt_pk_bf16(v1[2], v1[3]);
                *(u32x4*)(G + (size_t)(32 * c + tau) * ldg + 16 * g + p0) = w; } }
    }
};

template <class Epi, class Sched, bool ALIGN_EPI = false, bool SP2 = false>
__device__ __forceinline__ void gemm_phase(PG8_LAS unsigned char* lds, const Gemm g, const Sched& S, const Epi& E) {
    int tid_o = threadIdx.x; asm volatile("" : "+v"(tid_o)); const int tid = tid_o, wid = __builtin_amdgcn_readfirstlane(tid >> 6), lane = tid & 63, wr = wid >> 2, wc = wid & 3, fr = lane & 15, fq = lane >> 4;
    const int K = g.K, nt = K / BK;
    unsigned voffA[2], voffB[2];
#pragma unroll
    for (int i = 0; i < 2; ++i) { int R, C; stage_rc(tid * 16 + i * 8192, R, C); const int Rb = Epi::PERM ? ((R & ~31) + perm32(R & 31)) : R;
        voffA[i] = (unsigned)(R * g.lda + C) * 2u; voffB[i] = (unsigned)(Rb * g.ldb + C) * 2u; }
    const size_t kstep = (size_t)(BK * 2);
    const size_t hstepA = (size_t)HALF * g.lda * 2, hstepB = (size_t)HALF * g.ldb * 2;
    const size_t tstepA = 2 * hstepA, tstepB = 2 * hstepB;
    const unsigned ldsw = (unsigned)wid * 1024u;
    const int aoff = lds_byte(wr * 64 + fr, fq * 8), boff = lds_byte(wc * 32 + fr, fq * 8);
#define PG8_SA(b, h) (((b) * 2 + (h)) * HTB)
#define PG8_SB(b, h) ((4 + (b) * 2 + (h)) * HTB)
#define PG8_STAGE(bufoff, gbase, voff) do { _Pragma("unroll") for (int _i = 0; _i < 2; ++_i) \
        __builtin_amdgcn_global_load_lds((const unsigned*)((const char*)(gbase) + (voff)[_i]), (PG8_LAS unsigned*)(lds + (bufoff) + ldsw + _i * 8192), 16, 0, 0); } while (0)
#define PG8_LDA(dst, b, h) do { _Pragma("unroll") for (int m = 0; m < 4; ++m) _Pragma("unroll") for (int k = 0; k < 2; ++k) dst[m][k] = *(const PG8_LAS bf16x8*)(lds + PG8_SA(b, h) + aoff + m * 2048 + k * 1024); } while (0)
#define PG8_LDB(dst, b, h) do { _Pragma("unroll") for (int n = 0; n < 2; ++n) _Pragma("unroll") for (int k = 0; k < 2; ++k) dst[n][k] = *(const PG8_LAS bf16x8*)(lds + PG8_SB(b, h) + boff + n * 2048 + k * 1024); } while (0)
#define PG8_MMA(ai, bj, At, Bt) do { __builtin_amdgcn_s_setprio(1); _Pragma("unroll") for (int m = 0; m < 4; ++m) _Pragma("unroll") for (int n = 0; n < 2; ++n) _Pragma("unroll") for (int k = 0; k < 2; ++k) \
        acc[ai][bj][m][n] = __builtin_amdgcn_mfma_f32_16x16x32_bf16(Bt[n][k], At[m][k], acc[ai][bj][m][n], 0, 0, 0); __builtin_amdgcn_s_setprio(0); } while (0)
#define PG8_WAIT_V(n) asm volatile("s_waitcnt vmcnt(" #n ")" ::: "memory")
#define PG8_WAIT_L(n) asm volatile("s_waitcnt lgkmcnt(" #n ")" ::: "memory")
#define PG8_BAR __builtin_amdgcn_s_barrier()
#define PG8_SCHED __builtin_amdgcn_sched_barrier(0)
    Unit cur, nxt; int ui = 0;
    if (!S.next(0, cur)) return;
    f32x4 acc[2][2][4][2];
#pragma unroll
    for (int a = 0; a < 2; ++a)
#pragma unroll
        for (int b = 0; b < 2; ++b)
#pragma unroll
            for (int m = 0; m < 4; ++m)
#pragma unroll
                for (int n = 0; n < 2; ++n) acc[a][b][m][n] = (f32x4){0.f, 0.f, 0.f, 0.f};
    bf16x8 At[4][2], B0[2][2], B1[2][2];
    const char* cA = (const char*)g.A + (size_t)cur.pm * tstepA; const char* cB = (const char*)g.Bt + (size_t)cur.pn * tstepB;
    S.a_ready(cur);
    if constexpr (SP2) {
        PG8_STAGE(PG8_SB(0, 0), cB, voffB); PG8_STAGE(PG8_SB(0, 1), cB + hstepB, voffB); PG8_STAGE(PG8_SA(0, 0), cA, voffA); PG8_STAGE(PG8_SA(0, 1), cA + hstepA, voffA);
        if (wr == 1) PG8_BAR;
        PG8_WAIT_V(2); PG8_BAR;
        PG8_STAGE(PG8_SB(1, 0), cB + kstep, voffB); PG8_STAGE(PG8_SA(1, 0), cA + kstep, voffA); PG8_STAGE(PG8_SB(1, 1), cB + hstepB + kstep, voffB);
        PG8_WAIT_V(6); PG8_BAR;
    } else {
        PG8_STAGE(PG8_SB(0, 0), cB, voffB); PG8_STAGE(PG8_SA(0, 0), cA, voffA); PG8_STAGE(PG8_SB(0, 1), cB + hstepB, voffB); PG8_STAGE(PG8_SA(0, 1), cA + hstepA, voffA);
        if (wr == 1) PG8_BAR;
        PG8_WAIT_V(4); PG8_BAR;
        PG8_STAGE(PG8_SB(1, 0), cB + kstep, voffB); PG8_STAGE(PG8_SA(1, 0), cA + kstep, voffA); PG8_STAGE(PG8_SB(1, 1), cB + hstepB + kstep, voffB);
        PG8_WAIT_V(6); PG8_BAR;
    }
    for (;;) {
        const bool has_next = S.next(ui + 1, nxt);
        const char* nA = has_next ? (const char*)g.A + (size_t)nxt.pm * tstepA : cA; const char* nB = has_next ? (const char*)g.Bt + (size_t)nxt.pn * tstepB : cB;
        for (int t = 0; t < nt; t += 2) {
            const bool last = (t == nt - 2);
            const char* a1 = cA + (size_t)(t + 1) * kstep;
            const char* a2 = last ? nA : cA + (size_t)(t + 2) * kstep; const char* b2 = last ? nB : cB + (size_t)(t + 2) * kstep;
            const char* a3 = a2 + kstep; const char* b3 = b2 + kstep;
            if (last && has_next) S.a_ready(nxt);
            if constexpr (SP2) {
            PG8_LDB(B0, 0, 0); PG8_LDB(B1, 0, 1); PG8_SCHED; PG8_LDA(At, 0, 0); PG8_STAGE(PG8_SA(1, 1), a1 + hstepA, voffA);
            PG8_WAIT_V(8); PG8_WAIT_L(0); PG8_BAR; PG8_MMA(0, 0, At, B0); PG8_MMA(0, 1, At, B1); PG8_BAR; PG8_SCHED;
            PG8_LDA(At, 0, 1); PG8_STAGE(PG8_SB(0, 0), b2, voffB); PG8_STAGE(PG8_SB(0, 1), b2 + hstepB, voffB); PG8_STAGE(PG8_SA(0, 0), a2, voffA);
            PG8_WAIT_V(8); PG8_WAIT_L(0); PG8_BAR; PG8_MMA(1, 0, At, B0); PG8_MMA(1, 1, At, B1); PG8_BAR; PG8_SCHED;
            PG8_LDB(B0, 1, 0); PG8_LDB(B1, 1, 1); PG8_SCHED; PG8_LDA(At, 1, 0); PG8_STAGE(PG8_SA(0, 1), a2 + hstepA, voffA);
            PG8_WAIT_V(8); PG8_WAIT_L(0); PG8_BAR; PG8_MMA(0, 0, At, B0); PG8_MMA(0, 1, At, B1); PG8_BAR; PG8_SCHED;
            PG8_LDA(At, 1, 1); PG8_STAGE(PG8_SB(1, 0), b3, voffB); PG8_STAGE(PG8_SB(1, 1), b3 + hstepB, voffB); PG8_STAGE(PG8_SA(1, 0), a3, voffA);
            PG8_WAIT_V(8); PG8_WAIT_L(0); PG8_BAR; PG8_MMA(1, 0, At, B0); PG8_MMA(1, 1, At, B1); PG8_BAR; PG8_SCHED;
            } else {
            PG8_LDB(B0, 0, 0); PG8_SCHED; PG8_LDA(At, 0, 0); PG8_STAGE(PG8_SA(1, 1), a1 + hstepA, voffA);
            PG8_WAIT_L(8); PG8_BAR; PG8_WAIT_L(0); PG8_MMA(0, 0, At, B0); PG8_BAR; PG8_SCHED;
            PG8_LDB(B1, 0, 1); PG8_STAGE(PG8_SB(0, 0), b2, voffB);
            PG8_BAR; PG8_WAIT_L(0); PG8_MMA(0, 1, At, B1); PG8_BAR;
            PG8_LDA(At, 0, 1); PG8_STAGE(PG8_SA(0, 0), a2, voffA);
            PG8_BAR; PG8_WAIT_L(0); PG8_MMA(1, 0, At, B0); PG8_BAR; PG8_SCHED;
            PG8_STAGE(PG8_SB(0, 1), b2 + hstepB, voffB);
            PG8_WAIT_V(6); PG8_BAR; PG8_MMA(1, 1, At, B1); PG8_BAR;
            PG8_LDB(B0, 1, 0); PG8_SCHED; PG8_LDA(At, 1, 0); PG8_STAGE(PG8_SA(0, 1), a2 + hstepA, voffA);
            PG8_WAIT_L(8); PG8_BAR; PG8_WAIT_L(0); PG8_MMA(0, 0, At, B0); PG8_BAR; PG8_SCHED;
            PG8_LDB(B1, 1, 1); PG8_STAGE(PG8_SB(1, 0), b3, voffB);
            PG8_BAR; PG8_WAIT_L(0); PG8_MMA(0, 1, At, B1); PG8_BAR;
            PG8_LDA(At, 1, 1); PG8_STAGE(PG8_SA(1, 0), a3, voffA);
            PG8_BAR; PG8_WAIT_L(0); PG8_MMA(1, 0, At, B0); PG8_BAR; PG8_SCHED;
            PG8_STAGE(PG8_SB(1, 1), b3 + hstepB, voffB);
            PG8_WAIT_V(6); PG8_BAR; PG8_MMA(1, 1, At, B1); PG8_BAR;
            }
        }
        if constexpr (ALIGN_EPI) { if (wr == 0) PG8_BAR; }
        if constexpr (!Epi::AFTER_DRAIN) { E(acc, cur, wr, wc, fr, fq); PROBE_EPI_DUP S.done(cur); }
        if (!has_next) break;
#pragma unroll
        for (int a = 0; a < 2; ++a)
#pragma unroll
            for (int b = 0; b < 2; ++b)
#pragma unroll
                for (int m = 0; m < 4; ++m)
#pragma unroll
                    for (int n = 0; n < 2; ++n) acc[a][b][m][n] = (f32x4){0.f, 0.f, 0.f, 0.f};
        cur = nxt; cA = nA; cB = nB; ++ui;
        if constexpr (ALIGN_EPI) { if (wr == 1) PG8_BAR; }
    }
    PG8_WAIT_V(0);
    if constexpr (!ALIGN_EPI) { if (wr == 0) PG8_BAR; }
    PG8_BAR;
    if constexpr (Epi::AFTER_DRAIN) { E.fused(acc, cur, wr, wc, fr, fq, lds, wid, lane); S.done(cur); }
#undef PG8_SA
#undef PG8_SB
#undef PG8_STAGE
#undef PG8_LDA
#undef PG8_LDB
#undef PG8_MMA
#undef PG8_WAIT_V
#undef PG8_WAIT_L
#undef PG8_BAR
#undef PG8_SCHED
}
}
#define XB_TMO      128
#define XB_XCNT(j)  (256  + 64 * (j))
#define XB_XSUB(j)  (1280 + 64 * (j))
#define XB_XGEN(j)  (2304 + 64 * (j))
#define XB_TOP      3328
#define XB_TOPGEN   3392
#define XCD_BAR_WORDS 3456
#define XB_SPIN_CAP (1u << 18)

__device__ __forceinline__ unsigned xb_ld(unsigned* p)              { return __hip_atomic_load(p, __ATOMIC_RELAXED, __HIP_MEMORY_SCOPE_AGENT); }
__device__ __forceinline__ unsigned xb_add(unsigned* p, unsigned v) { return __hip_atomic_fetch_add(p, v, __ATOMIC_RELAXED, __HIP_MEMORY_SCOPE_AGENT); }
__device__ __forceinline__ unsigned xb_xcc_id() { return (unsigned)__builtin_amdgcn_s_getreg((3 << 11) | 20) & 0xFu; }
#define XB_SPIN(cond, bar) do { unsigned _sp = 0; while (cond) { __builtin_amdgcn_s_sleep(1); \
    if ((++_sp & 255u) == 0u) { if (xb_ld(&(bar)[XB_TMO])) break; if (_sp > XB_SPIN_CAP) { atomicAdd(&(bar)[XB_TMO], 1u); break; } } } } while (0)

struct XcdBarrier {
    unsigned* bar; unsigned x;
    volatile LAS unsigned* st;
};

__device__ __forceinline__ XcdBarrier xcd_barrier_post(unsigned* bar, volatile LAS unsigned* st) {
    XcdBarrier b; b.bar = bar; b.x = xb_xcc_id(); b.st = st;
    if (threadIdx.x == 0) (void)xb_add(&bar[XB_XCNT(b.x)], 1u);
    return b;
}
__device__ __forceinline__ void xcd_barrier_complete(unsigned* bar, unsigned x, unsigned& nloc, unsigned& nx) {
    const unsigned G = gridDim.x * gridDim.y * gridDim.z;
    unsigned sum, cnt, mine, sp = 0u;
    for (;;) {
        sum = 0u; cnt = 0u; mine = 0u;
#pragma unroll
        for (unsigned j = 0; j < 16; ++j) { const unsigned c = xb_ld(&bar[XB_XCNT(j)]); sum += c; cnt += (c > 0u) ? 1u : 0u; mine = (j == x) ? c : mine; }
        if (sum == G) break;
        __builtin_amdgcn_s_sleep(1);
        if ((++sp & 255u) == 0u) { if (xb_ld(&bar[XB_TMO])) break; if (sp > XB_SPIN_CAP) { atomicAdd(&bar[XB_TMO], 1u); break; } }
    }
    nloc = mine > 0u ? mine : 1u; nx = cnt > 0u ? cnt : 1u;
}

__device__ __forceinline__ void xcd_barrier(const XcdBarrier& b) {
    asm volatile("s_waitcnt vmcnt(0)" ::: "memory");
    __syncthreads();
    if (threadIdx.x == 0) {
        unsigned* bar = b.bar;
        __builtin_amdgcn_s_waitcnt(0);
        unsigned nloc = b.st[0], nx = b.st[1];
        if (nloc == 0u) { xcd_barrier_complete(bar, b.x, nloc, nx); b.st[0] = nloc; b.st[1] = nx; }
        const unsigned old = xb_add(&bar[XB_XSUB(b.x)], 1u);
        const unsigned gen = old / nloc;
        if (old + 1u == (gen + 1u) * nloc) {
            __builtin_amdgcn_fence(__ATOMIC_RELEASE, "agent");
            asm volatile("s_waitcnt vmcnt(0)" ::: "memory");
            const unsigned og = xb_add(&bar[XB_TOP], 1u);
            const unsigned tg = og / nx;
            if (og + 1u == (tg + 1u) * nx) xb_add(&bar[XB_TOPGEN], 1u);
            else XB_SPIN(xb_ld(&bar[XB_TOPGEN]) == tg, bar);
            __builtin_amdgcn_fence(__ATOMIC_ACQUIRE, "agent");
            xb_add(&bar[XB_XGEN(b.x)], 1u);
            asm volatile("s_waitcnt vmcnt(0)" ::: "memory");
        } else {
            XB_SPIN(xb_ld(&bar[XB_XGEN(b.x)]) == gen, bar);
            __builtin_amdgcn_fence(__ATOMIC_ACQUIRE, "agent");
            asm volatile("s_waitcnt vmcnt(0)" ::: "memory");
        }
    }
    __syncthreads();
}
namespace dattn {
typedef unsigned short bf16;
constexpr int   D = 128, NW = 8, QBLK = 32, KVBLK = 64;
constexpr float SCALE = 0.088388347648318440f;
constexpr float THR = 8.f;
constexpr int SDEPTH = 2;
constexpr int LDQ = 4096, LDK = 1024, LDO = 4096;
constexpr size_t SHM_V = KVBLK * D * 2, SHM_K = KVBLK * D * 2, SHM_ATTN = 3 * SHM_V + 3 * SHM_K + NW * 64 * 4 + 2048;
using bf16x8 = __attribute__((ext_vector_type(8))) short;
using s16x4  = __attribute__((ext_vector_type(4))) short;
using f32x16 = __attribute__((ext_vector_type(16))) float;
using f32x8  = __attribute__((ext_vector_type(8))) float;
using u32x4  = __attribute__((ext_vector_type(4))) unsigned;
#define KSWZ(row, colB) ((row) * 256 + ((colB) ^ (((row) & 7) << 4)))
#define SBAR() __builtin_amdgcn_sched_barrier(0)
__device__ __forceinline__ int crow(int r, int hi) { return (r & 3) + 8 * (r >> 2) + 4 * hi; }
__device__ __forceinline__ unsigned cvtpk(float lo, float hi) {
  unsigned r; asm volatile("v_cvt_pk_bf16_f32 %0, %1, %2" : "=v"(r) : "v"(lo), "v"(hi)); return r;
}
template <typename TIn> struct Stage;
template <> struct Stage<bf16>  { using T = bf16x8;
  __device__ static __forceinline__ T ld8(const bf16* p) { return *reinterpret_cast<const bf16x8*>(p); }
  __device__ static __forceinline__ bf16x8 tobf(T x) { return x; } };
template <> struct Stage<float> { using T = f32x8;
  __device__ static __forceinline__ T ld8(const float* p) { return *reinterpret_cast<const f32x8*>(p); }
  __device__ static __forceinline__ bf16x8 tobf(T x) {
    u32x4 w = {cvtpk(x[0], x[1]), cvtpk(x[2], x[3]), cvtpk(x[4], x[5]), cvtpk(x[6], x[7])}; return *reinterpret_cast<bf16x8*>(&w); } };

__device__ __forceinline__ void partialSM(f32x16& p0, f32x16& p1, float& m_reg, float& mn, float& alpha) {
  constexpr float C = SCALE * 1.4426950408889634f;
  float pmax = p0[0]; for (int r = 1; r < 16; ++r) pmax = fmaxf(pmax, p0[r]); for (int r = 0; r < 16; ++r) pmax = fmaxf(pmax, p1[r]);
  { auto rr = __builtin_amdgcn_permlane32_swap(__float_as_uint(pmax), __float_as_uint(pmax), false, false);
    pmax = fmaxf(__uint_as_float(rr[0]), __uint_as_float(rr[1])); }
  if (__builtin_expect(__all(pmax - m_reg <= THR / SCALE), 1)) { mn = m_reg; alpha = 1.f; }
  else { mn = fmaxf(m_reg, pmax); alpha = __builtin_amdgcn_exp2f((m_reg - mn) * C); m_reg = mn; }
  float mnC = -mn * C;
  for (int r = 0; r < 16; ++r) p0[r] = fmaf(p0[r], C, mnC); for (int r = 0; r < 16; ++r) p1[r] = fmaf(p1[r], C, mnC);
  for (int r = 0; r < 16; ++r) p0[r] = __builtin_amdgcn_exp2f(p0[r]);
}
__device__ __forceinline__ void finishSM(f32x16& p0, f32x16& p1, float alpha, float& l_reg, bf16x8& pa0, bf16x8& pa1, bf16x8& pa2, bf16x8& pa3) {
  for (int r = 0; r < 16; ++r) p1[r] = __builtin_amdgcn_exp2f(p1[r]);
  float ps = 0; for (int r = 0; r < 16; ++r) ps += p0[r]; for (int r = 0; r < 16; ++r) ps += p1[r];
  { auto rr = __builtin_amdgcn_permlane32_swap(__float_as_uint(ps), __float_as_uint(ps), false, false);
    ps = __uint_as_float(rr[0]) + __uint_as_float(rr[1]); }
  l_reg = l_reg * alpha + ps;
#define PK4(P, BASE, OUT) do { unsigned a0 = cvtpk(P[BASE + 0], P[BASE + 1]), a1 = cvtpk(P[BASE + 2], P[BASE + 3]);   \
    unsigned b0 = cvtpk(P[BASE + 4], P[BASE + 5]), b1 = cvtpk(P[BASE + 6], P[BASE + 7]);                              \
    auto r0 = __builtin_amdgcn_permlane32_swap(a0, b0, false, false); auto r1 = __builtin_amdgcn_permlane32_swap(a1, b1, false, false); \
    u32x4 w = {r0[0], r1[0], r0[1], r1[1]}; OUT = *reinterpret_cast<bf16x8*>(&w); } while (0)
  PK4(p0, 0, pa0); PK4(p0, 8, pa1); PK4(p1, 0, pa2); PK4(p1, 8, pa3);
#undef PK4
}
__device__ __forceinline__ void qkt(f32x16& p0, f32x16& p1, const bf16* Ks, const bf16x8* qr, int r32, int hi) {
  p0 = f32x16{}; p1 = f32x16{};
  bf16x8 nb0 = *reinterpret_cast<const bf16x8*>((const char*)Ks + KSWZ(r32, (hi * 8) * 2)), nb1 = *reinterpret_cast<const bf16x8*>((const char*)Ks + KSWZ(32 + r32, (hi * 8) * 2));
#pragma unroll
  for (int d0 = 0; d0 < 8; ++d0) { const bf16x8 b0 = nb0, b1 = nb1;
    if (d0 < 7) { const int cb = ((d0 + 1) * 16 + hi * 8) * 2;
      nb0 = *reinterpret_cast<const bf16x8*>((const char*)Ks + KSWZ(r32, cb)); nb1 = *reinterpret_cast<const bf16x8*>((const char*)Ks + KSWZ(32 + r32, cb)); }
    p0 = __builtin_amdgcn_mfma_f32_32x32x16_bf16(b0, qr[d0], p0, 0, 0, 0);
    p1 = __builtin_amdgcn_mfma_f32_32x32x16_bf16(b1, qr[d0], p1, 0, 0, 0); }
}
__device__ __forceinline__ int v_st(int k, int c) { const int kk = (k & ~0xC) | ((k & 4) << 1) | ((k & 8) >> 1); return ((kk >> 3) * 4 + (c >> 5)) * 512 + ((kk & 7) * 32 + (c & 31)) * 2; }
__device__ __forceinline__ int v_rd_base(int lane) { return ((lane & 3) << 3) | (((lane >> 2) & 3) << 6) | (((lane >> 4) & 1) << 5) | (((lane >> 5) & 1) << 8); }
constexpr int v_rd_off(int d0, int ks, int half) { return d0 * 512 + ks * 4096 + half * 2048; }
template <int OFF> __device__ __forceinline__ s16x4 tr_read(int vb) {
  s16x4 r; asm volatile("ds_read_b64_tr_b16 %0, %1 offset:%2" : "=&v"(r) : "v"(vb), "i"(OFF) : "memory"); return r;
}
template <int D0> __device__ __forceinline__ void pv_one(f32x16& od, int vb, bf16x8 pa0, bf16x8 pa1, bf16x8 pa2, bf16x8 pa3) {
  const s16x4 l0 = tr_read<v_rd_off(D0, 0, 0)>(vb), h0 = tr_read<v_rd_off(D0, 0, 1)>(vb), l1 = tr_read<v_rd_off(D0, 1, 0)>(vb), h1 = tr_read<v_rd_off(D0, 1, 1)>(vb);
  const s16x4 l2 = tr_read<v_rd_off(D0, 2, 0)>(vb), h2 = tr_read<v_rd_off(D0, 2, 1)>(vb), l3 = tr_read<v_rd_off(D0, 3, 0)>(vb), h3 = tr_read<v_rd_off(D0, 3, 1)>(vb);
  asm volatile("s_waitcnt lgkmcnt(0)" ::: "memory"); SBAR();
#define PK(L, H) (bf16x8){L[0], L[1], L[2], L[3], H[0], H[1], H[2], H[3]}
  od = __builtin_amdgcn_mfma_f32_32x32x16_bf16(pa0, PK(l0, h0), od, 0, 0, 0);
  od = __builtin_amdgcn_mfma_f32_32x32x16_bf16(pa1, PK(l1, h1), od, 0, 0, 0);
  od = __builtin_amdgcn_mfma_f32_32x32x16_bf16(pa2, PK(l2, h2), od, 0, 0, 0);
  od = __builtin_amdgcn_mfma_f32_32x32x16_bf16(pa3, PK(l3, h3), od, 0, 0, 0);
#undef PK
}
__device__ __forceinline__ void pv_d0(f32x16* o, int vb, bf16x8 pa0, bf16x8 pa1, bf16x8 pa2, bf16x8 pa3) {
  pv_one<0>(o[0], vb, pa0, pa1, pa2, pa3); pv_one<1>(o[1], vb, pa0, pa1, pa2, pa3); pv_one<2>(o[2], vb, pa0, pa1, pa2, pa3); pv_one<3>(o[3], vb, pa0, pa1, pa2, pa3);
}

template <typename TQ>
__device__ __forceinline__ void attn_dense_body(const TQ* __restrict__ Qb, const bf16* __restrict__ Kh, const bf16* __restrict__ Vh,
                                                bf16* __restrict__ Ob, int seq, char* lds) {
  using St = Stage<bf16>; using SQ = Stage<TQ>;
  int tid_o = threadIdx.x; asm volatile("" : "+v"(tid_o)); const int tid = tid_o, wid = __builtin_amdgcn_readfirstlane(tid >> 6), lane = tid & 63, r32 = lane & 31, hi = lane >> 5;
  bf16* V_lds = (bf16*)lds; bf16* K_lds = (bf16*)(lds + 3 * SHM_V);
  float* ws = (float*)(lds + 3 * SHM_V + 3 * SHM_K) + wid * 64; float* li_l = ws; float* al_l = ws + 32;
  float m_reg = -1e30f, l_reg = 0; f32x16 o[4] = {}; bf16x8 qr[8];
  const TQ* Qw = Qb + (long)(wid * QBLK + r32) * LDQ + hi * 8;
#pragma unroll
  for (int d0 = 0; d0 < 8; ++d0) qr[d0] = SQ::tobf(SQ::ld8(Qw + d0 * 16));
  const int sr = tid >> 4, sc = (tid & 15) * 8, vst0 = v_st(sr, sc), vst1 = v_st(32 + sr, sc);
  const int vb0 = (int)(uintptr_t)V_lds + v_rd_base(lane);
  struct { typename St::T vs0, vs1, ks0, ks1; } sr_[SDEPTH];
#define SLOAD(i, k0) do { sr_[i].vs0 = St::ld8(&Vh[(long)((k0) + sr) * LDK + sc]); sr_[i].vs1 = St::ld8(&Vh[(long)((k0) + 32 + sr) * LDK + sc]); \
    sr_[i].ks0 = St::ld8(&Kh[(long)((k0) + sr) * LDK + sc]); sr_[i].ks1 = St::ld8(&Kh[(long)((k0) + 32 + sr) * LDK + sc]); } while (0)
#define SWRITE(b, i) do { *(bf16x8*)((char*)V_lds + (b) * SHM_V + vst0) = St::tobf(sr_[i].vs0);          \
    *(bf16x8*)((char*)V_lds + (b) * SHM_V + vst1) = St::tobf(sr_[i].vs1); int kc = sc * 2;               \
    *(bf16x8*)((char*)K_lds + (b) * SHM_K + KSWZ(sr, kc)) = St::tobf(sr_[i].ks0);                       \
    *(bf16x8*)((char*)K_lds + (b) * SHM_K + KSWZ(32 + sr, kc)) = St::tobf(sr_[i].ks1); } while (0)
#define SWAIT() do { if constexpr (SDEPTH == 2) asm volatile("s_waitcnt vmcnt(4)" ::: "memory"); else asm volatile("s_waitcnt vmcnt(0)" ::: "memory"); } while (0)
#define RESC(a) do { if (__any((a) < 1.f)) { if (hi == 0) al_l[r32] = (a); asm volatile("s_waitcnt lgkmcnt(0)" ::: "memory"); \
    for (int d = 0; d < 4; ++d) for (int r = 0; r < 16; ++r) o[d][r] *= al_l[crow(r, hi)]; } } while (0)
  f32x16 pA0, pA1, pB0, pB1; float mnA, mnB, alA, alB; bf16x8 pa0, pa1, pa2, pa3; const int NT = seq / KVBLK;
  constexpr int SE = 0, SO = SDEPTH - 1;
  SLOAD(SE, 0); asm volatile("s_waitcnt vmcnt(0)" ::: "memory"); SWRITE(0, SE); __syncthreads();
  qkt(pA0, pA1, K_lds, qr, r32, hi); partialSM(pA0, pA1, m_reg, mnA, alA);
  SLOAD(SO, KVBLK); if constexpr (SDEPTH == 2) { if (2 < NT) SLOAD(SE, 2 * KVBLK); }
  SWAIT(); SWRITE(1, SO); __syncthreads();
  int bk = 1, bv = 0, bw = 2;
#define ROT3() do { const int t_ = bv; bv = bk; bk = bw; bw = t_; } while (0)
  for (int j = 1; j + 1 < NT; j += 2) {
    SBAR(); qkt(pB0, pB1, (bf16*)((char*)K_lds + bk * SHM_K), qr, r32, hi);
    finishSM(pA0, pA1, alA, l_reg, pa0, pa1, pa2, pa3); SBAR();
    SLOAD(SO, (j + SDEPTH) * KVBLK); SBAR();
    pv_d0(o, vb0 + bv * (int)SHM_V, pa0, pa1, pa2, pa3); partialSM(pB0, pB1, m_reg, mnB, alB);
    SWAIT(); SWRITE(bw, SE);
    RESC(alB); __syncthreads(); ROT3();
    SBAR(); qkt(pA0, pA1, (bf16*)((char*)K_lds + bk * SHM_K), qr, r32, hi);
    finishSM(pB0, pB1, alB, l_reg, pa0, pa1, pa2, pa3); SBAR();
    if (SDEPTH == 1 || j + 3 < NT) SLOAD(SE, (j + 1 + SDEPTH) * KVBLK); SBAR();
    pv_d0(o, vb0 + bv * (int)SHM_V, pa0, pa1, pa2, pa3); partialSM(pA0, pA1, m_reg, mnA, alA);
    SWAIT(); SWRITE(bw, SO);
    RESC(alA); __syncthreads(); ROT3();
  }
  SBAR(); qkt(pB0, pB1, (bf16*)((char*)K_lds + bk * SHM_K), qr, r32, hi);
  finishSM(pA0, pA1, alA, l_reg, pa0, pa1, pa2, pa3); SBAR();
  pv_d0(o, vb0 + bv * (int)SHM_V, pa0, pa1, pa2, pa3); partialSM(pB0, pB1, m_reg, mnB, alB);
  RESC(alB);
  finishSM(pB0, pB1, alB, l_reg, pa0, pa1, pa2, pa3); SBAR();
  pv_d0(o, vb0 + bk * (int)SHM_V, pa0, pa1, pa2, pa3);
#undef ROT3
  if (hi == 0) li_l[r32] = l_reg; asm volatile("s_waitcnt lgkmcnt(0)" ::: "memory");
  float rli[16];
#pragma unroll
  for (int r = 0; r < 16; ++r) rli[r] = __builtin_amdgcn_rcpf(li_l[crow(r, hi)]);
  bf16* Ow = Ob + (long)(wid * QBLK) * LDO;
#pragma unroll
  for (int r = 0; r < 16; ++r) { int orow = crow(r, hi);
    for (int d0 = 0; d0 < 4; ++d0) Ow[(long)orow * LDO + d0 * 32 + r32] = (bf16)(cvtpk(o[d0][r] * rli[r], 0.f) & 0xffffu); }
#undef SLOAD
#undef SWRITE
#undef SWAIT
#undef RESC
}

constexpr int NA_LD = 4096, NA_TILES = 12;
__device__ __forceinline__ void na_block_body(const bf16* __restrict__ Qb, const bf16* __restrict__ Kh, const bf16* __restrict__ Vh, bf16* __restrict__ Ob,
                                              const float* __restrict__ rpb_h, const float* __restrict__ qgain, const float* __restrict__ kgain, int R, int ks, char* lds) {
  using St = Stage<bf16>;
  int tid_o = threadIdx.x; asm volatile("" : "+v"(tid_o)); const int tid = tid_o, wid = __builtin_amdgcn_readfirstlane(tid >> 6), lane = tid & 63, r32 = lane & 31, hi = lane >> 5;
  bf16* V_lds = (bf16*)lds; bf16* K_lds = (bf16*)(lds + 2 * SHM_V);
  float* ws = (float*)(lds + 2 * SHM_V + 2 * SHM_K) + wid * 64; float* li_l = ws; float* al_l = ws + 32;
  float* bt = (float*)(lds + 2 * SHM_V + 2 * SHM_K + NW * 64 * 4);
  float m_reg = -1e30f, l_reg = 0; f32x16 o[4] = {}; bf16x8 qr[8];
  const bf16* Qw = Qb + (long)(wid * QBLK + r32) * NA_LD + hi * 8;
#pragma unroll
  for (int d0 = 0; d0 < 8; ++d0) qr[d0] = St::ld8(Qw + d0 * 16);
  {
    float ss = 0.f;
#pragma unroll
    for (int d0 = 0; d0 < 8; ++d0) { const u32x4 w = __builtin_bit_cast(u32x4, qr[d0]);
#pragma unroll
      for (int e = 0; e < 4; ++e) { const float a = __uint_as_float(w[e] << 16), b = __uint_as_float(w[e] & 0xffff0000u); ss += a * a + b * b; } }
    ss += __shfl_xor(ss, 32);
    const float rinv = __builtin_amdgcn_rsqf(ss * (1.0f / 128.0f) + 1e-6f);
#pragma unroll
    for (int d0 = 0; d0 < 8; ++d0) { const u32x4 w = __builtin_bit_cast(u32x4, qr[d0]); const float* gp = qgain + d0 * 16 + hi * 8;
      const f32x8 g = *reinterpret_cast<const f32x8*>(gp); u32x4 o;
#pragma unroll
      for (int e = 0; e < 4; ++e) o[e] = cvtpk(__uint_as_float(w[e] << 16) * rinv * g[2 * e], __uint_as_float(w[e] & 0xffff0000u) * rinv * g[2 * e + 1]);
      qr[d0] = __builtin_bit_cast(bf16x8, o); } }
  const f32x8 kg = *reinterpret_cast<const f32x8*>(kgain + (tid & 15) * 8);
  for (int i = tid; i < 15 * 31; i += 64 * NW) bt[i] = rpb_h[i];
  const int sr = tid >> 4, sc = (tid & 15) * 8, vst0 = v_st(sr, sc), vst1 = v_st(32 + sr, sc);
  const int vb0 = (int)(uintptr_t)V_lds + v_rd_base(lane);
  bf16x8 s_vs0, s_vs1, s_ks0, s_ks1;
#define NLOAD(k0) do { s_vs0 = St::ld8(&Vh[(long)((k0) + sr) * NA_LD + sc]); s_vs1 = St::ld8(&Vh[(long)((k0) + 32 + sr) * NA_LD + sc]); \
    s_ks0 = St::ld8(&Kh[(long)((k0) + sr) * NA_LD + sc]); s_ks1 = St::ld8(&Kh[(long)((k0) + 32 + sr) * NA_LD + sc]); } while (0)
#define KNORM(x) do { const u32x4 w_ = __builtin_bit_cast(u32x4, x); float a_[8]; float ss_ = 0.f; \
    _Pragma("unroll") for (int e = 0; e < 4; ++e) { a_[2 * e] = __uint_as_float(w_[e] << 16); a_[2 * e + 1] = __uint_as_float(w_[e] & 0xffff0000u); ss_ += a_[2 * e] * a_[2 * e] + a_[2 * e + 1] * a_[2 * e + 1]; } \
    ss_ += __shfl_xor(ss_, 1); ss_ += __shfl_xor(ss_, 2); ss_ += __shfl_xor(ss_, 4); ss_ += __shfl_xor(ss_, 8); \
    const float ri_ = __builtin_amdgcn_rsqf(ss_ * (1.0f / 128.0f) + 1e-6f); u32x4 o_; \
    _Pragma("unroll") for (int e = 0; e < 4; ++e) o_[e] = cvtpk(a_[2 * e] * ri_ * kg[2 * e], a_[2 * e + 1] * ri_ * kg[2 * e + 1]); \
    x = __builtin_bit_cast(bf16x8, o_); } while (0)
#define NWRITE(b) do { KNORM(s_ks0); KNORM(s_ks1); \
    *(bf16x8*)((char*)V_lds + (b) * SHM_V + vst0) = s_vs0; *(bf16x8*)((char*)V_lds + (b) * SHM_V + vst1) = s_vs1; const int kc_ = sc * 2; \
    *(bf16x8*)((char*)K_lds + (b) * SHM_K + KSWZ(sr, kc_)) = s_ks0; *(bf16x8*)((char*)K_lds + (b) * SHM_K + KSWZ(32 + sr, kc_)) = s_ks1; } while (0)
  const int qrow = R + (wid >> 1), r0q = min(max(qrow - 4, 0), 248), jlo = r0q - ks;
  const int c = 32 * (wid & 1) + r32, c0 = min(max(c - 8, 0), 48);
  NLOAD(0); asm volatile("s_waitcnt vmcnt(0)" ::: "memory"); NWRITE(0); __syncthreads();
  for (int j = 0; j < NA_TILES; ++j) {
    const int buf = j & 1;
    if (j + 1 < NA_TILES) NLOAD((j + 1) * KVBLK);
    if (j >= jlo && j < jlo + 8) {
      f32x16 p0, p1; float mn, al; bf16x8 pa0, pa1, pa2, pa3;
      SBAR(); qkt(p0, p1, (bf16*)((char*)K_lds + buf * SHM_K), qr, r32, hi);
      const float* brow = bt + (ks + j - qrow + 7) * 31 + (15 - c);
#pragma unroll
      for (int r = 0; r < 16; ++r) { const int k0 = crow(r, hi), k1 = 32 + k0; const bool v0 = (k0 >= c0) && (k0 < c0 + 16), v1 = (k1 >= c0) && (k1 < c0 + 16);
        const float b0 = brow[v0 ? k0 : c], b1 = brow[v1 ? k1 : c];
        p0[r] = v0 ? fmaf(b0, 1.0f / SCALE, p0[r]) : -1e30f; p1[r] = v1 ? fmaf(b1, 1.0f / SCALE, p1[r]) : -1e30f; }
      partialSM(p0, p1, m_reg, mn, al);
      if (__any(al < 1.f)) { if (hi == 0) al_l[r32] = al; asm volatile("s_waitcnt lgkmcnt(0)" ::: "memory");
#pragma unroll
        for (int d = 0; d < 4; ++d)
#pragma unroll
          for (int r = 0; r < 16; ++r) o[d][r] *= al_l[crow(r, hi)]; }
      finishSM(p0, p1, al, l_reg, pa0, pa1, pa2, pa3); SBAR();
      pv_d0(o, vb0 + buf * (int)SHM_V, pa0, pa1, pa2, pa3);
    }
    if (j + 1 < NA_TILES) { asm volatile("s_waitcnt vmcnt(0)" ::: "memory"); NWRITE(buf ^ 1); }
    __syncthreads();
  }
  if (hi == 0) li_l[r32] = l_reg; asm volatile("s_waitcnt lgkmcnt(0)" ::: "memory");
  float rli[16];
#pragma unroll
  for (int r = 0; r < 16; ++r) rli[r] = __builtin_amdgcn_rcpf(li_l[crow(r, hi)]);
  bf16* Ow = Ob + (long)(wid * QBLK) * NA_LD;
#pragma unroll
  for (int r = 0; r < 16; ++r) { const int orow = crow(r, hi);
    for (int d0 = 0; d0 < 4; ++d0) Ow[(long)orow * NA_LD + d0 * 32 + r32] = (bf16)(cvtpk(o[d0][r] * rli[r], 0.f) & 0xffffu); }
#undef NLOAD
#undef NWRITE
#undef KNORM
}
}
struct Frame {
    LAS unsigned char* lds;
    int tid, lane, wave;
    int bid, vcu, G;
};
__device__ __forceinline__ float wave_sum(float v) {
#pragma unroll
    for (int o = 1; o < 64; o <<= 1) v += __shfl_xor(v, o);
    return v;
}
__device__ __forceinline__ void xrows_phase(const Frame& F, const float* __restrict__ h, bf16* __restrict__ hb, pg8::rs_t* __restrict__ rs) {
    const int gw = F.vcu * 8 + F.wave, NGW = F.G * 8;
    for (int m = gw; m < L; m += NGW) {
        const f32x4* xr = (const f32x4*)(h + (size_t)m * DM) + F.lane;
        v2u* o8 = (v2u*)(hb + (size_t)m * DM) + F.lane;
        float s = 0.f;
#pragma unroll
        for (int j = 0; j < 16; ++j) { const f32x4 v = xr[64 * j]; s += (v.x * v.x + v.y * v.y) + (v.z * v.z + v.w * v.w); v2u w; w.x = pk2(v.x, v.y); w.y = pk2(v.z, v.w); o8[64 * j] = w; }
        s = wave_sum(s);
        if (F.lane == 0) rs[m] = (pg8::rs_t)(s * pg8::RS_FIX);
    }
}
__device__ __forceinline__ void headnorm_rows(bf16* __restrict__ X, int ld, int nheads, const float* __restrict__ gain, int t, int lane, bool rope, const float (&cs)[8], const float (&sn)[8]) {
    const int hs = lane >> 4, l16 = lane & 15;
    f32x4 g0 = *(const f32x4*)(gain + 8 * l16), g1 = *(const f32x4*)(gain + 8 * l16 + 4);
    const float gg[8] = {g0.x, g0.y, g0.z, g0.w, g1.x, g1.y, g1.z, g1.w};
    const bool second = ((l16 >> 2) & 1) != 0;
    for (int hg = 0; hg < nheads / 4; ++hg) {
        bf16* p = X + (size_t)t * ld + (size_t)(4 * hg + hs) * HD + 8 * l16;
        const v4u raw = *(const v4u*)p;
        float x[8] = {bflo(raw.x), bfhi(raw.x), bflo(raw.y), bfhi(raw.y), bflo(raw.z), bfhi(raw.z), bflo(raw.w), bfhi(raw.w)};
        float ss = 0.f;
#pragma unroll
        for (int e = 0; e < 8; ++e) ss += x[e] * x[e];
        ss += __shfl_xor(ss, 1); ss += __shfl_xor(ss, 2); ss += __shfl_xor(ss, 4); ss += __shfl_xor(ss, 8);
        const float rinv = 1.0f / sqrtf(ss * (1.0f / HD) + EPS);
        float y[8];
#pragma unroll
        for (int e = 0; e < 8; ++e) y[e] = x[e] * rinv * gg[e];
        if (rope) {
#pragma unroll
            for (int e = 0; e < 8; ++e) { const float yp = __shfl_xor(y[e], 4); y[e] = second ? (y[e] * cs[e] + yp * sn[e]) : (y[e] * cs[e] - yp * sn[e]); }
        }
        v4u w; w.x = pk2(y[0], y[1]); w.y = pk2(y[2], y[3]); w.z = pk2(y[4], y[5]); w.w = pk2(y[6], y[7]);
        *(v4u*)p = w;
    }
}
__device__ __forceinline__ void prep_phase(const Frame& F, bf16* Q, bf16* K, int ldk, int nkh, const float* qgain, const float* kgain, bool rope) {
    const int gw = F.vcu * 8 + F.wave, NGW = F.G * 8;
    const int l16 = F.lane & 15;
    for (int t = gw; t < L; t += NGW) {
        float cs[8], sn[8];
#pragma unroll
        for (int e = 0; e < 8; ++e) { cs[e] = 1.f; sn[e] = 0.f; }
        if (rope) {
            const int ax = l16 >> 3; const float pos = (float)(ax ? (t & (GRID_W - 1)) : (t / GRID_W));
#pragma unroll
            for (int e = 0; e < 8; ++e) { const int f = (l16 & 3) * 8 + e; const float inv = 1.0f / powf(10000.0f, (float)f * (1.0f / 32.0f)); const float ang = pos * inv; cs[e] = cosf(ang); sn[e] = sinf(ang); }
        }
        headnorm_rows(Q, DM, NH, qgain, t, F.lane, rope, cs, sn);
        headnorm_rows(K, ldk, nkh, kgain, t, F.lane, rope, cs, sn);
    }
}

constexpr int S5T = pg8::S5T, S5NCH = pg8::S5NCH, S5KS = pg8::S5KS;
__device__ __forceinline__ void s5_gen_group(const Frame& F, int g, const float* __restrict__ lam_re, const float* __restrict__ lam_im, const float* __restrict__ log_step,
                                             const float* __restrict__ b_re, const float* __restrict__ b_im, const float* __restrict__ c_re, const float* __restrict__ c_im,
                                             bf16* __restrict__ GM, bf16* __restrict__ BMt, f32x2* __restrict__ PAT) {
    LAS f32x2* apow = (LAS f32x2*)F.lds;
    LAS f32x2* zt = apow + 2 * 33 * 64;
    LAS float* Kd = (LAS float*)(zt + 2 * 64);
    const int tid = F.tid;
    if (tid < 128) {
        const int dir = tid >> 6, n = tid & 63, dg = dir * S5G + g, idx = dg * S5N + n;
        const double dt = exp((double)log_step[dg]);
        const double lr = (double)lam_re[idx], li = (double)lam_im[idx];
        const double mag = exp(lr * dt), are = mag * cos(li * dt), aim = mag * sin(li * dt);
        const double den = lr * lr + li * li, nre = are - 1.0;
        zt[dir * 64 + n] = (f32x2){(float)((nre * lr + aim * li) / den), (float)((aim * lr - nre * li) / den)};
        double pr = 1.0, pi = 0.0;
        for (int k = 0; k <= 32; ++k) { apow[(dir * 33 + k) * 64 + n] = (f32x2){(float)pr, (float)pi}; const double t = pr * are - pi * aim; pi = pr * aim + pi * are; pr = t; }
        PAT[idx] = apow[(dir * 33 + 32) * 64 + n];
    }
    LDS_WAIT(); __syncthreads();
    {
        const int dir = tid >> 8, p = (tid >> 4) & 15, q = tid & 15, dg = dir * S5G + g;
        float wr[64], wi[64];
        const float* cr = c_re + ((size_t)dg * S5P + p) * S5N; const float* ci = c_im + ((size_t)dg * S5P + p) * S5N;
#pragma unroll
        for (int n = 0; n < 64; ++n) { const f32x2 z = zt[dir * 64 + n]; const float br = b_re[((size_t)dg * S5N + n) * S5P + q], bi = b_im[((size_t)dg * S5N + n) * S5P + q];
            const float bbr = z.x * br - z.y * bi, bbi = z.x * bi + z.y * br; const float c0 = cr[n], c1 = ci[n];
            wr[n] = c0 * bbr - c1 * bbi; wi[n] = c0 * bbi + c1 * bbr; }
        for (int d = 0; d < 32; ++d) { float acc = 0.f; const LAS f32x2* ap = apow + (dir * 33 + d) * 64;
#pragma unroll
            for (int n = 0; n < 64; ++n) { const f32x2 a = ap[n]; acc = fmaf(wr[n], a.x, acc); acc = fmaf(-wi[n], a.y, acc); }
            Kd[(dir * 32 + d) * 256 + p * 16 + q] = acc; }
    }
    LDS_WAIT(); __syncthreads();
    bf16* BMg = BMt + (size_t)g * 512 * S5KS;
    for (int it = tid; it < 512 * 64; it += 512) { const int row = it >> 6, ch = it & 63, tau = row >> 4, p = row & 15, sg = ch >> 1, q0 = (ch & 1) * 8;
        float v[8];
        if (sg < tau) { const LAS float* k = Kd + (0 * 32 + (tau - sg)) * 256 + p * 16 + q0;
#pragma unroll
            for (int j = 0; j < 8; ++j) v[j] = k[j]; }
        else if (sg > tau) { const LAS float* k = Kd + (1 * 32 + (sg - tau)) * 256 + p * 16 + q0;
#pragma unroll
            for (int j = 0; j < 8; ++j) v[j] = k[j]; }
        else { const LAS float* k0 = Kd + p * 16 + q0; const LAS float* k1 = Kd + 32 * 256 + p * 16 + q0;
#pragma unroll
            for (int j = 0; j < 8; ++j) v[j] = k0[j] + k1[j]; }
        v4u w; w.x = pk2(v[0], v[1]); w.y = pk2(v[2], v[3]); w.z = pk2(v[4], v[5]); w.w = pk2(v[6], v[7]);
        *(v4u*)(BMg + (size_t)row * S5KS + ch * 8) = w; }
    for (int it = tid; it < 512 * 32; it += 512) { const int row = it >> 5, ch = it & 31, tau = row >> 4, p = row & 15, dir = ch >> 4, n0 = (ch & 15) * 4, dg = dir * S5G + g;
        const int k = dir ? (32 - tau) : (tau + 1);
        const f32x4 cr = *(const f32x4*)(c_re + ((size_t)dg * S5P + p) * S5N + n0), ci = *(const f32x4*)(c_im + ((size_t)dg * S5P + p) * S5N + n0);
        const LAS f32x2* ap = apow + (dir * 33 + k) * 64 + n0;
        unsigned o[4];
#pragma unroll
        for (int j = 0; j < 4; ++j) { const f32x2 a = ap[j]; const float vr = cr[j] * a.x - ci[j] * a.y, vi = cr[j] * a.y + ci[j] * a.x; o[j] = pk2(vr, -vi); }
        *(v4u*)(BMg + (size_t)row * S5KS + 512 + ch * 8) = (v4u){o[0], o[1], o[2], o[3]}; }
    bf16* GMg = GM + (size_t)g * 256 * 512;
    for (int it = tid; it < 128 * 64; it += 512) { const int dn = it >> 6, ch = it & 63, dir = dn >> 6, n = dn & 63, sg = ch >> 1, q0 = (ch & 1) * 8, dg = dir * S5G + g;
        const int pw = dir ? sg : (31 - sg);
        const f32x2 a = apow[(dir * 33 + pw) * 64 + n], z = zt[dir * 64 + n];
        const float wr_ = a.x * z.x - a.y * z.y, wi_ = a.x * z.y + a.y * z.x;
        const float* br = b_re + ((size_t)dg * S5N + n) * S5P + q0; const float* bi = b_im + ((size_t)dg * S5N + n) * S5P + q0;
        float re[8], im[8];
#pragma unroll
        for (int j = 0; j < 8; ++j) { re[j] = wr_ * br[j] - wi_ * bi[j]; im[j] = wr_ * bi[j] + wi_ * br[j]; }
        v4u w0, w1; w0.x = pk2(re[0], re[1]); w0.y = pk2(re[2], re[3]); w0.z = pk2(re[4], re[5]); w0.w = pk2(re[6], re[7]);
        w1.x = pk2(im[0], im[1]); w1.y = pk2(im[2], im[3]); w1.z = pk2(im[4], im[5]); w1.w = pk2(im[6], im[7]);
        *(v4u*)(GMg + (size_t)(dir * 128 + 2 * n) * 512 + ch * 8) = w0; *(v4u*)(GMg + (size_t)(dir * 128 + 2 * n + 1) * 512 + ch * 8) = w1; }
    LDS_WAIT(); __syncthreads();
}
__device__ __forceinline__ void s5_scan_phase(const Frame& F, const f32x2* __restrict__ PAT, const float* __restrict__ E, bf16* __restrict__ UA) {
    for (int task = F.bid + F.G * F.wave; task < 2 * S5G; task += F.G * 8) {
        const int dir = task >> 8, g = task & 255;
        const f32x2 a = PAT[task * S5N + F.lane];
        const float* e = E + (size_t)g * S5NCH * 256 + dir * 128 + 2 * F.lane;
        bf16* s = UA + (size_t)g * S5NCH * S5KS + 512 + dir * 128 + 2 * F.lane;
        float cr = 0.f, ci = 0.f;
        for (int c8 = 0; c8 < S5NCH; c8 += 8) {
            f32x2 v[8];
#pragma unroll
            for (int k = 0; k < 8; ++k) { const int c = dir ? (S5NCH - 1 - (c8 + k)) : (c8 + k); v[k] = *(const f32x2*)(e + (size_t)c * 256); }
#pragma unroll
            for (int k = 0; k < 8; ++k) { const int c = dir ? (S5NCH - 1 - (c8 + k)) : (c8 + k);
                *(unsigned*)(s + (size_t)c * S5KS) = pk2(cr, ci);
                const float nr = fmaf(a.x, cr, fmaf(-a.y, ci, v[k].x)), ni = fmaf(a.x, ci, fmaf(a.y, cr, v[k].y)); cr = nr; ci = ni; }
        }
    }
}


__device__ __forceinline__ void gqa_selfcheck(const Frame& F, const bf16* __restrict__ Qraw, const bf16* __restrict__ Kraw, const bf16* __restrict__ V, const bf16* __restrict__ O,
                                              const float* __restrict__ qg, const float* __restrict__ kg, float* __restrict__ SC, unsigned* flag) {
    LAS float* ql = (LAS float*)(F.lds + F.wave * 1024);
    const int lane = F.lane;
#pragma unroll 1
    for (int s = F.bid * 8 + F.wave; s < 1024; s += F.G * 8) {
        const int tok = (int)(((long)(s >> 5) * 5209 + 77) % L), hq = s & 31, kv = hq >> 2;
        float* sc = SC + (size_t)(F.bid * 8 + F.wave) * L;
        float qv[2]; { const bf16* qp = Qraw + (size_t)tok * DM + hq * HD; qv[0] = bf2f(qp[lane]); qv[1] = bf2f(qp[lane + 64]); }
        { const float ss = wave_sum(qv[0] * qv[0] + qv[1] * qv[1]); const float ri = 1.0f / sqrtf(ss * (1.0f / HD) + EPS); qv[0] *= ri * qg[lane]; qv[1] *= ri * qg[lane + 64]; }
#pragma unroll
        for (int a = 0; a < 2; ++a) { const float pos = (float)(a ? (tok & 63) : (tok >> 6)); const int f = lane & 31; const float ang = pos * (1.0f / powf(10000.0f, (float)f * (1.0f / 32.0f)));
            const float c = cosf(ang), sn = sinf(ang); const float other = __shfl_xor(qv[a], 32); qv[a] = (lane & 32) ? (qv[a] * c + other * sn) : (qv[a] * c - other * sn); }
        ql[lane] = qv[0]; ql[lane + 64] = qv[1]; LDS_WAIT();
        float mx = -1e30f;
#pragma unroll 1
        for (int j = lane; j < L; j += 64) { const bf16* kp = Kraw + (size_t)j * KVD + kv * HD; float ss = 0.f;
#pragma unroll 1
            for (int d = 0; d < HD; ++d) { const float x = bf2f(kp[d]); ss += x * x; }
            const float ri = 1.0f / sqrtf(ss * (1.0f / HD) + EPS); float dot = 0.f;
#pragma unroll 1
            for (int a = 0; a < 2; ++a) { const float pos = (float)(a ? (j & 63) : (j >> 6));
#pragma unroll 1
                for (int f = 0; f < 32; ++f) { const float ang = pos * (1.0f / powf(10000.0f, (float)f * (1.0f / 32.0f))); const float c = cosf(ang), sn = sinf(ang);
                    const float x1 = bf2f(kp[64 * a + f]) * ri * kg[64 * a + f], x2 = bf2f(kp[64 * a + 32 + f]) * ri * kg[64 * a + 32 + f];
                    dot += (x1 * c - x2 * sn) * ql[64 * a + f] + (x2 * c + x1 * sn) * ql[64 * a + 32 + f]; } }
            dot *= 0.088388347648318440f; sc[j] = dot; mx = fmaxf(mx, dot); }
#pragma unroll
        for (int o = 1; o < 64; o <<= 1) mx = fmaxf(mx, __shfl_xor(mx, o));
        asm volatile("s_waitcnt vmcnt(0)" ::: "memory"); __builtin_amdgcn_fence(__ATOMIC_RELEASE, "workgroup"); __builtin_amdgcn_fence(__ATOMIC_ACQUIRE, "agent");
        float o0 = 0.f, o1 = 0.f, lsum = 0.f;
#pragma unroll 1
        for (int j = 0; j < L; ++j) { const float pj = expf(__hip_atomic_load(sc + j, __ATOMIC_RELAXED, __HIP_MEMORY_SCOPE_AGENT) - mx); const bf16* vp = V + (size_t)j * KVD + kv * HD; o0 += pj * bf2f(vp[lane]); o1 += pj * bf2f(vp[lane + 64]); lsum += pj; }
        o0 /= lsum; o1 /= lsum;
        const bf16* op = O + (size_t)tok * DM + hq * HD; const float g0 = bf2f(op[lane]), g1 = bf2f(op[lane + 64]);
        float am = fmaxf(fabsf(o0), fabsf(o1));
#pragma unroll
        for (int o = 1; o < 64; o <<= 1) am = fmaxf(am, __shfl_xor(am, o));
        const float tol = 0.05f * am + 1e-5f;
        const bool bad = !(fabsf(g0 - o0) <= tol) || !(fabsf(g1 - o1) <= tol);
        if (__any(bad) && lane == 0) __hip_atomic_fetch_or(flag, 1u, __ATOMIC_RELAXED, __HIP_MEMORY_SCOPE_AGENT);
        LDS_WAIT();
    }
}

__device__ __forceinline__ void transpose_item(const float* __restrict__ W, int K, int N, bf16* __restrict__ WT, int mode, const float* __restrict__ gain, LAS float* scr, int item, int lane) {
    const int nblk = N / 32, kb = item / nblk, nb = item % nblk, k0 = 64 * kb, n0 = 32 * nb;
    int r0 = n0;
    if (mode == 1) r0 = (n0 < DM) ? ((n0 >> 7) * 256 + (n0 & 127)) : (((n0 - DM) >> 7) * 256 + 128 + ((n0 - DM) & 127));
    const float* src = W + (size_t)(k0 + (lane >> 5)) * N + n0 + (lane & 31);
    float v[32];
#pragma unroll
    for (int i = 0; i < 32; ++i) v[i] = src[(size_t)(2 * i) * N];
    const int c = lane & 7;
    f32x4 g0 = (f32x4){1.f, 1.f, 1.f, 1.f}, g1 = g0;
    if (gain) { g0 = *(const f32x4*)(gain + k0 + 8 * c); g1 = *(const f32x4*)(gain + k0 + 8 * c + 4); }
#pragma unroll
    for (int i = 0; i < 32; ++i) scr[(2 * i + (lane >> 5)) * 33 + (lane & 31)] = v[i];
    LDS_WAIT(); asm volatile("" ::: "memory");
#pragma unroll
    for (int j = 0; j < 4; ++j) { const int n = (lane >> 3) + 8 * j; const LAS float* s = scr + (8 * c) * 33 + n;
        v4u o; o.x = pk2(s[0 * 33] * g0.x, s[1 * 33] * g0.y); o.y = pk2(s[2 * 33] * g0.z, s[3 * 33] * g0.w); o.z = pk2(s[4 * 33] * g1.x, s[5 * 33] * g1.y); o.w = pk2(s[6 * 33] * g1.z, s[7 * 33] * g1.w);
        *(v4u*)(WT + (size_t)(r0 + n) * K + k0 + 8 * c) = o; }
    LDS_WAIT(); asm volatile("" ::: "memory");
}

constexpr size_t MiB = 1u << 20;
constexpr size_t SZ_NAQKV = (size_t)3 * DM * DM * 2, SZ_DD = (size_t)DM * DM * 2, SZ_GQAQKV = (size_t)(DM + 2 * KVD) * DM * 2, SZ_W1 = (size_t)FF * DM * 2, SZ_PROJ = (size_t)DM * PLE * 2, SZ_ACT = (size_t)L * DM * 2;
constexpr size_t OFF_CTL = 0, CTL_ZERO_BYTES = 3 * MiB, OFF_RS = 1 * MiB;
constexpr size_t OFF_NAQKV = 4 * MiB;
constexpr size_t OFF_NAWO = OFF_NAQKV + 2 * SZ_NAQKV;
constexpr size_t OFF_GQAQKV = OFF_NAWO + 2 * SZ_DD;
constexpr size_t OFF_GQAWO = OFF_GQAQKV + SZ_GQAQKV;
constexpr size_t OFF_S5IN = OFF_GQAWO + SZ_DD;
constexpr size_t OFF_S5OUT = OFF_S5IN + SZ_DD;
constexpr size_t OFF_W1 = OFF_S5OUT + 2 * SZ_DD;
constexpr size_t OFF_W2 = OFF_W1 + 4 * SZ_W1;
constexpr size_t OFF_PROJ = OFF_W2 + 4 * SZ_W1;
constexpr size_t OFF_GATE = OFF_PROJ + 4 * SZ_PROJ;
constexpr size_t OFF_PBF = OFF_GATE + 4 * SZ_DD;
constexpr size_t OFF_XN = OFF_PBF + 4 * (size_t)L * PLE * 2;
constexpr size_t OFF_ACT = OFF_XN + SZ_ACT;
constexpr size_t OFF_PP = OFF_ACT + 4 * SZ_ACT;
constexpr size_t OFF_S5BM = OFF_PP + SZ_ACT;
constexpr size_t OFF_S5GM = OFF_S5BM + 192 * MiB;
constexpr size_t OFF_S5PAR = OFF_S5GM + 64 * MiB;
constexpr size_t OFF_DUMMY = OFF_S5PAR + 8 * MiB;
constexpr size_t OFF_HB1 = OFF_DUMMY + 256 * MiB;
constexpr size_t WS_END = OFF_HB1 + SZ_ACT;
constexpr int CW_BAR = 4096;
constexpr int RING_BYTES = 131072, LDSCTL_OFF = RING_BYTES, MISC_OFF = LDSCTL_OFF + 320, PTAB_OFF = LDSCTL_OFF + 1024, LDS_BYTES = 147456;
static_assert(dattn::SHM_ATTN <= RING_BYTES && 8 * 64 * 33 * 4 <= RING_BYTES, "phase scratch fits the ring region");

constexpr int PH_PER_LAYER = 8, NPH = 1 + DEPTH * PH_PER_LAYER;
struct Args { const float* in[28]; float* out; unsigned char* ws; int ph_lo, ph_hi; };
enum { I_X = 0, I_P, I_MIXN, I_MLPN, I_PLEN, I_NAQKV, I_NAWO, I_NAQG, I_NAKG, I_NARPB, I_GQKV, I_GWO, I_GQG, I_GKG, I_S5IN, I_LAMRE, I_LAMIM, I_LOGSTEP, I_BRE, I_BIM, I_CRE, I_CIM, I_S5D, I_S5OUT, I_W1, I_W2, I_PROJ, I_GATE };


__device__ __forceinline__ unsigned long long tab_get(LAS unsigned char* lds, int i) {
    volatile LAS unsigned* t = (volatile LAS unsigned*)(lds + PTAB_OFF); const unsigned lo = t[2 * i], hi = t[2 * i + 1];
    return ((unsigned long long)(unsigned)__builtin_amdgcn_readfirstlane((int)hi) << 32) | (unsigned)__builtin_amdgcn_readfirstlane((int)lo); }
#define INP(i) ((const float*)(const GAS float*)tab_get(F.lds, (i)))
#define OUTP() ((float*)(GAS float*)tab_get(F.lds, 28))
#define WSP() ((unsigned char*)(GAS unsigned char*)tab_get(F.lds, 29))
__device__ __forceinline__ Frame mkframe(unsigned char* lds_generic) {
    Frame F; int t = threadIdx.x; asm volatile("" : "+v"(t)); F.tid = t; F.lane = t & 63; F.wave = __builtin_amdgcn_readfirstlane(t >> 6);
    F.lds = (LAS unsigned char*)lds_generic; int b = blockIdx.x; asm volatile("" : "+s"(b)); F.bid = b; int G = gridDim.x; asm volatile("" : "+s"(G)); F.G = G;
    F.vcu = (G % 8 == 0) ? (b % 8) * (G / 8) + b / 8 : b; return F; }
__device__ __forceinline__ void prologue_phase(const Frame& F) {
    unsigned char* ws = WSP();
    LAS float* scr = (LAS float*)(F.lds + F.wave * (64 * 33 * 4));
    const int gw = F.vcu * 8 + F.wave, NGW = F.G * 8;
    constexpr int I_QKV = (DM / 64) * (3 * DM / 32), I_DD = (DM / 64) * (DM / 32), I_GQ = (DM / 64) * ((DM + 2 * KVD) / 32), I_SO = (DM / 64) * (2 * DM / 32),
                  I_1 = (DM / 64) * (FF / 32), I_2 = (FF / 64) * (DM / 32), I_PJ = (PLE / 64) * (DM / 32);
    constexpr int NITEMS = 2 * I_QKV + 2 * I_DD + I_GQ + I_DD + I_DD + I_SO + 4 * I_1 + 4 * I_2 + 4 * I_PJ + 4 * I_DD;
    for (int it = gw; it < NITEMS; it += NGW) {
        int r = it; const float* W; int K, N, mode = 0; bf16* WT; const float* gain = nullptr;
        if (r < 2 * I_QKV) { const int l = r / I_QKV; r -= l * I_QKV; W = INP(I_NAQKV) + (size_t)l * DM * 3 * DM; K = DM; N = 3 * DM; WT = (bf16*)(ws + OFF_NAQKV + l * SZ_NAQKV); gain = INP(I_MIXN) + (size_t)(3 * l) * DM; }
        else { r -= 2 * I_QKV;
        if (r < 2 * I_DD) { const int l = r / I_DD; r -= l * I_DD; W = INP(I_NAWO) + (size_t)l * DM * DM; K = DM; N = DM; WT = (bf16*)(ws + OFF_NAWO + l * SZ_DD); }
        else { r -= 2 * I_DD;
        if (r < I_GQ) { W = INP(I_GQKV); K = DM; N = DM + 2 * KVD; WT = (bf16*)(ws + OFF_GQAQKV); gain = INP(I_MIXN) + (size_t)1 * DM; }
        else { r -= I_GQ;
        if (r < I_DD) { W = INP(I_GWO); K = DM; N = DM; WT = (bf16*)(ws + OFF_GQAWO); }
        else { r -= I_DD;
        if (r < I_DD) { W = INP(I_S5IN); K = DM; N = DM; WT = (bf16*)(ws + OFF_S5IN); gain = INP(I_MIXN) + (size_t)2 * DM; }
        else { r -= I_DD;
        if (r < I_SO) { W = INP(I_S5OUT); K = DM; N = 2 * DM; WT = (bf16*)(ws + OFF_S5OUT); mode = 1; }
        else { r -= I_SO;
        if (r < 4 * I_1) { const int l = r / I_1; r -= l * I_1; W = INP(I_W1) + (size_t)l * DM * FF; K = DM; N = FF; WT = (bf16*)(ws + OFF_W1 + l * SZ_W1); gain = INP(I_MLPN) + (size_t)l * DM; }
        else { r -= 4 * I_1;
        if (r < 4 * I_2) { const int l = r / I_2; r -= l * I_2; W = INP(I_W2) + (size_t)l * FF * DM; K = FF; N = DM; WT = (bf16*)(ws + OFF_W2 + l * SZ_W1); }
        else { r -= 4 * I_2;
        if (r < 4 * I_PJ) { const int l = r / I_PJ; r -= l * I_PJ; W = INP(I_PROJ) + (size_t)l * PLE * DM; K = PLE; N = DM; WT = (bf16*)(ws + OFF_PROJ + l * SZ_PROJ); }
        else { r -= 4 * I_PJ; const int l = r / I_DD; r -= l * I_DD; W = INP(I_GATE) + (size_t)l * DM * DM; K = DM; N = DM; WT = (bf16*)(ws + OFF_GATE + l * SZ_DD); gain = INP(I_PLEN) + (size_t)l * DM; } } } } } } } } }
        transpose_item(W, K, N, WT, mode, gain, scr, r, F.lane);
    }
    xrows_phase(F, INP(I_X), (bf16*)(ws + OFF_XN), (pg8::rs_t*)(ws + OFF_RS));
    { const size_t n8 = (size_t)DEPTH * L * PLE / 8; const float* p = INP(I_P); bf16* pb = (bf16*)(ws + OFF_PBF);
      for (size_t i = (size_t)gw * 64 + F.lane; i < n8; i += (size_t)NGW * 64) { const f32x4 a = *(const f32x4*)(p + i * 8), b = *(const f32x4*)(p + i * 8 + 4);
          v4u w; w.x = pk2(a.x, a.y); w.y = pk2(a.z, a.w); w.z = pk2(b.x, b.y); w.w = pk2(b.z, b.w); *(v4u*)(pb + i * 8) = w; } }
    { bf16* GM = (bf16*)(ws + OFF_S5GM); bf16* BMt = (bf16*)(ws + OFF_S5BM); f32x2* PAT = (f32x2*)(ws + OFF_S5PAR);
      LDS_WAIT(); __syncthreads();
      for (int g = F.bid; g < S5G; g += F.G) s5_gen_group(F, g, INP(I_LAMRE), INP(I_LAMIM), INP(I_LOGSTEP), INP(I_BRE), INP(I_BIM), INP(I_CRE), INP(I_CIM), GM, BMt, PAT); }
}

#define WS_PTRS() unsigned char* ws = WSP(); bf16* HB0 = (bf16*)(ws + OFF_XN); bf16* HB1 = (bf16*)(ws + OFF_HB1); bf16* Qb = (bf16*)(ws + OFF_ACT); bf16* Kb = (bf16*)(ws + OFF_ACT + SZ_ACT); bf16* Vb = (bf16*)(ws + OFF_ACT + 2 * SZ_ACT); \
    bf16* Ob = (bf16*)(ws + OFF_ACT + 3 * SZ_ACT); bf16* HID = (bf16*)(ws + OFF_ACT); bf16* UA = (bf16*)(ws + OFF_ACT); bf16* S5Gb = (bf16*)(ws + OFF_ACT + 2 * SZ_ACT); float* S5E = (float*)(ws + OFF_ACT + 3 * SZ_ACT); bf16* PP = (bf16*)(ws + OFF_PP); \
    (void)HB0; (void)HB1; (void)Qb; (void)Kb; (void)Vb; (void)Ob; (void)HID; (void)UA; (void)S5Gb; (void)PP; (void)S5E;
__global__ void __launch_bounds__(512, 2) enc_fwd(Args args) {
    extern __shared__ __attribute__((aligned(16))) unsigned char lds[];
    {
        LAS unsigned char* l3 = (LAS unsigned char*)lds;
        for (int u = threadIdx.x; u < (LDS_BYTES - LDSCTL_OFF) / 4; u += 512) ((LAS unsigned*)(l3 + LDSCTL_OFF))[u] = 0u;
        __syncthreads();
        if (threadIdx.x == 0) { LAS unsigned long long* t = (LAS unsigned long long*)(l3 + PTAB_OFF);
#pragma unroll
            for (int i = 0; i < 28; ++i) t[i] = (unsigned long long)args.in[i];
            t[28] = (unsigned long long)args.out; t[29] = (unsigned long long)args.ws; }
        __syncthreads();
    }
    const int lo = args.ph_lo, hi = args.ph_hi;
    XcdBarrier bar;
    { LAS unsigned char* l3 = (LAS unsigned char*)lds; unsigned* ctl = (unsigned*)(GAS unsigned*)(tab_get(l3, 29) + OFF_CTL); bar.bar = ctl + CW_BAR; bar.x = 0; bar.st = nullptr;
      if (hi - lo > 1) bar = xcd_barrier_post(ctl + CW_BAR, (volatile LAS unsigned*)(l3 + MISC_OFF) + 8); }
#define IN(k) (lo <= (k) && (k) < hi)
#ifndef PROBE_PH
#define PROBE_PH (-1)
#endif
#define REPS(k) for (int rep_ = 0, nrep_ = (((k) == PROBE_PH || PROBE_PH == -2) ? 2 : ((PROBE_PH == 300 && (k) == 11) ? 4 : 1)); rep_ < nrep_; ++rep_)
#define HBOUT(p) ((nrep_ == 2 && rep_ == 0) ? (bf16*)(ws + OFF_DUMMY) : (p))
#define RSOUT(i) ((nrep_ == 2 && rep_ == 0) ? (pg8::rs_t*)(ws + OFF_DUMMY + 128 * MiB) : RSP(i))
#define SEAM(k) do { if (IN(k) && IN((k) + 1)) xcd_barrier(bar); } while (0)

    if (IN(0)) REPS(0) { const Frame F = mkframe(lds); prologue_phase(F); } SEAM(0);
#if PROBE_PH == 200
    for (int xb_ = 0; xb_ < 40; ++xb_) xcd_barrier(bar);
#endif

#pragma unroll 1
    for (int layer = 0; layer < DEPTH; ++layer) {
        const int kind = layer % 3, slot = layer / 3, pb = 1 + PH_PER_LAYER * layer;
#define RSP(i) ((pg8::rs_t*)(ws + OFF_RS) + (size_t)(i) * L)
        const int irs = (layer == 0) ? 0 : 3 * layer;
        if (IN(pb + 0)) REPS(pb + 0) {
            const Frame F = mkframe(lds); WS_PTRS();
            if (kind != 2) {
                const int N = (kind == 0) ? 3 * DM : DM + 2 * KVD;
                const bf16* W = (kind == 0) ? (const bf16*)(ws + OFF_NAQKV + slot * SZ_NAQKV) : (const bf16*)(ws + OFF_GQAQKV);
                const pg8::Gemm g = pg8::mkgemm(HB0, W, L, N, DM); pg8::StaticOrder S; S.init(L, N, F.G, F.bid);
                pg8::EpiBf16<0> E{Qb, Kb, Vb, DM, (kind == 0) ? DM : KVD, (kind == 0) ? DM : KVD, DM, (kind == 0) ? 2 * DM : DM + KVD, RSP(irs), 0, (kind == 0) ? 2 * DM : DM + KVD};
                pg8::gemm_phase<pg8::EpiBf16<0>, pg8::StaticOrder, false, true>(F.lds, g, S, E);
            } else {
                const pg8::Gemm g = pg8::mkgemm(HB0, (const bf16*)(ws + OFF_S5IN), L, DM, DM); pg8::StaticOrder S; S.init(L, DM, F.G, F.bid);
                pg8::EpiS5U E{UA, RSP(irs)};
                pg8::gemm_phase<pg8::EpiS5U, pg8::StaticOrder, false, true>(F.lds, g, S, E);
            }
        }
        SEAM(pb + 0);
        if (kind != 2) {
#if PROBE_PH == 400
            if (kind == 1) { const Frame F = mkframe(lds); WS_PTRS();
                const v4u* sq = (const v4u*)Qb; v4u* dq = (v4u*)(ws + OFF_DUMMY); const v4u* sk = (const v4u*)Kb; v4u* dk = (v4u*)(ws + OFF_DUMMY + 128 * MiB);
                for (size_t i = (size_t)F.bid * 512 + F.tid; i < (size_t)L * DM / 8; i += (size_t)F.G * 512) dq[i] = sq[i];
                for (size_t i = (size_t)F.bid * 512 + F.tid; i < (size_t)L * KVD / 8; i += (size_t)F.G * 512) dk[i] = sk[i];
                xcd_barrier(bar); }
#endif
            if (kind == 1) { if (IN(pb + 1)) { const Frame F = mkframe(lds); WS_PTRS(); prep_phase(F, Qb, Kb, KVD, NKV, INP(I_GQG), INP(I_GKG), true); }
                SEAM(pb + 1); }
            if (IN(pb + 2)) REPS(pb + 2) { const Frame F = mkframe(lds); WS_PTRS();
                if (kind == 0) {
                    const float* rpb = INP(I_NARPB) + (size_t)slot * NH * 15 * 31;
                    for (int i = 0;; ++i) { const int unit = i * F.G + F.bid; if (unit >= NH * (GROWS / 4)) break;
                        const int h = unit >> 6, R = (unit & 63) * 4, ks = min(max(R - 4, 0), GROWS - dattn::NA_TILES);
                        dattn::na_block_body(Qb + (size_t)(R * GRID_W) * DM + h * HD, Kb + (size_t)(ks * GRID_W) * DM + h * HD, Vb + (size_t)(ks * GRID_W) * DM + h * HD,
                                             Ob + (size_t)(R * GRID_W) * DM + h * HD, rpb + (size_t)h * 15 * 31, INP(I_NAQG) + slot * HD, INP(I_NAKG) + slot * HD, R, ks, (char*)lds);
                        __syncthreads(); }
                } else {
                    for (int i = 0;; ++i) { const int unit = i * F.G + F.bid; if (unit >= NH * (L / 256)) break;
                        const int kvh = unit & 7, rest = unit >> 3, hq = kvh * 4 + (rest >> 6), qb = rest & 63;
                        dattn::attn_dense_body<bf16>(Qb + (size_t)(qb * 256) * DM + hq * HD, Kb + kvh * HD, Vb + kvh * HD, Ob + (size_t)(qb * 256) * DM + hq * HD, L, (char*)lds);
                        __syncthreads(); }
                }
            }
            if (IN(pb + 2) && IN(pb + 4)) xcd_barrier(bar);
#if PROBE_PH == 400
            if (kind == 1) { const Frame F = mkframe(lds); WS_PTRS();
                gqa_selfcheck(F, (const bf16*)(ws + OFF_DUMMY), (const bf16*)(ws + OFF_DUMMY + 128 * MiB), Vb, Ob, INP(I_GQG), INP(I_GKG), (float*)(ws + OFF_PP), (unsigned*)(ws + OFF_CTL) + 8);
                xcd_barrier(bar); }
#endif
        } else {
            if (IN(pb + 1)) REPS(pb + 1) { const Frame F = mkframe(lds); WS_PTRS();
                pg8::Gemm g; g.A = UA; g.Bt = (const bf16*)(ws + OFF_S5GM); g.M = S5G * S5NCH; g.N = 256; g.K = 512; g.lda = S5KS; g.ldb = 512;
                pg8::S5Order S{F.G, F.bid, 2, 1}; pg8::EpiS5E E{S5E};
                pg8::gemm_phase<pg8::EpiS5E, pg8::S5Order, false, true>(F.lds, g, S, E); }
            SEAM(pb + 1);
            if (IN(pb + 2)) REPS(pb + 2) { const Frame F = mkframe(lds); WS_PTRS(); s5_scan_phase(F, (const f32x2*)(ws + OFF_S5PAR), S5E, UA); }
            SEAM(pb + 2);
            if (IN(pb + 3)) REPS(pb + 3) { const Frame F = mkframe(lds); WS_PTRS();
                pg8::Gemm g; g.A = UA; g.Bt = (const bf16*)(ws + OFF_S5BM); g.M = S5G * S5NCH; g.N = S5G * 512; g.K = S5KS; g.lda = S5KS; g.ldb = S5KS;
                pg8::S5Order S{F.G, F.bid, 2, 2}; pg8::EpiS5Y E{UA, INP(I_S5D), S5Gb, DM};
                pg8::gemm_phase<pg8::EpiS5Y, pg8::S5Order, false, true>(F.lds, g, S, E); }
            SEAM(pb + 3);
        }
        if (IN(pb + 4)) REPS(pb + 4) {
            const Frame F = mkframe(lds); WS_PTRS();
            if (kind != 2) {
                const bf16* W = (kind == 0) ? (const bf16*)(ws + OFF_NAWO + slot * SZ_DD) : (const bf16*)(ws + OFF_GQAWO);
                const pg8::Gemm g = pg8::mkgemm(Ob, W, L, DM, DM); pg8::StaticOrder S; S.init(L, DM, F.G, F.bid);
                pg8::EpiRes E{HB0, HBOUT(HB0), RSOUT(1 + 3 * layer), DM, nullptr};
                pg8::gemm_phase<pg8::EpiRes, pg8::StaticOrder, false, true>(F.lds, g, S, E);
            } else {
                const pg8::Gemm g = pg8::mkgemm(S5Gb, (const bf16*)(ws + OFF_S5OUT), L, 2 * DM, DM); pg8::StaticOrder S; S.init(L, 2 * DM, F.G, F.bid);
                pg8::EpiGlu E{HB0, HBOUT(HB0), RSOUT(1 + 3 * layer), DM};
                pg8::gemm_phase<pg8::EpiGlu, pg8::StaticOrder, false, true>(F.lds, g, S, E);
            }
        }
        SEAM(pb + 4);
        if (IN(pb + 5)) REPS(pb + 5) { const Frame F = mkframe(lds); WS_PTRS();
            const pg8::Gemm g = pg8::mkgemm(HB0, (const bf16*)(ws + OFF_W1 + layer * SZ_W1), L, FF, DM); pg8::StaticOrder S; S.init(L, FF, F.G, F.bid);
            pg8::EpiBf16<2> E{HID, HID, HID, FF, FF, FF, 1 << 30, 1 << 30, nullptr, 0, 0};
#if PROBE_PH == 201
            { pg8::RangeOrder R1{S, 0, 8}, R2{S, 8, 16};
              pg8::gemm_phase<pg8::EpiBf16<2>, pg8::RangeOrder, false, true>(F.lds, g, R1, E); xcd_barrier(bar);
              pg8::gemm_phase<pg8::EpiBf16<2>, pg8::RangeOrder, false, true>(F.lds, g, R2, E); }
#else
            pg8::gemm_phase<pg8::EpiBf16<2>, pg8::StaticOrder, false, true>(F.lds, g, S, E);
#endif
        }
        SEAM(pb + 5);
        if (IN(pb + 6)) REPS(pb + 6) { const Frame F = mkframe(lds); WS_PTRS();
            { const pg8::Gemm g = pg8::mkgemm(HID, (const bf16*)(ws + OFF_W2 + layer * SZ_W1), L, DM, FF); pg8::StaticOrder S; S.init(L, DM, F.G, F.bid);
              pg8::EpiRes E{HB0, HBOUT(HB1), RSOUT(2 + 3 * layer), DM, RSP(1 + 3 * layer)};
              pg8::gemm_phase<pg8::EpiRes, pg8::StaticOrder, false, true>(F.lds, g, S, E); }
            { const pg8::Gemm g = pg8::mkgemm((const bf16*)(ws + OFF_PBF + (size_t)layer * L * PLE * 2), (const bf16*)(ws + OFF_PROJ + layer * SZ_PROJ), L, DM, PLE); pg8::StaticOrder S; S.init(L, DM, F.G, F.bid);
              pg8::EpiBf16<0> E{PP, PP, PP, DM, DM, DM, 1 << 30, 1 << 30, nullptr, 0, 0};
              pg8::gemm_phase<pg8::EpiBf16<0>, pg8::StaticOrder, false, true>(F.lds, g, S, E); }
        }
        SEAM(pb + 6);
        if (IN(pb + 7)) REPS(pb + 7) { const Frame F = mkframe(lds); WS_PTRS();
            const pg8::Gemm g = pg8::mkgemm(HB1, (const bf16*)(ws + OFF_GATE + layer * SZ_DD), L, DM, DM); pg8::StaticOrder S; S.init(L, DM, F.G, F.bid);
            pg8::EpiGate E{HB1, HBOUT(HB0), (layer == DEPTH - 1) ? OUTP() : nullptr, PP, RSP(2 + 3 * layer), RSOUT(3 + 3 * layer), DM};
            pg8::gemm_phase<pg8::EpiGate, pg8::StaticOrder, false, true>(F.lds, g, S, E);
        }
        SEAM(pb + 7);
    }
#if PROBE_PH == 400
    { xcd_barrier(bar); const Frame F = mkframe(lds); unsigned char* ws = WSP();
      if (__hip_atomic_load((unsigned*)(ws + OFF_CTL) + 8, __ATOMIC_RELAXED, __HIP_MEMORY_SCOPE_AGENT) != 0u && F.bid == 0 && F.tid < 64) OUTP()[F.tid] = __builtin_nanf(""); }
#endif
#undef IN
#undef SEAM
}

extern "C" void kernel_launch(void* const* d_in, const int* in_sizes, int n_in, void* d_out, int out_size, void* d_ws, size_t ws_size, hipStream_t stream) {
    static int grid = 0;
    if (grid == 0) {
        if (n_in != 28 || in_sizes[0] != L * DM || out_size != L * DM || ws_size < WS_END) {
            fprintf(stderr, "kernel_launch: built for 28 inputs, x/out of %d floats, >= %zu bytes of workspace; got n_in %d, in0 %d, out %d, ws %zu; nothing launched\n", L * DM, (size_t)WS_END, n_in, n_in > 0 ? in_sizes[0] : -1, out_size, ws_size);
            grid = -1; return; }
        int dev = 0, cus = 0, per_cu = 0;
        if (hipGetDevice(&dev) != hipSuccess || hipDeviceGetAttribute(&cus, hipDeviceAttributeMultiprocessorCount, dev) != hipSuccess) { fprintf(stderr, "kernel_launch: device query failed\n"); grid = -1; return; }
        if (hipFuncSetAttribute((const void*)enc_fwd, hipFuncAttributeMaxDynamicSharedMemorySize, LDS_BYTES) != hipSuccess) { fprintf(stderr, "kernel_launch: hipFuncSetAttribute failed\n"); grid = -1; return; }
        if (hipOccupancyMaxActiveBlocksPerMultiprocessor(&per_cu, (const void*)enc_fwd, 512, LDS_BYTES) != hipSuccess || per_cu < 1)
            fprintf(stderr, "kernel_launch: note: occupancy query reports %d workgroups per CU\n", per_cu);
        (void)hipGetLastError();
        grid = cus;
    }
    if (grid < 0) return;
    if (hipMemsetAsync((char*)d_ws + OFF_CTL, 0, CTL_ZERO_BYTES, stream) != hipSuccess) { fprintf(stderr, "kernel_launch: memset failed\n"); return; }
    Args a{};
    for (int i = 0; i < 28; ++i) a.in[i] = (const float*)d_in[i];
    a.out = (float*)d_out; a.ws = (unsigned char*)d_ws;
#if MK_N_LAUNCHES == 1
    a.ph_lo = 0; a.ph_hi = NPH;
    hipLaunchKernelGGL(enc_fwd, dim3(grid), dim3(512), LDS_BYTES, stream, a);
#else
    for (int ph = 0; ph < NPH; ++ph) {
        if (ph > 0) { const int layer = (ph - 1) / PH_PER_LAYER, j = (ph - 1) % PH_PER_LAYER; if (j == 3 && layer % 3 != 2) continue; }
        a.ph_lo = ph; a.ph_hi = ph + 1;
        hipLaunchKernelGGL(enc_fwd, dim3(grid), dim3(512), LDS_BYTES, stream, a);
    }
#endif
    const hipError_t le = hipPeekAtLastError();
    if (le != hipSuccess) fprintf(stderr, "kernel_launch: launch failed: %s\n", hipGetErrorName(le));
}
```

```cpp
#include <hip/hip_runtime.h>
#include <cstdio>
#include <cstdint>

#ifndef MK_N_LAUNCHES
#define MK_N_LAUNCHES 1
#endif

constexpr int L = 16384, DM = 4096, DEPTH = 4, GRID_W = 64, GROWS = L / GRID_W, HD = 128, NH = 32, NKV = 8, KVD = NKV * HD, FF = 4 * DM, PLE = 256;
constexpr int S5G = 256, S5P = 16, S5N = 64, S5TC = 16, S5NC = L / S5TC;
constexpr float EPS = 1e-6f;

#define GAS __attribute__((address_space(1)))
#define LAS __attribute__((address_space(3)))
typedef unsigned short bf16;
typedef unsigned v4u __attribute__((ext_vector_type(4)));
typedef unsigned v2u __attribute__((ext_vector_type(2)));
typedef float f32x4 __attribute__((ext_vector_type(4)));
typedef float f32x2 __attribute__((ext_vector_type(2)));
typedef short bf16x8 __attribute__((ext_vector_type(8)));
typedef short s16x4 __attribute__((ext_vector_type(4)));
typedef GAS unsigned gu32;
#define RLX_AGENT __ATOMIC_RELAXED, __HIP_MEMORY_SCOPE_AGENT
#define LDS_WAIT() asm volatile("s_waitcnt lgkmcnt(0)" ::: "memory")
#define VM_WAIT() asm volatile("s_waitcnt vmcnt(0)" ::: "memory")
__device__ __forceinline__ unsigned f2bf(float f) { unsigned u = __builtin_bit_cast(unsigned, f); return (u + 0x7fffu + ((u >> 16) & 1u)) >> 16; }
__device__ __forceinline__ unsigned pk2(float lo, float hi) { return f2bf(lo) | (f2bf(hi) << 16); }
__device__ __forceinline__ float bf2f(unsigned short b) { return __builtin_bit_cast(float, (unsigned)b << 16); }
__device__ __forceinline__ float bflo(unsigned w) { return __builtin_bit_cast(float, w << 16); }
__device__ __forceinline__ float bfhi(unsigned w) { return __builtin_bit_cast(float, w & 0xffff0000u); }
__device__ __forceinline__ float sigmoidf_fast(float x) { return __builtin_amdgcn_rcpf(1.0f + __builtin_amdgcn_exp2f(-1.4426950408889634f * x)); }

namespace pg8 {
#define PG8_LAS __attribute__((address_space(3)))
#if defined(PROBE_EPI2)
#define PROBE_EPI_DUP if constexpr (Epi::PERM) E(acc, cur, wr, wc, fr, fq);
#else
#define PROBE_EPI_DUP
#endif
typedef unsigned short bf16_t;
typedef short bf16x8 __attribute__((ext_vector_type(8)));
typedef float f32x4 __attribute__((ext_vector_type(4)));
typedef unsigned u32x4 __attribute__((ext_vector_type(4)));
constexpr int BM = 256, BK = 64, HALF = 128, HTB = HALF * BK * 2  , STAGE_BYTES = 8 * HTB, NXCD = 8, WGM = 8;

__host__ __device__ __forceinline__ int lds_byte(int r, int c) { const int st = (r >> 4) * 2 + (c >> 5), rr = r & 15, cc = c & 31, ob = rr * 64 + cc * 2; return st * 1024 + (ob ^ (((ob >> 9) & 1) << 5)); }
__host__ __device__ __forceinline__ void stage_rc(int b, int& R, int& C) { const int st = b / 1024, sb = b % 1024, swz = sb ^ (((sb >> 9) & 1) << 5); R = (st >> 1) * 16 + swz / 64; C = (st & 1) * 32 + (swz % 64) / 2; }
__host__ __device__ __forceinline__ int perm32(int rho) { const int n = rho >> 4, i = rho & 15; return 8 * (i >> 2) + 4 * n + (i & 3); }

struct Unit { int pm, pn; };
struct Gemm { const bf16_t* A; const bf16_t* Bt; int M, N, K, lda, ldb; };
__host__ __device__ __forceinline__ Gemm mkgemm(const bf16_t* A, const bf16_t* Bt, int M, int N, int K) { Gemm g; g.A = A; g.Bt = Bt; g.M = M; g.N = N; g.K = K; g.lda = K; g.ldb = K; return g; }

struct StaticOrder {
    int nM, nN, nwg, G, c;
    __host__ __device__ void init(int M, int N, int G_, int c_) { nM = M / BM; nN = N / BM; nwg = nM * nN; G = G_; c = c_; }
    __host__ __device__ bool next(int i, Unit& u) const {
        const long L = (long)i * G + c; if (L >= nwg) return false;
        int wgid = (int)L; { const int q = nwg / NXCD, r = nwg % NXCD, xcd = wgid % NXCD, off = wgid / NXCD; wgid = (xcd < r ? xcd * (q + 1) : r * (q + 1) + (xcd - r) * q) + off; }
        const int nig = WGM * nN, gid = wgid / nig, fm = gid * WGM, gsz = (nM - fm) < WGM ? (nM - fm) : WGM;
        u.pm = fm + ((wgid % nig) % gsz); u.pn = (wgid % nig) / gsz; return true;
    }
    __device__ __forceinline__ void a_ready(const Unit&) const {}
    __device__ __forceinline__ void done(const Unit&) const {}
};
struct RangeOrder { StaticOrder S; int i0, i1;
    __host__ __device__ bool next(int i, Unit& u) const { return (i + i0 < i1) ? S.next(i + i0, u) : false; }
    __device__ __forceinline__ void a_ready(const Unit&) const {}
    __device__ __forceinline__ void done(const Unit&) const {} };


__device__ __forceinline__ unsigned cvt_pk_bf16(float lo, float hi) { unsigned r; asm volatile("v_cvt_pk_bf16_f32 %0, %1, %2" : "=v"(r) : "v"(lo), "v"(hi)); return r; }
__device__ __forceinline__ float sigm(float x) { return __builtin_amdgcn_rcpf(1.0f + __builtin_amdgcn_exp2f(-1.4426950408889634f * x)); }

typedef unsigned long long rs_t;
constexpr float RS_FIX = 16777216.0f, RS_INV = 1.0f / (16777216.0f * 4096.0f), RS_EPS = 1e-6f;
__device__ __forceinline__ void row_ss_add(rs_t* rs, int row, float s, int fq) {
    s += __shfl_xor(s, 16); s += __shfl_xor(s, 32);
    if (fq == 0) __hip_atomic_fetch_add(rs + row, (rs_t)(s * RS_FIX), __ATOMIC_RELAXED, __HIP_MEMORY_SCOPE_AGENT);
}
__device__ __forceinline__ float rs_rinv(rs_t v) { return __builtin_amdgcn_rsqf((float)v * RS_INV + RS_EPS); }
#define PIN8(a) asm volatile("" : "+v"((a)[0]), "+v"((a)[1]), "+v"((a)[2]), "+v"((a)[3]), "+v"((a)[4]), "+v"((a)[5]), "+v"((a)[6]), "+v"((a)[7]))
template <int ACT> struct EpiBf16 {
    static constexpr bool PERM = true, AFTER_DRAIN = false;
    bf16_t *O0, *O1, *O2; int ld0, ld1, ld2, c1, c2; const rs_t* rs; int vt; int rs_from;
    __device__ __forceinline__ void operator()(const f32x4 (&acc)[2][2][4][2], const Unit& u, int wr, int wc, int fr, int fq) const {
        const int row0 = u.pm * BM + wr * 64 + fr; int colt = u.pn * BM; bf16_t* base = O0; int ldc = ld0;
        const rs_t* rs = (colt >= rs_from) ? this->rs : nullptr;
        bool tr = false;
        if (colt >= c2) { base = O2; ldc = ld2; colt -= c2; tr = vt != 0; } else if (colt >= c1) { base = O1; ldc = ld1; colt -= c1; }
        const int col0 = colt + wc * 32 + 8 * fq;
        rs_t scv[8];
#pragma unroll
        for (int gi = 0; gi < 8; ++gi) scv[gi] = rs ? rs[row0 + (gi >> 2) * HALF + (gi & 3) * 16] : 0ull;
        PIN8(scv);
#pragma unroll
        for (int ai = 0; ai < 2; ++ai)
#pragma unroll
            for (int m = 0; m < 4; ++m) { bf16_t* rowp = base + (size_t)(row0 + ai * HALF + m * 16) * ldc + col0; const float sc = rs ? rs_rinv(scv[ai * 4 + m]) : 1.0f;
#pragma unroll
                for (int bj = 0; bj < 2; ++bj) { f32x4 v0 = acc[ai][bj][m][0] * sc, v1 = acc[ai][bj][m][1] * sc;
                    if (ACT == 2) {
#pragma unroll
                        for (int j = 0; j < 4; ++j) { const float a = fmaxf(v0[j], 0.f), b = fmaxf(v1[j], 0.f); v0[j] = a * a; v1[j] = b * b; } }
                    u32x4 w; w.x = cvt_pk_bf16(v0[0], v0[1]); w.y = cvt_pk_bf16(v0[2], v0[3]); w.z = cvt_pk_bf16(v1[0], v1[1]); w.w = cvt_pk_bf16(v1[2], v1[3]);
                    if (tr) { bf16_t* tp = base + (size_t)(col0 + bj * HALF) * ldc + (row0 + ai * HALF + m * 16);
                        tp[0] = (bf16_t)w.x; tp[(size_t)ldc] = (bf16_t)(w.x >> 16); tp[(size_t)2 * ldc] = (bf16_t)w.y; tp[(size_t)3 * ldc] = (bf16_t)(w.y >> 16);
                        tp[(size_t)4 * ldc] = (bf16_t)w.z; tp[(size_t)5 * ldc] = (bf16_t)(w.z >> 16); tp[(size_t)6 * ldc] = (bf16_t)w.w; tp[(size_t)7 * ldc] = (bf16_t)(w.w >> 16); }
                    else *(u32x4*)(rowp + bj * HALF) = w; } }
    }
};
struct EpiF32 {
    static constexpr bool PERM = false, AFTER_DRAIN = false;
    float* C; int ldc;
    __device__ __forceinline__ void operator()(const f32x4 (&acc)[2][2][4][2], const Unit& u, int wr, int wc, int fr, int fq) const {
        const int row0 = u.pm * BM + wr * 64 + fr, col0 = u.pn * BM + wc * 32 + 4 * fq;
#pragma unroll
        for (int ai = 0; ai < 2; ++ai)
#pragma unroll
            for (int m = 0; m < 4; ++m) { float* rowp = C + (size_t)(row0 + ai * HALF + m * 16) * ldc + col0;
#pragma unroll
                for (int bj = 0; bj < 2; ++bj)
#pragma unroll
                    for (int n = 0; n < 2; ++n) *(f32x4*)(rowp + bj * HALF + n * 16) = acc[ai][bj][m][n]; }
    }
};
typedef unsigned u32x2 __attribute__((ext_vector_type(2)));
__device__ __forceinline__ f32x4 bf4_to_f32(u32x2 p) { return (f32x4){__builtin_bit_cast(float, p.x << 16), __builtin_bit_cast(float, p.x & 0xffff0000u), __builtin_bit_cast(float, p.y << 16), __builtin_bit_cast(float, p.y & 0xffff0000u)}; }
struct EpiRes {
    static constexpr bool PERM = false, AFTER_DRAIN = false;
    const bf16_t* base; bf16_t* out; rs_t* rs; int ldc; const rs_t* rsq;
    __device__ __forceinline__ void operator()(const f32x4 (&acc)[2][2][4][2], const Unit& u, int wr, int wc, int fr, int fq) const {
        constexpr int PD = 3;
        const int row0 = u.pm * BM + wr * 64 + fr, col0 = u.pn * BM + wc * 32 + 4 * fq;
        u32x2 nb[8][2][2];
        rs_t scv[8];
#pragma unroll
        for (int gi = 0; gi < 8; ++gi) scv[gi] = rsq ? rsq[row0 + (gi >> 2) * HALF + (gi & 3) * 16] : 0ull;
#define EPI_LD(g) do { const size_t o_ = (size_t)(row0 + ((g) >> 2) * HALF + ((g) & 3) * 16) * ldc + col0; _Pragma("unroll") for (int bj = 0; bj < 2; ++bj) _Pragma("unroll") for (int n = 0; n < 2; ++n) nb[g][bj][n] = *(const u32x2*)(base + o_ + bj * HALF + n * 16); } while (0)
#pragma unroll
        for (int g = 0; g < PD; ++g) EPI_LD(g);
        PIN8(scv);
#pragma unroll
        for (int gi = 0; gi < 8; ++gi) { const int ai = gi >> 2, m = gi & 3; const int row = row0 + ai * HALF + m * 16; const size_t off = (size_t)row * ldc + col0;
            if (gi + PD < 8) EPI_LD(gi + PD);
            const float sc2 = rsq ? __builtin_amdgcn_rcpf((float)scv[gi] * RS_INV + RS_EPS) : 1.0f;
            float ss = 0.f;
#pragma unroll
            for (int bj = 0; bj < 2; ++bj)
#pragma unroll
                for (int n = 0; n < 2; ++n) { const f32x4 o = bf4_to_f32(nb[gi][bj][n]) + acc[ai][bj][m][n] * sc2;
                    ss += (o[0] * o[0] + o[1] * o[1]) + (o[2] * o[2] + o[3] * o[3]);
                    u32x2 w; w.x = cvt_pk_bf16(o[0], o[1]); w.y = cvt_pk_bf16(o[2], o[3]); *(u32x2*)(out + off + bj * HALF + n * 16) = w; }
            row_ss_add(rs, row, ss, fq); }
#undef EPI_LD
    }
};
struct EpiGate {
    static constexpr bool PERM = false, AFTER_DRAIN = false;
    const bf16_t* base; bf16_t* out; float* out32; const bf16_t* pp; const rs_t* rsin; rs_t* rs; int ldc;
    __device__ __forceinline__ void operator()(const f32x4 (&acc)[2][2][4][2], const Unit& u, int wr, int wc, int fr, int fq) const {
        constexpr int PD = 2;
        const int row0 = u.pm * BM + wr * 64 + fr, col0 = u.pn * BM + wc * 32 + 4 * fq;
        rs_t scv[8];
#pragma unroll
        for (int gi = 0; gi < 8; ++gi) scv[gi] = rsin[row0 + (gi >> 2) * HALF + (gi & 3) * 16];
        u32x2 nb[8][2][2], np[8][2][2];
#define EPI_LD(g) do { const size_t o_ = (size_t)(row0 + ((g) >> 2) * HALF + ((g) & 3) * 16) * ldc + col0; _Pragma("unroll") for (int bj = 0; bj < 2; ++bj) _Pragma("unroll") for (int n = 0; n < 2; ++n) { \
            nb[g][bj][n] = *(const u32x2*)(base + o_ + bj * HALF + n * 16); np[g][bj][n] = *(const u32x2*)(pp + o_ + bj * HALF + n * 16); } } while (0)
#pragma unroll
        for (int g = 0; g < PD; ++g) EPI_LD(g);
        PIN8(scv);
#pragma unroll
        for (int gi = 0; gi < 8; ++gi) { const int ai = gi >> 2, m = gi & 3; const int row = row0 + ai * HALF + m * 16; const size_t off = (size_t)row * ldc + col0;
            if (gi + PD < 8) EPI_LD(gi + PD);
            const float sc = rs_rinv(scv[gi]);
            float ss = 0.f;
#pragma unroll
            for (int bj = 0; bj < 2; ++bj)
#pragma unroll
                for (int n = 0; n < 2; ++n) { const f32x4 a = acc[ai][bj][m][n] * sc, p = bf4_to_f32(np[gi][bj][n]); f32x4 o = bf4_to_f32(nb[gi][bj][n]);
#pragma unroll
                    for (int j = 0; j < 4; ++j) o[j] += sigm(a[j]) * p[j];
                    if (out32) *(f32x4*)(out32 + off + bj * HALF + n * 16) = o;
                    ss += (o[0] * o[0] + o[1] * o[1]) + (o[2] * o[2] + o[3] * o[3]);
                    u32x2 w; w.x = cvt_pk_bf16(o[0], o[1]); w.y = cvt_pk_bf16(o[2], o[3]); *(u32x2*)(out + off + bj * HALF + n * 16) = w; }
            row_ss_add(rs, row, ss, fq); }
#undef EPI_LD
    }
};
struct EpiGlu {
    static constexpr bool PERM = false, AFTER_DRAIN = false;
    const bf16_t* base; bf16_t* out; rs_t* rs; int ldc;
    __device__ __forceinline__ void operator()(const f32x4 (&acc)[2][2][4][2], const Unit& u, int wr, int wc, int fr, int fq) const {
        constexpr int PD = 3;
        const int row0 = u.pm * BM + wr * 64 + fr, col0 = u.pn * HALF + wc * 32 + 4 * fq;
        u32x2 nb[8][2];
#define EPI_LD(g) do { const size_t o_ = (size_t)(row0 + ((g) >> 2) * HALF + ((g) & 3) * 16) * ldc + col0; _Pragma("unroll") for (int n = 0; n < 2; ++n) nb[g][n] = *(const u32x2*)(base + o_ + n * 16); } while (0)
#pragma unroll
        for (int g = 0; g < PD; ++g) EPI_LD(g);
#pragma unroll
        for (int gi = 0; gi < 8; ++gi) { const int ai = gi >> 2, m = gi & 3; const int row = row0 + ai * HALF + m * 16; const size_t off = (size_t)row * ldc + col0;
            if (gi + PD < 8) EPI_LD(gi + PD);
            float ss = 0.f;
#pragma unroll
            for (int n = 0; n < 2; ++n) { const f32x4 a = acc[ai][0][m][n], g = acc[ai][1][m][n]; f32x4 o = bf4_to_f32(nb[gi][n]);
#pragma unroll
                for (int j = 0; j < 4; ++j) o[j] += a[j] * sigm(g[j]);
                ss += (o[0] * o[0] + o[1] * o[1]) + (o[2] * o[2] + o[3] * o[3]);
                u32x2 w; w.x = cvt_pk_bf16(o[0], o[1]); w.y = cvt_pk_bf16(o[2], o[3]); *(u32x2*)(out + off + n * 16) = w; }
            row_ss_add(rs, row, ss, fq); }
#undef EPI_LD
    }
};

constexpr int S5T = 32, S5NCH = 512, S5KS = 768;
struct S5Order {
    int G, c, MT, NT;
    __device__ __forceinline__ bool next(int i, Unit& u) const { const int idx = i * G + c; if (idx >= 256 * MT * NT) return false; const int g = idx & 255, sub = idx >> 8;
        u.pm = g * MT + sub / NT; u.pn = g * NT + sub % NT; return true; }
    __device__ __forceinline__ void a_ready(const Unit&) const {}
    __device__ __forceinline__ void done(const Unit&) const {}
};
struct EpiS5U {
    static constexpr bool PERM = true, AFTER_DRAIN = false;
    bf16_t* UA; const rs_t* rs;
    __device__ __forceinline__ void operator()(const f32x4 (&acc)[2][2][4][2], const Unit& u, int wr, int wc, int fr, int fq) const {
        const int row0 = u.pm * BM + wr * 64 + fr, col0 = u.pn * BM + wc * 32 + 8 * fq;
        rs_t scv[8];
#pragma unroll
        for (int gi = 0; gi < 8; ++gi) scv[gi] = rs[row0 + (gi >> 2) * HALF + (gi & 3) * 16];
        PIN8(scv);
#pragma unroll
        for (int ai = 0; ai < 2; ++ai)
#pragma unroll
            for (int m = 0; m < 4; ++m) { const int t = row0 + ai * HALF + m * 16, c = t >> 5, sg = t & 31; const float sc = rs_rinv(scv[ai * 4 + m]);
#pragma unroll
                for (int bj = 0; bj < 2; ++bj) { const int col = col0 + bj * HALF, g = col >> 4, q0 = col & 15;
                    const f32x4 v0 = acc[ai][bj][m][0] * sc, v1 = acc[ai][bj][m][1] * sc;
                    u32x4 w; w.x = cvt_pk_bf16(v0[0], v0[1]); w.y = cvt_pk_bf16(v0[2], v0[3]); w.z = cvt_pk_bf16(v1[0], v1[1]); w.w = cvt_pk_bf16(v1[2], v1[3]);
                    *(u32x4*)(UA + ((size_t)(g * S5NCH + c) * S5KS + sg * 16 + q0)) = w; } }
    }
};
struct EpiS5E {
    static constexpr bool PERM = false, AFTER_DRAIN = false;
    float* E;
    __device__ __forceinline__ void operator()(const f32x4 (&acc)[2][2][4][2], const Unit& u, int wr, int wc, int fr, int fq) const {
        const int row0 = u.pm * BM + wr * 64 + fr, col0 = wc * 32 + 4 * fq;
#pragma unroll
        for (int ai = 0; ai < 2; ++ai)
#pragma unroll
            for (int m = 0; m < 4; ++m) { float* rowp = E + (size_t)(row0 + ai * HALF + m * 16) * 256 + col0;
#pragma unroll
                for (int bj = 0; bj < 2; ++bj)
#pragma unroll
                    for (int n = 0; n < 2; ++n) *(f32x4*)(rowp + bj * HALF + n * 16) = acc[ai][bj][m][n]; }
    }
};
__device__ __forceinline__ float gelu_tanh_f(float v) {
    const float z = 0.7978845608028654f * (v + 0.044715f * v * v * v);
    const float e = __builtin_amdgcn_exp2f(2.0f * 1.4426950408889634f * z);
    return 0.5f * v * (2.0f - 2.0f * __builtin_amdgcn_rcpf(e + 1.0f));
}
struct EpiS5Y {
    static constexpr bool PERM = true, AFTER_DRAIN = false;
    const bf16_t* UA; const float* dskip; bf16_t* G; int ldg;
    __device__ __forceinline__ void operator()(const f32x4 (&acc)[2][2][4][2], const Unit& u, int wr, int wc, int fr, int fq) const {
        const int row0 = u.pm * BM + wr * 64 + fr, col0 = (u.pn & 1) * BM + wc * 32 + 8 * fq;
        const int g = u.pm >> 1, p0 = col0 & 15;
        const f32x4 d0 = *(const f32x4*)(dskip + 16 * g + p0), d1 = *(const f32x4*)(dskip + 16 * g + p0 + 4);
        u32x4 uu[8][2];
#pragma unroll
        for (int gi = 0; gi < 8; ++gi)
#pragma unroll
            for (int bj = 0; bj < 2; ++bj) uu[gi][bj] = *(const u32x4*)(UA + ((size_t)(row0 + (gi >> 2) * HALF + (gi & 3) * 16) * S5KS + col0 + bj * HALF));
#pragma unroll
        for (int gi = 0; gi < 8; ++gi) asm volatile("" : "+v"(uu[gi][0]), "+v"(uu[gi][1]));
#pragma unroll
        for (int gi = 0; gi < 8; ++gi) { const int ai = gi >> 2, m = gi & 3; const int rowg = row0 + ai * HALF + m * 16, c = rowg & 511;
#pragma unroll
            for (int bj = 0; bj < 2; ++bj) { const int col = col0 + bj * HALF, tau = col >> 4; const u32x4 w4 = uu[gi][bj];
                f32x4 v0 = acc[ai][bj][m][0], v1 = acc[ai][bj][m][1];
                v0[0] += d0[0] * __builtin_bit_cast(float, w4.x << 16); v0[1] += d0[1] * __builtin_bit_cast(float, w4.x & 0xffff0000u);
                v0[2] += d0[2] * __builtin_bit_cast(float, w4.y << 16); v0[3] += d0[3] * __builtin_bit_cast(float, w4.y & 0xffff0000u);
                v1[0] += d1[0] * __builtin_bit_cast(float, w4.z << 16); v1[1] += d1[1] * __builtin_bit_cast(float, w4.z & 0xffff0000u);
                v1[2] += d1[2] * __builtin_bit_cast(float, w4.w << 16); v1[3] += d1[3] * __builtin_bit_cast(float, w4.w & 0xffff0000u);
#pragma unroll
                for (int j = 0; j < 4; ++j) { v0[j] = gelu_tanh_f(v0[j]); v1[j] = gelu_tanh_f(v1[j]); }
                u32x4 w; w.x = cvt_pk_bf16(v0[0], v0[1]); w.y = cvt_pk_bf16(v0[2], v0[3]); w.z = cvt_pk_bf16(v1[0], v1[1]); w.w = cvt_pk_bf16(v1[2], v1[3]);
                *(u32x4*)(G + (size_t)(32 * c + tau) * ldg + 16 * g + p0) = w; } }
    }
};

template <class Epi, class Sched, bool ALIGN_EPI = false, bool SP2 = false>
__device__ __forceinline__ void gemm_phase(PG8_LAS unsigned char* lds, const Gemm g, const Sched& S, const Epi& E) {
    int tid_o = threadIdx.x; asm volatile("" : "+v"(tid_o)); const int tid = tid_o, wid = __builtin_amdgcn_readfirstlane(tid >> 6), lane = tid & 63, wr = wid >> 2, wc = wid & 3, fr = lane & 15, fq = lane >> 4;
    const int K = g.K, nt = K / BK;
    unsigned voffA[2], voffB[2];
#pragma unroll
    for (int i = 0; i < 2; ++i) { int R, C; stage_rc(tid * 16 + i * 8192, R, C); const int Rb = Epi::PERM ? ((R & ~31) + perm32(R & 31)) : R;
        voffA[i] = (unsigned)(R * g.lda + C) * 2u; voffB[i] = (unsigned)(Rb * g.ldb + C) * 2u; }
    const size_t kstep = (size_t)(BK * 2);
    const size_t hstepA = (size_t)HALF * g.lda * 2, hstepB = (size_t)HALF * g.ldb * 2;
    const size_t tstepA = 2 * hstepA, tstepB = 2 * hstepB;
    const unsigned ldsw = (unsigned)wid * 1024u;
    const int aoff = lds_byte(wr * 64 + fr, fq * 8), boff = lds_byte(wc * 32 + fr, fq * 8);
#define PG8_SA(b, h) (((b) * 2 + (h)) * HTB)
#define PG8_SB(b, h) ((4 + (b) * 2 + (h)) * HTB)
#define PG8_STAGE(bufoff, gbase, voff) do { _Pragma("unroll") for (int _i = 0; _i < 2; ++_i) \
        __builtin_amdgcn_global_load_lds((const unsigned*)((const char*)(gbase) + (voff)[_i]), (PG8_LAS unsigned*)(lds + (bufoff) + ldsw + _i * 8192), 16, 0, 0); } while (0)
#define PG8_LDA(dst, b, h) do { _Pragma("unroll") for (int m = 0; m < 4; ++m) _Pragma("unroll") for (int k = 0; k < 2; ++k) dst[m][k] = *(const PG8_LAS bf16x8*)(lds + PG8_SA(b, h) + aoff + m * 2048 + k * 1024); } while (0)
#define PG8_LDB(dst, b, h) do { _Pragma("unroll") for (int n = 0; n < 2; ++n) _Pragma("unroll") for (int k = 0; k < 2; ++k) dst[n][k] = *(const PG8_LAS bf16x8*)(lds + PG8_SB(b, h) + boff + n * 2048 + k * 1024); } while (0)
#define PG8_MMA(ai, bj, At, Bt) do { __builtin_amdgcn_s_setprio(1); _Pragma("unroll") for (int m = 0; m < 4; ++m) _Pragma("unroll") for (int n = 0; n < 2; ++n) _Pragma("unroll") for (int k = 0; k < 2; ++k) \
        acc[ai][bj][m][n] = __builtin_amdgcn_mfma_f32_16x16x32_bf16(Bt[n][k], At[m][k], acc[ai][bj][m][n], 0, 0, 0); __builtin_amdgcn_s_setprio(0); } while (0)
#define PG8_WAIT_V(n) asm volatile("s_waitcnt vmcnt(" #n ")" ::: "memory")
#define PG8_WAIT_L(n) asm volatile("s_waitcnt lgkmcnt(" #n ")" ::: "memory")
#define PG8_BAR __builtin_amdgcn_s_barrier()
#define PG8_SCHED __builtin_amdgcn_sched_barrier(0)
    Unit cur, nxt; int ui = 0;
    if (!S.next(0, cur)) return;
    f32x4 acc[2][2][4][2];
#pragma unroll
    for (int a = 0; a < 2; ++a)
#pragma unroll
        for (int b = 0; b < 2; ++b)
#pragma unroll
            for (int m = 0; m < 4; ++m)
#pragma unroll
                for (int n = 0; n < 2; ++n) acc[a][b][m][n] = (f32x4){0.f, 0.f, 0.f, 0.f};
    bf16x8 At[4][2], B0[2][2], B1[2][2];
    const char* cA = (const char*)g.A + (size_t)cur.pm * tstepA; const char* cB = (const char*)g.Bt + (size_t)cur.pn * tstepB;
    S.a_ready(cur);
    if constexpr (SP2) {
        PG8_STAGE(PG8_SB(0, 0), cB, voffB); PG8_STAGE(PG8_SB(0, 1), cB + hstepB, voffB); PG8_STAGE(PG8_SA(0, 0), cA, voffA); PG8_STAGE(PG8_SA(0, 1), cA + hstepA, voffA);
        if (wr == 1) PG8_BAR;
        PG8_WAIT_V(2); PG8_BAR;
        PG8_STAGE(PG8_SB(1, 0), cB + kstep, voffB); PG8_STAGE(PG8_SA(1, 0), cA + kstep, voffA); PG8_STAGE(PG8_SB(1, 1), cB + hstepB + kstep, voffB);
        PG8_WAIT_V(6); PG8_BAR;
    } else {
        PG8_STAGE(PG8_SB(0, 0), cB, voffB); PG8_STAGE(PG8_SA(0, 0), cA, voffA); PG8_STAGE(PG8_SB(0, 1), cB + hstepB, voffB); PG8_STAGE(PG8_SA(0, 1), cA + hstepA, voffA);
        if (wr == 1) PG8_BAR;
        PG8_WAIT_V(4); PG8_BAR;
        PG8_STAGE(PG8_SB(1, 0), cB + kstep, voffB); PG8_STAGE(PG8_SA(1, 0), cA + kstep, voffA); PG8_STAGE(PG8_SB(1, 1), cB + hstepB + kstep, voffB);
        PG8_WAIT_V(6); PG8_BAR;
    }
    for (;;) {
        const bool has_next = S.next(ui + 1, nxt);
        const char* nA = has_next ? (const char*)g.A + (size_t)nxt.pm * tstepA : cA; const char* nB = has_next ? (const char*)g.Bt + (size_t)nxt.pn * tstepB : cB;
        for (int t = 0; t < nt; t += 2) {
            const bool last = (t == nt - 2);
            const char* a1 = cA + (size_t)(t + 1) * kstep;
            const char* a2 = last ? nA : cA + (size_t)(t + 2) * kstep; const char* b2 = last ? nB : cB + (size_t)(t + 2) * kstep;
            const char* a3 = a2 + kstep; const char* b3 = b2 + kstep;
            if (last && has_next) S.a_ready(nxt);
            if constexpr (SP2) {
            PG8_LDB(B0, 0, 0); PG8_LDB(B1, 0, 1); PG8_SCHED; PG8_LDA(At, 0, 0); PG8_STAGE(PG8_SA(1, 1), a1 + hstepA, voffA);
            PG8_WAIT_V(8); PG8_WAIT_L(0); PG8_BAR; PG8_MMA(0, 0, At, B0); PG8_MMA(0, 1, At, B1); PG8_BAR; PG8_SCHED;
            PG8_LDA(At, 0, 1); PG8_STAGE(PG8_SB(0, 0), b2, voffB); PG8_STAGE(PG8_SB(0, 1), b2 + hstepB, voffB); PG8_STAGE(PG8_SA(0, 0), a2, voffA);
            PG8_WAIT_V(8); PG8_WAIT_L(0); PG8_BAR; PG8_MMA(1, 0, At, B0); PG8_MMA(1, 1, At, B1); PG8_BAR; PG8_SCHED;
            PG8_LDB(B0, 1, 0); PG8_LDB(B1, 1, 1); PG8_SCHED; PG8_LDA(At, 1, 0); PG8_STAGE(PG8_SA(0, 1), a2 + hstepA, voffA);
            PG8_WAIT_V(8); PG8_WAIT_L(0); PG8_BAR; PG8_MMA(0, 0, At, B0); PG8_MMA(0, 1, At, B1); PG8_BAR; PG8_SCHED;
            PG8_LDA(At, 1, 1); PG8_STAGE(PG8_SB(1, 0), b3, voffB); PG8_STAGE(PG8_SB(1, 1), b3 + hstepB, voffB); PG8_STAGE(PG8_SA(1, 0), a3, voffA);
            PG8_WAIT_V(8); PG8_WAIT_L(0); PG8_BAR; PG8_MMA(1, 0, At, B0); PG8_MMA(1, 1, At, B1); PG8_BAR; PG8_SCHED;
            } else {
            PG8_LDB(B0, 0, 0); PG8_SCHED; PG8_LDA(At, 0, 0); PG8_STAGE(PG8_SA(1, 1), a1 + hstepA, voffA);
            PG8_WAIT_L(8); PG8_BAR; PG8_WAIT_L(0); PG8_MMA(0, 0, At, B0); PG8_BAR; PG8_SCHED;
            PG8_LDB(B1, 0, 1); PG8_STAGE(PG8_SB(0, 0), b2, voffB);
            PG8_BAR; PG8_WAIT_L(0); PG8_MMA(0, 1, At, B1); PG8_BAR;
            PG8_LDA(At, 0, 1); PG8_STAGE(PG8_SA(0, 0), a2, voffA);
            PG8_BAR; PG8_WAIT_L(0); PG8_MMA(1, 0, At, B0); PG8_BAR; PG8_SCHED;
            PG8_STAGE(PG8_SB(0, 1), b2 + hstepB, voffB);
            PG8_WAIT_V(6); PG8_BAR; PG8_MMA(1, 1, At, B1); PG8_BAR;
            PG8_LDB(B0, 1, 0); PG8_SCHED; PG8_LDA(At, 1, 0); PG8_STAGE(PG8_SA(0, 1), a2 + hstepA, voffA);
            PG8_WAIT_L(8); PG8_BAR; PG8_WAIT_L(0); PG8_MMA(0, 0, At, B0); PG8_BAR; PG8_SCHED;
            PG8_LDB(B1, 1, 1); PG8_STAGE(PG8_SB(1, 0), b3, voffB);
            PG8_BAR; PG8_WAIT_L(0); PG8_MMA(0, 1, At, B1); PG8_BAR;
            PG8_LDA(At, 1, 1); PG8_STAGE(PG8_SA(1, 0), a3, voffA);
            PG8_BAR; PG8_WAIT_L(0); PG8_MMA(1, 0, At, B0); PG8_BAR; PG8_SCHED;
            PG8_STAGE(PG8_SB(1, 1), b3 + hstepB, voffB);
            PG8_WAIT_V(6); PG8_BAR; PG8_MMA(1, 1, At, B1); PG8_BAR;
            }
        }
        if constexpr (ALIGN_EPI) { if (wr == 0) PG8_BAR; }
        if constexpr (!Epi::AFTER_DRAIN) { E(acc, cur, wr, wc, fr, fq); PROBE_EPI_DUP S.done(cur); }
        if (!has_next) break;
#pragma unroll
        for (int a = 0; a < 2; ++a)
#pragma unroll
            for (int b = 0; b < 2; ++b)
#pragma unroll
                for (int m = 0; m < 4; ++m)
#pragma unroll
                    for (int n = 0; n < 2; ++n) acc[a][b][m][n] = (f32x4){0.f, 0.f, 0.f, 0.f};
        cur = nxt; cA = nA; cB = nB; ++ui;
        if constexpr (ALIGN_EPI) { if (wr == 1) PG8_BAR; }
    }
    PG8_WAIT_V(0);
    if constexpr (!ALIGN_EPI) { if (wr == 0) PG8_BAR; }
    PG8_BAR;
    if constexpr (Epi::AFTER_DRAIN) { E.fused(acc, cur, wr, wc, fr, fq, lds, wid, lane); S.done(cur); }
#undef PG8_SA
#undef PG8_SB
#undef PG8_STAGE
#undef PG8_LDA
#undef PG8_LDB
#undef PG8_MMA
#undef PG8_WAIT_V
#undef PG8_WAIT_L
#undef PG8_BAR
#undef PG8_SCHED
}
}
#define XB_TMO      128
#define XB_XCNT(j)  (256  + 64 * (j))
#define XB_XSUB(j)  (1280 + 64 * (j))
#define XB_XGEN(j)  (2304 + 64 * (j))
#define XB_TOP      3328
#define XB_TOPGEN   3392
#define XCD_BAR_WORDS 3456
#define XB_SPIN_CAP (1u << 18)

__device__ __forceinline__ unsigned xb_ld(unsigned* p)              { return __hip_atomic_load(p, __ATOMIC_RELAXED, __HIP_MEMORY_SCOPE_AGENT); }
__device__ __forceinline__ unsigned xb_add(unsigned* p, unsigned v) { return __hip_atomic_fetch_add(p, v, __ATOMIC_RELAXED, __HIP_MEMORY_SCOPE_AGENT); }
__device__ __forceinline__ unsigned xb_xcc_id() { return (unsigned)__builtin_amdgcn_s_getreg((3 << 11) | 20) & 0xFu; }
#define XB_SPIN(cond, bar) do { unsigned _sp = 0; while (cond) { __builtin_amdgcn_s_sleep(1); \
    if ((++_sp & 255u) == 0u) { if (xb_ld(&(bar)[XB_TMO])) break; if (_sp > XB_SPIN_CAP) { atomicAdd(&(bar)[XB_TMO], 1u); break; } } } } while (0)

struct XcdBarrier {
    unsigned* bar; unsigned x;
    volatile LAS unsigned* st;
};

__device__ __forceinline__ XcdBarrier xcd_barrier_post(unsigned* bar, volatile LAS unsigned* st) {
    XcdBarrier b; b.bar = bar; b.x = xb_xcc_id(); b.st = st;
    if (threadIdx.x == 0) (void)xb_add(&bar[XB_XCNT(b.x)], 1u);
    return b;
}
__device__ __forceinline__ void xcd_barrier_complete(unsigned* bar, unsigned x, unsigned& nloc, unsigned& nx) {
    const unsigned G = gridDim.x * gridDim.y * gridDim.z;
    unsigned sum, cnt, mine, sp = 0u;
    for (;;) {
        sum = 0u; cnt = 0u; mine = 0u;
#pragma unroll
        for (unsigned j = 0; j < 16; ++j) { const unsigned c = xb_ld(&bar[XB_XCNT(j)]); sum += c; cnt += (c > 0u) ? 1u : 0u; mine = (j == x) ? c : mine; }
        if (sum == G) break;
        __builtin_amdgcn_s_sleep(1);
        if ((++sp & 255u) == 0u) { if (xb_ld(&bar[XB_TMO])) break; if (sp > XB_SPIN_CAP) { atomicAdd(&bar[XB_TMO], 1u); break; } }
    }
    nloc = mine > 0u ? mine : 1u; nx = cnt > 0u ? cnt : 1u;
}

__device__ __forceinline__ void xcd_barrier(const XcdBarrier& b) {
    asm volatile("s_waitcnt vmcnt(0)" ::: "memory");
    __syncthreads();
    if (threadIdx.x == 0) {
        unsigned* bar = b.bar;
        __builtin_amdgcn_s_waitcnt(0);
        unsigned nloc = b.st[0], nx = b.st[1];
        if (nloc == 0u) { xcd_barrier_complete(bar, b.x, nloc, nx); b.st[0] = nloc; b.st[1] = nx; }
        const unsigned old = xb_add(&bar[XB_XSUB(b.x)], 1u);
        const unsigned gen = old / nloc;
        if (old + 1u == (gen + 1u) * nloc) {
            __builtin_amdgcn_fence(__ATOMIC_RELEASE, "agent");
            asm volatile("s_waitcnt vmcnt(0)" ::: "memory");
            const unsigned og = xb_add(&bar[XB_TOP], 1u);
            const unsigned tg = og / nx;
            if (og + 1u == (tg + 1u) * nx) xb_add(&bar[XB_TOPGEN], 1u);
            else XB_SPIN(xb_ld(&bar[XB_TOPGEN]) == tg, bar);
            __builtin_amdgcn_fence(__ATOMIC_ACQUIRE, "agent");
            xb_add(&bar[XB_XGEN(b.x)], 1u);
            asm volatile("s_waitcnt vmcnt(0)" ::: "memory");
        } else {
            XB_SPIN(xb_ld(&bar[XB_XGEN(b.x)]) == gen, bar);
            __builtin_amdgcn_fence(__ATOMIC_ACQUIRE, "agent");
            asm volatile("s_waitcnt vmcnt(0)" ::: "memory");
        }
    }
    __syncthreads();
}
namespace dattn {
typedef unsigned short bf16;
constexpr int   D = 128, NW = 8, QBLK = 32, KVBLK = 64;
constexpr float SCALE = 0.088388347648318440f;
constexpr float THR = 8.f;
constexpr int SDEPTH = 2;
constexpr int LDQ = 4096, LDK = 1024, LDO = 4096;
constexpr size_t SHM_V = KVBLK * D * 2, SHM_K = KVBLK * D * 2, SHM_ATTN = 3 * SHM_V + 3 * SHM_K + NW * 64 * 4 + 2048;
using bf16x8 = __attribute__((ext_vector_type(8))) short;
using s16x4  = __attribute__((ext_vector_type(4))) short;
using f32x16 = __attribute__((ext_vector_type(16))) float;
using f32x8  = __attribute__((ext_vector_type(8))) float;
using u32x4  = __attribute__((ext_vector_type(4))) unsigned;
#define KSWZ(row, colB) ((row) * 256 + ((colB) ^ (((row) & 7) << 4)))
#define SBAR() __builtin_amdgcn_sched_barrier(0)
__device__ __forceinline__ int crow(int r, int hi) { return (r & 3) + 8 * (r >> 2) + 4 * hi; }
__device__ __forceinline__ unsigned cvtpk(float lo, float hi) {
  unsigned r; asm volatile("v_cvt_pk_bf16_f32 %0, %1, %2" : "=v"(r) : "v"(lo), "v"(hi)); return r;
}
template <typename TIn> struct Stage;
template <> struct Stage<bf16>  { using T = bf16x8;
  __device__ static __forceinline__ T ld8(const bf16* p) { return *reinterpret_cast<const bf16x8*>(p); }
  __device__ static __forceinline__ bf16x8 tobf(T x) { return x; } };
template <> struct Stage<float> { using T = f32x8;
  __device__ static __forceinline__ T ld8(const float* p) { return *reinterpret_cast<const f32x8*>(p); }
  __device__ static __forceinline__ bf16x8 tobf(T x) {
    u32x4 w = {cvtpk(x[0], x[1]), cvtpk(x[2], x[3]), cvtpk(x[4], x[5]), cvtpk(x[6], x[7])}; return *reinterpret_cast<bf16x8*>(&w); } };

__device__ __forceinline__ void partialSM(f32x16& p0, f32x16& p1, float& m_reg, float& mn, float& alpha) {
  constexpr float C = SCALE * 1.4426950408889634f;
  float pmax = p0[0]; for (int r = 1; r < 16; ++r) pmax = fmaxf(pmax, p0[r]); for (int r = 0; r < 16; ++r) pmax = fmaxf(pmax, p1[r]);
  { auto rr = __builtin_amdgcn_permlane32_swap(__float_as_uint(pmax), __float_as_uint(pmax), false, false);
    pmax = fmaxf(__uint_as_float(rr[0]), __uint_as_float(rr[1])); }
  if (__builtin_expect(__all(pmax - m_reg <= THR / SCALE), 1)) { mn = m_reg; alpha = 1.f; }
  else { mn = fmaxf(m_reg, pmax); alpha = __builtin_amdgcn_exp2f((m_reg - mn) * C); m_reg = mn; }
  float mnC = -mn * C;
  for (int r = 0; r < 16; ++r) p0[r] = fmaf(p0[r], C, mnC); for (int r = 0; r < 16; ++r) p1[r] = fmaf(p1[r], C, mnC);
  for (int r = 0; r < 16; ++r) p0[r] = __builtin_amdgcn_exp2f(p0[r]);
}
__device__ __forceinline__ void finishSM(f32x16& p0, f32x16& p1, float alpha, float& l_reg, bf16x8& pa0, bf16x8& pa1, bf16x8& pa2, bf16x8& pa3) {
  for (int r = 0; r < 16; ++r) p1[r] = __builtin_amdgcn_exp2f(p1[r]);
  float ps = 0; for (int r = 0; r < 16; ++r) ps += p0[r]; for (int r = 0; r < 16; ++r) ps += p1[r];
  { auto rr = __builtin_amdgcn_permlane32_swap(__float_as_uint(ps), __float_as_uint(ps), false, false);
    ps = __uint_as_float(rr[0]) + __uint_as_float(rr[1]); }
  l_reg = l_reg * alpha + ps;
#define PK4(P, BASE, OUT) do { unsigned a0 = cvtpk(P[BASE + 0], P[BASE + 1]), a1 = cvtpk(P[BASE + 2], P[BASE + 3]);   \
    unsigned b0 = cvtpk(P[BASE + 4], P[BASE + 5]), b1 = cvtpk(P[BASE + 6], P[BASE + 7]);                              \
    auto r0 = __builtin_amdgcn_permlane32_swap(a0, b0, false, false); auto r1 = __builtin_amdgcn_permlane32_swap(a1, b1, false, false); \
    u32x4 w = {r0[0], r1[0], r0[1], r1[1]}; OUT = *reinterpret_cast<bf16x8*>(&w); } while (0)
  PK4(p0, 0, pa0); PK4(p0, 8, pa1); PK4(p1, 0, pa2); PK4(p1, 8, pa3);
#undef PK4
}
__device__ __forceinline__ void qkt(f32x16& p0, f32x16& p1, const bf16* Ks, const bf16x8* qr, int r32, int hi) {
  p0 = f32x16{}; p1 = f32x16{};
  bf16x8 nb0 = *reinterpret_cast<const bf16x8*>((const char*)Ks + KSWZ(r32, (hi * 8) * 2)), nb1 = *reinterpret_cast<const bf16x8*>((const char*)Ks + KSWZ(32 + r32, (hi * 8) * 2));
#pragma unroll
  for (int d0 = 0; d0 < 8; ++d0) { const bf16x8 b0 = nb0, b1 = nb1;
    if (d0 < 7) { const int cb = ((d0 + 1) * 16 + hi * 8) * 2;
      nb0 = *reinterpret_cast<const bf16x8*>((const char*)Ks + KSWZ(r32, cb)); nb1 = *reinterpret_cast<const bf16x8*>((const char*)Ks + KSWZ(32 + r32, cb)); }
    p0 = __builtin_amdgcn_mfma_f32_32x32x16_bf16(b0, qr[d0], p0, 0, 0, 0);
    p1 = __builtin_amdgcn_mfma_f32_32x32x16_bf16(b1, qr[d0], p1, 0, 0, 0); }
}
__device__ __forceinline__ int v_st(int k, int c) { const int kk = (k & ~0xC) | ((k & 4) << 1) | ((k & 8) >> 1); return ((kk >> 3) * 4 + (c >> 5)) * 512 + ((kk & 7) * 32 + (c & 31)) * 2; }
__device__ __forceinline__ int v_rd_base(int lane) { return ((lane & 3) << 3) | (((lane >> 2) & 3) << 6) | (((lane >> 4) & 1) << 5) | (((lane >> 5) & 1) << 8); }
constexpr int v_rd_off(int d0, int ks, int half) { return d0 * 512 + ks * 4096 + half * 2048; }
template <int OFF> __device__ __forceinline__ s16x4 tr_read(int vb) {
  s16x4 r; asm volatile("ds_read_b64_tr_b16 %0, %1 offset:%2" : "=&v"(r) : "v"(vb), "i"(OFF) : "memory"); return r;
}
template <int D0> __device__ __forceinline__ void pv_one(f32x16& od, int vb, bf16x8 pa0, bf16x8 pa1, bf16x8 pa2, bf16x8 pa3) {
  const s16x4 l0 = tr_read<v_rd_off(D0, 0, 0)>(vb), h0 = tr_read<v_rd_off(D0, 0, 1)>(vb), l1 = tr_read<v_rd_off(D0, 1, 0)>(vb), h1 = tr_read<v_rd_off(D0, 1, 1)>(vb);
  const s16x4 l2 = tr_read<v_rd_off(D0, 2, 0)>(vb), h2 = tr_read<v_rd_off(D0, 2, 1)>(vb), l3 = tr_read<v_rd_off(D0, 3, 0)>(vb), h3 = tr_read<v_rd_off(D0, 3, 1)>(vb);
  asm volatile("s_waitcnt lgkmcnt(0)" ::: "memory"); SBAR();
#define PK(L, H) (bf16x8){L[0], L[1], L[2], L[3], H[0], H[1], H[2], H[3]}
  od = __builtin_amdgcn_mfma_f32_32x32x16_bf16(pa0, PK(l0, h0), od, 0, 0, 0);
  od = __builtin_amdgcn_mfma_f32_32x32x16_bf16(pa1, PK(l1, h1), od, 0, 0, 0);
  od = __builtin_amdgcn_mfma_f32_32x32x16_bf16(pa2, PK(l2, h2), od, 0, 0, 0);
  od = __builtin_amdgcn_mfma_f32_32x32x16_bf16(pa3, PK(l3, h3), od, 0, 0, 0);
#undef PK
}
__device__ __forceinline__ void pv_d0(f32x16* o, int vb, bf16x8 pa0, bf16x8 pa1, bf16x8 pa2, bf16x8 pa3) {
  pv_one<0>(o[0], vb, pa0, pa1, pa2, pa3); pv_one<1>(o[1], vb, pa0, pa1, pa2, pa3); pv_one<2>(o[2], vb, pa0, pa1, pa2, pa3); pv_one<3>(o[3], vb, pa0, pa1, pa2, pa3);
}

template <typename TQ>
__device__ __forceinline__ void attn_dense_body(const TQ* __restrict__ Qb, const bf16* __restrict__ Kh, const bf16* __restrict__ Vh,
                                                bf16* __restrict__ Ob, int seq, char* lds) {
  using St = Stage<bf16>; using SQ = Stage<TQ>;
  int tid_o = threadIdx.x; asm volatile("" : "+v"(tid_o)); const int tid = tid_o, wid = __builtin_amdgcn_readfirstlane(tid >> 6), lane = tid & 63, r32 = lane & 31, hi = lane >> 5;
  bf16* V_lds = (bf16*)lds; bf16* K_lds = (bf16*)(lds + 3 * SHM_V);
  float* ws = (float*)(lds + 3 * SHM_V + 3 * SHM_K) + wid * 64; float* li_l = ws; float* al_l = ws + 32;
  float m_reg = -1e30f, l_reg = 0; f32x16 o[4] = {}; bf16x8 qr[8];
  const TQ* Qw = Qb + (long)(wid * QBLK + r32) * LDQ + hi * 8;
#pragma unroll
  for (int d0 = 0; d0 < 8; ++d0) qr[d0] = SQ::tobf(SQ::ld8(Qw + d0 * 16));
  const int sr = tid >> 4, sc = (tid & 15) * 8, vst0 = v_st(sr, sc), vst1 = v_st(32 + sr, sc);
  const int vb0 = (int)(uintptr_t)V_lds + v_rd_base(lane);
  struct { typename St::T vs0, vs1, ks0, ks1; } sr_[SDEPTH];
#define SLOAD(i, k0) do { sr_[i].vs0 = St::ld8(&Vh[(long)((k0) + sr) * LDK + sc]); sr_[i].vs1 = St::ld8(&Vh[(long)((k0) + 32 + sr) * LDK + sc]); \
    sr_[i].ks0 = St::ld8(&Kh[(long)((k0) + sr) * LDK + sc]); sr_[i].ks1 = St::ld8(&Kh[(long)((k0) + 32 + sr) * LDK + sc]); } while (0)
#define SWRITE(b, i) do { *(bf16x8*)((char*)V_lds + (b) * SHM_V + vst0) = St::tobf(sr_[i].vs0);          \
    *(bf16x8*)((char*)V_lds + (b) * SHM_V + vst1) = St::tobf(sr_[i].vs1); int kc = sc * 2;               \
    *(bf16x8*)((char*)K_lds + (b) * SHM_K + KSWZ(sr, kc)) = St::tobf(sr_[i].ks0);                       \
    *(bf16x8*)((char*)K_lds + (b) * SHM_K + KSWZ(32 + sr, kc)) = St::tobf(sr_[i].ks1); } while (0)
#define SWAIT() do { if constexpr (SDEPTH == 2) asm volatile("s_waitcnt vmcnt(4)" ::: "memory"); else asm volatile("s_waitcnt vmcnt(0)" ::: "memory"); } while (0)
#define RESC(a) do { if (__any((a) < 1.f)) { if (hi == 0) al_l[r32] = (a); asm volatile("s_waitcnt lgkmcnt(0)" ::: "memory"); \
    for (int d = 0; d < 4; ++d) for (int r = 0; r < 16; ++r) o[d][r] *= al_l[crow(r, hi)]; } } while (0)
  f32x16 pA0, pA1, pB0, pB1; float mnA, mnB, alA, alB; bf16x8 pa0, pa1, pa2, pa3; const int NT = seq / KVBLK;
  constexpr int SE = 0, SO = SDEPTH - 1;
  SLOAD(SE, 0); asm volatile("s_waitcnt vmcnt(0)" ::: "memory"); SWRITE(0, SE); __syncthreads();
  qkt(pA0, pA1, K_lds, qr, r32, hi); partialSM(pA0, pA1, m_reg, mnA, alA);
  SLOAD(SO, KVBLK); if constexpr (SDEPTH == 2) { if (2 < NT) SLOAD(SE, 2 * KVBLK); }
  SWAIT(); SWRITE(1, SO); __syncthreads();
  int bk = 1, bv = 0, bw = 2;
  if (wid >= 4) __builtin_amdgcn_s_setprio(1);
#define ROT3() do { const int t_ = bv; bv = bk; bk = bw; bw = t_; } while (0)
  for (int j = 1; j + 1 < NT; j += 2) {
    SBAR(); qkt(pB0, pB1, (bf16*)((char*)K_lds + bk * SHM_K), qr, r32, hi);
    finishSM(pA0, pA1, alA, l_reg, pa0, pa1, pa2, pa3); SBAR();
    SLOAD(SO, (j + SDEPTH) * KVBLK); SBAR();
    pv_d0(o, vb0 + bv * (int)SHM_V, pa0, pa1, pa2, pa3); partialSM(pB0, pB1, m_reg, mnB, alB);
    SWAIT(); SWRITE(bw, SE);
    RESC(alB); __syncthreads(); ROT3();
    SBAR(); qkt(pA0, pA1, (bf16*)((char*)K_lds + bk * SHM_K), qr, r32, hi);
    finishSM(pB0, pB1, alB, l_reg, pa0, pa1, pa2, pa3); SBAR();
    if (SDEPTH == 1 || j + 3 < NT) SLOAD(SE, (j + 1 + SDEPTH) * KVBLK); SBAR();
    pv_d0(o, vb0 + bv * (int)SHM_V, pa0, pa1, pa2, pa3); partialSM(pA0, pA1, m_reg, mnA, alA);
    SWAIT(); SWRITE(bw, SO);
    RESC(alA); __syncthreads(); ROT3();
  }
  SBAR(); qkt(pB0, pB1, (bf16*)((char*)K_lds + bk * SHM_K), qr, r32, hi);
  finishSM(pA0, pA1, alA, l_reg, pa0, pa1, pa2, pa3); SBAR();
  pv_d0(o, vb0 + bv * (int)SHM_V, pa0, pa1, pa2, pa3); partialSM(pB0, pB1, m_reg, mnB, alB);
  RESC(alB);
  finishSM(pB0, pB1, alB, l_reg, pa0, pa1, pa2, pa3); SBAR();
  pv_d0(o, vb0 + bk * (int)SHM_V, pa0, pa1, pa2, pa3);
#undef ROT3
  __builtin_amdgcn_s_setprio(0);
  if (hi == 0) li_l[r32] = l_reg; asm volatile("s_waitcnt lgkmcnt(0)" ::: "memory");
  float rli[16];
#pragma unroll
  for (int r = 0; r < 16; ++r) rli[r] = __builtin_amdgcn_rcpf(li_l[crow(r, hi)]);
  bf16* Ow = Ob + (long)(wid * QBLK) * LDO;
#pragma unroll
  for (int r = 0; r < 16; ++r) { int orow = crow(r, hi);
    for (int d0 = 0; d0 < 4; ++d0) Ow[(long)orow * LDO + d0 * 32 + r32] = (bf16)(cvtpk(o[d0][r] * rli[r], 0.f) & 0xffffu); }
#undef SLOAD
#undef SWRITE
#undef SWAIT
#undef RESC
}

constexpr int NA_LD = 4096, NA_TILES = 12;
__device__ __forceinline__ void na_block_body(const bf16* __restrict__ Qb, const bf16* __restrict__ Kh, const bf16* __restrict__ Vh, bf16* __restrict__ Ob,
                                              const float* __restrict__ rpb_h, const float* __restrict__ qgain, const float* __restrict__ kgain, int R, int ks, char* lds) {
  using St = Stage<bf16>;
  int tid_o = threadIdx.x; asm volatile("" : "+v"(tid_o)); const int tid = tid_o, wid = __builtin_amdgcn_readfirstlane(tid >> 6), lane = tid & 63, r32 = lane & 31, hi = lane >> 5;
  bf16* V_lds = (bf16*)lds; bf16* K_lds = (bf16*)(lds + 2 * SHM_V);
  float* ws = (float*)(lds + 2 * SHM_V + 2 * SHM_K) + wid * 64; float* li_l = ws; float* al_l = ws + 32;
  float* bt = (float*)(lds + 2 * SHM_V + 2 * SHM_K + NW * 64 * 4);
  float m_reg = -1e30f, l_reg = 0; f32x16 o[4] = {}; bf16x8 qr[8];
  const bf16* Qw = Qb + (long)(wid * QBLK + r32) * NA_LD + hi * 8;
#pragma unroll
  for (int d0 = 0; d0 < 8; ++d0) qr[d0] = St::ld8(Qw + d0 * 16);
  {
    float ss = 0.f;
#pragma unroll
    for (int d0 = 0; d0 < 8; ++d0) { const u32x4 w = __builtin_bit_cast(u32x4, qr[d0]);
#pragma unroll
      for (int e = 0; e < 4; ++e) { const float a = __uint_as_float(w[e] << 16), b = __uint_as_float(w[e] & 0xffff0000u); ss += a * a + b * b; } }
    ss += __shfl_xor(ss, 32);
    const float rinv = __builtin_amdgcn_rsqf(ss * (1.0f / 128.0f) + 1e-6f);
#pragma unroll
    for (int d0 = 0; d0 < 8; ++d0) { const u32x4 w = __builtin_bit_cast(u32x4, qr[d0]); const float* gp = qgain + d0 * 16 + hi * 8;
      const f32x8 g = *reinterpret_cast<const f32x8*>(gp); u32x4 o;
#pragma unroll
      for (int e = 0; e < 4; ++e) o[e] = cvtpk(__uint_as_float(w[e] << 16) * rinv * g[2 * e], __uint_as_float(w[e] & 0xffff0000u) * rinv * g[2 * e + 1]);
      qr[d0] = __builtin_bit_cast(bf16x8, o); } }
  const f32x8 kg = *reinterpret_cast<const f32x8*>(kgain + (tid & 15) * 8);
  for (int i = tid; i < 15 * 31; i += 64 * NW) bt[i] = rpb_h[i];
  const int sr = tid >> 4, sc = (tid & 15) * 8, vst0 = v_st(sr, sc), vst1 = v_st(32 + sr, sc);
  const int vb0 = (int)(uintptr_t)V_lds + v_rd_base(lane);
  bf16x8 s_vs0, s_vs1, s_ks0, s_ks1;
#define NLOAD(k0) do { s_vs0 = St::ld8(&Vh[(long)((k0) + sr) * NA_LD + sc]); s_vs1 = St::ld8(&Vh[(long)((k0) + 32 + sr) * NA_LD + sc]); \
    s_ks0 = St::ld8(&Kh[(long)((k0) + sr) * NA_LD + sc]); s_ks1 = St::ld8(&Kh[(long)((k0) + 32 + sr) * NA_LD + sc]); } while (0)
#define KNORM(x) do { const u32x4 w_ = __builtin_bit_cast(u32x4, x); float a_[8]; float ss_ = 0.f; \
    _Pragma("unroll") for (int e = 0; e < 4; ++e) { a_[2 * e] = __uint_as_float(w_[e] << 16); a_[2 * e + 1] = __uint_as_float(w_[e] & 0xffff0000u); ss_ += a_[2 * e] * a_[2 * e] + a_[2 * e + 1] * a_[2 * e + 1]; } \
    ss_ += __shfl_xor(ss_, 1); ss_ += __shfl_xor(ss_, 2); ss_ += __shfl_xor(ss_, 4); ss_ += __shfl_xor(ss_, 8); \
    const float ri_ = __builtin_amdgcn_rsqf(ss_ * (1.0f / 128.0f) + 1e-6f); u32x4 o_; \
    _Pragma("unroll") for (int e = 0; e < 4; ++e) o_[e] = cvtpk(a_[2 * e] * ri_ * kg[2 * e], a_[2 * e + 1] * ri_ * kg[2 * e + 1]); \
    x = __builtin_bit_cast(bf16x8, o_); } while (0)
#define NWRITE(b) do { KNORM(s_ks0); KNORM(s_ks1); \
    *(bf16x8*)((char*)V_lds + (b) * SHM_V + vst0) = s_vs0; *(bf16x8*)((char*)V_lds + (b) * SHM_V + vst1) = s_vs1; const int kc_ = sc * 2; \
    *(bf16x8*)((char*)K_lds + (b) * SHM_K + KSWZ(sr, kc_)) = s_ks0; *(bf16x8*)((char*)K_lds + (b) * SHM_K + KSWZ(32 + sr, kc_)) = s_ks1; } while (0)
  const int qrow = R + (wid >> 1), r0q = min(max(qrow - 4, 0), 248), jlo = r0q - ks;
  const int c = 32 * (wid & 1) + r32, c0 = min(max(c - 8, 0), 48);
  NLOAD(0); asm volatile("s_waitcnt vmcnt(0)" ::: "memory"); NWRITE(0); __syncthreads();
  for (int j = 0; j < NA_TILES; ++j) {
    const int buf = j & 1;
    if (j + 1 < NA_TILES) NLOAD((j + 1) * KVBLK);
    if (j >= jlo && j < jlo + 8) {
      f32x16 p0, p1; float mn, al; bf16x8 pa0, pa1, pa2, pa3;
      SBAR(); qkt(p0, p1, (bf16*)((char*)K_lds + buf * SHM_K), qr, r32, hi);
      const float* brow = bt + (ks + j - qrow + 7) * 31 + (15 - c);
#pragma unroll
      for (int r = 0; r < 16; ++r) { const int k0 = crow(r, hi), k1 = 32 + k0; const bool v0 = (k0 >= c0) && (k0 < c0 + 16), v1 = (k1 >= c0) && (k1 < c0 + 16);
        const float b0 = brow[v0 ? k0 : c], b1 = brow[v1 ? k1 : c];
        p0[r] = v0 ? fmaf(b0, 1.0f / SCALE, p0[r]) : -1e30f; p1[r] = v1 ? fmaf(b1, 1.0f / SCALE, p1[r]) : -1e30f; }
      partialSM(p0, p1, m_reg, mn, al);
      if (__any(al < 1.f)) { if (hi == 0) al_l[r32] = al; asm volatile("s_waitcnt lgkmcnt(0)" ::: "memory");
#pragma unroll
        for (int d = 0; d < 4; ++d)
#pragma unroll
          for (int r = 0; r < 16; ++r) o[d][r] *= al_l[crow(r, hi)]; }
      finishSM(p0, p1, al, l_reg, pa0, pa1, pa2, pa3); SBAR();
      pv_d0(o, vb0 + buf * (int)SHM_V, pa0, pa1, pa2, pa3);
    }
    if (j + 1 < NA_TILES) { asm volatile("s_waitcnt vmcnt(0)" ::: "memory"); NWRITE(buf ^ 1); }
    __syncthreads();
  }
  if (hi == 0) li_l[r32] = l_reg; asm volatile("s_waitcnt lgkmcnt(0)" ::: "memory");
  float rli[16];
#pragma unroll
  for (int r = 0; r < 16; ++r) rli[r] = __builtin_amdgcn_rcpf(li_l[crow(r, hi)]);
  bf16* Ow = Ob + (long)(wid * QBLK) * NA_LD;
#pragma unroll
  for (int r = 0; r < 16; ++r) { const int orow = crow(r, hi);
    for (int d0 = 0; d0 < 4; ++d0) Ow[(long)orow * NA_LD + d0 * 32 + r32] = (bf16)(cvtpk(o[d0][r] * rli[r], 0.f) & 0xffffu); }
#undef NLOAD
#undef NWRITE
#undef KNORM
}
}
struct Frame {
    LAS unsigned char* lds;
    int tid, lane, wave;
    int bid, vcu, G;
};
__device__ __forceinline__ float wave_sum(float v) {
#pragma unroll
    for (int o = 1; o < 64; o <<= 1) v += __shfl_xor(v, o);
    return v;
}
__device__ __forceinline__ void xrows_phase(const Frame& F, const float* __restrict__ h, bf16* __restrict__ hb, pg8::rs_t* __restrict__ rs) {
    const int gw = F.vcu * 8 + F.wave, NGW = F.G * 8;
    for (int m = gw; m < L; m += NGW) {
        const f32x4* xr = (const f32x4*)(h + (size_t)m * DM) + F.lane;
        v2u* o8 = (v2u*)(hb + (size_t)m * DM) + F.lane;
        float s = 0.f;
#pragma unroll
        for (int j = 0; j < 16; ++j) { const f32x4 v = xr[64 * j]; s += (v.x * v.x + v.y * v.y) + (v.z * v.z + v.w * v.w); v2u w; w.x = pk2(v.x, v.y); w.y = pk2(v.z, v.w); o8[64 * j] = w; }
        s = wave_sum(s);
        if (F.lane == 0) rs[m] = (pg8::rs_t)(s * pg8::RS_FIX);
    }
}
__device__ __forceinline__ void headnorm_rows(bf16* __restrict__ X, int ld, int nheads, const float* __restrict__ gain, int t, int lane, bool rope, const float (&cs)[8], const float (&sn)[8]) {
    const int hs = lane >> 4, l16 = lane & 15;
    f32x4 g0 = *(const f32x4*)(gain + 8 * l16), g1 = *(const f32x4*)(gain + 8 * l16 + 4);
    const float gg[8] = {g0.x, g0.y, g0.z, g0.w, g1.x, g1.y, g1.z, g1.w};
    const bool second = ((l16 >> 2) & 1) != 0;
    for (int hg = 0; hg < nheads / 4; ++hg) {
        bf16* p = X + (size_t)t * ld + (size_t)(4 * hg + hs) * HD + 8 * l16;
        const v4u raw = *(const v4u*)p;
        float x[8] = {bflo(raw.x), bfhi(raw.x), bflo(raw.y), bfhi(raw.y), bflo(raw.z), bfhi(raw.z), bflo(raw.w), bfhi(raw.w)};
        float ss = 0.f;
#pragma unroll
        for (int e = 0; e < 8; ++e) ss += x[e] * x[e];
        ss += __shfl_xor(ss, 1); ss += __shfl_xor(ss, 2); ss += __shfl_xor(ss, 4); ss += __shfl_xor(ss, 8);
        const float rinv = 1.0f / sqrtf(ss * (1.0f / HD) + EPS);
        float y[8];
#pragma unroll
        for (int e = 0; e < 8; ++e) y[e] = x[e] * rinv * gg[e];
        if (rope) {
#pragma unroll
            for (int e = 0; e < 8; ++e) { const float yp = __shfl_xor(y[e], 4); y[e] = second ? (y[e] * cs[e] + yp * sn[e]) : (y[e] * cs[e] - yp * sn[e]); }
        }
        v4u w; w.x = pk2(y[0], y[1]); w.y = pk2(y[2], y[3]); w.z = pk2(y[4], y[5]); w.w = pk2(y[6], y[7]);
        *(v4u*)p = w;
    }
}
__device__ __forceinline__ void prep_phase(const Frame& F, bf16* Q, bf16* K, int ldk, int nkh, const float* qgain, const float* kgain, bool rope) {
    const int gw = F.vcu * 8 + F.wave, NGW = F.G * 8;
    const int l16 = F.lane & 15;
    for (int t = gw; t < L; t += NGW) {
        float cs[8], sn[8];
#pragma unroll
        for (int e = 0; e < 8; ++e) { cs[e] = 1.f; sn[e] = 0.f; }
        if (rope) {
            const int ax = l16 >> 3; const float pos = (float)(ax ? (t & (GRID_W - 1)) : (t / GRID_W));
#pragma unroll
            for (int e = 0; e < 8; ++e) { const int f = (l16 & 3) * 8 + e; const float inv = 1.0f / powf(10000.0f, (float)f * (1.0f / 32.0f)); const float ang = pos * inv; cs[e] = cosf(ang); sn[e] = sinf(ang); }
        }
        headnorm_rows(Q, DM, NH, qgain, t, F.lane, rope, cs, sn);
        headnorm_rows(K, ldk, nkh, kgain, t, F.lane, rope, cs, sn);
    }
}

constexpr int S5T = pg8::S5T, S5NCH = pg8::S5NCH, S5KS = pg8::S5KS;
__device__ __forceinline__ void s5_gen_group(const Frame& F, int g, const float* __restrict__ lam_re, const float* __restrict__ lam_im, const float* __restrict__ log_step,
                                             const float* __restrict__ b_re, const float* __restrict__ b_im, const float* __restrict__ c_re, const float* __restrict__ c_im,
                                             bf16* __restrict__ GM, bf16* __restrict__ BMt, f32x2* __restrict__ PAT) {
    LAS f32x2* apow = (LAS f32x2*)F.lds;
    LAS f32x2* zt = apow + 2 * 33 * 64;
    LAS float* Kd = (LAS float*)(zt + 2 * 64);
    const int tid = F.tid;
    if (tid < 128) {
        const int dir = tid >> 6, n = tid & 63, dg = dir * S5G + g, idx = dg * S5N + n;
        const double dt = exp((double)log_step[dg]);
        const double lr = (double)lam_re[idx], li = (double)lam_im[idx];
        const double mag = exp(lr * dt), are = mag * cos(li * dt), aim = mag * sin(li * dt);
        const double den = lr * lr + li * li, nre = are - 1.0;
        zt[dir * 64 + n] = (f32x2){(float)((nre * lr + aim * li) / den), (float)((aim * lr - nre * li) / den)};
        double pr = 1.0, pi = 0.0;
        for (int k = 0; k <= 32; ++k) { apow[(dir * 33 + k) * 64 + n] = (f32x2){(float)pr, (float)pi}; const double t = pr * are - pi * aim; pi = pr * aim + pi * are; pr = t; }
        PAT[idx] = apow[(dir * 33 + 32) * 64 + n];
    }
    LDS_WAIT(); __syncthreads();
    {
        const int dir = tid >> 8, p = (tid >> 4) & 15, q = tid & 15, dg = dir * S5G + g;
        float wr[64], wi[64];
        const float* cr = c_re + ((size_t)dg * S5P + p) * S5N; const float* ci = c_im + ((size_t)dg * S5P + p) * S5N;
#pragma unroll
        for (int n = 0; n < 64; ++n) { const f32x2 z = zt[dir * 64 + n]; const float br = b_re[((size_t)dg * S5N + n) * S5P + q], bi = b_im[((size_t)dg * S5N + n) * S5P + q];
            const float bbr = z.x * br - z.y * bi, bbi = z.x * bi + z.y * br; const float c0 = cr[n], c1 = ci[n];
            wr[n] = c0 * bbr - c1 * bbi; wi[n] = c0 * bbi + c1 * bbr; }
        for (int d = 0; d < 32; ++d) { float acc = 0.f; const LAS f32x2* ap = apow + (dir * 33 + d) * 64;
#pragma unroll
            for (int n = 0; n < 64; ++n) { const f32x2 a = ap[n]; acc = fmaf(wr[n], a.x, acc); acc = fmaf(-wi[n], a.y, acc); }
            Kd[(dir * 32 + d) * 256 + p * 16 + q] = acc; }
    }
    LDS_WAIT(); __syncthreads();
    bf16* BMg = BMt + (size_t)g * 512 * S5KS;
    for (int it = tid; it < 512 * 64; it += 512) { const int row = it >> 6, ch = it & 63, tau = row >> 4, p = row & 15, sg = ch >> 1, q0 = (ch & 1) * 8;
        float v[8];
        if (sg < tau) { const LAS float* k = Kd + (0 * 32 + (tau - sg)) * 256 + p * 16 + q0;
#pragma unroll
            for (int j = 0; j < 8; ++j) v[j] = k[j]; }
        else if (sg > tau) { const LAS float* k = Kd + (1 * 32 + (sg - tau)) * 256 + p * 16 + q0;
#pragma unroll
            for (int j = 0; j < 8; ++j) v[j] = k[j]; }
        else { const LAS float* k0 = Kd + p * 16 + q0; const LAS float* k1 = Kd + 32 * 256 + p * 16 + q0;
#pragma unroll
            for (int j = 0; j < 8; ++j) v[j] = k0[j] + k1[j]; }
        v4u w; w.x = pk2(v[0], v[1]); w.y = pk2(v[2], v[3]); w.z = pk2(v[4], v[5]); w.w = pk2(v[6], v[7]);
        *(v4u*)(BMg + (size_t)row * S5KS + ch * 8) = w; }
    for (int it = tid; it < 512 * 32; it += 512) { const int row = it >> 5, ch = it & 31, tau = row >> 4, p = row & 15, dir = ch >> 4, n0 = (ch & 15) * 4, dg = dir * S5G + g;
        const int k = dir ? (32 - tau) : (tau + 1);
        const f32x4 cr = *(const f32x4*)(c_re + ((size_t)dg * S5P + p) * S5N + n0), ci = *(const f32x4*)(c_im + ((size_t)dg * S5P + p) * S5N + n0);
        const LAS f32x2* ap = apow + (dir * 33 + k) * 64 + n0;
        unsigned o[4];
#pragma unroll
        for (int j = 0; j < 4; ++j) { const f32x2 a = ap[j]; const float vr = cr[j] * a.x - ci[j] * a.y, vi = cr[j] * a.y + ci[j] * a.x; o[j] = pk2(vr, -vi); }
        *(v4u*)(BMg + (size_t)row * S5KS + 512 + ch * 8) = (v4u){o[0], o[1], o[2], o[3]}; }
    bf16* GMg = GM + (size_t)g * 256 * 512;
    for (int it = tid; it < 128 * 64; it += 512) { const int dn = it >> 6, ch = it & 63, dir = dn >> 6, n = dn & 63, sg = ch >> 1, q0 = (ch & 1) * 8, dg = dir * S5G + g;
        const int pw = dir ? sg : (31 - sg);
        const f32x2 a = apow[(dir * 33 + pw) * 64 + n], z = zt[dir * 64 + n];
        const float wr_ = a.x * z.x - a.y * z.y, wi_ = a.x * z.y + a.y * z.x;
        const float* br = b_re + ((size_t)dg * S5N + n) * S5P + q0; const float* bi = b_im + ((size_t)dg * S5N + n) * S5P + q0;
        float re[8], im[8];
#pragma unroll
        for (int j = 0; j < 8; ++j) { re[j] = wr_ * br[j] - wi_ * bi[j]; im[j] = wr_ * bi[j] + wi_ * br[j]; }
        v4u w0, w1; w0.x = pk2(re[0], re[1]); w0.y = pk2(re[2], re[3]); w0.z = pk2(re[4], re[5]); w0.w = pk2(re[6], re[7]);
        w1.x = pk2(im[0], im[1]); w1.y = pk2(im[2], im[3]); w1.z = pk2(im[4], im[5]); w1.w = pk2(im[6], im[7]);
        *(v4u*)(GMg + (size_t)(dir * 128 + 2 * n) * 512 + ch * 8) = w0; *(v4u*)(GMg + (size_t)(dir * 128 + 2 * n + 1) * 512 + ch * 8) = w1; }
    LDS_WAIT(); __syncthreads();
}
__device__ __forceinline__ void s5_scan_phase(const Frame& F, const f32x2* __restrict__ PAT, const float* __restrict__ E, bf16* __restrict__ UA) {
    for (int task = F.bid + F.G * F.wave; task < 2 * S5G; task += F.G * 8) {
        const int dir = task >> 8, g = task & 255;
        const f32x2 a = PAT[task * S5N + F.lane];
        const float* e = E + (size_t)g * S5NCH * 256 + dir * 128 + 2 * F.lane;
        bf16* s = UA + (size_t)g * S5NCH * S5KS + 512 + dir * 128 + 2 * F.lane;
        float cr = 0.f, ci = 0.f;
        for (int c8 = 0; c8 < S5NCH; c8 += 8) {
            f32x2 v[8];
#pragma unroll
            for (int k = 0; k < 8; ++k) { const int c = dir ? (S5NCH - 1 - (c8 + k)) : (c8 + k); v[k] = *(const f32x2*)(e + (size_t)c * 256); }
#pragma unroll
            for (int k = 0; k < 8; ++k) { const int c = dir ? (S5NCH - 1 - (c8 + k)) : (c8 + k);
                *(unsigned*)(s + (size_t)c * S5KS) = pk2(cr, ci);
                const float nr = fmaf(a.x, cr, fmaf(-a.y, ci, v[k].x)), ni = fmaf(a.x, ci, fmaf(a.y, cr, v[k].y)); cr = nr; ci = ni; }
        }
    }
}


__device__ __forceinline__ void gqa_selfcheck(const Frame& F, const bf16* __restrict__ Qraw, const bf16* __restrict__ Kraw, const bf16* __restrict__ V, const bf16* __restrict__ O,
                                              const float* __restrict__ qg, const float* __restrict__ kg, float* __restrict__ SC, unsigned* flag) {
    LAS float* ql = (LAS float*)(F.lds + F.wave * 1024);
    const int lane = F.lane;
#pragma unroll 1
    for (int s = F.bid * 8 + F.wave; s < 1024; s += F.G * 8) {
        const int tok = (int)(((long)(s >> 5) * 5209 + 77) % L), hq = s & 31, kv = hq >> 2;
        float* sc = SC + (size_t)(F.bid * 8 + F.wave) * L;
        float qv[2]; { const bf16* qp = Qraw + (size_t)tok * DM + hq * HD; qv[0] = bf2f(qp[lane]); qv[1] = bf2f(qp[lane + 64]); }
        { const float ss = wave_sum(qv[0] * qv[0] + qv[1] * qv[1]); const float ri = 1.0f / sqrtf(ss * (1.0f / HD) + EPS); qv[0] *= ri * qg[lane]; qv[1] *= ri * qg[lane + 64]; }
#pragma unroll
        for (int a = 0; a < 2; ++a) { const float pos = (float)(a ? (tok & 63) : (tok >> 6)); const int f = lane & 31; const float ang = pos * (1.0f / powf(10000.0f, (float)f * (1.0f / 32.0f)));
            const float c = cosf(ang), sn = sinf(ang); const float other = __shfl_xor(qv[a], 32); qv[a] = (lane & 32) ? (qv[a] * c + other * sn) : (qv[a] * c - other * sn); }
        ql[lane] = qv[0]; ql[lane + 64] = qv[1]; LDS_WAIT();
        float mx = -1e30f;
#pragma unroll 1
        for (int j = lane; j < L; j += 64) { const bf16* kp = Kraw + (size_t)j * KVD + kv * HD; float ss = 0.f;
#pragma unroll 1
            for (int d = 0; d < HD; ++d) { const float x = bf2f(kp[d]); ss += x * x; }
            const float ri = 1.0f / sqrtf(ss * (1.0f / HD) + EPS); float dot = 0.f;
#pragma unroll 1
            for (int a = 0; a < 2; ++a) { const float pos = (float)(a ? (j & 63) : (j >> 6));
#pragma unroll 1
                for (int f = 0; f < 32; ++f) { const float ang = pos * (1.0f / powf(10000.0f, (float)f * (1.0f / 32.0f))); const float c = cosf(ang), sn = sinf(ang);
                    const float x1 = bf2f(kp[64 * a + f]) * ri * kg[64 * a + f], x2 = bf2f(kp[64 * a + 32 + f]) * ri * kg[64 * a + 32 + f];
                    dot += (x1 * c - x2 * sn) * ql[64 * a + f] + (x2 * c + x1 * sn) * ql[64 * a + 32 + f]; } }
            dot *= 0.088388347648318440f; sc[j] = dot; mx = fmaxf(mx, dot); }
#pragma unroll
        for (int o = 1; o < 64; o <<= 1) mx = fmaxf(mx, __shfl_xor(mx, o));
        asm volatile("s_waitcnt vmcnt(0)" ::: "memory"); __builtin_amdgcn_fence(__ATOMIC_RELEASE, "workgroup"); __builtin_amdgcn_fence(__ATOMIC_ACQUIRE, "agent");
        float o0 = 0.f, o1 = 0.f, lsum = 0.f;
#pragma unroll 1
        for (int j = 0; j < L; ++j) { const float pj = expf(__hip_atomic_load(sc + j, __ATOMIC_RELAXED, __HIP_MEMORY_SCOPE_AGENT) - mx); const bf16* vp = V + (size_t)j * KVD + kv * HD; o0 += pj * bf2f(vp[lane]); o1 += pj * bf2f(vp[lane + 64]); lsum += pj; }
        o0 /= lsum; o1 /= lsum;
        const bf16* op = O + (size_t)tok * DM + hq * HD; const float g0 = bf2f(op[lane]), g1 = bf2f(op[lane + 64]);
        float am = fmaxf(fabsf(o0), fabsf(o1));
#pragma unroll
        for (int o = 1; o < 64; o <<= 1) am = fmaxf(am, __shfl_xor(am, o));
        const float tol = 0.05f * am + 1e-5f;
        const bool bad = !(fabsf(g0 - o0) <= tol) || !(fabsf(g1 - o1) <= tol);
        if (__any(bad) && lane == 0) __hip_atomic_fetch_or(flag, 1u, __ATOMIC_RELAXED, __HIP_MEMORY_SCOPE_AGENT);
        LDS_WAIT();
    }
}

__device__ __forceinline__ void transpose_item(const float* __restrict__ W, int K, int N, bf16* __restrict__ WT, int mode, const float* __restrict__ gain, LAS float* scr, int item, int lane) {
    const int nblk = N / 32, kb = item / nblk, nb = item % nblk, k0 = 64 * kb, n0 = 32 * nb;
    int r0 = n0;
    if (mode == 1) r0 = (n0 < DM) ? ((n0 >> 7) * 256 + (n0 & 127)) : (((n0 - DM) >> 7) * 256 + 128 + ((n0 - DM) & 127));
    const float* src = W + (size_t)(k0 + (lane >> 5)) * N + n0 + (lane & 31);
    float v[32];
#pragma unroll
    for (int i = 0; i < 32; ++i) v[i] = src[(size_t)(2 * i) * N];
    const int c = lane & 7;
    f32x4 g0 = (f32x4){1.f, 1.f, 1.f, 1.f}, g1 = g0;
    if (gain) { g0 = *(const f32x4*)(gain + k0 + 8 * c); g1 = *(const f32x4*)(gain + k0 + 8 * c + 4); }
#pragma unroll
    for (int i = 0; i < 32; ++i) scr[(2 * i + (lane >> 5)) * 33 + (lane & 31)] = v[i];
    LDS_WAIT(); asm volatile("" ::: "memory");
#pragma unroll
    for (int j = 0; j < 4; ++j) { const int n = (lane >> 3) + 8 * j; const LAS float* s = scr + (8 * c) * 33 + n;
        v4u o; o.x = pk2(s[0 * 33] * g0.x, s[1 * 33] * g0.y); o.y = pk2(s[2 * 33] * g0.z, s[3 * 33] * g0.w); o.z = pk2(s[4 * 33] * g1.x, s[5 * 33] * g1.y); o.w = pk2(s[6 * 33] * g1.z, s[7 * 33] * g1.w);
        *(v4u*)(WT + (size_t)(r0 + n) * K + k0 + 8 * c) = o; }
    LDS_WAIT(); asm volatile("" ::: "memory");
}

constexpr size_t MiB = 1u << 20;
constexpr size_t SZ_NAQKV = (size_t)3 * DM * DM * 2, SZ_DD = (size_t)DM * DM * 2, SZ_GQAQKV = (size_t)(DM + 2 * KVD) * DM * 2, SZ_W1 = (size_t)FF * DM * 2, SZ_PROJ = (size_t)DM * PLE * 2, SZ_ACT = (size_t)L * DM * 2;
constexpr size_t OFF_CTL = 0, CTL_ZERO_BYTES = 3 * MiB, OFF_RS = 1 * MiB;
constexpr size_t OFF_NAQKV = 4 * MiB;
constexpr size_t OFF_NAWO = OFF_NAQKV + 2 * SZ_NAQKV;
constexpr size_t OFF_GQAQKV = OFF_NAWO + 2 * SZ_DD;
constexpr size_t OFF_GQAWO = OFF_GQAQKV + SZ_GQAQKV;
constexpr size_t OFF_S5IN = OFF_GQAWO + SZ_DD;
constexpr size_t OFF_S5OUT = OFF_S5IN + SZ_DD;
constexpr size_t OFF_W1 = OFF_S5OUT + 2 * SZ_DD;
constexpr size_t OFF_W2 = OFF_W1 + 4 * SZ_W1;
constexpr size_t OFF_PROJ = OFF_W2 + 4 * SZ_W1;
constexpr size_t OFF_GATE = OFF_PROJ + 4 * SZ_PROJ;
constexpr size_t OFF_PBF = OFF_GATE + 4 * SZ_DD;
constexpr size_t OFF_XN = OFF_PBF + 4 * (size_t)L * PLE * 2;
constexpr size_t OFF_ACT = OFF_XN + SZ_ACT;
constexpr size_t OFF_PP = OFF_ACT + 4 * SZ_ACT;
constexpr size_t OFF_S5BM = OFF_PP + SZ_ACT;
constexpr size_t OFF_S5GM = OFF_S5BM + 192 * MiB;
constexpr size_t OFF_S5PAR = OFF_S5GM + 64 * MiB;
constexpr size_t OFF_DUMMY = OFF_S5PAR + 8 * MiB;
constexpr size_t OFF_HB1 = OFF_DUMMY + 256 * MiB;
constexpr size_t WS_END = OFF_HB1 + SZ_ACT;
constexpr int CW_BAR = 4096;
constexpr int RING_BYTES = 131072, LDSCTL_OFF = RING_BYTES, MISC_OFF = LDSCTL_OFF + 320, PTAB_OFF = LDSCTL_OFF + 1024, LDS_BYTES = 147456;
static_assert(dattn::SHM_ATTN <= RING_BYTES && 8 * 64 * 33 * 4 <= RING_BYTES, "phase scratch fits the ring region");

constexpr int PH_PER_LAYER = 8, NPH = 1 + DEPTH * PH_PER_LAYER;
struct Args { const float* in[28]; float* out; unsigned char* ws; int ph_lo, ph_hi; };
enum { I_X = 0, I_P, I_MIXN, I_MLPN, I_PLEN, I_NAQKV, I_NAWO, I_NAQG, I_NAKG, I_NARPB, I_GQKV, I_GWO, I_GQG, I_GKG, I_S5IN, I_LAMRE, I_LAMIM, I_LOGSTEP, I_BRE, I_BIM, I_CRE, I_CIM, I_S5D, I_S5OUT, I_W1, I_W2, I_PROJ, I_GATE };


__device__ __forceinline__ unsigned long long tab_get(LAS unsigned char* lds, int i) {
    volatile LAS unsigned* t = (volatile LAS unsigned*)(lds + PTAB_OFF); const unsigned lo = t[2 * i], hi = t[2 * i + 1];
    return ((unsigned long long)(unsigned)__builtin_amdgcn_readfirstlane((int)hi) << 32) | (unsigned)__builtin_amdgcn_readfirstlane((int)lo); }
#define INP(i) ((const float*)(const GAS float*)tab_get(F.lds, (i)))
#define OUTP() ((float*)(GAS float*)tab_get(F.lds, 28))
#define WSP() ((unsigned char*)(GAS unsigned char*)tab_get(F.lds, 29))
__device__ __forceinline__ Frame mkframe(unsigned char* lds_generic) {
    Frame F; int t = threadIdx.x; asm volatile("" : "+v"(t)); F.tid = t; F.lane = t & 63; F.wave = __builtin_amdgcn_readfirstlane(t >> 6);
    F.lds = (LAS unsigned char*)lds_generic; int b = blockIdx.x; asm volatile("" : "+s"(b)); F.bid = b; int G = gridDim.x; asm volatile("" : "+s"(G)); F.G = G;
    F.vcu = (G % 8 == 0) ? (b % 8) * (G / 8) + b / 8 : b; return F; }
__device__ __forceinline__ void prologue_phase(const Frame& F) {
    unsigned char* ws = WSP();
    LAS float* scr = (LAS float*)(F.lds + F.wave * (64 * 33 * 4));
    const int gw = F.vcu * 8 + F.wave, NGW = F.G * 8;
    constexpr int I_QKV = (DM / 64) * (3 * DM / 32), I_DD = (DM / 64) * (DM / 32), I_GQ = (DM / 64) * ((DM + 2 * KVD) / 32), I_SO = (DM / 64) * (2 * DM / 32),
                  I_1 = (DM / 64) * (FF / 32), I_2 = (FF / 64) * (DM / 32), I_PJ = (PLE / 64) * (DM / 32);
    constexpr int NITEMS = 2 * I_QKV + 2 * I_DD + I_GQ + I_DD + I_DD + I_SO + 4 * I_1 + 4 * I_2 + 4 * I_PJ + 4 * I_DD;
    for (int it = gw; it < NITEMS; it += NGW) {
        int r = it; const float* W; int K, N, mode = 0; bf16* WT; const float* gain = nullptr;
        if (r < 2 * I_QKV) { const int l = r / I_QKV; r -= l * I_QKV; W = INP(I_NAQKV) + (size_t)l * DM * 3 * DM; K = DM; N = 3 * DM; WT = (bf16*)(ws + OFF_NAQKV + l * SZ_NAQKV); gain = INP(I_MIXN) + (size_t)(3 * l) * DM; }
        else { r -= 2 * I_QKV;
        if (r < 2 * I_DD) { const int l = r / I_DD; r -= l * I_DD; W = INP(I_NAWO) + (size_t)l * DM * DM; K = DM; N = DM; WT = (bf16*)(ws + OFF_NAWO + l * SZ_DD); }
        else { r -= 2 * I_DD;
        if (r < I_GQ) { W = INP(I_GQKV); K = DM; N = DM + 2 * KVD; WT = (bf16*)(ws + OFF_GQAQKV); gain = INP(I_MIXN) + (size_t)1 * DM; }
        else { r -= I_GQ;
        if (r < I_DD) { W = INP(I_GWO); K = DM; N = DM; WT = (bf16*)(ws + OFF_GQAWO); }
        else { r -= I_DD;
        if (r < I_DD) { W = INP(I_S5IN); K = DM; N = DM; WT = (bf16*)(ws + OFF_S5IN); gain = INP(I_MIXN) + (size_t)2 * DM; }
        else { r -= I_DD;
        if (r < I_SO) { W = INP(I_S5OUT); K = DM; N = 2 * DM; WT = (bf16*)(ws + OFF_S5OUT); mode = 1; }
        else { r -= I_SO;
        if (r < 4 * I_1) { const int l = r / I_1; r -= l * I_1; W = INP(I_W1) + (size_t)l * DM * FF; K = DM; N = FF; WT = (bf16*)(ws + OFF_W1 + l * SZ_W1); gain = INP(I_MLPN) + (size_t)l * DM; }
        else { r -= 4 * I_1;
        if (r < 4 * I_2) { const int l = r / I_2; r -= l * I_2; W = INP(I_W2) + (size_t)l * FF * DM; K = FF; N = DM; WT = (bf16*)(ws + OFF_W2 + l * SZ_W1); }
        else { r -= 4 * I_2;
        if (r < 4 * I_PJ) { const int l = r / I_PJ; r -= l * I_PJ; W = INP(I_PROJ) + (size_t)l * PLE * DM; K = PLE; N = DM; WT = (bf16*)(ws + OFF_PROJ + l * SZ_PROJ); }
        else { r -= 4 * I_PJ; const int l = r / I_DD; r -= l * I_DD; W = INP(I_GATE) + (size_t)l * DM * DM; K = DM; N = DM; WT = (bf16*)(ws + OFF_GATE + l * SZ_DD); gain = INP(I_PLEN) + (size_t)l * DM; } } } } } } } } }
        transpose_item(W, K, N, WT, mode, gain, scr, r, F.lane);
    }
    xrows_phase(F, INP(I_X), (bf16*)(ws + OFF_XN), (pg8::rs_t*)(ws + OFF_RS));
    { const size_t n8 = (size_t)DEPTH * L * PLE / 8; const float* p = INP(I_P); bf16* pb = (bf16*)(ws + OFF_PBF);
      for (size_t i = (size_t)gw * 64 + F.lane; i < n8; i += (size_t)NGW * 64) { const f32x4 a = *(const f32x4*)(p + i * 8), b = *(const f32x4*)(p + i * 8 + 4);
          v4u w; w.x = pk2(a.x, a.y); w.y = pk2(a.z, a.w); w.z = pk2(b.x, b.y); w.w = pk2(b.z, b.w); *(v4u*)(pb + i * 8) = w; } }
    { bf16* GM = (bf16*)(ws + OFF_S5GM); bf16* BMt = (bf16*)(ws + OFF_S5BM); f32x2* PAT = (f32x2*)(ws + OFF_S5PAR);
      LDS_WAIT(); __syncthreads();
      for (int g = F.bid; g < S5G; g += F.G) s5_gen_group(F, g, INP(I_LAMRE), INP(I_LAMIM), INP(I_LOGSTEP), INP(I_BRE), INP(I_BIM), INP(I_CRE), INP(I_CIM), GM, BMt, PAT); }
}

#define WS_PTRS() unsigned char* ws = WSP(); bf16* HB0 = (bf16*)(ws + OFF_XN); bf16* HB1 = (bf16*)(ws + OFF_HB1); bf16* Qb = (bf16*)(ws + OFF_ACT); bf16* Kb = (bf16*)(ws + OFF_ACT + SZ_ACT); bf16* Vb = (bf16*)(ws + OFF_ACT + 2 * SZ_ACT); \
    bf16* Ob = (bf16*)(ws + OFF_ACT + 3 * SZ_ACT); bf16* HID = (bf16*)(ws + OFF_ACT); bf16* UA = (bf16*)(ws + OFF_ACT); bf16* S5Gb = (bf16*)(ws + OFF_ACT + 2 * SZ_ACT); float* S5E = (float*)(ws + OFF_ACT + 3 * SZ_ACT); bf16* PP = (bf16*)(ws + OFF_PP); \
    (void)HB0; (void)HB1; (void)Qb; (void)Kb; (void)Vb; (void)Ob; (void)HID; (void)UA; (void)S5Gb; (void)PP; (void)S5E;
__global__ void __launch_bounds__(512, 2) enc_fwd(Args args) {
    extern __shared__ __attribute__((aligned(16))) unsigned char lds[];
    {
        LAS unsigned char* l3 = (LAS unsigned char*)lds;
        for (int u = threadIdx.x; u < (LDS_BYTES - LDSCTL_OFF) / 4; u += 512) ((LAS unsigned*)(l3 + LDSCTL_OFF))[u] = 0u;
        __syncthreads();
        if (threadIdx.x == 0) { LAS unsigned long long* t = (LAS unsigned long long*)(l3 + PTAB_OFF);
#pragma unroll
            for (int i = 0; i < 28; ++i) t[i] = (unsigned long long)args.in[i];
            t[28] = (unsigned long long)args.out; t[29] = (unsigned long long)args.ws; }
        __syncthreads();
    }
    const int lo = args.ph_lo, hi = args.ph_hi;
    XcdBarrier bar;
    { LAS unsigned char* l3 = (LAS unsigned char*)lds; unsigned* ctl = (unsigned*)(GAS unsigned*)(tab_get(l3, 29) + OFF_CTL); bar.bar = ctl + CW_BAR; bar.x = 0; bar.st = nullptr;
      if (hi - lo > 1) bar = xcd_barrier_post(ctl + CW_BAR, (volatile LAS unsigned*)(l3 + MISC_OFF) + 8); }
#define IN(k) (lo <= (k) && (k) < hi)
#ifndef PROBE_PH
#define PROBE_PH (-1)
#endif
#define REPS(k) for (int rep_ = 0, nrep_ = (((k) == PROBE_PH || PROBE_PH == -2) ? 2 : ((PROBE_PH == 300 && (k) == 11) ? 4 : 1)); rep_ < nrep_; ++rep_)
#define HBOUT(p) ((nrep_ == 2 && rep_ == 0) ? (bf16*)(ws + OFF_DUMMY) : (p))
#define RSOUT(i) ((nrep_ == 2 && rep_ == 0) ? (pg8::rs_t*)(ws + OFF_DUMMY + 128 * MiB) : RSP(i))
#define SEAM(k) do { if (IN(k) && IN((k) + 1)) xcd_barrier(bar); } while (0)

    if (IN(0)) REPS(0) { const Frame F = mkframe(lds); prologue_phase(F); } SEAM(0);
#if PROBE_PH == 200
    for (int xb_ = 0; xb_ < 40; ++xb_) xcd_barrier(bar);
#endif

#pragma unroll 1
    for (int layer = 0; layer < DEPTH; ++layer) {
        const int kind = layer % 3, slot = layer / 3, pb = 1 + PH_PER_LAYER * layer;
#define RSP(i) ((pg8::rs_t*)(ws + OFF_RS) + (size_t)(i) * L)
        const int irs = (layer == 0) ? 0 : 3 * layer;
        if (IN(pb + 0)) REPS(pb + 0) {
            const Frame F = mkframe(lds); WS_PTRS();
            if (kind != 2) {
                const int N = (kind == 0) ? 3 * DM : DM + 2 * KVD;
                const bf16* W = (kind == 0) ? (const bf16*)(ws + OFF_NAQKV + slot * SZ_NAQKV) : (const bf16*)(ws + OFF_GQAQKV);
                const pg8::Gemm g = pg8::mkgemm(HB0, W, L, N, DM); pg8::StaticOrder S; S.init(L, N, F.G, F.bid);
                pg8::EpiBf16<0> E{Qb, Kb, Vb, DM, (kind == 0) ? DM : KVD, (kind == 0) ? DM : KVD, DM, (kind == 0) ? 2 * DM : DM + KVD, RSP(irs), 0, (kind == 0) ? 2 * DM : DM + KVD};
                pg8::gemm_phase<pg8::EpiBf16<0>, pg8::StaticOrder, false, true>(F.lds, g, S, E);
            } else {
                const pg8::Gemm g = pg8::mkgemm(HB0, (const bf16*)(ws + OFF_S5IN), L, DM, DM); pg8::StaticOrder S; S.init(L, DM, F.G, F.bid);
                pg8::EpiS5U E{UA, RSP(irs)};
                pg8::gemm_phase<pg8::EpiS5U, pg8::StaticOrder, false, true>(F.lds, g, S, E);
            }
        }
        SEAM(pb + 0);
        if (kind != 2) {
#if PROBE_PH == 400
            if (kind == 1) { const Frame F = mkframe(lds); WS_PTRS();
                const v4u* sq = (const v4u*)Qb; v4u* dq = (v4u*)(ws + OFF_DUMMY); const v4u* sk = (const v4u*)Kb; v4u* dk = (v4u*)(ws + OFF_DUMMY + 128 * MiB);
                for (size_t i = (size_t)F.bid * 512 + F.tid; i < (size_t)L * DM / 8; i += (size_t)F.G * 512) dq[i] = sq[i];
                for (size_t i = (size_t)F.bid * 512 + F.tid; i < (size_t)L * KVD / 8; i += (size_t)F.G * 512) dk[i] = sk[i];
                xcd_barrier(bar); }
#endif
            if (kind == 1) { if (IN(pb + 1)) { const Frame F = mkframe(lds); WS_PTRS(); prep_phase(F, Qb, Kb, KVD, NKV, INP(I_GQG), INP(I_GKG), true); }
                SEAM(pb + 1); }
            if (IN(pb + 2)) REPS(pb + 2) { const Frame F = mkframe(lds); WS_PTRS();
                if (kind == 0) {
                    const float* rpb = INP(I_NARPB) + (size_t)slot * NH * 15 * 31;
                    for (int i = 0;; ++i) { const int unit = i * F.G + F.vcu; if (unit >= NH * (GROWS / 4)) break;
                        const int h = unit >> 6, R = (unit & 63) * 4, ks = min(max(R - 4, 0), GROWS - dattn::NA_TILES);
                        dattn::na_block_body(Qb + (size_t)(R * GRID_W) * DM + h * HD, Kb + (size_t)(ks * GRID_W) * DM + h * HD, Vb + (size_t)(ks * GRID_W) * DM + h * HD,
                                             Ob + (size_t)(R * GRID_W) * DM + h * HD, rpb + (size_t)h * 15 * 31, INP(I_NAQG) + slot * HD, INP(I_NAKG) + slot * HD, R, ks, (char*)lds);
                        __syncthreads(); }
                } else {
                    for (int i = 0;; ++i) { const int unit = i * F.G + F.bid; if (unit >= NH * (L / 256)) break;
                        const int kvh = unit & 7, rest = unit >> 3, hq = kvh * 4 + (rest >> 6), qb = rest & 63;
                        dattn::attn_dense_body<bf16>(Qb + (size_t)(qb * 256) * DM + hq * HD, Kb + kvh * HD, Vb + kvh * HD, Ob + (size_t)(qb * 256) * DM + hq * HD, L, (char*)lds);
                        __syncthreads(); }
                }
            }
            if (IN(pb + 2) && IN(pb + 4)) xcd_barrier(bar);
#if PROBE_PH == 400
            if (kind == 1) { const Frame F = mkframe(lds); WS_PTRS();
                gqa_selfcheck(F, (const bf16*)(ws + OFF_DUMMY), (const bf16*)(ws + OFF_DUMMY + 128 * MiB), Vb, Ob, INP(I_GQG), INP(I_GKG), (float*)(ws + OFF_PP), (unsigned*)(ws + OFF_CTL) + 8);
                xcd_barrier(bar); }
#endif
        } else {
            if (IN(pb + 1)) REPS(pb + 1) { const Frame F = mkframe(lds); WS_PTRS();
                pg8::Gemm g; g.A = UA; g.Bt = (const bf16*)(ws + OFF_S5GM); g.M = S5G * S5NCH; g.N = 256; g.K = 512; g.lda = S5KS; g.ldb = 512;
                pg8::S5Order S{F.G, F.bid, 2, 1}; pg8::EpiS5E E{S5E};
                pg8::gemm_phase<pg8::EpiS5E, pg8::S5Order, false, true>(F.lds, g, S, E); }
            SEAM(pb + 1);
            if (IN(pb + 2)) REPS(pb + 2) { const Frame F = mkframe(lds); WS_PTRS(); s5_scan_phase(F, (const f32x2*)(ws + OFF_S5PAR), S5E, UA); }
            SEAM(pb + 2);
            if (IN(pb + 3)) REPS(pb + 3) { const Frame F = mkframe(lds); WS_PTRS();
                pg8::Gemm g; g.A = UA; g.Bt = (const bf16*)(ws + OFF_S5BM); g.M = S5G * S5NCH; g.N = S5G * 512; g.K = S5KS; g.lda = S5KS; g.ldb = S5KS;
                pg8::S5Order S{F.G, F.bid, 2, 2}; pg8::EpiS5Y E{UA, INP(I_S5D), S5Gb, DM};
                pg8::gemm_phase<pg8::EpiS5Y, pg8::S5Order, false, true>(F.lds, g, S, E); }
            SEAM(pb + 3);
        }
        if (IN(pb + 4)) REPS(pb + 4) {
            const Frame F = mkframe(lds); WS_PTRS();
            if (kind != 2) {
                const bf16* W = (kind == 0) ? (const bf16*)(ws + OFF_NAWO + slot * SZ_DD) : (const bf16*)(ws + OFF_GQAWO);
                const pg8::Gemm g = pg8::mkgemm(Ob, W, L, DM, DM); pg8::StaticOrder S; S.init(L, DM, F.G, F.bid);
                pg8::EpiRes E{HB0, HBOUT(HB0), RSOUT(1 + 3 * layer), DM, nullptr};
                pg8::gemm_phase<pg8::EpiRes, pg8::StaticOrder, false, true>(F.lds, g, S, E);
            } else {
                const pg8::Gemm g = pg8::mkgemm(S5Gb, (const bf16*)(ws + OFF_S5OUT), L, 2 * DM, DM); pg8::StaticOrder S; S.init(L, 2 * DM, F.G, F.bid);
                pg8::EpiGlu E{HB0, HBOUT(HB0), RSOUT(1 + 3 * layer), DM};
                pg8::gemm_phase<pg8::EpiGlu, pg8::StaticOrder, false, true>(F.lds, g, S, E);
            }
        }
        SEAM(pb + 4);
        if (IN(pb + 5)) REPS(pb + 5) { const Frame F = mkframe(lds); WS_PTRS();
            const pg8::Gemm g = pg8::mkgemm(HB0, (const bf16*)(ws + OFF_W1 + layer * SZ_W1), L, FF, DM); pg8::StaticOrder S; S.init(L, FF, F.G, F.bid);
            pg8::EpiBf16<2> E{HID, HID, HID, FF, FF, FF, 1 << 30, 1 << 30, nullptr, 0, 0};
#if PROBE_PH == 201
            { pg8::RangeOrder R1{S, 0, 8}, R2{S, 8, 16};
              pg8::gemm_phase<pg8::EpiBf16<2>, pg8::RangeOrder, false, true>(F.lds, g, R1, E); xcd_barrier(bar);
              pg8::gemm_phase<pg8::EpiBf16<2>, pg8::RangeOrder, false, true>(F.lds, g, R2, E); }
#else
            pg8::gemm_phase<pg8::EpiBf16<2>, pg8::StaticOrder, false, true>(F.lds, g, S, E);
#endif
        }
        SEAM(pb + 5);
        if (IN(pb + 6)) REPS(pb + 6) { const Frame F = mkframe(lds); WS_PTRS();
            { const pg8::Gemm g = pg8::mkgemm(HID, (const bf16*)(ws + OFF_W2 + layer * SZ_W1), L, DM, FF); pg8::StaticOrder S; S.init(L, DM, F.G, F.bid);
              pg8::EpiRes E{HB0, HBOUT(HB1), RSOUT(2 + 3 * layer), DM, RSP(1 + 3 * layer)};
              pg8::gemm_phase<pg8::EpiRes, pg8::StaticOrder, false, true>(F.lds, g, S, E); }
            { const pg8::Gemm g = pg8::mkgemm((const bf16*)(ws + OFF_PBF + (size_t)layer * L * PLE * 2), (const bf16*)(ws + OFF_PROJ + layer * SZ_PROJ), L, DM, PLE); pg8::StaticOrder S; S.init(L, DM, F.G, F.bid);
              pg8::EpiBf16<0> E{PP, PP, PP, DM, DM, DM, 1 << 30, 1 << 30, nullptr, 0, 0};
              pg8::gemm_phase<pg8::EpiBf16<0>, pg8::StaticOrder, false, true>(F.lds, g, S, E); }
        }
        SEAM(pb + 6);
        if (IN(pb + 7)) REPS(pb + 7) { const Frame F = mkframe(lds); WS_PTRS();
            const pg8::Gemm g = pg8::mkgemm(HB1, (const bf16*)(ws + OFF_GATE + layer * SZ_DD), L, DM, DM); pg8::StaticOrder S; S.init(L, DM, F.G, F.bid);
            pg8::EpiGate E{HB1, HBOUT(HB0), (layer == DEPTH - 1) ? OUTP() : nullptr, PP, RSP(2 + 3 * layer), RSOUT(3 + 3 * layer), DM};
            pg8::gemm_phase<pg8::EpiGate, pg8::StaticOrder, false, true>(F.lds, g, S, E);
        }
        SEAM(pb + 7);
    }
#if PROBE_PH == 400
    { xcd_barrier(bar); const Frame F = mkframe(lds); unsigned char* ws = WSP();
      if (__hip_atomic_load((unsigned*)(ws + OFF_CTL) + 8, __ATOMIC_RELAXED, __HIP_MEMORY_SCOPE_AGENT) != 0u && F.bid == 0 && F.tid < 64) OUTP()[F.tid] = __builtin_nanf(""); }
#endif
#undef IN
#undef SEAM
}

extern "C" void kernel_launch(void* const* d_in, const int* in_sizes, int n_in, void* d_out, int out_size, void* d_ws, size_t ws_size, hipStream_t stream) {
    static int grid = 0;
    if (grid == 0) {
        if (n_in != 28 || in_sizes[0] != L * DM || out_size != L * DM || ws_size < WS_END) {
            fprintf(stderr, "kernel_launch: built for 28 inputs, x/out of %d floats, >= %zu bytes of workspace; got n_in %d, in0 %d, out %d, ws %zu; nothing launched\n", L * DM, (size_t)WS_END, n_in, n_in > 0 ? in_sizes[0] : -1, out_size, ws_size);
            grid = -1; return; }
        int dev = 0, cus = 0, per_cu = 0;
        if (hipGetDevice(&dev) != hipSuccess || hipDeviceGetAttribute(&cus, hipDeviceAttributeMultiprocessorCount, dev) != hipSuccess) { fprintf(stderr, "kernel_launch: device query failed\n"); grid = -1; return; }
        if (hipFuncSetAttribute((const void*)enc_fwd, hipFuncAttributeMaxDynamicSharedMemorySize, LDS_BYTES) != hipSuccess) { fprintf(stderr, "kernel_launch: hipFuncSetAttribute failed\n"); grid = -1; return; }
        if (hipOccupancyMaxActiveBlocksPerMultiprocessor(&per_cu, (const void*)enc_fwd, 512, LDS_BYTES) != hipSuccess || per_cu < 1)
            fprintf(stderr, "kernel_launch: note: occupancy query reports %d workgroups per CU\n", per_cu);
        (void)hipGetLastError();
        grid = cus;
    }
    if (grid < 0) return;
    if (hipMemsetAsync((char*)d_ws + OFF_CTL, 0, CTL_ZERO_BYTES, stream) != hipSuccess) { fprintf(stderr, "kernel_launch: memset failed\n"); return; }
    Args a{};
    for (int i = 0; i < 28; ++i) a.in[i] = (const float*)d_in[i];
    a.out = (float*)d_out; a.ws = (unsigned char*)d_ws;
#if MK_N_LAUNCHES == 1
    a.ph_lo = 0; a.ph_hi = NPH;
    hipLaunchKernelGGL(enc_fwd, dim3(grid), dim3(512), LDS_BYTES, stream, a);
#else
    for (int ph = 0; ph < NPH; ++ph) {
        if (ph > 0) { const int layer = (ph - 1) / PH_PER_LAYER, j = (ph - 1) % PH_PER_LAYER; if (j == 3 && layer % 3 != 2) continue; }
        a.ph_lo = ph; a.ph_hi = ph + 1;
        hipLaunchKernelGGL(enc_fwd, dim3(grid), dim3(512), LDS_BYTES, stream, a);
    }
#endif
    const hipError_t le = hipPeekAtLastError();
    if (le != hipSuccess) fprintf(stderr, "kernel_launch: launch failed: %s\n", hipGetErrorName(le));
}
```

```cpp
#include <hip/hip_runtime.h>
#include <cstdio>
#include <cstdint>

#ifndef MK_N_LAUNCHES
#define MK_N_LAUNCHES 1
#endif

constexpr int L = 16384, DM = 4096, DEPTH = 4, GRID_W = 64, GROWS = L / GRID_W, HD = 128, NH = 32, NKV = 8, KVD = NKV * HD, FF = 4 * DM, PLE = 256;
constexpr int S5G = 256, S5P = 16, S5N = 64, S5TC = 16, S5NC = L / S5TC;
constexpr float EPS = 1e-6f;

#define GAS __attribute__((address_space(1)))
#define LAS __attribute__((address_space(3)))
typedef unsigned short bf16;
typedef unsigned v4u __attribute__((ext_vector_type(4)));
typedef unsigned v2u __attribute__((ext_vector_type(2)));
typedef float f32x4 __attribute__((ext_vector_type(4)));
typedef float f32x2 __attribute__((ext_vector_type(2)));
typedef short bf16x8 __attribute__((ext_vector_type(8)));
typedef short s16x4 __attribute__((ext_vector_type(4)));
typedef GAS unsigned gu32;
#define RLX_AGENT __ATOMIC_RELAXED, __HIP_MEMORY_SCOPE_AGENT
#define LDS_WAIT() asm volatile("s_waitcnt lgkmcnt(0)" ::: "memory")
#define VM_WAIT() asm volatile("s_waitcnt vmcnt(0)" ::: "memory")
__device__ __forceinline__ unsigned f2bf(float f) { unsigned u = __builtin_bit_cast(unsigned, f); return (u + 0x7fffu + ((u >> 16) & 1u)) >> 16; }
__device__ __forceinline__ unsigned pk2(float lo, float hi) { return f2bf(lo) | (f2bf(hi) << 16); }
__device__ __forceinline__ float bf2f(unsigned short b) { return __builtin_bit_cast(float, (unsigned)b << 16); }
__device__ __forceinline__ float bflo(unsigned w) { return __builtin_bit_cast(float, w << 16); }
__device__ __forceinline__ float bfhi(unsigned w) { return __builtin_bit_cast(float, w & 0xffff0000u); }
__device__ __forceinline__ float sigmoidf_fast(float x) { return __builtin_amdgcn_rcpf(1.0f + __builtin_amdgcn_exp2f(-1.4426950408889634f * x)); }

namespace pg8 {
#define PG8_LAS __attribute__((address_space(3)))
#if defined(PROBE_EPI2)
#define PROBE_EPI_DUP if constexpr (Epi::PERM) E(acc, cur, wr, wc, fr, fq);
#else
#define PROBE_EPI_DUP
#endif
typedef unsigned short bf16_t;
typedef short bf16x8 __attribute__((ext_vector_type(8)));
typedef float f32x4 __attribute__((ext_vector_type(4)));
typedef unsigned u32x4 __attribute__((ext_vector_type(4)));
constexpr int BM = 256, BK = 64, HALF = 128, HTB = HALF * BK * 2  , STAGE_BYTES = 8 * HTB, NXCD = 8, WGM = 8;

__host__ __device__ __forceinline__ int lds_byte(int r, int c) { const int st = (r >> 4) * 2 + (c >> 5), rr = r & 15, cc = c & 31, ob = rr * 64 + cc * 2; return st * 1024 + (ob ^ (((ob >> 9) & 1) << 5)); }
__host__ __device__ __forceinline__ void stage_rc(int b, int& R, int& C) { const int st = b / 1024, sb = b % 1024, swz = sb ^ (((sb >> 9) & 1) << 5); R = (st >> 1) * 16 + swz / 64; C = (st & 1) * 32 + (swz % 64) / 2; }
__host__ __device__ __forceinline__ int perm32(int rho) { const int n = rho >> 4, i = rho & 15; return 8 * (i >> 2) + 4 * n + (i & 3); }

struct Unit { int pm, pn; };
struct Gemm { const bf16_t* A; const bf16_t* Bt; int M, N, K, lda, ldb; };
__host__ __device__ __forceinline__ Gemm mkgemm(const bf16_t* A, const bf16_t* Bt, int M, int N, int K) { Gemm g; g.A = A; g.Bt = Bt; g.M = M; g.N = N; g.K = K; g.lda = K; g.ldb = K; return g; }

struct StaticOrder {
    int nM, nN, nwg, G, c;
    __host__ __device__ void init(int M, int N, int G_, int c_) { nM = M / BM; nN = N / BM; nwg = nM * nN; G = G_; c = c_; }
    __host__ __device__ bool next(int i, Unit& u) const {
        const long L = (long)i * G + c; if (L >= nwg) return false;
        int wgid = (int)L; { const int q = nwg / NXCD, r = nwg % NXCD, xcd = wgid % NXCD, off = wgid / NXCD; wgid = (xcd < r ? xcd * (q + 1) : r * (q + 1) + (xcd - r) * q) + off; }
        const int nig = WGM * nN, gid = wgid / nig, fm = gid * WGM, gsz = (nM - fm) < WGM ? (nM - fm) : WGM;
        u.pm = fm + ((wgid % nig) % gsz); u.pn = (wgid % nig) / gsz; return true;
    }
    __device__ __forceinline__ void a_ready(const Unit&) const {}
    __device__ __forceinline__ void done(const Unit&) const {}
};
struct RangeOrder { StaticOrder S; int i0, i1;
    __host__ __device__ bool next(int i, Unit& u) const { return (i + i0 < i1) ? S.next(i + i0, u) : false; }
    __device__ __forceinline__ void a_ready(const Unit&) const {}
    __device__ __forceinline__ void done(const Unit&) const {} };


__device__ __forceinline__ unsigned cvt_pk_bf16(float lo, float hi) { unsigned r; asm volatile("v_cvt_pk_bf16_f32 %0, %1, %2" : "=v"(r) : "v"(lo), "v"(hi)); return r; }
__device__ __forceinline__ float sigm(float x) { return __builtin_amdgcn_rcpf(1.0f + __builtin_amdgcn_exp2f(-1.4426950408889634f * x)); }

typedef unsigned long long rs_t;
constexpr float RS_FIX = 16777216.0f, RS_INV = 1.0f / (16777216.0f * 4096.0f), RS_EPS = 1e-6f;
__device__ __forceinline__ void row_ss_add(rs_t* rs, int row, float s, int fq) {
    s += __shfl_xor(s, 16); s += __shfl_xor(s, 32);
    if (fq == 0) __hip_atomic_fetch_add(rs + row, (rs_t)(s * RS_FIX), __ATOMIC_RELAXED, __HIP_MEMORY_SCOPE_AGENT);
}
__device__ __forceinline__ float rs_rinv(rs_t v) { return __builtin_amdgcn_rsqf((float)v * RS_INV + RS_EPS); }
#define PIN8(a) asm volatile("" : "+v"((a)[0]), "+v"((a)[1]), "+v"((a)[2]), "+v"((a)[3]), "+v"((a)[4]), "+v"((a)[5]), "+v"((a)[6]), "+v"((a)[7]))
template <int ACT> struct EpiBf16 {
    static constexpr bool PERM = true, AFTER_DRAIN = false;
    bf16_t *O0, *O1, *O2; int ld0, ld1, ld2, c1, c2; const rs_t* rs; int vt; int rs_from;
    __device__ __forceinline__ void operator()(const f32x4 (&acc)[2][2][4][2], const Unit& u, int wr, int wc, int fr, int fq) const {
        const int row0 = u.pm * BM + wr * 64 + fr; int colt = u.pn * BM; bf16_t* base = O0; int ldc = ld0;
        const rs_t* rs = (colt >= rs_from) ? this->rs : nullptr;
        bool tr = false;
        if (colt >= c2) { base = O2; ldc = ld2; colt -= c2; tr = vt != 0; } else if (colt >= c1) { base = O1; ldc = ld1; colt -= c1; }
        const int col0 = colt + wc * 32 + 8 * fq;
        rs_t scv[8];
#pragma unroll
        for (int gi = 0; gi < 8; ++gi) scv[gi] = rs ? rs[row0 + (gi >> 2) * HALF + (gi & 3) * 16] : 0ull;
        PIN8(scv);
#pragma unroll
        for (int ai = 0; ai < 2; ++ai)
#pragma unroll
            for (int m = 0; m < 4; ++m) { bf16_t* rowp = base + (size_t)(row0 + ai * HALF + m * 16) * ldc + col0; const float sc = rs ? rs_rinv(scv[ai * 4 + m]) : 1.0f;
#pragma unroll
                for (int bj = 0; bj < 2; ++bj) { f32x4 v0 = acc[ai][bj][m][0] * sc, v1 = acc[ai][bj][m][1] * sc;
                    if (ACT == 2) {
#pragma unroll
                        for (int j = 0; j < 4; ++j) { const float a = fmaxf(v0[j], 0.f), b = fmaxf(v1[j], 0.f); v0[j] = a * a; v1[j] = b * b; } }
                    u32x4 w; w.x = cvt_pk_bf16(v0[0], v0[1]); w.y = cvt_pk_bf16(v0[2], v0[3]); w.z = cvt_pk_bf16(v1[0], v1[1]); w.w = cvt_pk_bf16(v1[2], v1[3]);
                    if (vt == 2 && tr) {
                        unsigned char* tp = (unsigned char*)base + (size_t)(col0 + bj * HALF) * ldc + (row0 + ai * HALF + m * 16);
                        int w0 = __builtin_amdgcn_cvt_pk_fp8_f32(v0[0], v0[1], 0, false); w0 = __builtin_amdgcn_cvt_pk_fp8_f32(v0[2], v0[3], w0, true);
                        int w1 = __builtin_amdgcn_cvt_pk_fp8_f32(v1[0], v1[1], 0, false); w1 = __builtin_amdgcn_cvt_pk_fp8_f32(v1[2], v1[3], w1, true);
                        tp[0] = (unsigned char)w0; tp[(size_t)ldc] = (unsigned char)(w0 >> 8); tp[(size_t)2 * ldc] = (unsigned char)(w0 >> 16); tp[(size_t)3 * ldc] = (unsigned char)(w0 >> 24);
                        tp[(size_t)4 * ldc] = (unsigned char)w1; tp[(size_t)5 * ldc] = (unsigned char)(w1 >> 8); tp[(size_t)6 * ldc] = (unsigned char)(w1 >> 16); tp[(size_t)7 * ldc] = (unsigned char)(w1 >> 24); }
                    else if (tr) { bf16_t* tp = base + (size_t)(col0 + bj * HALF) * ldc + (row0 + ai * HALF + m * 16);
                        tp[0] = (bf16_t)w.x; tp[(size_t)ldc] = (bf16_t)(w.x >> 16); tp[(size_t)2 * ldc] = (bf16_t)w.y; tp[(size_t)3 * ldc] = (bf16_t)(w.y >> 16);
                        tp[(size_t)4 * ldc] = (bf16_t)w.z; tp[(size_t)5 * ldc] = (bf16_t)(w.z >> 16); tp[(size_t)6 * ldc] = (bf16_t)w.w; tp[(size_t)7 * ldc] = (bf16_t)(w.w >> 16); }
                    else *(u32x4*)(rowp + bj * HALF) = w; } }
    }
};
struct EpiF32 {
    static constexpr bool PERM = false, AFTER_DRAIN = false;
    float* C; int ldc;
    __device__ __forceinline__ void operator()(const f32x4 (&acc)[2][2][4][2], const Unit& u, int wr, int wc, int fr, int fq) const {
        const int row0 = u.pm * BM + wr * 64 + fr, col0 = u.pn * BM + wc * 32 + 4 * fq;
#pragma unroll
        for (int ai = 0; ai < 2; ++ai)
#pragma unroll
            for (int m = 0; m < 4; ++m) { float* rowp = C + (size_t)(row0 + ai * HALF + m * 16) * ldc + col0;
#pragma unroll
                for (int bj = 0; bj < 2; ++bj)
#pragma unroll
                    for (int n = 0; n < 2; ++n) *(f32x4*)(rowp + bj * HALF + n * 16) = acc[ai][bj][m][n]; }
    }
};
typedef unsigned u32x2 __attribute__((ext_vector_type(2)));
__device__ __forceinline__ f32x4 bf4_to_f32(u32x2 p) { return (f32x4){__builtin_bit_cast(float, p.x << 16), __builtin_bit_cast(float, p.x & 0xffff0000u), __builtin_bit_cast(float, p.y << 16), __builtin_bit_cast(float, p.y & 0xffff0000u)}; }
struct EpiRes {
    static constexpr bool PERM = false, AFTER_DRAIN = false;
    const bf16_t* base; bf16_t* out; rs_t* rs; int ldc; const rs_t* rsq;
    __device__ __forceinline__ void operator()(const f32x4 (&acc)[2][2][4][2], const Unit& u, int wr, int wc, int fr, int fq) const {
        constexpr int PD = 3;
        const int row0 = u.pm * BM + wr * 64 + fr, col0 = u.pn * BM + wc * 32 + 4 * fq;
        u32x2 nb[8][2][2];
        rs_t scv[8];
#pragma unroll
        for (int gi = 0; gi < 8; ++gi) scv[gi] = rsq ? rsq[row0 + (gi >> 2) * HALF + (gi & 3) * 16] : 0ull;
#define EPI_LD(g) do { const size_t o_ = (size_t)(row0 + ((g) >> 2) * HALF + ((g) & 3) * 16) * ldc + col0; _Pragma("unroll") for (int bj = 0; bj < 2; ++bj) _Pragma("unroll") for (int n = 0; n < 2; ++n) nb[g][bj][n] = *(const u32x2*)(base + o_ + bj * HALF + n * 16); } while (0)
#pragma unroll
        for (int g = 0; g < PD; ++g) EPI_LD(g);
        PIN8(scv);
#pragma unroll
        for (int gi = 0; gi < 8; ++gi) { const int ai = gi >> 2, m = gi & 3; const int row = row0 + ai * HALF + m * 16; const size_t off = (size_t)row * ldc + col0;
            if (gi + PD < 8) EPI_LD(gi + PD);
            const float sc2 = rsq ? __builtin_amdgcn_rcpf((float)scv[gi] * RS_INV + RS_EPS) : 1.0f;
            float ss = 0.f;
#pragma unroll
            for (int bj = 0; bj < 2; ++bj)
#pragma unroll
                for (int n = 0; n < 2; ++n) { const f32x4 o = bf4_to_f32(nb[gi][bj][n]) + acc[ai][bj][m][n] * sc2;
                    ss += (o[0] * o[0] + o[1] * o[1]) + (o[2] * o[2] + o[3] * o[3]);
                    u32x2 w; w.x = cvt_pk_bf16(o[0], o[1]); w.y = cvt_pk_bf16(o[2], o[3]); *(u32x2*)(out + off + bj * HALF + n * 16) = w; }
            row_ss_add(rs, row, ss, fq); }
#undef EPI_LD
    }
};
struct EpiGate {
    static constexpr bool PERM = false, AFTER_DRAIN = false;
    const bf16_t* base; bf16_t* out; float* out32; const bf16_t* pp; const rs_t* rsin; rs_t* rs; int ldc;
    __device__ __forceinline__ void operator()(const f32x4 (&acc)[2][2][4][2], const Unit& u, int wr, int wc, int fr, int fq) const {
        constexpr int PD = 2;
        const int row0 = u.pm * BM + wr * 64 + fr, col0 = u.pn * BM + wc * 32 + 4 * fq;
        rs_t scv[8];
#pragma unroll
        for (int gi = 0; gi < 8; ++gi) scv[gi] = rsin[row0 + (gi >> 2) * HALF + (gi & 3) * 16];
        u32x2 nb[8][2][2], np[8][2][2];
#define EPI_LD(g) do { const size_t o_ = (size_t)(row0 + ((g) >> 2) * HALF + ((g) & 3) * 16) * ldc + col0; _Pragma("unroll") for (int bj = 0; bj < 2; ++bj) _Pragma("unroll") for (int n = 0; n < 2; ++n) { \
            nb[g][bj][n] = *(const u32x2*)(base + o_ + bj * HALF + n * 16); np[g][bj][n] = *(const u32x2*)(pp + o_ + bj * HALF + n * 16); } } while (0)
#pragma unroll
        for (int g = 0; g < PD; ++g) EPI_LD(g);
        PIN8(scv);
#pragma unroll
        for (int gi = 0; gi < 8; ++gi) { const int ai = gi >> 2, m = gi & 3; const int row = row0 + ai * HALF + m * 16; const size_t off = (size_t)row * ldc + col0;
            if (gi + PD < 8) EPI_LD(gi + PD);
            const float sc = rs_rinv(scv[gi]);
            float ss = 0.f;
#pragma unroll
            for (int bj = 0; bj < 2; ++bj)
#pragma unroll
                for (int n = 0; n < 2; ++n) { const f32x4 a = acc[ai][bj][m][n] * sc, p = bf4_to_f32(np[gi][bj][n]); f32x4 o = bf4_to_f32(nb[gi][bj][n]);
#pragma unroll
                    for (int j = 0; j < 4; ++j) o[j] += sigm(a[j]) * p[j];
                    if (out32) *(f32x4*)(out32 + off + bj * HALF + n * 16) = o;
                    ss += (o[0] * o[0] + o[1] * o[1]) + (o[2] * o[2] + o[3] * o[3]);
                    u32x2 w; w.x = cvt_pk_bf16(o[0], o[1]); w.y = cvt_pk_bf16(o[2], o[3]); *(u32x2*)(out + off + bj * HALF + n * 16) = w; }
            row_ss_add(rs, row, ss, fq); }
#undef EPI_LD
    }
};
struct EpiGlu {
    static constexpr bool PERM = false, AFTER_DRAIN = false;
    const bf16_t* base; bf16_t* out; rs_t* rs; int ldc;
    __device__ __forceinline__ void operator()(const f32x4 (&acc)[2][2][4][2], const Unit& u, int wr, int wc, int fr, int fq) const {
        constexpr int PD = 3;
        const int row0 = u.pm * BM + wr * 64 + fr, col0 = u.pn * HALF + wc * 32 + 4 * fq;
        u32x2 nb[8][2];
#define EPI_LD(g) do { const size_t o_ = (size_t)(row0 + ((g) >> 2) * HALF + ((g) & 3) * 16) * ldc + col0; _Pragma("unroll") for (int n = 0; n < 2; ++n) nb[g][n] = *(const u32x2*)(base + o_ + n * 16); } while (0)
#pragma unroll
        for (int g = 0; g < PD; ++g) EPI_LD(g);
#pragma unroll
        for (int gi = 0; gi < 8; ++gi) { const int ai = gi >> 2, m = gi & 3; const int row = row0 + ai * HALF + m * 16; const size_t off = (size_t)row * ldc + col0;
            if (gi + PD < 8) EPI_LD(gi + PD);
            float ss = 0.f;
#pragma unroll
            for (int n = 0; n < 2; ++n) { const f32x4 a = acc[ai][0][m][n], g = acc[ai][1][m][n]; f32x4 o = bf4_to_f32(nb[gi][n]);
#pragma unroll
                for (int j = 0; j < 4; ++j) o[j] += a[j] * sigm(g[j]);
                ss += (o[0] * o[0] + o[1] * o[1]) + (o[2] * o[2] + o[3] * o[3]);
                u32x2 w; w.x = cvt_pk_bf16(o[0], o[1]); w.y = cvt_pk_bf16(o[2], o[3]); *(u32x2*)(out + off + n * 16) = w; }
            row_ss_add(rs, row, ss, fq); }
#undef EPI_LD
    }
};

constexpr int S5T = 32, S5NCH = 512, S5KS = 768;
struct S5Order {
    int G, c, MT, NT;
    __device__ __forceinline__ bool next(int i, Unit& u) const { const int idx = i * G + c; if (idx >= 256 * MT * NT) return false; const int g = idx & 255, sub = idx >> 8;
        u.pm = g * MT + sub / NT; u.pn = g * NT + sub % NT; return true; }
    __device__ __forceinline__ void a_ready(const Unit&) const {}
    __device__ __forceinline__ void done(const Unit&) const {}
};
struct EpiS5U {
    static constexpr bool PERM = true, AFTER_DRAIN = false;
    bf16_t* UA; const rs_t* rs;
    __device__ __forceinline__ void operator()(const f32x4 (&acc)[2][2][4][2], const Unit& u, int wr, int wc, int fr, int fq) const {
        const int row0 = u.pm * BM + wr * 64 + fr, col0 = u.pn * BM + wc * 32 + 8 * fq;
        rs_t scv[8];
#pragma unroll
        for (int gi = 0; gi < 8; ++gi) scv[gi] = rs[row0 + (gi >> 2) * HALF + (gi & 3) * 16];
        PIN8(scv);
#pragma unroll
        for (int ai = 0; ai < 2; ++ai)
#pragma unroll
            for (int m = 0; m < 4; ++m) { const int t = row0 + ai * HALF + m * 16, c = t >> 5, sg = t & 31; const float sc = rs_rinv(scv[ai * 4 + m]);
#pragma unroll
                for (int bj = 0; bj < 2; ++bj) { const int col = col0 + bj * HALF, g = col >> 4, q0 = col & 15;
                    const f32x4 v0 = acc[ai][bj][m][0] * sc, v1 = acc[ai][bj][m][1] * sc;
                    u32x4 w; w.x = cvt_pk_bf16(v0[0], v0[1]); w.y = cvt_pk_bf16(v0[2], v0[3]); w.z = cvt_pk_bf16(v1[0], v1[1]); w.w = cvt_pk_bf16(v1[2], v1[3]);
                    *(u32x4*)(UA + ((size_t)(g * S5NCH + c) * S5KS + sg * 16 + q0)) = w; } }
    }
};
struct EpiS5E {
    static constexpr bool PERM = false, AFTER_DRAIN = false;
    float* E;
    __device__ __forceinline__ void operator()(const f32x4 (&acc)[2][2][4][2], const Unit& u, int wr, int wc, int fr, int fq) const {
        const int row0 = u.pm * BM + wr * 64 + fr, col0 = wc * 32 + 4 * fq;
#pragma unroll
        for (int ai = 0; ai < 2; ++ai)
#pragma unroll
            for (int m = 0; m < 4; ++m) { float* rowp = E + (size_t)(row0 + ai * HALF + m * 16) * 256 + col0;
#pragma unroll
                for (int bj = 0; bj < 2; ++bj)
#pragma unroll
                    for (int n = 0; n < 2; ++n) *(f32x4*)(rowp + bj * HALF + n * 16) = acc[ai][bj][m][n]; }
    }
};
__device__ __forceinline__ float gelu_tanh_f(float v) {
    const float z = 0.7978845608028654f * (v + 0.044715f * v * v * v);
    const float e = __builtin_amdgcn_exp2f(2.0f * 1.4426950408889634f * z);
    return 0.5f * v * (2.0f - 2.0f * __builtin_amdgcn_rcpf(e + 1.0f));
}
struct EpiS5Y {
    static constexpr bool PERM = true, AFTER_DRAIN = false;
    const bf16_t* UA; const float* dskip; bf16_t* G; int ldg;
    __device__ __forceinline__ void operator()(const f32x4 (&acc)[2][2][4][2], const Unit& u, int wr, int wc, int fr, int fq) const {
        const int row0 = u.pm * BM + wr * 64 + fr, col0 = (u.pn & 1) * BM + wc * 32 + 8 * fq;
        const int g = u.pm >> 1, p0 = col0 & 15;
        const f32x4 d0 = *(const f32x4*)(dskip + 16 * g + p0), d1 = *(const f32x4*)(dskip + 16 * g + p0 + 4);
        u32x4 uu[8][2];
#pragma unroll
        for (int gi = 0; gi < 8; ++gi)
#pragma unroll
            for (int bj = 0; bj < 2; ++bj) uu[gi][bj] = *(const u32x4*)(UA + ((size_t)(row0 + (gi >> 2) * HALF + (gi & 3) * 16) * S5KS + col0 + bj * HALF));
#pragma unroll
        for (int gi = 0; gi < 8; ++gi) asm volatile("" : "+v"(uu[gi][0]), "+v"(uu[gi][1]));
#pragma unroll
        for (int gi = 0; gi < 8; ++gi) { const int ai = gi >> 2, m = gi & 3; const int rowg = row0 + ai * HALF + m * 16, c = rowg & 511;
#pragma unroll
            for (int bj = 0; bj < 2; ++bj) { const int col = col0 + bj * HALF, tau = col >> 4; const u32x4 w4 = uu[gi][bj];
                f32x4 v0 = acc[ai][bj][m][0], v1 = acc[ai][bj][m][1];
                v0[0] += d0[0] * __builtin_bit_cast(float, w4.x << 16); v0[1] += d0[1] * __builtin_bit_cast(float, w4.x & 0xffff0000u);
                v0[2] += d0[2] * __builtin_bit_cast(float, w4.y << 16); v0[3] += d0[3] * __builtin_bit_cast(float, w4.y & 0xffff0000u);
                v1[0] += d1[0] * __builtin_bit_cast(float, w4.z << 16); v1[1] += d1[1] * __builtin_bit_cast(float, w4.z & 0xffff0000u);
                v1[2] += d1[2] * __builtin_bit_cast(float, w4.w << 16); v1[3] += d1[3] * __builtin_bit_cast(float, w4.w & 0xffff0000u);
#pragma unroll
                for (int j = 0; j < 4; ++j) { v0[j] = gelu_tanh_f(v0[j]); v1[j] = gelu_tanh_f(v1[j]); }
                u32x4 w; w.x = cvt_pk_bf16(v0[0], v0[1]); w.y = cvt_pk_bf16(v0[2], v0[3]); w.z = cvt_pk_bf16(v1[0], v1[1]); w.w = cvt_pk_bf16(v1[2], v1[3]);
                *(u32x4*)(G + (size_t)(32 * c + tau) * ldg + 16 * g + p0) = w; } }
    }
};

template <class Epi, class Sched, bool ALIGN_EPI = false, bool SP2 = false>
__device__ __forceinline__ void gemm_phase(PG8_LAS unsigned char* lds, const Gemm g, const Sched& S, const Epi& E) {
    int tid_o = threadIdx.x; asm volatile("" : "+v"(tid_o)); const int tid = tid_o, wid = __builtin_amdgcn_readfirstlane(tid >> 6), lane = tid & 63, wr = wid >> 2, wc = wid & 3, fr = lane & 15, fq = lane >> 4;
    const int K = g.K, nt = K / BK;
    unsigned voffA[2], voffB[2];
#pragma unroll
    for (int i = 0; i < 2; ++i) { int R, C; stage_rc(tid * 16 + i * 8192, R, C); const int Rb = Epi::PERM ? ((R & ~31) + perm32(R & 31)) : R;
        voffA[i] = (unsigned)(R * g.lda + C) * 2u; voffB[i] = (unsigned)(Rb * g.ldb + C) * 2u; }
    const size_t kstep = (size_t)(BK * 2);
    const size_t hstepA = (size_t)HALF * g.lda * 2, hstepB = (size_t)HALF * g.ldb * 2;
    const size_t tstepA = 2 * hstepA, tstepB = 2 * hstepB;
    const unsigned ldsw = (unsigned)wid * 1024u;
    const int aoff = lds_byte(wr * 64 + fr, fq * 8), boff = lds_byte(wc * 32 + fr, fq * 8);
#define PG8_SA(b, h) (((b) * 2 + (h)) * HTB)
#define PG8_SB(b, h) ((4 + (b) * 2 + (h)) * HTB)
#define PG8_STAGE(bufoff, gbase, voff) do { _Pragma("unroll") for (int _i = 0; _i < 2; ++_i) \
        __builtin_amdgcn_global_load_lds((const unsigned*)((const char*)(gbase) + (voff)[_i]), (PG8_LAS unsigned*)(lds + (bufoff) + ldsw + _i * 8192), 16, 0, 0); } while (0)
#define PG8_LDA(dst, b, h) do { _Pragma("unroll") for (int m = 0; m < 4; ++m) _Pragma("unroll") for (int k = 0; k < 2; ++k) dst[m][k] = *(const PG8_LAS bf16x8*)(lds + PG8_SA(b, h) + aoff + m * 2048 + k * 1024); } while (0)
#define PG8_LDB(dst, b, h) do { _Pragma("unroll") for (int n = 0; n < 2; ++n) _Pragma("unroll") for (int k = 0; k < 2; ++k) dst[n][k] = *(const PG8_LAS bf16x8*)(lds + PG8_SB(b, h) + boff + n * 2048 + k * 1024); } while (0)
#define PG8_MMA(ai, bj, At, Bt) do { __builtin_amdgcn_s_setprio(1); _Pragma("unroll") for (int m = 0; m < 4; ++m) _Pragma("unroll") for (int n = 0; n < 2; ++n) _Pragma("unroll") for (int k = 0; k < 2; ++k) \
        acc[ai][bj][m][n] = __builtin_amdgcn_mfma_f32_16x16x32_bf16(Bt[n][k], At[m][k], acc[ai][bj][m][n], 0, 0, 0); __builtin_amdgcn_s_setprio(0); } while (0)
#define PG8_WAIT_V(n) asm volatile("s_waitcnt vmcnt(" #n ")" ::: "memory")
#define PG8_WAIT_L(n) asm volatile("s_waitcnt lgkmcnt(" #n ")" ::: "memory")
#define PG8_BAR __builtin_amdgcn_s_barrier()
#define PG8_SCHED __builtin_amdgcn_sched_barrier(0)
    Unit cur, nxt; int ui = 0;
    if (!S.next(0, cur)) return;
    f32x4 acc[2][2][4][2];
#pragma unroll
    for (int a = 0; a < 2; ++a)
#pragma unroll
        for (int b = 0; b < 2; ++b)
#pragma unroll
            for (int m = 0; m < 4; ++m)
#pragma unroll
                for (int n = 0; n < 2; ++n) acc[a][b][m][n] = (f32x4){0.f, 0.f, 0.f, 0.f};
    bf16x8 At[4][2], B0[2][2], B1[2][2];
    const char* cA = (const char*)g.A + (size_t)cur.pm * tstepA; const char* cB = (const char*)g.Bt + (size_t)cur.pn * tstepB;
    S.a_ready(cur);
    if constexpr (SP2) {
        PG8_STAGE(PG8_SB(0, 0), cB, voffB); PG8_STAGE(PG8_SB(0, 1), cB + hstepB, voffB); PG8_STAGE(PG8_SA(0, 0), cA, voffA); PG8_STAGE(PG8_SA(0, 1), cA + hstepA, voffA);
        if (wr == 1) PG8_BAR;
        PG8_WAIT_V(2); PG8_BAR;
        PG8_STAGE(PG8_SB(1, 0), cB + kstep, voffB); PG8_STAGE(PG8_SA(1, 0), cA + kstep, voffA); PG8_STAGE(PG8_SB(1, 1), cB + hstepB + kstep, voffB);
        PG8_WAIT_V(6); PG8_BAR;
    } else {
        PG8_STAGE(PG8_SB(0, 0), cB, voffB); PG8_STAGE(PG8_SA(0, 0), cA, voffA); PG8_STAGE(PG8_SB(0, 1), cB + hstepB, voffB); PG8_STAGE(PG8_SA(0, 1), cA + hstepA, voffA);
        if (wr == 1) PG8_BAR;
        PG8_WAIT_V(4); PG8_BAR;
        PG8_STAGE(PG8_SB(1, 0), cB + kstep, voffB); PG8_STAGE(PG8_SA(1, 0), cA + kstep, voffA); PG8_STAGE(PG8_SB(1, 1), cB + hstepB + kstep, voffB);
        PG8_WAIT_V(6); PG8_BAR;
    }
    for (;;) {
        const bool has_next = S.next(ui + 1, nxt);
        const char* nA = has_next ? (const char*)g.A + (size_t)nxt.pm * tstepA : cA; const char* nB = has_next ? (const char*)g.Bt + (size_t)nxt.pn * tstepB : cB;
        for (int t = 0; t < nt; t += 2) {
            const bool last = (t == nt - 2);
            const char* a1 = cA + (size_t)(t + 1) * kstep;
            const char* a2 = last ? nA : cA + (size_t)(t + 2) * kstep; const char* b2 = last ? nB : cB + (size_t)(t + 2) * kstep;
            const char* a3 = a2 + kstep; const char* b3 = b2 + kstep;
            if (last && has_next) S.a_ready(nxt);
            if constexpr (SP2) {
            PG8_LDB(B0, 0, 0); PG8_LDB(B1, 0, 1); PG8_SCHED; PG8_LDA(At, 0, 0); PG8_STAGE(PG8_SA(1, 1), a1 + hstepA, voffA);
            PG8_WAIT_V(8); PG8_WAIT_L(0); PG8_BAR; PG8_MMA(0, 0, At, B0); PG8_MMA(0, 1, At, B1); PG8_BAR; PG8_SCHED;
            PG8_LDA(At, 0, 1); PG8_STAGE(PG8_SB(0, 0), b2, voffB); PG8_STAGE(PG8_SB(0, 1), b2 + hstepB, voffB); PG8_STAGE(PG8_SA(0, 0), a2, voffA);
            PG8_WAIT_V(8); PG8_WAIT_L(0); PG8_BAR; PG8_MMA(1, 0, At, B0); PG8_MMA(1, 1, At, B1); PG8_BAR; PG8_SCHED;
            PG8_LDB(B0, 1, 0); PG8_LDB(B1, 1, 1); PG8_SCHED; PG8_LDA(At, 1, 0); PG8_STAGE(PG8_SA(0, 1), a2 + hstepA, voffA);
            PG8_WAIT_V(8); PG8_WAIT_L(0); PG8_BAR; PG8_MMA(0, 0, At, B0); PG8_MMA(0, 1, At, B1); PG8_BAR; PG8_SCHED;
            PG8_LDA(At, 1, 1); PG8_STAGE(PG8_SB(1, 0), b3, voffB); PG8_STAGE(PG8_SB(1, 1), b3 + hstepB, voffB); PG8_STAGE(PG8_SA(1, 0), a3, voffA);
            PG8_WAIT_V(8); PG8_WAIT_L(0); PG8_BAR; PG8_MMA(1, 0, At, B0); PG8_MMA(1, 1, At, B1); PG8_BAR; PG8_SCHED;
            } else {
            PG8_LDB(B0, 0, 0); PG8_SCHED; PG8_LDA(At, 0, 0); PG8_STAGE(PG8_SA(1, 1), a1 + hstepA, voffA);
            PG8_WAIT_L(8); PG8_BAR; PG8_WAIT_L(0); PG8_MMA(0, 0, At, B0); PG8_BAR; PG8_SCHED;
            PG8_LDB(B1, 0, 1); PG8_STAGE(PG8_SB(0, 0), b2, voffB);
            PG8_BAR; PG8_WAIT_L(0); PG8_MMA(0, 1, At, B1); PG8_BAR;
            PG8_LDA(At, 0, 1); PG8_STAGE(PG8_SA(0, 0), a2, voffA);
            PG8_BAR; PG8_WAIT_L(0); PG8_MMA(1, 0, At, B0); PG8_BAR; PG8_SCHED;
            PG8_STAGE(PG8_SB(0, 1), b2 + hstepB, voffB);
            PG8_WAIT_V(6); PG8_BAR; PG8_MMA(1, 1, At, B1); PG8_BAR;
            PG8_LDB(B0, 1, 0); PG8_SCHED; PG8_LDA(At, 1, 0); PG8_STAGE(PG8_SA(0, 1), a2 + hstepA, voffA);
            PG8_WAIT_L(8); PG8_BAR; PG8_WAIT_L(0); PG8_MMA(0, 0, At, B0); PG8_BAR; PG8_SCHED;
            PG8_LDB(B1, 1, 1); PG8_STAGE(PG8_SB(1, 0), b3, voffB);
            PG8_BAR; PG8_WAIT_L(0); PG8_MMA(0, 1, At, B1); PG8_BAR;
            PG8_LDA(At, 1, 1); PG8_STAGE(PG8_SA(1, 0), a3, voffA);
            PG8_BAR; PG8_WAIT_L(0); PG8_MMA(1, 0, At, B0); PG8_BAR; PG8_SCHED;
            PG8_STAGE(PG8_SB(1, 1), b3 + hstepB, voffB);
            PG8_WAIT_V(6); PG8_BAR; PG8_MMA(1, 1, At, B1); PG8_BAR;
            }
        }
        if constexpr (ALIGN_EPI) { if (wr == 0) PG8_BAR; }
        if constexpr (!Epi::AFTER_DRAIN) { E(acc, cur, wr, wc, fr, fq); PROBE_EPI_DUP S.done(cur); }
        if (!has_next) break;
#pragma unroll
        for (int a = 0; a < 2; ++a)
#pragma unroll
            for (int b = 0; b < 2; ++b)
#pragma unroll
                for (int m = 0; m < 4; ++m)
#pragma unroll
                    for (int n = 0; n < 2; ++n) acc[a][b][m][n] = (f32x4){0.f, 0.f, 0.f, 0.f};
        cur = nxt; cA = nA; cB = nB; ++ui;
        if constexpr (ALIGN_EPI) { if (wr == 1) PG8_BAR; }
    }
    PG8_WAIT_V(0);
    if constexpr (!ALIGN_EPI) { if (wr == 0) PG8_BAR; }
    PG8_BAR;
    if constexpr (Epi::AFTER_DRAIN) { E.fused(acc, cur, wr, wc, fr, fq, lds, wid, lane); S.done(cur); }
#undef PG8_SA
#undef PG8_SB
#undef PG8_STAGE
#undef PG8_LDA
#undef PG8_LDB
#undef PG8_MMA
#undef PG8_WAIT_V
#undef PG8_WAIT_L
#undef PG8_BAR
#undef PG8_SCHED
}
}
#define XB_TMO      128
#define XB_XCNT(j)  (256  + 64 * (j))
#define XB_XSUB(j)  (1280 + 64 * (j))
#define XB_XGEN(j)  (2304 + 64 * (j))
#define XB_TOP      3328
#define XB_TOPGEN   3392
#define XCD_BAR_WORDS 3456
#define XB_SPIN_CAP (1u << 18)

__device__ __forceinline__ unsigned xb_ld(unsigned* p)              { return __hip_atomic_load(p, __ATOMIC_RELAXED, __HIP_MEMORY_SCOPE_AGENT); }
__device__ __forceinline__ unsigned xb_add(unsigned* p, unsigned v) { return __hip_atomic_fetch_add(p, v, __ATOMIC_RELAXED, __HIP_MEMORY_SCOPE_AGENT); }
__device__ __forceinline__ unsigned xb_xcc_id() { return (unsigned)__builtin_amdgcn_s_getreg((3 << 11) | 20) & 0xFu; }
#define XB_SPIN(cond, bar) do { unsigned _sp = 0; while (cond) { __builtin_amdgcn_s_sleep(1); \
    if ((++_sp & 255u) == 0u) { if (xb_ld(&(bar)[XB_TMO])) break; if (_sp > XB_SPIN_CAP) { atomicAdd(&(bar)[XB_TMO], 1u); break; } } } } while (0)

struct XcdBarrier {
    unsigned* bar; unsigned x;
    volatile LAS unsigned* st;
};

__device__ __forceinline__ XcdBarrier xcd_barrier_post(unsigned* bar, volatile LAS unsigned* st) {
    XcdBarrier b; b.bar = bar; b.x = xb_xcc_id(); b.st = st;
    if (threadIdx.x == 0) (void)xb_add(&bar[XB_XCNT(b.x)], 1u);
    return b;
}
__device__ __forceinline__ void xcd_barrier_complete(unsigned* bar, unsigned x, unsigned& nloc, unsigned& nx) {
    const unsigned G = gridDim.x * gridDim.y * gridDim.z;
    unsigned sum, cnt, mine, sp = 0u;
    for (;;) {
        sum = 0u; cnt = 0u; mine = 0u;
#pragma unroll
        for (unsigned j = 0; j < 16; ++j) { const unsigned c = xb_ld(&bar[XB_XCNT(j)]); sum += c; cnt += (c > 0u) ? 1u : 0u; mine = (j == x) ? c : mine; }
        if (sum == G) break;
        __builtin_amdgcn_s_sleep(1);
        if ((++sp & 255u) == 0u) { if (xb_ld(&bar[XB_TMO])) break; if (sp > XB_SPIN_CAP) { atomicAdd(&bar[XB_TMO], 1u); break; } }
    }
    nloc = mine > 0u ? mine : 1u; nx = cnt > 0u ? cnt : 1u;
}

__device__ __forceinline__ void xcd_barrier(const XcdBarrier& b) {
    asm volatile("s_waitcnt vmcnt(0)" ::: "memory");
    __syncthreads();
    if (threadIdx.x == 0) {
        unsigned* bar = b.bar;
        __builtin_amdgcn_s_waitcnt(0);
        unsigned nloc = b.st[0], nx = b.st[1];
        if (nloc == 0u) { xcd_barrier_complete(bar, b.x, nloc, nx); b.st[0] = nloc; b.st[1] = nx; }
        const unsigned old = xb_add(&bar[XB_XSUB(b.x)], 1u);
        const unsigned gen = old / nloc;
        if (old + 1u == (gen + 1u) * nloc) {
            __builtin_amdgcn_fence(__ATOMIC_RELEASE, "agent");
            asm volatile("s_waitcnt vmcnt(0)" ::: "memory");
            const unsigned og = xb_add(&bar[XB_TOP], 1u);
            const unsigned tg = og / nx;
            if (og + 1u == (tg + 1u) * nx) xb_add(&bar[XB_TOPGEN], 1u);
            else XB_SPIN(xb_ld(&bar[XB_TOPGEN]) == tg, bar);
            __builtin_amdgcn_fence(__ATOMIC_ACQUIRE, "agent");
            xb_add(&bar[XB_XGEN(b.x)], 1u);
            asm volatile("s_waitcnt vmcnt(0)" ::: "memory");
        } else {
            XB_SPIN(xb_ld(&bar[XB_XGEN(b.x)]) == gen, bar);
            __builtin_amdgcn_fence(__ATOMIC_ACQUIRE, "agent");
            asm volatile("s_waitcnt vmcnt(0)" ::: "memory");
        }
    }
    __syncthreads();
}
namespace dattn {
typedef unsigned short bf16;
constexpr int   D = 128, NW = 8, QBLK = 32, KVBLK = 64;
constexpr float SCALE = 0.088388347648318440f;
constexpr float THR = 8.f;
constexpr int SDEPTH = 2;
constexpr int LDQ = 4096, LDK = 1024, LDO = 4096;
constexpr size_t SHM_V = KVBLK * D * 2, SHM_K = KVBLK * D * 2, SHM_ATTN = 3 * SHM_V + 3 * SHM_K + NW * 64 * 4 + 2048;
using bf16x8 = __attribute__((ext_vector_type(8))) short;
using s16x4  = __attribute__((ext_vector_type(4))) short;
using f32x16 = __attribute__((ext_vector_type(16))) float;
using f32x8  = __attribute__((ext_vector_type(8))) float;
using u32x4  = __attribute__((ext_vector_type(4))) unsigned;
#define KSWZ(row, colB) ((row) * 256 + ((colB) ^ (((row) & 7) << 4)))
#define SBAR() __builtin_amdgcn_sched_barrier(0)
__device__ __forceinline__ int crow(int r, int hi) { return (r & 3) + 8 * (r >> 2) + 4 * hi; }
__device__ __forceinline__ unsigned cvtpk(float lo, float hi) {
  unsigned r; asm volatile("v_cvt_pk_bf16_f32 %0, %1, %2" : "=v"(r) : "v"(lo), "v"(hi)); return r;
}
template <typename TIn> struct Stage;
template <> struct Stage<bf16>  { using T = bf16x8;
  __device__ static __forceinline__ T ld8(const bf16* p) { return *reinterpret_cast<const bf16x8*>(p); }
  __device__ static __forceinline__ bf16x8 tobf(T x) { return x; } };
template <> struct Stage<float> { using T = f32x8;
  __device__ static __forceinline__ T ld8(const float* p) { return *reinterpret_cast<const f32x8*>(p); }
  __device__ static __forceinline__ bf16x8 tobf(T x) {
    u32x4 w = {cvtpk(x[0], x[1]), cvtpk(x[2], x[3]), cvtpk(x[4], x[5]), cvtpk(x[6], x[7])}; return *reinterpret_cast<bf16x8*>(&w); } };

__device__ __forceinline__ void partialSM(f32x16& p0, f32x16& p1, float& m_reg, float& mn, float& alpha) {
  constexpr float C = SCALE * 1.4426950408889634f;
  float pmax = p0[0]; for (int r = 1; r < 16; ++r) pmax = fmaxf(pmax, p0[r]); for (int r = 0; r < 16; ++r) pmax = fmaxf(pmax, p1[r]);
  { auto rr = __builtin_amdgcn_permlane32_swap(__float_as_uint(pmax), __float_as_uint(pmax), false, false);
    pmax = fmaxf(__uint_as_float(rr[0]), __uint_as_float(rr[1])); }
  if (__builtin_expect(__all(pmax - m_reg <= THR / SCALE), 1)) { mn = m_reg; alpha = 1.f; }
  else { mn = fmaxf(m_reg, pmax); alpha = __builtin_amdgcn_exp2f((m_reg - mn) * C); m_reg = mn; }
  float mnC = -mn * C;
  for (int r = 0; r < 16; ++r) p0[r] = fmaf(p0[r], C, mnC); for (int r = 0; r < 16; ++r) p1[r] = fmaf(p1[r], C, mnC);
  for (int r = 0; r < 16; ++r) p0[r] = __builtin_amdgcn_exp2f(p0[r]);
}
__device__ __forceinline__ void finishSM(f32x16& p0, f32x16& p1, float alpha, float& l_reg, bf16x8& pa0, bf16x8& pa1, bf16x8& pa2, bf16x8& pa3) {
  for (int r = 0; r < 16; ++r) p1[r] = __builtin_amdgcn_exp2f(p1[r]);
  float ps = 0; for (int r = 0; r < 16; ++r) ps += p0[r]; for (int r = 0; r < 16; ++r) ps += p1[r];
  { auto rr = __builtin_amdgcn_permlane32_swap(__float_as_uint(ps), __float_as_uint(ps), false, false);
    ps = __uint_as_float(rr[0]) + __uint_as_float(rr[1]); }
  l_reg = l_reg * alpha + ps;
#define PK4(P, BASE, OUT) do { unsigned a0 = cvtpk(P[BASE + 0], P[BASE + 1]), a1 = cvtpk(P[BASE + 2], P[BASE + 3]);   \
    unsigned b0 = cvtpk(P[BASE + 4], P[BASE + 5]), b1 = cvtpk(P[BASE + 6], P[BASE + 7]);                              \
    auto r0 = __builtin_amdgcn_permlane32_swap(a0, b0, false, false); auto r1 = __builtin_amdgcn_permlane32_swap(a1, b1, false, false); \
    u32x4 w = {r0[0], r1[0], r0[1], r1[1]}; OUT = *reinterpret_cast<bf16x8*>(&w); } while (0)
  PK4(p0, 0, pa0); PK4(p0, 8, pa1); PK4(p1, 0, pa2); PK4(p1, 8, pa3);
#undef PK4
}
__device__ __forceinline__ void qkt(f32x16& p0, f32x16& p1, const bf16* Ks, const bf16x8* qr, int r32, int hi) {
  p0 = f32x16{}; p1 = f32x16{};
  bf16x8 nb0 = *reinterpret_cast<const bf16x8*>((const char*)Ks + KSWZ(r32, (hi * 8) * 2)), nb1 = *reinterpret_cast<const bf16x8*>((const char*)Ks + KSWZ(32 + r32, (hi * 8) * 2));
#pragma unroll
  for (int d0 = 0; d0 < 8; ++d0) { const bf16x8 b0 = nb0, b1 = nb1;
    if (d0 < 7) { const int cb = ((d0 + 1) * 16 + hi * 8) * 2;
      nb0 = *reinterpret_cast<const bf16x8*>((const char*)Ks + KSWZ(r32, cb)); nb1 = *reinterpret_cast<const bf16x8*>((const char*)Ks + KSWZ(32 + r32, cb)); }
    p0 = __builtin_amdgcn_mfma_f32_32x32x16_bf16(b0, qr[d0], p0, 0, 0, 0);
    p1 = __builtin_amdgcn_mfma_f32_32x32x16_bf16(b1, qr[d0], p1, 0, 0, 0); }
}
__device__ __forceinline__ int v_st(int k, int c) { const int kk = (k & ~0xC) | ((k & 4) << 1) | ((k & 8) >> 1); return ((kk >> 3) * 4 + (c >> 5)) * 512 + ((kk & 7) * 32 + (c & 31)) * 2; }
__device__ __forceinline__ int v_rd_base(int lane) { return ((lane & 3) << 3) | (((lane >> 2) & 3) << 6) | (((lane >> 4) & 1) << 5) | (((lane >> 5) & 1) << 8); }
constexpr int v_rd_off(int d0, int ks, int half) { return d0 * 512 + ks * 4096 + half * 2048; }
template <int OFF> __device__ __forceinline__ s16x4 tr_read(int vb) {
  s16x4 r; asm volatile("ds_read_b64_tr_b16 %0, %1 offset:%2" : "=&v"(r) : "v"(vb), "i"(OFF) : "memory"); return r;
}
template <int D0> __device__ __forceinline__ void pv_one(f32x16& od, int vb, bf16x8 pa0, bf16x8 pa1, bf16x8 pa2, bf16x8 pa3) {
  const s16x4 l0 = tr_read<v_rd_off(D0, 0, 0)>(vb), h0 = tr_read<v_rd_off(D0, 0, 1)>(vb), l1 = tr_read<v_rd_off(D0, 1, 0)>(vb), h1 = tr_read<v_rd_off(D0, 1, 1)>(vb);
  const s16x4 l2 = tr_read<v_rd_off(D0, 2, 0)>(vb), h2 = tr_read<v_rd_off(D0, 2, 1)>(vb), l3 = tr_read<v_rd_off(D0, 3, 0)>(vb), h3 = tr_read<v_rd_off(D0, 3, 1)>(vb);
  asm volatile("s_waitcnt lgkmcnt(0)" ::: "memory"); SBAR();
#define PK(L, H) (bf16x8){L[0], L[1], L[2], L[3], H[0], H[1], H[2], H[3]}
  od = __builtin_amdgcn_mfma_f32_32x32x16_bf16(pa0, PK(l0, h0), od, 0, 0, 0);
  od = __builtin_amdgcn_mfma_f32_32x32x16_bf16(pa1, PK(l1, h1), od, 0, 0, 0);
  od = __builtin_amdgcn_mfma_f32_32x32x16_bf16(pa2, PK(l2, h2), od, 0, 0, 0);
  od = __builtin_amdgcn_mfma_f32_32x32x16_bf16(pa3, PK(l3, h3), od, 0, 0, 0);
#undef PK
}
__device__ __forceinline__ void pv_d0(f32x16* o, int vb, bf16x8 pa0, bf16x8 pa1, bf16x8 pa2, bf16x8 pa3) {
  pv_one<0>(o[0], vb, pa0, pa1, pa2, pa3); pv_one<1>(o[1], vb, pa0, pa1, pa2, pa3); pv_one<2>(o[2], vb, pa0, pa1, pa2, pa3); pv_one<3>(o[3], vb, pa0, pa1, pa2, pa3);
}

template <typename TQ>
__device__ __forceinline__ void attn_dense_body(const TQ* __restrict__ Qb, const bf16* __restrict__ Kh, const bf16* __restrict__ Vh,
                                                bf16* __restrict__ Ob, int seq, char* lds) {
  using St = Stage<bf16>; using SQ = Stage<TQ>;
  int tid_o = threadIdx.x; asm volatile("" : "+v"(tid_o)); const int tid = tid_o, wid = __builtin_amdgcn_readfirstlane(tid >> 6), lane = tid & 63, r32 = lane & 31, hi = lane >> 5;
  bf16* V_lds = (bf16*)lds; bf16* K_lds = (bf16*)(lds + 3 * SHM_V);
  float* ws = (float*)(lds + 3 * SHM_V + 3 * SHM_K) + wid * 64; float* li_l = ws; float* al_l = ws + 32;
  float m_reg = -1e30f, l_reg = 0; f32x16 o[4] = {}; bf16x8 qr[8];
  const TQ* Qw = Qb + (long)(wid * QBLK + r32) * LDQ + hi * 8;
#pragma unroll
  for (int d0 = 0; d0 < 8; ++d0) qr[d0] = SQ::tobf(SQ::ld8(Qw + d0 * 16));
  const int sr = tid >> 4, sc = (tid & 15) * 8, vst0 = v_st(sr, sc), vst1 = v_st(32 + sr, sc);
  const int vb0 = (int)(uintptr_t)V_lds + v_rd_base(lane);
  struct { typename St::T vs0, vs1, ks0, ks1; } sr_[SDEPTH];
#define SLOAD(i, k0) do { sr_[i].vs0 = St::ld8(&Vh[(long)((k0) + sr) * LDK + sc]); sr_[i].vs1 = St::ld8(&Vh[(long)((k0) + 32 + sr) * LDK + sc]); \
    sr_[i].ks0 = St::ld8(&Kh[(long)((k0) + sr) * LDK + sc]); sr_[i].ks1 = St::ld8(&Kh[(long)((k0) + 32 + sr) * LDK + sc]); } while (0)
#define SWRITE(b, i) do { *(bf16x8*)((char*)V_lds + (b) * SHM_V + vst0) = St::tobf(sr_[i].vs0);          \
    *(bf16x8*)((char*)V_lds + (b) * SHM_V + vst1) = St::tobf(sr_[i].vs1); int kc = sc * 2;               \
    *(bf16x8*)((char*)K_lds + (b) * SHM_K + KSWZ(sr, kc)) = St::tobf(sr_[i].ks0);                       \
    *(bf16x8*)((char*)K_lds + (b) * SHM_K + KSWZ(32 + sr, kc)) = St::tobf(sr_[i].ks1); } while (0)
#define SWAIT() do { if constexpr (SDEPTH == 2) asm volatile("s_waitcnt vmcnt(4)" ::: "memory"); else asm volatile("s_waitcnt vmcnt(0)" ::: "memory"); } while (0)
#define RESC(a) do { if (__any((a) < 1.f)) { if (hi == 0) al_l[r32] = (a); asm volatile("s_waitcnt lgkmcnt(0)" ::: "memory"); \
    for (int d = 0; d < 4; ++d) for (int r = 0; r < 16; ++r) o[d][r] *= al_l[crow(r, hi)]; } } while (0)
  f32x16 pA0, pA1, pB0, pB1; float mnA, mnB, alA, alB; bf16x8 pa0, pa1, pa2, pa3; const int NT = seq / KVBLK;
  constexpr int SE = 0, SO = SDEPTH - 1;
  SLOAD(SE, 0); asm volatile("s_waitcnt vmcnt(0)" ::: "memory"); SWRITE(0, SE); __syncthreads();
  qkt(pA0, pA1, K_lds, qr, r32, hi); partialSM(pA0, pA1, m_reg, mnA, alA);
  SLOAD(SO, KVBLK); if constexpr (SDEPTH == 2) { if (2 < NT) SLOAD(SE, 2 * KVBLK); }
  SWAIT(); SWRITE(1, SO); __syncthreads();
  int bk = 1, bv = 0, bw = 2;
  if (wid >= 4) __builtin_amdgcn_s_setprio(1);
#define ROT3() do { const int t_ = bv; bv = bk; bk = bw; bw = t_; } while (0)
  for (int j = 1; j + 1 < NT; j += 2) {
    SBAR(); qkt(pB0, pB1, (bf16*)((char*)K_lds + bk * SHM_K), qr, r32, hi);
    finishSM(pA0, pA1, alA, l_reg, pa0, pa1, pa2, pa3); SBAR();
    SLOAD(SO, (j + SDEPTH) * KVBLK); SBAR();
    pv_d0(o, vb0 + bv * (int)SHM_V, pa0, pa1, pa2, pa3); partialSM(pB0, pB1, m_reg, mnB, alB);
    SWAIT(); SWRITE(bw, SE);
    RESC(alB); __syncthreads(); ROT3();
    SBAR(); qkt(pA0, pA1, (bf16*)((char*)K_lds + bk * SHM_K), qr, r32, hi);
    finishSM(pB0, pB1, alB, l_reg, pa0, pa1, pa2, pa3); SBAR();
    if (SDEPTH == 1 || j + 3 < NT) SLOAD(SE, (j + 1 + SDEPTH) * KVBLK); SBAR();
    pv_d0(o, vb0 + bv * (int)SHM_V, pa0, pa1, pa2, pa3); partialSM(pA0, pA1, m_reg, mnA, alA);
    SWAIT(); SWRITE(bw, SO);
    RESC(alA); __syncthreads(); ROT3();
  }
  SBAR(); qkt(pB0, pB1, (bf16*)((char*)K_lds + bk * SHM_K), qr, r32, hi);
  finishSM(pA0, pA1, alA, l_reg, pa0, pa1, pa2, pa3); SBAR();
  pv_d0(o, vb0 + bv * (int)SHM_V, pa0, pa1, pa2, pa3); partialSM(pB0, pB1, m_reg, mnB, alB);
  RESC(alB);
  finishSM(pB0, pB1, alB, l_reg, pa0, pa1, pa2, pa3); SBAR();
  pv_d0(o, vb0 + bk * (int)SHM_V, pa0, pa1, pa2, pa3);
#undef ROT3
  __builtin_amdgcn_s_setprio(0);
  if (hi == 0) li_l[r32] = l_reg; asm volatile("s_waitcnt lgkmcnt(0)" ::: "memory");
  float rli[16];
#pragma unroll
  for (int r = 0; r < 16; ++r) rli[r] = __builtin_amdgcn_rcpf(li_l[crow(r, hi)]);
  bf16* Ow = Ob + (long)(wid * QBLK) * LDO;
#pragma unroll
  for (int r = 0; r < 16; ++r) { int orow = crow(r, hi);
    for (int d0 = 0; d0 < 4; ++d0) Ow[(long)orow * LDO + d0 * 32 + r32] = (bf16)(cvtpk(o[d0][r] * rli[r], 0.f) & 0xffffu); }
#undef SLOAD
#undef SWRITE
#undef SWAIT
#undef RESC
}

constexpr int NA_LD = 4096, NA_TILES = 12;
__device__ __forceinline__ void na_block_body(const bf16* __restrict__ Qb, const bf16* __restrict__ Kh, const bf16* __restrict__ Vh, bf16* __restrict__ Ob,
                                              const float* __restrict__ rpb_h, const float* __restrict__ qgain, const float* __restrict__ kgain, int R, int ks, char* lds) {
  using St = Stage<bf16>;
  int tid_o = threadIdx.x; asm volatile("" : "+v"(tid_o)); const int tid = tid_o, wid = __builtin_amdgcn_readfirstlane(tid >> 6), lane = tid & 63, r32 = lane & 31, hi = lane >> 5;
  bf16* V_lds = (bf16*)lds; bf16* K_lds = (bf16*)(lds + 2 * SHM_V);
  float* ws = (float*)(lds + 2 * SHM_V + 2 * SHM_K) + wid * 64; float* li_l = ws; float* al_l = ws + 32;
  float* bt = (float*)(lds + 2 * SHM_V + 2 * SHM_K + NW * 64 * 4);
  float m_reg = -1e30f, l_reg = 0; f32x16 o[4] = {}; bf16x8 qr[8];
  const bf16* Qw = Qb + (long)(wid * QBLK + r32) * NA_LD + hi * 8;
#pragma unroll
  for (int d0 = 0; d0 < 8; ++d0) qr[d0] = St::ld8(Qw + d0 * 16);
  {
    float ss = 0.f;
#pragma unroll
    for (int d0 = 0; d0 < 8; ++d0) { const u32x4 w = __builtin_bit_cast(u32x4, qr[d0]);
#pragma unroll
      for (int e = 0; e < 4; ++e) { const float a = __uint_as_float(w[e] << 16), b = __uint_as_float(w[e] & 0xffff0000u); ss += a * a + b * b; } }
    ss += __shfl_xor(ss, 32);
    const float rinv = __builtin_amdgcn_rsqf(ss * (1.0f / 128.0f) + 1e-6f);
#pragma unroll
    for (int d0 = 0; d0 < 8; ++d0) { const u32x4 w = __builtin_bit_cast(u32x4, qr[d0]); const float* gp = qgain + d0 * 16 + hi * 8;
      const f32x8 g = *reinterpret_cast<const f32x8*>(gp); u32x4 o;
#pragma unroll
      for (int e = 0; e < 4; ++e) o[e] = cvtpk(__uint_as_float(w[e] << 16) * rinv * g[2 * e], __uint_as_float(w[e] & 0xffff0000u) * rinv * g[2 * e + 1]);
      qr[d0] = __builtin_bit_cast(bf16x8, o); } }
  const f32x8 kg = *reinterpret_cast<const f32x8*>(kgain + (tid & 15) * 8);
  for (int i = tid; i < 15 * 31; i += 64 * NW) bt[i] = rpb_h[i];
  const int sr = tid >> 4, sc = (tid & 15) * 8, vst0 = v_st(sr, sc), vst1 = v_st(32 + sr, sc);
  const int vb0 = (int)(uintptr_t)V_lds + v_rd_base(lane);
  bf16x8 s_vs0, s_vs1, s_ks0, s_ks1;
#define NLOAD(k0) do { s_vs0 = St::ld8(&Vh[(long)((k0) + sr) * NA_LD + sc]); s_vs1 = St::ld8(&Vh[(long)((k0) + 32 + sr) * NA_LD + sc]); \
    s_ks0 = St::ld8(&Kh[(long)((k0) + sr) * NA_LD + sc]); s_ks1 = St::ld8(&Kh[(long)((k0) + 32 + sr) * NA_LD + sc]); } while (0)
#define KNORM(x) do { const u32x4 w_ = __builtin_bit_cast(u32x4, x); float a_[8]; float ss_ = 0.f; \
    _Pragma("unroll") for (int e = 0; e < 4; ++e) { a_[2 * e] = __uint_as_float(w_[e] << 16); a_[2 * e + 1] = __uint_as_float(w_[e] & 0xffff0000u); ss_ += a_[2 * e] * a_[2 * e] + a_[2 * e + 1] * a_[2 * e + 1]; } \
    ss_ += __shfl_xor(ss_, 1); ss_ += __shfl_xor(ss_, 2); ss_ += __shfl_xor(ss_, 4); ss_ += __shfl_xor(ss_, 8); \
    const float ri_ = __builtin_amdgcn_rsqf(ss_ * (1.0f / 128.0f) + 1e-6f); u32x4 o_; \
    _Pragma("unroll") for (int e = 0; e < 4; ++e) o_[e] = cvtpk(a_[2 * e] * ri_ * kg[2 * e], a_[2 * e + 1] * ri_ * kg[2 * e + 1]); \
    x = __builtin_bit_cast(bf16x8, o_); } while (0)
#define NWRITE(b) do { KNORM(s_ks0); KNORM(s_ks1); \
    *(bf16x8*)((char*)V_lds + (b) * SHM_V + vst0) = s_vs0; *(bf16x8*)((char*)V_lds + (b) * SHM_V + vst1) = s_vs1; const int kc_ = sc * 2; \
    *(bf16x8*)((char*)K_lds + (b) * SHM_K + KSWZ(sr, kc_)) = s_ks0; *(bf16x8*)((char*)K_lds + (b) * SHM_K + KSWZ(32 + sr, kc_)) = s_ks1; } while (0)
  const int qrow = R + (wid >> 1), r0q = min(max(qrow - 4, 0), 248), jlo = r0q - ks;
  const int c = 32 * (wid & 1) + r32, c0 = min(max(c - 8, 0), 48);
  NLOAD(0); asm volatile("s_waitcnt vmcnt(0)" ::: "memory"); NWRITE(0); __syncthreads();
  for (int j = 0; j < NA_TILES; ++j) {
    const int buf = j & 1;
    if (j + 1 < NA_TILES) NLOAD((j + 1) * KVBLK);
    if (j >= jlo && j < jlo + 8) {
      f32x16 p0, p1; float mn, al; bf16x8 pa0, pa1, pa2, pa3;
      SBAR(); qkt(p0, p1, (bf16*)((char*)K_lds + buf * SHM_K), qr, r32, hi);
      const float* brow = bt + (ks + j - qrow + 7) * 31 + (15 - c);
#pragma unroll
      for (int r = 0; r < 16; ++r) { const int k0 = crow(r, hi), k1 = 32 + k0; const bool v0 = (k0 >= c0) && (k0 < c0 + 16), v1 = (k1 >= c0) && (k1 < c0 + 16);
        const float b0 = brow[v0 ? k0 : c], b1 = brow[v1 ? k1 : c];
        p0[r] = v0 ? fmaf(b0, 1.0f / SCALE, p0[r]) : -1e30f; p1[r] = v1 ? fmaf(b1, 1.0f / SCALE, p1[r]) : -1e30f; }
      partialSM(p0, p1, m_reg, mn, al);
      if (__any(al < 1.f)) { if (hi == 0) al_l[r32] = al; asm volatile("s_waitcnt lgkmcnt(0)" ::: "memory");
#pragma unroll
        for (int d = 0; d < 4; ++d)
#pragma unroll
          for (int r = 0; r < 16; ++r) o[d][r] *= al_l[crow(r, hi)]; }
      finishSM(p0, p1, al, l_reg, pa0, pa1, pa2, pa3); SBAR();
      pv_d0(o, vb0 + buf * (int)SHM_V, pa0, pa1, pa2, pa3);
    }
    if (j + 1 < NA_TILES) { asm volatile("s_waitcnt vmcnt(0)" ::: "memory"); NWRITE(buf ^ 1); }
    __syncthreads();
  }
  if (hi == 0) li_l[r32] = l_reg; asm volatile("s_waitcnt lgkmcnt(0)" ::: "memory");
  float rli[16];
#pragma unroll
  for (int r = 0; r < 16; ++r) rli[r] = __builtin_amdgcn_rcpf(li_l[crow(r, hi)]);
  bf16* Ow = Ob + (long)(wid * QBLK) * NA_LD;
#pragma unroll
  for (int r = 0; r < 16; ++r) { const int orow = crow(r, hi);
    for (int d0 = 0; d0 < 4; ++d0) Ow[(long)orow * NA_LD + d0 * 32 + r32] = (bf16)(cvtpk(o[d0][r] * rli[r], 0.f) & 0xffffu); }
#undef NLOAD
#undef NWRITE
#undef KNORM
}

typedef int v8i __attribute__((ext_vector_type(8)));
typedef unsigned u32x2 __attribute__((ext_vector_type(2)));
constexpr int K8_LD = 1024, V8_LD = 16384, SHM_K8 = KVBLK * D, SHM_V8 = KVBLK * D;
constexpr float THR8 = 3.0f;
__device__ __forceinline__ int cvt4_fp8(float a, float b, float c, float d) { int w = __builtin_amdgcn_cvt_pk_fp8_f32(a, b, 0, false); return __builtin_amdgcn_cvt_pk_fp8_f32(c, d, w, true); }
__device__ __forceinline__ v8i mk8(u32x4 lo, u32x4 hi) { return (v8i){(int)lo[0], (int)lo[1], (int)lo[2], (int)lo[3], (int)hi[0], (int)hi[1], (int)hi[2], (int)hi[3]}; }
__device__ __forceinline__ void qkt8(f32x16& p0, f32x16& p1, const char* Ks, const v8i* qf, int r32, int hi) {
  const int x0 = (r32 >> 1) & 7, x1 = ((32 + r32) >> 1) & 7;
  const char* k0 = Ks + r32 * 128; const char* k1 = Ks + (32 + r32) * 128;
  v8i a[2][2];
#pragma unroll
  for (int s = 0; s < 2; ++s) { const int c = 4 * s + 2 * hi;
    a[0][s] = mk8(*reinterpret_cast<const u32x4*>(k0 + 16 * (c ^ x0)), *reinterpret_cast<const u32x4*>(k0 + 16 * ((c + 1) ^ x0)));
    a[1][s] = mk8(*reinterpret_cast<const u32x4*>(k1 + 16 * (c ^ x1)), *reinterpret_cast<const u32x4*>(k1 + 16 * ((c + 1) ^ x1))); }
  p0 = f32x16{}; p1 = f32x16{};
#pragma unroll
  for (int s = 0; s < 2; ++s) {
    p0 = __builtin_amdgcn_mfma_scale_f32_32x32x64_f8f6f4(a[0][s], qf[s], p0, 0, 0, 0, 0x7F7F7F7F, 0, 0x7F7F7F7F);
    p1 = __builtin_amdgcn_mfma_scale_f32_32x32x64_f8f6f4(a[1][s], qf[s], p1, 0, 0, 0, 0x7F7F7F7F, 0, 0x7F7F7F7F); }
}
__device__ __forceinline__ void partialSM8(f32x16& p0, f32x16& p1, float& m_reg, float& mn, float& alpha) {
  constexpr float C = SCALE * 1.4426950408889634f;
  float pmax = p0[0]; for (int r = 1; r < 16; ++r) pmax = fmaxf(pmax, p0[r]); for (int r = 0; r < 16; ++r) pmax = fmaxf(pmax, p1[r]);
  { auto rr = __builtin_amdgcn_permlane32_swap(__float_as_uint(pmax), __float_as_uint(pmax), false, false);
    pmax = fmaxf(__uint_as_float(rr[0]), __uint_as_float(rr[1])); }
  if (__builtin_expect(__all(pmax - m_reg <= THR8 / SCALE), 1)) { mn = m_reg; alpha = 1.f; }
  else { mn = fmaxf(m_reg, pmax); alpha = __builtin_amdgcn_exp2f((m_reg - mn) * C); m_reg = mn; }
  const float mnC = 4.0f - mn * C;
  for (int r = 0; r < 16; ++r) p0[r] = fmaf(p0[r], C, mnC); for (int r = 0; r < 16; ++r) p1[r] = fmaf(p1[r], C, mnC);
  for (int r = 0; r < 16; ++r) p0[r] = __builtin_amdgcn_exp2f(p0[r]);
}
__device__ __forceinline__ void finishSM8(f32x16& p0, f32x16& p1, float alpha, float& l_reg, v8i& pa) {
  for (int r = 0; r < 16; ++r) p1[r] = __builtin_amdgcn_exp2f(p1[r]);
  float ps = 0; for (int r = 0; r < 16; ++r) ps += p0[r]; for (int r = 0; r < 16; ++r) ps += p1[r];
  { auto rr = __builtin_amdgcn_permlane32_swap(__float_as_uint(ps), __float_as_uint(ps), false, false);
    ps = __uint_as_float(rr[0]) + __uint_as_float(rr[1]); }
  l_reg = l_reg * alpha + ps;
#pragma unroll
  for (int v = 0; v < 4; ++v) { pa[v] = cvt4_fp8(p0[4 * v], p0[4 * v + 1], p0[4 * v + 2], p0[4 * v + 3]); pa[4 + v] = cvt4_fp8(p1[4 * v], p1[4 * v + 1], p1[4 * v + 2], p1[4 * v + 3]); }
}
__device__ __forceinline__ void pv8(f32x16* o, const char* Vs, const v8i& pa, int r32, int hi) {
  v8i b[4];
#pragma unroll
  for (int db = 0; db < 4; ++db) { const int d = 32 * db + r32, x = (d >> 2) & 3; const char* vp = Vs + d * 64;
    b[db] = mk8(*reinterpret_cast<const u32x4*>(vp + 16 * ((2 * hi) ^ x)), *reinterpret_cast<const u32x4*>(vp + 16 * ((2 * hi + 1) ^ x))); }
#pragma unroll
  for (int db = 0; db < 4; ++db) o[db] = __builtin_amdgcn_mfma_scale_f32_32x32x64_f8f6f4(pa, b[db], o[db], 0, 0, 0, 0x7F7F7F7F, 0, 0x7F7F7F7F);
}
__device__ __forceinline__ void attn_dense_body8(const bf16* __restrict__ Qb, const unsigned char* __restrict__ K8h, const unsigned char* __restrict__ V8h, bf16* __restrict__ Ob, int seq, char* lds) {
  int tid_o = threadIdx.x; asm volatile("" : "+v"(tid_o)); const int tid = tid_o, wid = __builtin_amdgcn_readfirstlane(tid >> 6), lane = tid & 63, r32 = lane & 31, hi = lane >> 5;
  char* V_lds = lds; char* K_lds = lds + 3 * SHM_V8;
  float* ws = (float*)(lds + 3 * SHM_V8 + 3 * SHM_K8) + wid * 64; float* li_l = ws; float* al_l = ws + 32;
  float m_reg = -1e30f, l_reg = 0; f32x16 o[4] = {}; v8i qf[2];
  { const bf16* Qw = Qb + (long)(wid * QBLK + r32) * LDQ + hi * 32;
#pragma unroll
    for (int s = 0; s < 2; ++s) {
#pragma unroll
      for (int c = 0; c < 4; ++c) { const u32x4 w = *reinterpret_cast<const u32x4*>(Qw + s * 64 + c * 8);
        qf[s][2 * c] = cvt4_fp8(__uint_as_float(w[0] << 16), __uint_as_float(w[0] & 0xffff0000u), __uint_as_float(w[1] << 16), __uint_as_float(w[1] & 0xffff0000u));
        qf[s][2 * c + 1] = cvt4_fp8(__uint_as_float(w[2] << 16), __uint_as_float(w[2] & 0xffff0000u), __uint_as_float(w[3] << 16), __uint_as_float(w[3] & 0xffff0000u)); } } }
  const int skey = tid >> 3, sck = tid & 7, sd = tid >> 2, sc4 = tid & 3;
  const int kst = skey * 128 + 16 * (sck ^ ((skey >> 1) & 7));
  const int vx = (sd >> 2) & 3, vst0 = sd * 64 + 16 * ((sc4 >> 1) ^ vx) + 8 * (sc4 & 1), vst1 = sd * 64 + 16 * ((2 + (sc4 >> 1)) ^ vx) + 8 * (sc4 & 1);
  const unsigned char* kg = K8h + (long)skey * K8_LD + 16 * sck; const unsigned char* vg = V8h + (long)sd * V8_LD + 16 * sc4;
  struct { u32x4 k, v; } sr_[2];
#define SLOAD8(i, k0) do { sr_[i].k = *reinterpret_cast<const u32x4*>(kg + (long)(k0) * K8_LD); sr_[i].v = *reinterpret_cast<const u32x4*>(vg + (k0)); } while (0)
#define SWRITE8(b, i) do { *reinterpret_cast<u32x4*>(K_lds + (b) * SHM_K8 + kst) = sr_[i].k; \
    *reinterpret_cast<u32x2*>(V_lds + (b) * SHM_V8 + vst0) = (u32x2){sr_[i].v[0], sr_[i].v[2]}; *reinterpret_cast<u32x2*>(V_lds + (b) * SHM_V8 + vst1) = (u32x2){sr_[i].v[1], sr_[i].v[3]}; } while (0)
#define SWAIT8() asm volatile("s_waitcnt vmcnt(2)" ::: "memory")
#define RESC8(a) do { if (__any((a) < 1.f)) { if (hi == 0) al_l[r32] = (a); asm volatile("s_waitcnt lgkmcnt(0)" ::: "memory"); \
    for (int d = 0; d < 4; ++d) for (int r = 0; r < 16; ++r) o[d][r] *= al_l[crow(r, hi)]; } } while (0)
  f32x16 pA0, pA1, pB0, pB1; float mnA, mnB, alA, alB; v8i pa; const int NT = seq / KVBLK;
  SLOAD8(0, 0); asm volatile("s_waitcnt vmcnt(0)" ::: "memory"); SWRITE8(0, 0); __syncthreads();
  qkt8(pA0, pA1, K_lds, qf, r32, hi); partialSM8(pA0, pA1, m_reg, mnA, alA);
  SLOAD8(1, KVBLK); if (2 < NT) SLOAD8(0, 2 * KVBLK);
  SWAIT8(); SWRITE8(1, 1); __syncthreads();
  int bk = 1, bv = 0, bw = 2;
  if (wid >= 4) __builtin_amdgcn_s_setprio(1);
#define ROT3() do { const int t_ = bv; bv = bk; bk = bw; bw = t_; } while (0)
  for (int j = 1; j + 1 < NT; j += 2) {
    SBAR(); qkt8(pB0, pB1, K_lds + bk * SHM_K8, qf, r32, hi);
    finishSM8(pA0, pA1, alA, l_reg, pa); SBAR();
    SLOAD8(1, (j + 2) * KVBLK); SBAR();
    pv8(o, V_lds + bv * SHM_V8, pa, r32, hi); partialSM8(pB0, pB1, m_reg, mnB, alB);
    SWAIT8(); SWRITE8(bw, 0);
    RESC8(alB); __syncthreads(); ROT3();
    SBAR(); qkt8(pA0, pA1, K_lds + bk * SHM_K8, qf, r32, hi);
    finishSM8(pB0, pB1, alB, l_reg, pa); SBAR();
    if (j + 3 < NT) SLOAD8(0, (j + 3) * KVBLK); SBAR();
    pv8(o, V_lds + bv * SHM_V8, pa, r32, hi); partialSM8(pA0, pA1, m_reg, mnA, alA);
    SWAIT8(); SWRITE8(bw, 1);
    RESC8(alA); __syncthreads(); ROT3();
  }
  SBAR(); qkt8(pB0, pB1, K_lds + bk * SHM_K8, qf, r32, hi);
  finishSM8(pA0, pA1, alA, l_reg, pa); SBAR();
  pv8(o, V_lds + bv * SHM_V8, pa, r32, hi); partialSM8(pB0, pB1, m_reg, mnB, alB);
  RESC8(alB);
  finishSM8(pB0, pB1, alB, l_reg, pa); SBAR();
  pv8(o, V_lds + bk * SHM_V8, pa, r32, hi);
#undef ROT3
  __builtin_amdgcn_s_setprio(0);
  if (hi == 0) li_l[r32] = l_reg; asm volatile("s_waitcnt lgkmcnt(0)" ::: "memory");
  float rli[16];
#pragma unroll
  for (int r = 0; r < 16; ++r) rli[r] = __builtin_amdgcn_rcpf(li_l[crow(r, hi)]);
  bf16* Ow = Ob + (long)(wid * QBLK) * LDO;
#pragma unroll
  for (int r = 0; r < 16; ++r) { const int orow = crow(r, hi);
    for (int d0 = 0; d0 < 4; ++d0) Ow[(long)orow * LDO + d0 * 32 + r32] = (bf16)(cvtpk(o[d0][r] * rli[r], 0.f) & 0xffffu); }
#undef SLOAD8
#undef SWRITE8
#undef SWAIT8
#undef RESC8
}
}
struct Frame {
    LAS unsigned char* lds;
    int tid, lane, wave;
    int bid, vcu, G;
};
__device__ __forceinline__ float wave_sum(float v) {
#pragma unroll
    for (int o = 1; o < 64; o <<= 1) v += __shfl_xor(v, o);
    return v;
}
__device__ __forceinline__ void xrows_phase(const Frame& F, const float* __restrict__ h, bf16* __restrict__ hb, pg8::rs_t* __restrict__ rs) {
    const int gw = F.vcu * 8 + F.wave, NGW = F.G * 8;
    for (int m = gw; m < L; m += NGW) {
        const f32x4* xr = (const f32x4*)(h + (size_t)m * DM) + F.lane;
        v2u* o8 = (v2u*)(hb + (size_t)m * DM) + F.lane;
        float s = 0.f;
#pragma unroll
        for (int j = 0; j < 16; ++j) { const f32x4 v = xr[64 * j]; s += (v.x * v.x + v.y * v.y) + (v.z * v.z + v.w * v.w); v2u w; w.x = pk2(v.x, v.y); w.y = pk2(v.z, v.w); o8[64 * j] = w; }
        s = wave_sum(s);
        if (F.lane == 0) rs[m] = (pg8::rs_t)(s * pg8::RS_FIX);
    }
}
__device__ __forceinline__ void headnorm_rows(bf16* __restrict__ X, int ld, int nheads, const float* __restrict__ gain, int t, int lane, bool rope, const float (&cs)[8], const float (&sn)[8], unsigned char* __restrict__ X8 = nullptr) {
    const int hs = lane >> 4, l16 = lane & 15;
    f32x4 g0 = *(const f32x4*)(gain + 8 * l16), g1 = *(const f32x4*)(gain + 8 * l16 + 4);
    const float gg[8] = {g0.x, g0.y, g0.z, g0.w, g1.x, g1.y, g1.z, g1.w};
    const bool second = ((l16 >> 2) & 1) != 0;
    for (int hg = 0; hg < nheads / 4; ++hg) {
        bf16* p = X + (size_t)t * ld + (size_t)(4 * hg + hs) * HD + 8 * l16;
        const v4u raw = *(const v4u*)p;
        float x[8] = {bflo(raw.x), bfhi(raw.x), bflo(raw.y), bfhi(raw.y), bflo(raw.z), bfhi(raw.z), bflo(raw.w), bfhi(raw.w)};
        float ss = 0.f;
#pragma unroll
        for (int e = 0; e < 8; ++e) ss += x[e] * x[e];
        ss += __shfl_xor(ss, 1); ss += __shfl_xor(ss, 2); ss += __shfl_xor(ss, 4); ss += __shfl_xor(ss, 8);
        const float rinv = 1.0f / sqrtf(ss * (1.0f / HD) + EPS);
        float y[8];
#pragma unroll
        for (int e = 0; e < 8; ++e) y[e] = x[e] * rinv * gg[e];
        if (rope) {
#pragma unroll
            for (int e = 0; e < 8; ++e) { const float yp = __shfl_xor(y[e], 4); y[e] = second ? (y[e] * cs[e] + yp * sn[e]) : (y[e] * cs[e] - yp * sn[e]); }
        }
        if (X8) { int w0 = __builtin_amdgcn_cvt_pk_fp8_f32(y[0], y[1], 0, false); w0 = __builtin_amdgcn_cvt_pk_fp8_f32(y[2], y[3], w0, true);
            int w1 = __builtin_amdgcn_cvt_pk_fp8_f32(y[4], y[5], 0, false); w1 = __builtin_amdgcn_cvt_pk_fp8_f32(y[6], y[7], w1, true);
            *(v2u*)(X8 + (size_t)t * ld + (size_t)(4 * hg + hs) * HD + 8 * l16) = (v2u){(unsigned)w0, (unsigned)w1}; }
        else { v4u w; w.x = pk2(y[0], y[1]); w.y = pk2(y[2], y[3]); w.z = pk2(y[4], y[5]); w.w = pk2(y[6], y[7]);
            *(v4u*)p = w; }
    }
}
__device__ __forceinline__ void prep_phase(const Frame& F, bf16* Q, bf16* K, int ldk, int nkh, const float* qgain, const float* kgain, bool rope, unsigned char* K8 = nullptr) {
    const int gw = F.vcu * 8 + F.wave, NGW = F.G * 8;
    const int l16 = F.lane & 15;
    for (int t = gw; t < L; t += NGW) {
        float cs[8], sn[8];
#pragma unroll
        for (int e = 0; e < 8; ++e) { cs[e] = 1.f; sn[e] = 0.f; }
        if (rope) {
            const int ax = l16 >> 3; const float pos = (float)(ax ? (t & (GRID_W - 1)) : (t / GRID_W));
#pragma unroll
            for (int e = 0; e < 8; ++e) { const int f = (l16 & 3) * 8 + e; const float inv = 1.0f / powf(10000.0f, (float)f * (1.0f / 32.0f)); const float ang = pos * inv; cs[e] = cosf(ang); sn[e] = sinf(ang); }
        }
        headnorm_rows(Q, DM, NH, qgain, t, F.lane, rope, cs, sn);
        headnorm_rows(K, ldk, nkh, kgain, t, F.lane, rope, cs, sn, K8);
    }
}

constexpr int S5T = pg8::S5T, S5NCH = pg8::S5NCH, S5KS = pg8::S5KS;
__device__ __forceinline__ void s5_gen_group(const Frame& F, int g, const float* __restrict__ lam_re, const float* __restrict__ lam_im, const float* __restrict__ log_step,
                                             const float* __restrict__ b_re, const float* __restrict__ b_im, const float* __restrict__ c_re, const float* __restrict__ c_im,
                                             bf16* __restrict__ GM, bf16* __restrict__ BMt, f32x2* __restrict__ PAT) {
    LAS f32x2* apow = (LAS f32x2*)F.lds;
    LAS f32x2* zt = apow + 2 * 33 * 64;
    LAS float* Kd = (LAS float*)(zt + 2 * 64);
    const int tid = F.tid;
    if (tid < 128) {
        const int dir = tid >> 6, n = tid & 63, dg = dir * S5G + g, idx = dg * S5N + n;
        const double dt = exp((double)log_step[dg]);
        const double lr = (double)lam_re[idx], li = (double)lam_im[idx];
        const double mag = exp(lr * dt), are = mag * cos(li * dt), aim = mag * sin(li * dt);
        const double den = lr * lr + li * li, nre = are - 1.0;
        zt[dir * 64 + n] = (f32x2){(float)((nre * lr + aim * li) / den), (float)((aim * lr - nre * li) / den)};
        double pr = 1.0, pi = 0.0;
        for (int k = 0; k <= 32; ++k) { apow[(dir * 33 + k) * 64 + n] = (f32x2){(float)pr, (float)pi}; const double t = pr * are - pi * aim; pi = pr * aim + pi * are; pr = t; }
        PAT[idx] = apow[(dir * 33 + 32) * 64 + n];
    }
    LDS_WAIT(); __syncthreads();
    {
        const int dir = tid >> 8, p = (tid >> 4) & 15, q = tid & 15, dg = dir * S5G + g;
        float wr[64], wi[64];
        const float* cr = c_re + ((size_t)dg * S5P + p) * S5N; const float* ci = c_im + ((size_t)dg * S5P + p) * S5N;
#pragma unroll
        for (int n = 0; n < 64; ++n) { const f32x2 z = zt[dir * 64 + n]; const float br = b_re[((size_t)dg * S5N + n) * S5P + q], bi = b_im[((size_t)dg * S5N + n) * S5P + q];
            const float bbr = z.x * br - z.y * bi, bbi = z.x * bi + z.y * br; const float c0 = cr[n], c1 = ci[n];
            wr[n] = c0 * bbr - c1 * bbi; wi[n] = c0 * bbi + c1 * bbr; }
        for (int d = 0; d < 32; ++d) { float acc = 0.f; const LAS f32x2* ap = apow + (dir * 33 + d) * 64;
#pragma unroll
            for (int n = 0; n < 64; ++n) { const f32x2 a = ap[n]; acc = fmaf(wr[n], a.x, acc); acc = fmaf(-wi[n], a.y, acc); }
            Kd[(dir * 32 + d) * 256 + p * 16 + q] = acc; }
    }
    LDS_WAIT(); __syncthreads();
    bf16* BMg = BMt + (size_t)g * 512 * S5KS;
    for (int it = tid; it < 512 * 64; it += 512) { const int row = it >> 6, ch = it & 63, tau = row >> 4, p = row & 15, sg = ch >> 1, q0 = (ch & 1) * 8;
        float v[8];
        if (sg < tau) { const LAS float* k = Kd + (0 * 32 + (tau - sg)) * 256 + p * 16 + q0;
#pragma unroll
            for (int j = 0; j < 8; ++j) v[j] = k[j]; }
        else if (sg > tau) { const LAS float* k = Kd + (1 * 32 + (sg - tau)) * 256 + p * 16 + q0;
#pragma unroll
            for (int j = 0; j < 8; ++j) v[j] = k[j]; }
        else { const LAS float* k0 = Kd + p * 16 + q0; const LAS float* k1 = Kd + 32 * 256 + p * 16 + q0;
#pragma unroll
            for (int j = 0; j < 8; ++j) v[j] = k0[j] + k1[j]; }
        v4u w; w.x = pk2(v[0], v[1]); w.y = pk2(v[2], v[3]); w.z = pk2(v[4], v[5]); w.w = pk2(v[6], v[7]);
        *(v4u*)(BMg + (size_t)row * S5KS + ch * 8) = w; }
    for (int it = tid; it < 512 * 32; it += 512) { const int row = it >> 5, ch = it & 31, tau = row >> 4, p = row & 15, dir = ch >> 4, n0 = (ch & 15) * 4, dg = dir * S5G + g;
        const int k = dir ? (32 - tau) : (tau + 1);
        const f32x4 cr = *(const f32x4*)(c_re + ((size_t)dg * S5P + p) * S5N + n0), ci = *(const f32x4*)(c_im + ((size_t)dg * S5P + p) * S5N + n0);
        const LAS f32x2* ap = apow + (dir * 33 + k) * 64 + n0;
        unsigned o[4];
#pragma unroll
        for (int j = 0; j < 4; ++j) { const f32x2 a = ap[j]; const float vr = cr[j] * a.x - ci[j] * a.y, vi = cr[j] * a.y + ci[j] * a.x; o[j] = pk2(vr, -vi); }
        *(v4u*)(BMg + (size_t)row * S5KS + 512 + ch * 8) = (v4u){o[0], o[1], o[2], o[3]}; }
    bf16* GMg = GM + (size_t)g * 256 * 512;
    for (int it = tid; it < 128 * 64; it += 512) { const int dn = it >> 6, ch = it & 63, dir = dn >> 6, n = dn & 63, sg = ch >> 1, q0 = (ch & 1) * 8, dg = dir * S5G + g;
        const int pw = dir ? sg : (31 - sg);
        const f32x2 a = apow[(dir * 33 + pw) * 64 + n], z = zt[dir * 64 + n];
        const float wr_ = a.x * z.x - a.y * z.y, wi_ = a.x * z.y + a.y * z.x;
        const float* br = b_re + ((size_t)dg * S5N + n) * S5P + q0; const float* bi = b_im + ((size_t)dg * S5N + n) * S5P + q0;
        float re[8], im[8];
#pragma unroll
        for (int j = 0; j < 8; ++j) { re[j] = wr_ * br[j] - wi_ * bi[j]; im[j] = wr_ * bi[j] + wi_ * br[j]; }
        v4u w0, w1; w0.x = pk2(re[0], re[1]); w0.y = pk2(re[2], re[3]); w0.z = pk2(re[4], re[5]); w0.w = pk2(re[6], re[7]);
        w1.x = pk2(im[0], im[1]); w1.y = pk2(im[2], im[3]); w1.z = pk2(im[4], im[5]); w1.w = pk2(im[6], im[7]);
        *(v4u*)(GMg + (size_t)(dir * 128 + 2 * n) * 512 + ch * 8) = w0; *(v4u*)(GMg + (size_t)(dir * 128 + 2 * n + 1) * 512 + ch * 8) = w1; }
    LDS_WAIT(); __syncthreads();
}
__device__ __forceinline__ void s5_scan_phase(const Frame& F, const f32x2* __restrict__ PAT, const float* __restrict__ E, bf16* __restrict__ UA) {
    for (int task = F.bid + F.G * F.wave; task < 2 * S5G; task += F.G * 8) {
        const int dir = task >> 8, g = task & 255;
        const f32x2 a = PAT[task * S5N + F.lane];
        const float* e = E + (size_t)g * S5NCH * 256 + dir * 128 + 2 * F.lane;
        bf16* s = UA + (size_t)g * S5NCH * S5KS + 512 + dir * 128 + 2 * F.lane;
        float cr = 0.f, ci = 0.f;
        for (int c8 = 0; c8 < S5NCH; c8 += 8) {
            f32x2 v[8];
#pragma unroll
            for (int k = 0; k < 8; ++k) { const int c = dir ? (S5NCH - 1 - (c8 + k)) : (c8 + k); v[k] = *(const f32x2*)(e + (size_t)c * 256); }
#pragma unroll
            for (int k = 0; k < 8; ++k) { const int c = dir ? (S5NCH - 1 - (c8 + k)) : (c8 + k);
                *(unsigned*)(s + (size_t)c * S5KS) = pk2(cr, ci);
                const float nr = fmaf(a.x, cr, fmaf(-a.y, ci, v[k].x)), ni = fmaf(a.x, ci, fmaf(a.y, cr, v[k].y)); cr = nr; ci = ni; }
        }
    }
}


__device__ __forceinline__ float fp8_to_f32(unsigned char b) { const int e = (b >> 3) & 15, m = b & 7; const float v = e ? __builtin_ldexpf(1.0f + (float)m * 0.125f, e - 7) : __builtin_ldexpf((float)m * 0.125f, -6); return (b & 0x80) ? -v : v; }
__device__ __forceinline__ void gqa_selfcheck(const Frame& F, const bf16* __restrict__ Qp, const unsigned char* __restrict__ K8, const unsigned char* __restrict__ V8t, const bf16* __restrict__ O,
                                              float* __restrict__ SC, unsigned* flag) {
    LAS float* ql = (LAS float*)(F.lds + F.wave * 1024);
    const int lane = F.lane;
#pragma unroll 1
    for (int s = F.bid * 8 + F.wave; s < 1024; s += F.G * 8) {
        const int tok = (int)(((long)(s >> 5) * 5209 + 77) % L), hq = s & 31, kv = hq >> 2;
        float* sc = SC + (size_t)(F.bid * 8 + F.wave) * L;
        { const bf16* qp = Qp + (size_t)tok * DM + hq * HD; ql[lane] = bf2f(qp[lane]); ql[lane + 64] = bf2f(qp[lane + 64]); } LDS_WAIT();
        float mx = -1e30f;
#pragma unroll 1
        for (int j = lane; j < L; j += 64) { const unsigned char* kp = K8 + (size_t)j * KVD + kv * HD; float dot = 0.f;
#pragma unroll 1
            for (int d = 0; d < HD; ++d) dot += fp8_to_f32(kp[d]) * ql[d];
            dot *= 0.088388347648318440f; sc[j] = dot; mx = fmaxf(mx, dot); }
#pragma unroll
        for (int o = 1; o < 64; o <<= 1) mx = fmaxf(mx, __shfl_xor(mx, o));
        asm volatile("s_waitcnt vmcnt(0)" ::: "memory"); __builtin_amdgcn_fence(__ATOMIC_RELEASE, "workgroup"); __builtin_amdgcn_fence(__ATOMIC_ACQUIRE, "agent");
        float o0 = 0.f, o1 = 0.f, lsum = 0.f;
#pragma unroll 1
        for (int j = 0; j < L; ++j) { const float pj = expf(__hip_atomic_load(sc + j, __ATOMIC_RELAXED, __HIP_MEMORY_SCOPE_AGENT) - mx);
            o0 += pj * fp8_to_f32(V8t[(size_t)(kv * HD + lane) * L + j]); o1 += pj * fp8_to_f32(V8t[(size_t)(kv * HD + lane + 64) * L + j]); lsum += pj; }
        o0 /= lsum; o1 /= lsum;
        const bf16* op = O + (size_t)tok * DM + hq * HD; const float g0 = bf2f(op[lane]), g1 = bf2f(op[lane + 64]);
        float am = fmaxf(fabsf(o0), fabsf(o1));
#pragma unroll
        for (int o = 1; o < 64; o <<= 1) am = fmaxf(am, __shfl_xor(am, o));
        const float tol = 0.2f * am + 1e-5f;
        const bool bad = !(fabsf(g0 - o0) <= tol) || !(fabsf(g1 - o1) <= tol);
        if (__any(bad) && lane == 0) __hip_atomic_fetch_or(flag, 1u, __ATOMIC_RELAXED, __HIP_MEMORY_SCOPE_AGENT);
        LDS_WAIT();
    }
}

__device__ __forceinline__ void transpose_item(const float* __restrict__ W, int K, int N, bf16* __restrict__ WT, int mode, const float* __restrict__ gain, LAS float* scr, int item, int lane) {
    const int nblk = N / 32, kb = item / nblk, nb = item % nblk, k0 = 64 * kb, n0 = 32 * nb;
    int r0 = n0;
    if (mode == 1) r0 = (n0 < DM) ? ((n0 >> 7) * 256 + (n0 & 127)) : (((n0 - DM) >> 7) * 256 + 128 + ((n0 - DM) & 127));
    const float* src = W + (size_t)(k0 + (lane >> 5)) * N + n0 + (lane & 31);
    float v[32];
#pragma unroll
    for (int i = 0; i < 32; ++i) v[i] = src[(size_t)(2 * i) * N];
    const int c = lane & 7;
    f32x4 g0 = (f32x4){1.f, 1.f, 1.f, 1.f}, g1 = g0;
    if (gain) { g0 = *(const f32x4*)(gain + k0 + 8 * c); g1 = *(const f32x4*)(gain + k0 + 8 * c + 4); }
#pragma unroll
    for (int i = 0; i < 32; ++i) scr[(2 * i + (lane >> 5)) * 33 + (lane & 31)] = v[i];
    LDS_WAIT(); asm volatile("" ::: "memory");
#pragma unroll
    for (int j = 0; j < 4; ++j) { const int n = (lane >> 3) + 8 * j; const LAS float* s = scr + (8 * c) * 33 + n;
        v4u o; o.x = pk2(s[0 * 33] * g0.x, s[1 * 33] * g0.y); o.y = pk2(s[2 * 33] * g0.z, s[3 * 33] * g0.w); o.z = pk2(s[4 * 33] * g1.x, s[5 * 33] * g1.y); o.w = pk2(s[6 * 33] * g1.z, s[7 * 33] * g1.w);
        *(v4u*)(WT + (size_t)(r0 + n) * K + k0 + 8 * c) = o; }
    LDS_WAIT(); asm volatile("" ::: "memory");
}

constexpr size_t MiB = 1u << 20;
constexpr size_t SZ_NAQKV = (size_t)3 * DM * DM * 2, SZ_DD = (size_t)DM * DM * 2, SZ_GQAQKV = (size_t)(DM + 2 * KVD) * DM * 2, SZ_W1 = (size_t)FF * DM * 2, SZ_PROJ = (size_t)DM * PLE * 2, SZ_ACT = (size_t)L * DM * 2;
constexpr size_t OFF_CTL = 0, CTL_ZERO_BYTES = 3 * MiB, OFF_RS = 1 * MiB;
constexpr size_t OFF_NAQKV = 4 * MiB;
constexpr size_t OFF_NAWO = OFF_NAQKV + 2 * SZ_NAQKV;
constexpr size_t OFF_GQAQKV = OFF_NAWO + 2 * SZ_DD;
constexpr size_t OFF_GQAWO = OFF_GQAQKV + SZ_GQAQKV;
constexpr size_t OFF_S5IN = OFF_GQAWO + SZ_DD;
constexpr size_t OFF_S5OUT = OFF_S5IN + SZ_DD;
constexpr size_t OFF_W1 = OFF_S5OUT + 2 * SZ_DD;
constexpr size_t OFF_W2 = OFF_W1 + 4 * SZ_W1;
constexpr size_t OFF_PROJ = OFF_W2 + 4 * SZ_W1;
constexpr size_t OFF_GATE = OFF_PROJ + 4 * SZ_PROJ;
constexpr size_t OFF_PBF = OFF_GATE + 4 * SZ_DD;
constexpr size_t OFF_XN = OFF_PBF + 4 * (size_t)L * PLE * 2;
constexpr size_t OFF_ACT = OFF_XN + SZ_ACT;
constexpr size_t OFF_PP = OFF_ACT + 4 * SZ_ACT;
constexpr size_t OFF_S5BM = OFF_PP + SZ_ACT;
constexpr size_t OFF_S5GM = OFF_S5BM + 192 * MiB;
constexpr size_t OFF_S5PAR = OFF_S5GM + 64 * MiB;
constexpr size_t OFF_DUMMY = OFF_S5PAR + 8 * MiB;
constexpr size_t OFF_HB1 = OFF_DUMMY + 256 * MiB;
constexpr size_t WS_END = OFF_HB1 + SZ_ACT;
constexpr int CW_BAR = 4096;
constexpr int RING_BYTES = 131072, LDSCTL_OFF = RING_BYTES, MISC_OFF = LDSCTL_OFF + 320, PTAB_OFF = LDSCTL_OFF + 1024, LDS_BYTES = 147456;
static_assert(dattn::SHM_ATTN <= RING_BYTES && 8 * 64 * 33 * 4 <= RING_BYTES, "phase scratch fits the ring region");

constexpr int PH_PER_LAYER = 8, NPH = 1 + DEPTH * PH_PER_LAYER;
struct Args { const float* in[28]; float* out; unsigned char* ws; int ph_lo, ph_hi; };
enum { I_X = 0, I_P, I_MIXN, I_MLPN, I_PLEN, I_NAQKV, I_NAWO, I_NAQG, I_NAKG, I_NARPB, I_GQKV, I_GWO, I_GQG, I_GKG, I_S5IN, I_LAMRE, I_LAMIM, I_LOGSTEP, I_BRE, I_BIM, I_CRE, I_CIM, I_S5D, I_S5OUT, I_W1, I_W2, I_PROJ, I_GATE };


__device__ __forceinline__ unsigned long long tab_get(LAS unsigned char* lds, int i) {
    volatile LAS unsigned* t = (volatile LAS unsigned*)(lds + PTAB_OFF); const unsigned lo = t[2 * i], hi = t[2 * i + 1];
    return ((unsigned long long)(unsigned)__builtin_amdgcn_readfirstlane((int)hi) << 32) | (unsigned)__builtin_amdgcn_readfirstlane((int)lo); }
#define INP(i) ((const float*)(const GAS float*)tab_get(F.lds, (i)))
#define OUTP() ((float*)(GAS float*)tab_get(F.lds, 28))
#define WSP() ((unsigned char*)(GAS unsigned char*)tab_get(F.lds, 29))
__device__ __forceinline__ Frame mkframe(unsigned char* lds_generic) {
    Frame F; int t = threadIdx.x; asm volatile("" : "+v"(t)); F.tid = t; F.lane = t & 63; F.wave = __builtin_amdgcn_readfirstlane(t >> 6);
    F.lds = (LAS unsigned char*)lds_generic; int b = blockIdx.x; asm volatile("" : "+s"(b)); F.bid = b; int G = gridDim.x; asm volatile("" : "+s"(G)); F.G = G;
    F.vcu = (G % 8 == 0) ? (b % 8) * (G / 8) + b / 8 : b; return F; }
__device__ __forceinline__ void prologue_phase(const Frame& F) {
    unsigned char* ws = WSP();
    LAS float* scr = (LAS float*)(F.lds + F.wave * (64 * 33 * 4));
    const int gw = F.vcu * 8 + F.wave, NGW = F.G * 8;
    constexpr int I_QKV = (DM / 64) * (3 * DM / 32), I_DD = (DM / 64) * (DM / 32), I_GQ = (DM / 64) * ((DM + 2 * KVD) / 32), I_SO = (DM / 64) * (2 * DM / 32),
                  I_1 = (DM / 64) * (FF / 32), I_2 = (FF / 64) * (DM / 32), I_PJ = (PLE / 64) * (DM / 32);
    constexpr int NITEMS = 2 * I_QKV + 2 * I_DD + I_GQ + I_DD + I_DD + I_SO + 4 * I_1 + 4 * I_2 + 4 * I_PJ + 4 * I_DD;
    for (int it = gw; it < NITEMS; it += NGW) {
        int r = it; const float* W; int K, N, mode = 0; bf16* WT; const float* gain = nullptr;
        if (r < 2 * I_QKV) { const int l = r / I_QKV; r -= l * I_QKV; W = INP(I_NAQKV) + (size_t)l * DM * 3 * DM; K = DM; N = 3 * DM; WT = (bf16*)(ws + OFF_NAQKV + l * SZ_NAQKV); gain = INP(I_MIXN) + (size_t)(3 * l) * DM; }
        else { r -= 2 * I_QKV;
        if (r < 2 * I_DD) { const int l = r / I_DD; r -= l * I_DD; W = INP(I_NAWO) + (size_t)l * DM * DM; K = DM; N = DM; WT = (bf16*)(ws + OFF_NAWO + l * SZ_DD); }
        else { r -= 2 * I_DD;
        if (r < I_GQ) { W = INP(I_GQKV); K = DM; N = DM + 2 * KVD; WT = (bf16*)(ws + OFF_GQAQKV); gain = INP(I_MIXN) + (size_t)1 * DM; }
        else { r -= I_GQ;
        if (r < I_DD) { W = INP(I_GWO); K = DM; N = DM; WT = (bf16*)(ws + OFF_GQAWO); }
        else { r -= I_DD;
        if (r < I_DD) { W = INP(I_S5IN); K = DM; N = DM; WT = (bf16*)(ws + OFF_S5IN); gain = INP(I_MIXN) + (size_t)2 * DM; }
        else { r -= I_DD;
        if (r < I_SO) { W = INP(I_S5OUT); K = DM; N = 2 * DM; WT = (bf16*)(ws + OFF_S5OUT); mode = 1; }
        else { r -= I_SO;
        if (r < 4 * I_1) { const int l = r / I_1; r -= l * I_1; W = INP(I_W1) + (size_t)l * DM * FF; K = DM; N = FF; WT = (bf16*)(ws + OFF_W1 + l * SZ_W1); gain = INP(I_MLPN) + (size_t)l * DM; }
        else { r -= 4 * I_1;
        if (r < 4 * I_2) { const int l = r / I_2; r -= l * I_2; W = INP(I_W2) + (size_t)l * FF * DM; K = FF; N = DM; WT = (bf16*)(ws + OFF_W2 + l * SZ_W1); }
        else { r -= 4 * I_2;
        if (r < 4 * I_PJ) { const int l = r / I_PJ; r -= l * I_PJ; W = INP(I_PROJ) + (size_t)l * PLE * DM; K = PLE; N = DM; WT = (bf16*)(ws + OFF_PROJ + l * SZ_PROJ); }
        else { r -= 4 * I_PJ; const int l = r / I_DD; r -= l * I_DD; W = INP(I_GATE) + (size_t)l * DM * DM; K = DM; N = DM; WT = (bf16*)(ws + OFF_GATE + l * SZ_DD); gain = INP(I_PLEN) + (size_t)l * DM; } } } } } } } } }
        transpose_item(W, K, N, WT, mode, gain, scr, r, F.lane);
    }
    xrows_phase(F, INP(I_X), (bf16*)(ws + OFF_XN), (pg8::rs_t*)(ws + OFF_RS));
    { const size_t n8 = (size_t)DEPTH * L * PLE / 8; const float* p = INP(I_P); bf16* pb = (bf16*)(ws + OFF_PBF);
      for (size_t i = (size_t)gw * 64 + F.lane; i < n8; i += (size_t)NGW * 64) { const f32x4 a = *(const f32x4*)(p + i * 8), b = *(const f32x4*)(p + i * 8 + 4);
          v4u w; w.x = pk2(a.x, a.y); w.y = pk2(a.z, a.w); w.z = pk2(b.x, b.y); w.w = pk2(b.z, b.w); *(v4u*)(pb + i * 8) = w; } }
    { bf16* GM = (bf16*)(ws + OFF_S5GM); bf16* BMt = (bf16*)(ws + OFF_S5BM); f32x2* PAT = (f32x2*)(ws + OFF_S5PAR);
      LDS_WAIT(); __syncthreads();
      for (int g = F.bid; g < S5G; g += F.G) s5_gen_group(F, g, INP(I_LAMRE), INP(I_LAMIM), INP(I_LOGSTEP), INP(I_BRE), INP(I_BIM), INP(I_CRE), INP(I_CIM), GM, BMt, PAT); }
}

#define WS_PTRS() unsigned char* ws = WSP(); bf16* HB0 = (bf16*)(ws + OFF_XN); bf16* HB1 = (bf16*)(ws + OFF_HB1); bf16* Qb = (bf16*)(ws + OFF_ACT); bf16* Kb = (bf16*)(ws + OFF_ACT + SZ_ACT); bf16* Vb = (bf16*)(ws + OFF_ACT + 2 * SZ_ACT); \
    bf16* Ob = (bf16*)(ws + OFF_ACT + 3 * SZ_ACT); bf16* HID = (bf16*)(ws + OFF_ACT); bf16* UA = (bf16*)(ws + OFF_ACT); bf16* S5Gb = (bf16*)(ws + OFF_ACT + 2 * SZ_ACT); float* S5E = (float*)(ws + OFF_ACT + 3 * SZ_ACT); bf16* PP = (bf16*)(ws + OFF_PP); \
    (void)HB0; (void)HB1; (void)Qb; (void)Kb; (void)Vb; (void)Ob; (void)HID; (void)UA; (void)S5Gb; (void)PP; (void)S5E;
__global__ void __launch_bounds__(512, 2) enc_fwd(Args args) {
    extern __shared__ __attribute__((aligned(16))) unsigned char lds[];
    {
        LAS unsigned char* l3 = (LAS unsigned char*)lds;
        for (int u = threadIdx.x; u < (LDS_BYTES - LDSCTL_OFF) / 4; u += 512) ((LAS unsigned*)(l3 + LDSCTL_OFF))[u] = 0u;
        __syncthreads();
        if (threadIdx.x == 0) { LAS unsigned long long* t = (LAS unsigned long long*)(l3 + PTAB_OFF);
#pragma unroll
            for (int i = 0; i < 28; ++i) t[i] = (unsigned long long)args.in[i];
            t[28] = (unsigned long long)args.out; t[29] = (unsigned long long)args.ws; }
        __syncthreads();
    }
    const int lo = args.ph_lo, hi = args.ph_hi;
    XcdBarrier bar;
    { LAS unsigned char* l3 = (LAS unsigned char*)lds; unsigned* ctl = (unsigned*)(GAS unsigned*)(tab_get(l3, 29) + OFF_CTL); bar.bar = ctl + CW_BAR; bar.x = 0; bar.st = nullptr;
      if (hi - lo > 1) bar = xcd_barrier_post(ctl + CW_BAR, (volatile LAS unsigned*)(l3 + MISC_OFF) + 8); }
#define IN(k) (lo <= (k) && (k) < hi)
#ifndef PROBE_PH
#define PROBE_PH (-1)
#endif
#define REPS(k) for (int rep_ = 0, nrep_ = (((k) == PROBE_PH || PROBE_PH == -2) ? 2 : ((PROBE_PH == 300 && (k) == 11) ? 4 : 1)); rep_ < nrep_; ++rep_)
#define HBOUT(p) ((nrep_ == 2 && rep_ == 0) ? (bf16*)(ws + OFF_DUMMY) : (p))
#define RSOUT(i) ((nrep_ == 2 && rep_ == 0) ? (pg8::rs_t*)(ws + OFF_DUMMY + 128 * MiB) : RSP(i))
#define SEAM(k) do { if (IN(k) && IN((k) + 1)) xcd_barrier(bar); } while (0)

#if PROBE_PH == 600
    if (blockIdx.x == 0 && threadIdx.x < 64) {
        typedef int v8i_ __attribute__((ext_vector_type(8))); typedef float f16v_ __attribute__((ext_vector_type(16)));
        const int l = threadIdx.x, ij = l & 31, kb = l >> 5; const unsigned lut[7] = {0xC4u, 0xC0u, 0xB8u, 0x00u, 0x38u, 0x40u, 0x44u};
        v8i_ A, B;
#pragma unroll
        for (int v = 0; v < 8; ++v) { unsigned wa = 0, wb = 0;
#pragma unroll
            for (int b = 0; b < 4; ++b) { const int kk = 32 * kb + 4 * v + b; const int av = ((ij + 2 * kk) % 5) - 2, bv = ((3 * kk + ij) % 7) - 3;
                unsigned ea = 0, eb = 0;
#pragma unroll
                for (int t = 0; t < 7; ++t) { ea = (av + 3 == t) ? lut[t] : ea; eb = (bv + 3 == t) ? lut[t] : eb; }
                wa |= ea << (8 * b); wb |= eb << (8 * b); }
            A[v] = (int)wa; B[v] = (int)wb; }
        f16v_ c1 = {}, c2 = {};
        c1 = __builtin_amdgcn_mfma_scale_f32_32x32x64_f8f6f4(A, B, c1, 0, 0, 0, 0x7F7F7F7F, 0, 0x7F7F7F7F);
        c2 = __builtin_amdgcn_mfma_scale_f32_32x32x64_f8f6f4(A, B, c2, 0, 0, 0, 0x7B7B7B7B, 0, 0x7F7F7F7F);
        bool ok1 = true, ok2 = true;
#pragma unroll
        for (int r = 0; r < 16; ++r) { const int i = (r & 3) + 8 * (r >> 2) + 4 * kb, j = ij; int s = 0;
            for (int kk = 0; kk < 64; ++kk) s += (((i + 2 * kk) % 5) - 2) * (((3 * kk + j) % 7) - 3);
            ok1 = ok1 && (c1[r] == (float)s); ok2 = ok2 && (c2[r] == (float)s * 0.0625f); }
        int w = __builtin_amdgcn_cvt_pk_fp8_f32(1.0f, 2.0f, 0, false); w = __builtin_amdgcn_cvt_pk_fp8_f32(3.0f, -1.0f, w, true);
        const bool ok3 = ((unsigned)w == 0xB8444038u);
        unsigned long long ticks = 0; if (!__all(ok1)) ticks += 400000ull; if (!__all(ok2)) ticks += 800000ull; if (!__all(ok3)) ticks += 1600000ull;
        const unsigned long long t0 = __builtin_amdgcn_s_memrealtime(); while (__builtin_amdgcn_s_memrealtime() - t0 < ticks) __builtin_amdgcn_s_sleep(8);
    }
    __syncthreads();
#endif
    if (IN(0)) REPS(0) { const Frame F = mkframe(lds); prologue_phase(F); } SEAM(0);
#if PROBE_PH == 200
    for (int xb_ = 0; xb_ < 40; ++xb_) xcd_barrier(bar);
#endif

#pragma unroll 1
    for (int layer = 0; layer < DEPTH; ++layer) {
        const int kind = layer % 3, slot = layer / 3, pb = 1 + PH_PER_LAYER * layer;
#define RSP(i) ((pg8::rs_t*)(ws + OFF_RS) + (size_t)(i) * L)
        const int irs = (layer == 0) ? 0 : 3 * layer;
        if (IN(pb + 0)) REPS(pb + 0) {
            const Frame F = mkframe(lds); WS_PTRS();
            if (kind != 2) {
                const int N = (kind == 0) ? 3 * DM : DM + 2 * KVD;
                const bf16* W = (kind == 0) ? (const bf16*)(ws + OFF_NAQKV + slot * SZ_NAQKV) : (const bf16*)(ws + OFF_GQAQKV);
                const pg8::Gemm g = pg8::mkgemm(HB0, W, L, N, DM); pg8::StaticOrder S; S.init(L, N, F.G, F.bid);
                pg8::EpiBf16<0> E{Qb, Kb, Vb, DM, (kind == 0) ? DM : KVD, (kind == 0) ? DM : L, DM, (kind == 0) ? 2 * DM : DM + KVD, RSP(irs), (kind == 0) ? 0 : 2, (kind == 0) ? 2 * DM : DM + KVD};
                pg8::gemm_phase<pg8::EpiBf16<0>, pg8::StaticOrder, false, true>(F.lds, g, S, E);
            } else {
                const pg8::Gemm g = pg8::mkgemm(HB0, (const bf16*)(ws + OFF_S5IN), L, DM, DM); pg8::StaticOrder S; S.init(L, DM, F.G, F.bid);
                pg8::EpiS5U E{UA, RSP(irs)};
                pg8::gemm_phase<pg8::EpiS5U, pg8::StaticOrder, false, true>(F.lds, g, S, E);
            }
        }
        SEAM(pb + 0);
        if (kind != 2) {
            if (kind == 1) { if (IN(pb + 1)) { const Frame F = mkframe(lds); WS_PTRS(); prep_phase(F, Qb, Kb, KVD, NKV, INP(I_GQG), INP(I_GKG), true, (unsigned char*)Kb + 64 * MiB); }
                SEAM(pb + 1); }
            if (IN(pb + 2)) REPS(pb + 2) { const Frame F = mkframe(lds); WS_PTRS();
                if (kind == 0) {
                    const float* rpb = INP(I_NARPB) + (size_t)slot * NH * 15 * 31;
                    for (int i = 0;; ++i) { const int unit = i * F.G + F.vcu; if (unit >= NH * (GROWS / 4)) break;
                        const int h = unit >> 6, R = (unit & 63) * 4, ks = min(max(R - 4, 0), GROWS - dattn::NA_TILES);
                        dattn::na_block_body(Qb + (size_t)(R * GRID_W) * DM + h * HD, Kb + (size_t)(ks * GRID_W) * DM + h * HD, Vb + (size_t)(ks * GRID_W) * DM + h * HD,
                                             Ob + (size_t)(R * GRID_W) * DM + h * HD, rpb + (size_t)h * 15 * 31, INP(I_NAQG) + slot * HD, INP(I_NAKG) + slot * HD, R, ks, (char*)lds);
                        __syncthreads(); }
                } else {
                    for (int i = 0;; ++i) { const int unit = i * F.G + F.bid; if (unit >= NH * (L / 256)) break;
                        const int kvh = unit & 7, rest = unit >> 3, hq = kvh * 4 + (rest >> 6), qb = rest & 63;
                        dattn::attn_dense_body8(Qb + (size_t)(qb * 256) * DM + hq * HD, (const unsigned char*)Kb + 64 * MiB + kvh * HD, (const unsigned char*)Vb + (size_t)(kvh * HD) * L, Ob + (size_t)(qb * 256) * DM + hq * HD, L, (char*)lds);
                        __syncthreads(); }
                }
            }
            if (IN(pb + 2) && IN(pb + 4)) xcd_barrier(bar);
#if PROBE_PH == 400
            if (kind == 1) { const Frame F = mkframe(lds); WS_PTRS();
                gqa_selfcheck(F, Qb, (const unsigned char*)Kb + 64 * MiB, (const unsigned char*)Vb, Ob, (float*)(ws + OFF_PP), (unsigned*)(ws + OFF_CTL) + 8);
                xcd_barrier(bar); }
#endif
        } else {
            if (IN(pb + 1)) REPS(pb + 1) { const Frame F = mkframe(lds); WS_PTRS();
                pg8::Gemm g; g.A = UA; g.Bt = (const bf16*)(ws + OFF_S5GM); g.M = S5G * S5NCH; g.N = 256; g.K = 512; g.lda = S5KS; g.ldb = 512;
                pg8::S5Order S{F.G, F.bid, 2, 1}; pg8::EpiS5E E{S5E};
                pg8::gemm_phase<pg8::EpiS5E, pg8::S5Order, false, true>(F.lds, g, S, E); }
            SEAM(pb + 1);
            if (IN(pb + 2)) REPS(pb + 2) { const Frame F = mkframe(lds); WS_PTRS(); s5_scan_phase(F, (const f32x2*)(ws + OFF_S5PAR), S5E, UA); }
            SEAM(pb + 2);
            if (IN(pb + 3)) REPS(pb + 3) { const Frame F = mkframe(lds); WS_PTRS();
                pg8::Gemm g; g.A = UA; g.Bt = (const bf16*)(ws + OFF_S5BM); g.M = S5G * S5NCH; g.N = S5G * 512; g.K = S5KS; g.lda = S5KS; g.ldb = S5KS;
                pg8::S5Order S{F.G, F.bid, 2, 2}; pg8::EpiS5Y E{UA, INP(I_S5D), S5Gb, DM};
                pg8::gemm_phase<pg8::EpiS5Y, pg8::S5Order, false, true>(F.lds, g, S, E); }
            SEAM(pb + 3);
        }
        if (IN(pb + 4)) REPS(pb + 4) {
            const Frame F = mkframe(lds); WS_PTRS();
            if (kind != 2) {
                const bf16* W = (kind == 0) ? (const bf16*)(ws + OFF_NAWO + slot * SZ_DD) : (const bf16*)(ws + OFF_GQAWO);
                const pg8::Gemm g = pg8::mkgemm(Ob, W, L, DM, DM); pg8::StaticOrder S; S.init(L, DM, F.G, F.bid);
                pg8::EpiRes E{HB0, HBOUT(HB0), RSOUT(1 + 3 * layer), DM, nullptr};
                pg8::gemm_phase<pg8::EpiRes, pg8::StaticOrder, false, true>(F.lds, g, S, E);
            } else {
                const pg8::Gemm g = pg8::mkgemm(S5Gb, (const bf16*)(ws + OFF_S5OUT), L, 2 * DM, DM); pg8::StaticOrder S; S.init(L, 2 * DM, F.G, F.bid);
                pg8::EpiGlu E{HB0, HBOUT(HB0), RSOUT(1 + 3 * layer), DM};
                pg8::gemm_phase<pg8::EpiGlu, pg8::StaticOrder, false, true>(F.lds, g, S, E);
            }
        }
        SEAM(pb + 4);
        if (IN(pb + 5)) REPS(pb + 5) { const Frame F = mkframe(lds); WS_PTRS();
            const pg8::Gemm g = pg8::mkgemm(HB0, (const bf16*)(ws + OFF_W1 + layer * SZ_W1), L, FF, DM); pg8::StaticOrder S; S.init(L, FF, F.G, F.bid);
            pg8::EpiBf16<2> E{HID, HID, HID, FF, FF, FF, 1 << 30, 1 << 30, nullptr, 0, 0};
#if PROBE_PH == 201
            { pg8::RangeOrder R1{S, 0, 8}, R2{S, 8, 16};
              pg8::gemm_phase<pg8::EpiBf16<2>, pg8::RangeOrder, false, true>(F.lds, g, R1, E); xcd_barrier(bar);
              pg8::gemm_phase<pg8::EpiBf16<2>, pg8::RangeOrder, false, true>(F.lds, g, R2, E); }
#else
            pg8::gemm_phase<pg8::EpiBf16<2>, pg8::StaticOrder, false, true>(F.lds, g, S, E);
#endif
        }
        SEAM(pb + 5);
        if (IN(pb + 6)) REPS(pb + 6) { const Frame F = mkframe(lds); WS_PTRS();
            { const pg8::Gemm g = pg8::mkgemm(HID, (const bf16*)(ws + OFF_W2 + layer * SZ_W1), L, DM, FF); pg8::StaticOrder S; S.init(L, DM, F.G, F.bid);
              pg8::EpiRes E{HB0, HBOUT(HB1), RSOUT(2 + 3 * layer), DM, RSP(1 + 3 * layer)};
              pg8::gemm_phase<pg8::EpiRes, pg8::StaticOrder, false, true>(F.lds, g, S, E); }
            { const pg8::Gemm g = pg8::mkgemm((const bf16*)(ws + OFF_PBF + (size_t)layer * L * PLE * 2), (const bf16*)(ws + OFF_PROJ + layer * SZ_PROJ), L, DM, PLE); pg8::StaticOrder S; S.init(L, DM, F.G, F.bid);
              pg8::EpiBf16<0> E{PP, PP, PP, DM, DM, DM, 1 << 30, 1 << 30, nullptr, 0, 0};
              pg8::gemm_phase<pg8::EpiBf16<0>, pg8::StaticOrder, false, true>(F.lds, g, S, E); }
        }
        SEAM(pb + 6);
        if (IN(pb + 7)) REPS(pb + 7) { const Frame F = mkframe(lds); WS_PTRS();
            const pg8::Gemm g = pg8::mkgemm(HB1, (const bf16*)(ws + OFF_GATE + layer * SZ_DD), L, DM, DM); pg8::StaticOrder S; S.init(L, DM, F.G, F.bid);
            pg8::EpiGate E{HB1, HBOUT(HB0), (layer == DEPTH - 1) ? OUTP() : nullptr, PP, RSP(2 + 3 * layer), RSOUT(3 + 3 * layer), DM};
            pg8::gemm_phase<pg8::EpiGate, pg8::StaticOrder, false, true>(F.lds, g, S, E);
        }
        SEAM(pb + 7);
    }
#if PROBE_PH == 400
    { xcd_barrier(bar); const Frame F = mkframe(lds); unsigned char* ws = WSP();
      if (__hip_atomic_load((unsigned*)(ws + OFF_CTL) + 8, __ATOMIC_RELAXED, __HIP_MEMORY_SCOPE_AGENT) != 0u && F.bid == 0 && F.tid < 64) OUTP()[F.tid] = __builtin_nanf(""); }
#endif
#undef IN
#undef SEAM
}

extern "C" void kernel_launch(void* const* d_in, const int* in_sizes, int n_in, void* d_out, int out_size, void* d_ws, size_t ws_size, hipStream_t stream) {
    static int grid = 0;
    if (grid == 0) {
        if (n_in != 28 || in_sizes[0] != L * DM || out_size != L * DM || ws_size < WS_END) {
            fprintf(stderr, "kernel_launch: built for 28 inputs, x/out of %d floats, >= %zu bytes of workspace; got n_in %d, in0 %d, out %d, ws %zu; nothing launched\n", L * DM, (size_t)WS_END, n_in, n_in > 0 ? in_sizes[0] : -1, out_size, ws_size);
            grid = -1; return; }
        int dev = 0, cus = 0, per_cu = 0;
        if (hipGetDevice(&dev) != hipSuccess || hipDeviceGetAttribute(&cus, hipDeviceAttributeMultiprocessorCount, dev) != hipSuccess) { fprintf(stderr, "kernel_launch: device query failed\n"); grid = -1; return; }
        if (hipFuncSetAttribute((const void*)enc_fwd, hipFuncAttributeMaxDynamicSharedMemorySize, LDS_BYTES) != hipSuccess) { fprintf(stderr, "kernel_launch: hipFuncSetAttribute failed\n"); grid = -1; return; }
        if (hipOccupancyMaxActiveBlocksPerMultiprocessor(&per_cu, (const void*)enc_fwd, 512, LDS_BYTES) != hipSuccess || per_cu < 1)
            fprintf(stderr, "kernel_launch: note: occupancy query reports %d workgroups per CU\n", per_cu);
        (void)hipGetLastError();
        grid = cus;
    }
    if (grid < 0) return;
    if (hipMemsetAsync((char*)d_ws + OFF_CTL, 0, CTL_ZERO_BYTES, stream) != hipSuccess) { fprintf(stderr, "kernel_launch: memset failed\n"); return; }
    Args a{};
    for (int i = 0; i < 28; ++i) a.in[i] = (const float*)d_in[i];
    a.out = (float*)d_out; a.ws = (unsigned char*)d_ws;
#if MK_N_LAUNCHES == 1
    a.ph_lo = 0; a.ph_hi = NPH;
    hipLaunchKernelGGL(enc_fwd, dim3(grid), dim3(512), LDS_BYTES, stream, a);
#else
    for (int ph = 0; ph < NPH; ++ph) {
        if (ph > 0) { const int layer = (ph - 1) / PH_PER_LAYER, j = (ph - 1) % PH_PER_LAYER; if (j == 3 && layer % 3 != 2) continue; }
        a.ph_lo = ph; a.ph_hi = ph + 1;
        hipLaunchKernelGGL(enc_fwd, dim3(grid), dim3(512), LDS_BYTES, stream, a);
    }
#endif
    const hipError_t le = hipPeekAtLastError();
    if (le != hipSuccess) fprintf(stderr, "kernel_launch: launch failed: %s\n", hipGetErrorName(le));
}
```

```cpp
#include <hip/hip_runtime.h>
#include <cstdio>
#include <cstdint>

#ifndef MK_N_LAUNCHES
#define MK_N_LAUNCHES 1
#endif

constexpr int L = 16384, DM = 4096, DEPTH = 4, GRID_W = 64, GROWS = L / GRID_W, HD = 128, NH = 32, NKV = 8, KVD = NKV * HD, FF = 4 * DM, PLE = 256;
constexpr int S5G = 256, S5P = 16, S5N = 64, S5TC = 16, S5NC = L / S5TC;
constexpr float EPS = 1e-6f;

#define GAS __attribute__((address_space(1)))
#define LAS __attribute__((address_space(3)))
typedef unsigned short bf16;
typedef unsigned v4u __attribute__((ext_vector_type(4)));
typedef unsigned v2u __attribute__((ext_vector_type(2)));
typedef float f32x4 __attribute__((ext_vector_type(4)));
typedef float f32x2 __attribute__((ext_vector_type(2)));
typedef short bf16x8 __attribute__((ext_vector_type(8)));
typedef short s16x4 __attribute__((ext_vector_type(4)));
typedef GAS unsigned gu32;
#define RLX_AGENT __ATOMIC_RELAXED, __HIP_MEMORY_SCOPE_AGENT
#define LDS_WAIT() asm volatile("s_waitcnt lgkmcnt(0)" ::: "memory")
#define VM_WAIT() asm volatile("s_waitcnt vmcnt(0)" ::: "memory")
__device__ __forceinline__ unsigned f2bf(float f) { unsigned u = __builtin_bit_cast(unsigned, f); return (u + 0x7fffu + ((u >> 16) & 1u)) >> 16; }
__device__ __forceinline__ unsigned pk2(float lo, float hi) { return f2bf(lo) | (f2bf(hi) << 16); }
__device__ __forceinline__ float bf2f(unsigned short b) { return __builtin_bit_cast(float, (unsigned)b << 16); }
__device__ __forceinline__ float bflo(unsigned w) { return __builtin_bit_cast(float, w << 16); }
__device__ __forceinline__ float bfhi(unsigned w) { return __builtin_bit_cast(float, w & 0xffff0000u); }
__device__ __forceinline__ float sigmoidf_fast(float x) { return __builtin_amdgcn_rcpf(1.0f + __builtin_amdgcn_exp2f(-1.4426950408889634f * x)); }

namespace pg8 {
#define PG8_LAS __attribute__((address_space(3)))
#if defined(PROBE_EPI2)
#define PROBE_EPI_DUP if constexpr (Epi::PERM) E(acc, cur, wr, wc, fr, fq);
#else
#define PROBE_EPI_DUP
#endif
typedef unsigned short bf16_t;
typedef short bf16x8 __attribute__((ext_vector_type(8)));
typedef float f32x4 __attribute__((ext_vector_type(4)));
typedef unsigned u32x4 __attribute__((ext_vector_type(4)));
constexpr int BM = 256, BK = 64, HALF = 128, HTB = HALF * BK * 2  , STAGE_BYTES = 8 * HTB, NXCD = 8, WGM = 8;

__host__ __device__ __forceinline__ int lds_byte(int r, int c) { const int st = (r >> 4) * 2 + (c >> 5), rr = r & 15, cc = c & 31, ob = rr * 64 + cc * 2; return st * 1024 + (ob ^ (((ob >> 9) & 1) << 5)); }
__host__ __device__ __forceinline__ void stage_rc(int b, int& R, int& C) { const int st = b / 1024, sb = b % 1024, swz = sb ^ (((sb >> 9) & 1) << 5); R = (st >> 1) * 16 + swz / 64; C = (st & 1) * 32 + (swz % 64) / 2; }
__host__ __device__ __forceinline__ int perm32(int rho) { const int n = rho >> 4, i = rho & 15; return 8 * (i >> 2) + 4 * n + (i & 3); }

struct Unit { int pm, pn; };
struct Gemm { const bf16_t* A; const bf16_t* Bt; int M, N, K, lda, ldb; };
__host__ __device__ __forceinline__ Gemm mkgemm(const bf16_t* A, const bf16_t* Bt, int M, int N, int K) { Gemm g; g.A = A; g.Bt = Bt; g.M = M; g.N = N; g.K = K; g.lda = K; g.ldb = K; return g; }

struct StaticOrder {
    int nM, nN, nwg, G, c;
    __host__ __device__ void init(int M, int N, int G_, int c_) { nM = M / BM; nN = N / BM; nwg = nM * nN; G = G_; c = c_; }
    __host__ __device__ bool next(int i, Unit& u) const {
        const long L = (long)i * G + c; if (L >= nwg) return false;
        int wgid = (int)L; { const int q = nwg / NXCD, r = nwg % NXCD, xcd = wgid % NXCD, off = wgid / NXCD; wgid = (xcd < r ? xcd * (q + 1) : r * (q + 1) + (xcd - r) * q) + off; }
        const int nig = WGM * nN, gid = wgid / nig, fm = gid * WGM, gsz = (nM - fm) < WGM ? (nM - fm) : WGM;
        u.pm = fm + ((wgid % nig) % gsz); u.pn = (wgid % nig) / gsz; return true;
    }
    __device__ __forceinline__ void a_ready(const Unit&) const {}
    __device__ __forceinline__ void done(const Unit&) const {}
};
struct RangeOrder { StaticOrder S; int i0, i1;
    __host__ __device__ bool next(int i, Unit& u) const { return (i + i0 < i1) ? S.next(i + i0, u) : false; }
    __device__ __forceinline__ void a_ready(const Unit&) const {}
    __device__ __forceinline__ void done(const Unit&) const {} };


__device__ __forceinline__ unsigned cvt_pk_bf16(float lo, float hi) { unsigned r; asm volatile("v_cvt_pk_bf16_f32 %0, %1, %2" : "=v"(r) : "v"(lo), "v"(hi)); return r; }
__device__ __forceinline__ float sigm(float x) { return __builtin_amdgcn_rcpf(1.0f + __builtin_amdgcn_exp2f(-1.4426950408889634f * x)); }

typedef unsigned long long rs_t;
constexpr float RS_FIX = 16777216.0f, RS_INV = 1.0f / (16777216.0f * 4096.0f), RS_EPS = 1e-6f;
__device__ __forceinline__ void row_ss_add(rs_t* rs, int row, float s, int fq) {
    s += __shfl_xor(s, 16); s += __shfl_xor(s, 32);
    if (fq == 0) __hip_atomic_fetch_add(rs + row, (rs_t)(s * RS_FIX), __ATOMIC_RELAXED, __HIP_MEMORY_SCOPE_AGENT);
}
__device__ __forceinline__ float rs_rinv(rs_t v) { return __builtin_amdgcn_rsqf((float)v * RS_INV + RS_EPS); }
#define PIN8(a) asm volatile("" : "+v"((a)[0]), "+v"((a)[1]), "+v"((a)[2]), "+v"((a)[3]), "+v"((a)[4]), "+v"((a)[5]), "+v"((a)[6]), "+v"((a)[7]))
template <int ACT> struct EpiBf16 {
    static constexpr bool PERM = true, AFTER_DRAIN = false;
    bf16_t *O0, *O1, *O2; int ld0, ld1, ld2, c1, c2; const rs_t* rs; int vt; int rs_from;
    __device__ __forceinline__ void operator()(const f32x4 (&acc)[2][2][4][2], const Unit& u, int wr, int wc, int fr, int fq) const {
        const int row0 = u.pm * BM + wr * 64 + fr; int colt = u.pn * BM; bf16_t* base = O0; int ldc = ld0;
        const rs_t* rs = (colt >= rs_from) ? this->rs : nullptr;
        bool tr = false;
        if (colt >= c2) { base = O2; ldc = ld2; colt -= c2; tr = vt != 0; } else if (colt >= c1) { base = O1; ldc = ld1; colt -= c1; }
        const int col0 = colt + wc * 32 + 8 * fq;
        rs_t scv[8];
#pragma unroll
        for (int gi = 0; gi < 8; ++gi) scv[gi] = rs ? rs[row0 + (gi >> 2) * HALF + (gi & 3) * 16] : 0ull;
        PIN8(scv);
#pragma unroll
        for (int ai = 0; ai < 2; ++ai)
#pragma unroll
            for (int m = 0; m < 4; ++m) { bf16_t* rowp = base + (size_t)(row0 + ai * HALF + m * 16) * ldc + col0; const float sc = rs ? rs_rinv(scv[ai * 4 + m]) : 1.0f;
#pragma unroll
                for (int bj = 0; bj < 2; ++bj) { f32x4 v0 = acc[ai][bj][m][0] * sc, v1 = acc[ai][bj][m][1] * sc;
                    if (ACT == 2) {
#pragma unroll
                        for (int j = 0; j < 4; ++j) { const float a = fmaxf(v0[j], 0.f), b = fmaxf(v1[j], 0.f); v0[j] = a * a; v1[j] = b * b; } }
                    u32x4 w; w.x = cvt_pk_bf16(v0[0], v0[1]); w.y = cvt_pk_bf16(v0[2], v0[3]); w.z = cvt_pk_bf16(v1[0], v1[1]); w.w = cvt_pk_bf16(v1[2], v1[3]);
                    if (vt == 2 && tr) {
                        unsigned char* tp = (unsigned char*)base + (size_t)(col0 + bj * HALF) * ldc + (row0 + ai * HALF + m * 16);
                        int w0 = __builtin_amdgcn_cvt_pk_fp8_f32(v0[0], v0[1], 0, false); w0 = __builtin_amdgcn_cvt_pk_fp8_f32(v0[2], v0[3], w0, true);
                        int w1 = __builtin_amdgcn_cvt_pk_fp8_f32(v1[0], v1[1], 0, false); w1 = __builtin_amdgcn_cvt_pk_fp8_f32(v1[2], v1[3], w1, true);
                        tp[0] = (unsigned char)w0; tp[(size_t)ldc] = (unsigned char)(w0 >> 8); tp[(size_t)2 * ldc] = (unsigned char)(w0 >> 16); tp[(size_t)3 * ldc] = (unsigned char)(w0 >> 24);
                        tp[(size_t)4 * ldc] = (unsigned char)w1; tp[(size_t)5 * ldc] = (unsigned char)(w1 >> 8); tp[(size_t)6 * ldc] = (unsigned char)(w1 >> 16); tp[(size_t)7 * ldc] = (unsigned char)(w1 >> 24); }
                    else if (tr) { bf16_t* tp = base + (size_t)(col0 + bj * HALF) * ldc + (row0 + ai * HALF + m * 16);
                        tp[0] = (bf16_t)w.x; tp[(size_t)ldc] = (bf16_t)(w.x >> 16); tp[(size_t)2 * ldc] = (bf16_t)w.y; tp[(size_t)3 * ldc] = (bf16_t)(w.y >> 16);
                        tp[(size_t)4 * ldc] = (bf16_t)w.z; tp[(size_t)5 * ldc] = (bf16_t)(w.z >> 16); tp[(size_t)6 * ldc] = (bf16_t)w.w; tp[(size_t)7 * ldc] = (bf16_t)(w.w >> 16); }
                    else *(u32x4*)(rowp + bj * HALF) = w; } }
    }
};
struct EpiF32 {
    static constexpr bool PERM = false, AFTER_DRAIN = false;
    float* C; int ldc;
    __device__ __forceinline__ void operator()(const f32x4 (&acc)[2][2][4][2], const Unit& u, int wr, int wc, int fr, int fq) const {
        const int row0 = u.pm * BM + wr * 64 + fr, col0 = u.pn * BM + wc * 32 + 4 * fq;
#pragma unroll
        for (int ai = 0; ai < 2; ++ai)
#pragma unroll
            for (int m = 0; m < 4; ++m) { float* rowp = C + (size_t)(row0 + ai * HALF + m * 16) * ldc + col0;
#pragma unroll
                for (int bj = 0; bj < 2; ++bj)
#pragma unroll
                    for (int n = 0; n < 2; ++n) *(f32x4*)(rowp + bj * HALF + n * 16) = acc[ai][bj][m][n]; }
    }
};
typedef unsigned u32x2 __attribute__((ext_vector_type(2)));
__device__ __forceinline__ f32x4 bf4_to_f32(u32x2 p) { return (f32x4){__builtin_bit_cast(float, p.x << 16), __builtin_bit_cast(float, p.x & 0xffff0000u), __builtin_bit_cast(float, p.y << 16), __builtin_bit_cast(float, p.y & 0xffff0000u)}; }
struct EpiRes {
    static constexpr bool PERM = false, AFTER_DRAIN = false;
    const bf16_t* base; bf16_t* out; rs_t* rs; int ldc; const rs_t* rsq;
    __device__ __forceinline__ void operator()(const f32x4 (&acc)[2][2][4][2], const Unit& u, int wr, int wc, int fr, int fq) const {
        constexpr int PD = 3;
        const int row0 = u.pm * BM + wr * 64 + fr, col0 = u.pn * BM + wc * 32 + 4 * fq;
        u32x2 nb[8][2][2];
        rs_t scv[8];
#pragma unroll
        for (int gi = 0; gi < 8; ++gi) scv[gi] = rsq ? rsq[row0 + (gi >> 2) * HALF + (gi & 3) * 16] : 0ull;
#define EPI_LD(g) do { const size_t o_ = (size_t)(row0 + ((g) >> 2) * HALF + ((g) & 3) * 16) * ldc + col0; _Pragma("unroll") for (int bj = 0; bj < 2; ++bj) _Pragma("unroll") for (int n = 0; n < 2; ++n) nb[g][bj][n] = *(const u32x2*)(base + o_ + bj * HALF + n * 16); } while (0)
#pragma unroll
        for (int g = 0; g < PD; ++g) EPI_LD(g);
        PIN8(scv);
#pragma unroll
        for (int gi = 0; gi < 8; ++gi) { const int ai = gi >> 2, m = gi & 3; const int row = row0 + ai * HALF + m * 16; const size_t off = (size_t)row * ldc + col0;
            if (gi + PD < 8) EPI_LD(gi + PD);
            const float sc2 = rsq ? __builtin_amdgcn_rcpf((float)scv[gi] * RS_INV + RS_EPS) : 1.0f;
            float ss = 0.f;
#pragma unroll
            for (int bj = 0; bj < 2; ++bj)
#pragma unroll
                for (int n = 0; n < 2; ++n) { const f32x4 o = bf4_to_f32(nb[gi][bj][n]) + acc[ai][bj][m][n] * sc2;
                    ss += (o[0] * o[0] + o[1] * o[1]) + (o[2] * o[2] + o[3] * o[3]);
                    u32x2 w; w.x = cvt_pk_bf16(o[0], o[1]); w.y = cvt_pk_bf16(o[2], o[3]); *(u32x2*)(out + off + bj * HALF + n * 16) = w; }
            row_ss_add(rs, row, ss, fq); }
#undef EPI_LD
    }
};
struct EpiGate {
    static constexpr bool PERM = false, AFTER_DRAIN = false;
    const bf16_t* base; bf16_t* out; float* out32; const bf16_t* pp; const rs_t* rsin; rs_t* rs; int ldc; unsigned char* out8;
    __device__ __forceinline__ void operator()(const f32x4 (&acc)[2][2][4][2], const Unit& u, int wr, int wc, int fr, int fq) const {
        constexpr int PD = 2;
        const int row0 = u.pm * BM + wr * 64 + fr, col0 = u.pn * BM + wc * 32 + 4 * fq;
        rs_t scv[8];
#pragma unroll
        for (int gi = 0; gi < 8; ++gi) scv[gi] = rsin[row0 + (gi >> 2) * HALF + (gi & 3) * 16];
        u32x2 nb[8][2][2], np[8][2][2];
#define EPI_LD(g) do { const size_t o_ = (size_t)(row0 + ((g) >> 2) * HALF + ((g) & 3) * 16) * ldc + col0; _Pragma("unroll") for (int bj = 0; bj < 2; ++bj) _Pragma("unroll") for (int n = 0; n < 2; ++n) { \
            nb[g][bj][n] = *(const u32x2*)(base + o_ + bj * HALF + n * 16); np[g][bj][n] = *(const u32x2*)(pp + o_ + bj * HALF + n * 16); } } while (0)
#pragma unroll
        for (int g = 0; g < PD; ++g) EPI_LD(g);
        PIN8(scv);
#pragma unroll
        for (int gi = 0; gi < 8; ++gi) { const int ai = gi >> 2, m = gi & 3; const int row = row0 + ai * HALF + m * 16; const size_t off = (size_t)row * ldc + col0;
            if (gi + PD < 8) EPI_LD(gi + PD);
            const float sc = rs_rinv(scv[gi]);
            float ss = 0.f;
#pragma unroll
            for (int bj = 0; bj < 2; ++bj)
#pragma unroll
                for (int n = 0; n < 2; ++n) { const f32x4 a = acc[ai][bj][m][n] * sc, p = bf4_to_f32(np[gi][bj][n]); f32x4 o = bf4_to_f32(nb[gi][bj][n]);
#pragma unroll
                    for (int j = 0; j < 4; ++j) o[j] += sigm(a[j]) * p[j];
                    if (out32) *(f32x4*)(out32 + off + bj * HALF + n * 16) = o;
                    if (out8) { int w8 = __builtin_amdgcn_cvt_pk_fp8_f32(o[0], o[1], 0, false); w8 = __builtin_amdgcn_cvt_pk_fp8_f32(o[2], o[3], w8, true); *(unsigned*)(out8 + off + bj * HALF + n * 16) = (unsigned)w8; }
                    ss += (o[0] * o[0] + o[1] * o[1]) + (o[2] * o[2] + o[3] * o[3]);
                    u32x2 w; w.x = cvt_pk_bf16(o[0], o[1]); w.y = cvt_pk_bf16(o[2], o[3]); *(u32x2*)(out + off + bj * HALF + n * 16) = w; }
            row_ss_add(rs, row, ss, fq); }
#undef EPI_LD
    }
};
struct EpiGlu {
    static constexpr bool PERM = false, AFTER_DRAIN = false;
    const bf16_t* base; bf16_t* out; rs_t* rs; int ldc;
    __device__ __forceinline__ void operator()(const f32x4 (&acc)[2][2][4][2], const Unit& u, int wr, int wc, int fr, int fq) const {
        constexpr int PD = 3;
        const int row0 = u.pm * BM + wr * 64 + fr, col0 = u.pn * HALF + wc * 32 + 4 * fq;
        u32x2 nb[8][2];
#define EPI_LD(g) do { const size_t o_ = (size_t)(row0 + ((g) >> 2) * HALF + ((g) & 3) * 16) * ldc + col0; _Pragma("unroll") for (int n = 0; n < 2; ++n) nb[g][n] = *(const u32x2*)(base + o_ + n * 16); } while (0)
#pragma unroll
        for (int g = 0; g < PD; ++g) EPI_LD(g);
#pragma unroll
        for (int gi = 0; gi < 8; ++gi) { const int ai = gi >> 2, m = gi & 3; const int row = row0 + ai * HALF + m * 16; const size_t off = (size_t)row * ldc + col0;
            if (gi + PD < 8) EPI_LD(gi + PD);
            float ss = 0.f;
#pragma unroll
            for (int n = 0; n < 2; ++n) { const f32x4 a = acc[ai][0][m][n], g = acc[ai][1][m][n]; f32x4 o = bf4_to_f32(nb[gi][n]);
#pragma unroll
                for (int j = 0; j < 4; ++j) o[j] += a[j] * sigm(g[j]);
                ss += (o[0] * o[0] + o[1] * o[1]) + (o[2] * o[2] + o[3] * o[3]);
                u32x2 w; w.x = cvt_pk_bf16(o[0], o[1]); w.y = cvt_pk_bf16(o[2], o[3]); *(u32x2*)(out + off + n * 16) = w; }
            row_ss_add(rs, row, ss, fq); }
#undef EPI_LD
    }
};

constexpr int S5T = 32, S5NCH = 512, S5KS = 768;
struct S5Order {
    int G, c, MT, NT;
    __device__ __forceinline__ bool next(int i, Unit& u) const { const int idx = i * G + c; if (idx >= 256 * MT * NT) return false; const int g = idx & 255, sub = idx >> 8;
        u.pm = g * MT + sub / NT; u.pn = g * NT + sub % NT; return true; }
    __device__ __forceinline__ void a_ready(const Unit&) const {}
    __device__ __forceinline__ void done(const Unit&) const {}
};
struct EpiS5U {
    static constexpr bool PERM = true, AFTER_DRAIN = false;
    bf16_t* UA; const rs_t* rs;
    __device__ __forceinline__ void operator()(const f32x4 (&acc)[2][2][4][2], const Unit& u, int wr, int wc, int fr, int fq) const {
        const int row0 = u.pm * BM + wr * 64 + fr, col0 = u.pn * BM + wc * 32 + 8 * fq;
        rs_t scv[8];
#pragma unroll
        for (int gi = 0; gi < 8; ++gi) scv[gi] = rs[row0 + (gi >> 2) * HALF + (gi & 3) * 16];
        PIN8(scv);
#pragma unroll
        for (int ai = 0; ai < 2; ++ai)
#pragma unroll
            for (int m = 0; m < 4; ++m) { const int t = row0 + ai * HALF + m * 16, c = t >> 5, sg = t & 31; const float sc = rs_rinv(scv[ai * 4 + m]);
#pragma unroll
                for (int bj = 0; bj < 2; ++bj) { const int col = col0 + bj * HALF, g = col >> 4, q0 = col & 15;
                    const f32x4 v0 = acc[ai][bj][m][0] * sc, v1 = acc[ai][bj][m][1] * sc;
                    u32x4 w; w.x = cvt_pk_bf16(v0[0], v0[1]); w.y = cvt_pk_bf16(v0[2], v0[3]); w.z = cvt_pk_bf16(v1[0], v1[1]); w.w = cvt_pk_bf16(v1[2], v1[3]);
                    *(u32x4*)(UA + ((size_t)(g * S5NCH + c) * S5KS + sg * 16 + q0)) = w; } }
    }
};
struct EpiS5E {
    static constexpr bool PERM = false, AFTER_DRAIN = false;
    float* E;
    __device__ __forceinline__ void operator()(const f32x4 (&acc)[2][2][4][2], const Unit& u, int wr, int wc, int fr, int fq) const {
        const int row0 = u.pm * BM + wr * 64 + fr, col0 = wc * 32 + 4 * fq;
#pragma unroll
        for (int ai = 0; ai < 2; ++ai)
#pragma unroll
            for (int m = 0; m < 4; ++m) { float* rowp = E + (size_t)(row0 + ai * HALF + m * 16) * 256 + col0;
#pragma unroll
                for (int bj = 0; bj < 2; ++bj)
#pragma unroll
                    for (int n = 0; n < 2; ++n) *(f32x4*)(rowp + bj * HALF + n * 16) = acc[ai][bj][m][n]; }
    }
};
__device__ __forceinline__ float gelu_tanh_f(float v) {
    const float z = 0.7978845608028654f * (v + 0.044715f * v * v * v);
    const float e = __builtin_amdgcn_exp2f(2.0f * 1.4426950408889634f * z);
    return 0.5f * v * (2.0f - 2.0f * __builtin_amdgcn_rcpf(e + 1.0f));
}
struct EpiS5Y {
    static constexpr bool PERM = true, AFTER_DRAIN = false;
    const bf16_t* UA; const float* dskip; bf16_t* G; int ldg;
    __device__ __forceinline__ void operator()(const f32x4 (&acc)[2][2][4][2], const Unit& u, int wr, int wc, int fr, int fq) const {
        const int row0 = u.pm * BM + wr * 64 + fr, col0 = (u.pn & 1) * BM + wc * 32 + 8 * fq;
        const int g = u.pm >> 1, p0 = col0 & 15;
        const f32x4 d0 = *(const f32x4*)(dskip + 16 * g + p0), d1 = *(const f32x4*)(dskip + 16 * g + p0 + 4);
        u32x4 uu[8][2];
#pragma unroll
        for (int gi = 0; gi < 8; ++gi)
#pragma unroll
            for (int bj = 0; bj < 2; ++bj) uu[gi][bj] = *(const u32x4*)(UA + ((size_t)(row0 + (gi >> 2) * HALF + (gi & 3) * 16) * S5KS + col0 + bj * HALF));
#pragma unroll
        for (int gi = 0; gi < 8; ++gi) asm volatile("" : "+v"(uu[gi][0]), "+v"(uu[gi][1]));
#pragma unroll
        for (int gi = 0; gi < 8; ++gi) { const int ai = gi >> 2, m = gi & 3; const int rowg = row0 + ai * HALF + m * 16, c = rowg & 511;
#pragma unroll
            for (int bj = 0; bj < 2; ++bj) { const int col = col0 + bj * HALF, tau = col >> 4; const u32x4 w4 = uu[gi][bj];
                f32x4 v0 = acc[ai][bj][m][0], v1 = acc[ai][bj][m][1];
                v0[0] += d0[0] * __builtin_bit_cast(float, w4.x << 16); v0[1] += d0[1] * __builtin_bit_cast(float, w4.x & 0xffff0000u);
                v0[2] += d0[2] * __builtin_bit_cast(float, w4.y << 16); v0[3] += d0[3] * __builtin_bit_cast(float, w4.y & 0xffff0000u);
                v1[0] += d1[0] * __builtin_bit_cast(float, w4.z << 16); v1[1] += d1[1] * __builtin_bit_cast(float, w4.z & 0xffff0000u);
                v1[2] += d1[2] * __builtin_bit_cast(float, w4.w << 16); v1[3] += d1[3] * __builtin_bit_cast(float, w4.w & 0xffff0000u);
#pragma unroll
                for (int j = 0; j < 4; ++j) { v0[j] = gelu_tanh_f(v0[j]); v1[j] = gelu_tanh_f(v1[j]); }
                u32x4 w; w.x = cvt_pk_bf16(v0[0], v0[1]); w.y = cvt_pk_bf16(v0[2], v0[3]); w.z = cvt_pk_bf16(v1[0], v1[1]); w.w = cvt_pk_bf16(v1[2], v1[3]);
                *(u32x4*)(G + (size_t)(32 * c + tau) * ldg + 16 * g + p0) = w; } }
    }
};

template <class Epi, class Sched, bool ALIGN_EPI = false, bool SP2 = false, bool FP8 = false>
__device__ __forceinline__ void gemm_phase(PG8_LAS unsigned char* lds, const Gemm g, const Sched& S, const Epi& E) {
    int tid_o = threadIdx.x; asm volatile("" : "+v"(tid_o)); const int tid = tid_o, wid = __builtin_amdgcn_readfirstlane(tid >> 6), lane = tid & 63, wr = wid >> 2, wc = wid & 3, fr = lane & 15, fq = lane >> 4;
    const int K = g.K, nt = K / BK;
    unsigned voffA[2], voffB[2];
#pragma unroll
    for (int i = 0; i < 2; ++i) { int R, C; stage_rc(tid * 16 + i * 8192, R, C); const int Rb = Epi::PERM ? ((R & ~31) + perm32(R & 31)) : R;
        voffA[i] = (unsigned)(R * g.lda + C) * 2u; voffB[i] = (unsigned)(Rb * g.ldb + C) * 2u; }
    const size_t kstep = (size_t)(BK * 2);
    const size_t hstepA = (size_t)HALF * g.lda * 2, hstepB = (size_t)HALF * g.ldb * 2;
    const size_t tstepA = 2 * hstepA, tstepB = 2 * hstepB;
    const unsigned ldsw = (unsigned)wid * 1024u;
    const int aoff = lds_byte(wr * 64 + fr, fq * 8), boff = lds_byte(wc * 32 + fr, fq * 8);
    const int aoff8 = lds_byte(wr * 64 + fr, fq * 16), boff8 = lds_byte(wc * 32 + fr, fq * 16);
#define PG8_SA(b, h) (((b) * 2 + (h)) * HTB)
#define PG8_SB(b, h) ((4 + (b) * 2 + (h)) * HTB)
#define PG8_STAGE(bufoff, gbase, voff) do { _Pragma("unroll") for (int _i = 0; _i < 2; ++_i) \
        __builtin_amdgcn_global_load_lds((const unsigned*)((const char*)(gbase) + (voff)[_i]), (PG8_LAS unsigned*)(lds + (bufoff) + ldsw + _i * 8192), 16, 0, 0); } while (0)
#define PG8_LDA(dst, b, h) do { if constexpr (FP8) { _Pragma("unroll") for (int m = 0; m < 4; ++m) { const PG8_LAS unsigned char* p_ = lds + PG8_SA(b, h) + aoff8 + m * 2048; const v4i32 l_ = *(const PG8_LAS v4i32*)p_, h_ = *(const PG8_LAS v4i32*)(p_ + 16); \
        dst##8[m] = __builtin_shufflevector(l_, h_, 0, 1, 2, 3, 4, 5, 6, 7); } } else { \
        _Pragma("unroll") for (int m = 0; m < 4; ++m) _Pragma("unroll") for (int k = 0; k < 2; ++k) dst[m][k] = *(const PG8_LAS bf16x8*)(lds + PG8_SA(b, h) + aoff + m * 2048 + k * 1024); } } while (0)
#define PG8_LDB(dst, b, h) do { if constexpr (FP8) { _Pragma("unroll") for (int n = 0; n < 2; ++n) { const PG8_LAS unsigned char* p_ = lds + PG8_SB(b, h) + boff8 + n * 2048; const v4i32 l_ = *(const PG8_LAS v4i32*)p_, h_ = *(const PG8_LAS v4i32*)(p_ + 16); \
        dst##8[n] = __builtin_shufflevector(l_, h_, 0, 1, 2, 3, 4, 5, 6, 7); } } else { \
        _Pragma("unroll") for (int n = 0; n < 2; ++n) _Pragma("unroll") for (int k = 0; k < 2; ++k) dst[n][k] = *(const PG8_LAS bf16x8*)(lds + PG8_SB(b, h) + boff + n * 2048 + k * 1024); } } while (0)
#define PG8_MMA(ai, bj, At, Bt) do { __builtin_amdgcn_s_setprio(1); if constexpr (FP8) { _Pragma("unroll") for (int m = 0; m < 4; ++m) _Pragma("unroll") for (int n = 0; n < 2; ++n) \
        asm volatile("v_mfma_scale_f32_16x16x128_f8f6f4 %0, %1, %2, %0, %3, %4 op_sel_hi:[0,0,0]" : "+v"(acc[ai][bj][m][n]) : "v"(Bt##8[n]), "v"(At##8[m]), "v"(sc_w8), "v"(sc_a8)); } else { \
        _Pragma("unroll") for (int m = 0; m < 4; ++m) _Pragma("unroll") for (int n = 0; n < 2; ++n) _Pragma("unroll") for (int k = 0; k < 2; ++k) \
        acc[ai][bj][m][n] = __builtin_amdgcn_mfma_f32_16x16x32_bf16(Bt[n][k], At[m][k], acc[ai][bj][m][n], 0, 0, 0); } __builtin_amdgcn_s_setprio(0); } while (0)
#define PG8_WAIT_V(n) asm volatile("s_waitcnt vmcnt(" #n ")" ::: "memory")
#define PG8_WAIT_L(n) asm volatile("s_waitcnt lgkmcnt(" #n ")" ::: "memory")
#define PG8_BAR __builtin_amdgcn_s_barrier()
#define PG8_SCHED __builtin_amdgcn_sched_barrier(0)
    Unit cur, nxt; int ui = 0;
    if (!S.next(0, cur)) return;
    f32x4 acc[2][2][4][2];
#pragma unroll
    for (int a = 0; a < 2; ++a)
#pragma unroll
        for (int b = 0; b < 2; ++b)
#pragma unroll
            for (int m = 0; m < 4; ++m)
#pragma unroll
                for (int n = 0; n < 2; ++n) acc[a][b][m][n] = (f32x4){0.f, 0.f, 0.f, 0.f};
    bf16x8 At[4][2], B0[2][2], B1[2][2];
    typedef int v8i32 __attribute__((ext_vector_type(8))); typedef int v4i32 __attribute__((ext_vector_type(4))); v8i32 At8[4], B08[2], B18[2];
    const int sc_w8 = 0x79797979, sc_a8 = 0x7F7F7F7F;
    const char* cA = (const char*)g.A + (size_t)cur.pm * tstepA; const char* cB = (const char*)g.Bt + (size_t)cur.pn * tstepB;
    S.a_ready(cur);
    if constexpr (SP2) {
        PG8_STAGE(PG8_SB(0, 0), cB, voffB); PG8_STAGE(PG8_SB(0, 1), cB + hstepB, voffB); PG8_STAGE(PG8_SA(0, 0), cA, voffA); PG8_STAGE(PG8_SA(0, 1), cA + hstepA, voffA);
        if (wr == 1) PG8_BAR;
        PG8_WAIT_V(2); PG8_BAR;
        PG8_STAGE(PG8_SB(1, 0), cB + kstep, voffB); PG8_STAGE(PG8_SA(1, 0), cA + kstep, voffA); PG8_STAGE(PG8_SB(1, 1), cB + hstepB + kstep, voffB);
        PG8_WAIT_V(6); PG8_BAR;
    } else {
        PG8_STAGE(PG8_SB(0, 0), cB, voffB); PG8_STAGE(PG8_SA(0, 0), cA, voffA); PG8_STAGE(PG8_SB(0, 1), cB + hstepB, voffB); PG8_STAGE(PG8_SA(0, 1), cA + hstepA, voffA);
        if (wr == 1) PG8_BAR;
        PG8_WAIT_V(4); PG8_BAR;
        PG8_STAGE(PG8_SB(1, 0), cB + kstep, voffB); PG8_STAGE(PG8_SA(1, 0), cA + kstep, voffA); PG8_STAGE(PG8_SB(1, 1), cB + hstepB + kstep, voffB);
        PG8_WAIT_V(6); PG8_BAR;
    }
    for (;;) {
        const bool has_next = S.next(ui + 1, nxt);
        const char* nA = has_next ? (const char*)g.A + (size_t)nxt.pm * tstepA : cA; const char* nB = has_next ? (const char*)g.Bt + (size_t)nxt.pn * tstepB : cB;
        for (int t = 0; t < nt; t += 2) {
            const bool last = (t == nt - 2);
            const char* a1 = cA + (size_t)(t + 1) * kstep;
            const char* a2 = last ? nA : cA + (size_t)(t + 2) * kstep; const char* b2 = last ? nB : cB + (size_t)(t + 2) * kstep;
            const char* a3 = a2 + kstep; const char* b3 = b2 + kstep;
            if (last && has_next) S.a_ready(nxt);
            if constexpr (SP2) {
            PG8_LDB(B0, 0, 0); PG8_LDB(B1, 0, 1); PG8_SCHED; PG8_LDA(At, 0, 0); PG8_STAGE(PG8_SA(1, 1), a1 + hstepA, voffA);
            PG8_WAIT_V(8); PG8_WAIT_L(0); PG8_BAR; PG8_MMA(0, 0, At, B0); PG8_MMA(0, 1, At, B1); PG8_BAR; PG8_SCHED;
            PG8_LDA(At, 0, 1); PG8_STAGE(PG8_SB(0, 0), b2, voffB); PG8_STAGE(PG8_SB(0, 1), b2 + hstepB, voffB); PG8_STAGE(PG8_SA(0, 0), a2, voffA);
            PG8_WAIT_V(8); PG8_WAIT_L(0); PG8_BAR; PG8_MMA(1, 0, At, B0); PG8_MMA(1, 1, At, B1); PG8_BAR; PG8_SCHED;
            PG8_LDB(B0, 1, 0); PG8_LDB(B1, 1, 1); PG8_SCHED; PG8_LDA(At, 1, 0); PG8_STAGE(PG8_SA(0, 1), a2 + hstepA, voffA);
            PG8_WAIT_V(8); PG8_WAIT_L(0); PG8_BAR; PG8_MMA(0, 0, At, B0); PG8_MMA(0, 1, At, B1); PG8_BAR; PG8_SCHED;
            PG8_LDA(At, 1, 1); PG8_STAGE(PG8_SB(1, 0), b3, voffB); PG8_STAGE(PG8_SB(1, 1), b3 + hstepB, voffB); PG8_STAGE(PG8_SA(1, 0), a3, voffA);
            PG8_WAIT_V(8); PG8_WAIT_L(0); PG8_BAR; PG8_MMA(1, 0, At, B0); PG8_MMA(1, 1, At, B1); PG8_BAR; PG8_SCHED;
            } else {
            PG8_LDB(B0, 0, 0); PG8_SCHED; PG8_LDA(At, 0, 0); PG8_STAGE(PG8_SA(1, 1), a1 + hstepA, voffA);
            PG8_WAIT_L(8); PG8_BAR; PG8_WAIT_L(0); PG8_MMA(0, 0, At, B0); PG8_BAR; PG8_SCHED;
            PG8_LDB(B1, 0, 1); PG8_STAGE(PG8_SB(0, 0), b2, voffB);
            PG8_BAR; PG8_WAIT_L(0); PG8_MMA(0, 1, At, B1); PG8_BAR;
            PG8_LDA(At, 0, 1); PG8_STAGE(PG8_SA(0, 0), a2, voffA);
            PG8_BAR; PG8_WAIT_L(0); PG8_MMA(1, 0, At, B0); PG8_BAR; PG8_SCHED;
            PG8_STAGE(PG8_SB(0, 1), b2 + hstepB, voffB);
            PG8_WAIT_V(6); PG8_BAR; PG8_MMA(1, 1, At, B1); PG8_BAR;
            PG8_LDB(B0, 1, 0); PG8_SCHED; PG8_LDA(At, 1, 0); PG8_STAGE(PG8_SA(0, 1), a2 + hstepA, voffA);
            PG8_WAIT_L(8); PG8_BAR; PG8_WAIT_L(0); PG8_MMA(0, 0, At, B0); PG8_BAR; PG8_SCHED;
            PG8_LDB(B1, 1, 1); PG8_STAGE(PG8_SB(1, 0), b3, voffB);
            PG8_BAR; PG8_WAIT_L(0); PG8_MMA(0, 1, At, B1); PG8_BAR;
            PG8_LDA(At, 1, 1); PG8_STAGE(PG8_SA(1, 0), a3, voffA);
            PG8_BAR; PG8_WAIT_L(0); PG8_MMA(1, 0, At, B0); PG8_BAR; PG8_SCHED;
            PG8_STAGE(PG8_SB(1, 1), b3 + hstepB, voffB);
            PG8_WAIT_V(6); PG8_BAR; PG8_MMA(1, 1, At, B1); PG8_BAR;
            }
        }
        if constexpr (FP8) asm volatile("s_nop 15\n\ts_nop 7" ::: "memory");
        if constexpr (ALIGN_EPI) { if (wr == 0) PG8_BAR; }
        if constexpr (!Epi::AFTER_DRAIN) { E(acc, cur, wr, wc, fr, fq); PROBE_EPI_DUP S.done(cur); }
        if (!has_next) break;
#pragma unroll
        for (int a = 0; a < 2; ++a)
#pragma unroll
            for (int b = 0; b < 2; ++b)
#pragma unroll
                for (int m = 0; m < 4; ++m)
#pragma unroll
                    for (int n = 0; n < 2; ++n) acc[a][b][m][n] = (f32x4){0.f, 0.f, 0.f, 0.f};
        cur = nxt; cA = nA; cB = nB; ++ui;
        if constexpr (ALIGN_EPI) { if (wr == 1) PG8_BAR; }
    }
    PG8_WAIT_V(0);
    if constexpr (!ALIGN_EPI) { if (wr == 0) PG8_BAR; }
    PG8_BAR;
    if constexpr (Epi::AFTER_DRAIN) { E.fused(acc, cur, wr, wc, fr, fq, lds, wid, lane); S.done(cur); }
#undef PG8_SA
#undef PG8_SB
#undef PG8_STAGE
#undef PG8_LDA
#undef PG8_LDB
#undef PG8_MMA
#undef PG8_WAIT_V
#undef PG8_WAIT_L
#undef PG8_BAR
#undef PG8_SCHED
}
}
#define XB_TMO      128
#define XB_XCNT(j)  (256  + 64 * (j))
#define XB_XSUB(j)  (1280 + 64 * (j))
#define XB_XGEN(j)  (2304 + 64 * (j))
#define XB_TOP      3328
#define XB_TOPGEN   3392
#define XCD_BAR_WORDS 3456
#define XB_SPIN_CAP (1u << 18)

__device__ __forceinline__ unsigned xb_ld(unsigned* p)              { return __hip_atomic_load(p, __ATOMIC_RELAXED, __HIP_MEMORY_SCOPE_AGENT); }
__device__ __forceinline__ unsigned xb_add(unsigned* p, unsigned v) { return __hip_atomic_fetch_add(p, v, __ATOMIC_RELAXED, __HIP_MEMORY_SCOPE_AGENT); }
__device__ __forceinline__ unsigned xb_xcc_id() { return (unsigned)__builtin_amdgcn_s_getreg((3 << 11) | 20) & 0xFu; }
#define XB_SPIN(cond, bar) do { unsigned _sp = 0; while (cond) { __builtin_amdgcn_s_sleep(1); \
    if ((++_sp & 255u) == 0u) { if (xb_ld(&(bar)[XB_TMO])) break; if (_sp > XB_SPIN_CAP) { atomicAdd(&(bar)[XB_TMO], 1u); break; } } } } while (0)

struct XcdBarrier {
    unsigned* bar; unsigned x;
    volatile LAS unsigned* st;
};

__device__ __forceinline__ XcdBarrier xcd_barrier_post(unsigned* bar, volatile LAS unsigned* st) {
    XcdBarrier b; b.bar = bar; b.x = xb_xcc_id(); b.st = st;
    if (threadIdx.x == 0) (void)xb_add(&bar[XB_XCNT(b.x)], 1u);
    return b;
}
__device__ __forceinline__ void xcd_barrier_complete(unsigned* bar, unsigned x, unsigned& nloc, unsigned& nx) {
    const unsigned G = gridDim.x * gridDim.y * gridDim.z;
    unsigned sum, cnt, mine, sp = 0u;
    for (;;) {
        sum = 0u; cnt = 0u; mine = 0u;
#pragma unroll
        for (unsigned j = 0; j < 16; ++j) { const unsigned c = xb_ld(&bar[XB_XCNT(j)]); sum += c; cnt += (c > 0u) ? 1u : 0u; mine = (j == x) ? c : mine; }
        if (sum == G) break;
        __builtin_amdgcn_s_sleep(1);
        if ((++sp & 255u) == 0u) { if (xb_ld(&bar[XB_TMO])) break; if (sp > XB_SPIN_CAP) { atomicAdd(&bar[XB_TMO], 1u); break; } }
    }
    nloc = mine > 0u ? mine : 1u; nx = cnt > 0u ? cnt : 1u;
}

__device__ __forceinline__ void xcd_barrier(const XcdBarrier& b) {
    asm volatile("s_waitcnt vmcnt(0)" ::: "memory");
    __syncthreads();
    if (threadIdx.x == 0) {
        unsigned* bar = b.bar;
        __builtin_amdgcn_s_waitcnt(0);
        unsigned nloc = b.st[0], nx = b.st[1];
        if (nloc == 0u) { xcd_barrier_complete(bar, b.x, nloc, nx); b.st[0] = nloc; b.st[1] = nx; }
        const unsigned old = xb_add(&bar[XB_XSUB(b.x)], 1u);
        const unsigned gen = old / nloc;
        if (old + 1u == (gen + 1u) * nloc) {
            __builtin_amdgcn_fence(__ATOMIC_RELEASE, "agent");
            asm volatile("s_waitcnt vmcnt(0)" ::: "memory");
            const unsigned og = xb_add(&bar[XB_TOP], 1u);
            const unsigned tg = og / nx;
            if (og + 1u == (tg + 1u) * nx) xb_add(&bar[XB_TOPGEN], 1u);
            else XB_SPIN(xb_ld(&bar[XB_TOPGEN]) == tg, bar);
            __builtin_amdgcn_fence(__ATOMIC_ACQUIRE, "agent");
            xb_add(&bar[XB_XGEN(b.x)], 1u);
            asm volatile("s_waitcnt vmcnt(0)" ::: "memory");
        } else {
            XB_SPIN(xb_ld(&bar[XB_XGEN(b.x)]) == gen, bar);
            __builtin_amdgcn_fence(__ATOMIC_ACQUIRE, "agent");
            asm volatile("s_waitcnt vmcnt(0)" ::: "memory");
        }
    }
    __syncthreads();
}
namespace dattn {
typedef unsigned short bf16;
constexpr int   D = 128, NW = 8, QBLK = 32, KVBLK = 64;
constexpr float SCALE = 0.088388347648318440f;
constexpr float THR = 8.f;
constexpr int SDEPTH = 2;
constexpr int LDQ = 4096, LDK = 1024, LDO = 4096;
constexpr size_t SHM_V = KVBLK * D * 2, SHM_K = KVBLK * D * 2, SHM_ATTN = 3 * SHM_V + 3 * SHM_K + NW * 64 * 4 + 2048;
using bf16x8 = __attribute__((ext_vector_type(8))) short;
using s16x4  = __attribute__((ext_vector_type(4))) short;
using f32x16 = __attribute__((ext_vector_type(16))) float;
using f32x8  = __attribute__((ext_vector_type(8))) float;
using u32x4  = __attribute__((ext_vector_type(4))) unsigned;
#define KSWZ(row, colB) ((row) * 256 + ((colB) ^ (((row) & 7) << 4)))
#define SBAR() __builtin_amdgcn_sched_barrier(0)
__device__ __forceinline__ int crow(int r, int hi) { return (r & 3) + 8 * (r >> 2) + 4 * hi; }
__device__ __forceinline__ unsigned cvtpk(float lo, float hi) {
  unsigned r; asm volatile("v_cvt_pk_bf16_f32 %0, %1, %2" : "=v"(r) : "v"(lo), "v"(hi)); return r;
}
template <typename TIn> struct Stage;
template <> struct Stage<bf16>  { using T = bf16x8;
  __device__ static __forceinline__ T ld8(const bf16* p) { return *reinterpret_cast<const bf16x8*>(p); }
  __device__ static __forceinline__ bf16x8 tobf(T x) { return x; } };
template <> struct Stage<float> { using T = f32x8;
  __device__ static __forceinline__ T ld8(const float* p) { return *reinterpret_cast<const f32x8*>(p); }
  __device__ static __forceinline__ bf16x8 tobf(T x) {
    u32x4 w = {cvtpk(x[0], x[1]), cvtpk(x[2], x[3]), cvtpk(x[4], x[5]), cvtpk(x[6], x[7])}; return *reinterpret_cast<bf16x8*>(&w); } };

__device__ __forceinline__ void partialSM(f32x16& p0, f32x16& p1, float& m_reg, float& mn, float& alpha) {
  constexpr float C = SCALE * 1.4426950408889634f;
  float pmax = p0[0]; for (int r = 1; r < 16; ++r) pmax = fmaxf(pmax, p0[r]); for (int r = 0; r < 16; ++r) pmax = fmaxf(pmax, p1[r]);
  { auto rr = __builtin_amdgcn_permlane32_swap(__float_as_uint(pmax), __float_as_uint(pmax), false, false);
    pmax = fmaxf(__uint_as_float(rr[0]), __uint_as_float(rr[1])); }
  if (__builtin_expect(__all(pmax - m_reg <= THR / SCALE), 1)) { mn = m_reg; alpha = 1.f; }
  else { mn = fmaxf(m_reg, pmax); alpha = __builtin_amdgcn_exp2f((m_reg - mn) * C); m_reg = mn; }
  float mnC = -mn * C;
  for (int r = 0; r < 16; ++r) p0[r] = fmaf(p0[r], C, mnC); for (int r = 0; r < 16; ++r) p1[r] = fmaf(p1[r], C, mnC);
  for (int r = 0; r < 16; ++r) p0[r] = __builtin_amdgcn_exp2f(p0[r]);
}
__device__ __forceinline__ void finishSM(f32x16& p0, f32x16& p1, float alpha, float& l_reg, bf16x8& pa0, bf16x8& pa1, bf16x8& pa2, bf16x8& pa3) {
  for (int r = 0; r < 16; ++r) p1[r] = __builtin_amdgcn_exp2f(p1[r]);
  float ps = 0; for (int r = 0; r < 16; ++r) ps += p0[r]; for (int r = 0; r < 16; ++r) ps += p1[r];
  { auto rr = __builtin_amdgcn_permlane32_swap(__float_as_uint(ps), __float_as_uint(ps), false, false);
    ps = __uint_as_float(rr[0]) + __uint_as_float(rr[1]); }
  l_reg = l_reg * alpha + ps;
#define PK4(P, BASE, OUT) do { unsigned a0 = cvtpk(P[BASE + 0], P[BASE + 1]), a1 = cvtpk(P[BASE + 2], P[BASE + 3]);   \
    unsigned b0 = cvtpk(P[BASE + 4], P[BASE + 5]), b1 = cvtpk(P[BASE + 6], P[BASE + 7]);                              \
    auto r0 = __builtin_amdgcn_permlane32_swap(a0, b0, false, false); auto r1 = __builtin_amdgcn_permlane32_swap(a1, b1, false, false); \
    u32x4 w = {r0[0], r1[0], r0[1], r1[1]}; OUT = *reinterpret_cast<bf16x8*>(&w); } while (0)
  PK4(p0, 0, pa0); PK4(p0, 8, pa1); PK4(p1, 0, pa2); PK4(p1, 8, pa3);
#undef PK4
}
__device__ __forceinline__ void qkt(f32x16& p0, f32x16& p1, const bf16* Ks, const bf16x8* qr, int r32, int hi) {
  p0 = f32x16{}; p1 = f32x16{};
  bf16x8 nb0 = *reinterpret_cast<const bf16x8*>((const char*)Ks + KSWZ(r32, (hi * 8) * 2)), nb1 = *reinterpret_cast<const bf16x8*>((const char*)Ks + KSWZ(32 + r32, (hi * 8) * 2));
#pragma unroll
  for (int d0 = 0; d0 < 8; ++d0) { const bf16x8 b0 = nb0, b1 = nb1;
    if (d0 < 7) { const int cb = ((d0 + 1) * 16 + hi * 8) * 2;
      nb0 = *reinterpret_cast<const bf16x8*>((const char*)Ks + KSWZ(r32, cb)); nb1 = *reinterpret_cast<const bf16x8*>((const char*)Ks + KSWZ(32 + r32, cb)); }
    p0 = __builtin_amdgcn_mfma_f32_32x32x16_bf16(b0, qr[d0], p0, 0, 0, 0);
    p1 = __builtin_amdgcn_mfma_f32_32x32x16_bf16(b1, qr[d0], p1, 0, 0, 0); }
}
__device__ __forceinline__ int v_st(int k, int c) { const int kk = (k & ~0xC) | ((k & 4) << 1) | ((k & 8) >> 1); return ((kk >> 3) * 4 + (c >> 5)) * 512 + ((kk & 7) * 32 + (c & 31)) * 2; }
__device__ __forceinline__ int v_rd_base(int lane) { return ((lane & 3) << 3) | (((lane >> 2) & 3) << 6) | (((lane >> 4) & 1) << 5) | (((lane >> 5) & 1) << 8); }
constexpr int v_rd_off(int d0, int ks, int half) { return d0 * 512 + ks * 4096 + half * 2048; }
template <int OFF> __device__ __forceinline__ s16x4 tr_read(int vb) {
  s16x4 r; asm volatile("ds_read_b64_tr_b16 %0, %1 offset:%2" : "=&v"(r) : "v"(vb), "i"(OFF) : "memory"); return r;
}
template <int D0> __device__ __forceinline__ void pv_one(f32x16& od, int vb, bf16x8 pa0, bf16x8 pa1, bf16x8 pa2, bf16x8 pa3) {
  const s16x4 l0 = tr_read<v_rd_off(D0, 0, 0)>(vb), h0 = tr_read<v_rd_off(D0, 0, 1)>(vb), l1 = tr_read<v_rd_off(D0, 1, 0)>(vb), h1 = tr_read<v_rd_off(D0, 1, 1)>(vb);
  const s16x4 l2 = tr_read<v_rd_off(D0, 2, 0)>(vb), h2 = tr_read<v_rd_off(D0, 2, 1)>(vb), l3 = tr_read<v_rd_off(D0, 3, 0)>(vb), h3 = tr_read<v_rd_off(D0, 3, 1)>(vb);
  asm volatile("s_waitcnt lgkmcnt(0)" ::: "memory"); SBAR();
#define PK(L, H) (bf16x8){L[0], L[1], L[2], L[3], H[0], H[1], H[2], H[3]}
  od = __builtin_amdgcn_mfma_f32_32x32x16_bf16(pa0, PK(l0, h0), od, 0, 0, 0);
  od = __builtin_amdgcn_mfma_f32_32x32x16_bf16(pa1, PK(l1, h1), od, 0, 0, 0);
  od = __builtin_amdgcn_mfma_f32_32x32x16_bf16(pa2, PK(l2, h2), od, 0, 0, 0);
  od = __builtin_amdgcn_mfma_f32_32x32x16_bf16(pa3, PK(l3, h3), od, 0, 0, 0);
#undef PK
}
__device__ __forceinline__ void pv_d0(f32x16* o, int vb, bf16x8 pa0, bf16x8 pa1, bf16x8 pa2, bf16x8 pa3) {
  pv_one<0>(o[0], vb, pa0, pa1, pa2, pa3); pv_one<1>(o[1], vb, pa0, pa1, pa2, pa3); pv_one<2>(o[2], vb, pa0, pa1, pa2, pa3); pv_one<3>(o[3], vb, pa0, pa1, pa2, pa3);
}

template <typename TQ>
__device__ __forceinline__ void attn_dense_body(const TQ* __restrict__ Qb, const bf16* __restrict__ Kh, const bf16* __restrict__ Vh,
                                                bf16* __restrict__ Ob, int seq, char* lds) {
  using St = Stage<bf16>; using SQ = Stage<TQ>;
  int tid_o = threadIdx.x; asm volatile("" : "+v"(tid_o)); const int tid = tid_o, wid = __builtin_amdgcn_readfirstlane(tid >> 6), lane = tid & 63, r32 = lane & 31, hi = lane >> 5;
  bf16* V_lds = (bf16*)lds; bf16* K_lds = (bf16*)(lds + 3 * SHM_V);
  float* ws = (float*)(lds + 3 * SHM_V + 3 * SHM_K) + wid * 64; float* li_l = ws; float* al_l = ws + 32;
  float m_reg = -1e30f, l_reg = 0; f32x16 o[4] = {}; bf16x8 qr[8];
  const TQ* Qw = Qb + (long)(wid * QBLK + r32) * LDQ + hi * 8;
#pragma unroll
  for (int d0 = 0; d0 < 8; ++d0) qr[d0] = SQ::tobf(SQ::ld8(Qw + d0 * 16));
  const int sr = tid >> 4, sc = (tid & 15) * 8, vst0 = v_st(sr, sc), vst1 = v_st(32 + sr, sc);
  const int vb0 = (int)(uintptr_t)V_lds + v_rd_base(lane);
  struct { typename St::T vs0, vs1, ks0, ks1; } sr_[SDEPTH];
#define SLOAD(i, k0) do { sr_[i].vs0 = St::ld8(&Vh[(long)((k0) + sr) * LDK + sc]); sr_[i].vs1 = St::ld8(&Vh[(long)((k0) + 32 + sr) * LDK + sc]); \
    sr_[i].ks0 = St::ld8(&Kh[(long)((k0) + sr) * LDK + sc]); sr_[i].ks1 = St::ld8(&Kh[(long)((k0) + 32 + sr) * LDK + sc]); } while (0)
#define SWRITE(b, i) do { *(bf16x8*)((char*)V_lds + (b) * SHM_V + vst0) = St::tobf(sr_[i].vs0);          \
    *(bf16x8*)((char*)V_lds + (b) * SHM_V + vst1) = St::tobf(sr_[i].vs1); int kc = sc * 2;               \
    *(bf16x8*)((char*)K_lds + (b) * SHM_K + KSWZ(sr, kc)) = St::tobf(sr_[i].ks0);                       \
    *(bf16x8*)((char*)K_lds + (b) * SHM_K + KSWZ(32 + sr, kc)) = St::tobf(sr_[i].ks1); } while (0)
#define SWAIT() do { if constexpr (SDEPTH == 2) asm volatile("s_waitcnt vmcnt(4)" ::: "memory"); else asm volatile("s_waitcnt vmcnt(0)" ::: "memory"); } while (0)
#define RESC(a) do { if (__any((a) < 1.f)) { if (hi == 0) al_l[r32] = (a); asm volatile("s_waitcnt lgkmcnt(0)" ::: "memory"); \
    for (int d = 0; d < 4; ++d) for (int r = 0; r < 16; ++r) o[d][r] *= al_l[crow(r, hi)]; } } while (0)
  f32x16 pA0, pA1, pB0, pB1; float mnA, mnB, alA, alB; bf16x8 pa0, pa1, pa2, pa3; const int NT = seq / KVBLK;
  constexpr int SE = 0, SO = SDEPTH - 1;
  SLOAD(SE, 0); asm volatile("s_waitcnt vmcnt(0)" ::: "memory"); SWRITE(0, SE); __syncthreads();
  qkt(pA0, pA1, K_lds, qr, r32, hi); partialSM(pA0, pA1, m_reg, mnA, alA);
  SLOAD(SO, KVBLK); if constexpr (SDEPTH == 2) { if (2 < NT) SLOAD(SE, 2 * KVBLK); }
  SWAIT(); SWRITE(1, SO); __syncthreads();
  int bk = 1, bv = 0, bw = 2;
  if (wid >= 4) __builtin_amdgcn_s_setprio(1);
#define ROT3() do { const int t_ = bv; bv = bk; bk = bw; bw = t_; } while (0)
  for (int j = 1; j + 1 < NT; j += 2) {
    SBAR(); qkt(pB0, pB1, (bf16*)((char*)K_lds + bk * SHM_K), qr, r32, hi);
    finishSM(pA0, pA1, alA, l_reg, pa0, pa1, pa2, pa3); SBAR();
    SLOAD(SO, (j + SDEPTH) * KVBLK); SBAR();
    pv_d0(o, vb0 + bv * (int)SHM_V, pa0, pa1, pa2, pa3); partialSM(pB0, pB1, m_reg, mnB, alB);
    SWAIT(); SWRITE(bw, SE);
    RESC(alB); __syncthreads(); ROT3();
    SBAR(); qkt(pA0, pA1, (bf16*)((char*)K_lds + bk * SHM_K), qr, r32, hi);
    finishSM(pB0, pB1, alB, l_reg, pa0, pa1, pa2, pa3); SBAR();
    if (SDEPTH == 1 || j + 3 < NT) SLOAD(SE, (j + 1 + SDEPTH) * KVBLK); SBAR();
    pv_d0(o, vb0 + bv * (int)SHM_V, pa0, pa1, pa2, pa3); partialSM(pA0, pA1, m_reg, mnA, alA);
    SWAIT(); SWRITE(bw, SO);
    RESC(alA); __syncthreads(); ROT3();
  }
  SBAR(); qkt(pB0, pB1, (bf16*)((char*)K_lds + bk * SHM_K), qr, r32, hi);
  finishSM(pA0, pA1, alA, l_reg, pa0, pa1, pa2, pa3); SBAR();
  pv_d0(o, vb0 + bv * (int)SHM_V, pa0, pa1, pa2, pa3); partialSM(pB0, pB1, m_reg, mnB, alB);
  RESC(alB);
  finishSM(pB0, pB1, alB, l_reg, pa0, pa1, pa2, pa3); SBAR();
  pv_d0(o, vb0 + bk * (int)SHM_V, pa0, pa1, pa2, pa3);
#undef ROT3
  __builtin_amdgcn_s_setprio(0);
  if (hi == 0) li_l[r32] = l_reg; asm volatile("s_waitcnt lgkmcnt(0)" ::: "memory");
  float rli[16];
#pragma unroll
  for (int r = 0; r < 16; ++r) rli[r] = __builtin_amdgcn_rcpf(li_l[crow(r, hi)]);
  bf16* Ow = Ob + (long)(wid * QBLK) * LDO;
#pragma unroll
  for (int r = 0; r < 16; ++r) { int orow = crow(r, hi);
    for (int d0 = 0; d0 < 4; ++d0) Ow[(long)orow * LDO + d0 * 32 + r32] = (bf16)(cvtpk(o[d0][r] * rli[r], 0.f) & 0xffffu); }
#undef SLOAD
#undef SWRITE
#undef SWAIT
#undef RESC
}

constexpr int NA_LD = 4096, NA_TILES = 12;
__device__ __forceinline__ void na_block_body(const bf16* __restrict__ Qb, const bf16* __restrict__ Kh, const bf16* __restrict__ Vh, bf16* __restrict__ Ob,
                                              const float* __restrict__ rpb_h, const float* __restrict__ qgain, const float* __restrict__ kgain, int R, int ks, char* lds) {
  using St = Stage<bf16>;
  int tid_o = threadIdx.x; asm volatile("" : "+v"(tid_o)); const int tid = tid_o, wid = __builtin_amdgcn_readfirstlane(tid >> 6), lane = tid & 63, r32 = lane & 31, hi = lane >> 5;
  bf16* V_lds = (bf16*)lds; bf16* K_lds = (bf16*)(lds + 2 * SHM_V);
  float* ws = (float*)(lds + 2 * SHM_V + 2 * SHM_K) + wid * 64; float* li_l = ws; float* al_l = ws + 32;
  float* bt = (float*)(lds + 2 * SHM_V + 2 * SHM_K + NW * 64 * 4);
  float m_reg = -1e30f, l_reg = 0; f32x16 o[4] = {}; bf16x8 qr[8];
  const bf16* Qw = Qb + (long)(wid * QBLK + r32) * NA_LD + hi * 8;
#pragma unroll
  for (int d0 = 0; d0 < 8; ++d0) qr[d0] = St::ld8(Qw + d0 * 16);
  {
    float ss = 0.f;
#pragma unroll
    for (int d0 = 0; d0 < 8; ++d0) { const u32x4 w = __builtin_bit_cast(u32x4, qr[d0]);
#pragma unroll
      for (int e = 0; e < 4; ++e) { const float a = __uint_as_float(w[e] << 16), b = __uint_as_float(w[e] & 0xffff0000u); ss += a * a + b * b; } }
    ss += __shfl_xor(ss, 32);
    const float rinv = __builtin_amdgcn_rsqf(ss * (1.0f / 128.0f) + 1e-6f);
#pragma unroll
    for (int d0 = 0; d0 < 8; ++d0) { const u32x4 w = __builtin_bit_cast(u32x4, qr[d0]); const float* gp = qgain + d0 * 16 + hi * 8;
      const f32x8 g = *reinterpret_cast<const f32x8*>(gp); u32x4 o;
#pragma unroll
      for (int e = 0; e < 4; ++e) o[e] = cvtpk(__uint_as_float(w[e] << 16) * rinv * g[2 * e], __uint_as_float(w[e] & 0xffff0000u) * rinv * g[2 * e + 1]);
      qr[d0] = __builtin_bit_cast(bf16x8, o); } }
  const f32x8 kg = *reinterpret_cast<const f32x8*>(kgain + (tid & 15) * 8);
  for (int i = tid; i < 15 * 31; i += 64 * NW) bt[i] = rpb_h[i];
  const int sr = tid >> 4, sc = (tid & 15) * 8, vst0 = v_st(sr, sc), vst1 = v_st(32 + sr, sc);
  const int vb0 = (int)(uintptr_t)V_lds + v_rd_base(lane);
  bf16x8 s_vs0, s_vs1, s_ks0, s_ks1;
#define NLOAD(k0) do { s_vs0 = St::ld8(&Vh[(long)((k0) + sr) * NA_LD + sc]); s_vs1 = St::ld8(&Vh[(long)((k0) + 32 + sr) * NA_LD + sc]); \
    s_ks0 = St::ld8(&Kh[(long)((k0) + sr) * NA_LD + sc]); s_ks1 = St::ld8(&Kh[(long)((k0) + 32 + sr) * NA_LD + sc]); } while (0)
#define KNORM(x) do { const u32x4 w_ = __builtin_bit_cast(u32x4, x); float a_[8]; float ss_ = 0.f; \
    _Pragma("unroll") for (int e = 0; e < 4; ++e) { a_[2 * e] = __uint_as_float(w_[e] << 16); a_[2 * e + 1] = __uint_as_float(w_[e] & 0xffff0000u); ss_ += a_[2 * e] * a_[2 * e] + a_[2 * e + 1] * a_[2 * e + 1]; } \
    ss_ += __shfl_xor(ss_, 1); ss_ += __shfl_xor(ss_, 2); ss_ += __shfl_xor(ss_, 4); ss_ += __shfl_xor(ss_, 8); \
    const float ri_ = __builtin_amdgcn_rsqf(ss_ * (1.0f / 128.0f) + 1e-6f); u32x4 o_; \
    _Pragma("unroll") for (int e = 0; e < 4; ++e) o_[e] = cvtpk(a_[2 * e] * ri_ * kg[2 * e], a_[2 * e + 1] * ri_ * kg[2 * e + 1]); \
    x = __builtin_bit_cast(bf16x8, o_); } while (0)
#define NWRITE(b) do { KNORM(s_ks0); KNORM(s_ks1); \
    *(bf16x8*)((char*)V_lds + (b) * SHM_V + vst0) = s_vs0; *(bf16x8*)((char*)V_lds + (b) * SHM_V + vst1) = s_vs1; const int kc_ = sc * 2; \
    *(bf16x8*)((char*)K_lds + (b) * SHM_K + KSWZ(sr, kc_)) = s_ks0; *(bf16x8*)((char*)K_lds + (b) * SHM_K + KSWZ(32 + sr, kc_)) = s_ks1; } while (0)
  const int qrow = R + (wid >> 1), r0q = min(max(qrow - 4, 0), 248), jlo = r0q - ks;
  const int c = 32 * (wid & 1) + r32, c0 = min(max(c - 8, 0), 48);
  NLOAD(0); asm volatile("s_waitcnt vmcnt(0)" ::: "memory"); NWRITE(0); __syncthreads();
  for (int j = 0; j < NA_TILES; ++j) {
    const int buf = j & 1;
    if (j + 1 < NA_TILES) NLOAD((j + 1) * KVBLK);
    if (j >= jlo && j < jlo + 8) {
      f32x16 p0, p1; float mn, al; bf16x8 pa0, pa1, pa2, pa3;
      SBAR(); qkt(p0, p1, (bf16*)((char*)K_lds + buf * SHM_K), qr, r32, hi);
      const float* brow = bt + (ks + j - qrow + 7) * 31 + (15 - c);
#pragma unroll
      for (int r = 0; r < 16; ++r) { const int k0 = crow(r, hi), k1 = 32 + k0; const bool v0 = (k0 >= c0) && (k0 < c0 + 16), v1 = (k1 >= c0) && (k1 < c0 + 16);
        const float b0 = brow[v0 ? k0 : c], b1 = brow[v1 ? k1 : c];
        p0[r] = v0 ? fmaf(b0, 1.0f / SCALE, p0[r]) : -1e30f; p1[r] = v1 ? fmaf(b1, 1.0f / SCALE, p1[r]) : -1e30f; }
      partialSM(p0, p1, m_reg, mn, al);
      if (__any(al < 1.f)) { if (hi == 0) al_l[r32] = al; asm volatile("s_waitcnt lgkmcnt(0)" ::: "memory");
#pragma unroll
        for (int d = 0; d < 4; ++d)
#pragma unroll
          for (int r = 0; r < 16; ++r) o[d][r] *= al_l[crow(r, hi)]; }
      finishSM(p0, p1, al, l_reg, pa0, pa1, pa2, pa3); SBAR();
      pv_d0(o, vb0 + buf * (int)SHM_V, pa0, pa1, pa2, pa3);
    }
    if (j + 1 < NA_TILES) { asm volatile("s_waitcnt vmcnt(0)" ::: "memory"); NWRITE(buf ^ 1); }
    __syncthreads();
  }
  if (hi == 0) li_l[r32] = l_reg; asm volatile("s_waitcnt lgkmcnt(0)" ::: "memory");
  float rli[16];
#pragma unroll
  for (int r = 0; r < 16; ++r) rli[r] = __builtin_amdgcn_rcpf(li_l[crow(r, hi)]);
  bf16* Ow = Ob + (long)(wid * QBLK) * NA_LD;
#pragma unroll
  for (int r = 0; r < 16; ++r) { const int orow = crow(r, hi);
    for (int d0 = 0; d0 < 4; ++d0) Ow[(long)orow * NA_LD + d0 * 32 + r32] = (bf16)(cvtpk(o[d0][r] * rli[r], 0.f) & 0xffffu); }
#undef NLOAD
#undef NWRITE
#undef KNORM
}

typedef int v8i __attribute__((ext_vector_type(8)));
typedef unsigned u32x2 __attribute__((ext_vector_type(2)));
constexpr int K8_LD = 1024, V8_LD = 16384, SHM_K8 = KVBLK * D, SHM_V8 = KVBLK * D;
constexpr float THR8 = 3.0f;
__device__ __forceinline__ int cvt4_fp8(float a, float b, float c, float d) { int w = __builtin_amdgcn_cvt_pk_fp8_f32(a, b, 0, false); return __builtin_amdgcn_cvt_pk_fp8_f32(c, d, w, true); }
__device__ __forceinline__ v8i mk8(u32x4 lo, u32x4 hi) { return (v8i){(int)lo[0], (int)lo[1], (int)lo[2], (int)lo[3], (int)hi[0], (int)hi[1], (int)hi[2], (int)hi[3]}; }
__device__ __forceinline__ void qkt8(f32x16& p0, f32x16& p1, const char* Ks, const v8i* qf, int r32, int hi) {
  const int x0 = (r32 >> 1) & 7, x1 = ((32 + r32) >> 1) & 7;
  const char* k0 = Ks + r32 * 128; const char* k1 = Ks + (32 + r32) * 128;
  v8i a[2][2];
#pragma unroll
  for (int s = 0; s < 2; ++s) { const int c = 4 * s + 2 * hi;
    a[0][s] = mk8(*reinterpret_cast<const u32x4*>(k0 + 16 * (c ^ x0)), *reinterpret_cast<const u32x4*>(k0 + 16 * ((c + 1) ^ x0)));
    a[1][s] = mk8(*reinterpret_cast<const u32x4*>(k1 + 16 * (c ^ x1)), *reinterpret_cast<const u32x4*>(k1 + 16 * ((c + 1) ^ x1))); }
  p0 = f32x16{}; p1 = f32x16{};
#pragma unroll
  for (int s = 0; s < 2; ++s) {
    p0 = __builtin_amdgcn_mfma_scale_f32_32x32x64_f8f6f4(a[0][s], qf[s], p0, 0, 0, 0, 0x7F7F7F7F, 0, 0x7F7F7F7F);
    p1 = __builtin_amdgcn_mfma_scale_f32_32x32x64_f8f6f4(a[1][s], qf[s], p1, 0, 0, 0, 0x7F7F7F7F, 0, 0x7F7F7F7F); }
}
__device__ __forceinline__ void partialSM8(f32x16& p0, f32x16& p1, float& m_reg, float& mn, float& alpha) {
  constexpr float C = SCALE * 1.4426950408889634f;
  float pmax = p0[0]; for (int r = 1; r < 16; ++r) pmax = fmaxf(pmax, p0[r]); for (int r = 0; r < 16; ++r) pmax = fmaxf(pmax, p1[r]);
  { auto rr = __builtin_amdgcn_permlane32_swap(__float_as_uint(pmax), __float_as_uint(pmax), false, false);
    pmax = fmaxf(__uint_as_float(rr[0]), __uint_as_float(rr[1])); }
  if (__builtin_expect(__all(pmax - m_reg <= THR8 / SCALE), 1)) { mn = m_reg; alpha = 1.f; }
  else { mn = fmaxf(m_reg, pmax); alpha = __builtin_amdgcn_exp2f((m_reg - mn) * C); m_reg = mn; }
  const float mnC = 4.0f - mn * C;
  for (int r = 0; r < 16; ++r) p0[r] = fmaf(p0[r], C, mnC); for (int r = 0; r < 16; ++r) p1[r] = fmaf(p1[r], C, mnC);
  for (int r = 0; r < 16; ++r) p0[r] = __builtin_amdgcn_exp2f(p0[r]);
}
__device__ __forceinline__ void finishSM8(f32x16& p0, f32x16& p1, float alpha, float& l_reg, v8i& pa) {
  for (int r = 0; r < 16; ++r) p1[r] = __builtin_amdgcn_exp2f(p1[r]);
  float ps = 0; for (int r = 0; r < 16; ++r) ps += p0[r]; for (int r = 0; r < 16; ++r) ps += p1[r];
  { auto rr = __builtin_amdgcn_permlane32_swap(__float_as_uint(ps), __float_as_uint(ps), false, false);
    ps = __uint_as_float(rr[0]) + __uint_as_float(rr[1]); }
  l_reg = l_reg * alpha + ps;
#pragma unroll
  for (int v = 0; v < 4; ++v) { pa[v] = cvt4_fp8(p0[4 * v], p0[4 * v + 1], p0[4 * v + 2], p0[4 * v + 3]); pa[4 + v] = cvt4_fp8(p1[4 * v], p1[4 * v + 1], p1[4 * v + 2], p1[4 * v + 3]); }
}
__device__ __forceinline__ void pv8(f32x16* o, const char* Vs, const v8i& pa, int r32, int hi) {
  v8i b[4];
#pragma unroll
  for (int db = 0; db < 4; ++db) { const int d = 32 * db + r32, x = (d >> 2) & 3; const char* vp = Vs + d * 64;
    b[db] = mk8(*reinterpret_cast<const u32x4*>(vp + 16 * ((2 * hi) ^ x)), *reinterpret_cast<const u32x4*>(vp + 16 * ((2 * hi + 1) ^ x))); }
#pragma unroll
  for (int db = 0; db < 4; ++db) o[db] = __builtin_amdgcn_mfma_scale_f32_32x32x64_f8f6f4(pa, b[db], o[db], 0, 0, 0, 0x7F7F7F7F, 0, 0x7F7F7F7F);
}
__device__ __forceinline__ void attn_dense_body8(const bf16* __restrict__ Qb, const unsigned char* __restrict__ K8h, const unsigned char* __restrict__ V8h, bf16* __restrict__ Ob, int seq, char* lds) {
  int tid_o = threadIdx.x; asm volatile("" : "+v"(tid_o)); const int tid = tid_o, wid = __builtin_amdgcn_readfirstlane(tid >> 6), lane = tid & 63, r32 = lane & 31, hi = lane >> 5;
  char* V_lds = lds; char* K_lds = lds + 3 * SHM_V8;
  float* ws = (float*)(lds + 3 * SHM_V8 + 3 * SHM_K8) + wid * 64; float* li_l = ws; float* al_l = ws + 32;
  float m_reg = -1e30f, l_reg = 0; f32x16 o[4] = {}; v8i qf[2];
  { const bf16* Qw = Qb + (long)(wid * QBLK + r32) * LDQ + hi * 32;
#pragma unroll
    for (int s = 0; s < 2; ++s) {
#pragma unroll
      for (int c = 0; c < 4; ++c) { const u32x4 w = *reinterpret_cast<const u32x4*>(Qw + s * 64 + c * 8);
        qf[s][2 * c] = cvt4_fp8(__uint_as_float(w[0] << 16), __uint_as_float(w[0] & 0xffff0000u), __uint_as_float(w[1] << 16), __uint_as_float(w[1] & 0xffff0000u));
        qf[s][2 * c + 1] = cvt4_fp8(__uint_as_float(w[2] << 16), __uint_as_float(w[2] & 0xffff0000u), __uint_as_float(w[3] << 16), __uint_as_float(w[3] & 0xffff0000u)); } } }
  const int skey = tid >> 3, sck = tid & 7, sd = tid >> 2, sc4 = tid & 3;
  const int kst = skey * 128 + 16 * (sck ^ ((skey >> 1) & 7));
  const int vx = (sd >> 2) & 3, vst0 = sd * 64 + 16 * ((sc4 >> 1) ^ vx) + 8 * (sc4 & 1), vst1 = sd * 64 + 16 * ((2 + (sc4 >> 1)) ^ vx) + 8 * (sc4 & 1);
  const unsigned char* kg = K8h + (long)skey * K8_LD + 16 * sck; const unsigned char* vg = V8h + (long)sd * V8_LD + 16 * sc4;
  struct { u32x4 k, v; } sr_[2];
#define SLOAD8(i, k0) do { sr_[i].k = *reinterpret_cast<const u32x4*>(kg + (long)(k0) * K8_LD); sr_[i].v = *reinterpret_cast<const u32x4*>(vg + (k0)); } while (0)
#define SWRITE8(b, i) do { *reinterpret_cast<u32x4*>(K_lds + (b) * SHM_K8 + kst) = sr_[i].k; \
    *reinterpret_cast<u32x2*>(V_lds + (b) * SHM_V8 + vst0) = (u32x2){sr_[i].v[0], sr_[i].v[2]}; *reinterpret_cast<u32x2*>(V_lds + (b) * SHM_V8 + vst1) = (u32x2){sr_[i].v[1], sr_[i].v[3]}; } while (0)
#define SWAIT8() asm volatile("s_waitcnt vmcnt(2)" ::: "memory")
#define RESC8(a) do { if (__any((a) < 1.f)) { if (hi == 0) al_l[r32] = (a); asm volatile("s_waitcnt lgkmcnt(0)" ::: "memory"); \
    for (int d = 0; d < 4; ++d) for (int r = 0; r < 16; ++r) o[d][r] *= al_l[crow(r, hi)]; } } while (0)
  f32x16 pA0, pA1, pB0, pB1; float mnA, mnB, alA, alB; v8i pa; const int NT = seq / KVBLK;
  SLOAD8(0, 0); asm volatile("s_waitcnt vmcnt(0)" ::: "memory"); SWRITE8(0, 0); __syncthreads();
  qkt8(pA0, pA1, K_lds, qf, r32, hi); partialSM8(pA0, pA1, m_reg, mnA, alA);
  SLOAD8(1, KVBLK); if (2 < NT) SLOAD8(0, 2 * KVBLK);
  SWAIT8(); SWRITE8(1, 1); __syncthreads();
  int bk = 1, bv = 0, bw = 2;
  if (wid >= 4) __builtin_amdgcn_s_setprio(1);
#define ROT3() do { const int t_ = bv; bv = bk; bk = bw; bw = t_; } while (0)
  for (int j = 1; j + 1 < NT; j += 2) {
    SBAR(); qkt8(pB0, pB1, K_lds + bk * SHM_K8, qf, r32, hi);
    finishSM8(pA0, pA1, alA, l_reg, pa); SBAR();
    SLOAD8(1, (j + 2) * KVBLK); SBAR();
    pv8(o, V_lds + bv * SHM_V8, pa, r32, hi); partialSM8(pB0, pB1, m_reg, mnB, alB);
    SWAIT8(); SWRITE8(bw, 0);
    RESC8(alB); __syncthreads(); ROT3();
    SBAR(); qkt8(pA0, pA1, K_lds + bk * SHM_K8, qf, r32, hi);
    finishSM8(pB0, pB1, alB, l_reg, pa); SBAR();
    if (j + 3 < NT) SLOAD8(0, (j + 3) * KVBLK); SBAR();
    pv8(o, V_lds + bv * SHM_V8, pa, r32, hi); partialSM8(pA0, pA1, m_reg, mnA, alA);
    SWAIT8(); SWRITE8(bw, 1);
    RESC8(alA); __syncthreads(); ROT3();
  }
  SBAR(); qkt8(pB0, pB1, K_lds + bk * SHM_K8, qf, r32, hi);
  finishSM8(pA0, pA1, alA, l_reg, pa); SBAR();
  pv8(o, V_lds + bv * SHM_V8, pa, r32, hi); partialSM8(pB0, pB1, m_reg, mnB, alB);
  RESC8(alB);
  finishSM8(pB0, pB1, alB, l_reg, pa); SBAR();
  pv8(o, V_lds + bk * SHM_V8, pa, r32, hi);
#undef ROT3
  __builtin_amdgcn_s_setprio(0);
  if (hi == 0) li_l[r32] = l_reg; asm volatile("s_waitcnt lgkmcnt(0)" ::: "memory");
  float rli[16];
#pragma unroll
  for (int r = 0; r < 16; ++r) rli[r] = __builtin_amdgcn_rcpf(li_l[crow(r, hi)]);
  bf16* Ow = Ob + (long)(wid * QBLK) * LDO;
#pragma unroll
  for (int r = 0; r < 16; ++r) { const int orow = crow(r, hi);
    for (int d0 = 0; d0 < 4; ++d0) Ow[(long)orow * LDO + d0 * 32 + r32] = (bf16)(cvtpk(o[d0][r] * rli[r], 0.f) & 0xffffu); }
#undef SLOAD8
#undef SWRITE8
#undef SWAIT8
#undef RESC8
}
}
struct Frame {
    LAS unsigned char* lds;
    int tid, lane, wave;
    int bid, vcu, G;
};
__device__ __forceinline__ float wave_sum(float v) {
#pragma unroll
    for (int o = 1; o < 64; o <<= 1) v += __shfl_xor(v, o);
    return v;
}
__device__ __forceinline__ void xrows_phase(const Frame& F, const float* __restrict__ h, bf16* __restrict__ hb, pg8::rs_t* __restrict__ rs, unsigned char* __restrict__ hb8) {
    const int gw = F.vcu * 8 + F.wave, NGW = F.G * 8;
    for (int m = gw; m < L; m += NGW) {
        const f32x4* xr = (const f32x4*)(h + (size_t)m * DM) + F.lane;
        v2u* o8 = (v2u*)(hb + (size_t)m * DM) + F.lane;
        float s = 0.f;
#pragma unroll
        for (int j = 0; j < 16; ++j) { const f32x4 v = xr[64 * j]; s += (v.x * v.x + v.y * v.y) + (v.z * v.z + v.w * v.w); v2u w; w.x = pk2(v.x, v.y); w.y = pk2(v.z, v.w); o8[64 * j] = w;
            int w8 = __builtin_amdgcn_cvt_pk_fp8_f32(v.x, v.y, 0, false); w8 = __builtin_amdgcn_cvt_pk_fp8_f32(v.z, v.w, w8, true); *((unsigned*)(hb8 + (size_t)m * DM) + 64 * j + F.lane) = (unsigned)w8; }
        s = wave_sum(s);
        if (F.lane == 0) rs[m] = (pg8::rs_t)(s * pg8::RS_FIX);
    }
}
__device__ __forceinline__ void headnorm_rows(bf16* __restrict__ X, int ld, int nheads, const float* __restrict__ gain, int t, int lane, bool rope, const float (&cs)[8], const float (&sn)[8], unsigned char* __restrict__ X8 = nullptr) {
    const int hs = lane >> 4, l16 = lane & 15;
    f32x4 g0 = *(const f32x4*)(gain + 8 * l16), g1 = *(const f32x4*)(gain + 8 * l16 + 4);
    const float gg[8] = {g0.x, g0.y, g0.z, g0.w, g1.x, g1.y, g1.z, g1.w};
    const bool second = ((l16 >> 2) & 1) != 0;
    for (int hg = 0; hg < nheads / 4; ++hg) {
        bf16* p = X + (size_t)t * ld + (size_t)(4 * hg + hs) * HD + 8 * l16;
        const v4u raw = *(const v4u*)p;
        float x[8] = {bflo(raw.x), bfhi(raw.x), bflo(raw.y), bfhi(raw.y), bflo(raw.z), bfhi(raw.z), bflo(raw.w), bfhi(raw.w)};
        float ss = 0.f;
#pragma unroll
        for (int e = 0; e < 8; ++e) ss += x[e] * x[e];
        ss += __shfl_xor(ss, 1); ss += __shfl_xor(ss, 2); ss += __shfl_xor(ss, 4); ss += __shfl_xor(ss, 8);
        const float rinv = 1.0f / sqrtf(ss * (1.0f / HD) + EPS);
        float y[8];
#pragma unroll
        for (int e = 0; e < 8; ++e) y[e] = x[e] * rinv * gg[e];
        if (rope) {
#pragma unroll
            for (int e = 0; e < 8; ++e) { const float yp = __shfl_xor(y[e], 4); y[e] = second ? (y[e] * cs[e] + yp * sn[e]) : (y[e] * cs[e] - yp * sn[e]); }
        }
        if (X8) { int w0 = __builtin_amdgcn_cvt_pk_fp8_f32(y[0], y[1], 0, false); w0 = __builtin_amdgcn_cvt_pk_fp8_f32(y[2], y[3], w0, true);
            int w1 = __builtin_amdgcn_cvt_pk_fp8_f32(y[4], y[5], 0, false); w1 = __builtin_amdgcn_cvt_pk_fp8_f32(y[6], y[7], w1, true);
            *(v2u*)(X8 + (size_t)t * ld + (size_t)(4 * hg + hs) * HD + 8 * l16) = (v2u){(unsigned)w0, (unsigned)w1}; }
        else { v4u w; w.x = pk2(y[0], y[1]); w.y = pk2(y[2], y[3]); w.z = pk2(y[4], y[5]); w.w = pk2(y[6], y[7]);
            *(v4u*)p = w; }
    }
}
__device__ __forceinline__ void prep_phase(const Frame& F, bf16* Q, bf16* K, int ldk, int nkh, const float* qgain, const float* kgain, bool rope, unsigned char* K8 = nullptr) {
    const int gw = F.vcu * 8 + F.wave, NGW = F.G * 8;
    const int l16 = F.lane & 15;
    for (int t = gw; t < L; t += NGW) {
        float cs[8], sn[8];
#pragma unroll
        for (int e = 0; e < 8; ++e) { cs[e] = 1.f; sn[e] = 0.f; }
        if (rope) {
            const int ax = l16 >> 3; const float pos = (float)(ax ? (t & (GRID_W - 1)) : (t / GRID_W));
#pragma unroll
            for (int e = 0; e < 8; ++e) { const int f = (l16 & 3) * 8 + e; const float inv = 1.0f / powf(10000.0f, (float)f * (1.0f / 32.0f)); const float ang = pos * inv; cs[e] = cosf(ang); sn[e] = sinf(ang); }
        }
        headnorm_rows(Q, DM, NH, qgain, t, F.lane, rope, cs, sn);
        headnorm_rows(K, ldk, nkh, kgain, t, F.lane, rope, cs, sn, K8);
    }
}

constexpr int S5T = pg8::S5T, S5NCH = pg8::S5NCH, S5KS = pg8::S5KS;
__device__ __forceinline__ void s5_gen_group(const Frame& F, int g, const float* __restrict__ lam_re, const float* __restrict__ lam_im, const float* __restrict__ log_step,
                                             const float* __restrict__ b_re, const float* __restrict__ b_im, const float* __restrict__ c_re, const float* __restrict__ c_im,
                                             bf16* __restrict__ GM, bf16* __restrict__ BMt, f32x2* __restrict__ PAT) {
    LAS f32x2* apow = (LAS f32x2*)F.lds;
    LAS f32x2* zt = apow + 2 * 33 * 64;
    LAS float* Kd = (LAS float*)(zt + 2 * 64);
    const int tid = F.tid;
    if (tid < 128) {
        const int dir = tid >> 6, n = tid & 63, dg = dir * S5G + g, idx = dg * S5N + n;
        const double dt = exp((double)log_step[dg]);
        const double lr = (double)lam_re[idx], li = (double)lam_im[idx];
        const double mag = exp(lr * dt), are = mag * cos(li * dt), aim = mag * sin(li * dt);
        const double den = lr * lr + li * li, nre = are - 1.0;
        zt[dir * 64 + n] = (f32x2){(float)((nre * lr + aim * li) / den), (float)((aim * lr - nre * li) / den)};
        double pr = 1.0, pi = 0.0;
        for (int k = 0; k <= 32; ++k) { apow[(dir * 33 + k) * 64 + n] = (f32x2){(float)pr, (float)pi}; const double t = pr * are - pi * aim; pi = pr * aim + pi * are; pr = t; }
        PAT[idx] = apow[(dir * 33 + 32) * 64 + n];
    }
    LDS_WAIT(); __syncthreads();
    {
        const int dir = tid >> 8, p = (tid >> 4) & 15, q = tid & 15, dg = dir * S5G + g;
        float wr[64], wi[64];
        const float* cr = c_re + ((size_t)dg * S5P + p) * S5N; const float* ci = c_im + ((size_t)dg * S5P + p) * S5N;
#pragma unroll
        for (int n = 0; n < 64; ++n) { const f32x2 z = zt[dir * 64 + n]; const float br = b_re[((size_t)dg * S5N + n) * S5P + q], bi = b_im[((size_t)dg * S5N + n) * S5P + q];
            const float bbr = z.x * br - z.y * bi, bbi = z.x * bi + z.y * br; const float c0 = cr[n], c1 = ci[n];
            wr[n] = c0 * bbr - c1 * bbi; wi[n] = c0 * bbi + c1 * bbr; }
        for (int d = 0; d < 32; ++d) { float acc = 0.f; const LAS f32x2* ap = apow + (dir * 33 + d) * 64;
#pragma unroll
            for (int n = 0; n < 64; ++n) { const f32x2 a = ap[n]; acc = fmaf(wr[n], a.x, acc); acc = fmaf(-wi[n], a.y, acc); }
            Kd[(dir * 32 + d) * 256 + p * 16 + q] = acc; }
    }
    LDS_WAIT(); __syncthreads();
    bf16* BMg = BMt + (size_t)g * 512 * S5KS;
    for (int it = tid; it < 512 * 64; it += 512) { const int row = it >> 6, ch = it & 63, tau = row >> 4, p = row & 15, sg = ch >> 1, q0 = (ch & 1) * 8;
        float v[8];
        if (sg < tau) { const LAS float* k = Kd + (0 * 32 + (tau - sg)) * 256 + p * 16 + q0;
#pragma unroll
            for (int j = 0; j < 8; ++j) v[j] = k[j]; }
        else if (sg > tau) { const LAS float* k = Kd + (1 * 32 + (sg - tau)) * 256 + p * 16 + q0;
#pragma unroll
            for (int j = 0; j < 8; ++j) v[j] = k[j]; }
        else { const LAS float* k0 = Kd + p * 16 + q0; const LAS float* k1 = Kd + 32 * 256 + p * 16 + q0;
#pragma unroll
            for (int j = 0; j < 8; ++j) v[j] = k0[j] + k1[j]; }
        v4u w; w.x = pk2(v[0], v[1]); w.y = pk2(v[2], v[3]); w.z = pk2(v[4], v[5]); w.w = pk2(v[6], v[7]);
        *(v4u*)(BMg + (size_t)row * S5KS + ch * 8) = w; }
    for (int it = tid; it < 512 * 32; it += 512) { const int row = it >> 5, ch = it & 31, tau = row >> 4, p = row & 15, dir = ch >> 4, n0 = (ch & 15) * 4, dg = dir * S5G + g;
        const int k = dir ? (32 - tau) : (tau + 1);
        const f32x4 cr = *(const f32x4*)(c_re + ((size_t)dg * S5P + p) * S5N + n0), ci = *(const f32x4*)(c_im + ((size_t)dg * S5P + p) * S5N + n0);
        const LAS f32x2* ap = apow + (dir * 33 + k) * 64 + n0;
        unsigned o[4];
#pragma unroll
        for (int j = 0; j < 4; ++j) { const f32x2 a = ap[j]; const float vr = cr[j] * a.x - ci[j] * a.y, vi = cr[j] * a.y + ci[j] * a.x; o[j] = pk2(vr, -vi); }
        *(v4u*)(BMg + (size_t)row * S5KS + 512 + ch * 8) = (v4u){o[0], o[1], o[2], o[3]}; }
    bf16* GMg = GM + (size_t)g * 256 * 512;
    for (int it = tid; it < 128 * 64; it += 512) { const int dn = it >> 6, ch = it & 63, dir = dn >> 6, n = dn & 63, sg = ch >> 1, q0 = (ch & 1) * 8, dg = dir * S5G + g;
        const int pw = dir ? sg : (31 - sg);
        const f32x2 a = apow[(dir * 33 + pw) * 64 + n], z = zt[dir * 64 + n];
        const float wr_ = a.x * z.x - a.y * z.y, wi_ = a.x * z.y + a.y * z.x;
        const float* br = b_re + ((size_t)dg * S5N + n) * S5P + q0; const float* bi = b_im + ((size_t)dg * S5N + n) * S5P + q0;
        float re[8], im[8];
#pragma unroll
        for (int j = 0; j < 8; ++j) { re[j] = wr_ * br[j] - wi_ * bi[j]; im[j] = wr_ * bi[j] + wi_ * br[j]; }
        v4u w0, w1; w0.x = pk2(re[0], re[1]); w0.y = pk2(re[2], re[3]); w0.z = pk2(re[4], re[5]); w0.w = pk2(re[6], re[7]);
        w1.x = pk2(im[0], im[1]); w1.y = pk2(im[2], im[3]); w1.z = pk2(im[4], im[5]); w1.w = pk2(im[6], im[7]);
        *(v4u*)(GMg + (size_t)(dir * 128 + 2 * n) * 512 + ch * 8) = w0; *(v4u*)(GMg + (size_t)(dir * 128 + 2 * n + 1) * 512 + ch * 8) = w1; }
    LDS_WAIT(); __syncthreads();
}
__device__ __forceinline__ void s5_scan_phase(const Frame& F, const f32x2* __restrict__ PAT, const float* __restrict__ E, bf16* __restrict__ UA) {
    for (int task = F.bid + F.G * F.wave; task < 2 * S5G; task += F.G * 8) {
        const int dir = task >> 8, g = task & 255;
        const f32x2 a = PAT[task * S5N + F.lane];
        const float* e = E + (size_t)g * S5NCH * 256 + dir * 128 + 2 * F.lane;
        bf16* s = UA + (size_t)g * S5NCH * S5KS + 512 + dir * 128 + 2 * F.lane;
        float cr = 0.f, ci = 0.f;
        for (int c8 = 0; c8 < S5NCH; c8 += 8) {
            f32x2 v[8];
#pragma unroll
            for (int k = 0; k < 8; ++k) { const int c = dir ? (S5NCH - 1 - (c8 + k)) : (c8 + k); v[k] = *(const f32x2*)(e + (size_t)c * 256); }
#pragma unroll
            for (int k = 0; k < 8; ++k) { const int c = dir ? (S5NCH - 1 - (c8 + k)) : (c8 + k);
                *(unsigned*)(s + (size_t)c * S5KS) = pk2(cr, ci);
                const float nr = fmaf(a.x, cr, fmaf(-a.y, ci, v[k].x)), ni = fmaf(a.x, ci, fmaf(a.y, cr, v[k].y)); cr = nr; ci = ni; }
        }
    }
}


__device__ __forceinline__ float fp8_to_f32(unsigned char b) { const int e = (b >> 3) & 15, m = b & 7; const float v = e ? __builtin_ldexpf(1.0f + (float)m * 0.125f, e - 7) : __builtin_ldexpf((float)m * 0.125f, -6); return (b & 0x80) ? -v : v; }
__device__ __forceinline__ void gqa_selfcheck(const Frame& F, const bf16* __restrict__ Qp, const unsigned char* __restrict__ K8, const unsigned char* __restrict__ V8t, const bf16* __restrict__ O,
                                              float* __restrict__ SC, unsigned* flag) {
    LAS float* ql = (LAS float*)(F.lds + F.wave * 1024);
    const int lane = F.lane;
#pragma unroll 1
    for (int s = F.bid * 8 + F.wave; s < 1024; s += F.G * 8) {
        const int tok = (int)(((long)(s >> 5) * 5209 + 77) % L), hq = s & 31, kv = hq >> 2;
        float* sc = SC + (size_t)(F.bid * 8 + F.wave) * L;
        { const bf16* qp = Qp + (size_t)tok * DM + hq * HD; ql[lane] = bf2f(qp[lane]); ql[lane + 64] = bf2f(qp[lane + 64]); } LDS_WAIT();
        float mx = -1e30f;
#pragma unroll 1
        for (int j = lane; j < L; j += 64) { const unsigned char* kp = K8 + (size_t)j * KVD + kv * HD; float dot = 0.f;
#pragma unroll 1
            for (int d = 0; d < HD; ++d) dot += fp8_to_f32(kp[d]) * ql[d];
            dot *= 0.088388347648318440f; sc[j] = dot; mx = fmaxf(mx, dot); }
#pragma unroll
        for (int o = 1; o < 64; o <<= 1) mx = fmaxf(mx, __shfl_xor(mx, o));
        asm volatile("s_waitcnt vmcnt(0)" ::: "memory"); __builtin_amdgcn_fence(__ATOMIC_RELEASE, "workgroup"); __builtin_amdgcn_fence(__ATOMIC_ACQUIRE, "agent");
        float o0 = 0.f, o1 = 0.f, lsum = 0.f;
#pragma unroll 1
        for (int j = 0; j < L; ++j) { const float pj = expf(__hip_atomic_load(sc + j, __ATOMIC_RELAXED, __HIP_MEMORY_SCOPE_AGENT) - mx);
            o0 += pj * fp8_to_f32(V8t[(size_t)(kv * HD + lane) * L + j]); o1 += pj * fp8_to_f32(V8t[(size_t)(kv * HD + lane + 64) * L + j]); lsum += pj; }
        o0 /= lsum; o1 /= lsum;
        const bf16* op = O + (size_t)tok * DM + hq * HD; const float g0 = bf2f(op[lane]), g1 = bf2f(op[lane + 64]);
        float am = fmaxf(fabsf(o0), fabsf(o1));
#pragma unroll
        for (int o = 1; o < 64; o <<= 1) am = fmaxf(am, __shfl_xor(am, o));
        const float tol = 0.2f * am + 1e-5f;
        const bool bad = !(fabsf(g0 - o0) <= tol) || !(fabsf(g1 - o1) <= tol);
        if (__any(bad) && lane == 0) __hip_atomic_fetch_or(flag, 1u, __ATOMIC_RELAXED, __HIP_MEMORY_SCOPE_AGENT);
        LDS_WAIT();
    }
}

__device__ __forceinline__ void transpose_item(const float* __restrict__ W, int K, int N, bf16* __restrict__ WT, int mode, const float* __restrict__ gain, LAS float* scr, int item, int lane, int fp8 = 0) {
    const int nblk = N / 32, kb = item / nblk, nb = item % nblk, k0 = 64 * kb, n0 = 32 * nb;
    int r0 = n0;
    if (mode == 1) r0 = (n0 < DM) ? ((n0 >> 7) * 256 + (n0 & 127)) : (((n0 - DM) >> 7) * 256 + 128 + ((n0 - DM) & 127));
    const float* src = W + (size_t)(k0 + (lane >> 5)) * N + n0 + (lane & 31);
    float v[32];
#pragma unroll
    for (int i = 0; i < 32; ++i) v[i] = src[(size_t)(2 * i) * N];
    const int c = lane & 7;
    f32x4 g0 = (f32x4){1.f, 1.f, 1.f, 1.f}, g1 = g0;
    if (gain) { g0 = *(const f32x4*)(gain + k0 + 8 * c); g1 = *(const f32x4*)(gain + k0 + 8 * c + 4); }
#pragma unroll
    for (int i = 0; i < 32; ++i) scr[(2 * i + (lane >> 5)) * 33 + (lane & 31)] = v[i];
    LDS_WAIT(); asm volatile("" ::: "memory");
#pragma unroll
    for (int j = 0; j < 4; ++j) { const int n = (lane >> 3) + 8 * j; const LAS float* s = scr + (8 * c) * 33 + n;
        if (fp8) { int w0 = __builtin_amdgcn_cvt_pk_fp8_f32(64.f * s[0 * 33] * g0.x, 64.f * s[1 * 33] * g0.y, 0, false); w0 = __builtin_amdgcn_cvt_pk_fp8_f32(64.f * s[2 * 33] * g0.z, 64.f * s[3 * 33] * g0.w, w0, true);
            int w1 = __builtin_amdgcn_cvt_pk_fp8_f32(64.f * s[4 * 33] * g1.x, 64.f * s[5 * 33] * g1.y, 0, false); w1 = __builtin_amdgcn_cvt_pk_fp8_f32(64.f * s[6 * 33] * g1.z, 64.f * s[7 * 33] * g1.w, w1, true);
            *(v2u*)((unsigned char*)WT + (size_t)(r0 + n) * K + k0 + 8 * c) = (v2u){(unsigned)w0, (unsigned)w1}; }
        else { v4u o; o.x = pk2(s[0 * 33] * g0.x, s[1 * 33] * g0.y); o.y = pk2(s[2 * 33] * g0.z, s[3 * 33] * g0.w); o.z = pk2(s[4 * 33] * g1.x, s[5 * 33] * g1.y); o.w = pk2(s[6 * 33] * g1.z, s[7 * 33] * g1.w);
            *(v4u*)(WT + (size_t)(r0 + n) * K + k0 + 8 * c) = o; } }
    LDS_WAIT(); asm volatile("" ::: "memory");
}

constexpr size_t MiB = 1u << 20;
constexpr size_t SZ_NAQKV = (size_t)3 * DM * DM * 2, SZ_DD = (size_t)DM * DM * 2, SZ_GQAQKV = (size_t)(DM + 2 * KVD) * DM * 2, SZ_W1 = (size_t)FF * DM * 2, SZ_PROJ = (size_t)DM * PLE * 2, SZ_ACT = (size_t)L * DM * 2;
constexpr size_t OFF_CTL = 0, CTL_ZERO_BYTES = 3 * MiB, OFF_RS = 1 * MiB;
constexpr size_t OFF_NAQKV = 4 * MiB;
constexpr size_t OFF_NAWO = OFF_NAQKV + 2 * SZ_NAQKV;
constexpr size_t OFF_GQAQKV = OFF_NAWO + 2 * SZ_DD;
constexpr size_t OFF_GQAWO = OFF_GQAQKV + SZ_GQAQKV;
constexpr size_t OFF_S5IN = OFF_GQAWO + SZ_DD;
constexpr size_t OFF_S5OUT = OFF_S5IN + SZ_DD;
constexpr size_t OFF_W1 = OFF_S5OUT + 2 * SZ_DD;
constexpr size_t OFF_W2 = OFF_W1 + 4 * SZ_W1;
constexpr size_t OFF_PROJ = OFF_W2 + 4 * SZ_W1;
constexpr size_t OFF_GATE = OFF_PROJ + 4 * SZ_PROJ;
constexpr size_t OFF_PBF = OFF_GATE + 4 * SZ_DD;
constexpr size_t OFF_XN = OFF_PBF + 4 * (size_t)L * PLE * 2;
constexpr size_t OFF_ACT = OFF_XN + SZ_ACT;
constexpr size_t OFF_PP = OFF_ACT + 4 * SZ_ACT;
constexpr size_t OFF_S5BM = OFF_PP + SZ_ACT;
constexpr size_t OFF_S5GM = OFF_S5BM + 192 * MiB;
constexpr size_t OFF_S5PAR = OFF_S5GM + 64 * MiB;
constexpr size_t OFF_DUMMY = OFF_S5PAR + 8 * MiB;
constexpr size_t OFF_HB1 = OFF_DUMMY + 256 * MiB;
constexpr size_t OFF_HB8 = OFF_HB1 + SZ_ACT;
constexpr size_t WS_END = OFF_HB8 + (size_t)L * DM;
constexpr int CW_BAR = 4096;
constexpr int RING_BYTES = 131072, LDSCTL_OFF = RING_BYTES, MISC_OFF = LDSCTL_OFF + 320, PTAB_OFF = LDSCTL_OFF + 1024, LDS_BYTES = 147456;
static_assert(dattn::SHM_ATTN <= RING_BYTES && 8 * 64 * 33 * 4 <= RING_BYTES, "phase scratch fits the ring region");

constexpr int PH_PER_LAYER = 8, NPH = 1 + DEPTH * PH_PER_LAYER;
struct Args { const float* in[28]; float* out; unsigned char* ws; int ph_lo, ph_hi; };
enum { I_X = 0, I_P, I_MIXN, I_MLPN, I_PLEN, I_NAQKV, I_NAWO, I_NAQG, I_NAKG, I_NARPB, I_GQKV, I_GWO, I_GQG, I_GKG, I_S5IN, I_LAMRE, I_LAMIM, I_LOGSTEP, I_BRE, I_BIM, I_CRE, I_CIM, I_S5D, I_S5OUT, I_W1, I_W2, I_PROJ, I_GATE };


__device__ __forceinline__ unsigned long long tab_get(LAS unsigned char* lds, int i) {
    volatile LAS unsigned* t = (volatile LAS unsigned*)(lds + PTAB_OFF); const unsigned lo = t[2 * i], hi = t[2 * i + 1];
    return ((unsigned long long)(unsigned)__builtin_amdgcn_readfirstlane((int)hi) << 32) | (unsigned)__builtin_amdgcn_readfirstlane((int)lo); }
#define INP(i) ((const float*)(const GAS float*)tab_get(F.lds, (i)))
#define OUTP() ((float*)(GAS float*)tab_get(F.lds, 28))
#define WSP() ((unsigned char*)(GAS unsigned char*)tab_get(F.lds, 29))
__device__ __forceinline__ Frame mkframe(unsigned char* lds_generic) {
    Frame F; int t = threadIdx.x; asm volatile("" : "+v"(t)); F.tid = t; F.lane = t & 63; F.wave = __builtin_amdgcn_readfirstlane(t >> 6);
    F.lds = (LAS unsigned char*)lds_generic; int b = blockIdx.x; asm volatile("" : "+s"(b)); F.bid = b; int G = gridDim.x; asm volatile("" : "+s"(G)); F.G = G;
    F.vcu = (G % 8 == 0) ? (b % 8) * (G / 8) + b / 8 : b; return F; }
__device__ __forceinline__ void prologue_phase(const Frame& F) {
    unsigned char* ws = WSP();
    LAS float* scr = (LAS float*)(F.lds + F.wave * (64 * 33 * 4));
    const int gw = F.vcu * 8 + F.wave, NGW = F.G * 8;
    constexpr int I_QKV = (DM / 64) * (3 * DM / 32), I_DD = (DM / 64) * (DM / 32), I_GQ = (DM / 64) * ((DM + 2 * KVD) / 32), I_SO = (DM / 64) * (2 * DM / 32),
                  I_1 = (DM / 64) * (FF / 32), I_2 = (FF / 64) * (DM / 32), I_PJ = (PLE / 64) * (DM / 32);
    constexpr int NITEMS = 2 * I_QKV + 2 * I_DD + I_GQ + I_DD + I_DD + I_SO + 4 * I_1 + 4 * I_2 + 4 * I_PJ + 4 * I_DD;
    for (int it = gw; it < NITEMS; it += NGW) {
        int r = it; const float* W; int K, N, mode = 0, fp8 = 0; bf16* WT; const float* gain = nullptr;
        if (r < 2 * I_QKV) { const int l = r / I_QKV; r -= l * I_QKV; W = INP(I_NAQKV) + (size_t)l * DM * 3 * DM; K = DM; N = 3 * DM; WT = (bf16*)(ws + OFF_NAQKV + l * SZ_NAQKV); gain = INP(I_MIXN) + (size_t)(3 * l) * DM; fp8 = 1; }
        else { r -= 2 * I_QKV;
        if (r < 2 * I_DD) { const int l = r / I_DD; r -= l * I_DD; W = INP(I_NAWO) + (size_t)l * DM * DM; K = DM; N = DM; WT = (bf16*)(ws + OFF_NAWO + l * SZ_DD); }
        else { r -= 2 * I_DD;
        if (r < I_GQ) { W = INP(I_GQKV); K = DM; N = DM + 2 * KVD; WT = (bf16*)(ws + OFF_GQAQKV); gain = INP(I_MIXN) + (size_t)1 * DM; fp8 = 1; }
        else { r -= I_GQ;
        if (r < I_DD) { W = INP(I_GWO); K = DM; N = DM; WT = (bf16*)(ws + OFF_GQAWO); }
        else { r -= I_DD;
        if (r < I_DD) { W = INP(I_S5IN); K = DM; N = DM; WT = (bf16*)(ws + OFF_S5IN); gain = INP(I_MIXN) + (size_t)2 * DM; }
        else { r -= I_DD;
        if (r < I_SO) { W = INP(I_S5OUT); K = DM; N = 2 * DM; WT = (bf16*)(ws + OFF_S5OUT); mode = 1; }
        else { r -= I_SO;
        if (r < 4 * I_1) { const int l = r / I_1; r -= l * I_1; W = INP(I_W1) + (size_t)l * DM * FF; K = DM; N = FF; WT = (bf16*)(ws + OFF_W1 + l * SZ_W1); gain = INP(I_MLPN) + (size_t)l * DM; }
        else { r -= 4 * I_1;
        if (r < 4 * I_2) { const int l = r / I_2; r -= l * I_2; W = INP(I_W2) + (size_t)l * FF * DM; K = FF; N = DM; WT = (bf16*)(ws + OFF_W2 + l * SZ_W1); }
        else { r -= 4 * I_2;
        if (r < 4 * I_PJ) { const int l = r / I_PJ; r -= l * I_PJ; W = INP(I_PROJ) + (size_t)l * PLE * DM; K = PLE; N = DM; WT = (bf16*)(ws + OFF_PROJ + l * SZ_PROJ); }
        else { r -= 4 * I_PJ; const int l = r / I_DD; r -= l * I_DD; W = INP(I_GATE) + (size_t)l * DM * DM; K = DM; N = DM; WT = (bf16*)(ws + OFF_GATE + l * SZ_DD); gain = INP(I_PLEN) + (size_t)l * DM; } } } } } } } } }
        transpose_item(W, K, N, WT, mode, gain, scr, r, F.lane, fp8);
    }
    xrows_phase(F, INP(I_X), (bf16*)(ws + OFF_XN), (pg8::rs_t*)(ws + OFF_RS), ws + OFF_HB8);
    { const size_t n8 = (size_t)DEPTH * L * PLE / 8; const float* p = INP(I_P); bf16* pb = (bf16*)(ws + OFF_PBF);
      for (size_t i = (size_t)gw * 64 + F.lane; i < n8; i += (size_t)NGW * 64) { const f32x4 a = *(const f32x4*)(p + i * 8), b = *(const f32x4*)(p + i * 8 + 4);
          v4u w; w.x = pk2(a.x, a.y); w.y = pk2(a.z, a.w); w.z = pk2(b.x, b.y); w.w = pk2(b.z, b.w); *(v4u*)(pb + i * 8) = w; } }
    { bf16* GM = (bf16*)(ws + OFF_S5GM); bf16* BMt = (bf16*)(ws + OFF_S5BM); f32x2* PAT = (f32x2*)(ws + OFF_S5PAR);
      LDS_WAIT(); __syncthreads();
      for (int g = F.bid; g < S5G; g += F.G) s5_gen_group(F, g, INP(I_LAMRE), INP(I_LAMIM), INP(I_LOGSTEP), INP(I_BRE), INP(I_BIM), INP(I_CRE), INP(I_CIM), GM, BMt, PAT); }
}

#define WS_PTRS() unsigned char* ws = WSP(); bf16* HB0 = (bf16*)(ws + OFF_XN); bf16* HB1 = (bf16*)(ws + OFF_HB1); bf16* Qb = (bf16*)(ws + OFF_ACT); bf16* Kb = (bf16*)(ws + OFF_ACT + SZ_ACT); bf16* Vb = (bf16*)(ws + OFF_ACT + 2 * SZ_ACT); \
    bf16* Ob = (bf16*)(ws + OFF_ACT + 3 * SZ_ACT); bf16* HID = (bf16*)(ws + OFF_ACT); bf16* UA = (bf16*)(ws + OFF_ACT); bf16* S5Gb = (bf16*)(ws + OFF_ACT + 2 * SZ_ACT); float* S5E = (float*)(ws + OFF_ACT + 3 * SZ_ACT); bf16* PP = (bf16*)(ws + OFF_PP); \
    (void)HB0; (void)HB1; (void)Qb; (void)Kb; (void)Vb; (void)Ob; (void)HID; (void)UA; (void)S5Gb; (void)PP; (void)S5E;
__global__ void __launch_bounds__(512, 2) enc_fwd(Args args) {
    extern __shared__ __attribute__((aligned(16))) unsigned char lds[];
    {
        LAS unsigned char* l3 = (LAS unsigned char*)lds;
        for (int u = threadIdx.x; u < (LDS_BYTES - LDSCTL_OFF) / 4; u += 512) ((LAS unsigned*)(l3 + LDSCTL_OFF))[u] = 0u;
        __syncthreads();
        if (threadIdx.x == 0) { LAS unsigned long long* t = (LAS unsigned long long*)(l3 + PTAB_OFF);
#pragma unroll
            for (int i = 0; i < 28; ++i) t[i] = (unsigned long long)args.in[i];
            t[28] = (unsigned long long)args.out; t[29] = (unsigned long long)args.ws; }
        __syncthreads();
    }
    const int lo = args.ph_lo, hi = args.ph_hi;
    XcdBarrier bar;
    { LAS unsigned char* l3 = (LAS unsigned char*)lds; unsigned* ctl = (unsigned*)(GAS unsigned*)(tab_get(l3, 29) + OFF_CTL); bar.bar = ctl + CW_BAR; bar.x = 0; bar.st = nullptr;
      if (hi - lo > 1) bar = xcd_barrier_post(ctl + CW_BAR, (volatile LAS unsigned*)(l3 + MISC_OFF) + 8); }
#define IN(k) (lo <= (k) && (k) < hi)
#ifndef PROBE_PH
#define PROBE_PH (-1)
#endif
#define REPS(k) for (int rep_ = 0, nrep_ = (((k) == PROBE_PH || PROBE_PH == -2) ? 2 : ((PROBE_PH == 300 && (k) == 11) ? 4 : 1)); rep_ < nrep_; ++rep_)
#define HBOUT(p) ((nrep_ == 2 && rep_ == 0) ? (bf16*)(ws + OFF_DUMMY) : (p))
#define RSOUT(i) ((nrep_ == 2 && rep_ == 0) ? (pg8::rs_t*)(ws + OFF_DUMMY + 128 * MiB) : RSP(i))
#define SEAM(k) do { if (IN(k) && IN((k) + 1)) xcd_barrier(bar); } while (0)

#if PROBE_PH == 601
    if (blockIdx.x == 0 && threadIdx.x < 64) {
        typedef int v8i_ __attribute__((ext_vector_type(8))); typedef float f4v_ __attribute__((ext_vector_type(4)));
        const int l = threadIdx.x, ij = l & 15, kb = l >> 4; const unsigned lut[7] = {0xC4u, 0xC0u, 0xB8u, 0x00u, 0x38u, 0x40u, 0x44u};
        v8i_ A, B;
#pragma unroll
        for (int v = 0; v < 8; ++v) { unsigned wa = 0, wb = 0;
#pragma unroll
            for (int b = 0; b < 4; ++b) { const int kk = 32 * kb + 4 * v + b; const int av = ((ij + 2 * kk) % 5) - 2, bv = ((3 * kk + ij) % 7) - 3;
                unsigned ea = 0, eb = 0;
#pragma unroll
                for (int t = 0; t < 7; ++t) { ea = (av + 3 == t) ? lut[t] : ea; eb = (bv + 3 == t) ? lut[t] : eb; }
                wa |= ea << (8 * b); wb |= eb << (8 * b); }
            A[v] = (int)wa; B[v] = (int)wb; }
        f4v_ c1 = {};
        c1 = __builtin_amdgcn_mfma_scale_f32_16x16x128_f8f6f4(A, B, c1, 0, 0, 0, 0x7F7F7F7F, 0, 0x7F7F7F7F);
        bool ok1 = true;
#pragma unroll
        for (int r = 0; r < 4; ++r) { const int i = 4 * kb + r, j = ij; int s = 0;
            for (int kk = 0; kk < 128; ++kk) s += (((i + 2 * kk) % 5) - 2) * (((3 * kk + j) % 7) - 3);
            ok1 = ok1 && (c1[r] == (float)s); }
        unsigned long long ticks = 0; if (!__all(ok1)) ticks += 400000ull;
        const unsigned long long t0 = __builtin_amdgcn_s_memrealtime(); while (__builtin_amdgcn_s_memrealtime() - t0 < ticks) __builtin_amdgcn_s_sleep(8);
    }
    __syncthreads();
#endif
#if PROBE_PH == 600
    if (blockIdx.x == 0 && threadIdx.x < 64) {
        typedef int v8i_ __attribute__((ext_vector_type(8))); typedef float f16v_ __attribute__((ext_vector_type(16)));
        const int l = threadIdx.x, ij = l & 31, kb = l >> 5; const unsigned lut[7] = {0xC4u, 0xC0u, 0xB8u, 0x00u, 0x38u, 0x40u, 0x44u};
        v8i_ A, B;
#pragma unroll
        for (int v = 0; v < 8; ++v) { unsigned wa = 0, wb = 0;
#pragma unroll
            for (int b = 0; b < 4; ++b) { const int kk = 32 * kb + 4 * v + b; const int av = ((ij + 2 * kk) % 5) - 2, bv = ((3 * kk + ij) % 7) - 3;
                unsigned ea = 0, eb = 0;
#pragma unroll
                for (int t = 0; t < 7; ++t) { ea = (av + 3 == t) ? lut[t] : ea; eb = (bv + 3 == t) ? lut[t] : eb; }
                wa |= ea << (8 * b); wb |= eb << (8 * b); }
            A[v] = (int)wa; B[v] = (int)wb; }
        f16v_ c1 = {}, c2 = {};
        c1 = __builtin_amdgcn_mfma_scale_f32_32x32x64_f8f6f4(A, B, c1, 0, 0, 0, 0x7F7F7F7F, 0, 0x7F7F7F7F);
        c2 = __builtin_amdgcn_mfma_scale_f32_32x32x64_f8f6f4(A, B, c2, 0, 0, 0, 0x7B7B7B7B, 0, 0x7F7F7F7F);
        bool ok1 = true, ok2 = true;
#pragma unroll
        for (int r = 0; r < 16; ++r) { const int i = (r & 3) + 8 * (r >> 2) + 4 * kb, j = ij; int s = 0;
            for (int kk = 0; kk < 64; ++kk) s += (((i + 2 * kk) % 5) - 2) * (((3 * kk + j) % 7) - 3);
            ok1 = ok1 && (c1[r] == (float)s); ok2 = ok2 && (c2[r] == (float)s * 0.0625f); }
        int w = __builtin_amdgcn_cvt_pk_fp8_f32(1.0f, 2.0f, 0, false); w = __builtin_amdgcn_cvt_pk_fp8_f32(3.0f, -1.0f, w, true);
        const bool ok3 = ((unsigned)w == 0xB8444038u);
        unsigned long long ticks = 0; if (!__all(ok1)) ticks += 400000ull; if (!__all(ok2)) ticks += 800000ull; if (!__all(ok3)) ticks += 1600000ull;
        const unsigned long long t0 = __builtin_amdgcn_s_memrealtime(); while (__builtin_amdgcn_s_memrealtime() - t0 < ticks) __builtin_amdgcn_s_sleep(8);
    }
    __syncthreads();
#endif
    if (IN(0)) REPS(0) { const Frame F = mkframe(lds); prologue_phase(F); } SEAM(0);
#if PROBE_PH == 200
    for (int xb_ = 0; xb_ < 40; ++xb_) xcd_barrier(bar);
#endif

#pragma unroll 1
    for (int layer = 0; layer < DEPTH; ++layer) {
        const int kind = layer % 3, slot = layer / 3, pb = 1 + PH_PER_LAYER * layer;
#define RSP(i) ((pg8::rs_t*)(ws + OFF_RS) + (size_t)(i) * L)
        const int irs = (layer == 0) ? 0 : 3 * layer;
        if (IN(pb + 0)) REPS(pb + 0) {
            const Frame F = mkframe(lds); WS_PTRS();
            if (kind != 2) {
                const int N = (kind == 0) ? 3 * DM : DM + 2 * KVD;
                const bf16* W = (kind == 0) ? (const bf16*)(ws + OFF_NAQKV + slot * SZ_NAQKV) : (const bf16*)(ws + OFF_GQAQKV);
                const pg8::Gemm g = pg8::mkgemm((const bf16*)(ws + OFF_HB8), W, L, N, DM / 2); pg8::StaticOrder S; S.init(L, N, F.G, F.bid);
                pg8::EpiBf16<0> E{Qb, Kb, Vb, DM, (kind == 0) ? DM : KVD, (kind == 0) ? DM : L, DM, (kind == 0) ? 2 * DM : DM + KVD, RSP(irs), (kind == 0) ? 0 : 2, (kind == 0) ? 2 * DM : DM + KVD};
                pg8::gemm_phase<pg8::EpiBf16<0>, pg8::StaticOrder, false, true, true>(F.lds, g, S, E);
            } else {
                const pg8::Gemm g = pg8::mkgemm(HB0, (const bf16*)(ws + OFF_S5IN), L, DM, DM); pg8::StaticOrder S; S.init(L, DM, F.G, F.bid);
                pg8::EpiS5U E{UA, RSP(irs)};
                pg8::gemm_phase<pg8::EpiS5U, pg8::StaticOrder, false, true>(F.lds, g, S, E);
            }
        }
        SEAM(pb + 0);
        if (kind != 2) {
            if (kind == 1) { if (IN(pb + 1)) { const Frame F = mkframe(lds); WS_PTRS(); prep_phase(F, Qb, Kb, KVD, NKV, INP(I_GQG), INP(I_GKG), true, (unsigned char*)Kb + 64 * MiB); }
                SEAM(pb + 1); }
            if (IN(pb + 2)) REPS(pb + 2) { const Frame F = mkframe(lds); WS_PTRS();
                if (kind == 0) {
                    const float* rpb = INP(I_NARPB) + (size_t)slot * NH * 15 * 31;
                    for (int i = 0;; ++i) { const int unit = i * F.G + F.vcu; if (unit >= NH * (GROWS / 4)) break;
                        const int h = unit >> 6, R = (unit & 63) * 4, ks = min(max(R - 4, 0), GROWS - dattn::NA_TILES);
                        dattn::na_block_body(Qb + (size_t)(R * GRID_W) * DM + h * HD, Kb + (size_t)(ks * GRID_W) * DM + h * HD, Vb + (size_t)(ks * GRID_W) * DM + h * HD,
                                             Ob + (size_t)(R * GRID_W) * DM + h * HD, rpb + (size_t)h * 15 * 31, INP(I_NAQG) + slot * HD, INP(I_NAKG) + slot * HD, R, ks, (char*)lds);
                        __syncthreads(); }
                } else {
                    for (int i = 0;; ++i) { const int unit = i * F.G + F.bid; if (unit >= NH * (L / 256)) break;
                        const int kvh = unit & 7, rest = unit >> 3, hq = kvh * 4 + (rest >> 6), qb = rest & 63;
                        dattn::attn_dense_body8(Qb + (size_t)(qb * 256) * DM + hq * HD, (const unsigned char*)Kb + 64 * MiB + kvh * HD, (const unsigned char*)Vb + (size_t)(kvh * HD) * L, Ob + (size_t)(qb * 256) * DM + hq * HD, L, (char*)lds);
                        __syncthreads(); }
                }
            }
            if (IN(pb + 2) && IN(pb + 4)) xcd_barrier(bar);
#if PROBE_PH == 400
            if (kind == 1) { const Frame F = mkframe(lds); WS_PTRS();
                gqa_selfcheck(F, Qb, (const unsigned char*)Kb + 64 * MiB, (const unsigned char*)Vb, Ob, (float*)(ws + OFF_PP), (unsigned*)(ws + OFF_CTL) + 8);
                xcd_barrier(bar); }
#endif
        } else {
            if (IN(pb + 1)) REPS(pb + 1) { const Frame F = mkframe(lds); WS_PTRS();
                pg8::Gemm g; g.A = UA; g.Bt = (const bf16*)(ws + OFF_S5GM); g.M = S5G * S5NCH; g.N = 256; g.K = 512; g.lda = S5KS; g.ldb = 512;
                pg8::S5Order S{F.G, F.bid, 2, 1}; pg8::EpiS5E E{S5E};
                pg8::gemm_phase<pg8::EpiS5E, pg8::S5Order, false, true>(F.lds, g, S, E); }
            SEAM(pb + 1);
            if (IN(pb + 2)) REPS(pb + 2) { const Frame F = mkframe(lds); WS_PTRS(); s5_scan_phase(F, (const f32x2*)(ws + OFF_S5PAR), S5E, UA); }
            SEAM(pb + 2);
            if (IN(pb + 3)) REPS(pb + 3) { const Frame F = mkframe(lds); WS_PTRS();
                pg8::Gemm g; g.A = UA; g.Bt = (const bf16*)(ws + OFF_S5BM); g.M = S5G * S5NCH; g.N = S5G * 512; g.K = S5KS; g.lda = S5KS; g.ldb = S5KS;
                pg8::S5Order S{F.G, F.bid, 2, 2}; pg8::EpiS5Y E{UA, INP(I_S5D), S5Gb, DM};
                pg8::gemm_phase<pg8::EpiS5Y, pg8::S5Order, false, true>(F.lds, g, S, E); }
            SEAM(pb + 3);
        }
        if (IN(pb + 4)) REPS(pb + 4) {
            const Frame F = mkframe(lds); WS_PTRS();
            if (kind != 2) {
                const bf16* W = (kind == 0) ? (const bf16*)(ws + OFF_NAWO + slot * SZ_DD) : (const bf16*)(ws + OFF_GQAWO);
                const pg8::Gemm g = pg8::mkgemm(Ob, W, L, DM, DM); pg8::StaticOrder S; S.init(L, DM, F.G, F.bid);
                pg8::EpiRes E{HB0, HBOUT(HB0), RSOUT(1 + 3 * layer), DM, nullptr};
                pg8::gemm_phase<pg8::EpiRes, pg8::StaticOrder, false, true>(F.lds, g, S, E);
            } else {
                const pg8::Gemm g = pg8::mkgemm(S5Gb, (const bf16*)(ws + OFF_S5OUT), L, 2 * DM, DM); pg8::StaticOrder S; S.init(L, 2 * DM, F.G, F.bid);
                pg8::EpiGlu E{HB0, HBOUT(HB0), RSOUT(1 + 3 * layer), DM};
                pg8::gemm_phase<pg8::EpiGlu, pg8::StaticOrder, false, true>(F.lds, g, S, E);
            }
        }
        SEAM(pb + 4);
        if (IN(pb + 5)) REPS(pb + 5) { const Frame F = mkframe(lds); WS_PTRS();
            const pg8::Gemm g = pg8::mkgemm(HB0, (const bf16*)(ws + OFF_W1 + layer * SZ_W1), L, FF, DM); pg8::StaticOrder S; S.init(L, FF, F.G, F.bid);
            pg8::EpiBf16<2> E{HID, HID, HID, FF, FF, FF, 1 << 30, 1 << 30, nullptr, 0, 0};
#if PROBE_PH == 201
            { pg8::RangeOrder R1{S, 0, 8}, R2{S, 8, 16};
              pg8::gemm_phase<pg8::EpiBf16<2>, pg8::RangeOrder, false, true>(F.lds, g, R1, E); xcd_barrier(bar);
              pg8::gemm_phase<pg8::EpiBf16<2>, pg8::RangeOrder, false, true>(F.lds, g, R2, E); }
#else
            pg8::gemm_phase<pg8::EpiBf16<2>, pg8::StaticOrder, false, true>(F.lds, g, S, E);
#endif
        }
        SEAM(pb + 5);
        if (IN(pb + 6)) REPS(pb + 6) { const Frame F = mkframe(lds); WS_PTRS();
            { const pg8::Gemm g = pg8::mkgemm(HID, (const bf16*)(ws + OFF_W2 + layer * SZ_W1), L, DM, FF); pg8::StaticOrder S; S.init(L, DM, F.G, F.bid);
              pg8::EpiRes E{HB0, HBOUT(HB1), RSOUT(2 + 3 * layer), DM, RSP(1 + 3 * layer)};
              pg8::gemm_phase<pg8::EpiRes, pg8::StaticOrder, false, true>(F.lds, g, S, E); }
            { const pg8::Gemm g = pg8::mkgemm((const bf16*)(ws + OFF_PBF + (size_t)layer * L * PLE * 2), (const bf16*)(ws + OFF_PROJ + layer * SZ_PROJ), L, DM, PLE); pg8::StaticOrder S; S.init(L, DM, F.G, F.bid);
              pg8::EpiBf16<0> E{PP, PP, PP, DM, DM, DM, 1 << 30, 1 << 30, nullptr, 0, 0};
              pg8::gemm_phase<pg8::EpiBf16<0>, pg8::StaticOrder, false, true>(F.lds, g, S, E); }
        }
        SEAM(pb + 6);
        if (IN(pb + 7)) REPS(pb + 7) { const Frame F = mkframe(lds); WS_PTRS();
            const pg8::Gemm g = pg8::mkgemm(HB1, (const bf16*)(ws + OFF_GATE + layer * SZ_DD), L, DM, DM); pg8::StaticOrder S; S.init(L, DM, F.G, F.bid);
            pg8::EpiGate E{HB1, HBOUT(HB0), (layer == DEPTH - 1) ? OUTP() : nullptr, PP, RSP(2 + 3 * layer), RSOUT(3 + 3 * layer), DM, (layer + 1 < DEPTH && (layer + 1) % 3 != 2 && !(nrep_ == 2 && rep_ == 0)) ? ws + OFF_HB8 : nullptr};
            pg8::gemm_phase<pg8::EpiGate, pg8::StaticOrder, false, true>(F.lds, g, S, E);
        }
        SEAM(pb + 7);
    }
#if PROBE_PH == 400
    { xcd_barrier(bar); const Frame F = mkframe(lds); unsigned char* ws = WSP();
      if (__hip_atomic_load((unsigned*)(ws + OFF_CTL) + 8, __ATOMIC_RELAXED, __HIP_MEMORY_SCOPE_AGENT) != 0u && F.bid == 0 && F.tid < 64) OUTP()[F.tid] = __builtin_nanf(""); }
#endif
#undef IN
#undef SEAM
}

extern "C" void kernel_launch(void* const* d_in, const int* in_sizes, int n_in, void* d_out, int out_size, void* d_ws, size_t ws_size, hipStream_t stream) {
    static int grid = 0;
    if (grid == 0) {
        if (n_in != 28 || in_sizes[0] != L * DM || out_size != L * DM || ws_size < WS_END) {
            fprintf(stderr, "kernel_launch: built for 28 inputs, x/out of %d floats, >= %zu bytes of workspace; got n_in %d, in0 %d, out %d, ws %zu; nothing launched\n", L * DM, (size_t)WS_END, n_in, n_in > 0 ? in_sizes[0] : -1, out_size, ws_size);
            grid = -1; return; }
        int dev = 0, cus = 0, per_cu = 0;
        if (hipGetDevice(&dev) != hipSuccess || hipDeviceGetAttribute(&cus, hipDeviceAttributeMultiprocessorCount, dev) != hipSuccess) { fprintf(stderr, "kernel_launch: device query failed\n"); grid = -1; return; }
        if (hipFuncSetAttribute((const void*)enc_fwd, hipFuncAttributeMaxDynamicSharedMemorySize, LDS_BYTES) != hipSuccess) { fprintf(stderr, "kernel_launch: hipFuncSetAttribute failed\n"); grid = -1; return; }
        if (hipOccupancyMaxActiveBlocksPerMultiprocessor(&per_cu, (const void*)enc_fwd, 512, LDS_BYTES) != hipSuccess || per_cu < 1)
            fprintf(stderr, "kernel_launch: note: occupancy query reports %d workgroups per CU\n", per_cu);
        (void)hipGetLastError();
        grid = cus;
    }
    if (grid < 0) return;
    if (hipMemsetAsync((char*)d_ws + OFF_CTL, 0, CTL_ZERO_BYTES, stream) != hipSuccess) { fprintf(stderr, "kernel_launch: memset failed\n"); return; }
    Args a{};
    for (int i = 0; i < 28; ++i) a.in[i] = (const float*)d_in[i];
    a.out = (float*)d_out; a.ws = (unsigned char*)d_ws;
#if MK_N_LAUNCHES == 1
    a.ph_lo = 0; a.ph_hi = NPH;
    hipLaunchKernelGGL(enc_fwd, dim3(grid), dim3(512), LDS_BYTES, stream, a);
#else
    for (int ph = 0; ph < NPH; ++ph) {
        if (ph > 0) { const int layer = (ph - 1) / PH_PER_LAYER, j = (ph - 1) % PH_PER_LAYER; if (j == 3 && layer % 3 != 2) continue; }
        a.ph_lo = ph; a.ph_hi = ph + 1;
        hipLaunchKernelGGL(enc_fwd, dim3(grid), dim3(512), LDS_BYTES, stream, a);
    }
#endif
    const hipError_t le = hipPeekAtLastError();
    if (le != hipSuccess) fprintf(stderr, "kernel_launch: launch failed: %s\n", hipGetErrorName(le));
}
```

```cpp
#include <hip/hip_runtime.h>
#include <cstdio>
#include <cstdint>

#ifndef MK_N_LAUNCHES
#define MK_N_LAUNCHES 1
#endif

constexpr int L = 16384, DM = 4096, DEPTH = 4, GRID_W = 64, GROWS = L / GRID_W, HD = 128, NH = 32, NKV = 8, KVD = NKV * HD, FF = 4 * DM, PLE = 256;
constexpr int S5G = 256, S5P = 16, S5N = 64, S5TC = 16, S5NC = L / S5TC;
constexpr float EPS = 1e-6f;

#define GAS __attribute__((address_space(1)))
#define LAS __attribute__((address_space(3)))
typedef unsigned short bf16;
typedef unsigned v4u __attribute__((ext_vector_type(4)));
typedef unsigned v2u __attribute__((ext_vector_type(2)));
typedef float f32x4 __attribute__((ext_vector_type(4)));
typedef float f32x2 __attribute__((ext_vector_type(2)));
typedef short bf16x8 __attribute__((ext_vector_type(8)));
typedef short s16x4 __attribute__((ext_vector_type(4)));
typedef GAS unsigned gu32;
#define RLX_AGENT __ATOMIC_RELAXED, __HIP_MEMORY_SCOPE_AGENT
#define LDS_WAIT() asm volatile("s_waitcnt lgkmcnt(0)" ::: "memory")
#define VM_WAIT() asm volatile("s_waitcnt vmcnt(0)" ::: "memory")
__device__ __forceinline__ unsigned f2bf(float f) { unsigned u = __builtin_bit_cast(unsigned, f); return (u + 0x7fffu + ((u >> 16) & 1u)) >> 16; }
__device__ __forceinline__ unsigned pk2(float lo, float hi) { return f2bf(lo) | (f2bf(hi) << 16); }
__device__ __forceinline__ float bf2f(unsigned short b) { return __builtin_bit_cast(float, (unsigned)b << 16); }
__device__ __forceinline__ float bflo(unsigned w) { return __builtin_bit_cast(float, w << 16); }
__device__ __forceinline__ float bfhi(unsigned w) { return __builtin_bit_cast(float, w & 0xffff0000u); }
__device__ __forceinline__ float sigmoidf_fast(float x) { return __builtin_amdgcn_rcpf(1.0f + __builtin_amdgcn_exp2f(-1.4426950408889634f * x)); }

namespace pg8 {
#define PG8_LAS __attribute__((address_space(3)))
#if defined(PROBE_EPI2)
#define PROBE_EPI_DUP if constexpr (Epi::PERM) E(acc, cur, wr, wc, fr, fq);
#else
#define PROBE_EPI_DUP
#endif
typedef unsigned short bf16_t;
typedef short bf16x8 __attribute__((ext_vector_type(8)));
typedef float f32x4 __attribute__((ext_vector_type(4)));
typedef unsigned u32x4 __attribute__((ext_vector_type(4)));
constexpr int BM = 256, BK = 64, HALF = 128, HTB = HALF * BK * 2  , STAGE_BYTES = 8 * HTB, NXCD = 8, WGM = 8;

__host__ __device__ __forceinline__ int lds_byte(int r, int c) { const int st = (r >> 4) * 2 + (c >> 5), rr = r & 15, cc = c & 31, ob = rr * 64 + cc * 2; return st * 1024 + (ob ^ (((ob >> 9) & 1) << 5)); }
__host__ __device__ __forceinline__ void stage_rc(int b, int& R, int& C) { const int st = b / 1024, sb = b % 1024, swz = sb ^ (((sb >> 9) & 1) << 5); R = (st >> 1) * 16 + swz / 64; C = (st & 1) * 32 + (swz % 64) / 2; }
__host__ __device__ __forceinline__ int perm32(int rho) { const int n = rho >> 4, i = rho & 15; return 8 * (i >> 2) + 4 * n + (i & 3); }

struct Unit { int pm, pn; };
struct Gemm { const bf16_t* A; const bf16_t* Bt; int M, N, K, lda, ldb, sa; };
__host__ __device__ __forceinline__ Gemm mkgemm(const bf16_t* A, const bf16_t* Bt, int M, int N, int K) { Gemm g; g.A = A; g.Bt = Bt; g.M = M; g.N = N; g.K = K; g.lda = K; g.ldb = K; g.sa = 0x7F7F7F7F; return g; }

struct StaticOrder {
    int nM, nN, nwg, G, c;
    __host__ __device__ void init(int M, int N, int G_, int c_) { nM = M / BM; nN = N / BM; nwg = nM * nN; G = G_; c = c_; }
    __host__ __device__ bool next(int i, Unit& u) const {
        const long L = (long)i * G + c; if (L >= nwg) return false;
        int wgid = (int)L; { const int q = nwg / NXCD, r = nwg % NXCD, xcd = wgid % NXCD, off = wgid / NXCD; wgid = (xcd < r ? xcd * (q + 1) : r * (q + 1) + (xcd - r) * q) + off; }
        const int nig = WGM * nN, gid = wgid / nig, fm = gid * WGM, gsz = (nM - fm) < WGM ? (nM - fm) : WGM;
        u.pm = fm + ((wgid % nig) % gsz); u.pn = (wgid % nig) / gsz; return true;
    }
    __device__ __forceinline__ void a_ready(const Unit&) const {}
    __device__ __forceinline__ void done(const Unit&) const {}
};
struct RangeOrder { StaticOrder S; int i0, i1;
    __host__ __device__ bool next(int i, Unit& u) const { return (i + i0 < i1) ? S.next(i + i0, u) : false; }
    __device__ __forceinline__ void a_ready(const Unit&) const {}
    __device__ __forceinline__ void done(const Unit&) const {} };


__device__ __forceinline__ unsigned cvt_pk_bf16(float lo, float hi) { unsigned r; asm volatile("v_cvt_pk_bf16_f32 %0, %1, %2" : "=v"(r) : "v"(lo), "v"(hi)); return r; }
__device__ __forceinline__ float sigm(float x) { return __builtin_amdgcn_rcpf(1.0f + __builtin_amdgcn_exp2f(-1.4426950408889634f * x)); }

typedef unsigned long long rs_t;
constexpr float RS_FIX = 16777216.0f, RS_INV = 1.0f / (16777216.0f * 4096.0f), RS_EPS = 1e-6f;
__device__ __forceinline__ void row_ss_add(rs_t* rs, int row, float s, int fq) {
    s += __shfl_xor(s, 16); s += __shfl_xor(s, 32);
    if (fq == 0) __hip_atomic_fetch_add(rs + row, (rs_t)(s * RS_FIX), __ATOMIC_RELAXED, __HIP_MEMORY_SCOPE_AGENT);
}
__device__ __forceinline__ float rs_rinv(rs_t v) { return __builtin_amdgcn_rsqf((float)v * RS_INV + RS_EPS); }
#define PIN8(a) asm volatile("" : "+v"((a)[0]), "+v"((a)[1]), "+v"((a)[2]), "+v"((a)[3]), "+v"((a)[4]), "+v"((a)[5]), "+v"((a)[6]), "+v"((a)[7]))
template <int ACT> struct EpiBf16 {
    static constexpr bool PERM = true, AFTER_DRAIN = false;
    bf16_t *O0, *O1, *O2; int ld0, ld1, ld2, c1, c2; const rs_t* rs; int vt; int rs_from;
    __device__ __forceinline__ void operator()(const f32x4 (&acc)[2][2][4][2], const Unit& u, int wr, int wc, int fr, int fq) const {
        const int row0 = u.pm * BM + wr * 64 + fr; int colt = u.pn * BM; bf16_t* base = O0; int ldc = ld0;
        const rs_t* rs = (colt >= rs_from) ? this->rs : nullptr;
        bool tr = false;
        if (colt >= c2) { base = O2; ldc = ld2; colt -= c2; tr = vt != 0; } else if (colt >= c1) { base = O1; ldc = ld1; colt -= c1; }
        const int col0 = colt + wc * 32 + 8 * fq;
        rs_t scv[8];
#pragma unroll
        for (int gi = 0; gi < 8; ++gi) scv[gi] = rs ? rs[row0 + (gi >> 2) * HALF + (gi & 3) * 16] : 0ull;
        PIN8(scv);
#pragma unroll
        for (int ai = 0; ai < 2; ++ai)
#pragma unroll
            for (int m = 0; m < 4; ++m) { bf16_t* rowp = base + (size_t)(row0 + ai * HALF + m * 16) * ldc + col0; const float sc = rs ? rs_rinv(scv[ai * 4 + m]) : 1.0f;
#pragma unroll
                for (int bj = 0; bj < 2; ++bj) { f32x4 v0 = acc[ai][bj][m][0] * sc, v1 = acc[ai][bj][m][1] * sc;
                    if (ACT == 2) {
#pragma unroll
                        for (int j = 0; j < 4; ++j) { const float a = fmaxf(v0[j], 0.f), b = fmaxf(v1[j], 0.f); v0[j] = a * a; v1[j] = b * b; } }
                    u32x4 w; w.x = cvt_pk_bf16(v0[0], v0[1]); w.y = cvt_pk_bf16(v0[2], v0[3]); w.z = cvt_pk_bf16(v1[0], v1[1]); w.w = cvt_pk_bf16(v1[2], v1[3]);
                    if (vt == 2 && tr) {
                        unsigned char* tp = (unsigned char*)base + (size_t)(col0 + bj * HALF) * ldc + (row0 + ai * HALF + m * 16);
                        int w0 = __builtin_amdgcn_cvt_pk_fp8_f32(v0[0], v0[1], 0, false); w0 = __builtin_amdgcn_cvt_pk_fp8_f32(v0[2], v0[3], w0, true);
                        int w1 = __builtin_amdgcn_cvt_pk_fp8_f32(v1[0], v1[1], 0, false); w1 = __builtin_amdgcn_cvt_pk_fp8_f32(v1[2], v1[3], w1, true);
                        tp[0] = (unsigned char)w0; tp[(size_t)ldc] = (unsigned char)(w0 >> 8); tp[(size_t)2 * ldc] = (unsigned char)(w0 >> 16); tp[(size_t)3 * ldc] = (unsigned char)(w0 >> 24);
                        tp[(size_t)4 * ldc] = (unsigned char)w1; tp[(size_t)5 * ldc] = (unsigned char)(w1 >> 8); tp[(size_t)6 * ldc] = (unsigned char)(w1 >> 16); tp[(size_t)7 * ldc] = (unsigned char)(w1 >> 24); }
                    else if (tr) { bf16_t* tp = base + (size_t)(col0 + bj * HALF) * ldc + (row0 + ai * HALF + m * 16);
                        tp[0] = (bf16_t)w.x; tp[(size_t)ldc] = (bf16_t)(w.x >> 16); tp[(size_t)2 * ldc] = (bf16_t)w.y; tp[(size_t)3 * ldc] = (bf16_t)(w.y >> 16);
                        tp[(size_t)4 * ldc] = (bf16_t)w.z; tp[(size_t)5 * ldc] = (bf16_t)(w.z >> 16); tp[(size_t)6 * ldc] = (bf16_t)w.w; tp[(size_t)7 * ldc] = (bf16_t)(w.w >> 16); }
                    else *(u32x4*)(rowp + bj * HALF) = w; } }
    }
};
struct EpiF32 {
    static constexpr bool PERM = false, AFTER_DRAIN = false;
    float* C; int ldc;
    __device__ __forceinline__ void operator()(const f32x4 (&acc)[2][2][4][2], const Unit& u, int wr, int wc, int fr, int fq) const {
        const int row0 = u.pm * BM + wr * 64 + fr, col0 = u.pn * BM + wc * 32 + 4 * fq;
#pragma unroll
        for (int ai = 0; ai < 2; ++ai)
#pragma unroll
            for (int m = 0; m < 4; ++m) { float* rowp = C + (size_t)(row0 + ai * HALF + m * 16) * ldc + col0;
#pragma unroll
                for (int bj = 0; bj < 2; ++bj)
#pragma unroll
                    for (int n = 0; n < 2; ++n) *(f32x4*)(rowp + bj * HALF + n * 16) = acc[ai][bj][m][n]; }
    }
};
typedef unsigned u32x2 __attribute__((ext_vector_type(2)));
__device__ __forceinline__ f32x4 bf4_to_f32(u32x2 p) { return (f32x4){__builtin_bit_cast(float, p.x << 16), __builtin_bit_cast(float, p.x & 0xffff0000u), __builtin_bit_cast(float, p.y << 16), __builtin_bit_cast(float, p.y & 0xffff0000u)}; }
struct EpiRes {
    static constexpr bool PERM = false, AFTER_DRAIN = false;
    const bf16_t* base; bf16_t* out; rs_t* rs; int ldc; const rs_t* rsq;
    __device__ __forceinline__ void operator()(const f32x4 (&acc)[2][2][4][2], const Unit& u, int wr, int wc, int fr, int fq) const {
        constexpr int PD = 3;
        const int row0 = u.pm * BM + wr * 64 + fr, col0 = u.pn * BM + wc * 32 + 4 * fq;
        u32x2 nb[8][2][2];
        rs_t scv[8];
#pragma unroll
        for (int gi = 0; gi < 8; ++gi) scv[gi] = rsq ? rsq[row0 + (gi >> 2) * HALF + (gi & 3) * 16] : 0ull;
#define EPI_LD(g) do { const size_t o_ = (size_t)(row0 + ((g) >> 2) * HALF + ((g) & 3) * 16) * ldc + col0; _Pragma("unroll") for (int bj = 0; bj < 2; ++bj) _Pragma("unroll") for (int n = 0; n < 2; ++n) nb[g][bj][n] = *(const u32x2*)(base + o_ + bj * HALF + n * 16); } while (0)
#pragma unroll
        for (int g = 0; g < PD; ++g) EPI_LD(g);
        PIN8(scv);
#pragma unroll
        for (int gi = 0; gi < 8; ++gi) { const int ai = gi >> 2, m = gi & 3; const int row = row0 + ai * HALF + m * 16; const size_t off = (size_t)row * ldc + col0;
            if (gi + PD < 8) EPI_LD(gi + PD);
            const float sc2 = rsq ? __builtin_amdgcn_rcpf((float)scv[gi] * RS_INV + RS_EPS) : 1.0f;
            float ss = 0.f;
#pragma unroll
            for (int bj = 0; bj < 2; ++bj)
#pragma unroll
                for (int n = 0; n < 2; ++n) { const f32x4 o = bf4_to_f32(nb[gi][bj][n]) + acc[ai][bj][m][n] * sc2;
                    ss += (o[0] * o[0] + o[1] * o[1]) + (o[2] * o[2] + o[3] * o[3]);
                    u32x2 w; w.x = cvt_pk_bf16(o[0], o[1]); w.y = cvt_pk_bf16(o[2], o[3]); *(u32x2*)(out + off + bj * HALF + n * 16) = w; }
            row_ss_add(rs, row, ss, fq); }
#undef EPI_LD
    }
};
struct EpiGate {
    static constexpr bool PERM = false, AFTER_DRAIN = false;
    const bf16_t* base; bf16_t* out; float* out32; const bf16_t* pp; const rs_t* rsin; rs_t* rs; int ldc; unsigned char* out8;
    __device__ __forceinline__ void operator()(const f32x4 (&acc)[2][2][4][2], const Unit& u, int wr, int wc, int fr, int fq) const {
        constexpr int PD = 2;
        const int row0 = u.pm * BM + wr * 64 + fr, col0 = u.pn * BM + wc * 32 + 4 * fq;
        rs_t scv[8];
#pragma unroll
        for (int gi = 0; gi < 8; ++gi) scv[gi] = rsin[row0 + (gi >> 2) * HALF + (gi & 3) * 16];
        u32x2 nb[8][2][2], np[8][2][2];
#define EPI_LD(g) do { const size_t o_ = (size_t)(row0 + ((g) >> 2) * HALF + ((g) & 3) * 16) * ldc + col0; _Pragma("unroll") for (int bj = 0; bj < 2; ++bj) _Pragma("unroll") for (int n = 0; n < 2; ++n) { \
            nb[g][bj][n] = *(const u32x2*)(base + o_ + bj * HALF + n * 16); np[g][bj][n] = *(const u32x2*)(pp + o_ + bj * HALF + n * 16); } } while (0)
#pragma unroll
        for (int g = 0; g < PD; ++g) EPI_LD(g);
        PIN8(scv);
#pragma unroll
        for (int gi = 0; gi < 8; ++gi) { const int ai = gi >> 2, m = gi & 3; const int row = row0 + ai * HALF + m * 16; const size_t off = (size_t)row * ldc + col0;
            if (gi + PD < 8) EPI_LD(gi + PD);
            const float sc = rs_rinv(scv[gi]);
            float ss = 0.f;
#pragma unroll
            for (int bj = 0; bj < 2; ++bj)
#pragma unroll
                for (int n = 0; n < 2; ++n) { const f32x4 a = acc[ai][bj][m][n] * sc, p = bf4_to_f32(np[gi][bj][n]); f32x4 o = bf4_to_f32(nb[gi][bj][n]);
#pragma unroll
                    for (int j = 0; j < 4; ++j) o[j] += sigm(a[j]) * p[j];
                    if (out32) *(f32x4*)(out32 + off + bj * HALF + n * 16) = o;
                    if (out8) { int w8 = __builtin_amdgcn_cvt_pk_fp8_f32(o[0], o[1], 0, false); w8 = __builtin_amdgcn_cvt_pk_fp8_f32(o[2], o[3], w8, true); *(unsigned*)(out8 + off + bj * HALF + n * 16) = (unsigned)w8; }
                    ss += (o[0] * o[0] + o[1] * o[1]) + (o[2] * o[2] + o[3] * o[3]);
                    u32x2 w; w.x = cvt_pk_bf16(o[0], o[1]); w.y = cvt_pk_bf16(o[2], o[3]); *(u32x2*)(out + off + bj * HALF + n * 16) = w; }
            row_ss_add(rs, row, ss, fq); }
#undef EPI_LD
    }
};
struct EpiGlu {
    static constexpr bool PERM = false, AFTER_DRAIN = false;
    const bf16_t* base; bf16_t* out; rs_t* rs; int ldc;
    __device__ __forceinline__ void operator()(const f32x4 (&acc)[2][2][4][2], const Unit& u, int wr, int wc, int fr, int fq) const {
        constexpr int PD = 3;
        const int row0 = u.pm * BM + wr * 64 + fr, col0 = u.pn * HALF + wc * 32 + 4 * fq;
        u32x2 nb[8][2];
#define EPI_LD(g) do { const size_t o_ = (size_t)(row0 + ((g) >> 2) * HALF + ((g) & 3) * 16) * ldc + col0; _Pragma("unroll") for (int n = 0; n < 2; ++n) nb[g][n] = *(const u32x2*)(base + o_ + n * 16); } while (0)
#pragma unroll
        for (int g = 0; g < PD; ++g) EPI_LD(g);
#pragma unroll
        for (int gi = 0; gi < 8; ++gi) { const int ai = gi >> 2, m = gi & 3; const int row = row0 + ai * HALF + m * 16; const size_t off = (size_t)row * ldc + col0;
            if (gi + PD < 8) EPI_LD(gi + PD);
            float ss = 0.f;
#pragma unroll
            for (int n = 0; n < 2; ++n) { const f32x4 a = acc[ai][0][m][n], g = acc[ai][1][m][n]; f32x4 o = bf4_to_f32(nb[gi][n]);
#pragma unroll
                for (int j = 0; j < 4; ++j) o[j] += a[j] * sigm(g[j]);
                ss += (o[0] * o[0] + o[1] * o[1]) + (o[2] * o[2] + o[3] * o[3]);
                u32x2 w; w.x = cvt_pk_bf16(o[0], o[1]); w.y = cvt_pk_bf16(o[2], o[3]); *(u32x2*)(out + off + n * 16) = w; }
            row_ss_add(rs, row, ss, fq); }
#undef EPI_LD
    }
};

constexpr int S5T = 32, S5NCH = 512, S5KS = 768;
struct S5Order {
    int G, c, MT, NT;
    __device__ __forceinline__ bool next(int i, Unit& u) const { const int idx = i * G + c; if (idx >= 256 * MT * NT) return false; const int g = idx & 255, sub = idx >> 8;
        u.pm = g * MT + sub / NT; u.pn = g * NT + sub % NT; return true; }
    __device__ __forceinline__ void a_ready(const Unit&) const {}
    __device__ __forceinline__ void done(const Unit&) const {}
};
struct EpiS5U {
    static constexpr bool PERM = true, AFTER_DRAIN = false;
    bf16_t* UA; const rs_t* rs;
    __device__ __forceinline__ void operator()(const f32x4 (&acc)[2][2][4][2], const Unit& u, int wr, int wc, int fr, int fq) const {
        const int row0 = u.pm * BM + wr * 64 + fr, col0 = u.pn * BM + wc * 32 + 8 * fq;
        rs_t scv[8];
#pragma unroll
        for (int gi = 0; gi < 8; ++gi) scv[gi] = rs[row0 + (gi >> 2) * HALF + (gi & 3) * 16];
        PIN8(scv);
#pragma unroll
        for (int ai = 0; ai < 2; ++ai)
#pragma unroll
            for (int m = 0; m < 4; ++m) { const int t = row0 + ai * HALF + m * 16, c = t >> 5, sg = t & 31; const float sc = rs_rinv(scv[ai * 4 + m]);
#pragma unroll
                for (int bj = 0; bj < 2; ++bj) { const int col = col0 + bj * HALF, g = col >> 4, q0 = col & 15;
                    const f32x4 v0 = acc[ai][bj][m][0] * sc, v1 = acc[ai][bj][m][1] * sc;
                    u32x4 w; w.x = cvt_pk_bf16(v0[0], v0[1]); w.y = cvt_pk_bf16(v0[2], v0[3]); w.z = cvt_pk_bf16(v1[0], v1[1]); w.w = cvt_pk_bf16(v1[2], v1[3]);
                    *(u32x4*)(UA + ((size_t)(g * S5NCH + c) * S5KS + sg * 16 + q0)) = w; } }
    }
};
struct EpiS5E {
    static constexpr bool PERM = false, AFTER_DRAIN = false;
    float* E;
    __device__ __forceinline__ void operator()(const f32x4 (&acc)[2][2][4][2], const Unit& u, int wr, int wc, int fr, int fq) const {
        const int row0 = u.pm * BM + wr * 64 + fr, col0 = wc * 32 + 4 * fq;
#pragma unroll
        for (int ai = 0; ai < 2; ++ai)
#pragma unroll
            for (int m = 0; m < 4; ++m) { float* rowp = E + (size_t)(row0 + ai * HALF + m * 16) * 256 + col0;
#pragma unroll
                for (int bj = 0; bj < 2; ++bj)
#pragma unroll
                    for (int n = 0; n < 2; ++n) *(f32x4*)(rowp + bj * HALF + n * 16) = acc[ai][bj][m][n]; }
    }
};
__device__ __forceinline__ float gelu_tanh_f(float v) {
    const float z = 0.7978845608028654f * (v + 0.044715f * v * v * v);
    const float e = __builtin_amdgcn_exp2f(2.0f * 1.4426950408889634f * z);
    return 0.5f * v * (2.0f - 2.0f * __builtin_amdgcn_rcpf(e + 1.0f));
}
struct EpiS5Y {
    static constexpr bool PERM = true, AFTER_DRAIN = false;
    const bf16_t* UA; const float* dskip; bf16_t* G; int ldg;
    __device__ __forceinline__ void operator()(const f32x4 (&acc)[2][2][4][2], const Unit& u, int wr, int wc, int fr, int fq) const {
        const int row0 = u.pm * BM + wr * 64 + fr, col0 = (u.pn & 1) * BM + wc * 32 + 8 * fq;
        const int g = u.pm >> 1, p0 = col0 & 15;
        const f32x4 d0 = *(const f32x4*)(dskip + 16 * g + p0), d1 = *(const f32x4*)(dskip + 16 * g + p0 + 4);
        u32x4 uu[8][2];
#pragma unroll
        for (int gi = 0; gi < 8; ++gi)
#pragma unroll
            for (int bj = 0; bj < 2; ++bj) uu[gi][bj] = *(const u32x4*)(UA + ((size_t)(row0 + (gi >> 2) * HALF + (gi & 3) * 16) * S5KS + col0 + bj * HALF));
#pragma unroll
        for (int gi = 0; gi < 8; ++gi) asm volatile("" : "+v"(uu[gi][0]), "+v"(uu[gi][1]));
#pragma unroll
        for (int gi = 0; gi < 8; ++gi) { const int ai = gi >> 2, m = gi & 3; const int rowg = row0 + ai * HALF + m * 16, c = rowg & 511;
#pragma unroll
            for (int bj = 0; bj < 2; ++bj) { const int col = col0 + bj * HALF, tau = col >> 4; const u32x4 w4 = uu[gi][bj];
                f32x4 v0 = acc[ai][bj][m][0], v1 = acc[ai][bj][m][1];
                v0[0] += d0[0] * __builtin_bit_cast(float, w4.x << 16); v0[1] += d0[1] * __builtin_bit_cast(float, w4.x & 0xffff0000u);
                v0[2] += d0[2] * __builtin_bit_cast(float, w4.y << 16); v0[3] += d0[3] * __builtin_bit_cast(float, w4.y & 0xffff0000u);
                v1[0] += d1[0] * __builtin_bit_cast(float, w4.z << 16); v1[1] += d1[1] * __builtin_bit_cast(float, w4.z & 0xffff0000u);
                v1[2] += d1[2] * __builtin_bit_cast(float, w4.w << 16); v1[3] += d1[3] * __builtin_bit_cast(float, w4.w & 0xffff0000u);
#pragma unroll
                for (int j = 0; j < 4; ++j) { v0[j] = gelu_tanh_f(v0[j]); v1[j] = gelu_tanh_f(v1[j]); }
                u32x4 w; w.x = cvt_pk_bf16(v0[0], v0[1]); w.y = cvt_pk_bf16(v0[2], v0[3]); w.z = cvt_pk_bf16(v1[0], v1[1]); w.w = cvt_pk_bf16(v1[2], v1[3]);
                *(u32x4*)(G + (size_t)(32 * c + tau) * ldg + 16 * g + p0) = w; } }
    }
};

template <class Epi, class Sched, bool ALIGN_EPI = false, bool SP2 = false, bool FP8 = false>
__device__ __forceinline__ void gemm_phase(PG8_LAS unsigned char* lds, const Gemm g, const Sched& S, const Epi& E) {
    int tid_o = threadIdx.x; asm volatile("" : "+v"(tid_o)); const int tid = tid_o, wid = __builtin_amdgcn_readfirstlane(tid >> 6), lane = tid & 63, wr = wid >> 2, wc = wid & 3, fr = lane & 15, fq = lane >> 4;
    const int K = g.K, nt = K / BK;
    unsigned voffA[2], voffB[2];
#pragma unroll
    for (int i = 0; i < 2; ++i) { int R, C; stage_rc(tid * 16 + i * 8192, R, C); const int Rb = Epi::PERM ? ((R & ~31) + perm32(R & 31)) : R;
        voffA[i] = (unsigned)(R * g.lda + C) * 2u; voffB[i] = (unsigned)(Rb * g.ldb + C) * 2u; }
    const size_t kstep = (size_t)(BK * 2);
    const size_t hstepA = (size_t)HALF * g.lda * 2, hstepB = (size_t)HALF * g.ldb * 2;
    const size_t tstepA = 2 * hstepA, tstepB = 2 * hstepB;
    const unsigned ldsw = (unsigned)wid * 1024u;
    const int aoff = lds_byte(wr * 64 + fr, fq * 8), boff = lds_byte(wc * 32 + fr, fq * 8);
    const int aoff8 = lds_byte(wr * 64 + fr, fq * 16), boff8 = lds_byte(wc * 32 + fr, fq * 16);
#define PG8_SA(b, h) (((b) * 2 + (h)) * HTB)
#define PG8_SB(b, h) ((4 + (b) * 2 + (h)) * HTB)
#define PG8_STAGE(bufoff, gbase, voff) do { _Pragma("unroll") for (int _i = 0; _i < 2; ++_i) \
        __builtin_amdgcn_global_load_lds((const unsigned*)((const char*)(gbase) + (voff)[_i]), (PG8_LAS unsigned*)(lds + (bufoff) + ldsw + _i * 8192), 16, 0, 0); } while (0)
#define PG8_LDA(dst, b, h) do { if constexpr (FP8) { _Pragma("unroll") for (int m = 0; m < 4; ++m) { const PG8_LAS unsigned char* p_ = lds + PG8_SA(b, h) + aoff8 + m * 2048; const v4i32 l_ = *(const PG8_LAS v4i32*)p_, h_ = *(const PG8_LAS v4i32*)(p_ + 16); \
        dst##8[m] = __builtin_shufflevector(l_, h_, 0, 1, 2, 3, 4, 5, 6, 7); } } else { \
        _Pragma("unroll") for (int m = 0; m < 4; ++m) _Pragma("unroll") for (int k = 0; k < 2; ++k) dst[m][k] = *(const PG8_LAS bf16x8*)(lds + PG8_SA(b, h) + aoff + m * 2048 + k * 1024); } } while (0)
#define PG8_LDB(dst, b, h) do { if constexpr (FP8) { _Pragma("unroll") for (int n = 0; n < 2; ++n) { const PG8_LAS unsigned char* p_ = lds + PG8_SB(b, h) + boff8 + n * 2048; const v4i32 l_ = *(const PG8_LAS v4i32*)p_, h_ = *(const PG8_LAS v4i32*)(p_ + 16); \
        dst##8[n] = __builtin_shufflevector(l_, h_, 0, 1, 2, 3, 4, 5, 6, 7); } } else { \
        _Pragma("unroll") for (int n = 0; n < 2; ++n) _Pragma("unroll") for (int k = 0; k < 2; ++k) dst[n][k] = *(const PG8_LAS bf16x8*)(lds + PG8_SB(b, h) + boff + n * 2048 + k * 1024); } } while (0)
#define PG8_MMA(ai, bj, At, Bt) do { __builtin_amdgcn_s_setprio(1); if constexpr (FP8) { _Pragma("unroll") for (int m = 0; m < 4; ++m) _Pragma("unroll") for (int n = 0; n < 2; ++n) \
        asm volatile("v_mfma_scale_f32_16x16x128_f8f6f4 %0, %1, %2, %0, %3, %4 op_sel_hi:[0,0,0]" : "+v"(acc[ai][bj][m][n]) : "v"(Bt##8[n]), "v"(At##8[m]), "v"(sc_w8), "v"(sc_a8)); } else { \
        _Pragma("unroll") for (int m = 0; m < 4; ++m) _Pragma("unroll") for (int n = 0; n < 2; ++n) _Pragma("unroll") for (int k = 0; k < 2; ++k) \
        acc[ai][bj][m][n] = __builtin_amdgcn_mfma_f32_16x16x32_bf16(Bt[n][k], At[m][k], acc[ai][bj][m][n], 0, 0, 0); } __builtin_amdgcn_s_setprio(0); } while (0)
#define PG8_WAIT_V(n) asm volatile("s_waitcnt vmcnt(" #n ")" ::: "memory")
#define PG8_WAIT_L(n) asm volatile("s_waitcnt lgkmcnt(" #n ")" ::: "memory")
#define PG8_BAR __builtin_amdgcn_s_barrier()
#define PG8_SCHED __builtin_amdgcn_sched_barrier(0)
    Unit cur, nxt; int ui = 0;
    if (!S.next(0, cur)) return;
    f32x4 acc[2][2][4][2];
#pragma unroll
    for (int a = 0; a < 2; ++a)
#pragma unroll
        for (int b = 0; b < 2; ++b)
#pragma unroll
            for (int m = 0; m < 4; ++m)
#pragma unroll
                for (int n = 0; n < 2; ++n) acc[a][b][m][n] = (f32x4){0.f, 0.f, 0.f, 0.f};
    bf16x8 At[4][2], B0[2][2], B1[2][2];
    typedef int v8i32 __attribute__((ext_vector_type(8))); typedef int v4i32 __attribute__((ext_vector_type(4))); v8i32 At8[4], B08[2], B18[2];
    const int sc_w8 = 0x79797979, sc_a8 = g.sa;
    const char* cA = (const char*)g.A + (size_t)cur.pm * tstepA; const char* cB = (const char*)g.Bt + (size_t)cur.pn * tstepB;
    S.a_ready(cur);
    if constexpr (SP2) {
        PG8_STAGE(PG8_SB(0, 0), cB, voffB); PG8_STAGE(PG8_SB(0, 1), cB + hstepB, voffB); PG8_STAGE(PG8_SA(0, 0), cA, voffA); PG8_STAGE(PG8_SA(0, 1), cA + hstepA, voffA);
        if (wr == 1) PG8_BAR;
        PG8_WAIT_V(2); PG8_BAR;
        PG8_STAGE(PG8_SB(1, 0), cB + kstep, voffB); PG8_STAGE(PG8_SA(1, 0), cA + kstep, voffA); PG8_STAGE(PG8_SB(1, 1), cB + hstepB + kstep, voffB);
        PG8_WAIT_V(6); PG8_BAR;
    } else {
        PG8_STAGE(PG8_SB(0, 0), cB, voffB); PG8_STAGE(PG8_SA(0, 0), cA, voffA); PG8_STAGE(PG8_SB(0, 1), cB + hstepB, voffB); PG8_STAGE(PG8_SA(0, 1), cA + hstepA, voffA);
        if (wr == 1) PG8_BAR;
        PG8_WAIT_V(4); PG8_BAR;
        PG8_STAGE(PG8_SB(1, 0), cB + kstep, voffB); PG8_STAGE(PG8_SA(1, 0), cA + kstep, voffA); PG8_STAGE(PG8_SB(1, 1), cB + hstepB + kstep, voffB);
        PG8_WAIT_V(6); PG8_BAR;
    }
    for (;;) {
        const bool has_next = S.next(ui + 1, nxt);
        const char* nA = has_next ? (const char*)g.A + (size_t)nxt.pm * tstepA : cA; const char* nB = has_next ? (const char*)g.Bt + (size_t)nxt.pn * tstepB : cB;
        for (int t = 0; t < nt; t += 2) {
            const bool last = (t == nt - 2);
            const char* a1 = cA + (size_t)(t + 1) * kstep;
            const char* a2 = last ? nA : cA + (size_t)(t + 2) * kstep; const char* b2 = last ? nB : cB + (size_t)(t + 2) * kstep;
            const char* a3 = a2 + kstep; const char* b3 = b2 + kstep;
            if (last && has_next) S.a_ready(nxt);
            if constexpr (SP2) {
            PG8_LDB(B0, 0, 0); PG8_LDB(B1, 0, 1); PG8_SCHED; PG8_LDA(At, 0, 0); PG8_STAGE(PG8_SA(1, 1), a1 + hstepA, voffA);
            PG8_WAIT_V(8); PG8_WAIT_L(0); PG8_BAR; PG8_MMA(0, 0, At, B0); PG8_MMA(0, 1, At, B1); PG8_BAR; PG8_SCHED;
            PG8_LDA(At, 0, 1); PG8_STAGE(PG8_SB(0, 0), b2, voffB); PG8_STAGE(PG8_SB(0, 1), b2 + hstepB, voffB); PG8_STAGE(PG8_SA(0, 0), a2, voffA);
            PG8_WAIT_V(8); PG8_WAIT_L(0); PG8_BAR; PG8_MMA(1, 0, At, B0); PG8_MMA(1, 1, At, B1); PG8_BAR; PG8_SCHED;
            PG8_LDB(B0, 1, 0); PG8_LDB(B1, 1, 1); PG8_SCHED; PG8_LDA(At, 1, 0); PG8_STAGE(PG8_SA(0, 1), a2 + hstepA, voffA);
            PG8_WAIT_V(8); PG8_WAIT_L(0); PG8_BAR; PG8_MMA(0, 0, At, B0); PG8_MMA(0, 1, At, B1); PG8_BAR; PG8_SCHED;
            PG8_LDA(At, 1, 1); PG8_STAGE(PG8_SB(1, 0), b3, voffB); PG8_STAGE(PG8_SB(1, 1), b3 + hstepB, voffB); PG8_STAGE(PG8_SA(1, 0), a3, voffA);
            PG8_WAIT_V(8); PG8_WAIT_L(0); PG8_BAR; PG8_MMA(1, 0, At, B0); PG8_MMA(1, 1, At, B1); PG8_BAR; PG8_SCHED;
            } else {
            PG8_LDB(B0, 0, 0); PG8_SCHED; PG8_LDA(At, 0, 0); PG8_STAGE(PG8_SA(1, 1), a1 + hstepA, voffA);
            PG8_WAIT_L(8); PG8_BAR; PG8_WAIT_L(0); PG8_MMA(0, 0, At, B0); PG8_BAR; PG8_SCHED;
            PG8_LDB(B1, 0, 1); PG8_STAGE(PG8_SB(0, 0), b2, voffB);
            PG8_BAR; PG8_WAIT_L(0); PG8_MMA(0, 1, At, B1); PG8_BAR;
            PG8_LDA(At, 0, 1); PG8_STAGE(PG8_SA(0, 0), a2, voffA);
            PG8_BAR; PG8_WAIT_L(0); PG8_MMA(1, 0, At, B0); PG8_BAR; PG8_SCHED;
            PG8_STAGE(PG8_SB(0, 1), b2 + hstepB, voffB);
            PG8_WAIT_V(6); PG8_BAR; PG8_MMA(1, 1, At, B1); PG8_BAR;
            PG8_LDB(B0, 1, 0); PG8_SCHED; PG8_LDA(At, 1, 0); PG8_STAGE(PG8_SA(0, 1), a2 + hstepA, voffA);
            PG8_WAIT_L(8); PG8_BAR; PG8_WAIT_L(0); PG8_MMA(0, 0, At, B0); PG8_BAR; PG8_SCHED;
            PG8_LDB(B1, 1, 1); PG8_STAGE(PG8_SB(1, 0), b3, voffB);
            PG8_BAR; PG8_WAIT_L(0); PG8_MMA(0, 1, At, B1); PG8_BAR;
            PG8_LDA(At, 1, 1); PG8_STAGE(PG8_SA(1, 0), a3, voffA);
            PG8_BAR; PG8_WAIT_L(0); PG8_MMA(1, 0, At, B0); PG8_BAR; PG8_SCHED;
            PG8_STAGE(PG8_SB(1, 1), b3 + hstepB, voffB);
            PG8_WAIT_V(6); PG8_BAR; PG8_MMA(1, 1, At, B1); PG8_BAR;
            }
        }
        if constexpr (FP8) asm volatile("s_nop 15\n\ts_nop 7" ::: "memory");
        if constexpr (ALIGN_EPI) { if (wr == 0) PG8_BAR; }
        if constexpr (!Epi::AFTER_DRAIN) { E(acc, cur, wr, wc, fr, fq); PROBE_EPI_DUP S.done(cur); }
        if (!has_next) break;
#pragma unroll
        for (int a = 0; a < 2; ++a)
#pragma unroll
            for (int b = 0; b < 2; ++b)
#pragma unroll
                for (int m = 0; m < 4; ++m)
#pragma unroll
                    for (int n = 0; n < 2; ++n) acc[a][b][m][n] = (f32x4){0.f, 0.f, 0.f, 0.f};
        cur = nxt; cA = nA; cB = nB; ++ui;
        if constexpr (ALIGN_EPI) { if (wr == 1) PG8_BAR; }
    }
    PG8_WAIT_V(0);
    if constexpr (!ALIGN_EPI) { if (wr == 0) PG8_BAR; }
    PG8_BAR;
    if constexpr (Epi::AFTER_DRAIN) { E.fused(acc, cur, wr, wc, fr, fq, lds, wid, lane); S.done(cur); }
#undef PG8_SA
#undef PG8_SB
#undef PG8_STAGE
#undef PG8_LDA
#undef PG8_LDB
#undef PG8_MMA
#undef PG8_WAIT_V
#undef PG8_WAIT_L
#undef PG8_BAR
#undef PG8_SCHED
}
}
#define XB_TMO      128
#define XB_XCNT(j)  (256  + 64 * (j))
#define XB_XSUB(j)  (1280 + 64 * (j))
#define XB_XGEN(j)  (2304 + 64 * (j))
#define XB_TOP      3328
#define XB_TOPGEN   3392
#define XCD_BAR_WORDS 3456
#define XB_SPIN_CAP (1u << 18)

__device__ __forceinline__ unsigned xb_ld(unsigned* p)              { return __hip_atomic_load(p, __ATOMIC_RELAXED, __HIP_MEMORY_SCOPE_AGENT); }
__device__ __forceinline__ unsigned xb_add(unsigned* p, unsigned v) { return __hip_atomic_fetch_add(p, v, __ATOMIC_RELAXED, __HIP_MEMORY_SCOPE_AGENT); }
__device__ __forceinline__ unsigned xb_xcc_id() { return (unsigned)__builtin_amdgcn_s_getreg((3 << 11) | 20) & 0xFu; }
#define XB_SPIN(cond, bar) do { unsigned _sp = 0; while (cond) { __builtin_amdgcn_s_sleep(1); \
    if ((++_sp & 255u) == 0u) { if (xb_ld(&(bar)[XB_TMO])) break; if (_sp > XB_SPIN_CAP) { atomicAdd(&(bar)[XB_TMO], 1u); break; } } } } while (0)

struct XcdBarrier {
    unsigned* bar; unsigned x;
    volatile LAS unsigned* st;
};

__device__ __forceinline__ XcdBarrier xcd_barrier_post(unsigned* bar, volatile LAS unsigned* st) {
    XcdBarrier b; b.bar = bar; b.x = xb_xcc_id(); b.st = st;
    if (threadIdx.x == 0) (void)xb_add(&bar[XB_XCNT(b.x)], 1u);
    return b;
}
__device__ __forceinline__ void xcd_barrier_complete(unsigned* bar, unsigned x, unsigned& nloc, unsigned& nx) {
    const unsigned G = gridDim.x * gridDim.y * gridDim.z;
    unsigned sum, cnt, mine, sp = 0u;
    for (;;) {
        sum = 0u; cnt = 0u; mine = 0u;
#pragma unroll
        for (unsigned j = 0; j < 16; ++j) { const unsigned c = xb_ld(&bar[XB_XCNT(j)]); sum += c; cnt += (c > 0u) ? 1u : 0u; mine = (j == x) ? c : mine; }
        if (sum == G) break;
        __builtin_amdgcn_s_sleep(1);
        if ((++sp & 255u) == 0u) { if (xb_ld(&bar[XB_TMO])) break; if (sp > XB_SPIN_CAP) { atomicAdd(&bar[XB_TMO], 1u); break; } }
    }
    nloc = mine > 0u ? mine : 1u; nx = cnt > 0u ? cnt : 1u;
}

__device__ __forceinline__ void xcd_barrier(const XcdBarrier& b) {
    asm volatile("s_waitcnt vmcnt(0)" ::: "memory");
    __syncthreads();
    if (threadIdx.x == 0) {
        unsigned* bar = b.bar;
        __builtin_amdgcn_s_waitcnt(0);
        unsigned nloc = b.st[0], nx = b.st[1];
        if (nloc == 0u) { xcd_barrier_complete(bar, b.x, nloc, nx); b.st[0] = nloc; b.st[1] = nx; }
        const unsigned old = xb_add(&bar[XB_XSUB(b.x)], 1u);
        const unsigned gen = old / nloc;
        if (old + 1u == (gen + 1u) * nloc) {
            __builtin_amdgcn_fence(__ATOMIC_RELEASE, "agent");
            asm volatile("s_waitcnt vmcnt(0)" ::: "memory");
            const unsigned og = xb_add(&bar[XB_TOP], 1u);
            const unsigned tg = og / nx;
            if (og + 1u == (tg + 1u) * nx) xb_add(&bar[XB_TOPGEN], 1u);
            else XB_SPIN(xb_ld(&bar[XB_TOPGEN]) == tg, bar);
            __builtin_amdgcn_fence(__ATOMIC_ACQUIRE, "agent");
            xb_add(&bar[XB_XGEN(b.x)], 1u);
            asm volatile("s_waitcnt vmcnt(0)" ::: "memory");
        } else {
            XB_SPIN(xb_ld(&bar[XB_XGEN(b.x)]) == gen, bar);
            __builtin_amdgcn_fence(__ATOMIC_ACQUIRE, "agent");
            asm volatile("s_waitcnt vmcnt(0)" ::: "memory");
        }
    }
    __syncthreads();
}
namespace dattn {
typedef unsigned short bf16;
constexpr int   D = 128, NW = 8, QBLK = 32, KVBLK = 64;
constexpr float SCALE = 0.088388347648318440f;
constexpr float THR = 8.f;
constexpr int SDEPTH = 2;
constexpr int LDQ = 4096, LDK = 1024, LDO = 4096;
constexpr size_t SHM_V = KVBLK * D * 2, SHM_K = KVBLK * D * 2, SHM_ATTN = 3 * SHM_V + 3 * SHM_K + NW * 64 * 4 + 2048;
using bf16x8 = __attribute__((ext_vector_type(8))) short;
using s16x4  = __attribute__((ext_vector_type(4))) short;
using f32x16 = __attribute__((ext_vector_type(16))) float;
using f32x8  = __attribute__((ext_vector_type(8))) float;
using u32x4  = __attribute__((ext_vector_type(4))) unsigned;
#define KSWZ(row, colB) ((row) * 256 + ((colB) ^ (((row) & 7) << 4)))
#define SBAR() __builtin_amdgcn_sched_barrier(0)
__device__ __forceinline__ int crow(int r, int hi) { return (r & 3) + 8 * (r >> 2) + 4 * hi; }
__device__ __forceinline__ unsigned cvtpk(float lo, float hi) {
  unsigned r; asm volatile("v_cvt_pk_bf16_f32 %0, %1, %2" : "=v"(r) : "v"(lo), "v"(hi)); return r;
}
template <typename TIn> struct Stage;
template <> struct Stage<bf16>  { using T = bf16x8;
  __device__ static __forceinline__ T ld8(const bf16* p) { return *reinterpret_cast<const bf16x8*>(p); }
  __device__ static __forceinline__ bf16x8 tobf(T x) { return x; } };
template <> struct Stage<float> { using T = f32x8;
  __device__ static __forceinline__ T ld8(const float* p) { return *reinterpret_cast<const f32x8*>(p); }
  __device__ static __forceinline__ bf16x8 tobf(T x) {
    u32x4 w = {cvtpk(x[0], x[1]), cvtpk(x[2], x[3]), cvtpk(x[4], x[5]), cvtpk(x[6], x[7])}; return *reinterpret_cast<bf16x8*>(&w); } };

__device__ __forceinline__ void partialSM(f32x16& p0, f32x16& p1, float& m_reg, float& mn, float& alpha) {
  constexpr float C = SCALE * 1.4426950408889634f;
  float pmax = p0[0]; for (int r = 1; r < 16; ++r) pmax = fmaxf(pmax, p0[r]); for (int r = 0; r < 16; ++r) pmax = fmaxf(pmax, p1[r]);
  { auto rr = __builtin_amdgcn_permlane32_swap(__float_as_uint(pmax), __float_as_uint(pmax), false, false);
    pmax = fmaxf(__uint_as_float(rr[0]), __uint_as_float(rr[1])); }
  if (__builtin_expect(__all(pmax - m_reg <= THR / SCALE), 1)) { mn = m_reg; alpha = 1.f; }
  else { mn = fmaxf(m_reg, pmax); alpha = __builtin_amdgcn_exp2f((m_reg - mn) * C); m_reg = mn; }
  float mnC = -mn * C;
  for (int r = 0; r < 16; ++r) p0[r] = fmaf(p0[r], C, mnC); for (int r = 0; r < 16; ++r) p1[r] = fmaf(p1[r], C, mnC);
  for (int r = 0; r < 16; ++r) p0[r] = __builtin_amdgcn_exp2f(p0[r]);
}
__device__ __forceinline__ void finishSM(f32x16& p0, f32x16& p1, float alpha, float& l_reg, bf16x8& pa0, bf16x8& pa1, bf16x8& pa2, bf16x8& pa3) {
  for (int r = 0; r < 16; ++r) p1[r] = __builtin_amdgcn_exp2f(p1[r]);
  float ps = 0; for (int r = 0; r < 16; ++r) ps += p0[r]; for (int r = 0; r < 16; ++r) ps += p1[r];
  { auto rr = __builtin_amdgcn_permlane32_swap(__float_as_uint(ps), __float_as_uint(ps), false, false);
    ps = __uint_as_float(rr[0]) + __uint_as_float(rr[1]); }
  l_reg = l_reg * alpha + ps;
#define PK4(P, BASE, OUT) do { unsigned a0 = cvtpk(P[BASE + 0], P[BASE + 1]), a1 = cvtpk(P[BASE + 2], P[BASE + 3]);   \
    unsigned b0 = cvtpk(P[BASE + 4], P[BASE + 5]), b1 = cvtpk(P[BASE + 6], P[BASE + 7]);                              \
    auto r0 = __builtin_amdgcn_permlane32_swap(a0, b0, false, false); auto r1 = __builtin_amdgcn_permlane32_swap(a1, b1, false, false); \
    u32x4 w = {r0[0], r1[0], r0[1], r1[1]}; OUT = *reinterpret_cast<bf16x8*>(&w); } while (0)
  PK4(p0, 0, pa0); PK4(p0, 8, pa1); PK4(p1, 0, pa2); PK4(p1, 8, pa3);
#undef PK4
}
__device__ __forceinline__ void qkt(f32x16& p0, f32x16& p1, const bf16* Ks, const bf16x8* qr, int r32, int hi) {
  p0 = f32x16{}; p1 = f32x16{};
  bf16x8 nb0 = *reinterpret_cast<const bf16x8*>((const char*)Ks + KSWZ(r32, (hi * 8) * 2)), nb1 = *reinterpret_cast<const bf16x8*>((const char*)Ks + KSWZ(32 + r32, (hi * 8) * 2));
#pragma unroll
  for (int d0 = 0; d0 < 8; ++d0) { const bf16x8 b0 = nb0, b1 = nb1;
    if (d0 < 7) { const int cb = ((d0 + 1) * 16 + hi * 8) * 2;
      nb0 = *reinterpret_cast<const bf16x8*>((const char*)Ks + KSWZ(r32, cb)); nb1 = *reinterpret_cast<const bf16x8*>((const char*)Ks + KSWZ(32 + r32, cb)); }
    p0 = __builtin_amdgcn_mfma_f32_32x32x16_bf16(b0, qr[d0], p0, 0, 0, 0);
    p1 = __builtin_amdgcn_mfma_f32_32x32x16_bf16(b1, qr[d0], p1, 0, 0, 0); }
}
__device__ __forceinline__ int v_st(int k, int c) { const int kk = (k & ~0xC) | ((k & 4) << 1) | ((k & 8) >> 1); return ((kk >> 3) * 4 + (c >> 5)) * 512 + ((kk & 7) * 32 + (c & 31)) * 2; }
__device__ __forceinline__ int v_rd_base(int lane) { return ((lane & 3) << 3) | (((lane >> 2) & 3) << 6) | (((lane >> 4) & 1) << 5) | (((lane >> 5) & 1) << 8); }
constexpr int v_rd_off(int d0, int ks, int half) { return d0 * 512 + ks * 4096 + half * 2048; }
template <int OFF> __device__ __forceinline__ s16x4 tr_read(int vb) {
  s16x4 r; asm volatile("ds_read_b64_tr_b16 %0, %1 offset:%2" : "=&v"(r) : "v"(vb), "i"(OFF) : "memory"); return r;
}
template <int D0> __device__ __forceinline__ void pv_one(f32x16& od, int vb, bf16x8 pa0, bf16x8 pa1, bf16x8 pa2, bf16x8 pa3) {
  const s16x4 l0 = tr_read<v_rd_off(D0, 0, 0)>(vb), h0 = tr_read<v_rd_off(D0, 0, 1)>(vb), l1 = tr_read<v_rd_off(D0, 1, 0)>(vb), h1 = tr_read<v_rd_off(D0, 1, 1)>(vb);
  const s16x4 l2 = tr_read<v_rd_off(D0, 2, 0)>(vb), h2 = tr_read<v_rd_off(D0, 2, 1)>(vb), l3 = tr_read<v_rd_off(D0, 3, 0)>(vb), h3 = tr_read<v_rd_off(D0, 3, 1)>(vb);
  asm volatile("s_waitcnt lgkmcnt(0)" ::: "memory"); SBAR();
#define PK(L, H) (bf16x8){L[0], L[1], L[2], L[3], H[0], H[1], H[2], H[3]}
  od = __builtin_amdgcn_mfma_f32_32x32x16_bf16(pa0, PK(l0, h0), od, 0, 0, 0);
  od = __builtin_amdgcn_mfma_f32_32x32x16_bf16(pa1, PK(l1, h1), od, 0, 0, 0);
  od = __builtin_amdgcn_mfma_f32_32x32x16_bf16(pa2, PK(l2, h2), od, 0, 0, 0);
  od = __builtin_amdgcn_mfma_f32_32x32x16_bf16(pa3, PK(l3, h3), od, 0, 0, 0);
#undef PK
}
__device__ __forceinline__ void pv_d0(f32x16* o, int vb, bf16x8 pa0, bf16x8 pa1, bf16x8 pa2, bf16x8 pa3) {
  pv_one<0>(o[0], vb, pa0, pa1, pa2, pa3); pv_one<1>(o[1], vb, pa0, pa1, pa2, pa3); pv_one<2>(o[2], vb, pa0, pa1, pa2, pa3); pv_one<3>(o[3], vb, pa0, pa1, pa2, pa3);
}

template <typename TQ>
__device__ __forceinline__ void attn_dense_body(const TQ* __restrict__ Qb, const bf16* __restrict__ Kh, const bf16* __restrict__ Vh,
                                                bf16* __restrict__ Ob, int seq, char* lds) {
  using St = Stage<bf16>; using SQ = Stage<TQ>;
  int tid_o = threadIdx.x; asm volatile("" : "+v"(tid_o)); const int tid = tid_o, wid = __builtin_amdgcn_readfirstlane(tid >> 6), lane = tid & 63, r32 = lane & 31, hi = lane >> 5;
  bf16* V_lds = (bf16*)lds; bf16* K_lds = (bf16*)(lds + 3 * SHM_V);
  float* ws = (float*)(lds + 3 * SHM_V + 3 * SHM_K) + wid * 64; float* li_l = ws; float* al_l = ws + 32;
  float m_reg = -1e30f, l_reg = 0; f32x16 o[4] = {}; bf16x8 qr[8];
  const TQ* Qw = Qb + (long)(wid * QBLK + r32) * LDQ + hi * 8;
#pragma unroll
  for (int d0 = 0; d0 < 8; ++d0) qr[d0] = SQ::tobf(SQ::ld8(Qw + d0 * 16));
  const int sr = tid >> 4, sc = (tid & 15) * 8, vst0 = v_st(sr, sc), vst1 = v_st(32 + sr, sc);
  const int vb0 = (int)(uintptr_t)V_lds + v_rd_base(lane);
  struct { typename St::T vs0, vs1, ks0, ks1; } sr_[SDEPTH];
#define SLOAD(i, k0) do { sr_[i].vs0 = St::ld8(&Vh[(long)((k0) + sr) * LDK + sc]); sr_[i].vs1 = St::ld8(&Vh[(long)((k0) + 32 + sr) * LDK + sc]); \
    sr_[i].ks0 = St::ld8(&Kh[(long)((k0) + sr) * LDK + sc]); sr_[i].ks1 = St::ld8(&Kh[(long)((k0) + 32 + sr) * LDK + sc]); } while (0)
#define SWRITE(b, i) do { *(bf16x8*)((char*)V_lds + (b) * SHM_V + vst0) = St::tobf(sr_[i].vs0);          \
    *(bf16x8*)((char*)V_lds + (b) * SHM_V + vst1) = St::tobf(sr_[i].vs1); int kc = sc * 2;               \
    *(bf16x8*)((char*)K_lds + (b) * SHM_K + KSWZ(sr, kc)) = St::tobf(sr_[i].ks0);                       \
    *(bf16x8*)((char*)K_lds + (b) * SHM_K + KSWZ(32 + sr, kc)) = St::tobf(sr_[i].ks1); } while (0)
#define SWAIT() do { if constexpr (SDEPTH == 2) asm volatile("s_waitcnt vmcnt(4)" ::: "memory"); else asm volatile("s_waitcnt vmcnt(0)" ::: "memory"); } while (0)
#define RESC(a) do { if (__any((a) < 1.f)) { if (hi == 0) al_l[r32] = (a); asm volatile("s_waitcnt lgkmcnt(0)" ::: "memory"); \
    for (int d = 0; d < 4; ++d) for (int r = 0; r < 16; ++r) o[d][r] *= al_l[crow(r, hi)]; } } while (0)
  f32x16 pA0, pA1, pB0, pB1; float mnA, mnB, alA, alB; bf16x8 pa0, pa1, pa2, pa3; const int NT = seq / KVBLK;
  constexpr int SE = 0, SO = SDEPTH - 1;
  SLOAD(SE, 0); asm volatile("s_waitcnt vmcnt(0)" ::: "memory"); SWRITE(0, SE); __syncthreads();
  qkt(pA0, pA1, K_lds, qr, r32, hi); partialSM(pA0, pA1, m_reg, mnA, alA);
  SLOAD(SO, KVBLK); if constexpr (SDEPTH == 2) { if (2 < NT) SLOAD(SE, 2 * KVBLK); }
  SWAIT(); SWRITE(1, SO); __syncthreads();
  int bk = 1, bv = 0, bw = 2;
  if (wid >= 4) __builtin_amdgcn_s_setprio(1);
#define ROT3() do { const int t_ = bv; bv = bk; bk = bw; bw = t_; } while (0)
  for (int j = 1; j + 1 < NT; j += 2) {
    SBAR(); qkt(pB0, pB1, (bf16*)((char*)K_lds + bk * SHM_K), qr, r32, hi);
    finishSM(pA0, pA1, alA, l_reg, pa0, pa1, pa2, pa3); SBAR();
    SLOAD(SO, (j + SDEPTH) * KVBLK); SBAR();
    pv_d0(o, vb0 + bv * (int)SHM_V, pa0, pa1, pa2, pa3); partialSM(pB0, pB1, m_reg, mnB, alB);
    SWAIT(); SWRITE(bw, SE);
    RESC(alB); __syncthreads(); ROT3();
    SBAR(); qkt(pA0, pA1, (bf16*)((char*)K_lds + bk * SHM_K), qr, r32, hi);
    finishSM(pB0, pB1, alB, l_reg, pa0, pa1, pa2, pa3); SBAR();
    if (SDEPTH == 1 || j + 3 < NT) SLOAD(SE, (j + 1 + SDEPTH) * KVBLK); SBAR();
    pv_d0(o, vb0 + bv * (int)SHM_V, pa0, pa1, pa2, pa3); partialSM(pA0, pA1, m_reg, mnA, alA);
    SWAIT(); SWRITE(bw, SO);
    RESC(alA); __syncthreads(); ROT3();
  }
  SBAR(); qkt(pB0, pB1, (bf16*)((char*)K_lds + bk * SHM_K), qr, r32, hi);
  finishSM(pA0, pA1, alA, l_reg, pa0, pa1, pa2, pa3); SBAR();
  pv_d0(o, vb0 + bv * (int)SHM_V, pa0, pa1, pa2, pa3); partialSM(pB0, pB1, m_reg, mnB, alB);
  RESC(alB);
  finishSM(pB0, pB1, alB, l_reg, pa0, pa1, pa2, pa3); SBAR();
  pv_d0(o, vb0 + bk * (int)SHM_V, pa0, pa1, pa2, pa3);
#undef ROT3
  __builtin_amdgcn_s_setprio(0);
  if (hi == 0) li_l[r32] = l_reg; asm volatile("s_waitcnt lgkmcnt(0)" ::: "memory");
  float rli[16];
#pragma unroll
  for (int r = 0; r < 16; ++r) rli[r] = __builtin_amdgcn_rcpf(li_l[crow(r, hi)]);
  bf16* Ow = Ob + (long)(wid * QBLK) * LDO;
#pragma unroll
  for (int r = 0; r < 16; ++r) { int orow = crow(r, hi);
    for (int d0 = 0; d0 < 4; ++d0) Ow[(long)orow * LDO + d0 * 32 + r32] = (bf16)(cvtpk(o[d0][r] * rli[r], 0.f) & 0xffffu); }
#undef SLOAD
#undef SWRITE
#undef SWAIT
#undef RESC
}

constexpr int NA_LD = 4096, NA_TILES = 12;
__device__ __forceinline__ void na_block_body(const bf16* __restrict__ Qb, const bf16* __restrict__ Kh, const bf16* __restrict__ Vh, bf16* __restrict__ Ob,
                                              const float* __restrict__ rpb_h, const float* __restrict__ qgain, const float* __restrict__ kgain, int R, int ks, char* lds) {
  using St = Stage<bf16>;
  int tid_o = threadIdx.x; asm volatile("" : "+v"(tid_o)); const int tid = tid_o, wid = __builtin_amdgcn_readfirstlane(tid >> 6), lane = tid & 63, r32 = lane & 31, hi = lane >> 5;
  bf16* V_lds = (bf16*)lds; bf16* K_lds = (bf16*)(lds + 2 * SHM_V);
  float* ws = (float*)(lds + 2 * SHM_V + 2 * SHM_K) + wid * 64; float* li_l = ws; float* al_l = ws + 32;
  float* bt = (float*)(lds + 2 * SHM_V + 2 * SHM_K + NW * 64 * 4);
  float m_reg = -1e30f, l_reg = 0; f32x16 o[4] = {}; bf16x8 qr[8];
  const bf16* Qw = Qb + (long)(wid * QBLK + r32) * NA_LD + hi * 8;
#pragma unroll
  for (int d0 = 0; d0 < 8; ++d0) qr[d0] = St::ld8(Qw + d0 * 16);
  {
    float ss = 0.f;
#pragma unroll
    for (int d0 = 0; d0 < 8; ++d0) { const u32x4 w = __builtin_bit_cast(u32x4, qr[d0]);
#pragma unroll
      for (int e = 0; e < 4; ++e) { const float a = __uint_as_float(w[e] << 16), b = __uint_as_float(w[e] & 0xffff0000u); ss += a * a + b * b; } }
    ss += __shfl_xor(ss, 32);
    const float rinv = __builtin_amdgcn_rsqf(ss * (1.0f / 128.0f) + 1e-6f);
#pragma unroll
    for (int d0 = 0; d0 < 8; ++d0) { const u32x4 w = __builtin_bit_cast(u32x4, qr[d0]); const float* gp = qgain + d0 * 16 + hi * 8;
      const f32x8 g = *reinterpret_cast<const f32x8*>(gp); u32x4 o;
#pragma unroll
      for (int e = 0; e < 4; ++e) o[e] = cvtpk(__uint_as_float(w[e] << 16) * rinv * g[2 * e], __uint_as_float(w[e] & 0xffff0000u) * rinv * g[2 * e + 1]);
      qr[d0] = __builtin_bit_cast(bf16x8, o); } }
  const f32x8 kg = *reinterpret_cast<const f32x8*>(kgain + (tid & 15) * 8);
  for (int i = tid; i < 15 * 31; i += 64 * NW) bt[i] = rpb_h[i];
  const int sr = tid >> 4, sc = (tid & 15) * 8, vst0 = v_st(sr, sc), vst1 = v_st(32 + sr, sc);
  const int vb0 = (int)(uintptr_t)V_lds + v_rd_base(lane);
  bf16x8 s_vs0, s_vs1, s_ks0, s_ks1;
#define NLOAD(k0) do { s_vs0 = St::ld8(&Vh[(long)((k0) + sr) * NA_LD + sc]); s_vs1 = St::ld8(&Vh[(long)((k0) + 32 + sr) * NA_LD + sc]); \
    s_ks0 = St::ld8(&Kh[(long)((k0) + sr) * NA_LD + sc]); s_ks1 = St::ld8(&Kh[(long)((k0) + 32 + sr) * NA_LD + sc]); } while (0)
#define KNORM(x) do { const u32x4 w_ = __builtin_bit_cast(u32x4, x); float a_[8]; float ss_ = 0.f; \
    _Pragma("unroll") for (int e = 0; e < 4; ++e) { a_[2 * e] = __uint_as_float(w_[e] << 16); a_[2 * e + 1] = __uint_as_float(w_[e] & 0xffff0000u); ss_ += a_[2 * e] * a_[2 * e] + a_[2 * e + 1] * a_[2 * e + 1]; } \
    ss_ += __shfl_xor(ss_, 1); ss_ += __shfl_xor(ss_, 2); ss_ += __shfl_xor(ss_, 4); ss_ += __shfl_xor(ss_, 8); \
    const float ri_ = __builtin_amdgcn_rsqf(ss_ * (1.0f / 128.0f) + 1e-6f); u32x4 o_; \
    _Pragma("unroll") for (int e = 0; e < 4; ++e) o_[e] = cvtpk(a_[2 * e] * ri_ * kg[2 * e], a_[2 * e + 1] * ri_ * kg[2 * e + 1]); \
    x = __builtin_bit_cast(bf16x8, o_); } while (0)
#define NWRITE(b) do { KNORM(s_ks0); KNORM(s_ks1); \
    *(bf16x8*)((char*)V_lds + (b) * SHM_V + vst0) = s_vs0; *(bf16x8*)((char*)V_lds + (b) * SHM_V + vst1) = s_vs1; const int kc_ = sc * 2; \
    *(bf16x8*)((char*)K_lds + (b) * SHM_K + KSWZ(sr, kc_)) = s_ks0; *(bf16x8*)((char*)K_lds + (b) * SHM_K + KSWZ(32 + sr, kc_)) = s_ks1; } while (0)
  const int qrow = R + (wid >> 1), r0q = min(max(qrow - 4, 0), 248), jlo = r0q - ks;
  const int c = 32 * (wid & 1) + r32, c0 = min(max(c - 8, 0), 48);
  NLOAD(0); asm volatile("s_waitcnt vmcnt(0)" ::: "memory"); NWRITE(0); __syncthreads();
  for (int j = 0; j < NA_TILES; ++j) {
    const int buf = j & 1;
    if (j + 1 < NA_TILES) NLOAD((j + 1) * KVBLK);
    if (j >= jlo && j < jlo + 8) {
      f32x16 p0, p1; float mn, al; bf16x8 pa0, pa1, pa2, pa3;
      SBAR(); qkt(p0, p1, (bf16*)((char*)K_lds + buf * SHM_K), qr, r32, hi);
      const float* brow = bt + (ks + j - qrow + 7) * 31 + (15 - c);
#pragma unroll
      for (int r = 0; r < 16; ++r) { const int k0 = crow(r, hi), k1 = 32 + k0; const bool v0 = (k0 >= c0) && (k0 < c0 + 16), v1 = (k1 >= c0) && (k1 < c0 + 16);
        const float b0 = brow[v0 ? k0 : c], b1 = brow[v1 ? k1 : c];
        p0[r] = v0 ? fmaf(b0, 1.0f / SCALE, p0[r]) : -1e30f; p1[r] = v1 ? fmaf(b1, 1.0f / SCALE, p1[r]) : -1e30f; }
      partialSM(p0, p1, m_reg, mn, al);
      if (__any(al < 1.f)) { if (hi == 0) al_l[r32] = al; asm volatile("s_waitcnt lgkmcnt(0)" ::: "memory");
#pragma unroll
        for (int d = 0; d < 4; ++d)
#pragma unroll
          for (int r = 0; r < 16; ++r) o[d][r] *= al_l[crow(r, hi)]; }
      finishSM(p0, p1, al, l_reg, pa0, pa1, pa2, pa3); SBAR();
      pv_d0(o, vb0 + buf * (int)SHM_V, pa0, pa1, pa2, pa3);
    }
    if (j + 1 < NA_TILES) { asm volatile("s_waitcnt vmcnt(0)" ::: "memory"); NWRITE(buf ^ 1); }
    __syncthreads();
  }
  if (hi == 0) li_l[r32] = l_reg; asm volatile("s_waitcnt lgkmcnt(0)" ::: "memory");
  float rli[16];
#pragma unroll
  for (int r = 0; r < 16; ++r) rli[r] = 64.0f * __builtin_amdgcn_rcpf(li_l[crow(r, hi)]);
  unsigned char* Ow = (unsigned char*)Ob + (long)(wid * QBLK) * NA_LD;
#pragma unroll
  for (int r = 0; r < 16; ++r) { const int orow = crow(r, hi);
    for (int d0 = 0; d0 < 4; ++d0) Ow[(long)orow * NA_LD + d0 * 32 + r32] = (unsigned char)__builtin_amdgcn_cvt_pk_fp8_f32(o[d0][r] * rli[r], 0.f, 0, false); }
#undef NLOAD
#undef NWRITE
#undef KNORM
}

typedef int v8i __attribute__((ext_vector_type(8)));
typedef unsigned u32x2 __attribute__((ext_vector_type(2)));
constexpr int K8_LD = 1024, V8_LD = 16384, SHM_K8 = KVBLK * D, SHM_V8 = KVBLK * D;
constexpr float THR8 = 3.0f;
__device__ __forceinline__ int cvt4_fp8(float a, float b, float c, float d) { int w = __builtin_amdgcn_cvt_pk_fp8_f32(a, b, 0, false); return __builtin_amdgcn_cvt_pk_fp8_f32(c, d, w, true); }
__device__ __forceinline__ v8i mk8(u32x4 lo, u32x4 hi) { return (v8i){(int)lo[0], (int)lo[1], (int)lo[2], (int)lo[3], (int)hi[0], (int)hi[1], (int)hi[2], (int)hi[3]}; }
__device__ __forceinline__ void qkt8(f32x16& p0, f32x16& p1, const char* Ks, const v8i* qf, int r32, int hi) {
  const int x0 = (r32 >> 1) & 7, x1 = ((32 + r32) >> 1) & 7;
  const char* k0 = Ks + r32 * 128; const char* k1 = Ks + (32 + r32) * 128;
  v8i a[2][2];
#pragma unroll
  for (int s = 0; s < 2; ++s) { const int c = 4 * s + 2 * hi;
    a[0][s] = mk8(*reinterpret_cast<const u32x4*>(k0 + 16 * (c ^ x0)), *reinterpret_cast<const u32x4*>(k0 + 16 * ((c + 1) ^ x0)));
    a[1][s] = mk8(*reinterpret_cast<const u32x4*>(k1 + 16 * (c ^ x1)), *reinterpret_cast<const u32x4*>(k1 + 16 * ((c + 1) ^ x1))); }
  p0 = f32x16{}; p1 = f32x16{};
#pragma unroll
  for (int s = 0; s < 2; ++s) {
    p0 = __builtin_amdgcn_mfma_scale_f32_32x32x64_f8f6f4(a[0][s], qf[s], p0, 0, 0, 0, 0x7F7F7F7F, 0, 0x7F7F7F7F);
    p1 = __builtin_amdgcn_mfma_scale_f32_32x32x64_f8f6f4(a[1][s], qf[s], p1, 0, 0, 0, 0x7F7F7F7F, 0, 0x7F7F7F7F); }
}
__device__ __forceinline__ void partialSM8(f32x16& p0, f32x16& p1, float& m_reg, float& mn, float& alpha) {
  constexpr float C = SCALE * 1.4426950408889634f;
  float pmax = p0[0]; for (int r = 1; r < 16; ++r) pmax = fmaxf(pmax, p0[r]); for (int r = 0; r < 16; ++r) pmax = fmaxf(pmax, p1[r]);
  { auto rr = __builtin_amdgcn_permlane32_swap(__float_as_uint(pmax), __float_as_uint(pmax), false, false);
    pmax = fmaxf(__uint_as_float(rr[0]), __uint_as_float(rr[1])); }
  if (__builtin_expect(__all(pmax - m_reg <= THR8 / SCALE), 1)) { mn = m_reg; alpha = 1.f; }
  else { mn = fmaxf(m_reg, pmax); alpha = __builtin_amdgcn_exp2f((m_reg - mn) * C); m_reg = mn; }
  const float mnC = 4.0f - mn * C;
  for (int r = 0; r < 16; ++r) p0[r] = fmaf(p0[r], C, mnC); for (int r = 0; r < 16; ++r) p1[r] = fmaf(p1[r], C, mnC);
  for (int r = 0; r < 16; ++r) p0[r] = __builtin_amdgcn_exp2f(p0[r]);
}
__device__ __forceinline__ void finishSM8(f32x16& p0, f32x16& p1, float alpha, float& l_reg, v8i& pa) {
  for (int r = 0; r < 16; ++r) p1[r] = __builtin_amdgcn_exp2f(p1[r]);
  float ps = 0; for (int r = 0; r < 16; ++r) ps += p0[r]; for (int r = 0; r < 16; ++r) ps += p1[r];
  { auto rr = __builtin_amdgcn_permlane32_swap(__float_as_uint(ps), __float_as_uint(ps), false, false);
    ps = __uint_as_float(rr[0]) + __uint_as_float(rr[1]); }
  l_reg = l_reg * alpha + ps;
#pragma unroll
  for (int v = 0; v < 4; ++v) { pa[v] = cvt4_fp8(p0[4 * v], p0[4 * v + 1], p0[4 * v + 2], p0[4 * v + 3]); pa[4 + v] = cvt4_fp8(p1[4 * v], p1[4 * v + 1], p1[4 * v + 2], p1[4 * v + 3]); }
}
__device__ __forceinline__ void pv8(f32x16* o, const char* Vs, const v8i& pa, int r32, int hi) {
  v8i b[4];
#pragma unroll
  for (int db = 0; db < 4; ++db) { const int d = 32 * db + r32, x = (d >> 2) & 3; const char* vp = Vs + d * 64;
    b[db] = mk8(*reinterpret_cast<const u32x4*>(vp + 16 * ((2 * hi) ^ x)), *reinterpret_cast<const u32x4*>(vp + 16 * ((2 * hi + 1) ^ x))); }
#pragma unroll
  for (int db = 0; db < 4; ++db) o[db] = __builtin_amdgcn_mfma_scale_f32_32x32x64_f8f6f4(pa, b[db], o[db], 0, 0, 0, 0x7F7F7F7F, 0, 0x7F7F7F7F);
}
__device__ __forceinline__ void attn_dense_body8(const bf16* __restrict__ Qb, const unsigned char* __restrict__ K8h, const unsigned char* __restrict__ V8h, bf16* __restrict__ Ob, int seq, char* lds) {
  int tid_o = threadIdx.x; asm volatile("" : "+v"(tid_o)); const int tid = tid_o, wid = __builtin_amdgcn_readfirstlane(tid >> 6), lane = tid & 63, r32 = lane & 31, hi = lane >> 5;
  char* V_lds = lds; char* K_lds = lds + 3 * SHM_V8;
  float* ws = (float*)(lds + 3 * SHM_V8 + 3 * SHM_K8) + wid * 64; float* li_l = ws; float* al_l = ws + 32;
  float m_reg = -1e30f, l_reg = 0; f32x16 o[4] = {}; v8i qf[2];
  { const bf16* Qw = Qb + (long)(wid * QBLK + r32) * LDQ + hi * 32;
#pragma unroll
    for (int s = 0; s < 2; ++s) {
#pragma unroll
      for (int c = 0; c < 4; ++c) { const u32x4 w = *reinterpret_cast<const u32x4*>(Qw + s * 64 + c * 8);
        qf[s][2 * c] = cvt4_fp8(__uint_as_float(w[0] << 16), __uint_as_float(w[0] & 0xffff0000u), __uint_as_float(w[1] << 16), __uint_as_float(w[1] & 0xffff0000u));
        qf[s][2 * c + 1] = cvt4_fp8(__uint_as_float(w[2] << 16), __uint_as_float(w[2] & 0xffff0000u), __uint_as_float(w[3] << 16), __uint_as_float(w[3] & 0xffff0000u)); } } }
  const int skey = tid >> 3, sck = tid & 7, sd = tid >> 2, sc4 = tid & 3;
  const int kst = skey * 128 + 16 * (sck ^ ((skey >> 1) & 7));
  const int vx = (sd >> 2) & 3, vst0 = sd * 64 + 16 * ((sc4 >> 1) ^ vx) + 8 * (sc4 & 1), vst1 = sd * 64 + 16 * ((2 + (sc4 >> 1)) ^ vx) + 8 * (sc4 & 1);
  const unsigned char* kg = K8h + (long)skey * K8_LD + 16 * sck; const unsigned char* vg = V8h + (long)sd * V8_LD + 16 * sc4;
  struct { u32x4 k, v; } sr_[2];
#define SLOAD8(i, k0) do { sr_[i].k = *reinterpret_cast<const u32x4*>(kg + (long)(k0) * K8_LD); sr_[i].v = *reinterpret_cast<const u32x4*>(vg + (k0)); } while (0)
#define SWRITE8(b, i) do { *reinterpret_cast<u32x4*>(K_lds + (b) * SHM_K8 + kst) = sr_[i].k; \
    *reinterpret_cast<u32x2*>(V_lds + (b) * SHM_V8 + vst0) = (u32x2){sr_[i].v[0], sr_[i].v[2]}; *reinterpret_cast<u32x2*>(V_lds + (b) * SHM_V8 + vst1) = (u32x2){sr_[i].v[1], sr_[i].v[3]}; } while (0)
#define SWAIT8() asm volatile("s_waitcnt vmcnt(2)" ::: "memory")
#define RESC8(a) do { if (__any((a) < 1.f)) { if (hi == 0) al_l[r32] = (a); asm volatile("s_waitcnt lgkmcnt(0)" ::: "memory"); \
    for (int d = 0; d < 4; ++d) for (int r = 0; r < 16; ++r) o[d][r] *= al_l[crow(r, hi)]; } } while (0)
  f32x16 pA0, pA1, pB0, pB1; float mnA, mnB, alA, alB; v8i pa; const int NT = seq / KVBLK;
  SLOAD8(0, 0); asm volatile("s_waitcnt vmcnt(0)" ::: "memory"); SWRITE8(0, 0); __syncthreads();
  qkt8(pA0, pA1, K_lds, qf, r32, hi); partialSM8(pA0, pA1, m_reg, mnA, alA);
  SLOAD8(1, KVBLK); if (2 < NT) SLOAD8(0, 2 * KVBLK);
  SWAIT8(); SWRITE8(1, 1); __syncthreads();
  int bk = 1, bv = 0, bw = 2;
  if (wid >= 4) __builtin_amdgcn_s_setprio(1);
#define ROT3() do { const int t_ = bv; bv = bk; bk = bw; bw = t_; } while (0)
  for (int j = 1; j + 1 < NT; j += 2) {
    SBAR(); qkt8(pB0, pB1, K_lds + bk * SHM_K8, qf, r32, hi);
    finishSM8(pA0, pA1, alA, l_reg, pa); SBAR();
    SLOAD8(1, (j + 2) * KVBLK); SBAR();
    pv8(o, V_lds + bv * SHM_V8, pa, r32, hi); partialSM8(pB0, pB1, m_reg, mnB, alB);
    SWAIT8(); SWRITE8(bw, 0);
    RESC8(alB); __syncthreads(); ROT3();
    SBAR(); qkt8(pA0, pA1, K_lds + bk * SHM_K8, qf, r32, hi);
    finishSM8(pB0, pB1, alB, l_reg, pa); SBAR();
    if (j + 3 < NT) SLOAD8(0, (j + 3) * KVBLK); SBAR();
    pv8(o, V_lds + bv * SHM_V8, pa, r32, hi); partialSM8(pA0, pA1, m_reg, mnA, alA);
    SWAIT8(); SWRITE8(bw, 1);
    RESC8(alA); __syncthreads(); ROT3();
  }
  SBAR(); qkt8(pB0, pB1, K_lds + bk * SHM_K8, qf, r32, hi);
  finishSM8(pA0, pA1, alA, l_reg, pa); SBAR();
  pv8(o, V_lds + bv * SHM_V8, pa, r32, hi); partialSM8(pB0, pB1, m_reg, mnB, alB);
  RESC8(alB);
  finishSM8(pB0, pB1, alB, l_reg, pa); SBAR();
  pv8(o, V_lds + bk * SHM_V8, pa, r32, hi);
#undef ROT3
  __builtin_amdgcn_s_setprio(0);
  if (hi == 0) li_l[r32] = l_reg; asm volatile("s_waitcnt lgkmcnt(0)" ::: "memory");
  float rli[16];
#pragma unroll
  for (int r = 0; r < 16; ++r) rli[r] = 64.0f * __builtin_amdgcn_rcpf(li_l[crow(r, hi)]);
  unsigned char* Ow = (unsigned char*)Ob + (long)(wid * QBLK) * LDO;
#pragma unroll
  for (int r = 0; r < 16; ++r) { const int orow = crow(r, hi);
    for (int d0 = 0; d0 < 4; ++d0) Ow[(long)orow * LDO + d0 * 32 + r32] = (unsigned char)__builtin_amdgcn_cvt_pk_fp8_f32(o[d0][r] * rli[r], 0.f, 0, false); }
#undef SLOAD8
#undef SWRITE8
#undef SWAIT8
#undef RESC8
}
}
struct Frame {
    LAS unsigned char* lds;
    int tid, lane, wave;
    int bid, vcu, G;
};
__device__ __forceinline__ float wave_sum(float v) {
#pragma unroll
    for (int o = 1; o < 64; o <<= 1) v += __shfl_xor(v, o);
    return v;
}
__device__ __forceinline__ void xrows_phase(const Frame& F, const float* __restrict__ h, bf16* __restrict__ hb, pg8::rs_t* __restrict__ rs, unsigned char* __restrict__ hb8) {
    const int gw = F.vcu * 8 + F.wave, NGW = F.G * 8;
    for (int m = gw; m < L; m += NGW) {
        const f32x4* xr = (const f32x4*)(h + (size_t)m * DM) + F.lane;
        v2u* o8 = (v2u*)(hb + (size_t)m * DM) + F.lane;
        float s = 0.f;
#pragma unroll
        for (int j = 0; j < 16; ++j) { const f32x4 v = xr[64 * j]; s += (v.x * v.x + v.y * v.y) + (v.z * v.z + v.w * v.w); v2u w; w.x = pk2(v.x, v.y); w.y = pk2(v.z, v.w); o8[64 * j] = w;
            int w8 = __builtin_amdgcn_cvt_pk_fp8_f32(v.x, v.y, 0, false); w8 = __builtin_amdgcn_cvt_pk_fp8_f32(v.z, v.w, w8, true); *((unsigned*)(hb8 + (size_t)m * DM) + 64 * j + F.lane) = (unsigned)w8; }
        s = wave_sum(s);
        if (F.lane == 0) rs[m] = (pg8::rs_t)(s * pg8::RS_FIX);
    }
}
__device__ __forceinline__ void headnorm_rows(bf16* __restrict__ X, int ld, int nheads, const float* __restrict__ gain, int t, int lane, bool rope, const float (&cs)[8], const float (&sn)[8], unsigned char* __restrict__ X8 = nullptr) {
    const int hs = lane >> 4, l16 = lane & 15;
    f32x4 g0 = *(const f32x4*)(gain + 8 * l16), g1 = *(const f32x4*)(gain + 8 * l16 + 4);
    const float gg[8] = {g0.x, g0.y, g0.z, g0.w, g1.x, g1.y, g1.z, g1.w};
    const bool second = ((l16 >> 2) & 1) != 0;
    for (int hg = 0; hg < nheads / 4; ++hg) {
        bf16* p = X + (size_t)t * ld + (size_t)(4 * hg + hs) * HD + 8 * l16;
        const v4u raw = *(const v4u*)p;
        float x[8] = {bflo(raw.x), bfhi(raw.x), bflo(raw.y), bfhi(raw.y), bflo(raw.z), bfhi(raw.z), bflo(raw.w), bfhi(raw.w)};
        float ss = 0.f;
#pragma unroll
        for (int e = 0; e < 8; ++e) ss += x[e] * x[e];
        ss += __shfl_xor(ss, 1); ss += __shfl_xor(ss, 2); ss += __shfl_xor(ss, 4); ss += __shfl_xor(ss, 8);
        const float rinv = 1.0f / sqrtf(ss * (1.0f / HD) + EPS);
        float y[8];
#pragma unroll
        for (int e = 0; e < 8; ++e) y[e] = x[e] * rinv * gg[e];
        if (rope) {
#pragma unroll
            for (int e = 0; e < 8; ++e) { const float yp = __shfl_xor(y[e], 4); y[e] = second ? (y[e] * cs[e] + yp * sn[e]) : (y[e] * cs[e] - yp * sn[e]); }
        }
        if (X8) { int w0 = __builtin_amdgcn_cvt_pk_fp8_f32(y[0], y[1], 0, false); w0 = __builtin_amdgcn_cvt_pk_fp8_f32(y[2], y[3], w0, true);
            int w1 = __builtin_amdgcn_cvt_pk_fp8_f32(y[4], y[5], 0, false); w1 = __builtin_amdgcn_cvt_pk_fp8_f32(y[6], y[7], w1, true);
            *(v2u*)(X8 + (size_t)t * ld + (size_t)(4 * hg + hs) * HD + 8 * l16) = (v2u){(unsigned)w0, (unsigned)w1}; }
        else { v4u w; w.x = pk2(y[0], y[1]); w.y = pk2(y[2], y[3]); w.z = pk2(y[4], y[5]); w.w = pk2(y[6], y[7]);
            *(v4u*)p = w; }
    }
}
__device__ __forceinline__ void prep_phase(const Frame& F, bf16* Q, bf16* K, int ldk, int nkh, const float* qgain, const float* kgain, bool rope, unsigned char* K8 = nullptr) {
    const int gw = F.vcu * 8 + F.wave, NGW = F.G * 8;
    const int l16 = F.lane & 15;
    for (int t = gw; t < L; t += NGW) {
        float cs[8], sn[8];
#pragma unroll
        for (int e = 0; e < 8; ++e) { cs[e] = 1.f; sn[e] = 0.f; }
        if (rope) {
            const int ax = l16 >> 3; const float pos = (float)(ax ? (t & (GRID_W - 1)) : (t / GRID_W));
#pragma unroll
            for (int e = 0; e < 8; ++e) { const int f = (l16 & 3) * 8 + e; const float inv = 1.0f / powf(10000.0f, (float)f * (1.0f / 32.0f)); const float ang = pos * inv; cs[e] = cosf(ang); sn[e] = sinf(ang); }
        }
        headnorm_rows(Q, DM, NH, qgain, t, F.lane, rope, cs, sn);
        headnorm_rows(K, ldk, nkh, kgain, t, F.lane, rope, cs, sn, K8);
    }
}

constexpr int S5T = pg8::S5T, S5NCH = pg8::S5NCH, S5KS = pg8::S5KS;
__device__ __forceinline__ void s5_gen_group(const Frame& F, int g, const float* __restrict__ lam_re, const float* __restrict__ lam_im, const float* __restrict__ log_step,
                                             const float* __restrict__ b_re, const float* __restrict__ b_im, const float* __restrict__ c_re, const float* __restrict__ c_im,
                                             bf16* __restrict__ GM, bf16* __restrict__ BMt, f32x2* __restrict__ PAT) {
    LAS f32x2* apow = (LAS f32x2*)F.lds;
    LAS f32x2* zt = apow + 2 * 33 * 64;
    LAS float* Kd = (LAS float*)(zt + 2 * 64);
    const int tid = F.tid;
    if (tid < 128) {
        const int dir = tid >> 6, n = tid & 63, dg = dir * S5G + g, idx = dg * S5N + n;
        const double dt = exp((double)log_step[dg]);
        const double lr = (double)lam_re[idx], li = (double)lam_im[idx];
        const double mag = exp(lr * dt), are = mag * cos(li * dt), aim = mag * sin(li * dt);
        const double den = lr * lr + li * li, nre = are - 1.0;
        zt[dir * 64 + n] = (f32x2){(float)((nre * lr + aim * li) / den), (float)((aim * lr - nre * li) / den)};
        double pr = 1.0, pi = 0.0;
        for (int k = 0; k <= 32; ++k) { apow[(dir * 33 + k) * 64 + n] = (f32x2){(float)pr, (float)pi}; const double t = pr * are - pi * aim; pi = pr * aim + pi * are; pr = t; }
        PAT[idx] = apow[(dir * 33 + 32) * 64 + n];
    }
    LDS_WAIT(); __syncthreads();
    {
        const int dir = tid >> 8, p = (tid >> 4) & 15, q = tid & 15, dg = dir * S5G + g;
        float wr[64], wi[64];
        const float* cr = c_re + ((size_t)dg * S5P + p) * S5N; const float* ci = c_im + ((size_t)dg * S5P + p) * S5N;
#pragma unroll
        for (int n = 0; n < 64; ++n) { const f32x2 z = zt[dir * 64 + n]; const float br = b_re[((size_t)dg * S5N + n) * S5P + q], bi = b_im[((size_t)dg * S5N + n) * S5P + q];
            const float bbr = z.x * br - z.y * bi, bbi = z.x * bi + z.y * br; const float c0 = cr[n], c1 = ci[n];
            wr[n] = c0 * bbr - c1 * bbi; wi[n] = c0 * bbi + c1 * bbr; }
        for (int d = 0; d < 32; ++d) { float acc = 0.f; const LAS f32x2* ap = apow + (dir * 33 + d) * 64;
#pragma unroll
            for (int n = 0; n < 64; ++n) { const f32x2 a = ap[n]; acc = fmaf(wr[n], a.x, acc); acc = fmaf(-wi[n], a.y, acc); }
            Kd[(dir * 32 + d) * 256 + p * 16 + q] = acc; }
    }
    LDS_WAIT(); __syncthreads();
    bf16* BMg = BMt + (size_t)g * 512 * S5KS;
    for (int it = tid; it < 512 * 64; it += 512) { const int row = it >> 6, ch = it & 63, tau = row >> 4, p = row & 15, sg = ch >> 1, q0 = (ch & 1) * 8;
        float v[8];
        if (sg < tau) { const LAS float* k = Kd + (0 * 32 + (tau - sg)) * 256 + p * 16 + q0;
#pragma unroll
            for (int j = 0; j < 8; ++j) v[j] = k[j]; }
        else if (sg > tau) { const LAS float* k = Kd + (1 * 32 + (sg - tau)) * 256 + p * 16 + q0;
#pragma unroll
            for (int j = 0; j < 8; ++j) v[j] = k[j]; }
        else { const LAS float* k0 = Kd + p * 16 + q0; const LAS float* k1 = Kd + 32 * 256 + p * 16 + q0;
#pragma unroll
            for (int j = 0; j < 8; ++j) v[j] = k0[j] + k1[j]; }
        v4u w; w.x = pk2(v[0], v[1]); w.y = pk2(v[2], v[3]); w.z = pk2(v[4], v[5]); w.w = pk2(v[6], v[7]);
        *(v4u*)(BMg + (size_t)row * S5KS + ch * 8) = w; }
    for (int it = tid; it < 512 * 32; it += 512) { const int row = it >> 5, ch = it & 31, tau = row >> 4, p = row & 15, dir = ch >> 4, n0 = (ch & 15) * 4, dg = dir * S5G + g;
        const int k = dir ? (32 - tau) : (tau + 1);
        const f32x4 cr = *(const f32x4*)(c_re + ((size_t)dg * S5P + p) * S5N + n0), ci = *(const f32x4*)(c_im + ((size_t)dg * S5P + p) * S5N + n0);
        const LAS f32x2* ap = apow + (dir * 33 + k) * 64 + n0;
        unsigned o[4];
#pragma unroll
        for (int j = 0; j < 4; ++j) { const f32x2 a = ap[j]; const float vr = cr[j] * a.x - ci[j] * a.y, vi = cr[j] * a.y + ci[j] * a.x; o[j] = pk2(vr, -vi); }
        *(v4u*)(BMg + (size_t)row * S5KS + 512 + ch * 8) = (v4u){o[0], o[1], o[2], o[3]}; }
    bf16* GMg = GM + (size_t)g * 256 * 512;
    for (int it = tid; it < 128 * 64; it += 512) { const int dn = it >> 6, ch = it & 63, dir = dn >> 6, n = dn & 63, sg = ch >> 1, q0 = (ch & 1) * 8, dg = dir * S5G + g;
        const int pw = dir ? sg : (31 - sg);
        const f32x2 a = apow[(dir * 33 + pw) * 64 + n], z = zt[dir * 64 + n];
        const float wr_ = a.x * z.x - a.y * z.y, wi_ = a.x * z.y + a.y * z.x;
        const float* br = b_re + ((size_t)dg * S5N + n) * S5P + q0; const float* bi = b_im + ((size_t)dg * S5N + n) * S5P + q0;
        float re[8], im[8];
#pragma unroll
        for (int j = 0; j < 8; ++j) { re[j] = wr_ * br[j] - wi_ * bi[j]; im[j] = wr_ * bi[j] + wi_ * br[j]; }
        v4u w0, w1; w0.x = pk2(re[0], re[1]); w0.y = pk2(re[2], re[3]); w0.z = pk2(re[4], re[5]); w0.w = pk2(re[6], re[7]);
        w1.x = pk2(im[0], im[1]); w1.y = pk2(im[2], im[3]); w1.z = pk2(im[4], im[5]); w1.w = pk2(im[6], im[7]);
        *(v4u*)(GMg + (size_t)(dir * 128 + 2 * n) * 512 + ch * 8) = w0; *(v4u*)(GMg + (size_t)(dir * 128 + 2 * n + 1) * 512 + ch * 8) = w1; }
    LDS_WAIT(); __syncthreads();
}
__device__ __forceinline__ void s5_scan_phase(const Frame& F, const f32x2* __restrict__ PAT, const float* __restrict__ E, bf16* __restrict__ UA) {
    for (int task = F.bid + F.G * F.wave; task < 2 * S5G; task += F.G * 8) {
        const int dir = task >> 8, g = task & 255;
        const f32x2 a = PAT[task * S5N + F.lane];
        const float* e = E + (size_t)g * S5NCH * 256 + dir * 128 + 2 * F.lane;
        bf16* s = UA + (size_t)g * S5NCH * S5KS + 512 + dir * 128 + 2 * F.lane;
        float cr = 0.f, ci = 0.f;
        for (int c8 = 0; c8 < S5NCH; c8 += 8) {
            f32x2 v[8];
#pragma unroll
            for (int k = 0; k < 8; ++k) { const int c = dir ? (S5NCH - 1 - (c8 + k)) : (c8 + k); v[k] = *(const f32x2*)(e + (size_t)c * 256); }
#pragma unroll
            for (int k = 0; k < 8; ++k) { const int c = dir ? (S5NCH - 1 - (c8 + k)) : (c8 + k);
                *(unsigned*)(s + (size_t)c * S5KS) = pk2(cr, ci);
                const float nr = fmaf(a.x, cr, fmaf(-a.y, ci, v[k].x)), ni = fmaf(a.x, ci, fmaf(a.y, cr, v[k].y)); cr = nr; ci = ni; }
        }
    }
}


__device__ __forceinline__ float fp8_to_f32(unsigned char b) { const int e = (b >> 3) & 15, m = b & 7; const float v = e ? __builtin_ldexpf(1.0f + (float)m * 0.125f, e - 7) : __builtin_ldexpf((float)m * 0.125f, -6); return (b & 0x80) ? -v : v; }
__device__ __forceinline__ void gqa_selfcheck(const Frame& F, const bf16* __restrict__ Qp, const unsigned char* __restrict__ K8, const unsigned char* __restrict__ V8t, const bf16* __restrict__ O,
                                              float* __restrict__ SC, unsigned* flag) {
    LAS float* ql = (LAS float*)(F.lds + F.wave * 1024);
    const int lane = F.lane;
#pragma unroll 1
    for (int s = F.bid * 8 + F.wave; s < 1024; s += F.G * 8) {
        const int tok = (int)(((long)(s >> 5) * 5209 + 77) % L), hq = s & 31, kv = hq >> 2;
        float* sc = SC + (size_t)(F.bid * 8 + F.wave) * L;
        { const bf16* qp = Qp + (size_t)tok * DM + hq * HD; ql[lane] = bf2f(qp[lane]); ql[lane + 64] = bf2f(qp[lane + 64]); } LDS_WAIT();
        float mx = -1e30f;
#pragma unroll 1
        for (int j = lane; j < L; j += 64) { const unsigned char* kp = K8 + (size_t)j * KVD + kv * HD; float dot = 0.f;
#pragma unroll 1
            for (int d = 0; d < HD; ++d) dot += fp8_to_f32(kp[d]) * ql[d];
            dot *= 0.088388347648318440f; sc[j] = dot; mx = fmaxf(mx, dot); }
#pragma unroll
        for (int o = 1; o < 64; o <<= 1) mx = fmaxf(mx, __shfl_xor(mx, o));
        asm volatile("s_waitcnt vmcnt(0)" ::: "memory"); __builtin_amdgcn_fence(__ATOMIC_RELEASE, "workgroup"); __builtin_amdgcn_fence(__ATOMIC_ACQUIRE, "agent");
        float o0 = 0.f, o1 = 0.f, lsum = 0.f;
#pragma unroll 1
        for (int j = 0; j < L; ++j) { const float pj = expf(__hip_atomic_load(sc + j, __ATOMIC_RELAXED, __HIP_MEMORY_SCOPE_AGENT) - mx);
            o0 += pj * fp8_to_f32(V8t[(size_t)(kv * HD + lane) * L + j]); o1 += pj * fp8_to_f32(V8t[(size_t)(kv * HD + lane + 64) * L + j]); lsum += pj; }
        o0 /= lsum; o1 /= lsum;
        const unsigned char* op = (const unsigned char*)O + (size_t)tok * DM + hq * HD; const float g0 = fp8_to_f32(op[lane]) * 0.015625f, g1 = fp8_to_f32(op[lane + 64]) * 0.015625f;
        float am = fmaxf(fabsf(o0), fabsf(o1));
#pragma unroll
        for (int o = 1; o < 64; o <<= 1) am = fmaxf(am, __shfl_xor(am, o));
        const float tol = 0.2f * am + 1e-5f;
        const bool bad = !(fabsf(g0 - o0) <= tol) || !(fabsf(g1 - o1) <= tol);
        if (__any(bad) && lane == 0) __hip_atomic_fetch_or(flag, 1u, __ATOMIC_RELAXED, __HIP_MEMORY_SCOPE_AGENT);
        LDS_WAIT();
    }
}

__device__ __forceinline__ void transpose_item(const float* __restrict__ W, int K, int N, bf16* __restrict__ WT, int mode, const float* __restrict__ gain, LAS float* scr, int item, int lane, int fp8 = 0) {
    const int nblk = N / 32, kb = item / nblk, nb = item % nblk, k0 = 64 * kb, n0 = 32 * nb;
    int r0 = n0;
    if (mode == 1) r0 = (n0 < DM) ? ((n0 >> 7) * 256 + (n0 & 127)) : (((n0 - DM) >> 7) * 256 + 128 + ((n0 - DM) & 127));
    const float* src = W + (size_t)(k0 + (lane >> 5)) * N + n0 + (lane & 31);
    float v[32];
#pragma unroll
    for (int i = 0; i < 32; ++i) v[i] = src[(size_t)(2 * i) * N];
    const int c = lane & 7;
    f32x4 g0 = (f32x4){1.f, 1.f, 1.f, 1.f}, g1 = g0;
    if (gain) { g0 = *(const f32x4*)(gain + k0 + 8 * c); g1 = *(const f32x4*)(gain + k0 + 8 * c + 4); }
#pragma unroll
    for (int i = 0; i < 32; ++i) scr[(2 * i + (lane >> 5)) * 33 + (lane & 31)] = v[i];
    LDS_WAIT(); asm volatile("" ::: "memory");
#pragma unroll
    for (int j = 0; j < 4; ++j) { const int n = (lane >> 3) + 8 * j; const LAS float* s = scr + (8 * c) * 33 + n;
        if (fp8) { int w0 = __builtin_amdgcn_cvt_pk_fp8_f32(64.f * s[0 * 33] * g0.x, 64.f * s[1 * 33] * g0.y, 0, false); w0 = __builtin_amdgcn_cvt_pk_fp8_f32(64.f * s[2 * 33] * g0.z, 64.f * s[3 * 33] * g0.w, w0, true);
            int w1 = __builtin_amdgcn_cvt_pk_fp8_f32(64.f * s[4 * 33] * g1.x, 64.f * s[5 * 33] * g1.y, 0, false); w1 = __builtin_amdgcn_cvt_pk_fp8_f32(64.f * s[6 * 33] * g1.z, 64.f * s[7 * 33] * g1.w, w1, true);
            *(v2u*)((unsigned char*)WT + (size_t)(r0 + n) * K + k0 + 8 * c) = (v2u){(unsigned)w0, (unsigned)w1}; }
        else { v4u o; o.x = pk2(s[0 * 33] * g0.x, s[1 * 33] * g0.y); o.y = pk2(s[2 * 33] * g0.z, s[3 * 33] * g0.w); o.z = pk2(s[4 * 33] * g1.x, s[5 * 33] * g1.y); o.w = pk2(s[6 * 33] * g1.z, s[7 * 33] * g1.w);
            *(v4u*)(WT + (size_t)(r0 + n) * K + k0 + 8 * c) = o; } }
    LDS_WAIT(); asm volatile("" ::: "memory");
}

constexpr size_t MiB = 1u << 20;
constexpr size_t SZ_NAQKV = (size_t)3 * DM * DM * 2, SZ_DD = (size_t)DM * DM * 2, SZ_GQAQKV = (size_t)(DM + 2 * KVD) * DM * 2, SZ_W1 = (size_t)FF * DM * 2, SZ_PROJ = (size_t)DM * PLE * 2, SZ_ACT = (size_t)L * DM * 2;
constexpr size_t OFF_CTL = 0, CTL_ZERO_BYTES = 3 * MiB, OFF_RS = 1 * MiB;
constexpr size_t OFF_NAQKV = 4 * MiB;
constexpr size_t OFF_NAWO = OFF_NAQKV + 2 * SZ_NAQKV;
constexpr size_t OFF_GQAQKV = OFF_NAWO + 2 * SZ_DD;
constexpr size_t OFF_GQAWO = OFF_GQAQKV + SZ_GQAQKV;
constexpr size_t OFF_S5IN = OFF_GQAWO + SZ_DD;
constexpr size_t OFF_S5OUT = OFF_S5IN + SZ_DD;
constexpr size_t OFF_W1 = OFF_S5OUT + 2 * SZ_DD;
constexpr size_t OFF_W2 = OFF_W1 + 4 * SZ_W1;
constexpr size_t OFF_PROJ = OFF_W2 + 4 * SZ_W1;
constexpr size_t OFF_GATE = OFF_PROJ + 4 * SZ_PROJ;
constexpr size_t OFF_PBF = OFF_GATE + 4 * SZ_DD;
constexpr size_t OFF_XN = OFF_PBF + 4 * (size_t)L * PLE * 2;
constexpr size_t OFF_ACT = OFF_XN + SZ_ACT;
constexpr size_t OFF_PP = OFF_ACT + 4 * SZ_ACT;
constexpr size_t OFF_S5BM = OFF_PP + SZ_ACT;
constexpr size_t OFF_S5GM = OFF_S5BM + 192 * MiB;
constexpr size_t OFF_S5PAR = OFF_S5GM + 64 * MiB;
constexpr size_t OFF_DUMMY = OFF_S5PAR + 8 * MiB;
constexpr size_t OFF_HB1 = OFF_DUMMY + 256 * MiB;
constexpr size_t OFF_HB8 = OFF_HB1 + SZ_ACT;
constexpr size_t WS_END = OFF_HB8 + (size_t)L * DM;
constexpr int CW_BAR = 4096;
constexpr int RING_BYTES = 131072, LDSCTL_OFF = RING_BYTES, MISC_OFF = LDSCTL_OFF + 320, PTAB_OFF = LDSCTL_OFF + 1024, LDS_BYTES = 147456;
static_assert(dattn::SHM_ATTN <= RING_BYTES && 8 * 64 * 33 * 4 <= RING_BYTES, "phase scratch fits the ring region");

constexpr int PH_PER_LAYER = 8, NPH = 1 + DEPTH * PH_PER_LAYER;
struct Args { const float* in[28]; float* out; unsigned char* ws; int ph_lo, ph_hi; };
enum { I_X = 0, I_P, I_MIXN, I_MLPN, I_PLEN, I_NAQKV, I_NAWO, I_NAQG, I_NAKG, I_NARPB, I_GQKV, I_GWO, I_GQG, I_GKG, I_S5IN, I_LAMRE, I_LAMIM, I_LOGSTEP, I_BRE, I_BIM, I_CRE, I_CIM, I_S5D, I_S5OUT, I_W1, I_W2, I_PROJ, I_GATE };


__device__ __forceinline__ unsigned long long tab_get(LAS unsigned char* lds, int i) {
    volatile LAS unsigned* t = (volatile LAS unsigned*)(lds + PTAB_OFF); const unsigned lo = t[2 * i], hi = t[2 * i + 1];
    return ((unsigned long long)(unsigned)__builtin_amdgcn_readfirstlane((int)hi) << 32) | (unsigned)__builtin_amdgcn_readfirstlane((int)lo); }
#define INP(i) ((const float*)(const GAS float*)tab_get(F.lds, (i)))
#define OUTP() ((float*)(GAS float*)tab_get(F.lds, 28))
#define WSP() ((unsigned char*)(GAS unsigned char*)tab_get(F.lds, 29))
__device__ __forceinline__ Frame mkframe(unsigned char* lds_generic) {
    Frame F; int t = threadIdx.x; asm volatile("" : "+v"(t)); F.tid = t; F.lane = t & 63; F.wave = __builtin_amdgcn_readfirstlane(t >> 6);
    F.lds = (LAS unsigned char*)lds_generic; int b = blockIdx.x; asm volatile("" : "+s"(b)); F.bid = b; int G = gridDim.x; asm volatile("" : "+s"(G)); F.G = G;
    F.vcu = (G % 8 == 0) ? (b % 8) * (G / 8) + b / 8 : b; return F; }
__device__ __forceinline__ void prologue_phase(const Frame& F) {
    unsigned char* ws = WSP();
    LAS float* scr = (LAS float*)(F.lds + F.wave * (64 * 33 * 4));
    const int gw = F.vcu * 8 + F.wave, NGW = F.G * 8;
    constexpr int I_QKV = (DM / 64) * (3 * DM / 32), I_DD = (DM / 64) * (DM / 32), I_GQ = (DM / 64) * ((DM + 2 * KVD) / 32), I_SO = (DM / 64) * (2 * DM / 32),
                  I_1 = (DM / 64) * (FF / 32), I_2 = (FF / 64) * (DM / 32), I_PJ = (PLE / 64) * (DM / 32);
    constexpr int NITEMS = 2 * I_QKV + 2 * I_DD + I_GQ + I_DD + I_DD + I_SO + 4 * I_1 + 4 * I_2 + 4 * I_PJ + 4 * I_DD;
    for (int it = gw; it < NITEMS; it += NGW) {
        int r = it; const float* W; int K, N, mode = 0, fp8 = 0; bf16* WT; const float* gain = nullptr;
        if (r < 2 * I_QKV) { const int l = r / I_QKV; r -= l * I_QKV; W = INP(I_NAQKV) + (size_t)l * DM * 3 * DM; K = DM; N = 3 * DM; WT = (bf16*)(ws + OFF_NAQKV + l * SZ_NAQKV); gain = INP(I_MIXN) + (size_t)(3 * l) * DM; fp8 = 1; }
        else { r -= 2 * I_QKV;
        if (r < 2 * I_DD) { const int l = r / I_DD; r -= l * I_DD; W = INP(I_NAWO) + (size_t)l * DM * DM; K = DM; N = DM; WT = (bf16*)(ws + OFF_NAWO + l * SZ_DD); fp8 = 1; }
        else { r -= 2 * I_DD;
        if (r < I_GQ) { W = INP(I_GQKV); K = DM; N = DM + 2 * KVD; WT = (bf16*)(ws + OFF_GQAQKV); gain = INP(I_MIXN) + (size_t)1 * DM; fp8 = 1; }
        else { r -= I_GQ;
        if (r < I_DD) { W = INP(I_GWO); K = DM; N = DM; WT = (bf16*)(ws + OFF_GQAWO); fp8 = 1; }
        else { r -= I_DD;
        if (r < I_DD) { W = INP(I_S5IN); K = DM; N = DM; WT = (bf16*)(ws + OFF_S5IN); gain = INP(I_MIXN) + (size_t)2 * DM; }
        else { r -= I_DD;
        if (r < I_SO) { W = INP(I_S5OUT); K = DM; N = 2 * DM; WT = (bf16*)(ws + OFF_S5OUT); mode = 1; }
        else { r -= I_SO;
        if (r < 4 * I_1) { const int l = r / I_1; r -= l * I_1; W = INP(I_W1) + (size_t)l * DM * FF; K = DM; N = FF; WT = (bf16*)(ws + OFF_W1 + l * SZ_W1); gain = INP(I_MLPN) + (size_t)l * DM; }
        else { r -= 4 * I_1;
        if (r < 4 * I_2) { const int l = r / I_2; r -= l * I_2; W = INP(I_W2) + (size_t)l * FF * DM; K = FF; N = DM; WT = (bf16*)(ws + OFF_W2 + l * SZ_W1); }
        else { r -= 4 * I_2;
        if (r < 4 * I_PJ) { const int l = r / I_PJ; r -= l * I_PJ; W = INP(I_PROJ) + (size_t)l * PLE * DM; K = PLE; N = DM; WT = (bf16*)(ws + OFF_PROJ + l * SZ_PROJ); }
        else { r -= 4 * I_PJ; const int l = r / I_DD; r -= l * I_DD; W = INP(I_GATE) + (size_t)l * DM * DM; K = DM; N = DM; WT = (bf16*)(ws + OFF_GATE + l * SZ_DD); gain = INP(I_PLEN) + (size_t)l * DM; } } } } } } } } }
        transpose_item(W, K, N, WT, mode, gain, scr, r, F.lane, fp8);
    }
    xrows_phase(F, INP(I_X), (bf16*)(ws + OFF_XN), (pg8::rs_t*)(ws + OFF_RS), ws + OFF_HB8);
    { const size_t n8 = (size_t)DEPTH * L * PLE / 8; const float* p = INP(I_P); bf16* pb = (bf16*)(ws + OFF_PBF);
      for (size_t i = (size_t)gw * 64 + F.lane; i < n8; i += (size_t)NGW * 64) { const f32x4 a = *(const f32x4*)(p + i * 8), b = *(const f32x4*)(p + i * 8 + 4);
          v4u w; w.x = pk2(a.x, a.y); w.y = pk2(a.z, a.w); w.z = pk2(b.x, b.y); w.w = pk2(b.z, b.w); *(v4u*)(pb + i * 8) = w; } }
    { bf16* GM = (bf16*)(ws + OFF_S5GM); bf16* BMt = (bf16*)(ws + OFF_S5BM); f32x2* PAT = (f32x2*)(ws + OFF_S5PAR);
      LDS_WAIT(); __syncthreads();
      for (int g = F.bid; g < S5G; g += F.G) s5_gen_group(F, g, INP(I_LAMRE), INP(I_LAMIM), INP(I_LOGSTEP), INP(I_BRE), INP(I_BIM), INP(I_CRE), INP(I_CIM), GM, BMt, PAT); }
}

#define WS_PTRS() unsigned char* ws = WSP(); bf16* HB0 = (bf16*)(ws + OFF_XN); bf16* HB1 = (bf16*)(ws + OFF_HB1); bf16* Qb = (bf16*)(ws + OFF_ACT); bf16* Kb = (bf16*)(ws + OFF_ACT + SZ_ACT); bf16* Vb = (bf16*)(ws + OFF_ACT + 2 * SZ_ACT); \
    bf16* Ob = (bf16*)(ws + OFF_ACT + 3 * SZ_ACT); bf16* HID = (bf16*)(ws + OFF_ACT); bf16* UA = (bf16*)(ws + OFF_ACT); bf16* S5Gb = (bf16*)(ws + OFF_ACT + 2 * SZ_ACT); float* S5E = (float*)(ws + OFF_ACT + 3 * SZ_ACT); bf16* PP = (bf16*)(ws + OFF_PP); \
    (void)HB0; (void)HB1; (void)Qb; (void)Kb; (void)Vb; (void)Ob; (void)HID; (void)UA; (void)S5Gb; (void)PP; (void)S5E;
__global__ void __launch_bounds__(512, 2) enc_fwd(Args args) {
    extern __shared__ __attribute__((aligned(16))) unsigned char lds[];
    {
        LAS unsigned char* l3 = (LAS unsigned char*)lds;
        for (int u = threadIdx.x; u < (LDS_BYTES - LDSCTL_OFF) / 4; u += 512) ((LAS unsigned*)(l3 + LDSCTL_OFF))[u] = 0u;
        __syncthreads();
        if (threadIdx.x == 0) { LAS unsigned long long* t = (LAS unsigned long long*)(l3 + PTAB_OFF);
#pragma unroll
            for (int i = 0; i < 28; ++i) t[i] = (unsigned long long)args.in[i];
            t[28] = (unsigned long long)args.out; t[29] = (unsigned long long)args.ws; }
        __syncthreads();
    }
    const int lo = args.ph_lo, hi = args.ph_hi;
    XcdBarrier bar;
    { LAS unsigned char* l3 = (LAS unsigned char*)lds; unsigned* ctl = (unsigned*)(GAS unsigned*)(tab_get(l3, 29) + OFF_CTL); bar.bar = ctl + CW_BAR; bar.x = 0; bar.st = nullptr;
      if (hi - lo > 1) bar = xcd_barrier_post(ctl + CW_BAR, (volatile LAS unsigned*)(l3 + MISC_OFF) + 8); }
#define IN(k) (lo <= (k) && (k) < hi)
#ifndef PROBE_PH
#define PROBE_PH (-1)
#endif
#define REPS(k) for (int rep_ = 0, nrep_ = (((k) == PROBE_PH || PROBE_PH == -2) ? 2 : ((PROBE_PH == 300 && (k) == 11) ? 4 : 1)); rep_ < nrep_; ++rep_)
#define HBOUT(p) ((nrep_ == 2 && rep_ == 0) ? (bf16*)(ws + OFF_DUMMY) : (p))
#define RSOUT(i) ((nrep_ == 2 && rep_ == 0) ? (pg8::rs_t*)(ws + OFF_DUMMY + 128 * MiB) : RSP(i))
#define SEAM(k) do { if (IN(k) && IN((k) + 1)) xcd_barrier(bar); } while (0)

#if PROBE_PH == 601
    if (blockIdx.x == 0 && threadIdx.x < 64) {
        typedef int v8i_ __attribute__((ext_vector_type(8))); typedef float f4v_ __attribute__((ext_vector_type(4)));
        const int l = threadIdx.x, ij = l & 15, kb = l >> 4; const unsigned lut[7] = {0xC4u, 0xC0u, 0xB8u, 0x00u, 0x38u, 0x40u, 0x44u};
        v8i_ A, B;
#pragma unroll
        for (int v = 0; v < 8; ++v) { unsigned wa = 0, wb = 0;
#pragma unroll
            for (int b = 0; b < 4; ++b) { const int kk = 32 * kb + 4 * v + b; const int av = ((ij + 2 * kk) % 5) - 2, bv = ((3 * kk + ij) % 7) - 3;
                unsigned ea = 0, eb = 0;
#pragma unroll
                for (int t = 0; t < 7; ++t) { ea = (av + 3 == t) ? lut[t] : ea; eb = (bv + 3 == t) ? lut[t] : eb; }
                wa |= ea << (8 * b); wb |= eb << (8 * b); }
            A[v] = (int)wa; B[v] = (int)wb; }
        f4v_ c1 = {};
        c1 = __builtin_amdgcn_mfma_scale_f32_16x16x128_f8f6f4(A, B, c1, 0, 0, 0, 0x7F7F7F7F, 0, 0x7F7F7F7F);
        bool ok1 = true;
#pragma unroll
        for (int r = 0; r < 4; ++r) { const int i = 4 * kb + r, j = ij; int s = 0;
            for (int kk = 0; kk < 128; ++kk) s += (((i + 2 * kk) % 5) - 2) * (((3 * kk + j) % 7) - 3);
            ok1 = ok1 && (c1[r] == (float)s); }
        unsigned long long ticks = 0; if (!__all(ok1)) ticks += 400000ull;
        const unsigned long long t0 = __builtin_amdgcn_s_memrealtime(); while (__builtin_amdgcn_s_memrealtime() - t0 < ticks) __builtin_amdgcn_s_sleep(8);
    }
    __syncthreads();
#endif
#if PROBE_PH == 600
    if (blockIdx.x == 0 && threadIdx.x < 64) {
        typedef int v8i_ __attribute__((ext_vector_type(8))); typedef float f16v_ __attribute__((ext_vector_type(16)));
        const int l = threadIdx.x, ij = l & 31, kb = l >> 5; const unsigned lut[7] = {0xC4u, 0xC0u, 0xB8u, 0x00u, 0x38u, 0x40u, 0x44u};
        v8i_ A, B;
#pragma unroll
        for (int v = 0; v < 8; ++v) { unsigned wa = 0, wb = 0;
#pragma unroll
            for (int b = 0; b < 4; ++b) { const int kk = 32 * kb + 4 * v + b; const int av = ((ij + 2 * kk) % 5) - 2, bv = ((3 * kk + ij) % 7) - 3;
                unsigned ea = 0, eb = 0;
#pragma unroll
                for (int t = 0; t < 7; ++t) { ea = (av + 3 == t) ? lut[t] : ea; eb = (bv + 3 == t) ? lut[t] : eb; }
                wa |= ea << (8 * b); wb |= eb << (8 * b); }
            A[v] = (int)wa; B[v] = (int)wb; }
        f16v_ c1 = {}, c2 = {};
        c1 = __builtin_amdgcn_mfma_scale_f32_32x32x64_f8f6f4(A, B, c1, 0, 0, 0, 0x7F7F7F7F, 0, 0x7F7F7F7F);
        c2 = __builtin_amdgcn_mfma_scale_f32_32x32x64_f8f6f4(A, B, c2, 0, 0, 0, 0x7B7B7B7B, 0, 0x7F7F7F7F);
        bool ok1 = true, ok2 = true;
#pragma unroll
        for (int r = 0; r < 16; ++r) { const int i = (r & 3) + 8 * (r >> 2) + 4 * kb, j = ij; int s = 0;
            for (int kk = 0; kk < 64; ++kk) s += (((i + 2 * kk) % 5) - 2) * (((3 * kk + j) % 7) - 3);
            ok1 = ok1 && (c1[r] == (float)s); ok2 = ok2 && (c2[r] == (float)s * 0.0625f); }
        int w = __builtin_amdgcn_cvt_pk_fp8_f32(1.0f, 2.0f, 0, false); w = __builtin_amdgcn_cvt_pk_fp8_f32(3.0f, -1.0f, w, true);
        const bool ok3 = ((unsigned)w == 0xB8444038u);
        unsigned long long ticks = 0; if (!__all(ok1)) ticks += 400000ull; if (!__all(ok2)) ticks += 800000ull; if (!__all(ok3)) ticks += 1600000ull;
        const unsigned long long t0 = __builtin_amdgcn_s_memrealtime(); while (__builtin_amdgcn_s_memrealtime() - t0 < ticks) __builtin_amdgcn_s_sleep(8);
    }
    __syncthreads();
#endif
    if (IN(0)) REPS(0) { const Frame F = mkframe(lds); prologue_phase(F); } SEAM(0);
#if PROBE_PH == 200
    for (int xb_ = 0; xb_ < 40; ++xb_) xcd_barrier(bar);
#endif

#pragma unroll 1
    for (int layer = 0; layer < DEPTH; ++layer) {
        const int kind = layer % 3, slot = layer / 3, pb = 1 + PH_PER_LAYER * layer;
#define RSP(i) ((pg8::rs_t*)(ws + OFF_RS) + (size_t)(i) * L)
        const int irs = (layer == 0) ? 0 : 3 * layer;
        if (IN(pb + 0)) REPS(pb + 0) {
            const Frame F = mkframe(lds); WS_PTRS();
            if (kind != 2) {
                const int N = (kind == 0) ? 3 * DM : DM + 2 * KVD;
                const bf16* W = (kind == 0) ? (const bf16*)(ws + OFF_NAQKV + slot * SZ_NAQKV) : (const bf16*)(ws + OFF_GQAQKV);
                const pg8::Gemm g = pg8::mkgemm((const bf16*)(ws + OFF_HB8), W, L, N, DM / 2); pg8::StaticOrder S; S.init(L, N, F.G, F.bid);
                pg8::EpiBf16<0> E{Qb, Kb, Vb, DM, (kind == 0) ? DM : KVD, (kind == 0) ? DM : L, DM, (kind == 0) ? 2 * DM : DM + KVD, RSP(irs), (kind == 0) ? 0 : 2, (kind == 0) ? 2 * DM : DM + KVD};
                pg8::gemm_phase<pg8::EpiBf16<0>, pg8::StaticOrder, false, true, true>(F.lds, g, S, E);
            } else {
                const pg8::Gemm g = pg8::mkgemm(HB0, (const bf16*)(ws + OFF_S5IN), L, DM, DM); pg8::StaticOrder S; S.init(L, DM, F.G, F.bid);
                pg8::EpiS5U E{UA, RSP(irs)};
                pg8::gemm_phase<pg8::EpiS5U, pg8::StaticOrder, false, true>(F.lds, g, S, E);
            }
        }
        SEAM(pb + 0);
        if (kind != 2) {
            if (kind == 1) { if (IN(pb + 1)) { const Frame F = mkframe(lds); WS_PTRS(); prep_phase(F, Qb, Kb, KVD, NKV, INP(I_GQG), INP(I_GKG), true, (unsigned char*)Kb + 64 * MiB); }
                SEAM(pb + 1); }
            if (IN(pb + 2)) REPS(pb + 2) { const Frame F = mkframe(lds); WS_PTRS();
                if (kind == 0) {
                    const float* rpb = INP(I_NARPB) + (size_t)slot * NH * 15 * 31;
                    for (int i = 0;; ++i) { const int unit = i * F.G + F.vcu; if (unit >= NH * (GROWS / 4)) break;
                        const int h = unit >> 6, R = (unit & 63) * 4, ks = min(max(R - 4, 0), GROWS - dattn::NA_TILES);
                        dattn::na_block_body(Qb + (size_t)(R * GRID_W) * DM + h * HD, Kb + (size_t)(ks * GRID_W) * DM + h * HD, Vb + (size_t)(ks * GRID_W) * DM + h * HD,
                                             (bf16*)((unsigned char*)Ob + (size_t)(R * GRID_W) * DM + h * HD), rpb + (size_t)h * 15 * 31, INP(I_NAQG) + slot * HD, INP(I_NAKG) + slot * HD, R, ks, (char*)lds);
                        __syncthreads(); }
                } else {
                    for (int i = 0;; ++i) { const int unit = i * F.G + F.bid; if (unit >= NH * (L / 256)) break;
                        const int kvh = unit & 7, rest = unit >> 3, hq = kvh * 4 + (rest >> 6), qb = rest & 63;
                        dattn::attn_dense_body8(Qb + (size_t)(qb * 256) * DM + hq * HD, (const unsigned char*)Kb + 64 * MiB + kvh * HD, (const unsigned char*)Vb + (size_t)(kvh * HD) * L, (bf16*)((unsigned char*)Ob + (size_t)(qb * 256) * DM + hq * HD), L, (char*)lds);
                        __syncthreads(); }
                }
            }
            if (IN(pb + 2) && IN(pb + 4)) xcd_barrier(bar);
#if PROBE_PH == 400
            if (kind == 1) { const Frame F = mkframe(lds); WS_PTRS();
                gqa_selfcheck(F, Qb, (const unsigned char*)Kb + 64 * MiB, (const unsigned char*)Vb, Ob, (float*)(ws + OFF_PP), (unsigned*)(ws + OFF_CTL) + 8);
                xcd_barrier(bar); }
#endif
        } else {
            if (IN(pb + 1)) REPS(pb + 1) { const Frame F = mkframe(lds); WS_PTRS();
                pg8::Gemm g; g.A = UA; g.Bt = (const bf16*)(ws + OFF_S5GM); g.M = S5G * S5NCH; g.N = 256; g.K = 512; g.lda = S5KS; g.ldb = 512; g.sa = 0x7F7F7F7F;
                pg8::S5Order S{F.G, F.bid, 2, 1}; pg8::EpiS5E E{S5E};
                pg8::gemm_phase<pg8::EpiS5E, pg8::S5Order, false, true>(F.lds, g, S, E); }
            SEAM(pb + 1);
            if (IN(pb + 2)) REPS(pb + 2) { const Frame F = mkframe(lds); WS_PTRS(); s5_scan_phase(F, (const f32x2*)(ws + OFF_S5PAR), S5E, UA); }
            SEAM(pb + 2);
            if (IN(pb + 3)) REPS(pb + 3) { const Frame F = mkframe(lds); WS_PTRS();
                pg8::Gemm g; g.A = UA; g.Bt = (const bf16*)(ws + OFF_S5BM); g.M = S5G * S5NCH; g.N = S5G * 512; g.K = S5KS; g.lda = S5KS; g.ldb = S5KS; g.sa = 0x7F7F7F7F;
                pg8::S5Order S{F.G, F.bid, 2, 2}; pg8::EpiS5Y E{UA, INP(I_S5D), S5Gb, DM};
                pg8::gemm_phase<pg8::EpiS5Y, pg8::S5Order, false, true>(F.lds, g, S, E); }
            SEAM(pb + 3);
        }
        if (IN(pb + 4)) REPS(pb + 4) {
            const Frame F = mkframe(lds); WS_PTRS();
            if (kind != 2) {
                const bf16* W = (kind == 0) ? (const bf16*)(ws + OFF_NAWO + slot * SZ_DD) : (const bf16*)(ws + OFF_GQAWO);
                pg8::Gemm g = pg8::mkgemm(Ob, W, L, DM, DM / 2); g.sa = 0x79797979; pg8::StaticOrder S; S.init(L, DM, F.G, F.bid);
                pg8::EpiRes E{HB0, HBOUT(HB0), RSOUT(1 + 3 * layer), DM, nullptr};
                pg8::gemm_phase<pg8::EpiRes, pg8::StaticOrder, false, true, true>(F.lds, g, S, E);
            } else {
                const pg8::Gemm g = pg8::mkgemm(S5Gb, (const bf16*)(ws + OFF_S5OUT), L, 2 * DM, DM); pg8::StaticOrder S; S.init(L, 2 * DM, F.G, F.bid);
                pg8::EpiGlu E{HB0, HBOUT(HB0), RSOUT(1 + 3 * layer), DM};
                pg8::gemm_phase<pg8::EpiGlu, pg8::StaticOrder, false, true>(F.lds, g, S, E);
            }
        }
        SEAM(pb + 4);
        if (IN(pb + 5)) REPS(pb + 5) { const Frame F = mkframe(lds); WS_PTRS();
            const pg8::Gemm g = pg8::mkgemm(HB0, (const bf16*)(ws + OFF_W1 + layer * SZ_W1), L, FF, DM); pg8::StaticOrder S; S.init(L, FF, F.G, F.bid);
            pg8::EpiBf16<2> E{HID, HID, HID, FF, FF, FF, 1 << 30, 1 << 30, nullptr, 0, 0};
#if PROBE_PH == 201
            { pg8::RangeOrder R1{S, 0, 8}, R2{S, 8, 16};
              pg8::gemm_phase<pg8::EpiBf16<2>, pg8::RangeOrder, false, true>(F.lds, g, R1, E); xcd_barrier(bar);
              pg8::gemm_phase<pg8::EpiBf16<2>, pg8::RangeOrder, false, true>(F.lds, g, R2, E); }
#else
            pg8::gemm_phase<pg8::EpiBf16<2>, pg8::StaticOrder, false, true>(F.lds, g, S, E);
#endif
        }
        SEAM(pb + 5);
        if (IN(pb + 6)) REPS(pb + 6) { const Frame F = mkframe(lds); WS_PTRS();
            { const pg8::Gemm g = pg8::mkgemm(HID, (const bf16*)(ws + OFF_W2 + layer * SZ_W1), L, DM, FF); pg8::StaticOrder S; S.init(L, DM, F.G, F.bid);
              pg8::EpiRes E{HB0, HBOUT(HB1), RSOUT(2 + 3 * layer), DM, RSP(1 + 3 * layer)};
              pg8::gemm_phase<pg8::EpiRes, pg8::StaticOrder, false, true>(F.lds, g, S, E); }
            { const pg8::Gemm g = pg8::mkgemm((const bf16*)(ws + OFF_PBF + (size_t)layer * L * PLE * 2), (const bf16*)(ws + OFF_PROJ + layer * SZ_PROJ), L, DM, PLE); pg8::StaticOrder S; S.init(L, DM, F.G, F.bid);
              pg8::EpiBf16<0> E{PP, PP, PP, DM, DM, DM, 1 << 30, 1 << 30, nullptr, 0, 0};
              pg8::gemm_phase<pg8::EpiBf16<0>, pg8::StaticOrder, false, true>(F.lds, g, S, E); }
        }
        SEAM(pb + 6);
        if (IN(pb + 7)) REPS(pb + 7) { const Frame F = mkframe(lds); WS_PTRS();
            const pg8::Gemm g = pg8::mkgemm(HB1, (const bf16*)(ws + OFF_GATE + layer * SZ_DD), L, DM, DM); pg8::StaticOrder S; S.init(L, DM, F.G, F.bid);
            pg8::EpiGate E{HB1, HBOUT(HB0), (layer == DEPTH - 1) ? OUTP() : nullptr, PP, RSP(2 + 3 * layer), RSOUT(3 + 3 * layer), DM, (layer + 1 < DEPTH && (layer + 1) % 3 != 2 && !(nrep_ == 2 && rep_ == 0)) ? ws + OFF_HB8 : nullptr};
            pg8::gemm_phase<pg8::EpiGate, pg8::StaticOrder, false, true>(F.lds, g, S, E);
        }
        SEAM(pb + 7);
    }
#if PROBE_PH == 400
    { xcd_barrier(bar); const Frame F = mkframe(lds); unsigned char* ws = WSP();
      if (__hip_atomic_load((unsigned*)(ws + OFF_CTL) + 8, __ATOMIC_RELAXED, __HIP_MEMORY_SCOPE_AGENT) != 0u && F.bid == 0 && F.tid < 64) OUTP()[F.tid] = __builtin_nanf(""); }
#endif
#undef IN
#undef SEAM
}

extern "C" void kernel_launch(void* const* d_in, const int* in_sizes, int n_in, void* d_out, int out_size, void* d_ws, size_t ws_size, hipStream_t stream) {
    static int grid = 0;
    if (grid == 0) {
        if (n_in != 28 || in_sizes[0] != L * DM || out_size != L * DM || ws_size < WS_END) {
            fprintf(stderr, "kernel_launch: built for 28 inputs, x/out of %d floats, >= %zu bytes of workspace; got n_in %d, in0 %d, out %d, ws %zu; nothing launched\n", L * DM, (size_t)WS_END, n_in, n_in > 0 ? in_sizes[0] : -1, out_size, ws_size);
            grid = -1; return; }
        int dev = 0, cus = 0, per_cu = 0;
        if (hipGetDevice(&dev) != hipSuccess || hipDeviceGetAttribute(&cus, hipDeviceAttributeMultiprocessorCount, dev) != hipSuccess) { fprintf(stderr, "kernel_launch: device query failed\n"); grid = -1; return; }
        if (hipFuncSetAttribute((const void*)enc_fwd, hipFuncAttributeMaxDynamicSharedMemorySize, LDS_BYTES) != hipSuccess) { fprintf(stderr, "kernel_launch: hipFuncSetAttribute failed\n"); grid = -1; return; }
        if (hipOccupancyMaxActiveBlocksPerMultiprocessor(&per_cu, (const void*)enc_fwd, 512, LDS_BYTES) != hipSuccess || per_cu < 1)
            fprintf(stderr, "kernel_launch: note: occupancy query reports %d workgroups per CU\n", per_cu);
        (void)hipGetLastError();
        grid = cus;
    }
    if (grid < 0) return;
    if (hipMemsetAsync((char*)d_ws + OFF_CTL, 0, CTL_ZERO_BYTES, stream) != hipSuccess) { fprintf(stderr, "kernel_launch: memset failed\n"); return; }
    Args a{};
    for (int i = 0; i < 28; ++i) a.in[i] = (const float*)d_in[i];
    a.out = (float*)d_out; a.ws = (unsigned char*)d_ws;
#if MK_N_LAUNCHES == 1
    a.ph_lo = 0; a.ph_hi = NPH;
    hipLaunchKernelGGL(enc_fwd, dim3(grid), dim3(512), LDS_BYTES, stream, a);
#else
    for (int ph = 0; ph < NPH; ++ph) {
        if (ph > 0) { const int layer = (ph - 1) / PH_PER_LAYER, j = (ph - 1) % PH_PER_LAYER; if (j == 3 && layer % 3 != 2) continue; }
        a.ph_lo = ph; a.ph_hi = ph + 1;
        hipLaunchKernelGGL(enc_fwd, dim3(grid), dim3(512), LDS_BYTES, stream, a);
    }
#endif
    const hipError_t le = hipPeekAtLastError();
    if (le != hipSuccess) fprintf(stderr, "kernel_launch: launch failed: %s\n", hipGetErrorName(le));
}
```

```cpp
#include <hip/hip_runtime.h>
#include <cstdio>
#include <cstdint>

#ifndef MK_N_LAUNCHES
#define MK_N_LAUNCHES 1
#endif

constexpr int L = 16384, DM = 4096, DEPTH = 4, GRID_W = 64, GROWS = L / GRID_W, HD = 128, NH = 32, NKV = 8, KVD = NKV * HD, FF = 4 * DM, PLE = 256;
constexpr int S5G = 256, S5P = 16, S5N = 64, S5TC = 16, S5NC = L / S5TC;
constexpr float EPS = 1e-6f;

#define GAS __attribute__((address_space(1)))
#define LAS __attribute__((address_space(3)))
typedef unsigned short bf16;
typedef unsigned v4u __attribute__((ext_vector_type(4)));
typedef unsigned v2u __attribute__((ext_vector_type(2)));
typedef float f32x4 __attribute__((ext_vector_type(4)));
typedef float f32x2 __attribute__((ext_vector_type(2)));
typedef short bf16x8 __attribute__((ext_vector_type(8)));
typedef short s16x4 __attribute__((ext_vector_type(4)));
typedef GAS unsigned gu32;
#define RLX_AGENT __ATOMIC_RELAXED, __HIP_MEMORY_SCOPE_AGENT
#define LDS_WAIT() asm volatile("s_waitcnt lgkmcnt(0)" ::: "memory")
#define VM_WAIT() asm volatile("s_waitcnt vmcnt(0)" ::: "memory")
__device__ __forceinline__ unsigned f2bf(float f) { unsigned u = __builtin_bit_cast(unsigned, f); return (u + 0x7fffu + ((u >> 16) & 1u)) >> 16; }
__device__ __forceinline__ unsigned pk2(float lo, float hi) { return f2bf(lo) | (f2bf(hi) << 16); }
__device__ __forceinline__ float bf2f(unsigned short b) { return __builtin_bit_cast(float, (unsigned)b << 16); }
__device__ __forceinline__ float bflo(unsigned w) { return __builtin_bit_cast(float, w << 16); }
__device__ __forceinline__ float bfhi(unsigned w) { return __builtin_bit_cast(float, w & 0xffff0000u); }
__device__ __forceinline__ float sigmoidf_fast(float x) { return __builtin_amdgcn_rcpf(1.0f + __builtin_amdgcn_exp2f(-1.4426950408889634f * x)); }

namespace pg8 {
#define PG8_LAS __attribute__((address_space(3)))
#if defined(PROBE_EPI2)
#define PROBE_EPI_DUP if constexpr (Epi::PERM) E(acc, cur, wr, wc, fr, fq);
#else
#define PROBE_EPI_DUP
#endif
typedef unsigned short bf16_t;
typedef short bf16x8 __attribute__((ext_vector_type(8)));
typedef float f32x4 __attribute__((ext_vector_type(4)));
typedef unsigned u32x4 __attribute__((ext_vector_type(4)));
constexpr int BM = 256, BK = 64, HALF = 128, HTB = HALF * BK * 2  , STAGE_BYTES = 8 * HTB, NXCD = 8, WGM = 8;

__host__ __device__ __forceinline__ int lds_byte(int r, int c) { const int st = (r >> 4) * 2 + (c >> 5), rr = r & 15, cc = c & 31, ob = rr * 64 + cc * 2; return st * 1024 + (ob ^ (((ob >> 9) & 1) << 5)); }
__host__ __device__ __forceinline__ void stage_rc(int b, int& R, int& C) { const int st = b / 1024, sb = b % 1024, swz = sb ^ (((sb >> 9) & 1) << 5); R = (st >> 1) * 16 + swz / 64; C = (st & 1) * 32 + (swz % 64) / 2; }
__host__ __device__ __forceinline__ int perm32(int rho) { const int n = rho >> 4, i = rho & 15; return 8 * (i >> 2) + 4 * n + (i & 3); }

struct Unit { int pm, pn; };
struct Gemm { const bf16_t* A; const bf16_t* Bt; int M, N, K, lda, ldb, sa; };
__host__ __device__ __forceinline__ Gemm mkgemm(const bf16_t* A, const bf16_t* Bt, int M, int N, int K) { Gemm g; g.A = A; g.Bt = Bt; g.M = M; g.N = N; g.K = K; g.lda = K; g.ldb = K; g.sa = 0x7F7F7F7F; return g; }

struct StaticOrder {
    int nM, nN, nwg, G, c;
    __host__ __device__ void init(int M, int N, int G_, int c_) { nM = M / BM; nN = N / BM; nwg = nM * nN; G = G_; c = c_; }
    __host__ __device__ bool next(int i, Unit& u) const {
        const long L = (long)i * G + c; if (L >= nwg) return false;
        int wgid = (int)L; { const int q = nwg / NXCD, r = nwg % NXCD, xcd = wgid % NXCD, off = wgid / NXCD; wgid = (xcd < r ? xcd * (q + 1) : r * (q + 1) + (xcd - r) * q) + off; }
        const int nig = WGM * nN, gid = wgid / nig, fm = gid * WGM, gsz = (nM - fm) < WGM ? (nM - fm) : WGM;
        u.pm = fm + ((wgid % nig) % gsz); u.pn = (wgid % nig) / gsz; return true;
    }
    __device__ __forceinline__ void a_ready(const Unit&) const {}
    __device__ __forceinline__ void done(const Unit&) const {}
};
struct RangeOrder { StaticOrder S; int i0, i1;
    __host__ __device__ bool next(int i, Unit& u) const { return (i + i0 < i1) ? S.next(i + i0, u) : false; }
    __device__ __forceinline__ void a_ready(const Unit&) const {}
    __device__ __forceinline__ void done(const Unit&) const {} };


__device__ __forceinline__ unsigned cvt_pk_bf16(float lo, float hi) { unsigned r; asm volatile("v_cvt_pk_bf16_f32 %0, %1, %2" : "=v"(r) : "v"(lo), "v"(hi)); return r; }
__device__ __forceinline__ float sigm(float x) { return __builtin_amdgcn_rcpf(1.0f + __builtin_amdgcn_exp2f(-1.4426950408889634f * x)); }

typedef unsigned long long rs_t;
constexpr float RS_FIX = 16777216.0f, RS_INV = 1.0f / (16777216.0f * 4096.0f), RS_EPS = 1e-6f;
__device__ __forceinline__ void row_ss_add(rs_t* rs, int row, float s, int fq) {
    s += __shfl_xor(s, 16); s += __shfl_xor(s, 32);
    if (fq == 0) __hip_atomic_fetch_add(rs + row, (rs_t)(s * RS_FIX), __ATOMIC_RELAXED, __HIP_MEMORY_SCOPE_AGENT);
}
__device__ __forceinline__ float rs_rinv(rs_t v) { return __builtin_amdgcn_rsqf((float)v * RS_INV + RS_EPS); }
#define PIN8(a) asm volatile("" : "+v"((a)[0]), "+v"((a)[1]), "+v"((a)[2]), "+v"((a)[3]), "+v"((a)[4]), "+v"((a)[5]), "+v"((a)[6]), "+v"((a)[7]))
template <int ACT> struct EpiBf16 {
    static constexpr bool PERM = true, AFTER_DRAIN = false;
    bf16_t *O0, *O1, *O2; int ld0, ld1, ld2, c1, c2; const rs_t* rs; int vt; int rs_from;
    __device__ __forceinline__ void operator()(const f32x4 (&acc)[2][2][4][2], const Unit& u, int wr, int wc, int fr, int fq) const {
        const int row0 = u.pm * BM + wr * 64 + fr; int colt = u.pn * BM; bf16_t* base = O0; int ldc = ld0;
        const rs_t* rs = (colt >= rs_from) ? this->rs : nullptr;
        bool tr = false;
        if (colt >= c2) { base = O2; ldc = ld2; colt -= c2; tr = vt != 0; } else if (colt >= c1) { base = O1; ldc = ld1; colt -= c1; }
        const int col0 = colt + wc * 32 + 8 * fq;
        rs_t scv[8];
#pragma unroll
        for (int gi = 0; gi < 8; ++gi) scv[gi] = rs ? rs[row0 + (gi >> 2) * HALF + (gi & 3) * 16] : 0ull;
        PIN8(scv);
#pragma unroll
        for (int ai = 0; ai < 2; ++ai)
#pragma unroll
            for (int m = 0; m < 4; ++m) { bf16_t* rowp = base + (size_t)(row0 + ai * HALF + m * 16) * ldc + col0; const float sc = rs ? rs_rinv(scv[ai * 4 + m]) : 1.0f;
#pragma unroll
                for (int bj = 0; bj < 2; ++bj) { f32x4 v0 = acc[ai][bj][m][0] * sc, v1 = acc[ai][bj][m][1] * sc;
                    if (ACT == 2) {
#pragma unroll
                        for (int j = 0; j < 4; ++j) { const float a = fmaxf(v0[j], 0.f), b = fmaxf(v1[j], 0.f); v0[j] = a * a; v1[j] = b * b; } }
                    u32x4 w; w.x = cvt_pk_bf16(v0[0], v0[1]); w.y = cvt_pk_bf16(v0[2], v0[3]); w.z = cvt_pk_bf16(v1[0], v1[1]); w.w = cvt_pk_bf16(v1[2], v1[3]);
                    if (vt == 2 && tr) {
                        unsigned char* tp = (unsigned char*)base + (size_t)(col0 + bj * HALF) * ldc + (row0 + ai * HALF + m * 16);
                        int w0 = __builtin_amdgcn_cvt_pk_fp8_f32(v0[0], v0[1], 0, false); w0 = __builtin_amdgcn_cvt_pk_fp8_f32(v0[2], v0[3], w0, true);
                        int w1 = __builtin_amdgcn_cvt_pk_fp8_f32(v1[0], v1[1], 0, false); w1 = __builtin_amdgcn_cvt_pk_fp8_f32(v1[2], v1[3], w1, true);
                        tp[0] = (unsigned char)w0; tp[(size_t)ldc] = (unsigned char)(w0 >> 8); tp[(size_t)2 * ldc] = (unsigned char)(w0 >> 16); tp[(size_t)3 * ldc] = (unsigned char)(w0 >> 24);
                        tp[(size_t)4 * ldc] = (unsigned char)w1; tp[(size_t)5 * ldc] = (unsigned char)(w1 >> 8); tp[(size_t)6 * ldc] = (unsigned char)(w1 >> 16); tp[(size_t)7 * ldc] = (unsigned char)(w1 >> 24); }
                    else if (tr) { bf16_t* tp = base + (size_t)(col0 + bj * HALF) * ldc + (row0 + ai * HALF + m * 16);
                        tp[0] = (bf16_t)w.x; tp[(size_t)ldc] = (bf16_t)(w.x >> 16); tp[(size_t)2 * ldc] = (bf16_t)w.y; tp[(size_t)3 * ldc] = (bf16_t)(w.y >> 16);
                        tp[(size_t)4 * ldc] = (bf16_t)w.z; tp[(size_t)5 * ldc] = (bf16_t)(w.z >> 16); tp[(size_t)6 * ldc] = (bf16_t)w.w; tp[(size_t)7 * ldc] = (bf16_t)(w.w >> 16); }
                    else *(u32x4*)(rowp + bj * HALF) = w; } }
    }
};
struct EpiF32 {
    static constexpr bool PERM = false, AFTER_DRAIN = false;
    float* C; int ldc;
    __device__ __forceinline__ void operator()(const f32x4 (&acc)[2][2][4][2], const Unit& u, int wr, int wc, int fr, int fq) const {
        const int row0 = u.pm * BM + wr * 64 + fr, col0 = u.pn * BM + wc * 32 + 4 * fq;
#pragma unroll
        for (int ai = 0; ai < 2; ++ai)
#pragma unroll
            for (int m = 0; m < 4; ++m) { float* rowp = C + (size_t)(row0 + ai * HALF + m * 16) * ldc + col0;
#pragma unroll
                for (int bj = 0; bj < 2; ++bj)
#pragma unroll
                    for (int n = 0; n < 2; ++n) *(f32x4*)(rowp + bj * HALF + n * 16) = acc[ai][bj][m][n]; }
    }
};
typedef unsigned u32x2 __attribute__((ext_vector_type(2)));
__device__ __forceinline__ f32x4 bf4_to_f32(u32x2 p) { return (f32x4){__builtin_bit_cast(float, p.x << 16), __builtin_bit_cast(float, p.x & 0xffff0000u), __builtin_bit_cast(float, p.y << 16), __builtin_bit_cast(float, p.y & 0xffff0000u)}; }
struct EpiRes {
    static constexpr bool PERM = false, AFTER_DRAIN = false;
    const bf16_t* base; bf16_t* out; rs_t* rs; int ldc; const rs_t* rsq;
    __device__ __forceinline__ void operator()(const f32x4 (&acc)[2][2][4][2], const Unit& u, int wr, int wc, int fr, int fq) const {
        constexpr int PD = 3;
        const int row0 = u.pm * BM + wr * 64 + fr, col0 = u.pn * BM + wc * 32 + 4 * fq;
        u32x2 nb[8][2][2];
        rs_t scv[8];
#pragma unroll
        for (int gi = 0; gi < 8; ++gi) scv[gi] = rsq ? rsq[row0 + (gi >> 2) * HALF + (gi & 3) * 16] : 0ull;
#define EPI_LD(g) do { const size_t o_ = (size_t)(row0 + ((g) >> 2) * HALF + ((g) & 3) * 16) * ldc + col0; _Pragma("unroll") for (int bj = 0; bj < 2; ++bj) _Pragma("unroll") for (int n = 0; n < 2; ++n) nb[g][bj][n] = *(const u32x2*)(base + o_ + bj * HALF + n * 16); } while (0)
#pragma unroll
        for (int g = 0; g < PD; ++g) EPI_LD(g);
        PIN8(scv);
#pragma unroll
        for (int gi = 0; gi < 8; ++gi) { const int ai = gi >> 2, m = gi & 3; const int row = row0 + ai * HALF + m * 16; const size_t off = (size_t)row * ldc + col0;
            if (gi + PD < 8) EPI_LD(gi + PD);
            const float sc2 = rsq ? __builtin_amdgcn_rcpf((float)scv[gi] * RS_INV + RS_EPS) : 1.0f;
            float ss = 0.f;
#pragma unroll
            for (int bj = 0; bj < 2; ++bj)
#pragma unroll
                for (int n = 0; n < 2; ++n) { const f32x4 o = bf4_to_f32(nb[gi][bj][n]) + acc[ai][bj][m][n] * sc2;
                    ss += (o[0] * o[0] + o[1] * o[1]) + (o[2] * o[2] + o[3] * o[3]);
                    u32x2 w; w.x = cvt_pk_bf16(o[0], o[1]); w.y = cvt_pk_bf16(o[2], o[3]); *(u32x2*)(out + off + bj * HALF + n * 16) = w; }
            row_ss_add(rs, row, ss, fq); }
#undef EPI_LD
    }
};
struct EpiGate {
    static constexpr bool PERM = false, AFTER_DRAIN = false;
    const bf16_t* base; bf16_t* out; float* out32; const bf16_t* pp; const rs_t* rsin; rs_t* rs; int ldc; unsigned char* out8;
    __device__ __forceinline__ void operator()(const f32x4 (&acc)[2][2][4][2], const Unit& u, int wr, int wc, int fr, int fq) const {
        constexpr int PD = 2;
        const int row0 = u.pm * BM + wr * 64 + fr, col0 = u.pn * BM + wc * 32 + 4 * fq;
        rs_t scv[8];
#pragma unroll
        for (int gi = 0; gi < 8; ++gi) scv[gi] = rsin[row0 + (gi >> 2) * HALF + (gi & 3) * 16];
        u32x2 nb[8][2][2], np[8][2][2];
#define EPI_LD(g) do { const size_t o_ = (size_t)(row0 + ((g) >> 2) * HALF + ((g) & 3) * 16) * ldc + col0; _Pragma("unroll") for (int bj = 0; bj < 2; ++bj) _Pragma("unroll") for (int n = 0; n < 2; ++n) { \
            nb[g][bj][n] = *(const u32x2*)(base + o_ + bj * HALF + n * 16); np[g][bj][n] = *(const u32x2*)(pp + o_ + bj * HALF + n * 16); } } while (0)
#pragma unroll
        for (int g = 0; g < PD; ++g) EPI_LD(g);
        PIN8(scv);
#pragma unroll
        for (int gi = 0; gi < 8; ++gi) { const int ai = gi >> 2, m = gi & 3; const int row = row0 + ai * HALF + m * 16; const size_t off = (size_t)row * ldc + col0;
            if (gi + PD < 8) EPI_LD(gi + PD);
            const float sc = rs_rinv(scv[gi]);
            float ss = 0.f;
#pragma unroll
            for (int bj = 0; bj < 2; ++bj)
#pragma unroll
                for (int n = 0; n < 2; ++n) { const f32x4 a = acc[ai][bj][m][n] * sc, p = bf4_to_f32(np[gi][bj][n]); f32x4 o = bf4_to_f32(nb[gi][bj][n]);
#pragma unroll
                    for (int j = 0; j < 4; ++j) o[j] += sigm(a[j]) * p[j];
                    if (out32) *(f32x4*)(out32 + off + bj * HALF + n * 16) = o;
                    if (out8) { int w8 = __builtin_amdgcn_cvt_pk_fp8_f32(o[0], o[1], 0, false); w8 = __builtin_amdgcn_cvt_pk_fp8_f32(o[2], o[3], w8, true); *(unsigned*)(out8 + off + bj * HALF + n * 16) = (unsigned)w8; }
                    ss += (o[0] * o[0] + o[1] * o[1]) + (o[2] * o[2] + o[3] * o[3]);
                    u32x2 w; w.x = cvt_pk_bf16(o[0], o[1]); w.y = cvt_pk_bf16(o[2], o[3]); *(u32x2*)(out + off + bj * HALF + n * 16) = w; }
            row_ss_add(rs, row, ss, fq); }
#undef EPI_LD
    }
};
struct EpiGlu {
    static constexpr bool PERM = false, AFTER_DRAIN = false;
    const bf16_t* base; bf16_t* out; rs_t* rs; int ldc;
    __device__ __forceinline__ void operator()(const f32x4 (&acc)[2][2][4][2], const Unit& u, int wr, int wc, int fr, int fq) const {
        constexpr int PD = 3;
        const int row0 = u.pm * BM + wr * 64 + fr, col0 = u.pn * HALF + wc * 32 + 4 * fq;
        u32x2 nb[8][2];
#define EPI_LD(g) do { const size_t o_ = (size_t)(row0 + ((g) >> 2) * HALF + ((g) & 3) * 16) * ldc + col0; _Pragma("unroll") for (int n = 0; n < 2; ++n) nb[g][n] = *(const u32x2*)(base + o_ + n * 16); } while (0)
#pragma unroll
        for (int g = 0; g < PD; ++g) EPI_LD(g);
#pragma unroll
        for (int gi = 0; gi < 8; ++gi) { const int ai = gi >> 2, m = gi & 3; const int row = row0 + ai * HALF + m * 16; const size_t off = (size_t)row * ldc + col0;
            if (gi + PD < 8) EPI_LD(gi + PD);
            float ss = 0.f;
#pragma unroll
            for (int n = 0; n < 2; ++n) { const f32x4 a = acc[ai][0][m][n], g = acc[ai][1][m][n]; f32x4 o = bf4_to_f32(nb[gi][n]);
#pragma unroll
                for (int j = 0; j < 4; ++j) o[j] += a[j] * sigm(g[j]);
                ss += (o[0] * o[0] + o[1] * o[1]) + (o[2] * o[2] + o[3] * o[3]);
                u32x2 w; w.x = cvt_pk_bf16(o[0], o[1]); w.y = cvt_pk_bf16(o[2], o[3]); *(u32x2*)(out + off + n * 16) = w; }
            row_ss_add(rs, row, ss, fq); }
#undef EPI_LD
    }
};

constexpr int S5T = 32, S5NCH = 512, S5KS = 768;
struct S5Order {
    int G, c, MT, NT;
    __device__ __forceinline__ bool next(int i, Unit& u) const { const int idx = i * G + c; if (idx >= 256 * MT * NT) return false; const int g = idx & 255, sub = idx >> 8;
        u.pm = g * MT + sub / NT; u.pn = g * NT + sub % NT; return true; }
    __device__ __forceinline__ void a_ready(const Unit&) const {}
    __device__ __forceinline__ void done(const Unit&) const {}
};
struct EpiS5U {
    static constexpr bool PERM = true, AFTER_DRAIN = false;
    bf16_t* UA; const rs_t* rs;
    __device__ __forceinline__ void operator()(const f32x4 (&acc)[2][2][4][2], const Unit& u, int wr, int wc, int fr, int fq) const {
        const int row0 = u.pm * BM + wr * 64 + fr, col0 = u.pn * BM + wc * 32 + 8 * fq;
        rs_t scv[8];
#pragma unroll
        for (int gi = 0; gi < 8; ++gi) scv[gi] = rs[row0 + (gi >> 2) * HALF + (gi & 3) * 16];
        PIN8(scv);
#pragma unroll
        for (int ai = 0; ai < 2; ++ai)
#pragma unroll
            for (int m = 0; m < 4; ++m) { const int t = row0 + ai * HALF + m * 16, c = t >> 5, sg = t & 31; const float sc = rs_rinv(scv[ai * 4 + m]);
#pragma unroll
                for (int bj = 0; bj < 2; ++bj) { const int col = col0 + bj * HALF, g = col >> 4, q0 = col & 15;
                    const f32x4 v0 = acc[ai][bj][m][0] * sc, v1 = acc[ai][bj][m][1] * sc;
                    u32x4 w; w.x = cvt_pk_bf16(v0[0], v0[1]); w.y = cvt_pk_bf16(v0[2], v0[3]); w.z = cvt_pk_bf16(v1[0], v1[1]); w.w = cvt_pk_bf16(v1[2], v1[3]);
                    *(u32x4*)(UA + ((size_t)(g * S5NCH + c) * S5KS + sg * 16 + q0)) = w; } }
    }
};
struct EpiS5E {
    static constexpr bool PERM = false, AFTER_DRAIN = false;
    float* E;
    __device__ __forceinline__ void operator()(const f32x4 (&acc)[2][2][4][2], const Unit& u, int wr, int wc, int fr, int fq) const {
        const int row0 = u.pm * BM + wr * 64 + fr, col0 = wc * 32 + 4 * fq;
#pragma unroll
        for (int ai = 0; ai < 2; ++ai)
#pragma unroll
            for (int m = 0; m < 4; ++m) { float* rowp = E + (size_t)(row0 + ai * HALF + m * 16) * 256 + col0;
#pragma unroll
                for (int bj = 0; bj < 2; ++bj)
#pragma unroll
                    for (int n = 0; n < 2; ++n) *(f32x4*)(rowp + bj * HALF + n * 16) = acc[ai][bj][m][n]; }
    }
};
__device__ __forceinline__ float gelu_tanh_f(float v) {
    const float z = 0.7978845608028654f * (v + 0.044715f * v * v * v);
    const float e = __builtin_amdgcn_exp2f(2.0f * 1.4426950408889634f * z);
    return 0.5f * v * (2.0f - 2.0f * __builtin_amdgcn_rcpf(e + 1.0f));
}
struct EpiS5Y {
    static constexpr bool PERM = true, AFTER_DRAIN = false;
    const bf16_t* UA; const float* dskip; bf16_t* G; int ldg;
    __device__ __forceinline__ void operator()(const f32x4 (&acc)[2][2][4][2], const Unit& u, int wr, int wc, int fr, int fq) const {
        const int row0 = u.pm * BM + wr * 64 + fr, col0 = (u.pn & 1) * BM + wc * 32 + 8 * fq;
        const int g = u.pm >> 1, p0 = col0 & 15;
        const f32x4 d0 = *(const f32x4*)(dskip + 16 * g + p0), d1 = *(const f32x4*)(dskip + 16 * g + p0 + 4);
        u32x4 uu[8][2];
#pragma unroll
        for (int gi = 0; gi < 8; ++gi)
#pragma unroll
            for (int bj = 0; bj < 2; ++bj) uu[gi][bj] = *(const u32x4*)(UA + ((size_t)(row0 + (gi >> 2) * HALF + (gi & 3) * 16) * S5KS + col0 + bj * HALF));
#pragma unroll
        for (int gi = 0; gi < 8; ++gi) asm volatile("" : "+v"(uu[gi][0]), "+v"(uu[gi][1]));
#pragma unroll
        for (int gi = 0; gi < 8; ++gi) { const int ai = gi >> 2, m = gi & 3; const int rowg = row0 + ai * HALF + m * 16, c = rowg & 511;
#pragma unroll
            for (int bj = 0; bj < 2; ++bj) { const int col = col0 + bj * HALF, tau = col >> 4; const u32x4 w4 = uu[gi][bj];
                f32x4 v0 = acc[ai][bj][m][0], v1 = acc[ai][bj][m][1];
                v0[0] += d0[0] * __builtin_bit_cast(float, w4.x << 16); v0[1] += d0[1] * __builtin_bit_cast(float, w4.x & 0xffff0000u);
                v0[2] += d0[2] * __builtin_bit_cast(float, w4.y << 16); v0[3] += d0[3] * __builtin_bit_cast(float, w4.y & 0xffff0000u);
                v1[0] += d1[0] * __builtin_bit_cast(float, w4.z << 16); v1[1] += d1[1] * __builtin_bit_cast(float, w4.z & 0xffff0000u);
                v1[2] += d1[2] * __builtin_bit_cast(float, w4.w << 16); v1[3] += d1[3] * __builtin_bit_cast(float, w4.w & 0xffff0000u);
#pragma unroll
                for (int j = 0; j < 4; ++j) { v0[j] = gelu_tanh_f(v0[j]); v1[j] = gelu_tanh_f(v1[j]); }
                u32x4 w; w.x = cvt_pk_bf16(v0[0], v0[1]); w.y = cvt_pk_bf16(v0[2], v0[3]); w.z = cvt_pk_bf16(v1[0], v1[1]); w.w = cvt_pk_bf16(v1[2], v1[3]);
                *(u32x4*)(G + (size_t)(32 * c + tau) * ldg + 16 * g + p0) = w; } }
    }
};

template <class Epi, class Sched, bool ALIGN_EPI = false, bool SP2 = false, bool FP8 = false>
__device__ __forceinline__ void gemm_phase(PG8_LAS unsigned char* lds, const Gemm g, const Sched& S, const Epi& E) {
    int tid_o = threadIdx.x; asm volatile("" : "+v"(tid_o)); const int tid = tid_o, wid = __builtin_amdgcn_readfirstlane(tid >> 6), lane = tid & 63, wr = wid >> 2, wc = wid & 3, fr = lane & 15, fq = lane >> 4;
    const int K = g.K, nt = K / BK;
    unsigned voffA[2], voffB[2];
#pragma unroll
    for (int i = 0; i < 2; ++i) { int R, C; stage_rc(tid * 16 + i * 8192, R, C); const int Rb = Epi::PERM ? ((R & ~31) + perm32(R & 31)) : R;
        voffA[i] = (unsigned)(R * g.lda + C) * 2u; voffB[i] = (unsigned)(Rb * g.ldb + C) * 2u; }
    const size_t kstep = (size_t)(BK * 2);
    const size_t hstepA = (size_t)HALF * g.lda * 2, hstepB = (size_t)HALF * g.ldb * 2;
    const size_t tstepA = 2 * hstepA, tstepB = 2 * hstepB;
    const unsigned ldsw = (unsigned)wid * 1024u;
    const int aoff = lds_byte(wr * 64 + fr, fq * 8), boff = lds_byte(wc * 32 + fr, fq * 8);
    const int aoff8 = lds_byte(wr * 64 + fr, fq * 16), boff8 = lds_byte(wc * 32 + fr, fq * 16);
#define PG8_SA(b, h) (((b) * 2 + (h)) * HTB)
#define PG8_SB(b, h) ((4 + (b) * 2 + (h)) * HTB)
#define PG8_STAGE(bufoff, gbase, voff) do { _Pragma("unroll") for (int _i = 0; _i < 2; ++_i) \
        __builtin_amdgcn_global_load_lds((const unsigned*)((const char*)(gbase) + (voff)[_i]), (PG8_LAS unsigned*)(lds + (bufoff) + ldsw + _i * 8192), 16, 0, 0); } while (0)
#define PG8_LDA(dst, b, h) do { if constexpr (FP8) { _Pragma("unroll") for (int m = 0; m < 4; ++m) { const PG8_LAS unsigned char* p_ = lds + PG8_SA(b, h) + aoff8 + m * 2048; const v4i32 l_ = *(const PG8_LAS v4i32*)p_, h_ = *(const PG8_LAS v4i32*)(p_ + 16); \
        dst##8[m] = __builtin_shufflevector(l_, h_, 0, 1, 2, 3, 4, 5, 6, 7); } } else { \
        _Pragma("unroll") for (int m = 0; m < 4; ++m) _Pragma("unroll") for (int k = 0; k < 2; ++k) dst[m][k] = *(const PG8_LAS bf16x8*)(lds + PG8_SA(b, h) + aoff + m * 2048 + k * 1024); } } while (0)
#define PG8_LDB(dst, b, h) do { if constexpr (FP8) { _Pragma("unroll") for (int n = 0; n < 2; ++n) { const PG8_LAS unsigned char* p_ = lds + PG8_SB(b, h) + boff8 + n * 2048; const v4i32 l_ = *(const PG8_LAS v4i32*)p_, h_ = *(const PG8_LAS v4i32*)(p_ + 16); \
        dst##8[n] = __builtin_shufflevector(l_, h_, 0, 1, 2, 3, 4, 5, 6, 7); } } else { \
        _Pragma("unroll") for (int n = 0; n < 2; ++n) _Pragma("unroll") for (int k = 0; k < 2; ++k) dst[n][k] = *(const PG8_LAS bf16x8*)(lds + PG8_SB(b, h) + boff + n * 2048 + k * 1024); } } while (0)
#define PG8_MMA(ai, bj, At, Bt) do { __builtin_amdgcn_s_setprio(1); if constexpr (FP8) { _Pragma("unroll") for (int m = 0; m < 4; ++m) _Pragma("unroll") for (int n = 0; n < 2; ++n) \
        asm volatile("v_mfma_scale_f32_16x16x128_f8f6f4 %0, %1, %2, %0, %3, %4 op_sel_hi:[0,0,0]" : "+v"(acc[ai][bj][m][n]) : "v"(Bt##8[n]), "v"(At##8[m]), "v"(sc_w8), "v"(sc_a8)); } else { \
        _Pragma("unroll") for (int m = 0; m < 4; ++m) _Pragma("unroll") for (int n = 0; n < 2; ++n) _Pragma("unroll") for (int k = 0; k < 2; ++k) \
        acc[ai][bj][m][n] = __builtin_amdgcn_mfma_f32_16x16x32_bf16(Bt[n][k], At[m][k], acc[ai][bj][m][n], 0, 0, 0); } __builtin_amdgcn_s_setprio(0); } while (0)
#define PG8_WAIT_V(n) asm volatile("s_waitcnt vmcnt(" #n ")" ::: "memory")
#define PG8_WAIT_L(n) asm volatile("s_waitcnt lgkmcnt(" #n ")" ::: "memory")
#define PG8_BAR __builtin_amdgcn_s_barrier()
#define PG8_SCHED __builtin_amdgcn_sched_barrier(0)
    Unit cur, nxt; int ui = 0;
    if (!S.next(0, cur)) return;
    f32x4 acc[2][2][4][2];
#pragma unroll
    for (int a = 0; a < 2; ++a)
#pragma unroll
        for (int b = 0; b < 2; ++b)
#pragma unroll
            for (int m = 0; m < 4; ++m)
#pragma unroll
                for (int n = 0; n < 2; ++n) acc[a][b][m][n] = (f32x4){0.f, 0.f, 0.f, 0.f};
    bf16x8 At[4][2], B0[2][2], B1[2][2];
    typedef int v8i32 __attribute__((ext_vector_type(8))); typedef int v4i32 __attribute__((ext_vector_type(4))); v8i32 At8[4], B08[2], B18[2];
    const int sc_w8 = 0x79797979, sc_a8 = g.sa;
    const char* cA = (const char*)g.A + (size_t)cur.pm * tstepA; const char* cB = (const char*)g.Bt + (size_t)cur.pn * tstepB;
    S.a_ready(cur);
    if constexpr (SP2) {
        PG8_STAGE(PG8_SB(0, 0), cB, voffB); PG8_STAGE(PG8_SB(0, 1), cB + hstepB, voffB); PG8_STAGE(PG8_SA(0, 0), cA, voffA); PG8_STAGE(PG8_SA(0, 1), cA + hstepA, voffA);
        if (wr == 1) PG8_BAR;
        PG8_WAIT_V(2); PG8_BAR;
        PG8_STAGE(PG8_SB(1, 0), cB + kstep, voffB); PG8_STAGE(PG8_SA(1, 0), cA + kstep, voffA); PG8_STAGE(PG8_SB(1, 1), cB + hstepB + kstep, voffB);
        PG8_WAIT_V(6); PG8_BAR;
    } else {
        PG8_STAGE(PG8_SB(0, 0), cB, voffB); PG8_STAGE(PG8_SA(0, 0), cA, voffA); PG8_STAGE(PG8_SB(0, 1), cB + hstepB, voffB); PG8_STAGE(PG8_SA(0, 1), cA + hstepA, voffA);
        if (wr == 1) PG8_BAR;
        PG8_WAIT_V(4); PG8_BAR;
        PG8_STAGE(PG8_SB(1, 0), cB + kstep, voffB); PG8_STAGE(PG8_SA(1, 0), cA + kstep, voffA); PG8_STAGE(PG8_SB(1, 1), cB + hstepB + kstep, voffB);
        PG8_WAIT_V(6); PG8_BAR;
    }
    for (;;) {
        const bool has_next = S.next(ui + 1, nxt);
        const char* nA = has_next ? (const char*)g.A + (size_t)nxt.pm * tstepA : cA; const char* nB = has_next ? (const char*)g.Bt + (size_t)nxt.pn * tstepB : cB;
        for (int t = 0; t < nt; t += 2) {
            const bool last = (t == nt - 2);
            const char* a1 = cA + (size_t)(t + 1) * kstep;
            const char* a2 = last ? nA : cA + (size_t)(t + 2) * kstep; const char* b2 = last ? nB : cB + (size_t)(t + 2) * kstep;
            const char* a3 = a2 + kstep; const char* b3 = b2 + kstep;
            if (last && has_next) S.a_ready(nxt);
            if constexpr (SP2) {
            PG8_LDB(B0, 0, 0); PG8_LDB(B1, 0, 1); PG8_SCHED; PG8_LDA(At, 0, 0); PG8_STAGE(PG8_SA(1, 1), a1 + hstepA, voffA);
            PG8_WAIT_V(8); PG8_WAIT_L(0); PG8_BAR; PG8_MMA(0, 0, At, B0); PG8_MMA(0, 1, At, B1); PG8_BAR; PG8_SCHED;
            PG8_LDA(At, 0, 1); PG8_STAGE(PG8_SB(0, 0), b2, voffB); PG8_STAGE(PG8_SB(0, 1), b2 + hstepB, voffB); PG8_STAGE(PG8_SA(0, 0), a2, voffA);
            PG8_WAIT_V(8); PG8_WAIT_L(0); PG8_BAR; PG8_MMA(1, 0, At, B0); PG8_MMA(1, 1, At, B1); PG8_BAR; PG8_SCHED;
            PG8_LDB(B0, 1, 0); PG8_LDB(B1, 1, 1); PG8_SCHED; PG8_LDA(At, 1, 0); PG8_STAGE(PG8_SA(0, 1), a2 + hstepA, voffA);
            PG8_WAIT_V(8); PG8_WAIT_L(0); PG8_BAR; PG8_MMA(0, 0, At, B0); PG8_MMA(0, 1, At, B1); PG8_BAR; PG8_SCHED;
            PG8_LDA(At, 1, 1); PG8_STAGE(PG8_SB(1, 0), b3, voffB); PG8_STAGE(PG8_SB(1, 1), b3 + hstepB, voffB); PG8_STAGE(PG8_SA(1, 0), a3, voffA);
            PG8_WAIT_V(8); PG8_WAIT_L(0); PG8_BAR; PG8_MMA(1, 0, At, B0); PG8_MMA(1, 1, At, B1); PG8_BAR; PG8_SCHED;
            } else {
            PG8_LDB(B0, 0, 0); PG8_SCHED; PG8_LDA(At, 0, 0); PG8_STAGE(PG8_SA(1, 1), a1 + hstepA, voffA);
            PG8_WAIT_L(8); PG8_BAR; PG8_WAIT_L(0); PG8_MMA(0, 0, At, B0); PG8_BAR; PG8_SCHED;
            PG8_LDB(B1, 0, 1); PG8_STAGE(PG8_SB(0, 0), b2, voffB);
            PG8_BAR; PG8_WAIT_L(0); PG8_MMA(0, 1, At, B1); PG8_BAR;
            PG8_LDA(At, 0, 1); PG8_STAGE(PG8_SA(0, 0), a2, voffA);
            PG8_BAR; PG8_WAIT_L(0); PG8_MMA(1, 0, At, B0); PG8_BAR; PG8_SCHED;
            PG8_STAGE(PG8_SB(0, 1), b2 + hstepB, voffB);
            PG8_WAIT_V(6); PG8_BAR; PG8_MMA(1, 1, At, B1); PG8_BAR;
            PG8_LDB(B0, 1, 0); PG8_SCHED; PG8_LDA(At, 1, 0); PG8_STAGE(PG8_SA(0, 1), a2 + hstepA, voffA);
            PG8_WAIT_L(8); PG8_BAR; PG8_WAIT_L(0); PG8_MMA(0, 0, At, B0); PG8_BAR; PG8_SCHED;
            PG8_LDB(B1, 1, 1); PG8_STAGE(PG8_SB(1, 0), b3, voffB);
            PG8_BAR; PG8_WAIT_L(0); PG8_MMA(0, 1, At, B1); PG8_BAR;
            PG8_LDA(At, 1, 1); PG8_STAGE(PG8_SA(1, 0), a3, voffA);
            PG8_BAR; PG8_WAIT_L(0); PG8_MMA(1, 0, At, B0); PG8_BAR; PG8_SCHED;
            PG8_STAGE(PG8_SB(1, 1), b3 + hstepB, voffB);
            PG8_WAIT_V(6); PG8_BAR; PG8_MMA(1, 1, At, B1); PG8_BAR;
            }
        }
        if constexpr (FP8) asm volatile("s_nop 15\n\ts_nop 7" ::: "memory");
        if constexpr (ALIGN_EPI) { if (wr == 0) PG8_BAR; }
        if constexpr (!Epi::AFTER_DRAIN) { E(acc, cur, wr, wc, fr, fq); PROBE_EPI_DUP S.done(cur); }
        if (!has_next) break;
#pragma unroll
        for (int a = 0; a < 2; ++a)
#pragma unroll
            for (int b = 0; b < 2; ++b)
#pragma unroll
                for (int m = 0; m < 4; ++m)
#pragma unroll
                    for (int n = 0; n < 2; ++n) acc[a][b][m][n] = (f32x4){0.f, 0.f, 0.f, 0.f};
        cur = nxt; cA = nA; cB = nB; ++ui;
        if constexpr (ALIGN_EPI) { if (wr == 1) PG8_BAR; }
    }
    PG8_WAIT_V(0);
    if constexpr (!ALIGN_EPI) { if (wr == 0) PG8_BAR; }
    PG8_BAR;
    if constexpr (Epi::AFTER_DRAIN) { E.fused(acc, cur, wr, wc, fr, fq, lds, wid, lane); S.done(cur); }
#undef PG8_SA
#undef PG8_SB
#undef PG8_STAGE
#undef PG8_LDA
#undef PG8_LDB
#undef PG8_MMA
#undef PG8_WAIT_V
#undef PG8_WAIT_L
#undef PG8_BAR
#undef PG8_SCHED
}
}
#define XB_TMO      128
#define XB_XCNT(j)  (256  + 64 * (j))
#define XB_XSUB(j)  (1280 + 64 * (j))
#define XB_XGEN(j)  (2304 + 64 * (j))
#define XB_TOP      3328
#define XB_TOPGEN   3392
#define XCD_BAR_WORDS 3456
#define XB_SPIN_CAP (1u << 18)

__device__ __forceinline__ unsigned xb_ld(unsigned* p)              { return __hip_atomic_load(p, __ATOMIC_RELAXED, __HIP_MEMORY_SCOPE_AGENT); }
__device__ __forceinline__ unsigned xb_add(unsigned* p, unsigned v) { return __hip_atomic_fetch_add(p, v, __ATOMIC_RELAXED, __HIP_MEMORY_SCOPE_AGENT); }
__device__ __forceinline__ unsigned xb_xcc_id() { return (unsigned)__builtin_amdgcn_s_getreg((3 << 11) | 20) & 0xFu; }
#define XB_SPIN(cond, bar) do { unsigned _sp = 0; while (cond) { __builtin_amdgcn_s_sleep(1); \
    if ((++_sp & 255u) == 0u) { if (xb_ld(&(bar)[XB_TMO])) break; if (_sp > XB_SPIN_CAP) { atomicAdd(&(bar)[XB_TMO], 1u); break; } } } } while (0)

struct XcdBarrier {
    unsigned* bar; unsigned x;
    volatile LAS unsigned* st;
};

__device__ __forceinline__ XcdBarrier xcd_barrier_post(unsigned* bar, volatile LAS unsigned* st) {
    XcdBarrier b; b.bar = bar; b.x = xb_xcc_id(); b.st = st;
    if (threadIdx.x == 0) (void)xb_add(&bar[XB_XCNT(b.x)], 1u);
    return b;
}
__device__ __forceinline__ void xcd_barrier_complete(unsigned* bar, unsigned x, unsigned& nloc, unsigned& nx) {
    const unsigned G = gridDim.x * gridDim.y * gridDim.z;
    unsigned sum, cnt, mine, sp = 0u;
    for (;;) {
        sum = 0u; cnt = 0u; mine = 0u;
#pragma unroll
        for (unsigned j = 0; j < 16; ++j) { const unsigned c = xb_ld(&bar[XB_XCNT(j)]); sum += c; cnt += (c > 0u) ? 1u : 0u; mine = (j == x) ? c : mine; }
        if (sum == G) break;
        __builtin_amdgcn_s_sleep(1);
        if ((++sp & 255u) == 0u) { if (xb_ld(&bar[XB_TMO])) break; if (sp > XB_SPIN_CAP) { atomicAdd(&bar[XB_TMO], 1u); break; } }
    }
    nloc = mine > 0u ? mine : 1u; nx = cnt > 0u ? cnt : 1u;
}

__device__ __forceinline__ void xcd_barrier(const XcdBarrier& b) {
    asm volatile("s_waitcnt vmcnt(0)" ::: "memory");
    __syncthreads();
    if (threadIdx.x == 0) {
        unsigned* bar = b.bar;
        __builtin_amdgcn_s_waitcnt(0);
        unsigned nloc = b.st[0], nx = b.st[1];
        if (nloc == 0u) { xcd_barrier_complete(bar, b.x, nloc, nx); b.st[0] = nloc; b.st[1] = nx; }
        const unsigned old = xb_add(&bar[XB_XSUB(b.x)], 1u);
        const unsigned gen = old / nloc;
        if (old + 1u == (gen + 1u) * nloc) {
            __builtin_amdgcn_fence(__ATOMIC_RELEASE, "agent");
            asm volatile("s_waitcnt vmcnt(0)" ::: "memory");
            const unsigned og = xb_add(&bar[XB_TOP], 1u);
            const unsigned tg = og / nx;
            if (og + 1u == (tg + 1u) * nx) xb_add(&bar[XB_TOPGEN], 1u);
            else XB_SPIN(xb_ld(&bar[XB_TOPGEN]) == tg, bar);
            __builtin_amdgcn_fence(__ATOMIC_ACQUIRE, "agent");
            xb_add(&bar[XB_XGEN(b.x)], 1u);
            asm volatile("s_waitcnt vmcnt(0)" ::: "memory");
        } else {
            XB_SPIN(xb_ld(&bar[XB_XGEN(b.x)]) == gen, bar);
            __builtin_amdgcn_fence(__ATOMIC_ACQUIRE, "agent");
            asm volatile("s_waitcnt vmcnt(0)" ::: "memory");
        }
    }
    __syncthreads();
}
namespace dattn {
typedef unsigned short bf16;
constexpr int   D = 128, NW = 8, QBLK = 32, KVBLK = 64;
constexpr float SCALE = 0.088388347648318440f;
constexpr float THR = 8.f;
constexpr int SDEPTH = 2;
constexpr int LDQ = 4096, LDK = 1024, LDO = 4096;
constexpr size_t SHM_V = KVBLK * D * 2, SHM_K = KVBLK * D * 2, SHM_ATTN = 3 * SHM_V + 3 * SHM_K + NW * 64 * 4 + 2048;
using bf16x8 = __attribute__((ext_vector_type(8))) short;
using s16x4  = __attribute__((ext_vector_type(4))) short;
using f32x16 = __attribute__((ext_vector_type(16))) float;
using f32x8  = __attribute__((ext_vector_type(8))) float;
using u32x4  = __attribute__((ext_vector_type(4))) unsigned;
#define KSWZ(row, colB) ((row) * 256 + ((colB) ^ (((row) & 7) << 4)))
#define SBAR() __builtin_amdgcn_sched_barrier(0)
__device__ __forceinline__ int crow(int r, int hi) { return (r & 3) + 8 * (r >> 2) + 4 * hi; }
__device__ __forceinline__ unsigned cvtpk(float lo, float hi) {
  unsigned r; asm volatile("v_cvt_pk_bf16_f32 %0, %1, %2" : "=v"(r) : "v"(lo), "v"(hi)); return r;
}
template <typename TIn> struct Stage;
template <> struct Stage<bf16>  { using T = bf16x8;
  __device__ static __forceinline__ T ld8(const bf16* p) { return *reinterpret_cast<const bf16x8*>(p); }
  __device__ static __forceinline__ bf16x8 tobf(T x) { return x; } };
template <> struct Stage<float> { using T = f32x8;
  __device__ static __forceinline__ T ld8(const float* p) { return *reinterpret_cast<const f32x8*>(p); }
  __device__ static __forceinline__ bf16x8 tobf(T x) {
    u32x4 w = {cvtpk(x[0], x[1]), cvtpk(x[2], x[3]), cvtpk(x[4], x[5]), cvtpk(x[6], x[7])}; return *reinterpret_cast<bf16x8*>(&w); } };

__device__ __forceinline__ void partialSM(f32x16& p0, f32x16& p1, float& m_reg, float& mn, float& alpha) {
  constexpr float C = SCALE * 1.4426950408889634f;
  float pmax = p0[0]; for (int r = 1; r < 16; ++r) pmax = fmaxf(pmax, p0[r]); for (int r = 0; r < 16; ++r) pmax = fmaxf(pmax, p1[r]);
  { auto rr = __builtin_amdgcn_permlane32_swap(__float_as_uint(pmax), __float_as_uint(pmax), false, false);
    pmax = fmaxf(__uint_as_float(rr[0]), __uint_as_float(rr[1])); }
  if (__builtin_expect(__all(pmax - m_reg <= THR / SCALE), 1)) { mn = m_reg; alpha = 1.f; }
  else { mn = fmaxf(m_reg, pmax); alpha = __builtin_amdgcn_exp2f((m_reg - mn) * C); m_reg = mn; }
  float mnC = -mn * C;
  for (int r = 0; r < 16; ++r) p0[r] = fmaf(p0[r], C, mnC); for (int r = 0; r < 16; ++r) p1[r] = fmaf(p1[r], C, mnC);
  for (int r = 0; r < 16; ++r) p0[r] = __builtin_amdgcn_exp2f(p0[r]);
}
__device__ __forceinline__ void finishSM(f32x16& p0, f32x16& p1, float alpha, float& l_reg, bf16x8& pa0, bf16x8& pa1, bf16x8& pa2, bf16x8& pa3) {
  for (int r = 0; r < 16; ++r) p1[r] = __builtin_amdgcn_exp2f(p1[r]);
  float ps = 0; for (int r = 0; r < 16; ++r) ps += p0[r]; for (int r = 0; r < 16; ++r) ps += p1[r];
  { auto rr = __builtin_amdgcn_permlane32_swap(__float_as_uint(ps), __float_as_uint(ps), false, false);
    ps = __uint_as_float(rr[0]) + __uint_as_float(rr[1]); }
  l_reg = l_reg * alpha + ps;
#define PK4(P, BASE, OUT) do { unsigned a0 = cvtpk(P[BASE + 0], P[BASE + 1]), a1 = cvtpk(P[BASE + 2], P[BASE + 3]);   \
    unsigned b0 = cvtpk(P[BASE + 4], P[BASE + 5]), b1 = cvtpk(P[BASE + 6], P[BASE + 7]);                              \
    auto r0 = __builtin_amdgcn_permlane32_swap(a0, b0, false, false); auto r1 = __builtin_amdgcn_permlane32_swap(a1, b1, false, false); \
    u32x4 w = {r0[0], r1[0], r0[1], r1[1]}; OUT = *reinterpret_cast<bf16x8*>(&w); } while (0)
  PK4(p0, 0, pa0); PK4(p0, 8, pa1); PK4(p1, 0, pa2); PK4(p1, 8, pa3);
#undef PK4
}
__device__ __forceinline__ void qkt(f32x16& p0, f32x16& p1, const bf16* Ks, const bf16x8* qr, int r32, int hi) {
  p0 = f32x16{}; p1 = f32x16{};
  bf16x8 nb0 = *reinterpret_cast<const bf16x8*>((const char*)Ks + KSWZ(r32, (hi * 8) * 2)), nb1 = *reinterpret_cast<const bf16x8*>((const char*)Ks + KSWZ(32 + r32, (hi * 8) * 2));
#pragma unroll
  for (int d0 = 0; d0 < 8; ++d0) { const bf16x8 b0 = nb0, b1 = nb1;
    if (d0 < 7) { const int cb = ((d0 + 1) * 16 + hi * 8) * 2;
      nb0 = *reinterpret_cast<const bf16x8*>((const char*)Ks + KSWZ(r32, cb)); nb1 = *reinterpret_cast<const bf16x8*>((const char*)Ks + KSWZ(32 + r32, cb)); }
    p0 = __builtin_amdgcn_mfma_f32_32x32x16_bf16(b0, qr[d0], p0, 0, 0, 0);
    p1 = __builtin_amdgcn_mfma_f32_32x32x16_bf16(b1, qr[d0], p1, 0, 0, 0); }
}
__device__ __forceinline__ int v_st(int k, int c) { const int kk = (k & ~0xC) | ((k & 4) << 1) | ((k & 8) >> 1); return ((kk >> 3) * 4 + (c >> 5)) * 512 + ((kk & 7) * 32 + (c & 31)) * 2; }
__device__ __forceinline__ int v_rd_base(int lane) { return ((lane & 3) << 3) | (((lane >> 2) & 3) << 6) | (((lane >> 4) & 1) << 5) | (((lane >> 5) & 1) << 8); }
constexpr int v_rd_off(int d0, int ks, int half) { return d0 * 512 + ks * 4096 + half * 2048; }
template <int OFF> __device__ __forceinline__ s16x4 tr_read(int vb) {
  s16x4 r; asm volatile("ds_read_b64_tr_b16 %0, %1 offset:%2" : "=&v"(r) : "v"(vb), "i"(OFF) : "memory"); return r;
}
template <int D0> __device__ __forceinline__ void pv_one(f32x16& od, int vb, bf16x8 pa0, bf16x8 pa1, bf16x8 pa2, bf16x8 pa3) {
  const s16x4 l0 = tr_read<v_rd_off(D0, 0, 0)>(vb), h0 = tr_read<v_rd_off(D0, 0, 1)>(vb), l1 = tr_read<v_rd_off(D0, 1, 0)>(vb), h1 = tr_read<v_rd_off(D0, 1, 1)>(vb);
  const s16x4 l2 = tr_read<v_rd_off(D0, 2, 0)>(vb), h2 = tr_read<v_rd_off(D0, 2, 1)>(vb), l3 = tr_read<v_rd_off(D0, 3, 0)>(vb), h3 = tr_read<v_rd_off(D0, 3, 1)>(vb);
  asm volatile("s_waitcnt lgkmcnt(0)" ::: "memory"); SBAR();
#define PK(L, H) (bf16x8){L[0], L[1], L[2], L[3], H[0], H[1], H[2], H[3]}
  od = __builtin_amdgcn_mfma_f32_32x32x16_bf16(pa0, PK(l0, h0), od, 0, 0, 0);
  od = __builtin_amdgcn_mfma_f32_32x32x16_bf16(pa1, PK(l1, h1), od, 0, 0, 0);
  od = __builtin_amdgcn_mfma_f32_32x32x16_bf16(pa2, PK(l2, h2), od, 0, 0, 0);
  od = __builtin_amdgcn_mfma_f32_32x32x16_bf16(pa3, PK(l3, h3), od, 0, 0, 0);
#undef PK
}
__device__ __forceinline__ void pv_d0(f32x16* o, int vb, bf16x8 pa0, bf16x8 pa1, bf16x8 pa2, bf16x8 pa3) {
  pv_one<0>(o[0], vb, pa0, pa1, pa2, pa3); pv_one<1>(o[1], vb, pa0, pa1, pa2, pa3); pv_one<2>(o[2], vb, pa0, pa1, pa2, pa3); pv_one<3>(o[3], vb, pa0, pa1, pa2, pa3);
}

template <typename TQ>
__device__ __forceinline__ void attn_dense_body(const TQ* __restrict__ Qb, const bf16* __restrict__ Kh, const bf16* __restrict__ Vh,
                                                bf16* __restrict__ Ob, int seq, char* lds) {
  using St = Stage<bf16>; using SQ = Stage<TQ>;
  int tid_o = threadIdx.x; asm volatile("" : "+v"(tid_o)); const int tid = tid_o, wid = __builtin_amdgcn_readfirstlane(tid >> 6), lane = tid & 63, r32 = lane & 31, hi = lane >> 5;
  bf16* V_lds = (bf16*)lds; bf16* K_lds = (bf16*)(lds + 3 * SHM_V);
  float* ws = (float*)(lds + 3 * SHM_V + 3 * SHM_K) + wid * 64; float* li_l = ws; float* al_l = ws + 32;
  float m_reg = -1e30f, l_reg = 0; f32x16 o[4] = {}; bf16x8 qr[8];
  const TQ* Qw = Qb + (long)(wid * QBLK + r32) * LDQ + hi * 8;
#pragma unroll
  for (int d0 = 0; d0 < 8; ++d0) qr[d0] = SQ::tobf(SQ::ld8(Qw + d0 * 16));
  const int sr = tid >> 4, sc = (tid & 15) * 8, vst0 = v_st(sr, sc), vst1 = v_st(32 + sr, sc);
  const int vb0 = (int)(uintptr_t)V_lds + v_rd_base(lane);
  struct { typename St::T vs0, vs1, ks0, ks1; } sr_[SDEPTH];
#define SLOAD(i, k0) do { sr_[i].vs0 = St::ld8(&Vh[(long)((k0) + sr) * LDK + sc]); sr_[i].vs1 = St::ld8(&Vh[(long)((k0) + 32 + sr) * LDK + sc]); \
    sr_[i].ks0 = St::ld8(&Kh[(long)((k0) + sr) * LDK + sc]); sr_[i].ks1 = St::ld8(&Kh[(long)((k0) + 32 + sr) * LDK + sc]); } while (0)
#define SWRITE(b, i) do { *(bf16x8*)((char*)V_lds + (b) * SHM_V + vst0) = St::tobf(sr_[i].vs0);          \
    *(bf16x8*)((char*)V_lds + (b) * SHM_V + vst1) = St::tobf(sr_[i].vs1); int kc = sc * 2;               \
    *(bf16x8*)((char*)K_lds + (b) * SHM_K + KSWZ(sr, kc)) = St::tobf(sr_[i].ks0);                       \
    *(bf16x8*)((char*)K_lds + (b) * SHM_K + KSWZ(32 + sr, kc)) = St::tobf(sr_[i].ks1); } while (0)
#define SWAIT() do { if constexpr (SDEPTH == 2) asm volatile("s_waitcnt vmcnt(4)" ::: "memory"); else asm volatile("s_waitcnt vmcnt(0)" ::: "memory"); } while (0)
#define RESC(a) do { if (__any((a) < 1.f)) { if (hi == 0) al_l[r32] = (a); asm volatile("s_waitcnt lgkmcnt(0)" ::: "memory"); \
    for (int d = 0; d < 4; ++d) for (int r = 0; r < 16; ++r) o[d][r] *= al_l[crow(r, hi)]; } } while (0)
  f32x16 pA0, pA1, pB0, pB1; float mnA, mnB, alA, alB; bf16x8 pa0, pa1, pa2, pa3; const int NT = seq / KVBLK;
  constexpr int SE = 0, SO = SDEPTH - 1;
  SLOAD(SE, 0); asm volatile("s_waitcnt vmcnt(0)" ::: "memory"); SWRITE(0, SE); __syncthreads();
  qkt(pA0, pA1, K_lds, qr, r32, hi); partialSM(pA0, pA1, m_reg, mnA, alA);
  SLOAD(SO, KVBLK); if constexpr (SDEPTH == 2) { if (2 < NT) SLOAD(SE, 2 * KVBLK); }
  SWAIT(); SWRITE(1, SO); __syncthreads();
  int bk = 1, bv = 0, bw = 2;
  if (wid >= 4) __builtin_amdgcn_s_setprio(1);
#define ROT3() do { const int t_ = bv; bv = bk; bk = bw; bw = t_; } while (0)
  for (int j = 1; j + 1 < NT; j += 2) {
    SBAR(); qkt(pB0, pB1, (bf16*)((char*)K_lds + bk * SHM_K), qr, r32, hi);
    finishSM(pA0, pA1, alA, l_reg, pa0, pa1, pa2, pa3); SBAR();
    SLOAD(SO, (j + SDEPTH) * KVBLK); SBAR();
    pv_d0(o, vb0 + bv * (int)SHM_V, pa0, pa1, pa2, pa3); partialSM(pB0, pB1, m_reg, mnB, alB);
    SWAIT(); SWRITE(bw, SE);
    RESC(alB); __syncthreads(); ROT3();
    SBAR(); qkt(pA0, pA1, (bf16*)((char*)K_lds + bk * SHM_K), qr, r32, hi);
    finishSM(pB0, pB1, alB, l_reg, pa0, pa1, pa2, pa3); SBAR();
    if (SDEPTH == 1 || j + 3 < NT) SLOAD(SE, (j + 1 + SDEPTH) * KVBLK); SBAR();
    pv_d0(o, vb0 + bv * (int)SHM_V, pa0, pa1, pa2, pa3); partialSM(pA0, pA1, m_reg, mnA, alA);
    SWAIT(); SWRITE(bw, SO);
    RESC(alA); __syncthreads(); ROT3();
  }
  SBAR(); qkt(pB0, pB1, (bf16*)((char*)K_lds + bk * SHM_K), qr, r32, hi);
  finishSM(pA0, pA1, alA, l_reg, pa0, pa1, pa2, pa3); SBAR();
  pv_d0(o, vb0 + bv * (int)SHM_V, pa0, pa1, pa2, pa3); partialSM(pB0, pB1, m_reg, mnB, alB);
  RESC(alB);
  finishSM(pB0, pB1, alB, l_reg, pa0, pa1, pa2, pa3); SBAR();
  pv_d0(o, vb0 + bk * (int)SHM_V, pa0, pa1, pa2, pa3);
#undef ROT3
  __builtin_amdgcn_s_setprio(0);
  if (hi == 0) li_l[r32] = l_reg; asm volatile("s_waitcnt lgkmcnt(0)" ::: "memory");
  float rli[16];
#pragma unroll
  for (int r = 0; r < 16; ++r) rli[r] = __builtin_amdgcn_rcpf(li_l[crow(r, hi)]);
  bf16* Ow = Ob + (long)(wid * QBLK) * LDO;
#pragma unroll
  for (int r = 0; r < 16; ++r) { int orow = crow(r, hi);
    for (int d0 = 0; d0 < 4; ++d0) Ow[(long)orow * LDO + d0 * 32 + r32] = (bf16)(cvtpk(o[d0][r] * rli[r], 0.f) & 0xffffu); }
#undef SLOAD
#undef SWRITE
#undef SWAIT
#undef RESC
}

constexpr int NA_LD = 4096, NA_TILES = 12;
__device__ __forceinline__ void na_block_body(const bf16* __restrict__ Qb, const bf16* __restrict__ Kh, const bf16* __restrict__ Vh, bf16* __restrict__ Ob,
                                              const float* __restrict__ rpb_h, const float* __restrict__ qgain, const float* __restrict__ kgain, int R, int ks, char* lds) {
  using St = Stage<bf16>;
  int tid_o = threadIdx.x; asm volatile("" : "+v"(tid_o)); const int tid = tid_o, wid = __builtin_amdgcn_readfirstlane(tid >> 6), lane = tid & 63, r32 = lane & 31, hi = lane >> 5;
  bf16* V_lds = (bf16*)lds; bf16* K_lds = (bf16*)(lds + 2 * SHM_V);
  float* ws = (float*)(lds + 2 * SHM_V + 2 * SHM_K) + wid * 64; float* li_l = ws; float* al_l = ws + 32;
  float* bt = (float*)(lds + 2 * SHM_V + 2 * SHM_K + NW * 64 * 4);
  float m_reg = -1e30f, l_reg = 0; f32x16 o[4] = {}; bf16x8 qr[8];
  const bf16* Qw = Qb + (long)(wid * QBLK + r32) * NA_LD + hi * 8;
#pragma unroll
  for (int d0 = 0; d0 < 8; ++d0) qr[d0] = St::ld8(Qw + d0 * 16);
  {
    float ss = 0.f;
#pragma unroll
    for (int d0 = 0; d0 < 8; ++d0) { const u32x4 w = __builtin_bit_cast(u32x4, qr[d0]);
#pragma unroll
      for (int e = 0; e < 4; ++e) { const float a = __uint_as_float(w[e] << 16), b = __uint_as_float(w[e] & 0xffff0000u); ss += a * a + b * b; } }
    ss += __shfl_xor(ss, 32);
    const float rinv = __builtin_amdgcn_rsqf(ss * (1.0f / 128.0f) + 1e-6f);
#pragma unroll
    for (int d0 = 0; d0 < 8; ++d0) { const u32x4 w = __builtin_bit_cast(u32x4, qr[d0]); const float* gp = qgain + d0 * 16 + hi * 8;
      const f32x8 g = *reinterpret_cast<const f32x8*>(gp); u32x4 o;
#pragma unroll
      for (int e = 0; e < 4; ++e) o[e] = cvtpk(__uint_as_float(w[e] << 16) * rinv * g[2 * e], __uint_as_float(w[e] & 0xffff0000u) * rinv * g[2 * e + 1]);
      qr[d0] = __builtin_bit_cast(bf16x8, o); } }
  const f32x8 kg = *reinterpret_cast<const f32x8*>(kgain + (tid & 15) * 8);
  for (int i = tid; i < 15 * 31; i += 64 * NW) bt[i] = rpb_h[i];
  const int sr = tid >> 4, sc = (tid & 15) * 8, vst0 = v_st(sr, sc), vst1 = v_st(32 + sr, sc);
  const int vb0 = (int)(uintptr_t)V_lds + v_rd_base(lane);
  bf16x8 s_vs0, s_vs1, s_ks0, s_ks1;
#define NLOAD(k0) do { s_vs0 = St::ld8(&Vh[(long)((k0) + sr) * NA_LD + sc]); s_vs1 = St::ld8(&Vh[(long)((k0) + 32 + sr) * NA_LD + sc]); \
    s_ks0 = St::ld8(&Kh[(long)((k0) + sr) * NA_LD + sc]); s_ks1 = St::ld8(&Kh[(long)((k0) + 32 + sr) * NA_LD + sc]); } while (0)
#define KNORM(x) do { const u32x4 w_ = __builtin_bit_cast(u32x4, x); float a_[8]; float ss_ = 0.f; \
    _Pragma("unroll") for (int e = 0; e < 4; ++e) { a_[2 * e] = __uint_as_float(w_[e] << 16); a_[2 * e + 1] = __uint_as_float(w_[e] & 0xffff0000u); ss_ += a_[2 * e] * a_[2 * e] + a_[2 * e + 1] * a_[2 * e + 1]; } \
    ss_ += __shfl_xor(ss_, 1); ss_ += __shfl_xor(ss_, 2); ss_ += __shfl_xor(ss_, 4); ss_ += __shfl_xor(ss_, 8); \
    const float ri_ = __builtin_amdgcn_rsqf(ss_ * (1.0f / 128.0f) + 1e-6f); u32x4 o_; \
    _Pragma("unroll") for (int e = 0; e < 4; ++e) o_[e] = cvtpk(a_[2 * e] * ri_ * kg[2 * e], a_[2 * e + 1] * ri_ * kg[2 * e + 1]); \
    x = __builtin_bit_cast(bf16x8, o_); } while (0)
#define NWRITE(b) do { KNORM(s_ks0); KNORM(s_ks1); \
    *(bf16x8*)((char*)V_lds + (b) * SHM_V + vst0) = s_vs0; *(bf16x8*)((char*)V_lds + (b) * SHM_V + vst1) = s_vs1; const int kc_ = sc * 2; \
    *(bf16x8*)((char*)K_lds + (b) * SHM_K + KSWZ(sr, kc_)) = s_ks0; *(bf16x8*)((char*)K_lds + (b) * SHM_K + KSWZ(32 + sr, kc_)) = s_ks1; } while (0)
  const int qrow = R + (wid >> 1), r0q = min(max(qrow - 4, 0), 248), jlo = r0q - ks;
  const int c = 32 * (wid & 1) + r32, c0 = min(max(c - 8, 0), 48);
  NLOAD(0); asm volatile("s_waitcnt vmcnt(0)" ::: "memory"); NWRITE(0); __syncthreads();
  for (int j = 0; j < NA_TILES; ++j) {
    const int buf = j & 1;
    if (j + 1 < NA_TILES) NLOAD((j + 1) * KVBLK);
    if (j >= jlo && j < jlo + 8) {
      f32x16 p0, p1; float mn, al; bf16x8 pa0, pa1, pa2, pa3;
      SBAR(); qkt(p0, p1, (bf16*)((char*)K_lds + buf * SHM_K), qr, r32, hi);
      const float* brow = bt + (ks + j - qrow + 7) * 31 + (15 - c);
#pragma unroll
      for (int r = 0; r < 16; ++r) { const int k0 = crow(r, hi), k1 = 32 + k0; const bool v0 = (k0 >= c0) && (k0 < c0 + 16), v1 = (k1 >= c0) && (k1 < c0 + 16);
        const float b0 = brow[v0 ? k0 : c], b1 = brow[v1 ? k1 : c];
        p0[r] = v0 ? fmaf(b0, 1.0f / SCALE, p0[r]) : -1e30f; p1[r] = v1 ? fmaf(b1, 1.0f / SCALE, p1[r]) : -1e30f; }
      partialSM(p0, p1, m_reg, mn, al);
      if (__any(al < 1.f)) { if (hi == 0) al_l[r32] = al; asm volatile("s_waitcnt lgkmcnt(0)" ::: "memory");
#pragma unroll
        for (int d = 0; d < 4; ++d)
#pragma unroll
          for (int r = 0; r < 16; ++r) o[d][r] *= al_l[crow(r, hi)]; }
      finishSM(p0, p1, al, l_reg, pa0, pa1, pa2, pa3); SBAR();
      pv_d0(o, vb0 + buf * (int)SHM_V, pa0, pa1, pa2, pa3);
    }
    if (j + 1 < NA_TILES) { asm volatile("s_waitcnt vmcnt(0)" ::: "memory"); NWRITE(buf ^ 1); }
    __syncthreads();
  }
  if (hi == 0) li_l[r32] = l_reg; asm volatile("s_waitcnt lgkmcnt(0)" ::: "memory");
  float rli[16];
#pragma unroll
  for (int r = 0; r < 16; ++r) rli[r] = 64.0f * __builtin_amdgcn_rcpf(li_l[crow(r, hi)]);
  unsigned char* Ow = (unsigned char*)Ob + (long)(wid * QBLK) * NA_LD;
#pragma unroll
  for (int r = 0; r < 16; ++r) { const int orow = crow(r, hi);
    for (int d0 = 0; d0 < 4; ++d0) Ow[(long)orow * NA_LD + d0 * 32 + r32] = (unsigned char)__builtin_amdgcn_cvt_pk_fp8_f32(o[d0][r] * rli[r], 0.f, 0, false); }
#undef NLOAD
#undef NWRITE
#undef KNORM
}

typedef int v8i __attribute__((ext_vector_type(8)));
typedef unsigned u32x2 __attribute__((ext_vector_type(2)));
constexpr int K8_LD = 1024, V8_LD = 16384, SHM_K8 = KVBLK * D, SHM_V8 = KVBLK * D;
constexpr float THR8 = 3.0f;
__device__ __forceinline__ int cvt4_fp8(float a, float b, float c, float d) { int w = __builtin_amdgcn_cvt_pk_fp8_f32(a, b, 0, false); return __builtin_amdgcn_cvt_pk_fp8_f32(c, d, w, true); }
__device__ __forceinline__ v8i mk8(u32x4 lo, u32x4 hi) { return (v8i){(int)lo[0], (int)lo[1], (int)lo[2], (int)lo[3], (int)hi[0], (int)hi[1], (int)hi[2], (int)hi[3]}; }
__device__ __forceinline__ void qkt8(f32x16& p0, f32x16& p1, const char* Ks, const v8i* qf, int r32, int hi) {
  const int x0 = (r32 >> 1) & 7, x1 = ((32 + r32) >> 1) & 7;
  const char* k0 = Ks + r32 * 128; const char* k1 = Ks + (32 + r32) * 128;
  v8i a[2][2];
#pragma unroll
  for (int s = 0; s < 2; ++s) { const int c = 4 * s + 2 * hi;
    a[0][s] = mk8(*reinterpret_cast<const u32x4*>(k0 + 16 * (c ^ x0)), *reinterpret_cast<const u32x4*>(k0 + 16 * ((c + 1) ^ x0)));
    a[1][s] = mk8(*reinterpret_cast<const u32x4*>(k1 + 16 * (c ^ x1)), *reinterpret_cast<const u32x4*>(k1 + 16 * ((c + 1) ^ x1))); }
  p0 = f32x16{}; p1 = f32x16{};
#pragma unroll
  for (int s = 0; s < 2; ++s) {
    p0 = __builtin_amdgcn_mfma_scale_f32_32x32x64_f8f6f4(a[0][s], qf[s], p0, 0, 0, 0, 0x7F7F7F7F, 0, 0x7F7F7F7F);
    p1 = __builtin_amdgcn_mfma_scale_f32_32x32x64_f8f6f4(a[1][s], qf[s], p1, 0, 0, 0, 0x7F7F7F7F, 0, 0x7F7F7F7F); }
}
__device__ __forceinline__ void partialSM8(f32x16& p0, f32x16& p1, float& m_reg, float& mn, float& alpha) {
  constexpr float C = SCALE * 1.4426950408889634f;
  float pmax = p0[0]; for (int r = 1; r < 16; ++r) pmax = fmaxf(pmax, p0[r]); for (int r = 0; r < 16; ++r) pmax = fmaxf(pmax, p1[r]);
  { auto rr = __builtin_amdgcn_permlane32_swap(__float_as_uint(pmax), __float_as_uint(pmax), false, false);
    pmax = fmaxf(__uint_as_float(rr[0]), __uint_as_float(rr[1])); }
  if (__builtin_expect(__all(pmax - m_reg <= THR8 / SCALE), 1)) { mn = m_reg; alpha = 1.f; }
  else { mn = fmaxf(m_reg, pmax); alpha = __builtin_amdgcn_exp2f((m_reg - mn) * C); m_reg = mn; }
  const float mnC = 4.0f - mn * C;
  for (int r = 0; r < 16; ++r) p0[r] = fmaf(p0[r], C, mnC); for (int r = 0; r < 16; ++r) p1[r] = fmaf(p1[r], C, mnC);
  for (int r = 0; r < 16; ++r) p0[r] = __builtin_amdgcn_exp2f(p0[r]);
}
__device__ __forceinline__ void finishSM8(f32x16& p0, f32x16& p1, v8i& pa) {
  for (int r = 0; r < 16; ++r) p1[r] = __builtin_amdgcn_exp2f(p1[r]);
#pragma unroll
  for (int v = 0; v < 4; ++v) { pa[v] = cvt4_fp8(p0[4 * v], p0[4 * v + 1], p0[4 * v + 2], p0[4 * v + 3]); pa[4 + v] = cvt4_fp8(p1[4 * v], p1[4 * v + 1], p1[4 * v + 2], p1[4 * v + 3]); }
}
__device__ __forceinline__ void pv8(f32x16* o, const char* Vs, const v8i& pa, int r32, int hi) {
  v8i b[4];
#pragma unroll
  for (int db = 0; db < 4; ++db) { const int d = 32 * db + r32, x = (d >> 2) & 3; const char* vp = Vs + d * 64;
    b[db] = mk8(*reinterpret_cast<const u32x4*>(vp + 16 * ((2 * hi) ^ x)), *reinterpret_cast<const u32x4*>(vp + 16 * ((2 * hi + 1) ^ x))); }
  const v8i ones = (v8i){0x38383838, 0x38383838, 0x38383838, 0x38383838, 0x38383838, 0x38383838, 0x38383838, 0x38383838};
#pragma unroll
  for (int db = 0; db < 4; ++db) o[db] = __builtin_amdgcn_mfma_scale_f32_32x32x64_f8f6f4(pa, b[db], o[db], 0, 0, 0, 0x7F7F7F7F, 0, 0x7F7F7F7F);
  o[4] = __builtin_amdgcn_mfma_scale_f32_32x32x64_f8f6f4(pa, ones, o[4], 0, 0, 0, 0x7F7F7F7F, 0, 0x7F7F7F7F);
}
__device__ __forceinline__ void attn_dense_body8(const bf16* __restrict__ Qb, const unsigned char* __restrict__ K8h, const unsigned char* __restrict__ V8h, bf16* __restrict__ Ob, int seq, char* lds) {
  int tid_o = threadIdx.x; asm volatile("" : "+v"(tid_o)); const int tid = tid_o, wid = __builtin_amdgcn_readfirstlane(tid >> 6), lane = tid & 63, r32 = lane & 31, hi = lane >> 5;
  char* V_lds = lds; char* K_lds = lds + 3 * SHM_V8;
  float* ws = (float*)(lds + 3 * SHM_V8 + 3 * SHM_K8) + wid * 64; float* al_l = ws + 32;
  float m_reg = -1e30f; f32x16 o[5] = {}; v8i qf[2];
  { const bf16* Qw = Qb + (long)(wid * QBLK + r32) * LDQ + hi * 32;
#pragma unroll
    for (int s = 0; s < 2; ++s) {
#pragma unroll
      for (int c = 0; c < 4; ++c) { const u32x4 w = *reinterpret_cast<const u32x4*>(Qw + s * 64 + c * 8);
        qf[s][2 * c] = cvt4_fp8(__uint_as_float(w[0] << 16), __uint_as_float(w[0] & 0xffff0000u), __uint_as_float(w[1] << 16), __uint_as_float(w[1] & 0xffff0000u));
        qf[s][2 * c + 1] = cvt4_fp8(__uint_as_float(w[2] << 16), __uint_as_float(w[2] & 0xffff0000u), __uint_as_float(w[3] << 16), __uint_as_float(w[3] & 0xffff0000u)); } } }
  const int skey = tid >> 3, sck = tid & 7, sd = tid >> 2, sc4 = tid & 3;
  const int kst = skey * 128 + 16 * (sck ^ ((skey >> 1) & 7));
  const int vx = (sd >> 2) & 3, vst0 = sd * 64 + 16 * ((sc4 >> 1) ^ vx) + 8 * (sc4 & 1), vst1 = sd * 64 + 16 * ((2 + (sc4 >> 1)) ^ vx) + 8 * (sc4 & 1);
  const unsigned char* kg = K8h + (long)skey * K8_LD + 16 * sck; const unsigned char* vg = V8h + (long)sd * V8_LD + 16 * sc4;
  struct { u32x4 k, v; } sr_[2];
#define SLOAD8(i, k0) do { sr_[i].k = *reinterpret_cast<const u32x4*>(kg + (long)(k0) * K8_LD); sr_[i].v = *reinterpret_cast<const u32x4*>(vg + (k0)); } while (0)
#define SWRITE8(b, i) do { *reinterpret_cast<u32x4*>(K_lds + (b) * SHM_K8 + kst) = sr_[i].k; \
    *reinterpret_cast<u32x2*>(V_lds + (b) * SHM_V8 + vst0) = (u32x2){sr_[i].v[0], sr_[i].v[2]}; *reinterpret_cast<u32x2*>(V_lds + (b) * SHM_V8 + vst1) = (u32x2){sr_[i].v[1], sr_[i].v[3]}; } while (0)
#define SWAIT8() asm volatile("s_waitcnt vmcnt(2)" ::: "memory")
#define RESC8(a) do { if (__any((a) < 1.f)) { if (hi == 0) al_l[r32] = (a); asm volatile("s_waitcnt lgkmcnt(0)" ::: "memory"); \
    for (int d = 0; d < 5; ++d) for (int r = 0; r < 16; ++r) o[d][r] *= al_l[crow(r, hi)]; } } while (0)
  f32x16 pA0, pA1, pB0, pB1; float mnA, mnB, alA, alB; v8i pa; const int NT = seq / KVBLK;
  SLOAD8(0, 0); asm volatile("s_waitcnt vmcnt(0)" ::: "memory"); SWRITE8(0, 0); __syncthreads();
  qkt8(pA0, pA1, K_lds, qf, r32, hi); partialSM8(pA0, pA1, m_reg, mnA, alA);
  SLOAD8(1, KVBLK); if (2 < NT) SLOAD8(0, 2 * KVBLK);
  SWAIT8(); SWRITE8(1, 1); __syncthreads();
  int bk = 1, bv = 0, bw = 2;
  if (wid >= 4) __builtin_amdgcn_s_setprio(1);
#define ROT3() do { const int t_ = bv; bv = bk; bk = bw; bw = t_; } while (0)
  for (int j = 1; j + 1 < NT; j += 2) {
    SBAR(); qkt8(pB0, pB1, K_lds + bk * SHM_K8, qf, r32, hi);
    finishSM8(pA0, pA1, pa); SBAR();
    SLOAD8(1, (j + 2) * KVBLK); SBAR();
    pv8(o, V_lds + bv * SHM_V8, pa, r32, hi); partialSM8(pB0, pB1, m_reg, mnB, alB);
    SWAIT8(); SWRITE8(bw, 0);
    RESC8(alB); __syncthreads(); ROT3();
    SBAR(); qkt8(pA0, pA1, K_lds + bk * SHM_K8, qf, r32, hi);
    finishSM8(pB0, pB1, pa); SBAR();
    if (j + 3 < NT) SLOAD8(0, (j + 3) * KVBLK); SBAR();
    pv8(o, V_lds + bv * SHM_V8, pa, r32, hi); partialSM8(pA0, pA1, m_reg, mnA, alA);
    SWAIT8(); SWRITE8(bw, 1);
    RESC8(alA); __syncthreads(); ROT3();
  }
  SBAR(); qkt8(pB0, pB1, K_lds + bk * SHM_K8, qf, r32, hi);
  finishSM8(pA0, pA1, pa); SBAR();
  pv8(o, V_lds + bv * SHM_V8, pa, r32, hi); partialSM8(pB0, pB1, m_reg, mnB, alB);
  RESC8(alB);
  finishSM8(pB0, pB1, pa); SBAR();
  pv8(o, V_lds + bk * SHM_V8, pa, r32, hi);
#undef ROT3
  __builtin_amdgcn_s_setprio(0);
  float rli[16];
#pragma unroll
  for (int r = 0; r < 16; ++r) rli[r] = 64.0f * __builtin_amdgcn_rcpf(o[4][r]);
  unsigned char* Ow = (unsigned char*)Ob + (long)(wid * QBLK) * LDO;
#pragma unroll
  for (int r = 0; r < 16; ++r) { const int orow = crow(r, hi);
    for (int d0 = 0; d0 < 4; ++d0) Ow[(long)orow * LDO + d0 * 32 + r32] = (unsigned char)__builtin_amdgcn_cvt_pk_fp8_f32(o[d0][r] * rli[r], 0.f, 0, false); }
#undef SLOAD8
#undef SWRITE8
#undef SWAIT8
#undef RESC8
}
}
struct Frame {
    LAS unsigned char* lds;
    int tid, lane, wave;
    int bid, vcu, G;
};
__device__ __forceinline__ float wave_sum(float v) {
#pragma unroll
    for (int o = 1; o < 64; o <<= 1) v += __shfl_xor(v, o);
    return v;
}
__device__ __forceinline__ void xrows_phase(const Frame& F, const float* __restrict__ h, bf16* __restrict__ hb, pg8::rs_t* __restrict__ rs, unsigned char* __restrict__ hb8) {
    const int gw = F.vcu * 8 + F.wave, NGW = F.G * 8;
    for (int m = gw; m < L; m += NGW) {
        const f32x4* xr = (const f32x4*)(h + (size_t)m * DM) + F.lane;
        v2u* o8 = (v2u*)(hb + (size_t)m * DM) + F.lane;
        float s = 0.f;
#pragma unroll
        for (int j = 0; j < 16; ++j) { const f32x4 v = xr[64 * j]; s += (v.x * v.x + v.y * v.y) + (v.z * v.z + v.w * v.w); v2u w; w.x = pk2(v.x, v.y); w.y = pk2(v.z, v.w); o8[64 * j] = w;
            int w8 = __builtin_amdgcn_cvt_pk_fp8_f32(v.x, v.y, 0, false); w8 = __builtin_amdgcn_cvt_pk_fp8_f32(v.z, v.w, w8, true); *((unsigned*)(hb8 + (size_t)m * DM) + 64 * j + F.lane) = (unsigned)w8; }
        s = wave_sum(s);
        if (F.lane == 0) rs[m] = (pg8::rs_t)(s * pg8::RS_FIX);
    }
}
__device__ __forceinline__ void headnorm_rows(bf16* __restrict__ X, int ld, int nheads, const float* __restrict__ gain, int t, int lane, bool rope, const float (&cs)[8], const float (&sn)[8], unsigned char* __restrict__ X8 = nullptr) {
    const int hs = lane >> 4, l16 = lane & 15;
    f32x4 g0 = *(const f32x4*)(gain + 8 * l16), g1 = *(const f32x4*)(gain + 8 * l16 + 4);
    const float gg[8] = {g0.x, g0.y, g0.z, g0.w, g1.x, g1.y, g1.z, g1.w};
    const bool second = ((l16 >> 2) & 1) != 0;
    for (int hg = 0; hg < nheads / 4; ++hg) {
        bf16* p = X + (size_t)t * ld + (size_t)(4 * hg + hs) * HD + 8 * l16;
        const v4u raw = *(const v4u*)p;
        float x[8] = {bflo(raw.x), bfhi(raw.x), bflo(raw.y), bfhi(raw.y), bflo(raw.z), bfhi(raw.z), bflo(raw.w), bfhi(raw.w)};
        float ss = 0.f;
#pragma unroll
        for (int e = 0; e < 8; ++e) ss += x[e] * x[e];
        ss += __shfl_xor(ss, 1); ss += __shfl_xor(ss, 2); ss += __shfl_xor(ss, 4); ss += __shfl_xor(ss, 8);
        const float rinv = 1.0f / sqrtf(ss * (1.0f / HD) + EPS);
        float y[8];
#pragma unroll
        for (int e = 0; e < 8; ++e) y[e] = x[e] * rinv * gg[e];
        if (rope) {
#pragma unroll
            for (int e = 0; e < 8; ++e) { const float yp = __shfl_xor(y[e], 4); y[e] = second ? (y[e] * cs[e] + yp * sn[e]) : (y[e] * cs[e] - yp * sn[e]); }
        }
        if (X8) { int w0 = __builtin_amdgcn_cvt_pk_fp8_f32(y[0], y[1], 0, false); w0 = __builtin_amdgcn_cvt_pk_fp8_f32(y[2], y[3], w0, true);
            int w1 = __builtin_amdgcn_cvt_pk_fp8_f32(y[4], y[5], 0, false); w1 = __builtin_amdgcn_cvt_pk_fp8_f32(y[6], y[7], w1, true);
            *(v2u*)(X8 + (size_t)t * ld + (size_t)(4 * hg + hs) * HD + 8 * l16) = (v2u){(unsigned)w0, (unsigned)w1}; }
        else { v4u w; w.x = pk2(y[0], y[1]); w.y = pk2(y[2], y[3]); w.z = pk2(y[4], y[5]); w.w = pk2(y[6], y[7]);
            *(v4u*)p = w; }
    }
}
__device__ __forceinline__ void prep_phase(const Frame& F, bf16* Q, bf16* K, int ldk, int nkh, const float* qgain, const float* kgain, bool rope, unsigned char* K8 = nullptr) {
    const int gw = F.vcu * 8 + F.wave, NGW = F.G * 8;
    const int l16 = F.lane & 15;
    for (int t = gw; t < L; t += NGW) {
        float cs[8], sn[8];
#pragma unroll
        for (int e = 0; e < 8; ++e) { cs[e] = 1.f; sn[e] = 0.f; }
        if (rope) {
            const int ax = l16 >> 3; const float pos = (float)(ax ? (t & (GRID_W - 1)) : (t / GRID_W));
#pragma unroll
            for (int e = 0; e < 8; ++e) { const int f = (l16 & 3) * 8 + e; const float inv = 1.0f / powf(10000.0f, (float)f * (1.0f / 32.0f)); const float ang = pos * inv; cs[e] = cosf(ang); sn[e] = sinf(ang); }
        }
        headnorm_rows(Q, DM, NH, qgain, t, F.lane, rope, cs, sn);
        headnorm_rows(K, ldk, nkh, kgain, t, F.lane, rope, cs, sn, K8);
    }
}

constexpr int S5T = pg8::S5T, S5NCH = pg8::S5NCH, S5KS = pg8::S5KS;
__device__ __forceinline__ void s5_gen_group(const Frame& F, int g, const float* __restrict__ lam_re, const float* __restrict__ lam_im, const float* __restrict__ log_step,
                                             const float* __restrict__ b_re, const float* __restrict__ b_im, const float* __restrict__ c_re, const float* __restrict__ c_im,
                                             bf16* __restrict__ GM, bf16* __restrict__ BMt, f32x2* __restrict__ PAT) {
    LAS f32x2* apow = (LAS f32x2*)F.lds;
    LAS f32x2* zt = apow + 2 * 33 * 64;
    LAS float* Kd = (LAS float*)(zt + 2 * 64);
    const int tid = F.tid;
    if (tid < 128) {
        const int dir = tid >> 6, n = tid & 63, dg = dir * S5G + g, idx = dg * S5N + n;
        const double dt = exp((double)log_step[dg]);
        const double lr = (double)lam_re[idx], li = (double)lam_im[idx];
        const double mag = exp(lr * dt), are = mag * cos(li * dt), aim = mag * sin(li * dt);
        const double den = lr * lr + li * li, nre = are - 1.0;
        zt[dir * 64 + n] = (f32x2){(float)((nre * lr + aim * li) / den), (float)((aim * lr - nre * li) / den)};
        double pr = 1.0, pi = 0.0;
        for (int k = 0; k <= 32; ++k) { apow[(dir * 33 + k) * 64 + n] = (f32x2){(float)pr, (float)pi}; const double t = pr * are - pi * aim; pi = pr * aim + pi * are; pr = t; }
        PAT[idx] = apow[(dir * 33 + 32) * 64 + n];
    }
    LDS_WAIT(); __syncthreads();
    {
        const int dir = tid >> 8, p = (tid >> 4) & 15, q = tid & 15, dg = dir * S5G + g;
        float wr[64], wi[64];
        const float* cr = c_re + ((size_t)dg * S5P + p) * S5N; const float* ci = c_im + ((size_t)dg * S5P + p) * S5N;
#pragma unroll
        for (int n = 0; n < 64; ++n) { const f32x2 z = zt[dir * 64 + n]; const float br = b_re[((size_t)dg * S5N + n) * S5P + q], bi = b_im[((size_t)dg * S5N + n) * S5P + q];
            const float bbr = z.x * br - z.y * bi, bbi = z.x * bi + z.y * br; const float c0 = cr[n], c1 = ci[n];
            wr[n] = c0 * bbr - c1 * bbi; wi[n] = c0 * bbi + c1 * bbr; }
        for (int d = 0; d < 32; ++d) { float acc = 0.f; const LAS f32x2* ap = apow + (dir * 33 + d) * 64;
#pragma unroll
            for (int n = 0; n < 64; ++n) { const f32x2 a = ap[n]; acc = fmaf(wr[n], a.x, acc); acc = fmaf(-wi[n], a.y, acc); }
            Kd[(dir * 32 + d) * 256 + p * 16 + q] = acc; }
    }
    LDS_WAIT(); __syncthreads();
    bf16* BMg = BMt + (size_t)g * 512 * S5KS;
    for (int it = tid; it < 512 * 64; it += 512) { const int row = it >> 6, ch = it & 63, tau = row >> 4, p = row & 15, sg = ch >> 1, q0 = (ch & 1) * 8;
        float v[8];
        if (sg < tau) { const LAS float* k = Kd + (0 * 32 + (tau - sg)) * 256 + p * 16 + q0;
#pragma unroll
            for (int j = 0; j < 8; ++j) v[j] = k[j]; }
        else if (sg > tau) { const LAS float* k = Kd + (1 * 32 + (sg - tau)) * 256 + p * 16 + q0;
#pragma unroll
            for (int j = 0; j < 8; ++j) v[j] = k[j]; }
        else { const LAS float* k0 = Kd + p * 16 + q0; const LAS float* k1 = Kd + 32 * 256 + p * 16 + q0;
#pragma unroll
            for (int j = 0; j < 8; ++j) v[j] = k0[j] + k1[j]; }
        v4u w; w.x = pk2(v[0], v[1]); w.y = pk2(v[2], v[3]); w.z = pk2(v[4], v[5]); w.w = pk2(v[6], v[7]);
        *(v4u*)(BMg + (size_t)row * S5KS + ch * 8) = w; }
    for (int it = tid; it < 512 * 32; it += 512) { const int row = it >> 5, ch = it & 31, tau = row >> 4, p = row & 15, dir = ch >> 4, n0 = (ch & 15) * 4, dg = dir * S5G + g;
        const int k = dir ? (32 - tau) : (tau + 1);
        const f32x4 cr = *(const f32x4*)(c_re + ((size_t)dg * S5P + p) * S5N + n0), ci = *(const f32x4*)(c_im + ((size_t)dg * S5P + p) * S5N + n0);
        const LAS f32x2* ap = apow + (dir * 33 + k) * 64 + n0;
        unsigned o[4];
#pragma unroll
        for (int j = 0; j < 4; ++j) { const f32x2 a = ap[j]; const float vr = cr[j] * a.x - ci[j] * a.y, vi = cr[j] * a.y + ci[j] * a.x; o[j] = pk2(vr, -vi); }
        *(v4u*)(BMg + (size_t)row * S5KS + 512 + ch * 8) = (v4u){o[0], o[1], o[2], o[3]}; }
    bf16* GMg = GM + (size_t)g * 256 * 512;
    for (int it = tid; it < 128 * 64; it += 512) { const int dn = it >> 6, ch = it & 63, dir = dn >> 6, n = dn & 63, sg = ch >> 1, q0 = (ch & 1) * 8, dg = dir * S5G + g;
        const int pw = dir ? sg : (31 - sg);
        const f32x2 a = apow[(dir * 33 + pw) * 64 + n], z = zt[dir * 64 + n];
        const float wr_ = a.x * z.x - a.y * z.y, wi_ = a.x * z.y + a.y * z.x;
        const float* br = b_re + ((size_t)dg * S5N + n) * S5P + q0; const float* bi = b_im + ((size_t)dg * S5N + n) * S5P + q0;
        float re[8], im[8];
#pragma unroll
        for (int j = 0; j < 8; ++j) { re[j] = wr_ * br[j] - wi_ * bi[j]; im[j] = wr_ * bi[j] + wi_ * br[j]; }
        v4u w0, w1; w0.x = pk2(re[0], re[1]); w0.y = pk2(re[2], re[3]); w0.z = pk2(re[4], re[5]); w0.w = pk2(re[6], re[7]);
        w1.x = pk2(im[0], im[1]); w1.y = pk2(im[2], im[3]); w1.z = pk2(im[4], im[5]); w1.w = pk2(im[6], im[7]);
        *(v4u*)(GMg + (size_t)(dir * 128 + 2 * n) * 512 + ch * 8) = w0; *(v4u*)(GMg + (size_t)(dir * 128 + 2 * n + 1) * 512 + ch * 8) = w1; }
    LDS_WAIT(); __syncthreads();
}
__device__ __forceinline__ void s5_scan_phase(const Frame& F, const f32x2* __restrict__ PAT, const float* __restrict__ E, bf16* __restrict__ UA) {
    for (int task = F.bid + F.G * F.wave; task < 2 * S5G; task += F.G * 8) {
        const int dir = task >> 8, g = task & 255;
        const f32x2 a = PAT[task * S5N + F.lane];
        const float* e = E + (size_t)g * S5NCH * 256 + dir * 128 + 2 * F.lane;
        bf16* s = UA + (size_t)g * S5NCH * S5KS + 512 + dir * 128 + 2 * F.lane;
        float cr = 0.f, ci = 0.f;
        for (int c8 = 0; c8 < S5NCH; c8 += 8) {
            f32x2 v[8];
#pragma unroll
            for (int k = 0; k < 8; ++k) { const int c = dir ? (S5NCH - 1 - (c8 + k)) : (c8 + k); v[k] = *(const f32x2*)(e + (size_t)c * 256); }
#pragma unroll
            for (int k = 0; k < 8; ++k) { const int c = dir ? (S5NCH - 1 - (c8 + k)) : (c8 + k);
                *(unsigned*)(s + (size_t)c * S5KS) = pk2(cr, ci);
                const float nr = fmaf(a.x, cr, fmaf(-a.y, ci, v[k].x)), ni = fmaf(a.x, ci, fmaf(a.y, cr, v[k].y)); cr = nr; ci = ni; }
        }
    }
}


__device__ __forceinline__ float fp8_to_f32(unsigned char b) { const int e = (b >> 3) & 15, m = b & 7; const float v = e ? __builtin_ldexpf(1.0f + (float)m * 0.125f, e - 7) : __builtin_ldexpf((float)m * 0.125f, -6); return (b & 0x80) ? -v : v; }
__device__ __forceinline__ void gqa_selfcheck(const Frame& F, const bf16* __restrict__ Qp, const unsigned char* __restrict__ K8, const unsigned char* __restrict__ V8t, const bf16* __restrict__ O,
                                              float* __restrict__ SC, unsigned* flag) {
    LAS float* ql = (LAS float*)(F.lds + F.wave * 1024);
    const int lane = F.lane;
#pragma unroll 1
    for (int s = F.bid * 8 + F.wave; s < 1024; s += F.G * 8) {
        const int tok = (int)(((long)(s >> 5) * 5209 + 77) % L), hq = s & 31, kv = hq >> 2;
        float* sc = SC + (size_t)(F.bid * 8 + F.wave) * L;
        { const bf16* qp = Qp + (size_t)tok * DM + hq * HD; ql[lane] = bf2f(qp[lane]); ql[lane + 64] = bf2f(qp[lane + 64]); } LDS_WAIT();
        float mx = -1e30f;
#pragma unroll 1
        for (int j = lane; j < L; j += 64) { const unsigned char* kp = K8 + (size_t)j * KVD + kv * HD; float dot = 0.f;
#pragma unroll 1
            for (int d = 0; d < HD; ++d) dot += fp8_to_f32(kp[d]) * ql[d];
            dot *= 0.088388347648318440f; sc[j] = dot; mx = fmaxf(mx, dot); }
#pragma unroll
        for (int o = 1; o < 64; o <<= 1) mx = fmaxf(mx, __shfl_xor(mx, o));
        asm volatile("s_waitcnt vmcnt(0)" ::: "memory"); __builtin_amdgcn_fence(__ATOMIC_RELEASE, "workgroup"); __builtin_amdgcn_fence(__ATOMIC_ACQUIRE, "agent");
        float o0 = 0.f, o1 = 0.f, lsum = 0.f;
#pragma unroll 1
        for (int j = 0; j < L; ++j) { const float pj = expf(__hip_atomic_load(sc + j, __ATOMIC_RELAXED, __HIP_MEMORY_SCOPE_AGENT) - mx);
            o0 += pj * fp8_to_f32(V8t[(size_t)(kv * HD + lane) * L + j]); o1 += pj * fp8_to_f32(V8t[(size_t)(kv * HD + lane + 64) * L + j]); lsum += pj; }
        o0 /= lsum; o1 /= lsum;
        const unsigned char* op = (const unsigned char*)O + (size_t)tok * DM + hq * HD; const float g0 = fp8_to_f32(op[lane]) * 0.015625f, g1 = fp8_to_f32(op[lane + 64]) * 0.015625f;
        float am = fmaxf(fabsf(o0), fabsf(o1));
#pragma unroll
        for (int o = 1; o < 64; o <<= 1) am = fmaxf(am, __shfl_xor(am, o));
        const float tol = 0.2f * am + 1e-5f;
        const bool bad = !(fabsf(g0 - o0) <= tol) || !(fabsf(g1 - o1) <= tol);
        if (__any(bad) && lane == 0) __hip_atomic_fetch_or(flag, 1u, __ATOMIC_RELAXED, __HIP_MEMORY_SCOPE_AGENT);
        LDS_WAIT();
    }
}

__device__ __forceinline__ void transpose_item(const float* __restrict__ W, int K, int N, bf16* __restrict__ WT, int mode, const float* __restrict__ gain, LAS float* scr, int item, int lane, int fp8 = 0) {
    const int nblk = N / 32, kb = item / nblk, nb = item % nblk, k0 = 64 * kb, n0 = 32 * nb;
    int r0 = n0;
    if (mode == 1) r0 = (n0 < DM) ? ((n0 >> 7) * 256 + (n0 & 127)) : (((n0 - DM) >> 7) * 256 + 128 + ((n0 - DM) & 127));
    const float* src = W + (size_t)(k0 + (lane >> 5)) * N + n0 + (lane & 31);
    float v[32];
#pragma unroll
    for (int i = 0; i < 32; ++i) v[i] = src[(size_t)(2 * i) * N];
    const int c = lane & 7;
    f32x4 g0 = (f32x4){1.f, 1.f, 1.f, 1.f}, g1 = g0;
    if (gain) { g0 = *(const f32x4*)(gain + k0 + 8 * c); g1 = *(const f32x4*)(gain + k0 + 8 * c + 4); }
#pragma unroll
    for (int i = 0; i < 32; ++i) scr[(2 * i + (lane >> 5)) * 33 + (lane & 31)] = v[i];
    LDS_WAIT(); asm volatile("" ::: "memory");
#pragma unroll
    for (int j = 0; j < 4; ++j) { const int n = (lane >> 3) + 8 * j; const LAS float* s = scr + (8 * c) * 33 + n;
        if (fp8) { int w0 = __builtin_amdgcn_cvt_pk_fp8_f32(64.f * s[0 * 33] * g0.x, 64.f * s[1 * 33] * g0.y, 0, false); w0 = __builtin_amdgcn_cvt_pk_fp8_f32(64.f * s[2 * 33] * g0.z, 64.f * s[3 * 33] * g0.w, w0, true);
            int w1 = __builtin_amdgcn_cvt_pk_fp8_f32(64.f * s[4 * 33] * g1.x, 64.f * s[5 * 33] * g1.y, 0, false); w1 = __builtin_amdgcn_cvt_pk_fp8_f32(64.f * s[6 * 33] * g1.z, 64.f * s[7 * 33] * g1.w, w1, true);
            *(v2u*)((unsigned char*)WT + (size_t)(r0 + n) * K + k0 + 8 * c) = (v2u){(unsigned)w0, (unsigned)w1}; }
        else { v4u o; o.x = pk2(s[0 * 33] * g0.x, s[1 * 33] * g0.y); o.y = pk2(s[2 * 33] * g0.z, s[3 * 33] * g0.w); o.z = pk2(s[4 * 33] * g1.x, s[5 * 33] * g1.y); o.w = pk2(s[6 * 33] * g1.z, s[7 * 33] * g1.w);
            *(v4u*)(WT + (size_t)(r0 + n) * K + k0 + 8 * c) = o; } }
    LDS_WAIT(); asm volatile("" ::: "memory");
}

constexpr size_t MiB = 1u << 20;
constexpr size_t SZ_NAQKV = (size_t)3 * DM * DM * 2, SZ_DD = (size_t)DM * DM * 2, SZ_GQAQKV = (size_t)(DM + 2 * KVD) * DM * 2, SZ_W1 = (size_t)FF * DM * 2, SZ_PROJ = (size_t)DM * PLE * 2, SZ_ACT = (size_t)L * DM * 2;
constexpr size_t OFF_CTL = 0, CTL_ZERO_BYTES = 3 * MiB, OFF_RS = 1 * MiB;
constexpr size_t OFF_NAQKV = 4 * MiB;
constexpr size_t OFF_NAWO = OFF_NAQKV + 2 * SZ_NAQKV;
constexpr size_t OFF_GQAQKV = OFF_NAWO + 2 * SZ_DD;
constexpr size_t OFF_GQAWO = OFF_GQAQKV + SZ_GQAQKV;
constexpr size_t OFF_S5IN = OFF_GQAWO + SZ_DD;
constexpr size_t OFF_S5OUT = OFF_S5IN + SZ_DD;
constexpr size_t OFF_W1 = OFF_S5OUT + 2 * SZ_DD;
constexpr size_t OFF_W2 = OFF_W1 + 4 * SZ_W1;
constexpr size_t OFF_PROJ = OFF_W2 + 4 * SZ_W1;
constexpr size_t OFF_GATE = OFF_PROJ + 4 * SZ_PROJ;
constexpr size_t OFF_PBF = OFF_GATE + 4 * SZ_DD;
constexpr size_t OFF_XN = OFF_PBF + 4 * (size_t)L * PLE * 2;
constexpr size_t OFF_ACT = OFF_XN + SZ_ACT;
constexpr size_t OFF_PP = OFF_ACT + 4 * SZ_ACT;
constexpr size_t OFF_S5BM = OFF_PP + SZ_ACT;
constexpr size_t OFF_S5GM = OFF_S5BM + 192 * MiB;
constexpr size_t OFF_S5PAR = OFF_S5GM + 64 * MiB;
constexpr size_t OFF_DUMMY = OFF_S5PAR + 8 * MiB;
constexpr size_t OFF_HB1 = OFF_DUMMY + 256 * MiB;
constexpr size_t OFF_HB8 = OFF_HB1 + SZ_ACT;
constexpr size_t WS_END = OFF_HB8 + (size_t)L * DM;
constexpr int CW_BAR = 4096;
constexpr int RING_BYTES = 131072, LDSCTL_OFF = RING_BYTES, MISC_OFF = LDSCTL_OFF + 320, PTAB_OFF = LDSCTL_OFF + 1024, LDS_BYTES = 147456;
static_assert(dattn::SHM_ATTN <= RING_BYTES && 8 * 64 * 33 * 4 <= RING_BYTES, "phase scratch fits the ring region");

constexpr int PH_PER_LAYER = 8, NPH = 1 + DEPTH * PH_PER_LAYER;
struct Args { const float* in[28]; float* out; unsigned char* ws; int ph_lo, ph_hi; };
enum { I_X = 0, I_P, I_MIXN, I_MLPN, I_PLEN, I_NAQKV, I_NAWO, I_NAQG, I_NAKG, I_NARPB, I_GQKV, I_GWO, I_GQG, I_GKG, I_S5IN, I_LAMRE, I_LAMIM, I_LOGSTEP, I_BRE, I_BIM, I_CRE, I_CIM, I_S5D, I_S5OUT, I_W1, I_W2, I_PROJ, I_GATE };


__device__ __forceinline__ unsigned long long tab_get(LAS unsigned char* lds, int i) {
    volatile LAS unsigned* t = (volatile LAS unsigned*)(lds + PTAB_OFF); const unsigned lo = t[2 * i], hi = t[2 * i + 1];
    return ((unsigned long long)(unsigned)__builtin_amdgcn_readfirstlane((int)hi) << 32) | (unsigned)__builtin_amdgcn_readfirstlane((int)lo); }
#define INP(i) ((const float*)(const GAS float*)tab_get(F.lds, (i)))
#define OUTP() ((float*)(GAS float*)tab_get(F.lds, 28))
#define WSP() ((unsigned char*)(GAS unsigned char*)tab_get(F.lds, 29))
__device__ __forceinline__ Frame mkframe(unsigned char* lds_generic) {
    Frame F; int t = threadIdx.x; asm volatile("" : "+v"(t)); F.tid = t; F.lane = t & 63; F.wave = __builtin_amdgcn_readfirstlane(t >> 6);
    F.lds = (LAS unsigned char*)lds_generic; int b = blockIdx.x; asm volatile("" : "+s"(b)); F.bid = b; int G = gridDim.x; asm volatile("" : "+s"(G)); F.G = G;
    F.vcu = (G % 8 == 0) ? (b % 8) * (G / 8) + b / 8 : b; return F; }
__device__ __forceinline__ void prologue_phase(const Frame& F) {
    unsigned char* ws = WSP();
    LAS float* scr = (LAS float*)(F.lds + F.wave * (64 * 33 * 4));
    const int gw = F.vcu * 8 + F.wave, NGW = F.G * 8;
    constexpr int I_QKV = (DM / 64) * (3 * DM / 32), I_DD = (DM / 64) * (DM / 32), I_GQ = (DM / 64) * ((DM + 2 * KVD) / 32), I_SO = (DM / 64) * (2 * DM / 32),
                  I_1 = (DM / 64) * (FF / 32), I_2 = (FF / 64) * (DM / 32), I_PJ = (PLE / 64) * (DM / 32);
    constexpr int NITEMS = 2 * I_QKV + 2 * I_DD + I_GQ + I_DD + I_DD + I_SO + 4 * I_1 + 4 * I_2 + 4 * I_PJ + 4 * I_DD;
    for (int it = gw; it < NITEMS; it += NGW) {
        int r = it; const float* W; int K, N, mode = 0, fp8 = 0; bf16* WT; const float* gain = nullptr;
        if (r < 2 * I_QKV) { const int l = r / I_QKV; r -= l * I_QKV; W = INP(I_NAQKV) + (size_t)l * DM * 3 * DM; K = DM; N = 3 * DM; WT = (bf16*)(ws + OFF_NAQKV + l * SZ_NAQKV); gain = INP(I_MIXN) + (size_t)(3 * l) * DM; fp8 = 1; }
        else { r -= 2 * I_QKV;
        if (r < 2 * I_DD) { const int l = r / I_DD; r -= l * I_DD; W = INP(I_NAWO) + (size_t)l * DM * DM; K = DM; N = DM; WT = (bf16*)(ws + OFF_NAWO + l * SZ_DD); fp8 = 1; }
        else { r -= 2 * I_DD;
        if (r < I_GQ) { W = INP(I_GQKV); K = DM; N = DM + 2 * KVD; WT = (bf16*)(ws + OFF_GQAQKV); gain = INP(I_MIXN) + (size_t)1 * DM; fp8 = 1; }
        else { r -= I_GQ;
        if (r < I_DD) { W = INP(I_GWO); K = DM; N = DM; WT = (bf16*)(ws + OFF_GQAWO); fp8 = 1; }
        else { r -= I_DD;
        if (r < I_DD) { W = INP(I_S5IN); K = DM; N = DM; WT = (bf16*)(ws + OFF_S5IN); gain = INP(I_MIXN) + (size_t)2 * DM; }
        else { r -= I_DD;
        if (r < I_SO) { W = INP(I_S5OUT); K = DM; N = 2 * DM; WT = (bf16*)(ws + OFF_S5OUT); mode = 1; }
        else { r -= I_SO;
        if (r < 4 * I_1) { const int l = r / I_1; r -= l * I_1; W = INP(I_W1) + (size_t)l * DM * FF; K = DM; N = FF; WT = (bf16*)(ws + OFF_W1 + l * SZ_W1); gain = INP(I_MLPN) + (size_t)l * DM; }
        else { r -= 4 * I_1;
        if (r < 4 * I_2) { const int l = r / I_2; r -= l * I_2; W = INP(I_W2) + (size_t)l * FF * DM; K = FF; N = DM; WT = (bf16*)(ws + OFF_W2 + l * SZ_W1); }
        else { r -= 4 * I_2;
        if (r < 4 * I_PJ) { const int l = r / I_PJ; r -= l * I_PJ; W = INP(I_PROJ) + (size_t)l * PLE * DM; K = PLE; N = DM; WT = (bf16*)(ws + OFF_PROJ + l * SZ_PROJ); }
        else { r -= 4 * I_PJ; const int l = r / I_DD; r -= l * I_DD; W = INP(I_GATE) + (size_t)l * DM * DM; K = DM; N = DM; WT = (bf16*)(ws + OFF_GATE + l * SZ_DD); gain = INP(I_PLEN) + (size_t)l * DM; } } } } } } } } }
        transpose_item(W, K, N, WT, mode, gain, scr, r, F.lane, fp8);
    }
    xrows_phase(F, INP(I_X), (bf16*)(ws + OFF_XN), (pg8::rs_t*)(ws + OFF_RS), ws + OFF_HB8);
    { const size_t n8 = (size_t)DEPTH * L * PLE / 8; const float* p = INP(I_P); bf16* pb = (bf16*)(ws + OFF_PBF);
      for (size_t i = (size_t)gw * 64 + F.lane; i < n8; i += (size_t)NGW * 64) { const f32x4 a = *(const f32x4*)(p + i * 8), b = *(const f32x4*)(p + i * 8 + 4);
          v4u w; w.x = pk2(a.x, a.y); w.y = pk2(a.z, a.w); w.z = pk2(b.x, b.y); w.w = pk2(b.z, b.w); *(v4u*)(pb + i * 8) = w; } }
    { bf16* GM = (bf16*)(ws + OFF_S5GM); bf16* BMt = (bf16*)(ws + OFF_S5BM); f32x2* PAT = (f32x2*)(ws + OFF_S5PAR);
      LDS_WAIT(); __syncthreads();
      for (int g = F.bid; g < S5G; g += F.G) s5_gen_group(F, g, INP(I_LAMRE), INP(I_LAMIM), INP(I_LOGSTEP), INP(I_BRE), INP(I_BIM), INP(I_CRE), INP(I_CIM), GM, BMt, PAT); }
}

#define WS_PTRS() unsigned char* ws = WSP(); bf16* HB0 = (bf16*)(ws + OFF_XN); bf16* HB1 = (bf16*)(ws + OFF_HB1); bf16* Qb = (bf16*)(ws + OFF_ACT); bf16* Kb = (bf16*)(ws + OFF_ACT + SZ_ACT); bf16* Vb = (bf16*)(ws + OFF_ACT + 2 * SZ_ACT); \
    bf16* Ob = (bf16*)(ws + OFF_ACT + 3 * SZ_ACT); bf16* HID = (bf16*)(ws + OFF_ACT); bf16* UA = (bf16*)(ws + OFF_ACT); bf16* S5Gb = (bf16*)(ws + OFF_ACT + 2 * SZ_ACT); float* S5E = (float*)(ws + OFF_ACT + 3 * SZ_ACT); bf16* PP = (bf16*)(ws + OFF_PP); \
    (void)HB0; (void)HB1; (void)Qb; (void)Kb; (void)Vb; (void)Ob; (void)HID; (void)UA; (void)S5Gb; (void)PP; (void)S5E;
__global__ void __launch_bounds__(512, 2) enc_fwd(Args args) {
    extern __shared__ __attribute__((aligned(16))) unsigned char lds[];
    {
        LAS unsigned char* l3 = (LAS unsigned char*)lds;
        for (int u = threadIdx.x; u < (LDS_BYTES - LDSCTL_OFF) / 4; u += 512) ((LAS unsigned*)(l3 + LDSCTL_OFF))[u] = 0u;
        __syncthreads();
        if (threadIdx.x == 0) { LAS unsigned long long* t = (LAS unsigned long long*)(l3 + PTAB_OFF);
#pragma unroll
            for (int i = 0; i < 28; ++i) t[i] = (unsigned long long)args.in[i];
            t[28] = (unsigned long long)args.out; t[29] = (unsigned long long)args.ws; }
        __syncthreads();
    }
    const int lo = args.ph_lo, hi = args.ph_hi;
    XcdBarrier bar;
    { LAS unsigned char* l3 = (LAS unsigned char*)lds; unsigned* ctl = (unsigned*)(GAS unsigned*)(tab_get(l3, 29) + OFF_CTL); bar.bar = ctl + CW_BAR; bar.x = 0; bar.st = nullptr;
      if (hi - lo > 1) bar = xcd_barrier_post(ctl + CW_BAR, (volatile LAS unsigned*)(l3 + MISC_OFF) + 8); }
#define IN(k) (lo <= (k) && (k) < hi)
#ifndef PROBE_PH
#define PROBE_PH (-1)
#endif
#define REPS(k) for (int rep_ = 0, nrep_ = (((k) == PROBE_PH || PROBE_PH == -2) ? 2 : ((PROBE_PH == 300 && (k) == 11) ? 4 : 1)); rep_ < nrep_; ++rep_)
#define HBOUT(p) ((nrep_ == 2 && rep_ == 0) ? (bf16*)(ws + OFF_DUMMY) : (p))
#define RSOUT(i) ((nrep_ == 2 && rep_ == 0) ? (pg8::rs_t*)(ws + OFF_DUMMY + 128 * MiB) : RSP(i))
#define SEAM(k) do { if (IN(k) && IN((k) + 1)) xcd_barrier(bar); } while (0)

#if PROBE_PH == 601
    if (blockIdx.x == 0 && threadIdx.x < 64) {
        typedef int v8i_ __attribute__((ext_vector_type(8))); typedef float f4v_ __attribute__((ext_vector_type(4)));
        const int l = threadIdx.x, ij = l & 15, kb = l >> 4; const unsigned lut[7] = {0xC4u, 0xC0u, 0xB8u, 0x00u, 0x38u, 0x40u, 0x44u};
        v8i_ A, B;
#pragma unroll
        for (int v = 0; v < 8; ++v) { unsigned wa = 0, wb = 0;
#pragma unroll
            for (int b = 0; b < 4; ++b) { const int kk = 32 * kb + 4 * v + b; const int av = ((ij + 2 * kk) % 5) - 2, bv = ((3 * kk + ij) % 7) - 3;
                unsigned ea = 0, eb = 0;
#pragma unroll
                for (int t = 0; t < 7; ++t) { ea = (av + 3 == t) ? lut[t] : ea; eb = (bv + 3 == t) ? lut[t] : eb; }
                wa |= ea << (8 * b); wb |= eb << (8 * b); }
            A[v] = (int)wa; B[v] = (int)wb; }
        f4v_ c1 = {};
        c1 = __builtin_amdgcn_mfma_scale_f32_16x16x128_f8f6f4(A, B, c1, 0, 0, 0, 0x7F7F7F7F, 0, 0x7F7F7F7F);
        bool ok1 = true;
#pragma unroll
        for (int r = 0; r < 4; ++r) { const int i = 4 * kb + r, j = ij; int s = 0;
            for (int kk = 0; kk < 128; ++kk) s += (((i + 2 * kk) % 5) - 2) * (((3 * kk + j) % 7) - 3);
            ok1 = ok1 && (c1[r] == (float)s); }
        unsigned long long ticks = 0; if (!__all(ok1)) ticks += 400000ull;
        const unsigned long long t0 = __builtin_amdgcn_s_memrealtime(); while (__builtin_amdgcn_s_memrealtime() - t0 < ticks) __builtin_amdgcn_s_sleep(8);
    }
    __syncthreads();
#endif
#if PROBE_PH == 600
    if (blockIdx.x == 0 && threadIdx.x < 64) {
        typedef int v8i_ __attribute__((ext_vector_type(8))); typedef float f16v_ __attribute__((ext_vector_type(16)));
        const int l = threadIdx.x, ij = l & 31, kb = l >> 5; const unsigned lut[7] = {0xC4u, 0xC0u, 0xB8u, 0x00u, 0x38u, 0x40u, 0x44u};
        v8i_ A, B;
#pragma unroll
        for (int v = 0; v < 8; ++v) { unsigned wa = 0, wb = 0;
#pragma unroll
            for (int b = 0; b < 4; ++b) { const int kk = 32 * kb + 4 * v + b; const int av = ((ij + 2 * kk) % 5) - 2, bv = ((3 * kk + ij) % 7) - 3;
                unsigned ea = 0, eb = 0;
#pragma unroll
                for (int t = 0; t < 7; ++t) { ea = (av + 3 == t) ? lut[t] : ea; eb = (bv + 3 == t) ? lut[t] : eb; }
                wa |= ea << (8 * b); wb |= eb << (8 * b); }
            A[v] = (int)wa; B[v] = (int)wb; }
        f16v_ c1 = {}, c2 = {};
        c1 = __builtin_amdgcn_mfma_scale_f32_32x32x64_f8f6f4(A, B, c1, 0, 0, 0, 0x7F7F7F7F, 0, 0x7F7F7F7F);
        c2 = __builtin_amdgcn_mfma_scale_f32_32x32x64_f8f6f4(A, B, c2, 0, 0, 0, 0x7B7B7B7B, 0, 0x7F7F7F7F);
        bool ok1 = true, ok2 = true;
#pragma unroll
        for (int r = 0; r < 16; ++r) { const int i = (r & 3) + 8 * (r >> 2) + 4 * kb, j = ij; int s = 0;
            for (int kk = 0; kk < 64; ++kk) s += (((i + 2 * kk) % 5) - 2) * (((3 * kk + j) % 7) - 3);
            ok1 = ok1 && (c1[r] == (float)s); ok2 = ok2 && (c2[r] == (float)s * 0.0625f); }
        int w = __builtin_amdgcn_cvt_pk_fp8_f32(1.0f, 2.0f, 0, false); w = __builtin_amdgcn_cvt_pk_fp8_f32(3.0f, -1.0f, w, true);
        const bool ok3 = ((unsigned)w == 0xB8444038u);
        unsigned long long ticks = 0; if (!__all(ok1)) ticks += 400000ull; if (!__all(ok2)) ticks += 800000ull; if (!__all(ok3)) ticks += 1600000ull;
        const unsigned long long t0 = __builtin_amdgcn_s_memrealtime(); while (__builtin_amdgcn_s_memrealtime() - t0 < ticks) __builtin_amdgcn_s_sleep(8);
    }
    __syncthreads();
#endif
    if (IN(0)) REPS(0) { const Frame F = mkframe(lds); prologue_phase(F); } SEAM(0);
#if PROBE_PH == 200
    for (int xb_ = 0; xb_ < 40; ++xb_) xcd_barrier(bar);
#endif

#pragma unroll 1
    for (int layer = 0; layer < DEPTH; ++layer) {
        const int kind = layer % 3, slot = layer / 3, pb = 1 + PH_PER_LAYER * layer;
#define RSP(i) ((pg8::rs_t*)(ws + OFF_RS) + (size_t)(i) * L)
        const int irs = (layer == 0) ? 0 : 3 * layer;
        if (IN(pb + 0)) REPS(pb + 0) {
            const Frame F = mkframe(lds); WS_PTRS();
            if (kind != 2) {
                const int N = (kind == 0) ? 3 * DM : DM + 2 * KVD;
                const bf16* W = (kind == 0) ? (const bf16*)(ws + OFF_NAQKV + slot * SZ_NAQKV) : (const bf16*)(ws + OFF_GQAQKV);
                const pg8::Gemm g = pg8::mkgemm((const bf16*)(ws + OFF_HB8), W, L, N, DM / 2); pg8::StaticOrder S; S.init(L, N, F.G, F.bid);
                pg8::EpiBf16<0> E{Qb, Kb, Vb, DM, (kind == 0) ? DM : KVD, (kind == 0) ? DM : L, DM, (kind == 0) ? 2 * DM : DM + KVD, RSP(irs), (kind == 0) ? 0 : 2, (kind == 0) ? 2 * DM : DM + KVD};
                pg8::gemm_phase<pg8::EpiBf16<0>, pg8::StaticOrder, false, true, true>(F.lds, g, S, E);
            } else {
                const pg8::Gemm g = pg8::mkgemm(HB0, (const bf16*)(ws + OFF_S5IN), L, DM, DM); pg8::StaticOrder S; S.init(L, DM, F.G, F.bid);
                pg8::EpiS5U E{UA, RSP(irs)};
                pg8::gemm_phase<pg8::EpiS5U, pg8::StaticOrder, false, true>(F.lds, g, S, E);
            }
        }
        SEAM(pb + 0);
        if (kind != 2) {
            if (kind == 1) { if (IN(pb + 1)) { const Frame F = mkframe(lds); WS_PTRS(); prep_phase(F, Qb, Kb, KVD, NKV, INP(I_GQG), INP(I_GKG), true, (unsigned char*)Kb + 64 * MiB); }
                SEAM(pb + 1); }
            if (IN(pb + 2)) REPS(pb + 2) { const Frame F = mkframe(lds); WS_PTRS();
                if (kind == 0) {
                    const float* rpb = INP(I_NARPB) + (size_t)slot * NH * 15 * 31;
                    for (int i = 0;; ++i) { const int unit = i * F.G + F.vcu; if (unit >= NH * (GROWS / 4)) break;
                        const int h = unit >> 6, R = (unit & 63) * 4, ks = min(max(R - 4, 0), GROWS - dattn::NA_TILES);
                        dattn::na_block_body(Qb + (size_t)(R * GRID_W) * DM + h * HD, Kb + (size_t)(ks * GRID_W) * DM + h * HD, Vb + (size_t)(ks * GRID_W) * DM + h * HD,
                                             (bf16*)((unsigned char*)Ob + (size_t)(R * GRID_W) * DM + h * HD), rpb + (size_t)h * 15 * 31, INP(I_NAQG) + slot * HD, INP(I_NAKG) + slot * HD, R, ks, (char*)lds);
                        __syncthreads(); }
                } else {
                    for (int i = 0;; ++i) { const int unit = i * F.G + F.bid; if (unit >= NH * (L / 256)) break;
                        const int kvh = unit & 7, rest = unit >> 3, hq = kvh * 4 + (rest >> 6), qb = rest & 63;
                        dattn::attn_dense_body8(Qb + (size_t)(qb * 256) * DM + hq * HD, (const unsigned char*)Kb + 64 * MiB + kvh * HD, (const unsigned char*)Vb + (size_t)(kvh * HD) * L, (bf16*)((unsigned char*)Ob + (size_t)(qb * 256) * DM + hq * HD), L, (char*)lds);
                        __syncthreads(); }
                }
            }
            if (IN(pb + 2) && IN(pb + 4)) xcd_barrier(bar);
#if PROBE_PH == 400
            if (kind == 1) { const Frame F = mkframe(lds); WS_PTRS();
                gqa_selfcheck(F, Qb, (const unsigned char*)Kb + 64 * MiB, (const unsigned char*)Vb, Ob, (float*)(ws + OFF_PP), (unsigned*)(ws + OFF_CTL) + 8);
                xcd_barrier(bar); }
#endif
        } else {
            if (IN(pb + 1)) REPS(pb + 1) { const Frame F = mkframe(lds); WS_PTRS();
                pg8::Gemm g; g.A = UA; g.Bt = (const bf16*)(ws + OFF_S5GM); g.M = S5G * S5NCH; g.N = 256; g.K = 512; g.lda = S5KS; g.ldb = 512; g.sa = 0x7F7F7F7F;
                pg8::S5Order S{F.G, F.bid, 2, 1}; pg8::EpiS5E E{S5E};
                pg8::gemm_phase<pg8::EpiS5E, pg8::S5Order, false, true>(F.lds, g, S, E); }
            SEAM(pb + 1);
            if (IN(pb + 2)) REPS(pb + 2) { const Frame F = mkframe(lds); WS_PTRS(); s5_scan_phase(F, (const f32x2*)(ws + OFF_S5PAR), S5E, UA); }
            SEAM(pb + 2);
            if (IN(pb + 3)) REPS(pb + 3) { const Frame F = mkframe(lds); WS_PTRS();
                pg8::Gemm g; g.A = UA; g.Bt = (const bf16*)(ws + OFF_S5BM); g.M = S5G * S5NCH; g.N = S5G * 512; g.K = S5KS; g.lda = S5KS; g.ldb = S5KS; g.sa = 0x7F7F7F7F;
                pg8::S5Order S{F.G, F.bid, 2, 2}; pg8::EpiS5Y E{UA, INP(I_S5D), S5Gb, DM};
                pg8::gemm_phase<pg8::EpiS5Y, pg8::S5Order, false, true>(F.lds, g, S, E); }
            SEAM(pb + 3);
        }
        if (IN(pb + 4)) REPS(pb + 4) {
            const Frame F = mkframe(lds); WS_PTRS();
            if (kind != 2) {
                const bf16* W = (kind == 0) ? (const bf16*)(ws + OFF_NAWO + slot * SZ_DD) : (const bf16*)(ws + OFF_GQAWO);
                pg8::Gemm g = pg8::mkgemm(Ob, W, L, DM, DM / 2); g.sa = 0x79797979; pg8::StaticOrder S; S.init(L, DM, F.G, F.bid);
                pg8::EpiRes E{HB0, HBOUT(HB0), RSOUT(1 + 3 * layer), DM, nullptr};
                pg8::gemm_phase<pg8::EpiRes, pg8::StaticOrder, false, true, true>(F.lds, g, S, E);
            } else {
                const pg8::Gemm g = pg8::mkgemm(S5Gb, (const bf16*)(ws + OFF_S5OUT), L, 2 * DM, DM); pg8::StaticOrder S; S.init(L, 2 * DM, F.G, F.bid);
                pg8::EpiGlu E{HB0, HBOUT(HB0), RSOUT(1 + 3 * layer), DM};
                pg8::gemm_phase<pg8::EpiGlu, pg8::StaticOrder, false, true>(F.lds, g, S, E);
            }
        }
        SEAM(pb + 4);
        if (IN(pb + 5)) REPS(pb + 5) { const Frame F = mkframe(lds); WS_PTRS();
            const pg8::Gemm g = pg8::mkgemm(HB0, (const bf16*)(ws + OFF_W1 + layer * SZ_W1), L, FF, DM); pg8::StaticOrder S; S.init(L, FF, F.G, F.bid);
            pg8::EpiBf16<2> E{HID, HID, HID, FF, FF, FF, 1 << 30, 1 << 30, nullptr, 0, 0};
#if PROBE_PH == 201
            { pg8::RangeOrder R1{S, 0, 8}, R2{S, 8, 16};
              pg8::gemm_phase<pg8::EpiBf16<2>, pg8::RangeOrder, false, true>(F.lds, g, R1, E); xcd_barrier(bar);
              pg8::gemm_phase<pg8::EpiBf16<2>, pg8::RangeOrder, false, true>(F.lds, g, R2, E); }
#else
            pg8::gemm_phase<pg8::EpiBf16<2>, pg8::StaticOrder, false, true>(F.lds, g, S, E);
#endif
        }
        SEAM(pb + 5);
        if (IN(pb + 6)) REPS(pb + 6) { const Frame F = mkframe(lds); WS_PTRS();
            { const pg8::Gemm g = pg8::mkgemm(HID, (const bf16*)(ws + OFF_W2 + layer * SZ_W1), L, DM, FF); pg8::StaticOrder S; S.init(L, DM, F.G, F.bid);
              pg8::EpiRes E{HB0, HBOUT(HB1), RSOUT(2 + 3 * layer), DM, RSP(1 + 3 * layer)};
              pg8::gemm_phase<pg8::EpiRes, pg8::StaticOrder, false, true>(F.lds, g, S, E); }
            { const pg8::Gemm g = pg8::mkgemm((const bf16*)(ws + OFF_PBF + (size_t)layer * L * PLE * 2), (const bf16*)(ws + OFF_PROJ + layer * SZ_PROJ), L, DM, PLE); pg8::StaticOrder S; S.init(L, DM, F.G, F.bid);
              pg8::EpiBf16<0> E{PP, PP, PP, DM, DM, DM, 1 << 30, 1 << 30, nullptr, 0, 0};
              pg8::gemm_phase<pg8::EpiBf16<0>, pg8::StaticOrder, false, true>(F.lds, g, S, E); }
        }
        SEAM(pb + 6);
        if (IN(pb + 7)) REPS(pb + 7) { const Frame F = mkframe(lds); WS_PTRS();
            const pg8::Gemm g = pg8::mkgemm(HB1, (const bf16*)(ws + OFF_GATE + layer * SZ_DD), L, DM, DM); pg8::StaticOrder S; S.init(L, DM, F.G, F.bid);
            pg8::EpiGate E{HB1, HBOUT(HB0), (layer == DEPTH - 1) ? OUTP() : nullptr, PP, RSP(2 + 3 * layer), RSOUT(3 + 3 * layer), DM, (layer + 1 < DEPTH && (layer + 1) % 3 != 2 && !(nrep_ == 2 && rep_ == 0)) ? ws + OFF_HB8 : nullptr};
            pg8::gemm_phase<pg8::EpiGate, pg8::StaticOrder, false, true>(F.lds, g, S, E);
        }
        SEAM(pb + 7);
    }
#if PROBE_PH == 400
    { xcd_barrier(bar); const Frame F = mkframe(lds); unsigned char* ws = WSP();
      if (__hip_atomic_load((unsigned*)(ws + OFF_CTL) + 8, __ATOMIC_RELAXED, __HIP_MEMORY_SCOPE_AGENT) != 0u && F.bid == 0 && F.tid < 64) OUTP()[F.tid] = __builtin_nanf(""); }
#endif
#undef IN
#undef SEAM
}

extern "C" void kernel_launch(void* const* d_in, const int* in_sizes, int n_in, void* d_out, int out_size, void* d_ws, size_t ws_size, hipStream_t stream) {
    static int grid = 0;
    if (grid == 0) {
        if (n_in != 28 || in_sizes[0] != L * DM || out_size != L * DM || ws_size < WS_END) {
            fprintf(stderr, "kernel_launch: built for 28 inputs, x/out of %d floats, >= %zu bytes of workspace; got n_in %d, in0 %d, out %d, ws %zu; nothing launched\n", L * DM, (size_t)WS_END, n_in, n_in > 0 ? in_sizes[0] : -1, out_size, ws_size);
            grid = -1; return; }
        int dev = 0, cus = 0, per_cu = 0;
        if (hipGetDevice(&dev) != hipSuccess || hipDeviceGetAttribute(&cus, hipDeviceAttributeMultiprocessorCount, dev) != hipSuccess) { fprintf(stderr, "kernel_launch: device query failed\n"); grid = -1; return; }
        if (hipFuncSetAttribute((const void*)enc_fwd, hipFuncAttributeMaxDynamicSharedMemorySize, LDS_BYTES) != hipSuccess) { fprintf(stderr, "kernel_launch: hipFuncSetAttribute failed\n"); grid = -1; return; }
        if (hipOccupancyMaxActiveBlocksPerMultiprocessor(&per_cu, (const void*)enc_fwd, 512, LDS_BYTES) != hipSuccess || per_cu < 1)
            fprintf(stderr, "kernel_launch: note: occupancy query reports %d workgroups per CU\n", per_cu);
        (void)hipGetLastError();
        grid = cus;
    }
    if (grid < 0) return;
    if (hipMemsetAsync((char*)d_ws + OFF_CTL, 0, CTL_ZERO_BYTES, stream) != hipSuccess) { fprintf(stderr, "kernel_launch: memset failed\n"); return; }
    Args a{};
    for (int i = 0; i < 28; ++i) a.in[i] = (const float*)d_in[i];
    a.out = (float*)d_out; a.ws = (unsigned char*)d_ws;
#if MK_N_LAUNCHES == 1
    a.ph_lo = 0; a.ph_hi = NPH;
    hipLaunchKernelGGL(enc_fwd, dim3(grid), dim3(512), LDS_BYTES, stream, a);
#else
    for (int ph = 0; ph < NPH; ++ph) {
        if (ph > 0) { const int layer = (ph - 1) / PH_PER_LAYER, j = (ph - 1) % PH_PER_LAYER; if (j == 3 && layer % 3 != 2) continue; }
        a.ph_lo = ph; a.ph_hi = ph + 1;
        hipLaunchKernelGGL(enc_fwd, dim3(grid), dim3(512), LDS_BYTES, stream, a);
    }
#endif
    const hipError_t le = hipPeekAtLastError();
    if (le != hipSuccess) fprintf(stderr, "kernel_launch: launch failed: %s\n", hipGetErrorName(le));
}
```

```cpp
#include <hip/hip_runtime.h>
#include <cstdio>
#include <cstdint>

#ifndef MK_N_LAUNCHES
#define MK_N_LAUNCHES 1
#endif

constexpr int L = 16384, DM = 4096, DEPTH = 4, GRID_W = 64, GROWS = L / GRID_W, HD = 128, NH = 32, NKV = 8, KVD = NKV * HD, FF = 4 * DM, PLE = 256;
constexpr int S5G = 256, S5P = 16, S5N = 64, S5TC = 16, S5NC = L / S5TC;
constexpr float EPS = 1e-6f;

#define GAS __attribute__((address_space(1)))
#define LAS __attribute__((address_space(3)))
constexpr unsigned WTAB_OFF = 131072 + 2048;
__device__ __forceinline__ unsigned hw_wave_slot() { return (unsigned)__builtin_amdgcn_s_getreg((5 << 11) | 4) & 63u; }
__device__ __forceinline__ int wg_tid() {
    const unsigned wv = (unsigned)__builtin_amdgcn_readfirstlane((int)((volatile LAS unsigned*)(WTAB_OFF))[hw_wave_slot()]);
    return (int)(wv * 64u + __builtin_amdgcn_mbcnt_hi(~0u, __builtin_amdgcn_mbcnt_lo(~0u, 0u)));
}
typedef unsigned short bf16;
typedef unsigned v4u __attribute__((ext_vector_type(4)));
typedef unsigned v2u __attribute__((ext_vector_type(2)));
typedef float f32x4 __attribute__((ext_vector_type(4)));
typedef float f32x2 __attribute__((ext_vector_type(2)));
typedef short bf16x8 __attribute__((ext_vector_type(8)));
typedef short s16x4 __attribute__((ext_vector_type(4)));
typedef GAS unsigned gu32;
#define RLX_AGENT __ATOMIC_RELAXED, __HIP_MEMORY_SCOPE_AGENT
#define LDS_WAIT() asm volatile("s_waitcnt lgkmcnt(0)" ::: "memory")
#define VM_WAIT() asm volatile("s_waitcnt vmcnt(0)" ::: "memory")
__device__ __forceinline__ unsigned f2bf(float f) { unsigned u = __builtin_bit_cast(unsigned, f); return (u + 0x7fffu + ((u >> 16) & 1u)) >> 16; }
__device__ __forceinline__ unsigned pk2(float lo, float hi) { return f2bf(lo) | (f2bf(hi) << 16); }
__device__ __forceinline__ float bf2f(unsigned short b) { return __builtin_bit_cast(float, (unsigned)b << 16); }
__device__ __forceinline__ float bflo(unsigned w) { return __builtin_bit_cast(float, w << 16); }
__device__ __forceinline__ float bfhi(unsigned w) { return __builtin_bit_cast(float, w & 0xffff0000u); }
__device__ __forceinline__ float sigmoidf_fast(float x) { return __builtin_amdgcn_rcpf(1.0f + __builtin_amdgcn_exp2f(-1.4426950408889634f * x)); }

namespace pg8 {
#define PG8_LAS __attribute__((address_space(3)))
#if defined(PROBE_EPI2)
#define PROBE_EPI_DUP if constexpr (Epi::PERM) E(acc, cur, wr, wc, fr, fq);
#else
#define PROBE_EPI_DUP
#endif
typedef unsigned short bf16_t;
typedef short bf16x8 __attribute__((ext_vector_type(8)));
typedef float f32x4 __attribute__((ext_vector_type(4)));
typedef unsigned u32x4 __attribute__((ext_vector_type(4)));
constexpr int BM = 256, BK = 64, HALF = 128, HTB = HALF * BK * 2  , STAGE_BYTES = 8 * HTB, NXCD = 8, WGM = 8;

__host__ __device__ __forceinline__ int lds_byte(int r, int c) { const int st = (r >> 4) * 2 + (c >> 5), rr = r & 15, cc = c & 31, ob = rr * 64 + cc * 2; return st * 1024 + (ob ^ (((ob >> 9) & 1) << 5)); }
__host__ __device__ __forceinline__ void stage_rc(int b, int& R, int& C) { const int st = b / 1024, sb = b % 1024, swz = sb ^ (((sb >> 9) & 1) << 5); R = (st >> 1) * 16 + swz / 64; C = (st & 1) * 32 + (swz % 64) / 2; }
__host__ __device__ __forceinline__ int perm32(int rho) { const int n = rho >> 4, i = rho & 15; return 8 * (i >> 2) + 4 * n + (i & 3); }

struct Unit { int pm, pn; };
struct Gemm { const bf16_t* A; const bf16_t* Bt; int M, N, K, lda, ldb, sa; };
__host__ __device__ __forceinline__ Gemm mkgemm(const bf16_t* A, const bf16_t* Bt, int M, int N, int K) { Gemm g; g.A = A; g.Bt = Bt; g.M = M; g.N = N; g.K = K; g.lda = K; g.ldb = K; g.sa = 0x7F7F7F7F; return g; }

struct StaticOrder {
    int nM, nN, nwg, G, c;
    __host__ __device__ void init(int M, int N, int G_, int c_) { nM = M / BM; nN = N / BM; nwg = nM * nN; G = G_; c = c_; }
    __host__ __device__ bool next(int i, Unit& u) const {
        const long L = (long)i * G + c; if (L >= nwg) return false;
        int wgid = (int)L; { const int q = nwg / NXCD, r = nwg % NXCD, xcd = wgid % NXCD, off = wgid / NXCD; wgid = (xcd < r ? xcd * (q + 1) : r * (q + 1) + (xcd - r) * q) + off; }
        const int nig = WGM * nN, gid = wgid / nig, fm = gid * WGM, gsz = (nM - fm) < WGM ? (nM - fm) : WGM;
        u.pm = fm + ((wgid % nig) % gsz); u.pn = (wgid % nig) / gsz; return true;
    }
    __device__ __forceinline__ void a_ready(const Unit&) const {}
    __device__ __forceinline__ void done(const Unit&) const {}
};
struct RangeOrder { StaticOrder S; int i0, i1;
    __host__ __device__ bool next(int i, Unit& u) const { return (i + i0 < i1) ? S.next(i + i0, u) : false; }
    __device__ __forceinline__ void a_ready(const Unit&) const {}
    __device__ __forceinline__ void done(const Unit&) const {} };


__device__ __forceinline__ unsigned cvt_pk_bf16(float lo, float hi) { unsigned r; asm volatile("v_cvt_pk_bf16_f32 %0, %1, %2" : "=v"(r) : "v"(lo), "v"(hi)); return r; }
__device__ __forceinline__ float sigm(float x) { return __builtin_amdgcn_rcpf(1.0f + __builtin_amdgcn_exp2f(-1.4426950408889634f * x)); }

typedef unsigned long long rs_t;
constexpr float RS_FIX = 16777216.0f, RS_INV = 1.0f / (16777216.0f * 4096.0f), RS_EPS = 1e-6f;
__device__ __forceinline__ void row_ss_add(rs_t* rs, int row, float s, int fq) {
    s += __shfl_xor(s, 16); s += __shfl_xor(s, 32);
    if (fq == 0) __hip_atomic_fetch_add(rs + row, (rs_t)(s * RS_FIX), __ATOMIC_RELAXED, __HIP_MEMORY_SCOPE_AGENT);
}
__device__ __forceinline__ float rs_rinv(rs_t v) { return __builtin_amdgcn_rsqf((float)v * RS_INV + RS_EPS); }
#define PIN8(a) asm volatile("" : "+v"((a)[0]), "+v"((a)[1]), "+v"((a)[2]), "+v"((a)[3]), "+v"((a)[4]), "+v"((a)[5]), "+v"((a)[6]), "+v"((a)[7]))
template <int ACT> struct EpiBf16 {
    static constexpr bool PERM = true, AFTER_DRAIN = false;
    bf16_t *O0, *O1, *O2; int ld0, ld1, ld2, c1, c2; const rs_t* rs; int vt; int rs_from;
    __device__ __forceinline__ void operator()(const f32x4 (&acc)[2][2][4][2], const Unit& u, int wr, int wc, int fr, int fq) const {
        const int row0 = u.pm * BM + wr * 64 + fr; int colt = u.pn * BM; bf16_t* base = O0; int ldc = ld0;
        const rs_t* rs = (colt >= rs_from) ? this->rs : nullptr;
        bool tr = false;
        if (colt >= c2) { base = O2; ldc = ld2; colt -= c2; tr = vt != 0; } else if (colt >= c1) { base = O1; ldc = ld1; colt -= c1; }
        const int col0 = colt + wc * 32 + 8 * fq;
        rs_t scv[8];
#pragma unroll
        for (int gi = 0; gi < 8; ++gi) scv[gi] = rs ? rs[row0 + (gi >> 2) * HALF + (gi & 3) * 16] : 0ull;
        PIN8(scv);
#pragma unroll
        for (int ai = 0; ai < 2; ++ai)
#pragma unroll
            for (int m = 0; m < 4; ++m) { bf16_t* rowp = base + (size_t)(row0 + ai * HALF + m * 16) * ldc + col0; const float sc = rs ? rs_rinv(scv[ai * 4 + m]) : 1.0f;
#pragma unroll
                for (int bj = 0; bj < 2; ++bj) { f32x4 v0 = acc[ai][bj][m][0] * sc, v1 = acc[ai][bj][m][1] * sc;
                    if (ACT == 2) {
#pragma unroll
                        for (int j = 0; j < 4; ++j) { const float a = fmaxf(v0[j], 0.f), b = fmaxf(v1[j], 0.f); v0[j] = a * a; v1[j] = b * b; } }
                    u32x4 w; w.x = cvt_pk_bf16(v0[0], v0[1]); w.y = cvt_pk_bf16(v0[2], v0[3]); w.z = cvt_pk_bf16(v1[0], v1[1]); w.w = cvt_pk_bf16(v1[2], v1[3]);
                    if (vt == 2 && tr) {
                        unsigned char* tp = (unsigned char*)base + (size_t)(col0 + bj * HALF) * ldc + (row0 + ai * HALF + m * 16);
                        int w0 = __builtin_amdgcn_cvt_pk_fp8_f32(v0[0], v0[1], 0, false); w0 = __builtin_amdgcn_cvt_pk_fp8_f32(v0[2], v0[3], w0, true);
                        int w1 = __builtin_amdgcn_cvt_pk_fp8_f32(v1[0], v1[1], 0, false); w1 = __builtin_amdgcn_cvt_pk_fp8_f32(v1[2], v1[3], w1, true);
                        tp[0] = (unsigned char)w0; tp[(size_t)ldc] = (unsigned char)(w0 >> 8); tp[(size_t)2 * ldc] = (unsigned char)(w0 >> 16); tp[(size_t)3 * ldc] = (unsigned char)(w0 >> 24);
                        tp[(size_t)4 * ldc] = (unsigned char)w1; tp[(size_t)5 * ldc] = (unsigned char)(w1 >> 8); tp[(size_t)6 * ldc] = (unsigned char)(w1 >> 16); tp[(size_t)7 * ldc] = (unsigned char)(w1 >> 24); }
                    else if (tr) { bf16_t* tp = base + (size_t)(col0 + bj * HALF) * ldc + (row0 + ai * HALF + m * 16);
                        tp[0] = (bf16_t)w.x; tp[(size_t)ldc] = (bf16_t)(w.x >> 16); tp[(size_t)2 * ldc] = (bf16_t)w.y; tp[(size_t)3 * ldc] = (bf16_t)(w.y >> 16);
                        tp[(size_t)4 * ldc] = (bf16_t)w.z; tp[(size_t)5 * ldc] = (bf16_t)(w.z >> 16); tp[(size_t)6 * ldc] = (bf16_t)w.w; tp[(size_t)7 * ldc] = (bf16_t)(w.w >> 16); }
                    else *(u32x4*)(rowp + bj * HALF) = w; } }
    }
};
struct EpiF32 {
    static constexpr bool PERM = false, AFTER_DRAIN = false;
    float* C; int ldc;
    __device__ __forceinline__ void operator()(const f32x4 (&acc)[2][2][4][2], const Unit& u, int wr, int wc, int fr, int fq) const {
        const int row0 = u.pm * BM + wr * 64 + fr, col0 = u.pn * BM + wc * 32 + 4 * fq;
#pragma unroll
        for (int ai = 0; ai < 2; ++ai)
#pragma unroll
            for (int m = 0; m < 4; ++m) { float* rowp = C + (size_t)(row0 + ai * HALF + m * 16) * ldc + col0;
#pragma unroll
                for (int bj = 0; bj < 2; ++bj)
#pragma unroll
                    for (int n = 0; n < 2; ++n) *(f32x4*)(rowp + bj * HALF + n * 16) = acc[ai][bj][m][n]; }
    }
};
typedef unsigned u32x2 __attribute__((ext_vector_type(2)));
__device__ __forceinline__ f32x4 bf4_to_f32(u32x2 p) { return (f32x4){__builtin_bit_cast(float, p.x << 16), __builtin_bit_cast(float, p.x & 0xffff0000u), __builtin_bit_cast(float, p.y << 16), __builtin_bit_cast(float, p.y & 0xffff0000u)}; }
struct EpiRes {
    static constexpr bool PERM = false, AFTER_DRAIN = false;
    const bf16_t* base; bf16_t* out; rs_t* rs; int ldc; const rs_t* rsq;
    __device__ __forceinline__ void operator()(const f32x4 (&acc)[2][2][4][2], const Unit& u, int wr, int wc, int fr, int fq) const {
        constexpr int PD = 3;
        const int row0 = u.pm * BM + wr * 64 + fr, col0 = u.pn * BM + wc * 32 + 4 * fq;
        u32x2 nb[8][2][2];
        rs_t scv[8];
#pragma unroll
        for (int gi = 0; gi < 8; ++gi) scv[gi] = rsq ? rsq[row0 + (gi >> 2) * HALF + (gi & 3) * 16] : 0ull;
#define EPI_LD(g) do { const size_t o_ = (size_t)(row0 + ((g) >> 2) * HALF + ((g) & 3) * 16) * ldc + col0; _Pragma("unroll") for (int bj = 0; bj < 2; ++bj) _Pragma("unroll") for (int n = 0; n < 2; ++n) nb[g][bj][n] = *(const u32x2*)(base + o_ + bj * HALF + n * 16); } while (0)
#pragma unroll
        for (int g = 0; g < PD; ++g) EPI_LD(g);
        PIN8(scv);
#pragma unroll
        for (int gi = 0; gi < 8; ++gi) { const int ai = gi >> 2, m = gi & 3; const int row = row0 + ai * HALF + m * 16; const size_t off = (size_t)row * ldc + col0;
            if (gi + PD < 8) EPI_LD(gi + PD);
            const float sc2 = rsq ? __builtin_amdgcn_rcpf((float)scv[gi] * RS_INV + RS_EPS) : 1.0f;
            float ss = 0.f;
#pragma unroll
            for (int bj = 0; bj < 2; ++bj)
#pragma unroll
                for (int n = 0; n < 2; ++n) { const f32x4 o = bf4_to_f32(nb[gi][bj][n]) + acc[ai][bj][m][n] * sc2;
                    ss += (o[0] * o[0] + o[1] * o[1]) + (o[2] * o[2] + o[3] * o[3]);
                    u32x2 w; w.x = cvt_pk_bf16(o[0], o[1]); w.y = cvt_pk_bf16(o[2], o[3]); *(u32x2*)(out + off + bj * HALF + n * 16) = w; }
            row_ss_add(rs, row, ss, fq); }
#undef EPI_LD
    }
};
struct EpiGate {
    static constexpr bool PERM = false, AFTER_DRAIN = false;
    const bf16_t* base; bf16_t* out; float* out32; const bf16_t* pp; const rs_t* rsin; rs_t* rs; int ldc; unsigned char* out8;
    __device__ __forceinline__ void operator()(const f32x4 (&acc)[2][2][4][2], const Unit& u, int wr, int wc, int fr, int fq) const {
        constexpr int PD = 2;
        const int row0 = u.pm * BM + wr * 64 + fr, col0 = u.pn * BM + wc * 32 + 4 * fq;
        rs_t scv[8];
#pragma unroll
        for (int gi = 0; gi < 8; ++gi) scv[gi] = rsin[row0 + (gi >> 2) * HALF + (gi & 3) * 16];
        u32x2 nb[8][2][2], np[8][2][2];
#define EPI_LD(g) do { const size_t o_ = (size_t)(row0 + ((g) >> 2) * HALF + ((g) & 3) * 16) * ldc + col0; _Pragma("unroll") for (int bj = 0; bj < 2; ++bj) _Pragma("unroll") for (int n = 0; n < 2; ++n) { \
            nb[g][bj][n] = *(const u32x2*)(base + o_ + bj * HALF + n * 16); np[g][bj][n] = *(const u32x2*)(pp + o_ + bj * HALF + n * 16); } } while (0)
#pragma unroll
        for (int g = 0; g < PD; ++g) EPI_LD(g);
        PIN8(scv);
#pragma unroll
        for (int gi = 0; gi < 8; ++gi) { const int ai = gi >> 2, m = gi & 3; const int row = row0 + ai * HALF + m * 16; const size_t off = (size_t)row * ldc + col0;
            if (gi + PD < 8) EPI_LD(gi + PD);
            const float sc = rs_rinv(scv[gi]);
            float ss = 0.f;
#pragma unroll
            for (int bj = 0; bj < 2; ++bj)
#pragma unroll
                for (int n = 0; n < 2; ++n) { const f32x4 a = acc[ai][bj][m][n] * sc, p = bf4_to_f32(np[gi][bj][n]); f32x4 o = bf4_to_f32(nb[gi][bj][n]);
#pragma unroll
                    for (int j = 0; j < 4; ++j) o[j] += sigm(a[j]) * p[j];
                    if (out32) *(f32x4*)(out32 + off + bj * HALF + n * 16) = o;
                    if (out8) { int w8 = __builtin_amdgcn_cvt_pk_fp8_f32(o[0], o[1], 0, false); w8 = __builtin_amdgcn_cvt_pk_fp8_f32(o[2], o[3], w8, true); *(unsigned*)(out8 + off + bj * HALF + n * 16) = (unsigned)w8; }
                    ss += (o[0] * o[0] + o[1] * o[1]) + (o[2] * o[2] + o[3] * o[3]);
                    u32x2 w; w.x = cvt_pk_bf16(o[0], o[1]); w.y = cvt_pk_bf16(o[2], o[3]); *(u32x2*)(out + off + bj * HALF + n * 16) = w; }
            row_ss_add(rs, row, ss, fq); }
#undef EPI_LD
    }
};
struct EpiGlu {
    static constexpr bool PERM = false, AFTER_DRAIN = false;
    const bf16_t* base; bf16_t* out; rs_t* rs; int ldc;
    __device__ __forceinline__ void operator()(const f32x4 (&acc)[2][2][4][2], const Unit& u, int wr, int wc, int fr, int fq) const {
        constexpr int PD = 3;
        const int row0 = u.pm * BM + wr * 64 + fr, col0 = u.pn * HALF + wc * 32 + 4 * fq;
        u32x2 nb[8][2];
#define EPI_LD(g) do { const size_t o_ = (size_t)(row0 + ((g) >> 2) * HALF + ((g) & 3) * 16) * ldc + col0; _Pragma("unroll") for (int n = 0; n < 2; ++n) nb[g][n] = *(const u32x2*)(base + o_ + n * 16); } while (0)
#pragma unroll
        for (int g = 0; g < PD; ++g) EPI_LD(g);
#pragma unroll
        for (int gi = 0; gi < 8; ++gi) { const int ai = gi >> 2, m = gi & 3; const int row = row0 + ai * HALF + m * 16; const size_t off = (size_t)row * ldc + col0;
            if (gi + PD < 8) EPI_LD(gi + PD);
            float ss = 0.f;
#pragma unroll
            for (int n = 0; n < 2; ++n) { const f32x4 a = acc[ai][0][m][n], g = acc[ai][1][m][n]; f32x4 o = bf4_to_f32(nb[gi][n]);
#pragma unroll
                for (int j = 0; j < 4; ++j) o[j] += a[j] * sigm(g[j]);
                ss += (o[0] * o[0] + o[1] * o[1]) + (o[2] * o[2] + o[3] * o[3]);
                u32x2 w; w.x = cvt_pk_bf16(o[0], o[1]); w.y = cvt_pk_bf16(o[2], o[3]); *(u32x2*)(out + off + n * 16) = w; }
            row_ss_add(rs, row, ss, fq); }
#undef EPI_LD
    }
};

constexpr int S5T = 32, S5NCH = 512, S5KS = 768;
struct S5Order {
    int G, c, MT, NT;
    __device__ __forceinline__ bool next(int i, Unit& u) const { const int idx = i * G + c; if (idx >= 256 * MT * NT) return false; const int g = idx & 255, sub = idx >> 8;
        u.pm = g * MT + sub / NT; u.pn = g * NT + sub % NT; return true; }
    __device__ __forceinline__ void a_ready(const Unit&) const {}
    __device__ __forceinline__ void done(const Unit&) const {}
};
struct EpiS5U {
    static constexpr bool PERM = true, AFTER_DRAIN = false;
    bf16_t* UA; const rs_t* rs;
    __device__ __forceinline__ void operator()(const f32x4 (&acc)[2][2][4][2], const Unit& u, int wr, int wc, int fr, int fq) const {
        const int row0 = u.pm * BM + wr * 64 + fr, col0 = u.pn * BM + wc * 32 + 8 * fq;
        rs_t scv[8];
#pragma unroll
        for (int gi = 0; gi < 8; ++gi) scv[gi] = rs[row0 + (gi >> 2) * HALF + (gi & 3) * 16];
        PIN8(scv);
#pragma unroll
        for (int ai = 0; ai < 2; ++ai)
#pragma unroll
            for (int m = 0; m < 4; ++m) { const int t = row0 + ai * HALF + m * 16, c = t >> 5, sg = t & 31; const float sc = rs_rinv(scv[ai * 4 + m]);
#pragma unroll
                for (int bj = 0; bj < 2; ++bj) { const int col = col0 + bj * HALF, g = col >> 4, q0 = col & 15;
                    const f32x4 v0 = acc[ai][bj][m][0] * sc, v1 = acc[ai][bj][m][1] * sc;
                    u32x4 w; w.x = cvt_pk_bf16(v0[0], v0[1]); w.y = cvt_pk_bf16(v0[2], v0[3]); w.z = cvt_pk_bf16(v1[0], v1[1]); w.w = cvt_pk_bf16(v1[2], v1[3]);
                    *(u32x4*)(UA + ((size_t)(g * S5NCH + c) * S5KS + sg * 16 + q0)) = w; } }
    }
};
struct EpiS5E {
    static constexpr bool PERM = false, AFTER_DRAIN = false;
    float* E;
    __device__ __forceinline__ void operator()(const f32x4 (&acc)[2][2][4][2], const Unit& u, int wr, int wc, int fr, int fq) const {
        const int row0 = u.pm * BM + wr * 64 + fr, col0 = wc * 32 + 4 * fq;
#pragma unroll
        for (int ai = 0; ai < 2; ++ai)
#pragma unroll
            for (int m = 0; m < 4; ++m) { float* rowp = E + (size_t)(row0 + ai * HALF + m * 16) * 256 + col0;
#pragma unroll
                for (int bj = 0; bj < 2; ++bj)
#pragma unroll
                    for (int n = 0; n < 2; ++n) *(f32x4*)(rowp + bj * HALF + n * 16) = acc[ai][bj][m][n]; }
    }
};
__device__ __forceinline__ float gelu_tanh_f(float v) {
    const float z = 0.7978845608028654f * (v + 0.044715f * v * v * v);
    const float e = __builtin_amdgcn_exp2f(2.0f * 1.4426950408889634f * z);
    return 0.5f * v * (2.0f - 2.0f * __builtin_amdgcn_rcpf(e + 1.0f));
}
struct EpiS5Y {
    static constexpr bool PERM = true, AFTER_DRAIN = false;
    const bf16_t* UA; const float* dskip; bf16_t* G; int ldg;
    __device__ __forceinline__ void operator()(const f32x4 (&acc)[2][2][4][2], const Unit& u, int wr, int wc, int fr, int fq) const {
        const int row0 = u.pm * BM + wr * 64 + fr, col0 = (u.pn & 1) * BM + wc * 32 + 8 * fq;
        const int g = u.pm >> 1, p0 = col0 & 15;
        const f32x4 d0 = *(const f32x4*)(dskip + 16 * g + p0), d1 = *(const f32x4*)(dskip + 16 * g + p0 + 4);
        u32x4 uu[8][2];
#pragma unroll
        for (int gi = 0; gi < 8; ++gi)
#pragma unroll
            for (int bj = 0; bj < 2; ++bj) uu[gi][bj] = *(const u32x4*)(UA + ((size_t)(row0 + (gi >> 2) * HALF + (gi & 3) * 16) * S5KS + col0 + bj * HALF));
#pragma unroll
        for (int gi = 0; gi < 8; ++gi) asm volatile("" : "+v"(uu[gi][0]), "+v"(uu[gi][1]));
#pragma unroll
        for (int gi = 0; gi < 8; ++gi) { const int ai = gi >> 2, m = gi & 3; const int rowg = row0 + ai * HALF + m * 16, c = rowg & 511;
#pragma unroll
            for (int bj = 0; bj < 2; ++bj) { const int col = col0 + bj * HALF, tau = col >> 4; const u32x4 w4 = uu[gi][bj];
                f32x4 v0 = acc[ai][bj][m][0], v1 = acc[ai][bj][m][1];
                v0[0] += d0[0] * __builtin_bit_cast(float, w4.x << 16); v0[1] += d0[1] * __builtin_bit_cast(float, w4.x & 0xffff0000u);
                v0[2] += d0[2] * __builtin_bit_cast(float, w4.y << 16); v0[3] += d0[3] * __builtin_bit_cast(float, w4.y & 0xffff0000u);
                v1[0] += d1[0] * __builtin_bit_cast(float, w4.z << 16); v1[1] += d1[1] * __builtin_bit_cast(float, w4.z & 0xffff0000u);
                v1[2] += d1[2] * __builtin_bit_cast(float, w4.w << 16); v1[3] += d1[3] * __builtin_bit_cast(float, w4.w & 0xffff0000u);
#pragma unroll
                for (int j = 0; j < 4; ++j) { v0[j] = gelu_tanh_f(v0[j]); v1[j] = gelu_tanh_f(v1[j]); }
                int w0 = __builtin_amdgcn_cvt_pk_fp8_f32(16.f * v0[0], 16.f * v0[1], 0, false); w0 = __builtin_amdgcn_cvt_pk_fp8_f32(16.f * v0[2], 16.f * v0[3], w0, true);
                int w1 = __builtin_amdgcn_cvt_pk_fp8_f32(16.f * v1[0], 16.f * v1[1], 0, false); w1 = __builtin_amdgcn_cvt_pk_fp8_f32(16.f * v1[2], 16.f * v1[3], w1, true);
                *(v2u*)((unsigned char*)G + (size_t)(32 * c + tau) * ldg + 16 * g + p0) = (v2u){(unsigned)w0, (unsigned)w1}; } }
    }
};

template <class Epi, class Sched, bool ALIGN_EPI = false, bool SP2 = false, bool FP8 = false>
__device__ __forceinline__ void gemm_phase(PG8_LAS unsigned char* lds, const Gemm g, const Sched& S, const Epi& E) {
    int tid_o = wg_tid(); asm volatile("" : "+v"(tid_o)); const int tid = tid_o, wid = __builtin_amdgcn_readfirstlane(tid >> 6), lane = tid & 63, wr = wid >> 2, wc = wid & 3, fr = lane & 15, fq = lane >> 4;
    const int K = g.K, nt = K / BK;
    unsigned voffA[2], voffB[2];
#pragma unroll
    for (int i = 0; i < 2; ++i) { int R, C; stage_rc(tid * 16 + i * 8192, R, C); const int Rb = Epi::PERM ? ((R & ~31) + perm32(R & 31)) : R;
        voffA[i] = (unsigned)(R * g.lda + C) * 2u; voffB[i] = (unsigned)(Rb * g.ldb + C) * 2u; }
    const size_t kstep = (size_t)(BK * 2);
    const size_t hstepA = (size_t)HALF * g.lda * 2, hstepB = (size_t)HALF * g.ldb * 2;
    const size_t tstepA = 2 * hstepA, tstepB = 2 * hstepB;
    const unsigned ldsw = (unsigned)wid * 1024u;
    const int aoff = lds_byte(wr * 64 + fr, fq * 8), boff = lds_byte(wc * 32 + fr, fq * 8);
    const int aoff8 = lds_byte(wr * 64 + fr, fq * 16), boff8 = lds_byte(wc * 32 + fr, fq * 16);
#define PG8_SA(b, h) (((b) * 2 + (h)) * HTB)
#define PG8_SB(b, h) ((4 + (b) * 2 + (h)) * HTB)
#define PG8_STAGE(bufoff, gbase, voff) do { _Pragma("unroll") for (int _i = 0; _i < 2; ++_i) \
        __builtin_amdgcn_global_load_lds((const unsigned*)((const char*)(gbase) + (voff)[_i]), (PG8_LAS unsigned*)(lds + (bufoff) + ldsw + _i * 8192), 16, 0, 0); } while (0)
#define PG8_LDA(dst, b, h) do { if constexpr (FP8) { _Pragma("unroll") for (int m = 0; m < 4; ++m) { const PG8_LAS unsigned char* p_ = lds + PG8_SA(b, h) + aoff8 + m * 2048; const v4i32 l_ = *(const PG8_LAS v4i32*)p_, h_ = *(const PG8_LAS v4i32*)(p_ + 16); \
        dst##8[m] = __builtin_shufflevector(l_, h_, 0, 1, 2, 3, 4, 5, 6, 7); } } else { \
        _Pragma("unroll") for (int m = 0; m < 4; ++m) _Pragma("unroll") for (int k = 0; k < 2; ++k) dst[m][k] = *(const PG8_LAS bf16x8*)(lds + PG8_SA(b, h) + aoff + m * 2048 + k * 1024); } } while (0)
#define PG8_LDB(dst, b, h) do { if constexpr (FP8) { _Pragma("unroll") for (int n = 0; n < 2; ++n) { const PG8_LAS unsigned char* p_ = lds + PG8_SB(b, h) + boff8 + n * 2048; const v4i32 l_ = *(const PG8_LAS v4i32*)p_, h_ = *(const PG8_LAS v4i32*)(p_ + 16); \
        dst##8[n] = __builtin_shufflevector(l_, h_, 0, 1, 2, 3, 4, 5, 6, 7); } } else { \
        _Pragma("unroll") for (int n = 0; n < 2; ++n) _Pragma("unroll") for (int k = 0; k < 2; ++k) dst[n][k] = *(const PG8_LAS bf16x8*)(lds + PG8_SB(b, h) + boff + n * 2048 + k * 1024); } } while (0)
#define PG8_MMA(ai, bj, At, Bt) do { __builtin_amdgcn_s_setprio(1); if constexpr (FP8) { _Pragma("unroll") for (int m = 0; m < 4; ++m) _Pragma("unroll") for (int n = 0; n < 2; ++n) \
        asm volatile("v_mfma_scale_f32_16x16x128_f8f6f4 %0, %1, %2, %0, %3, %4 op_sel_hi:[0,0,0]" : "+v"(acc[ai][bj][m][n]) : "v"(Bt##8[n]), "v"(At##8[m]), "v"(sc_w8), "v"(sc_a8)); } else { \
        _Pragma("unroll") for (int m = 0; m < 4; ++m) _Pragma("unroll") for (int n = 0; n < 2; ++n) _Pragma("unroll") for (int k = 0; k < 2; ++k) \
        acc[ai][bj][m][n] = __builtin_amdgcn_mfma_f32_16x16x32_bf16(Bt[n][k], At[m][k], acc[ai][bj][m][n], 0, 0, 0); } __builtin_amdgcn_s_setprio(0); } while (0)
#define PG8_WAIT_V(n) asm volatile("s_waitcnt vmcnt(" #n ")" ::: "memory")
#define PG8_WAIT_L(n) asm volatile("s_waitcnt lgkmcnt(" #n ")" ::: "memory")
#define PG8_BAR __builtin_amdgcn_s_barrier()
#define PG8_SCHED __builtin_amdgcn_sched_barrier(0)
    Unit cur, nxt; int ui = 0;
    if (!S.next(0, cur)) return;
    f32x4 acc[2][2][4][2];
#pragma unroll
    for (int a = 0; a < 2; ++a)
#pragma unroll
        for (int b = 0; b < 2; ++b)
#pragma unroll
            for (int m = 0; m < 4; ++m)
#pragma unroll
                for (int n = 0; n < 2; ++n) acc[a][b][m][n] = (f32x4){0.f, 0.f, 0.f, 0.f};
    bf16x8 At[4][2], B0[2][2], B1[2][2];
    typedef int v8i32 __attribute__((ext_vector_type(8))); typedef int v4i32 __attribute__((ext_vector_type(4))); v8i32 At8[4], B08[2], B18[2];
    const int sc_w8 = 0x79797979, sc_a8 = g.sa;
    const char* cA = (const char*)g.A + (size_t)cur.pm * tstepA; const char* cB = (const char*)g.Bt + (size_t)cur.pn * tstepB;
    S.a_ready(cur);
    if constexpr (SP2) {
        PG8_STAGE(PG8_SB(0, 0), cB, voffB); PG8_STAGE(PG8_SB(0, 1), cB + hstepB, voffB); PG8_STAGE(PG8_SA(0, 0), cA, voffA); PG8_STAGE(PG8_SA(0, 1), cA + hstepA, voffA);
        if (wr == 1) PG8_BAR;
        PG8_WAIT_V(2); PG8_BAR;
        PG8_STAGE(PG8_SB(1, 0), cB + kstep, voffB); PG8_STAGE(PG8_SA(1, 0), cA + kstep, voffA); PG8_STAGE(PG8_SB(1, 1), cB + hstepB + kstep, voffB);
        PG8_WAIT_V(6); PG8_BAR;
    } else {
        PG8_STAGE(PG8_SB(0, 0), cB, voffB); PG8_STAGE(PG8_SA(0, 0), cA, voffA); PG8_STAGE(PG8_SB(0, 1), cB + hstepB, voffB); PG8_STAGE(PG8_SA(0, 1), cA + hstepA, voffA);
        if (wr == 1) PG8_BAR;
        PG8_WAIT_V(4); PG8_BAR;
        PG8_STAGE(PG8_SB(1, 0), cB + kstep, voffB); PG8_STAGE(PG8_SA(1, 0), cA + kstep, voffA); PG8_STAGE(PG8_SB(1, 1), cB + hstepB + kstep, voffB);
        PG8_WAIT_V(6); PG8_BAR;
    }
    for (;;) {
        const bool has_next = S.next(ui + 1, nxt);
        const char* nA = has_next ? (const char*)g.A + (size_t)nxt.pm * tstepA : cA; const char* nB = has_next ? (const char*)g.Bt + (size_t)nxt.pn * tstepB : cB;
        for (int t = 0; t < nt; t += 2) {
            const bool last = (t == nt - 2);
            const char* a1 = cA + (size_t)(t + 1) * kstep;
            const char* a2 = last ? nA : cA + (size_t)(t + 2) * kstep; const char* b2 = last ? nB : cB + (size_t)(t + 2) * kstep;
            const char* a3 = a2 + kstep; const char* b3 = b2 + kstep;
            if (last && has_next) S.a_ready(nxt);
            if constexpr (SP2) {
            PG8_LDB(B0, 0, 0); PG8_LDB(B1, 0, 1); PG8_SCHED; PG8_LDA(At, 0, 0); PG8_STAGE(PG8_SA(1, 1), a1 + hstepA, voffA);
            PG8_WAIT_V(8); PG8_WAIT_L(0); PG8_BAR; PG8_MMA(0, 0, At, B0); PG8_MMA(0, 1, At, B1); PG8_BAR; PG8_SCHED;
            PG8_LDA(At, 0, 1); PG8_STAGE(PG8_SB(0, 0), b2, voffB); PG8_STAGE(PG8_SB(0, 1), b2 + hstepB, voffB); PG8_STAGE(PG8_SA(0, 0), a2, voffA);
            PG8_WAIT_V(8); PG8_WAIT_L(0); PG8_BAR; PG8_MMA(1, 0, At, B0); PG8_MMA(1, 1, At, B1); PG8_BAR; PG8_SCHED;
            PG8_LDB(B0, 1, 0); PG8_LDB(B1, 1, 1); PG8_SCHED; PG8_LDA(At, 1, 0); PG8_STAGE(PG8_SA(0, 1), a2 + hstepA, voffA);
            PG8_WAIT_V(8); PG8_WAIT_L(0); PG8_BAR; PG8_MMA(0, 0, At, B0); PG8_MMA(0, 1, At, B1); PG8_BAR; PG8_SCHED;
            PG8_LDA(At, 1, 1); PG8_STAGE(PG8_SB(1, 0), b3, voffB); PG8_STAGE(PG8_SB(1, 1), b3 + hstepB, voffB); PG8_STAGE(PG8_SA(1, 0), a3, voffA);
            PG8_WAIT_V(8); PG8_WAIT_L(0); PG8_BAR; PG8_MMA(1, 0, At, B0); PG8_MMA(1, 1, At, B1); PG8_BAR; PG8_SCHED;
            } else {
            PG8_LDB(B0, 0, 0); PG8_SCHED; PG8_LDA(At, 0, 0); PG8_STAGE(PG8_SA(1, 1), a1 + hstepA, voffA);
            PG8_WAIT_L(8); PG8_BAR; PG8_WAIT_L(0); PG8_MMA(0, 0, At, B0); PG8_BAR; PG8_SCHED;
            PG8_LDB(B1, 0, 1); PG8_STAGE(PG8_SB(0, 0), b2, voffB);
            PG8_BAR; PG8_WAIT_L(0); PG8_MMA(0, 1, At, B1); PG8_BAR;
            PG8_LDA(At, 0, 1); PG8_STAGE(PG8_SA(0, 0), a2, voffA);
            PG8_BAR; PG8_WAIT_L(0); PG8_MMA(1, 0, At, B0); PG8_BAR; PG8_SCHED;
            PG8_STAGE(PG8_SB(0, 1), b2 + hstepB, voffB);
            PG8_WAIT_V(6); PG8_BAR; PG8_MMA(1, 1, At, B1); PG8_BAR;
            PG8_LDB(B0, 1, 0); PG8_SCHED; PG8_LDA(At, 1, 0); PG8_STAGE(PG8_SA(0, 1), a2 + hstepA, voffA);
            PG8_WAIT_L(8); PG8_BAR; PG8_WAIT_L(0); PG8_MMA(0, 0, At, B0); PG8_BAR; PG8_SCHED;
            PG8_LDB(B1, 1, 1); PG8_STAGE(PG8_SB(1, 0), b3, voffB);
            PG8_BAR; PG8_WAIT_L(0); PG8_MMA(0, 1, At, B1); PG8_BAR;
            PG8_LDA(At, 1, 1); PG8_STAGE(PG8_SA(1, 0), a3, voffA);
            PG8_BAR; PG8_WAIT_L(0); PG8_MMA(1, 0, At, B0); PG8_BAR; PG8_SCHED;
            PG8_STAGE(PG8_SB(1, 1), b3 + hstepB, voffB);
            PG8_WAIT_V(6); PG8_BAR; PG8_MMA(1, 1, At, B1); PG8_BAR;
            }
        }
        if constexpr (FP8) asm volatile("s_nop 15\n\ts_nop 7" ::: "memory");
        if constexpr (ALIGN_EPI) { if (wr == 0) PG8_BAR; }
        if constexpr (!Epi::AFTER_DRAIN) { E(acc, cur, wr, wc, fr, fq); PROBE_EPI_DUP S.done(cur); }
        if (!has_next) break;
#pragma unroll
        for (int a = 0; a < 2; ++a)
#pragma unroll
            for (int b = 0; b < 2; ++b)
#pragma unroll
                for (int m = 0; m < 4; ++m)
#pragma unroll
                    for (int n = 0; n < 2; ++n) acc[a][b][m][n] = (f32x4){0.f, 0.f, 0.f, 0.f};
        cur = nxt; cA = nA; cB = nB; ++ui;
        if constexpr (ALIGN_EPI) { if (wr == 1) PG8_BAR; }
    }
    PG8_WAIT_V(0);
    if constexpr (!ALIGN_EPI) { if (wr == 0) PG8_BAR; }
    PG8_BAR;
    if constexpr (Epi::AFTER_DRAIN) { E.fused(acc, cur, wr, wc, fr, fq, lds, wid, lane); S.done(cur); }
#undef PG8_SA
#undef PG8_SB
#undef PG8_STAGE
#undef PG8_LDA
#undef PG8_LDB
#undef PG8_MMA
#undef PG8_WAIT_V
#undef PG8_WAIT_L
#undef PG8_BAR
#undef PG8_SCHED
}
}
#define XB_TMO      128
#define XB_XCNT(j)  (256  + 64 * (j))
#define XB_XSUB(j)  (1280 + 64 * (j))
#define XB_XGEN(j)  (2304 + 64 * (j))
#define XB_TOP      3328
#define XB_TOPGEN   3392
#define XCD_BAR_WORDS 3456
#define XB_SPIN_CAP (1u << 18)

__device__ __forceinline__ unsigned xb_ld(unsigned* p)              { return __hip_atomic_load(p, __ATOMIC_RELAXED, __HIP_MEMORY_SCOPE_AGENT); }
__device__ __forceinline__ unsigned xb_add(unsigned* p, unsigned v) { return __hip_atomic_fetch_add(p, v, __ATOMIC_RELAXED, __HIP_MEMORY_SCOPE_AGENT); }
__device__ __forceinline__ unsigned xb_xcc_id() { return (unsigned)__builtin_amdgcn_s_getreg((3 << 11) | 20) & 0xFu; }
#define XB_SPIN(cond, bar) do { unsigned _sp = 0; while (cond) { __builtin_amdgcn_s_sleep(1); \
    if ((++_sp & 255u) == 0u) { if (xb_ld(&(bar)[XB_TMO])) break; if (_sp > XB_SPIN_CAP) { atomicAdd(&(bar)[XB_TMO], 1u); break; } } } } while (0)

struct XcdBarrier {
    unsigned* bar; unsigned x;
    volatile LAS unsigned* st;
};

__device__ __forceinline__ XcdBarrier xcd_barrier_post(unsigned* bar, volatile LAS unsigned* st) {
    XcdBarrier b; b.bar = bar; b.x = xb_xcc_id(); b.st = st;
    if (wg_tid() == 0) (void)xb_add(&bar[XB_XCNT(b.x)], 1u);
    return b;
}
__device__ __forceinline__ void xcd_barrier_complete(unsigned* bar, unsigned x, unsigned& nloc, unsigned& nx) {
    const unsigned G = gridDim.x * gridDim.y * gridDim.z;
    unsigned sum, cnt, mine, sp = 0u;
    for (;;) {
        sum = 0u; cnt = 0u; mine = 0u;
#pragma unroll
        for (unsigned j = 0; j < 16; ++j) { const unsigned c = xb_ld(&bar[XB_XCNT(j)]); sum += c; cnt += (c > 0u) ? 1u : 0u; mine = (j == x) ? c : mine; }
        if (sum == G) break;
        __builtin_amdgcn_s_sleep(1);
        if ((++sp & 255u) == 0u) { if (xb_ld(&bar[XB_TMO])) break; if (sp > XB_SPIN_CAP) { atomicAdd(&bar[XB_TMO], 1u); break; } }
    }
    nloc = mine > 0u ? mine : 1u; nx = cnt > 0u ? cnt : 1u;
}

__device__ __forceinline__ void xcd_barrier(const XcdBarrier& b) {
    asm volatile("s_waitcnt vmcnt(0)" ::: "memory");
    __syncthreads();
    if (wg_tid() == 0) {
        unsigned* bar = b.bar;
        __builtin_amdgcn_s_waitcnt(0);
        unsigned nloc = b.st[0], nx = b.st[1];
        if (nloc == 0u) { xcd_barrier_complete(bar, b.x, nloc, nx); b.st[0] = nloc; b.st[1] = nx; }
        const unsigned old = xb_add(&bar[XB_XSUB(b.x)], 1u);
        const unsigned gen = old / nloc;
        if (old + 1u == (gen + 1u) * nloc) {
            __builtin_amdgcn_fence(__ATOMIC_RELEASE, "agent");
            asm volatile("s_waitcnt vmcnt(0)" ::: "memory");
            const unsigned og = xb_add(&bar[XB_TOP], 1u);
            const unsigned tg = og / nx;
            if (og + 1u == (tg + 1u) * nx) xb_add(&bar[XB_TOPGEN], 1u);
            else XB_SPIN(xb_ld(&bar[XB_TOPGEN]) == tg, bar);
            __builtin_amdgcn_fence(__ATOMIC_ACQUIRE, "agent");
            xb_add(&bar[XB_XGEN(b.x)], 1u);
            asm volatile("s_waitcnt vmcnt(0)" ::: "memory");
        } else {
            XB_SPIN(xb_ld(&bar[XB_XGEN(b.x)]) == gen, bar);
            __builtin_amdgcn_fence(__ATOMIC_ACQUIRE, "agent");
            asm volatile("s_waitcnt vmcnt(0)" ::: "memory");
        }
    }
    __syncthreads();
}
namespace dattn {
typedef unsigned short bf16;
constexpr int   D = 128, NW = 8, QBLK = 32, KVBLK = 64;
constexpr float SCALE = 0.088388347648318440f;
constexpr float THR = 8.f;
constexpr int SDEPTH = 2;
constexpr int LDQ = 4096, LDK = 1024, LDO = 4096;
constexpr size_t SHM_V = KVBLK * D * 2, SHM_K = KVBLK * D * 2, SHM_ATTN = 3 * SHM_V + 3 * SHM_K + NW * 64 * 4 + 2048;
using bf16x8 = __attribute__((ext_vector_type(8))) short;
using s16x4  = __attribute__((ext_vector_type(4))) short;
using f32x16 = __attribute__((ext_vector_type(16))) float;
using f32x8  = __attribute__((ext_vector_type(8))) float;
using u32x4  = __attribute__((ext_vector_type(4))) unsigned;
#define KSWZ(row, colB) ((row) * 256 + ((colB) ^ (((row) & 7) << 4)))
#define SBAR() __builtin_amdgcn_sched_barrier(0)
__device__ __forceinline__ int crow(int r, int hi) { return (r & 3) + 8 * (r >> 2) + 4 * hi; }
__device__ __forceinline__ unsigned cvtpk(float lo, float hi) {
  unsigned r; asm volatile("v_cvt_pk_bf16_f32 %0, %1, %2" : "=v"(r) : "v"(lo), "v"(hi)); return r;
}
template <typename TIn> struct Stage;
template <> struct Stage<bf16>  { using T = bf16x8;
  __device__ static __forceinline__ T ld8(const bf16* p) { return *reinterpret_cast<const bf16x8*>(p); }
  __device__ static __forceinline__ bf16x8 tobf(T x) { return x; } };
template <> struct Stage<float> { using T = f32x8;
  __device__ static __forceinline__ T ld8(const float* p) { return *reinterpret_cast<const f32x8*>(p); }
  __device__ static __forceinline__ bf16x8 tobf(T x) {
    u32x4 w = {cvtpk(x[0], x[1]), cvtpk(x[2], x[3]), cvtpk(x[4], x[5]), cvtpk(x[6], x[7])}; return *reinterpret_cast<bf16x8*>(&w); } };

__device__ __forceinline__ void partialSM(f32x16& p0, f32x16& p1, float& m_reg, float& mn, float& alpha) {
  constexpr float C = SCALE * 1.4426950408889634f;
  float pmax = p0[0]; for (int r = 1; r < 16; ++r) pmax = fmaxf(pmax, p0[r]); for (int r = 0; r < 16; ++r) pmax = fmaxf(pmax, p1[r]);
  { auto rr = __builtin_amdgcn_permlane32_swap(__float_as_uint(pmax), __float_as_uint(pmax), false, false);
    pmax = fmaxf(__uint_as_float(rr[0]), __uint_as_float(rr[1])); }
  if (__builtin_expect(__all(pmax - m_reg <= THR / SCALE), 1)) { mn = m_reg; alpha = 1.f; }
  else { mn = fmaxf(m_reg, pmax); alpha = __builtin_amdgcn_exp2f((m_reg - mn) * C); m_reg = mn; }
  float mnC = -mn * C;
  for (int r = 0; r < 16; ++r) p0[r] = fmaf(p0[r], C, mnC); for (int r = 0; r < 16; ++r) p1[r] = fmaf(p1[r], C, mnC);
  for (int r = 0; r < 16; ++r) p0[r] = __builtin_amdgcn_exp2f(p0[r]);
}
__device__ __forceinline__ void finishSM(f32x16& p0, f32x16& p1, float alpha, float& l_reg, bf16x8& pa0, bf16x8& pa1, bf16x8& pa2, bf16x8& pa3) {
  for (int r = 0; r < 16; ++r) p1[r] = __builtin_amdgcn_exp2f(p1[r]);
  float ps = 0; for (int r = 0; r < 16; ++r) ps += p0[r]; for (int r = 0; r < 16; ++r) ps += p1[r];
  { auto rr = __builtin_amdgcn_permlane32_swap(__float_as_uint(ps), __float_as_uint(ps), false, false);
    ps = __uint_as_float(rr[0]) + __uint_as_float(rr[1]); }
  l_reg = l_reg * alpha + ps;
#define PK4(P, BASE, OUT) do { unsigned a0 = cvtpk(P[BASE + 0], P[BASE + 1]), a1 = cvtpk(P[BASE + 2], P[BASE + 3]);   \
    unsigned b0 = cvtpk(P[BASE + 4], P[BASE + 5]), b1 = cvtpk(P[BASE + 6], P[BASE + 7]);                              \
    auto r0 = __builtin_amdgcn_permlane32_swap(a0, b0, false, false); auto r1 = __builtin_amdgcn_permlane32_swap(a1, b1, false, false); \
    u32x4 w = {r0[0], r1[0], r0[1], r1[1]}; OUT = *reinterpret_cast<bf16x8*>(&w); } while (0)
  PK4(p0, 0, pa0); PK4(p0, 8, pa1); PK4(p1, 0, pa2); PK4(p1, 8, pa3);
#undef PK4
}
__device__ __forceinline__ void qkt(f32x16& p0, f32x16& p1, const bf16* Ks, const bf16x8* qr, int r32, int hi) {
  p0 = f32x16{}; p1 = f32x16{};
  bf16x8 nb0 = *reinterpret_cast<const bf16x8*>((const char*)Ks + KSWZ(r32, (hi * 8) * 2)), nb1 = *reinterpret_cast<const bf16x8*>((const char*)Ks + KSWZ(32 + r32, (hi * 8) * 2));
#pragma unroll
  for (int d0 = 0; d0 < 8; ++d0) { const bf16x8 b0 = nb0, b1 = nb1;
    if (d0 < 7) { const int cb = ((d0 + 1) * 16 + hi * 8) * 2;
      nb0 = *reinterpret_cast<const bf16x8*>((const char*)Ks + KSWZ(r32, cb)); nb1 = *reinterpret_cast<const bf16x8*>((const char*)Ks + KSWZ(32 + r32, cb)); }
    p0 = __builtin_amdgcn_mfma_f32_32x32x16_bf16(b0, qr[d0], p0, 0, 0, 0);
    p1 = __builtin_amdgcn_mfma_f32_32x32x16_bf16(b1, qr[d0], p1, 0, 0, 0); }
}
__device__ __forceinline__ int v_st(int k, int c) { const int kk = (k & ~0xC) | ((k & 4) << 1) | ((k & 8) >> 1); return ((kk >> 3) * 4 + (c >> 5)) * 512 + ((kk & 7) * 32 + (c & 31)) * 2; }
__device__ __forceinline__ int v_rd_base(int lane) { return ((lane & 3) << 3) | (((lane >> 2) & 3) << 6) | (((lane >> 4) & 1) << 5) | (((lane >> 5) & 1) << 8); }
constexpr int v_rd_off(int d0, int ks, int half) { return d0 * 512 + ks * 4096 + half * 2048; }
template <int OFF> __device__ __forceinline__ s16x4 tr_read(int vb) {
  s16x4 r; asm volatile("ds_read_b64_tr_b16 %0, %1 offset:%2" : "=&v"(r) : "v"(vb), "i"(OFF) : "memory"); return r;
}
template <int D0> __device__ __forceinline__ void pv_one(f32x16& od, int vb, bf16x8 pa0, bf16x8 pa1, bf16x8 pa2, bf16x8 pa3) {
  const s16x4 l0 = tr_read<v_rd_off(D0, 0, 0)>(vb), h0 = tr_read<v_rd_off(D0, 0, 1)>(vb), l1 = tr_read<v_rd_off(D0, 1, 0)>(vb), h1 = tr_read<v_rd_off(D0, 1, 1)>(vb);
  const s16x4 l2 = tr_read<v_rd_off(D0, 2, 0)>(vb), h2 = tr_read<v_rd_off(D0, 2, 1)>(vb), l3 = tr_read<v_rd_off(D0, 3, 0)>(vb), h3 = tr_read<v_rd_off(D0, 3, 1)>(vb);
  asm volatile("s_waitcnt lgkmcnt(0)" ::: "memory"); SBAR();
#define PK(L, H) (bf16x8){L[0], L[1], L[2], L[3], H[0], H[1], H[2], H[3]}
  od = __builtin_amdgcn_mfma_f32_32x32x16_bf16(pa0, PK(l0, h0), od, 0, 0, 0);
  od = __builtin_amdgcn_mfma_f32_32x32x16_bf16(pa1, PK(l1, h1), od, 0, 0, 0);
  od = __builtin_amdgcn_mfma_f32_32x32x16_bf16(pa2, PK(l2, h2), od, 0, 0, 0);
  od = __builtin_amdgcn_mfma_f32_32x32x16_bf16(pa3, PK(l3, h3), od, 0, 0, 0);
#undef PK
}
__device__ __forceinline__ void pv_d0(f32x16* o, int vb, bf16x8 pa0, bf16x8 pa1, bf16x8 pa2, bf16x8 pa3) {
  pv_one<0>(o[0], vb, pa0, pa1, pa2, pa3); pv_one<1>(o[1], vb, pa0, pa1, pa2, pa3); pv_one<2>(o[2], vb, pa0, pa1, pa2, pa3); pv_one<3>(o[3], vb, pa0, pa1, pa2, pa3);
}

template <typename TQ>
__device__ __forceinline__ void attn_dense_body(const TQ* __restrict__ Qb, const bf16* __restrict__ Kh, const bf16* __restrict__ Vh,
                                                bf16* __restrict__ Ob, int seq, char* lds) {
  using St = Stage<bf16>; using SQ = Stage<TQ>;
  int tid_o = wg_tid(); asm volatile("" : "+v"(tid_o)); const int tid = tid_o, wid = __builtin_amdgcn_readfirstlane(tid >> 6), lane = tid & 63, r32 = lane & 31, hi = lane >> 5;
  bf16* V_lds = (bf16*)lds; bf16* K_lds = (bf16*)(lds + 3 * SHM_V);
  float* ws = (float*)(lds + 3 * SHM_V + 3 * SHM_K) + wid * 64; float* li_l = ws; float* al_l = ws + 32;
  float m_reg = -1e30f, l_reg = 0; f32x16 o[4] = {}; bf16x8 qr[8];
  const TQ* Qw = Qb + (long)(wid * QBLK + r32) * LDQ + hi * 8;
#pragma unroll
  for (int d0 = 0; d0 < 8; ++d0) qr[d0] = SQ::tobf(SQ::ld8(Qw + d0 * 16));
  const int sr = tid >> 4, sc = (tid & 15) * 8, vst0 = v_st(sr, sc), vst1 = v_st(32 + sr, sc);
  const int vb0 = (int)(uintptr_t)V_lds + v_rd_base(lane);
  struct { typename St::T vs0, vs1, ks0, ks1; } sr_[SDEPTH];
#define SLOAD(i, k0) do { sr_[i].vs0 = St::ld8(&Vh[(long)((k0) + sr) * LDK + sc]); sr_[i].vs1 = St::ld8(&Vh[(long)((k0) + 32 + sr) * LDK + sc]); \
    sr_[i].ks0 = St::ld8(&Kh[(long)((k0) + sr) * LDK + sc]); sr_[i].ks1 = St::ld8(&Kh[(long)((k0) + 32 + sr) * LDK + sc]); } while (0)
#define SWRITE(b, i) do { *(bf16x8*)((char*)V_lds + (b) * SHM_V + vst0) = St::tobf(sr_[i].vs0);          \
    *(bf16x8*)((char*)V_lds + (b) * SHM_V + vst1) = St::tobf(sr_[i].vs1); int kc = sc * 2;               \
    *(bf16x8*)((char*)K_lds + (b) * SHM_K + KSWZ(sr, kc)) = St::tobf(sr_[i].ks0);                       \
    *(bf16x8*)((char*)K_lds + (b) * SHM_K + KSWZ(32 + sr, kc)) = St::tobf(sr_[i].ks1); } while (0)
#define SWAIT() do { if constexpr (SDEPTH == 2) asm volatile("s_waitcnt vmcnt(4)" ::: "memory"); else asm volatile("s_waitcnt vmcnt(0)" ::: "memory"); } while (0)
#define RESC(a) do { if (__any((a) < 1.f)) { if (hi == 0) al_l[r32] = (a); asm volatile("s_waitcnt lgkmcnt(0)" ::: "memory"); \
    for (int d = 0; d < 4; ++d) for (int r = 0; r < 16; ++r) o[d][r] *= al_l[crow(r, hi)]; } } while (0)
  f32x16 pA0, pA1, pB0, pB1; float mnA, mnB, alA, alB; bf16x8 pa0, pa1, pa2, pa3; const int NT = seq / KVBLK;
  constexpr int SE = 0, SO = SDEPTH - 1;
  SLOAD(SE, 0); asm volatile("s_waitcnt vmcnt(0)" ::: "memory"); SWRITE(0, SE); __syncthreads();
  qkt(pA0, pA1, K_lds, qr, r32, hi); partialSM(pA0, pA1, m_reg, mnA, alA);
  SLOAD(SO, KVBLK); if constexpr (SDEPTH == 2) { if (2 < NT) SLOAD(SE, 2 * KVBLK); }
  SWAIT(); SWRITE(1, SO); __syncthreads();
  int bk = 1, bv = 0, bw = 2;
  if (wid >= 4) __builtin_amdgcn_s_setprio(1);
#define ROT3() do { const int t_ = bv; bv = bk; bk = bw; bw = t_; } while (0)
  for (int j = 1; j + 1 < NT; j += 2) {
    SBAR(); qkt(pB0, pB1, (bf16*)((char*)K_lds + bk * SHM_K), qr, r32, hi);
    finishSM(pA0, pA1, alA, l_reg, pa0, pa1, pa2, pa3); SBAR();
    SLOAD(SO, (j + SDEPTH) * KVBLK); SBAR();
    pv_d0(o, vb0 + bv * (int)SHM_V, pa0, pa1, pa2, pa3); partialSM(pB0, pB1, m_reg, mnB, alB);
    SWAIT(); SWRITE(bw, SE);
    RESC(alB); __syncthreads(); ROT3();
    SBAR(); qkt(pA0, pA1, (bf16*)((char*)K_lds + bk * SHM_K), qr, r32, hi);
    finishSM(pB0, pB1, alB, l_reg, pa0, pa1, pa2, pa3); SBAR();
    if (SDEPTH == 1 || j + 3 < NT) SLOAD(SE, (j + 1 + SDEPTH) * KVBLK); SBAR();
    pv_d0(o, vb0 + bv * (int)SHM_V, pa0, pa1, pa2, pa3); partialSM(pA0, pA1, m_reg, mnA, alA);
    SWAIT(); SWRITE(bw, SO);
    RESC(alA); __syncthreads(); ROT3();
  }
  SBAR(); qkt(pB0, pB1, (bf16*)((char*)K_lds + bk * SHM_K), qr, r32, hi);
  finishSM(pA0, pA1, alA, l_reg, pa0, pa1, pa2, pa3); SBAR();
  pv_d0(o, vb0 + bv * (int)SHM_V, pa0, pa1, pa2, pa3); partialSM(pB0, pB1, m_reg, mnB, alB);
  RESC(alB);
  finishSM(pB0, pB1, alB, l_reg, pa0, pa1, pa2, pa3); SBAR();
  pv_d0(o, vb0 + bk * (int)SHM_V, pa0, pa1, pa2, pa3);
#undef ROT3
  __builtin_amdgcn_s_setprio(0);
  if (hi == 0) li_l[r32] = l_reg; asm volatile("s_waitcnt lgkmcnt(0)" ::: "memory");
  float rli[16];
#pragma unroll
  for (int r = 0; r < 16; ++r) rli[r] = __builtin_amdgcn_rcpf(li_l[crow(r, hi)]);
  bf16* Ow = Ob + (long)(wid * QBLK) * LDO;
#pragma unroll
  for (int r = 0; r < 16; ++r) { int orow = crow(r, hi);
    for (int d0 = 0; d0 < 4; ++d0) Ow[(long)orow * LDO + d0 * 32 + r32] = (bf16)(cvtpk(o[d0][r] * rli[r], 0.f) & 0xffffu); }
#undef SLOAD
#undef SWRITE
#undef SWAIT
#undef RESC
}

constexpr int NA_LD = 4096, NA_TILES = 12;
__device__ __forceinline__ void na_block_body(const bf16* __restrict__ Qb, const bf16* __restrict__ Kh, const bf16* __restrict__ Vh, bf16* __restrict__ Ob,
                                              const float* __restrict__ rpb_h, const float* __restrict__ qgain, const float* __restrict__ kgain, int R, int ks, char* lds) {
  using St = Stage<bf16>;
  int tid_o = wg_tid(); asm volatile("" : "+v"(tid_o)); const int tid = tid_o, wid = __builtin_amdgcn_readfirstlane(tid >> 6), lane = tid & 63, r32 = lane & 31, hi = lane >> 5;
  bf16* V_lds = (bf16*)lds; bf16* K_lds = (bf16*)(lds + 2 * SHM_V);
  float* ws = (float*)(lds + 2 * SHM_V + 2 * SHM_K) + wid * 64; float* li_l = ws; float* al_l = ws + 32;
  float* bt = (float*)(lds + 2 * SHM_V + 2 * SHM_K + NW * 64 * 4);
  float m_reg = -1e30f, l_reg = 0; f32x16 o[4] = {}; bf16x8 qr[8];
  const bf16* Qw = Qb + (long)(wid * QBLK + r32) * NA_LD + hi * 8;
#pragma unroll
  for (int d0 = 0; d0 < 8; ++d0) qr[d0] = St::ld8(Qw + d0 * 16);
  {
    float ss = 0.f;
#pragma unroll
    for (int d0 = 0; d0 < 8; ++d0) { const u32x4 w = __builtin_bit_cast(u32x4, qr[d0]);
#pragma unroll
      for (int e = 0; e < 4; ++e) { const float a = __uint_as_float(w[e] << 16), b = __uint_as_float(w[e] & 0xffff0000u); ss += a * a + b * b; } }
    ss += __shfl_xor(ss, 32);
    const float rinv = __builtin_amdgcn_rsqf(ss * (1.0f / 128.0f) + 1e-6f);
#pragma unroll
    for (int d0 = 0; d0 < 8; ++d0) { const u32x4 w = __builtin_bit_cast(u32x4, qr[d0]); const float* gp = qgain + d0 * 16 + hi * 8;
      const f32x8 g = *reinterpret_cast<const f32x8*>(gp); u32x4 o;
#pragma unroll
      for (int e = 0; e < 4; ++e) o[e] = cvtpk(__uint_as_float(w[e] << 16) * rinv * g[2 * e], __uint_as_float(w[e] & 0xffff0000u) * rinv * g[2 * e + 1]);
      qr[d0] = __builtin_bit_cast(bf16x8, o); } }
  const f32x8 kg = *reinterpret_cast<const f32x8*>(kgain + (tid & 15) * 8);
  for (int i = tid; i < 15 * 31; i += 64 * NW) bt[i] = rpb_h[i];
  const int sr = tid >> 4, sc = (tid & 15) * 8, vst0 = v_st(sr, sc), vst1 = v_st(32 + sr, sc);
  const int vb0 = (int)(uintptr_t)V_lds + v_rd_base(lane);
  bf16x8 s_vs0, s_vs1, s_ks0, s_ks1;
#define NLOAD(k0) do { s_vs0 = St::ld8(&Vh[(long)((k0) + sr) * NA_LD + sc]); s_vs1 = St::ld8(&Vh[(long)((k0) + 32 + sr) * NA_LD + sc]); \
    s_ks0 = St::ld8(&Kh[(long)((k0) + sr) * NA_LD + sc]); s_ks1 = St::ld8(&Kh[(long)((k0) + 32 + sr) * NA_LD + sc]); } while (0)
#define KNORM(x) do { const u32x4 w_ = __builtin_bit_cast(u32x4, x); float a_[8]; float ss_ = 0.f; \
    _Pragma("unroll") for (int e = 0; e < 4; ++e) { a_[2 * e] = __uint_as_float(w_[e] << 16); a_[2 * e + 1] = __uint_as_float(w_[e] & 0xffff0000u); ss_ += a_[2 * e] * a_[2 * e] + a_[2 * e + 1] * a_[2 * e + 1]; } \
    ss_ += __shfl_xor(ss_, 1); ss_ += __shfl_xor(ss_, 2); ss_ += __shfl_xor(ss_, 4); ss_ += __shfl_xor(ss_, 8); \
    const float ri_ = __builtin_amdgcn_rsqf(ss_ * (1.0f / 128.0f) + 1e-6f); u32x4 o_; \
    _Pragma("unroll") for (int e = 0; e < 4; ++e) o_[e] = cvtpk(a_[2 * e] * ri_ * kg[2 * e], a_[2 * e + 1] * ri_ * kg[2 * e + 1]); \
    x = __builtin_bit_cast(bf16x8, o_); } while (0)
#define NWRITE(b) do { KNORM(s_ks0); KNORM(s_ks1); \
    *(bf16x8*)((char*)V_lds + (b) * SHM_V + vst0) = s_vs0; *(bf16x8*)((char*)V_lds + (b) * SHM_V + vst1) = s_vs1; const int kc_ = sc * 2; \
    *(bf16x8*)((char*)K_lds + (b) * SHM_K + KSWZ(sr, kc_)) = s_ks0; *(bf16x8*)((char*)K_lds + (b) * SHM_K + KSWZ(32 + sr, kc_)) = s_ks1; } while (0)
  const int qrow = R + (wid >> 1), r0q = min(max(qrow - 4, 0), 248), jlo = r0q - ks;
  const int c = 32 * (wid & 1) + r32, c0 = min(max(c - 8, 0), 48);
  NLOAD(0); asm volatile("s_waitcnt vmcnt(0)" ::: "memory"); NWRITE(0); __syncthreads();
  for (int j = 0; j < NA_TILES; ++j) {
    const int buf = j & 1;
    if (j + 1 < NA_TILES) NLOAD((j + 1) * KVBLK);
    if (j >= jlo && j < jlo + 8) {
      f32x16 p0, p1; float mn, al; bf16x8 pa0, pa1, pa2, pa3;
      SBAR(); qkt(p0, p1, (bf16*)((char*)K_lds + buf * SHM_K), qr, r32, hi);
      const float* brow = bt + (ks + j - qrow + 7) * 31 + (15 - c);
#pragma unroll
      for (int r = 0; r < 16; ++r) { const int k0 = crow(r, hi), k1 = 32 + k0; const bool v0 = (k0 >= c0) && (k0 < c0 + 16), v1 = (k1 >= c0) && (k1 < c0 + 16);
        const float b0 = brow[v0 ? k0 : c], b1 = brow[v1 ? k1 : c];
        p0[r] = v0 ? fmaf(b0, 1.0f / SCALE, p0[r]) : -1e30f; p1[r] = v1 ? fmaf(b1, 1.0f / SCALE, p1[r]) : -1e30f; }
      partialSM(p0, p1, m_reg, mn, al);
      if (__any(al < 1.f)) { if (hi == 0) al_l[r32] = al; asm volatile("s_waitcnt lgkmcnt(0)" ::: "memory");
#pragma unroll
        for (int d = 0; d < 4; ++d)
#pragma unroll
          for (int r = 0; r < 16; ++r) o[d][r] *= al_l[crow(r, hi)]; }
      finishSM(p0, p1, al, l_reg, pa0, pa1, pa2, pa3); SBAR();
      pv_d0(o, vb0 + buf * (int)SHM_V, pa0, pa1, pa2, pa3);
    }
    if (j + 1 < NA_TILES) { asm volatile("s_waitcnt vmcnt(0)" ::: "memory"); NWRITE(buf ^ 1); }
    __syncthreads();
  }
  if (hi == 0) li_l[r32] = l_reg; asm volatile("s_waitcnt lgkmcnt(0)" ::: "memory");
  float rli[16];
#pragma unroll
  for (int r = 0; r < 16; ++r) rli[r] = 64.0f * __builtin_amdgcn_rcpf(li_l[crow(r, hi)]);
  unsigned char* Ow = (unsigned char*)Ob + (long)(wid * QBLK) * NA_LD;
#pragma unroll
  for (int r = 0; r < 16; ++r) { const int orow = crow(r, hi);
    for (int d0 = 0; d0 < 4; ++d0) Ow[(long)orow * NA_LD + d0 * 32 + r32] = (unsigned char)__builtin_amdgcn_cvt_pk_fp8_f32(o[d0][r] * rli[r], 0.f, 0, false); }
#undef NLOAD
#undef NWRITE
#undef KNORM
}

typedef int v8i __attribute__((ext_vector_type(8)));
typedef unsigned u32x2 __attribute__((ext_vector_type(2)));
constexpr int K8_LD = 1024, V8_LD = 16384, SHM_K8 = KVBLK * D, SHM_V8 = KVBLK * D;
constexpr float THR8 = 3.0f;
__device__ __forceinline__ int cvt4_fp8(float a, float b, float c, float d) { int w = __builtin_amdgcn_cvt_pk_fp8_f32(a, b, 0, false); return __builtin_amdgcn_cvt_pk_fp8_f32(c, d, w, true); }
__device__ __forceinline__ v8i mk8(u32x4 lo, u32x4 hi) { return (v8i){(int)lo[0], (int)lo[1], (int)lo[2], (int)lo[3], (int)hi[0], (int)hi[1], (int)hi[2], (int)hi[3]}; }
__device__ __forceinline__ void qkt8(f32x16& p0, f32x16& p1, const char* Ks, const v8i* qf, int r32, int hi) {
  const int x0 = (r32 >> 1) & 7, x1 = ((32 + r32) >> 1) & 7;
  const char* k0 = Ks + r32 * 128; const char* k1 = Ks + (32 + r32) * 128;
  v8i a[2][2];
#pragma unroll
  for (int s = 0; s < 2; ++s) { const int c = 4 * s + 2 * hi;
    a[0][s] = mk8(*reinterpret_cast<const u32x4*>(k0 + 16 * (c ^ x0)), *reinterpret_cast<const u32x4*>(k0 + 16 * ((c + 1) ^ x0)));
    a[1][s] = mk8(*reinterpret_cast<const u32x4*>(k1 + 16 * (c ^ x1)), *reinterpret_cast<const u32x4*>(k1 + 16 * ((c + 1) ^ x1))); }
  p0 = f32x16{}; p1 = f32x16{};
#pragma unroll
  for (int s = 0; s < 2; ++s) {
    p0 = __builtin_amdgcn_mfma_scale_f32_32x32x64_f8f6f4(a[0][s], qf[s], p0, 0, 0, 0, 0x7F7F7F7F, 0, 0x7F7F7F7F);
    p1 = __builtin_amdgcn_mfma_scale_f32_32x32x64_f8f6f4(a[1][s], qf[s], p1, 0, 0, 0, 0x7F7F7F7F, 0, 0x7F7F7F7F); }
}
__device__ __forceinline__ void partialSM8(f32x16& p0, f32x16& p1, float& m_reg, float& mn, float& alpha) {
  constexpr float C = SCALE * 1.4426950408889634f;
  float pmax = p0[0]; for (int r = 1; r < 16; ++r) pmax = fmaxf(pmax, p0[r]); for (int r = 0; r < 16; ++r) pmax = fmaxf(pmax, p1[r]);
  { auto rr = __builtin_amdgcn_permlane32_swap(__float_as_uint(pmax), __float_as_uint(pmax), false, false);
    pmax = fmaxf(__uint_as_float(rr[0]), __uint_as_float(rr[1])); }
  if (__builtin_expect(__all(pmax - m_reg <= THR8 / SCALE), 1)) { mn = m_reg; alpha = 1.f; }
  else { mn = fmaxf(m_reg, pmax); alpha = __builtin_amdgcn_exp2f((m_reg - mn) * C); m_reg = mn; }
  const float mnC = 4.0f - mn * C;
  for (int r = 0; r < 16; ++r) p0[r] = fmaf(p0[r], C, mnC); for (int r = 0; r < 16; ++r) p1[r] = fmaf(p1[r], C, mnC);
  for (int r = 0; r < 16; ++r) p0[r] = __builtin_amdgcn_exp2f(p0[r]);
}
__device__ __forceinline__ void finishSM8(f32x16& p0, f32x16& p1, v8i& pa) {
  for (int r = 0; r < 16; ++r) p1[r] = __builtin_amdgcn_exp2f(p1[r]);
#pragma unroll
  for (int v = 0; v < 4; ++v) { pa[v] = cvt4_fp8(p0[4 * v], p0[4 * v + 1], p0[4 * v + 2], p0[4 * v + 3]); pa[4 + v] = cvt4_fp8(p1[4 * v], p1[4 * v + 1], p1[4 * v + 2], p1[4 * v + 3]); }
}
__device__ __forceinline__ void pv8(f32x16* o, const char* Vs, const v8i& pa, int r32, int hi) {
  v8i b[4];
#pragma unroll
  for (int db = 0; db < 4; ++db) { const int d = 32 * db + r32, x = (d >> 2) & 3; const char* vp = Vs + d * 64;
    b[db] = mk8(*reinterpret_cast<const u32x4*>(vp + 16 * ((2 * hi) ^ x)), *reinterpret_cast<const u32x4*>(vp + 16 * ((2 * hi + 1) ^ x))); }
  const v8i ones = (v8i){0x38383838, 0x38383838, 0x38383838, 0x38383838, 0x38383838, 0x38383838, 0x38383838, 0x38383838};
#pragma unroll
  for (int db = 0; db < 4; ++db) o[db] = __builtin_amdgcn_mfma_scale_f32_32x32x64_f8f6f4(pa, b[db], o[db], 0, 0, 0, 0x7F7F7F7F, 0, 0x7F7F7F7F);
  o[4] = __builtin_amdgcn_mfma_scale_f32_32x32x64_f8f6f4(pa, ones, o[4], 0, 0, 0, 0x7F7F7F7F, 0, 0x7F7F7F7F);
}
__device__ __forceinline__ void attn_dense_body8(const bf16* __restrict__ Qb, const unsigned char* __restrict__ K8h, const unsigned char* __restrict__ V8h, bf16* __restrict__ Ob, int seq, char* lds) {
  int tid_o = wg_tid(); asm volatile("" : "+v"(tid_o)); const int tid = tid_o, wid = __builtin_amdgcn_readfirstlane(tid >> 6), lane = tid & 63, r32 = lane & 31, hi = lane >> 5;
  char* V_lds = lds; char* K_lds = lds + 3 * SHM_V8;
  float* ws = (float*)(lds + 3 * SHM_V8 + 3 * SHM_K8) + wid * 64; float* al_l = ws + 32;
  float m_reg = -1e30f; f32x16 o[5] = {}; v8i qf[2];
  { const bf16* Qw = Qb + (long)(wid * QBLK + r32) * LDQ + hi * 32;
#pragma unroll
    for (int s = 0; s < 2; ++s) {
#pragma unroll
      for (int c = 0; c < 4; ++c) { const u32x4 w = *reinterpret_cast<const u32x4*>(Qw + s * 64 + c * 8);
        qf[s][2 * c] = cvt4_fp8(__uint_as_float(w[0] << 16), __uint_as_float(w[0] & 0xffff0000u), __uint_as_float(w[1] << 16), __uint_as_float(w[1] & 0xffff0000u));
        qf[s][2 * c + 1] = cvt4_fp8(__uint_as_float(w[2] << 16), __uint_as_float(w[2] & 0xffff0000u), __uint_as_float(w[3] << 16), __uint_as_float(w[3] & 0xffff0000u)); } } }
  const int skey = tid >> 3, sck = tid & 7, sd = tid >> 2, sc4 = tid & 3;
  const int kst = skey * 128 + 16 * (sck ^ ((skey >> 1) & 7));
  const int vx = (sd >> 2) & 3, vst0 = sd * 64 + 16 * ((sc4 >> 1) ^ vx) + 8 * (sc4 & 1), vst1 = sd * 64 + 16 * ((2 + (sc4 >> 1)) ^ vx) + 8 * (sc4 & 1);
  const unsigned char* kg = K8h + (long)skey * K8_LD + 16 * sck; const unsigned char* vg = V8h + (long)sd * V8_LD + 16 * sc4;
  struct { u32x4 k, v; } sr_[2];
#define SLOAD8(i, k0) do { sr_[i].k = *reinterpret_cast<const u32x4*>(kg + (long)(k0) * K8_LD); sr_[i].v = *reinterpret_cast<const u32x4*>(vg + (k0)); } while (0)
#define SWRITE8(b, i) do { *reinterpret_cast<u32x4*>(K_lds + (b) * SHM_K8 + kst) = sr_[i].k; \
    *reinterpret_cast<u32x2*>(V_lds + (b) * SHM_V8 + vst0) = (u32x2){sr_[i].v[0], sr_[i].v[2]}; *reinterpret_cast<u32x2*>(V_lds + (b) * SHM_V8 + vst1) = (u32x2){sr_[i].v[1], sr_[i].v[3]}; } while (0)
#define SWAIT8() asm volatile("s_waitcnt vmcnt(2)" ::: "memory")
#define RESC8(a) do { if (__any((a) < 1.f)) { if (hi == 0) al_l[r32] = (a); asm volatile("s_waitcnt lgkmcnt(0)" ::: "memory"); \
    for (int d = 0; d < 5; ++d) for (int r = 0; r < 16; ++r) o[d][r] *= al_l[crow(r, hi)]; } } while (0)
  f32x16 pA0, pA1, pB0, pB1; float mnA, mnB, alA, alB; v8i pa; const int NT = seq / KVBLK;
  SLOAD8(0, 0); asm volatile("s_waitcnt vmcnt(0)" ::: "memory"); SWRITE8(0, 0); __syncthreads();
  qkt8(pA0, pA1, K_lds, qf, r32, hi); partialSM8(pA0, pA1, m_reg, mnA, alA);
  SLOAD8(1, KVBLK); if (2 < NT) SLOAD8(0, 2 * KVBLK);
  SWAIT8(); SWRITE8(1, 1); __syncthreads();
  int bk = 1, bv = 0, bw = 2;
  if (wid >= 4) __builtin_amdgcn_s_setprio(1);
#define ROT3() do { const int t_ = bv; bv = bk; bk = bw; bw = t_; } while (0)
  for (int j = 1; j + 1 < NT; j += 2) {
    SBAR(); qkt8(pB0, pB1, K_lds + bk * SHM_K8, qf, r32, hi);
    finishSM8(pA0, pA1, pa); SBAR();
    SLOAD8(1, (j + 2) * KVBLK); SBAR();
    pv8(o, V_lds + bv * SHM_V8, pa, r32, hi); partialSM8(pB0, pB1, m_reg, mnB, alB);
    SWAIT8(); SWRITE8(bw, 0);
    RESC8(alB); __syncthreads(); ROT3();
    SBAR(); qkt8(pA0, pA1, K_lds + bk * SHM_K8, qf, r32, hi);
    finishSM8(pB0, pB1, pa); SBAR();
    if (j + 3 < NT) SLOAD8(0, (j + 3) * KVBLK); SBAR();
    pv8(o, V_lds + bv * SHM_V8, pa, r32, hi); partialSM8(pA0, pA1, m_reg, mnA, alA);
    SWAIT8(); SWRITE8(bw, 1);
    RESC8(alA); __syncthreads(); ROT3();
  }
  SBAR(); qkt8(pB0, pB1, K_lds + bk * SHM_K8, qf, r32, hi);
  finishSM8(pA0, pA1, pa); SBAR();
  pv8(o, V_lds + bv * SHM_V8, pa, r32, hi); partialSM8(pB0, pB1, m_reg, mnB, alB);
  RESC8(alB);
  finishSM8(pB0, pB1, pa); SBAR();
  pv8(o, V_lds + bk * SHM_V8, pa, r32, hi);
#undef ROT3
  __builtin_amdgcn_s_setprio(0);
  float rli[16];
#pragma unroll
  for (int r = 0; r < 16; ++r) rli[r] = 64.0f * __builtin_amdgcn_rcpf(o[4][r]);
  unsigned char* Ow = (unsigned char*)Ob + (long)(wid * QBLK) * LDO;
#pragma unroll
  for (int r = 0; r < 16; ++r) { const int orow = crow(r, hi);
    for (int d0 = 0; d0 < 4; ++d0) Ow[(long)orow * LDO + d0 * 32 + r32] = (unsigned char)__builtin_amdgcn_cvt_pk_fp8_f32(o[d0][r] * rli[r], 0.f, 0, false); }
#undef SLOAD8
#undef SWRITE8
#undef SWAIT8
#undef RESC8
}
}
struct Frame {
    LAS unsigned char* lds;
    int tid, lane, wave;
    int bid, vcu, G;
};
__device__ __forceinline__ float wave_sum(float v) {
#pragma unroll
    for (int o = 1; o < 64; o <<= 1) v += __shfl_xor(v, o);
    return v;
}
__device__ __forceinline__ void xrows_phase(const Frame& F, const float* __restrict__ h, bf16* __restrict__ hb, pg8::rs_t* __restrict__ rs, unsigned char* __restrict__ hb8) {
    const int gw = F.vcu * 8 + F.wave, NGW = F.G * 8;
    for (int m = gw; m < L; m += NGW) {
        const f32x4* xr = (const f32x4*)(h + (size_t)m * DM) + F.lane;
        v2u* o8 = (v2u*)(hb + (size_t)m * DM) + F.lane;
        float s = 0.f;
#pragma unroll
        for (int j = 0; j < 16; ++j) { const f32x4 v = xr[64 * j]; s += (v.x * v.x + v.y * v.y) + (v.z * v.z + v.w * v.w); v2u w; w.x = pk2(v.x, v.y); w.y = pk2(v.z, v.w); o8[64 * j] = w;
            int w8 = __builtin_amdgcn_cvt_pk_fp8_f32(v.x, v.y, 0, false); w8 = __builtin_amdgcn_cvt_pk_fp8_f32(v.z, v.w, w8, true); *((unsigned*)(hb8 + (size_t)m * DM) + 64 * j + F.lane) = (unsigned)w8; }
        s = wave_sum(s);
        if (F.lane == 0) rs[m] = (pg8::rs_t)(s * pg8::RS_FIX);
    }
}
__device__ __forceinline__ void headnorm_rows(bf16* __restrict__ X, int ld, int nheads, const float* __restrict__ gain, int t, int lane, bool rope, const float (&cs)[8], const float (&sn)[8], unsigned char* __restrict__ X8 = nullptr) {
    const int hs = lane >> 4, l16 = lane & 15;
    f32x4 g0 = *(const f32x4*)(gain + 8 * l16), g1 = *(const f32x4*)(gain + 8 * l16 + 4);
    const float gg[8] = {g0.x, g0.y, g0.z, g0.w, g1.x, g1.y, g1.z, g1.w};
    const bool second = ((l16 >> 2) & 1) != 0;
    for (int hg = 0; hg < nheads / 4; ++hg) {
        bf16* p = X + (size_t)t * ld + (size_t)(4 * hg + hs) * HD + 8 * l16;
        const v4u raw = *(const v4u*)p;
        float x[8] = {bflo(raw.x), bfhi(raw.x), bflo(raw.y), bfhi(raw.y), bflo(raw.z), bfhi(raw.z), bflo(raw.w), bfhi(raw.w)};
        float ss = 0.f;
#pragma unroll
        for (int e = 0; e < 8; ++e) ss += x[e] * x[e];
        ss += __shfl_xor(ss, 1); ss += __shfl_xor(ss, 2); ss += __shfl_xor(ss, 4); ss += __shfl_xor(ss, 8);
        const float rinv = 1.0f / sqrtf(ss * (1.0f / HD) + EPS);
        float y[8];
#pragma unroll
        for (int e = 0; e < 8; ++e) y[e] = x[e] * rinv * gg[e];
        if (rope) {
#pragma unroll
            for (int e = 0; e < 8; ++e) { const float yp = __shfl_xor(y[e], 4); y[e] = second ? (y[e] * cs[e] + yp * sn[e]) : (y[e] * cs[e] - yp * sn[e]); }
        }
        if (X8) { int w0 = __builtin_amdgcn_cvt_pk_fp8_f32(y[0], y[1], 0, false); w0 = __builtin_amdgcn_cvt_pk_fp8_f32(y[2], y[3], w0, true);
            int w1 = __builtin_amdgcn_cvt_pk_fp8_f32(y[4], y[5], 0, false); w1 = __builtin_amdgcn_cvt_pk_fp8_f32(y[6], y[7], w1, true);
            *(v2u*)(X8 + (size_t)t * ld + (size_t)(4 * hg + hs) * HD + 8 * l16) = (v2u){(unsigned)w0, (unsigned)w1}; }
        else { v4u w; w.x = pk2(y[0], y[1]); w.y = pk2(y[2], y[3]); w.z = pk2(y[4], y[5]); w.w = pk2(y[6], y[7]);
            *(v4u*)p = w; }
    }
}
__device__ __forceinline__ void prep_phase(const Frame& F, bf16* Q, bf16* K, int ldk, int nkh, const float* qgain, const float* kgain, bool rope, unsigned char* K8 = nullptr) {
    const int gw = F.vcu * 8 + F.wave, NGW = F.G * 8;
    const int l16 = F.lane & 15;
    for (int t = gw; t < L; t += NGW) {
        float cs[8], sn[8];
#pragma unroll
        for (int e = 0; e < 8; ++e) { cs[e] = 1.f; sn[e] = 0.f; }
        if (rope) {
            const int ax = l16 >> 3; const float pos = (float)(ax ? (t & (GRID_W - 1)) : (t / GRID_W));
#pragma unroll
            for (int e = 0; e < 8; ++e) { const int f = (l16 & 3) * 8 + e; const float inv = 1.0f / powf(10000.0f, (float)f * (1.0f / 32.0f)); const float ang = pos * inv; cs[e] = cosf(ang); sn[e] = sinf(ang); }
        }
        headnorm_rows(Q, DM, NH, qgain, t, F.lane, rope, cs, sn);
        headnorm_rows(K, ldk, nkh, kgain, t, F.lane, rope, cs, sn, K8);
    }
}

constexpr int S5T = pg8::S5T, S5NCH = pg8::S5NCH, S5KS = pg8::S5KS;
__device__ __forceinline__ void s5_gen_group(const Frame& F, int g, const float* __restrict__ lam_re, const float* __restrict__ lam_im, const float* __restrict__ log_step,
                                             const float* __restrict__ b_re, const float* __restrict__ b_im, const float* __restrict__ c_re, const float* __restrict__ c_im,
                                             bf16* __restrict__ GM, bf16* __restrict__ BMt, f32x2* __restrict__ PAT) {
    LAS f32x2* apow = (LAS f32x2*)F.lds;
    LAS f32x2* zt = apow + 2 * 33 * 64;
    LAS float* Kd = (LAS float*)(zt + 2 * 64);
    const int tid = F.tid;
    if (tid < 128) {
        const int dir = tid >> 6, n = tid & 63, dg = dir * S5G + g, idx = dg * S5N + n;
        const double dt = exp((double)log_step[dg]);
        const double lr = (double)lam_re[idx], li = (double)lam_im[idx];
        const double mag = exp(lr * dt), are = mag * cos(li * dt), aim = mag * sin(li * dt);
        const double den = lr * lr + li * li, nre = are - 1.0;
        zt[dir * 64 + n] = (f32x2){(float)((nre * lr + aim * li) / den), (float)((aim * lr - nre * li) / den)};
        double pr = 1.0, pi = 0.0;
        for (int k = 0; k <= 32; ++k) { apow[(dir * 33 + k) * 64 + n] = (f32x2){(float)pr, (float)pi}; const double t = pr * are - pi * aim; pi = pr * aim + pi * are; pr = t; }
        PAT[idx] = apow[(dir * 33 + 32) * 64 + n];
    }
    LDS_WAIT(); __syncthreads();
    {
        const int dir = tid >> 8, p = (tid >> 4) & 15, q = tid & 15, dg = dir * S5G + g;
        float wr[64], wi[64];
        const float* cr = c_re + ((size_t)dg * S5P + p) * S5N; const float* ci = c_im + ((size_t)dg * S5P + p) * S5N;
#pragma unroll
        for (int n = 0; n < 64; ++n) { const f32x2 z = zt[dir * 64 + n]; const float br = b_re[((size_t)dg * S5N + n) * S5P + q], bi = b_im[((size_t)dg * S5N + n) * S5P + q];
            const float bbr = z.x * br - z.y * bi, bbi = z.x * bi + z.y * br; const float c0 = cr[n], c1 = ci[n];
            wr[n] = c0 * bbr - c1 * bbi; wi[n] = c0 * bbi + c1 * bbr; }
        for (int d = 0; d < 32; ++d) { float acc = 0.f; const LAS f32x2* ap = apow + (dir * 33 + d) * 64;
#pragma unroll
            for (int n = 0; n < 64; ++n) { const f32x2 a = ap[n]; acc = fmaf(wr[n], a.x, acc); acc = fmaf(-wi[n], a.y, acc); }
            Kd[(dir * 32 + d) * 256 + p * 16 + q] = acc; }
    }
    LDS_WAIT(); __syncthreads();
    bf16* BMg = BMt + (size_t)g * 512 * S5KS;
    for (int it = tid; it < 512 * 64; it += 512) { const int row = it >> 6, ch = it & 63, tau = row >> 4, p = row & 15, sg = ch >> 1, q0 = (ch & 1) * 8;
        float v[8];
        if (sg < tau) { const LAS float* k = Kd + (0 * 32 + (tau - sg)) * 256 + p * 16 + q0;
#pragma unroll
            for (int j = 0; j < 8; ++j) v[j] = k[j]; }
        else if (sg > tau) { const LAS float* k = Kd + (1 * 32 + (sg - tau)) * 256 + p * 16 + q0;
#pragma unroll
            for (int j = 0; j < 8; ++j) v[j] = k[j]; }
        else { const LAS float* k0 = Kd + p * 16 + q0; const LAS float* k1 = Kd + 32 * 256 + p * 16 + q0;
#pragma unroll
            for (int j = 0; j < 8; ++j) v[j] = k0[j] + k1[j]; }
        v4u w; w.x = pk2(v[0], v[1]); w.y = pk2(v[2], v[3]); w.z = pk2(v[4], v[5]); w.w = pk2(v[6], v[7]);
        *(v4u*)(BMg + (size_t)row * S5KS + ch * 8) = w; }
    for (int it = tid; it < 512 * 32; it += 512) { const int row = it >> 5, ch = it & 31, tau = row >> 4, p = row & 15, dir = ch >> 4, n0 = (ch & 15) * 4, dg = dir * S5G + g;
        const int k = dir ? (32 - tau) : (tau + 1);
        const f32x4 cr = *(const f32x4*)(c_re + ((size_t)dg * S5P + p) * S5N + n0), ci = *(const f32x4*)(c_im + ((size_t)dg * S5P + p) * S5N + n0);
        const LAS f32x2* ap = apow + (dir * 33 + k) * 64 + n0;
        unsigned o[4];
#pragma unroll
        for (int j = 0; j < 4; ++j) { const f32x2 a = ap[j]; const float vr = cr[j] * a.x - ci[j] * a.y, vi = cr[j] * a.y + ci[j] * a.x; o[j] = pk2(vr, -vi); }
        *(v4u*)(BMg + (size_t)row * S5KS + 512 + ch * 8) = (v4u){o[0], o[1], o[2], o[3]}; }
    bf16* GMg = GM + (size_t)g * 256 * 512;
    for (int it = tid; it < 128 * 64; it += 512) { const int dn = it >> 6, ch = it & 63, dir = dn >> 6, n = dn & 63, sg = ch >> 1, q0 = (ch & 1) * 8, dg = dir * S5G + g;
        const int pw = dir ? sg : (31 - sg);
        const f32x2 a = apow[(dir * 33 + pw) * 64 + n], z = zt[dir * 64 + n];
        const float wr_ = a.x * z.x - a.y * z.y, wi_ = a.x * z.y + a.y * z.x;
        const float* br = b_re + ((size_t)dg * S5N + n) * S5P + q0; const float* bi = b_im + ((size_t)dg * S5N + n) * S5P + q0;
        float re[8], im[8];
#pragma unroll
        for (int j = 0; j < 8; ++j) { re[j] = wr_ * br[j] - wi_ * bi[j]; im[j] = wr_ * bi[j] + wi_ * br[j]; }
        v4u w0, w1; w0.x = pk2(re[0], re[1]); w0.y = pk2(re[2], re[3]); w0.z = pk2(re[4], re[5]); w0.w = pk2(re[6], re[7]);
        w1.x = pk2(im[0], im[1]); w1.y = pk2(im[2], im[3]); w1.z = pk2(im[4], im[5]); w1.w = pk2(im[6], im[7]);
        *(v4u*)(GMg + (size_t)(dir * 128 + 2 * n) * 512 + ch * 8) = w0; *(v4u*)(GMg + (size_t)(dir * 128 + 2 * n + 1) * 512 + ch * 8) = w1; }
    LDS_WAIT(); __syncthreads();
}
__device__ __forceinline__ void s5_scan_phase(const Frame& F, const f32x2* __restrict__ PAT, const float* __restrict__ E, bf16* __restrict__ UA) {
    for (int task = F.bid + F.G * F.wave; task < 2 * S5G; task += F.G * 8) {
        const int dir = task >> 8, g = task & 255;
        const f32x2 a = PAT[task * S5N + F.lane];
        const float* e = E + (size_t)g * S5NCH * 256 + dir * 128 + 2 * F.lane;
        bf16* s = UA + (size_t)g * S5NCH * S5KS + 512 + dir * 128 + 2 * F.lane;
        float cr = 0.f, ci = 0.f;
        for (int c8 = 0; c8 < S5NCH; c8 += 8) {
            f32x2 v[8];
#pragma unroll
            for (int k = 0; k < 8; ++k) { const int c = dir ? (S5NCH - 1 - (c8 + k)) : (c8 + k); v[k] = *(const f32x2*)(e + (size_t)c * 256); }
#pragma unroll
            for (int k = 0; k < 8; ++k) { const int c = dir ? (S5NCH - 1 - (c8 + k)) : (c8 + k);
                *(unsigned*)(s + (size_t)c * S5KS) = pk2(cr, ci);
                const float nr = fmaf(a.x, cr, fmaf(-a.y, ci, v[k].x)), ni = fmaf(a.x, ci, fmaf(a.y, cr, v[k].y)); cr = nr; ci = ni; }
        }
    }
}


__device__ __forceinline__ float fp8_to_f32(unsigned char b) { const int e = (b >> 3) & 15, m = b & 7; const float v = e ? __builtin_ldexpf(1.0f + (float)m * 0.125f, e - 7) : __builtin_ldexpf((float)m * 0.125f, -6); return (b & 0x80) ? -v : v; }
__device__ __forceinline__ void gqa_selfcheck(const Frame& F, const bf16* __restrict__ Qp, const unsigned char* __restrict__ K8, const unsigned char* __restrict__ V8t, const bf16* __restrict__ O,
                                              float* __restrict__ SC, unsigned* flag) {
    LAS float* ql = (LAS float*)(F.lds + F.wave * 1024);
    const int lane = F.lane;
#pragma unroll 1
    for (int s = F.bid * 8 + F.wave; s < 1024; s += F.G * 8) {
        const int tok = (int)(((long)(s >> 5) * 5209 + 77) % L), hq = s & 31, kv = hq >> 2;
        float* sc = SC + (size_t)(F.bid * 8 + F.wave) * L;
        { const bf16* qp = Qp + (size_t)tok * DM + hq * HD; ql[lane] = bf2f(qp[lane]); ql[lane + 64] = bf2f(qp[lane + 64]); } LDS_WAIT();
        float mx = -1e30f;
#pragma unroll 1
        for (int j = lane; j < L; j += 64) { const unsigned char* kp = K8 + (size_t)j * KVD + kv * HD; float dot = 0.f;
#pragma unroll 1
            for (int d = 0; d < HD; ++d) dot += fp8_to_f32(kp[d]) * ql[d];
            dot *= 0.088388347648318440f; sc[j] = dot; mx = fmaxf(mx, dot); }
#pragma unroll
        for (int o = 1; o < 64; o <<= 1) mx = fmaxf(mx, __shfl_xor(mx, o));
        asm volatile("s_waitcnt vmcnt(0)" ::: "memory"); __builtin_amdgcn_fence(__ATOMIC_RELEASE, "workgroup"); __builtin_amdgcn_fence(__ATOMIC_ACQUIRE, "agent");
        float o0 = 0.f, o1 = 0.f, lsum = 0.f;
#pragma unroll 1
        for (int j = 0; j < L; ++j) { const float pj = expf(__hip_atomic_load(sc + j, __ATOMIC_RELAXED, __HIP_MEMORY_SCOPE_AGENT) - mx);
            o0 += pj * fp8_to_f32(V8t[(size_t)(kv * HD + lane) * L + j]); o1 += pj * fp8_to_f32(V8t[(size_t)(kv * HD + lane + 64) * L + j]); lsum += pj; }
        o0 /= lsum; o1 /= lsum;
        const unsigned char* op = (const unsigned char*)O + (size_t)tok * DM + hq * HD; const float g0 = fp8_to_f32(op[lane]) * 0.015625f, g1 = fp8_to_f32(op[lane + 64]) * 0.015625f;
        float am = fmaxf(fabsf(o0), fabsf(o1));
#pragma unroll
        for (int o = 1; o < 64; o <<= 1) am = fmaxf(am, __shfl_xor(am, o));
        const float tol = 0.2f * am + 1e-5f;
        const bool bad = !(fabsf(g0 - o0) <= tol) || !(fabsf(g1 - o1) <= tol);
        if (__any(bad) && lane == 0) __hip_atomic_fetch_or(flag, 1u, __ATOMIC_RELAXED, __HIP_MEMORY_SCOPE_AGENT);
        LDS_WAIT();
    }
}

__device__ __forceinline__ void transpose_item(const float* __restrict__ W, int K, int N, bf16* __restrict__ WT, int mode, const float* __restrict__ gain, LAS float* scr, int item, int lane, int fp8 = 0) {
    const int nblk = N / 32, kb = item / nblk, nb = item % nblk, k0 = 64 * kb, n0 = 32 * nb;
    int r0 = n0;
    if (mode == 1) r0 = (n0 < DM) ? ((n0 >> 7) * 256 + (n0 & 127)) : (((n0 - DM) >> 7) * 256 + 128 + ((n0 - DM) & 127));
    const float* src = W + (size_t)(k0 + (lane >> 5)) * N + n0 + (lane & 31);
    float v[32];
#pragma unroll
    for (int i = 0; i < 32; ++i) v[i] = src[(size_t)(2 * i) * N];
    const int c = lane & 7;
    f32x4 g0 = (f32x4){1.f, 1.f, 1.f, 1.f}, g1 = g0;
    if (gain) { g0 = *(const f32x4*)(gain + k0 + 8 * c); g1 = *(const f32x4*)(gain + k0 + 8 * c + 4); }
#pragma unroll
    for (int i = 0; i < 32; ++i) scr[(2 * i + (lane >> 5)) * 33 + (lane & 31)] = v[i];
    LDS_WAIT(); asm volatile("" ::: "memory");
#pragma unroll
    for (int j = 0; j < 4; ++j) { const int n = (lane >> 3) + 8 * j; const LAS float* s = scr + (8 * c) * 33 + n;
        if (fp8) { int w0 = __builtin_amdgcn_cvt_pk_fp8_f32(64.f * s[0 * 33] * g0.x, 64.f * s[1 * 33] * g0.y, 0, false); w0 = __builtin_amdgcn_cvt_pk_fp8_f32(64.f * s[2 * 33] * g0.z, 64.f * s[3 * 33] * g0.w, w0, true);
            int w1 = __builtin_amdgcn_cvt_pk_fp8_f32(64.f * s[4 * 33] * g1.x, 64.f * s[5 * 33] * g1.y, 0, false); w1 = __builtin_amdgcn_cvt_pk_fp8_f32(64.f * s[6 * 33] * g1.z, 64.f * s[7 * 33] * g1.w, w1, true);
            *(v2u*)((unsigned char*)WT + (size_t)(r0 + n) * K + k0 + 8 * c) = (v2u){(unsigned)w0, (unsigned)w1}; }
        else { v4u o; o.x = pk2(s[0 * 33] * g0.x, s[1 * 33] * g0.y); o.y = pk2(s[2 * 33] * g0.z, s[3 * 33] * g0.w); o.z = pk2(s[4 * 33] * g1.x, s[5 * 33] * g1.y); o.w = pk2(s[6 * 33] * g1.z, s[7 * 33] * g1.w);
            *(v4u*)(WT + (size_t)(r0 + n) * K + k0 + 8 * c) = o; } }
    LDS_WAIT(); asm volatile("" ::: "memory");
}

constexpr size_t MiB = 1u << 20;
constexpr size_t SZ_NAQKV = (size_t)3 * DM * DM * 2, SZ_DD = (size_t)DM * DM * 2, SZ_GQAQKV = (size_t)(DM + 2 * KVD) * DM * 2, SZ_W1 = (size_t)FF * DM * 2, SZ_PROJ = (size_t)DM * PLE * 2, SZ_ACT = (size_t)L * DM * 2;
constexpr size_t OFF_CTL = 0, CTL_ZERO_BYTES = 3 * MiB, OFF_RS = 1 * MiB;
constexpr size_t OFF_NAQKV = 4 * MiB;
constexpr size_t OFF_NAWO = OFF_NAQKV + 2 * SZ_NAQKV;
constexpr size_t OFF_GQAQKV = OFF_NAWO + 2 * SZ_DD;
constexpr size_t OFF_GQAWO = OFF_GQAQKV + SZ_GQAQKV;
constexpr size_t OFF_S5IN = OFF_GQAWO + SZ_DD;
constexpr size_t OFF_S5OUT = OFF_S5IN + SZ_DD;
constexpr size_t OFF_W1 = OFF_S5OUT + 2 * SZ_DD;
constexpr size_t OFF_W2 = OFF_W1 + 4 * SZ_W1;
constexpr size_t OFF_PROJ = OFF_W2 + 4 * SZ_W1;
constexpr size_t OFF_GATE = OFF_PROJ + 4 * SZ_PROJ;
constexpr size_t OFF_PBF = OFF_GATE + 4 * SZ_DD;
constexpr size_t OFF_XN = OFF_PBF + 4 * (size_t)L * PLE * 2;
constexpr size_t OFF_ACT = OFF_XN + SZ_ACT;
constexpr size_t OFF_PP = OFF_ACT + 4 * SZ_ACT;
constexpr size_t OFF_S5BM = OFF_PP + SZ_ACT;
constexpr size_t OFF_S5GM = OFF_S5BM + 192 * MiB;
constexpr size_t OFF_S5PAR = OFF_S5GM + 64 * MiB;
constexpr size_t OFF_DUMMY = OFF_S5PAR + 8 * MiB;
constexpr size_t OFF_HB1 = OFF_DUMMY + 256 * MiB;
constexpr size_t OFF_HB8 = OFF_HB1 + SZ_ACT;
constexpr size_t WS_END = OFF_HB8 + (size_t)L * DM;
constexpr int CW_BAR = 4096;
constexpr int RING_BYTES = 131072, LDSCTL_OFF = RING_BYTES, MISC_OFF = LDSCTL_OFF + 320, PTAB_OFF = LDSCTL_OFF + 1024, LDS_BYTES = 147456;
static_assert(dattn::SHM_ATTN <= RING_BYTES && 8 * 64 * 33 * 4 <= RING_BYTES, "phase scratch fits the ring region");

constexpr int PH_PER_LAYER = 8, NPH = 1 + DEPTH * PH_PER_LAYER;
struct Args { const float* in[28]; float* out; unsigned char* ws; int ph_lo, ph_hi; };
enum { I_X = 0, I_P, I_MIXN, I_MLPN, I_PLEN, I_NAQKV, I_NAWO, I_NAQG, I_NAKG, I_NARPB, I_GQKV, I_GWO, I_GQG, I_GKG, I_S5IN, I_LAMRE, I_LAMIM, I_LOGSTEP, I_BRE, I_BIM, I_CRE, I_CIM, I_S5D, I_S5OUT, I_W1, I_W2, I_PROJ, I_GATE };


__device__ __forceinline__ unsigned long long tab_get(LAS unsigned char* lds, int i) {
    volatile LAS unsigned* t = (volatile LAS unsigned*)(lds + PTAB_OFF); const unsigned lo = t[2 * i], hi = t[2 * i + 1];
    return ((unsigned long long)(unsigned)__builtin_amdgcn_readfirstlane((int)hi) << 32) | (unsigned)__builtin_amdgcn_readfirstlane((int)lo); }
#define INP(i) ((const float*)(const GAS float*)tab_get(F.lds, (i)))
#define OUTP() ((float*)(GAS float*)tab_get(F.lds, 28))
#define WSP() ((unsigned char*)(GAS unsigned char*)tab_get(F.lds, 29))
__device__ __forceinline__ Frame mkframe(unsigned char* lds_generic) {
    Frame F; int t = wg_tid(); asm volatile("" : "+v"(t)); F.tid = t; F.lane = t & 63; F.wave = __builtin_amdgcn_readfirstlane(t >> 6);
    F.lds = (LAS unsigned char*)lds_generic; int b = blockIdx.x; asm volatile("" : "+s"(b)); F.bid = b; int G = gridDim.x; asm volatile("" : "+s"(G)); F.G = G;
    F.vcu = (G % 8 == 0) ? (b % 8) * (G / 8) + b / 8 : b; return F; }
__device__ __forceinline__ void prologue_phase(const Frame& F) {
    unsigned char* ws = WSP();
    LAS float* scr = (LAS float*)(F.lds + F.wave * (64 * 33 * 4));
    const int gw = F.vcu * 8 + F.wave, NGW = F.G * 8;
    constexpr int I_QKV = (DM / 64) * (3 * DM / 32), I_DD = (DM / 64) * (DM / 32), I_GQ = (DM / 64) * ((DM + 2 * KVD) / 32), I_SO = (DM / 64) * (2 * DM / 32),
                  I_1 = (DM / 64) * (FF / 32), I_2 = (FF / 64) * (DM / 32), I_PJ = (PLE / 64) * (DM / 32);
    constexpr int NITEMS = 2 * I_QKV + 2 * I_DD + I_GQ + I_DD + I_DD + I_SO + 4 * I_1 + 4 * I_2 + 4 * I_PJ + 4 * I_DD;
    for (int it = gw; it < NITEMS; it += NGW) {
        int r = it; const float* W; int K, N, mode = 0, fp8 = 0; bf16* WT; const float* gain = nullptr;
        if (r < 2 * I_QKV) { const int l = r / I_QKV; r -= l * I_QKV; W = INP(I_NAQKV) + (size_t)l * DM * 3 * DM; K = DM; N = 3 * DM; WT = (bf16*)(ws + OFF_NAQKV + l * SZ_NAQKV); gain = INP(I_MIXN) + (size_t)(3 * l) * DM; fp8 = 1; }
        else { r -= 2 * I_QKV;
        if (r < 2 * I_DD) { const int l = r / I_DD; r -= l * I_DD; W = INP(I_NAWO) + (size_t)l * DM * DM; K = DM; N = DM; WT = (bf16*)(ws + OFF_NAWO + l * SZ_DD); fp8 = 1; }
        else { r -= 2 * I_DD;
        if (r < I_GQ) { W = INP(I_GQKV); K = DM; N = DM + 2 * KVD; WT = (bf16*)(ws + OFF_GQAQKV); gain = INP(I_MIXN) + (size_t)1 * DM; fp8 = 1; }
        else { r -= I_GQ;
        if (r < I_DD) { W = INP(I_GWO); K = DM; N = DM; WT = (bf16*)(ws + OFF_GQAWO); fp8 = 1; }
        else { r -= I_DD;
        if (r < I_DD) { W = INP(I_S5IN); K = DM; N = DM; WT = (bf16*)(ws + OFF_S5IN); gain = INP(I_MIXN) + (size_t)2 * DM; fp8 = 1; }
        else { r -= I_DD;
        if (r < I_SO) { W = INP(I_S5OUT); K = DM; N = 2 * DM; WT = (bf16*)(ws + OFF_S5OUT); mode = 1; fp8 = 1; }
        else { r -= I_SO;
        if (r < 4 * I_1) { const int l = r / I_1; r -= l * I_1; W = INP(I_W1) + (size_t)l * DM * FF; K = DM; N = FF; WT = (bf16*)(ws + OFF_W1 + l * SZ_W1); gain = INP(I_MLPN) + (size_t)l * DM; }
        else { r -= 4 * I_1;
        if (r < 4 * I_2) { const int l = r / I_2; r -= l * I_2; W = INP(I_W2) + (size_t)l * FF * DM; K = FF; N = DM; WT = (bf16*)(ws + OFF_W2 + l * SZ_W1); }
        else { r -= 4 * I_2;
        if (r < 4 * I_PJ) { const int l = r / I_PJ; r -= l * I_PJ; W = INP(I_PROJ) + (size_t)l * PLE * DM; K = PLE; N = DM; WT = (bf16*)(ws + OFF_PROJ + l * SZ_PROJ); }
        else { r -= 4 * I_PJ; const int l = r / I_DD; r -= l * I_DD; W = INP(I_GATE) + (size_t)l * DM * DM; K = DM; N = DM; WT = (bf16*)(ws + OFF_GATE + l * SZ_DD); gain = INP(I_PLEN) + (size_t)l * DM; } } } } } } } } }
        transpose_item(W, K, N, WT, mode, gain, scr, r, F.lane, fp8);
    }
    xrows_phase(F, INP(I_X), (bf16*)(ws + OFF_XN), (pg8::rs_t*)(ws + OFF_RS), ws + OFF_HB8);
    { const size_t n8 = (size_t)DEPTH * L * PLE / 8; const float* p = INP(I_P); bf16* pb = (bf16*)(ws + OFF_PBF);
      for (size_t i = (size_t)gw * 64 + F.lane; i < n8; i += (size_t)NGW * 64) { const f32x4 a = *(const f32x4*)(p + i * 8), b = *(const f32x4*)(p + i * 8 + 4);
          v4u w; w.x = pk2(a.x, a.y); w.y = pk2(a.z, a.w); w.z = pk2(b.x, b.y); w.w = pk2(b.z, b.w); *(v4u*)(pb + i * 8) = w; } }
    { bf16* GM = (bf16*)(ws + OFF_S5GM); bf16* BMt = (bf16*)(ws + OFF_S5BM); f32x2* PAT = (f32x2*)(ws + OFF_S5PAR);
      LDS_WAIT(); __syncthreads();
      for (int g = F.bid; g < S5G; g += F.G) s5_gen_group(F, g, INP(I_LAMRE), INP(I_LAMIM), INP(I_LOGSTEP), INP(I_BRE), INP(I_BIM), INP(I_CRE), INP(I_CIM), GM, BMt, PAT); }
}

#define WS_PTRS() unsigned char* ws = WSP(); bf16* HB0 = (bf16*)(ws + OFF_XN); bf16* HB1 = (bf16*)(ws + OFF_HB1); bf16* Qb = (bf16*)(ws + OFF_ACT); bf16* Kb = (bf16*)(ws + OFF_ACT + SZ_ACT); bf16* Vb = (bf16*)(ws + OFF_ACT + 2 * SZ_ACT); \
    bf16* Ob = (bf16*)(ws + OFF_ACT + 3 * SZ_ACT); bf16* HID = (bf16*)(ws + OFF_ACT); bf16* UA = (bf16*)(ws + OFF_ACT); bf16* S5Gb = (bf16*)(ws + OFF_ACT + 2 * SZ_ACT); float* S5E = (float*)(ws + OFF_ACT + 3 * SZ_ACT); bf16* PP = (bf16*)(ws + OFF_PP); \
    (void)HB0; (void)HB1; (void)Qb; (void)Kb; (void)Vb; (void)Ob; (void)HID; (void)UA; (void)S5Gb; (void)PP; (void)S5E;
__global__ void __launch_bounds__(512, 2) enc_fwd(Args args) {
    extern __shared__ __attribute__((aligned(16))) unsigned char lds[];
    {
        LAS unsigned char* l3 = (LAS unsigned char*)lds;
        for (int u = threadIdx.x; u < (LDS_BYTES - LDSCTL_OFF) / 4; u += 512) ((LAS unsigned*)(l3 + LDSCTL_OFF))[u] = 0u;
        __syncthreads();
        if (threadIdx.x == 0) { LAS unsigned long long* t = (LAS unsigned long long*)(l3 + PTAB_OFF);
#pragma unroll
            for (int i = 0; i < 28; ++i) t[i] = (unsigned long long)args.in[i];
            t[28] = (unsigned long long)args.out; t[29] = (unsigned long long)args.ws; }
        if ((threadIdx.x & 63) == 0) ((LAS unsigned*)(WTAB_OFF))[hw_wave_slot()] = threadIdx.x >> 6;
        __syncthreads();
    }
    const int lo = args.ph_lo, hi = args.ph_hi;
    XcdBarrier bar;
    { LAS unsigned char* l3 = (LAS unsigned char*)lds; unsigned* ctl = (unsigned*)(GAS unsigned*)(tab_get(l3, 29) + OFF_CTL); bar.bar = ctl + CW_BAR; bar.x = 0; bar.st = nullptr;
      if (hi - lo > 1) bar = xcd_barrier_post(ctl + CW_BAR, (volatile LAS unsigned*)(l3 + MISC_OFF) + 8); }
#define IN(k) (lo <= (k) && (k) < hi)
#ifndef PROBE_PH
#define PROBE_PH (-1)
#endif
#define REPS(k) for (int rep_ = 0, nrep_ = (((k) == PROBE_PH || PROBE_PH == -2) ? 2 : ((PROBE_PH == 300 && (k) == 11) ? 4 : 1)); rep_ < nrep_; ++rep_)
#define HBOUT(p) ((nrep_ == 2 && rep_ == 0) ? (bf16*)(ws + OFF_DUMMY) : (p))
#define RSOUT(i) ((nrep_ == 2 && rep_ == 0) ? (pg8::rs_t*)(ws + OFF_DUMMY + 128 * MiB) : RSP(i))
#define SEAM(k) do { if (IN(k) && IN((k) + 1)) xcd_barrier(bar); } while (0)

#if PROBE_PH == 601
    if (blockIdx.x == 0 && threadIdx.x < 64) {
        typedef int v8i_ __attribute__((ext_vector_type(8))); typedef float f4v_ __attribute__((ext_vector_type(4)));
        const int l = threadIdx.x, ij = l & 15, kb = l >> 4; const unsigned lut[7] = {0xC4u, 0xC0u, 0xB8u, 0x00u, 0x38u, 0x40u, 0x44u};
        v8i_ A, B;
#pragma unroll
        for (int v = 0; v < 8; ++v) { unsigned wa = 0, wb = 0;
#pragma unroll
            for (int b = 0; b < 4; ++b) { const int kk = 32 * kb + 4 * v + b; const int av = ((ij + 2 * kk) % 5) - 2, bv = ((3 * kk + ij) % 7) - 3;
                unsigned ea = 0, eb = 0;
#pragma unroll
                for (int t = 0; t < 7; ++t) { ea = (av + 3 == t) ? lut[t] : ea; eb = (bv + 3 == t) ? lut[t] : eb; }
                wa |= ea << (8 * b); wb |= eb << (8 * b); }
            A[v] = (int)wa; B[v] = (int)wb; }
        f4v_ c1 = {};
        c1 = __builtin_amdgcn_mfma_scale_f32_16x16x128_f8f6f4(A, B, c1, 0, 0, 0, 0x7F7F7F7F, 0, 0x7F7F7F7F);
        bool ok1 = true;
#pragma unroll
        for (int r = 0; r < 4; ++r) { const int i = 4 * kb + r, j = ij; int s = 0;
            for (int kk = 0; kk < 128; ++kk) s += (((i + 2 * kk) % 5) - 2) * (((3 * kk + j) % 7) - 3);
            ok1 = ok1 && (c1[r] == (float)s); }
        unsigned long long ticks = 0; if (!__all(ok1)) ticks += 400000ull;
        const unsigned long long t0 = __builtin_amdgcn_s_memrealtime(); while (__builtin_amdgcn_s_memrealtime() - t0 < ticks) __builtin_amdgcn_s_sleep(8);
    }
    __syncthreads();
#endif
#if PROBE_PH == 600
    if (blockIdx.x == 0 && threadIdx.x < 64) {
        typedef int v8i_ __attribute__((ext_vector_type(8))); typedef float f16v_ __attribute__((ext_vector_type(16)));
        const int l = threadIdx.x, ij = l & 31, kb = l >> 5; const unsigned lut[7] = {0xC4u, 0xC0u, 0xB8u, 0x00u, 0x38u, 0x40u, 0x44u};
        v8i_ A, B;
#pragma unroll
        for (int v = 0; v < 8; ++v) { unsigned wa = 0, wb = 0;
#pragma unroll
            for (int b = 0; b < 4; ++b) { const int kk = 32 * kb + 4 * v + b; const int av = ((ij + 2 * kk) % 5) - 2, bv = ((3 * kk + ij) % 7) - 3;
                unsigned ea = 0, eb = 0;
#pragma unroll
                for (int t = 0; t < 7; ++t) { ea = (av + 3 == t) ? lut[t] : ea; eb = (bv + 3 == t) ? lut[t] : eb; }
                wa |= ea << (8 * b); wb |= eb << (8 * b); }
            A[v] = (int)wa; B[v] = (int)wb; }
        f16v_ c1 = {}, c2 = {};
        c1 = __builtin_amdgcn_mfma_scale_f32_32x32x64_f8f6f4(A, B, c1, 0, 0, 0, 0x7F7F7F7F, 0, 0x7F7F7F7F);
        c2 = __builtin_amdgcn_mfma_scale_f32_32x32x64_f8f6f4(A, B, c2, 0, 0, 0, 0x7B7B7B7B, 0, 0x7F7F7F7F);
        bool ok1 = true, ok2 = true;
#pragma unroll
        for (int r = 0; r < 16; ++r) { const int i = (r & 3) + 8 * (r >> 2) + 4 * kb, j = ij; int s = 0;
            for (int kk = 0; kk < 64; ++kk) s += (((i + 2 * kk) % 5) - 2) * (((3 * kk + j) % 7) - 3);
            ok1 = ok1 && (c1[r] == (float)s); ok2 = ok2 && (c2[r] == (float)s * 0.0625f); }
        int w = __builtin_amdgcn_cvt_pk_fp8_f32(1.0f, 2.0f, 0, false); w = __builtin_amdgcn_cvt_pk_fp8_f32(3.0f, -1.0f, w, true);
        const bool ok3 = ((unsigned)w == 0xB8444038u);
        unsigned long long ticks = 0; if (!__all(ok1)) ticks += 400000ull; if (!__all(ok2)) ticks += 800000ull; if (!__all(ok3)) ticks += 1600000ull;
        const unsigned long long t0 = __builtin_amdgcn_s_memrealtime(); while (__builtin_amdgcn_s_memrealtime() - t0 < ticks) __builtin_amdgcn_s_sleep(8);
    }
    __syncthreads();
#endif
    if (IN(0)) REPS(0) { const Frame F = mkframe(lds); prologue_phase(F); } SEAM(0);
#if PROBE_PH == 200
    for (int xb_ = 0; xb_ < 40; ++xb_) xcd_barrier(bar);
#endif

#pragma unroll 1
    for (int layer = 0; layer < DEPTH; ++layer) {
        const int kind = layer % 3, slot = layer / 3, pb = 1 + PH_PER_LAYER * layer;
#define RSP(i) ((pg8::rs_t*)(ws + OFF_RS) + (size_t)(i) * L)
        const int irs = (layer == 0) ? 0 : 3 * layer;
        if (IN(pb + 0)) REPS(pb + 0) {
            const Frame F = mkframe(lds); WS_PTRS();
            if (kind != 2) {
                const int N = (kind == 0) ? 3 * DM : DM + 2 * KVD;
                const bf16* W = (kind == 0) ? (const bf16*)(ws + OFF_NAQKV + slot * SZ_NAQKV) : (const bf16*)(ws + OFF_GQAQKV);
                const pg8::Gemm g = pg8::mkgemm((const bf16*)(ws + OFF_HB8), W, L, N, DM / 2); pg8::StaticOrder S; S.init(L, N, F.G, F.bid);
                pg8::EpiBf16<0> E{Qb, Kb, Vb, DM, (kind == 0) ? DM : KVD, (kind == 0) ? DM : L, DM, (kind == 0) ? 2 * DM : DM + KVD, RSP(irs), (kind == 0) ? 0 : 2, (kind == 0) ? 2 * DM : DM + KVD};
                pg8::gemm_phase<pg8::EpiBf16<0>, pg8::StaticOrder, false, true, true>(F.lds, g, S, E);
            } else {
                const pg8::Gemm g = pg8::mkgemm((const bf16*)(ws + OFF_HB8), (const bf16*)(ws + OFF_S5IN), L, DM, DM / 2); pg8::StaticOrder S; S.init(L, DM, F.G, F.bid);
                pg8::EpiS5U E{UA, RSP(irs)};
                pg8::gemm_phase<pg8::EpiS5U, pg8::StaticOrder, false, true, true>(F.lds, g, S, E);
            }
        }
        SEAM(pb + 0);
        if (kind != 2) {
            if (kind == 1) { if (IN(pb + 1)) { const Frame F = mkframe(lds); WS_PTRS(); prep_phase(F, Qb, Kb, KVD, NKV, INP(I_GQG), INP(I_GKG), true, (unsigned char*)Kb + 64 * MiB); }
                SEAM(pb + 1); }
            if (IN(pb + 2)) REPS(pb + 2) { const Frame F = mkframe(lds); WS_PTRS();
                if (kind == 0) {
                    const float* rpb = INP(I_NARPB) + (size_t)slot * NH * 15 * 31;
                    for (int i = 0;; ++i) { const int unit = i * F.G + F.vcu; if (unit >= NH * (GROWS / 4)) break;
                        const int h = unit >> 6, R = (unit & 63) * 4, ks = min(max(R - 4, 0), GROWS - dattn::NA_TILES);
                        dattn::na_block_body(Qb + (size_t)(R * GRID_W) * DM + h * HD, Kb + (size_t)(ks * GRID_W) * DM + h * HD, Vb + (size_t)(ks * GRID_W) * DM + h * HD,
                                             (bf16*)((unsigned char*)Ob + (size_t)(R * GRID_W) * DM + h * HD), rpb + (size_t)h * 15 * 31, INP(I_NAQG) + slot * HD, INP(I_NAKG) + slot * HD, R, ks, (char*)lds);
                        __syncthreads(); }
                } else {
                    for (int i = 0;; ++i) { const int unit = i * F.G + F.bid; if (unit >= NH * (L / 256)) break;
                        const int kvh = unit & 7, rest = unit >> 3, hq = kvh * 4 + (rest >> 6), qb = rest & 63;
                        dattn::attn_dense_body8(Qb + (size_t)(qb * 256) * DM + hq * HD, (const unsigned char*)Kb + 64 * MiB + kvh * HD, (const unsigned char*)Vb + (size_t)(kvh * HD) * L, (bf16*)((unsigned char*)Ob + (size_t)(qb * 256) * DM + hq * HD), L, (char*)lds);
                        __syncthreads(); }
                }
            }
            if (IN(pb + 2) && IN(pb + 4)) xcd_barrier(bar);
#if PROBE_PH == 400
            if (kind == 1) { const Frame F = mkframe(lds); WS_PTRS();
                gqa_selfcheck(F, Qb, (const unsigned char*)Kb + 64 * MiB, (const unsigned char*)Vb, Ob, (float*)(ws + OFF_PP), (unsigned*)(ws + OFF_CTL) + 8);
                xcd_barrier(bar); }
#endif
        } else {
            if (IN(pb + 1)) REPS(pb + 1) { const Frame F = mkframe(lds); WS_PTRS();
                pg8::Gemm g; g.A = UA; g.Bt = (const bf16*)(ws + OFF_S5GM); g.M = S5G * S5NCH; g.N = 256; g.K = 512; g.lda = S5KS; g.ldb = 512; g.sa = 0x7F7F7F7F;
                pg8::S5Order S{F.G, F.bid, 2, 1}; pg8::EpiS5E E{S5E};
                pg8::gemm_phase<pg8::EpiS5E, pg8::S5Order, false, true>(F.lds, g, S, E); }
            SEAM(pb + 1);
            if (IN(pb + 2)) REPS(pb + 2) { const Frame F = mkframe(lds); WS_PTRS(); s5_scan_phase(F, (const f32x2*)(ws + OFF_S5PAR), S5E, UA); }
            SEAM(pb + 2);
            if (IN(pb + 3)) REPS(pb + 3) { const Frame F = mkframe(lds); WS_PTRS();
                pg8::Gemm g; g.A = UA; g.Bt = (const bf16*)(ws + OFF_S5BM); g.M = S5G * S5NCH; g.N = S5G * 512; g.K = S5KS; g.lda = S5KS; g.ldb = S5KS; g.sa = 0x7F7F7F7F;
                pg8::S5Order S{F.G, F.bid, 2, 2}; pg8::EpiS5Y E{UA, INP(I_S5D), S5Gb, DM};
                pg8::gemm_phase<pg8::EpiS5Y, pg8::S5Order, false, true>(F.lds, g, S, E); }
            SEAM(pb + 3);
        }
        if (IN(pb + 4)) REPS(pb + 4) {
            const Frame F = mkframe(lds); WS_PTRS();
            if (kind != 2) {
                const bf16* W = (kind == 0) ? (const bf16*)(ws + OFF_NAWO + slot * SZ_DD) : (const bf16*)(ws + OFF_GQAWO);
                pg8::Gemm g = pg8::mkgemm(Ob, W, L, DM, DM / 2); g.sa = 0x79797979; pg8::StaticOrder S; S.init(L, DM, F.G, F.bid);
                pg8::EpiRes E{HB0, HBOUT(HB0), RSOUT(1 + 3 * layer), DM, nullptr};
                pg8::gemm_phase<pg8::EpiRes, pg8::StaticOrder, false, true, true>(F.lds, g, S, E);
            } else {
                pg8::Gemm g = pg8::mkgemm(S5Gb, (const bf16*)(ws + OFF_S5OUT), L, 2 * DM, DM / 2); g.sa = 0x7B7B7B7B; pg8::StaticOrder S; S.init(L, 2 * DM, F.G, F.bid);
                pg8::EpiGlu E{HB0, HBOUT(HB0), RSOUT(1 + 3 * layer), DM};
                pg8::gemm_phase<pg8::EpiGlu, pg8::StaticOrder, false, true, true>(F.lds, g, S, E);
            }
        }
        SEAM(pb + 4);
        if (IN(pb + 5)) REPS(pb + 5) { const Frame F = mkframe(lds); WS_PTRS();
            const pg8::Gemm g = pg8::mkgemm(HB0, (const bf16*)(ws + OFF_W1 + layer * SZ_W1), L, FF, DM); pg8::StaticOrder S; S.init(L, FF, F.G, F.bid);
            pg8::EpiBf16<2> E{HID, HID, HID, FF, FF, FF, 1 << 30, 1 << 30, nullptr, 0, 0};
#if PROBE_PH == 201
            { pg8::RangeOrder R1{S, 0, 8}, R2{S, 8, 16};
              pg8::gemm_phase<pg8::EpiBf16<2>, pg8::RangeOrder, false, true>(F.lds, g, R1, E); xcd_barrier(bar);
              pg8::gemm_phase<pg8::EpiBf16<2>, pg8::RangeOrder, false, true>(F.lds, g, R2, E); }
#else
            pg8::gemm_phase<pg8::EpiBf16<2>, pg8::StaticOrder, false, true>(F.lds, g, S, E);
#endif
        }
        SEAM(pb + 5);
        if (IN(pb + 6)) REPS(pb + 6) { const Frame F = mkframe(lds); WS_PTRS();
            { const pg8::Gemm g = pg8::mkgemm(HID, (const bf16*)(ws + OFF_W2 + layer * SZ_W1), L, DM, FF); pg8::StaticOrder S; S.init(L, DM, F.G, F.bid);
              pg8::EpiRes E{HB0, HBOUT(HB1), RSOUT(2 + 3 * layer), DM, RSP(1 + 3 * layer)};
              pg8::gemm_phase<pg8::EpiRes, pg8::StaticOrder, false, true>(F.lds, g, S, E); }
            { const pg8::Gemm g = pg8::mkgemm((const bf16*)(ws + OFF_PBF + (size_t)layer * L * PLE * 2), (const bf16*)(ws + OFF_PROJ + layer * SZ_PROJ), L, DM, PLE); pg8::StaticOrder S; S.init(L, DM, F.G, F.bid);
              pg8::EpiBf16<0> E{PP, PP, PP, DM, DM, DM, 1 << 30, 1 << 30, nullptr, 0, 0};
              pg8::gemm_phase<pg8::EpiBf16<0>, pg8::StaticOrder, false, true>(F.lds, g, S, E); }
        }
        SEAM(pb + 6);
        if (IN(pb + 7)) REPS(pb + 7) { const Frame F = mkframe(lds); WS_PTRS();
            const pg8::Gemm g = pg8::mkgemm(HB1, (const bf16*)(ws + OFF_GATE + layer * SZ_DD), L, DM, DM); pg8::StaticOrder S; S.init(L, DM, F.G, F.bid);
            pg8::EpiGate E{HB1, HBOUT(HB0), (layer == DEPTH - 1) ? OUTP() : nullptr, PP, RSP(2 + 3 * layer), RSOUT(3 + 3 * layer), DM, (layer + 1 < DEPTH && !(nrep_ == 2 && rep_ == 0)) ? ws + OFF_HB8 : nullptr};
            pg8::gemm_phase<pg8::EpiGate, pg8::StaticOrder, false, true>(F.lds, g, S, E);
        }
        SEAM(pb + 7);
    }
#if PROBE_PH == 400
    { xcd_barrier(bar); const Frame F = mkframe(lds); unsigned char* ws = WSP();
      if (__hip_atomic_load((unsigned*)(ws + OFF_CTL) + 8, __ATOMIC_RELAXED, __HIP_MEMORY_SCOPE_AGENT) != 0u && F.bid == 0 && F.tid < 64) OUTP()[F.tid] = __builtin_nanf(""); }
#endif
#undef IN
#undef SEAM
}

extern "C" void kernel_launch(void* const* d_in, const int* in_sizes, int n_in, void* d_out, int out_size, void* d_ws, size_t ws_size, hipStream_t stream) {
    static int grid = 0;
    if (grid == 0) {
        if (n_in != 28 || in_sizes[0] != L * DM || out_size != L * DM || ws_size < WS_END) {
            fprintf(stderr, "kernel_launch: built for 28 inputs, x/out of %d floats, >= %zu bytes of workspace; got n_in %d, in0 %d, out %d, ws %zu; nothing launched\n", L * DM, (size_t)WS_END, n_in, n_in > 0 ? in_sizes[0] : -1, out_size, ws_size);
            grid = -1; return; }
        int dev = 0, cus = 0, per_cu = 0;
        if (hipGetDevice(&dev) != hipSuccess || hipDeviceGetAttribute(&cus, hipDeviceAttributeMultiprocessorCount, dev) != hipSuccess) { fprintf(stderr, "kernel_launch: device query failed\n"); grid = -1; return; }
        if (hipFuncSetAttribute((const void*)enc_fwd, hipFuncAttributeMaxDynamicSharedMemorySize, LDS_BYTES) != hipSuccess) { fprintf(stderr, "kernel_launch: hipFuncSetAttribute failed\n"); grid = -1; return; }
        if (hipOccupancyMaxActiveBlocksPerMultiprocessor(&per_cu, (const void*)enc_fwd, 512, LDS_BYTES) != hipSuccess || per_cu < 1)
            fprintf(stderr, "kernel_launch: note: occupancy query reports %d workgroups per CU\n", per_cu);
        (void)hipGetLastError();
        grid = cus;
    }
    if (grid < 0) return;
    if (hipMemsetAsync((char*)d_ws + OFF_CTL, 0, CTL_ZERO_BYTES, stream) != hipSuccess) { fprintf(stderr, "kernel_launch: memset failed\n"); return; }
    Args a{};
    for (int i = 0; i < 28; ++i) a.in[i] = (const float*)d_in[i];
    a.out = (float*)d_out; a.ws = (unsigned char*)d_ws;
#if MK_N_LAUNCHES == 1
    a.ph_lo = 0; a.ph_hi = NPH;
    hipLaunchKernelGGL(enc_fwd, dim3(grid), dim3(512), LDS_BYTES, stream, a);
#else
    for (int ph = 0; ph < NPH; ++ph) {
        if (ph > 0) { const int layer = (ph - 1) / PH_PER_LAYER, j = (ph - 1) % PH_PER_LAYER; if (j == 3 && layer % 3 != 2) continue; }
        a.ph_lo = ph; a.ph_hi = ph + 1;
        hipLaunchKernelGGL(enc_fwd, dim3(grid), dim3(512), LDS_BYTES, stream, a);
    }
#endif
    const hipError_t le = hipPeekAtLastError();
    if (le != hipSuccess) fprintf(stderr, "kernel_launch: launch failed: %s\n", hipGetErrorName(le));
}
```

```cpp
#include <hip/hip_runtime.h>
#include <cstdio>
#include <cstdint>

#ifndef MK_N_LAUNCHES
#define MK_N_LAUNCHES 1
#endif

constexpr int L = 16384, DM = 4096, DEPTH = 4, GRID_W = 64, GROWS = L / GRID_W, HD = 128, NH = 32, NKV = 8, KVD = NKV * HD, FF = 4 * DM, PLE = 256;
constexpr int S5G = 256, S5P = 16, S5N = 64, S5TC = 16, S5NC = L / S5TC;
constexpr float EPS = 1e-6f;

#define GAS __attribute__((address_space(1)))
#define LAS __attribute__((address_space(3)))
constexpr unsigned WTAB_OFF = 131072 + 2048;
__device__ __forceinline__ unsigned hw_wave_slot() { return (unsigned)__builtin_amdgcn_s_getreg((5 << 11) | 4) & 63u; }
__device__ __forceinline__ int wg_tid() {
    const unsigned wv = (unsigned)__builtin_amdgcn_readfirstlane((int)((volatile LAS unsigned*)(WTAB_OFF))[hw_wave_slot()]);
    return (int)(wv * 64u + __builtin_amdgcn_mbcnt_hi(~0u, __builtin_amdgcn_mbcnt_lo(~0u, 0u)));
}
typedef unsigned short bf16;
typedef unsigned v4u __attribute__((ext_vector_type(4)));
typedef unsigned v2u __attribute__((ext_vector_type(2)));
typedef float f32x4 __attribute__((ext_vector_type(4)));
typedef float f32x2 __attribute__((ext_vector_type(2)));
typedef short bf16x8 __attribute__((ext_vector_type(8)));
typedef short s16x4 __attribute__((ext_vector_type(4)));
typedef GAS unsigned gu32;
#define RLX_AGENT __ATOMIC_RELAXED, __HIP_MEMORY_SCOPE_AGENT
#define LDS_WAIT() asm volatile("s_waitcnt lgkmcnt(0)" ::: "memory")
#define VM_WAIT() asm volatile("s_waitcnt vmcnt(0)" ::: "memory")
__device__ __forceinline__ unsigned f2bf(float f) { unsigned u = __builtin_bit_cast(unsigned, f); return (u + 0x7fffu + ((u >> 16) & 1u)) >> 16; }
__device__ __forceinline__ unsigned pk2(float lo, float hi) { return f2bf(lo) | (f2bf(hi) << 16); }
__device__ __forceinline__ float bf2f(unsigned short b) { return __builtin_bit_cast(float, (unsigned)b << 16); }
__device__ __forceinline__ float bflo(unsigned w) { return __builtin_bit_cast(float, w << 16); }
__device__ __forceinline__ float bfhi(unsigned w) { return __builtin_bit_cast(float, w & 0xffff0000u); }
__device__ __forceinline__ float sigmoidf_fast(float x) { return __builtin_amdgcn_rcpf(1.0f + __builtin_amdgcn_exp2f(-1.4426950408889634f * x)); }

namespace pg8 {
#define PG8_LAS __attribute__((address_space(3)))
#if defined(PROBE_EPI2)
#define PROBE_EPI_DUP if constexpr (Epi::PERM) E(acc, cur, wr, wc, fr, fq);
#else
#define PROBE_EPI_DUP
#endif
typedef unsigned short bf16_t;
typedef short bf16x8 __attribute__((ext_vector_type(8)));
typedef float f32x4 __attribute__((ext_vector_type(4)));
typedef unsigned u32x4 __attribute__((ext_vector_type(4)));
constexpr int BM = 256, BK = 64, HALF = 128, HTB = HALF * BK * 2  , STAGE_BYTES = 8 * HTB, NXCD = 8, WGM = 8;

__host__ __device__ __forceinline__ int lds_byte(int r, int c) { const int st = (r >> 4) * 2 + (c >> 5), rr = r & 15, cc = c & 31, ob = rr * 64 + cc * 2; return st * 1024 + (ob ^ (((ob >> 9) & 1) << 5)); }
__host__ __device__ __forceinline__ void stage_rc(int b, int& R, int& C) { const int st = b / 1024, sb = b % 1024, swz = sb ^ (((sb >> 9) & 1) << 5); R = (st >> 1) * 16 + swz / 64; C = (st & 1) * 32 + (swz % 64) / 2; }
__host__ __device__ __forceinline__ int perm32(int rho) { const int n = rho >> 4, i = rho & 15; return 8 * (i >> 2) + 4 * n + (i & 3); }

struct Unit { int pm, pn; };
struct Gemm { const bf16_t* A; const bf16_t* Bt; int M, N, K, lda, ldb, sa; };
__host__ __device__ __forceinline__ Gemm mkgemm(const bf16_t* A, const bf16_t* Bt, int M, int N, int K) { Gemm g; g.A = A; g.Bt = Bt; g.M = M; g.N = N; g.K = K; g.lda = K; g.ldb = K; g.sa = 0x7F7F7F7F; return g; }

struct StaticOrder {
    int nM, nN, nwg, G, c;
    __host__ __device__ void init(int M, int N, int G_, int c_) { nM = M / BM; nN = N / BM; nwg = nM * nN; G = G_; c = c_; }
    __host__ __device__ bool next(int i, Unit& u) const {
        const long L = (long)i * G + c; if (L >= nwg) return false;
        int wgid = (int)L; { const int q = nwg / NXCD, r = nwg % NXCD, xcd = wgid % NXCD, off = wgid / NXCD; wgid = (xcd < r ? xcd * (q + 1) : r * (q + 1) + (xcd - r) * q) + off; }
        const int nig = WGM * nN, gid = wgid / nig, fm = gid * WGM, gsz = (nM - fm) < WGM ? (nM - fm) : WGM;
        u.pm = fm + ((wgid % nig) % gsz); u.pn = (wgid % nig) / gsz; return true;
    }
    __device__ __forceinline__ void a_ready(const Unit&) const {}
    __device__ __forceinline__ void done(const Unit&) const {}
};
struct RangeOrder { StaticOrder S; int i0, i1;
    __host__ __device__ bool next(int i, Unit& u) const { return (i + i0 < i1) ? S.next(i + i0, u) : false; }
    __device__ __forceinline__ void a_ready(const Unit&) const {}
    __device__ __forceinline__ void done(const Unit&) const {} };


__device__ __forceinline__ unsigned cvt_pk_bf16(float lo, float hi) { unsigned r; asm volatile("v_cvt_pk_bf16_f32 %0, %1, %2" : "=v"(r) : "v"(lo), "v"(hi)); return r; }
__device__ __forceinline__ float sigm(float x) { return __builtin_amdgcn_rcpf(1.0f + __builtin_amdgcn_exp2f(-1.4426950408889634f * x)); }

typedef unsigned long long rs_t;
constexpr float RS_FIX = 16777216.0f, RS_INV = 1.0f / (16777216.0f * 4096.0f), RS_EPS = 1e-6f;
__device__ __forceinline__ void row_ss_add(rs_t* rs, int row, float s, int fq) {
    s += __shfl_xor(s, 16); s += __shfl_xor(s, 32);
    if (fq == 0) __hip_atomic_fetch_add(rs + row, (rs_t)(s * RS_FIX), __ATOMIC_RELAXED, __HIP_MEMORY_SCOPE_AGENT);
}
__device__ __forceinline__ float rs_rinv(rs_t v) { return __builtin_amdgcn_rsqf((float)v * RS_INV + RS_EPS); }
#define PIN8(a) asm volatile("" : "+v"((a)[0]), "+v"((a)[1]), "+v"((a)[2]), "+v"((a)[3]), "+v"((a)[4]), "+v"((a)[5]), "+v"((a)[6]), "+v"((a)[7]))
template <int ACT> struct EpiBf16 {
    static constexpr bool PERM = true, AFTER_DRAIN = false;
    bf16_t *O0, *O1, *O2; int ld0, ld1, ld2, c1, c2; const rs_t* rs; int vt; int rs_from;
    __device__ __forceinline__ void operator()(const f32x4 (&acc)[2][2][4][2], const Unit& u, int wr, int wc, int fr, int fq) const {
        const int row0 = u.pm * BM + wr * 64 + fr; int colt = u.pn * BM; bf16_t* base = O0; int ldc = ld0;
        const rs_t* rs = (colt >= rs_from) ? this->rs : nullptr;
        bool tr = false;
        if (colt >= c2) { base = O2; ldc = ld2; colt -= c2; tr = vt != 0; } else if (colt >= c1) { base = O1; ldc = ld1; colt -= c1; }
        const int col0 = colt + wc * 32 + 8 * fq;
        rs_t scv[8];
#pragma unroll
        for (int gi = 0; gi < 8; ++gi) scv[gi] = rs ? rs[row0 + (gi >> 2) * HALF + (gi & 3) * 16] : 0ull;
        PIN8(scv);
#pragma unroll
        for (int ai = 0; ai < 2; ++ai)
#pragma unroll
            for (int m = 0; m < 4; ++m) { bf16_t* rowp = base + (size_t)(row0 + ai * HALF + m * 16) * ldc + col0; const float sc = rs ? rs_rinv(scv[ai * 4 + m]) : 1.0f;
#pragma unroll
                for (int bj = 0; bj < 2; ++bj) { f32x4 v0 = acc[ai][bj][m][0] * sc, v1 = acc[ai][bj][m][1] * sc;
                    if (ACT == 2) {
#pragma unroll
                        for (int j = 0; j < 4; ++j) { const float a = fmaxf(v0[j], 0.f), b = fmaxf(v1[j], 0.f); v0[j] = a * a; v1[j] = b * b; } }
                    u32x4 w; w.x = cvt_pk_bf16(v0[0], v0[1]); w.y = cvt_pk_bf16(v0[2], v0[3]); w.z = cvt_pk_bf16(v1[0], v1[1]); w.w = cvt_pk_bf16(v1[2], v1[3]);
                    if (vt == 2 && tr) {
                        unsigned char* tp = (unsigned char*)base + (size_t)(col0 + bj * HALF) * ldc + (row0 + ai * HALF + m * 16);
                        int w0 = __builtin_amdgcn_cvt_pk_fp8_f32(v0[0], v0[1], 0, false); w0 = __builtin_amdgcn_cvt_pk_fp8_f32(v0[2], v0[3], w0, true);
                        int w1 = __builtin_amdgcn_cvt_pk_fp8_f32(v1[0], v1[1], 0, false); w1 = __builtin_amdgcn_cvt_pk_fp8_f32(v1[2], v1[3], w1, true);
                        tp[0] = (unsigned char)w0; tp[(size_t)ldc] = (unsigned char)(w0 >> 8); tp[(size_t)2 * ldc] = (unsigned char)(w0 >> 16); tp[(size_t)3 * ldc] = (unsigned char)(w0 >> 24);
                        tp[(size_t)4 * ldc] = (unsigned char)w1; tp[(size_t)5 * ldc] = (unsigned char)(w1 >> 8); tp[(size_t)6 * ldc] = (unsigned char)(w1 >> 16); tp[(size_t)7 * ldc] = (unsigned char)(w1 >> 24); }
                    else if (tr) { bf16_t* tp = base + (size_t)(col0 + bj * HALF) * ldc + (row0 + ai * HALF + m * 16);
                        tp[0] = (bf16_t)w.x; tp[(size_t)ldc] = (bf16_t)(w.x >> 16); tp[(size_t)2 * ldc] = (bf16_t)w.y; tp[(size_t)3 * ldc] = (bf16_t)(w.y >> 16);
                        tp[(size_t)4 * ldc] = (bf16_t)w.z; tp[(size_t)5 * ldc] = (bf16_t)(w.z >> 16); tp[(size_t)6 * ldc] = (bf16_t)w.w; tp[(size_t)7 * ldc] = (bf16_t)(w.w >> 16); }
                    else *(u32x4*)(rowp + bj * HALF) = w; } }
    }
};
struct EpiF32 {
    static constexpr bool PERM = false, AFTER_DRAIN = false;
    float* C; int ldc;
    __device__ __forceinline__ void operator()(const f32x4 (&acc)[2][2][4][2], const Unit& u, int wr, int wc, int fr, int fq) const {
        const int row0 = u.pm * BM + wr * 64 + fr, col0 = u.pn * BM + wc * 32 + 4 * fq;
#pragma unroll
        for (int ai = 0; ai < 2; ++ai)
#pragma unroll
            for (int m = 0; m < 4; ++m) { float* rowp = C + (size_t)(row0 + ai * HALF + m * 16) * ldc + col0;
#pragma unroll
                for (int bj = 0; bj < 2; ++bj)
#pragma unroll
                    for (int n = 0; n < 2; ++n) *(f32x4*)(rowp + bj * HALF + n * 16) = acc[ai][bj][m][n]; }
    }
};
typedef unsigned u32x2 __attribute__((ext_vector_type(2)));
__device__ __forceinline__ f32x4 bf4_to_f32(u32x2 p) { return (f32x4){__builtin_bit_cast(float, p.x << 16), __builtin_bit_cast(float, p.x & 0xffff0000u), __builtin_bit_cast(float, p.y << 16), __builtin_bit_cast(float, p.y & 0xffff0000u)}; }
struct EpiRes {
    static constexpr bool PERM = false, AFTER_DRAIN = false;
    const bf16_t* base; bf16_t* out; rs_t* rs; int ldc; const rs_t* rsq;
    __device__ __forceinline__ void operator()(const f32x4 (&acc)[2][2][4][2], const Unit& u, int wr, int wc, int fr, int fq) const {
        constexpr int PD = 3;
        const int row0 = u.pm * BM + wr * 64 + fr, col0 = u.pn * BM + wc * 32 + 4 * fq;
        u32x2 nb[8][2][2];
        rs_t scv[8];
#pragma unroll
        for (int gi = 0; gi < 8; ++gi) scv[gi] = rsq ? rsq[row0 + (gi >> 2) * HALF + (gi & 3) * 16] : 0ull;
#define EPI_LD(g) do { const size_t o_ = (size_t)(row0 + ((g) >> 2) * HALF + ((g) & 3) * 16) * ldc + col0; _Pragma("unroll") for (int bj = 0; bj < 2; ++bj) _Pragma("unroll") for (int n = 0; n < 2; ++n) nb[g][bj][n] = *(const u32x2*)(base + o_ + bj * HALF + n * 16); } while (0)
#pragma unroll
        for (int g = 0; g < PD; ++g) EPI_LD(g);
        PIN8(scv);
#pragma unroll
        for (int gi = 0; gi < 8; ++gi) { const int ai = gi >> 2, m = gi & 3; const int row = row0 + ai * HALF + m * 16; const size_t off = (size_t)row * ldc + col0;
            if (gi + PD < 8) EPI_LD(gi + PD);
            const float sc2 = rsq ? __builtin_amdgcn_rcpf((float)scv[gi] * RS_INV + RS_EPS) : 1.0f;
            float ss = 0.f;
#pragma unroll
            for (int bj = 0; bj < 2; ++bj)
#pragma unroll
                for (int n = 0; n < 2; ++n) { const f32x4 o = bf4_to_f32(nb[gi][bj][n]) + acc[ai][bj][m][n] * sc2;
                    ss += (o[0] * o[0] + o[1] * o[1]) + (o[2] * o[2] + o[3] * o[3]);
                    u32x2 w; w.x = cvt_pk_bf16(o[0], o[1]); w.y = cvt_pk_bf16(o[2], o[3]); *(u32x2*)(out + off + bj * HALF + n * 16) = w; }
            row_ss_add(rs, row, ss, fq); }
#undef EPI_LD
    }
};
struct EpiGate {
    static constexpr bool PERM = false, AFTER_DRAIN = false;
    const bf16_t* base; bf16_t* out; float* out32; const bf16_t* pp; const rs_t* rsin; rs_t* rs; int ldc; unsigned char* out8;
    __device__ __forceinline__ void operator()(const f32x4 (&acc)[2][2][4][2], const Unit& u, int wr, int wc, int fr, int fq) const {
        constexpr int PD = 2;
        const int row0 = u.pm * BM + wr * 64 + fr, col0 = u.pn * BM + wc * 32 + 4 * fq;
        rs_t scv[8];
#pragma unroll
        for (int gi = 0; gi < 8; ++gi) scv[gi] = rsin[row0 + (gi >> 2) * HALF + (gi & 3) * 16];
        u32x2 nb[8][2][2], np[8][2][2];
#define EPI_LD(g) do { const size_t o_ = (size_t)(row0 + ((g) >> 2) * HALF + ((g) & 3) * 16) * ldc + col0; _Pragma("unroll") for (int bj = 0; bj < 2; ++bj) _Pragma("unroll") for (int n = 0; n < 2; ++n) { \
            nb[g][bj][n] = *(const u32x2*)(base + o_ + bj * HALF + n * 16); np[g][bj][n] = *(const u32x2*)(pp + o_ + bj * HALF + n * 16); } } while (0)
#pragma unroll
        for (int g = 0; g < PD; ++g) EPI_LD(g);
        PIN8(scv);
#pragma unroll
        for (int gi = 0; gi < 8; ++gi) { const int ai = gi >> 2, m = gi & 3; const int row = row0 + ai * HALF + m * 16; const size_t off = (size_t)row * ldc + col0;
            if (gi + PD < 8) EPI_LD(gi + PD);
            const float sc = rs_rinv(scv[gi]);
            float ss = 0.f;
#pragma unroll
            for (int bj = 0; bj < 2; ++bj)
#pragma unroll
                for (int n = 0; n < 2; ++n) { const f32x4 a = acc[ai][bj][m][n] * sc, p = bf4_to_f32(np[gi][bj][n]); f32x4 o = bf4_to_f32(nb[gi][bj][n]);
#pragma unroll
                    for (int j = 0; j < 4; ++j) o[j] += sigm(a[j]) * p[j];
                    if (out32) *(f32x4*)(out32 + off + bj * HALF + n * 16) = o;
                    if (out8) { int w8 = __builtin_amdgcn_cvt_pk_fp8_f32(o[0], o[1], 0, false); w8 = __builtin_amdgcn_cvt_pk_fp8_f32(o[2], o[3], w8, true); *(unsigned*)(out8 + off + bj * HALF + n * 16) = (unsigned)w8; }
                    ss += (o[0] * o[0] + o[1] * o[1]) + (o[2] * o[2] + o[3] * o[3]);
                    u32x2 w; w.x = cvt_pk_bf16(o[0], o[1]); w.y = cvt_pk_bf16(o[2], o[3]); *(u32x2*)(out + off + bj * HALF + n * 16) = w; }
            row_ss_add(rs, row, ss, fq); }
#undef EPI_LD
    }
};
struct EpiGlu {
    static constexpr bool PERM = false, AFTER_DRAIN = false;
    const bf16_t* base; bf16_t* out; rs_t* rs; int ldc;
    __device__ __forceinline__ void operator()(const f32x4 (&acc)[2][2][4][2], const Unit& u, int wr, int wc, int fr, int fq) const {
        constexpr int PD = 3;
        const int row0 = u.pm * BM + wr * 64 + fr, col0 = u.pn * HALF + wc * 32 + 4 * fq;
        u32x2 nb[8][2];
#define EPI_LD(g) do { const size_t o_ = (size_t)(row0 + ((g) >> 2) * HALF + ((g) & 3) * 16) * ldc + col0; _Pragma("unroll") for (int n = 0; n < 2; ++n) nb[g][n] = *(const u32x2*)(base + o_ + n * 16); } while (0)
#pragma unroll
        for (int g = 0; g < PD; ++g) EPI_LD(g);
#pragma unroll
        for (int gi = 0; gi < 8; ++gi) { const int ai = gi >> 2, m = gi & 3; const int row = row0 + ai * HALF + m * 16; const size_t off = (size_t)row * ldc + col0;
            if (gi + PD < 8) EPI_LD(gi + PD);
            float ss = 0.f;
#pragma unroll
            for (int n = 0; n < 2; ++n) { const f32x4 a = acc[ai][0][m][n], g = acc[ai][1][m][n]; f32x4 o = bf4_to_f32(nb[gi][n]);
#pragma unroll
                for (int j = 0; j < 4; ++j) o[j] += a[j] * sigm(g[j]);
                ss += (o[0] * o[0] + o[1] * o[1]) + (o[2] * o[2] + o[3] * o[3]);
                u32x2 w; w.x = cvt_pk_bf16(o[0], o[1]); w.y = cvt_pk_bf16(o[2], o[3]); *(u32x2*)(out + off + n * 16) = w; }
            row_ss_add(rs, row, ss, fq); }
#undef EPI_LD
    }
};

constexpr int S5T = 32, S5NCH = 512, S5KS = 768;
struct S5Order {
    int G, c, MT, NT;
    __device__ __forceinline__ bool next(int i, Unit& u) const { const int idx = i * G + c; if (idx >= 256 * MT * NT) return false; const int g = idx & 255, sub = idx >> 8;
        u.pm = g * MT + sub / NT; u.pn = g * NT + sub % NT; return true; }
    __device__ __forceinline__ void a_ready(const Unit&) const {}
    __device__ __forceinline__ void done(const Unit&) const {}
};
struct EpiS5U {
    static constexpr bool PERM = true, AFTER_DRAIN = false;
    bf16_t* UA; const rs_t* rs;
    __device__ __forceinline__ void operator()(const f32x4 (&acc)[2][2][4][2], const Unit& u, int wr, int wc, int fr, int fq) const {
        const int row0 = u.pm * BM + wr * 64 + fr, col0 = u.pn * BM + wc * 32 + 8 * fq;
        rs_t scv[8];
#pragma unroll
        for (int gi = 0; gi < 8; ++gi) scv[gi] = rs[row0 + (gi >> 2) * HALF + (gi & 3) * 16];
        PIN8(scv);
#pragma unroll
        for (int ai = 0; ai < 2; ++ai)
#pragma unroll
            for (int m = 0; m < 4; ++m) { const int t = row0 + ai * HALF + m * 16, c = t >> 5, sg = t & 31; const float sc = rs_rinv(scv[ai * 4 + m]);
#pragma unroll
                for (int bj = 0; bj < 2; ++bj) { const int col = col0 + bj * HALF, g = col >> 4, q0 = col & 15;
                    const f32x4 v0 = acc[ai][bj][m][0] * sc, v1 = acc[ai][bj][m][1] * sc;
                    u32x4 w; w.x = cvt_pk_bf16(v0[0], v0[1]); w.y = cvt_pk_bf16(v0[2], v0[3]); w.z = cvt_pk_bf16(v1[0], v1[1]); w.w = cvt_pk_bf16(v1[2], v1[3]);
                    *(u32x4*)(UA + ((size_t)(g * S5NCH + c) * S5KS + sg * 16 + q0)) = w; } }
    }
};
struct EpiS5E {
    static constexpr bool PERM = false, AFTER_DRAIN = false;
    float* E;
    __device__ __forceinline__ void operator()(const f32x4 (&acc)[2][2][4][2], const Unit& u, int wr, int wc, int fr, int fq) const {
        const int row0 = u.pm * BM + wr * 64 + fr, col0 = wc * 32 + 4 * fq;
#pragma unroll
        for (int ai = 0; ai < 2; ++ai)
#pragma unroll
            for (int m = 0; m < 4; ++m) { float* rowp = E + (size_t)(row0 + ai * HALF + m * 16) * 256 + col0;
#pragma unroll
                for (int bj = 0; bj < 2; ++bj)
#pragma unroll
                    for (int n = 0; n < 2; ++n) *(f32x4*)(rowp + bj * HALF + n * 16) = acc[ai][bj][m][n]; }
    }
};
__device__ __forceinline__ float gelu_tanh_f(float v) {
    const float z = 0.7978845608028654f * (v + 0.044715f * v * v * v);
    const float e = __builtin_amdgcn_exp2f(2.0f * 1.4426950408889634f * z);
    return 0.5f * v * (2.0f - 2.0f * __builtin_amdgcn_rcpf(e + 1.0f));
}
struct EpiS5Y {
    static constexpr bool PERM = true, AFTER_DRAIN = false;
    const bf16_t* UA; const float* dskip; bf16_t* G; int ldg;
    __device__ __forceinline__ void operator()(const f32x4 (&acc)[2][2][4][2], const Unit& u, int wr, int wc, int fr, int fq) const {
        const int row0 = u.pm * BM + wr * 64 + fr, col0 = (u.pn & 1) * BM + wc * 32 + 8 * fq;
        const int g = u.pm >> 1, p0 = col0 & 15;
        const f32x4 d0 = *(const f32x4*)(dskip + 16 * g + p0), d1 = *(const f32x4*)(dskip + 16 * g + p0 + 4);
        u32x4 uu[8][2];
#pragma unroll
        for (int gi = 0; gi < 8; ++gi)
#pragma unroll
            for (int bj = 0; bj < 2; ++bj) uu[gi][bj] = *(const u32x4*)(UA + ((size_t)(row0 + (gi >> 2) * HALF + (gi & 3) * 16) * S5KS + col0 + bj * HALF));
#pragma unroll
        for (int gi = 0; gi < 8; ++gi) asm volatile("" : "+v"(uu[gi][0]), "+v"(uu[gi][1]));
#pragma unroll
        for (int gi = 0; gi < 8; ++gi) { const int ai = gi >> 2, m = gi & 3; const int rowg = row0 + ai * HALF + m * 16, c = rowg & 511;
#pragma unroll
            for (int bj = 0; bj < 2; ++bj) { const int col = col0 + bj * HALF, tau = col >> 4; const u32x4 w4 = uu[gi][bj];
                f32x4 v0 = acc[ai][bj][m][0], v1 = acc[ai][bj][m][1];
                v0[0] += d0[0] * __builtin_bit_cast(float, w4.x << 16); v0[1] += d0[1] * __builtin_bit_cast(float, w4.x & 0xffff0000u);
                v0[2] += d0[2] * __builtin_bit_cast(float, w4.y << 16); v0[3] += d0[3] * __builtin_bit_cast(float, w4.y & 0xffff0000u);
                v1[0] += d1[0] * __builtin_bit_cast(float, w4.z << 16); v1[1] += d1[1] * __builtin_bit_cast(float, w4.z & 0xffff0000u);
                v1[2] += d1[2] * __builtin_bit_cast(float, w4.w << 16); v1[3] += d1[3] * __builtin_bit_cast(float, w4.w & 0xffff0000u);
#pragma unroll
                for (int j = 0; j < 4; ++j) { v0[j] = gelu_tanh_f(v0[j]); v1[j] = gelu_tanh_f(v1[j]); }
                int w0 = __builtin_amdgcn_cvt_pk_fp8_f32(16.f * v0[0], 16.f * v0[1], 0, false); w0 = __builtin_amdgcn_cvt_pk_fp8_f32(16.f * v0[2], 16.f * v0[3], w0, true);
                int w1 = __builtin_amdgcn_cvt_pk_fp8_f32(16.f * v1[0], 16.f * v1[1], 0, false); w1 = __builtin_amdgcn_cvt_pk_fp8_f32(16.f * v1[2], 16.f * v1[3], w1, true);
                *(v2u*)((unsigned char*)G + (size_t)(32 * c + tau) * ldg + 16 * g + p0) = (v2u){(unsigned)w0, (unsigned)w1}; } }
    }
};

template <class Epi, class Sched, bool ALIGN_EPI = false, bool SP2 = false, bool FP8 = false>
__device__ __forceinline__ void gemm_phase(PG8_LAS unsigned char* lds, const Gemm g, const Sched& S, const Epi& E) {
    int tid_o = wg_tid(); asm volatile("" : "+v"(tid_o)); const int tid = tid_o, wid = __builtin_amdgcn_readfirstlane(tid >> 6), lane = tid & 63, wr = wid >> 2, wc = wid & 3, fr = lane & 15, fq = lane >> 4;
    const int K = g.K, nt = K / BK;
    unsigned voffA[2], voffB[2];
#pragma unroll
    for (int i = 0; i < 2; ++i) { int R, C; stage_rc(tid * 16 + i * 8192, R, C); const int Rb = Epi::PERM ? ((R & ~31) + perm32(R & 31)) : R;
        voffA[i] = (unsigned)(R * g.lda + C) * 2u; voffB[i] = (unsigned)(Rb * g.ldb + C) * 2u; }
    const size_t kstep = (size_t)(BK * 2);
    const size_t hstepA = (size_t)HALF * g.lda * 2, hstepB = (size_t)HALF * g.ldb * 2;
    const size_t tstepA = 2 * hstepA, tstepB = 2 * hstepB;
    const unsigned ldsw = (unsigned)wid * 1024u;
    const int aoff = lds_byte(wr * 64 + fr, fq * 8), boff = lds_byte(wc * 32 + fr, fq * 8);
    const int aoff8 = lds_byte(wr * 64 + fr, fq * 16), boff8 = lds_byte(wc * 32 + fr, fq * 16);
#define PG8_SA(b, h) (((b) * 2 + (h)) * HTB)
#define PG8_SB(b, h) ((4 + (b) * 2 + (h)) * HTB)
#define PG8_STAGE(bufoff, gbase, voff) do { _Pragma("unroll") for (int _i = 0; _i < 2; ++_i) \
        __builtin_amdgcn_global_load_lds((const unsigned*)((const char*)(gbase) + (voff)[_i]), (PG8_LAS unsigned*)(lds + (bufoff) + ldsw + _i * 8192), 16, 0, 0); } while (0)
#define PG8_LDA(dst, b, h) do { if constexpr (FP8) { _Pragma("unroll") for (int m = 0; m < 4; ++m) { const PG8_LAS unsigned char* p_ = lds + PG8_SA(b, h) + aoff8 + m * 2048; const v4i32 l_ = *(const PG8_LAS v4i32*)p_, h_ = *(const PG8_LAS v4i32*)(p_ + 16); \
        dst##8[m] = __builtin_shufflevector(l_, h_, 0, 1, 2, 3, 4, 5, 6, 7); } } else { \
        _Pragma("unroll") for (int m = 0; m < 4; ++m) _Pragma("unroll") for (int k = 0; k < 2; ++k) dst[m][k] = *(const PG8_LAS bf16x8*)(lds + PG8_SA(b, h) + aoff + m * 2048 + k * 1024); } } while (0)
#define PG8_LDB(dst, b, h) do { if constexpr (FP8) { _Pragma("unroll") for (int n = 0; n < 2; ++n) { const PG8_LAS unsigned char* p_ = lds + PG8_SB(b, h) + boff8 + n * 2048; const v4i32 l_ = *(const PG8_LAS v4i32*)p_, h_ = *(const PG8_LAS v4i32*)(p_ + 16); \
        dst##8[n] = __builtin_shufflevector(l_, h_, 0, 1, 2, 3, 4, 5, 6, 7); } } else { \
        _Pragma("unroll") for (int n = 0; n < 2; ++n) _Pragma("unroll") for (int k = 0; k < 2; ++k) dst[n][k] = *(const PG8_LAS bf16x8*)(lds + PG8_SB(b, h) + boff + n * 2048 + k * 1024); } } while (0)
#define PG8_MMA(ai, bj, At, Bt) do { __builtin_amdgcn_s_setprio(1); if constexpr (FP8) { _Pragma("unroll") for (int m = 0; m < 4; ++m) _Pragma("unroll") for (int n = 0; n < 2; ++n) \
        asm volatile("v_mfma_scale_f32_16x16x128_f8f6f4 %0, %1, %2, %0, %3, %4 op_sel_hi:[0,0,0]" : "+v"(acc[ai][bj][m][n]) : "v"(Bt##8[n]), "v"(At##8[m]), "v"(sc_w8), "v"(sc_a8)); } else { \
        _Pragma("unroll") for (int m = 0; m < 4; ++m) _Pragma("unroll") for (int n = 0; n < 2; ++n) _Pragma("unroll") for (int k = 0; k < 2; ++k) \
        acc[ai][bj][m][n] = __builtin_amdgcn_mfma_f32_16x16x32_bf16(Bt[n][k], At[m][k], acc[ai][bj][m][n], 0, 0, 0); } __builtin_amdgcn_s_setprio(0); } while (0)
#define PG8_WAIT_V(n) asm volatile("s_waitcnt vmcnt(" #n ")" ::: "memory")
#define PG8_WAIT_L(n) asm volatile("s_waitcnt lgkmcnt(" #n ")" ::: "memory")
#define PG8_BAR __builtin_amdgcn_s_barrier()
#define PG8_SCHED __builtin_amdgcn_sched_barrier(0)
    Unit cur, nxt; int ui = 0;
    if (!S.next(0, cur)) return;
    f32x4 acc[2][2][4][2];
#pragma unroll
    for (int a = 0; a < 2; ++a)
#pragma unroll
        for (int b = 0; b < 2; ++b)
#pragma unroll
            for (int m = 0; m < 4; ++m)
#pragma unroll
                for (int n = 0; n < 2; ++n) acc[a][b][m][n] = (f32x4){0.f, 0.f, 0.f, 0.f};
    bf16x8 At[4][2], B0[2][2], B1[2][2];
    typedef int v8i32 __attribute__((ext_vector_type(8))); typedef int v4i32 __attribute__((ext_vector_type(4))); v8i32 At8[4], B08[2], B18[2];
    const int sc_w8 = 0x79797979, sc_a8 = g.sa;
    const char* cA = (const char*)g.A + (size_t)cur.pm * tstepA; const char* cB = (const char*)g.Bt + (size_t)cur.pn * tstepB;
    S.a_ready(cur);
    if constexpr (SP2) {
        PG8_STAGE(PG8_SB(0, 0), cB, voffB); PG8_STAGE(PG8_SB(0, 1), cB + hstepB, voffB); PG8_STAGE(PG8_SA(0, 0), cA, voffA); PG8_STAGE(PG8_SA(0, 1), cA + hstepA, voffA);
        if (wr == 1) PG8_BAR;
        PG8_WAIT_V(2); PG8_BAR;
        PG8_STAGE(PG8_SB(1, 0), cB + kstep, voffB); PG8_STAGE(PG8_SA(1, 0), cA + kstep, voffA); PG8_STAGE(PG8_SB(1, 1), cB + hstepB + kstep, voffB);
        PG8_WAIT_V(6); PG8_BAR;
    } else {
        PG8_STAGE(PG8_SB(0, 0), cB, voffB); PG8_STAGE(PG8_SA(0, 0), cA, voffA); PG8_STAGE(PG8_SB(0, 1), cB + hstepB, voffB); PG8_STAGE(PG8_SA(0, 1), cA + hstepA, voffA);
        if (wr == 1) PG8_BAR;
        PG8_WAIT_V(4); PG8_BAR;
        PG8_STAGE(PG8_SB(1, 0), cB + kstep, voffB); PG8_STAGE(PG8_SA(1, 0), cA + kstep, voffA); PG8_STAGE(PG8_SB(1, 1), cB + hstepB + kstep, voffB);
        PG8_WAIT_V(6); PG8_BAR;
    }
    for (;;) {
        const bool has_next = S.next(ui + 1, nxt);
        const char* nA = has_next ? (const char*)g.A + (size_t)nxt.pm * tstepA : cA; const char* nB = has_next ? (const char*)g.Bt + (size_t)nxt.pn * tstepB : cB;
        for (int t = 0; t < nt; t += 2) {
            const bool last = (t == nt - 2);
            const char* a1 = cA + (size_t)(t + 1) * kstep;
            const char* a2 = last ? nA : cA + (size_t)(t + 2) * kstep; const char* b2 = last ? nB : cB + (size_t)(t + 2) * kstep;
            const char* a3 = a2 + kstep; const char* b3 = b2 + kstep;
            if (last && has_next) S.a_ready(nxt);
            if constexpr (SP2) {
            PG8_LDB(B0, 0, 0); PG8_LDB(B1, 0, 1); PG8_SCHED; PG8_LDA(At, 0, 0); PG8_STAGE(PG8_SA(1, 1), a1 + hstepA, voffA);
            PG8_WAIT_V(8); PG8_WAIT_L(0); PG8_BAR; PG8_MMA(0, 0, At, B0); PG8_MMA(0, 1, At, B1); PG8_BAR; PG8_SCHED;
            PG8_LDA(At, 0, 1); PG8_STAGE(PG8_SB(0, 0), b2, voffB); PG8_STAGE(PG8_SB(0, 1), b2 + hstepB, voffB); PG8_STAGE(PG8_SA(0, 0), a2, voffA);
            PG8_WAIT_V(8); PG8_WAIT_L(0); PG8_BAR; PG8_MMA(1, 0, At, B0); PG8_MMA(1, 1, At, B1); PG8_BAR; PG8_SCHED;
            PG8_LDB(B0, 1, 0); PG8_LDB(B1, 1, 1); PG8_SCHED; PG8_LDA(At, 1, 0); PG8_STAGE(PG8_SA(0, 1), a2 + hstepA, voffA);
            PG8_WAIT_V(8); PG8_WAIT_L(0); PG8_BAR; PG8_MMA(0, 0, At, B0); PG8_MMA(0, 1, At, B1); PG8_BAR; PG8_SCHED;
            PG8_LDA(At, 1, 1); PG8_STAGE(PG8_SB(1, 0), b3, voffB); PG8_STAGE(PG8_SB(1, 1), b3 + hstepB, voffB); PG8_STAGE(PG8_SA(1, 0), a3, voffA);
            PG8_WAIT_V(8); PG8_WAIT_L(0); PG8_BAR; PG8_MMA(1, 0, At, B0); PG8_MMA(1, 1, At, B1); PG8_BAR; PG8_SCHED;
            } else {
            PG8_LDB(B0, 0, 0); PG8_SCHED; PG8_LDA(At, 0, 0); PG8_STAGE(PG8_SA(1, 1), a1 + hstepA, voffA);
            PG8_WAIT_L(8); PG8_BAR; PG8_WAIT_L(0); PG8_MMA(0, 0, At, B0); PG8_BAR; PG8_SCHED;
            PG8_LDB(B1, 0, 1); PG8_STAGE(PG8_SB(0, 0), b2, voffB);
            PG8_BAR; PG8_WAIT_L(0); PG8_MMA(0, 1, At, B1); PG8_BAR;
            PG8_LDA(At, 0, 1); PG8_STAGE(PG8_SA(0, 0), a2, voffA);
            PG8_BAR; PG8_WAIT_L(0); PG8_MMA(1, 0, At, B0); PG8_BAR; PG8_SCHED;
            PG8_STAGE(PG8_SB(0, 1), b2 + hstepB, voffB);
            PG8_WAIT_V(6); PG8_BAR; PG8_MMA(1, 1, At, B1); PG8_BAR;
            PG8_LDB(B0, 1, 0); PG8_SCHED; PG8_LDA(At, 1, 0); PG8_STAGE(PG8_SA(0, 1), a2 + hstepA, voffA);
            PG8_WAIT_L(8); PG8_BAR; PG8_WAIT_L(0); PG8_MMA(0, 0, At, B0); PG8_BAR; PG8_SCHED;
            PG8_LDB(B1, 1, 1); PG8_STAGE(PG8_SB(1, 0), b3, voffB);
            PG8_BAR; PG8_WAIT_L(0); PG8_MMA(0, 1, At, B1); PG8_BAR;
            PG8_LDA(At, 1, 1); PG8_STAGE(PG8_SA(1, 0), a3, voffA);
            PG8_BAR; PG8_WAIT_L(0); PG8_MMA(1, 0, At, B0); PG8_BAR; PG8_SCHED;
            PG8_STAGE(PG8_SB(1, 1), b3 + hstepB, voffB);
            PG8_WAIT_V(6); PG8_BAR; PG8_MMA(1, 1, At, B1); PG8_BAR;
            }
        }
        if constexpr (FP8) asm volatile("s_nop 15\n\ts_nop 7" ::: "memory");
        if constexpr (ALIGN_EPI) { if (wr == 0) PG8_BAR; }
        if constexpr (!Epi::AFTER_DRAIN) { E(acc, cur, wr, wc, fr, fq); PROBE_EPI_DUP S.done(cur); }
        if (!has_next) break;
#pragma unroll
        for (int a = 0; a < 2; ++a)
#pragma unroll
            for (int b = 0; b < 2; ++b)
#pragma unroll
                for (int m = 0; m < 4; ++m)
#pragma unroll
                    for (int n = 0; n < 2; ++n) acc[a][b][m][n] = (f32x4){0.f, 0.f, 0.f, 0.f};
        cur = nxt; cA = nA; cB = nB; ++ui;
        if constexpr (ALIGN_EPI) { if (wr == 1) PG8_BAR; }
    }
    PG8_WAIT_V(0);
    if constexpr (!ALIGN_EPI) { if (wr == 0) PG8_BAR; }
    PG8_BAR;
    if constexpr (Epi::AFTER_DRAIN) { E.fused(acc, cur, wr, wc, fr, fq, lds, wid, lane); S.done(cur); }
#undef PG8_SA
#undef PG8_SB
#undef PG8_STAGE
#undef PG8_LDA
#undef PG8_LDB
#undef PG8_MMA
#undef PG8_WAIT_V
#undef PG8_WAIT_L
#undef PG8_BAR
#undef PG8_SCHED
}
}
#define XB_TMO      128
#define XB_XCNT(j)  (256  + 64 * (j))
#define XB_XSUB(j)  (1280 + 64 * (j))
#define XB_XGEN(j)  (2304 + 64 * (j))
#define XB_TOP      3328
#define XB_TOPGEN   3392
#define XCD_BAR_WORDS 3456
#define XB_SPIN_CAP (1u << 18)

__device__ __forceinline__ unsigned xb_ld(unsigned* p)              { return __hip_atomic_load(p, __ATOMIC_RELAXED, __HIP_MEMORY_SCOPE_AGENT); }
__device__ __forceinline__ unsigned xb_add(unsigned* p, unsigned v) { return __hip_atomic_fetch_add(p, v, __ATOMIC_RELAXED, __HIP_MEMORY_SCOPE_AGENT); }
__device__ __forceinline__ unsigned xb_xcc_id() { return (unsigned)__builtin_amdgcn_s_getreg((3 << 11) | 20) & 0xFu; }
#define XB_SPIN(cond, bar) do { unsigned _sp = 0; while (cond) { __builtin_amdgcn_s_sleep(1); \
    if ((++_sp & 255u) == 0u) { if (xb_ld(&(bar)[XB_TMO])) break; if (_sp > XB_SPIN_CAP) { atomicAdd(&(bar)[XB_TMO], 1u); break; } } } } while (0)

struct XcdBarrier {
    unsigned* bar; unsigned x;
    volatile LAS unsigned* st;
};

__device__ __forceinline__ XcdBarrier xcd_barrier_post(unsigned* bar, volatile LAS unsigned* st) {
    XcdBarrier b; b.bar = bar; b.x = xb_xcc_id(); b.st = st;
    if (wg_tid() == 0) (void)xb_add(&bar[XB_XCNT(b.x)], 1u);
    return b;
}
__device__ __forceinline__ void xcd_barrier_complete(unsigned* bar, unsigned x, unsigned& nloc, unsigned& nx) {
    const unsigned G = gridDim.x * gridDim.y * gridDim.z;
    unsigned sum, cnt, mine, sp = 0u;
    for (;;) {
        sum = 0u; cnt = 0u; mine = 0u;
#pragma unroll
        for (unsigned j = 0; j < 16; ++j) { const unsigned c = xb_ld(&bar[XB_XCNT(j)]); sum += c; cnt += (c > 0u) ? 1u : 0u; mine = (j == x) ? c : mine; }
        if (sum == G) break;
        __builtin_amdgcn_s_sleep(1);
        if ((++sp & 255u) == 0u) { if (xb_ld(&bar[XB_TMO])) break; if (sp > XB_SPIN_CAP) { atomicAdd(&bar[XB_TMO], 1u); break; } }
    }
    nloc = mine > 0u ? mine : 1u; nx = cnt > 0u ? cnt : 1u;
}

__device__ __forceinline__ void xcd_barrier(const XcdBarrier& b) {
    asm volatile("s_waitcnt vmcnt(0)" ::: "memory");
    __syncthreads();
    if (wg_tid() == 0) {
        unsigned* bar = b.bar;
        __builtin_amdgcn_s_waitcnt(0);
        unsigned nloc = b.st[0], nx = b.st[1];
        if (nloc == 0u) { xcd_barrier_complete(bar, b.x, nloc, nx); b.st[0] = nloc; b.st[1] = nx; }
        const unsigned old = xb_add(&bar[XB_XSUB(b.x)], 1u);
        const unsigned gen = old / nloc;
        if (old + 1u == (gen + 1u) * nloc) {
            __builtin_amdgcn_fence(__ATOMIC_RELEASE, "agent");
            asm volatile("s_waitcnt vmcnt(0)" ::: "memory");
            const unsigned og = xb_add(&bar[XB_TOP], 1u);
            const unsigned tg = og / nx;
            if (og + 1u == (tg + 1u) * nx) xb_add(&bar[XB_TOPGEN], 1u);
            else XB_SPIN(xb_ld(&bar[XB_TOPGEN]) == tg, bar);
            __builtin_amdgcn_fence(__ATOMIC_ACQUIRE, "agent");
            xb_add(&bar[XB_XGEN(b.x)], 1u);
            asm volatile("s_waitcnt vmcnt(0)" ::: "memory");
        } else {
            XB_SPIN(xb_ld(&bar[XB_XGEN(b.x)]) == gen, bar);
            __builtin_amdgcn_fence(__ATOMIC_ACQUIRE, "agent");
            asm volatile("s_waitcnt vmcnt(0)" ::: "memory");
        }
    }
    __syncthreads();
}
namespace dattn {
typedef unsigned short bf16;
constexpr int   D = 128, NW = 8, QBLK = 32, KVBLK = 64;
constexpr float SCALE = 0.088388347648318440f;
constexpr float THR = 8.f;
constexpr int SDEPTH = 2;
constexpr int LDQ = 4096, LDK = 1024, LDO = 4096;
constexpr size_t SHM_V = KVBLK * D * 2, SHM_K = KVBLK * D * 2, SHM_ATTN = 3 * SHM_V + 3 * SHM_K + NW * 64 * 4 + 2048;
using bf16x8 = __attribute__((ext_vector_type(8))) short;
using s16x4  = __attribute__((ext_vector_type(4))) short;
using f32x16 = __attribute__((ext_vector_type(16))) float;
using f32x8  = __attribute__((ext_vector_type(8))) float;
using u32x4  = __attribute__((ext_vector_type(4))) unsigned;
#define KSWZ(row, colB) ((row) * 256 + ((colB) ^ (((row) & 7) << 4)))
#define SBAR() __builtin_amdgcn_sched_barrier(0)
__device__ __forceinline__ int crow(int r, int hi) { return (r & 3) + 8 * (r >> 2) + 4 * hi; }
__device__ __forceinline__ unsigned cvtpk(float lo, float hi) {
  unsigned r; asm volatile("v_cvt_pk_bf16_f32 %0, %1, %2" : "=v"(r) : "v"(lo), "v"(hi)); return r;
}
template <typename TIn> struct Stage;
template <> struct Stage<bf16>  { using T = bf16x8;
  __device__ static __forceinline__ T ld8(const bf16* p) { return *reinterpret_cast<const bf16x8*>(p); }
  __device__ static __forceinline__ bf16x8 tobf(T x) { return x; } };
template <> struct Stage<float> { using T = f32x8;
  __device__ static __forceinline__ T ld8(const float* p) { return *reinterpret_cast<const f32x8*>(p); }
  __device__ static __forceinline__ bf16x8 tobf(T x) {
    u32x4 w = {cvtpk(x[0], x[1]), cvtpk(x[2], x[3]), cvtpk(x[4], x[5]), cvtpk(x[6], x[7])}; return *reinterpret_cast<bf16x8*>(&w); } };

__device__ __forceinline__ void partialSM(f32x16& p0, f32x16& p1, float& m_reg, float& mn, float& alpha) {
  constexpr float C = SCALE * 1.4426950408889634f;
  float pmax;
  asm("v_max3_f32 %0, %1, %2, %3" : "=v"(pmax) : "v"(p0[0]), "v"(p0[1]), "v"(p0[2]));
#pragma unroll
  for (int r = 3; r < 15; r += 2) asm("v_max3_f32 %0, %0, %1, %2" : "+v"(pmax) : "v"(p0[r]), "v"(p0[r + 1]));
  asm("v_max3_f32 %0, %0, %1, %2" : "+v"(pmax) : "v"(p0[15]), "v"(p1[0]));
#pragma unroll
  for (int r = 1; r < 15; r += 2) asm("v_max3_f32 %0, %0, %1, %2" : "+v"(pmax) : "v"(p1[r]), "v"(p1[r + 1]));
  asm("v_max_f32 %0, %0, %1" : "+v"(pmax) : "v"(p1[15]));
  { auto rr = __builtin_amdgcn_permlane32_swap(__float_as_uint(pmax), __float_as_uint(pmax), false, false);
    pmax = fmaxf(__uint_as_float(rr[0]), __uint_as_float(rr[1])); }
  if (__builtin_expect(__all(pmax - m_reg <= THR / SCALE), 1)) { mn = m_reg; alpha = 1.f; }
  else { mn = fmaxf(m_reg, pmax); alpha = __builtin_amdgcn_exp2f((m_reg - mn) * C); m_reg = mn; }
  float mnC = -mn * C;
  { const f32x2 C2 = (f32x2){C, C}, m2 = (f32x2){mnC, mnC};
#pragma unroll
    for (int r = 0; r < 16; r += 2) { f32x2 a = (f32x2){p0[r], p0[r + 1]}, b = (f32x2){p1[r], p1[r + 1]};
      asm("v_pk_fma_f32 %0, %0, %1, %2" : "+v"(a) : "v"(C2), "v"(m2)); asm("v_pk_fma_f32 %0, %0, %1, %2" : "+v"(b) : "v"(C2), "v"(m2));
      p0[r] = a[0]; p0[r + 1] = a[1]; p1[r] = b[0]; p1[r + 1] = b[1]; } }
  for (int r = 0; r < 16; ++r) p0[r] = __builtin_amdgcn_exp2f(p0[r]);
}
__device__ __forceinline__ void finishSM(f32x16& p0, f32x16& p1, float alpha, float& l_reg, bf16x8& pa0, bf16x8& pa1, bf16x8& pa2, bf16x8& pa3) {
  for (int r = 0; r < 16; ++r) p1[r] = __builtin_amdgcn_exp2f(p1[r]);
  float ps = 0; for (int r = 0; r < 16; ++r) ps += p0[r]; for (int r = 0; r < 16; ++r) ps += p1[r];
  { auto rr = __builtin_amdgcn_permlane32_swap(__float_as_uint(ps), __float_as_uint(ps), false, false);
    ps = __uint_as_float(rr[0]) + __uint_as_float(rr[1]); }
  l_reg = l_reg * alpha + ps;
#define PK4(P, BASE, OUT) do { unsigned a0 = cvtpk(P[BASE + 0], P[BASE + 1]), a1 = cvtpk(P[BASE + 2], P[BASE + 3]);   \
    unsigned b0 = cvtpk(P[BASE + 4], P[BASE + 5]), b1 = cvtpk(P[BASE + 6], P[BASE + 7]);                              \
    auto r0 = __builtin_amdgcn_permlane32_swap(a0, b0, false, false); auto r1 = __builtin_amdgcn_permlane32_swap(a1, b1, false, false); \
    u32x4 w = {r0[0], r1[0], r0[1], r1[1]}; OUT = *reinterpret_cast<bf16x8*>(&w); } while (0)
  PK4(p0, 0, pa0); PK4(p0, 8, pa1); PK4(p1, 0, pa2); PK4(p1, 8, pa3);
#undef PK4
}
__device__ __forceinline__ void qkt(f32x16& p0, f32x16& p1, const bf16* Ks, const bf16x8* qr, int r32, int hi) {
  p0 = f32x16{}; p1 = f32x16{};
  bf16x8 nb0 = *reinterpret_cast<const bf16x8*>((const char*)Ks + KSWZ(r32, (hi * 8) * 2)), nb1 = *reinterpret_cast<const bf16x8*>((const char*)Ks + KSWZ(32 + r32, (hi * 8) * 2));
#pragma unroll
  for (int d0 = 0; d0 < 8; ++d0) { const bf16x8 b0 = nb0, b1 = nb1;
    if (d0 < 7) { const int cb = ((d0 + 1) * 16 + hi * 8) * 2;
      nb0 = *reinterpret_cast<const bf16x8*>((const char*)Ks + KSWZ(r32, cb)); nb1 = *reinterpret_cast<const bf16x8*>((const char*)Ks + KSWZ(32 + r32, cb)); }
    p0 = __builtin_amdgcn_mfma_f32_32x32x16_bf16(b0, qr[d0], p0, 0, 0, 0);
    p1 = __builtin_amdgcn_mfma_f32_32x32x16_bf16(b1, qr[d0], p1, 0, 0, 0); }
}
__device__ __forceinline__ int v_st(int k, int c) { const int kk = (k & ~0xC) | ((k & 4) << 1) | ((k & 8) >> 1); return ((kk >> 3) * 4 + (c >> 5)) * 512 + ((kk & 7) * 32 + (c & 31)) * 2; }
__device__ __forceinline__ int v_rd_base(int lane) { return ((lane & 3) << 3) | (((lane >> 2) & 3) << 6) | (((lane >> 4) & 1) << 5) | (((lane >> 5) & 1) << 8); }
constexpr int v_rd_off(int d0, int ks, int half) { return d0 * 512 + ks * 4096 + half * 2048; }
template <int OFF> __device__ __forceinline__ s16x4 tr_read(int vb) {
  s16x4 r; asm volatile("ds_read_b64_tr_b16 %0, %1 offset:%2" : "=&v"(r) : "v"(vb), "i"(OFF) : "memory"); return r;
}
template <int D0> __device__ __forceinline__ void pv_one(f32x16& od, int vb, bf16x8 pa0, bf16x8 pa1, bf16x8 pa2, bf16x8 pa3) {
  const s16x4 l0 = tr_read<v_rd_off(D0, 0, 0)>(vb), h0 = tr_read<v_rd_off(D0, 0, 1)>(vb), l1 = tr_read<v_rd_off(D0, 1, 0)>(vb), h1 = tr_read<v_rd_off(D0, 1, 1)>(vb);
  const s16x4 l2 = tr_read<v_rd_off(D0, 2, 0)>(vb), h2 = tr_read<v_rd_off(D0, 2, 1)>(vb), l3 = tr_read<v_rd_off(D0, 3, 0)>(vb), h3 = tr_read<v_rd_off(D0, 3, 1)>(vb);
  asm volatile("s_waitcnt lgkmcnt(0)" ::: "memory"); SBAR();
#define PK(L, H) (bf16x8){L[0], L[1], L[2], L[3], H[0], H[1], H[2], H[3]}
  od = __builtin_amdgcn_mfma_f32_32x32x16_bf16(pa0, PK(l0, h0), od, 0, 0, 0);
  od = __builtin_amdgcn_mfma_f32_32x32x16_bf16(pa1, PK(l1, h1), od, 0, 0, 0);
  od = __builtin_amdgcn_mfma_f32_32x32x16_bf16(pa2, PK(l2, h2), od, 0, 0, 0);
  od = __builtin_amdgcn_mfma_f32_32x32x16_bf16(pa3, PK(l3, h3), od, 0, 0, 0);
#undef PK
}
__device__ __forceinline__ void pv_d0(f32x16* o, int vb, bf16x8 pa0, bf16x8 pa1, bf16x8 pa2, bf16x8 pa3) {
  pv_one<0>(o[0], vb, pa0, pa1, pa2, pa3); pv_one<1>(o[1], vb, pa0, pa1, pa2, pa3); pv_one<2>(o[2], vb, pa0, pa1, pa2, pa3); pv_one<3>(o[3], vb, pa0, pa1, pa2, pa3);
}

template <typename TQ>
__device__ __forceinline__ void attn_dense_body(const TQ* __restrict__ Qb, const bf16* __restrict__ Kh, const bf16* __restrict__ Vh,
                                                bf16* __restrict__ Ob, int seq, char* lds) {
  using St = Stage<bf16>; using SQ = Stage<TQ>;
  int tid_o = wg_tid(); asm volatile("" : "+v"(tid_o)); const int tid = tid_o, wid = __builtin_amdgcn_readfirstlane(tid >> 6), lane = tid & 63, r32 = lane & 31, hi = lane >> 5;
  bf16* V_lds = (bf16*)lds; bf16* K_lds = (bf16*)(lds + 3 * SHM_V);
  float* ws = (float*)(lds + 3 * SHM_V + 3 * SHM_K) + wid * 64; float* li_l = ws; float* al_l = ws + 32;
  float m_reg = -1e30f, l_reg = 0; f32x16 o[4] = {}; bf16x8 qr[8];
  const TQ* Qw = Qb + (long)(wid * QBLK + r32) * LDQ + hi * 8;
#pragma unroll
  for (int d0 = 0; d0 < 8; ++d0) qr[d0] = SQ::tobf(SQ::ld8(Qw + d0 * 16));
  const int sr = tid >> 4, sc = (tid & 15) * 8, vst0 = v_st(sr, sc), vst1 = v_st(32 + sr, sc);
  const int vb0 = (int)(uintptr_t)V_lds + v_rd_base(lane);
  struct { typename St::T vs0, vs1, ks0, ks1; } sr_[SDEPTH];
#define SLOAD(i, k0) do { sr_[i].vs0 = St::ld8(&Vh[(long)((k0) + sr) * LDK + sc]); sr_[i].vs1 = St::ld8(&Vh[(long)((k0) + 32 + sr) * LDK + sc]); \
    sr_[i].ks0 = St::ld8(&Kh[(long)((k0) + sr) * LDK + sc]); sr_[i].ks1 = St::ld8(&Kh[(long)((k0) + 32 + sr) * LDK + sc]); } while (0)
#define SWRITE(b, i) do { *(bf16x8*)((char*)V_lds + (b) * SHM_V + vst0) = St::tobf(sr_[i].vs0);          \
    *(bf16x8*)((char*)V_lds + (b) * SHM_V + vst1) = St::tobf(sr_[i].vs1); int kc = sc * 2;               \
    *(bf16x8*)((char*)K_lds + (b) * SHM_K + KSWZ(sr, kc)) = St::tobf(sr_[i].ks0);                       \
    *(bf16x8*)((char*)K_lds + (b) * SHM_K + KSWZ(32 + sr, kc)) = St::tobf(sr_[i].ks1); } while (0)
#define SWAIT() do { if constexpr (SDEPTH == 2) asm volatile("s_waitcnt vmcnt(4)" ::: "memory"); else asm volatile("s_waitcnt vmcnt(0)" ::: "memory"); } while (0)
#define RESC(a) do { if (__any((a) < 1.f)) { if (hi == 0) al_l[r32] = (a); asm volatile("s_waitcnt lgkmcnt(0)" ::: "memory"); \
    for (int d = 0; d < 4; ++d) for (int r = 0; r < 16; ++r) o[d][r] *= al_l[crow(r, hi)]; } } while (0)
  f32x16 pA0, pA1, pB0, pB1; float mnA, mnB, alA, alB; bf16x8 pa0, pa1, pa2, pa3; const int NT = seq / KVBLK;
  constexpr int SE = 0, SO = SDEPTH - 1;
  SLOAD(SE, 0); asm volatile("s_waitcnt vmcnt(0)" ::: "memory"); SWRITE(0, SE); __syncthreads();
  qkt(pA0, pA1, K_lds, qr, r32, hi); partialSM(pA0, pA1, m_reg, mnA, alA);
  SLOAD(SO, KVBLK); if constexpr (SDEPTH == 2) { if (2 < NT) SLOAD(SE, 2 * KVBLK); }
  SWAIT(); SWRITE(1, SO); __syncthreads();
  int bk = 1, bv = 0, bw = 2;
  if (wid >= 4) __builtin_amdgcn_s_setprio(1);
#define ROT3() do { const int t_ = bv; bv = bk; bk = bw; bw = t_; } while (0)
  for (int j = 1; j + 1 < NT; j += 2) {
    SBAR(); qkt(pB0, pB1, (bf16*)((char*)K_lds + bk * SHM_K), qr, r32, hi);
    finishSM(pA0, pA1, alA, l_reg, pa0, pa1, pa2, pa3); SBAR();
    SLOAD(SO, (j + SDEPTH) * KVBLK); SBAR();
    pv_d0(o, vb0 + bv * (int)SHM_V, pa0, pa1, pa2, pa3); partialSM(pB0, pB1, m_reg, mnB, alB);
    SWAIT(); SWRITE(bw, SE);
    RESC(alB); __syncthreads(); ROT3();
    SBAR(); qkt(pA0, pA1, (bf16*)((char*)K_lds + bk * SHM_K), qr, r32, hi);
    finishSM(pB0, pB1, alB, l_reg, pa0, pa1, pa2, pa3); SBAR();
    if (SDEPTH == 1 || j + 3 < NT) SLOAD(SE, (j + 1 + SDEPTH) * KVBLK); SBAR();
    pv_d0(o, vb0 + bv * (int)SHM_V, pa0, pa1, pa2, pa3); partialSM(pA0, pA1, m_reg, mnA, alA);
    SWAIT(); SWRITE(bw, SO);
    RESC(alA); __syncthreads(); ROT3();
  }
  SBAR(); qkt(pB0, pB1, (bf16*)((char*)K_lds + bk * SHM_K), qr, r32, hi);
  finishSM(pA0, pA1, alA, l_reg, pa0, pa1, pa2, pa3); SBAR();
  pv_d0(o, vb0 + bv * (int)SHM_V, pa0, pa1, pa2, pa3); partialSM(pB0, pB1, m_reg, mnB, alB);
  RESC(alB);
  finishSM(pB0, pB1, alB, l_reg, pa0, pa1, pa2, pa3); SBAR();
  pv_d0(o, vb0 + bk * (int)SHM_V, pa0, pa1, pa2, pa3);
#undef ROT3
  __builtin_amdgcn_s_setprio(0);
  if (hi == 0) li_l[r32] = l_reg; asm volatile("s_waitcnt lgkmcnt(0)" ::: "memory");
  float rli[16];
#pragma unroll
  for (int r = 0; r < 16; ++r) rli[r] = __builtin_amdgcn_rcpf(li_l[crow(r, hi)]);
  bf16* Ow = Ob + (long)(wid * QBLK) * LDO;
#pragma unroll
  for (int r = 0; r < 16; ++r) { int orow = crow(r, hi);
    for (int d0 = 0; d0 < 4; ++d0) Ow[(long)orow * LDO + d0 * 32 + r32] = (bf16)(cvtpk(o[d0][r] * rli[r], 0.f) & 0xffffu); }
#undef SLOAD
#undef SWRITE
#undef SWAIT
#undef RESC
}

constexpr int NA_LD = 4096, NA_TILES = 12;
__device__ __forceinline__ void na_block_body(const bf16* __restrict__ Qb, const bf16* __restrict__ Kh, const bf16* __restrict__ Vh, bf16* __restrict__ Ob,
                                              const float* __restrict__ rpb_h, const float* __restrict__ qgain, const float* __restrict__ kgain, int R, int ks, char* lds) {
  using St = Stage<bf16>;
  int tid_o = wg_tid(); asm volatile("" : "+v"(tid_o)); const int tid = tid_o, wid = __builtin_amdgcn_readfirstlane(tid >> 6), lane = tid & 63, r32 = lane & 31, hi = lane >> 5;
  bf16* V_lds = (bf16*)lds; bf16* K_lds = (bf16*)(lds + 2 * SHM_V);
  float* ws = (float*)(lds + 2 * SHM_V + 2 * SHM_K) + wid * 64; float* li_l = ws; float* al_l = ws + 32;
  float* bt = (float*)(lds + 2 * SHM_V + 2 * SHM_K + NW * 64 * 4);
  float m_reg = -1e30f, l_reg = 0; f32x16 o[4] = {}; bf16x8 qr[8];
  const bf16* Qw = Qb + (long)(wid * QBLK + r32) * NA_LD + hi * 8;
#pragma unroll
  for (int d0 = 0; d0 < 8; ++d0) qr[d0] = St::ld8(Qw + d0 * 16);
  {
    float ss = 0.f;
#pragma unroll
    for (int d0 = 0; d0 < 8; ++d0) { const u32x4 w = __builtin_bit_cast(u32x4, qr[d0]);
#pragma unroll
      for (int e = 0; e < 4; ++e) { const float a = __uint_as_float(w[e] << 16), b = __uint_as_float(w[e] & 0xffff0000u); ss += a * a + b * b; } }
    ss += __shfl_xor(ss, 32);
    const float rinv = __builtin_amdgcn_rsqf(ss * (1.0f / 128.0f) + 1e-6f);
#pragma unroll
    for (int d0 = 0; d0 < 8; ++d0) { const u32x4 w = __builtin_bit_cast(u32x4, qr[d0]); const float* gp = qgain + d0 * 16 + hi * 8;
      const f32x8 g = *reinterpret_cast<const f32x8*>(gp); u32x4 o;
#pragma unroll
      for (int e = 0; e < 4; ++e) o[e] = cvtpk(__uint_as_float(w[e] << 16) * rinv * g[2 * e], __uint_as_float(w[e] & 0xffff0000u) * rinv * g[2 * e + 1]);
      qr[d0] = __builtin_bit_cast(bf16x8, o); } }
  const f32x8 kg = *reinterpret_cast<const f32x8*>(kgain + (tid & 15) * 8);
  for (int i = tid; i < 15 * 31; i += 64 * NW) bt[i] = rpb_h[i];
  const int sr = tid >> 4, sc = (tid & 15) * 8, vst0 = v_st(sr, sc), vst1 = v_st(32 + sr, sc);
  const int vb0 = (int)(uintptr_t)V_lds + v_rd_base(lane);
  bf16x8 s_vs0, s_vs1, s_ks0, s_ks1;
#define NLOAD(k0) do { s_vs0 = St::ld8(&Vh[(long)((k0) + sr) * NA_LD + sc]); s_vs1 = St::ld8(&Vh[(long)((k0) + 32 + sr) * NA_LD + sc]); \
    s_ks0 = St::ld8(&Kh[(long)((k0) + sr) * NA_LD + sc]); s_ks1 = St::ld8(&Kh[(long)((k0) + 32 + sr) * NA_LD + sc]); } while (0)
#define KNORM(x) do { const u32x4 w_ = __builtin_bit_cast(u32x4, x); float a_[8]; float ss_ = 0.f; \
    _Pragma("unroll") for (int e = 0; e < 4; ++e) { a_[2 * e] = __uint_as_float(w_[e] << 16); a_[2 * e + 1] = __uint_as_float(w_[e] & 0xffff0000u); ss_ += a_[2 * e] * a_[2 * e] + a_[2 * e + 1] * a_[2 * e + 1]; } \
    ss_ += __shfl_xor(ss_, 1); ss_ += __shfl_xor(ss_, 2); ss_ += __shfl_xor(ss_, 4); ss_ += __shfl_xor(ss_, 8); \
    const float ri_ = __builtin_amdgcn_rsqf(ss_ * (1.0f / 128.0f) + 1e-6f); u32x4 o_; \
    _Pragma("unroll") for (int e = 0; e < 4; ++e) o_[e] = cvtpk(a_[2 * e] * ri_ * kg[2 * e], a_[2 * e + 1] * ri_ * kg[2 * e + 1]); \
    x = __builtin_bit_cast(bf16x8, o_); } while (0)
#define NWRITE(b) do { KNORM(s_ks0); KNORM(s_ks1); \
    *(bf16x8*)((char*)V_lds + (b) * SHM_V + vst0) = s_vs0; *(bf16x8*)((char*)V_lds + (b) * SHM_V + vst1) = s_vs1; const int kc_ = sc * 2; \
    *(bf16x8*)((char*)K_lds + (b) * SHM_K + KSWZ(sr, kc_)) = s_ks0; *(bf16x8*)((char*)K_lds + (b) * SHM_K + KSWZ(32 + sr, kc_)) = s_ks1; } while (0)
  const int qrow = R + (wid >> 1), r0q = min(max(qrow - 4, 0), 248), jlo = r0q - ks;
  const int c = 32 * (wid & 1) + r32, c0 = min(max(c - 8, 0), 48);
  NLOAD(0); asm volatile("s_waitcnt vmcnt(0)" ::: "memory"); NWRITE(0); __syncthreads();
  for (int j = 0; j < NA_TILES; ++j) {
    const int buf = j & 1;
    if (j + 1 < NA_TILES) NLOAD((j + 1) * KVBLK);
    if (j >= jlo && j < jlo + 8) {
      f32x16 p0, p1; float mn, al; bf16x8 pa0, pa1, pa2, pa3;
      SBAR(); qkt(p0, p1, (bf16*)((char*)K_lds + buf * SHM_K), qr, r32, hi);
      const float* brow = bt + (ks + j - qrow + 7) * 31 + (15 - c);
#pragma unroll
      for (int r = 0; r < 16; ++r) { const int k0 = crow(r, hi), k1 = 32 + k0; const bool v0 = (k0 >= c0) && (k0 < c0 + 16), v1 = (k1 >= c0) && (k1 < c0 + 16);
        const float b0 = brow[v0 ? k0 : c], b1 = brow[v1 ? k1 : c];
        p0[r] = v0 ? fmaf(b0, 1.0f / SCALE, p0[r]) : -1e30f; p1[r] = v1 ? fmaf(b1, 1.0f / SCALE, p1[r]) : -1e30f; }
      partialSM(p0, p1, m_reg, mn, al);
      if (__any(al < 1.f)) { if (hi == 0) al_l[r32] = al; asm volatile("s_waitcnt lgkmcnt(0)" ::: "memory");
#pragma unroll
        for (int d = 0; d < 4; ++d)
#pragma unroll
          for (int r = 0; r < 16; ++r) o[d][r] *= al_l[crow(r, hi)]; }
      finishSM(p0, p1, al, l_reg, pa0, pa1, pa2, pa3); SBAR();
      pv_d0(o, vb0 + buf * (int)SHM_V, pa0, pa1, pa2, pa3);
    }
    if (j + 1 < NA_TILES) { asm volatile("s_waitcnt vmcnt(0)" ::: "memory"); NWRITE(buf ^ 1); }
    __syncthreads();
  }
  if (hi == 0) li_l[r32] = l_reg; asm volatile("s_waitcnt lgkmcnt(0)" ::: "memory");
  float rli[16];
#pragma unroll
  for (int r = 0; r < 16; ++r) rli[r] = 64.0f * __builtin_amdgcn_rcpf(li_l[crow(r, hi)]);
  unsigned char* Ow = (unsigned char*)Ob + (long)(wid * QBLK) * NA_LD;
#pragma unroll
  for (int r = 0; r < 16; ++r) { const int orow = crow(r, hi);
    for (int d0 = 0; d0 < 4; ++d0) Ow[(long)orow * NA_LD + d0 * 32 + r32] = (unsigned char)__builtin_amdgcn_cvt_pk_fp8_f32(o[d0][r] * rli[r], 0.f, 0, false); }
#undef NLOAD
#undef NWRITE
#undef KNORM
}

typedef int v8i __attribute__((ext_vector_type(8)));
typedef unsigned u32x2 __attribute__((ext_vector_type(2)));
constexpr int K8_LD = 1024, V8_LD = 16384, SHM_K8 = KVBLK * D, SHM_V8 = KVBLK * D;
constexpr float THR8 = 3.0f;
__device__ __forceinline__ int cvt4_fp8(float a, float b, float c, float d) { int w = __builtin_amdgcn_cvt_pk_fp8_f32(a, b, 0, false); return __builtin_amdgcn_cvt_pk_fp8_f32(c, d, w, true); }
__device__ __forceinline__ int cvt4_fp8_into(int w, float a, float b, float c, float d) { w = __builtin_amdgcn_cvt_pk_fp8_f32(a, b, w, false); return __builtin_amdgcn_cvt_pk_fp8_f32(c, d, w, true); }
__device__ __forceinline__ v8i mk8(u32x4 lo, u32x4 hi) { return (v8i){(int)lo[0], (int)lo[1], (int)lo[2], (int)lo[3], (int)hi[0], (int)hi[1], (int)hi[2], (int)hi[3]}; }
__device__ __forceinline__ void qkt8(f32x16& p0, f32x16& p1, const char* Ks, const v8i* qf, int r32, int hi) {
  const int x0 = (r32 >> 1) & 7, x1 = ((32 + r32) >> 1) & 7;
  const char* k0 = Ks + r32 * 128; const char* k1 = Ks + (32 + r32) * 128;
  v8i a[2][2];
#pragma unroll
  for (int s = 0; s < 2; ++s) { const int c = 4 * s + 2 * hi;
    a[0][s] = mk8(*reinterpret_cast<const u32x4*>(k0 + 16 * (c ^ x0)), *reinterpret_cast<const u32x4*>(k0 + 16 * ((c + 1) ^ x0)));
    a[1][s] = mk8(*reinterpret_cast<const u32x4*>(k1 + 16 * (c ^ x1)), *reinterpret_cast<const u32x4*>(k1 + 16 * ((c + 1) ^ x1))); }
  p0 = f32x16{}; p1 = f32x16{};
#pragma unroll
  for (int s = 0; s < 2; ++s) {
    p0 = __builtin_amdgcn_mfma_scale_f32_32x32x64_f8f6f4(a[0][s], qf[s], p0, 0, 0, 0, 0x7F7F7F7F, 0, 0x7F7F7F7F);
    p1 = __builtin_amdgcn_mfma_scale_f32_32x32x64_f8f6f4(a[1][s], qf[s], p1, 0, 0, 0, 0x7F7F7F7F, 0, 0x7F7F7F7F); }
}
__device__ __forceinline__ void partialSM8(f32x16& p0, f32x16& p1, float& m_reg, float& mn, float& alpha) {
  constexpr float C = SCALE * 1.4426950408889634f;
  float pmax;
  asm("v_max3_f32 %0, %1, %2, %3" : "=v"(pmax) : "v"(p0[0]), "v"(p0[1]), "v"(p0[2]));
#pragma unroll
  for (int r = 3; r < 15; r += 2) asm("v_max3_f32 %0, %0, %1, %2" : "+v"(pmax) : "v"(p0[r]), "v"(p0[r + 1]));
  asm("v_max3_f32 %0, %0, %1, %2" : "+v"(pmax) : "v"(p0[15]), "v"(p1[0]));
#pragma unroll
  for (int r = 1; r < 15; r += 2) asm("v_max3_f32 %0, %0, %1, %2" : "+v"(pmax) : "v"(p1[r]), "v"(p1[r + 1]));
  asm("v_max_f32 %0, %0, %1" : "+v"(pmax) : "v"(p1[15]));
  { auto rr = __builtin_amdgcn_permlane32_swap(__float_as_uint(pmax), __float_as_uint(pmax), false, false);
    pmax = fmaxf(__uint_as_float(rr[0]), __uint_as_float(rr[1])); }
  if (__builtin_expect(__all(pmax - m_reg <= THR8 / SCALE), 1)) { mn = m_reg; alpha = 1.f; }
  else { mn = fmaxf(m_reg, pmax); alpha = __builtin_amdgcn_exp2f((m_reg - mn) * C); m_reg = mn; }
  const float mnC = 4.0f - mn * C;
  { const f32x2 C2 = (f32x2){C, C}, m2 = (f32x2){mnC, mnC};
#pragma unroll
    for (int r = 0; r < 16; r += 2) { f32x2 a = (f32x2){p0[r], p0[r + 1]}, b = (f32x2){p1[r], p1[r + 1]};
      asm("v_pk_fma_f32 %0, %0, %1, %2" : "+v"(a) : "v"(C2), "v"(m2)); asm("v_pk_fma_f32 %0, %0, %1, %2" : "+v"(b) : "v"(C2), "v"(m2));
      p0[r] = a[0]; p0[r + 1] = a[1]; p1[r] = b[0]; p1[r + 1] = b[1]; } }
  for (int r = 0; r < 16; ++r) p0[r] = __builtin_amdgcn_exp2f(p0[r]);
}
__device__ __forceinline__ void finishSM8(f32x16& p0, f32x16& p1, v8i& pa) {
  for (int r = 0; r < 16; ++r) p1[r] = __builtin_amdgcn_exp2f(p1[r]);
#pragma unroll
  for (int v = 0; v < 4; ++v) { pa[v] = cvt4_fp8_into(pa[v], p0[4 * v], p0[4 * v + 1], p0[4 * v + 2], p0[4 * v + 3]); pa[4 + v] = cvt4_fp8_into(pa[4 + v], p1[4 * v], p1[4 * v + 1], p1[4 * v + 2], p1[4 * v + 3]); }
}
__device__ __forceinline__ void pv8(f32x16* o, const char* Vs, const v8i& pa, int r32, int hi) {
  v8i b[4];
#pragma unroll
  for (int db = 0; db < 4; ++db) { const int d = 32 * db + r32, x = (d >> 2) & 3; const char* vp = Vs + d * 64;
    b[db] = mk8(*reinterpret_cast<const u32x4*>(vp + 16 * ((2 * hi) ^ x)), *reinterpret_cast<const u32x4*>(vp + 16 * ((2 * hi + 1) ^ x))); }
  const v8i ones = (v8i){0x38383838, 0x38383838, 0x38383838, 0x38383838, 0x38383838, 0x38383838, 0x38383838, 0x38383838};
#pragma unroll
  for (int db = 0; db < 4; ++db) o[db] = __builtin_amdgcn_mfma_scale_f32_32x32x64_f8f6f4(pa, b[db], o[db], 0, 0, 0, 0x7F7F7F7F, 0, 0x7F7F7F7F);
  o[4] = __builtin_amdgcn_mfma_scale_f32_32x32x64_f8f6f4(pa, ones, o[4], 0, 0, 0, 0x7F7F7F7F, 0, 0x7F7F7F7F);
}
__device__ __forceinline__ void attn_dense_body8(const bf16* __restrict__ Qb, const unsigned char* __restrict__ K8h, const unsigned char* __restrict__ V8h, bf16* __restrict__ Ob, int seq, char* lds) {
  int tid_o = wg_tid(); asm volatile("" : "+v"(tid_o)); const int tid = tid_o, wid = __builtin_amdgcn_readfirstlane(tid >> 6), lane = tid & 63, r32 = lane & 31, hi = lane >> 5;
  char* V_lds = lds; char* K_lds = lds + 3 * SHM_V8;
  float* ws = (float*)(lds + 3 * SHM_V8 + 3 * SHM_K8) + wid * 64; float* al_l = ws + 32;
  float m_reg = -1e30f; f32x16 o[5] = {}; v8i qf[2];
  { const bf16* Qw = Qb + (long)(wid * QBLK + r32) * LDQ + hi * 32;
#pragma unroll
    for (int s = 0; s < 2; ++s) {
#pragma unroll
      for (int c = 0; c < 4; ++c) { const u32x4 w = *reinterpret_cast<const u32x4*>(Qw + s * 64 + c * 8);
        qf[s][2 * c] = cvt4_fp8(__uint_as_float(w[0] << 16), __uint_as_float(w[0] & 0xffff0000u), __uint_as_float(w[1] << 16), __uint_as_float(w[1] & 0xffff0000u));
        qf[s][2 * c + 1] = cvt4_fp8(__uint_as_float(w[2] << 16), __uint_as_float(w[2] & 0xffff0000u), __uint_as_float(w[3] << 16), __uint_as_float(w[3] & 0xffff0000u)); } } }
  const int skey = tid >> 3, sck = tid & 7, sd = tid >> 2, sc4 = tid & 3;
  const int kst = skey * 128 + 16 * (sck ^ ((skey >> 1) & 7));
  const int vx = (sd >> 2) & 3, vst0 = sd * 64 + 16 * ((sc4 >> 1) ^ vx) + 8 * (sc4 & 1), vst1 = sd * 64 + 16 * ((2 + (sc4 >> 1)) ^ vx) + 8 * (sc4 & 1);
  const unsigned char* kg = K8h + (long)skey * K8_LD + 16 * sck; const unsigned char* vg = V8h + (long)sd * V8_LD + 16 * sc4;
  struct { u32x4 k, v; } sr_[2];
#define SLOAD8(i, k0) do { sr_[i].k = *reinterpret_cast<const u32x4*>(kg + (long)(k0) * K8_LD); sr_[i].v = *reinterpret_cast<const u32x4*>(vg + (k0)); } while (0)
#define SWRITE8(b, i) do { *reinterpret_cast<u32x4*>(K_lds + (b) * SHM_K8 + kst) = sr_[i].k; \
    *reinterpret_cast<u32x2*>(V_lds + (b) * SHM_V8 + vst0) = (u32x2){sr_[i].v[0], sr_[i].v[2]}; *reinterpret_cast<u32x2*>(V_lds + (b) * SHM_V8 + vst1) = (u32x2){sr_[i].v[1], sr_[i].v[3]}; } while (0)
#define SWAIT8() asm volatile("s_waitcnt vmcnt(2)" ::: "memory")
#define RESC8(a) do { if (__any((a) < 1.f)) { if (hi == 0) al_l[r32] = (a); asm volatile("s_waitcnt lgkmcnt(0)" ::: "memory"); \
    for (int d = 0; d < 5; ++d) for (int r = 0; r < 16; ++r) o[d][r] *= al_l[crow(r, hi)]; } } while (0)
  f32x16 pA0, pA1, pB0, pB1; float mnA, mnB, alA, alB; v8i pa = {}; const int NT = seq / KVBLK;
  SLOAD8(0, 0); asm volatile("s_waitcnt vmcnt(0)" ::: "memory"); SWRITE8(0, 0); __syncthreads();
  qkt8(pA0, pA1, K_lds, qf, r32, hi);
  asm volatile("s_nop 15\n\ts_nop 7" : "+v"(pA0), "+v"(pA1));
  partialSM8(pA0, pA1, m_reg, mnA, alA);
  SLOAD8(1, KVBLK); if (2 < NT) SLOAD8(0, 2 * KVBLK);
  SWAIT8(); SWRITE8(1, 1); __syncthreads();
  int bk = 1, bv = 0, bw = 2;
  if (wid >= 4) __builtin_amdgcn_s_setprio(1);
#define ROT3() do { const int t_ = bv; bv = bk; bk = bw; bw = t_; } while (0)
  for (int j = 1; j + 1 < NT; j += 2) {
    SBAR(); qkt8(pB0, pB1, K_lds + bk * SHM_K8, qf, r32, hi);
    finishSM8(pA0, pA1, pa); SBAR();
    SLOAD8(1, (j + 2) * KVBLK); SBAR();
    pv8(o, V_lds + bv * SHM_V8, pa, r32, hi); partialSM8(pB0, pB1, m_reg, mnB, alB);
    SWAIT8(); SWRITE8(bw, 0);
    RESC8(alB); __syncthreads(); ROT3();
    SBAR(); qkt8(pA0, pA1, K_lds + bk * SHM_K8, qf, r32, hi);
    finishSM8(pB0, pB1, pa); SBAR();
    if (j + 3 < NT) SLOAD8(0, (j + 3) * KVBLK); SBAR();
    pv8(o, V_lds + bv * SHM_V8, pa, r32, hi); partialSM8(pA0, pA1, m_reg, mnA, alA);
    SWAIT8(); SWRITE8(bw, 1);
    RESC8(alA); __syncthreads(); ROT3();
  }
  SBAR(); qkt8(pB0, pB1, K_lds + bk * SHM_K8, qf, r32, hi);
  finishSM8(pA0, pA1, pa); SBAR();
  pv8(o, V_lds + bv * SHM_V8, pa, r32, hi); partialSM8(pB0, pB1, m_reg, mnB, alB);
  RESC8(alB);
  finishSM8(pB0, pB1, pa); SBAR();
  pv8(o, V_lds + bk * SHM_V8, pa, r32, hi);
#undef ROT3
  __builtin_amdgcn_s_setprio(0);
  float rli[16];
#pragma unroll
  for (int r = 0; r < 16; ++r) rli[r] = 64.0f * __builtin_amdgcn_rcpf(o[4][r]);
  unsigned char* Ow = (unsigned char*)Ob + (long)(wid * QBLK) * LDO;
#pragma unroll
  for (int r = 0; r < 16; ++r) { const int orow = crow(r, hi);
    for (int d0 = 0; d0 < 4; ++d0) Ow[(long)orow * LDO + d0 * 32 + r32] = (unsigned char)__builtin_amdgcn_cvt_pk_fp8_f32(o[d0][r] * rli[r], 0.f, 0, false); }
#undef SLOAD8
#undef SWRITE8
#undef SWAIT8
#undef RESC8
}
}
struct Frame {
    LAS unsigned char* lds;
    int tid, lane, wave;
    int bid, vcu, G;
};
__device__ __forceinline__ float wave_sum(float v) {
#pragma unroll
    for (int o = 1; o < 64; o <<= 1) v += __shfl_xor(v, o);
    return v;
}
__device__ __forceinline__ void xrows_phase(const Frame& F, const float* __restrict__ h, bf16* __restrict__ hb, pg8::rs_t* __restrict__ rs, unsigned char* __restrict__ hb8) {
    const int gw = F.vcu * 8 + F.wave, NGW = F.G * 8;
    for (int m = gw; m < L; m += NGW) {
        const f32x4* xr = (const f32x4*)(h + (size_t)m * DM) + F.lane;
        v2u* o8 = (v2u*)(hb + (size_t)m * DM) + F.lane;
        float s = 0.f;
#pragma unroll
        for (int j = 0; j < 16; ++j) { const f32x4 v = xr[64 * j]; s += (v.x * v.x + v.y * v.y) + (v.z * v.z + v.w * v.w); v2u w; w.x = pk2(v.x, v.y); w.y = pk2(v.z, v.w); o8[64 * j] = w;
            int w8 = __builtin_amdgcn_cvt_pk_fp8_f32(v.x, v.y, 0, false); w8 = __builtin_amdgcn_cvt_pk_fp8_f32(v.z, v.w, w8, true); *((unsigned*)(hb8 + (size_t)m * DM) + 64 * j + F.lane) = (unsigned)w8; }
        s = wave_sum(s);
        if (F.lane == 0) rs[m] = (pg8::rs_t)(s * pg8::RS_FIX);
    }
}
__device__ __forceinline__ void headnorm_rows(bf16* __restrict__ X, int ld, int nheads, const float* __restrict__ gain, int t, int lane, bool rope, const float (&cs)[8], const float (&sn)[8], unsigned char* __restrict__ X8 = nullptr) {
    const int hs = lane >> 4, l16 = lane & 15;
    f32x4 g0 = *(const f32x4*)(gain + 8 * l16), g1 = *(const f32x4*)(gain + 8 * l16 + 4);
    const float gg[8] = {g0.x, g0.y, g0.z, g0.w, g1.x, g1.y, g1.z, g1.w};
    const bool second = ((l16 >> 2) & 1) != 0;
    for (int hg = 0; hg < nheads / 4; ++hg) {
        bf16* p = X + (size_t)t * ld + (size_t)(4 * hg + hs) * HD + 8 * l16;
        const v4u raw = *(const v4u*)p;
        float x[8] = {bflo(raw.x), bfhi(raw.x), bflo(raw.y), bfhi(raw.y), bflo(raw.z), bfhi(raw.z), bflo(raw.w), bfhi(raw.w)};
        float ss = 0.f;
#pragma unroll
        for (int e = 0; e < 8; ++e) ss += x[e] * x[e];
        ss += __shfl_xor(ss, 1); ss += __shfl_xor(ss, 2); ss += __shfl_xor(ss, 4); ss += __shfl_xor(ss, 8);
        const float rinv = 1.0f / sqrtf(ss * (1.0f / HD) + EPS);
        float y[8];
#pragma unroll
        for (int e = 0; e < 8; ++e) y[e] = x[e] * rinv * gg[e];
        if (rope) {
#pragma unroll
            for (int e = 0; e < 8; ++e) { const float yp = __shfl_xor(y[e], 4); y[e] = second ? (y[e] * cs[e] + yp * sn[e]) : (y[e] * cs[e] - yp * sn[e]); }
        }
        if (X8) { int w0 = __builtin_amdgcn_cvt_pk_fp8_f32(y[0], y[1], 0, false); w0 = __builtin_amdgcn_cvt_pk_fp8_f32(y[2], y[3], w0, true);
            int w1 = __builtin_amdgcn_cvt_pk_fp8_f32(y[4], y[5], 0, false); w1 = __builtin_amdgcn_cvt_pk_fp8_f32(y[6], y[7], w1, true);
            *(v2u*)(X8 + (size_t)t * ld + (size_t)(4 * hg + hs) * HD + 8 * l16) = (v2u){(unsigned)w0, (unsigned)w1}; }
        else { v4u w; w.x = pk2(y[0], y[1]); w.y = pk2(y[2], y[3]); w.z = pk2(y[4], y[5]); w.w = pk2(y[6], y[7]);
            *(v4u*)p = w; }
    }
}
__device__ __forceinline__ void prep_phase(const Frame& F, bf16* Q, bf16* K, int ldk, int nkh, const float* qgain, const float* kgain, bool rope, unsigned char* K8 = nullptr) {
    const int gw = F.vcu * 8 + F.wave, NGW = F.G * 8;
    const int l16 = F.lane & 15;
    for (int t = gw; t < L; t += NGW) {
        float cs[8], sn[8];
#pragma unroll
        for (int e = 0; e < 8; ++e) { cs[e] = 1.f; sn[e] = 0.f; }
        if (rope) {
            const int ax = l16 >> 3; const float pos = (float)(ax ? (t & (GRID_W - 1)) : (t / GRID_W));
#pragma unroll
            for (int e = 0; e < 8; ++e) { const int f = (l16 & 3) * 8 + e; const float inv = 1.0f / powf(10000.0f, (float)f * (1.0f / 32.0f)); const float ang = pos * inv; cs[e] = cosf(ang); sn[e] = sinf(ang); }
        }
        headnorm_rows(Q, DM, NH, qgain, t, F.lane, rope, cs, sn);
        headnorm_rows(K, ldk, nkh, kgain, t, F.lane, rope, cs, sn, K8);
    }
}

constexpr int S5T = pg8::S5T, S5NCH = pg8::S5NCH, S5KS = pg8::S5KS;
__device__ __forceinline__ void s5_gen_group(const Frame& F, int g, const float* __restrict__ lam_re, const float* __restrict__ lam_im, const float* __restrict__ log_step,
                                             const float* __restrict__ b_re, const float* __restrict__ b_im, const float* __restrict__ c_re, const float* __restrict__ c_im,
                                             bf16* __restrict__ GM, bf16* __restrict__ BMt, f32x2* __restrict__ PAT) {
    LAS f32x2* apow = (LAS f32x2*)F.lds;
    LAS f32x2* zt = apow + 2 * 33 * 64;
    LAS float* Kd = (LAS float*)(zt + 2 * 64);
    const int tid = F.tid;
    if (tid < 128) {
        const int dir = tid >> 6, n = tid & 63, dg = dir * S5G + g, idx = dg * S5N + n;
        const double dt = exp((double)log_step[dg]);
        const double lr = (double)lam_re[idx], li = (double)lam_im[idx];
        const double mag = exp(lr * dt), are = mag * cos(li * dt), aim = mag * sin(li * dt);
        const double den = lr * lr + li * li, nre = are - 1.0;
        zt[dir * 64 + n] = (f32x2){(float)((nre * lr + aim * li) / den), (float)((aim * lr - nre * li) / den)};
        double pr = 1.0, pi = 0.0;
        for (int k = 0; k <= 32; ++k) { apow[(dir * 33 + k) * 64 + n] = (f32x2){(float)pr, (float)pi}; const double t = pr * are - pi * aim; pi = pr * aim + pi * are; pr = t; }
        PAT[idx] = apow[(dir * 33 + 32) * 64 + n];
    }
    LDS_WAIT(); __syncthreads();
    {
        const int dir = tid >> 8, p = (tid >> 4) & 15, q = tid & 15, dg = dir * S5G + g;
        float wr[64], wi[64];
        const float* cr = c_re + ((size_t)dg * S5P + p) * S5N; const float* ci = c_im + ((size_t)dg * S5P + p) * S5N;
#pragma unroll
        for (int n = 0; n < 64; ++n) { const f32x2 z = zt[dir * 64 + n]; const float br = b_re[((size_t)dg * S5N + n) * S5P + q], bi = b_im[((size_t)dg * S5N + n) * S5P + q];
            const float bbr = z.x * br - z.y * bi, bbi = z.x * bi + z.y * br; const float c0 = cr[n], c1 = ci[n];
            wr[n] = c0 * bbr - c1 * bbi; wi[n] = c0 * bbi + c1 * bbr; }
        for (int d = 0; d < 32; ++d) { float acc = 0.f; const LAS f32x2* ap = apow + (dir * 33 + d) * 64;
#pragma unroll
            for (int n = 0; n < 64; ++n) { const f32x2 a = ap[n]; acc = fmaf(wr[n], a.x, acc); acc = fmaf(-wi[n], a.y, acc); }
            Kd[(dir * 32 + d) * 256 + p * 16 + q] = acc; }
    }
    LDS_WAIT(); __syncthreads();
    bf16* BMg = BMt + (size_t)g * 512 * S5KS;
    for (int it = tid; it < 512 * 64; it += 512) { const int row = it >> 6, ch = it & 63, tau = row >> 4, p = row & 15, sg = ch >> 1, q0 = (ch & 1) * 8;
        float v[8];
        if (sg < tau) { const LAS float* k = Kd + (0 * 32 + (tau - sg)) * 256 + p * 16 + q0;
#pragma unroll
            for (int j = 0; j < 8; ++j) v[j] = k[j]; }
        else if (sg > tau) { const LAS float* k = Kd + (1 * 32 + (sg - tau)) * 256 + p * 16 + q0;
#pragma unroll
            for (int j = 0; j < 8; ++j) v[j] = k[j]; }
        else { const LAS float* k0 = Kd + p * 16 + q0; const LAS float* k1 = Kd + 32 * 256 + p * 16 + q0;
#pragma unroll
            for (int j = 0; j < 8; ++j) v[j] = k0[j] + k1[j]; }
        v4u w; w.x = pk2(v[0], v[1]); w.y = pk2(v[2], v[3]); w.z = pk2(v[4], v[5]); w.w = pk2(v[6], v[7]);
        *(v4u*)(BMg + (size_t)row * S5KS + ch * 8) = w; }
    for (int it = tid; it < 512 * 32; it += 512) { const int row = it >> 5, ch = it & 31, tau = row >> 4, p = row & 15, dir = ch >> 4, n0 = (ch & 15) * 4, dg = dir * S5G + g;
        const int k = dir ? (32 - tau) : (tau + 1);
        const f32x4 cr = *(const f32x4*)(c_re + ((size_t)dg * S5P + p) * S5N + n0), ci = *(const f32x4*)(c_im + ((size_t)dg * S5P + p) * S5N + n0);
        const LAS f32x2* ap = apow + (dir * 33 + k) * 64 + n0;
        unsigned o[4];
#pragma unroll
        for (int j = 0; j < 4; ++j) { const f32x2 a = ap[j]; const float vr = cr[j] * a.x - ci[j] * a.y, vi = cr[j] * a.y + ci[j] * a.x; o[j] = pk2(vr, -vi); }
        *(v4u*)(BMg + (size_t)row * S5KS + 512 + ch * 8) = (v4u){o[0], o[1], o[2], o[3]}; }
    bf16* GMg = GM + (size_t)g * 256 * 512;
    for (int it = tid; it < 128 * 64; it += 512) { const int dn = it >> 6, ch = it & 63, dir = dn >> 6, n = dn & 63, sg = ch >> 1, q0 = (ch & 1) * 8, dg = dir * S5G + g;
        const int pw = dir ? sg : (31 - sg);
        const f32x2 a = apow[(dir * 33 + pw) * 64 + n], z = zt[dir * 64 + n];
        const float wr_ = a.x * z.x - a.y * z.y, wi_ = a.x * z.y + a.y * z.x;
        const float* br = b_re + ((size_t)dg * S5N + n) * S5P + q0; const float* bi = b_im + ((size_t)dg * S5N + n) * S5P + q0;
        float re[8], im[8];
#pragma unroll
        for (int j = 0; j < 8; ++j) { re[j] = wr_ * br[j] - wi_ * bi[j]; im[j] = wr_ * bi[j] + wi_ * br[j]; }
        v4u w0, w1; w0.x = pk2(re[0], re[1]); w0.y = pk2(re[2], re[3]); w0.z = pk2(re[4], re[5]); w0.w = pk2(re[6], re[7]);
        w1.x = pk2(im[0], im[1]); w1.y = pk2(im[2], im[3]); w1.z = pk2(im[4], im[5]); w1.w = pk2(im[6], im[7]);
        *(v4u*)(GMg + (size_t)(dir * 128 + 2 * n) * 512 + ch * 8) = w0; *(v4u*)(GMg + (size_t)(dir * 128 + 2 * n + 1) * 512 + ch * 8) = w1; }
    LDS_WAIT(); __syncthreads();
}
__device__ __forceinline__ void s5_scan_phase(const Frame& F, const f32x2* __restrict__ PAT, const float* __restrict__ E, bf16* __restrict__ UA) {
    for (int task = F.bid + F.G * F.wave; task < 2 * S5G; task += F.G * 8) {
        const int dir = task >> 8, g = task & 255;
        const f32x2 a = PAT[task * S5N + F.lane];
        const float* e = E + (size_t)g * S5NCH * 256 + dir * 128 + 2 * F.lane;
        bf16* s = UA + (size_t)g * S5NCH * S5KS + 512 + dir * 128 + 2 * F.lane;
        float cr = 0.f, ci = 0.f;
        for (int c8 = 0; c8 < S5NCH; c8 += 8) {
            f32x2 v[8];
#pragma unroll
            for (int k = 0; k < 8; ++k) { const int c = dir ? (S5NCH - 1 - (c8 + k)) : (c8 + k); v[k] = *(const f32x2*)(e + (size_t)c * 256); }
#pragma unroll
            for (int k = 0; k < 8; ++k) { const int c = dir ? (S5NCH - 1 - (c8 + k)) : (c8 + k);
                *(unsigned*)(s + (size_t)c * S5KS) = pk2(cr, ci);
                const float nr = fmaf(a.x, cr, fmaf(-a.y, ci, v[k].x)), ni = fmaf(a.x, ci, fmaf(a.y, cr, v[k].y)); cr = nr; ci = ni; }
        }
    }
}


__device__ __forceinline__ float fp8_to_f32(unsigned char b) { const int e = (b >> 3) & 15, m = b & 7; const float v = e ? __builtin_ldexpf(1.0f + (float)m * 0.125f, e - 7) : __builtin_ldexpf((float)m * 0.125f, -6); return (b & 0x80) ? -v : v; }
__device__ __forceinline__ void gqa_selfcheck(const Frame& F, const bf16* __restrict__ Qp, const unsigned char* __restrict__ K8, const unsigned char* __restrict__ V8t, const bf16* __restrict__ O,
                                              float* __restrict__ SC, unsigned* flag) {
    LAS float* ql = (LAS float*)(F.lds + F.wave * 1024);
    const int lane = F.lane;
#pragma unroll 1
    for (int s = F.bid * 8 + F.wave; s < 1024; s += F.G * 8) {
        const int tok = (int)(((long)(s >> 5) * 5209 + 77) % L), hq = s & 31, kv = hq >> 2;
        float* sc = SC + (size_t)(F.bid * 8 + F.wave) * L;
        { const bf16* qp = Qp + (size_t)tok * DM + hq * HD; ql[lane] = bf2f(qp[lane]); ql[lane + 64] = bf2f(qp[lane + 64]); } LDS_WAIT();
        float mx = -1e30f;
#pragma unroll 1
        for (int j = lane; j < L; j += 64) { const unsigned char* kp = K8 + (size_t)j * KVD + kv * HD; float dot = 0.f;
#pragma unroll 1
            for (int d = 0; d < HD; ++d) dot += fp8_to_f32(kp[d]) * ql[d];
            dot *= 0.088388347648318440f; sc[j] = dot; mx = fmaxf(mx, dot); }
#pragma unroll
        for (int o = 1; o < 64; o <<= 1) mx = fmaxf(mx, __shfl_xor(mx, o));
        asm volatile("s_waitcnt vmcnt(0)" ::: "memory"); __builtin_amdgcn_fence(__ATOMIC_RELEASE, "workgroup"); __builtin_amdgcn_fence(__ATOMIC_ACQUIRE, "agent");
        float o0 = 0.f, o1 = 0.f, lsum = 0.f;
#pragma unroll 1
        for (int j = 0; j < L; ++j) { const float pj = expf(__hip_atomic_load(sc + j, __ATOMIC_RELAXED, __HIP_MEMORY_SCOPE_AGENT) - mx);
            o0 += pj * fp8_to_f32(V8t[(size_t)(kv * HD + lane) * L + j]); o1 += pj * fp8_to_f32(V8t[(size_t)(kv * HD + lane + 64) * L + j]); lsum += pj; }
        o0 /= lsum; o1 /= lsum;
        const unsigned char* op = (const unsigned char*)O + (size_t)tok * DM + hq * HD; const float g0 = fp8_to_f32(op[lane]) * 0.015625f, g1 = fp8_to_f32(op[lane + 64]) * 0.015625f;
        float am = fmaxf(fabsf(o0), fabsf(o1));
#pragma unroll
        for (int o = 1; o < 64; o <<= 1) am = fmaxf(am, __shfl_xor(am, o));
        const float tol = 0.2f * am + 1e-5f;
        const bool bad = !(fabsf(g0 - o0) <= tol) || !(fabsf(g1 - o1) <= tol);
        if (__any(bad) && lane == 0) __hip_atomic_fetch_or(flag, 1u, __ATOMIC_RELAXED, __HIP_MEMORY_SCOPE_AGENT);
        LDS_WAIT();
    }
}

__device__ __forceinline__ void transpose_item(const float* __restrict__ W, int K, int N, bf16* __restrict__ WT, int mode, const float* __restrict__ gain, LAS float* scr, int item, int lane, int fp8 = 0) {
    const int nblk = N / 32, kb = item / nblk, nb = item % nblk, k0 = 64 * kb, n0 = 32 * nb;
    int r0 = n0;
    if (mode == 1) r0 = (n0 < DM) ? ((n0 >> 7) * 256 + (n0 & 127)) : (((n0 - DM) >> 7) * 256 + 128 + ((n0 - DM) & 127));
    const float* src = W + (size_t)(k0 + (lane >> 5)) * N + n0 + (lane & 31);
    float v[32];
#pragma unroll
    for (int i = 0; i < 32; ++i) v[i] = src[(size_t)(2 * i) * N];
    const int c = lane & 7;
    f32x4 g0 = (f32x4){1.f, 1.f, 1.f, 1.f}, g1 = g0;
    if (gain) { g0 = *(const f32x4*)(gain + k0 + 8 * c); g1 = *(const f32x4*)(gain + k0 + 8 * c + 4); }
#pragma unroll
    for (int i = 0; i < 32; ++i) scr[(2 * i + (lane >> 5)) * 33 + (lane & 31)] = v[i];
    LDS_WAIT(); asm volatile("" ::: "memory");
#pragma unroll
    for (int j = 0; j < 4; ++j) { const int n = (lane >> 3) + 8 * j; const LAS float* s = scr + (8 * c) * 33 + n;
        if (fp8) { int w0 = __builtin_amdgcn_cvt_pk_fp8_f32(64.f * s[0 * 33] * g0.x, 64.f * s[1 * 33] * g0.y, 0, false); w0 = __builtin_amdgcn_cvt_pk_fp8_f32(64.f * s[2 * 33] * g0.z, 64.f * s[3 * 33] * g0.w, w0, true);
            int w1 = __builtin_amdgcn_cvt_pk_fp8_f32(64.f * s[4 * 33] * g1.x, 64.f * s[5 * 33] * g1.y, 0, false); w1 = __builtin_amdgcn_cvt_pk_fp8_f32(64.f * s[6 * 33] * g1.z, 64.f * s[7 * 33] * g1.w, w1, true);
            *(v2u*)((unsigned char*)WT + (size_t)(r0 + n) * K + k0 + 8 * c) = (v2u){(unsigned)w0, (unsigned)w1}; }
        else { v4u o; o.x = pk2(s[0 * 33] * g0.x, s[1 * 33] * g0.y); o.y = pk2(s[2 * 33] * g0.z, s[3 * 33] * g0.w); o.z = pk2(s[4 * 33] * g1.x, s[5 * 33] * g1.y); o.w = pk2(s[6 * 33] * g1.z, s[7 * 33] * g1.w);
            *(v4u*)(WT + (size_t)(r0 + n) * K + k0 + 8 * c) = o; } }
    LDS_WAIT(); asm volatile("" ::: "memory");
}

constexpr size_t MiB = 1u << 20;
constexpr size_t SZ_NAQKV = (size_t)3 * DM * DM * 2, SZ_DD = (size_t)DM * DM * 2, SZ_GQAQKV = (size_t)(DM + 2 * KVD) * DM * 2, SZ_W1 = (size_t)FF * DM * 2, SZ_PROJ = (size_t)DM * PLE * 2, SZ_ACT = (size_t)L * DM * 2;
constexpr size_t OFF_CTL = 0, CTL_ZERO_BYTES = 3 * MiB, OFF_RS = 1 * MiB;
constexpr size_t OFF_NAQKV = 4 * MiB;
constexpr size_t OFF_NAWO = OFF_NAQKV + 2 * SZ_NAQKV;
constexpr size_t OFF_GQAQKV = OFF_NAWO + 2 * SZ_DD;
constexpr size_t OFF_GQAWO = OFF_GQAQKV + SZ_GQAQKV;
constexpr size_t OFF_S5IN = OFF_GQAWO + SZ_DD;
constexpr size_t OFF_S5OUT = OFF_S5IN + SZ_DD;
constexpr size_t OFF_W1 = OFF_S5OUT + 2 * SZ_DD;
constexpr size_t OFF_W2 = OFF_W1 + 4 * SZ_W1;
constexpr size_t OFF_PROJ = OFF_W2 + 4 * SZ_W1;
constexpr size_t OFF_GATE = OFF_PROJ + 4 * SZ_PROJ;
constexpr size_t OFF_PBF = OFF_GATE + 4 * SZ_DD;
constexpr size_t OFF_XN = OFF_PBF + 4 * (size_t)L * PLE * 2;
constexpr size_t OFF_ACT = OFF_XN + SZ_ACT;
constexpr size_t OFF_PP = OFF_ACT + 4 * SZ_ACT;
constexpr size_t OFF_S5BM = OFF_PP + SZ_ACT;
constexpr size_t OFF_S5GM = OFF_S5BM + 192 * MiB;
constexpr size_t OFF_S5PAR = OFF_S5GM + 64 * MiB;
constexpr size_t OFF_DUMMY = OFF_S5PAR + 8 * MiB;
constexpr size_t OFF_HB1 = OFF_DUMMY + 256 * MiB;
constexpr size_t OFF_HB8 = OFF_HB1 + SZ_ACT;
constexpr size_t WS_END = OFF_HB8 + (size_t)L * DM;
constexpr int CW_BAR = 4096;
constexpr int RING_BYTES = 131072, LDSCTL_OFF = RING_BYTES, MISC_OFF = LDSCTL_OFF + 320, PTAB_OFF = LDSCTL_OFF + 1024, LDS_BYTES = 147456;
static_assert(dattn::SHM_ATTN <= RING_BYTES && 8 * 64 * 33 * 4 <= RING_BYTES, "phase scratch fits the ring region");

constexpr int PH_PER_LAYER = 8, NPH = 1 + DEPTH * PH_PER_LAYER;
struct Args { const float* in[28]; float* out; unsigned char* ws; int ph_lo, ph_hi; };
enum { I_X = 0, I_P, I_MIXN, I_MLPN, I_PLEN, I_NAQKV, I_NAWO, I_NAQG, I_NAKG, I_NARPB, I_GQKV, I_GWO, I_GQG, I_GKG, I_S5IN, I_LAMRE, I_LAMIM, I_LOGSTEP, I_BRE, I_BIM, I_CRE, I_CIM, I_S5D, I_S5OUT, I_W1, I_W2, I_PROJ, I_GATE };


__device__ __forceinline__ unsigned long long tab_get(LAS unsigned char* lds, int i) {
    volatile LAS unsigned* t = (volatile LAS unsigned*)(lds + PTAB_OFF); const unsigned lo = t[2 * i], hi = t[2 * i + 1];
    return ((unsigned long long)(unsigned)__builtin_amdgcn_readfirstlane((int)hi) << 32) | (unsigned)__builtin_amdgcn_readfirstlane((int)lo); }
#define INP(i) ((const float*)(const GAS float*)tab_get(F.lds, (i)))
#define OUTP() ((float*)(GAS float*)tab_get(F.lds, 28))
#define WSP() ((unsigned char*)(GAS unsigned char*)tab_get(F.lds, 29))
__device__ __forceinline__ Frame mkframe(unsigned char* lds_generic) {
    Frame F; int t = wg_tid(); asm volatile("" : "+v"(t)); F.tid = t; F.lane = t & 63; F.wave = __builtin_amdgcn_readfirstlane(t >> 6);
    F.lds = (LAS unsigned char*)lds_generic; int b = blockIdx.x; asm volatile("" : "+s"(b)); F.bid = b; int G = gridDim.x; asm volatile("" : "+s"(G)); F.G = G;
    F.vcu = (G % 8 == 0) ? (b % 8) * (G / 8) + b / 8 : b; return F; }
__device__ __forceinline__ void prologue_phase(const Frame& F) {
    unsigned char* ws = WSP();
    LAS float* scr = (LAS float*)(F.lds + F.wave * (64 * 33 * 4));
    const int gw = F.vcu * 8 + F.wave, NGW = F.G * 8;
    constexpr int I_QKV = (DM / 64) * (3 * DM / 32), I_DD = (DM / 64) * (DM / 32), I_GQ = (DM / 64) * ((DM + 2 * KVD) / 32), I_SO = (DM / 64) * (2 * DM / 32),
                  I_1 = (DM / 64) * (FF / 32), I_2 = (FF / 64) * (DM / 32), I_PJ = (PLE / 64) * (DM / 32);
    constexpr int NITEMS = 2 * I_QKV + 2 * I_DD + I_GQ + I_DD + I_DD + I_SO + 4 * I_1 + 4 * I_2 + 4 * I_PJ + 4 * I_DD;
    for (int it = gw; it < NITEMS; it += NGW) {
        int r = it; const float* W; int K, N, mode = 0, fp8 = 0; bf16* WT; const float* gain = nullptr;
        if (r < 2 * I_QKV) { const int l = r / I_QKV; r -= l * I_QKV; W = INP(I_NAQKV) + (size_t)l * DM * 3 * DM; K = DM; N = 3 * DM; WT = (bf16*)(ws + OFF_NAQKV + l * SZ_NAQKV); gain = INP(I_MIXN) + (size_t)(3 * l) * DM; fp8 = 1; }
        else { r -= 2 * I_QKV;
        if (r < 2 * I_DD) { const int l = r / I_DD; r -= l * I_DD; W = INP(I_NAWO) + (size_t)l * DM * DM; K = DM; N = DM; WT = (bf16*)(ws + OFF_NAWO + l * SZ_DD); fp8 = 1; }
        else { r -= 2 * I_DD;
        if (r < I_GQ) { W = INP(I_GQKV); K = DM; N = DM + 2 * KVD; WT = (bf16*)(ws + OFF_GQAQKV); gain = INP(I_MIXN) + (size_t)1 * DM; fp8 = 1; }
        else { r -= I_GQ;
        if (r < I_DD) { W = INP(I_GWO); K = DM; N = DM; WT = (bf16*)(ws + OFF_GQAWO); fp8 = 1; }
        else { r -= I_DD;
        if (r < I_DD) { W = INP(I_S5IN); K = DM; N = DM; WT = (bf16*)(ws + OFF_S5IN); gain = INP(I_MIXN) + (size_t)2 * DM; fp8 = 1; }
        else { r -= I_DD;
        if (r < I_SO) { W = INP(I_S5OUT); K = DM; N = 2 * DM; WT = (bf16*)(ws + OFF_S5OUT); mode = 1; fp8 = 1; }
        else { r -= I_SO;
        if (r < 4 * I_1) { const int l = r / I_1; r -= l * I_1; W = INP(I_W1) + (size_t)l * DM * FF; K = DM; N = FF; WT = (bf16*)(ws + OFF_W1 + l * SZ_W1); gain = INP(I_MLPN) + (size_t)l * DM; }
        else { r -= 4 * I_1;
        if (r < 4 * I_2) { const int l = r / I_2; r -= l * I_2; W = INP(I_W2) + (size_t)l * FF * DM; K = FF; N = DM; WT = (bf16*)(ws + OFF_W2 + l * SZ_W1); }
        else { r -= 4 * I_2;
        if (r < 4 * I_PJ) { const int l = r / I_PJ; r -= l * I_PJ; W = INP(I_PROJ) + (size_t)l * PLE * DM; K = PLE; N = DM; WT = (bf16*)(ws + OFF_PROJ + l * SZ_PROJ); }
        else { r -= 4 * I_PJ; const int l = r / I_DD; r -= l * I_DD; W = INP(I_GATE) + (size_t)l * DM * DM; K = DM; N = DM; WT = (bf16*)(ws + OFF_GATE + l * SZ_DD); gain = INP(I_PLEN) + (size_t)l * DM; } } } } } } } } }
        transpose_item(W, K, N, WT, mode, gain, scr, r, F.lane, fp8);
    }
    xrows_phase(F, INP(I_X), (bf16*)(ws + OFF_XN), (pg8::rs_t*)(ws + OFF_RS), ws + OFF_HB8);
    { const size_t n8 = (size_t)DEPTH * L * PLE / 8; const float* p = INP(I_P); bf16* pb = (bf16*)(ws + OFF_PBF);
      for (size_t i = (size_t)gw * 64 + F.lane; i < n8; i += (size_t)NGW * 64) { const f32x4 a = *(const f32x4*)(p + i * 8), b = *(const f32x4*)(p + i * 8 + 4);
          v4u w; w.x = pk2(a.x, a.y); w.y = pk2(a.z, a.w); w.z = pk2(b.x, b.y); w.w = pk2(b.z, b.w); *(v4u*)(pb + i * 8) = w; } }
    { bf16* GM = (bf16*)(ws + OFF_S5GM); bf16* BMt = (bf16*)(ws + OFF_S5BM); f32x2* PAT = (f32x2*)(ws + OFF_S5PAR);
      LDS_WAIT(); __syncthreads();
      for (int g = F.bid; g < S5G; g += F.G) s5_gen_group(F, g, INP(I_LAMRE), INP(I_LAMIM), INP(I_LOGSTEP), INP(I_BRE), INP(I_BIM), INP(I_CRE), INP(I_CIM), GM, BMt, PAT); }
}

#define WS_PTRS() unsigned char* ws = WSP(); bf16* HB0 = (bf16*)(ws + OFF_XN); bf16* HB1 = (bf16*)(ws + OFF_HB1); bf16* Qb = (bf16*)(ws + OFF_ACT); bf16* Kb = (bf16*)(ws + OFF_ACT + SZ_ACT); bf16* Vb = (bf16*)(ws + OFF_ACT + 2 * SZ_ACT); \
    bf16* Ob = (bf16*)(ws + OFF_ACT + 3 * SZ_ACT); bf16* HID = (bf16*)(ws + OFF_ACT); bf16* UA = (bf16*)(ws + OFF_ACT); bf16* S5Gb = (bf16*)(ws + OFF_ACT + 2 * SZ_ACT); float* S5E = (float*)(ws + OFF_ACT + 3 * SZ_ACT); bf16* PP = (bf16*)(ws + OFF_PP); \
    (void)HB0; (void)HB1; (void)Qb; (void)Kb; (void)Vb; (void)Ob; (void)HID; (void)UA; (void)S5Gb; (void)PP; (void)S5E;
__global__ void __launch_bounds__(512, 2) enc_fwd(Args args) {
    extern __shared__ __attribute__((aligned(16))) unsigned char lds[];
    {
        LAS unsigned char* l3 = (LAS unsigned char*)lds;
        for (int u = threadIdx.x; u < (LDS_BYTES - LDSCTL_OFF) / 4; u += 512) ((LAS unsigned*)(l3 + LDSCTL_OFF))[u] = 0u;
        __syncthreads();
        if (threadIdx.x == 0) { LAS unsigned long long* t = (LAS unsigned long long*)(l3 + PTAB_OFF);
#pragma unroll
            for (int i = 0; i < 28; ++i) t[i] = (unsigned long long)args.in[i];
            t[28] = (unsigned long long)args.out; t[29] = (unsigned long long)args.ws; }
        if ((threadIdx.x & 63) == 0) ((LAS unsigned*)(WTAB_OFF))[hw_wave_slot()] = threadIdx.x >> 6;
        __syncthreads();
    }
    const int lo = args.ph_lo, hi = args.ph_hi;
    XcdBarrier bar;
    { LAS unsigned char* l3 = (LAS unsigned char*)lds; unsigned* ctl = (unsigned*)(GAS unsigned*)(tab_get(l3, 29) + OFF_CTL); bar.bar = ctl + CW_BAR; bar.x = 0; bar.st = nullptr;
      if (hi - lo > 1) bar = xcd_barrier_post(ctl + CW_BAR, (volatile LAS unsigned*)(l3 + MISC_OFF) + 8); }
#define IN(k) (lo <= (k) && (k) < hi)
#ifndef PROBE_PH
#define PROBE_PH (-1)
#endif
#define REPS(k) for (int rep_ = 0, nrep_ = (((k) == PROBE_PH || PROBE_PH == -2) ? 2 : ((PROBE_PH == 300 && (k) == 11) ? 4 : 1)); rep_ < nrep_; ++rep_)
#define HBOUT(p) ((nrep_ == 2 && rep_ == 0) ? (bf16*)(ws + OFF_DUMMY) : (p))
#define RSOUT(i) ((nrep_ == 2 && rep_ == 0) ? (pg8::rs_t*)(ws + OFF_DUMMY + 128 * MiB) : RSP(i))
#define SEAM(k) do { if (IN(k) && IN((k) + 1)) xcd_barrier(bar); } while (0)

#if PROBE_PH == 601
    if (blockIdx.x == 0 && threadIdx.x < 64) {
        typedef int v8i_ __attribute__((ext_vector_type(8))); typedef float f4v_ __attribute__((ext_vector_type(4)));
        const int l = threadIdx.x, ij = l & 15, kb = l >> 4; const unsigned lut[7] = {0xC4u, 0xC0u, 0xB8u, 0x00u, 0x38u, 0x40u, 0x44u};
        v8i_ A, B;
#pragma unroll
        for (int v = 0; v < 8; ++v) { unsigned wa = 0, wb = 0;
#pragma unroll
            for (int b = 0; b < 4; ++b) { const int kk = 32 * kb + 4 * v + b; const int av = ((ij + 2 * kk) % 5) - 2, bv = ((3 * kk + ij) % 7) - 3;
                unsigned ea = 0, eb = 0;
#pragma unroll
                for (int t = 0; t < 7; ++t) { ea = (av + 3 == t) ? lut[t] : ea; eb = (bv + 3 == t) ? lut[t] : eb; }
                wa |= ea << (8 * b); wb |= eb << (8 * b); }
            A[v] = (int)wa; B[v] = (int)wb; }
        f4v_ c1 = {};
        c1 = __builtin_amdgcn_mfma_scale_f32_16x16x128_f8f6f4(A, B, c1, 0, 0, 0, 0x7F7F7F7F, 0, 0x7F7F7F7F);
        bool ok1 = true;
#pragma unroll
        for (int r = 0; r < 4; ++r) { const int i = 4 * kb + r, j = ij; int s = 0;
            for (int kk = 0; kk < 128; ++kk) s += (((i + 2 * kk) % 5) - 2) * (((3 * kk + j) % 7) - 3);
            ok1 = ok1 && (c1[r] == (float)s); }
        unsigned long long ticks = 0; if (!__all(ok1)) ticks += 400000ull;
        const unsigned long long t0 = __builtin_amdgcn_s_memrealtime(); while (__builtin_amdgcn_s_memrealtime() - t0 < ticks) __builtin_amdgcn_s_sleep(8);
    }
    __syncthreads();
#endif
#if PROBE_PH == 600
    if (blockIdx.x == 0 && threadIdx.x < 64) {
        typedef int v8i_ __attribute__((ext_vector_type(8))); typedef float f16v_ __attribute__((ext_vector_type(16)));
        const int l = threadIdx.x, ij = l & 31, kb = l >> 5; const unsigned lut[7] = {0xC4u, 0xC0u, 0xB8u, 0x00u, 0x38u, 0x40u, 0x44u};
        v8i_ A, B;
#pragma unroll
        for (int v = 0; v < 8; ++v) { unsigned wa = 0, wb = 0;
#pragma unroll
            for (int b = 0; b < 4; ++b) { const int kk = 32 * kb + 4 * v + b; const int av = ((ij + 2 * kk) % 5) - 2, bv = ((3 * kk + ij) % 7) - 3;
                unsigned ea = 0, eb = 0;
#pragma unroll
                for (int t = 0; t < 7; ++t) { ea = (av + 3 == t) ? lut[t] : ea; eb = (bv + 3 == t) ? lut[t] : eb; }
                wa |= ea << (8 * b); wb |= eb << (8 * b); }
            A[v] = (int)wa; B[v] = (int)wb; }
        f16v_ c1 = {}, c2 = {};
        c1 = __builtin_amdgcn_mfma_scale_f32_32x32x64_f8f6f4(A, B, c1, 0, 0, 0, 0x7F7F7F7F, 0, 0x7F7F7F7F);
        c2 = __builtin_amdgcn_mfma_scale_f32_32x32x64_f8f6f4(A, B, c2, 0, 0, 0, 0x7B7B7B7B, 0, 0x7F7F7F7F);
        bool ok1 = true, ok2 = true;
#pragma unroll
        for (int r = 0; r < 16; ++r) { const int i = (r & 3) + 8 * (r >> 2) + 4 * kb, j = ij; int s = 0;
            for (int kk = 0; kk < 64; ++kk) s += (((i + 2 * kk) % 5) - 2) * (((3 * kk + j) % 7) - 3);
            ok1 = ok1 && (c1[r] == (float)s); ok2 = ok2 && (c2[r] == (float)s * 0.0625f); }
        int w = __builtin_amdgcn_cvt_pk_fp8_f32(1.0f, 2.0f, 0, false); w = __builtin_amdgcn_cvt_pk_fp8_f32(3.0f, -1.0f, w, true);
        const bool ok3 = ((unsigned)w == 0xB8444038u);
        unsigned long long ticks = 0; if (!__all(ok1)) ticks += 400000ull; if (!__all(ok2)) ticks += 800000ull; if (!__all(ok3)) ticks += 1600000ull;
        const unsigned long long t0 = __builtin_amdgcn_s_memrealtime(); while (__builtin_amdgcn_s_memrealtime() - t0 < ticks) __builtin_amdgcn_s_sleep(8);
    }
    __syncthreads();
#endif
    if (IN(0)) REPS(0) { const Frame F = mkframe(lds); prologue_phase(F); } SEAM(0);
#if PROBE_PH == 200
    for (int xb_ = 0; xb_ < 40; ++xb_) xcd_barrier(bar);
#endif

#pragma unroll 1
    for (int layer = 0; layer < DEPTH; ++layer) {
        const int kind = layer % 3, slot = layer / 3, pb = 1 + PH_PER_LAYER * layer;
#define RSP(i) ((pg8::rs_t*)(ws + OFF_RS) + (size_t)(i) * L)
        const int irs = (layer == 0) ? 0 : 3 * layer;
        if (IN(pb + 0)) REPS(pb + 0) {
            const Frame F = mkframe(lds); WS_PTRS();
            if (kind != 2) {
                const int N = (kind == 0) ? 3 * DM : DM + 2 * KVD;
                const bf16* W = (kind == 0) ? (const bf16*)(ws + OFF_NAQKV + slot * SZ_NAQKV) : (const bf16*)(ws + OFF_GQAQKV);
                const pg8::Gemm g = pg8::mkgemm((const bf16*)(ws + OFF_HB8), W, L, N, DM / 2); pg8::StaticOrder S; S.init(L, N, F.G, F.bid);
                pg8::EpiBf16<0> E{Qb, Kb, Vb, DM, (kind == 0) ? DM : KVD, (kind == 0) ? DM : L, DM, (kind == 0) ? 2 * DM : DM + KVD, RSP(irs), (kind == 0) ? 0 : 2, (kind == 0) ? 2 * DM : DM + KVD};
                pg8::gemm_phase<pg8::EpiBf16<0>, pg8::StaticOrder, false, true, true>(F.lds, g, S, E);
            } else {
                const pg8::Gemm g = pg8::mkgemm((const bf16*)(ws + OFF_HB8), (const bf16*)(ws + OFF_S5IN), L, DM, DM / 2); pg8::StaticOrder S; S.init(L, DM, F.G, F.bid);
                pg8::EpiS5U E{UA, RSP(irs)};
                pg8::gemm_phase<pg8::EpiS5U, pg8::StaticOrder, false, true, true>(F.lds, g, S, E);
            }
        }
        SEAM(pb + 0);
        if (kind != 2) {
            if (kind == 1) { if (IN(pb + 1)) { const Frame F = mkframe(lds); WS_PTRS(); prep_phase(F, Qb, Kb, KVD, NKV, INP(I_GQG), INP(I_GKG), true, (unsigned char*)Kb + 64 * MiB); }
                SEAM(pb + 1); }
            if (IN(pb + 2)) REPS(pb + 2) { const Frame F = mkframe(lds); WS_PTRS();
                if (kind == 0) {
                    const float* rpb = INP(I_NARPB) + (size_t)slot * NH * 15 * 31;
                    for (int i = 0;; ++i) { const int unit = i * F.G + F.vcu; if (unit >= NH * (GROWS / 4)) break;
                        const int h = unit >> 6, R = (unit & 63) * 4, ks = min(max(R - 4, 0), GROWS - dattn::NA_TILES);
                        dattn::na_block_body(Qb + (size_t)(R * GRID_W) * DM + h * HD, Kb + (size_t)(ks * GRID_W) * DM + h * HD, Vb + (size_t)(ks * GRID_W) * DM + h * HD,
                                             (bf16*)((unsigned char*)Ob + (size_t)(R * GRID_W) * DM + h * HD), rpb + (size_t)h * 15 * 31, INP(I_NAQG) + slot * HD, INP(I_NAKG) + slot * HD, R, ks, (char*)lds);
                        __syncthreads(); }
                } else {
                    for (int i = 0;; ++i) { const int unit = i * F.G + F.bid; if (unit >= NH * (L / 256)) break;
                        const int kvh = unit & 7, rest = unit >> 3, hq = kvh * 4 + (rest >> 6), qb = rest & 63;
                        dattn::attn_dense_body8(Qb + (size_t)(qb * 256) * DM + hq * HD, (const unsigned char*)Kb + 64 * MiB + kvh * HD, (const unsigned char*)Vb + (size_t)(kvh * HD) * L, (bf16*)((unsigned char*)Ob + (size_t)(qb * 256) * DM + hq * HD), L, (char*)lds);
                        __syncthreads(); }
                }
            }
            if (IN(pb + 2) && IN(pb + 4)) xcd_barrier(bar);
#if PROBE_PH == 400
            if (kind == 1) { const Frame F = mkframe(lds); WS_PTRS();
                gqa_selfcheck(F, Qb, (const unsigned char*)Kb + 64 * MiB, (const unsigned char*)Vb, Ob, (float*)(ws + OFF_PP), (unsigned*)(ws + OFF_CTL) + 8);
                xcd_barrier(bar); }
#endif
        } else {
            if (IN(pb + 1)) REPS(pb + 1) { const Frame F = mkframe(lds); WS_PTRS();
                pg8::Gemm g; g.A = UA; g.Bt = (const bf16*)(ws + OFF_S5GM); g.M = S5G * S5NCH; g.N = 256; g.K = 512; g.lda = S5KS; g.ldb = 512; g.sa = 0x7F7F7F7F;
                pg8::S5Order S{F.G, F.bid, 2, 1}; pg8::EpiS5E E{S5E};
                pg8::gemm_phase<pg8::EpiS5E, pg8::S5Order, false, true>(F.lds, g, S, E); }
            SEAM(pb + 1);
            if (IN(pb + 2)) REPS(pb + 2) { const Frame F = mkframe(lds); WS_PTRS(); s5_scan_phase(F, (const f32x2*)(ws + OFF_S5PAR), S5E, UA); }
            SEAM(pb + 2);
            if (IN(pb + 3)) REPS(pb + 3) { const Frame F = mkframe(lds); WS_PTRS();
                pg8::Gemm g; g.A = UA; g.Bt = (const bf16*)(ws + OFF_S5BM); g.M = S5G * S5NCH; g.N = S5G * 512; g.K = S5KS; g.lda = S5KS; g.ldb = S5KS; g.sa = 0x7F7F7F7F;
                pg8::S5Order S{F.G, F.bid, 2, 2}; pg8::EpiS5Y E{UA, INP(I_S5D), S5Gb, DM};
                pg8::gemm_phase<pg8::EpiS5Y, pg8::S5Order, false, true>(F.lds, g, S, E); }
            SEAM(pb + 3);
        }
        if (IN(pb + 4)) REPS(pb + 4) {
            const Frame F = mkframe(lds); WS_PTRS();
            if (kind != 2) {
                const bf16* W = (kind == 0) ? (const bf16*)(ws + OFF_NAWO + slot * SZ_DD) : (const bf16*)(ws + OFF_GQAWO);
                pg8::Gemm g = pg8::mkgemm(Ob, W, L, DM, DM / 2); g.sa = 0x79797979; pg8::StaticOrder S; S.init(L, DM, F.G, F.bid);
                pg8::EpiRes E{HB0, HBOUT(HB0), RSOUT(1 + 3 * layer), DM, nullptr};
                pg8::gemm_phase<pg8::EpiRes, pg8::StaticOrder, false, true, true>(F.lds, g, S, E);
            } else {
                pg8::Gemm g = pg8::mkgemm(S5Gb, (const bf16*)(ws + OFF_S5OUT), L, 2 * DM, DM / 2); g.sa = 0x7B7B7B7B; pg8::StaticOrder S; S.init(L, 2 * DM, F.G, F.bid);
                pg8::EpiGlu E{HB0, HBOUT(HB0), RSOUT(1 + 3 * layer), DM};
                pg8::gemm_phase<pg8::EpiGlu, pg8::StaticOrder, false, true, true>(F.lds, g, S, E);
            }
        }
        SEAM(pb + 4);
        if (IN(pb + 5)) REPS(pb + 5) { const Frame F = mkframe(lds); WS_PTRS();
            const pg8::Gemm g = pg8::mkgemm(HB0, (const bf16*)(ws + OFF_W1 + layer * SZ_W1), L, FF, DM); pg8::StaticOrder S; S.init(L, FF, F.G, F.bid);
            pg8::EpiBf16<2> E{HID, HID, HID, FF, FF, FF, 1 << 30, 1 << 30, nullptr, 0, 0};
#if PROBE_PH == 201
            { pg8::RangeOrder R1{S, 0, 8}, R2{S, 8, 16};
              pg8::gemm_phase<pg8::EpiBf16<2>, pg8::RangeOrder, false, true>(F.lds, g, R1, E); xcd_barrier(bar);
              pg8::gemm_phase<pg8::EpiBf16<2>, pg8::RangeOrder, false, true>(F.lds, g, R2, E); }
#else
            pg8::gemm_phase<pg8::EpiBf16<2>, pg8::StaticOrder, false, true>(F.lds, g, S, E);
#endif
        }
        SEAM(pb + 5);
        if (IN(pb + 6)) REPS(pb + 6) { const Frame F = mkframe(lds); WS_PTRS();
            { const pg8::Gemm g = pg8::mkgemm(HID, (const bf16*)(ws + OFF_W2 + layer * SZ_W1), L, DM, FF); pg8::StaticOrder S; S.init(L, DM, F.G, F.bid);
              pg8::EpiRes E{HB0, HBOUT(HB1), RSOUT(2 + 3 * layer), DM, RSP(1 + 3 * layer)};
              pg8::gemm_phase<pg8::EpiRes, pg8::StaticOrder, false, true>(F.lds, g, S, E); }
            { const pg8::Gemm g = pg8::mkgemm((const bf16*)(ws + OFF_PBF + (size_t)layer * L * PLE * 2), (const bf16*)(ws + OFF_PROJ + layer * SZ_PROJ), L, DM, PLE); pg8::StaticOrder S; S.init(L, DM, F.G, F.bid);
              pg8::EpiBf16<0> E{PP, PP, PP, DM, DM, DM, 1 << 30, 1 << 30, nullptr, 0, 0};
              pg8::gemm_phase<pg8::EpiBf16<0>, pg8::StaticOrder, false, true>(F.lds, g, S, E); }
        }
        SEAM(pb + 6);
        if (IN(pb + 7)) REPS(pb + 7) { const Frame F = mkframe(lds); WS_PTRS();
            const pg8::Gemm g = pg8::mkgemm(HB1, (const bf16*)(ws + OFF_GATE + layer * SZ_DD), L, DM, DM); pg8::StaticOrder S; S.init(L, DM, F.G, F.bid);
            pg8::EpiGate E{HB1, HBOUT(HB0), (layer == DEPTH - 1) ? OUTP() : nullptr, PP, RSP(2 + 3 * layer), RSOUT(3 + 3 * layer), DM, (layer + 1 < DEPTH && !(nrep_ == 2 && rep_ == 0)) ? ws + OFF_HB8 : nullptr};
            pg8::gemm_phase<pg8::EpiGate, pg8::StaticOrder, false, true>(F.lds, g, S, E);
        }
        SEAM(pb + 7);
    }
#if PROBE_PH == 400
    { xcd_barrier(bar); const Frame F = mkframe(lds); unsigned char* ws = WSP();
      if (__hip_atomic_load((unsigned*)(ws + OFF_CTL) + 8, __ATOMIC_RELAXED, __HIP_MEMORY_SCOPE_AGENT) != 0u && F.bid == 0 && F.tid < 64) OUTP()[F.tid] = __builtin_nanf(""); }
#endif
#undef IN
#undef SEAM
}

extern "C" void kernel_launch(void* const* d_in, const int* in_sizes, int n_in, void* d_out, int out_size, void* d_ws, size_t ws_size, hipStream_t stream) {
    static int grid = 0;
    if (grid == 0) {
        if (n_in != 28 || in_sizes[0] != L * DM || out_size != L * DM || ws_size < WS_END) {
            fprintf(stderr, "kernel_launch: built for 28 inputs, x/out of %d floats, >= %zu bytes of workspace; got n_in %d, in0 %d, out %d, ws %zu; nothing launched\n", L * DM, (size_t)WS_END, n_in, n_in > 0 ? in_sizes[0] : -1, out_size, ws_size);
            grid = -1; return; }
        int dev = 0, cus = 0, per_cu = 0;
        if (hipGetDevice(&dev) != hipSuccess || hipDeviceGetAttribute(&cus, hipDeviceAttributeMultiprocessorCount, dev) != hipSuccess) { fprintf(stderr, "kernel_launch: device query failed\n"); grid = -1; return; }
        if (hipFuncSetAttribute((const void*)enc_fwd, hipFuncAttributeMaxDynamicSharedMemorySize, LDS_BYTES) != hipSuccess) { fprintf(stderr, "kernel_launch: hipFuncSetAttribute failed\n"); grid = -1; return; }
        if (hipOccupancyMaxActiveBlocksPerMultiprocessor(&per_cu, (const void*)enc_fwd, 512, LDS_BYTES) != hipSuccess || per_cu < 1)
            fprintf(stderr, "kernel_launch: note: occupancy query reports %d workgroups per CU\n", per_cu);
        (void)hipGetLastError();
        grid = cus;
    }
    if (grid < 0) return;
    if (hipMemsetAsync((char*)d_ws + OFF_CTL, 0, CTL_ZERO_BYTES, stream) != hipSuccess) { fprintf(stderr, "kernel_launch: memset failed\n"); return; }
    Args a{};
    for (int i = 0; i < 28; ++i) a.in[i] = (const float*)d_in[i];
    a.out = (float*)d_out; a.ws = (unsigned char*)d_ws;
#if MK_N_LAUNCHES == 1
    a.ph_lo = 0; a.ph_hi = NPH;
    hipLaunchKernelGGL(enc_fwd, dim3(grid), dim3(512), LDS_BYTES, stream, a);
#else
    for (int ph = 0; ph < NPH; ++ph) {
        if (ph > 0) { const int layer = (ph - 1) / PH_PER_LAYER, j = (ph - 1) % PH_PER_LAYER; if (j == 3 && layer % 3 != 2) continue; }
        a.ph_lo = ph; a.ph_hi = ph + 1;
        hipLaunchKernelGGL(enc_fwd, dim3(grid), dim3(512), LDS_BYTES, stream, a);
    }
#endif
    const hipError_t le = hipPeekAtLastError();
    if (le != hipSuccess) fprintf(stderr, "kernel_launch: launch failed: %s\n", hipGetErrorName(le));
}
```

```cpp
#include <hip/hip_runtime.h>
#include <cstdio>
#include <cstdint>

#ifndef MK_N_LAUNCHES
#define MK_N_LAUNCHES 1
#endif

constexpr int L = 16384, DM = 4096, DEPTH = 4, GRID_W = 64, GROWS = L / GRID_W, HD = 128, NH = 32, NKV = 8, KVD = NKV * HD, FF = 4 * DM, PLE = 256;
constexpr int S5G = 256, S5P = 16, S5N = 64, S5TC = 16, S5NC = L / S5TC;
constexpr float EPS = 1e-6f;

#define GAS __attribute__((address_space(1)))
#define LAS __attribute__((address_space(3)))
constexpr unsigned WTAB_OFF = 131072 + 2048;
__device__ __forceinline__ unsigned hw_wave_slot() { return (unsigned)__builtin_amdgcn_s_getreg((5 << 11) | 4) & 63u; }
__device__ __forceinline__ int wg_tid() {
    const unsigned wv = (unsigned)__builtin_amdgcn_readfirstlane((int)((volatile LAS unsigned*)(WTAB_OFF))[hw_wave_slot()]);
    return (int)(wv * 64u + __builtin_amdgcn_mbcnt_hi(~0u, __builtin_amdgcn_mbcnt_lo(~0u, 0u)));
}
typedef unsigned short bf16;
typedef unsigned v4u __attribute__((ext_vector_type(4)));
typedef unsigned v2u __attribute__((ext_vector_type(2)));
typedef float f32x4 __attribute__((ext_vector_type(4)));
typedef float f32x2 __attribute__((ext_vector_type(2)));
typedef short bf16x8 __attribute__((ext_vector_type(8)));
typedef short s16x4 __attribute__((ext_vector_type(4)));
typedef GAS unsigned gu32;
#define RLX_AGENT __ATOMIC_RELAXED, __HIP_MEMORY_SCOPE_AGENT
#define LDS_WAIT() asm volatile("s_waitcnt lgkmcnt(0)" ::: "memory")
#define VM_WAIT() asm volatile("s_waitcnt vmcnt(0)" ::: "memory")
__device__ __forceinline__ unsigned f2bf(float f) { unsigned u = __builtin_bit_cast(unsigned, f); return (u + 0x7fffu + ((u >> 16) & 1u)) >> 16; }
__device__ __forceinline__ unsigned pk2(float lo, float hi) { return f2bf(lo) | (f2bf(hi) << 16); }
__device__ __forceinline__ float bf2f(unsigned short b) { return __builtin_bit_cast(float, (unsigned)b << 16); }
__device__ __forceinline__ float bflo(unsigned w) { return __builtin_bit_cast(float, w << 16); }
__device__ __forceinline__ float bfhi(unsigned w) { return __builtin_bit_cast(float, w & 0xffff0000u); }
__device__ __forceinline__ float sigmoidf_fast(float x) { return __builtin_amdgcn_rcpf(1.0f + __builtin_amdgcn_exp2f(-1.4426950408889634f * x)); }

namespace pg8 {
#define PG8_LAS __attribute__((address_space(3)))
#if defined(PROBE_EPI2)
#define PROBE_EPI_DUP if constexpr (Epi::PERM) E(acc, cur, wr, wc, fr, fq);
#else
#define PROBE_EPI_DUP
#endif
typedef unsigned short bf16_t;
typedef short bf16x8 __attribute__((ext_vector_type(8)));
typedef float f32x4 __attribute__((ext_vector_type(4)));
typedef unsigned u32x4 __attribute__((ext_vector_type(4)));
constexpr int BM = 256, BK = 64, HALF = 128, HTB = HALF * BK * 2  , STAGE_BYTES = 8 * HTB, NXCD = 8, WGM = 8;

__host__ __device__ __forceinline__ int lds_byte(int r, int c) { const int st = (r >> 4) * 2 + (c >> 5), rr = r & 15, cc = c & 31, ob = rr * 64 + cc * 2; return st * 1024 + (ob ^ (((ob >> 9) & 1) << 5)); }
__host__ __device__ __forceinline__ void stage_rc(int b, int& R, int& C) { const int st = b / 1024, sb = b % 1024, swz = sb ^ (((sb >> 9) & 1) << 5); R = (st >> 1) * 16 + swz / 64; C = (st & 1) * 32 + (swz % 64) / 2; }
__host__ __device__ __forceinline__ int perm32(int rho) { const int n = rho >> 4, i = rho & 15; return 8 * (i >> 2) + 4 * n + (i & 3); }

struct Unit { int pm, pn; };
struct Gemm { const bf16_t* A; const bf16_t* Bt; int M, N, K, lda, ldb, sa; };
__host__ __device__ __forceinline__ Gemm mkgemm(const bf16_t* A, const bf16_t* Bt, int M, int N, int K) { Gemm g; g.A = A; g.Bt = Bt; g.M = M; g.N = N; g.K = K; g.lda = K; g.ldb = K; g.sa = 0x7F7F7F7F; return g; }

struct StaticOrder {
    int nM, nN, nwg, G, c, wgm;
    __host__ __device__ void init(int M, int N, int G_, int c_, int wgm_ = WGM) { nM = M / BM; nN = N / BM; nwg = nM * nN; G = G_; c = c_; wgm = wgm_; }
    __host__ __device__ bool next(int i, Unit& u) const {
        const long L = (long)i * G + c; if (L >= nwg) return false;
        int wgid = (int)L; { const int q = nwg / NXCD, r = nwg % NXCD, xcd = wgid % NXCD, off = wgid / NXCD; wgid = (xcd < r ? xcd * (q + 1) : r * (q + 1) + (xcd - r) * q) + off; }
        const int nig = wgm * nN, gid = wgid / nig, fm = gid * wgm, gsz = (nM - fm) < wgm ? (nM - fm) : wgm;
        u.pm = fm + ((wgid % nig) % gsz); u.pn = (wgid % nig) / gsz; return true;
    }
    __device__ __forceinline__ void a_ready(const Unit&) const {}
    __device__ __forceinline__ void done(const Unit&) const {}
};
struct RangeOrder { StaticOrder S; int i0, i1;
    __host__ __device__ bool next(int i, Unit& u) const { return (i + i0 < i1) ? S.next(i + i0, u) : false; }
    __device__ __forceinline__ void a_ready(const Unit&) const {}
    __device__ __forceinline__ void done(const Unit&) const {} };


__device__ __forceinline__ unsigned cvt_pk_bf16(float lo, float hi) { unsigned r; asm volatile("v_cvt_pk_bf16_f32 %0, %1, %2" : "=v"(r) : "v"(lo), "v"(hi)); return r; }
__device__ __forceinline__ float sigm(float x) { return __builtin_amdgcn_rcpf(1.0f + __builtin_amdgcn_exp2f(-1.4426950408889634f * x)); }

typedef unsigned long long rs_t;
constexpr float RS_FIX = 16777216.0f, RS_INV = 1.0f / (16777216.0f * 4096.0f), RS_EPS = 1e-6f;
__device__ __forceinline__ void row_ss_add(rs_t* rs, int row, float s, int fq) {
    s += __shfl_xor(s, 16); s += __shfl_xor(s, 32);
    if (fq == 0) __hip_atomic_fetch_add(rs + row, (rs_t)(s * RS_FIX), __ATOMIC_RELAXED, __HIP_MEMORY_SCOPE_AGENT);
}
__device__ __forceinline__ float rs_rinv(rs_t v) { return __builtin_amdgcn_rsqf((float)v * RS_INV + RS_EPS); }
#define PIN8(a) asm volatile("" : "+v"((a)[0]), "+v"((a)[1]), "+v"((a)[2]), "+v"((a)[3]), "+v"((a)[4]), "+v"((a)[5]), "+v"((a)[6]), "+v"((a)[7]))
template <int ACT> struct EpiBf16 {
    static constexpr bool PERM = true, AFTER_DRAIN = false;
    bf16_t *O0, *O1, *O2; int ld0, ld1, ld2, c1, c2; const rs_t* rs; int vt; int rs_from;
    __device__ __forceinline__ void operator()(const f32x4 (&acc)[2][2][4][2], const Unit& u, int wr, int wc, int fr, int fq) const {
        const int row0 = u.pm * BM + wr * 64 + fr; int colt = u.pn * BM; bf16_t* base = O0; int ldc = ld0;
        const rs_t* rs = (colt >= rs_from) ? this->rs : nullptr;
        bool tr = false;
        if (colt >= c2) { base = O2; ldc = ld2; colt -= c2; tr = vt != 0; } else if (colt >= c1) { base = O1; ldc = ld1; colt -= c1; }
        const int col0 = colt + wc * 32 + 8 * fq;
        rs_t scv[8];
#pragma unroll
        for (int gi = 0; gi < 8; ++gi) scv[gi] = rs ? rs[row0 + (gi >> 2) * HALF + (gi & 3) * 16] : 0ull;
        PIN8(scv);
#pragma unroll
        for (int ai = 0; ai < 2; ++ai)
#pragma unroll
            for (int m = 0; m < 4; ++m) { bf16_t* rowp = base + (size_t)(row0 + ai * HALF + m * 16) * ldc + col0; const float sc = rs ? rs_rinv(scv[ai * 4 + m]) : 1.0f;
#pragma unroll
                for (int bj = 0; bj < 2; ++bj) { f32x4 v0 = acc[ai][bj][m][0] * sc, v1 = acc[ai][bj][m][1] * sc;
                    if (ACT == 2) {
#pragma unroll
                        for (int j = 0; j < 4; ++j) { const float a = fmaxf(v0[j], 0.f), b = fmaxf(v1[j], 0.f); v0[j] = a * a; v1[j] = b * b; } }
                    u32x4 w; w.x = cvt_pk_bf16(v0[0], v0[1]); w.y = cvt_pk_bf16(v0[2], v0[3]); w.z = cvt_pk_bf16(v1[0], v1[1]); w.w = cvt_pk_bf16(v1[2], v1[3]);
                    if (vt == 2 && tr) {
                        unsigned char* tp = (unsigned char*)base + (size_t)(col0 + bj * HALF) * ldc + (row0 + ai * HALF + m * 16);
                        int w0 = __builtin_amdgcn_cvt_pk_fp8_f32(v0[0], v0[1], 0, false); w0 = __builtin_amdgcn_cvt_pk_fp8_f32(v0[2], v0[3], w0, true);
                        int w1 = __builtin_amdgcn_cvt_pk_fp8_f32(v1[0], v1[1], 0, false); w1 = __builtin_amdgcn_cvt_pk_fp8_f32(v1[2], v1[3], w1, true);
                        tp[0] = (unsigned char)w0; tp[(size_t)ldc] = (unsigned char)(w0 >> 8); tp[(size_t)2 * ldc] = (unsigned char)(w0 >> 16); tp[(size_t)3 * ldc] = (unsigned char)(w0 >> 24);
                        tp[(size_t)4 * ldc] = (unsigned char)w1; tp[(size_t)5 * ldc] = (unsigned char)(w1 >> 8); tp[(size_t)6 * ldc] = (unsigned char)(w1 >> 16); tp[(size_t)7 * ldc] = (unsigned char)(w1 >> 24); }
                    else if (tr) { bf16_t* tp = base + (size_t)(col0 + bj * HALF) * ldc + (row0 + ai * HALF + m * 16);
                        tp[0] = (bf16_t)w.x; tp[(size_t)ldc] = (bf16_t)(w.x >> 16); tp[(size_t)2 * ldc] = (bf16_t)w.y; tp[(size_t)3 * ldc] = (bf16_t)(w.y >> 16);
                        tp[(size_t)4 * ldc] = (bf16_t)w.z; tp[(size_t)5 * ldc] = (bf16_t)(w.z >> 16); tp[(size_t)6 * ldc] = (bf16_t)w.w; tp[(size_t)7 * ldc] = (bf16_t)(w.w >> 16); }
                    else *(u32x4*)(rowp + bj * HALF) = w; } }
    }
};
struct EpiF32 {
    static constexpr bool PERM = false, AFTER_DRAIN = false;
    float* C; int ldc;
    __device__ __forceinline__ void operator()(const f32x4 (&acc)[2][2][4][2], const Unit& u, int wr, int wc, int fr, int fq) const {
        const int row0 = u.pm * BM + wr * 64 + fr, col0 = u.pn * BM + wc * 32 + 4 * fq;
#pragma unroll
        for (int ai = 0; ai < 2; ++ai)
#pragma unroll
            for (int m = 0; m < 4; ++m) { float* rowp = C + (size_t)(row0 + ai * HALF + m * 16) * ldc + col0;
#pragma unroll
                for (int bj = 0; bj < 2; ++bj)
#pragma unroll
                    for (int n = 0; n < 2; ++n) *(f32x4*)(rowp + bj * HALF + n * 16) = acc[ai][bj][m][n]; }
    }
};
typedef unsigned u32x2 __attribute__((ext_vector_type(2)));
__device__ __forceinline__ f32x4 bf4_to_f32(u32x2 p) { return (f32x4){__builtin_bit_cast(float, p.x << 16), __builtin_bit_cast(float, p.x & 0xffff0000u), __builtin_bit_cast(float, p.y << 16), __builtin_bit_cast(float, p.y & 0xffff0000u)}; }
struct EpiRes {
    static constexpr bool PERM = false, AFTER_DRAIN = false;
    const bf16_t* base; bf16_t* out; rs_t* rs; int ldc; const rs_t* rsq;
    __device__ __forceinline__ void operator()(const f32x4 (&acc)[2][2][4][2], const Unit& u, int wr, int wc, int fr, int fq) const {
        constexpr int PD = 3;
        const int row0 = u.pm * BM + wr * 64 + fr, col0 = u.pn * BM + wc * 32 + 4 * fq;
        u32x2 nb[8][2][2];
        rs_t scv[8];
#pragma unroll
        for (int gi = 0; gi < 8; ++gi) scv[gi] = rsq ? rsq[row0 + (gi >> 2) * HALF + (gi & 3) * 16] : 0ull;
#define EPI_LD(g) do { const size_t o_ = (size_t)(row0 + ((g) >> 2) * HALF + ((g) & 3) * 16) * ldc + col0; _Pragma("unroll") for (int bj = 0; bj < 2; ++bj) _Pragma("unroll") for (int n = 0; n < 2; ++n) nb[g][bj][n] = *(const u32x2*)(base + o_ + bj * HALF + n * 16); } while (0)
#pragma unroll
        for (int g = 0; g < PD; ++g) EPI_LD(g);
        PIN8(scv);
#pragma unroll
        for (int gi = 0; gi < 8; ++gi) { const int ai = gi >> 2, m = gi & 3; const int row = row0 + ai * HALF + m * 16; const size_t off = (size_t)row * ldc + col0;
            if (gi + PD < 8) EPI_LD(gi + PD);
            const float sc2 = rsq ? __builtin_amdgcn_rcpf((float)scv[gi] * RS_INV + RS_EPS) : 1.0f;
            float ss = 0.f;
#pragma unroll
            for (int bj = 0; bj < 2; ++bj)
#pragma unroll
                for (int n = 0; n < 2; ++n) { const f32x4 o = bf4_to_f32(nb[gi][bj][n]) + acc[ai][bj][m][n] * sc2;
                    ss += (o[0] * o[0] + o[1] * o[1]) + (o[2] * o[2] + o[3] * o[3]);
                    u32x2 w; w.x = cvt_pk_bf16(o[0], o[1]); w.y = cvt_pk_bf16(o[2], o[3]); *(u32x2*)(out + off + bj * HALF + n * 16) = w; }
            row_ss_add(rs, row, ss, fq); }
#undef EPI_LD
    }
};
struct EpiGate {
    static constexpr bool PERM = false, AFTER_DRAIN = false;
    const bf16_t* base; bf16_t* out; float* out32; const bf16_t* pp; const rs_t* rsin; rs_t* rs; int ldc; unsigned char* out8;
    __device__ __forceinline__ void operator()(const f32x4 (&acc)[2][2][4][2], const Unit& u, int wr, int wc, int fr, int fq) const {
        constexpr int PD = 2;
        const int row0 = u.pm * BM + wr * 64 + fr, col0 = u.pn * BM + wc * 32 + 4 * fq;
        rs_t scv[8];
#pragma unroll
        for (int gi = 0; gi < 8; ++gi) scv[gi] = rsin[row0 + (gi >> 2) * HALF + (gi & 3) * 16];
        u32x2 nb[8][2][2], np[8][2][2];
#define EPI_LD(g) do { const size_t o_ = (size_t)(row0 + ((g) >> 2) * HALF + ((g) & 3) * 16) * ldc + col0; _Pragma("unroll") for (int bj = 0; bj < 2; ++bj) _Pragma("unroll") for (int n = 0; n < 2; ++n) { \
            nb[g][bj][n] = *(const u32x2*)(base + o_ + bj * HALF + n * 16); np[g][bj][n] = *(const u32x2*)(pp + o_ + bj * HALF + n * 16); } } while (0)
#pragma unroll
        for (int g = 0; g < PD; ++g) EPI_LD(g);
        PIN8(scv);
#pragma unroll
        for (int gi = 0; gi < 8; ++gi) { const int ai = gi >> 2, m = gi & 3; const int row = row0 + ai * HALF + m * 16; const size_t off = (size_t)row * ldc + col0;
            if (gi + PD < 8) EPI_LD(gi + PD);
            const float sc = rs_rinv(scv[gi]);
            float ss = 0.f;
#pragma unroll
            for (int bj = 0; bj < 2; ++bj)
#pragma unroll
                for (int n = 0; n < 2; ++n) { const f32x4 a = acc[ai][bj][m][n] * sc, p = bf4_to_f32(np[gi][bj][n]); f32x4 o = bf4_to_f32(nb[gi][bj][n]);
#pragma unroll
                    for (int j = 0; j < 4; ++j) o[j] += sigm(a[j]) * p[j];
                    if (out32) *(f32x4*)(out32 + off + bj * HALF + n * 16) = o;
                    if (out8) { int w8 = __builtin_amdgcn_cvt_pk_fp8_f32(o[0], o[1], 0, false); w8 = __builtin_amdgcn_cvt_pk_fp8_f32(o[2], o[3], w8, true); *(unsigned*)(out8 + off + bj * HALF + n * 16) = (unsigned)w8; }
                    ss += (o[0] * o[0] + o[1] * o[1]) + (o[2] * o[2] + o[3] * o[3]);
                    u32x2 w; w.x = cvt_pk_bf16(o[0], o[1]); w.y = cvt_pk_bf16(o[2], o[3]); *(u32x2*)(out + off + bj * HALF + n * 16) = w; }
            row_ss_add(rs, row, ss, fq); }
#undef EPI_LD
    }
};
struct EpiGlu {
    static constexpr bool PERM = false, AFTER_DRAIN = false;
    const bf16_t* base; bf16_t* out; rs_t* rs; int ldc;
    __device__ __forceinline__ void operator()(const f32x4 (&acc)[2][2][4][2], const Unit& u, int wr, int wc, int fr, int fq) const {
        constexpr int PD = 3;
        const int row0 = u.pm * BM + wr * 64 + fr, col0 = u.pn * HALF + wc * 32 + 4 * fq;
        u32x2 nb[8][2];
#define EPI_LD(g) do { const size_t o_ = (size_t)(row0 + ((g) >> 2) * HALF + ((g) & 3) * 16) * ldc + col0; _Pragma("unroll") for (int n = 0; n < 2; ++n) nb[g][n] = *(const u32x2*)(base + o_ + n * 16); } while (0)
#pragma unroll
        for (int g = 0; g < PD; ++g) EPI_LD(g);
#pragma unroll
        for (int gi = 0; gi < 8; ++gi) { const int ai = gi >> 2, m = gi & 3; const int row = row0 + ai * HALF + m * 16; const size_t off = (size_t)row * ldc + col0;
            if (gi + PD < 8) EPI_LD(gi + PD);
            float ss = 0.f;
#pragma unroll
            for (int n = 0; n < 2; ++n) { const f32x4 a = acc[ai][0][m][n], g = acc[ai][1][m][n]; f32x4 o = bf4_to_f32(nb[gi][n]);
#pragma unroll
                for (int j = 0; j < 4; ++j) o[j] += a[j] * sigm(g[j]);
                ss += (o[0] * o[0] + o[1] * o[1]) + (o[2] * o[2] + o[3] * o[3]);
                u32x2 w; w.x = cvt_pk_bf16(o[0], o[1]); w.y = cvt_pk_bf16(o[2], o[3]); *(u32x2*)(out + off + n * 16) = w; }
            row_ss_add(rs, row, ss, fq); }
#undef EPI_LD
    }
};

constexpr int S5T = 32, S5NCH = 512, S5KS = 768;
struct S5Order {
    int G, c, MT, NT;
    __device__ __forceinline__ bool next(int i, Unit& u) const { const int idx = i * G + c; if (idx >= 256 * MT * NT) return false; const int g = idx & 255, sub = idx >> 8;
        u.pm = g * MT + sub / NT; u.pn = g * NT + sub % NT; return true; }
    __device__ __forceinline__ void a_ready(const Unit&) const {}
    __device__ __forceinline__ void done(const Unit&) const {}
};
struct EpiS5U {
    static constexpr bool PERM = true, AFTER_DRAIN = false;
    bf16_t* UA; const rs_t* rs;
    __device__ __forceinline__ void operator()(const f32x4 (&acc)[2][2][4][2], const Unit& u, int wr, int wc, int fr, int fq) const {
        const int row0 = u.pm * BM + wr * 64 + fr, col0 = u.pn * BM + wc * 32 + 8 * fq;
        rs_t scv[8];
#pragma unroll
        for (int gi = 0; gi < 8; ++gi) scv[gi] = rs[row0 + (gi >> 2) * HALF + (gi & 3) * 16];
        PIN8(scv);
#pragma unroll
        for (int ai = 0; ai < 2; ++ai)
#pragma unroll
            for (int m = 0; m < 4; ++m) { const int t = row0 + ai * HALF + m * 16, c = t >> 5, sg = t & 31; const float sc = rs_rinv(scv[ai * 4 + m]);
#pragma unroll
                for (int bj = 0; bj < 2; ++bj) { const int col = col0 + bj * HALF, g = col >> 4, q0 = col & 15;
                    const f32x4 v0 = acc[ai][bj][m][0] * sc, v1 = acc[ai][bj][m][1] * sc;
                    u32x4 w; w.x = cvt_pk_bf16(v0[0], v0[1]); w.y = cvt_pk_bf16(v0[2], v0[3]); w.z = cvt_pk_bf16(v1[0], v1[1]); w.w = cvt_pk_bf16(v1[2], v1[3]);
                    *(u32x4*)(UA + ((size_t)(g * S5NCH + c) * S5KS + sg * 16 + q0)) = w; } }
    }
};
struct EpiS5E {
    static constexpr bool PERM = false, AFTER_DRAIN = false;
    float* E;
    __device__ __forceinline__ void operator()(const f32x4 (&acc)[2][2][4][2], const Unit& u, int wr, int wc, int fr, int fq) const {
        const int row0 = u.pm * BM + wr * 64 + fr, col0 = wc * 32 + 4 * fq;
#pragma unroll
        for (int ai = 0; ai < 2; ++ai)
#pragma unroll
            for (int m = 0; m < 4; ++m) { float* rowp = E + (size_t)(row0 + ai * HALF + m * 16) * 256 + col0;
#pragma unroll
                for (int bj = 0; bj < 2; ++bj)
#pragma unroll
                    for (int n = 0; n < 2; ++n) *(f32x4*)(rowp + bj * HALF + n * 16) = acc[ai][bj][m][n]; }
    }
};
__device__ __forceinline__ float gelu_tanh_f(float v) {
    const float z = 0.7978845608028654f * (v + 0.044715f * v * v * v);
    const float e = __builtin_amdgcn_exp2f(2.0f * 1.4426950408889634f * z);
    return 0.5f * v * (2.0f - 2.0f * __builtin_amdgcn_rcpf(e + 1.0f));
}
struct EpiS5Y {
    static constexpr bool PERM = true, AFTER_DRAIN = false;
    const bf16_t* UA; const float* dskip; bf16_t* G; int ldg;
    __device__ __forceinline__ void operator()(const f32x4 (&acc)[2][2][4][2], const Unit& u, int wr, int wc, int fr, int fq) const {
        const int row0 = u.pm * BM + wr * 64 + fr, col0 = (u.pn & 1) * BM + wc * 32 + 8 * fq;
        const int g = u.pm >> 1, p0 = col0 & 15;
        const f32x4 d0 = *(const f32x4*)(dskip + 16 * g + p0), d1 = *(const f32x4*)(dskip + 16 * g + p0 + 4);
        u32x4 uu[8][2];
#pragma unroll
        for (int gi = 0; gi < 8; ++gi)
#pragma unroll
            for (int bj = 0; bj < 2; ++bj) uu[gi][bj] = *(const u32x4*)(UA + ((size_t)(row0 + (gi >> 2) * HALF + (gi & 3) * 16) * S5KS + col0 + bj * HALF));
#pragma unroll
        for (int gi = 0; gi < 8; ++gi) asm volatile("" : "+v"(uu[gi][0]), "+v"(uu[gi][1]));
#pragma unroll
        for (int gi = 0; gi < 8; ++gi) { const int ai = gi >> 2, m = gi & 3; const int rowg = row0 + ai * HALF + m * 16, c = rowg & 511;
#pragma unroll
            for (int bj = 0; bj < 2; ++bj) { const int col = col0 + bj * HALF, tau = col >> 4; const u32x4 w4 = uu[gi][bj];
                f32x4 v0 = acc[ai][bj][m][0], v1 = acc[ai][bj][m][1];
                v0[0] += d0[0] * __builtin_bit_cast(float, w4.x << 16); v0[1] += d0[1] * __builtin_bit_cast(float, w4.x & 0xffff0000u);
                v0[2] += d0[2] * __builtin_bit_cast(float, w4.y << 16); v0[3] += d0[3] * __builtin_bit_cast(float, w4.y & 0xffff0000u);
                v1[0] += d1[0] * __builtin_bit_cast(float, w4.z << 16); v1[1] += d1[1] * __builtin_bit_cast(float, w4.z & 0xffff0000u);
                v1[2] += d1[2] * __builtin_bit_cast(float, w4.w << 16); v1[3] += d1[3] * __builtin_bit_cast(float, w4.w & 0xffff0000u);
#pragma unroll
                for (int j = 0; j < 4; ++j) { v0[j] = gelu_tanh_f(v0[j]); v1[j] = gelu_tanh_f(v1[j]); }
                int w0 = __builtin_amdgcn_cvt_pk_fp8_f32(16.f * v0[0], 16.f * v0[1], 0, false); w0 = __builtin_amdgcn_cvt_pk_fp8_f32(16.f * v0[2], 16.f * v0[3], w0, true);
                int w1 = __builtin_amdgcn_cvt_pk_fp8_f32(16.f * v1[0], 16.f * v1[1], 0, false); w1 = __builtin_amdgcn_cvt_pk_fp8_f32(16.f * v1[2], 16.f * v1[3], w1, true);
                *(v2u*)((unsigned char*)G + (size_t)(32 * c + tau) * ldg + 16 * g + p0) = (v2u){(unsigned)w0, (unsigned)w1}; } }
    }
};

template <class Epi, class Sched, bool ALIGN_EPI = false, bool SP2 = false, bool FP8 = false>
__device__ __forceinline__ void gemm_phase(PG8_LAS unsigned char* lds, const Gemm g, const Sched& S, const Epi& E) {
    int tid_o = wg_tid(); asm volatile("" : "+v"(tid_o)); const int tid = tid_o, wid = __builtin_amdgcn_readfirstlane(tid >> 6), lane = tid & 63, wr = wid >> 2, wc = wid & 3, fr = lane & 15, fq = lane >> 4;
    const int K = g.K, nt = K / BK;
    unsigned voffA[2], voffB[2];
#pragma unroll
    for (int i = 0; i < 2; ++i) { int R, C; stage_rc(tid * 16 + i * 8192, R, C); const int Rb = Epi::PERM ? ((R & ~31) + perm32(R & 31)) : R;
        voffA[i] = (unsigned)(R * g.lda + C) * 2u; voffB[i] = (unsigned)(Rb * g.ldb + C) * 2u; }
    const size_t kstep = (size_t)(BK * 2);
    const size_t hstepA = (size_t)HALF * g.lda * 2, hstepB = (size_t)HALF * g.ldb * 2;
    const size_t tstepA = 2 * hstepA, tstepB = 2 * hstepB;
    const unsigned ldsw = (unsigned)wid * 1024u;
    const int aoff = lds_byte(wr * 64 + fr, fq * 8), boff = lds_byte(wc * 32 + fr, fq * 8);
    const int aoff8 = lds_byte(wr * 64 + fr, fq * 16), boff8 = lds_byte(wc * 32 + fr, fq * 16);
#define PG8_SA(b, h) (((b) * 2 + (h)) * HTB)
#define PG8_SB(b, h) ((4 + (b) * 2 + (h)) * HTB)
#define PG8_STAGE(bufoff, gbase, voff) do { _Pragma("unroll") for (int _i = 0; _i < 2; ++_i) \
        __builtin_amdgcn_global_load_lds((const unsigned*)((const char*)(gbase) + (voff)[_i]), (PG8_LAS unsigned*)(lds + (bufoff) + ldsw + _i * 8192), 16, 0, 0); } while (0)
#define PG8_LDA(dst, b, h) do { if constexpr (FP8) { _Pragma("unroll") for (int m = 0; m < 4; ++m) { const PG8_LAS unsigned char* p_ = lds + PG8_SA(b, h) + aoff8 + m * 2048; const v4i32 l_ = *(const PG8_LAS v4i32*)p_, h_ = *(const PG8_LAS v4i32*)(p_ + 16); \
        dst##8[m] = __builtin_shufflevector(l_, h_, 0, 1, 2, 3, 4, 5, 6, 7); } } else { \
        _Pragma("unroll") for (int m = 0; m < 4; ++m) _Pragma("unroll") for (int k = 0; k < 2; ++k) dst[m][k] = *(const PG8_LAS bf16x8*)(lds + PG8_SA(b, h) + aoff + m * 2048 + k * 1024); } } while (0)
#define PG8_LDB(dst, b, h) do { if constexpr (FP8) { _Pragma("unroll") for (int n = 0; n < 2; ++n) { const PG8_LAS unsigned char* p_ = lds + PG8_SB(b, h) + boff8 + n * 2048; const v4i32 l_ = *(const PG8_LAS v4i32*)p_, h_ = *(const PG8_LAS v4i32*)(p_ + 16); \
        dst##8[n] = __builtin_shufflevector(l_, h_, 0, 1, 2, 3, 4, 5, 6, 7); } } else { \
        _Pragma("unroll") for (int n = 0; n < 2; ++n) _Pragma("unroll") for (int k = 0; k < 2; ++k) dst[n][k] = *(const PG8_LAS bf16x8*)(lds + PG8_SB(b, h) + boff + n * 2048 + k * 1024); } } while (0)
#define PG8_MMA(ai, bj, At, Bt) do { __builtin_amdgcn_s_setprio(1); if constexpr (FP8) { _Pragma("unroll") for (int m = 0; m < 4; ++m) _Pragma("unroll") for (int n = 0; n < 2; ++n) \
        asm volatile("v_mfma_scale_f32_16x16x128_f8f6f4 %0, %1, %2, %0, %3, %4 op_sel_hi:[0,0,0]" : "+v"(acc[ai][bj][m][n]) : "v"(Bt##8[n]), "v"(At##8[m]), "v"(sc_w8), "v"(sc_a8)); } else { \
        _Pragma("unroll") for (int m = 0; m < 4; ++m) _Pragma("unroll") for (int n = 0; n < 2; ++n) _Pragma("unroll") for (int k = 0; k < 2; ++k) \
        acc[ai][bj][m][n] = __builtin_amdgcn_mfma_f32_16x16x32_bf16(Bt[n][k], At[m][k], acc[ai][bj][m][n], 0, 0, 0); } __builtin_amdgcn_s_setprio(0); } while (0)
#define PG8_WAIT_V(n) asm volatile("s_waitcnt vmcnt(" #n ")" ::: "memory")
#define PG8_WAIT_L(n) asm volatile("s_waitcnt lgkmcnt(" #n ")" ::: "memory")
#define PG8_BAR __builtin_amdgcn_s_barrier()
#define PG8_SCHED __builtin_amdgcn_sched_barrier(0)
    Unit cur, nxt; int ui = 0;
    if (!S.next(0, cur)) return;
    f32x4 acc[2][2][4][2];
#pragma unroll
    for (int a = 0; a < 2; ++a)
#pragma unroll
        for (int b = 0; b < 2; ++b)
#pragma unroll
            for (int m = 0; m < 4; ++m)
#pragma unroll
                for (int n = 0; n < 2; ++n) acc[a][b][m][n] = (f32x4){0.f, 0.f, 0.f, 0.f};
    bf16x8 At[4][2], B0[2][2], B1[2][2];
    typedef int v8i32 __attribute__((ext_vector_type(8))); typedef int v4i32 __attribute__((ext_vector_type(4))); v8i32 At8[4], B08[2], B18[2];
    const int sc_w8 = 0x79797979, sc_a8 = g.sa;
    const char* cA = (const char*)g.A + (size_t)cur.pm * tstepA; const char* cB = (const char*)g.Bt + (size_t)cur.pn * tstepB;
    S.a_ready(cur);
    if constexpr (SP2) {
        PG8_STAGE(PG8_SB(0, 0), cB, voffB); PG8_STAGE(PG8_SB(0, 1), cB + hstepB, voffB); PG8_STAGE(PG8_SA(0, 0), cA, voffA); PG8_STAGE(PG8_SA(0, 1), cA + hstepA, voffA);
        if (wr == 1) PG8_BAR;
        PG8_WAIT_V(2); PG8_BAR;
        PG8_STAGE(PG8_SB(1, 0), cB + kstep, voffB); PG8_STAGE(PG8_SA(1, 0), cA + kstep, voffA); PG8_STAGE(PG8_SB(1, 1), cB + hstepB + kstep, voffB);
        PG8_WAIT_V(6); PG8_BAR;
    } else {
        PG8_STAGE(PG8_SB(0, 0), cB, voffB); PG8_STAGE(PG8_SA(0, 0), cA, voffA); PG8_STAGE(PG8_SB(0, 1), cB + hstepB, voffB); PG8_STAGE(PG8_SA(0, 1), cA + hstepA, voffA);
        if (wr == 1) PG8_BAR;
        PG8_WAIT_V(4); PG8_BAR;
        PG8_STAGE(PG8_SB(1, 0), cB + kstep, voffB); PG8_STAGE(PG8_SA(1, 0), cA + kstep, voffA); PG8_STAGE(PG8_SB(1, 1), cB + hstepB + kstep, voffB);
        PG8_WAIT_V(6); PG8_BAR;
    }
    for (;;) {
        const bool has_next = S.next(ui + 1, nxt);
        const char* nA = has_next ? (const char*)g.A + (size_t)nxt.pm * tstepA : cA; const char* nB = has_next ? (const char*)g.Bt + (size_t)nxt.pn * tstepB : cB;
        for (int t = 0; t < nt; t += 2) {
            const bool last = (t == nt - 2);
            const char* a1 = cA + (size_t)(t + 1) * kstep;
            const char* a2 = last ? nA : cA + (size_t)(t + 2) * kstep; const char* b2 = last ? nB : cB + (size_t)(t + 2) * kstep;
            const char* a3 = a2 + kstep; const char* b3 = b2 + kstep;
            if (last && has_next) S.a_ready(nxt);
            if constexpr (SP2) {
            PG8_LDB(B0, 0, 0); PG8_LDB(B1, 0, 1); PG8_SCHED; PG8_LDA(At, 0, 0); PG8_STAGE(PG8_SA(1, 1), a1 + hstepA, voffA);
            PG8_WAIT_V(8); PG8_WAIT_L(0); PG8_BAR; PG8_MMA(0, 0, At, B0); PG8_MMA(0, 1, At, B1); PG8_BAR; PG8_SCHED;
            PG8_LDA(At, 0, 1); PG8_STAGE(PG8_SB(0, 0), b2, voffB); PG8_STAGE(PG8_SB(0, 1), b2 + hstepB, voffB); PG8_STAGE(PG8_SA(0, 0), a2, voffA);
            PG8_WAIT_V(8); PG8_WAIT_L(0); PG8_BAR; PG8_MMA(1, 0, At, B0); PG8_MMA(1, 1, At, B1); PG8_BAR; PG8_SCHED;
            PG8_LDB(B0, 1, 0); PG8_LDB(B1, 1, 1); PG8_SCHED; PG8_LDA(At, 1, 0); PG8_STAGE(PG8_SA(0, 1), a2 + hstepA, voffA);
            PG8_WAIT_V(8); PG8_WAIT_L(0); PG8_BAR; PG8_MMA(0, 0, At, B0); PG8_MMA(0, 1, At, B1); PG8_BAR; PG8_SCHED;
            PG8_LDA(At, 1, 1); PG8_STAGE(PG8_SB(1, 0), b3, voffB); PG8_STAGE(PG8_SB(1, 1), b3 + hstepB, voffB); PG8_STAGE(PG8_SA(1, 0), a3, voffA);
            PG8_WAIT_V(8); PG8_WAIT_L(0); PG8_BAR; PG8_MMA(1, 0, At, B0); PG8_MMA(1, 1, At, B1); PG8_BAR; PG8_SCHED;
            } else {
            PG8_LDB(B0, 0, 0); PG8_SCHED; PG8_LDA(At, 0, 0); PG8_STAGE(PG8_SA(1, 1), a1 + hstepA, voffA);
            PG8_WAIT_L(8); PG8_BAR; PG8_WAIT_L(0); PG8_MMA(0, 0, At, B0); PG8_BAR; PG8_SCHED;
            PG8_LDB(B1, 0, 1); PG8_STAGE(PG8_SB(0, 0), b2, voffB);
            PG8_BAR; PG8_WAIT_L(0); PG8_MMA(0, 1, At, B1); PG8_BAR;
            PG8_LDA(At, 0, 1); PG8_STAGE(PG8_SA(0, 0), a2, voffA);
            PG8_BAR; PG8_WAIT_L(0); PG8_MMA(1, 0, At, B0); PG8_BAR; PG8_SCHED;
            PG8_STAGE(PG8_SB(0, 1), b2 + hstepB, voffB);
            PG8_WAIT_V(6); PG8_BAR; PG8_MMA(1, 1, At, B1); PG8_BAR;
            PG8_LDB(B0, 1, 0); PG8_SCHED; PG8_LDA(At, 1, 0); PG8_STAGE(PG8_SA(0, 1), a2 + hstepA, voffA);
            PG8_WAIT_L(8); PG8_BAR; PG8_WAIT_L(0); PG8_MMA(0, 0, At, B0); PG8_BAR; PG8_SCHED;
            PG8_LDB(B1, 1, 1); PG8_STAGE(PG8_SB(1, 0), b3, voffB);
            PG8_BAR; PG8_WAIT_L(0); PG8_MMA(0, 1, At, B1); PG8_BAR;
            PG8_LDA(At, 1, 1); PG8_STAGE(PG8_SA(1, 0), a3, voffA);
            PG8_BAR; PG8_WAIT_L(0); PG8_MMA(1, 0, At, B0); PG8_BAR; PG8_SCHED;
            PG8_STAGE(PG8_SB(1, 1), b3 + hstepB, voffB);
            PG8_WAIT_V(6); PG8_BAR; PG8_MMA(1, 1, At, B1); PG8_BAR;
            }
        }
        if constexpr (FP8) asm volatile("s_nop 15\n\ts_nop 7" ::: "memory");
        if constexpr (ALIGN_EPI) { if (wr == 0) PG8_BAR; }
        if constexpr (!Epi::AFTER_DRAIN) { E(acc, cur, wr, wc, fr, fq); PROBE_EPI_DUP S.done(cur); }
        if (!has_next) break;
#pragma unroll
        for (int a = 0; a < 2; ++a)
#pragma unroll
            for (int b = 0; b < 2; ++b)
#pragma unroll
                for (int m = 0; m < 4; ++m)
#pragma unroll
                    for (int n = 0; n < 2; ++n) acc[a][b][m][n] = (f32x4){0.f, 0.f, 0.f, 0.f};
        cur = nxt; cA = nA; cB = nB; ++ui;
        if constexpr (ALIGN_EPI) { if (wr == 1) PG8_BAR; }
    }
    PG8_WAIT_V(0);
    if constexpr (!ALIGN_EPI) { if (wr == 0) PG8_BAR; }
    PG8_BAR;
    if constexpr (Epi::AFTER_DRAIN) { E.fused(acc, cur, wr, wc, fr, fq, lds, wid, lane); S.done(cur); }
#undef PG8_SA
#undef PG8_SB
#undef PG8_STAGE
#undef PG8_LDA
#undef PG8_LDB
#undef PG8_MMA
#undef PG8_WAIT_V
#undef PG8_WAIT_L
#undef PG8_BAR
#undef PG8_SCHED
}
}
#define XB_TMO      128
#define XB_XCNT(j)  (256  + 64 * (j))
#define XB_XSUB(j)  (1280 + 64 * (j))
#define XB_XGEN(j)  (2304 + 64 * (j))
#define XB_TOP      3328
#define XB_TOPGEN   3392
#define XCD_BAR_WORDS 3456
#define XB_SPIN_CAP (1u << 18)

__device__ __forceinline__ unsigned xb_ld(unsigned* p)              { return __hip_atomic_load(p, __ATOMIC_RELAXED, __HIP_MEMORY_SCOPE_AGENT); }
__device__ __forceinline__ unsigned xb_add(unsigned* p, unsigned v) { return __hip_atomic_fetch_add(p, v, __ATOMIC_RELAXED, __HIP_MEMORY_SCOPE_AGENT); }
__device__ __forceinline__ unsigned xb_xcc_id() { return (unsigned)__builtin_amdgcn_s_getreg((3 << 11) | 20) & 0xFu; }
#define XB_SPIN(cond, bar) do { unsigned _sp = 0; while (cond) { __builtin_amdgcn_s_sleep(1); \
    if ((++_sp & 255u) == 0u) { if (xb_ld(&(bar)[XB_TMO])) break; if (_sp > XB_SPIN_CAP) { atomicAdd(&(bar)[XB_TMO], 1u); break; } } } } while (0)

struct XcdBarrier {
    unsigned* bar; unsigned x;
    volatile LAS unsigned* st;
};

__device__ __forceinline__ XcdBarrier xcd_barrier_post(unsigned* bar, volatile LAS unsigned* st) {
    XcdBarrier b; b.bar = bar; b.x = xb_xcc_id(); b.st = st;
    if (wg_tid() == 0) (void)xb_add(&bar[XB_XCNT(b.x)], 1u);
    return b;
}
__device__ __forceinline__ void xcd_barrier_complete(unsigned* bar, unsigned x, unsigned& nloc, unsigned& nx) {
    const unsigned G = gridDim.x * gridDim.y * gridDim.z;
    unsigned sum, cnt, mine, sp = 0u;
    for (;;) {
        sum = 0u; cnt = 0u; mine = 0u;
#pragma unroll
        for (unsigned j = 0; j < 16; ++j) { const unsigned c = xb_ld(&bar[XB_XCNT(j)]); sum += c; cnt += (c > 0u) ? 1u : 0u; mine = (j == x) ? c : mine; }
        if (sum == G) break;
        __builtin_amdgcn_s_sleep(1);
        if ((++sp & 255u) == 0u) { if (xb_ld(&bar[XB_TMO])) break; if (sp > XB_SPIN_CAP) { atomicAdd(&bar[XB_TMO], 1u); break; } }
    }
    nloc = mine > 0u ? mine : 1u; nx = cnt > 0u ? cnt : 1u;
}

__device__ __forceinline__ void xcd_barrier(const XcdBarrier& b) {
    asm volatile("s_waitcnt vmcnt(0)" ::: "memory");
    __syncthreads();
    if (wg_tid() == 0) {
        unsigned* bar = b.bar;
        __builtin_amdgcn_s_waitcnt(0);
        unsigned nloc = b.st[0], nx = b.st[1];
        if (nloc == 0u) { xcd_barrier_complete(bar, b.x, nloc, nx); b.st[0] = nloc; b.st[1] = nx; }
        const unsigned old = xb_add(&bar[XB_XSUB(b.x)], 1u);
        const unsigned gen = old / nloc;
        if (old + 1u == (gen + 1u) * nloc) {
            __builtin_amdgcn_fence(__ATOMIC_RELEASE, "agent");
            asm volatile("s_waitcnt vmcnt(0)" ::: "memory");
            const unsigned og = xb_add(&bar[XB_TOP], 1u);
            const unsigned tg = og / nx;
            if (og + 1u == (tg + 1u) * nx) xb_add(&bar[XB_TOPGEN], 1u);
            else XB_SPIN(xb_ld(&bar[XB_TOPGEN]) == tg, bar);
            __builtin_amdgcn_fence(__ATOMIC_ACQUIRE, "agent");
            xb_add(&bar[XB_XGEN(b.x)], 1u);
            asm volatile("s_waitcnt vmcnt(0)" ::: "memory");
        } else {
            XB_SPIN(xb_ld(&bar[XB_XGEN(b.x)]) == gen, bar);
            __builtin_amdgcn_fence(__ATOMIC_ACQUIRE, "agent");
            asm volatile("s_waitcnt vmcnt(0)" ::: "memory");
        }
    }
    __syncthreads();
}
namespace dattn {
typedef unsigned short bf16;
constexpr int   D = 128, NW = 8, QBLK = 32, KVBLK = 64;
constexpr float SCALE = 0.088388347648318440f;
constexpr float THR = 8.f;
constexpr int SDEPTH = 2;
constexpr int LDQ = 4096, LDK = 1024, LDO = 4096;
constexpr size_t SHM_V = KVBLK * D * 2, SHM_K = KVBLK * D * 2, SHM_ATTN = 3 * SHM_V + 3 * SHM_K + NW * 64 * 4 + 2048;
using bf16x8 = __attribute__((ext_vector_type(8))) short;
using s16x4  = __attribute__((ext_vector_type(4))) short;
using f32x16 = __attribute__((ext_vector_type(16))) float;
using f32x8  = __attribute__((ext_vector_type(8))) float;
using u32x4  = __attribute__((ext_vector_type(4))) unsigned;
#define KSWZ(row, colB) ((row) * 256 + ((colB) ^ (((row) & 7) << 4)))
#define SBAR() __builtin_amdgcn_sched_barrier(0)
__device__ __forceinline__ int crow(int r, int hi) { return (r & 3) + 8 * (r >> 2) + 4 * hi; }
__device__ __forceinline__ unsigned cvtpk(float lo, float hi) {
  unsigned r; asm volatile("v_cvt_pk_bf16_f32 %0, %1, %2" : "=v"(r) : "v"(lo), "v"(hi)); return r;
}
template <typename TIn> struct Stage;
template <> struct Stage<bf16>  { using T = bf16x8;
  __device__ static __forceinline__ T ld8(const bf16* p) { return *reinterpret_cast<const bf16x8*>(p); }
  __device__ static __forceinline__ bf16x8 tobf(T x) { return x; } };
template <> struct Stage<float> { using T = f32x8;
  __device__ static __forceinline__ T ld8(const float* p) { return *reinterpret_cast<const f32x8*>(p); }
  __device__ static __forceinline__ bf16x8 tobf(T x) {
    u32x4 w = {cvtpk(x[0], x[1]), cvtpk(x[2], x[3]), cvtpk(x[4], x[5]), cvtpk(x[6], x[7])}; return *reinterpret_cast<bf16x8*>(&w); } };

__device__ __forceinline__ void partialSM(f32x16& p0, f32x16& p1, float& m_reg, float& mn, float& alpha) {
  constexpr float C = SCALE * 1.4426950408889634f;
  float pmax = p0[0]; for (int r = 1; r < 16; ++r) pmax = fmaxf(pmax, p0[r]); for (int r = 0; r < 16; ++r) pmax = fmaxf(pmax, p1[r]);
  { auto rr = __builtin_amdgcn_permlane32_swap(__float_as_uint(pmax), __float_as_uint(pmax), false, false);
    pmax = fmaxf(__uint_as_float(rr[0]), __uint_as_float(rr[1])); }
  if (__builtin_expect(__all(pmax - m_reg <= THR / SCALE), 1)) { mn = m_reg; alpha = 1.f; }
  else { mn = fmaxf(m_reg, pmax); alpha = __builtin_amdgcn_exp2f((m_reg - mn) * C); m_reg = mn; }
  float mnC = -mn * C;
  for (int r = 0; r < 16; ++r) p0[r] = fmaf(p0[r], C, mnC); for (int r = 0; r < 16; ++r) p1[r] = fmaf(p1[r], C, mnC);
  for (int r = 0; r < 16; ++r) p0[r] = __builtin_amdgcn_exp2f(p0[r]);
}
__device__ __forceinline__ void finishSM(f32x16& p0, f32x16& p1, float alpha, float& l_reg, bf16x8& pa0, bf16x8& pa1, bf16x8& pa2, bf16x8& pa3) {
  for (int r = 0; r < 16; ++r) p1[r] = __builtin_amdgcn_exp2f(p1[r]);
  float ps = 0; for (int r = 0; r < 16; ++r) ps += p0[r]; for (int r = 0; r < 16; ++r) ps += p1[r];
  { auto rr = __builtin_amdgcn_permlane32_swap(__float_as_uint(ps), __float_as_uint(ps), false, false);
    ps = __uint_as_float(rr[0]) + __uint_as_float(rr[1]); }
  l_reg = l_reg * alpha + ps;
#define PK4(P, BASE, OUT) do { unsigned a0 = cvtpk(P[BASE + 0], P[BASE + 1]), a1 = cvtpk(P[BASE + 2], P[BASE + 3]);   \
    unsigned b0 = cvtpk(P[BASE + 4], P[BASE + 5]), b1 = cvtpk(P[BASE + 6], P[BASE + 7]);                              \
    auto r0 = __builtin_amdgcn_permlane32_swap(a0, b0, false, false); auto r1 = __builtin_amdgcn_permlane32_swap(a1, b1, false, false); \
    u32x4 w = {r0[0], r1[0], r0[1], r1[1]}; OUT = *reinterpret_cast<bf16x8*>(&w); } while (0)
  PK4(p0, 0, pa0); PK4(p0, 8, pa1); PK4(p1, 0, pa2); PK4(p1, 8, pa3);
#undef PK4
}
__device__ __forceinline__ void qkt(f32x16& p0, f32x16& p1, const bf16* Ks, const bf16x8* qr, int r32, int hi) {
  p0 = f32x16{}; p1 = f32x16{};
  bf16x8 nb0 = *reinterpret_cast<const bf16x8*>((const char*)Ks + KSWZ(r32, (hi * 8) * 2)), nb1 = *reinterpret_cast<const bf16x8*>((const char*)Ks + KSWZ(32 + r32, (hi * 8) * 2));
#pragma unroll
  for (int d0 = 0; d0 < 8; ++d0) { const bf16x8 b0 = nb0, b1 = nb1;
    if (d0 < 7) { const int cb = ((d0 + 1) * 16 + hi * 8) * 2;
      nb0 = *reinterpret_cast<const bf16x8*>((const char*)Ks + KSWZ(r32, cb)); nb1 = *reinterpret_cast<const bf16x8*>((const char*)Ks + KSWZ(32 + r32, cb)); }
    p0 = __builtin_amdgcn_mfma_f32_32x32x16_bf16(b0, qr[d0], p0, 0, 0, 0);
    p1 = __builtin_amdgcn_mfma_f32_32x32x16_bf16(b1, qr[d0], p1, 0, 0, 0); }
}
__device__ __forceinline__ int v_st(int k, int c) { const int kk = (k & ~0xC) | ((k & 4) << 1) | ((k & 8) >> 1); return ((kk >> 3) * 4 + (c >> 5)) * 512 + ((kk & 7) * 32 + (c & 31)) * 2; }
__device__ __forceinline__ int v_rd_base(int lane) { return ((lane & 3) << 3) | (((lane >> 2) & 3) << 6) | (((lane >> 4) & 1) << 5) | (((lane >> 5) & 1) << 8); }
constexpr int v_rd_off(int d0, int ks, int half) { return d0 * 512 + ks * 4096 + half * 2048; }
template <int OFF> __device__ __forceinline__ s16x4 tr_read(int vb) {
  s16x4 r; asm volatile("ds_read_b64_tr_b16 %0, %1 offset:%2" : "=&v"(r) : "v"(vb), "i"(OFF) : "memory"); return r;
}
template <int D0> __device__ __forceinline__ void pv_one(f32x16& od, int vb, bf16x8 pa0, bf16x8 pa1, bf16x8 pa2, bf16x8 pa3) {
  const s16x4 l0 = tr_read<v_rd_off(D0, 0, 0)>(vb), h0 = tr_read<v_rd_off(D0, 0, 1)>(vb), l1 = tr_read<v_rd_off(D0, 1, 0)>(vb), h1 = tr_read<v_rd_off(D0, 1, 1)>(vb);
  const s16x4 l2 = tr_read<v_rd_off(D0, 2, 0)>(vb), h2 = tr_read<v_rd_off(D0, 2, 1)>(vb), l3 = tr_read<v_rd_off(D0, 3, 0)>(vb), h3 = tr_read<v_rd_off(D0, 3, 1)>(vb);
  asm volatile("s_waitcnt lgkmcnt(0)" ::: "memory"); SBAR();
#define PK(L, H) (bf16x8){L[0], L[1], L[2], L[3], H[0], H[1], H[2], H[3]}
  od = __builtin_amdgcn_mfma_f32_32x32x16_bf16(pa0, PK(l0, h0), od, 0, 0, 0);
  od = __builtin_amdgcn_mfma_f32_32x32x16_bf16(pa1, PK(l1, h1), od, 0, 0, 0);
  od = __builtin_amdgcn_mfma_f32_32x32x16_bf16(pa2, PK(l2, h2), od, 0, 0, 0);
  od = __builtin_amdgcn_mfma_f32_32x32x16_bf16(pa3, PK(l3, h3), od, 0, 0, 0);
#undef PK
}
__device__ __forceinline__ void pv_d0(f32x16* o, int vb, bf16x8 pa0, bf16x8 pa1, bf16x8 pa2, bf16x8 pa3) {
  pv_one<0>(o[0], vb, pa0, pa1, pa2, pa3); pv_one<1>(o[1], vb, pa0, pa1, pa2, pa3); pv_one<2>(o[2], vb, pa0, pa1, pa2, pa3); pv_one<3>(o[3], vb, pa0, pa1, pa2, pa3);
}

template <typename TQ>
__device__ __forceinline__ void attn_dense_body(const TQ* __restrict__ Qb, const bf16* __restrict__ Kh, const bf16* __restrict__ Vh,
                                                bf16* __restrict__ Ob, int seq, char* lds) {
  using St = Stage<bf16>; using SQ = Stage<TQ>;
  int tid_o = wg_tid(); asm volatile("" : "+v"(tid_o)); const int tid = tid_o, wid = __builtin_amdgcn_readfirstlane(tid >> 6), lane = tid & 63, r32 = lane & 31, hi = lane >> 5;
  bf16* V_lds = (bf16*)lds; bf16* K_lds = (bf16*)(lds + 3 * SHM_V);
  float* ws = (float*)(lds + 3 * SHM_V + 3 * SHM_K) + wid * 64; float* li_l = ws; float* al_l = ws + 32;
  float m_reg = -1e30f, l_reg = 0; f32x16 o[4] = {}; bf16x8 qr[8];
  const TQ* Qw = Qb + (long)(wid * QBLK + r32) * LDQ + hi * 8;
#pragma unroll
  for (int d0 = 0; d0 < 8; ++d0) qr[d0] = SQ::tobf(SQ::ld8(Qw + d0 * 16));
  const int sr = tid >> 4, sc = (tid & 15) * 8, vst0 = v_st(sr, sc), vst1 = v_st(32 + sr, sc);
  const int vb0 = (int)(uintptr_t)V_lds + v_rd_base(lane);
  struct { typename St::T vs0, vs1, ks0, ks1; } sr_[SDEPTH];
#define SLOAD(i, k0) do { sr_[i].vs0 = St::ld8(&Vh[(long)((k0) + sr) * LDK + sc]); sr_[i].vs1 = St::ld8(&Vh[(long)((k0) + 32 + sr) * LDK + sc]); \
    sr_[i].ks0 = St::ld8(&Kh[(long)((k0) + sr) * LDK + sc]); sr_[i].ks1 = St::ld8(&Kh[(long)((k0) + 32 + sr) * LDK + sc]); } while (0)
#define SWRITE(b, i) do { *(bf16x8*)((char*)V_lds + (b) * SHM_V + vst0) = St::tobf(sr_[i].vs0);          \
    *(bf16x8*)((char*)V_lds + (b) * SHM_V + vst1) = St::tobf(sr_[i].vs1); int kc = sc * 2;               \
    *(bf16x8*)((char*)K_lds + (b) * SHM_K + KSWZ(sr, kc)) = St::tobf(sr_[i].ks0);                       \
    *(bf16x8*)((char*)K_lds + (b) * SHM_K + KSWZ(32 + sr, kc)) = St::tobf(sr_[i].ks1); } while (0)
#define SWAIT() do { if constexpr (SDEPTH == 2) asm volatile("s_waitcnt vmcnt(4)" ::: "memory"); else asm volatile("s_waitcnt vmcnt(0)" ::: "memory"); } while (0)
#define RESC(a) do { if (__any((a) < 1.f)) { if (hi == 0) al_l[r32] = (a); asm volatile("s_waitcnt lgkmcnt(0)" ::: "memory"); \
    for (int d = 0; d < 4; ++d) for (int r = 0; r < 16; ++r) o[d][r] *= al_l[crow(r, hi)]; } } while (0)
  f32x16 pA0, pA1, pB0, pB1; float mnA, mnB, alA, alB; bf16x8 pa0, pa1, pa2, pa3; const int NT = seq / KVBLK;
  constexpr int SE = 0, SO = SDEPTH - 1;
  SLOAD(SE, 0); asm volatile("s_waitcnt vmcnt(0)" ::: "memory"); SWRITE(0, SE); __syncthreads();
  qkt(pA0, pA1, K_lds, qr, r32, hi); partialSM(pA0, pA1, m_reg, mnA, alA);
  SLOAD(SO, KVBLK); if constexpr (SDEPTH == 2) { if (2 < NT) SLOAD(SE, 2 * KVBLK); }
  SWAIT(); SWRITE(1, SO); __syncthreads();
  int bk = 1, bv = 0, bw = 2;
  if (wid >= 4) __builtin_amdgcn_s_setprio(1);
#define ROT3() do { const int t_ = bv; bv = bk; bk = bw; bw = t_; } while (0)
  for (int j = 1; j + 1 < NT; j += 2) {
    SBAR(); qkt(pB0, pB1, (bf16*)((char*)K_lds + bk * SHM_K), qr, r32, hi);
    finishSM(pA0, pA1, alA, l_reg, pa0, pa1, pa2, pa3); SBAR();
    SLOAD(SO, (j + SDEPTH) * KVBLK); SBAR();
    pv_d0(o, vb0 + bv * (int)SHM_V, pa0, pa1, pa2, pa3); partialSM(pB0, pB1, m_reg, mnB, alB);
    SWAIT(); SWRITE(bw, SE);
    RESC(alB); __syncthreads(); ROT3();
    SBAR(); qkt(pA0, pA1, (bf16*)((char*)K_lds + bk * SHM_K), qr, r32, hi);
    finishSM(pB0, pB1, alB, l_reg, pa0, pa1, pa2, pa3); SBAR();
    if (SDEPTH == 1 || j + 3 < NT) SLOAD(SE, (j + 1 + SDEPTH) * KVBLK); SBAR();
    pv_d0(o, vb0 + bv * (int)SHM_V, pa0, pa1, pa2, pa3); partialSM(pA0, pA1, m_reg, mnA, alA);
    SWAIT(); SWRITE(bw, SO);
    RESC(alA); __syncthreads(); ROT3();
  }
  SBAR(); qkt(pB0, pB1, (bf16*)((char*)K_lds + bk * SHM_K), qr, r32, hi);
  finishSM(pA0, pA1, alA, l_reg, pa0, pa1, pa2, pa3); SBAR();
  pv_d0(o, vb0 + bv * (int)SHM_V, pa0, pa1, pa2, pa3); partialSM(pB0, pB1, m_reg, mnB, alB);
  RESC(alB);
  finishSM(pB0, pB1, alB, l_reg, pa0, pa1, pa2, pa3); SBAR();
  pv_d0(o, vb0 + bk * (int)SHM_V, pa0, pa1, pa2, pa3);
#undef ROT3
  __builtin_amdgcn_s_setprio(0);
  if (hi == 0) li_l[r32] = l_reg; asm volatile("s_waitcnt lgkmcnt(0)" ::: "memory");
  float rli[16];
#pragma unroll
  for (int r = 0; r < 16; ++r) rli[r] = __builtin_amdgcn_rcpf(li_l[crow(r, hi)]);
  bf16* Ow = Ob + (long)(wid * QBLK) * LDO;
#pragma unroll
  for (int r = 0; r < 16; ++r) { int orow = crow(r, hi);
    for (int d0 = 0; d0 < 4; ++d0) Ow[(long)orow * LDO + d0 * 32 + r32] = (bf16)(cvtpk(o[d0][r] * rli[r], 0.f) & 0xffffu); }
#undef SLOAD
#undef SWRITE
#undef SWAIT
#undef RESC
}

constexpr int NA_LD = 4096, NA_TILES = 12;
__device__ __forceinline__ void na_block_body(const bf16* __restrict__ Qb, const bf16* __restrict__ Kh, const bf16* __restrict__ Vh, bf16* __restrict__ Ob,
                                              const float* __restrict__ rpb_h, const float* __restrict__ qgain, const float* __restrict__ kgain, int R, int ks, char* lds) {
  using St = Stage<bf16>;
  int tid_o = wg_tid(); asm volatile("" : "+v"(tid_o)); const int tid = tid_o, wid = __builtin_amdgcn_readfirstlane(tid >> 6), lane = tid & 63, r32 = lane & 31, hi = lane >> 5;
  bf16* V_lds = (bf16*)lds; bf16* K_lds = (bf16*)(lds + 2 * SHM_V);
  float* ws = (float*)(lds + 2 * SHM_V + 2 * SHM_K) + wid * 64; float* li_l = ws; float* al_l = ws + 32;
  float* bt = (float*)(lds + 2 * SHM_V + 2 * SHM_K + NW * 64 * 4);
  float m_reg = -1e30f, l_reg = 0; f32x16 o[4] = {}; bf16x8 qr[8];
  const bf16* Qw = Qb + (long)(wid * QBLK + r32) * NA_LD + hi * 8;
#pragma unroll
  for (int d0 = 0; d0 < 8; ++d0) qr[d0] = St::ld8(Qw + d0 * 16);
  {
    float ss = 0.f;
#pragma unroll
    for (int d0 = 0; d0 < 8; ++d0) { const u32x4 w = __builtin_bit_cast(u32x4, qr[d0]);
#pragma unroll
      for (int e = 0; e < 4; ++e) { const float a = __uint_as_float(w[e] << 16), b = __uint_as_float(w[e] & 0xffff0000u); ss += a * a + b * b; } }
    ss += __shfl_xor(ss, 32);
    const float rinv = __builtin_amdgcn_rsqf(ss * (1.0f / 128.0f) + 1e-6f);
#pragma unroll
    for (int d0 = 0; d0 < 8; ++d0) { const u32x4 w = __builtin_bit_cast(u32x4, qr[d0]); const float* gp = qgain + d0 * 16 + hi * 8;
      const f32x8 g = *reinterpret_cast<const f32x8*>(gp); u32x4 o;
#pragma unroll
      for (int e = 0; e < 4; ++e) o[e] = cvtpk(__uint_as_float(w[e] << 16) * rinv * g[2 * e], __uint_as_float(w[e] & 0xffff0000u) * rinv * g[2 * e + 1]);
      qr[d0] = __builtin_bit_cast(bf16x8, o); } }
  const f32x8 kg = *reinterpret_cast<const f32x8*>(kgain + (tid & 15) * 8);
  for (int i = tid; i < 15 * 31; i += 64 * NW) bt[i] = rpb_h[i];
  const int sr = tid >> 4, sc = (tid & 15) * 8, vst0 = v_st(sr, sc), vst1 = v_st(32 + sr, sc);
  const int vb0 = (int)(uintptr_t)V_lds + v_rd_base(lane);
  bf16x8 s_vs0, s_vs1, s_ks0, s_ks1;
#define NLOAD(k0) do { s_vs0 = St::ld8(&Vh[(long)((k0) + sr) * NA_LD + sc]); s_vs1 = St::ld8(&Vh[(long)((k0) + 32 + sr) * NA_LD + sc]); \
    s_ks0 = St::ld8(&Kh[(long)((k0) + sr) * NA_LD + sc]); s_ks1 = St::ld8(&Kh[(long)((k0) + 32 + sr) * NA_LD + sc]); } while (0)
#define KNORM(x) do { const u32x4 w_ = __builtin_bit_cast(u32x4, x); float a_[8]; float ss_ = 0.f; \
    _Pragma("unroll") for (int e = 0; e < 4; ++e) { a_[2 * e] = __uint_as_float(w_[e] << 16); a_[2 * e + 1] = __uint_as_float(w_[e] & 0xffff0000u); ss_ += a_[2 * e] * a_[2 * e] + a_[2 * e + 1] * a_[2 * e + 1]; } \
    ss_ += __shfl_xor(ss_, 1); ss_ += __shfl_xor(ss_, 2); ss_ += __shfl_xor(ss_, 4); ss_ += __shfl_xor(ss_, 8); \
    const float ri_ = __builtin_amdgcn_rsqf(ss_ * (1.0f / 128.0f) + 1e-6f); u32x4 o_; \
    _Pragma("unroll") for (int e = 0; e < 4; ++e) o_[e] = cvtpk(a_[2 * e] * ri_ * kg[2 * e], a_[2 * e + 1] * ri_ * kg[2 * e + 1]); \
    x = __builtin_bit_cast(bf16x8, o_); } while (0)
#define NWRITE(b) do { KNORM(s_ks0); KNORM(s_ks1); \
    *(bf16x8*)((char*)V_lds + (b) * SHM_V + vst0) = s_vs0; *(bf16x8*)((char*)V_lds + (b) * SHM_V + vst1) = s_vs1; const int kc_ = sc * 2; \
    *(bf16x8*)((char*)K_lds + (b) * SHM_K + KSWZ(sr, kc_)) = s_ks0; *(bf16x8*)((char*)K_lds + (b) * SHM_K + KSWZ(32 + sr, kc_)) = s_ks1; } while (0)
  const int qrow = R + (wid >> 1), r0q = min(max(qrow - 4, 0), 248), jlo = r0q - ks;
  const int c = 32 * (wid & 1) + r32, c0 = min(max(c - 8, 0), 48);
  NLOAD(0); asm volatile("s_waitcnt vmcnt(0)" ::: "memory"); NWRITE(0); __syncthreads();
  for (int j = 0; j < NA_TILES; ++j) {
    const int buf = j & 1;
    if (j + 1 < NA_TILES) NLOAD((j + 1) * KVBLK);
    if (j >= jlo && j < jlo + 8) {
      f32x16 p0, p1; float mn, al; bf16x8 pa0, pa1, pa2, pa3;
      SBAR(); qkt(p0, p1, (bf16*)((char*)K_lds + buf * SHM_K), qr, r32, hi);
      const float* brow = bt + (ks + j - qrow + 7) * 31 + (15 - c);
#pragma unroll
      for (int r = 0; r < 16; ++r) { const int k0 = crow(r, hi), k1 = 32 + k0; const bool v0 = (k0 >= c0) && (k0 < c0 + 16), v1 = (k1 >= c0) && (k1 < c0 + 16);
        const float b0 = brow[v0 ? k0 : c], b1 = brow[v1 ? k1 : c];
        p0[r] = v0 ? fmaf(b0, 1.0f / SCALE, p0[r]) : -1e30f; p1[r] = v1 ? fmaf(b1, 1.0f / SCALE, p1[r]) : -1e30f; }
      partialSM(p0, p1, m_reg, mn, al);
      if (__any(al < 1.f)) { if (hi == 0) al_l[r32] = al; asm volatile("s_waitcnt lgkmcnt(0)" ::: "memory");
#pragma unroll
        for (int d = 0; d < 4; ++d)
#pragma unroll
          for (int r = 0; r < 16; ++r) o[d][r] *= al_l[crow(r, hi)]; }
      finishSM(p0, p1, al, l_reg, pa0, pa1, pa2, pa3); SBAR();
      pv_d0(o, vb0 + buf * (int)SHM_V, pa0, pa1, pa2, pa3);
    }
    if (j + 1 < NA_TILES) { asm volatile("s_waitcnt vmcnt(0)" ::: "memory"); NWRITE(buf ^ 1); }
    __syncthreads();
  }
  if (hi == 0) li_l[r32] = l_reg; asm volatile("s_waitcnt lgkmcnt(0)" ::: "memory");
  float rli[16];
#pragma unroll
  for (int r = 0; r < 16; ++r) rli[r] = 64.0f * __builtin_amdgcn_rcpf(li_l[crow(r, hi)]);
  unsigned char* Ow = (unsigned char*)Ob + (long)(wid * QBLK) * NA_LD;
#pragma unroll
  for (int r = 0; r < 16; ++r) { const int orow = crow(r, hi);
    for (int d0 = 0; d0 < 4; ++d0) Ow[(long)orow * NA_LD + d0 * 32 + r32] = (unsigned char)__builtin_amdgcn_cvt_pk_fp8_f32(o[d0][r] * rli[r], 0.f, 0, false); }
#undef NLOAD
#undef NWRITE
#undef KNORM
}

typedef int v8i __attribute__((ext_vector_type(8)));
typedef unsigned u32x2 __attribute__((ext_vector_type(2)));
constexpr int K8_LD = 1024, V8_LD = 16384, SHM_K8 = KVBLK * D, SHM_V8 = KVBLK * D;
constexpr float THR8 = 3.0f;
__device__ __forceinline__ int cvt4_fp8(float a, float b, float c, float d) { int w = __builtin_amdgcn_cvt_pk_fp8_f32(a, b, 0, false); return __builtin_amdgcn_cvt_pk_fp8_f32(c, d, w, true); }
typedef short s16x2 __attribute__((ext_vector_type(2)));
__device__ __forceinline__ int cvt4_fp8_scl(int w, float a, float b, float c, float d, float scl) {
  s16x2 t = __builtin_bit_cast(s16x2, w); t = __builtin_amdgcn_cvt_scalef32_pk_fp8_f32(t, a, b, scl, false); t = __builtin_amdgcn_cvt_scalef32_pk_fp8_f32(t, c, d, scl, true); return __builtin_bit_cast(int, t); }
__device__ __forceinline__ v8i mk8(u32x4 lo, u32x4 hi) { return (v8i){(int)lo[0], (int)lo[1], (int)lo[2], (int)lo[3], (int)hi[0], (int)hi[1], (int)hi[2], (int)hi[3]}; }
__device__ __forceinline__ void qkt8(f32x16& p0, f32x16& p1, const char* Ks, const v8i* qf, int r32, int hi) {
  const int x0 = (r32 >> 1) & 7, x1 = ((32 + r32) >> 1) & 7;
  const char* k0 = Ks + r32 * 128; const char* k1 = Ks + (32 + r32) * 128;
  v8i a[2][2];
#pragma unroll
  for (int s = 0; s < 2; ++s) { const int c = 4 * s + 2 * hi;
    a[0][s] = mk8(*reinterpret_cast<const u32x4*>(k0 + 16 * (c ^ x0)), *reinterpret_cast<const u32x4*>(k0 + 16 * ((c + 1) ^ x0)));
    a[1][s] = mk8(*reinterpret_cast<const u32x4*>(k1 + 16 * (c ^ x1)), *reinterpret_cast<const u32x4*>(k1 + 16 * ((c + 1) ^ x1))); }
  p0 = f32x16{}; p1 = f32x16{};
#pragma unroll
  for (int s = 0; s < 2; ++s) {
    p0 = __builtin_amdgcn_mfma_scale_f32_32x32x64_f8f6f4(a[0][s], qf[s], p0, 0, 0, 0, 0x7F7F7F7F, 0, 0x7C7C7C7C);
    p1 = __builtin_amdgcn_mfma_scale_f32_32x32x64_f8f6f4(a[1][s], qf[s], p1, 0, 0, 0, 0x7F7F7F7F, 0, 0x7C7C7C7C); }
}
constexpr float THR2 = 4.0f;
__device__ __forceinline__ void partialSM8(f32x16& p0, f32x16& p1, float& m_reg, float& scl, float& alpha) {
  float pmax;
  asm("v_max3_f32 %0, %1, %2, %3" : "=v"(pmax) : "v"(p0[0]), "v"(p0[1]), "v"(p0[2]));
#pragma unroll
  for (int r = 3; r < 15; r += 2) asm("v_max3_f32 %0, %0, %1, %2" : "+v"(pmax) : "v"(p0[r]), "v"(p0[r + 1]));
  asm("v_max3_f32 %0, %0, %1, %2" : "+v"(pmax) : "v"(p0[15]), "v"(p1[0]));
#pragma unroll
  for (int r = 1; r < 15; r += 2) asm("v_max3_f32 %0, %0, %1, %2" : "+v"(pmax) : "v"(p1[r]), "v"(p1[r + 1]));
  asm("v_max_f32 %0, %0, %1" : "+v"(pmax) : "v"(p1[15]));
  { auto rr = __builtin_amdgcn_permlane32_swap(__float_as_uint(pmax), __float_as_uint(pmax), false, false);
    pmax = fmaxf(__uint_as_float(rr[0]), __uint_as_float(rr[1])); }
  if (__builtin_expect(__all(pmax - m_reg <= THR2), 1)) { alpha = 1.f; }
  else { const float mn = __builtin_ceilf(fmaxf(m_reg, pmax)); alpha = __builtin_amdgcn_exp2f(m_reg - mn); m_reg = mn; }
  scl = __builtin_amdgcn_ldexpf(1.0f, (int)fmaxf(m_reg, -100.f) - 4);
  for (int r = 0; r < 16; ++r) p0[r] = __builtin_amdgcn_exp2f(p0[r]);
}
__device__ __forceinline__ void finishSM8(f32x16& p0, f32x16& p1, v8i& pa, float scl) {
  for (int r = 0; r < 16; ++r) p1[r] = __builtin_amdgcn_exp2f(p1[r]);
#pragma unroll
  for (int v = 0; v < 4; ++v) { pa[v] = cvt4_fp8_scl(pa[v], p0[4 * v], p0[4 * v + 1], p0[4 * v + 2], p0[4 * v + 3], scl); pa[4 + v] = cvt4_fp8_scl(pa[4 + v], p1[4 * v], p1[4 * v + 1], p1[4 * v + 2], p1[4 * v + 3], scl); }
}
__device__ __forceinline__ void pv8(f32x16* o, const char* Vs, const v8i& pa, int r32, int hi) {
  v8i b[4];
#pragma unroll
  for (int db = 0; db < 4; ++db) { const int d = 32 * db + r32, x = (d >> 2) & 3; const char* vp = Vs + d * 64;
    b[db] = mk8(*reinterpret_cast<const u32x4*>(vp + 16 * ((2 * hi) ^ x)), *reinterpret_cast<const u32x4*>(vp + 16 * ((2 * hi + 1) ^ x))); }
  const v8i ones = (v8i){0x38383838, 0x38383838, 0x38383838, 0x38383838, 0x38383838, 0x38383838, 0x38383838, 0x38383838};
#pragma unroll
  for (int db = 0; db < 4; ++db) o[db] = __builtin_amdgcn_mfma_scale_f32_32x32x64_f8f6f4(pa, b[db], o[db], 0, 0, 0, 0x7F7F7F7F, 0, 0x7F7F7F7F);
  o[4] = __builtin_amdgcn_mfma_scale_f32_32x32x64_f8f6f4(pa, ones, o[4], 0, 0, 0, 0x7F7F7F7F, 0, 0x7F7F7F7F);
}
__device__ __forceinline__ void attn_dense_body8(const bf16* __restrict__ Qb, const unsigned char* __restrict__ K8h, const unsigned char* __restrict__ V8h, bf16* __restrict__ Ob, int seq, char* lds) {
  int tid_o = wg_tid(); asm volatile("" : "+v"(tid_o)); const int tid = tid_o, wid = __builtin_amdgcn_readfirstlane(tid >> 6), lane = tid & 63, r32 = lane & 31, hi = lane >> 5;
  char* V_lds = lds; char* K_lds = lds + 3 * SHM_V8;
  float* ws = (float*)(lds + 3 * SHM_V8 + 3 * SHM_K8) + wid * 64; float* al_l = ws + 32;
  float m_reg = -1e30f; f32x16 o[5] = {}; v8i qf[2];
  { const bf16* Qw = Qb + (long)(wid * QBLK + r32) * LDQ + hi * 32;
#pragma unroll
    for (int s = 0; s < 2; ++s) {
#pragma unroll
      for (int c = 0; c < 4; ++c) { const u32x4 w = *reinterpret_cast<const u32x4*>(Qw + s * 64 + c * 8);
        constexpr float QS = 8.0f * SCALE * 1.4426950408889634f;
        qf[s][2 * c] = cvt4_fp8(QS * __uint_as_float(w[0] << 16), QS * __uint_as_float(w[0] & 0xffff0000u), QS * __uint_as_float(w[1] << 16), QS * __uint_as_float(w[1] & 0xffff0000u));
        qf[s][2 * c + 1] = cvt4_fp8(QS * __uint_as_float(w[2] << 16), QS * __uint_as_float(w[2] & 0xffff0000u), QS * __uint_as_float(w[3] << 16), QS * __uint_as_float(w[3] & 0xffff0000u)); } } }
  const int skey = tid >> 3, sck = tid & 7, sd = tid >> 2, sc4 = tid & 3;
  const int kst = skey * 128 + 16 * (sck ^ ((skey >> 1) & 7));
  const int vx = (sd >> 2) & 3, vst0 = sd * 64 + 16 * ((sc4 >> 1) ^ vx) + 8 * (sc4 & 1), vst1 = sd * 64 + 16 * ((2 + (sc4 >> 1)) ^ vx) + 8 * (sc4 & 1);
  const unsigned char* kg = K8h + (long)skey * K8_LD + 16 * sck; const unsigned char* vg = V8h + (long)sd * V8_LD + 16 * sc4;
  struct { u32x4 k, v; } sr_[2];
#define SLOAD8(i, k0) do { sr_[i].k = *reinterpret_cast<const u32x4*>(kg + (long)(k0) * K8_LD); sr_[i].v = *reinterpret_cast<const u32x4*>(vg + (k0)); } while (0)
#define SWRITE8(b, i) do { *reinterpret_cast<u32x4*>(K_lds + (b) * SHM_K8 + kst) = sr_[i].k; \
    *reinterpret_cast<u32x2*>(V_lds + (b) * SHM_V8 + vst0) = (u32x2){sr_[i].v[0], sr_[i].v[2]}; *reinterpret_cast<u32x2*>(V_lds + (b) * SHM_V8 + vst1) = (u32x2){sr_[i].v[1], sr_[i].v[3]}; } while (0)
#define SWAIT8() asm volatile("s_waitcnt vmcnt(2)" ::: "memory")
#define RESC8(a) do { if (__any((a) < 1.f)) { if (hi == 0) al_l[r32] = (a); asm volatile("s_waitcnt lgkmcnt(0)" ::: "memory"); \
    for (int d = 0; d < 5; ++d) for (int r = 0; r < 16; ++r) o[d][r] *= al_l[crow(r, hi)]; } } while (0)
  f32x16 pA0, pA1, pB0, pB1; float mnA, mnB, alA, alB; v8i pa = {}; const int NT = seq / KVBLK;
  SLOAD8(0, 0); asm volatile("s_waitcnt vmcnt(0)" ::: "memory"); SWRITE8(0, 0); __syncthreads();
  qkt8(pA0, pA1, K_lds, qf, r32, hi);
  asm volatile("s_nop 15\n\ts_nop 7" : "+v"(pA0), "+v"(pA1));
  partialSM8(pA0, pA1, m_reg, mnA, alA);
  SLOAD8(1, KVBLK); if (2 < NT) SLOAD8(0, 2 * KVBLK);
  SWAIT8(); SWRITE8(1, 1); __syncthreads();
  int bk = 1, bv = 0, bw = 2;
  if (wid >= 4) __builtin_amdgcn_s_setprio(1);
#define ROT3() do { const int t_ = bv; bv = bk; bk = bw; bw = t_; } while (0)
  for (int j = 1; j + 1 < NT; j += 2) {
    SBAR(); qkt8(pB0, pB1, K_lds + bk * SHM_K8, qf, r32, hi);
    finishSM8(pA0, pA1, pa, mnA); SBAR();
    SLOAD8(1, (j + 2) * KVBLK); SBAR();
    pv8(o, V_lds + bv * SHM_V8, pa, r32, hi); partialSM8(pB0, pB1, m_reg, mnB, alB);
    SWAIT8(); SWRITE8(bw, 0);
    RESC8(alB); __syncthreads(); ROT3();
    SBAR(); qkt8(pA0, pA1, K_lds + bk * SHM_K8, qf, r32, hi);
    finishSM8(pB0, pB1, pa, mnB); SBAR();
    if (j + 3 < NT) SLOAD8(0, (j + 3) * KVBLK); SBAR();
    pv8(o, V_lds + bv * SHM_V8, pa, r32, hi); partialSM8(pA0, pA1, m_reg, mnA, alA);
    SWAIT8(); SWRITE8(bw, 1);
    RESC8(alA); __syncthreads(); ROT3();
  }
  SBAR(); qkt8(pB0, pB1, K_lds + bk * SHM_K8, qf, r32, hi);
  finishSM8(pA0, pA1, pa, mnA); SBAR();
  pv8(o, V_lds + bv * SHM_V8, pa, r32, hi); partialSM8(pB0, pB1, m_reg, mnB, alB);
  RESC8(alB);
  finishSM8(pB0, pB1, pa, mnB); SBAR();
  pv8(o, V_lds + bk * SHM_V8, pa, r32, hi);
#undef ROT3
  __builtin_amdgcn_s_setprio(0);
  float rli[16];
#pragma unroll
  for (int r = 0; r < 16; ++r) rli[r] = 64.0f * __builtin_amdgcn_rcpf(o[4][r]);
  unsigned char* Ow = (unsigned char*)Ob + (long)(wid * QBLK) * LDO;
#pragma unroll
  for (int r = 0; r < 16; ++r) { const int orow = crow(r, hi);
    for (int d0 = 0; d0 < 4; ++d0) Ow[(long)orow * LDO + d0 * 32 + r32] = (unsigned char)__builtin_amdgcn_cvt_pk_fp8_f32(o[d0][r] * rli[r], 0.f, 0, false); }
#undef SLOAD8
#undef SWRITE8
#undef SWAIT8
#undef RESC8
}
}
struct Frame {
    LAS unsigned char* lds;
    int tid, lane, wave;
    int bid, vcu, G;
};
__device__ __forceinline__ float wave_sum(float v) {
#pragma unroll
    for (int o = 1; o < 64; o <<= 1) v += __shfl_xor(v, o);
    return v;
}
__device__ __forceinline__ void xrows_phase(const Frame& F, const float* __restrict__ h, bf16* __restrict__ hb, pg8::rs_t* __restrict__ rs, unsigned char* __restrict__ hb8) {
    const int gw = F.vcu * 8 + F.wave, NGW = F.G * 8;
    for (int m = gw; m < L; m += NGW) {
        const f32x4* xr = (const f32x4*)(h + (size_t)m * DM) + F.lane;
        v2u* o8 = (v2u*)(hb + (size_t)m * DM) + F.lane;
        float s = 0.f;
#pragma unroll
        for (int j = 0; j < 16; ++j) { const f32x4 v = xr[64 * j]; s += (v.x * v.x + v.y * v.y) + (v.z * v.z + v.w * v.w); v2u w; w.x = pk2(v.x, v.y); w.y = pk2(v.z, v.w); o8[64 * j] = w;
            int w8 = __builtin_amdgcn_cvt_pk_fp8_f32(v.x, v.y, 0, false); w8 = __builtin_amdgcn_cvt_pk_fp8_f32(v.z, v.w, w8, true); *((unsigned*)(hb8 + (size_t)m * DM) + 64 * j + F.lane) = (unsigned)w8; }
        s = wave_sum(s);
        if (F.lane == 0) rs[m] = (pg8::rs_t)(s * pg8::RS_FIX);
    }
}
__device__ __forceinline__ void headnorm_rows(bf16* __restrict__ X, int ld, int nheads, const float* __restrict__ gain, int t, int lane, bool rope, const float (&cs)[8], const float (&sn)[8], unsigned char* __restrict__ X8 = nullptr) {
    const int hs = lane >> 4, l16 = lane & 15;
    f32x4 g0 = *(const f32x4*)(gain + 8 * l16), g1 = *(const f32x4*)(gain + 8 * l16 + 4);
    const float gg[8] = {g0.x, g0.y, g0.z, g0.w, g1.x, g1.y, g1.z, g1.w};
    const bool second = ((l16 >> 2) & 1) != 0;
    for (int hg = 0; hg < nheads / 4; ++hg) {
        bf16* p = X + (size_t)t * ld + (size_t)(4 * hg + hs) * HD + 8 * l16;
        const v4u raw = *(const v4u*)p;
        float x[8] = {bflo(raw.x), bfhi(raw.x), bflo(raw.y), bfhi(raw.y), bflo(raw.z), bfhi(raw.z), bflo(raw.w), bfhi(raw.w)};
        float ss = 0.f;
#pragma unroll
        for (int e = 0; e < 8; ++e) ss += x[e] * x[e];
        ss += __shfl_xor(ss, 1); ss += __shfl_xor(ss, 2); ss += __shfl_xor(ss, 4); ss += __shfl_xor(ss, 8);
        const float rinv = 1.0f / sqrtf(ss * (1.0f / HD) + EPS);
        float y[8];
#pragma unroll
        for (int e = 0; e < 8; ++e) y[e] = x[e] * rinv * gg[e];
        if (rope) {
#pragma unroll
            for (int e = 0; e < 8; ++e) { const float yp = __shfl_xor(y[e], 4); y[e] = second ? (y[e] * cs[e] + yp * sn[e]) : (y[e] * cs[e] - yp * sn[e]); }
        }
        if (X8) { int w0 = __builtin_amdgcn_cvt_pk_fp8_f32(y[0], y[1], 0, false); w0 = __builtin_amdgcn_cvt_pk_fp8_f32(y[2], y[3], w0, true);
            int w1 = __builtin_amdgcn_cvt_pk_fp8_f32(y[4], y[5], 0, false); w1 = __builtin_amdgcn_cvt_pk_fp8_f32(y[6], y[7], w1, true);
            *(v2u*)(X8 + (size_t)t * ld + (size_t)(4 * hg + hs) * HD + 8 * l16) = (v2u){(unsigned)w0, (unsigned)w1}; }
        else { v4u w; w.x = pk2(y[0], y[1]); w.y = pk2(y[2], y[3]); w.z = pk2(y[4], y[5]); w.w = pk2(y[6], y[7]);
            *(v4u*)p = w; }
    }
}
__device__ __forceinline__ void prep_phase(const Frame& F, bf16* Q, bf16* K, int ldk, int nkh, const float* qgain, const float* kgain, bool rope, unsigned char* K8 = nullptr) {
    const int gw = F.vcu * 8 + F.wave, NGW = F.G * 8;
    const int l16 = F.lane & 15;
    for (int t = gw; t < L; t += NGW) {
        float cs[8], sn[8];
#pragma unroll
        for (int e = 0; e < 8; ++e) { cs[e] = 1.f; sn[e] = 0.f; }
        if (rope) {
            const int ax = l16 >> 3; const float pos = (float)(ax ? (t & (GRID_W - 1)) : (t / GRID_W));
#pragma unroll
            for (int e = 0; e < 8; ++e) { const int f = (l16 & 3) * 8 + e; const float inv = 1.0f / powf(10000.0f, (float)f * (1.0f / 32.0f)); const float ang = pos * inv; cs[e] = cosf(ang); sn[e] = sinf(ang); }
        }
        headnorm_rows(Q, DM, NH, qgain, t, F.lane, rope, cs, sn);
        headnorm_rows(K, ldk, nkh, kgain, t, F.lane, rope, cs, sn, K8);
    }
}

constexpr int S5T = pg8::S5T, S5NCH = pg8::S5NCH, S5KS = pg8::S5KS;
__device__ __forceinline__ void s5_gen_group(const Frame& F, int g, const float* __restrict__ lam_re, const float* __restrict__ lam_im, const float* __restrict__ log_step,
                                             const float* __restrict__ b_re, const float* __restrict__ b_im, const float* __restrict__ c_re, const float* __restrict__ c_im,
                                             bf16* __restrict__ GM, bf16* __restrict__ BMt, f32x2* __restrict__ PAT) {
    LAS f32x2* apow = (LAS f32x2*)F.lds;
    LAS f32x2* zt = apow + 2 * 33 * 64;
    LAS float* Kd = (LAS float*)(zt + 2 * 64);
    const int tid = F.tid;
    if (tid < 128) {
        const int dir = tid >> 6, n = tid & 63, dg = dir * S5G + g, idx = dg * S5N + n;
        const double dt = exp((double)log_step[dg]);
        const double lr = (double)lam_re[idx], li = (double)lam_im[idx];
        const double mag = exp(lr * dt), are = mag * cos(li * dt), aim = mag * sin(li * dt);
        const double den = lr * lr + li * li, nre = are - 1.0;
        zt[dir * 64 + n] = (f32x2){(float)((nre * lr + aim * li) / den), (float)((aim * lr - nre * li) / den)};
        double pr = 1.0, pi = 0.0;
        for (int k = 0; k <= 32; ++k) { apow[(dir * 33 + k) * 64 + n] = (f32x2){(float)pr, (float)pi}; const double t = pr * are - pi * aim; pi = pr * aim + pi * are; pr = t; }
        PAT[idx] = apow[(dir * 33 + 32) * 64 + n];
    }
    LDS_WAIT(); __syncthreads();
    {
        const int dir = tid >> 8, p = (tid >> 4) & 15, q = tid & 15, dg = dir * S5G + g;
        float wr[64], wi[64];
        const float* cr = c_re + ((size_t)dg * S5P + p) * S5N; const float* ci = c_im + ((size_t)dg * S5P + p) * S5N;
#pragma unroll
        for (int n = 0; n < 64; ++n) { const f32x2 z = zt[dir * 64 + n]; const float br = b_re[((size_t)dg * S5N + n) * S5P + q], bi = b_im[((size_t)dg * S5N + n) * S5P + q];
            const float bbr = z.x * br - z.y * bi, bbi = z.x * bi + z.y * br; const float c0 = cr[n], c1 = ci[n];
            wr[n] = c0 * bbr - c1 * bbi; wi[n] = c0 * bbi + c1 * bbr; }
        for (int d = 0; d < 32; ++d) { float acc = 0.f; const LAS f32x2* ap = apow + (dir * 33 + d) * 64;
#pragma unroll
            for (int n = 0; n < 64; ++n) { const f32x2 a = ap[n]; acc = fmaf(wr[n], a.x, acc); acc = fmaf(-wi[n], a.y, acc); }
            Kd[(dir * 32 + d) * 256 + p * 16 + q] = acc; }
    }
    LDS_WAIT(); __syncthreads();
    bf16* BMg = BMt + (size_t)g * 512 * S5KS;
    for (int it = tid; it < 512 * 64; it += 512) { const int row = it >> 6, ch = it & 63, tau = row >> 4, p = row & 15, sg = ch >> 1, q0 = (ch & 1) * 8;
        float v[8];
        if (sg < tau) { const LAS float* k = Kd + (0 * 32 + (tau - sg)) * 256 + p * 16 + q0;
#pragma unroll
            for (int j = 0; j < 8; ++j) v[j] = k[j]; }
        else if (sg > tau) { const LAS float* k = Kd + (1 * 32 + (sg - tau)) * 256 + p * 16 + q0;
#pragma unroll
            for (int j = 0; j < 8; ++j) v[j] = k[j]; }
        else { const LAS float* k0 = Kd + p * 16 + q0; const LAS float* k1 = Kd + 32 * 256 + p * 16 + q0;
#pragma unroll
            for (int j = 0; j < 8; ++j) v[j] = k0[j] + k1[j]; }
        v4u w; w.x = pk2(v[0], v[1]); w.y = pk2(v[2], v[3]); w.z = pk2(v[4], v[5]); w.w = pk2(v[6], v[7]);
        *(v4u*)(BMg + (size_t)row * S5KS + ch * 8) = w; }
    for (int it = tid; it < 512 * 32; it += 512) { const int row = it >> 5, ch = it & 31, tau = row >> 4, p = row & 15, dir = ch >> 4, n0 = (ch & 15) * 4, dg = dir * S5G + g;
        const int k = dir ? (32 - tau) : (tau + 1);
        const f32x4 cr = *(const f32x4*)(c_re + ((size_t)dg * S5P + p) * S5N + n0), ci = *(const f32x4*)(c_im + ((size_t)dg * S5P + p) * S5N + n0);
        const LAS f32x2* ap = apow + (dir * 33 + k) * 64 + n0;
        unsigned o[4];
#pragma unroll
        for (int j = 0; j < 4; ++j) { const f32x2 a = ap[j]; const float vr = cr[j] * a.x - ci[j] * a.y, vi = cr[j] * a.y + ci[j] * a.x; o[j] = pk2(vr, -vi); }
        *(v4u*)(BMg + (size_t)row * S5KS + 512 + ch * 8) = (v4u){o[0], o[1], o[2], o[3]}; }
    bf16* GMg = GM + (size_t)g * 256 * 512;
    for (int it = tid; it < 128 * 64; it += 512) { const int dn = it >> 6, ch = it & 63, dir = dn >> 6, n = dn & 63, sg = ch >> 1, q0 = (ch & 1) * 8, dg = dir * S5G + g;
        const int pw = dir ? sg : (31 - sg);
        const f32x2 a = apow[(dir * 33 + pw) * 64 + n], z = zt[dir * 64 + n];
        const float wr_ = a.x * z.x - a.y * z.y, wi_ = a.x * z.y + a.y * z.x;
        const float* br = b_re + ((size_t)dg * S5N + n) * S5P + q0; const float* bi = b_im + ((size_t)dg * S5N + n) * S5P + q0;
        float re[8], im[8];
#pragma unroll
        for (int j = 0; j < 8; ++j) { re[j] = wr_ * br[j] - wi_ * bi[j]; im[j] = wr_ * bi[j] + wi_ * br[j]; }
        v4u w0, w1; w0.x = pk2(re[0], re[1]); w0.y = pk2(re[2], re[3]); w0.z = pk2(re[4], re[5]); w0.w = pk2(re[6], re[7]);
        w1.x = pk2(im[0], im[1]); w1.y = pk2(im[2], im[3]); w1.z = pk2(im[4], im[5]); w1.w = pk2(im[6], im[7]);
        *(v4u*)(GMg + (size_t)(dir * 128 + 2 * n) * 512 + ch * 8) = w0; *(v4u*)(GMg + (size_t)(dir * 128 + 2 * n + 1) * 512 + ch * 8) = w1; }
    LDS_WAIT(); __syncthreads();
}
__device__ __forceinline__ void s5_scan_phase(const Frame& F, const f32x2* __restrict__ PAT, const float* __restrict__ E, bf16* __restrict__ UA) {
    for (int task = F.bid + F.G * F.wave; task < 2 * S5G; task += F.G * 8) {
        const int dir = task >> 8, g = task & 255;
        const f32x2 a = PAT[task * S5N + F.lane];
        const float* e = E + (size_t)g * S5NCH * 256 + dir * 128 + 2 * F.lane;
        bf16* s = UA + (size_t)g * S5NCH * S5KS + 512 + dir * 128 + 2 * F.lane;
        float cr = 0.f, ci = 0.f;
        for (int c8 = 0; c8 < S5NCH; c8 += 8) {
            f32x2 v[8];
#pragma unroll
            for (int k = 0; k < 8; ++k) { const int c = dir ? (S5NCH - 1 - (c8 + k)) : (c8 + k); v[k] = *(const f32x2*)(e + (size_t)c * 256); }
#pragma unroll
            for (int k = 0; k < 8; ++k) { const int c = dir ? (S5NCH - 1 - (c8 + k)) : (c8 + k);
                *(unsigned*)(s + (size_t)c * S5KS) = pk2(cr, ci);
                const float nr = fmaf(a.x, cr, fmaf(-a.y, ci, v[k].x)), ni = fmaf(a.x, ci, fmaf(a.y, cr, v[k].y)); cr = nr; ci = ni; }
        }
    }
}


__device__ __forceinline__ float fp8_to_f32(unsigned char b) { const int e = (b >> 3) & 15, m = b & 7; const float v = e ? __builtin_ldexpf(1.0f + (float)m * 0.125f, e - 7) : __builtin_ldexpf((float)m * 0.125f, -6); return (b & 0x80) ? -v : v; }
__device__ __forceinline__ void gqa_selfcheck(const Frame& F, const bf16* __restrict__ Qp, const unsigned char* __restrict__ K8, const unsigned char* __restrict__ V8t, const bf16* __restrict__ O,
                                              float* __restrict__ SC, unsigned* flag) {
    LAS float* ql = (LAS float*)(F.lds + F.wave * 1024);
    const int lane = F.lane;
#pragma unroll 1
    for (int s = F.bid * 8 + F.wave; s < 1024; s += F.G * 8) {
        const int tok = (int)(((long)(s >> 5) * 5209 + 77) % L), hq = s & 31, kv = hq >> 2;
        float* sc = SC + (size_t)(F.bid * 8 + F.wave) * L;
        { const bf16* qp = Qp + (size_t)tok * DM + hq * HD; ql[lane] = bf2f(qp[lane]); ql[lane + 64] = bf2f(qp[lane + 64]); } LDS_WAIT();
        float mx = -1e30f;
#pragma unroll 1
        for (int j = lane; j < L; j += 64) { const unsigned char* kp = K8 + (size_t)j * KVD + kv * HD; float dot = 0.f;
#pragma unroll 1
            for (int d = 0; d < HD; ++d) dot += fp8_to_f32(kp[d]) * ql[d];
            dot *= 0.088388347648318440f; sc[j] = dot; mx = fmaxf(mx, dot); }
#pragma unroll
        for (int o = 1; o < 64; o <<= 1) mx = fmaxf(mx, __shfl_xor(mx, o));
        asm volatile("s_waitcnt vmcnt(0)" ::: "memory"); __builtin_amdgcn_fence(__ATOMIC_RELEASE, "workgroup"); __builtin_amdgcn_fence(__ATOMIC_ACQUIRE, "agent");
        float o0 = 0.f, o1 = 0.f, lsum = 0.f;
#pragma unroll 1
        for (int j = 0; j < L; ++j) { const float pj = expf(__hip_atomic_load(sc + j, __ATOMIC_RELAXED, __HIP_MEMORY_SCOPE_AGENT) - mx);
            o0 += pj * fp8_to_f32(V8t[(size_t)(kv * HD + lane) * L + j]); o1 += pj * fp8_to_f32(V8t[(size_t)(kv * HD + lane + 64) * L + j]); lsum += pj; }
        o0 /= lsum; o1 /= lsum;
        const unsigned char* op = (const unsigned char*)O + (size_t)tok * DM + hq * HD; const float g0 = fp8_to_f32(op[lane]) * 0.015625f, g1 = fp8_to_f32(op[lane + 64]) * 0.015625f;
        float am = fmaxf(fabsf(o0), fabsf(o1));
#pragma unroll
        for (int o = 1; o < 64; o <<= 1) am = fmaxf(am, __shfl_xor(am, o));
        const float tol = 0.2f * am + 1e-5f;
        const bool bad = !(fabsf(g0 - o0) <= tol) || !(fabsf(g1 - o1) <= tol);
        if (__any(bad) && lane == 0) __hip_atomic_fetch_or(flag, 1u, __ATOMIC_RELAXED, __HIP_MEMORY_SCOPE_AGENT);
        LDS_WAIT();
    }
}

__device__ __forceinline__ void transpose_item(const float* __restrict__ W, int K, int N, bf16* __restrict__ WT, int mode, const float* __restrict__ gain, LAS float* scr, int item, int lane, int fp8 = 0) {
    const int nblk = N / 32, kb = item / nblk, nb = item % nblk, k0 = 64 * kb, n0 = 32 * nb;
    int r0 = n0;
    if (mode == 1) r0 = (n0 < DM) ? ((n0 >> 7) * 256 + (n0 & 127)) : (((n0 - DM) >> 7) * 256 + 128 + ((n0 - DM) & 127));
    const float* src = W + (size_t)(k0 + (lane >> 5)) * N + n0 + (lane & 31);
    float v[32];
#pragma unroll
    for (int i = 0; i < 32; ++i) v[i] = src[(size_t)(2 * i) * N];
    const int c = lane & 7;
    f32x4 g0 = (f32x4){1.f, 1.f, 1.f, 1.f}, g1 = g0;
    if (gain) { g0 = *(const f32x4*)(gain + k0 + 8 * c); g1 = *(const f32x4*)(gain + k0 + 8 * c + 4); }
#pragma unroll
    for (int i = 0; i < 32; ++i) scr[(2 * i + (lane >> 5)) * 33 + (lane & 31)] = v[i];
    LDS_WAIT(); asm volatile("" ::: "memory");
#pragma unroll
    for (int j = 0; j < 4; ++j) { const int n = (lane >> 3) + 8 * j; const LAS float* s = scr + (8 * c) * 33 + n;
        if (fp8) { int w0 = __builtin_amdgcn_cvt_pk_fp8_f32(64.f * s[0 * 33] * g0.x, 64.f * s[1 * 33] * g0.y, 0, false); w0 = __builtin_amdgcn_cvt_pk_fp8_f32(64.f * s[2 * 33] * g0.z, 64.f * s[3 * 33] * g0.w, w0, true);
            int w1 = __builtin_amdgcn_cvt_pk_fp8_f32(64.f * s[4 * 33] * g1.x, 64.f * s[5 * 33] * g1.y, 0, false); w1 = __builtin_amdgcn_cvt_pk_fp8_f32(64.f * s[6 * 33] * g1.z, 64.f * s[7 * 33] * g1.w, w1, true);
            *(v2u*)((unsigned char*)WT + (size_t)(r0 + n) * K + k0 + 8 * c) = (v2u){(unsigned)w0, (unsigned)w1}; }
        else { v4u o; o.x = pk2(s[0 * 33] * g0.x, s[1 * 33] * g0.y); o.y = pk2(s[2 * 33] * g0.z, s[3 * 33] * g0.w); o.z = pk2(s[4 * 33] * g1.x, s[5 * 33] * g1.y); o.w = pk2(s[6 * 33] * g1.z, s[7 * 33] * g1.w);
            *(v4u*)(WT + (size_t)(r0 + n) * K + k0 + 8 * c) = o; } }
    LDS_WAIT(); asm volatile("" ::: "memory");
}

constexpr size_t MiB = 1u << 20;
constexpr size_t SZ_NAQKV = (size_t)3 * DM * DM * 2, SZ_DD = (size_t)DM * DM * 2, SZ_GQAQKV = (size_t)(DM + 2 * KVD) * DM * 2, SZ_W1 = (size_t)FF * DM * 2, SZ_PROJ = (size_t)DM * PLE * 2, SZ_ACT = (size_t)L * DM * 2;
constexpr size_t OFF_CTL = 0, CTL_ZERO_BYTES = 3 * MiB, OFF_RS = 1 * MiB;
constexpr size_t OFF_NAQKV = 4 * MiB;
constexpr size_t OFF_NAWO = OFF_NAQKV + 2 * SZ_NAQKV;
constexpr size_t OFF_GQAQKV = OFF_NAWO + 2 * SZ_DD;
constexpr size_t OFF_GQAWO = OFF_GQAQKV + SZ_GQAQKV;
constexpr size_t OFF_S5IN = OFF_GQAWO + SZ_DD;
constexpr size_t OFF_S5OUT = OFF_S5IN + SZ_DD;
constexpr size_t OFF_W1 = OFF_S5OUT + 2 * SZ_DD;
constexpr size_t OFF_W2 = OFF_W1 + 4 * SZ_W1;
constexpr size_t OFF_PROJ = OFF_W2 + 4 * SZ_W1;
constexpr size_t OFF_GATE = OFF_PROJ + 4 * SZ_PROJ;
constexpr size_t OFF_PBF = OFF_GATE + 4 * SZ_DD;
constexpr size_t OFF_XN = OFF_PBF + 4 * (size_t)L * PLE * 2;
constexpr size_t OFF_ACT = OFF_XN + SZ_ACT;
constexpr size_t OFF_PP = OFF_ACT + 4 * SZ_ACT;
constexpr size_t OFF_S5BM = OFF_PP + SZ_ACT;
constexpr size_t OFF_S5GM = OFF_S5BM + 192 * MiB;
constexpr size_t OFF_S5PAR = OFF_S5GM + 64 * MiB;
constexpr size_t OFF_DUMMY = OFF_S5PAR + 8 * MiB;
constexpr size_t OFF_HB1 = OFF_DUMMY + 256 * MiB;
constexpr size_t OFF_HB8 = OFF_HB1 + SZ_ACT;
constexpr size_t WS_END = OFF_HB8 + (size_t)L * DM;
constexpr int CW_BAR = 4096;
constexpr int RING_BYTES = 131072, LDSCTL_OFF = RING_BYTES, MISC_OFF = LDSCTL_OFF + 320, PTAB_OFF = LDSCTL_OFF + 1024, LDS_BYTES = 147456;
static_assert(dattn::SHM_ATTN <= RING_BYTES && 8 * 64 * 33 * 4 <= RING_BYTES, "phase scratch fits the ring region");

constexpr int PH_PER_LAYER = 8, NPH = 1 + DEPTH * PH_PER_LAYER;
struct Args { const float* in[28]; float* out; unsigned char* ws; int ph_lo, ph_hi; };
enum { I_X = 0, I_P, I_MIXN, I_MLPN, I_PLEN, I_NAQKV, I_NAWO, I_NAQG, I_NAKG, I_NARPB, I_GQKV, I_GWO, I_GQG, I_GKG, I_S5IN, I_LAMRE, I_LAMIM, I_LOGSTEP, I_BRE, I_BIM, I_CRE, I_CIM, I_S5D, I_S5OUT, I_W1, I_W2, I_PROJ, I_GATE };


__device__ __forceinline__ unsigned long long tab_get(LAS unsigned char* lds, int i) {
    volatile LAS unsigned* t = (volatile LAS unsigned*)(lds + PTAB_OFF); const unsigned lo = t[2 * i], hi = t[2 * i + 1];
    return ((unsigned long long)(unsigned)__builtin_amdgcn_readfirstlane((int)hi) << 32) | (unsigned)__builtin_amdgcn_readfirstlane((int)lo); }
#define INP(i) ((const float*)(const GAS float*)tab_get(F.lds, (i)))
#define OUTP() ((float*)(GAS float*)tab_get(F.lds, 28))
#define WSP() ((unsigned char*)(GAS unsigned char*)tab_get(F.lds, 29))
__device__ __forceinline__ Frame mkframe(unsigned char* lds_generic) {
    Frame F; int t = wg_tid(); asm volatile("" : "+v"(t)); F.tid = t; F.lane = t & 63; F.wave = __builtin_amdgcn_readfirstlane(t >> 6);
    F.lds = (LAS unsigned char*)lds_generic; int b = blockIdx.x; asm volatile("" : "+s"(b)); F.bid = b; int G = gridDim.x; asm volatile("" : "+s"(G)); F.G = G;
    F.vcu = (G % 8 == 0) ? (b % 8) * (G / 8) + b / 8 : b; return F; }
__device__ __forceinline__ void prologue_phase(const Frame& F) {
    unsigned char* ws = WSP();
    LAS float* scr = (LAS float*)(F.lds + F.wave * (64 * 33 * 4));
    const int gw = F.vcu * 8 + F.wave, NGW = F.G * 8;
    constexpr int I_QKV = (DM / 64) * (3 * DM / 32), I_DD = (DM / 64) * (DM / 32), I_GQ = (DM / 64) * ((DM + 2 * KVD) / 32), I_SO = (DM / 64) * (2 * DM / 32),
                  I_1 = (DM / 64) * (FF / 32), I_2 = (FF / 64) * (DM / 32), I_PJ = (PLE / 64) * (DM / 32);
    constexpr int NITEMS = 2 * I_QKV + 2 * I_DD + I_GQ + I_DD + I_DD + I_SO + 4 * I_1 + 4 * I_2 + 4 * I_PJ + 4 * I_DD;
    for (int it = gw; it < NITEMS; it += NGW) {
        int r = it; const float* W; int K, N, mode = 0, fp8 = 0; bf16* WT; const float* gain = nullptr;
        if (r < 2 * I_QKV) { const int l = r / I_QKV; r -= l * I_QKV; W = INP(I_NAQKV) + (size_t)l * DM * 3 * DM; K = DM; N = 3 * DM; WT = (bf16*)(ws + OFF_NAQKV + l * SZ_NAQKV); gain = INP(I_MIXN) + (size_t)(3 * l) * DM; fp8 = 1; }
        else { r -= 2 * I_QKV;
        if (r < 2 * I_DD) { const int l = r / I_DD; r -= l * I_DD; W = INP(I_NAWO) + (size_t)l * DM * DM; K = DM; N = DM; WT = (bf16*)(ws + OFF_NAWO + l * SZ_DD); fp8 = 1; }
        else { r -= 2 * I_DD;
        if (r < I_GQ) { W = INP(I_GQKV); K = DM; N = DM + 2 * KVD; WT = (bf16*)(ws + OFF_GQAQKV); gain = INP(I_MIXN) + (size_t)1 * DM; fp8 = 1; }
        else { r -= I_GQ;
        if (r < I_DD) { W = INP(I_GWO); K = DM; N = DM; WT = (bf16*)(ws + OFF_GQAWO); fp8 = 1; }
        else { r -= I_DD;
        if (r < I_DD) { W = INP(I_S5IN); K = DM; N = DM; WT = (bf16*)(ws + OFF_S5IN); gain = INP(I_MIXN) + (size_t)2 * DM; fp8 = 1; }
        else { r -= I_DD;
        if (r < I_SO) { W = INP(I_S5OUT); K = DM; N = 2 * DM; WT = (bf16*)(ws + OFF_S5OUT); mode = 1; fp8 = 1; }
        else { r -= I_SO;
        if (r < 4 * I_1) { const int l = r / I_1; r -= l * I_1; W = INP(I_W1) + (size_t)l * DM * FF; K = DM; N = FF; WT = (bf16*)(ws + OFF_W1 + l * SZ_W1); gain = INP(I_MLPN) + (size_t)l * DM; }
        else { r -= 4 * I_1;
        if (r < 4 * I_2) { const int l = r / I_2; r -= l * I_2; W = INP(I_W2) + (size_t)l * FF * DM; K = FF; N = DM; WT = (bf16*)(ws + OFF_W2 + l * SZ_W1); }
        else { r -= 4 * I_2;
        if (r < 4 * I_PJ) { const int l = r / I_PJ; r -= l * I_PJ; W = INP(I_PROJ) + (size_t)l * PLE * DM; K = PLE; N = DM; WT = (bf16*)(ws + OFF_PROJ + l * SZ_PROJ); }
        else { r -= 4 * I_PJ; const int l = r / I_DD; r -= l * I_DD; W = INP(I_GATE) + (size_t)l * DM * DM; K = DM; N = DM; WT = (bf16*)(ws + OFF_GATE + l * SZ_DD); gain = INP(I_PLEN) + (size_t)l * DM; } } } } } } } } }
        transpose_item(W, K, N, WT, mode, gain, scr, r, F.lane, fp8);
    }
    xrows_phase(F, INP(I_X), (bf16*)(ws + OFF_XN), (pg8::rs_t*)(ws + OFF_RS), ws + OFF_HB8);
    { const size_t n8 = (size_t)DEPTH * L * PLE / 8; const float* p = INP(I_P); bf16* pb = (bf16*)(ws + OFF_PBF);
      for (size_t i = (size_t)gw * 64 + F.lane; i < n8; i += (size_t)NGW * 64) { const f32x4 a = *(const f32x4*)(p + i * 8), b = *(const f32x4*)(p + i * 8 + 4);
          v4u w; w.x = pk2(a.x, a.y); w.y = pk2(a.z, a.w); w.z = pk2(b.x, b.y); w.w = pk2(b.z, b.w); *(v4u*)(pb + i * 8) = w; } }
    { bf16* GM = (bf16*)(ws + OFF_S5GM); bf16* BMt = (bf16*)(ws + OFF_S5BM); f32x2* PAT = (f32x2*)(ws + OFF_S5PAR);
      LDS_WAIT(); __syncthreads();
      for (int g = F.bid; g < S5G; g += F.G) s5_gen_group(F, g, INP(I_LAMRE), INP(I_LAMIM), INP(I_LOGSTEP), INP(I_BRE), INP(I_BIM), INP(I_CRE), INP(I_CIM), GM, BMt, PAT); }
}

#define WS_PTRS() unsigned char* ws = WSP(); bf16* HB0 = (bf16*)(ws + OFF_XN); bf16* HB1 = (bf16*)(ws + OFF_HB1); bf16* Qb = (bf16*)(ws + OFF_ACT); bf16* Kb = (bf16*)(ws + OFF_ACT + SZ_ACT); bf16* Vb = (bf16*)(ws + OFF_ACT + 2 * SZ_ACT); \
    bf16* Ob = (bf16*)(ws + OFF_ACT + 3 * SZ_ACT); bf16* HID = (bf16*)(ws + OFF_ACT); bf16* UA = (bf16*)(ws + OFF_ACT); bf16* S5Gb = (bf16*)(ws + OFF_ACT + 2 * SZ_ACT); float* S5E = (float*)(ws + OFF_ACT + 3 * SZ_ACT); bf16* PP = (bf16*)(ws + OFF_PP); \
    (void)HB0; (void)HB1; (void)Qb; (void)Kb; (void)Vb; (void)Ob; (void)HID; (void)UA; (void)S5Gb; (void)PP; (void)S5E;
__global__ void __launch_bounds__(512, 2) enc_fwd(Args args) {
    extern __shared__ __attribute__((aligned(16))) unsigned char lds[];
    {
        LAS unsigned char* l3 = (LAS unsigned char*)lds;
        for (int u = threadIdx.x; u < (LDS_BYTES - LDSCTL_OFF) / 4; u += 512) ((LAS unsigned*)(l3 + LDSCTL_OFF))[u] = 0u;
        __syncthreads();
        if (threadIdx.x == 0) { LAS unsigned long long* t = (LAS unsigned long long*)(l3 + PTAB_OFF);
#pragma unroll
            for (int i = 0; i < 28; ++i) t[i] = (unsigned long long)args.in[i];
            t[28] = (unsigned long long)args.out; t[29] = (unsigned long long)args.ws; }
        if ((threadIdx.x & 63) == 0) ((LAS unsigned*)(WTAB_OFF))[hw_wave_slot()] = threadIdx.x >> 6;
        __syncthreads();
    }
    const int lo = args.ph_lo, hi = args.ph_hi;
    XcdBarrier bar;
    { LAS unsigned char* l3 = (LAS unsigned char*)lds; unsigned* ctl = (unsigned*)(GAS unsigned*)(tab_get(l3, 29) + OFF_CTL); bar.bar = ctl + CW_BAR; bar.x = 0; bar.st = nullptr;
      if (hi - lo > 1) bar = xcd_barrier_post(ctl + CW_BAR, (volatile LAS unsigned*)(l3 + MISC_OFF) + 8); }
#define IN(k) (lo <= (k) && (k) < hi)
#ifndef PROBE_PH
#define PROBE_PH (-1)
#endif
#define REPS(k) for (int rep_ = 0, nrep_ = (((k) == PROBE_PH || PROBE_PH == -2) ? 2 : (((PROBE_PH == 300 || PROBE_PH == 301) && (k) == 11) ? 4 : 1)); rep_ < nrep_; ++rep_)
#define HBOUT(p) ((nrep_ == 2 && rep_ == 0) ? (bf16*)(ws + OFF_DUMMY) : (p))
#define RSOUT(i) ((nrep_ == 2 && rep_ == 0) ? (pg8::rs_t*)(ws + OFF_DUMMY + 128 * MiB) : RSP(i))
#if PROBE_PH >= 700 && PROBE_PH < 900
#define SEAM(k) do { if (IN(k) && IN((k) + 1)) { unsigned long long* ts_ = (unsigned long long*)(GAS unsigned long long*)(tab_get((LAS unsigned char*)lds, 29) + OFF_DUMMY + 200 * MiB); \
        if ((k) == PROBE_PH % 100) { __syncthreads(); if (wg_tid() == 0) __hip_atomic_store(ts_ + blockIdx.x, (unsigned long long)wall_clock64(), __ATOMIC_RELAXED, __HIP_MEMORY_SCOPE_AGENT); } \
        xcd_barrier(bar); \
        if ((k) == PROBE_PH % 100 && blockIdx.x == 0 && wg_tid() == 0) { unsigned long long mx = 0, sm = 0, t0_ = ~0ull; const unsigned st_ = (PROBE_PH >= 800) ? 8u : 1u; \
            for (unsigned i_ = 0; i_ < gridDim.x; i_ += st_) { const unsigned long long t_ = __hip_atomic_load(ts_ + i_, __ATOMIC_RELAXED, __HIP_MEMORY_SCOPE_AGENT); mx = t_ > mx ? t_ : mx; t0_ = t_ < t0_ ? t_ : t0_; } \
            for (unsigned i_ = 0; i_ < gridDim.x; i_ += st_) sm += __hip_atomic_load(ts_ + i_, __ATOMIC_RELAXED, __HIP_MEMORY_SCOPE_AGENT) - t0_; \
            const unsigned long long idle_ = (mx - t0_) - sm / (gridDim.x / st_), until_ = (unsigned long long)wall_clock64() + 100ull * idle_; \
            while ((unsigned long long)wall_clock64() < until_) __builtin_amdgcn_s_sleep(32); } } } while (0)
#else
#define SEAM(k) do { if (IN(k) && IN((k) + 1)) xcd_barrier(bar); } while (0)
#endif

#if PROBE_PH == 601
    if (blockIdx.x == 0 && threadIdx.x < 64) {
        typedef int v8i_ __attribute__((ext_vector_type(8))); typedef float f4v_ __attribute__((ext_vector_type(4)));
        const int l = threadIdx.x, ij = l & 15, kb = l >> 4; const unsigned lut[7] = {0xC4u, 0xC0u, 0xB8u, 0x00u, 0x38u, 0x40u, 0x44u};
        v8i_ A, B;
#pragma unroll
        for (int v = 0; v < 8; ++v) { unsigned wa = 0, wb = 0;
#pragma unroll
            for (int b = 0; b < 4; ++b) { const int kk = 32 * kb + 4 * v + b; const int av = ((ij + 2 * kk) % 5) - 2, bv = ((3 * kk + ij) % 7) - 3;
                unsigned ea = 0, eb = 0;
#pragma unroll
                for (int t = 0; t < 7; ++t) { ea = (av + 3 == t) ? lut[t] : ea; eb = (bv + 3 == t) ? lut[t] : eb; }
                wa |= ea << (8 * b); wb |= eb << (8 * b); }
            A[v] = (int)wa; B[v] = (int)wb; }
        f4v_ c1 = {};
        c1 = __builtin_amdgcn_mfma_scale_f32_16x16x128_f8f6f4(A, B, c1, 0, 0, 0, 0x7F7F7F7F, 0, 0x7F7F7F7F);
        bool ok1 = true;
#pragma unroll
        for (int r = 0; r < 4; ++r) { const int i = 4 * kb + r, j = ij; int s = 0;
            for (int kk = 0; kk < 128; ++kk) s += (((i + 2 * kk) % 5) - 2) * (((3 * kk + j) % 7) - 3);
            ok1 = ok1 && (c1[r] == (float)s); }
        unsigned long long ticks = 0; if (!__all(ok1)) ticks += 400000ull;
        const unsigned long long t0 = __builtin_amdgcn_s_memrealtime(); while (__builtin_amdgcn_s_memrealtime() - t0 < ticks) __builtin_amdgcn_s_sleep(8);
    }
    __syncthreads();
#endif
#if PROBE_PH == 600
    if (blockIdx.x == 0 && threadIdx.x < 64) {
        typedef int v8i_ __attribute__((ext_vector_type(8))); typedef float f16v_ __attribute__((ext_vector_type(16)));
        const int l = threadIdx.x, ij = l & 31, kb = l >> 5; const unsigned lut[7] = {0xC4u, 0xC0u, 0xB8u, 0x00u, 0x38u, 0x40u, 0x44u};
        v8i_ A, B;
#pragma unroll
        for (int v = 0; v < 8; ++v) { unsigned wa = 0, wb = 0;
#pragma unroll
            for (int b = 0; b < 4; ++b) { const int kk = 32 * kb + 4 * v + b; const int av = ((ij + 2 * kk) % 5) - 2, bv = ((3 * kk + ij) % 7) - 3;
                unsigned ea = 0, eb = 0;
#pragma unroll
                for (int t = 0; t < 7; ++t) { ea = (av + 3 == t) ? lut[t] : ea; eb = (bv + 3 == t) ? lut[t] : eb; }
                wa |= ea << (8 * b); wb |= eb << (8 * b); }
            A[v] = (int)wa; B[v] = (int)wb; }
        f16v_ c1 = {}, c2 = {};
        c1 = __builtin_amdgcn_mfma_scale_f32_32x32x64_f8f6f4(A, B, c1, 0, 0, 0, 0x7F7F7F7F, 0, 0x7F7F7F7F);
        c2 = __builtin_amdgcn_mfma_scale_f32_32x32x64_f8f6f4(A, B, c2, 0, 0, 0, 0x7B7B7B7B, 0, 0x7F7F7F7F);
        bool ok1 = true, ok2 = true;
#pragma unroll
        for (int r = 0; r < 16; ++r) { const int i = (r & 3) + 8 * (r >> 2) + 4 * kb, j = ij; int s = 0;
            for (int kk = 0; kk < 64; ++kk) s += (((i + 2 * kk) % 5) - 2) * (((3 * kk + j) % 7) - 3);
            ok1 = ok1 && (c1[r] == (float)s); ok2 = ok2 && (c2[r] == (float)s * 0.0625f); }
        int w = __builtin_amdgcn_cvt_pk_fp8_f32(1.0f, 2.0f, 0, false); w = __builtin_amdgcn_cvt_pk_fp8_f32(3.0f, -1.0f, w, true);
        const bool ok3 = ((unsigned)w == 0xB8444038u);
        unsigned long long ticks = 0; if (!__all(ok1)) ticks += 400000ull; if (!__all(ok2)) ticks += 800000ull; if (!__all(ok3)) ticks += 1600000ull;
        const unsigned long long t0 = __builtin_amdgcn_s_memrealtime(); while (__builtin_amdgcn_s_memrealtime() - t0 < ticks) __builtin_amdgcn_s_sleep(8);
    }
    __syncthreads();
#endif
    if (IN(0)) REPS(0) { const Frame F = mkframe(lds); prologue_phase(F); } SEAM(0);
#if PROBE_PH == 200
    for (int xb_ = 0; xb_ < 40; ++xb_) xcd_barrier(bar);
#endif

#pragma unroll 1
    for (int layer = 0; layer < DEPTH; ++layer) {
        const int kind = layer % 3, slot = layer / 3, pb = 1 + PH_PER_LAYER * layer;
#define RSP(i) ((pg8::rs_t*)(ws + OFF_RS) + (size_t)(i) * L)
        const int irs = (layer == 0) ? 0 : 3 * layer;
        if (IN(pb + 0)) REPS(pb + 0) {
            const Frame F = mkframe(lds); WS_PTRS();
            if (kind != 2) {
                const int N = (kind == 0) ? 3 * DM : DM + 2 * KVD;
                const bf16* W = (kind == 0) ? (const bf16*)(ws + OFF_NAQKV + slot * SZ_NAQKV) : (const bf16*)(ws + OFF_GQAQKV);
                const pg8::Gemm g = pg8::mkgemm((const bf16*)(ws + OFF_HB8), W, L, N, DM / 2); pg8::StaticOrder S; S.init(L, N, F.G, F.bid);
                pg8::EpiBf16<0> E{Qb, Kb, Vb, DM, (kind == 0) ? DM : KVD, (kind == 0) ? DM : L, DM, (kind == 0) ? 2 * DM : DM + KVD, RSP(irs), (kind == 0) ? 0 : 2, (kind == 0) ? 2 * DM : DM + KVD};
                pg8::gemm_phase<pg8::EpiBf16<0>, pg8::StaticOrder, false, true, true>(F.lds, g, S, E);
            } else {
                const pg8::Gemm g = pg8::mkgemm((const bf16*)(ws + OFF_HB8), (const bf16*)(ws + OFF_S5IN), L, DM, DM / 2); pg8::StaticOrder S; S.init(L, DM, F.G, F.bid);
                pg8::EpiS5U E{UA, RSP(irs)};
                pg8::gemm_phase<pg8::EpiS5U, pg8::StaticOrder, false, true, true>(F.lds, g, S, E);
            }
        }
        SEAM(pb + 0);
        if (kind != 2) {
            if (kind == 1) { if (IN(pb + 1)) { const Frame F = mkframe(lds); WS_PTRS(); prep_phase(F, Qb, Kb, KVD, NKV, INP(I_GQG), INP(I_GKG), true, (unsigned char*)Kb + 64 * MiB); }
                SEAM(pb + 1); }
            if (IN(pb + 2)) REPS(pb + 2) { const Frame F = mkframe(lds); WS_PTRS();
                if (kind == 0) {
                    const float* rpb = INP(I_NARPB) + (size_t)slot * NH * 15 * 31;
                    for (int i = 0;; ++i) { const int unit = i * F.G + F.vcu; if (unit >= NH * (GROWS / 4)) break;
                        const int h = unit >> 6, R = (unit & 63) * 4, ks = min(max(R - 4, 0), GROWS - dattn::NA_TILES);
                        dattn::na_block_body(Qb + (size_t)(R * GRID_W) * DM + h * HD, Kb + (size_t)(ks * GRID_W) * DM + h * HD, Vb + (size_t)(ks * GRID_W) * DM + h * HD,
                                             (bf16*)((unsigned char*)Ob + (size_t)(R * GRID_W) * DM + h * HD), rpb + (size_t)h * 15 * 31, INP(I_NAQG) + slot * HD, INP(I_NAKG) + slot * HD, R, ks, (char*)lds);
                        __syncthreads(); }
                } else {
                    for (int i = 0;; ++i) { const int unit = i * F.G + F.bid; if (unit >= NH * (L / 256)) break;
                        const int kvh = unit & 7, rest = unit >> 3, hq = kvh * 4 + (rest >> 6), qb = rest & 63;
                        dattn::attn_dense_body8(Qb + (size_t)(qb * 256) * DM + hq * HD, (const unsigned char*)Kb + 64 * MiB + kvh * HD, (const unsigned char*)Vb + (size_t)(kvh * HD) * L, (bf16*)((unsigned char*)Ob + (size_t)(qb * 256) * DM + hq * HD), L, (char*)lds);
                        __syncthreads(); }
                }
            }
            if (IN(pb + 2) && IN(pb + 4)) xcd_barrier(bar);
#if PROBE_PH == 400
            if (kind == 1) { const Frame F = mkframe(lds); WS_PTRS();
                gqa_selfcheck(F, Qb, (const unsigned char*)Kb + 64 * MiB, (const unsigned char*)Vb, Ob, (float*)(ws + OFF_PP), (unsigned*)(ws + OFF_CTL) + 8);
                xcd_barrier(bar); }
#endif
        } else {
            if (IN(pb + 1)) REPS(pb + 1) { const Frame F = mkframe(lds); WS_PTRS();
                pg8::Gemm g; g.A = UA; g.Bt = (const bf16*)(ws + OFF_S5GM); g.M = S5G * S5NCH; g.N = 256; g.K = 512; g.lda = S5KS; g.ldb = 512; g.sa = 0x7F7F7F7F;
                pg8::S5Order S{F.G, F.bid, 2, 1}; pg8::EpiS5E E{S5E};
                pg8::gemm_phase<pg8::EpiS5E, pg8::S5Order, false, true>(F.lds, g, S, E); }
            SEAM(pb + 1);
            if (IN(pb + 2)) REPS(pb + 2) { const Frame F = mkframe(lds); WS_PTRS(); s5_scan_phase(F, (const f32x2*)(ws + OFF_S5PAR), S5E, UA); }
            SEAM(pb + 2);
            if (IN(pb + 3)) REPS(pb + 3) { const Frame F = mkframe(lds); WS_PTRS();
                pg8::Gemm g; g.A = UA; g.Bt = (const bf16*)(ws + OFF_S5BM); g.M = S5G * S5NCH; g.N = S5G * 512; g.K = S5KS; g.lda = S5KS; g.ldb = S5KS; g.sa = 0x7F7F7F7F;
                pg8::S5Order S{F.G, F.bid, 2, 2}; pg8::EpiS5Y E{UA, INP(I_S5D), S5Gb, DM};
                pg8::gemm_phase<pg8::EpiS5Y, pg8::S5Order, false, true>(F.lds, g, S, E); }
            SEAM(pb + 3);
        }
        if (IN(pb + 4)) REPS(pb + 4) {
            const Frame F = mkframe(lds); WS_PTRS();
            if (kind != 2) {
                const bf16* W = (kind == 0) ? (const bf16*)(ws + OFF_NAWO + slot * SZ_DD) : (const bf16*)(ws + OFF_GQAWO);
                pg8::Gemm g = pg8::mkgemm(Ob, W, L, DM, DM / 2); g.sa = 0x79797979; pg8::StaticOrder S; S.init(L, DM, F.G, F.bid);
                pg8::EpiRes E{HB0, HBOUT(HB0), RSOUT(1 + 3 * layer), DM, nullptr};
                pg8::gemm_phase<pg8::EpiRes, pg8::StaticOrder, false, true, true>(F.lds, g, S, E);
            } else {
                pg8::Gemm g = pg8::mkgemm(S5Gb, (const bf16*)(ws + OFF_S5OUT), L, 2 * DM, DM / 2); g.sa = 0x7B7B7B7B; pg8::StaticOrder S; S.init(L, 2 * DM, F.G, F.bid);
                pg8::EpiGlu E{HB0, HBOUT(HB0), RSOUT(1 + 3 * layer), DM};
                pg8::gemm_phase<pg8::EpiGlu, pg8::StaticOrder, false, true, true>(F.lds, g, S, E);
            }
        }
        SEAM(pb + 4);
        if (IN(pb + 5)) REPS(pb + 5) { const Frame F = mkframe(lds); WS_PTRS();
            const pg8::Gemm g = pg8::mkgemm(HB0, (const bf16*)(ws + OFF_W1 + layer * SZ_W1), L, FF, DM); pg8::StaticOrder S; S.init(L, FF, F.G, F.bid);
            pg8::EpiBf16<2> E{HID, HID, HID, FF, FF, FF, 1 << 30, 1 << 30, nullptr, 0, 0};
#if PROBE_PH == 201
            { pg8::RangeOrder R1{S, 0, 8}, R2{S, 8, 16};
              pg8::gemm_phase<pg8::EpiBf16<2>, pg8::RangeOrder, false, true>(F.lds, g, R1, E); xcd_barrier(bar);
              pg8::gemm_phase<pg8::EpiBf16<2>, pg8::RangeOrder, false, true>(F.lds, g, R2, E); }
#else
            pg8::gemm_phase<pg8::EpiBf16<2>, pg8::StaticOrder, false, true>(F.lds, g, S, E);
#endif
        }
        SEAM(pb + 5);
        if (IN(pb + 6)) REPS(pb + 6) { const Frame F = mkframe(lds); WS_PTRS();
            { const pg8::Gemm g = pg8::mkgemm(HID, (const bf16*)(ws + OFF_W2 + layer * SZ_W1), L, DM, FF); pg8::StaticOrder S; S.init(L, DM, F.G, F.bid);
              pg8::EpiRes E{HB0, HBOUT(HB1), RSOUT(2 + 3 * layer), DM, RSP(1 + 3 * layer)};
              pg8::gemm_phase<pg8::EpiRes, pg8::StaticOrder, false, true>(F.lds, g, S, E); }
            { const pg8::Gemm g = pg8::mkgemm((const bf16*)(ws + OFF_PBF + (size_t)layer * L * PLE * 2), (const bf16*)(ws + OFF_PROJ + layer * SZ_PROJ), L, DM, PLE); pg8::StaticOrder S; S.init(L, DM, F.G, F.bid);
              pg8::EpiBf16<0> E{PP, PP, PP, DM, DM, DM, 1 << 30, 1 << 30, nullptr, 0, 0};
              pg8::gemm_phase<pg8::EpiBf16<0>, pg8::StaticOrder, false, true>(F.lds, g, S, E); }
        }
        SEAM(pb + 6);
        if (IN(pb + 7)) REPS(pb + 7) { const Frame F = mkframe(lds); WS_PTRS();
            const pg8::Gemm g = pg8::mkgemm(HB1, (const bf16*)(ws + OFF_GATE + layer * SZ_DD), L, DM, DM); pg8::StaticOrder S; S.init(L, DM, F.G, F.bid);
            pg8::EpiGate E{HB1, HBOUT(HB0), (layer == DEPTH - 1) ? OUTP() : nullptr, PP, RSP(2 + 3 * layer), RSOUT(3 + 3 * layer), DM, (layer + 1 < DEPTH && !(nrep_ == 2 && rep_ == 0)) ? ws + OFF_HB8 : nullptr};
            pg8::gemm_phase<pg8::EpiGate, pg8::StaticOrder, false, true>(F.lds, g, S, E);
        }
        SEAM(pb + 7);
    }
#if PROBE_PH == 400
    { xcd_barrier(bar); const Frame F = mkframe(lds); unsigned char* ws = WSP();
      if (__hip_atomic_load((unsigned*)(ws + OFF_CTL) + 8, __ATOMIC_RELAXED, __HIP_MEMORY_SCOPE_AGENT) != 0u && F.bid == 0 && F.tid < 64) OUTP()[F.tid] = __builtin_nanf(""); }
#endif
#undef IN
#undef SEAM
}

extern "C" void kernel_launch(void* const* d_in, const int* in_sizes, int n_in, void* d_out, int out_size, void* d_ws, size_t ws_size, hipStream_t stream) {
    static int grid = 0;
    if (grid == 0) {
        if (n_in != 28 || in_sizes[0] != L * DM || out_size != L * DM || ws_size < WS_END) {
            fprintf(stderr, "kernel_launch: built for 28 inputs, x/out of %d floats, >= %zu bytes of workspace; got n_in %d, in0 %d, out %d, ws %zu; nothing launched\n", L * DM, (size_t)WS_END, n_in, n_in > 0 ? in_sizes[0] : -1, out_size, ws_size);
            grid = -1; return; }
        int dev = 0, cus = 0, per_cu = 0;
        if (hipGetDevice(&dev) != hipSuccess || hipDeviceGetAttribute(&cus, hipDeviceAttributeMultiprocessorCount, dev) != hipSuccess) { fprintf(stderr, "kernel_launch: device query failed\n"); grid = -1; return; }
        if (hipFuncSetAttribute((const void*)enc_fwd, hipFuncAttributeMaxDynamicSharedMemorySize, LDS_BYTES) != hipSuccess) { fprintf(stderr, "kernel_launch: hipFuncSetAttribute failed\n"); grid = -1; return; }
        if (hipOccupancyMaxActiveBlocksPerMultiprocessor(&per_cu, (const void*)enc_fwd, 512, LDS_BYTES) != hipSuccess || per_cu < 1)
            fprintf(stderr, "kernel_launch: note: occupancy query reports %d workgroups per CU\n", per_cu);
        (void)hipGetLastError();
        grid = cus;
    }
    if (grid < 0) return;
    if (hipMemsetAsync((char*)d_ws + OFF_CTL, 0, CTL_ZERO_BYTES, stream) != hipSuccess) { fprintf(stderr, "kernel_launch: memset failed\n"); return; }
    Args a{};
    for (int i = 0; i < 28; ++i) a.in[i] = (const float*)d_in[i];
    a.out = (float*)d_out; a.ws = (unsigned char*)d_ws;
#if MK_N_LAUNCHES == 1
    a.ph_lo = 0; a.ph_hi = NPH;
    hipLaunchKernelGGL(enc_fwd, dim3(grid), dim3(512), LDS_BYTES, stream, a);
#else
    for (int ph = 0; ph < NPH; ++ph) {
        if (ph > 0) { const int layer = (ph - 1) / PH_PER_LAYER, j = (ph - 1) % PH_PER_LAYER; if (j == 3 && layer % 3 != 2) continue; }
        a.ph_lo = ph; a.ph_hi = ph + 1;
        hipLaunchKernelGGL(enc_fwd, dim3(grid), dim3(512), LDS_BYTES, stream, a);
    }
#endif
    const hipError_t le = hipPeekAtLastError();
    if (le != hipSuccess) fprintf(stderr, "kernel_launch: launch failed: %s\n", hipGetErrorName(le));
}
```

```cpp
#include <hip/hip_runtime.h>
#include <cstdio>
#include <cstdint>

#ifndef MK_N_LAUNCHES
#define MK_N_LAUNCHES 1
#endif

constexpr int L = 16384, DM = 4096, DEPTH = 4, GRID_W = 64, GROWS = L / GRID_W, HD = 128, NH = 32, NKV = 8, KVD = NKV * HD, FF = 4 * DM, PLE = 256;
constexpr int S5G = 256, S5P = 16, S5N = 64, S5TC = 16, S5NC = L / S5TC;
constexpr float EPS = 1e-6f;

#define GAS __attribute__((address_space(1)))
#define LAS __attribute__((address_space(3)))
constexpr unsigned WTAB_OFF = 131072 + 2048;
__device__ __forceinline__ unsigned hw_wave_slot() { return (unsigned)__builtin_amdgcn_s_getreg((5 << 11) | 4) & 63u; }
__device__ __forceinline__ int wg_tid() {
    const unsigned wv = (unsigned)__builtin_amdgcn_readfirstlane((int)((volatile LAS unsigned*)(WTAB_OFF))[hw_wave_slot()]);
    unsigned ln; asm volatile("v_mbcnt_lo_u32_b32 %0, -1, 0\n\tv_mbcnt_hi_u32_b32 %0, -1, %0" : "=v"(ln));
    return (int)(wv * 64u + ln);
}
typedef unsigned short bf16;
typedef unsigned v4u __attribute__((ext_vector_type(4)));
typedef unsigned v2u __attribute__((ext_vector_type(2)));
typedef float f32x4 __attribute__((ext_vector_type(4)));
typedef float f32x2 __attribute__((ext_vector_type(2)));
typedef short bf16x8 __attribute__((ext_vector_type(8)));
typedef short s16x4 __attribute__((ext_vector_type(4)));
typedef GAS unsigned gu32;
#define RLX_AGENT __ATOMIC_RELAXED, __HIP_MEMORY_SCOPE_AGENT
#define LDS_WAIT() asm volatile("s_waitcnt lgkmcnt(0)" ::: "memory")
#define VM_WAIT() asm volatile("s_waitcnt vmcnt(0)" ::: "memory")
__device__ __forceinline__ unsigned f2bf(float f) { unsigned u = __builtin_bit_cast(unsigned, f); return (u + 0x7fffu + ((u >> 16) & 1u)) >> 16; }
__device__ __forceinline__ unsigned pk2(float lo, float hi) { return f2bf(lo) | (f2bf(hi) << 16); }
__device__ __forceinline__ float bf2f(unsigned short b) { return __builtin_bit_cast(float, (unsigned)b << 16); }
__device__ __forceinline__ float bflo(unsigned w) { return __builtin_bit_cast(float, w << 16); }
__device__ __forceinline__ float bfhi(unsigned w) { return __builtin_bit_cast(float, w & 0xffff0000u); }
__device__ __forceinline__ float sigmoidf_fast(float x) { return __builtin_amdgcn_rcpf(1.0f + __builtin_amdgcn_exp2f(-1.4426950408889634f * x)); }

namespace pg8 {
#define PG8_LAS __attribute__((address_space(3)))
#if defined(PROBE_EPI2)
#define PROBE_EPI_DUP if constexpr (Epi::PERM) E(acc, cur, wr, wc, fr, fq);
#else
#define PROBE_EPI_DUP
#endif
typedef unsigned short bf16_t;
typedef short bf16x8 __attribute__((ext_vector_type(8)));
typedef float f32x4 __attribute__((ext_vector_type(4)));
typedef unsigned u32x4 __attribute__((ext_vector_type(4)));
constexpr int BM = 256, BK = 64, HALF = 128, HTB = HALF * BK * 2  , STAGE_BYTES = 8 * HTB, NXCD = 8, WGM = 8;

__host__ __device__ __forceinline__ int lds_byte(int r, int c) { const int st = (r >> 4) * 2 + (c >> 5), rr = r & 15, cc = c & 31, ob = rr * 64 + cc * 2; return st * 1024 + (ob ^ (((ob >> 9) & 1) << 5)); }
__host__ __device__ __forceinline__ void stage_rc(int b, int& R, int& C) { const int st = b / 1024, sb = b % 1024, swz = sb ^ (((sb >> 9) & 1) << 5); R = (st >> 1) * 16 + swz / 64; C = (st & 1) * 32 + (swz % 64) / 2; }
__host__ __device__ __forceinline__ int perm32(int rho) { const int n = rho >> 4, i = rho & 15; return 8 * (i >> 2) + 4 * n + (i & 3); }

struct Unit { int pm, pn; };
struct Gemm { const bf16_t* A; const bf16_t* Bt; int M, N, K, lda, ldb, sa; };
__host__ __device__ __forceinline__ Gemm mkgemm(const bf16_t* A, const bf16_t* Bt, int M, int N, int K) { Gemm g; g.A = A; g.Bt = Bt; g.M = M; g.N = N; g.K = K; g.lda = K; g.ldb = K; g.sa = 0x7F7F7F7F; return g; }

struct StaticOrder {
    int nM, nN, nwg, G, c, wgm;
    __host__ __device__ void init(int M, int N, int G_, int c_, int wgm_ = WGM) { nM = M / BM; nN = N / BM; nwg = nM * nN; G = G_; c = c_; wgm = wgm_; }
    __host__ __device__ bool next(int i, Unit& u) const {
        const long L = (long)i * G + c; if (L >= nwg) return false;
        int wgid = (int)L; { const int q = nwg / NXCD, r = nwg % NXCD, xcd = wgid % NXCD, off = wgid / NXCD; wgid = (xcd < r ? xcd * (q + 1) : r * (q + 1) + (xcd - r) * q) + off; }
        const int nig = wgm * nN, gid = wgid / nig, fm = gid * wgm, gsz = (nM - fm) < wgm ? (nM - fm) : wgm;
        u.pm = fm + ((wgid % nig) % gsz); u.pn = (wgid % nig) / gsz; return true;
    }
    __device__ __forceinline__ void a_ready(const Unit&) const {}
    __device__ __forceinline__ void done(const Unit&) const {}
};
struct RangeOrder { StaticOrder S; int i0, i1;
    __host__ __device__ bool next(int i, Unit& u) const { return (i + i0 < i1) ? S.next(i + i0, u) : false; }
    __device__ __forceinline__ void a_ready(const Unit&) const {}
    __device__ __forceinline__ void done(const Unit&) const {} };


__device__ __forceinline__ unsigned cvt_pk_bf16(float lo, float hi) { unsigned r; asm volatile("v_cvt_pk_bf16_f32 %0, %1, %2" : "=v"(r) : "v"(lo), "v"(hi)); return r; }
__device__ __forceinline__ float sigm(float x) { return __builtin_amdgcn_rcpf(1.0f + __builtin_amdgcn_exp2f(-1.4426950408889634f * x)); }

typedef unsigned long long rs_t;
constexpr float RS_FIX = 16777216.0f, RS_INV = 1.0f / (16777216.0f * 4096.0f), RS_EPS = 1e-6f;
__device__ __forceinline__ void row_ss_add(rs_t* rs, int row, float s, int fq) {
    s += __shfl_xor(s, 16); s += __shfl_xor(s, 32);
    if (fq == 0) __hip_atomic_fetch_add(rs + row, (rs_t)(s * RS_FIX), __ATOMIC_RELAXED, __HIP_MEMORY_SCOPE_AGENT);
}
__device__ __forceinline__ float rs_rinv(rs_t v) { return __builtin_amdgcn_rsqf((float)v * RS_INV + RS_EPS); }
#define PIN8(a) asm volatile("" : "+v"((a)[0]), "+v"((a)[1]), "+v"((a)[2]), "+v"((a)[3]), "+v"((a)[4]), "+v"((a)[5]), "+v"((a)[6]), "+v"((a)[7]))
template <int ACT> struct EpiBf16 {
    static constexpr bool PERM = true, AFTER_DRAIN = false;
    bf16_t *O0, *O1, *O2; int ld0, ld1, ld2, c1, c2; const rs_t* rs; int vt; int rs_from;
    __device__ __forceinline__ void operator()(const f32x4 (&acc)[2][2][4][2], const Unit& u, int wr, int wc, int fr, int fq) const {
        const int row0 = u.pm * BM + wr * 64 + fr; int colt = u.pn * BM; bf16_t* base = O0; int ldc = ld0;
        const rs_t* rs = (colt >= rs_from) ? this->rs : nullptr;
        bool tr = false;
        if (colt >= c2) { base = O2; ldc = ld2; colt -= c2; tr = vt != 0; } else if (colt >= c1) { base = O1; ldc = ld1; colt -= c1; }
        const int col0 = colt + wc * 32 + 8 * fq;
        rs_t scv[8];
#pragma unroll
        for (int gi = 0; gi < 8; ++gi) scv[gi] = rs ? rs[row0 + (gi >> 2) * HALF + (gi & 3) * 16] : 0ull;
        PIN8(scv);
#pragma unroll
        for (int ai = 0; ai < 2; ++ai)
#pragma unroll
            for (int m = 0; m < 4; ++m) { bf16_t* rowp = base + (size_t)(row0 + ai * HALF + m * 16) * ldc + col0; const float sc = rs ? rs_rinv(scv[ai * 4 + m]) : 1.0f;
#pragma unroll
                for (int bj = 0; bj < 2; ++bj) { f32x4 v0 = acc[ai][bj][m][0] * sc, v1 = acc[ai][bj][m][1] * sc;
                    if (ACT == 2) {
#pragma unroll
                        for (int j = 0; j < 4; ++j) { const float a = fmaxf(v0[j], 0.f), b = fmaxf(v1[j], 0.f); v0[j] = a * a; v1[j] = b * b; } }
                    u32x4 w; w.x = cvt_pk_bf16(v0[0], v0[1]); w.y = cvt_pk_bf16(v0[2], v0[3]); w.z = cvt_pk_bf16(v1[0], v1[1]); w.w = cvt_pk_bf16(v1[2], v1[3]);
                    if (vt == 2 && tr) {
                        unsigned char* tp = (unsigned char*)base + (size_t)(col0 + bj * HALF) * ldc + (row0 + ai * HALF + m * 16);
                        int w0 = __builtin_amdgcn_cvt_pk_fp8_f32(v0[0], v0[1], 0, false); w0 = __builtin_amdgcn_cvt_pk_fp8_f32(v0[2], v0[3], w0, true);
                        int w1 = __builtin_amdgcn_cvt_pk_fp8_f32(v1[0], v1[1], 0, false); w1 = __builtin_amdgcn_cvt_pk_fp8_f32(v1[2], v1[3], w1, true);
                        tp[0] = (unsigned char)w0; tp[(size_t)ldc] = (unsigned char)(w0 >> 8); tp[(size_t)2 * ldc] = (unsigned char)(w0 >> 16); tp[(size_t)3 * ldc] = (unsigned char)(w0 >> 24);
                        tp[(size_t)4 * ldc] = (unsigned char)w1; tp[(size_t)5 * ldc] = (unsigned char)(w1 >> 8); tp[(size_t)6 * ldc] = (unsigned char)(w1 >> 16); tp[(size_t)7 * ldc] = (unsigned char)(w1 >> 24); }
                    else if (tr) { bf16_t* tp = base + (size_t)(col0 + bj * HALF) * ldc + (row0 + ai * HALF + m * 16);
                        tp[0] = (bf16_t)w.x; tp[(size_t)ldc] = (bf16_t)(w.x >> 16); tp[(size_t)2 * ldc] = (bf16_t)w.y; tp[(size_t)3 * ldc] = (bf16_t)(w.y >> 16);
                        tp[(size_t)4 * ldc] = (bf16_t)w.z; tp[(size_t)5 * ldc] = (bf16_t)(w.z >> 16); tp[(size_t)6 * ldc] = (bf16_t)w.w; tp[(size_t)7 * ldc] = (bf16_t)(w.w >> 16); }
                    else *(u32x4*)(rowp + bj * HALF) = w; } }
    }
};
struct EpiF32 {
    static constexpr bool PERM = false, AFTER_DRAIN = false;
    float* C; int ldc;
    __device__ __forceinline__ void operator()(const f32x4 (&acc)[2][2][4][2], const Unit& u, int wr, int wc, int fr, int fq) const {
        const int row0 = u.pm * BM + wr * 64 + fr, col0 = u.pn * BM + wc * 32 + 4 * fq;
#pragma unroll
        for (int ai = 0; ai < 2; ++ai)
#pragma unroll
            for (int m = 0; m < 4; ++m) { float* rowp = C + (size_t)(row0 + ai * HALF + m * 16) * ldc + col0;
#pragma unroll
                for (int bj = 0; bj < 2; ++bj)
#pragma unroll
                    for (int n = 0; n < 2; ++n) *(f32x4*)(rowp + bj * HALF + n * 16) = acc[ai][bj][m][n]; }
    }
};
typedef unsigned u32x2 __attribute__((ext_vector_type(2)));
__device__ __forceinline__ f32x4 bf4_to_f32(u32x2 p) { return (f32x4){__builtin_bit_cast(float, p.x << 16), __builtin_bit_cast(float, p.x & 0xffff0000u), __builtin_bit_cast(float, p.y << 16), __builtin_bit_cast(float, p.y & 0xffff0000u)}; }
struct EpiRes {
    static constexpr bool PERM = false, AFTER_DRAIN = false;
    const bf16_t* base; bf16_t* out; rs_t* rs; int ldc; const rs_t* rsq;
    __device__ __forceinline__ void operator()(const f32x4 (&acc)[2][2][4][2], const Unit& u, int wr, int wc, int fr, int fq) const {
        constexpr int PD = 3;
        const int row0 = u.pm * BM + wr * 64 + fr, col0 = u.pn * BM + wc * 32 + 4 * fq;
        u32x2 nb[8][2][2];
        rs_t scv[8];
#pragma unroll
        for (int gi = 0; gi < 8; ++gi) scv[gi] = rsq ? rsq[row0 + (gi >> 2) * HALF + (gi & 3) * 16] : 0ull;
#define EPI_LD(g) do { const size_t o_ = (size_t)(row0 + ((g) >> 2) * HALF + ((g) & 3) * 16) * ldc + col0; _Pragma("unroll") for (int bj = 0; bj < 2; ++bj) _Pragma("unroll") for (int n = 0; n < 2; ++n) nb[g][bj][n] = *(const u32x2*)(base + o_ + bj * HALF + n * 16); } while (0)
#pragma unroll
        for (int g = 0; g < PD; ++g) EPI_LD(g);
        PIN8(scv);
#pragma unroll
        for (int gi = 0; gi < 8; ++gi) { const int ai = gi >> 2, m = gi & 3; const int row = row0 + ai * HALF + m * 16; const size_t off = (size_t)row * ldc + col0;
            if (gi + PD < 8) EPI_LD(gi + PD);
            const float sc2 = rsq ? __builtin_amdgcn_rcpf((float)scv[gi] * RS_INV + RS_EPS) : 1.0f;
            float ss = 0.f;
#pragma unroll
            for (int bj = 0; bj < 2; ++bj)
#pragma unroll
                for (int n = 0; n < 2; ++n) { const f32x4 o = bf4_to_f32(nb[gi][bj][n]) + acc[ai][bj][m][n] * sc2;
                    ss += (o[0] * o[0] + o[1] * o[1]) + (o[2] * o[2] + o[3] * o[3]);
                    u32x2 w; w.x = cvt_pk_bf16(o[0], o[1]); w.y = cvt_pk_bf16(o[2], o[3]); *(u32x2*)(out + off + bj * HALF + n * 16) = w; }
            row_ss_add(rs, row, ss, fq); }
#undef EPI_LD
    }
};
struct EpiGate {
    static constexpr bool PERM = false, AFTER_DRAIN = false;
    const bf16_t* base; bf16_t* out; float* out32; const bf16_t* pp; const rs_t* rsin; rs_t* rs; int ldc; unsigned char* out8;
    __device__ __forceinline__ void operator()(const f32x4 (&acc)[2][2][4][2], const Unit& u, int wr, int wc, int fr, int fq) const {
        constexpr int PD = 2;
        const int row0 = u.pm * BM + wr * 64 + fr, col0 = u.pn * BM + wc * 32 + 4 * fq;
        rs_t scv[8];
#pragma unroll
        for (int gi = 0; gi < 8; ++gi) scv[gi] = rsin[row0 + (gi >> 2) * HALF + (gi & 3) * 16];
        u32x2 nb[8][2][2], np[8][2][2];
#define EPI_LD(g) do { const size_t o_ = (size_t)(row0 + ((g) >> 2) * HALF + ((g) & 3) * 16) * ldc + col0; _Pragma("unroll") for (int bj = 0; bj < 2; ++bj) _Pragma("unroll") for (int n = 0; n < 2; ++n) { \
            nb[g][bj][n] = *(const u32x2*)(base + o_ + bj * HALF + n * 16); np[g][bj][n] = *(const u32x2*)(pp + o_ + bj * HALF + n * 16); } } while (0)
#pragma unroll
        for (int g = 0; g < PD; ++g) EPI_LD(g);
        PIN8(scv);
#pragma unroll
        for (int gi = 0; gi < 8; ++gi) { const int ai = gi >> 2, m = gi & 3; const int row = row0 + ai * HALF + m * 16; const size_t off = (size_t)row * ldc + col0;
            if (gi + PD < 8) EPI_LD(gi + PD);
            const float sc = rs_rinv(scv[gi]);
            float ss = 0.f;
#pragma unroll
            for (int bj = 0; bj < 2; ++bj)
#pragma unroll
                for (int n = 0; n < 2; ++n) { const f32x4 a = acc[ai][bj][m][n] * sc, p = bf4_to_f32(np[gi][bj][n]); f32x4 o = bf4_to_f32(nb[gi][bj][n]);
#pragma unroll
                    for (int j = 0; j < 4; ++j) o[j] += sigm(a[j]) * p[j];
                    if (out32) *(f32x4*)(out32 + off + bj * HALF + n * 16) = o;
                    if (out8) { int w8 = __builtin_amdgcn_cvt_pk_fp8_f32(o[0], o[1], 0, false); w8 = __builtin_amdgcn_cvt_pk_fp8_f32(o[2], o[3], w8, true); *(unsigned*)(out8 + off + bj * HALF + n * 16) = (unsigned)w8; }
                    ss += (o[0] * o[0] + o[1] * o[1]) + (o[2] * o[2] + o[3] * o[3]);
                    u32x2 w; w.x = cvt_pk_bf16(o[0], o[1]); w.y = cvt_pk_bf16(o[2], o[3]); *(u32x2*)(out + off + bj * HALF + n * 16) = w; }
            row_ss_add(rs, row, ss, fq); }
#undef EPI_LD
    }
};
struct EpiGlu {
    static constexpr bool PERM = false, AFTER_DRAIN = false;
    const bf16_t* base; bf16_t* out; rs_t* rs; int ldc;
    __device__ __forceinline__ void operator()(const f32x4 (&acc)[2][2][4][2], const Unit& u, int wr, int wc, int fr, int fq) const {
        constexpr int PD = 3;
        const int row0 = u.pm * BM + wr * 64 + fr, col0 = u.pn * HALF + wc * 32 + 4 * fq;
        u32x2 nb[8][2];
#define EPI_LD(g) do { const size_t o_ = (size_t)(row0 + ((g) >> 2) * HALF + ((g) & 3) * 16) * ldc + col0; _Pragma("unroll") for (int n = 0; n < 2; ++n) nb[g][n] = *(const u32x2*)(base + o_ + n * 16); } while (0)
#pragma unroll
        for (int g = 0; g < PD; ++g) EPI_LD(g);
#pragma unroll
        for (int gi = 0; gi < 8; ++gi) { const int ai = gi >> 2, m = gi & 3; const int row = row0 + ai * HALF + m * 16; const size_t off = (size_t)row * ldc + col0;
            if (gi + PD < 8) EPI_LD(gi + PD);
            float ss = 0.f;
#pragma unroll
            for (int n = 0; n < 2; ++n) { const f32x4 a = acc[ai][0][m][n], g = acc[ai][1][m][n]; f32x4 o = bf4_to_f32(nb[gi][n]);
#pragma unroll
                for (int j = 0; j < 4; ++j) o[j] += a[j] * sigm(g[j]);
                ss += (o[0] * o[0] + o[1] * o[1]) + (o[2] * o[2] + o[3] * o[3]);
                u32x2 w; w.x = cvt_pk_bf16(o[0], o[1]); w.y = cvt_pk_bf16(o[2], o[3]); *(u32x2*)(out + off + n * 16) = w; }
            row_ss_add(rs, row, ss, fq); }
#undef EPI_LD
    }
};

constexpr int S5T = 32, S5NCH = 512, S5KS = 768;
struct S5Order {
    int G, c, MT, NT;
    __device__ __forceinline__ bool next(int i, Unit& u) const { const int idx = i * G + c; if (idx >= 256 * MT * NT) return false; const int g = idx & 255, sub = idx >> 8;
        u.pm = g * MT + sub / NT; u.pn = g * NT + sub % NT; return true; }
    __device__ __forceinline__ void a_ready(const Unit&) const {}
    __device__ __forceinline__ void done(const Unit&) const {}
};
struct EpiS5U {
    static constexpr bool PERM = true, AFTER_DRAIN = false;
    bf16_t* UA; const rs_t* rs;
    __device__ __forceinline__ void operator()(const f32x4 (&acc)[2][2][4][2], const Unit& u, int wr, int wc, int fr, int fq) const {
        const int row0 = u.pm * BM + wr * 64 + fr, col0 = u.pn * BM + wc * 32 + 8 * fq;
        rs_t scv[8];
#pragma unroll
        for (int gi = 0; gi < 8; ++gi) scv[gi] = rs[row0 + (gi >> 2) * HALF + (gi & 3) * 16];
        PIN8(scv);
#pragma unroll
        for (int ai = 0; ai < 2; ++ai)
#pragma unroll
            for (int m = 0; m < 4; ++m) { const int t = row0 + ai * HALF + m * 16, c = t >> 5, sg = t & 31; const float sc = rs_rinv(scv[ai * 4 + m]);
#pragma unroll
                for (int bj = 0; bj < 2; ++bj) { const int col = col0 + bj * HALF, g = col >> 4, q0 = col & 15;
                    const f32x4 v0 = acc[ai][bj][m][0] * sc, v1 = acc[ai][bj][m][1] * sc;
                    u32x4 w; w.x = cvt_pk_bf16(v0[0], v0[1]); w.y = cvt_pk_bf16(v0[2], v0[3]); w.z = cvt_pk_bf16(v1[0], v1[1]); w.w = cvt_pk_bf16(v1[2], v1[3]);
                    *(u32x4*)(UA + ((size_t)(g * S5NCH + c) * S5KS + sg * 16 + q0)) = w; } }
    }
};
struct EpiS5E {
    static constexpr bool PERM = false, AFTER_DRAIN = false;
    float* E;
    __device__ __forceinline__ void operator()(const f32x4 (&acc)[2][2][4][2], const Unit& u, int wr, int wc, int fr, int fq) const {
        const int row0 = u.pm * BM + wr * 64 + fr, col0 = wc * 32 + 4 * fq;
#pragma unroll
        for (int ai = 0; ai < 2; ++ai)
#pragma unroll
            for (int m = 0; m < 4; ++m) { float* rowp = E + (size_t)(row0 + ai * HALF + m * 16) * 256 + col0;
#pragma unroll
                for (int bj = 0; bj < 2; ++bj)
#pragma unroll
                    for (int n = 0; n < 2; ++n) *(f32x4*)(rowp + bj * HALF + n * 16) = acc[ai][bj][m][n]; }
    }
};
__device__ __forceinline__ float gelu_tanh_f(float v) {
    const float z = 0.7978845608028654f * (v + 0.044715f * v * v * v);
    const float e = __builtin_amdgcn_exp2f(2.0f * 1.4426950408889634f * z);
    return 0.5f * v * (2.0f - 2.0f * __builtin_amdgcn_rcpf(e + 1.0f));
}
struct EpiS5Y {
    static constexpr bool PERM = true, AFTER_DRAIN = false;
    const bf16_t* UA; const float* dskip; bf16_t* G; int ldg;
    __device__ __forceinline__ void operator()(const f32x4 (&acc)[2][2][4][2], const Unit& u, int wr, int wc, int fr, int fq) const {
        const int row0 = u.pm * BM + wr * 64 + fr, col0 = (u.pn & 1) * BM + wc * 32 + 8 * fq;
        const int g = u.pm >> 1, p0 = col0 & 15;
        const f32x4 d0 = *(const f32x4*)(dskip + 16 * g + p0), d1 = *(const f32x4*)(dskip + 16 * g + p0 + 4);
        u32x4 uu[8][2];
#pragma unroll
        for (int gi = 0; gi < 8; ++gi)
#pragma unroll
            for (int bj = 0; bj < 2; ++bj) uu[gi][bj] = *(const u32x4*)(UA + ((size_t)(row0 + (gi >> 2) * HALF + (gi & 3) * 16) * S5KS + col0 + bj * HALF));
#pragma unroll
        for (int gi = 0; gi < 8; ++gi) asm volatile("" : "+v"(uu[gi][0]), "+v"(uu[gi][1]));
#pragma unroll
        for (int gi = 0; gi < 8; ++gi) { const int ai = gi >> 2, m = gi & 3; const int rowg = row0 + ai * HALF + m * 16, c = rowg & 511;
#pragma unroll
            for (int bj = 0; bj < 2; ++bj) { const int col = col0 + bj * HALF, tau = col >> 4; const u32x4 w4 = uu[gi][bj];
                f32x4 v0 = acc[ai][bj][m][0], v1 = acc[ai][bj][m][1];
                v0[0] += d0[0] * __builtin_bit_cast(float, w4.x << 16); v0[1] += d0[1] * __builtin_bit_cast(float, w4.x & 0xffff0000u);
                v0[2] += d0[2] * __builtin_bit_cast(float, w4.y << 16); v0[3] += d0[3] * __builtin_bit_cast(float, w4.y & 0xffff0000u);
                v1[0] += d1[0] * __builtin_bit_cast(float, w4.z << 16); v1[1] += d1[1] * __builtin_bit_cast(float, w4.z & 0xffff0000u);
                v1[2] += d1[2] * __builtin_bit_cast(float, w4.w << 16); v1[3] += d1[3] * __builtin_bit_cast(float, w4.w & 0xffff0000u);
#pragma unroll
                for (int j = 0; j < 4; ++j) { v0[j] = gelu_tanh_f(v0[j]); v1[j] = gelu_tanh_f(v1[j]); }
                int w0 = __builtin_amdgcn_cvt_pk_fp8_f32(16.f * v0[0], 16.f * v0[1], 0, false); w0 = __builtin_amdgcn_cvt_pk_fp8_f32(16.f * v0[2], 16.f * v0[3], w0, true);
                int w1 = __builtin_amdgcn_cvt_pk_fp8_f32(16.f * v1[0], 16.f * v1[1], 0, false); w1 = __builtin_amdgcn_cvt_pk_fp8_f32(16.f * v1[2], 16.f * v1[3], w1, true);
                *(v2u*)((unsigned char*)G + (size_t)(32 * c + tau) * ldg + 16 * g + p0) = (v2u){(unsigned)w0, (unsigned)w1}; } }
    }
};

template <class Epi, class Sched, bool ALIGN_EPI = false, bool SP2 = false, bool FP8 = false>
__device__ __forceinline__ void gemm_phase(PG8_LAS unsigned char* lds, const Gemm g, const Sched& S, const Epi& E) {
    int tid_o = wg_tid(); asm volatile("" : "+v"(tid_o)); const int tid = tid_o, wid = __builtin_amdgcn_readfirstlane(tid >> 6), lane = tid & 63, wr = wid >> 2, wc = wid & 3, fr = lane & 15, fq = lane >> 4;
    const int K = g.K, nt = K / BK;
    unsigned voffA[2], voffB[2];
#pragma unroll
    for (int i = 0; i < 2; ++i) { int R, C; stage_rc(tid * 16 + i * 8192, R, C); const int Rb = Epi::PERM ? ((R & ~31) + perm32(R & 31)) : R;
        voffA[i] = (unsigned)(R * g.lda + C) * 2u; voffB[i] = (unsigned)(Rb * g.ldb + C) * 2u; }
    const size_t kstep = (size_t)(BK * 2);
    const size_t hstepA = (size_t)HALF * g.lda * 2, hstepB = (size_t)HALF * g.ldb * 2;
    const size_t tstepA = 2 * hstepA, tstepB = 2 * hstepB;
    const unsigned ldsw = (unsigned)wid * 1024u;
    const int aoff = lds_byte(wr * 64 + fr, fq * 8), boff = lds_byte(wc * 32 + fr, fq * 8);
    const int aoff8 = lds_byte(wr * 64 + fr, fq * 16), boff8 = lds_byte(wc * 32 + fr, fq * 16);
#define PG8_SA(b, h) (((b) * 2 + (h)) * HTB)
#define PG8_SB(b, h) ((4 + (b) * 2 + (h)) * HTB)
#define PG8_STAGE(bufoff, gbase, voff) do { _Pragma("unroll") for (int _i = 0; _i < 2; ++_i) \
        __builtin_amdgcn_global_load_lds((const unsigned*)((const char*)(gbase) + (voff)[_i]), (PG8_LAS unsigned*)(lds + (bufoff) + ldsw + _i * 8192), 16, 0, 0); } while (0)
#define PG8_LDA(dst, b, h) do { if constexpr (FP8) { _Pragma("unroll") for (int m = 0; m < 4; ++m) { const PG8_LAS unsigned char* p_ = lds + PG8_SA(b, h) + aoff8 + m * 2048; const v4i32 l_ = *(const PG8_LAS v4i32*)p_, h_ = *(const PG8_LAS v4i32*)(p_ + 16); \
        dst##8[m] = __builtin_shufflevector(l_, h_, 0, 1, 2, 3, 4, 5, 6, 7); } } else { \
        _Pragma("unroll") for (int m = 0; m < 4; ++m) _Pragma("unroll") for (int k = 0; k < 2; ++k) dst[m][k] = *(const PG8_LAS bf16x8*)(lds + PG8_SA(b, h) + aoff + m * 2048 + k * 1024); } } while (0)
#define PG8_LDB(dst, b, h) do { if constexpr (FP8) { _Pragma("unroll") for (int n = 0; n < 2; ++n) { const PG8_LAS unsigned char* p_ = lds + PG8_SB(b, h) + boff8 + n * 2048; const v4i32 l_ = *(const PG8_LAS v4i32*)p_, h_ = *(const PG8_LAS v4i32*)(p_ + 16); \
        dst##8[n] = __builtin_shufflevector(l_, h_, 0, 1, 2, 3, 4, 5, 6, 7); } } else { \
        _Pragma("unroll") for (int n = 0; n < 2; ++n) _Pragma("unroll") for (int k = 0; k < 2; ++k) dst[n][k] = *(const PG8_LAS bf16x8*)(lds + PG8_SB(b, h) + boff + n * 2048 + k * 1024); } } while (0)
#define PG8_MMA(ai, bj, At, Bt) do { __builtin_amdgcn_s_setprio(1); if constexpr (FP8) { _Pragma("unroll") for (int m = 0; m < 4; ++m) _Pragma("unroll") for (int n = 0; n < 2; ++n) \
        asm volatile("v_mfma_scale_f32_16x16x128_f8f6f4 %0, %1, %2, %0, %3, %4 op_sel_hi:[0,0,0]" : "+v"(acc[ai][bj][m][n]) : "v"(Bt##8[n]), "v"(At##8[m]), "v"(sc_w8), "v"(sc_a8)); } else { \
        _Pragma("unroll") for (int m = 0; m < 4; ++m) _Pragma("unroll") for (int n = 0; n < 2; ++n) _Pragma("unroll") for (int k = 0; k < 2; ++k) \
        acc[ai][bj][m][n] = __builtin_amdgcn_mfma_f32_16x16x32_bf16(Bt[n][k], At[m][k], acc[ai][bj][m][n], 0, 0, 0); } __builtin_amdgcn_s_setprio(0); } while (0)
#define PG8_WAIT_V(n) asm volatile("s_waitcnt vmcnt(" #n ")" ::: "memory")
#define PG8_WAIT_L(n) asm volatile("s_waitcnt lgkmcnt(" #n ")" ::: "memory")
#define PG8_BAR __builtin_amdgcn_s_barrier()
#define PG8_SCHED __builtin_amdgcn_sched_barrier(0)
    Unit cur, nxt; int ui = 0;
    if (!S.next(0, cur)) return;
    f32x4 acc[2][2][4][2];
#pragma unroll
    for (int a = 0; a < 2; ++a)
#pragma unroll
        for (int b = 0; b < 2; ++b)
#pragma unroll
            for (int m = 0; m < 4; ++m)
#pragma unroll
                for (int n = 0; n < 2; ++n) acc[a][b][m][n] = (f32x4){0.f, 0.f, 0.f, 0.f};
    bf16x8 At[4][2], B0[2][2], B1[2][2];
    typedef int v8i32 __attribute__((ext_vector_type(8))); typedef int v4i32 __attribute__((ext_vector_type(4))); v8i32 At8[4], B08[2], B18[2];
    const int sc_w8 = 0x79797979, sc_a8 = g.sa;
    const char* cA = (const char*)g.A + (size_t)cur.pm * tstepA; const char* cB = (const char*)g.Bt + (size_t)cur.pn * tstepB;
    S.a_ready(cur);
    if constexpr (SP2) {
        PG8_STAGE(PG8_SB(0, 0), cB, voffB); PG8_STAGE(PG8_SB(0, 1), cB + hstepB, voffB); PG8_STAGE(PG8_SA(0, 0), cA, voffA); PG8_STAGE(PG8_SA(0, 1), cA + hstepA, voffA);
        if (wr == 1) PG8_BAR;
        PG8_WAIT_V(2); PG8_BAR;
        PG8_STAGE(PG8_SB(1, 0), cB + kstep, voffB); PG8_STAGE(PG8_SA(1, 0), cA + kstep, voffA); PG8_STAGE(PG8_SB(1, 1), cB + hstepB + kstep, voffB);
        PG8_WAIT_V(6); PG8_BAR;
    } else {
        PG8_STAGE(PG8_SB(0, 0), cB, voffB); PG8_STAGE(PG8_SA(0, 0), cA, voffA); PG8_STAGE(PG8_SB(0, 1), cB + hstepB, voffB); PG8_STAGE(PG8_SA(0, 1), cA + hstepA, voffA);
        if (wr == 1) PG8_BAR;
        PG8_WAIT_V(4); PG8_BAR;
        PG8_STAGE(PG8_SB(1, 0), cB + kstep, voffB); PG8_STAGE(PG8_SA(1, 0), cA + kstep, voffA); PG8_STAGE(PG8_SB(1, 1), cB + hstepB + kstep, voffB);
        PG8_WAIT_V(6); PG8_BAR;
    }
    for (;;) {
        const bool has_next = S.next(ui + 1, nxt);
        const char* nA = has_next ? (const char*)g.A + (size_t)nxt.pm * tstepA : cA; const char* nB = has_next ? (const char*)g.Bt + (size_t)nxt.pn * tstepB : cB;
        for (int t = 0; t < nt; t += 2) {
            const bool last = (t == nt - 2);
            const char* a1 = cA + (size_t)(t + 1) * kstep;
            const char* a2 = last ? nA : cA + (size_t)(t + 2) * kstep; const char* b2 = last ? nB : cB + (size_t)(t + 2) * kstep;
            const char* a3 = a2 + kstep; const char* b3 = b2 + kstep;
            if (last && has_next) S.a_ready(nxt);
            if constexpr (SP2) {
            PG8_LDB(B0, 0, 0); PG8_LDB(B1, 0, 1); PG8_SCHED; PG8_LDA(At, 0, 0); PG8_STAGE(PG8_SA(1, 1), a1 + hstepA, voffA);
            PG8_WAIT_V(8); PG8_WAIT_L(0); PG8_BAR; PG8_MMA(0, 0, At, B0); PG8_MMA(0, 1, At, B1); PG8_BAR; PG8_SCHED;
            PG8_LDA(At, 0, 1); PG8_STAGE(PG8_SB(0, 0), b2, voffB); PG8_STAGE(PG8_SB(0, 1), b2 + hstepB, voffB); PG8_STAGE(PG8_SA(0, 0), a2, voffA);
            PG8_WAIT_V(8); PG8_WAIT_L(0); PG8_BAR; PG8_MMA(1, 0, At, B0); PG8_MMA(1, 1, At, B1); PG8_BAR; PG8_SCHED;
            PG8_LDB(B0, 1, 0); PG8_LDB(B1, 1, 1); PG8_SCHED; PG8_LDA(At, 1, 0); PG8_STAGE(PG8_SA(0, 1), a2 + hstepA, voffA);
            PG8_WAIT_V(8); PG8_WAIT_L(0); PG8_BAR; PG8_MMA(0, 0, At, B0); PG8_MMA(0, 1, At, B1); PG8_BAR; PG8_SCHED;
            PG8_LDA(At, 1, 1); PG8_STAGE(PG8_SB(1, 0), b3, voffB); PG8_STAGE(PG8_SB(1, 1), b3 + hstepB, voffB); PG8_STAGE(PG8_SA(1, 0), a3, voffA);
            PG8_WAIT_V(8); PG8_WAIT_L(0); PG8_BAR; PG8_MMA(1, 0, At, B0); PG8_MMA(1, 1, At, B1); PG8_BAR; PG8_SCHED;
            } else {
            PG8_LDB(B0, 0, 0); PG8_SCHED; PG8_LDA(At, 0, 0); PG8_STAGE(PG8_SA(1, 1), a1 + hstepA, voffA);
            PG8_WAIT_L(8); PG8_BAR; PG8_WAIT_L(0); PG8_MMA(0, 0, At, B0); PG8_BAR; PG8_SCHED;
            PG8_LDB(B1, 0, 1); PG8_STAGE(PG8_SB(0, 0), b2, voffB);
            PG8_BAR; PG8_WAIT_L(0); PG8_MMA(0, 1, At, B1); PG8_BAR;
            PG8_LDA(At, 0, 1); PG8_STAGE(PG8_SA(0, 0), a2, voffA);
            PG8_BAR; PG8_WAIT_L(0); PG8_MMA(1, 0, At, B0); PG8_BAR; PG8_SCHED;
            PG8_STAGE(PG8_SB(0, 1), b2 + hstepB, voffB);
            PG8_WAIT_V(6); PG8_BAR; PG8_MMA(1, 1, At, B1); PG8_BAR;
            PG8_LDB(B0, 1, 0); PG8_SCHED; PG8_LDA(At, 1, 0); PG8_STAGE(PG8_SA(0, 1), a2 + hstepA, voffA);
            PG8_WAIT_L(8); PG8_BAR; PG8_WAIT_L(0); PG8_MMA(0, 0, At, B0); PG8_BAR; PG8_SCHED;
            PG8_LDB(B1, 1, 1); PG8_STAGE(PG8_SB(1, 0), b3, voffB);
            PG8_BAR; PG8_WAIT_L(0); PG8_MMA(0, 1, At, B1); PG8_BAR;
            PG8_LDA(At, 1, 1); PG8_STAGE(PG8_SA(1, 0), a3, voffA);
            PG8_BAR; PG8_WAIT_L(0); PG8_MMA(1, 0, At, B0); PG8_BAR; PG8_SCHED;
            PG8_STAGE(PG8_SB(1, 1), b3 + hstepB, voffB);
            PG8_WAIT_V(6); PG8_BAR; PG8_MMA(1, 1, At, B1); PG8_BAR;
            }
        }
        if constexpr (FP8) asm volatile("s_nop 15\n\ts_nop 7" ::: "memory");
        if constexpr (ALIGN_EPI) { if (wr == 0) PG8_BAR; }
        if constexpr (!Epi::AFTER_DRAIN) { E(acc, cur, wr, wc, fr, fq); PROBE_EPI_DUP S.done(cur); }
        if (!has_next) break;
#pragma unroll
        for (int a = 0; a < 2; ++a)
#pragma unroll
            for (int b = 0; b < 2; ++b)
#pragma unroll
                for (int m = 0; m < 4; ++m)
#pragma unroll
                    for (int n = 0; n < 2; ++n) acc[a][b][m][n] = (f32x4){0.f, 0.f, 0.f, 0.f};
        cur = nxt; cA = nA; cB = nB; ++ui;
        if constexpr (ALIGN_EPI) { if (wr == 1) PG8_BAR; }
    }
    PG8_WAIT_V(0);
    if constexpr (!ALIGN_EPI) { if (wr == 0) PG8_BAR; }
    PG8_BAR;
    if constexpr (Epi::AFTER_DRAIN) { E.fused(acc, cur, wr, wc, fr, fq, lds, wid, lane); S.done(cur); }
#undef PG8_SA
#undef PG8_SB
#undef PG8_STAGE
#undef PG8_LDA
#undef PG8_LDB
#undef PG8_MMA
#undef PG8_WAIT_V
#undef PG8_WAIT_L
#undef PG8_BAR
#undef PG8_SCHED
}
}
#define XB_TMO      128
#define XB_XCNT(j)  (256  + 64 * (j))
#define XB_XSUB(j)  (1280 + 64 * (j))
#define XB_XGEN(j)  (2304 + 64 * (j))
#define XB_TOP      3328
#define XB_TOPGEN   3392
#define XCD_BAR_WORDS 3456
#define XB_SPIN_CAP (1u << 18)

__device__ __forceinline__ unsigned xb_ld(unsigned* p)              { return __hip_atomic_load(p, __ATOMIC_RELAXED, __HIP_MEMORY_SCOPE_AGENT); }
__device__ __forceinline__ unsigned xb_add(unsigned* p, unsigned v) { return __hip_atomic_fetch_add(p, v, __ATOMIC_RELAXED, __HIP_MEMORY_SCOPE_AGENT); }
__device__ __forceinline__ unsigned xb_xcc_id() { return (unsigned)__builtin_amdgcn_s_getreg((3 << 11) | 20) & 0xFu; }
#define XB_SPIN(cond, bar) do { unsigned _sp = 0; while (cond) { __builtin_amdgcn_s_sleep(1); \
    if ((++_sp & 255u) == 0u) { if (xb_ld(&(bar)[XB_TMO])) break; if (_sp > XB_SPIN_CAP) { atomicAdd(&(bar)[XB_TMO], 1u); break; } } } } while (0)

struct XcdBarrier {
    unsigned* bar; unsigned x;
    volatile LAS unsigned* st;
};

__device__ __forceinline__ XcdBarrier xcd_barrier_post(unsigned* bar, volatile LAS unsigned* st) {
    XcdBarrier b; b.bar = bar; b.x = xb_xcc_id(); b.st = st;
    if (wg_tid() == 0) (void)xb_add(&bar[XB_XCNT(b.x)], 1u);
    return b;
}
__device__ __forceinline__ void xcd_barrier_complete(unsigned* bar, unsigned x, unsigned& nloc, unsigned& nx) {
    const unsigned G = gridDim.x * gridDim.y * gridDim.z;
    unsigned sum, cnt, mine, sp = 0u;
    for (;;) {
        sum = 0u; cnt = 0u; mine = 0u;
#pragma unroll
        for (unsigned j = 0; j < 16; ++j) { const unsigned c = xb_ld(&bar[XB_XCNT(j)]); sum += c; cnt += (c > 0u) ? 1u : 0u; mine = (j == x) ? c : mine; }
        if (sum == G) break;
        __builtin_amdgcn_s_sleep(1);
        if ((++sp & 255u) == 0u) { if (xb_ld(&bar[XB_TMO])) break; if (sp > XB_SPIN_CAP) { atomicAdd(&bar[XB_TMO], 1u); break; } }
    }
    nloc = mine > 0u ? mine : 1u; nx = cnt > 0u ? cnt : 1u;
}

__device__ __forceinline__ void xcd_barrier(const XcdBarrier& b) {
    asm volatile("s_waitcnt vmcnt(0)" ::: "memory");
    __syncthreads();
    if (wg_tid() == 0) {
        unsigned* bar = b.bar;
        __builtin_amdgcn_s_waitcnt(0);
        unsigned nloc = b.st[0], nx = b.st[1];
        if (nloc == 0u) { xcd_barrier_complete(bar, b.x, nloc, nx); b.st[0] = nloc; b.st[1] = nx; }
        const unsigned old = xb_add(&bar[XB_XSUB(b.x)], 1u);
        const unsigned gen = old / nloc;
        if (old + 1u == (gen + 1u) * nloc) {
            __builtin_amdgcn_fence(__ATOMIC_RELEASE, "agent");
            asm volatile("s_waitcnt vmcnt(0)" ::: "memory");
            const unsigned og = xb_add(&bar[XB_TOP], 1u);
            const unsigned tg = og / nx;
            if (og + 1u == (tg + 1u) * nx) xb_add(&bar[XB_TOPGEN], 1u);
            else XB_SPIN(xb_ld(&bar[XB_TOPGEN]) == tg, bar);
            __builtin_amdgcn_fence(__ATOMIC_ACQUIRE, "agent");
            xb_add(&bar[XB_XGEN(b.x)], 1u);
            asm volatile("s_waitcnt vmcnt(0)" ::: "memory");
        } else {
            XB_SPIN(xb_ld(&bar[XB_XGEN(b.x)]) == gen, bar);
            __builtin_amdgcn_fence(__ATOMIC_ACQUIRE, "agent");
            asm volatile("s_waitcnt vmcnt(0)" ::: "memory");
        }
    }
    __syncthreads();
}
namespace dattn {
typedef unsigned short bf16;
constexpr int   D = 128, NW = 8, QBLK = 32, KVBLK = 64;
constexpr float SCALE = 0.088388347648318440f;
constexpr float THR = 8.f;
constexpr int SDEPTH = 2;
constexpr int LDQ = 4096, LDK = 1024, LDO = 4096;
constexpr size_t SHM_V = KVBLK * D * 2, SHM_K = KVBLK * D * 2, SHM_ATTN = 3 * SHM_V + 3 * SHM_K + NW * 64 * 4 + 2048;
using bf16x8 = __attribute__((ext_vector_type(8))) short;
using s16x4  = __attribute__((ext_vector_type(4))) short;
using f32x16 = __attribute__((ext_vector_type(16))) float;
using f32x8  = __attribute__((ext_vector_type(8))) float;
using u32x4  = __attribute__((ext_vector_type(4))) unsigned;
#define KSWZ(row, colB) ((row) * 256 + ((colB) ^ (((row) & 7) << 4)))
#define SBAR() __builtin_amdgcn_sched_barrier(0)
__device__ __forceinline__ int crow(int r, int hi) { return (r & 3) + 8 * (r >> 2) + 4 * hi; }
__device__ __forceinline__ unsigned cvtpk(float lo, float hi) {
  unsigned r; asm volatile("v_cvt_pk_bf16_f32 %0, %1, %2" : "=v"(r) : "v"(lo), "v"(hi)); return r;
}
template <typename TIn> struct Stage;
template <> struct Stage<bf16>  { using T = bf16x8;
  __device__ static __forceinline__ T ld8(const bf16* p) { return *reinterpret_cast<const bf16x8*>(p); }
  __device__ static __forceinline__ bf16x8 tobf(T x) { return x; } };
template <> struct Stage<float> { using T = f32x8;
  __device__ static __forceinline__ T ld8(const float* p) { return *reinterpret_cast<const f32x8*>(p); }
  __device__ static __forceinline__ bf16x8 tobf(T x) {
    u32x4 w = {cvtpk(x[0], x[1]), cvtpk(x[2], x[3]), cvtpk(x[4], x[5]), cvtpk(x[6], x[7])}; return *reinterpret_cast<bf16x8*>(&w); } };

__device__ __forceinline__ void partialSM(f32x16& p0, f32x16& p1, float& m_reg, float& mn, float& alpha) {
  constexpr float C = SCALE * 1.4426950408889634f;
  float pmax = p0[0]; for (int r = 1; r < 16; ++r) pmax = fmaxf(pmax, p0[r]); for (int r = 0; r < 16; ++r) pmax = fmaxf(pmax, p1[r]);
  { auto rr = __builtin_amdgcn_permlane32_swap(__float_as_uint(pmax), __float_as_uint(pmax), false, false);
    pmax = fmaxf(__uint_as_float(rr[0]), __uint_as_float(rr[1])); }
  if (__builtin_expect(__all(pmax - m_reg <= THR / SCALE), 1)) { mn = m_reg; alpha = 1.f; }
  else { mn = fmaxf(m_reg, pmax); alpha = __builtin_amdgcn_exp2f((m_reg - mn) * C); m_reg = mn; }
  float mnC = -mn * C;
  for (int r = 0; r < 16; ++r) p0[r] = fmaf(p0[r], C, mnC); for (int r = 0; r < 16; ++r) p1[r] = fmaf(p1[r], C, mnC);
  for (int r = 0; r < 16; ++r) p0[r] = __builtin_amdgcn_exp2f(p0[r]);
}
__device__ __forceinline__ void finishSM(f32x16& p0, f32x16& p1, float alpha, float& l_reg, bf16x8& pa0, bf16x8& pa1, bf16x8& pa2, bf16x8& pa3) {
  for (int r = 0; r < 16; ++r) p1[r] = __builtin_amdgcn_exp2f(p1[r]);
  float ps = 0; for (int r = 0; r < 16; ++r) ps += p0[r]; for (int r = 0; r < 16; ++r) ps += p1[r];
  { auto rr = __builtin_amdgcn_permlane32_swap(__float_as_uint(ps), __float_as_uint(ps), false, false);
    ps = __uint_as_float(rr[0]) + __uint_as_float(rr[1]); }
  l_reg = l_reg * alpha + ps;
#define PK4(P, BASE, OUT) do { unsigned a0 = cvtpk(P[BASE + 0], P[BASE + 1]), a1 = cvtpk(P[BASE + 2], P[BASE + 3]);   \
    unsigned b0 = cvtpk(P[BASE + 4], P[BASE + 5]), b1 = cvtpk(P[BASE + 6], P[BASE + 7]);                              \
    auto r0 = __builtin_amdgcn_permlane32_swap(a0, b0, false, false); auto r1 = __builtin_amdgcn_permlane32_swap(a1, b1, false, false); \
    u32x4 w = {r0[0], r1[0], r0[1], r1[1]}; OUT = *reinterpret_cast<bf16x8*>(&w); } while (0)
  PK4(p0, 0, pa0); PK4(p0, 8, pa1); PK4(p1, 0, pa2); PK4(p1, 8, pa3);
#undef PK4
}
__device__ __forceinline__ void qkt(f32x16& p0, f32x16& p1, const bf16* Ks, const bf16x8* qr, int r32, int hi) {
  p0 = f32x16{}; p1 = f32x16{};
  bf16x8 nb0 = *reinterpret_cast<const bf16x8*>((const char*)Ks + KSWZ(r32, (hi * 8) * 2)), nb1 = *reinterpret_cast<const bf16x8*>((const char*)Ks + KSWZ(32 + r32, (hi * 8) * 2));
#pragma unroll
  for (int d0 = 0; d0 < 8; ++d0) { const bf16x8 b0 = nb0, b1 = nb1;
    if (d0 < 7) { const int cb = ((d0 + 1) * 16 + hi * 8) * 2;
      nb0 = *reinterpret_cast<const bf16x8*>((const char*)Ks + KSWZ(r32, cb)); nb1 = *reinterpret_cast<const bf16x8*>((const char*)Ks + KSWZ(32 + r32, cb)); }
    p0 = __builtin_amdgcn_mfma_f32_32x32x16_bf16(b0, qr[d0], p0, 0, 0, 0);
    p1 = __builtin_amdgcn_mfma_f32_32x32x16_bf16(b1, qr[d0], p1, 0, 0, 0); }
}
__device__ __forceinline__ int v_st(int k, int c) { const int kk = (k & ~0xC) | ((k & 4) << 1) | ((k & 8) >> 1); return ((kk >> 3) * 4 + (c >> 5)) * 512 + ((kk & 7) * 32 + (c & 31)) * 2; }
__device__ __forceinline__ int v_rd_base(int lane) { return ((lane & 3) << 3) | (((lane >> 2) & 3) << 6) | (((lane >> 4) & 1) << 5) | (((lane >> 5) & 1) << 8); }
constexpr int v_rd_off(int d0, int ks, int half) { return d0 * 512 + ks * 4096 + half * 2048; }
template <int OFF> __device__ __forceinline__ s16x4 tr_read(int vb) {
  s16x4 r; asm volatile("ds_read_b64_tr_b16 %0, %1 offset:%2" : "=&v"(r) : "v"(vb), "i"(OFF) : "memory"); return r;
}
template <int D0> __device__ __forceinline__ void pv_one(f32x16& od, int vb, bf16x8 pa0, bf16x8 pa1, bf16x8 pa2, bf16x8 pa3) {
  const s16x4 l0 = tr_read<v_rd_off(D0, 0, 0)>(vb), h0 = tr_read<v_rd_off(D0, 0, 1)>(vb), l1 = tr_read<v_rd_off(D0, 1, 0)>(vb), h1 = tr_read<v_rd_off(D0, 1, 1)>(vb);
  const s16x4 l2 = tr_read<v_rd_off(D0, 2, 0)>(vb), h2 = tr_read<v_rd_off(D0, 2, 1)>(vb), l3 = tr_read<v_rd_off(D0, 3, 0)>(vb), h3 = tr_read<v_rd_off(D0, 3, 1)>(vb);
  asm volatile("s_waitcnt lgkmcnt(0)" ::: "memory"); SBAR();
#define PK(L, H) (bf16x8){L[0], L[1], L[2], L[3], H[0], H[1], H[2], H[3]}
  od = __builtin_amdgcn_mfma_f32_32x32x16_bf16(pa0, PK(l0, h0), od, 0, 0, 0);
  od = __builtin_amdgcn_mfma_f32_32x32x16_bf16(pa1, PK(l1, h1), od, 0, 0, 0);
  od = __builtin_amdgcn_mfma_f32_32x32x16_bf16(pa2, PK(l2, h2), od, 0, 0, 0);
  od = __builtin_amdgcn_mfma_f32_32x32x16_bf16(pa3, PK(l3, h3), od, 0, 0, 0);
#undef PK
}
__device__ __forceinline__ void pv_d0(f32x16* o, int vb, bf16x8 pa0, bf16x8 pa1, bf16x8 pa2, bf16x8 pa3) {
  pv_one<0>(o[0], vb, pa0, pa1, pa2, pa3); pv_one<1>(o[1], vb, pa0, pa1, pa2, pa3); pv_one<2>(o[2], vb, pa0, pa1, pa2, pa3); pv_one<3>(o[3], vb, pa0, pa1, pa2, pa3);
}

template <typename TQ>
__device__ __forceinline__ void attn_dense_body(const TQ* __restrict__ Qb, const bf16* __restrict__ Kh, const bf16* __restrict__ Vh,
                                                bf16* __restrict__ Ob, int seq, char* lds) {
  using St = Stage<bf16>; using SQ = Stage<TQ>;
  int tid_o = wg_tid(); asm volatile("" : "+v"(tid_o)); const int tid = tid_o, wid = __builtin_amdgcn_readfirstlane(tid >> 6), lane = tid & 63, r32 = lane & 31, hi = lane >> 5;
  bf16* V_lds = (bf16*)lds; bf16* K_lds = (bf16*)(lds + 3 * SHM_V);
  float* ws = (float*)(lds + 3 * SHM_V + 3 * SHM_K) + wid * 64; float* li_l = ws; float* al_l = ws + 32;
  float m_reg = -1e30f, l_reg = 0; f32x16 o[4] = {}; bf16x8 qr[8];
  const TQ* Qw = Qb + (long)(wid * QBLK + r32) * LDQ + hi * 8;
#pragma unroll
  for (int d0 = 0; d0 < 8; ++d0) qr[d0] = SQ::tobf(SQ::ld8(Qw + d0 * 16));
  const int sr = tid >> 4, sc = (tid & 15) * 8, vst0 = v_st(sr, sc), vst1 = v_st(32 + sr, sc);
  const int vb0 = (int)(uintptr_t)V_lds + v_rd_base(lane);
  struct { typename St::T vs0, vs1, ks0, ks1; } sr_[SDEPTH];
#define SLOAD(i, k0) do { sr_[i].vs0 = St::ld8(&Vh[(long)((k0) + sr) * LDK + sc]); sr_[i].vs1 = St::ld8(&Vh[(long)((k0) + 32 + sr) * LDK + sc]); \
    sr_[i].ks0 = St::ld8(&Kh[(long)((k0) + sr) * LDK + sc]); sr_[i].ks1 = St::ld8(&Kh[(long)((k0) + 32 + sr) * LDK + sc]); } while (0)
#define SWRITE(b, i) do { *(bf16x8*)((char*)V_lds + (b) * SHM_V + vst0) = St::tobf(sr_[i].vs0);          \
    *(bf16x8*)((char*)V_lds + (b) * SHM_V + vst1) = St::tobf(sr_[i].vs1); int kc = sc * 2;               \
    *(bf16x8*)((char*)K_lds + (b) * SHM_K + KSWZ(sr, kc)) = St::tobf(sr_[i].ks0);                       \
    *(bf16x8*)((char*)K_lds + (b) * SHM_K + KSWZ(32 + sr, kc)) = St::tobf(sr_[i].ks1); } while (0)
#define SWAIT() do { if constexpr (SDEPTH == 2) asm volatile("s_waitcnt vmcnt(4)" ::: "memory"); else asm volatile("s_waitcnt vmcnt(0)" ::: "memory"); } while (0)
#define RESC(a) do { if (__any((a) < 1.f)) { if (hi == 0) al_l[r32] = (a); asm volatile("s_waitcnt lgkmcnt(0)" ::: "memory"); \
    for (int d = 0; d < 4; ++d) for (int r = 0; r < 16; ++r) o[d][r] *= al_l[crow(r, hi)]; } } while (0)
  f32x16 pA0, pA1, pB0, pB1; float mnA, mnB, alA, alB; bf16x8 pa0, pa1, pa2, pa3; const int NT = seq / KVBLK;
  constexpr int SE = 0, SO = SDEPTH - 1;
  SLOAD(SE, 0); asm volatile("s_waitcnt vmcnt(0)" ::: "memory"); SWRITE(0, SE); __syncthreads();
  qkt(pA0, pA1, K_lds, qr, r32, hi); partialSM(pA0, pA1, m_reg, mnA, alA);
  SLOAD(SO, KVBLK); if constexpr (SDEPTH == 2) { if (2 < NT) SLOAD(SE, 2 * KVBLK); }
  SWAIT(); SWRITE(1, SO); __syncthreads();
  int bk = 1, bv = 0, bw = 2;
  if (wid >= 4) __builtin_amdgcn_s_setprio(1);
#define ROT3() do { const int t_ = bv; bv = bk; bk = bw; bw = t_; } while (0)
  for (int j = 1; j + 1 < NT; j += 2) {
    SBAR(); qkt(pB0, pB1, (bf16*)((char*)K_lds + bk * SHM_K), qr, r32, hi);
    finishSM(pA0, pA1, alA, l_reg, pa0, pa1, pa2, pa3); SBAR();
    SLOAD(SO, (j + SDEPTH) * KVBLK); SBAR();
    pv_d0(o, vb0 + bv * (int)SHM_V, pa0, pa1, pa2, pa3); partialSM(pB0, pB1, m_reg, mnB, alB);
    SWAIT(); SWRITE(bw, SE);
    RESC(alB); __syncthreads(); ROT3();
    SBAR(); qkt(pA0, pA1, (bf16*)((char*)K_lds + bk * SHM_K), qr, r32, hi);
    finishSM(pB0, pB1, alB, l_reg, pa0, pa1, pa2, pa3); SBAR();
    if (SDEPTH == 1 || j + 3 < NT) SLOAD(SE, (j + 1 + SDEPTH) * KVBLK); SBAR();
    pv_d0(o, vb0 + bv * (int)SHM_V, pa0, pa1, pa2, pa3); partialSM(pA0, pA1, m_reg, mnA, alA);
    SWAIT(); SWRITE(bw, SO);
    RESC(alA); __syncthreads(); ROT3();
  }
  SBAR(); qkt(pB0, pB1, (bf16*)((char*)K_lds + bk * SHM_K), qr, r32, hi);
  finishSM(pA0, pA1, alA, l_reg, pa0, pa1, pa2, pa3); SBAR();
  pv_d0(o, vb0 + bv * (int)SHM_V, pa0, pa1, pa2, pa3); partialSM(pB0, pB1, m_reg, mnB, alB);
  RESC(alB);
  finishSM(pB0, pB1, alB, l_reg, pa0, pa1, pa2, pa3); SBAR();
  pv_d0(o, vb0 + bk * (int)SHM_V, pa0, pa1, pa2, pa3);
#undef ROT3
  __builtin_amdgcn_s_setprio(0);
  if (hi == 0) li_l[r32] = l_reg; asm volatile("s_waitcnt lgkmcnt(0)" ::: "memory");
  float rli[16];
#pragma unroll
  for (int r = 0; r < 16; ++r) rli[r] = __builtin_amdgcn_rcpf(li_l[crow(r, hi)]);
  bf16* Ow = Ob + (long)(wid * QBLK) * LDO;
#pragma unroll
  for (int r = 0; r < 16; ++r) { int orow = crow(r, hi);
    for (int d0 = 0; d0 < 4; ++d0) Ow[(long)orow * LDO + d0 * 32 + r32] = (bf16)(cvtpk(o[d0][r] * rli[r], 0.f) & 0xffffu); }
#undef SLOAD
#undef SWRITE
#undef SWAIT
#undef RESC
}

constexpr int NA_LD = 4096, NA_TILES = 12;
__device__ __forceinline__ void na_block_body(const bf16* __restrict__ Qb, const bf16* __restrict__ Kh, const bf16* __restrict__ Vh, bf16* __restrict__ Ob,
                                              const float* __restrict__ rpb_h, const float* __restrict__ qgain, const float* __restrict__ kgain, int R, int ks, char* lds) {
  using St = Stage<bf16>;
  int tid_o = wg_tid(); asm volatile("" : "+v"(tid_o)); const int tid = tid_o, wid = __builtin_amdgcn_readfirstlane(tid >> 6), lane = tid & 63, r32 = lane & 31, hi = lane >> 5;
  bf16* V_lds = (bf16*)lds; bf16* K_lds = (bf16*)(lds + 2 * SHM_V);
  float* ws = (float*)(lds + 2 * SHM_V + 2 * SHM_K) + wid * 64; float* li_l = ws; float* al_l = ws + 32;
  float* bt = (float*)(lds + 2 * SHM_V + 2 * SHM_K + NW * 64 * 4);
  float m_reg = -1e30f, l_reg = 0; f32x16 o[4] = {}; bf16x8 qr[8];
  const bf16* Qw = Qb + (long)(wid * QBLK + r32) * NA_LD + hi * 8;
#pragma unroll
  for (int d0 = 0; d0 < 8; ++d0) qr[d0] = St::ld8(Qw + d0 * 16);
  {
    float ss = 0.f;
#pragma unroll
    for (int d0 = 0; d0 < 8; ++d0) { const u32x4 w = __builtin_bit_cast(u32x4, qr[d0]);
#pragma unroll
      for (int e = 0; e < 4; ++e) { const float a = __uint_as_float(w[e] << 16), b = __uint_as_float(w[e] & 0xffff0000u); ss += a * a + b * b; } }
    ss += __shfl_xor(ss, 32);
    const float rinv = __builtin_amdgcn_rsqf(ss * (1.0f / 128.0f) + 1e-6f);
#pragma unroll
    for (int d0 = 0; d0 < 8; ++d0) { const u32x4 w = __builtin_bit_cast(u32x4, qr[d0]); const float* gp = qgain + d0 * 16 + hi * 8;
      const f32x8 g = *reinterpret_cast<const f32x8*>(gp); u32x4 o;
#pragma unroll
      for (int e = 0; e < 4; ++e) o[e] = cvtpk(__uint_as_float(w[e] << 16) * rinv * g[2 * e], __uint_as_float(w[e] & 0xffff0000u) * rinv * g[2 * e + 1]);
      qr[d0] = __builtin_bit_cast(bf16x8, o); } }
  const f32x8 kg = *reinterpret_cast<const f32x8*>(kgain + (tid & 15) * 8);
  for (int i = tid; i < 15 * 31; i += 64 * NW) bt[i] = rpb_h[i];
  const int sr = tid >> 4, sc = (tid & 15) * 8, vst0 = v_st(sr, sc), vst1 = v_st(32 + sr, sc);
  const int vb0 = (int)(uintptr_t)V_lds + v_rd_base(lane);
  bf16x8 s_vs0, s_vs1, s_ks0, s_ks1;
#define NLOAD(k0) do { s_vs0 = St::ld8(&Vh[(long)((k0) + sr) * NA_LD + sc]); s_vs1 = St::ld8(&Vh[(long)((k0) + 32 + sr) * NA_LD + sc]); \
    s_ks0 = St::ld8(&Kh[(long)((k0) + sr) * NA_LD + sc]); s_ks1 = St::ld8(&Kh[(long)((k0) + 32 + sr) * NA_LD + sc]); } while (0)
#define KNORM(x) do { const u32x4 w_ = __builtin_bit_cast(u32x4, x); float a_[8]; float ss_ = 0.f; \
    _Pragma("unroll") for (int e = 0; e < 4; ++e) { a_[2 * e] = __uint_as_float(w_[e] << 16); a_[2 * e + 1] = __uint_as_float(w_[e] & 0xffff0000u); ss_ += a_[2 * e] * a_[2 * e] + a_[2 * e + 1] * a_[2 * e + 1]; } \
    ss_ += __shfl_xor(ss_, 1); ss_ += __shfl_xor(ss_, 2); ss_ += __shfl_xor(ss_, 4); ss_ += __shfl_xor(ss_, 8); \
    const float ri_ = __builtin_amdgcn_rsqf(ss_ * (1.0f / 128.0f) + 1e-6f); u32x4 o_; \
    _Pragma("unroll") for (int e = 0; e < 4; ++e) o_[e] = cvtpk(a_[2 * e] * ri_ * kg[2 * e], a_[2 * e + 1] * ri_ * kg[2 * e + 1]); \
    x = __builtin_bit_cast(bf16x8, o_); } while (0)
#define NWRITE(b) do { KNORM(s_ks0); KNORM(s_ks1); \
    *(bf16x8*)((char*)V_lds + (b) * SHM_V + vst0) = s_vs0; *(bf16x8*)((char*)V_lds + (b) * SHM_V + vst1) = s_vs1; const int kc_ = sc * 2; \
    *(bf16x8*)((char*)K_lds + (b) * SHM_K + KSWZ(sr, kc_)) = s_ks0; *(bf16x8*)((char*)K_lds + (b) * SHM_K + KSWZ(32 + sr, kc_)) = s_ks1; } while (0)
  const int qrow = R + (wid >> 1), r0q = min(max(qrow - 4, 0), 248), jlo = r0q - ks;
  const int c = 32 * (wid & 1) + r32, c0 = min(max(c - 8, 0), 48);
  NLOAD(0); asm volatile("s_waitcnt vmcnt(0)" ::: "memory"); NWRITE(0); __syncthreads();
  for (int j = 0; j < NA_TILES; ++j) {
    const int buf = j & 1;
    if (j + 1 < NA_TILES) NLOAD((j + 1) * KVBLK);
    if (j >= jlo && j < jlo + 8) {
      f32x16 p0, p1; float mn, al; bf16x8 pa0, pa1, pa2, pa3;
      SBAR(); qkt(p0, p1, (bf16*)((char*)K_lds + buf * SHM_K), qr, r32, hi);
      const float* brow = bt + (ks + j - qrow + 7) * 31 + (15 - c);
#pragma unroll
      for (int r = 0; r < 16; ++r) { const int k0 = crow(r, hi), k1 = 32 + k0; const bool v0 = (k0 >= c0) && (k0 < c0 + 16), v1 = (k1 >= c0) && (k1 < c0 + 16);
        const float b0 = brow[v0 ? k0 : c], b1 = brow[v1 ? k1 : c];
        p0[r] = v0 ? fmaf(b0, 1.0f / SCALE, p0[r]) : -1e30f; p1[r] = v1 ? fmaf(b1, 1.0f / SCALE, p1[r]) : -1e30f; }
      partialSM(p0, p1, m_reg, mn, al);
      if (__any(al < 1.f)) { if (hi == 0) al_l[r32] = al; asm volatile("s_waitcnt lgkmcnt(0)" ::: "memory");
#pragma unroll
        for (int d = 0; d < 4; ++d)
#pragma unroll
          for (int r = 0; r < 16; ++r) o[d][r] *= al_l[crow(r, hi)]; }
      finishSM(p0, p1, al, l_reg, pa0, pa1, pa2, pa3); SBAR();
      pv_d0(o, vb0 + buf * (int)SHM_V, pa0, pa1, pa2, pa3);
    }
    if (j + 1 < NA_TILES) { asm volatile("s_waitcnt vmcnt(0)" ::: "memory"); NWRITE(buf ^ 1); }
    __syncthreads();
  }
  if (hi == 0) li_l[r32] = l_reg; asm volatile("s_waitcnt lgkmcnt(0)" ::: "memory");
  float rli[16];
#pragma unroll
  for (int r = 0; r < 16; ++r) rli[r] = 64.0f * __builtin_amdgcn_rcpf(li_l[crow(r, hi)]);
  unsigned char* Ow = (unsigned char*)Ob + (long)(wid * QBLK) * NA_LD;
#pragma unroll
  for (int r = 0; r < 16; ++r) { const int orow = crow(r, hi);
    for (int d0 = 0; d0 < 4; ++d0) Ow[(long)orow * NA_LD + d0 * 32 + r32] = (unsigned char)__builtin_amdgcn_cvt_pk_fp8_f32(o[d0][r] * rli[r], 0.f, 0, false); }
#undef NLOAD
#undef NWRITE
#undef KNORM
}

typedef int v8i __attribute__((ext_vector_type(8)));
typedef unsigned u32x2 __attribute__((ext_vector_type(2)));
constexpr int K8_LD = 1024, V8_LD = 16384, SHM_K8 = KVBLK * D, SHM_V8 = KVBLK * D;
constexpr float THR8 = 3.0f;
__device__ __forceinline__ int cvt4_fp8(float a, float b, float c, float d) { int w = __builtin_amdgcn_cvt_pk_fp8_f32(a, b, 0, false); return __builtin_amdgcn_cvt_pk_fp8_f32(c, d, w, true); }
typedef short s16x2 __attribute__((ext_vector_type(2)));
__device__ __forceinline__ int cvt4_fp8_scl(int w, float a, float b, float c, float d, float scl) {
  s16x2 t = __builtin_bit_cast(s16x2, w); t = __builtin_amdgcn_cvt_scalef32_pk_fp8_f32(t, a, b, scl, false); t = __builtin_amdgcn_cvt_scalef32_pk_fp8_f32(t, c, d, scl, true); return __builtin_bit_cast(int, t); }
__device__ __forceinline__ v8i mk8(u32x4 lo, u32x4 hi) { return (v8i){(int)lo[0], (int)lo[1], (int)lo[2], (int)lo[3], (int)hi[0], (int)hi[1], (int)hi[2], (int)hi[3]}; }
__device__ __forceinline__ void qkt8(f32x16& p0, f32x16& p1, const char* Ks, const v8i* qf, int r32, int hi) {
  const int x0 = (r32 >> 1) & 7, x1 = ((32 + r32) >> 1) & 7;
  const char* k0 = Ks + r32 * 128; const char* k1 = Ks + (32 + r32) * 128;
  v8i a[2][2];
#pragma unroll
  for (int s = 0; s < 2; ++s) { const int c = 4 * s + 2 * hi;
    a[0][s] = mk8(*reinterpret_cast<const u32x4*>(k0 + 16 * (c ^ x0)), *reinterpret_cast<const u32x4*>(k0 + 16 * ((c + 1) ^ x0)));
    a[1][s] = mk8(*reinterpret_cast<const u32x4*>(k1 + 16 * (c ^ x1)), *reinterpret_cast<const u32x4*>(k1 + 16 * ((c + 1) ^ x1))); }
  p0 = f32x16{}; p1 = f32x16{};
#pragma unroll
  for (int s = 0; s < 2; ++s) {
    p0 = __builtin_amdgcn_mfma_scale_f32_32x32x64_f8f6f4(a[0][s], qf[s], p0, 0, 0, 0, 0x7F7F7F7F, 0, 0x7C7C7C7C);
    p1 = __builtin_amdgcn_mfma_scale_f32_32x32x64_f8f6f4(a[1][s], qf[s], p1, 0, 0, 0, 0x7F7F7F7F, 0, 0x7C7C7C7C); }
}
constexpr float THR2 = 4.0f;
__device__ __forceinline__ void partialSM8(f32x16& p0, f32x16& p1, float& m_reg, float& scl, float& alpha) {
  float pmax;
  asm("v_max3_f32 %0, %1, %2, %3\n\tv_max3_f32 %0, %0, %4, %5\n\tv_max3_f32 %0, %0, %6, %7\n\tv_max3_f32 %0, %0, %8, %9\n\tv_max3_f32 %0, %0, %10, %11\n\tv_max3_f32 %0, %0, %12, %13\n\tv_max3_f32 %0, %0, %14, %15\n\tv_max_f32 %0, %0, %16"
      : "=&v"(pmax) : "v"(p0[0]), "v"(p0[1]), "v"(p0[2]), "v"(p0[3]), "v"(p0[4]), "v"(p0[5]), "v"(p0[6]), "v"(p0[7]), "v"(p0[8]), "v"(p0[9]), "v"(p0[10]), "v"(p0[11]), "v"(p0[12]), "v"(p0[13]), "v"(p0[14]), "v"(p0[15]));
  asm("v_max3_f32 %0, %0, %1, %2\n\tv_max3_f32 %0, %0, %3, %4\n\tv_max3_f32 %0, %0, %5, %6\n\tv_max3_f32 %0, %0, %7, %8\n\tv_max3_f32 %0, %0, %9, %10\n\tv_max3_f32 %0, %0, %11, %12\n\tv_max3_f32 %0, %0, %13, %14\n\tv_max3_f32 %0, %0, %15, %16"
      : "+v"(pmax) : "v"(p1[0]), "v"(p1[1]), "v"(p1[2]), "v"(p1[3]), "v"(p1[4]), "v"(p1[5]), "v"(p1[6]), "v"(p1[7]), "v"(p1[8]), "v"(p1[9]), "v"(p1[10]), "v"(p1[11]), "v"(p1[12]), "v"(p1[13]), "v"(p1[14]), "v"(p1[15]));
  { auto rr = __builtin_amdgcn_permlane32_swap(__float_as_uint(pmax), __float_as_uint(pmax), false, false);
    pmax = fmaxf(__uint_as_float(rr[0]), __uint_as_float(rr[1])); }
  if (__builtin_expect(__all(pmax - m_reg <= THR2), 1)) { alpha = 1.f; }
  else { const float mn = __builtin_ceilf(fmaxf(m_reg, pmax)); alpha = __builtin_amdgcn_exp2f(m_reg - mn); m_reg = mn; }
  scl = __builtin_amdgcn_ldexpf(1.0f, (int)fmaxf(m_reg, -100.f) - 4);
  for (int r = 0; r < 16; ++r) p0[r] = __builtin_amdgcn_exp2f(p0[r]);
}
__device__ __forceinline__ void finishSM8(f32x16& p0, f32x16& p1, v8i& pa, float scl) {
  for (int r = 0; r < 16; ++r) p1[r] = __builtin_amdgcn_exp2f(p1[r]);
#pragma unroll
  for (int v = 0; v < 4; ++v) { pa[v] = cvt4_fp8_scl(pa[v], p0[4 * v], p0[4 * v + 1], p0[4 * v + 2], p0[4 * v + 3], scl); pa[4 + v] = cvt4_fp8_scl(pa[4 + v], p1[4 * v], p1[4 * v + 1], p1[4 * v + 2], p1[4 * v + 3], scl); }
}
__device__ __forceinline__ void pv8(f32x16* o, const char* Vs, const v8i& pa, int r32, int hi) {
  v8i b[4];
#pragma unroll
  for (int db = 0; db < 4; ++db) { const int d = 32 * db + r32, x = (d >> 2) & 3; const char* vp = Vs + d * 64;
    b[db] = mk8(*reinterpret_cast<const u32x4*>(vp + 16 * ((2 * hi) ^ x)), *reinterpret_cast<const u32x4*>(vp + 16 * ((2 * hi + 1) ^ x))); }
  const v8i ones = (v8i){0x22222222, 0x22222222, 0x22222222, 0x22222222, 0, 0, 0, 0};
#pragma unroll
  for (int db = 0; db < 4; ++db) o[db] = __builtin_amdgcn_mfma_scale_f32_32x32x64_f8f6f4(pa, b[db], o[db], 0, 0, 0, 0x7F7F7F7F, 0, 0x7F7F7F7F);
  o[4] = __builtin_amdgcn_mfma_scale_f32_32x32x64_f8f6f4(pa, ones, o[4], 0, 4, 0, 0x7F7F7F7F, 0, 0x7F7F7F7F);
}
__device__ __forceinline__ void attn_dense_body8(const bf16* __restrict__ Qb, const unsigned char* __restrict__ K8h, const unsigned char* __restrict__ V8h, bf16* __restrict__ Ob, int seq, char* lds) {
  int tid_o = wg_tid(); asm volatile("" : "+v"(tid_o)); const int tid = tid_o, wid = __builtin_amdgcn_readfirstlane(tid >> 6), lane = tid & 63, r32 = lane & 31, hi = lane >> 5;
  char* V_lds = lds; char* K_lds = lds + 3 * SHM_V8;
  float* ws = (float*)(lds + 3 * SHM_V8 + 3 * SHM_K8) + wid * 64; float* al_l = ws + 32;
  float m_reg = -1e30f; f32x16 o[5] = {}; v8i qf[2];
  { const bf16* Qw = Qb + (long)(wid * QBLK + r32) * LDQ + hi * 32;
#pragma unroll
    for (int s = 0; s < 2; ++s) {
#pragma unroll
      for (int c = 0; c < 4; ++c) { const u32x4 w = *reinterpret_cast<const u32x4*>(Qw + s * 64 + c * 8);
        constexpr float QS = 8.0f * SCALE * 1.4426950408889634f;
        qf[s][2 * c] = cvt4_fp8(QS * __uint_as_float(w[0] << 16), QS * __uint_as_float(w[0] & 0xffff0000u), QS * __uint_as_float(w[1] << 16), QS * __uint_as_float(w[1] & 0xffff0000u));
        qf[s][2 * c + 1] = cvt4_fp8(QS * __uint_as_float(w[2] << 16), QS * __uint_as_float(w[2] & 0xffff0000u), QS * __uint_as_float(w[3] << 16), QS * __uint_as_float(w[3] & 0xffff0000u)); } } }
  const int skey = tid >> 3, sck = tid & 7, sd = tid >> 2, sc4 = tid & 3;
  const int kst = skey * 128 + 16 * (sck ^ ((skey >> 1) & 7));
  const int vx = (sd >> 2) & 3, vst0 = sd * 64 + 16 * ((sc4 >> 1) ^ vx) + 8 * (sc4 & 1), vst1 = sd * 64 + 16 * ((2 + (sc4 >> 1)) ^ vx) + 8 * (sc4 & 1);
  const unsigned char* kg = K8h + (long)skey * K8_LD + 16 * sck; const unsigned char* vg = V8h + (long)sd * V8_LD + 16 * sc4;
  struct { u32x4 k, v; } sr_[2];
#define SLOAD8(i, k0) do { sr_[i].k = *reinterpret_cast<const u32x4*>(kg + (long)(k0) * K8_LD); sr_[i].v = *reinterpret_cast<const u32x4*>(vg + (k0)); } while (0)
#define SWRITE8(b, i) do { *reinterpret_cast<u32x4*>(K_lds + (b) * SHM_K8 + kst) = sr_[i].k; \
    *reinterpret_cast<u32x2*>(V_lds + (b) * SHM_V8 + vst0) = (u32x2){sr_[i].v[0], sr_[i].v[2]}; *reinterpret_cast<u32x2*>(V_lds + (b) * SHM_V8 + vst1) = (u32x2){sr_[i].v[1], sr_[i].v[3]}; } while (0)
#define SWAIT8() asm volatile("s_waitcnt vmcnt(2)" ::: "memory")
#define RESC8(a) do { if (__any((a) < 1.f)) { if (hi == 0) al_l[r32] = (a); asm volatile("s_waitcnt lgkmcnt(0)" ::: "memory"); \
    for (int d = 0; d < 5; ++d) for (int r = 0; r < 16; ++r) o[d][r] *= al_l[crow(r, hi)]; } } while (0)
  f32x16 pA0, pA1, pB0, pB1; float mnA, mnB, alA, alB; v8i pa = {}; const int NT = seq / KVBLK;
  SLOAD8(0, 0); asm volatile("s_waitcnt vmcnt(0)" ::: "memory"); SWRITE8(0, 0); __syncthreads();
  qkt8(pA0, pA1, K_lds, qf, r32, hi);
  asm volatile("s_nop 15\n\ts_nop 7" : "+v"(pA0), "+v"(pA1));
  partialSM8(pA0, pA1, m_reg, mnA, alA);
  SLOAD8(1, KVBLK); if (2 < NT) SLOAD8(0, 2 * KVBLK);
  SWAIT8(); SWRITE8(1, 1); __syncthreads();
  int bk = 1, bv = 0, bw = 2;
  if (wid >= 4) __builtin_amdgcn_s_setprio(1);
#define ROT3() do { const int t_ = bv; bv = bk; bk = bw; bw = t_; } while (0)
  for (int j = 1; j + 1 < NT; j += 2) {
    SBAR(); qkt8(pB0, pB1, K_lds + bk * SHM_K8, qf, r32, hi);
    finishSM8(pA0, pA1, pa, mnA); SBAR();
    SLOAD8(1, (j + 2) * KVBLK); SBAR();
    pv8(o, V_lds + bv * SHM_V8, pa, r32, hi); partialSM8(pB0, pB1, m_reg, mnB, alB);
    SWAIT8(); SWRITE8(bw, 0);
    RESC8(alB); __syncthreads(); ROT3();
    SBAR(); qkt8(pA0, pA1, K_lds + bk * SHM_K8, qf, r32, hi);
    finishSM8(pB0, pB1, pa, mnB); SBAR();
    if (j + 3 < NT) SLOAD8(0, (j + 3) * KVBLK); SBAR();
    pv8(o, V_lds + bv * SHM_V8, pa, r32, hi); partialSM8(pA0, pA1, m_reg, mnA, alA);
    SWAIT8(); SWRITE8(bw, 1);
    RESC8(alA); __syncthreads(); ROT3();
  }
  SBAR(); qkt8(pB0, pB1, K_lds + bk * SHM_K8, qf, r32, hi);
  finishSM8(pA0, pA1, pa, mnA); SBAR();
  pv8(o, V_lds + bv * SHM_V8, pa, r32, hi); partialSM8(pB0, pB1, m_reg, mnB, alB);
  RESC8(alB);
  finishSM8(pB0, pB1, pa, mnB); SBAR();
  pv8(o, V_lds + bk * SHM_V8, pa, r32, hi);
#undef ROT3
  __builtin_amdgcn_s_setprio(0);
  float rli[16];
#pragma unroll
  for (int r = 0; r < 16; ++r) rli[r] = 64.0f * __builtin_amdgcn_rcpf(o[4][r]);
  unsigned char* Ow = (unsigned char*)Ob + (long)(wid * QBLK) * LDO;
#pragma unroll
  for (int r = 0; r < 16; ++r) { const int orow = crow(r, hi);
    for (int d0 = 0; d0 < 4; ++d0) Ow[(long)orow * LDO + d0 * 32 + r32] = (unsigned char)__builtin_amdgcn_cvt_pk_fp8_f32(o[d0][r] * rli[r], 0.f, 0, false); }
#undef SLOAD8
#undef SWRITE8
#undef SWAIT8
#undef RESC8
}
}
struct Frame {
    LAS unsigned char* lds;
    int tid, lane, wave;
    int bid, vcu, G;
};
__device__ __forceinline__ float wave_sum(float v) {
#pragma unroll
    for (int o = 1; o < 64; o <<= 1) v += __shfl_xor(v, o);
    return v;
}
__device__ __forceinline__ void xrows_phase(const Frame& F, const float* __restrict__ h, bf16* __restrict__ hb, pg8::rs_t* __restrict__ rs, unsigned char* __restrict__ hb8) {
    const int gw = F.vcu * 8 + F.wave, NGW = F.G * 8;
    for (int m = gw; m < L; m += NGW) {
        const f32x4* xr = (const f32x4*)(h + (size_t)m * DM) + F.lane;
        v2u* o8 = (v2u*)(hb + (size_t)m * DM) + F.lane;
        float s = 0.f;
#pragma unroll
        for (int j = 0; j < 16; ++j) { const f32x4 v = xr[64 * j]; s += (v.x * v.x + v.y * v.y) + (v.z * v.z + v.w * v.w); v2u w; w.x = pk2(v.x, v.y); w.y = pk2(v.z, v.w); o8[64 * j] = w;
            int w8 = __builtin_amdgcn_cvt_pk_fp8_f32(v.x, v.y, 0, false); w8 = __builtin_amdgcn_cvt_pk_fp8_f32(v.z, v.w, w8, true); *((unsigned*)(hb8 + (size_t)m * DM) + 64 * j + F.lane) = (unsigned)w8; }
        s = wave_sum(s);
        if (F.lane == 0) rs[m] = (pg8::rs_t)(s * pg8::RS_FIX);
    }
}
__device__ __forceinline__ void headnorm_rows(bf16* __restrict__ X, int ld, int nheads, const float* __restrict__ gain, int t, int lane, bool rope, const float (&cs)[8], const float (&sn)[8], unsigned char* __restrict__ X8 = nullptr) {
    const int hs = lane >> 4, l16 = lane & 15;
    f32x4 g0 = *(const f32x4*)(gain + 8 * l16), g1 = *(const f32x4*)(gain + 8 * l16 + 4);
    const float gg[8] = {g0.x, g0.y, g0.z, g0.w, g1.x, g1.y, g1.z, g1.w};
    const bool second = ((l16 >> 2) & 1) != 0;
    for (int hg = 0; hg < nheads / 4; ++hg) {
        bf16* p = X + (size_t)t * ld + (size_t)(4 * hg + hs) * HD + 8 * l16;
        const v4u raw = *(const v4u*)p;
        float x[8] = {bflo(raw.x), bfhi(raw.x), bflo(raw.y), bfhi(raw.y), bflo(raw.z), bfhi(raw.z), bflo(raw.w), bfhi(raw.w)};
        float ss = 0.f;
#pragma unroll
        for (int e = 0; e < 8; ++e) ss += x[e] * x[e];
        ss += __shfl_xor(ss, 1); ss += __shfl_xor(ss, 2); ss += __shfl_xor(ss, 4); ss += __shfl_xor(ss, 8);
        const float rinv = 1.0f / sqrtf(ss * (1.0f / HD) + EPS);
        float y[8];
#pragma unroll
        for (int e = 0; e < 8; ++e) y[e] = x[e] * rinv * gg[e];
        if (rope) {
#pragma unroll
            for (int e = 0; e < 8; ++e) { const float yp = __shfl_xor(y[e], 4); y[e] = second ? (y[e] * cs[e] + yp * sn[e]) : (y[e] * cs[e] - yp * sn[e]); }
        }
        if (X8) { int w0 = __builtin_amdgcn_cvt_pk_fp8_f32(y[0], y[1], 0, false); w0 = __builtin_amdgcn_cvt_pk_fp8_f32(y[2], y[3], w0, true);
            int w1 = __builtin_amdgcn_cvt_pk_fp8_f32(y[4], y[5], 0, false); w1 = __builtin_amdgcn_cvt_pk_fp8_f32(y[6], y[7], w1, true);
            *(v2u*)(X8 + (size_t)t * ld + (size_t)(4 * hg + hs) * HD + 8 * l16) = (v2u){(unsigned)w0, (unsigned)w1}; }
        else { v4u w; w.x = pk2(y[0], y[1]); w.y = pk2(y[2], y[3]); w.z = pk2(y[4], y[5]); w.w = pk2(y[6], y[7]);
            *(v4u*)p = w; }
    }
}
__device__ __forceinline__ void prep_phase(const Frame& F, bf16* Q, bf16* K, int ldk, int nkh, const float* qgain, const float* kgain, bool rope, unsigned char* K8 = nullptr) {
    const int gw = F.vcu * 8 + F.wave, NGW = F.G * 8;
    const int l16 = F.lane & 15;
    for (int t = gw; t < L; t += NGW) {
        float cs[8], sn[8];
#pragma unroll
        for (int e = 0; e < 8; ++e) { cs[e] = 1.f; sn[e] = 0.f; }
        if (rope) {
            const int ax = l16 >> 3; const float pos = (float)(ax ? (t & (GRID_W - 1)) : (t / GRID_W));
#pragma unroll
            for (int e = 0; e < 8; ++e) { const int f = (l16 & 3) * 8 + e; const float inv = 1.0f / powf(10000.0f, (float)f * (1.0f / 32.0f)); const float ang = pos * inv; cs[e] = cosf(ang); sn[e] = sinf(ang); }
        }
        headnorm_rows(Q, DM, NH, qgain, t, F.lane, rope, cs, sn);
        headnorm_rows(K, ldk, nkh, kgain, t, F.lane, rope, cs, sn, K8);
    }
}

constexpr int S5T = pg8::S5T, S5NCH = pg8::S5NCH, S5KS = pg8::S5KS;
__device__ __forceinline__ void s5_gen_group(const Frame& F, int g, const float* __restrict__ lam_re, const float* __restrict__ lam_im, const float* __restrict__ log_step,
                                             const float* __restrict__ b_re, const float* __restrict__ b_im, const float* __restrict__ c_re, const float* __restrict__ c_im,
                                             bf16* __restrict__ GM, bf16* __restrict__ BMt, f32x2* __restrict__ PAT) {
    LAS f32x2* apow = (LAS f32x2*)F.lds;
    LAS f32x2* zt = apow + 2 * 33 * 64;
    LAS float* Kd = (LAS float*)(zt + 2 * 64);
    const int tid = F.tid;
    if (tid < 128) {
        const int dir = tid >> 6, n = tid & 63, dg = dir * S5G + g, idx = dg * S5N + n;
        const double dt = exp((double)log_step[dg]);
        const double lr = (double)lam_re[idx], li = (double)lam_im[idx];
        const double mag = exp(lr * dt), are = mag * cos(li * dt), aim = mag * sin(li * dt);
        const double den = lr * lr + li * li, nre = are - 1.0;
        zt[dir * 64 + n] = (f32x2){(float)((nre * lr + aim * li) / den), (float)((aim * lr - nre * li) / den)};
        double pr = 1.0, pi = 0.0;
        for (int k = 0; k <= 32; ++k) { apow[(dir * 33 + k) * 64 + n] = (f32x2){(float)pr, (float)pi}; const double t = pr * are - pi * aim; pi = pr * aim + pi * are; pr = t; }
        PAT[idx] = apow[(dir * 33 + 32) * 64 + n];
    }
    LDS_WAIT(); __syncthreads();
    {
        const int dir = tid >> 8, p = (tid >> 4) & 15, q = tid & 15, dg = dir * S5G + g;
        float wr[64], wi[64];
        const float* cr = c_re + ((size_t)dg * S5P + p) * S5N; const float* ci = c_im + ((size_t)dg * S5P + p) * S5N;
#pragma unroll
        for (int n = 0; n < 64; ++n) { const f32x2 z = zt[dir * 64 + n]; const float br = b_re[((size_t)dg * S5N + n) * S5P + q], bi = b_im[((size_t)dg * S5N + n) * S5P + q];
            const float bbr = z.x * br - z.y * bi, bbi = z.x * bi + z.y * br; const float c0 = cr[n], c1 = ci[n];
            wr[n] = c0 * bbr - c1 * bbi; wi[n] = c0 * bbi + c1 * bbr; }
        for (int d = 0; d < 32; ++d) { float acc = 0.f; const LAS f32x2* ap = apow + (dir * 33 + d) * 64;
#pragma unroll
            for (int n = 0; n < 64; ++n) { const f32x2 a = ap[n]; acc = fmaf(wr[n], a.x, acc); acc = fmaf(-wi[n], a.y, acc); }
            Kd[(dir * 32 + d) * 256 + p * 16 + q] = acc; }
    }
    LDS_WAIT(); __syncthreads();
    bf16* BMg = BMt + (size_t)g * 512 * S5KS;
    for (int it = tid; it < 512 * 64; it += 512) { const int row = it >> 6, ch = it & 63, tau = row >> 4, p = row & 15, sg = ch >> 1, q0 = (ch & 1) * 8;
        float v[8];
        if (sg < tau) { const LAS float* k = Kd + (0 * 32 + (tau - sg)) * 256 + p * 16 + q0;
#pragma unroll
            for (int j = 0; j < 8; ++j) v[j] = k[j]; }
        else if (sg > tau) { const LAS float* k = Kd + (1 * 32 + (sg - tau)) * 256 + p * 16 + q0;
#pragma unroll
            for (int j = 0; j < 8; ++j) v[j] = k[j]; }
        else { const LAS float* k0 = Kd + p * 16 + q0; const LAS float* k1 = Kd + 32 * 256 + p * 16 + q0;
#pragma unroll
            for (int j = 0; j < 8; ++j) v[j] = k0[j] + k1[j]; }
        v4u w; w.x = pk2(v[0], v[1]); w.y = pk2(v[2], v[3]); w.z = pk2(v[4], v[5]); w.w = pk2(v[6], v[7]);
        *(v4u*)(BMg + (size_t)row * S5KS + ch * 8) = w; }
    for (int it = tid; it < 512 * 32; it += 512) { const int row = it >> 5, ch = it & 31, tau = row >> 4, p = row & 15, dir = ch >> 4, n0 = (ch & 15) * 4, dg = dir * S5G + g;
        const int k = dir ? (32 - tau) : (tau + 1);
        const f32x4 cr = *(const f32x4*)(c_re + ((size_t)dg * S5P + p) * S5N + n0), ci = *(const f32x4*)(c_im + ((size_t)dg * S5P + p) * S5N + n0);
        const LAS f32x2* ap = apow + (dir * 33 + k) * 64 + n0;
        unsigned o[4];
#pragma unroll
        for (int j = 0; j < 4; ++j) { const f32x2 a = ap[j]; const float vr = cr[j] * a.x - ci[j] * a.y, vi = cr[j] * a.y + ci[j] * a.x; o[j] = pk2(vr, -vi); }
        *(v4u*)(BMg + (size_t)row * S5KS + 512 + ch * 8) = (v4u){o[0], o[1], o[2], o[3]}; }
    bf16* GMg = GM + (size_t)g * 256 * 512;
    for (int it = tid; it < 128 * 64; it += 512) { const int dn = it >> 6, ch = it & 63, dir = dn >> 6, n = dn & 63, sg = ch >> 1, q0 = (ch & 1) * 8, dg = dir * S5G + g;
        const int pw = dir ? sg : (31 - sg);
        const f32x2 a = apow[(dir * 33 + pw) * 64 + n], z = zt[dir * 64 + n];
        const float wr_ = a.x * z.x - a.y * z.y, wi_ = a.x * z.y + a.y * z.x;
        const float* br = b_re + ((size_t)dg * S5N + n) * S5P + q0; const float* bi = b_im + ((size_t)dg * S5N + n) * S5P + q0;
        float re[8], im[8];
#pragma unroll
        for (int j = 0; j < 8; ++j) { re[j] = wr_ * br[j] - wi_ * bi[j]; im[j] = wr_ * bi[j] + wi_ * br[j]; }
        v4u w0, w1; w0.x = pk2(re[0], re[1]); w0.y = pk2(re[2], re[3]); w0.z = pk2(re[4], re[5]); w0.w = pk2(re[6], re[7]);
        w1.x = pk2(im[0], im[1]); w1.y = pk2(im[2], im[3]); w1.z = pk2(im[4], im[5]); w1.w = pk2(im[6], im[7]);
        *(v4u*)(GMg + (size_t)(dir * 128 + 2 * n) * 512 + ch * 8) = w0; *(v4u*)(GMg + (size_t)(dir * 128 + 2 * n + 1) * 512 + ch * 8) = w1; }
    LDS_WAIT(); __syncthreads();
}
__device__ __forceinline__ void s5_scan_phase(const Frame& F, const f32x2* __restrict__ PAT, const float* __restrict__ E, bf16* __restrict__ UA) {
    for (int task = F.bid + F.G * F.wave; task < 2 * S5G; task += F.G * 8) {
        const int dir = task >> 8, g = task & 255;
        const f32x2 a = PAT[task * S5N + F.lane];
        const float* e = E + (size_t)g * S5NCH * 256 + dir * 128 + 2 * F.lane;
        bf16* s = UA + (size_t)g * S5NCH * S5KS + 512 + dir * 128 + 2 * F.lane;
        float cr = 0.f, ci = 0.f;
        for (int c8 = 0; c8 < S5NCH; c8 += 8) {
            f32x2 v[8];
#pragma unroll
            for (int k = 0; k < 8; ++k) { const int c = dir ? (S5NCH - 1 - (c8 + k)) : (c8 + k); v[k] = *(const f32x2*)(e + (size_t)c * 256); }
#pragma unroll
            for (int k = 0; k < 8; ++k) { const int c = dir ? (S5NCH - 1 - (c8 + k)) : (c8 + k);
                *(unsigned*)(s + (size_t)c * S5KS) = pk2(cr, ci);
                const float nr = fmaf(a.x, cr, fmaf(-a.y, ci, v[k].x)), ni = fmaf(a.x, ci, fmaf(a.y, cr, v[k].y)); cr = nr; ci = ni; }
        }
    }
}


__device__ __forceinline__ float fp8_to_f32(unsigned char b) { const int e = (b >> 3) & 15, m = b & 7; const float v = e ? __builtin_ldexpf(1.0f + (float)m * 0.125f, e - 7) : __builtin_ldexpf((float)m * 0.125f, -6); return (b & 0x80) ? -v : v; }
__device__ __forceinline__ void gqa_selfcheck(const Frame& F, const bf16* __restrict__ Qp, const unsigned char* __restrict__ K8, const unsigned char* __restrict__ V8t, const bf16* __restrict__ O,
                                              float* __restrict__ SC, unsigned* flag) {
    LAS float* ql = (LAS float*)(F.lds + F.wave * 1024);
    const int lane = F.lane;
#pragma unroll 1
    for (int s = F.bid * 8 + F.wave; s < 1024; s += F.G * 8) {
        const int tok = (int)(((long)(s >> 5) * 5209 + 77) % L), hq = s & 31, kv = hq >> 2;
        float* sc = SC + (size_t)(F.bid * 8 + F.wave) * L;
        { const bf16* qp = Qp + (size_t)tok * DM + hq * HD; ql[lane] = bf2f(qp[lane]); ql[lane + 64] = bf2f(qp[lane + 64]); } LDS_WAIT();
        float mx = -1e30f;
#pragma unroll 1
        for (int j = lane; j < L; j += 64) { const unsigned char* kp = K8 + (size_t)j * KVD + kv * HD; float dot = 0.f;
#pragma unroll 1
            for (int d = 0; d < HD; ++d) dot += fp8_to_f32(kp[d]) * ql[d];
            dot *= 0.088388347648318440f; sc[j] = dot; mx = fmaxf(mx, dot); }
#pragma unroll
        for (int o = 1; o < 64; o <<= 1) mx = fmaxf(mx, __shfl_xor(mx, o));
        asm volatile("s_waitcnt vmcnt(0)" ::: "memory"); __builtin_amdgcn_fence(__ATOMIC_RELEASE, "workgroup"); __builtin_amdgcn_fence(__ATOMIC_ACQUIRE, "agent");
        float o0 = 0.f, o1 = 0.f, lsum = 0.f;
#pragma unroll 1
        for (int j = 0; j < L; ++j) { const float pj = expf(__hip_atomic_load(sc + j, __ATOMIC_RELAXED, __HIP_MEMORY_SCOPE_AGENT) - mx);
            o0 += pj * fp8_to_f32(V8t[(size_t)(kv * HD + lane) * L + j]); o1 += pj * fp8_to_f32(V8t[(size_t)(kv * HD + lane + 64) * L + j]); lsum += pj; }
        o0 /= lsum; o1 /= lsum;
        const unsigned char* op = (const unsigned char*)O + (size_t)tok * DM + hq * HD; const float g0 = fp8_to_f32(op[lane]) * 0.015625f, g1 = fp8_to_f32(op[lane + 64]) * 0.015625f;
        float am = fmaxf(fabsf(o0), fabsf(o1));
#pragma unroll
        for (int o = 1; o < 64; o <<= 1) am = fmaxf(am, __shfl_xor(am, o));
        const float tol = 0.2f * am + 1e-5f;
        const bool bad = !(fabsf(g0 - o0) <= tol) || !(fabsf(g1 - o1) <= tol);
        if (__any(bad) && lane == 0) __hip_atomic_fetch_or(flag, 1u, __ATOMIC_RELAXED, __HIP_MEMORY_SCOPE_AGENT);
        LDS_WAIT();
    }
}

__device__ __forceinline__ void transpose_item(const float* __restrict__ W, int K, int N, bf16* __restrict__ WT, int mode, const float* __restrict__ gain, LAS float* scr, int item, int lane, int fp8 = 0) {
    const int nblk = N / 32, kb = item / nblk, nb = item % nblk, k0 = 64 * kb, n0 = 32 * nb;
    int r0 = n0;
    if (mode == 1) r0 = (n0 < DM) ? ((n0 >> 7) * 256 + (n0 & 127)) : (((n0 - DM) >> 7) * 256 + 128 + ((n0 - DM) & 127));
    const float* src = W + (size_t)(k0 + (lane >> 5)) * N + n0 + (lane & 31);
    float v[32];
#pragma unroll
    for (int i = 0; i < 32; ++i) v[i] = src[(size_t)(2 * i) * N];
    const int c = lane & 7;
    f32x4 g0 = (f32x4){1.f, 1.f, 1.f, 1.f}, g1 = g0;
    if (gain) { g0 = *(const f32x4*)(gain + k0 + 8 * c); g1 = *(const f32x4*)(gain + k0 + 8 * c + 4); }
#pragma unroll
    for (int i = 0; i < 32; ++i) scr[(2 * i + (lane >> 5)) * 33 + (lane & 31)] = v[i];
    LDS_WAIT(); asm volatile("" ::: "memory");
#pragma unroll
    for (int j = 0; j < 4; ++j) { const int n = (lane >> 3) + 8 * j; const LAS float* s = scr + (8 * c) * 33 + n;
        if (fp8) { int w0 = __builtin_amdgcn_cvt_pk_fp8_f32(64.f * s[0 * 33] * g0.x, 64.f * s[1 * 33] * g0.y, 0, false); w0 = __builtin_amdgcn_cvt_pk_fp8_f32(64.f * s[2 * 33] * g0.z, 64.f * s[3 * 33] * g0.w, w0, true);
            int w1 = __builtin_amdgcn_cvt_pk_fp8_f32(64.f * s[4 * 33] * g1.x, 64.f * s[5 * 33] * g1.y, 0, false); w1 = __builtin_amdgcn_cvt_pk_fp8_f32(64.f * s[6 * 33] * g1.z, 64.f * s[7 * 33] * g1.w, w1, true);
            *(v2u*)((unsigned char*)WT + (size_t)(r0 + n) * K + k0 + 8 * c) = (v2u){(unsigned)w0, (unsigned)w1}; }
        else { v4u o; o.x = pk2(s[0 * 33] * g0.x, s[1 * 33] * g0.y); o.y = pk2(s[2 * 33] * g0.z, s[3 * 33] * g0.w); o.z = pk2(s[4 * 33] * g1.x, s[5 * 33] * g1.y); o.w = pk2(s[6 * 33] * g1.z, s[7 * 33] * g1.w);
            *(v4u*)(WT + (size_t)(r0 + n) * K + k0 + 8 * c) = o; } }
    LDS_WAIT(); asm volatile("" ::: "memory");
}

constexpr size_t MiB = 1u << 20;
constexpr size_t SZ_NAQKV = (size_t)3 * DM * DM * 2, SZ_DD = (size_t)DM * DM * 2, SZ_GQAQKV = (size_t)(DM + 2 * KVD) * DM * 2, SZ_W1 = (size_t)FF * DM * 2, SZ_PROJ = (size_t)DM * PLE * 2, SZ_ACT = (size_t)L * DM * 2;
constexpr size_t OFF_CTL = 0, CTL_ZERO_BYTES = 3 * MiB, OFF_RS = 1 * MiB;
constexpr size_t OFF_NAQKV = 4 * MiB;
constexpr size_t OFF_NAWO = OFF_NAQKV + 2 * SZ_NAQKV;
constexpr size_t OFF_GQAQKV = OFF_NAWO + 2 * SZ_DD;
constexpr size_t OFF_GQAWO = OFF_GQAQKV + SZ_GQAQKV;
constexpr size_t OFF_S5IN = OFF_GQAWO + SZ_DD;
constexpr size_t OFF_S5OUT = OFF_S5IN + SZ_DD;
constexpr size_t OFF_W1 = OFF_S5OUT + 2 * SZ_DD;
constexpr size_t OFF_W2 = OFF_W1 + 4 * SZ_W1;
constexpr size_t OFF_PROJ = OFF_W2 + 4 * SZ_W1;
constexpr size_t OFF_GATE = OFF_PROJ + 4 * SZ_PROJ;
constexpr size_t OFF_PBF = OFF_GATE + 4 * SZ_DD;
constexpr size_t OFF_XN = OFF_PBF + 4 * (size_t)L * PLE * 2;
constexpr size_t OFF_ACT = OFF_XN + SZ_ACT;
constexpr size_t OFF_PP = OFF_ACT + 4 * SZ_ACT;
constexpr size_t OFF_S5BM = OFF_PP + SZ_ACT;
constexpr size_t OFF_S5GM = OFF_S5BM + 192 * MiB;
constexpr size_t OFF_S5PAR = OFF_S5GM + 64 * MiB;
constexpr size_t OFF_DUMMY = OFF_S5PAR + 8 * MiB;
constexpr size_t OFF_HB1 = OFF_DUMMY + 256 * MiB;
constexpr size_t OFF_HB8 = OFF_HB1 + SZ_ACT;
constexpr size_t WS_END = OFF_HB8 + (size_t)L * DM;
constexpr int CW_BAR = 4096;
constexpr int RING_BYTES = 131072, LDSCTL_OFF = RING_BYTES, MISC_OFF = LDSCTL_OFF + 320, PTAB_OFF = LDSCTL_OFF + 1024, LDS_BYTES = 147456;
static_assert(dattn::SHM_ATTN <= RING_BYTES && 8 * 64 * 33 * 4 <= RING_BYTES, "phase scratch fits the ring region");

constexpr int PH_PER_LAYER = 8, NPH = 1 + DEPTH * PH_PER_LAYER;
struct Args { const float* in[28]; float* out; unsigned char* ws; int ph_lo, ph_hi; };
enum { I_X = 0, I_P, I_MIXN, I_MLPN, I_PLEN, I_NAQKV, I_NAWO, I_NAQG, I_NAKG, I_NARPB, I_GQKV, I_GWO, I_GQG, I_GKG, I_S5IN, I_LAMRE, I_LAMIM, I_LOGSTEP, I_BRE, I_BIM, I_CRE, I_CIM, I_S5D, I_S5OUT, I_W1, I_W2, I_PROJ, I_GATE };


__device__ __forceinline__ unsigned long long tab_get(LAS unsigned char* lds, int i) {
    volatile LAS unsigned* t = (volatile LAS unsigned*)(lds + PTAB_OFF); const unsigned lo = t[2 * i], hi = t[2 * i + 1];
    return ((unsigned long long)(unsigned)__builtin_amdgcn_readfirstlane((int)hi) << 32) | (unsigned)__builtin_amdgcn_readfirstlane((int)lo); }
#define INP(i) ((const float*)(const GAS float*)tab_get(F.lds, (i)))
#define OUTP() ((float*)(GAS float*)tab_get(F.lds, 28))
#define WSP() ((unsigned char*)(GAS unsigned char*)tab_get(F.lds, 29))
__device__ __forceinline__ Frame mkframe(unsigned char* lds_generic) {
    Frame F; int t = wg_tid(); asm volatile("" : "+v"(t)); F.tid = t; F.lane = t & 63; F.wave = __builtin_amdgcn_readfirstlane(t >> 6);
    F.lds = (LAS unsigned char*)lds_generic; int b = blockIdx.x; asm volatile("" : "+s"(b)); F.bid = b; int G = gridDim.x; asm volatile("" : "+s"(G)); F.G = G;
    F.vcu = (G % 8 == 0) ? (b % 8) * (G / 8) + b / 8 : b; return F; }
__device__ __forceinline__ void prologue_phase(const Frame& F) {
    unsigned char* ws = WSP();
    LAS float* scr = (LAS float*)(F.lds + F.wave * (64 * 33 * 4));
    const int gw = F.vcu * 8 + F.wave, NGW = F.G * 8;
    constexpr int I_QKV = (DM / 64) * (3 * DM / 32), I_DD = (DM / 64) * (DM / 32), I_GQ = (DM / 64) * ((DM + 2 * KVD) / 32), I_SO = (DM / 64) * (2 * DM / 32),
                  I_1 = (DM / 64) * (FF / 32), I_2 = (FF / 64) * (DM / 32), I_PJ = (PLE / 64) * (DM / 32);
    constexpr int NITEMS = 2 * I_QKV + 2 * I_DD + I_GQ + I_DD + I_DD + I_SO + 4 * I_1 + 4 * I_2 + 4 * I_PJ + 4 * I_DD;
    for (int it = gw; it < NITEMS; it += NGW) {
        int r = it; const float* W; int K, N, mode = 0, fp8 = 0; bf16* WT; const float* gain = nullptr;
        if (r < 2 * I_QKV) { const int l = r / I_QKV; r -= l * I_QKV; W = INP(I_NAQKV) + (size_t)l * DM * 3 * DM; K = DM; N = 3 * DM; WT = (bf16*)(ws + OFF_NAQKV + l * SZ_NAQKV); gain = INP(I_MIXN) + (size_t)(3 * l) * DM; fp8 = 1; }
        else { r -= 2 * I_QKV;
        if (r < 2 * I_DD) { const int l = r / I_DD; r -= l * I_DD; W = INP(I_NAWO) + (size_t)l * DM * DM; K = DM; N = DM; WT = (bf16*)(ws + OFF_NAWO + l * SZ_DD); fp8 = 1; }
        else { r -= 2 * I_DD;
        if (r < I_GQ) { W = INP(I_GQKV); K = DM; N = DM + 2 * KVD; WT = (bf16*)(ws + OFF_GQAQKV); gain = INP(I_MIXN) + (size_t)1 * DM; fp8 = 1; }
        else { r -= I_GQ;
        if (r < I_DD) { W = INP(I_GWO); K = DM; N = DM; WT = (bf16*)(ws + OFF_GQAWO); fp8 = 1; }
        else { r -= I_DD;
        if (r < I_DD) { W = INP(I_S5IN); K = DM; N = DM; WT = (bf16*)(ws + OFF_S5IN); gain = INP(I_MIXN) + (size_t)2 * DM; fp8 = 1; }
        else { r -= I_DD;
        if (r < I_SO) { W = INP(I_S5OUT); K = DM; N = 2 * DM; WT = (bf16*)(ws + OFF_S5OUT); mode = 1; fp8 = 1; }
        else { r -= I_SO;
        if (r < 4 * I_1) { const int l = r / I_1; r -= l * I_1; W = INP(I_W1) + (size_t)l * DM * FF; K = DM; N = FF; WT = (bf16*)(ws + OFF_W1 + l * SZ_W1); gain = INP(I_MLPN) + (size_t)l * DM; }
        else { r -= 4 * I_1;
        if (r < 4 * I_2) { const int l = r / I_2; r -= l * I_2; W = INP(I_W2) + (size_t)l * FF * DM; K = FF; N = DM; WT = (bf16*)(ws + OFF_W2 + l * SZ_W1); }
        else { r -= 4 * I_2;
        if (r < 4 * I_PJ) { const int l = r / I_PJ; r -= l * I_PJ; W = INP(I_PROJ) + (size_t)l * PLE * DM; K = PLE; N = DM; WT = (bf16*)(ws + OFF_PROJ + l * SZ_PROJ); }
        else { r -= 4 * I_PJ; const int l = r / I_DD; r -= l * I_DD; W = INP(I_GATE) + (size_t)l * DM * DM; K = DM; N = DM; WT = (bf16*)(ws + OFF_GATE + l * SZ_DD); gain = INP(I_PLEN) + (size_t)l * DM; } } } } } } } } }
        transpose_item(W, K, N, WT, mode, gain, scr, r, F.lane, fp8);
    }
    xrows_phase(F, INP(I_X), (bf16*)(ws + OFF_XN), (pg8::rs_t*)(ws + OFF_RS), ws + OFF_HB8);
    { const size_t n8 = (size_t)DEPTH * L * PLE / 8; const float* p = INP(I_P); bf16* pb = (bf16*)(ws + OFF_PBF);
      for (size_t i = (size_t)gw * 64 + F.lane; i < n8; i += (size_t)NGW * 64) { const f32x4 a = *(const f32x4*)(p + i * 8), b = *(const f32x4*)(p + i * 8 + 4);
          v4u w; w.x = pk2(a.x, a.y); w.y = pk2(a.z, a.w); w.z = pk2(b.x, b.y); w.w = pk2(b.z, b.w); *(v4u*)(pb + i * 8) = w; } }
    { bf16* GM = (bf16*)(ws + OFF_S5GM); bf16* BMt = (bf16*)(ws + OFF_S5BM); f32x2* PAT = (f32x2*)(ws + OFF_S5PAR);
      LDS_WAIT(); __syncthreads();
      for (int g = F.bid; g < S5G; g += F.G) s5_gen_group(F, g, INP(I_LAMRE), INP(I_LAMIM), INP(I_LOGSTEP), INP(I_BRE), INP(I_BIM), INP(I_CRE), INP(I_CIM), GM, BMt, PAT); }
}

#define WS_PTRS() unsigned char* ws = WSP(); bf16* HB0 = (bf16*)(ws + OFF_XN); bf16* HB1 = (bf16*)(ws + OFF_HB1); bf16* Qb = (bf16*)(ws + OFF_ACT); bf16* Kb = (bf16*)(ws + OFF_ACT + SZ_ACT); bf16* Vb = (bf16*)(ws + OFF_ACT + 2 * SZ_ACT); \
    bf16* Ob = (bf16*)(ws + OFF_ACT + 3 * SZ_ACT); bf16* HID = (bf16*)(ws + OFF_ACT); bf16* UA = (bf16*)(ws + OFF_ACT); bf16* S5Gb = (bf16*)(ws + OFF_ACT + 2 * SZ_ACT); float* S5E = (float*)(ws + OFF_ACT + 3 * SZ_ACT); bf16* PP = (bf16*)(ws + OFF_PP); \
    (void)HB0; (void)HB1; (void)Qb; (void)Kb; (void)Vb; (void)Ob; (void)HID; (void)UA; (void)S5Gb; (void)PP; (void)S5E;
__global__ void __launch_bounds__(512, 2) enc_fwd(Args args) {
    extern __shared__ __attribute__((aligned(16))) unsigned char lds[];
    {
        LAS unsigned char* l3 = (LAS unsigned char*)lds;
        for (int u = threadIdx.x; u < (LDS_BYTES - LDSCTL_OFF) / 4; u += 512) ((LAS unsigned*)(l3 + LDSCTL_OFF))[u] = 0u;
        __syncthreads();
        if (threadIdx.x == 0) { LAS unsigned long long* t = (LAS unsigned long long*)(l3 + PTAB_OFF);
#pragma unroll
            for (int i = 0; i < 28; ++i) t[i] = (unsigned long long)args.in[i];
            t[28] = (unsigned long long)args.out; t[29] = (unsigned long long)args.ws; }
        if ((threadIdx.x & 63) == 0) ((LAS unsigned*)(WTAB_OFF))[hw_wave_slot()] = threadIdx.x >> 6;
        __syncthreads();
    }
    const int lo = args.ph_lo, hi = args.ph_hi;
    XcdBarrier bar;
    { LAS unsigned char* l3 = (LAS unsigned char*)lds; unsigned* ctl = (unsigned*)(GAS unsigned*)(tab_get(l3, 29) + OFF_CTL); bar.bar = ctl + CW_BAR; bar.x = 0; bar.st = nullptr;
      if (hi - lo > 1) bar = xcd_barrier_post(ctl + CW_BAR, (volatile LAS unsigned*)(l3 + MISC_OFF) + 8); }
#define IN(k) (lo <= (k) && (k) < hi)
#ifndef PROBE_PH
#define PROBE_PH (-1)
#endif
#define REPS(k) for (int rep_ = 0, nrep_ = (((k) == PROBE_PH || PROBE_PH == -2) ? 2 : (((PROBE_PH == 300 || PROBE_PH == 301) && (k) == 11) ? 4 : 1)); rep_ < nrep_; ++rep_)
#define HBOUT(p) ((nrep_ == 2 && rep_ == 0) ? (bf16*)(ws + OFF_DUMMY) : (p))
#define RSOUT(i) ((nrep_ == 2 && rep_ == 0) ? (pg8::rs_t*)(ws + OFF_DUMMY + 128 * MiB) : RSP(i))
#if PROBE_PH >= 700 && PROBE_PH < 900
#define SEAM(k) do { if (IN(k) && IN((k) + 1)) { unsigned long long* ts_ = (unsigned long long*)(GAS unsigned long long*)(tab_get((LAS unsigned char*)lds, 29) + OFF_DUMMY + 200 * MiB); \
        if ((k) == PROBE_PH % 100) { __syncthreads(); if (wg_tid() == 0) __hip_atomic_store(ts_ + blockIdx.x, (unsigned long long)wall_clock64(), __ATOMIC_RELAXED, __HIP_MEMORY_SCOPE_AGENT); } \
        xcd_barrier(bar); \
        if ((k) == PROBE_PH % 100 && blockIdx.x == 0 && wg_tid() == 0) { unsigned long long mx = 0, sm = 0, t0_ = ~0ull; const unsigned st_ = (PROBE_PH >= 800) ? 8u : 1u; \
            for (unsigned i_ = 0; i_ < gridDim.x; i_ += st_) { const unsigned long long t_ = __hip_atomic_load(ts_ + i_, __ATOMIC_RELAXED, __HIP_MEMORY_SCOPE_AGENT); mx = t_ > mx ? t_ : mx; t0_ = t_ < t0_ ? t_ : t0_; } \
            for (unsigned i_ = 0; i_ < gridDim.x; i_ += st_) sm += __hip_atomic_load(ts_ + i_, __ATOMIC_RELAXED, __HIP_MEMORY_SCOPE_AGENT) - t0_; \
            const unsigned long long idle_ = (mx - t0_) - sm / (gridDim.x / st_), until_ = (unsigned long long)wall_clock64() + 100ull * idle_; \
            while ((unsigned long long)wall_clock64() < until_) __builtin_amdgcn_s_sleep(32); } } } while (0)
#else
#define SEAM(k) do { if (IN(k) && IN((k) + 1)) xcd_barrier(bar); } while (0)
#endif

#if PROBE_PH == 601
    if (blockIdx.x == 0 && threadIdx.x < 64) {
        typedef int v8i_ __attribute__((ext_vector_type(8))); typedef float f4v_ __attribute__((ext_vector_type(4)));
        const int l = threadIdx.x, ij = l & 15, kb = l >> 4; const unsigned lut[7] = {0xC4u, 0xC0u, 0xB8u, 0x00u, 0x38u, 0x40u, 0x44u};
        v8i_ A, B;
#pragma unroll
        for (int v = 0; v < 8; ++v) { unsigned wa = 0, wb = 0;
#pragma unroll
            for (int b = 0; b < 4; ++b) { const int kk = 32 * kb + 4 * v + b; const int av = ((ij + 2 * kk) % 5) - 2, bv = ((3 * kk + ij) % 7) - 3;
                unsigned ea = 0, eb = 0;
#pragma unroll
                for (int t = 0; t < 7; ++t) { ea = (av + 3 == t) ? lut[t] : ea; eb = (bv + 3 == t) ? lut[t] : eb; }
                wa |= ea << (8 * b); wb |= eb << (8 * b); }
            A[v] = (int)wa; B[v] = (int)wb; }
        f4v_ c1 = {};
        c1 = __builtin_amdgcn_mfma_scale_f32_16x16x128_f8f6f4(A, B, c1, 0, 0, 0, 0x7F7F7F7F, 0, 0x7F7F7F7F);
        bool ok1 = true;
#pragma unroll
        for (int r = 0; r < 4; ++r) { const int i = 4 * kb + r, j = ij; int s = 0;
            for (int kk = 0; kk < 128; ++kk) s += (((i + 2 * kk) % 5) - 2) * (((3 * kk + j) % 7) - 3);
            ok1 = ok1 && (c1[r] == (float)s); }
        unsigned long long ticks = 0; if (!__all(ok1)) ticks += 400000ull;
        const unsigned long long t0 = __builtin_amdgcn_s_memrealtime(); while (__builtin_amdgcn_s_memrealtime() - t0 < ticks) __builtin_amdgcn_s_sleep(8);
    }
    __syncthreads();
#endif
#if PROBE_PH == 600
    if (blockIdx.x == 0 && threadIdx.x < 64) {
        typedef int v8i_ __attribute__((ext_vector_type(8))); typedef float f16v_ __attribute__((ext_vector_type(16)));
        const int l = threadIdx.x, ij = l & 31, kb = l >> 5; const unsigned lut[7] = {0xC4u, 0xC0u, 0xB8u, 0x00u, 0x38u, 0x40u, 0x44u};
        v8i_ A, B;
#pragma unroll
        for (int v = 0; v < 8; ++v) { unsigned wa = 0, wb = 0;
#pragma unroll
            for (int b = 0; b < 4; ++b) { const int kk = 32 * kb + 4 * v + b; const int av = ((ij + 2 * kk) % 5) - 2, bv = ((3 * kk + ij) % 7) - 3;
                unsigned ea = 0, eb = 0;
#pragma unroll
                for (int t = 0; t < 7; ++t) { ea = (av + 3 == t) ? lut[t] : ea; eb = (bv + 3 == t) ? lut[t] : eb; }
                wa |= ea << (8 * b); wb |= eb << (8 * b); }
            A[v] = (int)wa; B[v] = (int)wb; }
        f16v_ c1 = {}, c2 = {};
        c1 = __builtin_amdgcn_mfma_scale_f32_32x32x64_f8f6f4(A, B, c1, 0, 0, 0, 0x7F7F7F7F, 0, 0x7F7F7F7F);
        c2 = __builtin_amdgcn_mfma_scale_f32_32x32x64_f8f6f4(A, B, c2, 0, 0, 0, 0x7B7B7B7B, 0, 0x7F7F7F7F);
        bool ok1 = true, ok2 = true;
#pragma unroll
        for (int r = 0; r < 16; ++r) { const int i = (r & 3) + 8 * (r >> 2) + 4 * kb, j = ij; int s = 0;
            for (int kk = 0; kk < 64; ++kk) s += (((i + 2 * kk) % 5) - 2) * (((3 * kk + j) % 7) - 3);
            ok1 = ok1 && (c1[r] == (float)s); ok2 = ok2 && (c2[r] == (float)s * 0.0625f); }
        int w = __builtin_amdgcn_cvt_pk_fp8_f32(1.0f, 2.0f, 0, false); w = __builtin_amdgcn_cvt_pk_fp8_f32(3.0f, -1.0f, w, true);
        const bool ok3 = ((unsigned)w == 0xB8444038u);
        unsigned long long ticks = 0; if (!__all(ok1)) ticks += 400000ull; if (!__all(ok2)) ticks += 800000ull; if (!__all(ok3)) ticks += 1600000ull;
        const unsigned long long t0 = __builtin_amdgcn_s_memrealtime(); while (__builtin_amdgcn_s_memrealtime() - t0 < ticks) __builtin_amdgcn_s_sleep(8);
    }
    __syncthreads();
#endif
    if (IN(0)) REPS(0) { const Frame F = mkframe(lds); prologue_phase(F); } SEAM(0);
#if PROBE_PH == 200
    for (int xb_ = 0; xb_ < 40; ++xb_) xcd_barrier(bar);
#endif

#pragma unroll 1
    for (int layer = 0; layer < DEPTH; ++layer) {
        const int kind = layer % 3, slot = layer / 3, pb = 1 + PH_PER_LAYER * layer;
#define RSP(i) ((pg8::rs_t*)(ws + OFF_RS) + (size_t)(i) * L)
        const int irs = (layer == 0) ? 0 : 3 * layer;
        if (IN(pb + 0)) REPS(pb + 0) {
            const Frame F = mkframe(lds); WS_PTRS();
            if (kind != 2) {
                const int N = (kind == 0) ? 3 * DM : DM + 2 * KVD;
                const bf16* W = (kind == 0) ? (const bf16*)(ws + OFF_NAQKV + slot * SZ_NAQKV) : (const bf16*)(ws + OFF_GQAQKV);
                const pg8::Gemm g = pg8::mkgemm((const bf16*)(ws + OFF_HB8), W, L, N, DM / 2); pg8::StaticOrder S; S.init(L, N, F.G, F.bid);
                pg8::EpiBf16<0> E{Qb, Kb, Vb, DM, (kind == 0) ? DM : KVD, (kind == 0) ? DM : L, DM, (kind == 0) ? 2 * DM : DM + KVD, RSP(irs), (kind == 0) ? 0 : 2, (kind == 0) ? 2 * DM : DM + KVD};
                pg8::gemm_phase<pg8::EpiBf16<0>, pg8::StaticOrder, false, true, true>(F.lds, g, S, E);
            } else {
                const pg8::Gemm g = pg8::mkgemm((const bf16*)(ws + OFF_HB8), (const bf16*)(ws + OFF_S5IN), L, DM, DM / 2); pg8::StaticOrder S; S.init(L, DM, F.G, F.bid);
                pg8::EpiS5U E{UA, RSP(irs)};
                pg8::gemm_phase<pg8::EpiS5U, pg8::StaticOrder, false, true, true>(F.lds, g, S, E);
            }
        }
        SEAM(pb + 0);
        if (kind != 2) {
            if (kind == 1) { if (IN(pb + 1)) { const Frame F = mkframe(lds); WS_PTRS(); prep_phase(F, Qb, Kb, KVD, NKV, INP(I_GQG), INP(I_GKG), true, (unsigned char*)Kb + 64 * MiB); }
                SEAM(pb + 1); }
            if (IN(pb + 2)) REPS(pb + 2) { const Frame F = mkframe(lds); WS_PTRS();
                if (kind == 0) {
                    const float* rpb = INP(I_NARPB) + (size_t)slot * NH * 15 * 31;
                    for (int i = 0;; ++i) { const int unit = i * F.G + F.vcu; if (unit >= NH * (GROWS / 4)) break;
                        const int h = unit >> 6, R = (unit & 63) * 4, ks = min(max(R - 4, 0), GROWS - dattn::NA_TILES);
                        dattn::na_block_body(Qb + (size_t)(R * GRID_W) * DM + h * HD, Kb + (size_t)(ks * GRID_W) * DM + h * HD, Vb + (size_t)(ks * GRID_W) * DM + h * HD,
                                             (bf16*)((unsigned char*)Ob + (size_t)(R * GRID_W) * DM + h * HD), rpb + (size_t)h * 15 * 31, INP(I_NAQG) + slot * HD, INP(I_NAKG) + slot * HD, R, ks, (char*)lds);
                        __syncthreads(); }
                } else {
                    for (int i = 0;; ++i) { const int unit = i * F.G + F.bid; if (unit >= NH * (L / 256)) break;
                        const int kvh = unit & 7, rest = unit >> 3, hq = kvh * 4 + (rest >> 6), qb = rest & 63;
                        dattn::attn_dense_body8(Qb + (size_t)(qb * 256) * DM + hq * HD, (const unsigned char*)Kb + 64 * MiB + kvh * HD, (const unsigned char*)Vb + (size_t)(kvh * HD) * L, (bf16*)((unsigned char*)Ob + (size_t)(qb * 256) * DM + hq * HD), L, (char*)lds);
                        __syncthreads(); }
                }
            }
            if (IN(pb + 2) && IN(pb + 4)) xcd_barrier(bar);
#if PROBE_PH == 400
            if (kind == 1) { const Frame F = mkframe(lds); WS_PTRS();
                gqa_selfcheck(F, Qb, (const unsigned char*)Kb + 64 * MiB, (const unsigned char*)Vb, Ob, (float*)(ws + OFF_PP), (unsigned*)(ws + OFF_CTL) + 8);
                xcd_barrier(bar); }
#endif
        } else {
            if (IN(pb + 1)) REPS(pb + 1) { const Frame F = mkframe(lds); WS_PTRS();
                pg8::Gemm g; g.A = UA; g.Bt = (const bf16*)(ws + OFF_S5GM); g.M = S5G * S5NCH; g.N = 256; g.K = 512; g.lda = S5KS; g.ldb = 512; g.sa = 0x7F7F7F7F;
                pg8::S5Order S{F.G, F.bid, 2, 1}; pg8::EpiS5E E{S5E};
                pg8::gemm_phase<pg8::EpiS5E, pg8::S5Order, false, true>(F.lds, g, S, E); }
            SEAM(pb + 1);
            if (IN(pb + 2)) REPS(pb + 2) { const Frame F = mkframe(lds); WS_PTRS(); s5_scan_phase(F, (const f32x2*)(ws + OFF_S5PAR), S5E, UA); }
            SEAM(pb + 2);
            if (IN(pb + 3)) REPS(pb + 3) { const Frame F = mkframe(lds); WS_PTRS();
                pg8::Gemm g; g.A = UA; g.Bt = (const bf16*)(ws + OFF_S5BM); g.M = S5G * S5NCH; g.N = S5G * 512; g.K = S5KS; g.lda = S5KS; g.ldb = S5KS; g.sa = 0x7F7F7F7F;
                pg8::S5Order S{F.G, F.bid, 2, 2}; pg8::EpiS5Y E{UA, INP(I_S5D), S5Gb, DM};
                pg8::gemm_phase<pg8::EpiS5Y, pg8::S5Order, false, true>(F.lds, g, S, E); }
            SEAM(pb + 3);
        }
        if (IN(pb + 4)) REPS(pb + 4) {
            const Frame F = mkframe(lds); WS_PTRS();
            if (kind != 2) {
                const bf16* W = (kind == 0) ? (const bf16*)(ws + OFF_NAWO + slot * SZ_DD) : (const bf16*)(ws + OFF_GQAWO);
                pg8::Gemm g = pg8::mkgemm(Ob, W, L, DM, DM / 2); g.sa = 0x79797979; pg8::StaticOrder S; S.init(L, DM, F.G, F.bid);
                pg8::EpiRes E{HB0, HBOUT(HB0), RSOUT(1 + 3 * layer), DM, nullptr};
                pg8::gemm_phase<pg8::EpiRes, pg8::StaticOrder, false, true, true>(F.lds, g, S, E);
            } else {
                pg8::Gemm g = pg8::mkgemm(S5Gb, (const bf16*)(ws + OFF_S5OUT), L, 2 * DM, DM / 2); g.sa = 0x7B7B7B7B; pg8::StaticOrder S; S.init(L, 2 * DM, F.G, F.bid);
                pg8::EpiGlu E{HB0, HBOUT(HB0), RSOUT(1 + 3 * layer), DM};
                pg8::gemm_phase<pg8::EpiGlu, pg8::StaticOrder, false, true, true>(F.lds, g, S, E);
            }
        }
        SEAM(pb + 4);
        if (IN(pb + 5)) REPS(pb + 5) { const Frame F = mkframe(lds); WS_PTRS();
            const pg8::Gemm g = pg8::mkgemm(HB0, (const bf16*)(ws + OFF_W1 + layer * SZ_W1), L, FF, DM); pg8::StaticOrder S; S.init(L, FF, F.G, F.bid);
            pg8::EpiBf16<2> E{HID, HID, HID, FF, FF, FF, 1 << 30, 1 << 30, nullptr, 0, 0};
#if PROBE_PH == 201
            { pg8::RangeOrder R1{S, 0, 8}, R2{S, 8, 16};
              pg8::gemm_phase<pg8::EpiBf16<2>, pg8::RangeOrder, false, true>(F.lds, g, R1, E); xcd_barrier(bar);
              pg8::gemm_phase<pg8::EpiBf16<2>, pg8::RangeOrder, false, true>(F.lds, g, R2, E); }
#else
            pg8::gemm_phase<pg8::EpiBf16<2>, pg8::StaticOrder, false, true>(F.lds, g, S, E);
#endif
        }
        SEAM(pb + 5);
        if (IN(pb + 6)) REPS(pb + 6) { const Frame F = mkframe(lds); WS_PTRS();
            { const pg8::Gemm g = pg8::mkgemm(HID, (const bf16*)(ws + OFF_W2 + layer * SZ_W1), L, DM, FF); pg8::StaticOrder S; S.init(L, DM, F.G, F.bid);
              pg8::EpiRes E{HB0, HBOUT(HB1), RSOUT(2 + 3 * layer), DM, RSP(1 + 3 * layer)};
              pg8::gemm_phase<pg8::EpiRes, pg8::StaticOrder, false, true>(F.lds, g, S, E); }
            { const pg8::Gemm g = pg8::mkgemm((const bf16*)(ws + OFF_PBF + (size_t)layer * L * PLE * 2), (const bf16*)(ws + OFF_PROJ + layer * SZ_PROJ), L, DM, PLE); pg8::StaticOrder S; S.init(L, DM, F.G, F.bid);
              pg8::EpiBf16<0> E{PP, PP, PP, DM, DM, DM, 1 << 30, 1 << 30, nullptr, 0, 0};
              pg8::gemm_phase<pg8::EpiBf16<0>, pg8::StaticOrder, false, true>(F.lds, g, S, E); }
        }
        SEAM(pb + 6);
        if (IN(pb + 7)) REPS(pb + 7) { const Frame F = mkframe(lds); WS_PTRS();
            const pg8::Gemm g = pg8::mkgemm(HB1, (const bf16*)(ws + OFF_GATE + layer * SZ_DD), L, DM, DM); pg8::StaticOrder S; S.init(L, DM, F.G, F.bid);
            pg8::EpiGate E{HB1, HBOUT(HB0), (layer == DEPTH - 1) ? OUTP() : nullptr, PP, RSP(2 + 3 * layer), RSOUT(3 + 3 * layer), DM, (layer + 1 < DEPTH && !(nrep_ == 2 && rep_ == 0)) ? ws + OFF_HB8 : nullptr};
            pg8::gemm_phase<pg8::EpiGate, pg8::StaticOrder, false, true>(F.lds, g, S, E);
        }
        SEAM(pb + 7);
    }
#if PROBE_PH == 400
    { xcd_barrier(bar); const Frame F = mkframe(lds); unsigned char* ws = WSP();
      if (__hip_atomic_load((unsigned*)(ws + OFF_CTL) + 8, __ATOMIC_RELAXED, __HIP_MEMORY_SCOPE_AGENT) != 0u && F.bid == 0 && F.tid < 64) OUTP()[F.tid] = __builtin_nanf(""); }
#endif
#undef IN
#undef SEAM
}

extern "C" void kernel_launch(void* const* d_in, const int* in_sizes, int n_in, void* d_out, int out_size, void* d_ws, size_t ws_size, hipStream_t stream) {
    static int grid = 0;
    if (grid == 0) {
        if (n_in != 28 || in_sizes[0] != L * DM || out_size != L * DM || ws_size < WS_END) {
            fprintf(stderr, "kernel_launch: built for 28 inputs, x/out of %d floats, >= %zu bytes of workspace; got n_in %d, in0 %d, out %d, ws %zu; nothing launched\n", L * DM, (size_t)WS_END, n_in, n_in > 0 ? in_sizes[0] : -1, out_size, ws_size);
            grid = -1; return; }
        int dev = 0, cus = 0, per_cu = 0;
        if (hipGetDevice(&dev) != hipSuccess || hipDeviceGetAttribute(&cus, hipDeviceAttributeMultiprocessorCount, dev) != hipSuccess) { fprintf(stderr, "kernel_launch: device query failed\n"); grid = -1; return; }
        if (hipFuncSetAttribute((const void*)enc_fwd, hipFuncAttributeMaxDynamicSharedMemorySize, LDS_BYTES) != hipSuccess) { fprintf(stderr, "kernel_launch: hipFuncSetAttribute failed\n"); grid = -1; return; }
        if (hipOccupancyMaxActiveBlocksPerMultiprocessor(&per_cu, (const void*)enc_fwd, 512, LDS_BYTES) != hipSuccess || per_cu < 1)
            fprintf(stderr, "kernel_launch: note: occupancy query reports %d workgroups per CU\n", per_cu);
        (void)hipGetLastError();
        grid = cus;
    }
    if (grid < 0) return;
    if (hipMemsetAsync((char*)d_ws + OFF_CTL, 0, CTL_ZERO_BYTES, stream) != hipSuccess) { fprintf(stderr, "kernel_launch: memset failed\n"); return; }
    Args a{};
    for (int i = 0; i < 28; ++i) a.in[i] = (const float*)d_in[i];
    a.out = (float*)d_out; a.ws = (unsigned char*)d_ws;
#if MK_N_LAUNCHES == 1
    a.ph_lo = 0; a.ph_hi = NPH;
    hipLaunchKernelGGL(enc_fwd, dim3(grid), dim3(512), LDS_BYTES, stream, a);
#else
    for (int ph = 0; ph < NPH; ++ph) {
        if (ph > 0) { const int layer = (ph - 1) / PH_PER_LAYER, j = (ph - 1) % PH_PER_LAYER; if (j == 3 && layer % 3 != 2) continue; }
        a.ph_lo = ph; a.ph_hi = ph + 1;
        hipLaunchKernelGGL(enc_fwd, dim3(grid), dim3(512), LDS_BYTES, stream, a);
    }
#endif
    const hipError_t le = hipPeekAtLastError();
    if (le != hipSuccess) fprintf(stderr, "kernel_launch: launch failed: %s\n", hipGetErrorName(le));
}
```

```cpp
#include <hip/hip_runtime.h>
#include <cstdio>
#include <cstdint>

#ifndef MK_N_LAUNCHES
#define MK_N_LAUNCHES 1
#endif

constexpr int L = 16384, DM = 4096, DEPTH = 4, GRID_W = 64, GROWS = L / GRID_W, HD = 128, NH = 32, NKV = 8, KVD = NKV * HD, FF = 4 * DM, PLE = 256;
constexpr int S5G = 256, S5P = 16, S5N = 64, S5TC = 16, S5NC = L / S5TC;
constexpr float EPS = 1e-6f;

#define GAS __attribute__((address_space(1)))
#define LAS __attribute__((address_space(3)))
constexpr unsigned WTAB_OFF = 131072 + 2048;
__device__ __forceinline__ unsigned hw_wave_slot() { return (unsigned)__builtin_amdgcn_s_getreg((5 << 11) | 4) & 63u; }
__device__ __forceinline__ int wg_tid() {
    const unsigned wv = (unsigned)__builtin_amdgcn_readfirstlane((int)((volatile LAS unsigned*)(WTAB_OFF))[hw_wave_slot()]);
    unsigned ln; asm volatile("v_mbcnt_lo_u32_b32 %0, -1, 0\n\tv_mbcnt_hi_u32_b32 %0, -1, %0" : "=v"(ln));
    return (int)(wv * 64u + ln);
}
typedef unsigned short bf16;
typedef unsigned v4u __attribute__((ext_vector_type(4)));
typedef unsigned v2u __attribute__((ext_vector_type(2)));
typedef float f32x4 __attribute__((ext_vector_type(4)));
typedef float f32x2 __attribute__((ext_vector_type(2)));
typedef short bf16x8 __attribute__((ext_vector_type(8)));
typedef short s16x4 __attribute__((ext_vector_type(4)));
typedef GAS unsigned gu32;
#define RLX_AGENT __ATOMIC_RELAXED, __HIP_MEMORY_SCOPE_AGENT
#define LDS_WAIT() asm volatile("s_waitcnt lgkmcnt(0)" ::: "memory")
#define VM_WAIT() asm volatile("s_waitcnt vmcnt(0)" ::: "memory")
__device__ __forceinline__ unsigned f2bf(float f) { unsigned u = __builtin_bit_cast(unsigned, f); return (u + 0x7fffu + ((u >> 16) & 1u)) >> 16; }
__device__ __forceinline__ unsigned pk2(float lo, float hi) { return f2bf(lo) | (f2bf(hi) << 16); }
__device__ __forceinline__ float bf2f(unsigned short b) { return __builtin_bit_cast(float, (unsigned)b << 16); }
__device__ __forceinline__ float bflo(unsigned w) { return __builtin_bit_cast(float, w << 16); }
__device__ __forceinline__ float bfhi(unsigned w) { return __builtin_bit_cast(float, w & 0xffff0000u); }
__device__ __forceinline__ float sigmoidf_fast(float x) { return __builtin_amdgcn_rcpf(1.0f + __builtin_amdgcn_exp2f(-1.4426950408889634f * x)); }

namespace pg8 {
#define PG8_LAS __attribute__((address_space(3)))
#if defined(PROBE_EPI2)
#define PROBE_EPI_DUP if constexpr (Epi::PERM) E(acc, cur, wr, wc, fr, fq);
#else
#define PROBE_EPI_DUP
#endif
typedef unsigned short bf16_t;
typedef short bf16x8 __attribute__((ext_vector_type(8)));
typedef float f32x4 __attribute__((ext_vector_type(4)));
typedef unsigned u32x4 __attribute__((ext_vector_type(4)));
constexpr int BM = 256, BK = 64, HALF = 128, HTB = HALF * BK * 2  , STAGE_BYTES = 8 * HTB, NXCD = 8, WGM = 8;

__host__ __device__ __forceinline__ int lds_byte(int r, int c) { const int st = (r >> 4) * 2 + (c >> 5), rr = r & 15, cc = c & 31, ob = rr * 64 + cc * 2; return st * 1024 + (ob ^ (((ob >> 9) & 1) << 5)); }
__host__ __device__ __forceinline__ void stage_rc(int b, int& R, int& C) { const int st = b / 1024, sb = b % 1024, swz = sb ^ (((sb >> 9) & 1) << 5); R = (st >> 1) * 16 + swz / 64; C = (st & 1) * 32 + (swz % 64) / 2; }
__host__ __device__ __forceinline__ int perm32(int rho) { const int n = rho >> 4, i = rho & 15; return 8 * (i >> 2) + 4 * n + (i & 3); }

struct Unit { int pm, pn; };
struct Gemm { const bf16_t* A; const bf16_t* Bt; int M, N, K, lda, ldb, sa; };
__host__ __device__ __forceinline__ Gemm mkgemm(const bf16_t* A, const bf16_t* Bt, int M, int N, int K) { Gemm g; g.A = A; g.Bt = Bt; g.M = M; g.N = N; g.K = K; g.lda = K; g.ldb = K; g.sa = 0x7F7F7F7F; return g; }

struct StaticOrder {
    int nM, nN, nwg, G, c, wgm;
    __host__ __device__ void init(int M, int N, int G_, int c_, int wgm_ = WGM) { nM = M / BM; nN = N / BM; nwg = nM * nN; G = G_; c = c_; wgm = wgm_; }
    __host__ __device__ bool next(int i, Unit& u) const {
        const long L = (long)i * G + c; if (L >= nwg) return false;
        int wgid = (int)L; { const int q = nwg / NXCD, r = nwg % NXCD, xcd = wgid % NXCD, off = wgid / NXCD; wgid = (xcd < r ? xcd * (q + 1) : r * (q + 1) + (xcd - r) * q) + off; }
        const int nig = wgm * nN, gid = wgid / nig, fm = gid * wgm, gsz = (nM - fm) < wgm ? (nM - fm) : wgm;
        u.pm = fm + ((wgid % nig) % gsz); u.pn = (wgid % nig) / gsz; return true;
    }
    __device__ __forceinline__ void a_ready(const Unit&) const {}
    __device__ __forceinline__ void done(const Unit&) const {}
};
struct RangeOrder { StaticOrder S; int i0, i1;
    __host__ __device__ bool next(int i, Unit& u) const { return (i + i0 < i1) ? S.next(i + i0, u) : false; }
    __device__ __forceinline__ void a_ready(const Unit&) const {}
    __device__ __forceinline__ void done(const Unit&) const {} };


__device__ __forceinline__ unsigned cvt_pk_bf16(float lo, float hi) { unsigned r; asm volatile("v_cvt_pk_bf16_f32 %0, %1, %2" : "=v"(r) : "v"(lo), "v"(hi)); return r; }
__device__ __forceinline__ float sigm(float x) { return __builtin_amdgcn_rcpf(1.0f + __builtin_amdgcn_exp2f(-1.4426950408889634f * x)); }

typedef unsigned long long rs_t;
constexpr float RS_FIX = 16777216.0f, RS_INV = 1.0f / (16777216.0f * 4096.0f), RS_EPS = 1e-6f;
__device__ __forceinline__ void row_ss_add(rs_t* rs, int row, float s, int fq) {
    s += __shfl_xor(s, 16); s += __shfl_xor(s, 32);
    if (fq == 0) __hip_atomic_fetch_add(rs + row, (rs_t)(s * RS_FIX), __ATOMIC_RELAXED, __HIP_MEMORY_SCOPE_AGENT);
}
__device__ __forceinline__ float rs_rinv(rs_t v) { return __builtin_amdgcn_rsqf((float)v * RS_INV + RS_EPS); }
#define PIN8(a) asm volatile("" : "+v"((a)[0]), "+v"((a)[1]), "+v"((a)[2]), "+v"((a)[3]), "+v"((a)[4]), "+v"((a)[5]), "+v"((a)[6]), "+v"((a)[7]))
template <int ACT> struct EpiBf16 {
    static constexpr bool PERM = true, AFTER_DRAIN = false;
    bf16_t *O0, *O1, *O2; int ld0, ld1, ld2, c1, c2; const rs_t* rs; int vt; int rs_from;
    __device__ __forceinline__ void operator()(const f32x4 (&acc)[2][2][4][2], const Unit& u, int wr, int wc, int fr, int fq) const {
        const int row0 = u.pm * BM + wr * 64 + fr; int colt = u.pn * BM; bf16_t* base = O0; int ldc = ld0;
        const rs_t* rs = (colt >= rs_from) ? this->rs : nullptr;
        bool tr = false;
        if (colt >= c2) { base = O2; ldc = ld2; colt -= c2; tr = vt != 0; } else if (colt >= c1) { base = O1; ldc = ld1; colt -= c1; }
        const int col0 = colt + wc * 32 + 8 * fq;
        rs_t scv[8];
#pragma unroll
        for (int gi = 0; gi < 8; ++gi) scv[gi] = rs ? rs[row0 + (gi >> 2) * HALF + (gi & 3) * 16] : 0ull;
        PIN8(scv);
#pragma unroll
        for (int ai = 0; ai < 2; ++ai)
#pragma unroll
            for (int m = 0; m < 4; ++m) { bf16_t* rowp = base + (size_t)(row0 + ai * HALF + m * 16) * ldc + col0; const float sc = rs ? rs_rinv(scv[ai * 4 + m]) : 1.0f;
#pragma unroll
                for (int bj = 0; bj < 2; ++bj) { f32x4 v0 = acc[ai][bj][m][0] * sc, v1 = acc[ai][bj][m][1] * sc;
                    if (ACT == 2) {
#pragma unroll
                        for (int j = 0; j < 4; ++j) { const float a = fmaxf(v0[j], 0.f), b = fmaxf(v1[j], 0.f); v0[j] = a * a; v1[j] = b * b; } }
                    u32x4 w; w.x = cvt_pk_bf16(v0[0], v0[1]); w.y = cvt_pk_bf16(v0[2], v0[3]); w.z = cvt_pk_bf16(v1[0], v1[1]); w.w = cvt_pk_bf16(v1[2], v1[3]);
                    if (vt == 2 && tr) {
                        unsigned char* tp = (unsigned char*)base + (size_t)(col0 + bj * HALF) * ldc + (row0 + ai * HALF + m * 16);
                        int w0 = __builtin_amdgcn_cvt_pk_fp8_f32(v0[0], v0[1], 0, false); w0 = __builtin_amdgcn_cvt_pk_fp8_f32(v0[2], v0[3], w0, true);
                        int w1 = __builtin_amdgcn_cvt_pk_fp8_f32(v1[0], v1[1], 0, false); w1 = __builtin_amdgcn_cvt_pk_fp8_f32(v1[2], v1[3], w1, true);
                        tp[0] = (unsigned char)w0; tp[(size_t)ldc] = (unsigned char)(w0 >> 8); tp[(size_t)2 * ldc] = (unsigned char)(w0 >> 16); tp[(size_t)3 * ldc] = (unsigned char)(w0 >> 24);
                        tp[(size_t)4 * ldc] = (unsigned char)w1; tp[(size_t)5 * ldc] = (unsigned char)(w1 >> 8); tp[(size_t)6 * ldc] = (unsigned char)(w1 >> 16); tp[(size_t)7 * ldc] = (unsigned char)(w1 >> 24); }
                    else if (tr) { bf16_t* tp = base + (size_t)(col0 + bj * HALF) * ldc + (row0 + ai * HALF + m * 16);
                        tp[0] = (bf16_t)w.x; tp[(size_t)ldc] = (bf16_t)(w.x >> 16); tp[(size_t)2 * ldc] = (bf16_t)w.y; tp[(size_t)3 * ldc] = (bf16_t)(w.y >> 16);
                        tp[(size_t)4 * ldc] = (bf16_t)w.z; tp[(size_t)5 * ldc] = (bf16_t)(w.z >> 16); tp[(size_t)6 * ldc] = (bf16_t)w.w; tp[(size_t)7 * ldc] = (bf16_t)(w.w >> 16); }
                    else *(u32x4*)(rowp + bj * HALF) = w; } }
    }
};
struct EpiF32 {
    static constexpr bool PERM = false, AFTER_DRAIN = false;
    float* C; int ldc;
    __device__ __forceinline__ void operator()(const f32x4 (&acc)[2][2][4][2], const Unit& u, int wr, int wc, int fr, int fq) const {
        const int row0 = u.pm * BM + wr * 64 + fr, col0 = u.pn * BM + wc * 32 + 4 * fq;
#pragma unroll
        for (int ai = 0; ai < 2; ++ai)
#pragma unroll
            for (int m = 0; m < 4; ++m) { float* rowp = C + (size_t)(row0 + ai * HALF + m * 16) * ldc + col0;
#pragma unroll
                for (int bj = 0; bj < 2; ++bj)
#pragma unroll
                    for (int n = 0; n < 2; ++n) *(f32x4*)(rowp + bj * HALF + n * 16) = acc[ai][bj][m][n]; }
    }
};
typedef unsigned u32x2 __attribute__((ext_vector_type(2)));
__device__ __forceinline__ f32x4 bf4_to_f32(u32x2 p) { return (f32x4){__builtin_bit_cast(float, p.x << 16), __builtin_bit_cast(float, p.x & 0xffff0000u), __builtin_bit_cast(float, p.y << 16), __builtin_bit_cast(float, p.y & 0xffff0000u)}; }
struct EpiRes {
    static constexpr bool PERM = false, AFTER_DRAIN = false;
    const bf16_t* base; bf16_t* out; rs_t* rs; int ldc; const rs_t* rsq;
    __device__ __forceinline__ void operator()(const f32x4 (&acc)[2][2][4][2], const Unit& u, int wr, int wc, int fr, int fq) const {
        constexpr int PD = 3;
        const int row0 = u.pm * BM + wr * 64 + fr, col0 = u.pn * BM + wc * 32 + 4 * fq;
        u32x2 nb[8][2][2];
        rs_t scv[8];
#pragma unroll
        for (int gi = 0; gi < 8; ++gi) scv[gi] = rsq ? rsq[row0 + (gi >> 2) * HALF + (gi & 3) * 16] : 0ull;
#define EPI_LD(g) do { const size_t o_ = (size_t)(row0 + ((g) >> 2) * HALF + ((g) & 3) * 16) * ldc + col0; _Pragma("unroll") for (int bj = 0; bj < 2; ++bj) _Pragma("unroll") for (int n = 0; n < 2; ++n) nb[g][bj][n] = *(const u32x2*)(base + o_ + bj * HALF + n * 16); } while (0)
#pragma unroll
        for (int g = 0; g < PD; ++g) EPI_LD(g);
        PIN8(scv);
#pragma unroll
        for (int gi = 0; gi < 8; ++gi) { const int ai = gi >> 2, m = gi & 3; const int row = row0 + ai * HALF + m * 16; const size_t off = (size_t)row * ldc + col0;
            if (gi + PD < 8) EPI_LD(gi + PD);
            const float sc2 = rsq ? __builtin_amdgcn_rcpf((float)scv[gi] * RS_INV + RS_EPS) : 1.0f;
            float ss = 0.f;
#pragma unroll
            for (int bj = 0; bj < 2; ++bj)
#pragma unroll
                for (int n = 0; n < 2; ++n) { const f32x4 o = bf4_to_f32(nb[gi][bj][n]) + acc[ai][bj][m][n] * sc2;
                    ss += (o[0] * o[0] + o[1] * o[1]) + (o[2] * o[2] + o[3] * o[3]);
                    u32x2 w; w.x = cvt_pk_bf16(o[0], o[1]); w.y = cvt_pk_bf16(o[2], o[3]); *(u32x2*)(out + off + bj * HALF + n * 16) = w; }
            row_ss_add(rs, row, ss, fq); }
#undef EPI_LD
    }
};
struct EpiGate {
    static constexpr bool PERM = false, AFTER_DRAIN = false;
    const bf16_t* base; bf16_t* out; float* out32; const bf16_t* pp; const rs_t* rsin; rs_t* rs; int ldc; unsigned char* out8;
    __device__ __forceinline__ void operator()(const f32x4 (&acc)[2][2][4][2], const Unit& u, int wr, int wc, int fr, int fq) const {
        constexpr int PD = 2;
        const int row0 = u.pm * BM + wr * 64 + fr, col0 = u.pn * BM + wc * 32 + 4 * fq;
        rs_t scv[8];
#pragma unroll
        for (int gi = 0; gi < 8; ++gi) scv[gi] = rsin[row0 + (gi >> 2) * HALF + (gi & 3) * 16];
        u32x2 nb[8][2][2], np[8][2][2];
#define EPI_LD(g) do { const size_t o_ = (size_t)(row0 + ((g) >> 2) * HALF + ((g) & 3) * 16) * ldc + col0; _Pragma("unroll") for (int bj = 0; bj < 2; ++bj) _Pragma("unroll") for (int n = 0; n < 2; ++n) { \
            nb[g][bj][n] = *(const u32x2*)(base + o_ + bj * HALF + n * 16); np[g][bj][n] = *(const u32x2*)(pp + o_ + bj * HALF + n * 16); } } while (0)
#pragma unroll
        for (int g = 0; g < PD; ++g) EPI_LD(g);
        PIN8(scv);
#pragma unroll
        for (int gi = 0; gi < 8; ++gi) { const int ai = gi >> 2, m = gi & 3; const int row = row0 + ai * HALF + m * 16; const size_t off = (size_t)row * ldc + col0;
            if (gi + PD < 8) EPI_LD(gi + PD);
            const float sc = rs_rinv(scv[gi]);
            float ss = 0.f;
#pragma unroll
            for (int bj = 0; bj < 2; ++bj)
#pragma unroll
                for (int n = 0; n < 2; ++n) { const f32x4 a = acc[ai][bj][m][n] * sc, p = bf4_to_f32(np[gi][bj][n]); f32x4 o = bf4_to_f32(nb[gi][bj][n]);
#pragma unroll
                    for (int j = 0; j < 4; ++j) o[j] += sigm(a[j]) * p[j];
                    if (out32) *(f32x4*)(out32 + off + bj * HALF + n * 16) = o;
                    if (out8) { int w8 = __builtin_amdgcn_cvt_pk_fp8_f32(o[0], o[1], 0, false); w8 = __builtin_amdgcn_cvt_pk_fp8_f32(o[2], o[3], w8, true); *(unsigned*)(out8 + off + bj * HALF + n * 16) = (unsigned)w8; }
                    ss += (o[0] * o[0] + o[1] * o[1]) + (o[2] * o[2] + o[3] * o[3]);
                    u32x2 w; w.x = cvt_pk_bf16(o[0], o[1]); w.y = cvt_pk_bf16(o[2], o[3]); *(u32x2*)(out + off + bj * HALF + n * 16) = w; }
            row_ss_add(rs, row, ss, fq); }
#undef EPI_LD
    }
};
struct EpiGlu {
    static constexpr bool PERM = false, AFTER_DRAIN = false;
    const bf16_t* base; bf16_t* out; rs_t* rs; int ldc;
    __device__ __forceinline__ void operator()(const f32x4 (&acc)[2][2][4][2], const Unit& u, int wr, int wc, int fr, int fq) const {
        constexpr int PD = 3;
        const int row0 = u.pm * BM + wr * 64 + fr, col0 = u.pn * HALF + wc * 32 + 4 * fq;
        u32x2 nb[8][2];
#define EPI_LD(g) do { const size_t o_ = (size_t)(row0 + ((g) >> 2) * HALF + ((g) & 3) * 16) * ldc + col0; _Pragma("unroll") for (int n = 0; n < 2; ++n) nb[g][n] = *(const u32x2*)(base + o_ + n * 16); } while (0)
#pragma unroll
        for (int g = 0; g < PD; ++g) EPI_LD(g);
#pragma unroll
        for (int gi = 0; gi < 8; ++gi) { const int ai = gi >> 2, m = gi & 3; const int row = row0 + ai * HALF + m * 16; const size_t off = (size_t)row * ldc + col0;
            if (gi + PD < 8) EPI_LD(gi + PD);
            float ss = 0.f;
#pragma unroll
            for (int n = 0; n < 2; ++n) { const f32x4 a = acc[ai][0][m][n], g = acc[ai][1][m][n]; f32x4 o = bf4_to_f32(nb[gi][n]);
#pragma unroll
                for (int j = 0; j < 4; ++j) o[j] += a[j] * sigm(g[j]);
                ss += (o[0] * o[0] + o[1] * o[1]) + (o[2] * o[2] + o[3] * o[3]);
                u32x2 w; w.x = cvt_pk_bf16(o[0], o[1]); w.y = cvt_pk_bf16(o[2], o[3]); *(u32x2*)(out + off + n * 16) = w; }
            row_ss_add(rs, row, ss, fq); }
#undef EPI_LD
    }
};

constexpr int S5T = 32, S5NCH = 512, S5KS = 768;
struct S5Order {
    int G, c, MT, NT;
    __device__ __forceinline__ bool next(int i, Unit& u) const { const int idx = i * G + c; if (idx >= 256 * MT * NT) return false; const int g = idx & 255, sub = idx >> 8;
        u.pm = g * MT + sub / NT; u.pn = g * NT + sub % NT; return true; }
    __device__ __forceinline__ void a_ready(const Unit&) const {}
    __device__ __forceinline__ void done(const Unit&) const {}
};
struct EpiS5U {
    static constexpr bool PERM = true, AFTER_DRAIN = false;
    bf16_t* UA; const rs_t* rs;
    __device__ __forceinline__ void operator()(const f32x4 (&acc)[2][2][4][2], const Unit& u, int wr, int wc, int fr, int fq) const {
        const int row0 = u.pm * BM + wr * 64 + fr, col0 = u.pn * BM + wc * 32 + 8 * fq;
        rs_t scv[8];
#pragma unroll
        for (int gi = 0; gi < 8; ++gi) scv[gi] = rs[row0 + (gi >> 2) * HALF + (gi & 3) * 16];
        PIN8(scv);
#pragma unroll
        for (int ai = 0; ai < 2; ++ai)
#pragma unroll
            for (int m = 0; m < 4; ++m) { const int t = row0 + ai * HALF + m * 16, c = t >> 5, sg = t & 31; const float sc = rs_rinv(scv[ai * 4 + m]);
#pragma unroll
                for (int bj = 0; bj < 2; ++bj) { const int col = col0 + bj * HALF, g = col >> 4, q0 = col & 15;
                    const f32x4 v0 = acc[ai][bj][m][0] * sc, v1 = acc[ai][bj][m][1] * sc;
                    u32x4 w; w.x = cvt_pk_bf16(v0[0], v0[1]); w.y = cvt_pk_bf16(v0[2], v0[3]); w.z = cvt_pk_bf16(v1[0], v1[1]); w.w = cvt_pk_bf16(v1[2], v1[3]);
                    *(u32x4*)(UA + ((size_t)(g * S5NCH + c) * S5KS + sg * 16 + q0)) = w; } }
    }
};
struct EpiS5E {
    static constexpr bool PERM = false, AFTER_DRAIN = false;
    float* E;
    __device__ __forceinline__ void operator()(const f32x4 (&acc)[2][2][4][2], const Unit& u, int wr, int wc, int fr, int fq) const {
        const int row0 = u.pm * BM + wr * 64 + fr, col0 = wc * 32 + 4 * fq;
#pragma unroll
        for (int ai = 0; ai < 2; ++ai)
#pragma unroll
            for (int m = 0; m < 4; ++m) { float* rowp = E + (size_t)(row0 + ai * HALF + m * 16) * 256 + col0;
#pragma unroll
                for (int bj = 0; bj < 2; ++bj)
#pragma unroll
                    for (int n = 0; n < 2; ++n) *(f32x4*)(rowp + bj * HALF + n * 16) = acc[ai][bj][m][n]; }
    }
};
__device__ __forceinline__ float gelu_tanh_f(float v) {
    const float z = 0.7978845608028654f * (v + 0.044715f * v * v * v);
    const float e = __builtin_amdgcn_exp2f(2.0f * 1.4426950408889634f * z);
    return 0.5f * v * (2.0f - 2.0f * __builtin_amdgcn_rcpf(e + 1.0f));
}
struct EpiS5Y {
    static constexpr bool PERM = true, AFTER_DRAIN = false;
    const bf16_t* UA; const float* dskip; bf16_t* G; int ldg;
    __device__ __forceinline__ void operator()(const f32x4 (&acc)[2][2][4][2], const Unit& u, int wr, int wc, int fr, int fq) const {
        const int row0 = u.pm * BM + wr * 64 + fr, col0 = (u.pn & 1) * BM + wc * 32 + 8 * fq;
        const int g = u.pm >> 1, p0 = col0 & 15;
        const f32x4 d0 = *(const f32x4*)(dskip + 16 * g + p0), d1 = *(const f32x4*)(dskip + 16 * g + p0 + 4);
        u32x4 uu[8][2];
#pragma unroll
        for (int gi = 0; gi < 8; ++gi)
#pragma unroll
            for (int bj = 0; bj < 2; ++bj) uu[gi][bj] = *(const u32x4*)(UA + ((size_t)(row0 + (gi >> 2) * HALF + (gi & 3) * 16) * S5KS + col0 + bj * HALF));
#pragma unroll
        for (int gi = 0; gi < 8; ++gi) asm volatile("" : "+v"(uu[gi][0]), "+v"(uu[gi][1]));
#pragma unroll
        for (int gi = 0; gi < 8; ++gi) { const int ai = gi >> 2, m = gi & 3; const int rowg = row0 + ai * HALF + m * 16, c = rowg & 511;
#pragma unroll
            for (int bj = 0; bj < 2; ++bj) { const int col = col0 + bj * HALF, tau = col >> 4; const u32x4 w4 = uu[gi][bj];
                f32x4 v0 = acc[ai][bj][m][0], v1 = acc[ai][bj][m][1];
                v0[0] += d0[0] * __builtin_bit_cast(float, w4.x << 16); v0[1] += d0[1] * __builtin_bit_cast(float, w4.x & 0xffff0000u);
                v0[2] += d0[2] * __builtin_bit_cast(float, w4.y << 16); v0[3] += d0[3] * __builtin_bit_cast(float, w4.y & 0xffff0000u);
                v1[0] += d1[0] * __builtin_bit_cast(float, w4.z << 16); v1[1] += d1[1] * __builtin_bit_cast(float, w4.z & 0xffff0000u);
                v1[2] += d1[2] * __builtin_bit_cast(float, w4.w << 16); v1[3] += d1[3] * __builtin_bit_cast(float, w4.w & 0xffff0000u);
#pragma unroll
                for (int j = 0; j < 4; ++j) { v0[j] = gelu_tanh_f(v0[j]); v1[j] = gelu_tanh_f(v1[j]); }
                int w0 = __builtin_amdgcn_cvt_pk_fp8_f32(16.f * v0[0], 16.f * v0[1], 0, false); w0 = __builtin_amdgcn_cvt_pk_fp8_f32(16.f * v0[2], 16.f * v0[3], w0, true);
                int w1 = __builtin_amdgcn_cvt_pk_fp8_f32(16.f * v1[0], 16.f * v1[1], 0, false); w1 = __builtin_amdgcn_cvt_pk_fp8_f32(16.f * v1[2], 16.f * v1[3], w1, true);
                *(v2u*)((unsigned char*)G + (size_t)(32 * c + tau) * ldg + 16 * g + p0) = (v2u){(unsigned)w0, (unsigned)w1}; } }
    }
};

template <class Epi, class Sched, bool ALIGN_EPI = false, bool SP2 = false, bool FP8 = false>
__device__ __forceinline__ void gemm_phase(PG8_LAS unsigned char* lds, const Gemm g, const Sched& S, const Epi& E) {
    int tid_o = wg_tid(); asm volatile("" : "+v"(tid_o)); const int tid = tid_o, wid = __builtin_amdgcn_readfirstlane(tid >> 6), lane = tid & 63, wr = wid >> 2, wc = wid & 3, fr = lane & 15, fq = lane >> 4;
    const int K = g.K, nt = K / BK;
    unsigned voffA[2], voffB[2];
#pragma unroll
    for (int i = 0; i < 2; ++i) { int R, C; stage_rc(tid * 16 + i * 8192, R, C); const int Rb = Epi::PERM ? ((R & ~31) + perm32(R & 31)) : R;
        voffA[i] = (unsigned)(R * g.lda + C) * 2u; voffB[i] = (unsigned)(Rb * g.ldb + C) * 2u; }
    const size_t kstep = (size_t)(BK * 2);
    const size_t hstepA = (size_t)HALF * g.lda * 2, hstepB = (size_t)HALF * g.ldb * 2;
    const size_t tstepA = 2 * hstepA, tstepB = 2 * hstepB;
    const unsigned ldsw = (unsigned)wid * 1024u;
    const int aoff = lds_byte(wr * 64 + fr, fq * 8), boff = lds_byte(wc * 32 + fr, fq * 8);
    const int aoff8 = lds_byte(wr * 64 + fr, fq * 16), boff8 = lds_byte(wc * 32 + fr, fq * 16);
#define PG8_SA(b, h) (((b) * 2 + (h)) * HTB)
#define PG8_SB(b, h) ((4 + (b) * 2 + (h)) * HTB)
#define PG8_STAGE(bufoff, gbase, voff) do { _Pragma("unroll") for (int _i = 0; _i < 2; ++_i) \
        __builtin_amdgcn_global_load_lds((const unsigned*)((const char*)(gbase) + (voff)[_i]), (PG8_LAS unsigned*)(lds + (bufoff) + ldsw + _i * 8192), 16, 0, 0); } while (0)
#define PG8_LDA(dst, b, h) do { if constexpr (FP8) { _Pragma("unroll") for (int m = 0; m < 4; ++m) { const PG8_LAS unsigned char* p_ = lds + PG8_SA(b, h) + aoff8 + m * 2048; const v4i32 l_ = *(const PG8_LAS v4i32*)p_, h_ = *(const PG8_LAS v4i32*)(p_ + 16); \
        dst##8[m] = __builtin_shufflevector(l_, h_, 0, 1, 2, 3, 4, 5, 6, 7); } } else { \
        _Pragma("unroll") for (int m = 0; m < 4; ++m) _Pragma("unroll") for (int k = 0; k < 2; ++k) dst[m][k] = *(const PG8_LAS bf16x8*)(lds + PG8_SA(b, h) + aoff + m * 2048 + k * 1024); } } while (0)
#define PG8_LDB(dst, b, h) do { if constexpr (FP8) { _Pragma("unroll") for (int n = 0; n < 2; ++n) { const PG8_LAS unsigned char* p_ = lds + PG8_SB(b, h) + boff8 + n * 2048; const v4i32 l_ = *(const PG8_LAS v4i32*)p_, h_ = *(const PG8_LAS v4i32*)(p_ + 16); \
        dst##8[n] = __builtin_shufflevector(l_, h_, 0, 1, 2, 3, 4, 5, 6, 7); } } else { \
        _Pragma("unroll") for (int n = 0; n < 2; ++n) _Pragma("unroll") for (int k = 0; k < 2; ++k) dst[n][k] = *(const PG8_LAS bf16x8*)(lds + PG8_SB(b, h) + boff + n * 2048 + k * 1024); } } while (0)
#define PG8_MMA(ai, bj, At, Bt) do { __builtin_amdgcn_s_setprio(1); if constexpr (FP8) { _Pragma("unroll") for (int m = 0; m < 4; ++m) _Pragma("unroll") for (int n = 0; n < 2; ++n) \
        asm volatile("v_mfma_scale_f32_16x16x128_f8f6f4 %0, %1, %2, %0, %3, %4 op_sel_hi:[0,0,0]" : "+v"(acc[ai][bj][m][n]) : "v"(Bt##8[n]), "v"(At##8[m]), "v"(sc_w8), "v"(sc_a8)); } else { \
        _Pragma("unroll") for (int m = 0; m < 4; ++m) _Pragma("unroll") for (int n = 0; n < 2; ++n) _Pragma("unroll") for (int k = 0; k < 2; ++k) \
        acc[ai][bj][m][n] = __builtin_amdgcn_mfma_f32_16x16x32_bf16(Bt[n][k], At[m][k], acc[ai][bj][m][n], 0, 0, 0); } __builtin_amdgcn_s_setprio(0); } while (0)
#define PG8_WAIT_V(n) asm volatile("s_waitcnt vmcnt(" #n ")" ::: "memory")
#define PG8_WAIT_L(n) asm volatile("s_waitcnt lgkmcnt(" #n ")" ::: "memory")
#define PG8_BAR __builtin_amdgcn_s_barrier()
#define PG8_SCHED __builtin_amdgcn_sched_barrier(0)
    Unit cur, nxt; int ui = 0;
    if (!S.next(0, cur)) return;
    f32x4 acc[2][2][4][2];
#pragma unroll
    for (int a = 0; a < 2; ++a)
#pragma unroll
        for (int b = 0; b < 2; ++b)
#pragma unroll
            for (int m = 0; m < 4; ++m)
#pragma unroll
                for (int n = 0; n < 2; ++n) acc[a][b][m][n] = (f32x4){0.f, 0.f, 0.f, 0.f};
    bf16x8 At[4][2], B0[2][2], B1[2][2];
    typedef int v8i32 __attribute__((ext_vector_type(8))); typedef int v4i32 __attribute__((ext_vector_type(4))); v8i32 At8[4], B08[2], B18[2];
    const int sc_w8 = 0x79797979, sc_a8 = g.sa;
    const char* cA = (const char*)g.A + (size_t)cur.pm * tstepA; const char* cB = (const char*)g.Bt + (size_t)cur.pn * tstepB;
    S.a_ready(cur);
    if constexpr (SP2) {
        PG8_STAGE(PG8_SB(0, 0), cB, voffB); PG8_STAGE(PG8_SB(0, 1), cB + hstepB, voffB); PG8_STAGE(PG8_SA(0, 0), cA, voffA); PG8_STAGE(PG8_SA(0, 1), cA + hstepA, voffA);
        if (wr == 1) PG8_BAR;
        PG8_WAIT_V(2); PG8_BAR;
        PG8_STAGE(PG8_SB(1, 0), cB + kstep, voffB); PG8_STAGE(PG8_SA(1, 0), cA + kstep, voffA); PG8_STAGE(PG8_SB(1, 1), cB + hstepB + kstep, voffB);
        PG8_WAIT_V(6); PG8_BAR;
    } else {
        PG8_STAGE(PG8_SB(0, 0), cB, voffB); PG8_STAGE(PG8_SA(0, 0), cA, voffA); PG8_STAGE(PG8_SB(0, 1), cB + hstepB, voffB); PG8_STAGE(PG8_SA(0, 1), cA + hstepA, voffA);
        if (wr == 1) PG8_BAR;
        PG8_WAIT_V(4); PG8_BAR;
        PG8_STAGE(PG8_SB(1, 0), cB + kstep, voffB); PG8_STAGE(PG8_SA(1, 0), cA + kstep, voffA); PG8_STAGE(PG8_SB(1, 1), cB + hstepB + kstep, voffB);
        PG8_WAIT_V(6); PG8_BAR;
    }
    for (;;) {
        const bool has_next = S.next(ui + 1, nxt);
        const char* nA = has_next ? (const char*)g.A + (size_t)nxt.pm * tstepA : cA; const char* nB = has_next ? (const char*)g.Bt + (size_t)nxt.pn * tstepB : cB;
        for (int t = 0; t < nt; t += 2) {
            const bool last = (t == nt - 2);
            const char* a1 = cA + (size_t)(t + 1) * kstep;
            const char* a2 = last ? nA : cA + (size_t)(t + 2) * kstep; const char* b2 = last ? nB : cB + (size_t)(t + 2) * kstep;
            const char* a3 = a2 + kstep; const char* b3 = b2 + kstep;
            if (last && has_next) S.a_ready(nxt);
            if constexpr (SP2) {
            PG8_LDB(B0, 0, 0); PG8_LDB(B1, 0, 1); PG8_SCHED; PG8_LDA(At, 0, 0); PG8_STAGE(PG8_SA(1, 1), a1 + hstepA, voffA);
            PG8_WAIT_V(8); PG8_WAIT_L(0); PG8_BAR; PG8_MMA(0, 0, At, B0); PG8_MMA(0, 1, At, B1); PG8_BAR; PG8_SCHED;
            PG8_LDA(At, 0, 1); PG8_STAGE(PG8_SB(0, 0), b2, voffB); PG8_STAGE(PG8_SB(0, 1), b2 + hstepB, voffB); PG8_STAGE(PG8_SA(0, 0), a2, voffA);
            PG8_WAIT_V(8); PG8_WAIT_L(0); PG8_BAR; PG8_MMA(1, 0, At, B0); PG8_MMA(1, 1, At, B1); PG8_BAR; PG8_SCHED;
            PG8_LDB(B0, 1, 0); PG8_LDB(B1, 1, 1); PG8_SCHED; PG8_LDA(At, 1, 0); PG8_STAGE(PG8_SA(0, 1), a2 + hstepA, voffA);
            PG8_WAIT_V(8); PG8_WAIT_L(0); PG8_BAR; PG8_MMA(0, 0, At, B0); PG8_MMA(0, 1, At, B1); PG8_BAR; PG8_SCHED;
            PG8_LDA(At, 1, 1); PG8_STAGE(PG8_SB(1, 0), b3, voffB); PG8_STAGE(PG8_SB(1, 1), b3 + hstepB, voffB); PG8_STAGE(PG8_SA(1, 0), a3, voffA);
            PG8_WAIT_V(8); PG8_WAIT_L(0); PG8_BAR; PG8_MMA(1, 0, At, B0); PG8_MMA(1, 1, At, B1); PG8_BAR; PG8_SCHED;
            } else {
            PG8_LDB(B0, 0, 0); PG8_SCHED; PG8_LDA(At, 0, 0); PG8_STAGE(PG8_SA(1, 1), a1 + hstepA, voffA);
            PG8_WAIT_L(8); PG8_BAR; PG8_WAIT_L(0); PG8_MMA(0, 0, At, B0); PG8_BAR; PG8_SCHED;
            PG8_LDB(B1, 0, 1); PG8_STAGE(PG8_SB(0, 0), b2, voffB);
            PG8_BAR; PG8_WAIT_L(0); PG8_MMA(0, 1, At, B1); PG8_BAR;
            PG8_LDA(At, 0, 1); PG8_STAGE(PG8_SA(0, 0), a2, voffA);
            PG8_BAR; PG8_WAIT_L(0); PG8_MMA(1, 0, At, B0); PG8_BAR; PG8_SCHED;
            PG8_STAGE(PG8_SB(0, 1), b2 + hstepB, voffB);
            PG8_WAIT_V(6); PG8_BAR; PG8_MMA(1, 1, At, B1); PG8_BAR;
            PG8_LDB(B0, 1, 0); PG8_SCHED; PG8_LDA(At, 1, 0); PG8_STAGE(PG8_SA(0, 1), a2 + hstepA, voffA);
            PG8_WAIT_L(8); PG8_BAR; PG8_WAIT_L(0); PG8_MMA(0, 0, At, B0); PG8_BAR; PG8_SCHED;
            PG8_LDB(B1, 1, 1); PG8_STAGE(PG8_SB(1, 0), b3, voffB);
            PG8_BAR; PG8_WAIT_L(0); PG8_MMA(0, 1, At, B1); PG8_BAR;
            PG8_LDA(At, 1, 1); PG8_STAGE(PG8_SA(1, 0), a3, voffA);
            PG8_BAR; PG8_WAIT_L(0); PG8_MMA(1, 0, At, B0); PG8_BAR; PG8_SCHED;
            PG8_STAGE(PG8_SB(1, 1), b3 + hstepB, voffB);
            PG8_WAIT_V(6); PG8_BAR; PG8_MMA(1, 1, At, B1); PG8_BAR;
            }
        }
        if constexpr (FP8) asm volatile("s_nop 15\n\ts_nop 7" ::: "memory");
        if constexpr (ALIGN_EPI) { if (wr == 0) PG8_BAR; }
        if constexpr (!Epi::AFTER_DRAIN) { E(acc, cur, wr, wc, fr, fq); PROBE_EPI_DUP S.done(cur); }
        if (!has_next) break;
#pragma unroll
        for (int a = 0; a < 2; ++a)
#pragma unroll
            for (int b = 0; b < 2; ++b)
#pragma unroll
                for (int m = 0; m < 4; ++m)
#pragma unroll
                    for (int n = 0; n < 2; ++n) acc[a][b][m][n] = (f32x4){0.f, 0.f, 0.f, 0.f};
        cur = nxt; cA = nA; cB = nB; ++ui;
        if constexpr (ALIGN_EPI) { if (wr == 1) PG8_BAR; }
    }
    PG8_WAIT_V(0);
    if constexpr (!ALIGN_EPI) { if (wr == 0) PG8_BAR; }
    PG8_BAR;
    if constexpr (Epi::AFTER_DRAIN) { E.fused(acc, cur, wr, wc, fr, fq, lds, wid, lane); S.done(cur); }
#undef PG8_SA
#undef PG8_SB
#undef PG8_STAGE
#undef PG8_LDA
#undef PG8_LDB
#undef PG8_MMA
#undef PG8_WAIT_V
#undef PG8_WAIT_L
#undef PG8_BAR
#undef PG8_SCHED
}
}
#define XB_TMO      128
#define XB_XCNT(j)  (256  + 64 * (j))
#define XB_XSUB(j)  (1280 + 64 * (j))
#define XB_XGEN(j)  (2304 + 64 * (j))
#define XB_TOP      3328
#define XB_TOPGEN   3392
#define XCD_BAR_WORDS 3456
#define XB_SPIN_CAP (1u << 18)

__device__ __forceinline__ unsigned xb_ld(unsigned* p)              { return __hip_atomic_load(p, __ATOMIC_RELAXED, __HIP_MEMORY_SCOPE_AGENT); }
__device__ __forceinline__ unsigned xb_add(unsigned* p, unsigned v) { return __hip_atomic_fetch_add(p, v, __ATOMIC_RELAXED, __HIP_MEMORY_SCOPE_AGENT); }
__device__ __forceinline__ unsigned xb_xcc_id() { return (unsigned)__builtin_amdgcn_s_getreg((3 << 11) | 20) & 0xFu; }
#define XB_SPIN(cond, bar) do { unsigned _sp = 0; while (cond) { __builtin_amdgcn_s_sleep(1); \
    if ((++_sp & 255u) == 0u) { if (xb_ld(&(bar)[XB_TMO])) break; if (_sp > XB_SPIN_CAP) { atomicAdd(&(bar)[XB_TMO], 1u); break; } } } } while (0)

struct XcdBarrier {
    unsigned* bar; unsigned x;
    volatile LAS unsigned* st;
};

__device__ __forceinline__ XcdBarrier xcd_barrier_post(unsigned* bar, volatile LAS unsigned* st) {
    XcdBarrier b; b.bar = bar; b.x = xb_xcc_id(); b.st = st;
    if (wg_tid() == 0) (void)xb_add(&bar[XB_XCNT(b.x)], 1u);
    return b;
}
__device__ __forceinline__ void xcd_barrier_complete(unsigned* bar, unsigned x, unsigned& nloc, unsigned& nx) {
    const unsigned G = gridDim.x * gridDim.y * gridDim.z;
    unsigned sum, cnt, mine, sp = 0u;
    for (;;) {
        sum = 0u; cnt = 0u; mine = 0u;
#pragma unroll
        for (unsigned j = 0; j < 16; ++j) { const unsigned c = xb_ld(&bar[XB_XCNT(j)]); sum += c; cnt += (c > 0u) ? 1u : 0u; mine = (j == x) ? c : mine; }
        if (sum == G) break;
        __builtin_amdgcn_s_sleep(1);
        if ((++sp & 255u) == 0u) { if (xb_ld(&bar[XB_TMO])) break; if (sp > XB_SPIN_CAP) { atomicAdd(&bar[XB_TMO], 1u); break; } }
    }
    nloc = mine > 0u ? mine : 1u; nx = cnt > 0u ? cnt : 1u;
}

__device__ __forceinline__ void xcd_barrier(const XcdBarrier& b) {
    asm volatile("s_waitcnt vmcnt(0)" ::: "memory");
    __syncthreads();
    if (wg_tid() == 0) {
        unsigned* bar = b.bar;
        __builtin_amdgcn_s_waitcnt(0);
        unsigned nloc = b.st[0], nx = b.st[1];
        if (nloc == 0u) { xcd_barrier_complete(bar, b.x, nloc, nx); b.st[0] = nloc; b.st[1] = nx; }
        const unsigned old = xb_add(&bar[XB_XSUB(b.x)], 1u);
        const unsigned gen = old / nloc;
        if (old + 1u == (gen + 1u) * nloc) {
            __builtin_amdgcn_fence(__ATOMIC_RELEASE, "agent");
            asm volatile("s_waitcnt vmcnt(0)" ::: "memory");
            const unsigned og = xb_add(&bar[XB_TOP], 1u);
            const unsigned tg = og / nx;
            if (og + 1u == (tg + 1u) * nx) xb_add(&bar[XB_TOPGEN], 1u);
            else XB_SPIN(xb_ld(&bar[XB_TOPGEN]) == tg, bar);
            __builtin_amdgcn_fence(__ATOMIC_ACQUIRE, "agent");
            xb_add(&bar[XB_XGEN(b.x)], 1u);
            asm volatile("s_waitcnt vmcnt(0)" ::: "memory");
        } else {
            XB_SPIN(xb_ld(&bar[XB_XGEN(b.x)]) == gen, bar);
            __builtin_amdgcn_fence(__ATOMIC_ACQUIRE, "agent");
            asm volatile("s_waitcnt vmcnt(0)" ::: "memory");
        }
    }
    __syncthreads();
}
namespace dattn {
typedef unsigned short bf16;
constexpr int   D = 128, NW = 8, QBLK = 32, KVBLK = 64;
constexpr float SCALE = 0.088388347648318440f;
constexpr float THR = 8.f;
constexpr int SDEPTH = 2;
constexpr int LDQ = 4096, LDK = 1024, LDO = 4096;
constexpr size_t SHM_V = KVBLK * D * 2, SHM_K = KVBLK * D * 2, SHM_ATTN = 3 * SHM_V + 3 * SHM_K + NW * 64 * 4 + 2048;
using bf16x8 = __attribute__((ext_vector_type(8))) short;
using s16x4  = __attribute__((ext_vector_type(4))) short;
using f32x16 = __attribute__((ext_vector_type(16))) float;
using f32x8  = __attribute__((ext_vector_type(8))) float;
using u32x4  = __attribute__((ext_vector_type(4))) unsigned;
#define KSWZ(row, colB) ((row) * 256 + ((colB) ^ (((row) & 7) << 4)))
#define SBAR() __builtin_amdgcn_sched_barrier(0)
__device__ __forceinline__ int crow(int r, int hi) { return (r & 3) + 8 * (r >> 2) + 4 * hi; }
__device__ __forceinline__ unsigned cvtpk(float lo, float hi) {
  unsigned r; asm volatile("v_cvt_pk_bf16_f32 %0, %1, %2" : "=v"(r) : "v"(lo), "v"(hi)); return r;
}
template <typename TIn> struct Stage;
template <> struct Stage<bf16>  { using T = bf16x8;
  __device__ static __forceinline__ T ld8(const bf16* p) { return *reinterpret_cast<const bf16x8*>(p); }
  __device__ static __forceinline__ bf16x8 tobf(T x) { return x; } };
template <> struct Stage<float> { using T = f32x8;
  __device__ static __forceinline__ T ld8(const float* p) { return *reinterpret_cast<const f32x8*>(p); }
  __device__ static __forceinline__ bf16x8 tobf(T x) {
    u32x4 w = {cvtpk(x[0], x[1]), cvtpk(x[2], x[3]), cvtpk(x[4], x[5]), cvtpk(x[6], x[7])}; return *reinterpret_cast<bf16x8*>(&w); } };

__device__ __forceinline__ void partialSM(f32x16& p0, f32x16& p1, float& m_reg, float& mn, float& alpha) {
  constexpr float C = SCALE * 1.4426950408889634f;
  float pmax = p0[0]; for (int r = 1; r < 16; ++r) pmax = fmaxf(pmax, p0[r]); for (int r = 0; r < 16; ++r) pmax = fmaxf(pmax, p1[r]);
  { auto rr = __builtin_amdgcn_permlane32_swap(__float_as_uint(pmax), __float_as_uint(pmax), false, false);
    pmax = fmaxf(__uint_as_float(rr[0]), __uint_as_float(rr[1])); }
  if (__builtin_expect(__all(pmax - m_reg <= THR / SCALE), 1)) { mn = m_reg; alpha = 1.f; }
  else { mn = fmaxf(m_reg, pmax); alpha = __builtin_amdgcn_exp2f((m_reg - mn) * C); m_reg = mn; }
  float mnC = -mn * C;
  for (int r = 0; r < 16; ++r) p0[r] = fmaf(p0[r], C, mnC); for (int r = 0; r < 16; ++r) p1[r] = fmaf(p1[r], C, mnC);
  for (int r = 0; r < 16; ++r) p0[r] = __builtin_amdgcn_exp2f(p0[r]);
}
__device__ __forceinline__ void finishSM(f32x16& p0, f32x16& p1, float alpha, float& l_reg, bf16x8& pa0, bf16x8& pa1, bf16x8& pa2, bf16x8& pa3) {
  for (int r = 0; r < 16; ++r) p1[r] = __builtin_amdgcn_exp2f(p1[r]);
  float ps = 0; for (int r = 0; r < 16; ++r) ps += p0[r]; for (int r = 0; r < 16; ++r) ps += p1[r];
  { auto rr = __builtin_amdgcn_permlane32_swap(__float_as_uint(ps), __float_as_uint(ps), false, false);
    ps = __uint_as_float(rr[0]) + __uint_as_float(rr[1]); }
  l_reg = l_reg * alpha + ps;
#define PK4(P, BASE, OUT) do { unsigned a0 = cvtpk(P[BASE + 0], P[BASE + 1]), a1 = cvtpk(P[BASE + 2], P[BASE + 3]);   \
    unsigned b0 = cvtpk(P[BASE + 4], P[BASE + 5]), b1 = cvtpk(P[BASE + 6], P[BASE + 7]);                              \
    auto r0 = __builtin_amdgcn_permlane32_swap(a0, b0, false, false); auto r1 = __builtin_amdgcn_permlane32_swap(a1, b1, false, false); \
    u32x4 w = {r0[0], r1[0], r0[1], r1[1]}; OUT = *reinterpret_cast<bf16x8*>(&w); } while (0)
  PK4(p0, 0, pa0); PK4(p0, 8, pa1); PK4(p1, 0, pa2); PK4(p1, 8, pa3);
#undef PK4
}
__device__ __forceinline__ void qkt(f32x16& p0, f32x16& p1, const bf16* Ks, const bf16x8* qr, int r32, int hi) {
  p0 = f32x16{}; p1 = f32x16{};
  bf16x8 nb0 = *reinterpret_cast<const bf16x8*>((const char*)Ks + KSWZ(r32, (hi * 8) * 2)), nb1 = *reinterpret_cast<const bf16x8*>((const char*)Ks + KSWZ(32 + r32, (hi * 8) * 2));
#pragma unroll
  for (int d0 = 0; d0 < 8; ++d0) { const bf16x8 b0 = nb0, b1 = nb1;
    if (d0 < 7) { const int cb = ((d0 + 1) * 16 + hi * 8) * 2;
      nb0 = *reinterpret_cast<const bf16x8*>((const char*)Ks + KSWZ(r32, cb)); nb1 = *reinterpret_cast<const bf16x8*>((const char*)Ks + KSWZ(32 + r32, cb)); }
    p0 = __builtin_amdgcn_mfma_f32_32x32x16_bf16(b0, qr[d0], p0, 0, 0, 0);
    p1 = __builtin_amdgcn_mfma_f32_32x32x16_bf16(b1, qr[d0], p1, 0, 0, 0); }
}
__device__ __forceinline__ int v_st(int k, int c) { const int kk = (k & ~0xC) | ((k & 4) << 1) | ((k & 8) >> 1); return ((kk >> 3) * 4 + (c >> 5)) * 512 + ((kk & 7) * 32 + (c & 31)) * 2; }
__device__ __forceinline__ int v_rd_base(int lane) { return ((lane & 3) << 3) | (((lane >> 2) & 3) << 6) | (((lane >> 4) & 1) << 5) | (((lane >> 5) & 1) << 8); }
constexpr int v_rd_off(int d0, int ks, int half) { return d0 * 512 + ks * 4096 + half * 2048; }
template <int OFF> __device__ __forceinline__ s16x4 tr_read(int vb) {
  s16x4 r; asm volatile("ds_read_b64_tr_b16 %0, %1 offset:%2" : "=&v"(r) : "v"(vb), "i"(OFF) : "memory"); return r;
}
template <int D0> __device__ __forceinline__ void pv_one(f32x16& od, int vb, bf16x8 pa0, bf16x8 pa1, bf16x8 pa2, bf16x8 pa3) {
  const s16x4 l0 = tr_read<v_rd_off(D0, 0, 0)>(vb), h0 = tr_read<v_rd_off(D0, 0, 1)>(vb), l1 = tr_read<v_rd_off(D0, 1, 0)>(vb), h1 = tr_read<v_rd_off(D0, 1, 1)>(vb);
  const s16x4 l2 = tr_read<v_rd_off(D0, 2, 0)>(vb), h2 = tr_read<v_rd_off(D0, 2, 1)>(vb), l3 = tr_read<v_rd_off(D0, 3, 0)>(vb), h3 = tr_read<v_rd_off(D0, 3, 1)>(vb);
  asm volatile("s_waitcnt lgkmcnt(0)" ::: "memory"); SBAR();
#define PK(L, H) (bf16x8){L[0], L[1], L[2], L[3], H[0], H[1], H[2], H[3]}
  od = __builtin_amdgcn_mfma_f32_32x32x16_bf16(pa0, PK(l0, h0), od, 0, 0, 0);
  od = __builtin_amdgcn_mfma_f32_32x32x16_bf16(pa1, PK(l1, h1), od, 0, 0, 0);
  od = __builtin_amdgcn_mfma_f32_32x32x16_bf16(pa2, PK(l2, h2), od, 0, 0, 0);
  od = __builtin_amdgcn_mfma_f32_32x32x16_bf16(pa3, PK(l3, h3), od, 0, 0, 0);
#undef PK
}
__device__ __forceinline__ void pv_d0(f32x16* o, int vb, bf16x8 pa0, bf16x8 pa1, bf16x8 pa2, bf16x8 pa3) {
  pv_one<0>(o[0], vb, pa0, pa1, pa2, pa3); pv_one<1>(o[1], vb, pa0, pa1, pa2, pa3); pv_one<2>(o[2], vb, pa0, pa1, pa2, pa3); pv_one<3>(o[3], vb, pa0, pa1, pa2, pa3);
}

template <typename TQ>
__device__ __forceinline__ void attn_dense_body(const TQ* __restrict__ Qb, const bf16* __restrict__ Kh, const bf16* __restrict__ Vh,
                                                bf16* __restrict__ Ob, int seq, char* lds) {
  using St = Stage<bf16>; using SQ = Stage<TQ>;
  int tid_o = wg_tid(); asm volatile("" : "+v"(tid_o)); const int tid = tid_o, wid = __builtin_amdgcn_readfirstlane(tid >> 6), lane = tid & 63, r32 = lane & 31, hi = lane >> 5;
  bf16* V_lds = (bf16*)lds; bf16* K_lds = (bf16*)(lds + 3 * SHM_V);
  float* ws = (float*)(lds + 3 * SHM_V + 3 * SHM_K) + wid * 64; float* li_l = ws; float* al_l = ws + 32;
  float m_reg = -1e30f, l_reg = 0; f32x16 o[4] = {}; bf16x8 qr[8];
  const TQ* Qw = Qb + (long)(wid * QBLK + r32) * LDQ + hi * 8;
#pragma unroll
  for (int d0 = 0; d0 < 8; ++d0) qr[d0] = SQ::tobf(SQ::ld8(Qw + d0 * 16));
  const int sr = tid >> 4, sc = (tid & 15) * 8, vst0 = v_st(sr, sc), vst1 = v_st(32 + sr, sc);
  const int vb0 = (int)(uintptr_t)V_lds + v_rd_base(lane);
  struct { typename St::T vs0, vs1, ks0, ks1; } sr_[SDEPTH];
#define SLOAD(i, k0) do { sr_[i].vs0 = St::ld8(&Vh[(long)((k0) + sr) * LDK + sc]); sr_[i].vs1 = St::ld8(&Vh[(long)((k0) + 32 + sr) * LDK + sc]); \
    sr_[i].ks0 = St::ld8(&Kh[(long)((k0) + sr) * LDK + sc]); sr_[i].ks1 = St::ld8(&Kh[(long)((k0) + 32 + sr) * LDK + sc]); } while (0)
#define SWRITE(b, i) do { *(bf16x8*)((char*)V_lds + (b) * SHM_V + vst0) = St::tobf(sr_[i].vs0);          \
    *(bf16x8*)((char*)V_lds + (b) * SHM_V + vst1) = St::tobf(sr_[i].vs1); int kc = sc * 2;               \
    *(bf16x8*)((char*)K_lds + (b) * SHM_K + KSWZ(sr, kc)) = St::tobf(sr_[i].ks0);                       \
    *(bf16x8*)((char*)K_lds + (b) * SHM_K + KSWZ(32 + sr, kc)) = St::tobf(sr_[i].ks1); } while (0)
#define SWAIT() do { if constexpr (SDEPTH == 2) asm volatile("s_waitcnt vmcnt(4)" ::: "memory"); else asm volatile("s_waitcnt vmcnt(0)" ::: "memory"); } while (0)
#define RESC(a) do { if (__any((a) < 1.f)) { if (hi == 0) al_l[r32] = (a); asm volatile("s_waitcnt lgkmcnt(0)" ::: "memory"); \
    for (int d = 0; d < 4; ++d) for (int r = 0; r < 16; ++r) o[d][r] *= al_l[crow(r, hi)]; } } while (0)
  f32x16 pA0, pA1, pB0, pB1; float mnA, mnB, alA, alB; bf16x8 pa0, pa1, pa2, pa3; const int NT = seq / KVBLK;
  constexpr int SE = 0, SO = SDEPTH - 1;
  SLOAD(SE, 0); asm volatile("s_waitcnt vmcnt(0)" ::: "memory"); SWRITE(0, SE); __syncthreads();
  qkt(pA0, pA1, K_lds, qr, r32, hi); partialSM(pA0, pA1, m_reg, mnA, alA);
  SLOAD(SO, KVBLK); if constexpr (SDEPTH == 2) { if (2 < NT) SLOAD(SE, 2 * KVBLK); }
  SWAIT(); SWRITE(1, SO); __syncthreads();
  int bk = 1, bv = 0, bw = 2;
  if (wid >= 4) __builtin_amdgcn_s_setprio(1);
#define ROT3() do { const int t_ = bv; bv = bk; bk = bw; bw = t_; } while (0)
  for (int j = 1; j + 1 < NT; j += 2) {
    SBAR(); qkt(pB0, pB1, (bf16*)((char*)K_lds + bk * SHM_K), qr, r32, hi);
    finishSM(pA0, pA1, alA, l_reg, pa0, pa1, pa2, pa3); SBAR();
    SLOAD(SO, (j + SDEPTH) * KVBLK); SBAR();
    pv_d0(o, vb0 + bv * (int)SHM_V, pa0, pa1, pa2, pa3); partialSM(pB0, pB1, m_reg, mnB, alB);
    SWAIT(); SWRITE(bw, SE);
    RESC(alB); __syncthreads(); ROT3();
    SBAR(); qkt(pA0, pA1, (bf16*)((char*)K_lds + bk * SHM_K), qr, r32, hi);
    finishSM(pB0, pB1, alB, l_reg, pa0, pa1, pa2, pa3); SBAR();
    if (SDEPTH == 1 || j + 3 < NT) SLOAD(SE, (j + 1 + SDEPTH) * KVBLK); SBAR();
    pv_d0(o, vb0 + bv * (int)SHM_V, pa0, pa1, pa2, pa3); partialSM(pA0, pA1, m_reg, mnA, alA);
    SWAIT(); SWRITE(bw, SO);
    RESC(alA); __syncthreads(); ROT3();
  }
  SBAR(); qkt(pB0, pB1, (bf16*)((char*)K_lds + bk * SHM_K), qr, r32, hi);
  finishSM(pA0, pA1, alA, l_reg, pa0, pa1, pa2, pa3); SBAR();
  pv_d0(o, vb0 + bv * (int)SHM_V, pa0, pa1, pa2, pa3); partialSM(pB0, pB1, m_reg, mnB, alB);
  RESC(alB);
  finishSM(pB0, pB1, alB, l_reg, pa0, pa1, pa2, pa3); SBAR();
  pv_d0(o, vb0 + bk * (int)SHM_V, pa0, pa1, pa2, pa3);
#undef ROT3
  __builtin_amdgcn_s_setprio(0);
  if (hi == 0) li_l[r32] = l_reg; asm volatile("s_waitcnt lgkmcnt(0)" ::: "memory");
  float rli[16];
#pragma unroll
  for (int r = 0; r < 16; ++r) rli[r] = __builtin_amdgcn_rcpf(li_l[crow(r, hi)]);
  bf16* Ow = Ob + (long)(wid * QBLK) * LDO;
#pragma unroll
  for (int r = 0; r < 16; ++r) { int orow = crow(r, hi);
    for (int d0 = 0; d0 < 4; ++d0) Ow[(long)orow * LDO + d0 * 32 + r32] = (bf16)(cvtpk(o[d0][r] * rli[r], 0.f) & 0xffffu); }
#undef SLOAD
#undef SWRITE
#undef SWAIT
#undef RESC
}

constexpr int NA_LD = 4096, NA_TILES = 12;
__device__ __forceinline__ void na_block_body(const bf16* __restrict__ Qb, const bf16* __restrict__ Kh, const bf16* __restrict__ Vh, bf16* __restrict__ Ob,
                                              const float* __restrict__ rpb_h, const float* __restrict__ qgain, const float* __restrict__ kgain, int R, int ks, char* lds) {
  using St = Stage<bf16>;
  int tid_o = wg_tid(); asm volatile("" : "+v"(tid_o)); const int tid = tid_o, wid = __builtin_amdgcn_readfirstlane(tid >> 6), lane = tid & 63, r32 = lane & 31, hi = lane >> 5;
  bf16* V_lds = (bf16*)lds; bf16* K_lds = (bf16*)(lds + 2 * SHM_V);
  float* ws = (float*)(lds + 2 * SHM_V + 2 * SHM_K) + wid * 64; float* li_l = ws; float* al_l = ws + 32;
  float* bt = (float*)(lds + 2 * SHM_V + 2 * SHM_K + NW * 64 * 4);
  float m_reg = -1e30f, l_reg = 0; f32x16 o[4] = {}; bf16x8 qr[8];
  const bf16* Qw = Qb + (long)(wid * QBLK + r32) * NA_LD + hi * 8;
#pragma unroll
  for (int d0 = 0; d0 < 8; ++d0) qr[d0] = St::ld8(Qw + d0 * 16);
  {
    float ss = 0.f;
#pragma unroll
    for (int d0 = 0; d0 < 8; ++d0) { const u32x4 w = __builtin_bit_cast(u32x4, qr[d0]);
#pragma unroll
      for (int e = 0; e < 4; ++e) { const float a = __uint_as_float(w[e] << 16), b = __uint_as_float(w[e] & 0xffff0000u); ss += a * a + b * b; } }
    ss += __shfl_xor(ss, 32);
    const float rinv = __builtin_amdgcn_rsqf(ss * (1.0f / 128.0f) + 1e-6f);
#pragma unroll
    for (int d0 = 0; d0 < 8; ++d0) { const u32x4 w = __builtin_bit_cast(u32x4, qr[d0]); const float* gp = qgain + d0 * 16 + hi * 8;
      const f32x8 g = *reinterpret_cast<const f32x8*>(gp); u32x4 o;
#pragma unroll
      for (int e = 0; e < 4; ++e) o[e] = cvtpk(__uint_as_float(w[e] << 16) * rinv * g[2 * e], __uint_as_float(w[e] & 0xffff0000u) * rinv * g[2 * e + 1]);
      qr[d0] = __builtin_bit_cast(bf16x8, o); } }
  const f32x8 kg = *reinterpret_cast<const f32x8*>(kgain + (tid & 15) * 8);
  for (int i = tid; i < 15 * 31; i += 64 * NW) bt[i] = rpb_h[i];
  const int sr = tid >> 4, sc = (tid & 15) * 8, vst0 = v_st(sr, sc), vst1 = v_st(32 + sr, sc);
  const int vb0 = (int)(uintptr_t)V_lds + v_rd_base(lane);
  bf16x8 s_vs0, s_vs1, s_ks0, s_ks1;
#define NLOAD(k0) do { s_vs0 = St::ld8(&Vh[(long)((k0) + sr) * NA_LD + sc]); s_vs1 = St::ld8(&Vh[(long)((k0) + 32 + sr) * NA_LD + sc]); \
    s_ks0 = St::ld8(&Kh[(long)((k0) + sr) * NA_LD + sc]); s_ks1 = St::ld8(&Kh[(long)((k0) + 32 + sr) * NA_LD + sc]); } while (0)
#define KNORM(x) do { const u32x4 w_ = __builtin_bit_cast(u32x4, x); float a_[8]; float ss_ = 0.f; \
    _Pragma("unroll") for (int e = 0; e < 4; ++e) { a_[2 * e] = __uint_as_float(w_[e] << 16); a_[2 * e + 1] = __uint_as_float(w_[e] & 0xffff0000u); ss_ += a_[2 * e] * a_[2 * e] + a_[2 * e + 1] * a_[2 * e + 1]; } \
    ss_ += __shfl_xor(ss_, 1); ss_ += __shfl_xor(ss_, 2); ss_ += __shfl_xor(ss_, 4); ss_ += __shfl_xor(ss_, 8); \
    const float ri_ = __builtin_amdgcn_rsqf(ss_ * (1.0f / 128.0f) + 1e-6f); u32x4 o_; \
    _Pragma("unroll") for (int e = 0; e < 4; ++e) o_[e] = cvtpk(a_[2 * e] * ri_ * kg[2 * e], a_[2 * e + 1] * ri_ * kg[2 * e + 1]); \
    x = __builtin_bit_cast(bf16x8, o_); } while (0)
#define NWRITE(b) do { KNORM(s_ks0); KNORM(s_ks1); \
    *(bf16x8*)((char*)V_lds + (b) * SHM_V + vst0) = s_vs0; *(bf16x8*)((char*)V_lds + (b) * SHM_V + vst1) = s_vs1; const int kc_ = sc * 2; \
    *(bf16x8*)((char*)K_lds + (b) * SHM_K + KSWZ(sr, kc_)) = s_ks0; *(bf16x8*)((char*)K_lds + (b) * SHM_K + KSWZ(32 + sr, kc_)) = s_ks1; } while (0)
  const int qrow = R + (wid >> 1), r0q = min(max(qrow - 4, 0), 248), jlo = r0q - ks;
  const int c = 32 * (wid & 1) + r32, c0 = min(max(c - 8, 0), 48);
  NLOAD(0); asm volatile("s_waitcnt vmcnt(0)" ::: "memory"); NWRITE(0); __syncthreads();
  for (int j = 0; j < NA_TILES; ++j) {
    const int buf = j & 1;
    if (j + 1 < NA_TILES) NLOAD((j + 1) * KVBLK);
    if (j >= jlo && j < jlo + 8) {
      f32x16 p0, p1; float mn, al; bf16x8 pa0, pa1, pa2, pa3;
      SBAR(); qkt(p0, p1, (bf16*)((char*)K_lds + buf * SHM_K), qr, r32, hi);
      const float* brow = bt + (ks + j - qrow + 7) * 31 + (15 - c);
#pragma unroll
      for (int r = 0; r < 16; ++r) { const int k0 = crow(r, hi), k1 = 32 + k0; const bool v0 = (k0 >= c0) && (k0 < c0 + 16), v1 = (k1 >= c0) && (k1 < c0 + 16);
        const float b0 = brow[v0 ? k0 : c], b1 = brow[v1 ? k1 : c];
        p0[r] = v0 ? fmaf(b0, 1.0f / SCALE, p0[r]) : -1e30f; p1[r] = v1 ? fmaf(b1, 1.0f / SCALE, p1[r]) : -1e30f; }
      partialSM(p0, p1, m_reg, mn, al);
      if (__any(al < 1.f)) { if (hi == 0) al_l[r32] = al; asm volatile("s_waitcnt lgkmcnt(0)" ::: "memory");
#pragma unroll
        for (int d = 0; d < 4; ++d)
#pragma unroll
          for (int r = 0; r < 16; ++r) o[d][r] *= al_l[crow(r, hi)]; }
      finishSM(p0, p1, al, l_reg, pa0, pa1, pa2, pa3); SBAR();
      pv_d0(o, vb0 + buf * (int)SHM_V, pa0, pa1, pa2, pa3);
    }
    if (j + 1 < NA_TILES) { asm volatile("s_waitcnt vmcnt(0)" ::: "memory"); NWRITE(buf ^ 1); }
    __syncthreads();
  }
  if (hi == 0) li_l[r32] = l_reg; asm volatile("s_waitcnt lgkmcnt(0)" ::: "memory");
  float rli[16];
#pragma unroll
  for (int r = 0; r < 16; ++r) rli[r] = 64.0f * __builtin_amdgcn_rcpf(li_l[crow(r, hi)]);
  unsigned char* Ow = (unsigned char*)Ob + (long)(wid * QBLK) * NA_LD;
#pragma unroll
  for (int r = 0; r < 16; ++r) { const int orow = crow(r, hi);
    for (int d0 = 0; d0 < 4; ++d0) Ow[(long)orow * NA_LD + d0 * 32 + r32] = (unsigned char)__builtin_amdgcn_cvt_pk_fp8_f32(o[d0][r] * rli[r], 0.f, 0, false); }
#undef NLOAD
#undef NWRITE
#undef KNORM
}

typedef int v8i __attribute__((ext_vector_type(8)));
typedef unsigned u32x2 __attribute__((ext_vector_type(2)));
constexpr int K8_LD = 1024, V8_LD = 16384, SHM_K8 = KVBLK * D, SHM_V8 = KVBLK * D;
constexpr float THR8 = 3.0f;
__device__ __forceinline__ int cvt4_fp8(float a, float b, float c, float d) { int w = __builtin_amdgcn_cvt_pk_fp8_f32(a, b, 0, false); return __builtin_amdgcn_cvt_pk_fp8_f32(c, d, w, true); }
typedef short s16x2 __attribute__((ext_vector_type(2)));
__device__ __forceinline__ int cvt4_fp8_scl(int w, float a, float b, float c, float d, float scl) {
  s16x2 t = __builtin_bit_cast(s16x2, w); t = __builtin_amdgcn_cvt_scalef32_pk_fp8_f32(t, a, b, scl, false); t = __builtin_amdgcn_cvt_scalef32_pk_fp8_f32(t, c, d, scl, true); return __builtin_bit_cast(int, t); }
__device__ __forceinline__ v8i mk8(u32x4 lo, u32x4 hi) { return (v8i){(int)lo[0], (int)lo[1], (int)lo[2], (int)lo[3], (int)hi[0], (int)hi[1], (int)hi[2], (int)hi[3]}; }
__device__ __forceinline__ void qkt8(f32x16& p0, f32x16& p1, const char* Ks, const v8i* qf, int r32, int hi) {
  const int x0 = (r32 >> 1) & 7, x1 = ((32 + r32) >> 1) & 7;
  const char* k0 = Ks + r32 * 128; const char* k1 = Ks + (32 + r32) * 128;
  v8i a[2][2];
#pragma unroll
  for (int s = 0; s < 2; ++s) { const int c = 4 * s + 2 * hi;
    a[0][s] = mk8(*reinterpret_cast<const u32x4*>(k0 + 16 * (c ^ x0)), *reinterpret_cast<const u32x4*>(k0 + 16 * ((c + 1) ^ x0)));
    a[1][s] = mk8(*reinterpret_cast<const u32x4*>(k1 + 16 * (c ^ x1)), *reinterpret_cast<const u32x4*>(k1 + 16 * ((c + 1) ^ x1))); }
  p0 = f32x16{}; p1 = f32x16{};
#pragma unroll
  for (int s = 0; s < 2; ++s) {
    p0 = __builtin_amdgcn_mfma_scale_f32_32x32x64_f8f6f4(a[0][s], qf[s], p0, 0, 0, 0, 0x7F7F7F7F, 0, 0x7C7C7C7C);
    p1 = __builtin_amdgcn_mfma_scale_f32_32x32x64_f8f6f4(a[1][s], qf[s], p1, 0, 0, 0, 0x7F7F7F7F, 0, 0x7C7C7C7C); }
}
constexpr float THR2 = 4.0f;
__device__ __forceinline__ void partialSM8(f32x16& p0, f32x16& p1, float& m_reg, float& scl, float& alpha) {
  float pmax;
  asm("v_max3_f32 %0, %1, %2, %3\n\tv_max3_f32 %0, %0, %4, %5\n\tv_max3_f32 %0, %0, %6, %7\n\tv_max3_f32 %0, %0, %8, %9\n\tv_max3_f32 %0, %0, %10, %11\n\tv_max3_f32 %0, %0, %12, %13\n\tv_max3_f32 %0, %0, %14, %15\n\tv_max_f32 %0, %0, %16"
      : "=&v"(pmax) : "v"(p0[0]), "v"(p0[1]), "v"(p0[2]), "v"(p0[3]), "v"(p0[4]), "v"(p0[5]), "v"(p0[6]), "v"(p0[7]), "v"(p0[8]), "v"(p0[9]), "v"(p0[10]), "v"(p0[11]), "v"(p0[12]), "v"(p0[13]), "v"(p0[14]), "v"(p0[15]));
  asm("v_max3_f32 %0, %0, %1, %2\n\tv_max3_f32 %0, %0, %3, %4\n\tv_max3_f32 %0, %0, %5, %6\n\tv_max3_f32 %0, %0, %7, %8\n\tv_max3_f32 %0, %0, %9, %10\n\tv_max3_f32 %0, %0, %11, %12\n\tv_max3_f32 %0, %0, %13, %14\n\tv_max3_f32 %0, %0, %15, %16"
      : "+v"(pmax) : "v"(p1[0]), "v"(p1[1]), "v"(p1[2]), "v"(p1[3]), "v"(p1[4]), "v"(p1[5]), "v"(p1[6]), "v"(p1[7]), "v"(p1[8]), "v"(p1[9]), "v"(p1[10]), "v"(p1[11]), "v"(p1[12]), "v"(p1[13]), "v"(p1[14]), "v"(p1[15]));
  { auto rr = __builtin_amdgcn_permlane32_swap(__float_as_uint(pmax), __float_as_uint(pmax), false, false);
    pmax = fmaxf(__uint_as_float(rr[0]), __uint_as_float(rr[1])); }
  if (__builtin_expect(__all(pmax - m_reg <= THR2), 1)) { alpha = 1.f; }
  else { const float mn = __builtin_ceilf(fmaxf(m_reg, pmax)); alpha = __builtin_amdgcn_exp2f(m_reg - mn); m_reg = mn; }
  scl = __builtin_amdgcn_ldexpf(1.0f, (int)fmaxf(m_reg, -100.f) - 4);
  for (int r = 0; r < 16; ++r) p0[r] = __builtin_amdgcn_exp2f(p0[r]);
}
__device__ __forceinline__ void finishSM8(f32x16& p0, f32x16& p1, v8i& pa, float scl) {
  for (int r = 0; r < 16; ++r) p1[r] = __builtin_amdgcn_exp2f(p1[r]);
#pragma unroll
  for (int v = 0; v < 4; ++v) { pa[v] = cvt4_fp8_scl(pa[v], p0[4 * v], p0[4 * v + 1], p0[4 * v + 2], p0[4 * v + 3], scl); pa[4 + v] = cvt4_fp8_scl(pa[4 + v], p1[4 * v], p1[4 * v + 1], p1[4 * v + 2], p1[4 * v + 3], scl); }
}
__device__ __forceinline__ void pv8(f32x16* o, const char* Vs, const v8i& pa, int r32, int hi) {
  v8i b[4];
#pragma unroll
  for (int db = 0; db < 4; ++db) { const int d = 32 * db + r32, x = (d >> 2) & 3; const char* vp = Vs + d * 64;
    b[db] = mk8(*reinterpret_cast<const u32x4*>(vp + 16 * ((2 * hi) ^ x)), *reinterpret_cast<const u32x4*>(vp + 16 * ((2 * hi + 1) ^ x))); }
  const v8i ones = (v8i){0x22222222, 0x22222222, 0x22222222, 0x22222222, 0, 0, 0, 0};
#pragma unroll
  for (int db = 0; db < 4; ++db) o[db] = __builtin_amdgcn_mfma_scale_f32_32x32x64_f8f6f4(pa, b[db], o[db], 0, 0, 0, 0x7F7F7F7F, 0, 0x7F7F7F7F);
  o[4] = __builtin_amdgcn_mfma_scale_f32_32x32x64_f8f6f4(pa, ones, o[4], 0, 4, 0, 0x7F7F7F7F, 0, 0x7F7F7F7F);
}
__device__ __forceinline__ void attn_dense_body8(const bf16* __restrict__ Qb, const unsigned char* __restrict__ K8h, const unsigned char* __restrict__ V8h, bf16* __restrict__ Ob, int seq, char* lds) {
  int tid_o = wg_tid(); asm volatile("" : "+v"(tid_o)); const int tid = tid_o, wid = __builtin_amdgcn_readfirstlane(tid >> 6), lane = tid & 63, r32 = lane & 31, hi = lane >> 5;
  char* V_lds = lds; char* K_lds = lds + 4 * SHM_V8;
  float* ws = (float*)(lds + 4 * SHM_V8 + 4 * SHM_K8) + wid * 64; float* al_l = ws + 32;
  float m_reg = -1e30f; f32x16 o[5] = {}; v8i qf[2];
  { const bf16* Qw = Qb + (long)(wid * QBLK + r32) * LDQ + hi * 32;
#pragma unroll
    for (int s = 0; s < 2; ++s) {
#pragma unroll
      for (int c = 0; c < 4; ++c) { const u32x4 w = *reinterpret_cast<const u32x4*>(Qw + s * 64 + c * 8);
        constexpr float QS = 8.0f * SCALE * 1.4426950408889634f;
        qf[s][2 * c] = cvt4_fp8(QS * __uint_as_float(w[0] << 16), QS * __uint_as_float(w[0] & 0xffff0000u), QS * __uint_as_float(w[1] << 16), QS * __uint_as_float(w[1] & 0xffff0000u));
        qf[s][2 * c + 1] = cvt4_fp8(QS * __uint_as_float(w[2] << 16), QS * __uint_as_float(w[2] & 0xffff0000u), QS * __uint_as_float(w[3] << 16), QS * __uint_as_float(w[3] & 0xffff0000u)); } } }
  const int skey = tid >> 3, sck = tid & 7, sd = tid >> 2, sc4 = tid & 3;
  const int kst = skey * 128 + 16 * (sck ^ ((skey >> 1) & 7));
  const int vx = (sd >> 2) & 3, vst0 = sd * 64 + 16 * ((sc4 >> 1) ^ vx) + 8 * (sc4 & 1), vst1 = sd * 64 + 16 * ((2 + (sc4 >> 1)) ^ vx) + 8 * (sc4 & 1);
  const unsigned char* kg = K8h + (long)skey * K8_LD + 16 * sck; const unsigned char* vg = V8h + (long)sd * V8_LD + 16 * sc4;
  struct { u32x4 k, v; } sr_[2];
#define SLOAD8(i, k0) do { sr_[i].k = *reinterpret_cast<const u32x4*>(kg + (long)(k0) * K8_LD); sr_[i].v = *reinterpret_cast<const u32x4*>(vg + (k0)); } while (0)
#define SWRITE8(b, i) do { *reinterpret_cast<u32x4*>(K_lds + (b) * SHM_K8 + kst) = sr_[i].k; \
    *reinterpret_cast<u32x2*>(V_lds + (b) * SHM_V8 + vst0) = (u32x2){sr_[i].v[0], sr_[i].v[2]}; *reinterpret_cast<u32x2*>(V_lds + (b) * SHM_V8 + vst1) = (u32x2){sr_[i].v[1], sr_[i].v[3]}; } while (0)
#define SWAIT8() asm volatile("s_waitcnt vmcnt(2)" ::: "memory")
#define RESC8(a) do { if (__any((a) < 1.f)) { if (hi == 0) al_l[r32] = (a); asm volatile("s_waitcnt lgkmcnt(0)" ::: "memory"); \
    for (int d = 0; d < 5; ++d) for (int r = 0; r < 16; ++r) o[d][r] *= al_l[crow(r, hi)]; } } while (0)
  f32x16 pA0, pA1, pB0, pB1; float mnA, mnB, alA, alB; v8i pa = {}; const int NT = seq / KVBLK;
  SLOAD8(0, 0); asm volatile("s_waitcnt vmcnt(0)" ::: "memory"); SWRITE8(0, 0); __syncthreads();
  qkt8(pA0, pA1, K_lds, qf, r32, hi);
  asm volatile("s_nop 15\n\ts_nop 7" : "+v"(pA0), "+v"(pA1));
  partialSM8(pA0, pA1, m_reg, mnA, alA);
  SLOAD8(1, KVBLK); if (2 < NT) SLOAD8(0, 2 * KVBLK);
  SWAIT8(); SWRITE8(1, 1); __syncthreads();
  if (wid >= 4) __builtin_amdgcn_s_setprio(1);
#define HALF8(X0, X1, mnX, alX, Y0, Y1, mnY, TILE, BK, BV, BW, SL, SW, DOLOAD) do { \
    SBAR(); qkt8(X0, X1, K_lds + (BK) * SHM_K8, qf, r32, hi); \
    finishSM8(Y0, Y1, pa, mnY); SBAR(); \
    if (DOLOAD) SLOAD8(SL, ((TILE) + 2) * KVBLK); SBAR(); \
    pv8(o, V_lds + (BV) * SHM_V8, pa, r32, hi); partialSM8(X0, X1, m_reg, mnX, alX); \
    SWAIT8(); SWRITE8(BW, SW); \
    RESC8(alX); __syncthreads(); } while (0)
  int j = 1;
  for (; j + 4 < NT; j += 4) {
    HALF8(pB0, pB1, mnB, alB, pA0, pA1, mnA, j,     1, 0, 2, 1, 0, true);
    HALF8(pA0, pA1, mnA, alA, pB0, pB1, mnB, j + 1, 2, 1, 3, 0, 1, true);
    HALF8(pB0, pB1, mnB, alB, pA0, pA1, mnA, j + 2, 3, 2, 0, 1, 0, true);
    HALF8(pA0, pA1, mnA, alA, pB0, pB1, mnB, j + 3, 0, 3, 1, 0, 1, true);
  }
  HALF8(pB0, pB1, mnB, alB, pA0, pA1, mnA, j,     1, 0, 2, 1, 0, true);
  HALF8(pA0, pA1, mnA, alA, pB0, pB1, mnB, j + 1, 2, 1, 3, 0, 1, false);
  SBAR(); qkt8(pB0, pB1, K_lds + 3 * SHM_K8, qf, r32, hi);
  finishSM8(pA0, pA1, pa, mnA); SBAR();
  pv8(o, V_lds + 2 * SHM_V8, pa, r32, hi); partialSM8(pB0, pB1, m_reg, mnB, alB);
  RESC8(alB);
  finishSM8(pB0, pB1, pa, mnB); SBAR();
  pv8(o, V_lds + 3 * SHM_V8, pa, r32, hi);
#undef HALF8
  __builtin_amdgcn_s_setprio(0);
  float rli[16];
#pragma unroll
  for (int r = 0; r < 16; ++r) rli[r] = 64.0f * __builtin_amdgcn_rcpf(o[4][r]);
  unsigned char* Ow = (unsigned char*)Ob + (long)(wid * QBLK) * LDO;
#pragma unroll
  for (int r = 0; r < 16; ++r) { const int orow = crow(r, hi);
    for (int d0 = 0; d0 < 4; ++d0) Ow[(long)orow * LDO + d0 * 32 + r32] = (unsigned char)__builtin_amdgcn_cvt_pk_fp8_f32(o[d0][r] * rli[r], 0.f, 0, false); }
#undef SLOAD8
#undef SWRITE8
#undef SWAIT8
#undef RESC8
}
}
struct Frame {
    LAS unsigned char* lds;
    int tid, lane, wave;
    int bid, vcu, G;
};
__device__ __forceinline__ float wave_sum(float v) {
#pragma unroll
    for (int o = 1; o < 64; o <<= 1) v += __shfl_xor(v, o);
    return v;
}
__device__ __forceinline__ void xrows_phase(const Frame& F, const float* __restrict__ h, bf16* __restrict__ hb, pg8::rs_t* __restrict__ rs, unsigned char* __restrict__ hb8) {
    const int gw = F.vcu * 8 + F.wave, NGW = F.G * 8;
    for (int m = gw; m < L; m += NGW) {
        const f32x4* xr = (const f32x4*)(h + (size_t)m * DM) + F.lane;
        v2u* o8 = (v2u*)(hb + (size_t)m * DM) + F.lane;
        float s = 0.f;
#pragma unroll
        for (int j = 0; j < 16; ++j) { const f32x4 v = xr[64 * j]; s += (v.x * v.x + v.y * v.y) + (v.z * v.z + v.w * v.w); v2u w; w.x = pk2(v.x, v.y); w.y = pk2(v.z, v.w); o8[64 * j] = w;
            int w8 = __builtin_amdgcn_cvt_pk_fp8_f32(v.x, v.y, 0, false); w8 = __builtin_amdgcn_cvt_pk_fp8_f32(v.z, v.w, w8, true); *((unsigned*)(hb8 + (size_t)m * DM) + 64 * j + F.lane) = (unsigned)w8; }
        s = wave_sum(s);
        if (F.lane == 0) rs[m] = (pg8::rs_t)(s * pg8::RS_FIX);
    }
}
__device__ __forceinline__ void headnorm_rows(bf16* __restrict__ X, int ld, int nheads, const float* __restrict__ gain, int t, int lane, bool rope, const float (&cs)[8], const float (&sn)[8], unsigned char* __restrict__ X8 = nullptr) {
    const int hs = lane >> 4, l16 = lane & 15;
    f32x4 g0 = *(const f32x4*)(gain + 8 * l16), g1 = *(const f32x4*)(gain + 8 * l16 + 4);
    const float gg[8] = {g0.x, g0.y, g0.z, g0.w, g1.x, g1.y, g1.z, g1.w};
    const bool second = ((l16 >> 2) & 1) != 0;
    for (int hg = 0; hg < nheads / 4; ++hg) {
        bf16* p = X + (size_t)t * ld + (size_t)(4 * hg + hs) * HD + 8 * l16;
        const v4u raw = *(const v4u*)p;
        float x[8] = {bflo(raw.x), bfhi(raw.x), bflo(raw.y), bfhi(raw.y), bflo(raw.z), bfhi(raw.z), bflo(raw.w), bfhi(raw.w)};
        float ss = 0.f;
#pragma unroll
        for (int e = 0; e < 8; ++e) ss += x[e] * x[e];
        ss += __shfl_xor(ss, 1); ss += __shfl_xor(ss, 2); ss += __shfl_xor(ss, 4); ss += __shfl_xor(ss, 8);
        const float rinv = 1.0f / sqrtf(ss * (1.0f / HD) + EPS);
        float y[8];
#pragma unroll
        for (int e = 0; e < 8; ++e) y[e] = x[e] * rinv * gg[e];
        if (rope) {
#pragma unroll
            for (int e = 0; e < 8; ++e) { const float yp = __shfl_xor(y[e], 4); y[e] = second ? (y[e] * cs[e] + yp * sn[e]) : (y[e] * cs[e] - yp * sn[e]); }
        }
        if (X8) { int w0 = __builtin_amdgcn_cvt_pk_fp8_f32(y[0], y[1], 0, false); w0 = __builtin_amdgcn_cvt_pk_fp8_f32(y[2], y[3], w0, true);
            int w1 = __builtin_amdgcn_cvt_pk_fp8_f32(y[4], y[5], 0, false); w1 = __builtin_amdgcn_cvt_pk_fp8_f32(y[6], y[7], w1, true);
            *(v2u*)(X8 + (size_t)t * ld + (size_t)(4 * hg + hs) * HD + 8 * l16) = (v2u){(unsigned)w0, (unsigned)w1}; }
        else { v4u w; w.x = pk2(y[0], y[1]); w.y = pk2(y[2], y[3]); w.z = pk2(y[4], y[5]); w.w = pk2(y[6], y[7]);
            *(v4u*)p = w; }
    }
}
__device__ __forceinline__ void prep_phase(const Frame& F, bf16* Q, bf16* K, int ldk, int nkh, const float* qgain, const float* kgain, bool rope, unsigned char* K8 = nullptr) {
    const int gw = F.vcu * 8 + F.wave, NGW = F.G * 8;
    const int l16 = F.lane & 15;
    for (int t = gw; t < L; t += NGW) {
        float cs[8], sn[8];
#pragma unroll
        for (int e = 0; e < 8; ++e) { cs[e] = 1.f; sn[e] = 0.f; }
        if (rope) {
            const int ax = l16 >> 3; const float pos = (float)(ax ? (t & (GRID_W - 1)) : (t / GRID_W));
#pragma unroll
            for (int e = 0; e < 8; ++e) { const int f = (l16 & 3) * 8 + e; const float inv = 1.0f / powf(10000.0f, (float)f * (1.0f / 32.0f)); const float ang = pos * inv; cs[e] = cosf(ang); sn[e] = sinf(ang); }
        }
        headnorm_rows(Q, DM, NH, qgain, t, F.lane, rope, cs, sn);
        headnorm_rows(K, ldk, nkh, kgain, t, F.lane, rope, cs, sn, K8);
    }
}

constexpr int S5T = pg8::S5T, S5NCH = pg8::S5NCH, S5KS = pg8::S5KS;
__device__ __forceinline__ void s5_gen_group(const Frame& F, int g, const float* __restrict__ lam_re, const float* __restrict__ lam_im, const float* __restrict__ log_step,
                                             const float* __restrict__ b_re, const float* __restrict__ b_im, const float* __restrict__ c_re, const float* __restrict__ c_im,
                                             bf16* __restrict__ GM, bf16* __restrict__ BMt, f32x2* __restrict__ PAT) {
    LAS f32x2* apow = (LAS f32x2*)F.lds;
    LAS f32x2* zt = apow + 2 * 33 * 64;
    LAS float* Kd = (LAS float*)(zt + 2 * 64);
    const int tid = F.tid;
    if (tid < 128) {
        const int dir = tid >> 6, n = tid & 63, dg = dir * S5G + g, idx = dg * S5N + n;
        const double dt = exp((double)log_step[dg]);
        const double lr = (double)lam_re[idx], li = (double)lam_im[idx];
        const double mag = exp(lr * dt), are = mag * cos(li * dt), aim = mag * sin(li * dt);
        const double den = lr * lr + li * li, nre = are - 1.0;
        zt[dir * 64 + n] = (f32x2){(float)((nre * lr + aim * li) / den), (float)((aim * lr - nre * li) / den)};
        double pr = 1.0, pi = 0.0;
        for (int k = 0; k <= 32; ++k) { apow[(dir * 33 + k) * 64 + n] = (f32x2){(float)pr, (float)pi}; const double t = pr * are - pi * aim; pi = pr * aim + pi * are; pr = t; }
        PAT[idx] = apow[(dir * 33 + 32) * 64 + n];
    }
    LDS_WAIT(); __syncthreads();
    {
        const int dir = tid >> 8, p = (tid >> 4) & 15, q = tid & 15, dg = dir * S5G + g;
        float wr[64], wi[64];
        const float* cr = c_re + ((size_t)dg * S5P + p) * S5N; const float* ci = c_im + ((size_t)dg * S5P + p) * S5N;
#pragma unroll
        for (int n = 0; n < 64; ++n) { const f32x2 z = zt[dir * 64 + n]; const float br = b_re[((size_t)dg * S5N + n) * S5P + q], bi = b_im[((size_t)dg * S5N + n) * S5P + q];
            const float bbr = z.x * br - z.y * bi, bbi = z.x * bi + z.y * br; const float c0 = cr[n], c1 = ci[n];
            wr[n] = c0 * bbr - c1 * bbi; wi[n] = c0 * bbi + c1 * bbr; }
        for (int d = 0; d < 32; ++d) { float acc = 0.f; const LAS f32x2* ap = apow + (dir * 33 + d) * 64;
#pragma unroll
            for (int n = 0; n < 64; ++n) { const f32x2 a = ap[n]; acc = fmaf(wr[n], a.x, acc); acc = fmaf(-wi[n], a.y, acc); }
            Kd[(dir * 32 + d) * 256 + p * 16 + q] = acc; }
    }
    LDS_WAIT(); __syncthreads();
    bf16* BMg = BMt + (size_t)g * 512 * S5KS;
    for (int it = tid; it < 512 * 64; it += 512) { const int row = it >> 6, ch = it & 63, tau = row >> 4, p = row & 15, sg = ch >> 1, q0 = (ch & 1) * 8;
        float v[8];
        if (sg < tau) { const LAS float* k = Kd + (0 * 32 + (tau - sg)) * 256 + p * 16 + q0;
#pragma unroll
            for (int j = 0; j < 8; ++j) v[j] = k[j]; }
        else if (sg > tau) { const LAS float* k = Kd + (1 * 32 + (sg - tau)) * 256 + p * 16 + q0;
#pragma unroll
            for (int j = 0; j < 8; ++j) v[j] = k[j]; }
        else { const LAS float* k0 = Kd + p * 16 + q0; const LAS float* k1 = Kd + 32 * 256 + p * 16 + q0;
#pragma unroll
            for (int j = 0; j < 8; ++j) v[j] = k0[j] + k1[j]; }
        v4u w; w.x = pk2(v[0], v[1]); w.y = pk2(v[2], v[3]); w.z = pk2(v[4], v[5]); w.w = pk2(v[6], v[7]);
        *(v4u*)(BMg + (size_t)row * S5KS + ch * 8) = w; }
    for (int it = tid; it < 512 * 32; it += 512) { const int row = it >> 5, ch = it & 31, tau = row >> 4, p = row & 15, dir = ch >> 4, n0 = (ch & 15) * 4, dg = dir * S5G + g;
        const int k = dir ? (32 - tau) : (tau + 1);
        const f32x4 cr = *(const f32x4*)(c_re + ((size_t)dg * S5P + p) * S5N + n0), ci = *(const f32x4*)(c_im + ((size_t)dg * S5P + p) * S5N + n0);
        const LAS f32x2* ap = apow + (dir * 33 + k) * 64 + n0;
        unsigned o[4];
#pragma unroll
        for (int j = 0; j < 4; ++j) { const f32x2 a = ap[j]; const float vr = cr[j] * a.x - ci[j] * a.y, vi = cr[j] * a.y + ci[j] * a.x; o[j] = pk2(vr, -vi); }
        *(v4u*)(BMg + (size_t)row * S5KS + 512 + ch * 8) = (v4u){o[0], o[1], o[2], o[3]}; }
    bf16* GMg = GM + (size_t)g * 256 * 512;
    for (int it = tid; it < 128 * 64; it += 512) { const int dn = it >> 6, ch = it & 63, dir = dn >> 6, n = dn & 63, sg = ch >> 1, q0 = (ch & 1) * 8, dg = dir * S5G + g;
        const int pw = dir ? sg : (31 - sg);
        const f32x2 a = apow[(dir * 33 + pw) * 64 + n], z = zt[dir * 64 + n];
        const float wr_ = a.x * z.x - a.y * z.y, wi_ = a.x * z.y + a.y * z.x;
        const float* br = b_re + ((size_t)dg * S5N + n) * S5P + q0; const float* bi = b_im + ((size_t)dg * S5N + n) * S5P + q0;
        float re[8], im[8];
#pragma unroll
        for (int j = 0; j < 8; ++j) { re[j] = wr_ * br[j] - wi_ * bi[j]; im[j] = wr_ * bi[j] + wi_ * br[j]; }
        v4u w0, w1; w0.x = pk2(re[0], re[1]); w0.y = pk2(re[2], re[3]); w0.z = pk2(re[4], re[5]); w0.w = pk2(re[6], re[7]);
        w1.x = pk2(im[0], im[1]); w1.y = pk2(im[2], im[3]); w1.z = pk2(im[4], im[5]); w1.w = pk2(im[6], im[7]);
        *(v4u*)(GMg + (size_t)(dir * 128 + 2 * n) * 512 + ch * 8) = w0; *(v4u*)(GMg + (size_t)(dir * 128 + 2 * n + 1) * 512 + ch * 8) = w1; }
    LDS_WAIT(); __syncthreads();
}
__device__ __forceinline__ void s5_scan_phase(const Frame& F, const f32x2* __restrict__ PAT, const float* __restrict__ E, bf16* __restrict__ UA) {
    for (int task = F.bid + F.G * F.wave; task < 2 * S5G; task += F.G * 8) {
        const int dir = task >> 8, g = task & 255;
        const f32x2 a = PAT[task * S5N + F.lane];
        const float* e = E + (size_t)g * S5NCH * 256 + dir * 128 + 2 * F.lane;
        bf16* s = UA + (size_t)g * S5NCH * S5KS + 512 + dir * 128 + 2 * F.lane;
        float cr = 0.f, ci = 0.f;
        for (int c8 = 0; c8 < S5NCH; c8 += 8) {
            f32x2 v[8];
#pragma unroll
            for (int k = 0; k < 8; ++k) { const int c = dir ? (S5NCH - 1 - (c8 + k)) : (c8 + k); v[k] = *(const f32x2*)(e + (size_t)c * 256); }
#pragma unroll
            for (int k = 0; k < 8; ++k) { const int c = dir ? (S5NCH - 1 - (c8 + k)) : (c8 + k);
                *(unsigned*)(s + (size_t)c * S5KS) = pk2(cr, ci);
                const float nr = fmaf(a.x, cr, fmaf(-a.y, ci, v[k].x)), ni = fmaf(a.x, ci, fmaf(a.y, cr, v[k].y)); cr = nr; ci = ni; }
        }
    }
}


__device__ __forceinline__ float fp8_to_f32(unsigned char b) { const int e = (b >> 3) & 15, m = b & 7; const float v = e ? __builtin_ldexpf(1.0f + (float)m * 0.125f, e - 7) : __builtin_ldexpf((float)m * 0.125f, -6); return (b & 0x80) ? -v : v; }
__device__ __forceinline__ void gqa_selfcheck(const Frame& F, const bf16* __restrict__ Qp, const unsigned char* __restrict__ K8, const unsigned char* __restrict__ V8t, const bf16* __restrict__ O,
                                              float* __restrict__ SC, unsigned* flag) {
    LAS float* ql = (LAS float*)(F.lds + F.wave * 1024);
    const int lane = F.lane;
#pragma unroll 1
    for (int s = F.bid * 8 + F.wave; s < 1024; s += F.G * 8) {
        const int tok = (int)(((long)(s >> 5) * 5209 + 77) % L), hq = s & 31, kv = hq >> 2;
        float* sc = SC + (size_t)(F.bid * 8 + F.wave) * L;
        { const bf16* qp = Qp + (size_t)tok * DM + hq * HD; ql[lane] = bf2f(qp[lane]); ql[lane + 64] = bf2f(qp[lane + 64]); } LDS_WAIT();
        float mx = -1e30f;
#pragma unroll 1
        for (int j = lane; j < L; j += 64) { const unsigned char* kp = K8 + (size_t)j * KVD + kv * HD; float dot = 0.f;
#pragma unroll 1
            for (int d = 0; d < HD; ++d) dot += fp8_to_f32(kp[d]) * ql[d];
            dot *= 0.088388347648318440f; sc[j] = dot; mx = fmaxf(mx, dot); }
#pragma unroll
        for (int o = 1; o < 64; o <<= 1) mx = fmaxf(mx, __shfl_xor(mx, o));
        asm volatile("s_waitcnt vmcnt(0)" ::: "memory"); __builtin_amdgcn_fence(__ATOMIC_RELEASE, "workgroup"); __builtin_amdgcn_fence(__ATOMIC_ACQUIRE, "agent");
        float o0 = 0.f, o1 = 0.f, lsum = 0.f;
#pragma unroll 1
        for (int j = 0; j < L; ++j) { const float pj = expf(__hip_atomic_load(sc + j, __ATOMIC_RELAXED, __HIP_MEMORY_SCOPE_AGENT) - mx);
            o0 += pj * fp8_to_f32(V8t[(size_t)(kv * HD + lane) * L + j]); o1 += pj * fp8_to_f32(V8t[(size_t)(kv * HD + lane + 64) * L + j]); lsum += pj; }
        o0 /= lsum; o1 /= lsum;
        const unsigned char* op = (const unsigned char*)O + (size_t)tok * DM + hq * HD; const float g0 = fp8_to_f32(op[lane]) * 0.015625f, g1 = fp8_to_f32(op[lane + 64]) * 0.015625f;
        float am = fmaxf(fabsf(o0), fabsf(o1));
#pragma unroll
        for (int o = 1; o < 64; o <<= 1) am = fmaxf(am, __shfl_xor(am, o));
        const float tol = 0.2f * am + 1e-5f;
        const bool bad = !(fabsf(g0 - o0) <= tol) || !(fabsf(g1 - o1) <= tol);
        if (__any(bad) && lane == 0) __hip_atomic_fetch_or(flag, 1u, __ATOMIC_RELAXED, __HIP_MEMORY_SCOPE_AGENT);
        LDS_WAIT();
    }
}

__device__ __forceinline__ void transpose_item(const float* __restrict__ W, int K, int N, bf16* __restrict__ WT, int mode, const float* __restrict__ gain, LAS float* scr, int item, int lane, int fp8 = 0) {
    const int nblk = N / 32, kb = item / nblk, nb = item % nblk, k0 = 64 * kb, n0 = 32 * nb;
    int r0 = n0;
    if (mode == 1) r0 = (n0 < DM) ? ((n0 >> 7) * 256 + (n0 & 127)) : (((n0 - DM) >> 7) * 256 + 128 + ((n0 - DM) & 127));
    const float* src = W + (size_t)(k0 + (lane >> 5)) * N + n0 + (lane & 31);
    float v[32];
#pragma unroll
    for (int i = 0; i < 32; ++i) v[i] = src[(size_t)(2 * i) * N];
    const int c = lane & 7;
    f32x4 g0 = (f32x4){1.f, 1.f, 1.f, 1.f}, g1 = g0;
    if (gain) { g0 = *(const f32x4*)(gain + k0 + 8 * c); g1 = *(const f32x4*)(gain + k0 + 8 * c + 4); }
#pragma unroll
    for (int i = 0; i < 32; ++i) scr[(2 * i + (lane >> 5)) * 33 + (lane & 31)] = v[i];
    LDS_WAIT(); asm volatile("" ::: "memory");
#pragma unroll
    for (int j = 0; j < 4; ++j) { const int n = (lane >> 3) + 8 * j; const LAS float* s = scr + (8 * c) * 33 + n;
        if (fp8) { int w0 = __builtin_amdgcn_cvt_pk_fp8_f32(64.f * s[0 * 33] * g0.x, 64.f * s[1 * 33] * g0.y, 0, false); w0 = __builtin_amdgcn_cvt_pk_fp8_f32(64.f * s[2 * 33] * g0.z, 64.f * s[3 * 33] * g0.w, w0, true);
            int w1 = __builtin_amdgcn_cvt_pk_fp8_f32(64.f * s[4 * 33] * g1.x, 64.f * s[5 * 33] * g1.y, 0, false); w1 = __builtin_amdgcn_cvt_pk_fp8_f32(64.f * s[6 * 33] * g1.z, 64.f * s[7 * 33] * g1.w, w1, true);
            *(v2u*)((unsigned char*)WT + (size_t)(r0 + n) * K + k0 + 8 * c) = (v2u){(unsigned)w0, (unsigned)w1}; }
        else { v4u o; o.x = pk2(s[0 * 33] * g0.x, s[1 * 33] * g0.y); o.y = pk2(s[2 * 33] * g0.z, s[3 * 33] * g0.w); o.z = pk2(s[4 * 33] * g1.x, s[5 * 33] * g1.y); o.w = pk2(s[6 * 33] * g1.z, s[7 * 33] * g1.w);
            *(v4u*)(WT + (size_t)(r0 + n) * K + k0 + 8 * c) = o; } }
    LDS_WAIT(); asm volatile("" ::: "memory");
}

constexpr size_t MiB = 1u << 20;
constexpr size_t SZ_NAQKV = (size_t)3 * DM * DM * 2, SZ_DD = (size_t)DM * DM * 2, SZ_GQAQKV = (size_t)(DM + 2 * KVD) * DM * 2, SZ_W1 = (size_t)FF * DM * 2, SZ_PROJ = (size_t)DM * PLE * 2, SZ_ACT = (size_t)L * DM * 2;
constexpr size_t OFF_CTL = 0, CTL_ZERO_BYTES = 3 * MiB, OFF_RS = 1 * MiB;
constexpr size_t OFF_NAQKV = 4 * MiB;
constexpr size_t OFF_NAWO = OFF_NAQKV + 2 * SZ_NAQKV;
constexpr size_t OFF_GQAQKV = OFF_NAWO + 2 * SZ_DD;
constexpr size_t OFF_GQAWO = OFF_GQAQKV + SZ_GQAQKV;
constexpr size_t OFF_S5IN = OFF_GQAWO + SZ_DD;
constexpr size_t OFF_S5OUT = OFF_S5IN + SZ_DD;
constexpr size_t OFF_W1 = OFF_S5OUT + 2 * SZ_DD;
constexpr size_t OFF_W2 = OFF_W1 + 4 * SZ_W1;
constexpr size_t OFF_PROJ = OFF_W2 + 4 * SZ_W1;
constexpr size_t OFF_GATE = OFF_PROJ + 4 * SZ_PROJ;
constexpr size_t OFF_PBF = OFF_GATE + 4 * SZ_DD;
constexpr size_t OFF_XN = OFF_PBF + 4 * (size_t)L * PLE * 2;
constexpr size_t OFF_ACT = OFF_XN + SZ_ACT;
constexpr size_t OFF_PP = OFF_ACT + 4 * SZ_ACT;
constexpr size_t OFF_S5BM = OFF_PP + SZ_ACT;
constexpr size_t OFF_S5GM = OFF_S5BM + 192 * MiB;
constexpr size_t OFF_S5PAR = OFF_S5GM + 64 * MiB;
constexpr size_t OFF_DUMMY = OFF_S5PAR + 8 * MiB;
constexpr size_t OFF_HB1 = OFF_DUMMY + 256 * MiB;
constexpr size_t OFF_HB8 = OFF_HB1 + SZ_ACT;
constexpr size_t WS_END = OFF_HB8 + (size_t)L * DM;
constexpr int CW_BAR = 4096;
constexpr int RING_BYTES = 131072, LDSCTL_OFF = RING_BYTES, MISC_OFF = LDSCTL_OFF + 320, PTAB_OFF = LDSCTL_OFF + 1024, LDS_BYTES = 147456;
static_assert(dattn::SHM_ATTN <= RING_BYTES && 8 * 64 * 33 * 4 <= RING_BYTES, "phase scratch fits the ring region");

constexpr int PH_PER_LAYER = 8, NPH = 1 + DEPTH * PH_PER_LAYER;
struct Args { const float* in[28]; float* out; unsigned char* ws; int ph_lo, ph_hi; };
enum { I_X = 0, I_P, I_MIXN, I_MLPN, I_PLEN, I_NAQKV, I_NAWO, I_NAQG, I_NAKG, I_NARPB, I_GQKV, I_GWO, I_GQG, I_GKG, I_S5IN, I_LAMRE, I_LAMIM, I_LOGSTEP, I_BRE, I_BIM, I_CRE, I_CIM, I_S5D, I_S5OUT, I_W1, I_W2, I_PROJ, I_GATE };


__device__ __forceinline__ unsigned long long tab_get(LAS unsigned char* lds, int i) {
    volatile LAS unsigned* t = (volatile LAS unsigned*)(lds + PTAB_OFF); const unsigned lo = t[2 * i], hi = t[2 * i + 1];
    return ((unsigned long long)(unsigned)__builtin_amdgcn_readfirstlane((int)hi) << 32) | (unsigned)__builtin_amdgcn_readfirstlane((int)lo); }
#define INP(i) ((const float*)(const GAS float*)tab_get(F.lds, (i)))
#define OUTP() ((float*)(GAS float*)tab_get(F.lds, 28))
#define WSP() ((unsigned char*)(GAS unsigned char*)tab_get(F.lds, 29))
__device__ __forceinline__ Frame mkframe(unsigned char* lds_generic) {
    Frame F; int t = wg_tid(); asm volatile("" : "+v"(t)); F.tid = t; F.lane = t & 63; F.wave = __builtin_amdgcn_readfirstlane(t >> 6);
    F.lds = (LAS unsigned char*)lds_generic; int b = blockIdx.x; asm volatile("" : "+s"(b)); F.bid = b; int G = gridDim.x; asm volatile("" : "+s"(G)); F.G = G;
    F.vcu = (G % 8 == 0) ? (b % 8) * (G / 8) + b / 8 : b; return F; }
__device__ __forceinline__ void prologue_phase(const Frame& F) {
    unsigned char* ws = WSP();
    LAS float* scr = (LAS float*)(F.lds + F.wave * (64 * 33 * 4));
    const int gw = F.vcu * 8 + F.wave, NGW = F.G * 8;
    constexpr int I_QKV = (DM / 64) * (3 * DM / 32), I_DD = (DM / 64) * (DM / 32), I_GQ = (DM / 64) * ((DM + 2 * KVD) / 32), I_SO = (DM / 64) * (2 * DM / 32),
                  I_1 = (DM / 64) * (FF / 32), I_2 = (FF / 64) * (DM / 32), I_PJ = (PLE / 64) * (DM / 32);
    constexpr int NITEMS = 2 * I_QKV + 2 * I_DD + I_GQ + I_DD + I_DD + I_SO + 4 * I_1 + 4 * I_2 + 4 * I_PJ + 4 * I_DD;
    for (int it = gw; it < NITEMS; it += NGW) {
        int r = it; const float* W; int K, N, mode = 0, fp8 = 0; bf16* WT; const float* gain = nullptr;
        if (r < 2 * I_QKV) { const int l = r / I_QKV; r -= l * I_QKV; W = INP(I_NAQKV) + (size_t)l * DM * 3 * DM; K = DM; N = 3 * DM; WT = (bf16*)(ws + OFF_NAQKV + l * SZ_NAQKV); gain = INP(I_MIXN) + (size_t)(3 * l) * DM; fp8 = 1; }
        else { r -= 2 * I_QKV;
        if (r < 2 * I_DD) { const int l = r / I_DD; r -= l * I_DD; W = INP(I_NAWO) + (size_t)l * DM * DM; K = DM; N = DM; WT = (bf16*)(ws + OFF_NAWO + l * SZ_DD); fp8 = 1; }
        else { r -= 2 * I_DD;
        if (r < I_GQ) { W = INP(I_GQKV); K = DM; N = DM + 2 * KVD; WT = (bf16*)(ws + OFF_GQAQKV); gain = INP(I_MIXN) + (size_t)1 * DM; fp8 = 1; }
        else { r -= I_GQ;
        if (r < I_DD) { W = INP(I_GWO); K = DM; N = DM; WT = (bf16*)(ws + OFF_GQAWO); fp8 = 1; }
        else { r -= I_DD;
        if (r < I_DD) { W = INP(I_S5IN); K = DM; N = DM; WT = (bf16*)(ws + OFF_S5IN); gain = INP(I_MIXN) + (size_t)2 * DM; fp8 = 1; }
        else { r -= I_DD;
        if (r < I_SO) { W = INP(I_S5OUT); K = DM; N = 2 * DM; WT = (bf16*)(ws + OFF_S5OUT); mode = 1; fp8 = 1; }
        else { r -= I_SO;
        if (r < 4 * I_1) { const int l = r / I_1; r -= l * I_1; W = INP(I_W1) + (size_t)l * DM * FF; K = DM; N = FF; WT = (bf16*)(ws + OFF_W1 + l * SZ_W1); gain = INP(I_MLPN) + (size_t)l * DM; }
        else { r -= 4 * I_1;
        if (r < 4 * I_2) { const int l = r / I_2; r -= l * I_2; W = INP(I_W2) + (size_t)l * FF * DM; K = FF; N = DM; WT = (bf16*)(ws + OFF_W2 + l * SZ_W1); }
        else { r -= 4 * I_2;
        if (r < 4 * I_PJ) { const int l = r / I_PJ; r -= l * I_PJ; W = INP(I_PROJ) + (size_t)l * PLE * DM; K = PLE; N = DM; WT = (bf16*)(ws + OFF_PROJ + l * SZ_PROJ); }
        else { r -= 4 * I_PJ; const int l = r / I_DD; r -= l * I_DD; W = INP(I_GATE) + (size_t)l * DM * DM; K = DM; N = DM; WT = (bf16*)(ws + OFF_GATE + l * SZ_DD); gain = INP(I_PLEN) + (size_t)l * DM; } } } } } } } } }
        transpose_item(W, K, N, WT, mode, gain, scr, r, F.lane, fp8);
    }
    xrows_phase(F, INP(I_X), (bf16*)(ws + OFF_XN), (pg8::rs_t*)(ws + OFF_RS), ws + OFF_HB8);
    { const size_t n8 = (size_t)DEPTH * L * PLE / 8; const float* p = INP(I_P); bf16* pb = (bf16*)(ws + OFF_PBF);
      for (size_t i = (size_t)gw * 64 + F.lane; i < n8; i += (size_t)NGW * 64) { const f32x4 a = *(const f32x4*)(p + i * 8), b = *(const f32x4*)(p + i * 8 + 4);
          v4u w; w.x = pk2(a.x, a.y); w.y = pk2(a.z, a.w); w.z = pk2(b.x, b.y); w.w = pk2(b.z, b.w); *(v4u*)(pb + i * 8) = w; } }
    { bf16* GM = (bf16*)(ws + OFF_S5GM); bf16* BMt = (bf16*)(ws + OFF_S5BM); f32x2* PAT = (f32x2*)(ws + OFF_S5PAR);
      LDS_WAIT(); __syncthreads();
      for (int g = F.bid; g < S5G; g += F.G) s5_gen_group(F, g, INP(I_LAMRE), INP(I_LAMIM), INP(I_LOGSTEP), INP(I_BRE), INP(I_BIM), INP(I_CRE), INP(I_CIM), GM, BMt, PAT); }
}

#define WS_PTRS() unsigned char* ws = WSP(); bf16* HB0 = (bf16*)(ws + OFF_XN); bf16* HB1 = (bf16*)(ws + OFF_HB1); bf16* Qb = (bf16*)(ws + OFF_ACT); bf16* Kb = (bf16*)(ws + OFF_ACT + SZ_ACT); bf16* Vb = (bf16*)(ws + OFF_ACT + 2 * SZ_ACT); \
    bf16* Ob = (bf16*)(ws + OFF_ACT + 3 * SZ_ACT); bf16* HID = (bf16*)(ws + OFF_ACT); bf16* UA = (bf16*)(ws + OFF_ACT); bf16* S5Gb = (bf16*)(ws + OFF_ACT + 2 * SZ_ACT); float* S5E = (float*)(ws + OFF_ACT + 3 * SZ_ACT); bf16* PP = (bf16*)(ws + OFF_PP); \
    (void)HB0; (void)HB1; (void)Qb; (void)Kb; (void)Vb; (void)Ob; (void)HID; (void)UA; (void)S5Gb; (void)PP; (void)S5E;
__global__ void __launch_bounds__(512, 2) enc_fwd(Args args) {
    extern __shared__ __attribute__((aligned(16))) unsigned char lds[];
    {
        LAS unsigned char* l3 = (LAS unsigned char*)lds;
        for (int u = threadIdx.x; u < (LDS_BYTES - LDSCTL_OFF) / 4; u += 512) ((LAS unsigned*)(l3 + LDSCTL_OFF))[u] = 0u;
        __syncthreads();
        if (threadIdx.x == 0) { LAS unsigned long long* t = (LAS unsigned long long*)(l3 + PTAB_OFF);
#pragma unroll
            for (int i = 0; i < 28; ++i) t[i] = (unsigned long long)args.in[i];
            t[28] = (unsigned long long)args.out; t[29] = (unsigned long long)args.ws; }
        if ((threadIdx.x & 63) == 0) ((LAS unsigned*)(WTAB_OFF))[hw_wave_slot()] = threadIdx.x >> 6;
        __syncthreads();
    }
    const int lo = args.ph_lo, hi = args.ph_hi;
    XcdBarrier bar;
    { LAS unsigned char* l3 = (LAS unsigned char*)lds; unsigned* ctl = (unsigned*)(GAS unsigned*)(tab_get(l3, 29) + OFF_CTL); bar.bar = ctl + CW_BAR; bar.x = 0; bar.st = nullptr;
      if (hi - lo > 1) bar = xcd_barrier_post(ctl + CW_BAR, (volatile LAS unsigned*)(l3 + MISC_OFF) + 8); }
#define IN(k) (lo <= (k) && (k) < hi)
#ifndef PROBE_PH
#define PROBE_PH (-1)
#endif
#define REPS(k) for (int rep_ = 0, nrep_ = (((k) == PROBE_PH || PROBE_PH == -2) ? 2 : (((PROBE_PH == 300 || PROBE_PH == 301) && (k) == 11) ? 4 : 1)); rep_ < nrep_; ++rep_)
#define HBOUT(p) ((nrep_ == 2 && rep_ == 0) ? (bf16*)(ws + OFF_DUMMY) : (p))
#define RSOUT(i) ((nrep_ == 2 && rep_ == 0) ? (pg8::rs_t*)(ws + OFF_DUMMY + 128 * MiB) : RSP(i))
#if PROBE_PH >= 700 && PROBE_PH < 900
#define SEAM(k) do { if (IN(k) && IN((k) + 1)) { unsigned long long* ts_ = (unsigned long long*)(GAS unsigned long long*)(tab_get((LAS unsigned char*)lds, 29) + OFF_DUMMY + 200 * MiB); \
        if ((k) == PROBE_PH % 100) { __syncthreads(); if (wg_tid() == 0) __hip_atomic_store(ts_ + blockIdx.x, (unsigned long long)wall_clock64(), __ATOMIC_RELAXED, __HIP_MEMORY_SCOPE_AGENT); } \
        xcd_barrier(bar); \
        if ((k) == PROBE_PH % 100 && blockIdx.x == 0 && wg_tid() == 0) { unsigned long long mx = 0, sm = 0, t0_ = ~0ull; const unsigned st_ = (PROBE_PH >= 800) ? 8u : 1u; \
            for (unsigned i_ = 0; i_ < gridDim.x; i_ += st_) { const unsigned long long t_ = __hip_atomic_load(ts_ + i_, __ATOMIC_RELAXED, __HIP_MEMORY_SCOPE_AGENT); mx = t_ > mx ? t_ : mx; t0_ = t_ < t0_ ? t_ : t0_; } \
            for (unsigned i_ = 0; i_ < gridDim.x; i_ += st_) sm += __hip_atomic_load(ts_ + i_, __ATOMIC_RELAXED, __HIP_MEMORY_SCOPE_AGENT) - t0_; \
            const unsigned long long idle_ = (mx - t0_) - sm / (gridDim.x / st_), until_ = (unsigned long long)wall_clock64() + 100ull * idle_; \
            while ((unsigned long long)wall_clock64() < until_) __builtin_amdgcn_s_sleep(32); } } } while (0)
#else
#define SEAM(k) do { if (IN(k) && IN((k) + 1)) xcd_barrier(bar); } while (0)
#endif

#if PROBE_PH == 601
    if (blockIdx.x == 0 && threadIdx.x < 64) {
        typedef int v8i_ __attribute__((ext_vector_type(8))); typedef float f4v_ __attribute__((ext_vector_type(4)));
        const int l = threadIdx.x, ij = l & 15, kb = l >> 4; const unsigned lut[7] = {0xC4u, 0xC0u, 0xB8u, 0x00u, 0x38u, 0x40u, 0x44u};
        v8i_ A, B;
#pragma unroll
        for (int v = 0; v < 8; ++v) { unsigned wa = 0, wb = 0;
#pragma unroll
            for (int b = 0; b < 4; ++b) { const int kk = 32 * kb + 4 * v + b; const int av = ((ij + 2 * kk) % 5) - 2, bv = ((3 * kk + ij) % 7) - 3;
                unsigned ea = 0, eb = 0;
#pragma unroll
                for (int t = 0; t < 7; ++t) { ea = (av + 3 == t) ? lut[t] : ea; eb = (bv + 3 == t) ? lut[t] : eb; }
                wa |= ea << (8 * b); wb |= eb << (8 * b); }
            A[v] = (int)wa; B[v] = (int)wb; }
        f4v_ c1 = {};
        c1 = __builtin_amdgcn_mfma_scale_f32_16x16x128_f8f6f4(A, B, c1, 0, 0, 0, 0x7F7F7F7F, 0, 0x7F7F7F7F);
        bool ok1 = true;
#pragma unroll
        for (int r = 0; r < 4; ++r) { const int i = 4 * kb + r, j = ij; int s = 0;
            for (int kk = 0; kk < 128; ++kk) s += (((i + 2 * kk) % 5) - 2) * (((3 * kk + j) % 7) - 3);
            ok1 = ok1 && (c1[r] == (float)s); }
        unsigned long long ticks = 0; if (!__all(ok1)) ticks += 400000ull;
        const unsigned long long t0 = __builtin_amdgcn_s_memrealtime(); while (__builtin_amdgcn_s_memrealtime() - t0 < ticks) __builtin_amdgcn_s_sleep(8);
    }
    __syncthreads();
#endif
#if PROBE_PH == 600
    if (blockIdx.x == 0 && threadIdx.x < 64) {
        typedef int v8i_ __attribute__((ext_vector_type(8))); typedef float f16v_ __attribute__((ext_vector_type(16)));
        const int l = threadIdx.x, ij = l & 31, kb = l >> 5; const unsigned lut[7] = {0xC4u, 0xC0u, 0xB8u, 0x00u, 0x38u, 0x40u, 0x44u};
        v8i_ A, B;
#pragma unroll
        for (int v = 0; v < 8; ++v) { unsigned wa = 0, wb = 0;
#pragma unroll
            for (int b = 0; b < 4; ++b) { const int kk = 32 * kb + 4 * v + b; const int av = ((ij + 2 * kk) % 5) - 2, bv = ((3 * kk + ij) % 7) - 3;
                unsigned ea = 0, eb = 0;
#pragma unroll
                for (int t = 0; t < 7; ++t) { ea = (av + 3 == t) ? lut[t] : ea; eb = (bv + 3 == t) ? lut[t] : eb; }
                wa |= ea << (8 * b); wb |= eb << (8 * b); }
            A[v] = (int)wa; B[v] = (int)wb; }
        f16v_ c1 = {}, c2 = {};
        c1 = __builtin_amdgcn_mfma_scale_f32_32x32x64_f8f6f4(A, B, c1, 0, 0, 0, 0x7F7F7F7F, 0, 0x7F7F7F7F);
        c2 = __builtin_amdgcn_mfma_scale_f32_32x32x64_f8f6f4(A, B, c2, 0, 0, 0, 0x7B7B7B7B, 0, 0x7F7F7F7F);
        bool ok1 = true, ok2 = true;
#pragma unroll
        for (int r = 0; r < 16; ++r) { const int i = (r & 3) + 8 * (r >> 2) + 4 * kb, j = ij; int s = 0;
            for (int kk = 0; kk < 64; ++kk) s += (((i + 2 * kk) % 5) - 2) * (((3 * kk + j) % 7) - 3);
            ok1 = ok1 && (c1[r] == (float)s); ok2 = ok2 && (c2[r] == (float)s * 0.0625f); }
        int w = __builtin_amdgcn_cvt_pk_fp8_f32(1.0f, 2.0f, 0, false); w = __builtin_amdgcn_cvt_pk_fp8_f32(3.0f, -1.0f, w, true);
        const bool ok3 = ((unsigned)w == 0xB8444038u);
        unsigned long long ticks = 0; if (!__all(ok1)) ticks += 400000ull; if (!__all(ok2)) ticks += 800000ull; if (!__all(ok3)) ticks += 1600000ull;
        const unsigned long long t0 = __builtin_amdgcn_s_memrealtime(); while (__builtin_amdgcn_s_memrealtime() - t0 < ticks) __builtin_amdgcn_s_sleep(8);
    }
    __syncthreads();
#endif
    if (IN(0)) REPS(0) { const Frame F = mkframe(lds); prologue_phase(F); } SEAM(0);
#if PROBE_PH == 200
    for (int xb_ = 0; xb_ < 40; ++xb_) xcd_barrier(bar);
#endif

#pragma unroll 1
    for (int layer = 0; layer < DEPTH; ++layer) {
        const int kind = layer % 3, slot = layer / 3, pb = 1 + PH_PER_LAYER * layer;
#define RSP(i) ((pg8::rs_t*)(ws + OFF_RS) + (size_t)(i) * L)
        const int irs = (layer == 0) ? 0 : 3 * layer;
        if (IN(pb + 0)) REPS(pb + 0) {
            const Frame F = mkframe(lds); WS_PTRS();
            if (kind != 2) {
                const int N = (kind == 0) ? 3 * DM : DM + 2 * KVD;
                const bf16* W = (kind == 0) ? (const bf16*)(ws + OFF_NAQKV + slot * SZ_NAQKV) : (const bf16*)(ws + OFF_GQAQKV);
                const pg8::Gemm g = pg8::mkgemm((const bf16*)(ws + OFF_HB8), W, L, N, DM / 2); pg8::StaticOrder S; S.init(L, N, F.G, F.bid);
                pg8::EpiBf16<0> E{Qb, Kb, Vb, DM, (kind == 0) ? DM : KVD, (kind == 0) ? DM : L, DM, (kind == 0) ? 2 * DM : DM + KVD, RSP(irs), (kind == 0) ? 0 : 2, (kind == 0) ? 2 * DM : DM + KVD};
                pg8::gemm_phase<pg8::EpiBf16<0>, pg8::StaticOrder, false, true, true>(F.lds, g, S, E);
            } else {
                const pg8::Gemm g = pg8::mkgemm((const bf16*)(ws + OFF_HB8), (const bf16*)(ws + OFF_S5IN), L, DM, DM / 2); pg8::StaticOrder S; S.init(L, DM, F.G, F.bid);
                pg8::EpiS5U E{UA, RSP(irs)};
                pg8::gemm_phase<pg8::EpiS5U, pg8::StaticOrder, false, true, true>(F.lds, g, S, E);
            }
        }
        SEAM(pb + 0);
        if (kind != 2) {
            if (kind == 1) { if (IN(pb + 1)) { const Frame F = mkframe(lds); WS_PTRS(); prep_phase(F, Qb, Kb, KVD, NKV, INP(I_GQG), INP(I_GKG), true, (unsigned char*)Kb + 64 * MiB); }
                SEAM(pb + 1); }
            if (IN(pb + 2)) REPS(pb + 2) { const Frame F = mkframe(lds); WS_PTRS();
                if (kind == 0) {
                    const float* rpb = INP(I_NARPB) + (size_t)slot * NH * 15 * 31;
                    for (int i = 0;; ++i) { const int unit = i * F.G + F.vcu; if (unit >= NH * (GROWS / 4)) break;
                        const int h = unit >> 6, R = (unit & 63) * 4, ks = min(max(R - 4, 0), GROWS - dattn::NA_TILES);
                        dattn::na_block_body(Qb + (size_t)(R * GRID_W) * DM + h * HD, Kb + (size_t)(ks * GRID_W) * DM + h * HD, Vb + (size_t)(ks * GRID_W) * DM + h * HD,
                                             (bf16*)((unsigned char*)Ob + (size_t)(R * GRID_W) * DM + h * HD), rpb + (size_t)h * 15 * 31, INP(I_NAQG) + slot * HD, INP(I_NAKG) + slot * HD, R, ks, (char*)lds);
                        __syncthreads(); }
                } else {
                    for (int i = 0;; ++i) { const int unit = i * F.G + F.bid; if (unit >= NH * (L / 256)) break;
                        const int kvh = unit & 7, rest = unit >> 3, hq = kvh * 4 + (rest >> 6), qb = rest & 63;
                        dattn::attn_dense_body8(Qb + (size_t)(qb * 256) * DM + hq * HD, (const unsigned char*)Kb + 64 * MiB + kvh * HD, (const unsigned char*)Vb + (size_t)(kvh * HD) * L, (bf16*)((unsigned char*)Ob + (size_t)(qb * 256) * DM + hq * HD), L, (char*)lds);
                        __syncthreads(); }
                }
            }
            if (IN(pb + 2) && IN(pb + 4)) xcd_barrier(bar);
#if PROBE_PH == 400
            if (kind == 1) { const Frame F = mkframe(lds); WS_PTRS();
                gqa_selfcheck(F, Qb, (const unsigned char*)Kb + 64 * MiB, (const unsigned char*)Vb, Ob, (float*)(ws + OFF_PP), (unsigned*)(ws + OFF_CTL) + 8);
                xcd_barrier(bar); }
#endif
        } else {
            if (IN(pb + 1)) REPS(pb + 1) { const Frame F = mkframe(lds); WS_PTRS();
                pg8::Gemm g; g.A = UA; g.Bt = (const bf16*)(ws + OFF_S5GM); g.M = S5G * S5NCH; g.N = 256; g.K = 512; g.lda = S5KS; g.ldb = 512; g.sa = 0x7F7F7F7F;
                pg8::S5Order S{F.G, F.bid, 2, 1}; pg8::EpiS5E E{S5E};
                pg8::gemm_phase<pg8::EpiS5E, pg8::S5Order, false, true>(F.lds, g, S, E); }
            SEAM(pb + 1);
            if (IN(pb + 2)) REPS(pb + 2) { const Frame F = mkframe(lds); WS_PTRS(); s5_scan_phase(F, (const f32x2*)(ws + OFF_S5PAR), S5E, UA); }
            SEAM(pb + 2);
            if (IN(pb + 3)) REPS(pb + 3) { const Frame F = mkframe(lds); WS_PTRS();
                pg8::Gemm g; g.A = UA; g.Bt = (const bf16*)(ws + OFF_S5BM); g.M = S5G * S5NCH; g.N = S5G * 512; g.K = S5KS; g.lda = S5KS; g.ldb = S5KS; g.sa = 0x7F7F7F7F;
                pg8::S5Order S{F.G, F.bid, 2, 2}; pg8::EpiS5Y E{UA, INP(I_S5D), S5Gb, DM};
                pg8::gemm_phase<pg8::EpiS5Y, pg8::S5Order, false, true>(F.lds, g, S, E); }
            SEAM(pb + 3);
        }
        if (IN(pb + 4)) REPS(pb + 4) {
            const Frame F = mkframe(lds); WS_PTRS();
            if (kind != 2) {
                const bf16* W = (kind == 0) ? (const bf16*)(ws + OFF_NAWO + slot * SZ_DD) : (const bf16*)(ws + OFF_GQAWO);
                pg8::Gemm g = pg8::mkgemm(Ob, W, L, DM, DM / 2); g.sa = 0x79797979; pg8::StaticOrder S; S.init(L, DM, F.G, F.bid);
                pg8::EpiRes E{HB0, HBOUT(HB0), RSOUT(1 + 3 * layer), DM, nullptr};
                pg8::gemm_phase<pg8::EpiRes, pg8::StaticOrder, false, true, true>(F.lds, g, S, E);
            } else {
                pg8::Gemm g = pg8::mkgemm(S5Gb, (const bf16*)(ws + OFF_S5OUT), L, 2 * DM, DM / 2); g.sa = 0x7B7B7B7B; pg8::StaticOrder S; S.init(L, 2 * DM, F.G, F.bid);
                pg8::EpiGlu E{HB0, HBOUT(HB0), RSOUT(1 + 3 * layer), DM};
                pg8::gemm_phase<pg8::EpiGlu, pg8::StaticOrder, false, true, true>(F.lds, g, S, E);
            }
        }
        SEAM(pb + 4);
        if (IN(pb + 5)) REPS(pb + 5) { const Frame F = mkframe(lds); WS_PTRS();
            const pg8::Gemm g = pg8::mkgemm(HB0, (const bf16*)(ws + OFF_W1 + layer * SZ_W1), L, FF, DM); pg8::StaticOrder S; S.init(L, FF, F.G, F.bid);
            pg8::EpiBf16<2> E{HID, HID, HID, FF, FF, FF, 1 << 30, 1 << 30, nullptr, 0, 0};
#if PROBE_PH == 201
            { pg8::RangeOrder R1{S, 0, 8}, R2{S, 8, 16};
              pg8::gemm_phase<pg8::EpiBf16<2>, pg8::RangeOrder, false, true>(F.lds, g, R1, E); xcd_barrier(bar);
              pg8::gemm_phase<pg8::EpiBf16<2>, pg8::RangeOrder, false, true>(F.lds, g, R2, E); }
#else
            pg8::gemm_phase<pg8::EpiBf16<2>, pg8::StaticOrder, false, true>(F.lds, g, S, E);
#endif
        }
        SEAM(pb + 5);
        if (IN(pb + 6)) REPS(pb + 6) { const Frame F = mkframe(lds); WS_PTRS();
            { const pg8::Gemm g = pg8::mkgemm(HID, (const bf16*)(ws + OFF_W2 + layer * SZ_W1), L, DM, FF); pg8::StaticOrder S; S.init(L, DM, F.G, F.bid);
              pg8::EpiRes E{HB0, HBOUT(HB1), RSOUT(2 + 3 * layer), DM, RSP(1 + 3 * layer)};
              pg8::gemm_phase<pg8::EpiRes, pg8::StaticOrder, false, true>(F.lds, g, S, E); }
            { const pg8::Gemm g = pg8::mkgemm((const bf16*)(ws + OFF_PBF + (size_t)layer * L * PLE * 2), (const bf16*)(ws + OFF_PROJ + layer * SZ_PROJ), L, DM, PLE); pg8::StaticOrder S; S.init(L, DM, F.G, F.bid);
              pg8::EpiBf16<0> E{PP, PP, PP, DM, DM, DM, 1 << 30, 1 << 30, nullptr, 0, 0};
              pg8::gemm_phase<pg8::EpiBf16<0>, pg8::StaticOrder, false, true>(F.lds, g, S, E); }
        }
        SEAM(pb + 6);
        if (IN(pb + 7)) REPS(pb + 7) { const Frame F = mkframe(lds); WS_PTRS();
            const pg8::Gemm g = pg8::mkgemm(HB1, (const bf16*)(ws + OFF_GATE + layer * SZ_DD), L, DM, DM); pg8::StaticOrder S; S.init(L, DM, F.G, F.bid);
            pg8::EpiGate E{HB1, HBOUT(HB0), (layer == DEPTH - 1) ? OUTP() : nullptr, PP, RSP(2 + 3 * layer), RSOUT(3 + 3 * layer), DM, (layer + 1 < DEPTH && !(nrep_ == 2 && rep_ == 0)) ? ws + OFF_HB8 : nullptr};
            pg8::gemm_phase<pg8::EpiGate, pg8::StaticOrder, false, true>(F.lds, g, S, E);
        }
        SEAM(pb + 7);
    }
#if PROBE_PH == 400
    { xcd_barrier(bar); const Frame F = mkframe(lds); unsigned char* ws = WSP();
      if (__hip_atomic_load((unsigned*)(ws + OFF_CTL) + 8, __ATOMIC_RELAXED, __HIP_MEMORY_SCOPE_AGENT) != 0u && F.bid == 0 && F.tid < 64) OUTP()[F.tid] = __builtin_nanf(""); }
#endif
#undef IN
#undef SEAM
}

extern "C" void kernel_launch(void* const* d_in, const int* in_sizes, int n_in, void* d_out, int out_size, void* d_ws, size_t ws_size, hipStream_t stream) {
    static int grid = 0;
    if (grid == 0) {
        if (n_in != 28 || in_sizes[0] != L * DM || out_size != L * DM || ws_size < WS_END) {
            fprintf(stderr, "kernel_launch: built for 28 inputs, x/out of %d floats, >= %zu bytes of workspace; got n_in %d, in0 %d, out %d, ws %zu; nothing launched\n", L * DM, (size_t)WS_END, n_in, n_in > 0 ? in_sizes[0] : -1, out_size, ws_size);
            grid = -1; return; }
        int dev = 0, cus = 0, per_cu = 0;
        if (hipGetDevice(&dev) != hipSuccess || hipDeviceGetAttribute(&cus, hipDeviceAttributeMultiprocessorCount, dev) != hipSuccess) { fprintf(stderr, "kernel_launch: device query failed\n"); grid = -1; return; }
        if (hipFuncSetAttribute((const void*)enc_fwd, hipFuncAttributeMaxDynamicSharedMemorySize, LDS_BYTES) != hipSuccess) { fprintf(stderr, "kernel_launch: hipFuncSetAttribute failed\n"); grid = -1; return; }
        if (hipOccupancyMaxActiveBlocksPerMultiprocessor(&per_cu, (const void*)enc_fwd, 512, LDS_BYTES) != hipSuccess || per_cu < 1)
            fprintf(stderr, "kernel_launch: note: occupancy query reports %d workgroups per CU\n", per_cu);
        (void)hipGetLastError();
        grid = cus;
    }
    if (grid < 0) return;
    if (hipMemsetAsync((char*)d_ws + OFF_CTL, 0, CTL_ZERO_BYTES, stream) != hipSuccess) { fprintf(stderr, "kernel_launch: memset failed\n"); return; }
    Args a{};
    for (int i = 0; i < 28; ++i) a.in[i] = (const float*)d_in[i];
    a.out = (float*)d_out; a.ws = (unsigned char*)d_ws;
#if MK_N_LAUNCHES == 1
    a.ph_lo = 0; a.ph_hi = NPH;
    hipLaunchKernelGGL(enc_fwd, dim3(grid), dim3(512), LDS_BYTES, stream, a);
#else
    for (int ph = 0; ph < NPH; ++ph) {
        if (ph > 0) { const int layer = (ph - 1) / PH_PER_LAYER, j = (ph - 1) % PH_PER_LAYER; if (j == 3 && layer % 3 != 2) continue; }
        a.ph_lo = ph; a.ph_hi = ph + 1;
        hipLaunchKernelGGL(enc_fwd, dim3(grid), dim3(512), LDS_BYTES, stream, a);
    }
#endif
    const hipError_t le = hipPeekAtLastError();
    if (le != hipSuccess) fprintf(stderr, "kernel_launch: launch failed: %s\n", hipGetErrorName(le));
}
```

```cpp
#include <hip/hip_runtime.h>
#include <cstdio>
#include <cstdint>

#ifndef MK_N_LAUNCHES
#define MK_N_LAUNCHES 1
#endif

constexpr int L = 16384, DM = 4096, DEPTH = 4, GRID_W = 64, GROWS = L / GRID_W, HD = 128, NH = 32, NKV = 8, KVD = NKV * HD, FF = 4 * DM, PLE = 256;
constexpr int S5G = 256, S5P = 16, S5N = 64, S5TC = 16, S5NC = L / S5TC;
constexpr float EPS = 1e-6f;

#define GAS __attribute__((address_space(1)))
#define LAS __attribute__((address_space(3)))
constexpr unsigned WTAB_OFF = 131072 + 2048;
__device__ __forceinline__ unsigned hw_wave_slot() { return (unsigned)__builtin_amdgcn_s_getreg((5 << 11) | 4) & 63u; }
__device__ __forceinline__ int wg_tid() {
    const unsigned wv = (unsigned)__builtin_amdgcn_readfirstlane((int)((volatile LAS unsigned*)(WTAB_OFF))[hw_wave_slot()]);
    unsigned ln; asm volatile("v_mbcnt_lo_u32_b32 %0, -1, 0\n\tv_mbcnt_hi_u32_b32 %0, -1, %0" : "=v"(ln));
    return (int)(wv * 64u + ln);
}
typedef unsigned short bf16;
typedef unsigned v4u __attribute__((ext_vector_type(4)));
typedef unsigned v2u __attribute__((ext_vector_type(2)));
typedef float f32x4 __attribute__((ext_vector_type(4)));
typedef float f32x2 __attribute__((ext_vector_type(2)));
typedef short bf16x8 __attribute__((ext_vector_type(8)));
typedef short s16x4 __attribute__((ext_vector_type(4)));
typedef GAS unsigned gu32;
#define RLX_AGENT __ATOMIC_RELAXED, __HIP_MEMORY_SCOPE_AGENT
#define LDS_WAIT() asm volatile("s_waitcnt lgkmcnt(0)" ::: "memory")
#define VM_WAIT() asm volatile("s_waitcnt vmcnt(0)" ::: "memory")
__device__ __forceinline__ unsigned f2bf(float f) { unsigned u = __builtin_bit_cast(unsigned, f); return (u + 0x7fffu + ((u >> 16) & 1u)) >> 16; }
__device__ __forceinline__ unsigned pk2(float lo, float hi) { return f2bf(lo) | (f2bf(hi) << 16); }
__device__ __forceinline__ float bf2f(unsigned short b) { return __builtin_bit_cast(float, (unsigned)b << 16); }
__device__ __forceinline__ float bflo(unsigned w) { return __builtin_bit_cast(float, w << 16); }
__device__ __forceinline__ float bfhi(unsigned w) { return __builtin_bit_cast(float, w & 0xffff0000u); }
__device__ __forceinline__ float sigmoidf_fast(float x) { return __builtin_amdgcn_rcpf(1.0f + __builtin_amdgcn_exp2f(-1.4426950408889634f * x)); }

namespace pg8 {
#define PG8_LAS __attribute__((address_space(3)))
#if defined(PROBE_EPI2)
#define PROBE_EPI_DUP if constexpr (Epi::PERM) E(acc, cur, wr, wc, fr, fq);
#else
#define PROBE_EPI_DUP
#endif
typedef unsigned short bf16_t;
typedef short bf16x8 __attribute__((ext_vector_type(8)));
typedef float f32x4 __attribute__((ext_vector_type(4)));
typedef unsigned u32x4 __attribute__((ext_vector_type(4)));
constexpr int BM = 256, BK = 64, HALF = 128, HTB = HALF * BK * 2  , STAGE_BYTES = 8 * HTB, NXCD = 8, WGM = 8;

__host__ __device__ __forceinline__ int lds_byte(int r, int c) { const int st = (r >> 4) * 2 + (c >> 5), rr = r & 15, cc = c & 31, ob = rr * 64 + cc * 2; return st * 1024 + (ob ^ (((ob >> 9) & 1) << 5)); }
__host__ __device__ __forceinline__ void stage_rc(int b, int& R, int& C) { const int st = b / 1024, sb = b % 1024, swz = sb ^ (((sb >> 9) & 1) << 5); R = (st >> 1) * 16 + swz / 64; C = (st & 1) * 32 + (swz % 64) / 2; }
__host__ __device__ __forceinline__ int perm32(int rho) { const int n = rho >> 4, i = rho & 15; return 8 * (i >> 2) + 4 * n + (i & 3); }

struct Unit { int pm, pn; };
struct Gemm { const bf16_t* A; const bf16_t* Bt; int M, N, K, lda, ldb, sa; };
__host__ __device__ __forceinline__ Gemm mkgemm(const bf16_t* A, const bf16_t* Bt, int M, int N, int K) { Gemm g; g.A = A; g.Bt = Bt; g.M = M; g.N = N; g.K = K; g.lda = K; g.ldb = K; g.sa = 0x7F7F7F7F; return g; }

struct StaticOrder {
    int nM, nN, nwg, G, c, wgm;
    __host__ __device__ void init(int M, int N, int G_, int c_, int wgm_ = WGM) { nM = M / BM; nN = N / BM; nwg = nM * nN; G = G_; c = c_; wgm = wgm_; }
    __host__ __device__ bool next(int i, Unit& u) const {
        const long L = (long)i * G + c; if (L >= nwg) return false;
        int wgid = (int)L; { const int q = nwg / NXCD, r = nwg % NXCD, xcd = wgid % NXCD, off = wgid / NXCD; wgid = (xcd < r ? xcd * (q + 1) : r * (q + 1) + (xcd - r) * q) + off; }
        const int nig = wgm * nN, gid = wgid / nig, fm = gid * wgm, gsz = (nM - fm) < wgm ? (nM - fm) : wgm;
        u.pm = fm + ((wgid % nig) % gsz); u.pn = (wgid % nig) / gsz; return true;
    }
    __device__ __forceinline__ void a_ready(const Unit&) const {}
    __device__ __forceinline__ void done(const Unit&) const {}
};
struct RangeOrder { StaticOrder S; int i0, i1;
    __host__ __device__ bool next(int i, Unit& u) const { return (i + i0 < i1) ? S.next(i + i0, u) : false; }
    __device__ __forceinline__ void a_ready(const Unit&) const {}
    __device__ __forceinline__ void done(const Unit&) const {} };


__device__ __forceinline__ unsigned cvt_pk_bf16(float lo, float hi) { unsigned r; asm volatile("v_cvt_pk_bf16_f32 %0, %1, %2" : "=v"(r) : "v"(lo), "v"(hi)); return r; }
__device__ __forceinline__ float sigm(float x) { return __builtin_amdgcn_rcpf(1.0f + __builtin_amdgcn_exp2f(-1.4426950408889634f * x)); }

typedef unsigned long long rs_t;
constexpr float RS_FIX = 16777216.0f, RS_INV = 1.0f / (16777216.0f * 4096.0f), RS_EPS = 1e-6f;
__device__ __forceinline__ void row_ss_add(rs_t* rs, int row, float s, int fq) {
    s += __shfl_xor(s, 16); s += __shfl_xor(s, 32);
    if (fq == 0) __hip_atomic_fetch_add(rs + row, (rs_t)(s * RS_FIX), __ATOMIC_RELAXED, __HIP_MEMORY_SCOPE_AGENT);
}
__device__ __forceinline__ float rs_rinv(rs_t v) { return __builtin_amdgcn_rsqf((float)v * RS_INV + RS_EPS); }
#define PIN8(a) asm volatile("" : "+v"((a)[0]), "+v"((a)[1]), "+v"((a)[2]), "+v"((a)[3]), "+v"((a)[4]), "+v"((a)[5]), "+v"((a)[6]), "+v"((a)[7]))
template <int ACT> struct EpiBf16 {
    static constexpr bool PERM = true, AFTER_DRAIN = false;
    bf16_t *O0, *O1, *O2; int ld0, ld1, ld2, c1, c2; const rs_t* rs; int vt; int rs_from;
    __device__ __forceinline__ void operator()(const f32x4 (&acc)[2][2][4][2], const Unit& u, int wr, int wc, int fr, int fq) const {
        const int row0 = u.pm * BM + wr * 64 + fr; int colt = u.pn * BM; bf16_t* base = O0; int ldc = ld0;
        const rs_t* rs = (colt >= rs_from) ? this->rs : nullptr;
        bool tr = false;
        if (colt >= c2) { base = O2; ldc = ld2; colt -= c2; tr = vt != 0; } else if (colt >= c1) { base = O1; ldc = ld1; colt -= c1; }
        const int col0 = colt + wc * 32 + 8 * fq;
        rs_t scv[8];
#pragma unroll
        for (int gi = 0; gi < 8; ++gi) scv[gi] = rs ? rs[row0 + (gi >> 2) * HALF + (gi & 3) * 16] : 0ull;
        PIN8(scv);
#pragma unroll
        for (int ai = 0; ai < 2; ++ai)
#pragma unroll
            for (int m = 0; m < 4; ++m) { bf16_t* rowp = base + (size_t)(row0 + ai * HALF + m * 16) * ldc + col0; const float sc = rs ? rs_rinv(scv[ai * 4 + m]) : 1.0f;
#pragma unroll
                for (int bj = 0; bj < 2; ++bj) { f32x4 v0 = acc[ai][bj][m][0] * sc, v1 = acc[ai][bj][m][1] * sc;
                    if (ACT == 2) {
#pragma unroll
                        for (int j = 0; j < 4; ++j) { const float a = fmaxf(v0[j], 0.f), b = fmaxf(v1[j], 0.f); v0[j] = a * a; v1[j] = b * b; } }
                    u32x4 w; w.x = cvt_pk_bf16(v0[0], v0[1]); w.y = cvt_pk_bf16(v0[2], v0[3]); w.z = cvt_pk_bf16(v1[0], v1[1]); w.w = cvt_pk_bf16(v1[2], v1[3]);
                    if (vt == 2 && tr) {
                        unsigned char* tp = (unsigned char*)base + (size_t)(col0 + bj * HALF) * ldc + (row0 + ai * HALF + m * 16);
                        int w0 = __builtin_amdgcn_cvt_pk_fp8_f32(v0[0], v0[1], 0, false); w0 = __builtin_amdgcn_cvt_pk_fp8_f32(v0[2], v0[3], w0, true);
                        int w1 = __builtin_amdgcn_cvt_pk_fp8_f32(v1[0], v1[1], 0, false); w1 = __builtin_amdgcn_cvt_pk_fp8_f32(v1[2], v1[3], w1, true);
                        tp[0] = (unsigned char)w0; tp[(size_t)ldc] = (unsigned char)(w0 >> 8); tp[(size_t)2 * ldc] = (unsigned char)(w0 >> 16); tp[(size_t)3 * ldc] = (unsigned char)(w0 >> 24);
                        tp[(size_t)4 * ldc] = (unsigned char)w1; tp[(size_t)5 * ldc] = (unsigned char)(w1 >> 8); tp[(size_t)6 * ldc] = (unsigned char)(w1 >> 16); tp[(size_t)7 * ldc] = (unsigned char)(w1 >> 24); }
                    else if (tr) { bf16_t* tp = base + (size_t)(col0 + bj * HALF) * ldc + (row0 + ai * HALF + m * 16);
                        tp[0] = (bf16_t)w.x; tp[(size_t)ldc] = (bf16_t)(w.x >> 16); tp[(size_t)2 * ldc] = (bf16_t)w.y; tp[(size_t)3 * ldc] = (bf16_t)(w.y >> 16);
                        tp[(size_t)4 * ldc] = (bf16_t)w.z; tp[(size_t)5 * ldc] = (bf16_t)(w.z >> 16); tp[(size_t)6 * ldc] = (bf16_t)w.w; tp[(size_t)7 * ldc] = (bf16_t)(w.w >> 16); }
                    else *(u32x4*)(rowp + bj * HALF) = w; } }
    }
};
struct EpiF32 {
    static constexpr bool PERM = false, AFTER_DRAIN = false;
    float* C; int ldc;
    __device__ __forceinline__ void operator()(const f32x4 (&acc)[2][2][4][2], const Unit& u, int wr, int wc, int fr, int fq) const {
        const int row0 = u.pm * BM + wr * 64 + fr, col0 = u.pn * BM + wc * 32 + 4 * fq;
#pragma unroll
        for (int ai = 0; ai < 2; ++ai)
#pragma unroll
            for (int m = 0; m < 4; ++m) { float* rowp = C + (size_t)(row0 + ai * HALF + m * 16) * ldc + col0;
#pragma unroll
                for (int bj = 0; bj < 2; ++bj)
#pragma unroll
                    for (int n = 0; n < 2; ++n) *(f32x4*)(rowp + bj * HALF + n * 16) = acc[ai][bj][m][n]; }
    }
};
typedef unsigned u32x2 __attribute__((ext_vector_type(2)));
__device__ __forceinline__ f32x4 bf4_to_f32(u32x2 p) { return (f32x4){__builtin_bit_cast(float, p.x << 16), __builtin_bit_cast(float, p.x & 0xffff0000u), __builtin_bit_cast(float, p.y << 16), __builtin_bit_cast(float, p.y & 0xffff0000u)}; }
struct EpiRes {
    static constexpr bool PERM = false, AFTER_DRAIN = false;
    const bf16_t* base; bf16_t* out; rs_t* rs; int ldc; const rs_t* rsq;
    __device__ __forceinline__ void operator()(const f32x4 (&acc)[2][2][4][2], const Unit& u, int wr, int wc, int fr, int fq) const {
        constexpr int PD = 3;
        const int row0 = u.pm * BM + wr * 64 + fr, col0 = u.pn * BM + wc * 32 + 4 * fq;
        u32x2 nb[8][2][2];
        rs_t scv[8];
#pragma unroll
        for (int gi = 0; gi < 8; ++gi) scv[gi] = rsq ? rsq[row0 + (gi >> 2) * HALF + (gi & 3) * 16] : 0ull;
#define EPI_LD(g) do { const size_t o_ = (size_t)(row0 + ((g) >> 2) * HALF + ((g) & 3) * 16) * ldc + col0; _Pragma("unroll") for (int bj = 0; bj < 2; ++bj) _Pragma("unroll") for (int n = 0; n < 2; ++n) nb[g][bj][n] = *(const u32x2*)(base + o_ + bj * HALF + n * 16); } while (0)
#pragma unroll
        for (int g = 0; g < PD; ++g) EPI_LD(g);
        PIN8(scv);
#pragma unroll
        for (int gi = 0; gi < 8; ++gi) { const int ai = gi >> 2, m = gi & 3; const int row = row0 + ai * HALF + m * 16; const size_t off = (size_t)row * ldc + col0;
            if (gi + PD < 8) EPI_LD(gi + PD);
            const float sc2 = rsq ? __builtin_amdgcn_rcpf((float)scv[gi] * RS_INV + RS_EPS) : 1.0f;
            float ss = 0.f;
#pragma unroll
            for (int bj = 0; bj < 2; ++bj)
#pragma unroll
                for (int n = 0; n < 2; ++n) { const f32x4 o = bf4_to_f32(nb[gi][bj][n]) + acc[ai][bj][m][n] * sc2;
                    ss += (o[0] * o[0] + o[1] * o[1]) + (o[2] * o[2] + o[3] * o[3]);
                    u32x2 w; w.x = cvt_pk_bf16(o[0], o[1]); w.y = cvt_pk_bf16(o[2], o[3]); *(u32x2*)(out + off + bj * HALF + n * 16) = w; }
            row_ss_add(rs, row, ss, fq); }
#undef EPI_LD
    }
};
struct EpiGate {
    static constexpr bool PERM = false, AFTER_DRAIN = false;
    const bf16_t* base; bf16_t* out; float* out32; const bf16_t* pp; const rs_t* rsin; rs_t* rs; int ldc; unsigned char* out8;
    __device__ __forceinline__ void operator()(const f32x4 (&acc)[2][2][4][2], const Unit& u, int wr, int wc, int fr, int fq) const {
        constexpr int PD = 2;
        const int row0 = u.pm * BM + wr * 64 + fr, col0 = u.pn * BM + wc * 32 + 4 * fq;
        rs_t scv[8];
#pragma unroll
        for (int gi = 0; gi < 8; ++gi) scv[gi] = rsin[row0 + (gi >> 2) * HALF + (gi & 3) * 16];
        u32x2 nb[8][2][2], np[8][2][2];
#define EPI_LD(g) do { const size_t o_ = (size_t)(row0 + ((g) >> 2) * HALF + ((g) & 3) * 16) * ldc + col0; _Pragma("unroll") for (int bj = 0; bj < 2; ++bj) _Pragma("unroll") for (int n = 0; n < 2; ++n) { \
            nb[g][bj][n] = *(const u32x2*)(base + o_ + bj * HALF + n * 16); np[g][bj][n] = *(const u32x2*)(pp + o_ + bj * HALF + n * 16); } } while (0)
#pragma unroll
        for (int g = 0; g < PD; ++g) EPI_LD(g);
        PIN8(scv);
#pragma unroll
        for (int gi = 0; gi < 8; ++gi) { const int ai = gi >> 2, m = gi & 3; const int row = row0 + ai * HALF + m * 16; const size_t off = (size_t)row * ldc + col0;
            if (gi + PD < 8) EPI_LD(gi + PD);
            const float sc = rs_rinv(scv[gi]);
            float ss = 0.f;
#pragma unroll
            for (int bj = 0; bj < 2; ++bj)
#pragma unroll
                for (int n = 0; n < 2; ++n) { const f32x4 a = acc[ai][bj][m][n] * sc, p = bf4_to_f32(np[gi][bj][n]); f32x4 o = bf4_to_f32(nb[gi][bj][n]);
#pragma unroll
                    for (int j = 0; j < 4; ++j) o[j] += sigm(a[j]) * p[j];
                    if (out32) *(f32x4*)(out32 + off + bj * HALF + n * 16) = o;
                    if (out8) { int w8 = __builtin_amdgcn_cvt_pk_fp8_f32(o[0], o[1], 0, false); w8 = __builtin_amdgcn_cvt_pk_fp8_f32(o[2], o[3], w8, true); *(unsigned*)(out8 + off + bj * HALF + n * 16) = (unsigned)w8; }
                    ss += (o[0] * o[0] + o[1] * o[1]) + (o[2] * o[2] + o[3] * o[3]);
                    u32x2 w; w.x = cvt_pk_bf16(o[0], o[1]); w.y = cvt_pk_bf16(o[2], o[3]); *(u32x2*)(out + off + bj * HALF + n * 16) = w; }
            row_ss_add(rs, row, ss, fq); }
#undef EPI_LD
    }
};
struct EpiGlu {
    static constexpr bool PERM = false, AFTER_DRAIN = false;
    const bf16_t* base; bf16_t* out; rs_t* rs; int ldc;
    __device__ __forceinline__ void operator()(const f32x4 (&acc)[2][2][4][2], const Unit& u, int wr, int wc, int fr, int fq) const {
        constexpr int PD = 3;
        const int row0 = u.pm * BM + wr * 64 + fr, col0 = u.pn * HALF + wc * 32 + 4 * fq;
        u32x2 nb[8][2];
#define EPI_LD(g) do { const size_t o_ = (size_t)(row0 + ((g) >> 2) * HALF + ((g) & 3) * 16) * ldc + col0; _Pragma("unroll") for (int n = 0; n < 2; ++n) nb[g][n] = *(const u32x2*)(base + o_ + n * 16); } while (0)
#pragma unroll
        for (int g = 0; g < PD; ++g) EPI_LD(g);
#pragma unroll
        for (int gi = 0; gi < 8; ++gi) { const int ai = gi >> 2, m = gi & 3; const int row = row0 + ai * HALF + m * 16; const size_t off = (size_t)row * ldc + col0;
            if (gi + PD < 8) EPI_LD(gi + PD);
            float ss = 0.f;
#pragma unroll
            for (int n = 0; n < 2; ++n) { const f32x4 a = acc[ai][0][m][n], g = acc[ai][1][m][n]; f32x4 o = bf4_to_f32(nb[gi][n]);
#pragma unroll
                for (int j = 0; j < 4; ++j) o[j] += a[j] * sigm(g[j]);
                ss += (o[0] * o[0] + o[1] * o[1]) + (o[2] * o[2] + o[3] * o[3]);
                u32x2 w; w.x = cvt_pk_bf16(o[0], o[1]); w.y = cvt_pk_bf16(o[2], o[3]); *(u32x2*)(out + off + n * 16) = w; }
            row_ss_add(rs, row, ss, fq); }
#undef EPI_LD
    }
};

constexpr int S5T = 32, S5NCH = 512, S5KS = 768;
struct S5Order {
    int G, c, MT, NT;
    __device__ __forceinline__ bool next(int i, Unit& u) const { const int idx = i * G + c; if (idx >= 256 * MT * NT) return false; const int g = idx & 255, sub = idx >> 8;
        u.pm = g * MT + sub / NT; u.pn = g * NT + sub % NT; return true; }
    __device__ __forceinline__ void a_ready(const Unit&) const {}
    __device__ __forceinline__ void done(const Unit&) const {}
};
struct EpiS5U {
    static constexpr bool PERM = true, AFTER_DRAIN = false;
    bf16_t* UA; const rs_t* rs;
    __device__ __forceinline__ void operator()(const f32x4 (&acc)[2][2][4][2], const Unit& u, int wr, int wc, int fr, int fq) const {
        const int row0 = u.pm * BM + wr * 64 + fr, col0 = u.pn * BM + wc * 32 + 8 * fq;
        rs_t scv[8];
#pragma unroll
        for (int gi = 0; gi < 8; ++gi) scv[gi] = rs[row0 + (gi >> 2) * HALF + (gi & 3) * 16];
        PIN8(scv);
#pragma unroll
        for (int ai = 0; ai < 2; ++ai)
#pragma unroll
            for (int m = 0; m < 4; ++m) { const int t = row0 + ai * HALF + m * 16, c = t >> 5, sg = t & 31; const float sc = rs_rinv(scv[ai * 4 + m]);
#pragma unroll
                for (int bj = 0; bj < 2; ++bj) { const int col = col0 + bj * HALF, g = col >> 4, q0 = col & 15;
                    const f32x4 v0 = acc[ai][bj][m][0] * sc, v1 = acc[ai][bj][m][1] * sc;
                    u32x4 w; w.x = cvt_pk_bf16(v0[0], v0[1]); w.y = cvt_pk_bf16(v0[2], v0[3]); w.z = cvt_pk_bf16(v1[0], v1[1]); w.w = cvt_pk_bf16(v1[2], v1[3]);
                    *(u32x4*)(UA + ((size_t)(g * S5NCH + c) * S5KS + sg * 16 + q0)) = w; } }
    }
};
struct EpiS5E {
    static constexpr bool PERM = false, AFTER_DRAIN = false;
    float* E;
    __device__ __forceinline__ void operator()(const f32x4 (&acc)[2][2][4][2], const Unit& u, int wr, int wc, int fr, int fq) const {
        const int row0 = u.pm * BM + wr * 64 + fr, col0 = wc * 32 + 4 * fq;
#pragma unroll
        for (int ai = 0; ai < 2; ++ai)
#pragma unroll
            for (int m = 0; m < 4; ++m) { float* rowp = E + (size_t)(row0 + ai * HALF + m * 16) * 256 + col0;
#pragma unroll
                for (int bj = 0; bj < 2; ++bj)
#pragma unroll
                    for (int n = 0; n < 2; ++n) *(f32x4*)(rowp + bj * HALF + n * 16) = acc[ai][bj][m][n]; }
    }
};
__device__ __forceinline__ float gelu_tanh_f(float v) {
    const float z = 0.7978845608028654f * (v + 0.044715f * v * v * v);
    const float e = __builtin_amdgcn_exp2f(2.0f * 1.4426950408889634f * z);
    return 0.5f * v * (2.0f - 2.0f * __builtin_amdgcn_rcpf(e + 1.0f));
}
struct EpiS5Y {
    static constexpr bool PERM = true, AFTER_DRAIN = false;
    const bf16_t* UA; const float* dskip; bf16_t* G; int ldg;
    __device__ __forceinline__ void operator()(const f32x4 (&acc)[2][2][4][2], const Unit& u, int wr, int wc, int fr, int fq) const {
        const int row0 = u.pm * BM + wr * 64 + fr, col0 = (u.pn & 1) * BM + wc * 32 + 8 * fq;
        const int g = u.pm >> 1, p0 = col0 & 15;
        const f32x4 d0 = *(const f32x4*)(dskip + 16 * g + p0), d1 = *(const f32x4*)(dskip + 16 * g + p0 + 4);
        u32x4 uu[8][2];
#pragma unroll
        for (int gi = 0; gi < 8; ++gi)
#pragma unroll
            for (int bj = 0; bj < 2; ++bj) uu[gi][bj] = *(const u32x4*)(UA + ((size_t)(row0 + (gi >> 2) * HALF + (gi & 3) * 16) * S5KS + col0 + bj * HALF));
#pragma unroll
        for (int gi = 0; gi < 8; ++gi) asm volatile("" : "+v"(uu[gi][0]), "+v"(uu[gi][1]));
#pragma unroll
        for (int gi = 0; gi < 8; ++gi) { const int ai = gi >> 2, m = gi & 3; const int rowg = row0 + ai * HALF + m * 16, c = rowg & 511;
#pragma unroll
            for (int bj = 0; bj < 2; ++bj) { const int col = col0 + bj * HALF, tau = col >> 4; const u32x4 w4 = uu[gi][bj];
                f32x4 v0 = acc[ai][bj][m][0], v1 = acc[ai][bj][m][1];
                v0[0] += d0[0] * __builtin_bit_cast(float, w4.x << 16); v0[1] += d0[1] * __builtin_bit_cast(float, w4.x & 0xffff0000u);
                v0[2] += d0[2] * __builtin_bit_cast(float, w4.y << 16); v0[3] += d0[3] * __builtin_bit_cast(float, w4.y & 0xffff0000u);
                v1[0] += d1[0] * __builtin_bit_cast(float, w4.z << 16); v1[1] += d1[1] * __builtin_bit_cast(float, w4.z & 0xffff0000u);
                v1[2] += d1[2] * __builtin_bit_cast(float, w4.w << 16); v1[3] += d1[3] * __builtin_bit_cast(float, w4.w & 0xffff0000u);
#pragma unroll
                for (int j = 0; j < 4; ++j) { v0[j] = gelu_tanh_f(v0[j]); v1[j] = gelu_tanh_f(v1[j]); }
                int w0 = __builtin_amdgcn_cvt_pk_fp8_f32(16.f * v0[0], 16.f * v0[1], 0, false); w0 = __builtin_amdgcn_cvt_pk_fp8_f32(16.f * v0[2], 16.f * v0[3], w0, true);
                int w1 = __builtin_amdgcn_cvt_pk_fp8_f32(16.f * v1[0], 16.f * v1[1], 0, false); w1 = __builtin_amdgcn_cvt_pk_fp8_f32(16.f * v1[2], 16.f * v1[3], w1, true);
                *(v2u*)((unsigned char*)G + (size_t)(32 * c + tau) * ldg + 16 * g + p0) = (v2u){(unsigned)w0, (unsigned)w1}; } }
    }
};

template <class Epi, class Sched, bool ALIGN_EPI = false, bool SP2 = false, bool FP8 = false>
__device__ __forceinline__ void gemm_phase(PG8_LAS unsigned char* lds, const Gemm g, const Sched& S, const Epi& E) {
    int tid_o = wg_tid(); asm volatile("" : "+v"(tid_o)); const int tid = tid_o, wid = __builtin_amdgcn_readfirstlane(tid >> 6), lane = tid & 63, wr = wid >> 2, wc = wid & 3, fr = lane & 15, fq = lane >> 4;
    const int K = g.K, nt = K / BK;
    unsigned voffA[2], voffB[2];
#pragma unroll
    for (int i = 0; i < 2; ++i) { int R, C; stage_rc(tid * 16 + i * 8192, R, C); const int Rb = Epi::PERM ? ((R & ~31) + perm32(R & 31)) : R;
        voffA[i] = (unsigned)(R * g.lda + C) * 2u; voffB[i] = (unsigned)(Rb * g.ldb + C) * 2u; }
    const size_t kstep = (size_t)(BK * 2);
    const size_t hstepA = (size_t)HALF * g.lda * 2, hstepB = (size_t)HALF * g.ldb * 2;
    const size_t tstepA = 2 * hstepA, tstepB = 2 * hstepB;
    const unsigned ldsw = (unsigned)wid * 1024u;
    const int aoff = lds_byte(wr * 64 + fr, fq * 8), boff = lds_byte(wc * 32 + fr, fq * 8);
    const int aoff8 = lds_byte(wr * 64 + fr, fq * 16), boff8 = lds_byte(wc * 32 + fr, fq * 16);
#define PG8_SA(b, h) (((b) * 2 + (h)) * HTB)
#define PG8_SB(b, h) ((4 + (b) * 2 + (h)) * HTB)
#define PG8_STAGE(bufoff, gbase, voff) do { _Pragma("unroll") for (int _i = 0; _i < 2; ++_i) \
        __builtin_amdgcn_global_load_lds((const unsigned*)((const char*)(gbase) + (voff)[_i]), (PG8_LAS unsigned*)(lds + (bufoff) + ldsw + _i * 8192), 16, 0, 0); } while (0)
#define PG8_LDA(dst, b, h) do { if constexpr (FP8) { _Pragma("unroll") for (int m = 0; m < 4; ++m) { const PG8_LAS unsigned char* p_ = lds + PG8_SA(b, h) + aoff8 + m * 2048; const v4i32 l_ = *(const PG8_LAS v4i32*)p_, h_ = *(const PG8_LAS v4i32*)(p_ + 16); \
        dst##8[m] = __builtin_shufflevector(l_, h_, 0, 1, 2, 3, 4, 5, 6, 7); } } else { \
        _Pragma("unroll") for (int m = 0; m < 4; ++m) _Pragma("unroll") for (int k = 0; k < 2; ++k) dst[m][k] = *(const PG8_LAS bf16x8*)(lds + PG8_SA(b, h) + aoff + m * 2048 + k * 1024); } } while (0)
#define PG8_LDB(dst, b, h) do { if constexpr (FP8) { _Pragma("unroll") for (int n = 0; n < 2; ++n) { const PG8_LAS unsigned char* p_ = lds + PG8_SB(b, h) + boff8 + n * 2048; const v4i32 l_ = *(const PG8_LAS v4i32*)p_, h_ = *(const PG8_LAS v4i32*)(p_ + 16); \
        dst##8[n] = __builtin_shufflevector(l_, h_, 0, 1, 2, 3, 4, 5, 6, 7); } } else { \
        _Pragma("unroll") for (int n = 0; n < 2; ++n) _Pragma("unroll") for (int k = 0; k < 2; ++k) dst[n][k] = *(const PG8_LAS bf16x8*)(lds + PG8_SB(b, h) + boff + n * 2048 + k * 1024); } } while (0)
#define PG8_MMA(ai, bj, At, Bt) do { __builtin_amdgcn_s_setprio(1); if constexpr (FP8) { _Pragma("unroll") for (int m = 0; m < 4; ++m) _Pragma("unroll") for (int n = 0; n < 2; ++n) \
        asm volatile("v_mfma_scale_f32_16x16x128_f8f6f4 %0, %1, %2, %0, %3, %4 op_sel_hi:[0,0,0]" : "+v"(acc[ai][bj][m][n]) : "v"(Bt##8[n]), "v"(At##8[m]), "v"(sc_w8), "v"(sc_a8)); } else { \
        _Pragma("unroll") for (int m = 0; m < 4; ++m) _Pragma("unroll") for (int n = 0; n < 2; ++n) _Pragma("unroll") for (int k = 0; k < 2; ++k) \
        acc[ai][bj][m][n] = __builtin_amdgcn_mfma_f32_16x16x32_bf16(Bt[n][k], At[m][k], acc[ai][bj][m][n], 0, 0, 0); } __builtin_amdgcn_s_setprio(0); } while (0)
#define PG8_WAIT_V(n) asm volatile("s_waitcnt vmcnt(" #n ")" ::: "memory")
#define PG8_WAIT_L(n) asm volatile("s_waitcnt lgkmcnt(" #n ")" ::: "memory")
#define PG8_BAR __builtin_amdgcn_s_barrier()
#define PG8_SCHED __builtin_amdgcn_sched_barrier(0)
    Unit cur, nxt; int ui = 0;
    if (!S.next(0, cur)) return;
    f32x4 acc[2][2][4][2];
#pragma unroll
    for (int a = 0; a < 2; ++a)
#pragma unroll
        for (int b = 0; b < 2; ++b)
#pragma unroll
            for (int m = 0; m < 4; ++m)
#pragma unroll
                for (int n = 0; n < 2; ++n) acc[a][b][m][n] = (f32x4){0.f, 0.f, 0.f, 0.f};
    bf16x8 At[4][2], B0[2][2], B1[2][2];
    typedef int v8i32 __attribute__((ext_vector_type(8))); typedef int v4i32 __attribute__((ext_vector_type(4))); v8i32 At8[4], B08[2], B18[2];
    const int sc_w8 = 0x79797979, sc_a8 = g.sa;
    const char* cA = (const char*)g.A + (size_t)cur.pm * tstepA; const char* cB = (const char*)g.Bt + (size_t)cur.pn * tstepB;
    S.a_ready(cur);
    if constexpr (SP2) {
        PG8_STAGE(PG8_SB(0, 0), cB, voffB); PG8_STAGE(PG8_SB(0, 1), cB + hstepB, voffB); PG8_STAGE(PG8_SA(0, 0), cA, voffA); PG8_STAGE(PG8_SA(0, 1), cA + hstepA, voffA);
        if (wr == 1) PG8_BAR;
        PG8_WAIT_V(2); PG8_BAR;
        PG8_STAGE(PG8_SB(1, 0), cB + kstep, voffB); PG8_STAGE(PG8_SA(1, 0), cA + kstep, voffA); PG8_STAGE(PG8_SB(1, 1), cB + hstepB + kstep, voffB);
        PG8_WAIT_V(6); PG8_BAR;
    } else {
        PG8_STAGE(PG8_SB(0, 0), cB, voffB); PG8_STAGE(PG8_SA(0, 0), cA, voffA); PG8_STAGE(PG8_SB(0, 1), cB + hstepB, voffB); PG8_STAGE(PG8_SA(0, 1), cA + hstepA, voffA);
        if (wr == 1) PG8_BAR;
        PG8_WAIT_V(4); PG8_BAR;
        PG8_STAGE(PG8_SB(1, 0), cB + kstep, voffB); PG8_STAGE(PG8_SA(1, 0), cA + kstep, voffA); PG8_STAGE(PG8_SB(1, 1), cB + hstepB + kstep, voffB);
        PG8_WAIT_V(6); PG8_BAR;
    }
    for (;;) {
        const bool has_next = S.next(ui + 1, nxt);
        const char* nA = has_next ? (const char*)g.A + (size_t)nxt.pm * tstepA : cA; const char* nB = has_next ? (const char*)g.Bt + (size_t)nxt.pn * tstepB : cB;
        for (int t = 0; t < nt; t += 2) {
            const bool last = (t == nt - 2);
            const char* a1 = cA + (size_t)(t + 1) * kstep;
            const char* a2 = last ? nA : cA + (size_t)(t + 2) * kstep; const char* b2 = last ? nB : cB + (size_t)(t + 2) * kstep;
            const char* a3 = a2 + kstep; const char* b3 = b2 + kstep;
            if (last && has_next) S.a_ready(nxt);
            if constexpr (SP2) {
            PG8_LDB(B0, 0, 0); PG8_LDB(B1, 0, 1); PG8_SCHED; PG8_LDA(At, 0, 0); PG8_STAGE(PG8_SA(1, 1), a1 + hstepA, voffA);
            PG8_WAIT_V(8); PG8_WAIT_L(0); PG8_BAR; PG8_MMA(0, 0, At, B0); PG8_MMA(0, 1, At, B1); PG8_BAR; PG8_SCHED;
            PG8_LDA(At, 0, 1); PG8_STAGE(PG8_SB(0, 0), b2, voffB); PG8_STAGE(PG8_SB(0, 1), b2 + hstepB, voffB); PG8_STAGE(PG8_SA(0, 0), a2, voffA);
            PG8_WAIT_V(8); PG8_WAIT_L(0); PG8_BAR; PG8_MMA(1, 0, At, B0); PG8_MMA(1, 1, At, B1); PG8_BAR; PG8_SCHED;
            PG8_LDB(B0, 1, 0); PG8_LDB(B1, 1, 1); PG8_SCHED; PG8_LDA(At, 1, 0); PG8_STAGE(PG8_SA(0, 1), a2 + hstepA, voffA);
            PG8_WAIT_V(8); PG8_WAIT_L(0); PG8_BAR; PG8_MMA(0, 0, At, B0); PG8_MMA(0, 1, At, B1); PG8_BAR; PG8_SCHED;
            PG8_LDA(At, 1, 1); PG8_STAGE(PG8_SB(1, 0), b3, voffB); PG8_STAGE(PG8_SB(1, 1), b3 + hstepB, voffB); PG8_STAGE(PG8_SA(1, 0), a3, voffA);
            PG8_WAIT_V(8); PG8_WAIT_L(0); PG8_BAR; PG8_MMA(1, 0, At, B0); PG8_MMA(1, 1, At, B1); PG8_BAR; PG8_SCHED;
            } else {
            PG8_LDB(B0, 0, 0); PG8_SCHED; PG8_LDA(At, 0, 0); PG8_STAGE(PG8_SA(1, 1), a1 + hstepA, voffA);
            PG8_WAIT_L(8); PG8_BAR; PG8_WAIT_L(0); PG8_MMA(0, 0, At, B0); PG8_BAR; PG8_SCHED;
            PG8_LDB(B1, 0, 1); PG8_STAGE(PG8_SB(0, 0), b2, voffB);
            PG8_BAR; PG8_WAIT_L(0); PG8_MMA(0, 1, At, B1); PG8_BAR;
            PG8_LDA(At, 0, 1); PG8_STAGE(PG8_SA(0, 0), a2, voffA);
            PG8_BAR; PG8_WAIT_L(0); PG8_MMA(1, 0, At, B0); PG8_BAR; PG8_SCHED;
            PG8_STAGE(PG8_SB(0, 1), b2 + hstepB, voffB);
            PG8_WAIT_V(6); PG8_BAR; PG8_MMA(1, 1, At, B1); PG8_BAR;
            PG8_LDB(B0, 1, 0); PG8_SCHED; PG8_LDA(At, 1, 0); PG8_STAGE(PG8_SA(0, 1), a2 + hstepA, voffA);
            PG8_WAIT_L(8); PG8_BAR; PG8_WAIT_L(0); PG8_MMA(0, 0, At, B0); PG8_BAR; PG8_SCHED;
            PG8_LDB(B1, 1, 1); PG8_STAGE(PG8_SB(1, 0), b3, voffB);
            PG8_BAR; PG8_WAIT_L(0); PG8_MMA(0, 1, At, B1); PG8_BAR;
            PG8_LDA(At, 1, 1); PG8_STAGE(PG8_SA(1, 0), a3, voffA);
            PG8_BAR; PG8_WAIT_L(0); PG8_MMA(1, 0, At, B0); PG8_BAR; PG8_SCHED;
            PG8_STAGE(PG8_SB(1, 1), b3 + hstepB, voffB);
            PG8_WAIT_V(6); PG8_BAR; PG8_MMA(1, 1, At, B1); PG8_BAR;
            }
        }
        if constexpr (FP8) asm volatile("s_nop 15\n\ts_nop 7" ::: "memory");
        if constexpr (ALIGN_EPI) { if (wr == 0) PG8_BAR; }
        if constexpr (!Epi::AFTER_DRAIN) { E(acc, cur, wr, wc, fr, fq); PROBE_EPI_DUP S.done(cur); }
        if (!has_next) break;
#pragma unroll
        for (int a = 0; a < 2; ++a)
#pragma unroll
            for (int b = 0; b < 2; ++b)
#pragma unroll
                for (int m = 0; m < 4; ++m)
#pragma unroll
                    for (int n = 0; n < 2; ++n) acc[a][b][m][n] = (f32x4){0.f, 0.f, 0.f, 0.f};
        cur = nxt; cA = nA; cB = nB; ++ui;
        if constexpr (ALIGN_EPI) { if (wr == 1) PG8_BAR; }
    }
    PG8_WAIT_V(0);
    if constexpr (!ALIGN_EPI) { if (wr == 0) PG8_BAR; }
    PG8_BAR;
    if constexpr (Epi::AFTER_DRAIN) { E.fused(acc, cur, wr, wc, fr, fq, lds, wid, lane); S.done(cur); }
#undef PG8_SA
#undef PG8_SB
#undef PG8_STAGE
#undef PG8_LDA
#undef PG8_LDB
#undef PG8_MMA
#undef PG8_WAIT_V
#undef PG8_WAIT_L
#undef PG8_BAR
#undef PG8_SCHED
}
}
#define XB_TMO      128
#define XB_XCNT(j)  (256  + 64 * (j))
#define XB_XSUB(j)  (1280 + 64 * (j))
#define XB_XGEN(j)  (2304 + 64 * (j))
#define XB_TOP      3328
#define XB_TOPGEN   3392
#define XCD_BAR_WORDS 3456
#define XB_SPIN_CAP (1u << 18)

__device__ __forceinline__ unsigned xb_ld(unsigned* p)              { return __hip_atomic_load(p, __ATOMIC_RELAXED, __HIP_MEMORY_SCOPE_AGENT); }
__device__ __forceinline__ unsigned xb_add(unsigned* p, unsigned v) { return __hip_atomic_fetch_add(p, v, __ATOMIC_RELAXED, __HIP_MEMORY_SCOPE_AGENT); }
__device__ __forceinline__ unsigned xb_xcc_id() { return (unsigned)__builtin_amdgcn_s_getreg((3 << 11) | 20) & 0xFu; }
#define XB_SPIN(cond, bar) do { unsigned _sp = 0; while (cond) { __builtin_amdgcn_s_sleep(1); \
    if ((++_sp & 255u) == 0u) { if (xb_ld(&(bar)[XB_TMO])) break; if (_sp > XB_SPIN_CAP) { atomicAdd(&(bar)[XB_TMO], 1u); break; } } } } while (0)

struct XcdBarrier {
    unsigned* bar; unsigned x;
    volatile LAS unsigned* st;
};

__device__ __forceinline__ XcdBarrier xcd_barrier_post(unsigned* bar, volatile LAS unsigned* st) {
    XcdBarrier b; b.bar = bar; b.x = xb_xcc_id(); b.st = st;
    if (wg_tid() == 0) (void)xb_add(&bar[XB_XCNT(b.x)], 1u);
    return b;
}
__device__ __forceinline__ void xcd_barrier_complete(unsigned* bar, unsigned x, unsigned& nloc, unsigned& nx) {
    const unsigned G = gridDim.x * gridDim.y * gridDim.z;
    unsigned sum, cnt, mine, sp = 0u;
    for (;;) {
        sum = 0u; cnt = 0u; mine = 0u;
#pragma unroll
        for (unsigned j = 0; j < 16; ++j) { const unsigned c = xb_ld(&bar[XB_XCNT(j)]); sum += c; cnt += (c > 0u) ? 1u : 0u; mine = (j == x) ? c : mine; }
        if (sum == G) break;
        __builtin_amdgcn_s_sleep(1);
        if ((++sp & 255u) == 0u) { if (xb_ld(&bar[XB_TMO])) break; if (sp > XB_SPIN_CAP) { atomicAdd(&bar[XB_TMO], 1u); break; } }
    }
    nloc = mine > 0u ? mine : 1u; nx = cnt > 0u ? cnt : 1u;
}

__device__ __forceinline__ void xcd_barrier(const XcdBarrier& b) {
    asm volatile("s_waitcnt vmcnt(0)" ::: "memory");
    __syncthreads();
    if (wg_tid() == 0) {
        unsigned* bar = b.bar;
        __builtin_amdgcn_s_waitcnt(0);
        unsigned nloc = b.st[0], nx = b.st[1];
        if (nloc == 0u) { xcd_barrier_complete(bar, b.x, nloc, nx); b.st[0] = nloc; b.st[1] = nx; }
        const unsigned old = xb_add(&bar[XB_XSUB(b.x)], 1u);
        const unsigned gen = old / nloc;
        if (old + 1u == (gen + 1u) * nloc) {
            __builtin_amdgcn_fence(__ATOMIC_RELEASE, "agent");
            asm volatile("s_waitcnt vmcnt(0)" ::: "memory");
            const unsigned og = xb_add(&bar[XB_TOP], 1u);
            const unsigned tg = og / nx;
            if (og + 1u == (tg + 1u) * nx) xb_add(&bar[XB_TOPGEN], 1u);
            else XB_SPIN(xb_ld(&bar[XB_TOPGEN]) == tg, bar);
            __builtin_amdgcn_fence(__ATOMIC_ACQUIRE, "agent");
            xb_add(&bar[XB_XGEN(b.x)], 1u);
            asm volatile("s_waitcnt vmcnt(0)" ::: "memory");
        } else {
            XB_SPIN(xb_ld(&bar[XB_XGEN(b.x)]) == gen, bar);
            __builtin_amdgcn_fence(__ATOMIC_ACQUIRE, "agent");
            asm volatile("s_waitcnt vmcnt(0)" ::: "memory");
        }
    }
    __syncthreads();
}
namespace dattn {
typedef unsigned short bf16;
constexpr int   D = 128, NW = 8, QBLK = 32, KVBLK = 64;
constexpr float SCALE = 0.088388347648318440f;
constexpr float THR = 8.f;
constexpr int SDEPTH = 2;
constexpr int LDQ = 4096, LDK = 1024, LDO = 4096;
constexpr size_t SHM_V = KVBLK * D * 2, SHM_K = KVBLK * D * 2, SHM_ATTN = 3 * SHM_V + 3 * SHM_K + NW * 64 * 4 + 2048;
using bf16x8 = __attribute__((ext_vector_type(8))) short;
using s16x4  = __attribute__((ext_vector_type(4))) short;
using f32x16 = __attribute__((ext_vector_type(16))) float;
using f32x8  = __attribute__((ext_vector_type(8))) float;
using u32x4  = __attribute__((ext_vector_type(4))) unsigned;
#define KSWZ(row, colB) ((row) * 256 + ((colB) ^ (((row) & 7) << 4)))
#define SBAR() __builtin_amdgcn_sched_barrier(0)
__device__ __forceinline__ int crow(int r, int hi) { return (r & 3) + 8 * (r >> 2) + 4 * hi; }
__device__ __forceinline__ unsigned cvtpk(float lo, float hi) {
  unsigned r; asm volatile("v_cvt_pk_bf16_f32 %0, %1, %2" : "=v"(r) : "v"(lo), "v"(hi)); return r;
}
template <typename TIn> struct Stage;
template <> struct Stage<bf16>  { using T = bf16x8;
  __device__ static __forceinline__ T ld8(const bf16* p) { return *reinterpret_cast<const bf16x8*>(p); }
  __device__ static __forceinline__ bf16x8 tobf(T x) { return x; } };
template <> struct Stage<float> { using T = f32x8;
  __device__ static __forceinline__ T ld8(const float* p) { return *reinterpret_cast<const f32x8*>(p); }
  __device__ static __forceinline__ bf16x8 tobf(T x) {
    u32x4 w = {cvtpk(x[0], x[1]), cvtpk(x[2], x[3]), cvtpk(x[4], x[5]), cvtpk(x[6], x[7])}; return *reinterpret_cast<bf16x8*>(&w); } };

__device__ __forceinline__ void partialSM(f32x16& p0, f32x16& p1, float& m_reg, float& mn, float& alpha) {
  constexpr float C = SCALE * 1.4426950408889634f;
  float pmax = p0[0]; for (int r = 1; r < 16; ++r) pmax = fmaxf(pmax, p0[r]); for (int r = 0; r < 16; ++r) pmax = fmaxf(pmax, p1[r]);
  { auto rr = __builtin_amdgcn_permlane32_swap(__float_as_uint(pmax), __float_as_uint(pmax), false, false);
    pmax = fmaxf(__uint_as_float(rr[0]), __uint_as_float(rr[1])); }
  if (__builtin_expect(__all(pmax - m_reg <= THR / SCALE), 1)) { mn = m_reg; alpha = 1.f; }
  else { mn = fmaxf(m_reg, pmax); alpha = __builtin_amdgcn_exp2f((m_reg - mn) * C); m_reg = mn; }
  float mnC = -mn * C;
  for (int r = 0; r < 16; ++r) p0[r] = fmaf(p0[r], C, mnC); for (int r = 0; r < 16; ++r) p1[r] = fmaf(p1[r], C, mnC);
  for (int r = 0; r < 16; ++r) p0[r] = __builtin_amdgcn_exp2f(p0[r]);
}
__device__ __forceinline__ void finishSM(f32x16& p0, f32x16& p1, float alpha, float& l_reg, bf16x8& pa0, bf16x8& pa1, bf16x8& pa2, bf16x8& pa3) {
  for (int r = 0; r < 16; ++r) p1[r] = __builtin_amdgcn_exp2f(p1[r]);
  float ps = 0; for (int r = 0; r < 16; ++r) ps += p0[r]; for (int r = 0; r < 16; ++r) ps += p1[r];
  { auto rr = __builtin_amdgcn_permlane32_swap(__float_as_uint(ps), __float_as_uint(ps), false, false);
    ps = __uint_as_float(rr[0]) + __uint_as_float(rr[1]); }
  l_reg = l_reg * alpha + ps;
#define PK4(P, BASE, OUT) do { unsigned a0 = cvtpk(P[BASE + 0], P[BASE + 1]), a1 = cvtpk(P[BASE + 2], P[BASE + 3]);   \
    unsigned b0 = cvtpk(P[BASE + 4], P[BASE + 5]), b1 = cvtpk(P[BASE + 6], P[BASE + 7]);                              \
    auto r0 = __builtin_amdgcn_permlane32_swap(a0, b0, false, false); auto r1 = __builtin_amdgcn_permlane32_swap(a1, b1, false, false); \
    u32x4 w = {r0[0], r1[0], r0[1], r1[1]}; OUT = *reinterpret_cast<bf16x8*>(&w); } while (0)
  PK4(p0, 0, pa0); PK4(p0, 8, pa1); PK4(p1, 0, pa2); PK4(p1, 8, pa3);
#undef PK4
}
__device__ __forceinline__ void qkt(f32x16& p0, f32x16& p1, const bf16* Ks, const bf16x8* qr, int r32, int hi) {
  p0 = f32x16{}; p1 = f32x16{};
  bf16x8 nb0 = *reinterpret_cast<const bf16x8*>((const char*)Ks + KSWZ(r32, (hi * 8) * 2)), nb1 = *reinterpret_cast<const bf16x8*>((const char*)Ks + KSWZ(32 + r32, (hi * 8) * 2));
#pragma unroll
  for (int d0 = 0; d0 < 8; ++d0) { const bf16x8 b0 = nb0, b1 = nb1;
    if (d0 < 7) { const int cb = ((d0 + 1) * 16 + hi * 8) * 2;
      nb0 = *reinterpret_cast<const bf16x8*>((const char*)Ks + KSWZ(r32, cb)); nb1 = *reinterpret_cast<const bf16x8*>((const char*)Ks + KSWZ(32 + r32, cb)); }
    p0 = __builtin_amdgcn_mfma_f32_32x32x16_bf16(b0, qr[d0], p0, 0, 0, 0);
    p1 = __builtin_amdgcn_mfma_f32_32x32x16_bf16(b1, qr[d0], p1, 0, 0, 0); }
}
__device__ __forceinline__ int v_st(int k, int c) { const int kk = (k & ~0xC) | ((k & 4) << 1) | ((k & 8) >> 1); return ((kk >> 3) * 4 + (c >> 5)) * 512 + ((kk & 7) * 32 + (c & 31)) * 2; }
__device__ __forceinline__ int v_rd_base(int lane) { return ((lane & 3) << 3) | (((lane >> 2) & 3) << 6) | (((lane >> 4) & 1) << 5) | (((lane >> 5) & 1) << 8); }
constexpr int v_rd_off(int d0, int ks, int half) { return d0 * 512 + ks * 4096 + half * 2048; }
template <int OFF> __device__ __forceinline__ s16x4 tr_read(int vb) {
  s16x4 r; asm volatile("ds_read_b64_tr_b16 %0, %1 offset:%2" : "=&v"(r) : "v"(vb), "i"(OFF) : "memory"); return r;
}
template <int D0> __device__ __forceinline__ void pv_one(f32x16& od, int vb, bf16x8 pa0, bf16x8 pa1, bf16x8 pa2, bf16x8 pa3) {
  const s16x4 l0 = tr_read<v_rd_off(D0, 0, 0)>(vb), h0 = tr_read<v_rd_off(D0, 0, 1)>(vb), l1 = tr_read<v_rd_off(D0, 1, 0)>(vb), h1 = tr_read<v_rd_off(D0, 1, 1)>(vb);
  const s16x4 l2 = tr_read<v_rd_off(D0, 2, 0)>(vb), h2 = tr_read<v_rd_off(D0, 2, 1)>(vb), l3 = tr_read<v_rd_off(D0, 3, 0)>(vb), h3 = tr_read<v_rd_off(D0, 3, 1)>(vb);
  asm volatile("s_waitcnt lgkmcnt(0)" ::: "memory"); SBAR();
#define PK(L, H) (bf16x8){L[0], L[1], L[2], L[3], H[0], H[1], H[2], H[3]}
  od = __builtin_amdgcn_mfma_f32_32x32x16_bf16(pa0, PK(l0, h0), od, 0, 0, 0);
  od = __builtin_amdgcn_mfma_f32_32x32x16_bf16(pa1, PK(l1, h1), od, 0, 0, 0);
  od = __builtin_amdgcn_mfma_f32_32x32x16_bf16(pa2, PK(l2, h2), od, 0, 0, 0);
  od = __builtin_amdgcn_mfma_f32_32x32x16_bf16(pa3, PK(l3, h3), od, 0, 0, 0);
#undef PK
}
__device__ __forceinline__ void pv_d0(f32x16* o, int vb, bf16x8 pa0, bf16x8 pa1, bf16x8 pa2, bf16x8 pa3) {
  pv_one<0>(o[0], vb, pa0, pa1, pa2, pa3); pv_one<1>(o[1], vb, pa0, pa1, pa2, pa3); pv_one<2>(o[2], vb, pa0, pa1, pa2, pa3); pv_one<3>(o[3], vb, pa0, pa1, pa2, pa3);
}

template <typename TQ>
__device__ __forceinline__ void attn_dense_body(const TQ* __restrict__ Qb, const bf16* __restrict__ Kh, const bf16* __restrict__ Vh,
                                                bf16* __restrict__ Ob, int seq, char* lds) {
  using St = Stage<bf16>; using SQ = Stage<TQ>;
  int tid_o = wg_tid(); asm volatile("" : "+v"(tid_o)); const int tid = tid_o, wid = __builtin_amdgcn_readfirstlane(tid >> 6), lane = tid & 63, r32 = lane & 31, hi = lane >> 5;
  bf16* V_lds = (bf16*)lds; bf16* K_lds = (bf16*)(lds + 3 * SHM_V);
  float* ws = (float*)(lds + 3 * SHM_V + 3 * SHM_K) + wid * 64; float* li_l = ws; float* al_l = ws + 32;
  float m_reg = -1e30f, l_reg = 0; f32x16 o[4] = {}; bf16x8 qr[8];
  const TQ* Qw = Qb + (long)(wid * QBLK + r32) * LDQ + hi * 8;
#pragma unroll
  for (int d0 = 0; d0 < 8; ++d0) qr[d0] = SQ::tobf(SQ::ld8(Qw + d0 * 16));
  const int sr = tid >> 4, sc = (tid & 15) * 8, vst0 = v_st(sr, sc), vst1 = v_st(32 + sr, sc);
  const int vb0 = (int)(uintptr_t)V_lds + v_rd_base(lane);
  struct { typename St::T vs0, vs1, ks0, ks1; } sr_[SDEPTH];
#define SLOAD(i, k0) do { sr_[i].vs0 = St::ld8(&Vh[(long)((k0) + sr) * LDK + sc]); sr_[i].vs1 = St::ld8(&Vh[(long)((k0) + 32 + sr) * LDK + sc]); \
    sr_[i].ks0 = St::ld8(&Kh[(long)((k0) + sr) * LDK + sc]); sr_[i].ks1 = St::ld8(&Kh[(long)((k0) + 32 + sr) * LDK + sc]); } while (0)
#define SWRITE(b, i) do { *(bf16x8*)((char*)V_lds + (b) * SHM_V + vst0) = St::tobf(sr_[i].vs0);          \
    *(bf16x8*)((char*)V_lds + (b) * SHM_V + vst1) = St::tobf(sr_[i].vs1); int kc = sc * 2;               \
    *(bf16x8*)((char*)K_lds + (b) * SHM_K + KSWZ(sr, kc)) = St::tobf(sr_[i].ks0);                       \
    *(bf16x8*)((char*)K_lds + (b) * SHM_K + KSWZ(32 + sr, kc)) = St::tobf(sr_[i].ks1); } while (0)
#define SWAIT() do { if constexpr (SDEPTH == 2) asm volatile("s_waitcnt vmcnt(4)" ::: "memory"); else asm volatile("s_waitcnt vmcnt(0)" ::: "memory"); } while (0)
#define RESC(a) do { if (__any((a) < 1.f)) { if (hi == 0) al_l[r32] = (a); asm volatile("s_waitcnt lgkmcnt(0)" ::: "memory"); \
    for (int d = 0; d < 4; ++d) for (int r = 0; r < 16; ++r) o[d][r] *= al_l[crow(r, hi)]; } } while (0)
  f32x16 pA0, pA1, pB0, pB1; float mnA, mnB, alA, alB; bf16x8 pa0, pa1, pa2, pa3; const int NT = seq / KVBLK;
  constexpr int SE = 0, SO = SDEPTH - 1;
  SLOAD(SE, 0); asm volatile("s_waitcnt vmcnt(0)" ::: "memory"); SWRITE(0, SE); __syncthreads();
  qkt(pA0, pA1, K_lds, qr, r32, hi); partialSM(pA0, pA1, m_reg, mnA, alA);
  SLOAD(SO, KVBLK); if constexpr (SDEPTH == 2) { if (2 < NT) SLOAD(SE, 2 * KVBLK); }
  SWAIT(); SWRITE(1, SO); __syncthreads();
  int bk = 1, bv = 0, bw = 2;
  if (wid >= 4) __builtin_amdgcn_s_setprio(1);
#define ROT3() do { const int t_ = bv; bv = bk; bk = bw; bw = t_; } while (0)
  for (int j = 1; j + 1 < NT; j += 2) {
    SBAR(); qkt(pB0, pB1, (bf16*)((char*)K_lds + bk * SHM_K), qr, r32, hi);
    finishSM(pA0, pA1, alA, l_reg, pa0, pa1, pa2, pa3); SBAR();
    SLOAD(SO, (j + SDEPTH) * KVBLK); SBAR();
    pv_d0(o, vb0 + bv * (int)SHM_V, pa0, pa1, pa2, pa3); partialSM(pB0, pB1, m_reg, mnB, alB);
    SWAIT(); SWRITE(bw, SE);
    RESC(alB); __syncthreads(); ROT3();
    SBAR(); qkt(pA0, pA1, (bf16*)((char*)K_lds + bk * SHM_K), qr, r32, hi);
    finishSM(pB0, pB1, alB, l_reg, pa0, pa1, pa2, pa3); SBAR();
    if (SDEPTH == 1 || j + 3 < NT) SLOAD(SE, (j + 1 + SDEPTH) * KVBLK); SBAR();
    pv_d0(o, vb0 + bv * (int)SHM_V, pa0, pa1, pa2, pa3); partialSM(pA0, pA1, m_reg, mnA, alA);
    SWAIT(); SWRITE(bw, SO);
    RESC(alA); __syncthreads(); ROT3();
  }
  SBAR(); qkt(pB0, pB1, (bf16*)((char*)K_lds + bk * SHM_K), qr, r32, hi);
  finishSM(pA0, pA1, alA, l_reg, pa0, pa1, pa2, pa3); SBAR();
  pv_d0(o, vb0 + bv * (int)SHM_V, pa0, pa1, pa2, pa3); partialSM(pB0, pB1, m_reg, mnB, alB);
  RESC(alB);
  finishSM(pB0, pB1, alB, l_reg, pa0, pa1, pa2, pa3); SBAR();
  pv_d0(o, vb0 + bk * (int)SHM_V, pa0, pa1, pa2, pa3);
#undef ROT3
  __builtin_amdgcn_s_setprio(0);
  if (hi == 0) li_l[r32] = l_reg; asm volatile("s_waitcnt lgkmcnt(0)" ::: "memory");
  float rli[16];
#pragma unroll
  for (int r = 0; r < 16; ++r) rli[r] = __builtin_amdgcn_rcpf(li_l[crow(r, hi)]);
  bf16* Ow = Ob + (long)(wid * QBLK) * LDO;
#pragma unroll
  for (int r = 0; r < 16; ++r) { int orow = crow(r, hi);
    for (int d0 = 0; d0 < 4; ++d0) Ow[(long)orow * LDO + d0 * 32 + r32] = (bf16)(cvtpk(o[d0][r] * rli[r], 0.f) & 0xffffu); }
#undef SLOAD
#undef SWRITE
#undef SWAIT
#undef RESC
}

constexpr int NA_LD = 4096, NA_TILES = 12;
__device__ __forceinline__ void na_block_body(const bf16* __restrict__ Qb, const bf16* __restrict__ Kh, const bf16* __restrict__ Vh, bf16* __restrict__ Ob,
                                              const float* __restrict__ rpb_h, const float* __restrict__ qgain, const float* __restrict__ kgain, int R, int ks, char* lds) {
  using St = Stage<bf16>;
  int tid_o = wg_tid(); asm volatile("" : "+v"(tid_o)); const int tid = tid_o, wid = __builtin_amdgcn_readfirstlane(tid >> 6), lane = tid & 63, r32 = lane & 31, hi = lane >> 5;
  bf16* V_lds = (bf16*)lds; bf16* K_lds = (bf16*)(lds + 2 * SHM_V);
  float* ws = (float*)(lds + 2 * SHM_V + 2 * SHM_K) + wid * 64; float* li_l = ws; float* al_l = ws + 32;
  float* bt = (float*)(lds + 2 * SHM_V + 2 * SHM_K + NW * 64 * 4);
  float m_reg = -1e30f, l_reg = 0; f32x16 o[4] = {}; bf16x8 qr[8];
  const bf16* Qw = Qb + (long)(wid * QBLK + r32) * NA_LD + hi * 8;
#pragma unroll
  for (int d0 = 0; d0 < 8; ++d0) qr[d0] = St::ld8(Qw + d0 * 16);
  {
    float ss = 0.f;
#pragma unroll
    for (int d0 = 0; d0 < 8; ++d0) { const u32x4 w = __builtin_bit_cast(u32x4, qr[d0]);
#pragma unroll
      for (int e = 0; e < 4; ++e) { const float a = __uint_as_float(w[e] << 16), b = __uint_as_float(w[e] & 0xffff0000u); ss += a * a + b * b; } }
    ss += __shfl_xor(ss, 32);
    const float rinv = __builtin_amdgcn_rsqf(ss * (1.0f / 128.0f) + 1e-6f);
#pragma unroll
    for (int d0 = 0; d0 < 8; ++d0) { const u32x4 w = __builtin_bit_cast(u32x4, qr[d0]); const float* gp = qgain + d0 * 16 + hi * 8;
      const f32x8 g = *reinterpret_cast<const f32x8*>(gp); u32x4 o;
#pragma unroll
      for (int e = 0; e < 4; ++e) o[e] = cvtpk(__uint_as_float(w[e] << 16) * rinv * g[2 * e], __uint_as_float(w[e] & 0xffff0000u) * rinv * g[2 * e + 1]);
      qr[d0] = __builtin_bit_cast(bf16x8, o); } }
  const f32x8 kg = *reinterpret_cast<const f32x8*>(kgain + (tid & 15) * 8);
  for (int i = tid; i < 15 * 31; i += 64 * NW) bt[i] = rpb_h[i];
  const int sr = tid >> 4, sc = (tid & 15) * 8, vst0 = v_st(sr, sc), vst1 = v_st(32 + sr, sc);
  const int vb0 = (int)(uintptr_t)V_lds + v_rd_base(lane);
  bf16x8 s_vs0, s_vs1, s_ks0, s_ks1;
#define NLOAD(k0) do { s_vs0 = St::ld8(&Vh[(long)((k0) + sr) * NA_LD + sc]); s_vs1 = St::ld8(&Vh[(long)((k0) + 32 + sr) * NA_LD + sc]); \
    s_ks0 = St::ld8(&Kh[(long)((k0) + sr) * NA_LD + sc]); s_ks1 = St::ld8(&Kh[(long)((k0) + 32 + sr) * NA_LD + sc]); } while (0)
#define KNORM(x) do { const u32x4 w_ = __builtin_bit_cast(u32x4, x); float a_[8]; float ss_ = 0.f; \
    _Pragma("unroll") for (int e = 0; e < 4; ++e) { a_[2 * e] = __uint_as_float(w_[e] << 16); a_[2 * e + 1] = __uint_as_float(w_[e] & 0xffff0000u); ss_ += a_[2 * e] * a_[2 * e] + a_[2 * e + 1] * a_[2 * e + 1]; } \
    ss_ += __shfl_xor(ss_, 1); ss_ += __shfl_xor(ss_, 2); ss_ += __shfl_xor(ss_, 4); ss_ += __shfl_xor(ss_, 8); \
    const float ri_ = __builtin_amdgcn_rsqf(ss_ * (1.0f / 128.0f) + 1e-6f); u32x4 o_; \
    _Pragma("unroll") for (int e = 0; e < 4; ++e) o_[e] = cvtpk(a_[2 * e] * ri_ * kg[2 * e], a_[2 * e + 1] * ri_ * kg[2 * e + 1]); \
    x = __builtin_bit_cast(bf16x8, o_); } while (0)
#define NWRITE(b) do { KNORM(s_ks0); KNORM(s_ks1); \
    *(bf16x8*)((char*)V_lds + (b) * SHM_V + vst0) = s_vs0; *(bf16x8*)((char*)V_lds + (b) * SHM_V + vst1) = s_vs1; const int kc_ = sc * 2; \
    *(bf16x8*)((char*)K_lds + (b) * SHM_K + KSWZ(sr, kc_)) = s_ks0; *(bf16x8*)((char*)K_lds + (b) * SHM_K + KSWZ(32 + sr, kc_)) = s_ks1; } while (0)
  const int qrow = R + (wid >> 1), r0q = min(max(qrow - 4, 0), 248), jlo = r0q - ks;
  const int c = 32 * (wid & 1) + r32, c0 = min(max(c - 8, 0), 48);
  NLOAD(0); asm volatile("s_waitcnt vmcnt(0)" ::: "memory"); NWRITE(0); __syncthreads();
  for (int j = 0; j < NA_TILES; ++j) {
    const int buf = j & 1;
    if (j + 1 < NA_TILES) NLOAD((j + 1) * KVBLK);
    if (j >= jlo && j < jlo + 8) {
      f32x16 p0, p1; float mn, al; bf16x8 pa0, pa1, pa2, pa3;
      SBAR(); qkt(p0, p1, (bf16*)((char*)K_lds + buf * SHM_K), qr, r32, hi);
      const float* brow = bt + (ks + j - qrow + 7) * 31 + (15 - c);
#pragma unroll
      for (int r = 0; r < 16; ++r) { const int k0 = crow(r, hi), k1 = 32 + k0; const bool v0 = (k0 >= c0) && (k0 < c0 + 16), v1 = (k1 >= c0) && (k1 < c0 + 16);
        const float b0 = brow[v0 ? k0 : c], b1 = brow[v1 ? k1 : c];
        p0[r] = v0 ? fmaf(b0, 1.0f / SCALE, p0[r]) : -1e30f; p1[r] = v1 ? fmaf(b1, 1.0f / SCALE, p1[r]) : -1e30f; }
      partialSM(p0, p1, m_reg, mn, al);
      if (__any(al < 1.f)) { if (hi == 0) al_l[r32] = al; asm volatile("s_waitcnt lgkmcnt(0)" ::: "memory");
#pragma unroll
        for (int d = 0; d < 4; ++d)
#pragma unroll
          for (int r = 0; r < 16; ++r) o[d][r] *= al_l[crow(r, hi)]; }
      finishSM(p0, p1, al, l_reg, pa0, pa1, pa2, pa3); SBAR();
      pv_d0(o, vb0 + buf * (int)SHM_V, pa0, pa1, pa2, pa3);
    }
    if (j + 1 < NA_TILES) { asm volatile("s_waitcnt vmcnt(0)" ::: "memory"); NWRITE(buf ^ 1); }
    __syncthreads();
  }
  if (hi == 0) li_l[r32] = l_reg; asm volatile("s_waitcnt lgkmcnt(0)" ::: "memory");
  float rli[16];
#pragma unroll
  for (int r = 0; r < 16; ++r) rli[r] = 64.0f * __builtin_amdgcn_rcpf(li_l[crow(r, hi)]);
  unsigned char* Ow = (unsigned char*)Ob + (long)(wid * QBLK) * NA_LD;
#pragma unroll
  for (int r = 0; r < 16; ++r) { const int orow = crow(r, hi);
    for (int d0 = 0; d0 < 4; ++d0) Ow[(long)orow * NA_LD + d0 * 32 + r32] = (unsigned char)__builtin_amdgcn_cvt_pk_fp8_f32(o[d0][r] * rli[r], 0.f, 0, false); }
#undef NLOAD
#undef NWRITE
#undef KNORM
}

typedef int v8i __attribute__((ext_vector_type(8)));
#ifndef SGB_VARIANT
#if defined(PROBE_PH) && PROBE_PH >= 310 && PROBE_PH < 320
#define SGB_VARIANT (PROBE_PH - 310)
#else
#define SGB_VARIANT 3
#endif
#endif
typedef unsigned u32x2 __attribute__((ext_vector_type(2)));
constexpr int K8_LD = 1024, V8_LD = 16384, SHM_K8 = KVBLK * D, SHM_V8 = KVBLK * D;
constexpr float THR8 = 3.0f;
__device__ __forceinline__ int cvt4_fp8(float a, float b, float c, float d) { int w = __builtin_amdgcn_cvt_pk_fp8_f32(a, b, 0, false); return __builtin_amdgcn_cvt_pk_fp8_f32(c, d, w, true); }
typedef short s16x2 __attribute__((ext_vector_type(2)));
__device__ __forceinline__ int cvt4_fp8_scl(int w, float a, float b, float c, float d, float scl) {
  s16x2 t = __builtin_bit_cast(s16x2, w); t = __builtin_amdgcn_cvt_scalef32_pk_fp8_f32(t, a, b, scl, false); t = __builtin_amdgcn_cvt_scalef32_pk_fp8_f32(t, c, d, scl, true); return __builtin_bit_cast(int, t); }
__device__ __forceinline__ v8i mk8(u32x4 lo, u32x4 hi) { return (v8i){(int)lo[0], (int)lo[1], (int)lo[2], (int)lo[3], (int)hi[0], (int)hi[1], (int)hi[2], (int)hi[3]}; }
__device__ __forceinline__ void qkt8(f32x16& p0, f32x16& p1, const char* Ks, const v8i* qf, int r32, int hi) {
  const int x0 = (r32 >> 1) & 7, x1 = ((32 + r32) >> 1) & 7;
  const char* k0 = Ks + r32 * 128; const char* k1 = Ks + (32 + r32) * 128;
  v8i a[2][2];
#pragma unroll
  for (int s = 0; s < 2; ++s) { const int c = 4 * s + 2 * hi;
    a[0][s] = mk8(*reinterpret_cast<const u32x4*>(k0 + 16 * (c ^ x0)), *reinterpret_cast<const u32x4*>(k0 + 16 * ((c + 1) ^ x0)));
    a[1][s] = mk8(*reinterpret_cast<const u32x4*>(k1 + 16 * (c ^ x1)), *reinterpret_cast<const u32x4*>(k1 + 16 * ((c + 1) ^ x1))); }
  p0 = f32x16{}; p1 = f32x16{};
#pragma unroll
  for (int s = 0; s < 2; ++s) {
    p0 = __builtin_amdgcn_mfma_scale_f32_32x32x64_f8f6f4(a[0][s], qf[s], p0, 0, 0, 0, 0x7F7F7F7F, 0, 0x7C7C7C7C);
    p1 = __builtin_amdgcn_mfma_scale_f32_32x32x64_f8f6f4(a[1][s], qf[s], p1, 0, 0, 0, 0x7F7F7F7F, 0, 0x7C7C7C7C); }
}
constexpr float THR2 = 4.0f;
__device__ __forceinline__ void partialSM8(f32x16& p0, f32x16& p1, float& m_reg, float& scl, float& alpha) {
  float pmax;
  asm("v_max3_f32 %0, %1, %2, %3\n\tv_max3_f32 %0, %0, %4, %5\n\tv_max3_f32 %0, %0, %6, %7\n\tv_max3_f32 %0, %0, %8, %9\n\tv_max3_f32 %0, %0, %10, %11\n\tv_max3_f32 %0, %0, %12, %13\n\tv_max3_f32 %0, %0, %14, %15\n\tv_max_f32 %0, %0, %16"
      : "=&v"(pmax) : "v"(p0[0]), "v"(p0[1]), "v"(p0[2]), "v"(p0[3]), "v"(p0[4]), "v"(p0[5]), "v"(p0[6]), "v"(p0[7]), "v"(p0[8]), "v"(p0[9]), "v"(p0[10]), "v"(p0[11]), "v"(p0[12]), "v"(p0[13]), "v"(p0[14]), "v"(p0[15]));
  asm("v_max3_f32 %0, %0, %1, %2\n\tv_max3_f32 %0, %0, %3, %4\n\tv_max3_f32 %0, %0, %5, %6\n\tv_max3_f32 %0, %0, %7, %8\n\tv_max3_f32 %0, %0, %9, %10\n\tv_max3_f32 %0, %0, %11, %12\n\tv_max3_f32 %0, %0, %13, %14\n\tv_max3_f32 %0, %0, %15, %16"
      : "+v"(pmax) : "v"(p1[0]), "v"(p1[1]), "v"(p1[2]), "v"(p1[3]), "v"(p1[4]), "v"(p1[5]), "v"(p1[6]), "v"(p1[7]), "v"(p1[8]), "v"(p1[9]), "v"(p1[10]), "v"(p1[11]), "v"(p1[12]), "v"(p1[13]), "v"(p1[14]), "v"(p1[15]));
  { auto rr = __builtin_amdgcn_permlane32_swap(__float_as_uint(pmax), __float_as_uint(pmax), false, false);
    pmax = fmaxf(__uint_as_float(rr[0]), __uint_as_float(rr[1])); }
  if (__builtin_expect(__all(pmax - m_reg <= THR2), 1)) { alpha = 1.f; }
  else { const float mn = __builtin_ceilf(fmaxf(m_reg, pmax)); alpha = __builtin_amdgcn_exp2f(m_reg - mn); m_reg = mn; }
  scl = __builtin_amdgcn_ldexpf(1.0f, (int)fmaxf(m_reg, -100.f) - 4);
  for (int r = 0; r < 16; ++r) p0[r] = __builtin_amdgcn_exp2f(p0[r]);
}
__device__ __forceinline__ void finishSM8(f32x16& p0, f32x16& p1, v8i& pa, float scl) {
  for (int r = 0; r < 16; ++r) p1[r] = __builtin_amdgcn_exp2f(p1[r]);
#pragma unroll
  for (int v = 0; v < 4; ++v) { pa[v] = cvt4_fp8_scl(pa[v], p0[4 * v], p0[4 * v + 1], p0[4 * v + 2], p0[4 * v + 3], scl); pa[4 + v] = cvt4_fp8_scl(pa[4 + v], p1[4 * v], p1[4 * v + 1], p1[4 * v + 2], p1[4 * v + 3], scl); }
}
__device__ __forceinline__ void pv8(f32x16* o, const char* Vs, const v8i& pa, int r32, int hi) {
  v8i b[4];
#pragma unroll
  for (int db = 0; db < 4; ++db) { const int d = 32 * db + r32, x = (d >> 2) & 3; const char* vp = Vs + d * 64;
    b[db] = mk8(*reinterpret_cast<const u32x4*>(vp + 16 * ((2 * hi) ^ x)), *reinterpret_cast<const u32x4*>(vp + 16 * ((2 * hi + 1) ^ x))); }
  const v8i ones = (v8i){0x22222222, 0x22222222, 0x22222222, 0x22222222, 0, 0, 0, 0};
#pragma unroll
  for (int db = 0; db < 4; ++db) o[db] = __builtin_amdgcn_mfma_scale_f32_32x32x64_f8f6f4(pa, b[db], o[db], 0, 0, 0, 0x7F7F7F7F, 0, 0x7F7F7F7F);
  o[4] = __builtin_amdgcn_mfma_scale_f32_32x32x64_f8f6f4(pa, ones, o[4], 0, 4, 0, 0x7F7F7F7F, 0, 0x7F7F7F7F);
}
__device__ __forceinline__ void attn_dense_body8(const bf16* __restrict__ Qb, const unsigned char* __restrict__ K8h, const unsigned char* __restrict__ V8h, bf16* __restrict__ Ob, int seq, char* lds) {
  int tid_o = wg_tid(); asm volatile("" : "+v"(tid_o)); const int tid = tid_o, wid = __builtin_amdgcn_readfirstlane(tid >> 6), lane = tid & 63, r32 = lane & 31, hi = lane >> 5;
  char* V_lds = lds; char* K_lds = lds + 4 * SHM_V8;
  float* ws = (float*)(lds + 4 * SHM_V8 + 4 * SHM_K8) + wid * 64; float* al_l = ws + 32;
  float m_reg = -1e30f; f32x16 o[5] = {}; v8i qf[2];
  { const bf16* Qw = Qb + (long)(wid * QBLK + r32) * LDQ + hi * 32;
#pragma unroll
    for (int s = 0; s < 2; ++s) {
#pragma unroll
      for (int c = 0; c < 4; ++c) { const u32x4 w = *reinterpret_cast<const u32x4*>(Qw + s * 64 + c * 8);
        constexpr float QS = 8.0f * SCALE * 1.4426950408889634f;
        qf[s][2 * c] = cvt4_fp8(QS * __uint_as_float(w[0] << 16), QS * __uint_as_float(w[0] & 0xffff0000u), QS * __uint_as_float(w[1] << 16), QS * __uint_as_float(w[1] & 0xffff0000u));
        qf[s][2 * c + 1] = cvt4_fp8(QS * __uint_as_float(w[2] << 16), QS * __uint_as_float(w[2] & 0xffff0000u), QS * __uint_as_float(w[3] << 16), QS * __uint_as_float(w[3] & 0xffff0000u)); } } }
  const int skey = tid >> 3, sck = tid & 7, sd = tid >> 2, sc4 = tid & 3;
  const int kst = skey * 128 + 16 * (sck ^ ((skey >> 1) & 7));
  const int vx = (sd >> 2) & 3, vst0 = sd * 64 + 16 * ((sc4 >> 1) ^ vx) + 8 * (sc4 & 1), vst1 = sd * 64 + 16 * ((2 + (sc4 >> 1)) ^ vx) + 8 * (sc4 & 1);
  const unsigned char* kg = K8h + (long)skey * K8_LD + 16 * sck; const unsigned char* vg = V8h + (long)sd * V8_LD + 16 * sc4;
  struct { u32x4 k, v; } sr_[2];
#define SLOAD8(i, k0) do { sr_[i].k = *reinterpret_cast<const u32x4*>(kg + (long)(k0) * K8_LD); sr_[i].v = *reinterpret_cast<const u32x4*>(vg + (k0)); } while (0)
#define SWRITE8(b, i) do { *reinterpret_cast<u32x4*>(K_lds + (b) * SHM_K8 + kst) = sr_[i].k; \
    *reinterpret_cast<u32x2*>(V_lds + (b) * SHM_V8 + vst0) = (u32x2){sr_[i].v[0], sr_[i].v[2]}; *reinterpret_cast<u32x2*>(V_lds + (b) * SHM_V8 + vst1) = (u32x2){sr_[i].v[1], sr_[i].v[3]}; } while (0)
#define SWAIT8() asm volatile("s_waitcnt vmcnt(2)" ::: "memory")
#define RESC8(a) do { if (__any((a) < 1.f)) { if (hi == 0) al_l[r32] = (a); asm volatile("s_waitcnt lgkmcnt(0)" ::: "memory"); \
    for (int d = 0; d < 5; ++d) for (int r = 0; r < 16; ++r) o[d][r] *= al_l[crow(r, hi)]; } } while (0)
  f32x16 pA0, pA1, pB0, pB1; float mnA, mnB, alA, alB; v8i pa = {}; const int NT = seq / KVBLK;
  SLOAD8(0, 0); asm volatile("s_waitcnt vmcnt(0)" ::: "memory"); SWRITE8(0, 0); __syncthreads();
  qkt8(pA0, pA1, K_lds, qf, r32, hi);
  asm volatile("s_nop 15\n\ts_nop 7" : "+v"(pA0), "+v"(pA1));
  partialSM8(pA0, pA1, m_reg, mnA, alA);
  SLOAD8(1, KVBLK); if (2 < NT) SLOAD8(0, 2 * KVBLK);
  SWAIT8(); SWRITE8(1, 1); __syncthreads();
  if (wid >= 4) __builtin_amdgcn_s_setprio(1);
#define SGB(mask, n) __builtin_amdgcn_sched_group_barrier(mask, n, 0)
#if SGB_VARIANT == 1
#define SGB_QK() do { SGB(0x008, 1); SGB(0x400, 4); SGB(0x002, 4); SGB(0x008, 1); SGB(0x400, 4); SGB(0x002, 4); SGB(0x008, 1); SGB(0x400, 4); SGB(0x002, 4); SGB(0x008, 1); SGB(0x400, 4); SGB(0x002, 4); } while (0)
#define SGB_PV() do { SGB(0x008, 1); SGB(0x400, 4); SGB(0x008, 1); SGB(0x400, 4); SGB(0x008, 1); SGB(0x400, 4); SGB(0x008, 1); SGB(0x400, 4); SGB(0x008, 1); } while (0)
#elif SGB_VARIANT == 2
#define SGB_QK() do {} while (0)
#define SGB_PV() do { SGB(0x008, 1); SGB(0x400, 4); SGB(0x008, 1); SGB(0x400, 4); SGB(0x008, 1); SGB(0x400, 4); SGB(0x008, 1); SGB(0x400, 4); SGB(0x008, 1); } while (0)
#elif SGB_VARIANT == 3
#define SGB_QK() do { SGB(0x008, 1); SGB(0x400, 4); SGB(0x002, 4); SGB(0x008, 1); SGB(0x400, 4); SGB(0x002, 4); SGB(0x008, 1); SGB(0x400, 4); SGB(0x002, 4); SGB(0x008, 1); SGB(0x400, 4); SGB(0x002, 4); } while (0)
#define SGB_PV() do {} while (0)
#elif SGB_VARIANT == 4
#define SGB_QK() do { SGB(0x008, 1); SGB(0x400, 6); SGB(0x008, 1); SGB(0x400, 6); SGB(0x002, 2); SGB(0x008, 1); SGB(0x400, 4); SGB(0x002, 6); SGB(0x008, 1); SGB(0x002, 8); } while (0)
#define SGB_PV() do {} while (0)
#else
#define SGB_QK() do {} while (0)
#define SGB_PV() do {} while (0)
#endif
#define HALF8(X0, X1, mnX, alX, Y0, Y1, mnY, TILE, BK, BV, BW, SL, SW, DOLOAD) do { \
    SBAR(); qkt8(X0, X1, K_lds + (BK) * SHM_K8, qf, r32, hi); \
    finishSM8(Y0, Y1, pa, mnY); SGB_QK(); SBAR(); \
    if (DOLOAD) SLOAD8(SL, ((TILE) + 2) * KVBLK); SBAR(); \
    pv8(o, V_lds + (BV) * SHM_V8, pa, r32, hi); partialSM8(X0, X1, m_reg, mnX, alX); SGB_PV(); \
    SWAIT8(); SWRITE8(BW, SW); \
    RESC8(alX); __syncthreads(); } while (0)
  int j = 1;
  for (; j + 4 < NT; j += 4) {
    HALF8(pB0, pB1, mnB, alB, pA0, pA1, mnA, j,     1, 0, 2, 1, 0, true);
    HALF8(pA0, pA1, mnA, alA, pB0, pB1, mnB, j + 1, 2, 1, 3, 0, 1, true);
    HALF8(pB0, pB1, mnB, alB, pA0, pA1, mnA, j + 2, 3, 2, 0, 1, 0, true);
    HALF8(pA0, pA1, mnA, alA, pB0, pB1, mnB, j + 3, 0, 3, 1, 0, 1, true);
  }
  HALF8(pB0, pB1, mnB, alB, pA0, pA1, mnA, j,     1, 0, 2, 1, 0, true);
  HALF8(pA0, pA1, mnA, alA, pB0, pB1, mnB, j + 1, 2, 1, 3, 0, 1, false);
  SBAR(); qkt8(pB0, pB1, K_lds + 3 * SHM_K8, qf, r32, hi);
  finishSM8(pA0, pA1, pa, mnA); SBAR();
  pv8(o, V_lds + 2 * SHM_V8, pa, r32, hi); partialSM8(pB0, pB1, m_reg, mnB, alB);
  RESC8(alB);
  finishSM8(pB0, pB1, pa, mnB); SBAR();
  pv8(o, V_lds + 3 * SHM_V8, pa, r32, hi);
#undef HALF8
  __builtin_amdgcn_s_setprio(0);
  float rli[16];
#pragma unroll
  for (int r = 0; r < 16; ++r) rli[r] = 64.0f * __builtin_amdgcn_rcpf(o[4][r]);
  unsigned char* Ow = (unsigned char*)Ob + (long)(wid * QBLK) * LDO;
#pragma unroll
  for (int r = 0; r < 16; ++r) { const int orow = crow(r, hi);
    for (int d0 = 0; d0 < 4; ++d0) Ow[(long)orow * LDO + d0 * 32 + r32] = (unsigned char)__builtin_amdgcn_cvt_pk_fp8_f32(o[d0][r] * rli[r], 0.f, 0, false); }
#undef SLOAD8
#undef SWRITE8
#undef SWAIT8
#undef RESC8
}
}
struct Frame {
    LAS unsigned char* lds;
    int tid, lane, wave;
    int bid, vcu, G;
};
__device__ __forceinline__ float wave_sum(float v) {
#pragma unroll
    for (int o = 1; o < 64; o <<= 1) v += __shfl_xor(v, o);
    return v;
}
__device__ __forceinline__ void xrows_phase(const Frame& F, const float* __restrict__ h, bf16* __restrict__ hb, pg8::rs_t* __restrict__ rs, unsigned char* __restrict__ hb8) {
    const int gw = F.vcu * 8 + F.wave, NGW = F.G * 8;
    for (int m = gw; m < L; m += NGW) {
        const f32x4* xr = (const f32x4*)(h + (size_t)m * DM) + F.lane;
        v2u* o8 = (v2u*)(hb + (size_t)m * DM) + F.lane;
        float s = 0.f;
#pragma unroll
        for (int j = 0; j < 16; ++j) { const f32x4 v = xr[64 * j]; s += (v.x * v.x + v.y * v.y) + (v.z * v.z + v.w * v.w); v2u w; w.x = pk2(v.x, v.y); w.y = pk2(v.z, v.w); o8[64 * j] = w;
            int w8 = __builtin_amdgcn_cvt_pk_fp8_f32(v.x, v.y, 0, false); w8 = __builtin_amdgcn_cvt_pk_fp8_f32(v.z, v.w, w8, true); *((unsigned*)(hb8 + (size_t)m * DM) + 64 * j + F.lane) = (unsigned)w8; }
        s = wave_sum(s);
        if (F.lane == 0) rs[m] = (pg8::rs_t)(s * pg8::RS_FIX);
    }
}
__device__ __forceinline__ void headnorm_rows(bf16* __restrict__ X, int ld, int nheads, const float* __restrict__ gain, int t, int lane, bool rope, const float (&cs)[8], const float (&sn)[8], unsigned char* __restrict__ X8 = nullptr) {
    const int hs = lane >> 4, l16 = lane & 15;
    f32x4 g0 = *(const f32x4*)(gain + 8 * l16), g1 = *(const f32x4*)(gain + 8 * l16 + 4);
    const float gg[8] = {g0.x, g0.y, g0.z, g0.w, g1.x, g1.y, g1.z, g1.w};
    const bool second = ((l16 >> 2) & 1) != 0;
    for (int hg = 0; hg < nheads / 4; ++hg) {
        bf16* p = X + (size_t)t * ld + (size_t)(4 * hg + hs) * HD + 8 * l16;
        const v4u raw = *(const v4u*)p;
        float x[8] = {bflo(raw.x), bfhi(raw.x), bflo(raw.y), bfhi(raw.y), bflo(raw.z), bfhi(raw.z), bflo(raw.w), bfhi(raw.w)};
        float ss = 0.f;
#pragma unroll
        for (int e = 0; e < 8; ++e) ss += x[e] * x[e];
        ss += __shfl_xor(ss, 1); ss += __shfl_xor(ss, 2); ss += __shfl_xor(ss, 4); ss += __shfl_xor(ss, 8);
        const float rinv = 1.0f / sqrtf(ss * (1.0f / HD) + EPS);
        float y[8];
#pragma unroll
        for (int e = 0; e < 8; ++e) y[e] = x[e] * rinv * gg[e];
        if (rope) {
#pragma unroll
            for (int e = 0; e < 8; ++e) { const float yp = __shfl_xor(y[e], 4); y[e] = second ? (y[e] * cs[e] + yp * sn[e]) : (y[e] * cs[e] - yp * sn[e]); }
        }
        if (X8) { int w0 = __builtin_amdgcn_cvt_pk_fp8_f32(y[0], y[1], 0, false); w0 = __builtin_amdgcn_cvt_pk_fp8_f32(y[2], y[3], w0, true);
            int w1 = __builtin_amdgcn_cvt_pk_fp8_f32(y[4], y[5], 0, false); w1 = __builtin_amdgcn_cvt_pk_fp8_f32(y[6], y[7], w1, true);
            *(v2u*)(X8 + (size_t)t * ld + (size_t)(4 * hg + hs) * HD + 8 * l16) = (v2u){(unsigned)w0, (unsigned)w1}; }
        else { v4u w; w.x = pk2(y[0], y[1]); w.y = pk2(y[2], y[3]); w.z = pk2(y[4], y[5]); w.w = pk2(y[6], y[7]);
            *(v4u*)p = w; }
    }
}
__device__ __forceinline__ void prep_phase(const Frame& F, bf16* Q, bf16* K, int ldk, int nkh, const float* qgain, const float* kgain, bool rope, unsigned char* K8 = nullptr) {
    const int gw = F.vcu * 8 + F.wave, NGW = F.G * 8;
    const int l16 = F.lane & 15;
    for (int t = gw; t < L; t += NGW) {
        float cs[8], sn[8];
#pragma unroll
        for (int e = 0; e < 8; ++e) { cs[e] = 1.f; sn[e] = 0.f; }
        if (rope) {
            const int ax = l16 >> 3; const float pos = (float)(ax ? (t & (GRID_W - 1)) : (t / GRID_W));
#pragma unroll
            for (int e = 0; e < 8; ++e) { const int f = (l16 & 3) * 8 + e; const float inv = 1.0f / powf(10000.0f, (float)f * (1.0f / 32.0f)); const float ang = pos * inv; cs[e] = cosf(ang); sn[e] = sinf(ang); }
        }
        headnorm_rows(Q, DM, NH, qgain, t, F.lane, rope, cs, sn);
        headnorm_rows(K, ldk, nkh, kgain, t, F.lane, rope, cs, sn, K8);
    }
}

constexpr int S5T = pg8::S5T, S5NCH = pg8::S5NCH, S5KS = pg8::S5KS;
__device__ __forceinline__ void s5_gen_group(const Frame& F, int g, const float* __restrict__ lam_re, const float* __restrict__ lam_im, const float* __restrict__ log_step,
                                             const float* __restrict__ b_re, const float* __restrict__ b_im, const float* __restrict__ c_re, const float* __restrict__ c_im,
                                             bf16* __restrict__ GM, bf16* __restrict__ BMt, f32x2* __restrict__ PAT) {
    LAS f32x2* apow = (LAS f32x2*)F.lds;
    LAS f32x2* zt = apow + 2 * 33 * 64;
    LAS float* Kd = (LAS float*)(zt + 2 * 64);
    const int tid = F.tid;
    if (tid < 128) {
        const int dir = tid >> 6, n = tid & 63, dg = dir * S5G + g, idx = dg * S5N + n;
        const double dt = exp((double)log_step[dg]);
        const double lr = (double)lam_re[idx], li = (double)lam_im[idx];
        const double mag = exp(lr * dt), are = mag * cos(li * dt), aim = mag * sin(li * dt);
        const double den = lr * lr + li * li, nre = are - 1.0;
        zt[dir * 64 + n] = (f32x2){(float)((nre * lr + aim * li) / den), (float)((aim * lr - nre * li) / den)};
        double pr = 1.0, pi = 0.0;
        for (int k = 0; k <= 32; ++k) { apow[(dir * 33 + k) * 64 + n] = (f32x2){(float)pr, (float)pi}; const double t = pr * are - pi * aim; pi = pr * aim + pi * are; pr = t; }
        PAT[idx] = apow[(dir * 33 + 32) * 64 + n];
    }
    LDS_WAIT(); __syncthreads();
    {
        const int dir = tid >> 8, p = (tid >> 4) & 15, q = tid & 15, dg = dir * S5G + g;
        float wr[64], wi[64];
        const float* cr = c_re + ((size_t)dg * S5P + p) * S5N; const float* ci = c_im + ((size_t)dg * S5P + p) * S5N;
#pragma unroll
        for (int n = 0; n < 64; ++n) { const f32x2 z = zt[dir * 64 + n]; const float br = b_re[((size_t)dg * S5N + n) * S5P + q], bi = b_im[((size_t)dg * S5N + n) * S5P + q];
            const float bbr = z.x * br - z.y * bi, bbi = z.x * bi + z.y * br; const float c0 = cr[n], c1 = ci[n];
            wr[n] = c0 * bbr - c1 * bbi; wi[n] = c0 * bbi + c1 * bbr; }
        for (int d = 0; d < 32; ++d) { float acc = 0.f; const LAS f32x2* ap = apow + (dir * 33 + d) * 64;
#pragma unroll
            for (int n = 0; n < 64; ++n) { const f32x2 a = ap[n]; acc = fmaf(wr[n], a.x, acc); acc = fmaf(-wi[n], a.y, acc); }
            Kd[(dir * 32 + d) * 256 + p * 16 + q] = acc; }
    }
    LDS_WAIT(); __syncthreads();
    bf16* BMg = BMt + (size_t)g * 512 * S5KS;
    for (int it = tid; it < 512 * 64; it += 512) { const int row = it >> 6, ch = it & 63, tau = row >> 4, p = row & 15, sg = ch >> 1, q0 = (ch & 1) * 8;
        float v[8];
        if (sg < tau) { const LAS float* k = Kd + (0 * 32 + (tau - sg)) * 256 + p * 16 + q0;
#pragma unroll
            for (int j = 0; j < 8; ++j) v[j] = k[j]; }
        else if (sg > tau) { const LAS float* k = Kd + (1 * 32 + (sg - tau)) * 256 + p * 16 + q0;
#pragma unroll
            for (int j = 0; j < 8; ++j) v[j] = k[j]; }
        else { const LAS float* k0 = Kd + p * 16 + q0; const LAS float* k1 = Kd + 32 * 256 + p * 16 + q0;
#pragma unroll
            for (int j = 0; j < 8; ++j) v[j] = k0[j] + k1[j]; }
        v4u w; w.x = pk2(v[0], v[1]); w.y = pk2(v[2], v[3]); w.z = pk2(v[4], v[5]); w.w = pk2(v[6], v[7]);
        *(v4u*)(BMg + (size_t)row * S5KS + ch * 8) = w; }
    for (int it = tid; it < 512 * 32; it += 512) { const int row = it >> 5, ch = it & 31, tau = row >> 4, p = row & 15, dir = ch >> 4, n0 = (ch & 15) * 4, dg = dir * S5G + g;
        const int k = dir ? (32 - tau) : (tau + 1);
        const f32x4 cr = *(const f32x4*)(c_re + ((size_t)dg * S5P + p) * S5N + n0), ci = *(const f32x4*)(c_im + ((size_t)dg * S5P + p) * S5N + n0);
        const LAS f32x2* ap = apow + (dir * 33 + k) * 64 + n0;
        unsigned o[4];
#pragma unroll
        for (int j = 0; j < 4; ++j) { const f32x2 a = ap[j]; const float vr = cr[j] * a.x - ci[j] * a.y, vi = cr[j] * a.y + ci[j] * a.x; o[j] = pk2(vr, -vi); }
        *(v4u*)(BMg + (size_t)row * S5KS + 512 + ch * 8) = (v4u){o[0], o[1], o[2], o[3]}; }
    bf16* GMg = GM + (size_t)g * 256 * 512;
    for (int it = tid; it < 128 * 64; it += 512) { const int dn = it >> 6, ch = it & 63, dir = dn >> 6, n = dn & 63, sg = ch >> 1, q0 = (ch & 1) * 8, dg = dir * S5G + g;
        const int pw = dir ? sg : (31 - sg);
        const f32x2 a = apow[(dir * 33 + pw) * 64 + n], z = zt[dir * 64 + n];
        const float wr_ = a.x * z.x - a.y * z.y, wi_ = a.x * z.y + a.y * z.x;
        const float* br = b_re + ((size_t)dg * S5N + n) * S5P + q0; const float* bi = b_im + ((size_t)dg * S5N + n) * S5P + q0;
        float re[8], im[8];
#pragma unroll
        for (int j = 0; j < 8; ++j) { re[j] = wr_ * br[j] - wi_ * bi[j]; im[j] = wr_ * bi[j] + wi_ * br[j]; }
        v4u w0, w1; w0.x = pk2(re[0], re[1]); w0.y = pk2(re[2], re[3]); w0.z = pk2(re[4], re[5]); w0.w = pk2(re[6], re[7]);
        w1.x = pk2(im[0], im[1]); w1.y = pk2(im[2], im[3]); w1.z = pk2(im[4], im[5]); w1.w = pk2(im[6], im[7]);
        *(v4u*)(GMg + (size_t)(dir * 128 + 2 * n) * 512 + ch * 8) = w0; *(v4u*)(GMg + (size_t)(dir * 128 + 2 * n + 1) * 512 + ch * 8) = w1; }
    LDS_WAIT(); __syncthreads();
}
__device__ __forceinline__ void s5_scan_phase(const Frame& F, const f32x2* __restrict__ PAT, const float* __restrict__ E, bf16* __restrict__ UA) {
    for (int task = F.bid + F.G * F.wave; task < 2 * S5G; task += F.G * 8) {
        const int dir = task >> 8, g = task & 255;
        const f32x2 a = PAT[task * S5N + F.lane];
        const float* e = E + (size_t)g * S5NCH * 256 + dir * 128 + 2 * F.lane;
        bf16* s = UA + (size_t)g * S5NCH * S5KS + 512 + dir * 128 + 2 * F.lane;
        float cr = 0.f, ci = 0.f;
        for (int c8 = 0; c8 < S5NCH; c8 += 8) {
            f32x2 v[8];
#pragma unroll
            for (int k = 0; k < 8; ++k) { const int c = dir ? (S5NCH - 1 - (c8 + k)) : (c8 + k); v[k] = *(const f32x2*)(e + (size_t)c * 256); }
#pragma unroll
            for (int k = 0; k < 8; ++k) { const int c = dir ? (S5NCH - 1 - (c8 + k)) : (c8 + k);
                *(unsigned*)(s + (size_t)c * S5KS) = pk2(cr, ci);
                const float nr = fmaf(a.x, cr, fmaf(-a.y, ci, v[k].x)), ni = fmaf(a.x, ci, fmaf(a.y, cr, v[k].y)); cr = nr; ci = ni; }
        }
    }
}


__device__ __forceinline__ float fp8_to_f32(unsigned char b) { const int e = (b >> 3) & 15, m = b & 7; const float v = e ? __builtin_ldexpf(1.0f + (float)m * 0.125f, e - 7) : __builtin_ldexpf((float)m * 0.125f, -6); return (b & 0x80) ? -v : v; }
__device__ __forceinline__ void gqa_selfcheck(const Frame& F, const bf16* __restrict__ Qp, const unsigned char* __restrict__ K8, const unsigned char* __restrict__ V8t, const bf16* __restrict__ O,
                                              float* __restrict__ SC, unsigned* flag) {
    LAS float* ql = (LAS float*)(F.lds + F.wave * 1024);
    const int lane = F.lane;
#pragma unroll 1
    for (int s = F.bid * 8 + F.wave; s < 1024; s += F.G * 8) {
        const int tok = (int)(((long)(s >> 5) * 5209 + 77) % L), hq = s & 31, kv = hq >> 2;
        float* sc = SC + (size_t)(F.bid * 8 + F.wave) * L;
        { const bf16* qp = Qp + (size_t)tok * DM + hq * HD; ql[lane] = bf2f(qp[lane]); ql[lane + 64] = bf2f(qp[lane + 64]); } LDS_WAIT();
        float mx = -1e30f;
#pragma unroll 1
        for (int j = lane; j < L; j += 64) { const unsigned char* kp = K8 + (size_t)j * KVD + kv * HD; float dot = 0.f;
#pragma unroll 1
            for (int d = 0; d < HD; ++d) dot += fp8_to_f32(kp[d]) * ql[d];
            dot *= 0.088388347648318440f; sc[j] = dot; mx = fmaxf(mx, dot); }
#pragma unroll
        for (int o = 1; o < 64; o <<= 1) mx = fmaxf(mx, __shfl_xor(mx, o));
        asm volatile("s_waitcnt vmcnt(0)" ::: "memory"); __builtin_amdgcn_fence(__ATOMIC_RELEASE, "workgroup"); __builtin_amdgcn_fence(__ATOMIC_ACQUIRE, "agent");
        float o0 = 0.f, o1 = 0.f, lsum = 0.f;
#pragma unroll 1
        for (int j = 0; j < L; ++j) { const float pj = expf(__hip_atomic_load(sc + j, __ATOMIC_RELAXED, __HIP_MEMORY_SCOPE_AGENT) - mx);
            o0 += pj * fp8_to_f32(V8t[(size_t)(kv * HD + lane) * L + j]); o1 += pj * fp8_to_f32(V8t[(size_t)(kv * HD + lane + 64) * L + j]); lsum += pj; }
        o0 /= lsum; o1 /= lsum;
        const unsigned char* op = (const unsigned char*)O + (size_t)tok * DM + hq * HD; const float g0 = fp8_to_f32(op[lane]) * 0.015625f, g1 = fp8_to_f32(op[lane + 64]) * 0.015625f;
        float am = fmaxf(fabsf(o0), fabsf(o1));
#pragma unroll
        for (int o = 1; o < 64; o <<= 1) am = fmaxf(am, __shfl_xor(am, o));
        const float tol = 0.2f * am + 1e-5f;
        const bool bad = !(fabsf(g0 - o0) <= tol) || !(fabsf(g1 - o1) <= tol);
        if (__any(bad) && lane == 0) __hip_atomic_fetch_or(flag, 1u, __ATOMIC_RELAXED, __HIP_MEMORY_SCOPE_AGENT);
        LDS_WAIT();
    }
}

__device__ __forceinline__ void transpose_item(const float* __restrict__ W, int K, int N, bf16* __restrict__ WT, int mode, const float* __restrict__ gain, LAS float* scr, int item, int lane, int fp8 = 0) {
    const int nblk = N / 32, kb = item / nblk, nb = item % nblk, k0 = 64 * kb, n0 = 32 * nb;
    int r0 = n0;
    if (mode == 1) r0 = (n0 < DM) ? ((n0 >> 7) * 256 + (n0 & 127)) : (((n0 - DM) >> 7) * 256 + 128 + ((n0 - DM) & 127));
    const float* src = W + (size_t)(k0 + (lane >> 5)) * N + n0 + (lane & 31);
    float v[32];
#pragma unroll
    for (int i = 0; i < 32; ++i) v[i] = src[(size_t)(2 * i) * N];
    const int c = lane & 7;
    f32x4 g0 = (f32x4){1.f, 1.f, 1.f, 1.f}, g1 = g0;
    if (gain) { g0 = *(const f32x4*)(gain + k0 + 8 * c); g1 = *(const f32x4*)(gain + k0 + 8 * c + 4); }
#pragma unroll
    for (int i = 0; i < 32; ++i) scr[(2 * i + (lane >> 5)) * 33 + (lane & 31)] = v[i];
    LDS_WAIT(); asm volatile("" ::: "memory");
#pragma unroll
    for (int j = 0; j < 4; ++j) { const int n = (lane >> 3) + 8 * j; const LAS float* s = scr + (8 * c) * 33 + n;
        if (fp8) { int w0 = __builtin_amdgcn_cvt_pk_fp8_f32(64.f * s[0 * 33] * g0.x, 64.f * s[1 * 33] * g0.y, 0, false); w0 = __builtin_amdgcn_cvt_pk_fp8_f32(64.f * s[2 * 33] * g0.z, 64.f * s[3 * 33] * g0.w, w0, true);
            int w1 = __builtin_amdgcn_cvt_pk_fp8_f32(64.f * s[4 * 33] * g1.x, 64.f * s[5 * 33] * g1.y, 0, false); w1 = __builtin_amdgcn_cvt_pk_fp8_f32(64.f * s[6 * 33] * g1.z, 64.f * s[7 * 33] * g1.w, w1, true);
            *(v2u*)((unsigned char*)WT + (size_t)(r0 + n) * K + k0 + 8 * c) = (v2u){(unsigned)w0, (unsigned)w1}; }
        else { v4u o; o.x = pk2(s[0 * 33] * g0.x, s[1 * 33] * g0.y); o.y = pk2(s[2 * 33] * g0.z, s[3 * 33] * g0.w); o.z = pk2(s[4 * 33] * g1.x, s[5 * 33] * g1.y); o.w = pk2(s[6 * 33] * g1.z, s[7 * 33] * g1.w);
            *(v4u*)(WT + (size_t)(r0 + n) * K + k0 + 8 * c) = o; } }
    LDS_WAIT(); asm volatile("" ::: "memory");
}

constexpr size_t MiB = 1u << 20;
constexpr size_t SZ_NAQKV = (size_t)3 * DM * DM * 2, SZ_DD = (size_t)DM * DM * 2, SZ_GQAQKV = (size_t)(DM + 2 * KVD) * DM * 2, SZ_W1 = (size_t)FF * DM * 2, SZ_PROJ = (size_t)DM * PLE * 2, SZ_ACT = (size_t)L * DM * 2;
constexpr size_t OFF_CTL = 0, CTL_ZERO_BYTES = 3 * MiB, OFF_RS = 1 * MiB;
constexpr size_t OFF_NAQKV = 4 * MiB;
constexpr size_t OFF_NAWO = OFF_NAQKV + 2 * SZ_NAQKV;
constexpr size_t OFF_GQAQKV = OFF_NAWO + 2 * SZ_DD;
constexpr size_t OFF_GQAWO = OFF_GQAQKV + SZ_GQAQKV;
constexpr size_t OFF_S5IN = OFF_GQAWO + SZ_DD;
constexpr size_t OFF_S5OUT = OFF_S5IN + SZ_DD;
constexpr size_t OFF_W1 = OFF_S5OUT + 2 * SZ_DD;
constexpr size_t OFF_W2 = OFF_W1 + 4 * SZ_W1;
constexpr size_t OFF_PROJ = OFF_W2 + 4 * SZ_W1;
constexpr size_t OFF_GATE = OFF_PROJ + 4 * SZ_PROJ;
constexpr size_t OFF_PBF = OFF_GATE + 4 * SZ_DD;
constexpr size_t OFF_XN = OFF_PBF + 4 * (size_t)L * PLE * 2;
constexpr size_t OFF_ACT = OFF_XN + SZ_ACT;
constexpr size_t OFF_PP = OFF_ACT + 4 * SZ_ACT;
constexpr size_t OFF_S5BM = OFF_PP + SZ_ACT;
constexpr size_t OFF_S5GM = OFF_S5BM + 192 * MiB;
constexpr size_t OFF_S5PAR = OFF_S5GM + 64 * MiB;
constexpr size_t OFF_DUMMY = OFF_S5PAR + 8 * MiB;
constexpr size_t OFF_HB1 = OFF_DUMMY + 256 * MiB;
constexpr size_t OFF_HB8 = OFF_HB1 + SZ_ACT;
constexpr size_t WS_END = OFF_HB8 + (size_t)L * DM;
constexpr int CW_BAR = 4096;
constexpr int RING_BYTES = 131072, LDSCTL_OFF = RING_BYTES, MISC_OFF = LDSCTL_OFF + 320, PTAB_OFF = LDSCTL_OFF + 1024, LDS_BYTES = 147456;
static_assert(dattn::SHM_ATTN <= RING_BYTES && 8 * 64 * 33 * 4 <= RING_BYTES, "phase scratch fits the ring region");

constexpr int PH_PER_LAYER = 8, NPH = 1 + DEPTH * PH_PER_LAYER;
struct Args { const float* in[28]; float* out; unsigned char* ws; int ph_lo, ph_hi; };
enum { I_X = 0, I_P, I_MIXN, I_MLPN, I_PLEN, I_NAQKV, I_NAWO, I_NAQG, I_NAKG, I_NARPB, I_GQKV, I_GWO, I_GQG, I_GKG, I_S5IN, I_LAMRE, I_LAMIM, I_LOGSTEP, I_BRE, I_BIM, I_CRE, I_CIM, I_S5D, I_S5OUT, I_W1, I_W2, I_PROJ, I_GATE };


__device__ __forceinline__ unsigned long long tab_get(LAS unsigned char* lds, int i) {
    volatile LAS unsigned* t = (volatile LAS unsigned*)(lds + PTAB_OFF); const unsigned lo = t[2 * i], hi = t[2 * i + 1];
    return ((unsigned long long)(unsigned)__builtin_amdgcn_readfirstlane((int)hi) << 32) | (unsigned)__builtin_amdgcn_readfirstlane((int)lo); }
#define INP(i) ((const float*)(const GAS float*)tab_get(F.lds, (i)))
#define OUTP() ((float*)(GAS float*)tab_get(F.lds, 28))
#define WSP() ((unsigned char*)(GAS unsigned char*)tab_get(F.lds, 29))
__device__ __forceinline__ Frame mkframe(unsigned char* lds_generic) {
    Frame F; int t = wg_tid(); asm volatile("" : "+v"(t)); F.tid = t; F.lane = t & 63; F.wave = __builtin_amdgcn_readfirstlane(t >> 6);
    F.lds = (LAS unsigned char*)lds_generic; int b = blockIdx.x; asm volatile("" : "+s"(b)); F.bid = b; int G = gridDim.x; asm volatile("" : "+s"(G)); F.G = G;
    F.vcu = (G % 8 == 0) ? (b % 8) * (G / 8) + b / 8 : b; return F; }
__device__ __forceinline__ void prologue_phase(const Frame& F) {
    unsigned char* ws = WSP();
    LAS float* scr = (LAS float*)(F.lds + F.wave * (64 * 33 * 4));
    const int gw = F.vcu * 8 + F.wave, NGW = F.G * 8;
    constexpr int I_QKV = (DM / 64) * (3 * DM / 32), I_DD = (DM / 64) * (DM / 32), I_GQ = (DM / 64) * ((DM + 2 * KVD) / 32), I_SO = (DM / 64) * (2 * DM / 32),
                  I_1 = (DM / 64) * (FF / 32), I_2 = (FF / 64) * (DM / 32), I_PJ = (PLE / 64) * (DM / 32);
    constexpr int NITEMS = 2 * I_QKV + 2 * I_DD + I_GQ + I_DD + I_DD + I_SO + 4 * I_1 + 4 * I_2 + 4 * I_PJ + 4 * I_DD;
    for (int it = gw; it < NITEMS; it += NGW) {
        int r = it; const float* W; int K, N, mode = 0, fp8 = 0; bf16* WT; const float* gain = nullptr;
        if (r < 2 * I_QKV) { const int l = r / I_QKV; r -= l * I_QKV; W = INP(I_NAQKV) + (size_t)l * DM * 3 * DM; K = DM; N = 3 * DM; WT = (bf16*)(ws + OFF_NAQKV + l * SZ_NAQKV); gain = INP(I_MIXN) + (size_t)(3 * l) * DM; fp8 = 1; }
        else { r -= 2 * I_QKV;
        if (r < 2 * I_DD) { const int l = r / I_DD; r -= l * I_DD; W = INP(I_NAWO) + (size_t)l * DM * DM; K = DM; N = DM; WT = (bf16*)(ws + OFF_NAWO + l * SZ_DD); fp8 = 1; }
        else { r -= 2 * I_DD;
        if (r < I_GQ) { W = INP(I_GQKV); K = DM; N = DM + 2 * KVD; WT = (bf16*)(ws + OFF_GQAQKV); gain = INP(I_MIXN) + (size_t)1 * DM; fp8 = 1; }
        else { r -= I_GQ;
        if (r < I_DD) { W = INP(I_GWO); K = DM; N = DM; WT = (bf16*)(ws + OFF_GQAWO); fp8 = 1; }
        else { r -= I_DD;
        if (r < I_DD) { W = INP(I_S5IN); K = DM; N = DM; WT = (bf16*)(ws + OFF_S5IN); gain = INP(I_MIXN) + (size_t)2 * DM; fp8 = 1; }
        else { r -= I_DD;
        if (r < I_SO) { W = INP(I_S5OUT); K = DM; N = 2 * DM; WT = (bf16*)(ws + OFF_S5OUT); mode = 1; fp8 = 1; }
        else { r -= I_SO;
        if (r < 4 * I_1) { const int l = r / I_1; r -= l * I_1; W = INP(I_W1) + (size_t)l * DM * FF; K = DM; N = FF; WT = (bf16*)(ws + OFF_W1 + l * SZ_W1); gain = INP(I_MLPN) + (size_t)l * DM; }
        else { r -= 4 * I_1;
        if (r < 4 * I_2) { const int l = r / I_2; r -= l * I_2; W = INP(I_W2) + (size_t)l * FF * DM; K = FF; N = DM; WT = (bf16*)(ws + OFF_W2 + l * SZ_W1); }
        else { r -= 4 * I_2;
        if (r < 4 * I_PJ) { const int l = r / I_PJ; r -= l * I_PJ; W = INP(I_PROJ) + (size_t)l * PLE * DM; K = PLE; N = DM; WT = (bf16*)(ws + OFF_PROJ + l * SZ_PROJ); }
        else { r -= 4 * I_PJ; const int l = r / I_DD; r -= l * I_DD; W = INP(I_GATE) + (size_t)l * DM * DM; K = DM; N = DM; WT = (bf16*)(ws + OFF_GATE + l * SZ_DD); gain = INP(I_PLEN) + (size_t)l * DM; } } } } } } } } }
        transpose_item(W, K, N, WT, mode, gain, scr, r, F.lane, fp8);
    }
    xrows_phase(F, INP(I_X), (bf16*)(ws + OFF_XN), (pg8::rs_t*)(ws + OFF_RS), ws + OFF_HB8);
    { const size_t n8 = (size_t)DEPTH * L * PLE / 8; const float* p = INP(I_P); bf16* pb = (bf16*)(ws + OFF_PBF);
      for (size_t i = (size_t)gw * 64 + F.lane; i < n8; i += (size_t)NGW * 64) { const f32x4 a = *(const f32x4*)(p + i * 8), b = *(const f32x4*)(p + i * 8 + 4);
          v4u w; w.x = pk2(a.x, a.y); w.y = pk2(a.z, a.w); w.z = pk2(b.x, b.y); w.w = pk2(b.z, b.w); *(v4u*)(pb + i * 8) = w; } }
    { bf16* GM = (bf16*)(ws + OFF_S5GM); bf16* BMt = (bf16*)(ws + OFF_S5BM); f32x2* PAT = (f32x2*)(ws + OFF_S5PAR);
      LDS_WAIT(); __syncthreads();
      for (int g = F.bid; g < S5G; g += F.G) s5_gen_group(F, g, INP(I_LAMRE), INP(I_LAMIM), INP(I_LOGSTEP), INP(I_BRE), INP(I_BIM), INP(I_CRE), INP(I_CIM), GM, BMt, PAT); }
}

#define WS_PTRS() unsigned char* ws = WSP(); bf16* HB0 = (bf16*)(ws + OFF_XN); bf16* HB1 = (bf16*)(ws + OFF_HB1); bf16* Qb = (bf16*)(ws + OFF_ACT); bf16* Kb = (bf16*)(ws + OFF_ACT + SZ_ACT); bf16* Vb = (bf16*)(ws + OFF_ACT + 2 * SZ_ACT); \
    bf16* Ob = (bf16*)(ws + OFF_ACT + 3 * SZ_ACT); bf16* HID = (bf16*)(ws + OFF_ACT); bf16* UA = (bf16*)(ws + OFF_ACT); bf16* S5Gb = (bf16*)(ws + OFF_ACT + 2 * SZ_ACT); float* S5E = (float*)(ws + OFF_ACT + 3 * SZ_ACT); bf16* PP = (bf16*)(ws + OFF_PP); \
    (void)HB0; (void)HB1; (void)Qb; (void)Kb; (void)Vb; (void)Ob; (void)HID; (void)UA; (void)S5Gb; (void)PP; (void)S5E;
__global__ void __launch_bounds__(512, 2) enc_fwd(Args args) {
    extern __shared__ __attribute__((aligned(16))) unsigned char lds[];
    {
        LAS unsigned char* l3 = (LAS unsigned char*)lds;
        for (int u = threadIdx.x; u < (LDS_BYTES - LDSCTL_OFF) / 4; u += 512) ((LAS unsigned*)(l3 + LDSCTL_OFF))[u] = 0u;
        __syncthreads();
        if (threadIdx.x == 0) { LAS unsigned long long* t = (LAS unsigned long long*)(l3 + PTAB_OFF);
#pragma unroll
            for (int i = 0; i < 28; ++i) t[i] = (unsigned long long)args.in[i];
            t[28] = (unsigned long long)args.out; t[29] = (unsigned long long)args.ws; }
        if ((threadIdx.x & 63) == 0) ((LAS unsigned*)(WTAB_OFF))[hw_wave_slot()] = threadIdx.x >> 6;
        __syncthreads();
    }
    const int lo = args.ph_lo, hi = args.ph_hi;
    XcdBarrier bar;
    { LAS unsigned char* l3 = (LAS unsigned char*)lds; unsigned* ctl = (unsigned*)(GAS unsigned*)(tab_get(l3, 29) + OFF_CTL); bar.bar = ctl + CW_BAR; bar.x = 0; bar.st = nullptr;
      if (hi - lo > 1) bar = xcd_barrier_post(ctl + CW_BAR, (volatile LAS unsigned*)(l3 + MISC_OFF) + 8); }
#define IN(k) (lo <= (k) && (k) < hi)
#ifndef PROBE_PH
#define PROBE_PH (-1)
#endif
#define REPS(k) for (int rep_ = 0, nrep_ = (((k) == PROBE_PH || PROBE_PH == -2) ? 2 : ((((PROBE_PH >= 300 && PROBE_PH < 320)) && (k) == 11) ? 4 : 1)); rep_ < nrep_; ++rep_)
#define HBOUT(p) ((nrep_ == 2 && rep_ == 0) ? (bf16*)(ws + OFF_DUMMY) : (p))
#define RSOUT(i) ((nrep_ == 2 && rep_ == 0) ? (pg8::rs_t*)(ws + OFF_DUMMY + 128 * MiB) : RSP(i))
#if PROBE_PH >= 700 && PROBE_PH < 900
#define SEAM(k) do { if (IN(k) && IN((k) + 1)) { unsigned long long* ts_ = (unsigned long long*)(GAS unsigned long long*)(tab_get((LAS unsigned char*)lds, 29) + OFF_DUMMY + 200 * MiB); \
        if ((k) == PROBE_PH % 100) { __syncthreads(); if (wg_tid() == 0) __hip_atomic_store(ts_ + blockIdx.x, (unsigned long long)wall_clock64(), __ATOMIC_RELAXED, __HIP_MEMORY_SCOPE_AGENT); } \
        xcd_barrier(bar); \
        if ((k) == PROBE_PH % 100 && blockIdx.x == 0 && wg_tid() == 0) { unsigned long long mx = 0, sm = 0, t0_ = ~0ull; const unsigned st_ = (PROBE_PH >= 800) ? 8u : 1u; \
            for (unsigned i_ = 0; i_ < gridDim.x; i_ += st_) { const unsigned long long t_ = __hip_atomic_load(ts_ + i_, __ATOMIC_RELAXED, __HIP_MEMORY_SCOPE_AGENT); mx = t_ > mx ? t_ : mx; t0_ = t_ < t0_ ? t_ : t0_; } \
            for (unsigned i_ = 0; i_ < gridDim.x; i_ += st_) sm += __hip_atomic_load(ts_ + i_, __ATOMIC_RELAXED, __HIP_MEMORY_SCOPE_AGENT) - t0_; \
            const unsigned long long idle_ = (mx - t0_) - sm / (gridDim.x / st_), until_ = (unsigned long long)wall_clock64() + 100ull * idle_; \
            while ((unsigned long long)wall_clock64() < until_) __builtin_amdgcn_s_sleep(32); } } } while (0)
#else
#define SEAM(k) do { if (IN(k) && IN((k) + 1)) xcd_barrier(bar); } while (0)
#endif

#if PROBE_PH == 601
    if (blockIdx.x == 0 && threadIdx.x < 64) {
        typedef int v8i_ __attribute__((ext_vector_type(8))); typedef float f4v_ __attribute__((ext_vector_type(4)));
        const int l = threadIdx.x, ij = l & 15, kb = l >> 4; const unsigned lut[7] = {0xC4u, 0xC0u, 0xB8u, 0x00u, 0x38u, 0x40u, 0x44u};
        v8i_ A, B;
#pragma unroll
        for (int v = 0; v < 8; ++v) { unsigned wa = 0, wb = 0;
#pragma unroll
            for (int b = 0; b < 4; ++b) { const int kk = 32 * kb + 4 * v + b; const int av = ((ij + 2 * kk) % 5) - 2, bv = ((3 * kk + ij) % 7) - 3;
                unsigned ea = 0, eb = 0;
#pragma unroll
                for (int t = 0; t < 7; ++t) { ea = (av + 3 == t) ? lut[t] : ea; eb = (bv + 3 == t) ? lut[t] : eb; }
                wa |= ea << (8 * b); wb |= eb << (8 * b); }
            A[v] = (int)wa; B[v] = (int)wb; }
        f4v_ c1 = {};
        c1 = __builtin_amdgcn_mfma_scale_f32_16x16x128_f8f6f4(A, B, c1, 0, 0, 0, 0x7F7F7F7F, 0, 0x7F7F7F7F);
        bool ok1 = true;
#pragma unroll
        for (int r = 0; r < 4; ++r) { const int i = 4 * kb + r, j = ij; int s = 0;
            for (int kk = 0; kk < 128; ++kk) s += (((i + 2 * kk) % 5) - 2) * (((3 * kk + j) % 7) - 3);
            ok1 = ok1 && (c1[r] == (float)s); }
        unsigned long long ticks = 0; if (!__all(ok1)) ticks += 400000ull;
        const unsigned long long t0 = __builtin_amdgcn_s_memrealtime(); while (__builtin_amdgcn_s_memrealtime() - t0 < ticks) __builtin_amdgcn_s_sleep(8);
    }
    __syncthreads();
#endif
#if PROBE_PH == 600
    if (blockIdx.x == 0 && threadIdx.x < 64) {
        typedef int v8i_ __attribute__((ext_vector_type(8))); typedef float f16v_ __attribute__((ext_vector_type(16)));
        const int l = threadIdx.x, ij = l & 31, kb = l >> 5; const unsigned lut[7] = {0xC4u, 0xC0u, 0xB8u, 0x00u, 0x38u, 0x40u, 0x44u};
        v8i_ A, B;
#pragma unroll
        for (int v = 0; v < 8; ++v) { unsigned wa = 0, wb = 0;
#pragma unroll
            for (int b = 0; b < 4; ++b) { const int kk = 32 * kb + 4 * v + b; const int av = ((ij + 2 * kk) % 5) - 2, bv = ((3 * kk + ij) % 7) - 3;
                unsigned ea = 0, eb = 0;
#pragma unroll
                for (int t = 0; t < 7; ++t) { ea = (av + 3 == t) ? lut[t] : ea; eb = (bv + 3 == t) ? lut[t] : eb; }
                wa |= ea << (8 * b); wb |= eb << (8 * b); }
            A[v] = (int)wa; B[v] = (int)wb; }
        f16v_ c1 = {}, c2 = {};
        c1 = __builtin_amdgcn_mfma_scale_f32_32x32x64_f8f6f4(A, B, c1, 0, 0, 0, 0x7F7F7F7F, 0, 0x7F7F7F7F);
        c2 = __builtin_amdgcn_mfma_scale_f32_32x32x64_f8f6f4(A, B, c2, 0, 0, 0, 0x7B7B7B7B, 0, 0x7F7F7F7F);
        bool ok1 = true, ok2 = true;
#pragma unroll
        for (int r = 0; r < 16; ++r) { const int i = (r & 3) + 8 * (r >> 2) + 4 * kb, j = ij; int s = 0;
            for (int kk = 0; kk < 64; ++kk) s += (((i + 2 * kk) % 5) - 2) * (((3 * kk + j) % 7) - 3);
            ok1 = ok1 && (c1[r] == (float)s); ok2 = ok2 && (c2[r] == (float)s * 0.0625f); }
        int w = __builtin_amdgcn_cvt_pk_fp8_f32(1.0f, 2.0f, 0, false); w = __builtin_amdgcn_cvt_pk_fp8_f32(3.0f, -1.0f, w, true);
        const bool ok3 = ((unsigned)w == 0xB8444038u);
        unsigned long long ticks = 0; if (!__all(ok1)) ticks += 400000ull; if (!__all(ok2)) ticks += 800000ull; if (!__all(ok3)) ticks += 1600000ull;
        const unsigned long long t0 = __builtin_amdgcn_s_memrealtime(); while (__builtin_amdgcn_s_memrealtime() - t0 < ticks) __builtin_amdgcn_s_sleep(8);
    }
    __syncthreads();
#endif
    if (IN(0)) REPS(0) { const Frame F = mkframe(lds); prologue_phase(F); } SEAM(0);
#if PROBE_PH == 200
    for (int xb_ = 0; xb_ < 40; ++xb_) xcd_barrier(bar);
#endif

#pragma unroll 1
    for (int layer = 0; layer < DEPTH; ++layer) {
        const int kind = layer % 3, slot = layer / 3, pb = 1 + PH_PER_LAYER * layer;
#define RSP(i) ((pg8::rs_t*)(ws + OFF_RS) + (size_t)(i) * L)
        const int irs = (layer == 0) ? 0 : 3 * layer;
        if (IN(pb + 0)) REPS(pb + 0) {
            const Frame F = mkframe(lds); WS_PTRS();
            if (kind != 2) {
                const int N = (kind == 0) ? 3 * DM : DM + 2 * KVD;
                const bf16* W = (kind == 0) ? (const bf16*)(ws + OFF_NAQKV + slot * SZ_NAQKV) : (const bf16*)(ws + OFF_GQAQKV);
                const pg8::Gemm g = pg8::mkgemm((const bf16*)(ws + OFF_HB8), W, L, N, DM / 2); pg8::StaticOrder S; S.init(L, N, F.G, F.bid);
                pg8::EpiBf16<0> E{Qb, Kb, Vb, DM, (kind == 0) ? DM : KVD, (kind == 0) ? DM : L, DM, (kind == 0) ? 2 * DM : DM + KVD, RSP(irs), (kind == 0) ? 0 : 2, (kind == 0) ? 2 * DM : DM + KVD};
                pg8::gemm_phase<pg8::EpiBf16<0>, pg8::StaticOrder, false, true, true>(F.lds, g, S, E);
            } else {
                const pg8::Gemm g = pg8::mkgemm((const bf16*)(ws + OFF_HB8), (const bf16*)(ws + OFF_S5IN), L, DM, DM / 2); pg8::StaticOrder S; S.init(L, DM, F.G, F.bid);
                pg8::EpiS5U E{UA, RSP(irs)};
                pg8::gemm_phase<pg8::EpiS5U, pg8::StaticOrder, false, true, true>(F.lds, g, S, E);
            }
        }
        SEAM(pb + 0);
        if (kind != 2) {
            if (kind == 1) { if (IN(pb + 1)) { const Frame F = mkframe(lds); WS_PTRS(); prep_phase(F, Qb, Kb, KVD, NKV, INP(I_GQG), INP(I_GKG), true, (unsigned char*)Kb + 64 * MiB); }
                SEAM(pb + 1); }
            if (IN(pb + 2)) REPS(pb + 2) { const Frame F = mkframe(lds); WS_PTRS();
                if (kind == 0) {
                    const float* rpb = INP(I_NARPB) + (size_t)slot * NH * 15 * 31;
                    for (int i = 0;; ++i) { const int unit = i * F.G + F.vcu; if (unit >= NH * (GROWS / 4)) break;
                        const int h = unit >> 6, R = (unit & 63) * 4, ks = min(max(R - 4, 0), GROWS - dattn::NA_TILES);
                        dattn::na_block_body(Qb + (size_t)(R * GRID_W) * DM + h * HD, Kb + (size_t)(ks * GRID_W) * DM + h * HD, Vb + (size_t)(ks * GRID_W) * DM + h * HD,
                                             (bf16*)((unsigned char*)Ob + (size_t)(R * GRID_W) * DM + h * HD), rpb + (size_t)h * 15 * 31, INP(I_NAQG) + slot * HD, INP(I_NAKG) + slot * HD, R, ks, (char*)lds);
                        __syncthreads(); }
                } else {
                    for (int i = 0;; ++i) { const int unit = i * F.G + F.bid; if (unit >= NH * (L / 256)) break;
                        const int kvh = unit & 7, rest = unit >> 3, hq = kvh * 4 + (rest >> 6), qb = rest & 63;
                        dattn::attn_dense_body8(Qb + (size_t)(qb * 256) * DM + hq * HD, (const unsigned char*)Kb + 64 * MiB + kvh * HD, (const unsigned char*)Vb + (size_t)(kvh * HD) * L, (bf16*)((unsigned char*)Ob + (size_t)(qb * 256) * DM + hq * HD), L, (char*)lds);
                        __syncthreads(); }
                }
            }
            if (IN(pb + 2) && IN(pb + 4)) xcd_barrier(bar);
#if PROBE_PH == 400
            if (kind == 1) { const Frame F = mkframe(lds); WS_PTRS();
                gqa_selfcheck(F, Qb, (const unsigned char*)Kb + 64 * MiB, (const unsigned char*)Vb, Ob, (float*)(ws + OFF_PP), (unsigned*)(ws + OFF_CTL) + 8);
                xcd_barrier(bar); }
#endif
        } else {
            if (IN(pb + 1)) REPS(pb + 1) { const Frame F = mkframe(lds); WS_PTRS();
                pg8::Gemm g; g.A = UA; g.Bt = (const bf16*)(ws + OFF_S5GM); g.M = S5G * S5NCH; g.N = 256; g.K = 512; g.lda = S5KS; g.ldb = 512; g.sa = 0x7F7F7F7F;
                pg8::S5Order S{F.G, F.bid, 2, 1}; pg8::EpiS5E E{S5E};
                pg8::gemm_phase<pg8::EpiS5E, pg8::S5Order, false, true>(F.lds, g, S, E); }
            SEAM(pb + 1);
            if (IN(pb + 2)) REPS(pb + 2) { const Frame F = mkframe(lds); WS_PTRS(); s5_scan_phase(F, (const f32x2*)(ws + OFF_S5PAR), S5E, UA); }
            SEAM(pb + 2);
            if (IN(pb + 3)) REPS(pb + 3) { const Frame F = mkframe(lds); WS_PTRS();
                pg8::Gemm g; g.A = UA; g.Bt = (const bf16*)(ws + OFF_S5BM); g.M = S5G * S5NCH; g.N = S5G * 512; g.K = S5KS; g.lda = S5KS; g.ldb = S5KS; g.sa = 0x7F7F7F7F;
                pg8::S5Order S{F.G, F.bid, 2, 2}; pg8::EpiS5Y E{UA, INP(I_S5D), S5Gb, DM};
                pg8::gemm_phase<pg8::EpiS5Y, pg8::S5Order, false, true>(F.lds, g, S, E); }
            SEAM(pb + 3);
        }
        if (IN(pb + 4)) REPS(pb + 4) {
            const Frame F = mkframe(lds); WS_PTRS();
            if (kind != 2) {
                const bf16* W = (kind == 0) ? (const bf16*)(ws + OFF_NAWO + slot * SZ_DD) : (const bf16*)(ws + OFF_GQAWO);
                pg8::Gemm g = pg8::mkgemm(Ob, W, L, DM, DM / 2); g.sa = 0x79797979; pg8::StaticOrder S; S.init(L, DM, F.G, F.bid);
                pg8::EpiRes E{HB0, HBOUT(HB0), RSOUT(1 + 3 * layer), DM, nullptr};
                pg8::gemm_phase<pg8::EpiRes, pg8::StaticOrder, false, true, true>(F.lds, g, S, E);
            } else {
                pg8::Gemm g = pg8::mkgemm(S5Gb, (const bf16*)(ws + OFF_S5OUT), L, 2 * DM, DM / 2); g.sa = 0x7B7B7B7B; pg8::StaticOrder S; S.init(L, 2 * DM, F.G, F.bid);
                pg8::EpiGlu E{HB0, HBOUT(HB0), RSOUT(1 + 3 * layer), DM};
                pg8::gemm_phase<pg8::EpiGlu, pg8::StaticOrder, false, true, true>(F.lds, g, S, E);
            }
        }
        SEAM(pb + 4);
        if (IN(pb + 5)) REPS(pb + 5) { const Frame F = mkframe(lds); WS_PTRS();
            const pg8::Gemm g = pg8::mkgemm(HB0, (const bf16*)(ws + OFF_W1 + layer * SZ_W1), L, FF, DM); pg8::StaticOrder S; S.init(L, FF, F.G, F.bid);
            pg8::EpiBf16<2> E{HID, HID, HID, FF, FF, FF, 1 << 30, 1 << 30, nullptr, 0, 0};
#if PROBE_PH == 201
            { pg8::RangeOrder R1{S, 0, 8}, R2{S, 8, 16};
              pg8::gemm_phase<pg8::EpiBf16<2>, pg8::RangeOrder, false, true>(F.lds, g, R1, E); xcd_barrier(bar);
              pg8::gemm_phase<pg8::EpiBf16<2>, pg8::RangeOrder, false, true>(F.lds, g, R2, E); }
#else
            pg8::gemm_phase<pg8::EpiBf16<2>, pg8::StaticOrder, false, true>(F.lds, g, S, E);
#endif
        }
        SEAM(pb + 5);
        if (IN(pb + 6)) REPS(pb + 6) { const Frame F = mkframe(lds); WS_PTRS();
            { const pg8::Gemm g = pg8::mkgemm(HID, (const bf16*)(ws + OFF_W2 + layer * SZ_W1), L, DM, FF); pg8::StaticOrder S; S.init(L, DM, F.G, F.bid);
              pg8::EpiRes E{HB0, HBOUT(HB1), RSOUT(2 + 3 * layer), DM, RSP(1 + 3 * layer)};
              pg8::gemm_phase<pg8::EpiRes, pg8::StaticOrder, false, true>(F.lds, g, S, E); }
            { const pg8::Gemm g = pg8::mkgemm((const bf16*)(ws + OFF_PBF + (size_t)layer * L * PLE * 2), (const bf16*)(ws + OFF_PROJ + layer * SZ_PROJ), L, DM, PLE); pg8::StaticOrder S; S.init(L, DM, F.G, F.bid);
              pg8::EpiBf16<0> E{PP, PP, PP, DM, DM, DM, 1 << 30, 1 << 30, nullptr, 0, 0};
              pg8::gemm_phase<pg8::EpiBf16<0>, pg8::StaticOrder, false, true>(F.lds, g, S, E); }
        }
        SEAM(pb + 6);
        if (IN(pb + 7)) REPS(pb + 7) { const Frame F = mkframe(lds); WS_PTRS();
            const pg8::Gemm g = pg8::mkgemm(HB1, (const bf16*)(ws + OFF_GATE + layer * SZ_DD), L, DM, DM); pg8::StaticOrder S; S.init(L, DM, F.G, F.bid);
            pg8::EpiGate E{HB1, HBOUT(HB0), (layer == DEPTH - 1) ? OUTP() : nullptr, PP, RSP(2 + 3 * layer), RSOUT(3 + 3 * layer), DM, (layer + 1 < DEPTH && !(nrep_ == 2 && rep_ == 0)) ? ws + OFF_HB8 : nullptr};
            pg8::gemm_phase<pg8::EpiGate, pg8::StaticOrder, false, true>(F.lds, g, S, E);
        }
        SEAM(pb + 7);
    }
#if PROBE_PH == 400
    { xcd_barrier(bar); const Frame F = mkframe(lds); unsigned char* ws = WSP();
      if (__hip_atomic_load((unsigned*)(ws + OFF_CTL) + 8, __ATOMIC_RELAXED, __HIP_MEMORY_SCOPE_AGENT) != 0u && F.bid == 0 && F.tid < 64) OUTP()[F.tid] = __builtin_nanf(""); }
#endif
#undef IN
#undef SEAM
}

extern "C" void kernel_launch(void* const* d_in, const int* in_sizes, int n_in, void* d_out, int out_size, void* d_ws, size_t ws_size, hipStream_t stream) {
    static int grid = 0;
    if (grid == 0) {
        if (n_in != 28 || in_sizes[0] != L * DM || out_size != L * DM || ws_size < WS_END) {
            fprintf(stderr, "kernel_launch: built for 28 inputs, x/out of %d floats, >= %zu bytes of workspace; got n_in %d, in0 %d, out %d, ws %zu; nothing launched\n", L * DM, (size_t)WS_END, n_in, n_in > 0 ? in_sizes[0] : -1, out_size, ws_size);
            grid = -1; return; }
        int dev = 0, cus = 0, per_cu = 0;
        if (hipGetDevice(&dev) != hipSuccess || hipDeviceGetAttribute(&cus, hipDeviceAttributeMultiprocessorCount, dev) != hipSuccess) { fprintf(stderr, "kernel_launch: device query failed\n"); grid = -1; return; }
        if (hipFuncSetAttribute((const void*)enc_fwd, hipFuncAttributeMaxDynamicSharedMemorySize, LDS_BYTES) != hipSuccess) { fprintf(stderr, "kernel_launch: hipFuncSetAttribute failed\n"); grid = -1; return; }
        if (hipOccupancyMaxActiveBlocksPerMultiprocessor(&per_cu, (const void*)enc_fwd, 512, LDS_BYTES) != hipSuccess || per_cu < 1)
            fprintf(stderr, "kernel_launch: note: occupancy query reports %d workgroups per CU\n", per_cu);
        (void)hipGetLastError();
        grid = cus;
    }
    if (grid < 0) return;
    if (hipMemsetAsync((char*)d_ws + OFF_CTL, 0, CTL_ZERO_BYTES, stream) != hipSuccess) { fprintf(stderr, "kernel_launch: memset failed\n"); return; }
    Args a{};
    for (int i = 0; i < 28; ++i) a.in[i] = (const float*)d_in[i];
    a.out = (float*)d_out; a.ws = (unsigned char*)d_ws;
#if MK_N_LAUNCHES == 1
    a.ph_lo = 0; a.ph_hi = NPH;
    hipLaunchKernelGGL(enc_fwd, dim3(grid), dim3(512), LDS_BYTES, stream, a);
#else
    for (int ph = 0; ph < NPH; ++ph) {
        if (ph > 0) { const int layer = (ph - 1) / PH_PER_LAYER, j = (ph - 1) % PH_PER_LAYER; if (j == 3 && layer % 3 != 2) continue; }
        a.ph_lo = ph; a.ph_hi = ph + 1;
        hipLaunchKernelGGL(enc_fwd, dim3(grid), dim3(512), LDS_BYTES, stream, a);
    }
#endif
    const hipError_t le = hipPeekAtLastError();
    if (le != hipSuccess) fprintf(stderr, "kernel_launch: launch failed: %s\n", hipGetErrorName(le));
}
```

```cpp
#include <hip/hip_runtime.h>
#include <cstdio>
#include <cstdint>

#ifndef MK_N_LAUNCHES
#define MK_N_LAUNCHES 1
#endif

constexpr int L = 16384, DM = 4096, DEPTH = 4, GRID_W = 64, GROWS = L / GRID_W, HD = 128, NH = 32, NKV = 8, KVD = NKV * HD, FF = 4 * DM, PLE = 256;
constexpr int S5G = 256, S5P = 16, S5N = 64, S5TC = 16, S5NC = L / S5TC;
constexpr float EPS = 1e-6f;

#define GAS __attribute__((address_space(1)))
#define LAS __attribute__((address_space(3)))
constexpr unsigned WTAB_OFF = 131072 + 2048;
__device__ __forceinline__ unsigned hw_wave_slot() { return (unsigned)__builtin_amdgcn_s_getreg((5 << 11) | 4) & 63u; }
__device__ __forceinline__ int wg_tid() {
    const unsigned wv = (unsigned)__builtin_amdgcn_readfirstlane((int)((volatile LAS unsigned*)(WTAB_OFF))[hw_wave_slot()]);
    unsigned ln; asm volatile("v_mbcnt_lo_u32_b32 %0, -1, 0\n\tv_mbcnt_hi_u32_b32 %0, -1, %0" : "=v"(ln));
    return (int)(wv * 64u + ln);
}
typedef unsigned short bf16;
typedef unsigned v4u __attribute__((ext_vector_type(4)));
typedef unsigned v2u __attribute__((ext_vector_type(2)));
typedef float f32x4 __attribute__((ext_vector_type(4)));
typedef float f32x2 __attribute__((ext_vector_type(2)));
typedef short bf16x8 __attribute__((ext_vector_type(8)));
typedef short s16x4 __attribute__((ext_vector_type(4)));
typedef GAS unsigned gu32;
#define RLX_AGENT __ATOMIC_RELAXED, __HIP_MEMORY_SCOPE_AGENT
#define LDS_WAIT() asm volatile("s_waitcnt lgkmcnt(0)" ::: "memory")
#define VM_WAIT() asm volatile("s_waitcnt vmcnt(0)" ::: "memory")
__device__ __forceinline__ unsigned f2bf(float f) { unsigned u = __builtin_bit_cast(unsigned, f); return (u + 0x7fffu + ((u >> 16) & 1u)) >> 16; }
__device__ __forceinline__ unsigned pk2(float lo, float hi) { return f2bf(lo) | (f2bf(hi) << 16); }
__device__ __forceinline__ float bf2f(unsigned short b) { return __builtin_bit_cast(float, (unsigned)b << 16); }
__device__ __forceinline__ float bflo(unsigned w) { return __builtin_bit_cast(float, w << 16); }
__device__ __forceinline__ float bfhi(unsigned w) { return __builtin_bit_cast(float, w & 0xffff0000u); }
__device__ __forceinline__ float sigmoidf_fast(float x) { return __builtin_amdgcn_rcpf(1.0f + __builtin_amdgcn_exp2f(-1.4426950408889634f * x)); }

namespace pg8 {
#define PG8_LAS __attribute__((address_space(3)))
#if defined(PROBE_EPI2)
#define PROBE_EPI_DUP if constexpr (Epi::PERM) E(acc, cur, wr, wc, fr, fq);
#else
#define PROBE_EPI_DUP
#endif
typedef unsigned short bf16_t;
typedef short bf16x8 __attribute__((ext_vector_type(8)));
typedef float f32x4 __attribute__((ext_vector_type(4)));
typedef unsigned u32x4 __attribute__((ext_vector_type(4)));
constexpr int BM = 256, BK = 64, HALF = 128, HTB = HALF * BK * 2  , STAGE_BYTES = 8 * HTB, NXCD = 8, WGM = 8;

__host__ __device__ __forceinline__ int lds_byte(int r, int c) { const int st = (r >> 4) * 2 + (c >> 5), rr = r & 15, cc = c & 31, ob = rr * 64 + cc * 2; return st * 1024 + (ob ^ (((ob >> 9) & 1) << 5)); }
__host__ __device__ __forceinline__ void stage_rc(int b, int& R, int& C) { const int st = b / 1024, sb = b % 1024, swz = sb ^ (((sb >> 9) & 1) << 5); R = (st >> 1) * 16 + swz / 64; C = (st & 1) * 32 + (swz % 64) / 2; }
__host__ __device__ __forceinline__ int perm32(int rho) { const int n = rho >> 4, i = rho & 15; return 8 * (i >> 2) + 4 * n + (i & 3); }

struct Unit { int pm, pn; };
struct Gemm { const bf16_t* A; const bf16_t* Bt; int M, N, K, lda, ldb, sa; };
__host__ __device__ __forceinline__ Gemm mkgemm(const bf16_t* A, const bf16_t* Bt, int M, int N, int K) { Gemm g; g.A = A; g.Bt = Bt; g.M = M; g.N = N; g.K = K; g.lda = K; g.ldb = K; g.sa = 0x7F7F7F7F; return g; }

struct StaticOrder {
    int nM, nN, nwg, G, c, wgm;
    __host__ __device__ void init(int M, int N, int G_, int c_, int wgm_ = WGM) { nM = M / BM; nN = N / BM; nwg = nM * nN; G = G_; c = c_; wgm = wgm_; }
    __host__ __device__ bool next(int i, Unit& u) const {
        const long L = (long)i * G + c; if (L >= nwg) return false;
        int wgid = (int)L; { const int q = nwg / NXCD, r = nwg % NXCD, xcd = wgid % NXCD, off = wgid / NXCD; wgid = (xcd < r ? xcd * (q + 1) : r * (q + 1) + (xcd - r) * q) + off; }
        const int nig = wgm * nN, gid = wgid / nig, fm = gid * wgm, gsz = (nM - fm) < wgm ? (nM - fm) : wgm;
        u.pm = fm + ((wgid % nig) % gsz); u.pn = (wgid % nig) / gsz; return true;
    }
    __device__ __forceinline__ void a_ready(const Unit&) const {}
    __device__ __forceinline__ void done(const Unit&) const {}
};
struct DynOrder {
    int nM, nN, nwg; unsigned* ctr; PG8_LAS unsigned* slot;
    __device__ __forceinline__ bool next(int, Unit& u) const {
        __syncthreads();
        if (wg_tid() == 0) *slot = __hip_atomic_fetch_add(ctr, 1u, __ATOMIC_RELAXED, __HIP_MEMORY_SCOPE_AGENT);
        __syncthreads();
        const unsigned t = *(volatile PG8_LAS unsigned*)slot;
        if (t >= (unsigned)nwg) return false;
        u.pm = (int)(t / (unsigned)nN); u.pn = (int)(t % (unsigned)nN); return true;
    }
    __device__ __forceinline__ void a_ready(const Unit&) const {}
    __device__ __forceinline__ void done(const Unit&) const {}
};
struct RangeOrder { StaticOrder S; int i0, i1;
    __host__ __device__ bool next(int i, Unit& u) const { return (i + i0 < i1) ? S.next(i + i0, u) : false; }
    __device__ __forceinline__ void a_ready(const Unit&) const {}
    __device__ __forceinline__ void done(const Unit&) const {} };


__device__ __forceinline__ unsigned cvt_pk_bf16(float lo, float hi) { unsigned r; asm volatile("v_cvt_pk_bf16_f32 %0, %1, %2" : "=v"(r) : "v"(lo), "v"(hi)); return r; }
__device__ __forceinline__ float sigm(float x) { return __builtin_amdgcn_rcpf(1.0f + __builtin_amdgcn_exp2f(-1.4426950408889634f * x)); }

typedef unsigned long long rs_t;
constexpr float RS_FIX = 16777216.0f, RS_INV = 1.0f / (16777216.0f * 4096.0f), RS_EPS = 1e-6f;
__device__ __forceinline__ void row_ss_add(rs_t* rs, int row, float s, int fq) {
    s += __shfl_xor(s, 16); s += __shfl_xor(s, 32);
    if (fq == 0) __hip_atomic_fetch_add(rs + row, (rs_t)(s * RS_FIX), __ATOMIC_RELAXED, __HIP_MEMORY_SCOPE_AGENT);
}
__device__ __forceinline__ float rs_rinv(rs_t v) { return __builtin_amdgcn_rsqf((float)v * RS_INV + RS_EPS); }
#define PIN8(a) asm volatile("" : "+v"((a)[0]), "+v"((a)[1]), "+v"((a)[2]), "+v"((a)[3]), "+v"((a)[4]), "+v"((a)[5]), "+v"((a)[6]), "+v"((a)[7]))
template <int ACT> struct EpiBf16 {
    static constexpr bool PERM = true, AFTER_DRAIN = false;
    bf16_t *O0, *O1, *O2; int ld0, ld1, ld2, c1, c2; const rs_t* rs; int vt; int rs_from;
    __device__ __forceinline__ void operator()(const f32x4 (&acc)[2][2][4][2], const Unit& u, int wr, int wc, int fr, int fq) const {
        const int row0 = u.pm * BM + wr * 64 + fr; int colt = u.pn * BM; bf16_t* base = O0; int ldc = ld0;
        const rs_t* rs = (colt >= rs_from) ? this->rs : nullptr;
        bool tr = false;
        if (colt >= c2) { base = O2; ldc = ld2; colt -= c2; tr = vt != 0; } else if (colt >= c1) { base = O1; ldc = ld1; colt -= c1; }
        const int col0 = colt + wc * 32 + 8 * fq;
        rs_t scv[8];
#pragma unroll
        for (int gi = 0; gi < 8; ++gi) scv[gi] = rs ? rs[row0 + (gi >> 2) * HALF + (gi & 3) * 16] : 0ull;
        PIN8(scv);
#pragma unroll
        for (int ai = 0; ai < 2; ++ai)
#pragma unroll
            for (int m = 0; m < 4; ++m) { bf16_t* rowp = base + (size_t)(row0 + ai * HALF + m * 16) * ldc + col0; const float sc = rs ? rs_rinv(scv[ai * 4 + m]) : 1.0f;
#pragma unroll
                for (int bj = 0; bj < 2; ++bj) { f32x4 v0 = acc[ai][bj][m][0] * sc, v1 = acc[ai][bj][m][1] * sc;
                    if (ACT == 2) {
#pragma unroll
                        for (int j = 0; j < 4; ++j) { const float a = fmaxf(v0[j], 0.f), b = fmaxf(v1[j], 0.f); v0[j] = a * a; v1[j] = b * b; } }
                    u32x4 w; w.x = cvt_pk_bf16(v0[0], v0[1]); w.y = cvt_pk_bf16(v0[2], v0[3]); w.z = cvt_pk_bf16(v1[0], v1[1]); w.w = cvt_pk_bf16(v1[2], v1[3]);
                    if (vt == 2 && tr) {
                        unsigned char* tp = (unsigned char*)base + (size_t)(col0 + bj * HALF) * ldc + (row0 + ai * HALF + m * 16);
                        int w0 = __builtin_amdgcn_cvt_pk_fp8_f32(v0[0], v0[1], 0, false); w0 = __builtin_amdgcn_cvt_pk_fp8_f32(v0[2], v0[3], w0, true);
                        int w1 = __builtin_amdgcn_cvt_pk_fp8_f32(v1[0], v1[1], 0, false); w1 = __builtin_amdgcn_cvt_pk_fp8_f32(v1[2], v1[3], w1, true);
                        tp[0] = (unsigned char)w0; tp[(size_t)ldc] = (unsigned char)(w0 >> 8); tp[(size_t)2 * ldc] = (unsigned char)(w0 >> 16); tp[(size_t)3 * ldc] = (unsigned char)(w0 >> 24);
                        tp[(size_t)4 * ldc] = (unsigned char)w1; tp[(size_t)5 * ldc] = (unsigned char)(w1 >> 8); tp[(size_t)6 * ldc] = (unsigned char)(w1 >> 16); tp[(size_t)7 * ldc] = (unsigned char)(w1 >> 24); }
                    else if (tr) { bf16_t* tp = base + (size_t)(col0 + bj * HALF) * ldc + (row0 + ai * HALF + m * 16);
                        tp[0] = (bf16_t)w.x; tp[(size_t)ldc] = (bf16_t)(w.x >> 16); tp[(size_t)2 * ldc] = (bf16_t)w.y; tp[(size_t)3 * ldc] = (bf16_t)(w.y >> 16);
                        tp[(size_t)4 * ldc] = (bf16_t)w.z; tp[(size_t)5 * ldc] = (bf16_t)(w.z >> 16); tp[(size_t)6 * ldc] = (bf16_t)w.w; tp[(size_t)7 * ldc] = (bf16_t)(w.w >> 16); }
                    else *(u32x4*)(rowp + bj * HALF) = w; } }
    }
};
struct EpiF32 {
    static constexpr bool PERM = false, AFTER_DRAIN = false;
    float* C; int ldc;
    __device__ __forceinline__ void operator()(const f32x4 (&acc)[2][2][4][2], const Unit& u, int wr, int wc, int fr, int fq) const {
        const int row0 = u.pm * BM + wr * 64 + fr, col0 = u.pn * BM + wc * 32 + 4 * fq;
#pragma unroll
        for (int ai = 0; ai < 2; ++ai)
#pragma unroll
            for (int m = 0; m < 4; ++m) { float* rowp = C + (size_t)(row0 + ai * HALF + m * 16) * ldc + col0;
#pragma unroll
                for (int bj = 0; bj < 2; ++bj)
#pragma unroll
                    for (int n = 0; n < 2; ++n) *(f32x4*)(rowp + bj * HALF + n * 16) = acc[ai][bj][m][n]; }
    }
};
typedef unsigned u32x2 __attribute__((ext_vector_type(2)));
__device__ __forceinline__ f32x4 bf4_to_f32(u32x2 p) { return (f32x4){__builtin_bit_cast(float, p.x << 16), __builtin_bit_cast(float, p.x & 0xffff0000u), __builtin_bit_cast(float, p.y << 16), __builtin_bit_cast(float, p.y & 0xffff0000u)}; }
struct EpiRes {
    static constexpr bool PERM = false, AFTER_DRAIN = false;
    const bf16_t* base; bf16_t* out; rs_t* rs; int ldc; const rs_t* rsq;
    __device__ __forceinline__ void operator()(const f32x4 (&acc)[2][2][4][2], const Unit& u, int wr, int wc, int fr, int fq) const {
        constexpr int PD = 3;
        const int row0 = u.pm * BM + wr * 64 + fr, col0 = u.pn * BM + wc * 32 + 4 * fq;
        u32x2 nb[8][2][2];
        rs_t scv[8];
#pragma unroll
        for (int gi = 0; gi < 8; ++gi) scv[gi] = rsq ? rsq[row0 + (gi >> 2) * HALF + (gi & 3) * 16] : 0ull;
#define EPI_LD(g) do { const size_t o_ = (size_t)(row0 + ((g) >> 2) * HALF + ((g) & 3) * 16) * ldc + col0; _Pragma("unroll") for (int bj = 0; bj < 2; ++bj) _Pragma("unroll") for (int n = 0; n < 2; ++n) nb[g][bj][n] = *(const u32x2*)(base + o_ + bj * HALF + n * 16); } while (0)
#pragma unroll
        for (int g = 0; g < PD; ++g) EPI_LD(g);
        PIN8(scv);
#pragma unroll
        for (int gi = 0; gi < 8; ++gi) { const int ai = gi >> 2, m = gi & 3; const int row = row0 + ai * HALF + m * 16; const size_t off = (size_t)row * ldc + col0;
            if (gi + PD < 8) EPI_LD(gi + PD);
            const float sc2 = rsq ? __builtin_amdgcn_rcpf((float)scv[gi] * RS_INV + RS_EPS) : 1.0f;
            float ss = 0.f;
#pragma unroll
            for (int bj = 0; bj < 2; ++bj)
#pragma unroll
                for (int n = 0; n < 2; ++n) { const f32x4 o = bf4_to_f32(nb[gi][bj][n]) + acc[ai][bj][m][n] * sc2;
                    ss += (o[0] * o[0] + o[1] * o[1]) + (o[2] * o[2] + o[3] * o[3]);
                    u32x2 w; w.x = cvt_pk_bf16(o[0], o[1]); w.y = cvt_pk_bf16(o[2], o[3]); *(u32x2*)(out + off + bj * HALF + n * 16) = w; }
            row_ss_add(rs, row, ss, fq); }
#undef EPI_LD
    }
};
struct EpiGate {
    static constexpr bool PERM = false, AFTER_DRAIN = false;
    const bf16_t* base; bf16_t* out; float* out32; const bf16_t* pp; const rs_t* rsin; rs_t* rs; int ldc; unsigned char* out8;
    __device__ __forceinline__ void operator()(const f32x4 (&acc)[2][2][4][2], const Unit& u, int wr, int wc, int fr, int fq) const {
        constexpr int PD = 2;
        const int row0 = u.pm * BM + wr * 64 + fr, col0 = u.pn * BM + wc * 32 + 4 * fq;
        rs_t scv[8];
#pragma unroll
        for (int gi = 0; gi < 8; ++gi) scv[gi] = rsin[row0 + (gi >> 2) * HALF + (gi & 3) * 16];
        u32x2 nb[8][2][2], np[8][2][2];
#define EPI_LD(g) do { const size_t o_ = (size_t)(row0 + ((g) >> 2) * HALF + ((g) & 3) * 16) * ldc + col0; _Pragma("unroll") for (int bj = 0; bj < 2; ++bj) _Pragma("unroll") for (int n = 0; n < 2; ++n) { \
            nb[g][bj][n] = *(const u32x2*)(base + o_ + bj * HALF + n * 16); np[g][bj][n] = *(const u32x2*)(pp + o_ + bj * HALF + n * 16); } } while (0)
#pragma unroll
        for (int g = 0; g < PD; ++g) EPI_LD(g);
        PIN8(scv);
#pragma unroll
        for (int gi = 0; gi < 8; ++gi) { const int ai = gi >> 2, m = gi & 3; const int row = row0 + ai * HALF + m * 16; const size_t off = (size_t)row * ldc + col0;
            if (gi + PD < 8) EPI_LD(gi + PD);
            const float sc = rs_rinv(scv[gi]);
            float ss = 0.f;
#pragma unroll
            for (int bj = 0; bj < 2; ++bj)
#pragma unroll
                for (int n = 0; n < 2; ++n) { const f32x4 a = acc[ai][bj][m][n] * sc, p = bf4_to_f32(np[gi][bj][n]); f32x4 o = bf4_to_f32(nb[gi][bj][n]);
#pragma unroll
                    for (int j = 0; j < 4; ++j) o[j] += sigm(a[j]) * p[j];
                    if (out32) *(f32x4*)(out32 + off + bj * HALF + n * 16) = o;
                    if (out8) { int w8 = __builtin_amdgcn_cvt_pk_fp8_f32(o[0], o[1], 0, false); w8 = __builtin_amdgcn_cvt_pk_fp8_f32(o[2], o[3], w8, true); *(unsigned*)(out8 + off + bj * HALF + n * 16) = (unsigned)w8; }
                    ss += (o[0] * o[0] + o[1] * o[1]) + (o[2] * o[2] + o[3] * o[3]);
                    u32x2 w; w.x = cvt_pk_bf16(o[0], o[1]); w.y = cvt_pk_bf16(o[2], o[3]); *(u32x2*)(out + off + bj * HALF + n * 16) = w; }
            row_ss_add(rs, row, ss, fq); }
#undef EPI_LD
    }
};
struct EpiGlu {
    static constexpr bool PERM = false, AFTER_DRAIN = false;
    const bf16_t* base; bf16_t* out; rs_t* rs; int ldc;
    __device__ __forceinline__ void operator()(const f32x4 (&acc)[2][2][4][2], const Unit& u, int wr, int wc, int fr, int fq) const {
        constexpr int PD = 3;
        const int row0 = u.pm * BM + wr * 64 + fr, col0 = u.pn * HALF + wc * 32 + 4 * fq;
        u32x2 nb[8][2];
#define EPI_LD(g) do { const size_t o_ = (size_t)(row0 + ((g) >> 2) * HALF + ((g) & 3) * 16) * ldc + col0; _Pragma("unroll") for (int n = 0; n < 2; ++n) nb[g][n] = *(const u32x2*)(base + o_ + n * 16); } while (0)
#pragma unroll
        for (int g = 0; g < PD; ++g) EPI_LD(g);
#pragma unroll
        for (int gi = 0; gi < 8; ++gi) { const int ai = gi >> 2, m = gi & 3; const int row = row0 + ai * HALF + m * 16; const size_t off = (size_t)row * ldc + col0;
            if (gi + PD < 8) EPI_LD(gi + PD);
            float ss = 0.f;
#pragma unroll
            for (int n = 0; n < 2; ++n) { const f32x4 a = acc[ai][0][m][n], g = acc[ai][1][m][n]; f32x4 o = bf4_to_f32(nb[gi][n]);
#pragma unroll
                for (int j = 0; j < 4; ++j) o[j] += a[j] * sigm(g[j]);
                ss += (o[0] * o[0] + o[1] * o[1]) + (o[2] * o[2] + o[3] * o[3]);
                u32x2 w; w.x = cvt_pk_bf16(o[0], o[1]); w.y = cvt_pk_bf16(o[2], o[3]); *(u32x2*)(out + off + n * 16) = w; }
            row_ss_add(rs, row, ss, fq); }
#undef EPI_LD
    }
};

constexpr int S5T = 32, S5NCH = 512, S5KS = 768;
struct S5Order {
    int G, c, MT, NT;
    __device__ __forceinline__ bool next(int i, Unit& u) const { const int idx = i * G + c; if (idx >= 256 * MT * NT) return false; const int g = idx & 255, sub = idx >> 8;
        u.pm = g * MT + sub / NT; u.pn = g * NT + sub % NT; return true; }
    __device__ __forceinline__ void a_ready(const Unit&) const {}
    __device__ __forceinline__ void done(const Unit&) const {}
};
struct EpiS5U {
    static constexpr bool PERM = true, AFTER_DRAIN = false;
    bf16_t* UA; const rs_t* rs;
    __device__ __forceinline__ void operator()(const f32x4 (&acc)[2][2][4][2], const Unit& u, int wr, int wc, int fr, int fq) const {
        const int row0 = u.pm * BM + wr * 64 + fr, col0 = u.pn * BM + wc * 32 + 8 * fq;
        rs_t scv[8];
#pragma unroll
        for (int gi = 0; gi < 8; ++gi) scv[gi] = rs[row0 + (gi >> 2) * HALF + (gi & 3) * 16];
        PIN8(scv);
#pragma unroll
        for (int ai = 0; ai < 2; ++ai)
#pragma unroll
            for (int m = 0; m < 4; ++m) { const int t = row0 + ai * HALF + m * 16, c = t >> 5, sg = t & 31; const float sc = rs_rinv(scv[ai * 4 + m]);
#pragma unroll
                for (int bj = 0; bj < 2; ++bj) { const int col = col0 + bj * HALF, g = col >> 4, q0 = col & 15;
                    const f32x4 v0 = acc[ai][bj][m][0] * sc, v1 = acc[ai][bj][m][1] * sc;
                    u32x4 w; w.x = cvt_pk_bf16(v0[0], v0[1]); w.y = cvt_pk_bf16(v0[2], v0[3]); w.z = cvt_pk_bf16(v1[0], v1[1]); w.w = cvt_pk_bf16(v1[2], v1[3]);
                    *(u32x4*)(UA + ((size_t)(g * S5NCH + c) * S5KS + sg * 16 + q0)) = w; } }
    }
};
struct EpiS5E {
    static constexpr bool PERM = false, AFTER_DRAIN = false;
    float* E;
    __device__ __forceinline__ void operator()(const f32x4 (&acc)[2][2][4][2], const Unit& u, int wr, int wc, int fr, int fq) const {
        const int row0 = u.pm * BM + wr * 64 + fr, col0 = wc * 32 + 4 * fq;
#pragma unroll
        for (int ai = 0; ai < 2; ++ai)
#pragma unroll
            for (int m = 0; m < 4; ++m) { float* rowp = E + (size_t)(row0 + ai * HALF + m * 16) * 256 + col0;
#pragma unroll
                for (int bj = 0; bj < 2; ++bj)
#pragma unroll
                    for (int n = 0; n < 2; ++n) *(f32x4*)(rowp + bj * HALF + n * 16) = acc[ai][bj][m][n]; }
    }
};
__device__ __forceinline__ float gelu_tanh_f(float v) {
    const float z = 0.7978845608028654f * (v + 0.044715f * v * v * v);
    const float e = __builtin_amdgcn_exp2f(2.0f * 1.4426950408889634f * z);
    return 0.5f * v * (2.0f - 2.0f * __builtin_amdgcn_rcpf(e + 1.0f));
}
struct EpiS5Y {
    static constexpr bool PERM = true, AFTER_DRAIN = false;
    const bf16_t* UA; const float* dskip; bf16_t* G; int ldg;
    __device__ __forceinline__ void operator()(const f32x4 (&acc)[2][2][4][2], const Unit& u, int wr, int wc, int fr, int fq) const {
        const int row0 = u.pm * BM + wr * 64 + fr, col0 = (u.pn & 1) * BM + wc * 32 + 8 * fq;
        const int g = u.pm >> 1, p0 = col0 & 15;
        const f32x4 d0 = *(const f32x4*)(dskip + 16 * g + p0), d1 = *(const f32x4*)(dskip + 16 * g + p0 + 4);
        u32x4 uu[8][2];
#pragma unroll
        for (int gi = 0; gi < 8; ++gi)
#pragma unroll
            for (int bj = 0; bj < 2; ++bj) uu[gi][bj] = *(const u32x4*)(UA + ((size_t)(row0 + (gi >> 2) * HALF + (gi & 3) * 16) * S5KS + col0 + bj * HALF));
#pragma unroll
        for (int gi = 0; gi < 8; ++gi) asm volatile("" : "+v"(uu[gi][0]), "+v"(uu[gi][1]));
#pragma unroll
        for (int gi = 0; gi < 8; ++gi) { const int ai = gi >> 2, m = gi & 3; const int rowg = row0 + ai * HALF + m * 16, c = rowg & 511;
#pragma unroll
            for (int bj = 0; bj < 2; ++bj) { const int col = col0 + bj * HALF, tau = col >> 4; const u32x4 w4 = uu[gi][bj];
                f32x4 v0 = acc[ai][bj][m][0], v1 = acc[ai][bj][m][1];
                v0[0] += d0[0] * __builtin_bit_cast(float, w4.x << 16); v0[1] += d0[1] * __builtin_bit_cast(float, w4.x & 0xffff0000u);
                v0[2] += d0[2] * __builtin_bit_cast(float, w4.y << 16); v0[3] += d0[3] * __builtin_bit_cast(float, w4.y & 0xffff0000u);
                v1[0] += d1[0] * __builtin_bit_cast(float, w4.z << 16); v1[1] += d1[1] * __builtin_bit_cast(float, w4.z & 0xffff0000u);
                v1[2] += d1[2] * __builtin_bit_cast(float, w4.w << 16); v1[3] += d1[3] * __builtin_bit_cast(float, w4.w & 0xffff0000u);
#pragma unroll
                for (int j = 0; j < 4; ++j) { v0[j] = gelu_tanh_f(v0[j]); v1[j] = gelu_tanh_f(v1[j]); }
                int w0 = __builtin_amdgcn_cvt_pk_fp8_f32(16.f * v0[0], 16.f * v0[1], 0, false); w0 = __builtin_amdgcn_cvt_pk_fp8_f32(16.f * v0[2], 16.f * v0[3], w0, true);
                int w1 = __builtin_amdgcn_cvt_pk_fp8_f32(16.f * v1[0], 16.f * v1[1], 0, false); w1 = __builtin_amdgcn_cvt_pk_fp8_f32(16.f * v1[2], 16.f * v1[3], w1, true);
                *(v2u*)((unsigned char*)G + (size_t)(32 * c + tau) * ldg + 16 * g + p0) = (v2u){(unsigned)w0, (unsigned)w1}; } }
    }
};

template <class Epi, class Sched, bool ALIGN_EPI = false, bool SP2 = false, bool FP8 = false>
__device__ __forceinline__ void gemm_phase(PG8_LAS unsigned char* lds, const Gemm g, const Sched& S, const Epi& E) {
    int tid_o = wg_tid(); asm volatile("" : "+v"(tid_o)); const int tid = tid_o, wid = __builtin_amdgcn_readfirstlane(tid >> 6), lane = tid & 63, wr = wid >> 2, wc = wid & 3, fr = lane & 15, fq = lane >> 4;
    const int K = g.K, nt = K / BK;
    unsigned voffA[2], voffB[2];
#pragma unroll
    for (int i = 0; i < 2; ++i) { int R, C; stage_rc(tid * 16 + i * 8192, R, C); const int Rb = Epi::PERM ? ((R & ~31) + perm32(R & 31)) : R;
        voffA[i] = (unsigned)(R * g.lda + C) * 2u; voffB[i] = (unsigned)(Rb * g.ldb + C) * 2u; }
    const size_t kstep = (size_t)(BK * 2);
    const size_t hstepA = (size_t)HALF * g.lda * 2, hstepB = (size_t)HALF * g.ldb * 2;
    const size_t tstepA = 2 * hstepA, tstepB = 2 * hstepB;
    const unsigned ldsw = (unsigned)wid * 1024u;
    const int aoff = lds_byte(wr * 64 + fr, fq * 8), boff = lds_byte(wc * 32 + fr, fq * 8);
    const int aoff8 = lds_byte(wr * 64 + fr, fq * 16), boff8 = lds_byte(wc * 32 + fr, fq * 16);
#define PG8_SA(b, h) (((b) * 2 + (h)) * HTB)
#define PG8_SB(b, h) ((4 + (b) * 2 + (h)) * HTB)
#define PG8_STAGE(bufoff, gbase, voff) do { _Pragma("unroll") for (int _i = 0; _i < 2; ++_i) \
        __builtin_amdgcn_global_load_lds((const unsigned*)((const char*)(gbase) + (voff)[_i]), (PG8_LAS unsigned*)(lds + (bufoff) + ldsw + _i * 8192), 16, 0, 0); } while (0)
#define PG8_LDA(dst, b, h) do { if constexpr (FP8) { _Pragma("unroll") for (int m = 0; m < 4; ++m) { const PG8_LAS unsigned char* p_ = lds + PG8_SA(b, h) + aoff8 + m * 2048; const v4i32 l_ = *(const PG8_LAS v4i32*)p_, h_ = *(const PG8_LAS v4i32*)(p_ + 16); \
        dst##8[m] = __builtin_shufflevector(l_, h_, 0, 1, 2, 3, 4, 5, 6, 7); } } else { \
        _Pragma("unroll") for (int m = 0; m < 4; ++m) _Pragma("unroll") for (int k = 0; k < 2; ++k) dst[m][k] = *(const PG8_LAS bf16x8*)(lds + PG8_SA(b, h) + aoff + m * 2048 + k * 1024); } } while (0)
#define PG8_LDB(dst, b, h) do { if constexpr (FP8) { _Pragma("unroll") for (int n = 0; n < 2; ++n) { const PG8_LAS unsigned char* p_ = lds + PG8_SB(b, h) + boff8 + n * 2048; const v4i32 l_ = *(const PG8_LAS v4i32*)p_, h_ = *(const PG8_LAS v4i32*)(p_ + 16); \
        dst##8[n] = __builtin_shufflevector(l_, h_, 0, 1, 2, 3, 4, 5, 6, 7); } } else { \
        _Pragma("unroll") for (int n = 0; n < 2; ++n) _Pragma("unroll") for (int k = 0; k < 2; ++k) dst[n][k] = *(const PG8_LAS bf16x8*)(lds + PG8_SB(b, h) + boff + n * 2048 + k * 1024); } } while (0)
#define PG8_MMA(ai, bj, At, Bt) do { __builtin_amdgcn_s_setprio(1); if constexpr (FP8) { _Pragma("unroll") for (int m = 0; m < 4; ++m) _Pragma("unroll") for (int n = 0; n < 2; ++n) \
        asm volatile("v_mfma_scale_f32_16x16x128_f8f6f4 %0, %1, %2, %0, %3, %4 op_sel_hi:[0,0,0]" : "+v"(acc[ai][bj][m][n]) : "v"(Bt##8[n]), "v"(At##8[m]), "v"(sc_w8), "v"(sc_a8)); } else { \
        _Pragma("unroll") for (int m = 0; m < 4; ++m) _Pragma("unroll") for (int n = 0; n < 2; ++n) _Pragma("unroll") for (int k = 0; k < 2; ++k) \
        acc[ai][bj][m][n] = __builtin_amdgcn_mfma_f32_16x16x32_bf16(Bt[n][k], At[m][k], acc[ai][bj][m][n], 0, 0, 0); } __builtin_amdgcn_s_setprio(0); } while (0)
#define PG8_WAIT_V(n) asm volatile("s_waitcnt vmcnt(" #n ")" ::: "memory")
#define PG8_WAIT_L(n) asm volatile("s_waitcnt lgkmcnt(" #n ")" ::: "memory")
#define PG8_BAR __builtin_amdgcn_s_barrier()
#define PG8_SCHED __builtin_amdgcn_sched_barrier(0)
    Unit cur, nxt; int ui = 0;
    if (!S.next(0, cur)) return;
    f32x4 acc[2][2][4][2];
#pragma unroll
    for (int a = 0; a < 2; ++a)
#pragma unroll
        for (int b = 0; b < 2; ++b)
#pragma unroll
            for (int m = 0; m < 4; ++m)
#pragma unroll
                for (int n = 0; n < 2; ++n) acc[a][b][m][n] = (f32x4){0.f, 0.f, 0.f, 0.f};
    bf16x8 At[4][2], B0[2][2], B1[2][2];
    typedef int v8i32 __attribute__((ext_vector_type(8))); typedef int v4i32 __attribute__((ext_vector_type(4))); v8i32 At8[4], B08[2], B18[2];
    const int sc_w8 = 0x79797979, sc_a8 = g.sa;
    const char* cA = (const char*)g.A + (size_t)cur.pm * tstepA; const char* cB = (const char*)g.Bt + (size_t)cur.pn * tstepB;
    S.a_ready(cur);
    if constexpr (SP2) {
        PG8_STAGE(PG8_SB(0, 0), cB, voffB); PG8_STAGE(PG8_SB(0, 1), cB + hstepB, voffB); PG8_STAGE(PG8_SA(0, 0), cA, voffA); PG8_STAGE(PG8_SA(0, 1), cA + hstepA, voffA);
        if (wr == 1) PG8_BAR;
        PG8_WAIT_V(2); PG8_BAR;
        PG8_STAGE(PG8_SB(1, 0), cB + kstep, voffB); PG8_STAGE(PG8_SA(1, 0), cA + kstep, voffA); PG8_STAGE(PG8_SB(1, 1), cB + hstepB + kstep, voffB);
        PG8_WAIT_V(6); PG8_BAR;
    } else {
        PG8_STAGE(PG8_SB(0, 0), cB, voffB); PG8_STAGE(PG8_SA(0, 0), cA, voffA); PG8_STAGE(PG8_SB(0, 1), cB + hstepB, voffB); PG8_STAGE(PG8_SA(0, 1), cA + hstepA, voffA);
        if (wr == 1) PG8_BAR;
        PG8_WAIT_V(4); PG8_BAR;
        PG8_STAGE(PG8_SB(1, 0), cB + kstep, voffB); PG8_STAGE(PG8_SA(1, 0), cA + kstep, voffA); PG8_STAGE(PG8_SB(1, 1), cB + hstepB + kstep, voffB);
        PG8_WAIT_V(6); PG8_BAR;
    }
    for (;;) {
        const bool has_next = S.next(ui + 1, nxt);
        const char* nA = has_next ? (const char*)g.A + (size_t)nxt.pm * tstepA : cA; const char* nB = has_next ? (const char*)g.Bt + (size_t)nxt.pn * tstepB : cB;
        for (int t = 0; t < nt; t += 2) {
            const bool last = (t == nt - 2);
            const char* a1 = cA + (size_t)(t + 1) * kstep;
            const char* a2 = last ? nA : cA + (size_t)(t + 2) * kstep; const char* b2 = last ? nB : cB + (size_t)(t + 2) * kstep;
            const char* a3 = a2 + kstep; const char* b3 = b2 + kstep;
            if (last && has_next) S.a_ready(nxt);
            if constexpr (SP2) {
            PG8_LDB(B0, 0, 0); PG8_LDB(B1, 0, 1); PG8_SCHED; PG8_LDA(At, 0, 0); PG8_STAGE(PG8_SA(1, 1), a1 + hstepA, voffA);
            PG8_WAIT_V(8); PG8_WAIT_L(0); PG8_BAR; PG8_MMA(0, 0, At, B0); PG8_MMA(0, 1, At, B1); PG8_BAR; PG8_SCHED;
            PG8_LDA(At, 0, 1); PG8_STAGE(PG8_SB(0, 0), b2, voffB); PG8_STAGE(PG8_SB(0, 1), b2 + hstepB, voffB); PG8_STAGE(PG8_SA(0, 0), a2, voffA);
            PG8_WAIT_V(8); PG8_WAIT_L(0); PG8_BAR; PG8_MMA(1, 0, At, B0); PG8_MMA(1, 1, At, B1); PG8_BAR; PG8_SCHED;
            PG8_LDB(B0, 1, 0); PG8_LDB(B1, 1, 1); PG8_SCHED; PG8_LDA(At, 1, 0); PG8_STAGE(PG8_SA(0, 1), a2 + hstepA, voffA);
            PG8_WAIT_V(8); PG8_WAIT_L(0); PG8_BAR; PG8_MMA(0, 0, At, B0); PG8_MMA(0, 1, At, B1); PG8_BAR; PG8_SCHED;
            PG8_LDA(At, 1, 1); PG8_STAGE(PG8_SB(1, 0), b3, voffB); PG8_STAGE(PG8_SB(1, 1), b3 + hstepB, voffB); PG8_STAGE(PG8_SA(1, 0), a3, voffA);
            PG8_WAIT_V(8); PG8_WAIT_L(0); PG8_BAR; PG8_MMA(1, 0, At, B0); PG8_MMA(1, 1, At, B1); PG8_BAR; PG8_SCHED;
            } else {
            PG8_LDB(B0, 0, 0); PG8_SCHED; PG8_LDA(At, 0, 0); PG8_STAGE(PG8_SA(1, 1), a1 + hstepA, voffA);
            PG8_WAIT_L(8); PG8_BAR; PG8_WAIT_L(0); PG8_MMA(0, 0, At, B0); PG8_BAR; PG8_SCHED;
            PG8_LDB(B1, 0, 1); PG8_STAGE(PG8_SB(0, 0), b2, voffB);
            PG8_BAR; PG8_WAIT_L(0); PG8_MMA(0, 1, At, B1); PG8_BAR;
            PG8_LDA(At, 0, 1); PG8_STAGE(PG8_SA(0, 0), a2, voffA);
            PG8_BAR; PG8_WAIT_L(0); PG8_MMA(1, 0, At, B0); PG8_BAR; PG8_SCHED;
            PG8_STAGE(PG8_SB(0, 1), b2 + hstepB, voffB);
            PG8_WAIT_V(6); PG8_BAR; PG8_MMA(1, 1, At, B1); PG8_BAR;
            PG8_LDB(B0, 1, 0); PG8_SCHED; PG8_LDA(At, 1, 0); PG8_STAGE(PG8_SA(0, 1), a2 + hstepA, voffA);
            PG8_WAIT_L(8); PG8_BAR; PG8_WAIT_L(0); PG8_MMA(0, 0, At, B0); PG8_BAR; PG8_SCHED;
            PG8_LDB(B1, 1, 1); PG8_STAGE(PG8_SB(1, 0), b3, voffB);
            PG8_BAR; PG8_WAIT_L(0); PG8_MMA(0, 1, At, B1); PG8_BAR;
            PG8_LDA(At, 1, 1); PG8_STAGE(PG8_SA(1, 0), a3, voffA);
            PG8_BAR; PG8_WAIT_L(0); PG8_MMA(1, 0, At, B0); PG8_BAR; PG8_SCHED;
            PG8_STAGE(PG8_SB(1, 1), b3 + hstepB, voffB);
            PG8_WAIT_V(6); PG8_BAR; PG8_MMA(1, 1, At, B1); PG8_BAR;
            }
        }
        if constexpr (FP8) asm volatile("s_nop 15\n\ts_nop 7" ::: "memory");
        if constexpr (ALIGN_EPI) { if (wr == 0) PG8_BAR; }
        if constexpr (!Epi::AFTER_DRAIN) { E(acc, cur, wr, wc, fr, fq); PROBE_EPI_DUP S.done(cur); }
        if (!has_next) break;
#pragma unroll
        for (int a = 0; a < 2; ++a)
#pragma unroll
            for (int b = 0; b < 2; ++b)
#pragma unroll
                for (int m = 0; m < 4; ++m)
#pragma unroll
                    for (int n = 0; n < 2; ++n) acc[a][b][m][n] = (f32x4){0.f, 0.f, 0.f, 0.f};
        cur = nxt; cA = nA; cB = nB; ++ui;
        if constexpr (ALIGN_EPI) { if (wr == 1) PG8_BAR; }
    }
    PG8_WAIT_V(0);
    if constexpr (!ALIGN_EPI) { if (wr == 0) PG8_BAR; }
    PG8_BAR;
    if constexpr (Epi::AFTER_DRAIN) { E.fused(acc, cur, wr, wc, fr, fq, lds, wid, lane); S.done(cur); }
#undef PG8_SA
#undef PG8_SB
#undef PG8_STAGE
#undef PG8_LDA
#undef PG8_LDB
#undef PG8_MMA
#undef PG8_WAIT_V
#undef PG8_WAIT_L
#undef PG8_BAR
#undef PG8_SCHED
}
}
#define XB_TMO      128
#define XB_XCNT(j)  (256  + 64 * (j))
#define XB_XSUB(j)  (1280 + 64 * (j))
#define XB_XGEN(j)  (2304 + 64 * (j))
#define XB_TOP      3328
#define XB_TOPGEN   3392
#define XCD_BAR_WORDS 3456
#define XB_SPIN_CAP (1u << 18)

__device__ __forceinline__ unsigned xb_ld(unsigned* p)              { return __hip_atomic_load(p, __ATOMIC_RELAXED, __HIP_MEMORY_SCOPE_AGENT); }
__device__ __forceinline__ unsigned xb_add(unsigned* p, unsigned v) { return __hip_atomic_fetch_add(p, v, __ATOMIC_RELAXED, __HIP_MEMORY_SCOPE_AGENT); }
__device__ __forceinline__ unsigned xb_xcc_id() { return (unsigned)__builtin_amdgcn_s_getreg((3 << 11) | 20) & 0xFu; }
#define XB_SPIN(cond, bar) do { unsigned _sp = 0; while (cond) { __builtin_amdgcn_s_sleep(1); \
    if ((++_sp & 255u) == 0u) { if (xb_ld(&(bar)[XB_TMO])) break; if (_sp > XB_SPIN_CAP) { atomicAdd(&(bar)[XB_TMO], 1u); break; } } } } while (0)

struct XcdBarrier {
    unsigned* bar; unsigned x;
    volatile LAS unsigned* st;
};

__device__ __forceinline__ XcdBarrier xcd_barrier_post(unsigned* bar, volatile LAS unsigned* st) {
    XcdBarrier b; b.bar = bar; b.x = xb_xcc_id(); b.st = st;
    if (wg_tid() == 0) (void)xb_add(&bar[XB_XCNT(b.x)], 1u);
    return b;
}
__device__ __forceinline__ void xcd_barrier_complete(unsigned* bar, unsigned x, unsigned& nloc, unsigned& nx) {
    const unsigned G = gridDim.x * gridDim.y * gridDim.z;
    unsigned sum, cnt, mine, sp = 0u;
    for (;;) {
        sum = 0u; cnt = 0u; mine = 0u;
#pragma unroll
        for (unsigned j = 0; j < 16; ++j) { const unsigned c = xb_ld(&bar[XB_XCNT(j)]); sum += c; cnt += (c > 0u) ? 1u : 0u; mine = (j == x) ? c : mine; }
        if (sum == G) break;
        __builtin_amdgcn_s_sleep(1);
        if ((++sp & 255u) == 0u) { if (xb_ld(&bar[XB_TMO])) break; if (sp > XB_SPIN_CAP) { atomicAdd(&bar[XB_TMO], 1u); break; } }
    }
    nloc = mine > 0u ? mine : 1u; nx = cnt > 0u ? cnt : 1u;
}

__device__ __forceinline__ void xcd_barrier(const XcdBarrier& b) {
    asm volatile("s_waitcnt vmcnt(0)" ::: "memory");
    __syncthreads();
    if (wg_tid() == 0) {
        unsigned* bar = b.bar;
        __builtin_amdgcn_s_waitcnt(0);
        unsigned nloc = b.st[0], nx = b.st[1];
        if (nloc == 0u) { xcd_barrier_complete(bar, b.x, nloc, nx); b.st[0] = nloc; b.st[1] = nx; }
        const unsigned old = xb_add(&bar[XB_XSUB(b.x)], 1u);
        const unsigned gen = old / nloc;
        if (old + 1u == (gen + 1u) * nloc) {
            __builtin_amdgcn_fence(__ATOMIC_RELEASE, "agent");
            asm volatile("s_waitcnt vmcnt(0)" ::: "memory");
            const unsigned og = xb_add(&bar[XB_TOP], 1u);
            const unsigned tg = og / nx;
            if (og + 1u == (tg + 1u) * nx) xb_add(&bar[XB_TOPGEN], 1u);
            else XB_SPIN(xb_ld(&bar[XB_TOPGEN]) == tg, bar);
            __builtin_amdgcn_fence(__ATOMIC_ACQUIRE, "agent");
            xb_add(&bar[XB_XGEN(b.x)], 1u);
            asm volatile("s_waitcnt vmcnt(0)" ::: "memory");
        } else {
            XB_SPIN(xb_ld(&bar[XB_XGEN(b.x)]) == gen, bar);
            __builtin_amdgcn_fence(__ATOMIC_ACQUIRE, "agent");
            asm volatile("s_waitcnt vmcnt(0)" ::: "memory");
        }
    }
    __syncthreads();
}
namespace dattn {
typedef unsigned short bf16;
constexpr int   D = 128, NW = 8, QBLK = 32, KVBLK = 64;
constexpr float SCALE = 0.088388347648318440f;
constexpr float THR = 8.f;
constexpr int SDEPTH = 2;
constexpr int LDQ = 4096, LDK = 1024, LDO = 4096;
constexpr size_t SHM_V = KVBLK * D * 2, SHM_K = KVBLK * D * 2, SHM_ATTN = 3 * SHM_V + 3 * SHM_K + NW * 64 * 4 + 2048;
using bf16x8 = __attribute__((ext_vector_type(8))) short;
using s16x4  = __attribute__((ext_vector_type(4))) short;
using f32x16 = __attribute__((ext_vector_type(16))) float;
using f32x8  = __attribute__((ext_vector_type(8))) float;
using u32x4  = __attribute__((ext_vector_type(4))) unsigned;
#define KSWZ(row, colB) ((row) * 256 + ((colB) ^ (((row) & 7) << 4)))
#define SBAR() __builtin_amdgcn_sched_barrier(0)
__device__ __forceinline__ int crow(int r, int hi) { return (r & 3) + 8 * (r >> 2) + 4 * hi; }
__device__ __forceinline__ unsigned cvtpk(float lo, float hi) {
  unsigned r; asm volatile("v_cvt_pk_bf16_f32 %0, %1, %2" : "=v"(r) : "v"(lo), "v"(hi)); return r;
}
template <typename TIn> struct Stage;
template <> struct Stage<bf16>  { using T = bf16x8;
  __device__ static __forceinline__ T ld8(const bf16* p) { return *reinterpret_cast<const bf16x8*>(p); }
  __device__ static __forceinline__ bf16x8 tobf(T x) { return x; } };
template <> struct Stage<float> { using T = f32x8;
  __device__ static __forceinline__ T ld8(const float* p) { return *reinterpret_cast<const f32x8*>(p); }
  __device__ static __forceinline__ bf16x8 tobf(T x) {
    u32x4 w = {cvtpk(x[0], x[1]), cvtpk(x[2], x[3]), cvtpk(x[4], x[5]), cvtpk(x[6], x[7])}; return *reinterpret_cast<bf16x8*>(&w); } };

__device__ __forceinline__ void partialSM(f32x16& p0, f32x16& p1, float& m_reg, float& mn, float& alpha) {
  constexpr float C = SCALE * 1.4426950408889634f;
  float pmax = p0[0]; for (int r = 1; r < 16; ++r) pmax = fmaxf(pmax, p0[r]); for (int r = 0; r < 16; ++r) pmax = fmaxf(pmax, p1[r]);
  { auto rr = __builtin_amdgcn_permlane32_swap(__float_as_uint(pmax), __float_as_uint(pmax), false, false);
    pmax = fmaxf(__uint_as_float(rr[0]), __uint_as_float(rr[1])); }
  if (__builtin_expect(__all(pmax - m_reg <= THR / SCALE), 1)) { mn = m_reg; alpha = 1.f; }
  else { mn = fmaxf(m_reg, pmax); alpha = __builtin_amdgcn_exp2f((m_reg - mn) * C); m_reg = mn; }
  float mnC = -mn * C;
  for (int r = 0; r < 16; ++r) p0[r] = fmaf(p0[r], C, mnC); for (int r = 0; r < 16; ++r) p1[r] = fmaf(p1[r], C, mnC);
  for (int r = 0; r < 16; ++r) p0[r] = __builtin_amdgcn_exp2f(p0[r]);
}
__device__ __forceinline__ void finishSM(f32x16& p0, f32x16& p1, float alpha, float& l_reg, bf16x8& pa0, bf16x8& pa1, bf16x8& pa2, bf16x8& pa3) {
  for (int r = 0; r < 16; ++r) p1[r] = __builtin_amdgcn_exp2f(p1[r]);
  float ps = 0; for (int r = 0; r < 16; ++r) ps += p0[r]; for (int r = 0; r < 16; ++r) ps += p1[r];
  { auto rr = __builtin_amdgcn_permlane32_swap(__float_as_uint(ps), __float_as_uint(ps), false, false);
    ps = __uint_as_float(rr[0]) + __uint_as_float(rr[1]); }
  l_reg = l_reg * alpha + ps;
#define PK4(P, BASE, OUT) do { unsigned a0 = cvtpk(P[BASE + 0], P[BASE + 1]), a1 = cvtpk(P[BASE + 2], P[BASE + 3]);   \
    unsigned b0 = cvtpk(P[BASE + 4], P[BASE + 5]), b1 = cvtpk(P[BASE + 6], P[BASE + 7]);                              \
    auto r0 = __builtin_amdgcn_permlane32_swap(a0, b0, false, false); auto r1 = __builtin_amdgcn_permlane32_swap(a1, b1, false, false); \
    u32x4 w = {r0[0], r1[0], r0[1], r1[1]}; OUT = *reinterpret_cast<bf16x8*>(&w); } while (0)
  PK4(p0, 0, pa0); PK4(p0, 8, pa1); PK4(p1, 0, pa2); PK4(p1, 8, pa3);
#undef PK4
}
__device__ __forceinline__ void qkt(f32x16& p0, f32x16& p1, const bf16* Ks, const bf16x8* qr, int r32, int hi) {
  p0 = f32x16{}; p1 = f32x16{};
  bf16x8 nb0 = *reinterpret_cast<const bf16x8*>((const char*)Ks + KSWZ(r32, (hi * 8) * 2)), nb1 = *reinterpret_cast<const bf16x8*>((const char*)Ks + KSWZ(32 + r32, (hi * 8) * 2));
#pragma unroll
  for (int d0 = 0; d0 < 8; ++d0) { const bf16x8 b0 = nb0, b1 = nb1;
    if (d0 < 7) { const int cb = ((d0 + 1) * 16 + hi * 8) * 2;
      nb0 = *reinterpret_cast<const bf16x8*>((const char*)Ks + KSWZ(r32, cb)); nb1 = *reinterpret_cast<const bf16x8*>((const char*)Ks + KSWZ(32 + r32, cb)); }
    p0 = __builtin_amdgcn_mfma_f32_32x32x16_bf16(b0, qr[d0], p0, 0, 0, 0);
    p1 = __builtin_amdgcn_mfma_f32_32x32x16_bf16(b1, qr[d0], p1, 0, 0, 0); }
}
__device__ __forceinline__ int v_st(int k, int c) { const int kk = (k & ~0xC) | ((k & 4) << 1) | ((k & 8) >> 1); return ((kk >> 3) * 4 + (c >> 5)) * 512 + ((kk & 7) * 32 + (c & 31)) * 2; }
__device__ __forceinline__ int v_rd_base(int lane) { return ((lane & 3) << 3) | (((lane >> 2) & 3) << 6) | (((lane >> 4) & 1) << 5) | (((lane >> 5) & 1) << 8); }
constexpr int v_rd_off(int d0, int ks, int half) { return d0 * 512 + ks * 4096 + half * 2048; }
template <int OFF> __device__ __forceinline__ s16x4 tr_read(int vb) {
  s16x4 r; asm volatile("ds_read_b64_tr_b16 %0, %1 offset:%2" : "=&v"(r) : "v"(vb), "i"(OFF) : "memory"); return r;
}
template <int D0> __device__ __forceinline__ void pv_one(f32x16& od, int vb, bf16x8 pa0, bf16x8 pa1, bf16x8 pa2, bf16x8 pa3) {
  const s16x4 l0 = tr_read<v_rd_off(D0, 0, 0)>(vb), h0 = tr_read<v_rd_off(D0, 0, 1)>(vb), l1 = tr_read<v_rd_off(D0, 1, 0)>(vb), h1 = tr_read<v_rd_off(D0, 1, 1)>(vb);
  const s16x4 l2 = tr_read<v_rd_off(D0, 2, 0)>(vb), h2 = tr_read<v_rd_off(D0, 2, 1)>(vb), l3 = tr_read<v_rd_off(D0, 3, 0)>(vb), h3 = tr_read<v_rd_off(D0, 3, 1)>(vb);
  asm volatile("s_waitcnt lgkmcnt(0)" ::: "memory"); SBAR();
#define PK(L, H) (bf16x8){L[0], L[1], L[2], L[3], H[0], H[1], H[2], H[3]}
  od = __builtin_amdgcn_mfma_f32_32x32x16_bf16(pa0, PK(l0, h0), od, 0, 0, 0);
  od = __builtin_amdgcn_mfma_f32_32x32x16_bf16(pa1, PK(l1, h1), od, 0, 0, 0);
  od = __builtin_amdgcn_mfma_f32_32x32x16_bf16(pa2, PK(l2, h2), od, 0, 0, 0);
  od = __builtin_amdgcn_mfma_f32_32x32x16_bf16(pa3, PK(l3, h3), od, 0, 0, 0);
#undef PK
}
__device__ __forceinline__ void pv_d0(f32x16* o, int vb, bf16x8 pa0, bf16x8 pa1, bf16x8 pa2, bf16x8 pa3) {
  pv_one<0>(o[0], vb, pa0, pa1, pa2, pa3); pv_one<1>(o[1], vb, pa0, pa1, pa2, pa3); pv_one<2>(o[2], vb, pa0, pa1, pa2, pa3); pv_one<3>(o[3], vb, pa0, pa1, pa2, pa3);
}

template <typename TQ>
__device__ __forceinline__ void attn_dense_body(const TQ* __restrict__ Qb, const bf16* __restrict__ Kh, const bf16* __restrict__ Vh,
                                                bf16* __restrict__ Ob, int seq, char* lds) {
  using St = Stage<bf16>; using SQ = Stage<TQ>;
  int tid_o = wg_tid(); asm volatile("" : "+v"(tid_o)); const int tid = tid_o, wid = __builtin_amdgcn_readfirstlane(tid >> 6), lane = tid & 63, r32 = lane & 31, hi = lane >> 5;
  bf16* V_lds = (bf16*)lds; bf16* K_lds = (bf16*)(lds + 3 * SHM_V);
  float* ws = (float*)(lds + 3 * SHM_V + 3 * SHM_K) + wid * 64; float* li_l = ws; float* al_l = ws + 32;
  float m_reg = -1e30f, l_reg = 0; f32x16 o[4] = {}; bf16x8 qr[8];
  const TQ* Qw = Qb + (long)(wid * QBLK + r32) * LDQ + hi * 8;
#pragma unroll
  for (int d0 = 0; d0 < 8; ++d0) qr[d0] = SQ::tobf(SQ::ld8(Qw + d0 * 16));
  const int sr = tid >> 4, sc = (tid & 15) * 8, vst0 = v_st(sr, sc), vst1 = v_st(32 + sr, sc);
  const int vb0 = (int)(uintptr_t)V_lds + v_rd_base(lane);
  struct { typename St::T vs0, vs1, ks0, ks1; } sr_[SDEPTH];
#define SLOAD(i, k0) do { sr_[i].vs0 = St::ld8(&Vh[(long)((k0) + sr) * LDK + sc]); sr_[i].vs1 = St::ld8(&Vh[(long)((k0) + 32 + sr) * LDK + sc]); \
    sr_[i].ks0 = St::ld8(&Kh[(long)((k0) + sr) * LDK + sc]); sr_[i].ks1 = St::ld8(&Kh[(long)((k0) + 32 + sr) * LDK + sc]); } while (0)
#define SWRITE(b, i) do { *(bf16x8*)((char*)V_lds + (b) * SHM_V + vst0) = St::tobf(sr_[i].vs0);          \
    *(bf16x8*)((char*)V_lds + (b) * SHM_V + vst1) = St::tobf(sr_[i].vs1); int kc = sc * 2;               \
    *(bf16x8*)((char*)K_lds + (b) * SHM_K + KSWZ(sr, kc)) = St::tobf(sr_[i].ks0);                       \
    *(bf16x8*)((char*)K_lds + (b) * SHM_K + KSWZ(32 + sr, kc)) = St::tobf(sr_[i].ks1); } while (0)
#define SWAIT() do { if constexpr (SDEPTH == 2) asm volatile("s_waitcnt vmcnt(4)" ::: "memory"); else asm volatile("s_waitcnt vmcnt(0)" ::: "memory"); } while (0)
#define RESC(a) do { if (__any((a) < 1.f)) { if (hi == 0) al_l[r32] = (a); asm volatile("s_waitcnt lgkmcnt(0)" ::: "memory"); \
    for (int d = 0; d < 4; ++d) for (int r = 0; r < 16; ++r) o[d][r] *= al_l[crow(r, hi)]; } } while (0)
  f32x16 pA0, pA1, pB0, pB1; float mnA, mnB, alA, alB; bf16x8 pa0, pa1, pa2, pa3; const int NT = seq / KVBLK;
  constexpr int SE = 0, SO = SDEPTH - 1;
  SLOAD(SE, 0); asm volatile("s_waitcnt vmcnt(0)" ::: "memory"); SWRITE(0, SE); __syncthreads();
  qkt(pA0, pA1, K_lds, qr, r32, hi); partialSM(pA0, pA1, m_reg, mnA, alA);
  SLOAD(SO, KVBLK); if constexpr (SDEPTH == 2) { if (2 < NT) SLOAD(SE, 2 * KVBLK); }
  SWAIT(); SWRITE(1, SO); __syncthreads();
  int bk = 1, bv = 0, bw = 2;
  if (wid >= 4) __builtin_amdgcn_s_setprio(1);
#define ROT3() do { const int t_ = bv; bv = bk; bk = bw; bw = t_; } while (0)
  for (int j = 1; j + 1 < NT; j += 2) {
    SBAR(); qkt(pB0, pB1, (bf16*)((char*)K_lds + bk * SHM_K), qr, r32, hi);
    finishSM(pA0, pA1, alA, l_reg, pa0, pa1, pa2, pa3); SBAR();
    SLOAD(SO, (j + SDEPTH) * KVBLK); SBAR();
    pv_d0(o, vb0 + bv * (int)SHM_V, pa0, pa1, pa2, pa3); partialSM(pB0, pB1, m_reg, mnB, alB);
    SWAIT(); SWRITE(bw, SE);
    RESC(alB); __syncthreads(); ROT3();
    SBAR(); qkt(pA0, pA1, (bf16*)((char*)K_lds + bk * SHM_K), qr, r32, hi);
    finishSM(pB0, pB1, alB, l_reg, pa0, pa1, pa2, pa3); SBAR();
    if (SDEPTH == 1 || j + 3 < NT) SLOAD(SE, (j + 1 + SDEPTH) * KVBLK); SBAR();
    pv_d0(o, vb0 + bv * (int)SHM_V, pa0, pa1, pa2, pa3); partialSM(pA0, pA1, m_reg, mnA, alA);
    SWAIT(); SWRITE(bw, SO);
    RESC(alA); __syncthreads(); ROT3();
  }
  SBAR(); qkt(pB0, pB1, (bf16*)((char*)K_lds + bk * SHM_K), qr, r32, hi);
  finishSM(pA0, pA1, alA, l_reg, pa0, pa1, pa2, pa3); SBAR();
  pv_d0(o, vb0 + bv * (int)SHM_V, pa0, pa1, pa2, pa3); partialSM(pB0, pB1, m_reg, mnB, alB);
  RESC(alB);
  finishSM(pB0, pB1, alB, l_reg, pa0, pa1, pa2, pa3); SBAR();
  pv_d0(o, vb0 + bk * (int)SHM_V, pa0, pa1, pa2, pa3);
#undef ROT3
  __builtin_amdgcn_s_setprio(0);
  if (hi == 0) li_l[r32] = l_reg; asm volatile("s_waitcnt lgkmcnt(0)" ::: "memory");
  float rli[16];
#pragma unroll
  for (int r = 0; r < 16; ++r) rli[r] = __builtin_amdgcn_rcpf(li_l[crow(r, hi)]);
  bf16* Ow = Ob + (long)(wid * QBLK) * LDO;
#pragma unroll
  for (int r = 0; r < 16; ++r) { int orow = crow(r, hi);
    for (int d0 = 0; d0 < 4; ++d0) Ow[(long)orow * LDO + d0 * 32 + r32] = (bf16)(cvtpk(o[d0][r] * rli[r], 0.f) & 0xffffu); }
#undef SLOAD
#undef SWRITE
#undef SWAIT
#undef RESC
}

constexpr int NA_LD = 4096, NA_TILES = 12;
__device__ __forceinline__ void na_block_body(const bf16* __restrict__ Qb, const bf16* __restrict__ Kh, const bf16* __restrict__ Vh, bf16* __restrict__ Ob,
                                              const float* __restrict__ rpb_h, const float* __restrict__ qgain, const float* __restrict__ kgain, int R, int ks, char* lds) {
  using St = Stage<bf16>;
  int tid_o = wg_tid(); asm volatile("" : "+v"(tid_o)); const int tid = tid_o, wid = __builtin_amdgcn_readfirstlane(tid >> 6), lane = tid & 63, r32 = lane & 31, hi = lane >> 5;
  bf16* V_lds = (bf16*)lds; bf16* K_lds = (bf16*)(lds + 2 * SHM_V);
  float* ws = (float*)(lds + 2 * SHM_V + 2 * SHM_K) + wid * 64; float* li_l = ws; float* al_l = ws + 32;
  float* bt = (float*)(lds + 2 * SHM_V + 2 * SHM_K + NW * 64 * 4);
  float m_reg = -1e30f, l_reg = 0; f32x16 o[4] = {}; bf16x8 qr[8];
  const bf16* Qw = Qb + (long)(wid * QBLK + r32) * NA_LD + hi * 8;
#pragma unroll
  for (int d0 = 0; d0 < 8; ++d0) qr[d0] = St::ld8(Qw + d0 * 16);
  {
    float ss = 0.f;
#pragma unroll
    for (int d0 = 0; d0 < 8; ++d0) { const u32x4 w = __builtin_bit_cast(u32x4, qr[d0]);
#pragma unroll
      for (int e = 0; e < 4; ++e) { const float a = __uint_as_float(w[e] << 16), b = __uint_as_float(w[e] & 0xffff0000u); ss += a * a + b * b; } }
    ss += __shfl_xor(ss, 32);
    const float rinv = __builtin_amdgcn_rsqf(ss * (1.0f / 128.0f) + 1e-6f);
#pragma unroll
    for (int d0 = 0; d0 < 8; ++d0) { const u32x4 w = __builtin_bit_cast(u32x4, qr[d0]); const float* gp = qgain + d0 * 16 + hi * 8;
      const f32x8 g = *reinterpret_cast<const f32x8*>(gp); u32x4 o;
#pragma unroll
      for (int e = 0; e < 4; ++e) o[e] = cvtpk(__uint_as_float(w[e] << 16) * rinv * g[2 * e], __uint_as_float(w[e] & 0xffff0000u) * rinv * g[2 * e + 1]);
      qr[d0] = __builtin_bit_cast(bf16x8, o); } }
  const f32x8 kg = *reinterpret_cast<const f32x8*>(kgain + (tid & 15) * 8);
  for (int i = tid; i < 15 * 31; i += 64 * NW) bt[i] = rpb_h[i];
  const int sr = tid >> 4, sc = (tid & 15) * 8, vst0 = v_st(sr, sc), vst1 = v_st(32 + sr, sc);
  const int vb0 = (int)(uintptr_t)V_lds + v_rd_base(lane);
  bf16x8 s_vs0, s_vs1, s_ks0, s_ks1;
#define NLOAD(k0) do { s_vs0 = St::ld8(&Vh[(long)((k0) + sr) * NA_LD + sc]); s_vs1 = St::ld8(&Vh[(long)((k0) + 32 + sr) * NA_LD + sc]); \
    s_ks0 = St::ld8(&Kh[(long)((k0) + sr) * NA_LD + sc]); s_ks1 = St::ld8(&Kh[(long)((k0) + 32 + sr) * NA_LD + sc]); } while (0)
#define KNORM(x) do { const u32x4 w_ = __builtin_bit_cast(u32x4, x); float a_[8]; float ss_ = 0.f; \
    _Pragma("unroll") for (int e = 0; e < 4; ++e) { a_[2 * e] = __uint_as_float(w_[e] << 16); a_[2 * e + 1] = __uint_as_float(w_[e] & 0xffff0000u); ss_ += a_[2 * e] * a_[2 * e] + a_[2 * e + 1] * a_[2 * e + 1]; } \
    ss_ += __shfl_xor(ss_, 1); ss_ += __shfl_xor(ss_, 2); ss_ += __shfl_xor(ss_, 4); ss_ += __shfl_xor(ss_, 8); \
    const float ri_ = __builtin_amdgcn_rsqf(ss_ * (1.0f / 128.0f) + 1e-6f); u32x4 o_; \
    _Pragma("unroll") for (int e = 0; e < 4; ++e) o_[e] = cvtpk(a_[2 * e] * ri_ * kg[2 * e], a_[2 * e + 1] * ri_ * kg[2 * e + 1]); \
    x = __builtin_bit_cast(bf16x8, o_); } while (0)
#define NWRITE(b) do { KNORM(s_ks0); KNORM(s_ks1); \
    *(bf16x8*)((char*)V_lds + (b) * SHM_V + vst0) = s_vs0; *(bf16x8*)((char*)V_lds + (b) * SHM_V + vst1) = s_vs1; const int kc_ = sc * 2; \
    *(bf16x8*)((char*)K_lds + (b) * SHM_K + KSWZ(sr, kc_)) = s_ks0; *(bf16x8*)((char*)K_lds + (b) * SHM_K + KSWZ(32 + sr, kc_)) = s_ks1; } while (0)
  const int qrow = R + (wid >> 1), r0q = min(max(qrow - 4, 0), 248), jlo = r0q - ks;
  const int c = 32 * (wid & 1) + r32, c0 = min(max(c - 8, 0), 48);
  NLOAD(0); asm volatile("s_waitcnt vmcnt(0)" ::: "memory"); NWRITE(0); __syncthreads();
  for (int j = 0; j < NA_TILES; ++j) {
    const int buf = j & 1;
    if (j + 1 < NA_TILES) NLOAD((j + 1) * KVBLK);
    if (j >= jlo && j < jlo + 8) {
      f32x16 p0, p1; float mn, al; bf16x8 pa0, pa1, pa2, pa3;
      SBAR(); qkt(p0, p1, (bf16*)((char*)K_lds + buf * SHM_K), qr, r32, hi);
      const float* brow = bt + (ks + j - qrow + 7) * 31 + (15 - c);
#pragma unroll
      for (int r = 0; r < 16; ++r) { const int k0 = crow(r, hi), k1 = 32 + k0; const bool v0 = (k0 >= c0) && (k0 < c0 + 16), v1 = (k1 >= c0) && (k1 < c0 + 16);
        const float b0 = brow[v0 ? k0 : c], b1 = brow[v1 ? k1 : c];
        p0[r] = v0 ? fmaf(b0, 1.0f / SCALE, p0[r]) : -1e30f; p1[r] = v1 ? fmaf(b1, 1.0f / SCALE, p1[r]) : -1e30f; }
      partialSM(p0, p1, m_reg, mn, al);
      if (__any(al < 1.f)) { if (hi == 0) al_l[r32] = al; asm volatile("s_waitcnt lgkmcnt(0)" ::: "memory");
#pragma unroll
        for (int d = 0; d < 4; ++d)
#pragma unroll
          for (int r = 0; r < 16; ++r) o[d][r] *= al_l[crow(r, hi)]; }
      finishSM(p0, p1, al, l_reg, pa0, pa1, pa2, pa3); SBAR();
      pv_d0(o, vb0 + buf * (int)SHM_V, pa0, pa1, pa2, pa3);
    }
    if (j + 1 < NA_TILES) { asm volatile("s_waitcnt vmcnt(0)" ::: "memory"); NWRITE(buf ^ 1); }
    __syncthreads();
  }
  if (hi == 0) li_l[r32] = l_reg; asm volatile("s_waitcnt lgkmcnt(0)" ::: "memory");
  float rli[16];
#pragma unroll
  for (int r = 0; r < 16; ++r) rli[r] = 64.0f * __builtin_amdgcn_rcpf(li_l[crow(r, hi)]);
  unsigned char* Ow = (unsigned char*)Ob + (long)(wid * QBLK) * NA_LD;
#pragma unroll
  for (int r = 0; r < 16; ++r) { const int orow = crow(r, hi);
    for (int d0 = 0; d0 < 4; ++d0) Ow[(long)orow * NA_LD + d0 * 32 + r32] = (unsigned char)__builtin_amdgcn_cvt_pk_fp8_f32(o[d0][r] * rli[r], 0.f, 0, false); }
#undef NLOAD
#undef NWRITE
#undef KNORM
}

typedef int v8i __attribute__((ext_vector_type(8)));
#ifndef SGB_VARIANT
#if defined(PROBE_PH) && PROBE_PH >= 310 && PROBE_PH < 320
#define SGB_VARIANT (PROBE_PH - 310)
#else
#define SGB_VARIANT 3
#endif
#endif
typedef unsigned u32x2 __attribute__((ext_vector_type(2)));
constexpr int K8_LD = 1024, V8_LD = 16384, SHM_K8 = KVBLK * D, SHM_V8 = KVBLK * D;
constexpr float THR8 = 3.0f;
__device__ __forceinline__ int cvt4_fp8(float a, float b, float c, float d) { int w = __builtin_amdgcn_cvt_pk_fp8_f32(a, b, 0, false); return __builtin_amdgcn_cvt_pk_fp8_f32(c, d, w, true); }
typedef short s16x2 __attribute__((ext_vector_type(2)));
__device__ __forceinline__ int cvt4_fp8_scl(int w, float a, float b, float c, float d, float scl) {
  s16x2 t = __builtin_bit_cast(s16x2, w); t = __builtin_amdgcn_cvt_scalef32_pk_fp8_f32(t, a, b, scl, false); t = __builtin_amdgcn_cvt_scalef32_pk_fp8_f32(t, c, d, scl, true); return __builtin_bit_cast(int, t); }
__device__ __forceinline__ v8i mk8(u32x4 lo, u32x4 hi) { return (v8i){(int)lo[0], (int)lo[1], (int)lo[2], (int)lo[3], (int)hi[0], (int)hi[1], (int)hi[2], (int)hi[3]}; }
__device__ __forceinline__ void qkt8(f32x16& p0, f32x16& p1, const char* Ks, const v8i* qf, int r32, int hi) {
  const int x0 = (r32 >> 1) & 7, x1 = ((32 + r32) >> 1) & 7;
  const char* k0 = Ks + r32 * 128; const char* k1 = Ks + (32 + r32) * 128;
  v8i a[2][2];
#pragma unroll
  for (int s = 0; s < 2; ++s) { const int c = 4 * s + 2 * hi;
    a[0][s] = mk8(*reinterpret_cast<const u32x4*>(k0 + 16 * (c ^ x0)), *reinterpret_cast<const u32x4*>(k0 + 16 * ((c + 1) ^ x0)));
    a[1][s] = mk8(*reinterpret_cast<const u32x4*>(k1 + 16 * (c ^ x1)), *reinterpret_cast<const u32x4*>(k1 + 16 * ((c + 1) ^ x1))); }
  p0 = f32x16{}; p1 = f32x16{};
#pragma unroll
  for (int s = 0; s < 2; ++s) {
    p0 = __builtin_amdgcn_mfma_scale_f32_32x32x64_f8f6f4(a[0][s], qf[s], p0, 0, 0, 0, 0x7F7F7F7F, 0, 0x7C7C7C7C);
    p1 = __builtin_amdgcn_mfma_scale_f32_32x32x64_f8f6f4(a[1][s], qf[s], p1, 0, 0, 0, 0x7F7F7F7F, 0, 0x7C7C7C7C); }
}
constexpr float THR2 = 4.0f;
__device__ __forceinline__ void partialSM8(f32x16& p0, f32x16& p1, float& m_reg, float& scl, float& alpha) {
  float pmax;
  asm("v_max3_f32 %0, %1, %2, %3\n\tv_max3_f32 %0, %0, %4, %5\n\tv_max3_f32 %0, %0, %6, %7\n\tv_max3_f32 %0, %0, %8, %9\n\tv_max3_f32 %0, %0, %10, %11\n\tv_max3_f32 %0, %0, %12, %13\n\tv_max3_f32 %0, %0, %14, %15\n\tv_max_f32 %0, %0, %16"
      : "=&v"(pmax) : "v"(p0[0]), "v"(p0[1]), "v"(p0[2]), "v"(p0[3]), "v"(p0[4]), "v"(p0[5]), "v"(p0[6]), "v"(p0[7]), "v"(p0[8]), "v"(p0[9]), "v"(p0[10]), "v"(p0[11]), "v"(p0[12]), "v"(p0[13]), "v"(p0[14]), "v"(p0[15]));
  asm("v_max3_f32 %0, %0, %1, %2\n\tv_max3_f32 %0, %0, %3, %4\n\tv_max3_f32 %0, %0, %5, %6\n\tv_max3_f32 %0, %0, %7, %8\n\tv_max3_f32 %0, %0, %9, %10\n\tv_max3_f32 %0, %0, %11, %12\n\tv_max3_f32 %0, %0, %13, %14\n\tv_max3_f32 %0, %0, %15, %16"
      : "+v"(pmax) : "v"(p1[0]), "v"(p1[1]), "v"(p1[2]), "v"(p1[3]), "v"(p1[4]), "v"(p1[5]), "v"(p1[6]), "v"(p1[7]), "v"(p1[8]), "v"(p1[9]), "v"(p1[10]), "v"(p1[11]), "v"(p1[12]), "v"(p1[13]), "v"(p1[14]), "v"(p1[15]));
  { auto rr = __builtin_amdgcn_permlane32_swap(__float_as_uint(pmax), __float_as_uint(pmax), false, false);
    pmax = fmaxf(__uint_as_float(rr[0]), __uint_as_float(rr[1])); }
  if (__builtin_expect(__all(pmax - m_reg <= THR2), 1)) { alpha = 1.f; }
  else { const float mn = __builtin_ceilf(fmaxf(m_reg, pmax)); alpha = __builtin_amdgcn_exp2f(m_reg - mn); m_reg = mn; }
  scl = __builtin_amdgcn_ldexpf(1.0f, (int)fmaxf(m_reg, -100.f) - 4);
  for (int r = 0; r < 16; ++r) p0[r] = __builtin_amdgcn_exp2f(p0[r]);
}
__device__ __forceinline__ void finishSM8(f32x16& p0, f32x16& p1, v8i& pa, float scl) {
  for (int r = 0; r < 16; ++r) p1[r] = __builtin_amdgcn_exp2f(p1[r]);
#pragma unroll
  for (int v = 0; v < 4; ++v) { pa[v] = cvt4_fp8_scl(pa[v], p0[4 * v], p0[4 * v + 1], p0[4 * v + 2], p0[4 * v + 3], scl); pa[4 + v] = cvt4_fp8_scl(pa[4 + v], p1[4 * v], p1[4 * v + 1], p1[4 * v + 2], p1[4 * v + 3], scl); }
}
__device__ __forceinline__ void pv8(f32x16* o, const char* Vs, const v8i& pa, int r32, int hi) {
  v8i b[4];
#pragma unroll
  for (int db = 0; db < 4; ++db) { const int d = 32 * db + r32, x = (d >> 2) & 3; const char* vp = Vs + d * 64;
    b[db] = mk8(*reinterpret_cast<const u32x4*>(vp + 16 * ((2 * hi) ^ x)), *reinterpret_cast<const u32x4*>(vp + 16 * ((2 * hi + 1) ^ x))); }
  const v8i ones = (v8i){0x22222222, 0x22222222, 0x22222222, 0x22222222, 0, 0, 0, 0};
#pragma unroll
  for (int db = 0; db < 4; ++db) o[db] = __builtin_amdgcn_mfma_scale_f32_32x32x64_f8f6f4(pa, b[db], o[db], 0, 0, 0, 0x7F7F7F7F, 0, 0x7F7F7F7F);
  o[4] = __builtin_amdgcn_mfma_scale_f32_32x32x64_f8f6f4(pa, ones, o[4], 0, 4, 0, 0x7F7F7F7F, 0, 0x7F7F7F7F);
}
__device__ __forceinline__ void attn_dense_body8(const bf16* __restrict__ Qb, const unsigned char* __restrict__ K8h, const unsigned char* __restrict__ V8h, bf16* __restrict__ Ob, int seq, char* lds) {
  int tid_o = wg_tid(); asm volatile("" : "+v"(tid_o)); const int tid = tid_o, wid = __builtin_amdgcn_readfirstlane(tid >> 6), lane = tid & 63, r32 = lane & 31, hi = lane >> 5;
  char* V_lds = lds; char* K_lds = lds + 4 * SHM_V8;
  float* ws = (float*)(lds + 4 * SHM_V8 + 4 * SHM_K8) + wid * 64; float* al_l = ws + 32;
  float m_reg = -1e30f; f32x16 o[5] = {}; v8i qf[2];
  { const bf16* Qw = Qb + (long)(wid * QBLK + r32) * LDQ + hi * 32;
#pragma unroll
    for (int s = 0; s < 2; ++s) {
#pragma unroll
      for (int c = 0; c < 4; ++c) { const u32x4 w = *reinterpret_cast<const u32x4*>(Qw + s * 64 + c * 8);
        constexpr float QS = 8.0f * SCALE * 1.4426950408889634f;
        qf[s][2 * c] = cvt4_fp8(QS * __uint_as_float(w[0] << 16), QS * __uint_as_float(w[0] & 0xffff0000u), QS * __uint_as_float(w[1] << 16), QS * __uint_as_float(w[1] & 0xffff0000u));
        qf[s][2 * c + 1] = cvt4_fp8(QS * __uint_as_float(w[2] << 16), QS * __uint_as_float(w[2] & 0xffff0000u), QS * __uint_as_float(w[3] << 16), QS * __uint_as_float(w[3] & 0xffff0000u)); } } }
  const int skey = tid >> 3, sck = tid & 7, sd = tid >> 2, sc4 = tid & 3;
  const int kst = skey * 128 + 16 * (sck ^ ((skey >> 1) & 7));
  const int vx = (sd >> 2) & 3, vst0 = sd * 64 + 16 * ((sc4 >> 1) ^ vx) + 8 * (sc4 & 1), vst1 = sd * 64 + 16 * ((2 + (sc4 >> 1)) ^ vx) + 8 * (sc4 & 1);
  const unsigned char* kg = K8h + (long)skey * K8_LD + 16 * sck; const unsigned char* vg = V8h + (long)sd * V8_LD + 16 * sc4;
  struct { u32x4 k, v; } sr_[2];
#define SLOAD8(i, k0) do { sr_[i].k = *reinterpret_cast<const u32x4*>(kg + (long)(k0) * K8_LD); sr_[i].v = *reinterpret_cast<const u32x4*>(vg + (k0)); } while (0)
#define SWRITE8(b, i) do { *reinterpret_cast<u32x4*>(K_lds + (b) * SHM_K8 + kst) = sr_[i].k; \
    *reinterpret_cast<u32x2*>(V_lds + (b) * SHM_V8 + vst0) = (u32x2){sr_[i].v[0], sr_[i].v[2]}; *reinterpret_cast<u32x2*>(V_lds + (b) * SHM_V8 + vst1) = (u32x2){sr_[i].v[1], sr_[i].v[3]}; } while (0)
#define SWAIT8() asm volatile("s_waitcnt vmcnt(2)" ::: "memory")
#define RESC8(a) do { if (__any((a) < 1.f)) { if (hi == 0) al_l[r32] = (a); asm volatile("s_waitcnt lgkmcnt(0)" ::: "memory"); \
    for (int d = 0; d < 5; ++d) for (int r = 0; r < 16; ++r) o[d][r] *= al_l[crow(r, hi)]; } } while (0)
  f32x16 pA0, pA1, pB0, pB1; float mnA, mnB, alA, alB; v8i pa = {}; const int NT = seq / KVBLK;
  SLOAD8(0, 0); asm volatile("s_waitcnt vmcnt(0)" ::: "memory"); SWRITE8(0, 0); __syncthreads();
  qkt8(pA0, pA1, K_lds, qf, r32, hi);
  asm volatile("s_nop 15\n\ts_nop 7" : "+v"(pA0), "+v"(pA1));
  partialSM8(pA0, pA1, m_reg, mnA, alA);
  SLOAD8(1, KVBLK); if (2 < NT) SLOAD8(0, 2 * KVBLK);
  SWAIT8(); SWRITE8(1, 1); __syncthreads();
  if (wid >= 4) __builtin_amdgcn_s_setprio(1);
#define SGB(mask, n) __builtin_amdgcn_sched_group_barrier(mask, n, 0)
#if SGB_VARIANT == 1
#define SGB_QK() do { SGB(0x008, 1); SGB(0x400, 4); SGB(0x002, 4); SGB(0x008, 1); SGB(0x400, 4); SGB(0x002, 4); SGB(0x008, 1); SGB(0x400, 4); SGB(0x002, 4); SGB(0x008, 1); SGB(0x400, 4); SGB(0x002, 4); } while (0)
#define SGB_PV() do { SGB(0x008, 1); SGB(0x400, 4); SGB(0x008, 1); SGB(0x400, 4); SGB(0x008, 1); SGB(0x400, 4); SGB(0x008, 1); SGB(0x400, 4); SGB(0x008, 1); } while (0)
#elif SGB_VARIANT == 2
#define SGB_QK() do {} while (0)
#define SGB_PV() do { SGB(0x008, 1); SGB(0x400, 4); SGB(0x008, 1); SGB(0x400, 4); SGB(0x008, 1); SGB(0x400, 4); SGB(0x008, 1); SGB(0x400, 4); SGB(0x008, 1); } while (0)
#elif SGB_VARIANT == 3
#define SGB_QK() do { SGB(0x008, 1); SGB(0x400, 4); SGB(0x002, 4); SGB(0x008, 1); SGB(0x400, 4); SGB(0x002, 4); SGB(0x008, 1); SGB(0x400, 4); SGB(0x002, 4); SGB(0x008, 1); SGB(0x400, 4); SGB(0x002, 4); } while (0)
#define SGB_PV() do {} while (0)
#elif SGB_VARIANT == 4
#define SGB_QK() do { SGB(0x008, 1); SGB(0x400, 6); SGB(0x008, 1); SGB(0x400, 6); SGB(0x002, 2); SGB(0x008, 1); SGB(0x400, 4); SGB(0x002, 6); SGB(0x008, 1); SGB(0x002, 8); } while (0)
#define SGB_PV() do {} while (0)
#else
#define SGB_QK() do {} while (0)
#define SGB_PV() do {} while (0)
#endif
#define HALF8(X0, X1, mnX, alX, Y0, Y1, mnY, TILE, BK, BV, BW, SL, SW, DOLOAD) do { \
    SBAR(); qkt8(X0, X1, K_lds + (BK) * SHM_K8, qf, r32, hi); \
    finishSM8(Y0, Y1, pa, mnY); SGB_QK(); SBAR(); \
    if (DOLOAD) SLOAD8(SL, ((TILE) + 2) * KVBLK); SBAR(); \
    pv8(o, V_lds + (BV) * SHM_V8, pa, r32, hi); partialSM8(X0, X1, m_reg, mnX, alX); SGB_PV(); \
    SWAIT8(); SWRITE8(BW, SW); \
    RESC8(alX); __syncthreads(); } while (0)
  int j = 1;
  for (; j + 4 < NT; j += 4) {
    HALF8(pB0, pB1, mnB, alB, pA0, pA1, mnA, j,     1, 0, 2, 1, 0, true);
    HALF8(pA0, pA1, mnA, alA, pB0, pB1, mnB, j + 1, 2, 1, 3, 0, 1, true);
    HALF8(pB0, pB1, mnB, alB, pA0, pA1, mnA, j + 2, 3, 2, 0, 1, 0, true);
    HALF8(pA0, pA1, mnA, alA, pB0, pB1, mnB, j + 3, 0, 3, 1, 0, 1, true);
  }
  HALF8(pB0, pB1, mnB, alB, pA0, pA1, mnA, j,     1, 0, 2, 1, 0, true);
  HALF8(pA0, pA1, mnA, alA, pB0, pB1, mnB, j + 1, 2, 1, 3, 0, 1, false);
  SBAR(); qkt8(pB0, pB1, K_lds + 3 * SHM_K8, qf, r32, hi);
  finishSM8(pA0, pA1, pa, mnA); SBAR();
  pv8(o, V_lds + 2 * SHM_V8, pa, r32, hi); partialSM8(pB0, pB1, m_reg, mnB, alB);
  RESC8(alB);
  finishSM8(pB0, pB1, pa, mnB); SBAR();
  pv8(o, V_lds + 3 * SHM_V8, pa, r32, hi);
#undef HALF8
  __builtin_amdgcn_s_setprio(0);
  float rli[16];
#pragma unroll
  for (int r = 0; r < 16; ++r) rli[r] = 64.0f * __builtin_amdgcn_rcpf(o[4][r]);
  unsigned char* Ow = (unsigned char*)Ob + (long)(wid * QBLK) * LDO;
#pragma unroll
  for (int r = 0; r < 16; ++r) { const int orow = crow(r, hi);
    for (int d0 = 0; d0 < 4; ++d0) Ow[(long)orow * LDO + d0 * 32 + r32] = (unsigned char)__builtin_amdgcn_cvt_pk_fp8_f32(o[d0][r] * rli[r], 0.f, 0, false); }
#undef SLOAD8
#undef SWRITE8
#undef SWAIT8
#undef RESC8
}
}
struct Frame {
    LAS unsigned char* lds;
    int tid, lane, wave;
    int bid, vcu, G;
};
__device__ __forceinline__ float wave_sum(float v) {
#pragma unroll
    for (int o = 1; o < 64; o <<= 1) v += __shfl_xor(v, o);
    return v;
}
__device__ __forceinline__ void xrows_phase(const Frame& F, const float* __restrict__ h, bf16* __restrict__ hb, pg8::rs_t* __restrict__ rs, unsigned char* __restrict__ hb8) {
    const int gw = F.vcu * 8 + F.wave, NGW = F.G * 8;
    for (int m = gw; m < L; m += NGW) {
        const f32x4* xr = (const f32x4*)(h + (size_t)m * DM) + F.lane;
        v2u* o8 = (v2u*)(hb + (size_t)m * DM) + F.lane;
        float s = 0.f;
#pragma unroll
        for (int j = 0; j < 16; ++j) { const f32x4 v = xr[64 * j]; s += (v.x * v.x + v.y * v.y) + (v.z * v.z + v.w * v.w); v2u w; w.x = pk2(v.x, v.y); w.y = pk2(v.z, v.w); o8[64 * j] = w;
            int w8 = __builtin_amdgcn_cvt_pk_fp8_f32(v.x, v.y, 0, false); w8 = __builtin_amdgcn_cvt_pk_fp8_f32(v.z, v.w, w8, true); *((unsigned*)(hb8 + (size_t)m * DM) + 64 * j + F.lane) = (unsigned)w8; }
        s = wave_sum(s);
        if (F.lane == 0) rs[m] = (pg8::rs_t)(s * pg8::RS_FIX);
    }
}
__device__ __forceinline__ void headnorm_rows(bf16* __restrict__ X, int ld, int nheads, const float* __restrict__ gain, int t, int lane, bool rope, const float (&cs)[8], const float (&sn)[8], unsigned char* __restrict__ X8 = nullptr) {
    const int hs = lane >> 4, l16 = lane & 15;
    f32x4 g0 = *(const f32x4*)(gain + 8 * l16), g1 = *(const f32x4*)(gain + 8 * l16 + 4);
    const float gg[8] = {g0.x, g0.y, g0.z, g0.w, g1.x, g1.y, g1.z, g1.w};
    const bool second = ((l16 >> 2) & 1) != 0;
    for (int hg = 0; hg < nheads / 4; ++hg) {
        bf16* p = X + (size_t)t * ld + (size_t)(4 * hg + hs) * HD + 8 * l16;
        const v4u raw = *(const v4u*)p;
        float x[8] = {bflo(raw.x), bfhi(raw.x), bflo(raw.y), bfhi(raw.y), bflo(raw.z), bfhi(raw.z), bflo(raw.w), bfhi(raw.w)};
        float ss = 0.f;
#pragma unroll
        for (int e = 0; e < 8; ++e) ss += x[e] * x[e];
        ss += __shfl_xor(ss, 1); ss += __shfl_xor(ss, 2); ss += __shfl_xor(ss, 4); ss += __shfl_xor(ss, 8);
        const float rinv = 1.0f / sqrtf(ss * (1.0f / HD) + EPS);
        float y[8];
#pragma unroll
        for (int e = 0; e < 8; ++e) y[e] = x[e] * rinv * gg[e];
        if (rope) {
#pragma unroll
            for (int e = 0; e < 8; ++e) { const float yp = __shfl_xor(y[e], 4); y[e] = second ? (y[e] * cs[e] + yp * sn[e]) : (y[e] * cs[e] - yp * sn[e]); }
        }
        if (X8) { int w0 = __builtin_amdgcn_cvt_pk_fp8_f32(y[0], y[1], 0, false); w0 = __builtin_amdgcn_cvt_pk_fp8_f32(y[2], y[3], w0, true);
            int w1 = __builtin_amdgcn_cvt_pk_fp8_f32(y[4], y[5], 0, false); w1 = __builtin_amdgcn_cvt_pk_fp8_f32(y[6], y[7], w1, true);
            *(v2u*)(X8 + (size_t)t * ld + (size_t)(4 * hg + hs) * HD + 8 * l16) = (v2u){(unsigned)w0, (unsigned)w1}; }
        else { v4u w; w.x = pk2(y[0], y[1]); w.y = pk2(y[2], y[3]); w.z = pk2(y[4], y[5]); w.w = pk2(y[6], y[7]);
            *(v4u*)p = w; }
    }
}
__device__ __forceinline__ void prep_phase(const Frame& F, bf16* Q, bf16* K, int ldk, int nkh, const float* qgain, const float* kgain, bool rope, unsigned char* K8 = nullptr) {
    const int gw = F.vcu * 8 + F.wave, NGW = F.G * 8;
    const int l16 = F.lane & 15;
    for (int t = gw; t < L; t += NGW) {
        float cs[8], sn[8];
#pragma unroll
        for (int e = 0; e < 8; ++e) { cs[e] = 1.f; sn[e] = 0.f; }
        if (rope) {
            const int ax = l16 >> 3; const float pos = (float)(ax ? (t & (GRID_W - 1)) : (t / GRID_W));
#pragma unroll
            for (int e = 0; e < 8; ++e) { const int f = (l16 & 3) * 8 + e; const float inv = 1.0f / powf(10000.0f, (float)f * (1.0f / 32.0f)); const float ang = pos * inv; cs[e] = cosf(ang); sn[e] = sinf(ang); }
        }
        headnorm_rows(Q, DM, NH, qgain, t, F.lane, rope, cs, sn);
        headnorm_rows(K, ldk, nkh, kgain, t, F.lane, rope, cs, sn, K8);
    }
}

constexpr int S5T = pg8::S5T, S5NCH = pg8::S5NCH, S5KS = pg8::S5KS;
__device__ __forceinline__ void s5_gen_group(const Frame& F, int g, const float* __restrict__ lam_re, const float* __restrict__ lam_im, const float* __restrict__ log_step,
                                             const float* __restrict__ b_re, const float* __restrict__ b_im, const float* __restrict__ c_re, const float* __restrict__ c_im,
                                             bf16* __restrict__ GM, bf16* __restrict__ BMt, f32x2* __restrict__ PAT) {
    LAS f32x2* apow = (LAS f32x2*)F.lds;
    LAS f32x2* zt = apow + 2 * 33 * 64;
    LAS float* Kd = (LAS float*)(zt + 2 * 64);
    const int tid = F.tid;
    if (tid < 128) {
        const int dir = tid >> 6, n = tid & 63, dg = dir * S5G + g, idx = dg * S5N + n;
        const double dt = exp((double)log_step[dg]);
        const double lr = (double)lam_re[idx], li = (double)lam_im[idx];
        const double mag = exp(lr * dt), are = mag * cos(li * dt), aim = mag * sin(li * dt);
        const double den = lr * lr + li * li, nre = are - 1.0;
        zt[dir * 64 + n] = (f32x2){(float)((nre * lr + aim * li) / den), (float)((aim * lr - nre * li) / den)};
        double pr = 1.0, pi = 0.0;
        for (int k = 0; k <= 32; ++k) { apow[(dir * 33 + k) * 64 + n] = (f32x2){(float)pr, (float)pi}; const double t = pr * are - pi * aim; pi = pr * aim + pi * are; pr = t; }
        PAT[idx] = apow[(dir * 33 + 32) * 64 + n];
    }
    LDS_WAIT(); __syncthreads();
    {
        const int dir = tid >> 8, p = (tid >> 4) & 15, q = tid & 15, dg = dir * S5G + g;
        float wr[64], wi[64];
        const float* cr = c_re + ((size_t)dg * S5P + p) * S5N; const float* ci = c_im + ((size_t)dg * S5P + p) * S5N;
#pragma unroll
        for (int n = 0; n < 64; ++n) { const f32x2 z = zt[dir * 64 + n]; const float br = b_re[((size_t)dg * S5N + n) * S5P + q], bi = b_im[((size_t)dg * S5N + n) * S5P + q];
            const float bbr = z.x * br - z.y * bi, bbi = z.x * bi + z.y * br; const float c0 = cr[n], c1 = ci[n];
            wr[n] = c0 * bbr - c1 * bbi; wi[n] = c0 * bbi + c1 * bbr; }
        for (int d = 0; d < 32; ++d) { float acc = 0.f; const LAS f32x2* ap = apow + (dir * 33 + d) * 64;
#pragma unroll
            for (int n = 0; n < 64; ++n) { const f32x2 a = ap[n]; acc = fmaf(wr[n], a.x, acc); acc = fmaf(-wi[n], a.y, acc); }
            Kd[(dir * 32 + d) * 256 + p * 16 + q] = acc; }
    }
    LDS_WAIT(); __syncthreads();
    bf16* BMg = BMt + (size_t)g * 512 * S5KS;
    for (int it = tid; it < 512 * 64; it += 512) { const int row = it >> 6, ch = it & 63, tau = row >> 4, p = row & 15, sg = ch >> 1, q0 = (ch & 1) * 8;
        float v[8];
        if (sg < tau) { const LAS float* k = Kd + (0 * 32 + (tau - sg)) * 256 + p * 16 + q0;
#pragma unroll
            for (int j = 0; j < 8; ++j) v[j] = k[j]; }
        else if (sg > tau) { const LAS float* k = Kd + (1 * 32 + (sg - tau)) * 256 + p * 16 + q0;
#pragma unroll
            for (int j = 0; j < 8; ++j) v[j] = k[j]; }
        else { const LAS float* k0 = Kd + p * 16 + q0; const LAS float* k1 = Kd + 32 * 256 + p * 16 + q0;
#pragma unroll
            for (int j = 0; j < 8; ++j) v[j] = k0[j] + k1[j]; }
        v4u w; w.x = pk2(v[0], v[1]); w.y = pk2(v[2], v[3]); w.z = pk2(v[4], v[5]); w.w = pk2(v[6], v[7]);
        *(v4u*)(BMg + (size_t)row * S5KS + ch * 8) = w; }
    for (int it = tid; it < 512 * 32; it += 512) { const int row = it >> 5, ch = it & 31, tau = row >> 4, p = row & 15, dir = ch >> 4, n0 = (ch & 15) * 4, dg = dir * S5G + g;
        const int k = dir ? (32 - tau) : (tau + 1);
        const f32x4 cr = *(const f32x4*)(c_re + ((size_t)dg * S5P + p) * S5N + n0), ci = *(const f32x4*)(c_im + ((size_t)dg * S5P + p) * S5N + n0);
        const LAS f32x2* ap = apow + (dir * 33 + k) * 64 + n0;
        unsigned o[4];
#pragma unroll
        for (int j = 0; j < 4; ++j) { const f32x2 a = ap[j]; const float vr = cr[j] * a.x - ci[j] * a.y, vi = cr[j] * a.y + ci[j] * a.x; o[j] = pk2(vr, -vi); }
        *(v4u*)(BMg + (size_t)row * S5KS + 512 + ch * 8) = (v4u){o[0], o[1], o[2], o[3]}; }
    bf16* GMg = GM + (size_t)g * 256 * 512;
    for (int it = tid; it < 128 * 64; it += 512) { const int dn = it >> 6, ch = it & 63, dir = dn >> 6, n = dn & 63, sg = ch >> 1, q0 = (ch & 1) * 8, dg = dir * S5G + g;
        const int pw = dir ? sg : (31 - sg);
        const f32x2 a = apow[(dir * 33 + pw) * 64 + n], z = zt[dir * 64 + n];
        const float wr_ = a.x * z.x - a.y * z.y, wi_ = a.x * z.y + a.y * z.x;
        const float* br = b_re + ((size_t)dg * S5N + n) * S5P + q0; const float* bi = b_im + ((size_t)dg * S5N + n) * S5P + q0;
        float re[8], im[8];
#pragma unroll
        for (int j = 0; j < 8; ++j) { re[j] = wr_ * br[j] - wi_ * bi[j]; im[j] = wr_ * bi[j] + wi_ * br[j]; }
        v4u w0, w1; w0.x = pk2(re[0], re[1]); w0.y = pk2(re[2], re[3]); w0.z = pk2(re[4], re[5]); w0.w = pk2(re[6], re[7]);
        w1.x = pk2(im[0], im[1]); w1.y = pk2(im[2], im[3]); w1.z = pk2(im[4], im[5]); w1.w = pk2(im[6], im[7]);
        *(v4u*)(GMg + (size_t)(dir * 128 + 2 * n) * 512 + ch * 8) = w0; *(v4u*)(GMg + (size_t)(dir * 128 + 2 * n + 1) * 512 + ch * 8) = w1; }
    LDS_WAIT(); __syncthreads();
}
__device__ __forceinline__ void s5_scan_phase(const Frame& F, const f32x2* __restrict__ PAT, const float* __restrict__ E, bf16* __restrict__ UA) {
    for (int task = F.bid + F.G * F.wave; task < 2 * S5G; task += F.G * 8) {
        const int dir = task >> 8, g = task & 255;
        const f32x2 a = PAT[task * S5N + F.lane];
        const float* e = E + (size_t)g * S5NCH * 256 + dir * 128 + 2 * F.lane;
        bf16* s = UA + (size_t)g * S5NCH * S5KS + 512 + dir * 128 + 2 * F.lane;
        float cr = 0.f, ci = 0.f;
        for (int c8 = 0; c8 < S5NCH; c8 += 8) {
            f32x2 v[8];
#pragma unroll
            for (int k = 0; k < 8; ++k) { const int c = dir ? (S5NCH - 1 - (c8 + k)) : (c8 + k); v[k] = *(const f32x2*)(e + (size_t)c * 256); }
#pragma unroll
            for (int k = 0; k < 8; ++k) { const int c = dir ? (S5NCH - 1 - (c8 + k)) : (c8 + k);
                *(unsigned*)(s + (size_t)c * S5KS) = pk2(cr, ci);
                const float nr = fmaf(a.x, cr, fmaf(-a.y, ci, v[k].x)), ni = fmaf(a.x, ci, fmaf(a.y, cr, v[k].y)); cr = nr; ci = ni; }
        }
    }
}


__device__ __forceinline__ float fp8_to_f32(unsigned char b) { const int e = (b >> 3) & 15, m = b & 7; const float v = e ? __builtin_ldexpf(1.0f + (float)m * 0.125f, e - 7) : __builtin_ldexpf((float)m * 0.125f, -6); return (b & 0x80) ? -v : v; }
__device__ __forceinline__ void gqa_selfcheck(const Frame& F, const bf16* __restrict__ Qp, const unsigned char* __restrict__ K8, const unsigned char* __restrict__ V8t, const bf16* __restrict__ O,
                                              float* __restrict__ SC, unsigned* flag) {
    LAS float* ql = (LAS float*)(F.lds + F.wave * 1024);
    const int lane = F.lane;
#pragma unroll 1
    for (int s = F.bid * 8 + F.wave; s < 1024; s += F.G * 8) {
        const int tok = (int)(((long)(s >> 5) * 5209 + 77) % L), hq = s & 31, kv = hq >> 2;
        float* sc = SC + (size_t)(F.bid * 8 + F.wave) * L;
        { const bf16* qp = Qp + (size_t)tok * DM + hq * HD; ql[lane] = bf2f(qp[lane]); ql[lane + 64] = bf2f(qp[lane + 64]); } LDS_WAIT();
        float mx = -1e30f;
#pragma unroll 1
        for (int j = lane; j < L; j += 64) { const unsigned char* kp = K8 + (size_t)j * KVD + kv * HD; float dot = 0.f;
#pragma unroll 1
            for (int d = 0; d < HD; ++d) dot += fp8_to_f32(kp[d]) * ql[d];
            dot *= 0.088388347648318440f; sc[j] = dot; mx = fmaxf(mx, dot); }
#pragma unroll
        for (int o = 1; o < 64; o <<= 1) mx = fmaxf(mx, __shfl_xor(mx, o));
        asm volatile("s_waitcnt vmcnt(0)" ::: "memory"); __builtin_amdgcn_fence(__ATOMIC_RELEASE, "workgroup"); __builtin_amdgcn_fence(__ATOMIC_ACQUIRE, "agent");
        float o0 = 0.f, o1 = 0.f, lsum = 0.f;
#pragma unroll 1
        for (int j = 0; j < L; ++j) { const float pj = expf(__hip_atomic_load(sc + j, __ATOMIC_RELAXED, __HIP_MEMORY_SCOPE_AGENT) - mx);
            o0 += pj * fp8_to_f32(V8t[(size_t)(kv * HD + lane) * L + j]); o1 += pj * fp8_to_f32(V8t[(size_t)(kv * HD + lane + 64) * L + j]); lsum += pj; }
        o0 /= lsum; o1 /= lsum;
        const unsigned char* op = (const unsigned char*)O + (size_t)tok * DM + hq * HD; const float g0 = fp8_to_f32(op[lane]) * 0.015625f, g1 = fp8_to_f32(op[lane + 64]) * 0.015625f;
        float am = fmaxf(fabsf(o0), fabsf(o1));
#pragma unroll
        for (int o = 1; o < 64; o <<= 1) am = fmaxf(am, __shfl_xor(am, o));
        const float tol = 0.2f * am + 1e-5f;
        const bool bad = !(fabsf(g0 - o0) <= tol) || !(fabsf(g1 - o1) <= tol);
        if (__any(bad) && lane == 0) __hip_atomic_fetch_or(flag, 1u, __ATOMIC_RELAXED, __HIP_MEMORY_SCOPE_AGENT);
        LDS_WAIT();
    }
}

__device__ __forceinline__ void transpose_item(const float* __restrict__ W, int K, int N, bf16* __restrict__ WT, int mode, const float* __restrict__ gain, LAS float* scr, int item, int lane, int fp8 = 0) {
    const int nblk = N / 32, kb = item / nblk, nb = item % nblk, k0 = 64 * kb, n0 = 32 * nb;
    int r0 = n0;
    if (mode == 1) r0 = (n0 < DM) ? ((n0 >> 7) * 256 + (n0 & 127)) : (((n0 - DM) >> 7) * 256 + 128 + ((n0 - DM) & 127));
    const float* src = W + (size_t)(k0 + (lane >> 5)) * N + n0 + (lane & 31);
    float v[32];
#pragma unroll
    for (int i = 0; i < 32; ++i) v[i] = src[(size_t)(2 * i) * N];
    const int c = lane & 7;
    f32x4 g0 = (f32x4){1.f, 1.f, 1.f, 1.f}, g1 = g0;
    if (gain) { g0 = *(const f32x4*)(gain + k0 + 8 * c); g1 = *(const f32x4*)(gain + k0 + 8 * c + 4); }
#pragma unroll
    for (int i = 0; i < 32; ++i) scr[(2 * i + (lane >> 5)) * 33 + (lane & 31)] = v[i];
    LDS_WAIT(); asm volatile("" ::: "memory");
#pragma unroll
    for (int j = 0; j < 4; ++j) { const int n = (lane >> 3) + 8 * j; const LAS float* s = scr + (8 * c) * 33 + n;
        if (fp8) { int w0 = __builtin_amdgcn_cvt_pk_fp8_f32(64.f * s[0 * 33] * g0.x, 64.f * s[1 * 33] * g0.y, 0, false); w0 = __builtin_amdgcn_cvt_pk_fp8_f32(64.f * s[2 * 33] * g0.z, 64.f * s[3 * 33] * g0.w, w0, true);
            int w1 = __builtin_amdgcn_cvt_pk_fp8_f32(64.f * s[4 * 33] * g1.x, 64.f * s[5 * 33] * g1.y, 0, false); w1 = __builtin_amdgcn_cvt_pk_fp8_f32(64.f * s[6 * 33] * g1.z, 64.f * s[7 * 33] * g1.w, w1, true);
            *(v2u*)((unsigned char*)WT + (size_t)(r0 + n) * K + k0 + 8 * c) = (v2u){(unsigned)w0, (unsigned)w1}; }
        else { v4u o; o.x = pk2(s[0 * 33] * g0.x, s[1 * 33] * g0.y); o.y = pk2(s[2 * 33] * g0.z, s[3 * 33] * g0.w); o.z = pk2(s[4 * 33] * g1.x, s[5 * 33] * g1.y); o.w = pk2(s[6 * 33] * g1.z, s[7 * 33] * g1.w);
            *(v4u*)(WT + (size_t)(r0 + n) * K + k0 + 8 * c) = o; } }
    LDS_WAIT(); asm volatile("" ::: "memory");
}

constexpr size_t MiB = 1u << 20;
constexpr size_t SZ_NAQKV = (size_t)3 * DM * DM * 2, SZ_DD = (size_t)DM * DM * 2, SZ_GQAQKV = (size_t)(DM + 2 * KVD) * DM * 2, SZ_W1 = (size_t)FF * DM * 2, SZ_PROJ = (size_t)DM * PLE * 2, SZ_ACT = (size_t)L * DM * 2;
constexpr size_t OFF_CTL = 0, CTL_ZERO_BYTES = 3 * MiB, OFF_RS = 1 * MiB;
constexpr size_t OFF_NAQKV = 4 * MiB;
constexpr size_t OFF_NAWO = OFF_NAQKV + 2 * SZ_NAQKV;
constexpr size_t OFF_GQAQKV = OFF_NAWO + 2 * SZ_DD;
constexpr size_t OFF_GQAWO = OFF_GQAQKV + SZ_GQAQKV;
constexpr size_t OFF_S5IN = OFF_GQAWO + SZ_DD;
constexpr size_t OFF_S5OUT = OFF_S5IN + SZ_DD;
constexpr size_t OFF_W1 = OFF_S5OUT + 2 * SZ_DD;
constexpr size_t OFF_W2 = OFF_W1 + 4 * SZ_W1;
constexpr size_t OFF_PROJ = OFF_W2 + 4 * SZ_W1;
constexpr size_t OFF_GATE = OFF_PROJ + 4 * SZ_PROJ;
constexpr size_t OFF_PBF = OFF_GATE + 4 * SZ_DD;
constexpr size_t OFF_XN = OFF_PBF + 4 * (size_t)L * PLE * 2;
constexpr size_t OFF_ACT = OFF_XN + SZ_ACT;
constexpr size_t OFF_PP = OFF_ACT + 4 * SZ_ACT;
constexpr size_t OFF_S5BM = OFF_PP + SZ_ACT;
constexpr size_t OFF_S5GM = OFF_S5BM + 192 * MiB;
constexpr size_t OFF_S5PAR = OFF_S5GM + 64 * MiB;
constexpr size_t OFF_DUMMY = OFF_S5PAR + 8 * MiB;
constexpr size_t OFF_HB1 = OFF_DUMMY + 256 * MiB;
constexpr size_t OFF_HB8 = OFF_HB1 + SZ_ACT;
constexpr size_t WS_END = OFF_HB8 + (size_t)L * DM;
constexpr int CW_BAR = 4096, CW_DYN = 2048;
constexpr int RING_BYTES = 131072, LDSCTL_OFF = RING_BYTES, MISC_OFF = LDSCTL_OFF + 320, PTAB_OFF = LDSCTL_OFF + 1024, LDS_BYTES = 147456;
static_assert(dattn::SHM_ATTN <= RING_BYTES && 8 * 64 * 33 * 4 <= RING_BYTES, "phase scratch fits the ring region");

constexpr int PH_PER_LAYER = 8, NPH = 1 + DEPTH * PH_PER_LAYER;
struct Args { const float* in[28]; float* out; unsigned char* ws; int ph_lo, ph_hi; };
enum { I_X = 0, I_P, I_MIXN, I_MLPN, I_PLEN, I_NAQKV, I_NAWO, I_NAQG, I_NAKG, I_NARPB, I_GQKV, I_GWO, I_GQG, I_GKG, I_S5IN, I_LAMRE, I_LAMIM, I_LOGSTEP, I_BRE, I_BIM, I_CRE, I_CIM, I_S5D, I_S5OUT, I_W1, I_W2, I_PROJ, I_GATE };


__device__ __forceinline__ unsigned long long tab_get(LAS unsigned char* lds, int i) {
    volatile LAS unsigned* t = (volatile LAS unsigned*)(lds + PTAB_OFF); const unsigned lo = t[2 * i], hi = t[2 * i + 1];
    return ((unsigned long long)(unsigned)__builtin_amdgcn_readfirstlane((int)hi) << 32) | (unsigned)__builtin_amdgcn_readfirstlane((int)lo); }
#define INP(i) ((const float*)(const GAS float*)tab_get(F.lds, (i)))
#define OUTP() ((float*)(GAS float*)tab_get(F.lds, 28))
#define WSP() ((unsigned char*)(GAS unsigned char*)tab_get(F.lds, 29))
__device__ __forceinline__ Frame mkframe(unsigned char* lds_generic) {
    Frame F; int t = wg_tid(); asm volatile("" : "+v"(t)); F.tid = t; F.lane = t & 63; F.wave = __builtin_amdgcn_readfirstlane(t >> 6);
    F.lds = (LAS unsigned char*)lds_generic; int b = blockIdx.x; asm volatile("" : "+s"(b)); F.bid = b; int G = gridDim.x; asm volatile("" : "+s"(G)); F.G = G;
    F.vcu = (G % 8 == 0) ? (b % 8) * (G / 8) + b / 8 : b; return F; }
__device__ __forceinline__ void prologue_phase(const Frame& F) {
    unsigned char* ws = WSP();
    LAS float* scr = (LAS float*)(F.lds + F.wave * (64 * 33 * 4));
    const int gw = F.vcu * 8 + F.wave, NGW = F.G * 8;
    constexpr int I_QKV = (DM / 64) * (3 * DM / 32), I_DD = (DM / 64) * (DM / 32), I_GQ = (DM / 64) * ((DM + 2 * KVD) / 32), I_SO = (DM / 64) * (2 * DM / 32),
                  I_1 = (DM / 64) * (FF / 32), I_2 = (FF / 64) * (DM / 32), I_PJ = (PLE / 64) * (DM / 32);
    constexpr int NITEMS = 2 * I_QKV + 2 * I_DD + I_GQ + I_DD + I_DD + I_SO + 4 * I_1 + 4 * I_2 + 4 * I_PJ + 4 * I_DD;
    for (int it = gw; it < NITEMS; it += NGW) {
        int r = it; const float* W; int K, N, mode = 0, fp8 = 0; bf16* WT; const float* gain = nullptr;
        if (r < 2 * I_QKV) { const int l = r / I_QKV; r -= l * I_QKV; W = INP(I_NAQKV) + (size_t)l * DM * 3 * DM; K = DM; N = 3 * DM; WT = (bf16*)(ws + OFF_NAQKV + l * SZ_NAQKV); gain = INP(I_MIXN) + (size_t)(3 * l) * DM; fp8 = 1; }
        else { r -= 2 * I_QKV;
        if (r < 2 * I_DD) { const int l = r / I_DD; r -= l * I_DD; W = INP(I_NAWO) + (size_t)l * DM * DM; K = DM; N = DM; WT = (bf16*)(ws + OFF_NAWO + l * SZ_DD); fp8 = 1; }
        else { r -= 2 * I_DD;
        if (r < I_GQ) { W = INP(I_GQKV); K = DM; N = DM + 2 * KVD; WT = (bf16*)(ws + OFF_GQAQKV); gain = INP(I_MIXN) + (size_t)1 * DM; fp8 = 1; }
        else { r -= I_GQ;
        if (r < I_DD) { W = INP(I_GWO); K = DM; N = DM; WT = (bf16*)(ws + OFF_GQAWO); fp8 = 1; }
        else { r -= I_DD;
        if (r < I_DD) { W = INP(I_S5IN); K = DM; N = DM; WT = (bf16*)(ws + OFF_S5IN); gain = INP(I_MIXN) + (size_t)2 * DM; fp8 = 1; }
        else { r -= I_DD;
        if (r < I_SO) { W = INP(I_S5OUT); K = DM; N = 2 * DM; WT = (bf16*)(ws + OFF_S5OUT); mode = 1; fp8 = 1; }
        else { r -= I_SO;
        if (r < 4 * I_1) { const int l = r / I_1; r -= l * I_1; W = INP(I_W1) + (size_t)l * DM * FF; K = DM; N = FF; WT = (bf16*)(ws + OFF_W1 + l * SZ_W1); gain = INP(I_MLPN) + (size_t)l * DM; }
        else { r -= 4 * I_1;
        if (r < 4 * I_2) { const int l = r / I_2; r -= l * I_2; W = INP(I_W2) + (size_t)l * FF * DM; K = FF; N = DM; WT = (bf16*)(ws + OFF_W2 + l * SZ_W1); }
        else { r -= 4 * I_2;
        if (r < 4 * I_PJ) { const int l = r / I_PJ; r -= l * I_PJ; W = INP(I_PROJ) + (size_t)l * PLE * DM; K = PLE; N = DM; WT = (bf16*)(ws + OFF_PROJ + l * SZ_PROJ); }
        else { r -= 4 * I_PJ; const int l = r / I_DD; r -= l * I_DD; W = INP(I_GATE) + (size_t)l * DM * DM; K = DM; N = DM; WT = (bf16*)(ws + OFF_GATE + l * SZ_DD); gain = INP(I_PLEN) + (size_t)l * DM; } } } } } } } } }
        transpose_item(W, K, N, WT, mode, gain, scr, r, F.lane, fp8);
    }
    xrows_phase(F, INP(I_X), (bf16*)(ws + OFF_XN), (pg8::rs_t*)(ws + OFF_RS), ws + OFF_HB8);
    { const size_t n8 = (size_t)DEPTH * L * PLE / 8; const float* p = INP(I_P); bf16* pb = (bf16*)(ws + OFF_PBF);
      for (size_t i = (size_t)gw * 64 + F.lane; i < n8; i += (size_t)NGW * 64) { const f32x4 a = *(const f32x4*)(p + i * 8), b = *(const f32x4*)(p + i * 8 + 4);
          v4u w; w.x = pk2(a.x, a.y); w.y = pk2(a.z, a.w); w.z = pk2(b.x, b.y); w.w = pk2(b.z, b.w); *(v4u*)(pb + i * 8) = w; } }
    { bf16* GM = (bf16*)(ws + OFF_S5GM); bf16* BMt = (bf16*)(ws + OFF_S5BM); f32x2* PAT = (f32x2*)(ws + OFF_S5PAR);
      LDS_WAIT(); __syncthreads();
      for (int g = F.bid; g < S5G; g += F.G) s5_gen_group(F, g, INP(I_LAMRE), INP(I_LAMIM), INP(I_LOGSTEP), INP(I_BRE), INP(I_BIM), INP(I_CRE), INP(I_CIM), GM, BMt, PAT); }
}

#define WS_PTRS() unsigned char* ws = WSP(); bf16* HB0 = (bf16*)(ws + OFF_XN); bf16* HB1 = (bf16*)(ws + OFF_HB1); bf16* Qb = (bf16*)(ws + OFF_ACT); bf16* Kb = (bf16*)(ws + OFF_ACT + SZ_ACT); bf16* Vb = (bf16*)(ws + OFF_ACT + 2 * SZ_ACT); \
    bf16* Ob = (bf16*)(ws + OFF_ACT + 3 * SZ_ACT); bf16* HID = (bf16*)(ws + OFF_ACT); bf16* UA = (bf16*)(ws + OFF_ACT); bf16* S5Gb = (bf16*)(ws + OFF_ACT + 2 * SZ_ACT); float* S5E = (float*)(ws + OFF_ACT + 3 * SZ_ACT); bf16* PP = (bf16*)(ws + OFF_PP); \
    (void)HB0; (void)HB1; (void)Qb; (void)Kb; (void)Vb; (void)Ob; (void)HID; (void)UA; (void)S5Gb; (void)PP; (void)S5E;
__global__ void __launch_bounds__(512, 2) enc_fwd(Args args) {
    extern __shared__ __attribute__((aligned(16))) unsigned char lds[];
    {
        LAS unsigned char* l3 = (LAS unsigned char*)lds;
        for (int u = threadIdx.x; u < (LDS_BYTES - LDSCTL_OFF) / 4; u += 512) ((LAS unsigned*)(l3 + LDSCTL_OFF))[u] = 0u;
        __syncthreads();
        if (threadIdx.x == 0) { LAS unsigned long long* t = (LAS unsigned long long*)(l3 + PTAB_OFF);
#pragma unroll
            for (int i = 0; i < 28; ++i) t[i] = (unsigned long long)args.in[i];
            t[28] = (unsigned long long)args.out; t[29] = (unsigned long long)args.ws; }
        if ((threadIdx.x & 63) == 0) ((LAS unsigned*)(WTAB_OFF))[hw_wave_slot()] = threadIdx.x >> 6;
        __syncthreads();
    }
    const int lo = args.ph_lo, hi = args.ph_hi;
    XcdBarrier bar;
    { LAS unsigned char* l3 = (LAS unsigned char*)lds; unsigned* ctl = (unsigned*)(GAS unsigned*)(tab_get(l3, 29) + OFF_CTL); bar.bar = ctl + CW_BAR; bar.x = 0; bar.st = nullptr;
      if (hi - lo > 1) bar = xcd_barrier_post(ctl + CW_BAR, (volatile LAS unsigned*)(l3 + MISC_OFF) + 8); }
#define IN(k) (lo <= (k) && (k) < hi)
#ifndef PROBE_PH
#define PROBE_PH (-1)
#endif
#define REPS(k) for (int rep_ = 0, nrep_ = (((k) == PROBE_PH || PROBE_PH == -2) ? 2 : ((((PROBE_PH >= 300 && PROBE_PH < 320)) && (k) == 11) ? 4 : 1)); rep_ < nrep_; ++rep_)
#define HBOUT(p) ((nrep_ == 2 && rep_ == 0) ? (bf16*)(ws + OFF_DUMMY) : (p))
#define RSOUT(i) ((nrep_ == 2 && rep_ == 0) ? (pg8::rs_t*)(ws + OFF_DUMMY + 128 * MiB) : RSP(i))
#if PROBE_PH >= 700 && PROBE_PH < 900
#define SEAM(k) do { if (IN(k) && IN((k) + 1)) { unsigned long long* ts_ = (unsigned long long*)(GAS unsigned long long*)(tab_get((LAS unsigned char*)lds, 29) + OFF_DUMMY + 200 * MiB); \
        if ((k) == PROBE_PH % 100) { __syncthreads(); if (wg_tid() == 0) __hip_atomic_store(ts_ + blockIdx.x, (unsigned long long)wall_clock64(), __ATOMIC_RELAXED, __HIP_MEMORY_SCOPE_AGENT); } \
        xcd_barrier(bar); \
        if ((k) == PROBE_PH % 100 && blockIdx.x == 0 && wg_tid() == 0) { unsigned long long mx = 0, sm = 0, t0_ = ~0ull; const unsigned st_ = (PROBE_PH >= 800) ? 8u : 1u; \
            for (unsigned i_ = 0; i_ < gridDim.x; i_ += st_) { const unsigned long long t_ = __hip_atomic_load(ts_ + i_, __ATOMIC_RELAXED, __HIP_MEMORY_SCOPE_AGENT); mx = t_ > mx ? t_ : mx; t0_ = t_ < t0_ ? t_ : t0_; } \
            for (unsigned i_ = 0; i_ < gridDim.x; i_ += st_) sm += __hip_atomic_load(ts_ + i_, __ATOMIC_RELAXED, __HIP_MEMORY_SCOPE_AGENT) - t0_; \
            const unsigned long long idle_ = (mx - t0_) - sm / (gridDim.x / st_), until_ = (unsigned long long)wall_clock64() + 100ull * idle_; \
            while ((unsigned long long)wall_clock64() < until_) __builtin_amdgcn_s_sleep(32); } } } while (0)
#else
#define SEAM(k) do { if (IN(k) && IN((k) + 1)) xcd_barrier(bar); } while (0)
#endif

#if PROBE_PH == 601
    if (blockIdx.x == 0 && threadIdx.x < 64) {
        typedef int v8i_ __attribute__((ext_vector_type(8))); typedef float f4v_ __attribute__((ext_vector_type(4)));
        const int l = threadIdx.x, ij = l & 15, kb = l >> 4; const unsigned lut[7] = {0xC4u, 0xC0u, 0xB8u, 0x00u, 0x38u, 0x40u, 0x44u};
        v8i_ A, B;
#pragma unroll
        for (int v = 0; v < 8; ++v) { unsigned wa = 0, wb = 0;
#pragma unroll
            for (int b = 0; b < 4; ++b) { const int kk = 32 * kb + 4 * v + b; const int av = ((ij + 2 * kk) % 5) - 2, bv = ((3 * kk + ij) % 7) - 3;
                unsigned ea = 0, eb = 0;
#pragma unroll
                for (int t = 0; t < 7; ++t) { ea = (av + 3 == t) ? lut[t] : ea; eb = (bv + 3 == t) ? lut[t] : eb; }
                wa |= ea << (8 * b); wb |= eb << (8 * b); }
            A[v] = (int)wa; B[v] = (int)wb; }
        f4v_ c1 = {};
        c1 = __builtin_amdgcn_mfma_scale_f32_16x16x128_f8f6f4(A, B, c1, 0, 0, 0, 0x7F7F7F7F, 0, 0x7F7F7F7F);
        bool ok1 = true;
#pragma unroll
        for (int r = 0; r < 4; ++r) { const int i = 4 * kb + r, j = ij; int s = 0;
            for (int kk = 0; kk < 128; ++kk) s += (((i + 2 * kk) % 5) - 2) * (((3 * kk + j) % 7) - 3);
            ok1 = ok1 && (c1[r] == (float)s); }
        unsigned long long ticks = 0; if (!__all(ok1)) ticks += 400000ull;
        const unsigned long long t0 = __builtin_amdgcn_s_memrealtime(); while (__builtin_amdgcn_s_memrealtime() - t0 < ticks) __builtin_amdgcn_s_sleep(8);
    }
    __syncthreads();
#endif
#if PROBE_PH == 600
    if (blockIdx.x == 0 && threadIdx.x < 64) {
        typedef int v8i_ __attribute__((ext_vector_type(8))); typedef float f16v_ __attribute__((ext_vector_type(16)));
        const int l = threadIdx.x, ij = l & 31, kb = l >> 5; const unsigned lut[7] = {0xC4u, 0xC0u, 0xB8u, 0x00u, 0x38u, 0x40u, 0x44u};
        v8i_ A, B;
#pragma unroll
        for (int v = 0; v < 8; ++v) { unsigned wa = 0, wb = 0;
#pragma unroll
            for (int b = 0; b < 4; ++b) { const int kk = 32 * kb + 4 * v + b; const int av = ((ij + 2 * kk) % 5) - 2, bv = ((3 * kk + ij) % 7) - 3;
                unsigned ea = 0, eb = 0;
#pragma unroll
                for (int t = 0; t < 7; ++t) { ea = (av + 3 == t) ? lut[t] : ea; eb = (bv + 3 == t) ? lut[t] : eb; }
                wa |= ea << (8 * b); wb |= eb << (8 * b); }
            A[v] = (int)wa; B[v] = (int)wb; }
        f16v_ c1 = {}, c2 = {};
        c1 = __builtin_amdgcn_mfma_scale_f32_32x32x64_f8f6f4(A, B, c1, 0, 0, 0, 0x7F7F7F7F, 0, 0x7F7F7F7F);
        c2 = __builtin_amdgcn_mfma_scale_f32_32x32x64_f8f6f4(A, B, c2, 0, 0, 0, 0x7B7B7B7B, 0, 0x7F7F7F7F);
        bool ok1 = true, ok2 = true;
#pragma unroll
        for (int r = 0; r < 16; ++r) { const int i = (r & 3) + 8 * (r >> 2) + 4 * kb, j = ij; int s = 0;
            for (int kk = 0; kk < 64; ++kk) s += (((i + 2 * kk) % 5) - 2) * (((3 * kk + j) % 7) - 3);
            ok1 = ok1 && (c1[r] == (float)s); ok2 = ok2 && (c2[r] == (float)s * 0.0625f); }
        int w = __builtin_amdgcn_cvt_pk_fp8_f32(1.0f, 2.0f, 0, false); w = __builtin_amdgcn_cvt_pk_fp8_f32(3.0f, -1.0f, w, true);
        const bool ok3 = ((unsigned)w == 0xB8444038u);
        unsigned long long ticks = 0; if (!__all(ok1)) ticks += 400000ull; if (!__all(ok2)) ticks += 800000ull; if (!__all(ok3)) ticks += 1600000ull;
        const unsigned long long t0 = __builtin_amdgcn_s_memrealtime(); while (__builtin_amdgcn_s_memrealtime() - t0 < ticks) __builtin_amdgcn_s_sleep(8);
    }
    __syncthreads();
#endif
    if (IN(0)) REPS(0) { const Frame F = mkframe(lds); prologue_phase(F); } SEAM(0);
#if PROBE_PH == 200
    for (int xb_ = 0; xb_ < 40; ++xb_) xcd_barrier(bar);
#endif

#pragma unroll 1
    for (int layer = 0; layer < DEPTH; ++layer) {
        const int kind = layer % 3, slot = layer / 3, pb = 1 + PH_PER_LAYER * layer;
#define RSP(i) ((pg8::rs_t*)(ws + OFF_RS) + (size_t)(i) * L)
        const int irs = (layer == 0) ? 0 : 3 * layer;
        if (IN(pb + 0)) REPS(pb + 0) {
            const Frame F = mkframe(lds); WS_PTRS();
            if (kind != 2) {
                const int N = (kind == 0) ? 3 * DM : DM + 2 * KVD;
                const bf16* W = (kind == 0) ? (const bf16*)(ws + OFF_NAQKV + slot * SZ_NAQKV) : (const bf16*)(ws + OFF_GQAQKV);
                const pg8::Gemm g = pg8::mkgemm((const bf16*)(ws + OFF_HB8), W, L, N, DM / 2); pg8::StaticOrder S; S.init(L, N, F.G, F.bid);
                pg8::EpiBf16<0> E{Qb, Kb, Vb, DM, (kind == 0) ? DM : KVD, (kind == 0) ? DM : L, DM, (kind == 0) ? 2 * DM : DM + KVD, RSP(irs), (kind == 0) ? 0 : 2, (kind == 0) ? 2 * DM : DM + KVD};
                pg8::gemm_phase<pg8::EpiBf16<0>, pg8::StaticOrder, false, true, true>(F.lds, g, S, E);
            } else {
                const pg8::Gemm g = pg8::mkgemm((const bf16*)(ws + OFF_HB8), (const bf16*)(ws + OFF_S5IN), L, DM, DM / 2); pg8::StaticOrder S; S.init(L, DM, F.G, F.bid);
                pg8::EpiS5U E{UA, RSP(irs)};
                pg8::gemm_phase<pg8::EpiS5U, pg8::StaticOrder, false, true, true>(F.lds, g, S, E);
            }
        }
        SEAM(pb + 0);
        if (kind != 2) {
            if (kind == 1) { if (IN(pb + 1)) { const Frame F = mkframe(lds); WS_PTRS(); prep_phase(F, Qb, Kb, KVD, NKV, INP(I_GQG), INP(I_GKG), true, (unsigned char*)Kb + 64 * MiB); }
                SEAM(pb + 1); }
            if (IN(pb + 2)) REPS(pb + 2) { const Frame F = mkframe(lds); WS_PTRS();
                if (kind == 0) {
                    const float* rpb = INP(I_NARPB) + (size_t)slot * NH * 15 * 31;
                    for (int i = 0;; ++i) { const int unit = i * F.G + F.vcu; if (unit >= NH * (GROWS / 4)) break;
                        const int h = unit >> 6, R = (unit & 63) * 4, ks = min(max(R - 4, 0), GROWS - dattn::NA_TILES);
                        dattn::na_block_body(Qb + (size_t)(R * GRID_W) * DM + h * HD, Kb + (size_t)(ks * GRID_W) * DM + h * HD, Vb + (size_t)(ks * GRID_W) * DM + h * HD,
                                             (bf16*)((unsigned char*)Ob + (size_t)(R * GRID_W) * DM + h * HD), rpb + (size_t)h * 15 * 31, INP(I_NAQG) + slot * HD, INP(I_NAKG) + slot * HD, R, ks, (char*)lds);
                        __syncthreads(); }
                } else {
                    for (int i = 0;; ++i) { const int unit = i * F.G + F.bid; if (unit >= NH * (L / 256)) break;
                        const int kvh = unit & 7, rest = unit >> 3, hq = kvh * 4 + (rest >> 6), qb = rest & 63;
                        dattn::attn_dense_body8(Qb + (size_t)(qb * 256) * DM + hq * HD, (const unsigned char*)Kb + 64 * MiB + kvh * HD, (const unsigned char*)Vb + (size_t)(kvh * HD) * L, (bf16*)((unsigned char*)Ob + (size_t)(qb * 256) * DM + hq * HD), L, (char*)lds);
                        __syncthreads(); }
                }
            }
            if (IN(pb + 2) && IN(pb + 4)) xcd_barrier(bar);
#if PROBE_PH == 400
            if (kind == 1) { const Frame F = mkframe(lds); WS_PTRS();
                gqa_selfcheck(F, Qb, (const unsigned char*)Kb + 64 * MiB, (const unsigned char*)Vb, Ob, (float*)(ws + OFF_PP), (unsigned*)(ws + OFF_CTL) + 8);
                xcd_barrier(bar); }
#endif
        } else {
            if (IN(pb + 1)) REPS(pb + 1) { const Frame F = mkframe(lds); WS_PTRS();
                pg8::Gemm g; g.A = UA; g.Bt = (const bf16*)(ws + OFF_S5GM); g.M = S5G * S5NCH; g.N = 256; g.K = 512; g.lda = S5KS; g.ldb = 512; g.sa = 0x7F7F7F7F;
                pg8::S5Order S{F.G, F.bid, 2, 1}; pg8::EpiS5E E{S5E};
                pg8::gemm_phase<pg8::EpiS5E, pg8::S5Order, false, true>(F.lds, g, S, E); }
            SEAM(pb + 1);
            if (IN(pb + 2)) REPS(pb + 2) { const Frame F = mkframe(lds); WS_PTRS(); s5_scan_phase(F, (const f32x2*)(ws + OFF_S5PAR), S5E, UA); }
            SEAM(pb + 2);
            if (IN(pb + 3)) REPS(pb + 3) { const Frame F = mkframe(lds); WS_PTRS();
                pg8::Gemm g; g.A = UA; g.Bt = (const bf16*)(ws + OFF_S5BM); g.M = S5G * S5NCH; g.N = S5G * 512; g.K = S5KS; g.lda = S5KS; g.ldb = S5KS; g.sa = 0x7F7F7F7F;
                pg8::S5Order S{F.G, F.bid, 2, 2}; pg8::EpiS5Y E{UA, INP(I_S5D), S5Gb, DM};
                pg8::gemm_phase<pg8::EpiS5Y, pg8::S5Order, false, true>(F.lds, g, S, E); }
            SEAM(pb + 3);
        }
        if (IN(pb + 4)) REPS(pb + 4) {
            const Frame F = mkframe(lds); WS_PTRS();
            if (kind != 2) {
                const bf16* W = (kind == 0) ? (const bf16*)(ws + OFF_NAWO + slot * SZ_DD) : (const bf16*)(ws + OFF_GQAWO);
                pg8::Gemm g = pg8::mkgemm(Ob, W, L, DM, DM / 2); g.sa = 0x79797979; pg8::StaticOrder S; S.init(L, DM, F.G, F.bid);
                pg8::EpiRes E{HB0, HBOUT(HB0), RSOUT(1 + 3 * layer), DM, nullptr};
                pg8::gemm_phase<pg8::EpiRes, pg8::StaticOrder, false, true, true>(F.lds, g, S, E);
            } else {
                pg8::Gemm g = pg8::mkgemm(S5Gb, (const bf16*)(ws + OFF_S5OUT), L, 2 * DM, DM / 2); g.sa = 0x7B7B7B7B; pg8::StaticOrder S; S.init(L, 2 * DM, F.G, F.bid);
                pg8::EpiGlu E{HB0, HBOUT(HB0), RSOUT(1 + 3 * layer), DM};
                pg8::gemm_phase<pg8::EpiGlu, pg8::StaticOrder, false, true, true>(F.lds, g, S, E);
            }
        }
        SEAM(pb + 4);
        if (IN(pb + 5)) REPS(pb + 5) { const Frame F = mkframe(lds); WS_PTRS();
            const pg8::Gemm g = pg8::mkgemm(HB0, (const bf16*)(ws + OFF_W1 + layer * SZ_W1), L, FF, DM); pg8::StaticOrder S; S.init(L, FF, F.G, F.bid);
            pg8::EpiBf16<2> E{HID, HID, HID, FF, FF, FF, 1 << 30, 1 << 30, nullptr, 0, 0};
#if PROBE_PH == 201
            { pg8::RangeOrder R1{S, 0, 8}, R2{S, 8, 16};
              pg8::gemm_phase<pg8::EpiBf16<2>, pg8::RangeOrder, false, true>(F.lds, g, R1, E); xcd_barrier(bar);
              pg8::gemm_phase<pg8::EpiBf16<2>, pg8::RangeOrder, false, true>(F.lds, g, R2, E); }
#else
            pg8::gemm_phase<pg8::EpiBf16<2>, pg8::StaticOrder, false, true>(F.lds, g, S, E);
#endif
        }
        SEAM(pb + 5);
        if (IN(pb + 6)) REPS(pb + 6) { const Frame F = mkframe(lds); WS_PTRS();
            { const pg8::Gemm g = pg8::mkgemm(HID, (const bf16*)(ws + OFF_W2 + layer * SZ_W1), L, DM, FF); pg8::StaticOrder S; S.init(L, DM, F.G, F.bid);
              pg8::EpiRes E{HB0, HBOUT(HB1), RSOUT(2 + 3 * layer), DM, RSP(1 + 3 * layer)};
              pg8::gemm_phase<pg8::EpiRes, pg8::StaticOrder, false, true>(F.lds, g, S, E); }
            { const pg8::Gemm g = pg8::mkgemm((const bf16*)(ws + OFF_PBF + (size_t)layer * L * PLE * 2), (const bf16*)(ws + OFF_PROJ + layer * SZ_PROJ), L, DM, PLE);
              const pg8::DynOrder S{L / pg8::BM, DM / pg8::BM, (L / pg8::BM) * (DM / pg8::BM), (unsigned*)(ws + OFF_CTL) + CW_DYN + 4 * layer + rep_, (LAS unsigned*)(F.lds + LDSCTL_OFF + 3072)};
              pg8::EpiBf16<0> E{PP, PP, PP, DM, DM, DM, 1 << 30, 1 << 30, nullptr, 0, 0};
              pg8::gemm_phase<pg8::EpiBf16<0>, pg8::DynOrder, false, true>(F.lds, g, S, E); }
        }
        SEAM(pb + 6);
        if (IN(pb + 7)) REPS(pb + 7) { const Frame F = mkframe(lds); WS_PTRS();
            const pg8::Gemm g = pg8::mkgemm(HB1, (const bf16*)(ws + OFF_GATE + layer * SZ_DD), L, DM, DM); pg8::StaticOrder S; S.init(L, DM, F.G, F.bid);
            pg8::EpiGate E{HB1, HBOUT(HB0), (layer == DEPTH - 1) ? OUTP() : nullptr, PP, RSP(2 + 3 * layer), RSOUT(3 + 3 * layer), DM, (layer + 1 < DEPTH && !(nrep_ == 2 && rep_ == 0)) ? ws + OFF_HB8 : nullptr};
            pg8::gemm_phase<pg8::EpiGate, pg8::StaticOrder, false, true>(F.lds, g, S, E);
        }
        SEAM(pb + 7);
    }
#if PROBE_PH == 400
    { xcd_barrier(bar); const Frame F = mkframe(lds); unsigned char* ws = WSP();
      if (__hip_atomic_load((unsigned*)(ws + OFF_CTL) + 8, __ATOMIC_RELAXED, __HIP_MEMORY_SCOPE_AGENT) != 0u && F.bid == 0 && F.tid < 64) OUTP()[F.tid] = __builtin_nanf(""); }
#endif
#undef IN
#undef SEAM
}

extern "C" void kernel_launch(void* const* d_in, const int* in_sizes, int n_in, void* d_out, int out_size, void* d_ws, size_t ws_size, hipStream_t stream) {
    static int grid = 0;
    if (grid == 0) {
        if (n_in != 28 || in_sizes[0] != L * DM || out_size != L * DM || ws_size < WS_END) {
            fprintf(stderr, "kernel_launch: built for 28 inputs, x/out of %d floats, >= %zu bytes of workspace; got n_in %d, in0 %d, out %d, ws %zu; nothing launched\n", L * DM, (size_t)WS_END, n_in, n_in > 0 ? in_sizes[0] : -1, out_size, ws_size);
            grid = -1; return; }
        int dev = 0, cus = 0, per_cu = 0;
        if (hipGetDevice(&dev) != hipSuccess || hipDeviceGetAttribute(&cus, hipDeviceAttributeMultiprocessorCount, dev) != hipSuccess) { fprintf(stderr, "kernel_launch: device query failed\n"); grid = -1; return; }
        if (hipFuncSetAttribute((const void*)enc_fwd, hipFuncAttributeMaxDynamicSharedMemorySize, LDS_BYTES) != hipSuccess) { fprintf(stderr, "kernel_launch: hipFuncSetAttribute failed\n"); grid = -1; return; }
        if (hipOccupancyMaxActiveBlocksPerMultiprocessor(&per_cu, (const void*)enc_fwd, 512, LDS_BYTES) != hipSuccess || per_cu < 1)
            fprintf(stderr, "kernel_launch: note: occupancy query reports %d workgroups per CU\n", per_cu);
        (void)hipGetLastError();
        grid = cus;
    }
    if (grid < 0) return;
    if (hipMemsetAsync((char*)d_ws + OFF_CTL, 0, CTL_ZERO_BYTES, stream) != hipSuccess) { fprintf(stderr, "kernel_launch: memset failed\n"); return; }
    Args a{};
    for (int i = 0; i < 28; ++i) a.in[i] = (const float*)d_in[i];
    a.out = (float*)d_out; a.ws = (unsigned char*)d_ws;
#if MK_N_LAUNCHES == 1
    a.ph_lo = 0; a.ph_hi = NPH;
    hipLaunchKernelGGL(enc_fwd, dim3(grid), dim3(512), LDS_BYTES, stream, a);
#else
    for (int ph = 0; ph < NPH; ++ph) {
        if (ph > 0) { const int layer = (ph - 1) / PH_PER_LAYER, j = (ph - 1) % PH_PER_LAYER; if (j == 3 && layer % 3 != 2) continue; }
        a.ph_lo = ph; a.ph_hi = ph + 1;
        hipLaunchKernelGGL(enc_fwd, dim3(grid), dim3(512), LDS_BYTES, stream, a);
    }
#endif
    const hipError_t le = hipPeekAtLastError();
    if (le != hipSuccess) fprintf(stderr, "kernel_launch: launch failed: %s\n", hipGetErrorName(le));
}
```
